# Optimizing an MI355X kernel written in HIP

```python
import math
import jax
import jax.numpy as jnp
from jax import lax
import numpy as np

D_MODEL = 1024
BATCH = 1
SEQ = 16384
DEPTH = 2

F32 = jnp.float32

RWKV_HEAD_DIM = 64
RWKV_WIDTH = D_MODEL // 4
RWKV_HEADS = RWKV_WIDTH // RWKV_HEAD_DIM
RWKV_DECAY_RANK = 64
RWKV_ICLR_RANK = 64
RWKV_VRES_RANK = 32
RWKV_GATE_RANK = 128
RWKV_GN_EPS = 64e-5
GDN_HEAD_DIM = 128
GDN_WIDTH = D_MODEL // 2
GDN_HEADS = GDN_WIDTH // GDN_HEAD_DIM
GDN_CONV = 4
GDN_CHUNK = 64
RET_HEAD_DIM = 64
RET_WIDTH = D_MODEL // 4
RET_HEADS = RET_WIDTH // RET_HEAD_DIM
RET_CHUNK = 128
ROPE_BASE = 10000.0

MIX_WIDTH = RWKV_WIDTH + GDN_WIDTH + RET_WIDTH
A_COLS = (RWKV_WIDTH, RWKV_WIDTH, RWKV_WIDTH, RWKV_DECAY_RANK, RWKV_ICLR_RANK, RWKV_GATE_RANK)
B_COLS = (GDN_WIDTH, GDN_WIDTH, GDN_WIDTH, GDN_WIDTH, GDN_HEADS, GDN_HEADS)
C_COLS = (RET_WIDTH, RET_WIDTH, RET_WIDTH, RET_WIDTH)
A_SIZE = sum(A_COLS)
B_SIZE = sum(B_COLS)
C_SIZE = sum(C_COLS)
N_IN = A_SIZE + B_SIZE + C_SIZE

N_EXPERTS = 32
TOP_K = 4
D_FF = D_MODEL
SWIGLU_LIMIT = 7.0
SWIGLU_ALPHA = 1.702
MOE_BLOCK = 128

DEEPNORM_ALPHA = (2 * DEPTH) ** 0.25
DEEPNORM_BETA = (8 * DEPTH) ** -0.25
LN_EPS = 1e-5
RMS_EPS = 1e-6

kernel_name = 'hybrid_rwkv7_gdn_retention_moe_deepnorm'


def _split(t, sizes):
    return jnp.split(t, np.cumsum(sizes)[:-1].tolist(), axis=-1)


def _heads(t, n_heads):
    return t.reshape(t.shape[:-1] + (n_heads, t.shape[-1] // n_heads))


def _merge(t):
    return t.reshape(t.shape[:-2] + (t.shape[-2] * t.shape[-1],))


def _layer_norm(x, g, b):
    xf = x.astype(F32)
    mu = jnp.mean(xf, -1, keepdims=True)
    var = jnp.mean(jnp.square(xf - mu), -1, keepdims=True)
    return ((xf - mu) * lax.rsqrt(var + LN_EPS)).astype(x.dtype) * g + b


def _l2norm(t):
    tf = t.astype(F32)
    return tf * lax.rsqrt(jnp.sum(tf * tf, -1, keepdims=True) + 1e-12)


def _group_norm(t, g, b, eps):
    mu = jnp.mean(t, -1, keepdims=True)
    var = jnp.mean(jnp.square(t - mu), -1, keepdims=True)
    return _merge((t - mu) * lax.rsqrt(var + eps)) * g + b


def _rms_head(t, g):
    return _merge(t * lax.rsqrt(jnp.mean(t * t, -1, keepdims=True) + RMS_EPS) * g)


def _token_shift(p):
    return jnp.pad(p, ((0, 0), (1, 0), (0, 0)))[:, :-1]


def _causal_depthwise_conv(x, w):
    k_size, ch = w.shape
    return lax.conv_general_dilated(x, w[:, None, :], window_strides=(1,), padding=[(k_size - 1, 0)],
                                    dimension_numbers=('NWC', 'WIO', 'NWC'), feature_group_count=ch)


def _rotary(t, positions):
    half = t.shape[-1] // 2
    inv_freq = ROPE_BASE ** (-jnp.arange(half, dtype=F32) / half)
    ang = positions.astype(F32)[..., None] * inv_freq
    cos, sin = jnp.cos(ang)[:, :, None, :], jnp.sin(ang)[:, :, None, :]
    t1, t2 = t[..., :half], t[..., half:]
    return jnp.concatenate([t1 * cos - t2 * sin, t1 * sin + t2 * cos], axis=-1)


def _rwkv7_scan(r, w, k, v, a_vec, b_vec):
    bsz, _, n_heads, n = r.shape

    def step(state, inp):
        r_t, w_t, k_t, v_t, a_t, b_t = inp
        sa = jnp.einsum('bhij,bhj->bhi', state, a_t)
        state = (state * w_t[:, :, None, :] + sa[..., None] * b_t[:, :, None, :]
                 + v_t[..., None] * k_t[:, :, None, :])
        return state, jnp.einsum('bhij,bhj->bhi', state, r_t)

    xs = tuple(jnp.moveaxis(t, 1, 0) for t in (r, w, k, v, a_vec, b_vec))
    _, ys = lax.scan(step, jnp.zeros((bsz, n_heads, n, n), F32), xs)
    return jnp.moveaxis(ys, 0, 1)


def _rwkv7_group(pieces, v_lo, v_first, w0, w2, a0, a2, g2, k_k, k_a, r_k, ln_g, ln_b, v0, v2):
    r, k, v, w_lo, a_lo, g_lo = pieces
    w = -jax.nn.softplus(-(w0 + jnp.tanh(w_lo) @ w2)) - 0.5
    decay = jnp.exp(-jnp.exp(w.astype(F32)))
    a = jax.nn.sigmoid(a0 + a_lo @ a2)
    g = jax.nn.sigmoid(g_lo) @ g2
    if v_first is None:
        v_first = v
    else:
        v = v + (v_first - v) * jax.nn.sigmoid(v0 + v_lo @ v2)
    kk = _l2norm(_heads(k * k_k, RWKV_HEADS))
    k = k * (1.0 + (a - 1.0) * k_a)
    rh, kh, vh, ah, dh = (_heads(t, RWKV_HEADS).astype(F32) for t in (r, k, v, a, decay))
    y = _rwkv7_scan(rh, dh, kh, vh, -kk, kk * ah)
    y = _group_norm(y, ln_g, ln_b, RWKV_GN_EPS)
    bonus = _merge(jnp.sum(rh * kh * r_k, -1, keepdims=True) * vh)
    return (y + bonus) * g, v_first


def _gated_delta_chunked(q, k, v, g, beta):
    bsz, seq, n_heads, dk = q.shape
    dv = v.shape[-1]
    n_chunks = seq // GDN_CHUNK

    def chunks(t):
        return jnp.moveaxis(t.reshape((bsz, n_chunks, GDN_CHUNK, n_heads) + t.shape[3:]), 3, 1)

    q, k, v, g, beta = (chunks(t) for t in (q, k, v, g, beta))
    gc = jnp.cumsum(g, axis=-1)
    idx = jnp.arange(GDN_CHUNK)
    causal = idx[:, None] >= idx[None, :]
    strict = idx[:, None] > idx[None, :]
    decay_mask = jnp.exp(jnp.where(causal, gc[..., :, None] - gc[..., None, :], -jnp.inf))
    kb = k * beta[..., None]
    m_low = jnp.where(strict, jnp.einsum('bhncd,bhnmd->bhncm', kb, k) * decay_mask, 0.0)
    rhs = jnp.concatenate([v * beta[..., None], kb * jnp.exp(gc)[..., None]], axis=-1)
    sol = lax.linalg.triangular_solve(m_low, rhs, left_side=True, lower=True, unit_diagonal=True)
    u, w = sol[..., :dv], sol[..., dv:]
    attn = jnp.einsum('bhncd,bhnmd->bhncm', q, k) * decay_mask
    q_dec = q * jnp.exp(gc)[..., None]
    g_last = gc[..., -1]
    k_dec = k * jnp.exp(g_last[..., None] - gc)[..., None]

    def step(state, inp):
        u_n, w_n, attn_n, qd_n, kd_n, gl_n = inp
        v_new = u_n - jnp.einsum('bhcd,bhde->bhce', w_n, state)
        o = jnp.einsum('bhcd,bhde->bhce', qd_n, state) + jnp.einsum('bhcm,bhme->bhce', attn_n, v_new)
        state = state * jnp.exp(gl_n)[..., None, None] + jnp.einsum('bhcd,bhce->bhde', kd_n, v_new)
        return state, o

    xs = tuple(jnp.moveaxis(t, 2, 0) for t in (u, w, attn, q_dec, k_dec, g_last))
    _, o = lax.scan(step, jnp.zeros((bsz, n_heads, dk, dv), F32), xs)
    o = jnp.moveaxis(jnp.moveaxis(o, 0, 2), 1, 3)
    return o.reshape(bsz, seq, n_heads, dv)


def _gdn_group(pieces, conv_w, a_log, dt_bias, norm_g):
    q, k, v, z, a, b = pieces
    qkv = jax.nn.silu(_causal_depthwise_conv(jnp.concatenate([q, k, v], axis=-1), conv_w))
    q, k, v = jnp.split(qkv, 3, axis=-1)
    qh = _l2norm(_heads(q, GDN_HEADS)) * GDN_HEAD_DIM ** -0.5
    kh = _l2norm(_heads(k, GDN_HEADS))
    vh = _heads(v, GDN_HEADS).astype(F32)
    beta = jax.nn.sigmoid(b.astype(F32))
    g = -jnp.exp(a_log.astype(F32)) * jax.nn.softplus(a.astype(F32) + dt_bias.astype(F32))
    o = _gated_delta_chunked(qh, kh, vh, g, beta)
    return _rms_head(o, norm_g) * jax.nn.silu(z)


def _retention_chunked(q, k, v, log_gamma):
    bsz, seq, n_heads, _ = q.shape
    dv = v.shape[-1]
    n_chunks = seq // RET_CHUNK

    def chunks(t):
        return jnp.moveaxis(t.reshape(bsz, n_chunks, RET_CHUNK, n_heads, t.shape[-1]), 3, 1)

    q, k, v = chunks(q), chunks(k), chunks(v)
    idx = jnp.arange(RET_CHUNK, dtype=F32)
    dist = idx[:, None] - idx[None, :]
    dmat = jnp.exp(jnp.where(dist >= 0, dist * log_gamma[:, None, None], -jnp.inf))
    scores = jnp.einsum('bhncd,bhnmd->bhncm', q, k) * dmat[None, :, None]
    inner = jnp.einsum('bhncm,bhnme->bhnce', scores, v)
    zeta = jnp.exp((RET_CHUNK - 1.0 - idx)[None] * log_gamma[:, None])
    xi = jnp.exp((idx + 1.0)[None] * log_gamma[:, None])
    kv = jnp.einsum('bhncd,bhnce->bhnde', k * zeta[None, :, None, :, None], v)
    chunk_decay = jnp.exp(RET_CHUNK * log_gamma)[None, :, None, None]

    def step(state, kv_n):
        return state * chunk_decay + kv_n, state

    _, r_prev = lax.scan(step, jnp.zeros(kv.shape[:2] + kv.shape[3:], F32), jnp.moveaxis(kv, 2, 0))
    r_prev = jnp.moveaxis(r_prev, 0, 2)
    cross = jnp.einsum('bhncd,bhnde->bhnce', q * xi[None, :, None, :, None], r_prev)
    o = jnp.moveaxis(inner + cross, 1, 3)
    return o.reshape(bsz, seq, n_heads, dv)


def _retention_group(pieces, positions, ln_g, ln_b):
    q, k, v, g = pieces
    qh = _rotary(_heads(q, RET_HEADS).astype(F32), positions)
    kh = _rotary(_heads(k, RET_HEADS).astype(F32), positions) * RET_HEAD_DIM ** -0.5
    vh = _heads(v, RET_HEADS).astype(F32)
    log_gamma = jnp.log1p(-jnp.exp2(-5.0 - jnp.arange(RET_HEADS, dtype=F32)))
    o = _retention_chunked(qh, kh, vh, log_gamma)
    return _group_norm(o, ln_g, ln_b, LN_EPS) * jax.nn.silu(g)


def _clamped_swiglu(up):
    glu = jnp.minimum(up[..., :D_FF], SWIGLU_LIMIT)
    lin = jnp.clip(up[..., D_FF:], -SWIGLU_LIMIT, SWIGLU_LIMIT)
    return glu * jax.nn.sigmoid(SWIGLU_ALPHA * glu) * (lin + 1.0)


def _moe(h, router_w, router_b, w_up, b_up, w_down, b_down):
    bsz, seq, dm = h.shape
    n_tok = bsz * seq
    hf = h.reshape(n_tok, dm)
    logits = hf.astype(F32) @ router_w.astype(F32) + router_b.astype(F32)
    top_val, top_idx = lax.top_k(logits, TOP_K)
    gates = jax.nn.softmax(top_val, axis=-1)
    n_assign = n_tok * TOP_K
    flat_e = top_idx.reshape(n_assign)
    flat_tok = jnp.repeat(jnp.arange(n_tok, dtype=jnp.int32), TOP_K)
    order = jnp.argsort(flat_e)
    e_s, tok_s, g_s = flat_e[order], flat_tok[order], gates.reshape(n_assign)[order]
    counts = jax.ops.segment_sum(jnp.ones((n_assign,), jnp.int32), flat_e, num_segments=N_EXPERTS)
    padded = (counts + MOE_BLOCK - 1) // MOE_BLOCK * MOE_BLOCK
    start = jnp.cumsum(counts) - counts
    pend = jnp.cumsum(padded)
    pstart = pend - padded
    dest = pstart[e_s] + jnp.arange(n_assign, dtype=jnp.int32) - start[e_s]
    n_blocks = -(-(n_assign + N_EXPERTS * (MOE_BLOCK - 1)) // MOE_BLOCK)
    cap = n_blocks * MOE_BLOCK
    pad_tok = jnp.zeros((cap,), jnp.int32).at[dest].set(tok_s)
    pad_g = jnp.zeros((cap,), h.dtype).at[dest].set(g_s.astype(h.dtype))
    block_e = jnp.minimum(jnp.searchsorted(pend, jnp.arange(n_blocks) * MOE_BLOCK, side='right'),
                          N_EXPERTS - 1).astype(jnp.int32)

    def expert_block(args):
        tok_b, g_b, e = args
        up = hf[tok_b] @ w_up[e] + b_up[e]
        y = _clamped_swiglu(up) @ w_down[e] + b_down[e]
        return y * g_b[:, None]

    ys = lax.map(expert_block, (pad_tok.reshape(n_blocks, MOE_BLOCK), pad_g.reshape(n_blocks, MOE_BLOCK), block_e))
    out = jnp.zeros((n_tok, dm), h.dtype).at[pad_tok].add(ys.reshape(cap, dm))
    return out.reshape(bsz, seq, dm)


def setup_inputs(seed: int = 0) -> dict:
    key = jax.random.key(seed)
    ks = iter(jax.random.split(key, 64))

    def nrm(shape, scale):
        return jax.random.normal(next(ks), shape, F32) * scale

    def unif(shape, lo, hi):
        return jax.random.uniform(next(ks), shape, F32, minval=lo, maxval=hi)

    d, L = D_MODEL, DEPTH
    x = nrm((BATCH, SEQ, d), 1.0)
    c = nrm((BATCH, d), 1.0)
    offset = jax.random.randint(next(ks), (BATCH, 1), 0, 4096, dtype=jnp.int32)
    positions = offset + jnp.arange(SEQ, dtype=jnp.int32)[None, :]
    n = jnp.arange(RWKV_WIDTH, dtype=F32) / (RWKV_WIDTH - 1)
    w0_base = -7.0 + 5.0 * n ** 0.85 + 0.5
    dt = jnp.exp(unif((L, GDN_HEADS), math.log(1e-3), math.log(1e-1)))
    return {
        'x': x,
        'c': c,
        'positions': positions,
        'ada_w': nrm((L, d, 6 * d), 0.1 * d ** -0.5),
        'ada_b': nrm((L, 6 * d), 0.02),
        'w_in': nrm((L, d, N_IN), d ** -0.5),
        'w_in_vres': nrm((L - 1, d, RWKV_VRES_RANK), d ** -0.5),
        'tshift_mu': unif((L, A_SIZE), 0.0, 1.0),
        'tshift_mu_vres': unif((L - 1, RWKV_VRES_RANK), 0.0, 1.0),
        'rwkv_w0': w0_base[None] + nrm((L, RWKV_WIDTH), 0.1),
        'rwkv_w2': nrm((L, RWKV_DECAY_RANK, RWKV_WIDTH), 0.1 * RWKV_DECAY_RANK ** -0.5),
        'rwkv_a0': nrm((L, RWKV_WIDTH), 0.1),
        'rwkv_a2': nrm((L, RWKV_ICLR_RANK, RWKV_WIDTH), 0.1 * RWKV_ICLR_RANK ** -0.5),
        'rwkv_g2': nrm((L, RWKV_GATE_RANK, RWKV_WIDTH), RWKV_GATE_RANK ** -0.5),
        'rwkv_kk': 0.85 + nrm((L, RWKV_WIDTH), 0.02),
        'rwkv_ka': 1.0 + nrm((L, RWKV_WIDTH), 0.02),
        'rwkv_rk': nrm((L, RWKV_HEADS, RWKV_HEAD_DIM), 0.1),
        'rwkv_ln_g': 1.0 + nrm((L, RWKV_WIDTH), 0.02),
        'rwkv_ln_b': nrm((L, RWKV_WIDTH), 0.02),
        'rwkv_v0': 1.0 + nrm((L - 1, RWKV_WIDTH), 0.1),
        'rwkv_v2': nrm((L - 1, RWKV_VRES_RANK, RWKV_WIDTH), 0.1 * RWKV_VRES_RANK ** -0.5),
        'gdn_conv_w': nrm((L, GDN_CONV, 3 * GDN_WIDTH), GDN_CONV ** -0.5),
        'gdn_a_log': jnp.log(unif((L, GDN_HEADS), 1.0, 16.0)),
        'gdn_dt_bias': dt + jnp.log(-jnp.expm1(-dt)),
        'gdn_norm_g': 1.0 + nrm((L, GDN_HEAD_DIM), 0.02),
        'ret_norm_g': 1.0 + nrm((L, RET_WIDTH), 0.02),
        'ret_norm_b': nrm((L, RET_WIDTH), 0.02),
        'w_out': nrm((L, MIX_WIDTH, d), MIX_WIDTH ** -0.5 * DEEPNORM_BETA),
        'ln1_g': 1.0 + nrm((L, d), 0.02),
        'ln1_b': nrm((L, d), 0.02),
        'router_w': nrm((L, d, N_EXPERTS), d ** -0.5),
        'router_b': nrm((L, N_EXPERTS), 0.01),
        'exp_w_up': nrm((L, N_EXPERTS, d, 2 * D_FF), d ** -0.5),
        'exp_b_up': nrm((L, N_EXPERTS, 2 * D_FF), 0.02),
        'exp_w_down': nrm((L, N_EXPERTS, D_FF, d), D_FF ** -0.5 * DEEPNORM_BETA),
        'exp_b_down': nrm((L, N_EXPERTS, d), 0.02),
        'ln2_g': 1.0 + nrm((L, d), 0.02),
        'ln2_b': nrm((L, d), 0.02),
    }


def reference(x, c, positions, ada_w, ada_b, w_in, w_in_vres, tshift_mu, tshift_mu_vres,
              rwkv_w0, rwkv_w2, rwkv_a0, rwkv_a2, rwkv_g2, rwkv_kk, rwkv_ka, rwkv_rk,
              rwkv_ln_g, rwkv_ln_b, rwkv_v0, rwkv_v2, gdn_conv_w, gdn_a_log, gdn_dt_bias,
              gdn_norm_g, ret_norm_g, ret_norm_b, w_out, ln1_g, ln1_b, router_w, router_b,
              exp_w_up, exp_b_up, exp_w_down, exp_b_down, ln2_g, ln2_b):
    cond = jax.nn.silu(c)
    v_first = None
    for l in range(DEPTH):
        ada = (cond @ ada_w[l] + ada_b[l])[:, None, :]
        sh_mix, sc_mix, gt_mix, sh_ffn, sc_ffn, gt_ffn = jnp.split(ada, 6, axis=-1)

        h = x * (1.0 + sc_mix) + sh_mix
        if l == 0:
            w_comb, mu = w_in[l], tshift_mu[l]
            v0, v2 = None, None
        else:
            w_comb = jnp.concatenate([w_in[l], w_in_vres[l - 1]], axis=1)
            mu = jnp.concatenate([tshift_mu[l], tshift_mu_vres[l - 1]])
            v0, v2 = rwkv_v0[l - 1], rwkv_v2[l - 1]
        proj = h @ w_comb
        p_shift = jnp.concatenate([proj[..., :A_SIZE], proj[..., N_IN:]], axis=-1)
        p_shift = p_shift + (_token_shift(p_shift) - p_shift) * mu
        y_a, v_first = _rwkv7_group(_split(p_shift[..., :A_SIZE], A_COLS), p_shift[..., A_SIZE:], v_first,
                                    rwkv_w0[l], rwkv_w2[l], rwkv_a0[l], rwkv_a2[l], rwkv_g2[l],
                                    rwkv_kk[l], rwkv_ka[l], rwkv_rk[l], rwkv_ln_g[l], rwkv_ln_b[l], v0, v2)
        y_b = _gdn_group(_split(proj[..., A_SIZE:A_SIZE + B_SIZE], B_COLS),
                         gdn_conv_w[l], gdn_a_log[l], gdn_dt_bias[l], gdn_norm_g[l])
        y_c = _retention_group(_split(proj[..., A_SIZE + B_SIZE:N_IN], C_COLS), positions,
                               ret_norm_g[l], ret_norm_b[l])
        mix = jnp.concatenate([y_a, y_b, y_c], axis=-1).astype(x.dtype) @ w_out[l]
        x = _layer_norm(DEEPNORM_ALPHA * x + (1.0 + gt_mix) * mix, ln1_g[l], ln1_b[l])

        h = x * (1.0 + sc_ffn) + sh_ffn
        ffn = _moe(h, router_w[l], router_b[l], exp_w_up[l], exp_b_up[l], exp_w_down[l], exp_b_down[l])
        x = _layer_norm(DEEPNORM_ALPHA * x + (1.0 + gt_ffn) * ffn, ln2_g[l], ln2_b[l])
    return x
```

```cpp
#include <hip/hip_runtime.h>
#include <hip/hip_bf16.h>
#include <stdint.h>
#include <stdio.h>

#ifndef MEGA
#define MEGA 1
#endif

#define DEVI __device__ __forceinline__
#define LAS __attribute__((address_space(3)))

typedef unsigned short bf16;
typedef short bf16x8 __attribute__((ext_vector_type(8)));
typedef float f32x4 __attribute__((ext_vector_type(4)));
typedef unsigned u32x4 __attribute__((ext_vector_type(4)));
typedef unsigned u32x2 __attribute__((ext_vector_type(2)));

constexpr int S = 16384, D = 1024, NIN = 4104, NEXP = 32, DFF = 1024;
constexpr int NPROJ = 4096;
constexpr int NPAD = 4224;
constexpr float DN_ALPHA = 1.4142135623730951f;
constexpr int NT = 256;
constexpr int LDS_BYTES = 65536;

constexpr size_t MiB = 1ull << 20;
constexpr size_t WS_CTL = 0;
constexpr size_t CTL_BYTES = 1 * MiB;
constexpr size_t OFF_BAR = 0;
constexpr size_t OFF_ADA = 64 * 1024;
constexpr size_t OFF_CNT = 128 * 1024;
constexpr size_t WS_ROT = 1 * MiB;
constexpr size_t WS_WIN = WS_ROT + (size_t)S * 64 * 4;
constexpr size_t WS_WOUT = WS_WIN + 2ull * NPAD * D * 2;
constexpr size_t WS_WUP = WS_WOUT + 2ull * D * D * 2;
constexpr size_t WS_WDN = WS_WUP + 2ull * NEXP * 2048 * D * 2;
constexpr size_t WS_HB = WS_WDN + 2ull * NEXP * D * DFF * 2;
constexpr size_t WS_PROJ = WS_HB + (size_t)S * D * 2;
constexpr size_t WS_PEX = WS_PROJ + (size_t)S * NPROJ * 2;
constexpr size_t WS_VFIRST = WS_PEX + (size_t)S * 64 * 4;
constexpr size_t WS_RECR = WS_VFIRST + (size_t)S * 256 * 4;
constexpr size_t WS_RECG = WS_RECR + (size_t)S * 4 * 384 * 4;
constexpr size_t WS_RECT = WS_RECG + (size_t)S * 4 * 392 * 4;
constexpr size_t WS_G = WS_RECT + (size_t)S * 4 * 192 * 4;
constexpr size_t WS_BON = WS_G + (size_t)S * 256 * 4;
constexpr size_t WS_YR = WS_BON + (size_t)S * 4 * 4;
constexpr size_t WS_OG = WS_YR + (size_t)S * 256 * 4;
constexpr size_t WS_ORT = WS_OG + (size_t)S * 512 * 4;
constexpr size_t WS_MIX = WS_ORT + (size_t)S * 256 * 4;
constexpr size_t WS_OPRE = WS_MIX + (size_t)S * D * 2;
constexpr size_t WS_X = WS_OPRE + (size_t)S * D * 4;
constexpr size_t WS_H2 = WS_X + (size_t)S * D * 4;
constexpr size_t WS_LIST = WS_H2 + (size_t)S * D * 2;
constexpr size_t WS_GATE = WS_LIST + (size_t)NEXP * S * 4;
constexpr size_t WS_ACT = WS_GATE + (size_t)S * 4 * 4;
constexpr size_t WS_YB = WS_ACT + ((size_t)S * 4 + 128) * DFF * 2;
constexpr size_t WS_ADAP = WS_YB + (size_t)S * 4 * D * 2;
constexpr size_t WS_END = WS_ADAP + 16ull * 12288 * 4;

struct P {
    const float* in[38];
    const int* pos;
    float* out;
    char* ws;
    int ph_lo, ph_hi;
};

DEVI float bf2f(bf16 v) { return __uint_as_float(((unsigned)v) << 16); }
DEVI unsigned f2bf(float f) { unsigned u = __float_as_uint(f); return (u + 0x7fffu + ((u >> 16) & 1u)) >> 16; }
DEVI unsigned pk2(float lo, float hi) { return f2bf(lo) | (f2bf(hi) << 16); }
DEVI float sigmoidf_(float x) { return 1.f / (1.f + __expf(-x)); }
DEVI float siluf_(float x) { return x * sigmoidf_(x); }
DEVI float softplusf_(float x) { return fmaxf(x, 0.f) + log1pf(__expf(-fabsf(x))); }
DEVI float wave_sum(float v) {
#pragma unroll
    for (int o = 32; o >= 1; o >>= 1) v += __shfl_xor(v, o);
    return v;
}
template <int CTRL> DEVI float dpp_mov(float x) {
    return __int_as_float(__builtin_amdgcn_update_dpp(0, __float_as_int(x), CTRL, 0xf, 0xf, false));
}
DEVI float row16_sum(float x) {
    x += dpp_mov<0x128>(x);
    x += dpp_mov<0x124>(x);
    x += dpp_mov<0x122>(x);
    x += dpp_mov<0x121>(x);
    return x;
}

#define XB_TMO      128
#define XB_XCNT(j)  (256  + 64 * (j))
#define XB_XSUB(j)  (1280 + 64 * (j))
#define XB_XGEN(j)  (2304 + 64 * (j))
#define XB_TOP      3328
#define XB_TOPGEN   3392
#define XCD_BAR_WORDS 3456
#define XB_SPIN_CAP (1u << 22)
DEVI unsigned xb_ld(unsigned* p) { return __hip_atomic_load(p, __ATOMIC_RELAXED, __HIP_MEMORY_SCOPE_AGENT); }
DEVI unsigned xb_add(unsigned* p, unsigned v) { return __hip_atomic_fetch_add(p, v, __ATOMIC_RELAXED, __HIP_MEMORY_SCOPE_AGENT); }
DEVI unsigned xb_xcc_id() { return (unsigned)__builtin_amdgcn_s_getreg((3 << 11) | 20) & 0xFu; }
#define XB_SPIN(cond, bar) do { unsigned _sp = 0; while (cond) { __builtin_amdgcn_s_sleep(1); \
    if ((++_sp & 255u) == 0u) { if (xb_ld(&(bar)[XB_TMO])) break; if (_sp > XB_SPIN_CAP) { atomicAdd(&(bar)[XB_TMO], 1u); break; } } } } while (0)
struct XcdBarrier { unsigned* bar; unsigned x; volatile LAS unsigned* st; };
DEVI XcdBarrier xcd_barrier_post(unsigned* bar, volatile LAS unsigned* st) {
    XcdBarrier b; b.bar = bar; b.x = xb_xcc_id(); b.st = st;
    if (threadIdx.x == 0) (void)xb_add(&bar[XB_XCNT(b.x)], 1u);
    return b;
}
DEVI void xcd_barrier_complete(unsigned* bar, unsigned x, unsigned& nloc, unsigned& nx) {
    const unsigned G = gridDim.x * gridDim.y * gridDim.z;
    unsigned sum, cnt, mine, sp = 0u;
    for (;;) {
        sum = 0u; cnt = 0u; mine = 0u;
#pragma unroll
        for (unsigned j = 0; j < 16; ++j) { const unsigned c = xb_ld(&bar[XB_XCNT(j)]); sum += c; cnt += (c > 0u) ? 1u : 0u; mine = (j == x) ? c : mine; }
        if (sum == G) break;
        __builtin_amdgcn_s_sleep(1);
        if ((++sp & 255u) == 0u) { if (xb_ld(&bar[XB_TMO])) break; if (sp > XB_SPIN_CAP) { atomicAdd(&bar[XB_TMO], 1u); break; } }
    }
    nloc = mine > 0u ? mine : 1u; nx = cnt > 0u ? cnt : 1u;
}
DEVI void xcd_barrier(const XcdBarrier& b) {
    asm volatile("s_waitcnt vmcnt(0)" ::: "memory");
    __syncthreads();
    if (threadIdx.x == 0) {
        unsigned* bar = b.bar;
        __builtin_amdgcn_s_waitcnt(0);
        unsigned nloc = b.st[0], nx = b.st[1];
        if (nloc == 0u) { xcd_barrier_complete(bar, b.x, nloc, nx); b.st[0] = nloc; b.st[1] = nx; }
        const unsigned old = xb_add(&bar[XB_XSUB(b.x)], 1u);
        const unsigned gen = old / nloc;
        if (old + 1u == (gen + 1u) * nloc) {
            __builtin_amdgcn_fence(__ATOMIC_RELEASE, "agent");
            asm volatile("s_waitcnt vmcnt(0)" ::: "memory");
            const unsigned og = xb_add(&bar[XB_TOP], 1u);
            const unsigned tg = og / nx;
            if (og + 1u == (tg + 1u) * nx) xb_add(&bar[XB_TOPGEN], 1u);
            else XB_SPIN(xb_ld(&bar[XB_TOPGEN]) == tg, bar);
            __builtin_amdgcn_fence(__ATOMIC_ACQUIRE, "agent");
            xb_add(&bar[XB_XGEN(b.x)], 1u);
            asm volatile("s_waitcnt vmcnt(0)" ::: "memory");
        } else {
            XB_SPIN(xb_ld(&bar[XB_XGEN(b.x)]) == gen, bar);
            __builtin_amdgcn_fence(__ATOMIC_ACQUIRE, "agent");
            asm volatile("s_waitcnt vmcnt(0)" ::: "memory");
        }
    }
    __syncthreads();
}

DEVI void transpose_item(const float* __restrict__ src, size_t ld, int k0, int ns0, bf16* __restrict__ dst, int kd, int nd0, float* lds) {
    const int tid = threadIdx.x;
#pragma unroll 4
    for (int i = 0; i < 16; ++i) {
        const int kk = i * 4 + (tid >> 6), n = tid & 63;
        lds[kk * 65 + n] = src[(size_t)(k0 + kk) * ld + ns0 + n];
    }
    __syncthreads();
#pragma unroll
    for (int i = 0; i < 2; ++i) {
        const int q = tid + 256 * i, n = q >> 3, kc = q & 7;
        const float* s = lds + (kc * 8) * 65 + n;
        u32x4 o;
        o.x = pk2(s[0 * 65], s[1 * 65]); o.y = pk2(s[2 * 65], s[3 * 65]);
        o.z = pk2(s[4 * 65], s[5 * 65]); o.w = pk2(s[6 * 65], s[7 * 65]);
        *(u32x4*)(dst + (size_t)(nd0 + n) * kd + k0 + kc * 8) = o;
    }
    __syncthreads();
}

DEVI void phase_prep(const P& p, char* smem) {
    float* lds = (float*)smem;
    const int tid = threadIdx.x;
    const int nb = gridDim.x, bid = blockIdx.x;
    bf16* WIN = (bf16*)(p.ws + WS_WIN); bf16* WOUT = (bf16*)(p.ws + WS_WOUT);
    bf16* WUP = (bf16*)(p.ws + WS_WUP); bf16* WDN = (bf16*)(p.ws + WS_WDN);
    constexpr int I_UP = 2 * NEXP * 16 * 32;
    constexpr int I_DN = 2 * NEXP * 16 * 16;
    constexpr int I_IN = 2 * 16 * 64;
    constexpr int I_OUT = 2 * 16 * 16;
    constexpr int I_EX = 2 * 128;
    constexpr int I_ADA = 2 * 24 * 16;
    constexpr int I_ROT = S * 32 / 256;
    constexpr int NITEMS = I_UP + I_DN + I_IN + I_OUT + I_EX + I_ADA + I_ROT;
    for (int it = bid; it < NITEMS; it += nb) {
        int r = it;
        if (r < I_UP) {
            const int le = r / 512, q = r % 512, kt = q / 32, nt = q % 32;
            transpose_item(p.in[32] + (size_t)le * D * 2048, 2048, kt * 64, nt * 64, WUP + (size_t)le * 2048 * D, D, nt * 64, lds);
            continue;
        }
        r -= I_UP;
        if (r < I_DN) {
            const int le = r / 256, q = r % 256, kt = q / 16, nt = q % 16;
            transpose_item(p.in[34] + (size_t)le * DFF * D, D, kt * 64, nt * 64, WDN + (size_t)le * D * DFF, DFF, nt * 64, lds);
            continue;
        }
        r -= I_DN;
        if (r < I_IN) {
            const int l = r / 1024, q = r % 1024, kt = q / 64, nt = q % 64;
            const int nd0 = nt * 64, ns0 = nd0 < 3072 ? nd0 : nd0 + 8;
            transpose_item(p.in[5] + (size_t)l * D * NIN, NIN, kt * 64, ns0, WIN + (size_t)l * NPAD * D, D, nd0, lds);
            continue;
        }
        r -= I_IN;
        if (r < I_OUT) {
            const int l = r / 256, q = r % 256, kt = q / 16, nt = q % 16;
            transpose_item(p.in[27] + (size_t)l * D * D, D, kt * 64, nt * 64, WOUT + (size_t)l * D * D, D, nt * 64, lds);
            continue;
        }
        r -= I_OUT;
        if (r < I_EX) {
            const int l = r / 128, n = r % 128;
            bf16* dst = WIN + ((size_t)l * NPAD + NPROJ + n) * D;
            for (int k = tid; k < D; k += NT) {
                float v = 0.f;
                if (n < 8) v = p.in[5][(size_t)l * D * NIN + (size_t)k * NIN + 3072 + n];
                else if (n < 40 && l == 1) v = p.in[6][(size_t)k * 32 + (n - 8)];
                dst[k] = (bf16)f2bf(v);
            }
            continue;
        }
        r -= I_EX;
        if (r < I_ADA) {
            const int l = r / 384, q = r % 384, nc = q / 16, kc = q % 16;
            const int n = nc * 256 + tid;
            const float* W = p.in[3] + (size_t)l * D * 6144;
            float acc = (kc == 0) ? p.in[4][l * 6144 + n] : 0.f;
            for (int k = kc * 64; k < kc * 64 + 64; ++k) acc += siluf_(p.in[1][k]) * W[(size_t)k * 6144 + n];
            ((float*)(p.ws + WS_ADAP))[(size_t)kc * 12288 + l * 6144 + n] = acc;
            continue;
        }
        r -= I_ADA;
        {
            const int idx = r * 256 + tid;
            const int t = idx >> 5, i = idx & 31;
            const float invf = (float)pow(10000.0, -(double)i / 32.0);
            const float ang = (float)p.pos[t] * invf;
            float sn, cs; sincosf(ang, &sn, &cs);
            float* ROT = (float*)(p.ws + WS_ROT);
            ROT[(size_t)idx * 2] = cs; ROT[(size_t)idx * 2 + 1] = sn;
        }
    }
}

DEVI float ada_sum(const float* ADAP, int idx) {
    float s = 0.f;
#pragma unroll
    for (int kc = 0; kc < 16; ++kc) s += ADAP[(size_t)kc * 12288 + idx];
    return s;
}
DEVI void phase_h0(const P& p) {
    const float* ADAP = (const float*)(p.ws + WS_ADAP);
    float* ADA = (float*)(p.ws + OFF_ADA);
    bf16* HB = (bf16*)(p.ws + WS_HB);
    if (blockIdx.x < 48) ADA[blockIdx.x * 256 + threadIdx.x] = ada_sum(ADAP, blockIdx.x * 256 + threadIdx.x);
    const size_t n4 = (size_t)S * D / 4;
    const int c = (int)(((size_t)blockIdx.x * NT + threadIdx.x) % (D / 4)) * 4;
    f32x4 sh, sc;
    sh.x = ada_sum(ADAP, c); sh.y = ada_sum(ADAP, c + 1); sh.z = ada_sum(ADAP, c + 2); sh.w = ada_sum(ADAP, c + 3);
    sc.x = ada_sum(ADAP, 1024 + c); sc.y = ada_sum(ADAP, 1025 + c); sc.z = ada_sum(ADAP, 1026 + c); sc.w = ada_sum(ADAP, 1027 + c);
    for (size_t i = (size_t)blockIdx.x * NT + threadIdx.x; i < n4; i += (size_t)gridDim.x * NT) {
        const f32x4 x = ((const f32x4*)p.in[0])[i];
        u32x2 o;
        o.x = pk2(x.x * (1.f + sc.x) + sh.x, x.y * (1.f + sc.y) + sh.y);
        o.y = pk2(x.z * (1.f + sc.z) + sh.z, x.w * (1.f + sc.w) + sh.w);
        ((u32x2*)HB)[i] = o;
    }
}

template <class AF, class BF>
DEVI void gemm_tile(char* smem, AF arow, BF brow, int K, f32x4 (&acc)[4][4]) {
    bf16* SA = (bf16*)smem; bf16* SB = SA + 128 * 32;
    const int tid = threadIdx.x, wid = tid >> 6, lane = tid & 63, wr = wid >> 1, wc = wid & 1, fr = lane & 15, fq = lane >> 4;
    const bf16* pa0 = arow(tid >> 2) + (tid & 3) * 8;
    const bf16* pa1 = arow((tid >> 2) + 64) + (tid & 3) * 8;
    const bf16* pb0 = brow(tid >> 2) + (tid & 3) * 8;
    const bf16* pb1 = brow((tid >> 2) + 64) + (tid & 3) * 8;
#pragma unroll
    for (int m = 0; m < 4; ++m)
#pragma unroll
        for (int n = 0; n < 4; ++n) acc[m][n] = (f32x4){0.f, 0.f, 0.f, 0.f};
    const int nk = K / 32;
    for (int kt = 0; kt < nk; ++kt) {
        __builtin_amdgcn_global_load_lds((const unsigned*)(pa0 + kt * 32), (unsigned*)((char*)SA + tid * 16), 16, 0, 0);
        __builtin_amdgcn_global_load_lds((const unsigned*)(pa1 + kt * 32), (unsigned*)((char*)SA + tid * 16 + 4096), 16, 0, 0);
        __builtin_amdgcn_global_load_lds((const unsigned*)(pb0 + kt * 32), (unsigned*)((char*)SB + tid * 16), 16, 0, 0);
        __builtin_amdgcn_global_load_lds((const unsigned*)(pb1 + kt * 32), (unsigned*)((char*)SB + tid * 16 + 4096), 16, 0, 0);
        asm volatile("s_waitcnt vmcnt(0)" ::: "memory");
        __syncthreads();
        bf16x8 af[4], bfr[4];
#pragma unroll
        for (int m = 0; m < 4; ++m) af[m] = *(const bf16x8*)((char*)SA + (wr * 64 + m * 16 + fr) * 64 + fq * 16);
#pragma unroll
        for (int n = 0; n < 4; ++n) bfr[n] = *(const bf16x8*)((char*)SB + (wc * 64 + n * 16 + fr) * 64 + fq * 16);
#pragma unroll
        for (int m = 0; m < 4; ++m)
#pragma unroll
            for (int n = 0; n < 4; ++n)
                acc[m][n] = __builtin_amdgcn_mfma_f32_16x16x32_bf16(bfr[n], af[m], acc[m][n], 0, 0, 0);
        __syncthreads();
    }
}

DEVI void phase_inproj(const P& p, int l, char* smem) {
    const bf16* HB = (const bf16*)(p.ws + WS_HB);
    const bf16* W = (const bf16*)(p.ws + WS_WIN) + (size_t)l * NPAD * D;
    bf16* PROJ = (bf16*)(p.ws + WS_PROJ); float* PEX = (float*)(p.ws + WS_PEX);
    const int lane = threadIdx.x & 63, wid = threadIdx.x >> 6, wr = wid >> 1, wc = wid & 1, fr = lane & 15, fq = lane >> 4;
    constexpr int NTN = NPAD / 128;
    for (int tile = blockIdx.x; tile < (S / 128) * NTN; tile += gridDim.x) {
        const int mt = tile / NTN, nt = tile % NTN;
        f32x4 acc[4][4];
        gemm_tile(smem, [&](int r) { return HB + (size_t)(mt * 128 + r) * D; }, [&](int r) { return W + (size_t)(nt * 128 + r) * D; }, D, acc);
#pragma unroll
        for (int m = 0; m < 4; ++m) {
            const int tok = mt * 128 + wr * 64 + m * 16 + fr;
#pragma unroll
            for (int n = 0; n < 4; ++n) {
                const int f = wc * 64 + n * 16 + fq * 4;
                if (nt < 32) {
                    u32x2 o; o.x = pk2(acc[m][n].x, acc[m][n].y); o.y = pk2(acc[m][n].z, acc[m][n].w);
                    *(u32x2*)(PROJ + (size_t)tok * NPROJ + nt * 128 + f) = o;
                } else if (f < 64) {
                    *(f32x4*)(PEX + (size_t)tok * 64 + f) = acc[m][n];
                }
            }
        }
    }
}

DEVI float proj_at(const bf16* PROJ, int t, int col) { return bf2f(PROJ[(size_t)t * NPROJ + col]); }
DEVI float proj_shift(const bf16* PROJ, int t, int col, float mu) {
    const float cur = proj_at(PROJ, t, col);
    const float prv = t > 0 ? proj_at(PROJ, t - 1, col) : 0.f;
    return cur + (prv - cur) * mu;
}

DEVI void phase_mixprep(const P& p, int l, char* smem) {
    const bf16* PROJ = (const bf16*)(p.ws + WS_PROJ); const float* PEX = (const float*)(p.ws + WS_PEX);
    float* VFIRST = (float*)(p.ws + WS_VFIRST);
    float* RECR = (float*)(p.ws + WS_RECR); float* RECG = (float*)(p.ws + WS_RECG); float* RECT = (float*)(p.ws + WS_RECT);
    float* GB = (float*)(p.ws + WS_G); float* BON = (float*)(p.ws + WS_BON);
    const float* ROT = (const float*)(p.ws + WS_ROT);
    constexpr int TT = 8;
    float* L = (float*)smem;
    float* ACC = L + TT * 288;
    const int tid = threadIdx.x, lane = tid & 63, w = tid >> 6;
    for (int item = blockIdx.x; item < S / TT; item += gridDim.x) {
        const int t0 = item * TT;
        {
            const float* mu = p.in[7] + l * 1024; const float* muv = p.in[8];
            for (int idx = tid; idx < TT * 288; idx += NT) {
                const int tt = idx / 288, i = idx % 288, t = t0 + tt;
                float v;
                if (i < 64) v = tanhf(proj_shift(PROJ, t, 768 + i, mu[768 + i]));
                else if (i < 128) v = proj_shift(PROJ, t, 832 + (i - 64), mu[832 + (i - 64)]);
                else if (i < 256) v = sigmoidf_(proj_shift(PROJ, t, 896 + (i - 128), mu[896 + (i - 128)]));
                else {
                    v = 0.f;
                    if (l == 1) {
                        const int j = i - 256;
                        const float cur = PEX[(size_t)t * 64 + 8 + j];
                        const float prv = t > 0 ? PEX[(size_t)(t - 1) * 64 + 8 + j] : 0.f;
                        v = cur + (prv - cur) * muv[j];
                    }
                }
                L[idx] = v;
            }
        }
        __syncthreads();
        {
            const int c = tid;
#pragma unroll 1
            for (int q = 0; q < 4; ++q) {
                const float* W = (q == 0) ? (p.in[10] + l * 64 * 256) : (q == 1) ? (p.in[12] + l * 64 * 256) : (q == 2) ? (p.in[13] + l * 128 * 256) : p.in[20];
                const int nr = (q == 2) ? 128 : (q == 3) ? ((l == 1) ? 32 : 0) : 64;
                const int lo = (q == 0) ? 0 : (q == 1) ? 64 : (q == 2) ? 128 : 256;
                float acc[TT];
#pragma unroll
                for (int tt = 0; tt < TT; ++tt) acc[tt] = 0.f;
#pragma unroll 2
                for (int i = 0; i < nr; i += 4) {
                    const float q0 = W[(i + 0) * 256 + c], q1 = W[(i + 1) * 256 + c], q2 = W[(i + 2) * 256 + c], q3 = W[(i + 3) * 256 + c];
#pragma unroll
                    for (int tt = 0; tt < TT; ++tt) { const f32x4 x = *(const f32x4*)(L + tt * 288 + lo + i); acc[tt] += x.x * q0 + x.y * q1 + x.z * q2 + x.w * q3; }
                }
#pragma unroll
                for (int tt = 0; tt < TT; ++tt) ACC[(q * TT + tt) * 256 + c] = acc[tt];
            }
            const float* mu = p.in[7] + l * 1024;
            const float w0c = p.in[9][l * 256 + c], a0c = p.in[11][l * 256 + c], kkc = p.in[14][l * 256 + c], kac = p.in[15][l * 256 + c], rkc = p.in[16][l * 256 + c];
            const float mur = mu[c], muk = mu[256 + c], muvv = mu[512 + c];
            const float v0c = (l == 1) ? p.in[19][c] : 0.f;
            const int h = w, j = lane;
#pragma unroll 1
            for (int tt = 0; tt < TT; ++tt) {
                const int t = t0 + tt;
                const float r = proj_shift(PROJ, t, c, mur);
                const float k = proj_shift(PROJ, t, 256 + c, muk);
                float v = proj_shift(PROJ, t, 512 + c, muvv);
                const float wpre = w0c + ACC[(0 * TT + tt) * 256 + c];
                const float wl = -softplusf_(-wpre) - 0.5f;
                const float decay = __expf(-__expf(wl));
                const float a = sigmoidf_(a0c + ACC[(1 * TT + tt) * 256 + c]);
                if (l == 0) VFIRST[(size_t)t * 256 + c] = v;
                else { const float vf = VFIRST[(size_t)t * 256 + c]; v = v + (vf - v) * sigmoidf_(v0c + ACC[(3 * TT + tt) * 256 + c]); }
                const float kx = k * kkc;
                const float ss = wave_sum(kx * kx);
                const float kk = kx * rsqrtf(ss + 1e-12f);
                const float k2 = k * (1.f + (a - 1.f) * kac);
                const float bon = wave_sum(r * k2 * rkc);
                float* rec = RECR + ((size_t)t * 4 + h) * 384;
                rec[j] = -kk; rec[64 + j] = decay; rec[128 + j] = kk * a; rec[192 + j] = k2; rec[256 + j] = r; rec[320 + j] = v;
                GB[(size_t)t * 256 + c] = ACC[(2 * TT + tt) * 256 + c];
                if (j == 0) BON[(size_t)t * 4 + h] = bon;
            }
        }
        {
            const float* conv_w = p.in[21] + l * 4 * 1536;
            const int h = w;
            float hist[6][3], cw[6][4];
            int colb[6];
#pragma unroll
            for (int q = 0; q < 6; ++q) {
                const int which = q >> 1, u = q & 1;
                const int ch = which * 512 + h * 128 + lane + 64 * u;
                colb[q] = 1024 + ch;
#pragma unroll
                for (int i = 0; i < 4; ++i) cw[q][i] = conv_w[i * 1536 + ch];
#pragma unroll
                for (int i = 0; i < 3; ++i) { const int t = t0 - 3 + i; hist[q][i] = t >= 0 ? proj_at(PROJ, t, colb[q]) : 0.f; }
            }
            const float nA = -__expf(p.in[22][l * 4 + h]), dtb = p.in[23][l * 4 + h];
#pragma unroll 1
            for (int tt = 0; tt < TT; ++tt) {
                const int t = t0 + tt;
                float y[6];
#pragma unroll
                for (int q = 0; q < 6; ++q) {
                    const float xt = proj_at(PROJ, t, colb[q]);
                    const float cv = cw[q][0] * hist[q][0] + cw[q][1] * hist[q][1] + cw[q][2] * hist[q][2] + cw[q][3] * xt;
                    hist[q][0] = hist[q][1]; hist[q][1] = hist[q][2]; hist[q][2] = xt;
                    y[q] = siluf_(cv);
                }
                const float sq = wave_sum(y[0] * y[0] + y[1] * y[1]);
                const float sk = wave_sum(y[2] * y[2] + y[3] * y[3]);
                const float rq = rsqrtf(sq + 1e-12f) * 0.08838834764831845f;
                const float rk = rsqrtf(sk + 1e-12f);
                float* rec = RECG + ((size_t)t * 4 + h) * 392;
                rec[lane] = y[0] * rq; rec[64 + lane] = y[1] * rq;
                rec[128 + lane] = y[2] * rk; rec[192 + lane] = y[3] * rk;
                rec[256 + lane] = y[4]; rec[320 + lane] = y[5];
                if (lane == 0) {
                    const float av = PEX[(size_t)t * 64 + h], bv = PEX[(size_t)t * 64 + 4 + h];
                    const float g = nA * softplusf_(av + dtb);
                    rec[384] = __expf(g); rec[385] = sigmoidf_(bv); rec[386] = g; rec[387] = 0.f;
                }
            }
        }
        {
            const int h = w, i = lane, c = tid;
#pragma unroll 1
            for (int tt = 0; tt < TT; ++tt) {
                const int t = t0 + tt;
                const float q = proj_at(PROJ, t, 3072 + c), k = proj_at(PROJ, t, 3328 + c), v = proj_at(PROJ, t, 3584 + c);
                const float cs = ROT[((size_t)t * 32 + (i & 31)) * 2], sn = ROT[((size_t)t * 32 + (i & 31)) * 2 + 1];
                const float qo = __shfl_xor(q, 32), ko = __shfl_xor(k, 32);
                const float qr = (i < 32) ? (q * cs - qo * sn) : (qo * sn + q * cs);
                const float kr = (i < 32) ? (k * cs - ko * sn) : (ko * sn + k * cs);
                float* rec = RECT + ((size_t)t * 4 + h) * 192;
                rec[i] = qr; rec[64 + i] = kr * 0.125f; rec[128 + i] = v;
            }
        }
        __syncthreads();
    }
}

DEVI void scan_rwkv(const P& p, int item, char* smem) {
    const float* REC = (const float*)(p.ws + WS_RECR); float* YR = (float*)(p.ws + WS_YR);
    float* L = (float*)smem;
    const int h = item >> 2, rg = item & 3;
    const int tid = threadIdx.x, lane = tid & 63, w = tid >> 6, sub = lane & 15;
    const int i = rg * 16 + w * 4 + (lane >> 4);
    float s0 = 0.f, s1 = 0.f, s2 = 0.f, s3 = 0.f;
    for (int c0 = 0; c0 < S; c0 += 32) {
        for (int idx = tid; idx < 32 * 96; idx += NT) {
            const int tok = idx / 96, f4 = idx % 96;
            ((f32x4*)L)[idx] = *(const f32x4*)(REC + ((size_t)(c0 + tok) * 4 + h) * 384 + f4 * 4);
        }
        __syncthreads();
        for (int tt = 0; tt < 32; ++tt) {
            const float* R = L + tt * 384;
            const f32x4 a = *(const f32x4*)(R + sub * 4), wv = *(const f32x4*)(R + 64 + sub * 4), b = *(const f32x4*)(R + 128 + sub * 4);
            const f32x4 k = *(const f32x4*)(R + 192 + sub * 4), r = *(const f32x4*)(R + 256 + sub * 4);
            const float v = R[320 + i];
            const float sa = row16_sum(s0 * a.x + s1 * a.y + s2 * a.z + s3 * a.w);
            s0 = s0 * wv.x + sa * b.x + v * k.x; s1 = s1 * wv.y + sa * b.y + v * k.y;
            s2 = s2 * wv.z + sa * b.z + v * k.z; s3 = s3 * wv.w + sa * b.w + v * k.w;
            const float y = row16_sum(s0 * r.x + s1 * r.y + s2 * r.z + s3 * r.w);
            if (sub == 0) YR[(size_t)(c0 + tt) * 256 + h * 64 + i] = y;
        }
        __syncthreads();
    }
}
DEVI void scan_gdn(const P& p, int item, char* smem) {
    const float* REC = (const float*)(p.ws + WS_RECG); float* OG = (float*)(p.ws + WS_OG);
    float* L = (float*)smem;
    const int h = item >> 3, eg = item & 7;
    const int tid = threadIdx.x, lane = tid & 63, w = tid >> 6, sub = lane & 15;
    const int e = eg * 16 + w * 4 + (lane >> 4);
    float s[8];
#pragma unroll
    for (int j = 0; j < 8; ++j) s[j] = 0.f;
    for (int c0 = 0; c0 < S; c0 += 32) {
        for (int idx = tid; idx < 32 * 98; idx += NT) {
            const int tok = idx / 98, f4 = idx % 98;
            ((f32x4*)L)[idx] = *(const f32x4*)(REC + ((size_t)(c0 + tok) * 4 + h) * 392 + f4 * 4);
        }
        __syncthreads();
        for (int tt = 0; tt < 32; ++tt) {
            const float* R = L + tt * 392;
            const f32x4 q0 = *(const f32x4*)(R + sub * 8), q1 = *(const f32x4*)(R + sub * 8 + 4);
            const f32x4 k0 = *(const f32x4*)(R + 128 + sub * 8), k1 = *(const f32x4*)(R + 128 + sub * 8 + 4);
            const float v = R[256 + e], dec = R[384], beta = R[385];
#pragma unroll
            for (int j = 0; j < 8; ++j) s[j] *= dec;
            const float kS = row16_sum(s[0] * k0.x + s[1] * k0.y + s[2] * k0.z + s[3] * k0.w + s[4] * k1.x + s[5] * k1.y + s[6] * k1.z + s[7] * k1.w);
            const float cf = beta * (v - kS);
            s[0] += cf * k0.x; s[1] += cf * k0.y; s[2] += cf * k0.z; s[3] += cf * k0.w;
            s[4] += cf * k1.x; s[5] += cf * k1.y; s[6] += cf * k1.z; s[7] += cf * k1.w;
            const float o = row16_sum(s[0] * q0.x + s[1] * q0.y + s[2] * q0.z + s[3] * q0.w + s[4] * q1.x + s[5] * q1.y + s[6] * q1.z + s[7] * q1.w);
            if (sub == 0) OG[(size_t)(c0 + tt) * 512 + h * 128 + e] = o;
        }
        __syncthreads();
    }
}
DEVI void scan_ret(const P& p, int item, char* smem) {
    const float* REC = (const float*)(p.ws + WS_RECT); float* ORT = (float*)(p.ws + WS_ORT);
    float* L = (float*)smem;
    const int h = item >> 2, eg = item & 3;
    const int tid = threadIdx.x, lane = tid & 63, w = tid >> 6, sub = lane & 15;
    const int e = eg * 16 + w * 4 + (lane >> 4);
    const float gam = 1.f - exp2f(-5.f - (float)h);
    float s0 = 0.f, s1 = 0.f, s2 = 0.f, s3 = 0.f;
    for (int c0 = 0; c0 < S; c0 += 32) {
        for (int idx = tid; idx < 32 * 48; idx += NT) {
            const int tok = idx / 48, f4 = idx % 48;
            ((f32x4*)L)[idx] = *(const f32x4*)(REC + ((size_t)(c0 + tok) * 4 + h) * 192 + f4 * 4);
        }
        __syncthreads();
        for (int tt = 0; tt < 32; ++tt) {
            const float* R = L + tt * 192;
            const f32x4 q = *(const f32x4*)(R + sub * 4), k = *(const f32x4*)(R + 64 + sub * 4);
            const float v = R[128 + e];
            s0 = s0 * gam + k.x * v; s1 = s1 * gam + k.y * v; s2 = s2 * gam + k.z * v; s3 = s3 * gam + k.w * v;
            const float o = row16_sum(s0 * q.x + s1 * q.y + s2 * q.z + s3 * q.w);
            if (sub == 0) ORT[(size_t)(c0 + tt) * 256 + h * 64 + e] = o;
        }
        __syncthreads();
    }
}
DEVI void phase_scan(const P& p, char* smem) {
    for (int item = blockIdx.x; item < 64; item += gridDim.x) {
        if (item < 32) scan_gdn(p, item, smem);
        else if (item < 48) scan_rwkv(p, item - 32, smem);
        else scan_ret(p, item - 48, smem);
    }
}

DEVI void phase_post(const P& p, int l) {
    const bf16* PROJ = (const bf16*)(p.ws + WS_PROJ);
    const float* RECR = (const float*)(p.ws + WS_RECR);
    const float* GB = (const float*)(p.ws + WS_G); const float* BON = (const float*)(p.ws + WS_BON);
    const float* YR = (const float*)(p.ws + WS_YR); const float* OG = (const float*)(p.ws + WS_OG); const float* ORT = (const float*)(p.ws + WS_ORT);
    bf16* MIX = (bf16*)(p.ws + WS_MIX);
    const float* ln_g = p.in[17] + l * 256; const float* ln_b = p.in[18] + l * 256;
    const float* gn = p.in[24] + l * 128;
    const float* rg = p.in[25] + l * 256; const float* rb = p.in[26] + l * 256;
    const int tid = threadIdx.x, lane = tid & 63, h = tid >> 6;
    for (int t = blockIdx.x; t < S; t += gridDim.x) {
        {
            const int c = tid;
            const float y = YR[(size_t)t * 256 + c];
            const float mean = wave_sum(y) * (1.f / 64.f);
            const float d = y - mean;
            const float var = wave_sum(d * d) * (1.f / 64.f);
            const float yn = d * rsqrtf(var + 64e-5f) * ln_g[c] + ln_b[c];
            const float v = RECR[((size_t)t * 4 + h) * 384 + 320 + lane];
            const float o = (yn + BON[(size_t)t * 4 + h] * v) * GB[(size_t)t * 256 + c];
            MIX[(size_t)t * D + c] = (bf16)f2bf(o);
        }
        {
            const int c0 = h * 128 + lane, c1 = c0 + 64;
            const float o0 = OG[(size_t)t * 512 + c0], o1 = OG[(size_t)t * 512 + c1];
            const float ms = wave_sum(o0 * o0 + o1 * o1) * (1.f / 128.f);
            const float rs = rsqrtf(ms + 1e-6f);
            const float z0 = proj_at(PROJ, t, 2560 + c0), z1 = proj_at(PROJ, t, 2560 + c1);
            MIX[(size_t)t * D + 256 + c0] = (bf16)f2bf(o0 * rs * gn[lane] * siluf_(z0));
            MIX[(size_t)t * D + 256 + c1] = (bf16)f2bf(o1 * rs * gn[64 + lane] * siluf_(z1));
        }
        {
            const int c = tid;
            const float y = ORT[(size_t)t * 256 + c];
            const float mean = wave_sum(y) * (1.f / 64.f);
            const float d = y - mean;
            const float var = wave_sum(d * d) * (1.f / 64.f);
            const float yn = d * rsqrtf(var + 1e-5f) * rg[c] + rb[c];
            const float gt = proj_at(PROJ, t, 3840 + c);
            MIX[(size_t)t * D + 768 + c] = (bf16)f2bf(yn * siluf_(gt));
        }
    }
}

DEVI void phase_outproj(const P& p, int l, char* smem) {
    const bf16* MIX = (const bf16*)(p.ws + WS_MIX);
    const bf16* W = (const bf16*)(p.ws + WS_WOUT) + (size_t)l * D * D;
    float* OPRE = (float*)(p.ws + WS_OPRE);
    const int lane = threadIdx.x & 63, wid = threadIdx.x >> 6, wr = wid >> 1, wc = wid & 1, fr = lane & 15, fq = lane >> 4;
    for (int tile = blockIdx.x; tile < (S / 128) * 8; tile += gridDim.x) {
        const int mt = tile / 8, nt = tile % 8;
        f32x4 acc[4][4];
        gemm_tile(smem, [&](int r) { return MIX + (size_t)(mt * 128 + r) * D; }, [&](int r) { return W + (size_t)(nt * 128 + r) * D; }, D, acc);
#pragma unroll
        for (int m = 0; m < 4; ++m) {
            const int tok = mt * 128 + wr * 64 + m * 16 + fr;
#pragma unroll
            for (int n = 0; n < 4; ++n) *(f32x4*)(OPRE + (size_t)tok * D + nt * 128 + wc * 64 + n * 16 + fq * 4) = acc[m][n];
        }
    }
}

DEVI void phase_ln1_route(const P& p, int l, char* smem) {
    const float* ADA = (const float*)(p.ws + OFF_ADA) + l * 6144;
    const float* xin = (l == 0) ? p.in[0] : (const float*)(p.ws + WS_X);
    const float* OPRE = (const float*)(p.ws + WS_OPRE);
    float* X = (float*)(p.ws + WS_X); bf16* H2 = (bf16*)(p.ws + WS_H2);
    const float* lg = p.in[28] + l * D; const float* lb = p.in[29] + l * D;
    const float* rw = p.in[30] + (size_t)l * D * 32; const float* rbias = p.in[31] + l * 32;
    int* CNT = (int*)(p.ws + OFF_CNT) + l * 32; int* LIST = (int*)(p.ws + WS_LIST); float* GATE = (float*)(p.ws + WS_GATE);
    float* HS = (float*)smem;
    float* RED = HS + 4 * 1024;
    const int tid = threadIdx.x, lane = tid & 63, w = tid >> 6;
    for (int item = blockIdx.x; item < S / 4; item += gridDim.x) {
        const int t = item * 4 + w;
        {
            f32x4 v[4]; float s = 0.f;
#pragma unroll
            for (int j = 0; j < 4; ++j) {
                const int c = j * 256 + lane * 4;
                const f32x4 x = *(const f32x4*)(xin + (size_t)t * D + c);
                const f32x4 o = *(const f32x4*)(OPRE + (size_t)t * D + c);
                const f32x4 gt = *(const f32x4*)(ADA + 2048 + c);
                v[j].x = DN_ALPHA * x.x + (1.f + gt.x) * o.x; v[j].y = DN_ALPHA * x.y + (1.f + gt.y) * o.y;
                v[j].z = DN_ALPHA * x.z + (1.f + gt.z) * o.z; v[j].w = DN_ALPHA * x.w + (1.f + gt.w) * o.w;
                s += (v[j].x + v[j].y) + (v[j].z + v[j].w);
            }
            const float mean = wave_sum(s) * (1.f / D);
            float s2 = 0.f;
#pragma unroll
            for (int j = 0; j < 4; ++j) { v[j] = v[j] - mean; s2 += (v[j].x * v[j].x + v[j].y * v[j].y) + (v[j].z * v[j].z + v[j].w * v[j].w); }
            const float rstd = rsqrtf(wave_sum(s2) * (1.f / D) + 1e-5f);
#pragma unroll
            for (int j = 0; j < 4; ++j) {
                const int c = j * 256 + lane * 4;
                const f32x4 g = *(const f32x4*)(lg + c), b = *(const f32x4*)(lb + c);
                f32x4 xo = v[j] * rstd * g + b;
                *(f32x4*)(X + (size_t)t * D + c) = xo;
                const f32x4 sh = *(const f32x4*)(ADA + 3072 + c), sc = *(const f32x4*)(ADA + 4096 + c);
                f32x4 hh = xo * (1.f + sc) + sh;
                *(f32x4*)(HS + w * 1024 + c) = hh;
                u32x2 o; o.x = pk2(hh.x, hh.y); o.y = pk2(hh.z, hh.w);
                *(u32x2*)(H2 + (size_t)t * D + c) = o;
            }
        }
        __syncthreads();
        {
            const int e = tid & 31, ks = tid >> 5;
            float a0 = 0.f, a1 = 0.f, a2 = 0.f, a3 = 0.f;
            for (int k = ks * 128; k < ks * 128 + 128; k += 4) {
                const float w0 = rw[(k + 0) * 32 + e], w1 = rw[(k + 1) * 32 + e], w2 = rw[(k + 2) * 32 + e], w3 = rw[(k + 3) * 32 + e];
                const f32x4 h0 = *(const f32x4*)(HS + 0 * 1024 + k), h1 = *(const f32x4*)(HS + 1 * 1024 + k);
                const f32x4 h2 = *(const f32x4*)(HS + 2 * 1024 + k), h3 = *(const f32x4*)(HS + 3 * 1024 + k);
                a0 += h0.x * w0 + h0.y * w1 + h0.z * w2 + h0.w * w3;
                a1 += h1.x * w0 + h1.y * w1 + h1.z * w2 + h1.w * w3;
                a2 += h2.x * w0 + h2.y * w1 + h2.z * w2 + h2.w * w3;
                a3 += h3.x * w0 + h3.y * w1 + h3.z * w2 + h3.w * w3;
            }
            RED[(ks * 4 + 0) * 32 + e] = a0; RED[(ks * 4 + 1) * 32 + e] = a1; RED[(ks * 4 + 2) * 32 + e] = a2; RED[(ks * 4 + 3) * 32 + e] = a3;
        }
        __syncthreads();
        if (tid < 128) {
            const int tok = tid >> 5, e = tid & 31, tt = item * 4 + tok;
            float logit = rbias[e];
#pragma unroll
            for (int ks = 0; ks < 8; ++ks) logit += RED[(ks * 4 + tok) * 32 + e];
            bool taken = false;
            float sv[4]; int si[4];
#pragma unroll
            for (int j = 0; j < 4; ++j) {
                float cand = taken ? -3.0e38f : logit; int ci = e;
#pragma unroll
                for (int off = 16; off >= 1; off >>= 1) {
                    const float ov = __shfl_xor(cand, off, 32); const int oi = __shfl_xor(ci, off, 32);
                    if (ov > cand || (ov == cand && oi < ci)) { cand = ov; ci = oi; }
                }
                sv[j] = cand; si[j] = ci; if (ci == e) taken = true;
            }
            const float e0 = 1.f, e1 = __expf(sv[1] - sv[0]), e2 = __expf(sv[2] - sv[0]), e3 = __expf(sv[3] - sv[0]);
            const float inv = 1.f / (e0 + e1 + e2 + e3);
            const float gts[4] = {e0 * inv, e1 * inv, e2 * inv, e3 * inv};
#pragma unroll
            for (int j = 0; j < 4; ++j) {
                if (si[j] == e) {
                    const int pos = atomicAdd(&CNT[e], 1);
                    LIST[(size_t)e * S + pos] = tt * 4 + j;
                    GATE[(size_t)tt * 4 + j] = gts[j];
                }
            }
        }
        __syncthreads();
    }
}

struct MoeMap { int cnt[32]; int off[32]; int tstart[33]; };
DEVI void moe_map(const P& p, int l, MoeMap* mm) {
    const int* CNT = (const int*)(p.ws + OFF_CNT) + l * 32;
    if (threadIdx.x < 32) mm->cnt[threadIdx.x] = __hip_atomic_load(&CNT[threadIdx.x], __ATOMIC_RELAXED, __HIP_MEMORY_SCOPE_AGENT);
    __syncthreads();
    if (threadIdx.x == 0) {
        int o = 0, ts = 0;
        for (int e = 0; e < 32; ++e) { mm->off[e] = o; mm->tstart[e] = ts; o += mm->cnt[e]; ts += (mm->cnt[e] + 127) / 128; }
        mm->tstart[32] = ts;
    }
    __syncthreads();
}

DEVI void phase_moe_up(const P& p, int l, char* smem) {
    MoeMap* mm = (MoeMap*)(smem + 16384);
    int* rows = (int*)(smem + 16384 + 1024);
    moe_map(p, l, mm);
    const bf16* H2 = (const bf16*)(p.ws + WS_H2);
    const bf16* WUP = (const bf16*)(p.ws + WS_WUP) + (size_t)l * NEXP * 2048 * D;
    const float* bup = p.in[33] + (size_t)l * NEXP * 2048;
    const int* LIST = (const int*)(p.ws + WS_LIST);
    bf16* ACT = (bf16*)(p.ws + WS_ACT);
    const int lane = threadIdx.x & 63, wid = threadIdx.x >> 6, wr = wid >> 1, wc = wid & 1, fr = lane & 15, fq = lane >> 4;
    const int ntiles = mm->tstart[32] * 16;
    for (int tile = blockIdx.x; tile < ntiles; tile += gridDim.x) {
        const int mtg = tile / 16, nt = tile % 16;
        int e = 0;
        while (mm->tstart[e + 1] <= mtg) ++e;
        const int m0 = (mtg - mm->tstart[e]) * 128, cnt = mm->cnt[e];
        __syncthreads();
        if (threadIdx.x < 128) { const int r = m0 + threadIdx.x; rows[threadIdx.x] = LIST[(size_t)e * S + (r < cnt ? r : m0)]; }
        __syncthreads();
        const bf16* We = WUP + (size_t)e * 2048 * D;
        f32x4 acc[4][4];
        gemm_tile(smem, [&](int r) { return H2 + (size_t)(rows[r] >> 2) * D; },
                  [&](int r) { const int t16 = r >> 4; return We + (size_t)(nt * 64 + (t16 >> 1) * 16 + (r & 15) + ((t16 & 1) ? 1024 : 0)) * D; }, D, acc);
        const float* be = bup + (size_t)e * 2048;
#pragma unroll
        for (int m = 0; m < 4; ++m) {
            const int rl = m0 + wr * 64 + m * 16 + fr;
            if (rl < cnt) {
#pragma unroll
                for (int n2 = 0; n2 < 2; ++n2) {
                    const int col = nt * 64 + (wc * 2 + n2) * 16 + fq * 4;
                    const f32x4 bg = *(const f32x4*)(be + col), bl = *(const f32x4*)(be + 1024 + col);
                    float o[4];
#pragma unroll
                    for (int j = 0; j < 4; ++j) {
                        const float glu = fminf(acc[m][2 * n2][j] + bg[j], 7.f);
                        const float lin = fminf(fmaxf(acc[m][2 * n2 + 1][j] + bl[j], -7.f), 7.f);
                        o[j] = glu * sigmoidf_(1.702f * glu) * (lin + 1.f);
                    }
                    u32x2 ov; ov.x = pk2(o[0], o[1]); ov.y = pk2(o[2], o[3]);
                    *(u32x2*)(ACT + (size_t)(mm->off[e] + rl) * DFF + col) = ov;
                }
            }
        }
    }
}

DEVI void phase_moe_down(const P& p, int l, char* smem) {
    MoeMap* mm = (MoeMap*)(smem + 16384);
    int* rows = (int*)(smem + 16384 + 1024);
    moe_map(p, l, mm);
    const bf16* ACT = (const bf16*)(p.ws + WS_ACT);
    const bf16* WDN = (const bf16*)(p.ws + WS_WDN) + (size_t)l * NEXP * D * DFF;
    const float* bdn = p.in[35] + (size_t)l * NEXP * D;
    const int* LIST = (const int*)(p.ws + WS_LIST); const float* GATE = (const float*)(p.ws + WS_GATE);
    bf16* YB = (bf16*)(p.ws + WS_YB);
    const int lane = threadIdx.x & 63, wid = threadIdx.x >> 6, wr = wid >> 1, wc = wid & 1, fr = lane & 15, fq = lane >> 4;
    const int ntiles = mm->tstart[32] * 8;
    for (int tile = blockIdx.x; tile < ntiles; tile += gridDim.x) {
        const int mtg = tile / 8, nt = tile % 8;
        int e = 0;
        while (mm->tstart[e + 1] <= mtg) ++e;
        const int m0 = (mtg - mm->tstart[e]) * 128, cnt = mm->cnt[e];
        __syncthreads();
        if (threadIdx.x < 128) { const int r = m0 + threadIdx.x; rows[threadIdx.x] = LIST[(size_t)e * S + (r < cnt ? r : m0)]; }
        __syncthreads();
        const bf16* We = WDN + (size_t)e * D * DFF;
        const size_t abase = (size_t)mm->off[e] + m0;
        f32x4 acc[4][4];
        gemm_tile(smem, [&](int r) { return ACT + (abase + ((m0 + r) < cnt ? r : 0)) * DFF; },
                  [&](int r) { return We + (size_t)(nt * 128 + r) * DFF; }, DFF, acc);
        const float* be = bdn + (size_t)e * D;
#pragma unroll
        for (int m = 0; m < 4; ++m) {
            const int rt = wr * 64 + m * 16 + fr;
            if (m0 + rt < cnt) {
                const int ent = rows[rt];
                const float gt = GATE[ent];
#pragma unroll
                for (int n = 0; n < 4; ++n) {
                    const int col = nt * 128 + wc * 64 + n * 16 + fq * 4;
                    const f32x4 b = *(const f32x4*)(be + col);
                    u32x2 ov; ov.x = pk2((acc[m][n].x + b.x) * gt, (acc[m][n].y + b.y) * gt); ov.y = pk2((acc[m][n].z + b.z) * gt, (acc[m][n].w + b.w) * gt);
                    *(u32x2*)(YB + (size_t)ent * D + col) = ov;
                }
            }
        }
    }
}

DEVI void phase_ln2(const P& p, int l) {
    const float* ADA = (const float*)(p.ws + OFF_ADA) + l * 6144;
    const float* ADAn = (const float*)(p.ws + OFF_ADA) + 6144;
    float* X = (float*)(p.ws + WS_X); const bf16* YB = (const bf16*)(p.ws + WS_YB);
    bf16* HB = (bf16*)(p.ws + WS_HB);
    const float* lg = p.in[36] + l * D; const float* lb = p.in[37] + l * D;
    const int tid = threadIdx.x, lane = tid & 63, w = tid >> 6;
    for (int item = blockIdx.x; item < S / 4; item += gridDim.x) {
        const int t = item * 4 + w;
        f32x4 v[4]; float s = 0.f;
#pragma unroll
        for (int j = 0; j < 4; ++j) {
            const int c = j * 256 + lane * 4;
            const f32x4 x = *(const f32x4*)(X + (size_t)t * D + c);
            f32x4 f = {0.f, 0.f, 0.f, 0.f};
#pragma unroll
            for (int q = 0; q < 4; ++q) {
                const u32x2 y = *(const u32x2*)(YB + ((size_t)t * 4 + q) * D + c);
                f.x += __uint_as_float(y.x << 16); f.y += __uint_as_float(y.x & 0xffff0000u);
                f.z += __uint_as_float(y.y << 16); f.w += __uint_as_float(y.y & 0xffff0000u);
            }
            const f32x4 gt = *(const f32x4*)(ADA + 5120 + c);
            v[j] = x * DN_ALPHA + (gt + 1.f) * f;
            s += (v[j].x + v[j].y) + (v[j].z + v[j].w);
        }
        const float mean = wave_sum(s) * (1.f / D);
        float s2 = 0.f;
#pragma unroll
        for (int j = 0; j < 4; ++j) { v[j] = v[j] - mean; s2 += (v[j].x * v[j].x + v[j].y * v[j].y) + (v[j].z * v[j].z + v[j].w * v[j].w); }
        const float rstd = rsqrtf(wave_sum(s2) * (1.f / D) + 1e-5f);
#pragma unroll
        for (int j = 0; j < 4; ++j) {
            const int c = j * 256 + lane * 4;
            const f32x4 g = *(const f32x4*)(lg + c), b = *(const f32x4*)(lb + c);
            const f32x4 xo = v[j] * rstd * g + b;
            if (l == 0) {
                *(f32x4*)(X + (size_t)t * D + c) = xo;
                const f32x4 sh = *(const f32x4*)(ADAn + c), sc = *(const f32x4*)(ADAn + 1024 + c);
                const f32x4 hh = xo * (sc + 1.f) + sh;
                u32x2 o; o.x = pk2(hh.x, hh.y); o.y = pk2(hh.z, hh.w);
                *(u32x2*)(HB + (size_t)t * D + c) = o;
            } else {
                *(f32x4*)(p.out + (size_t)t * D + c) = xo;
            }
        }
    }
}

constexpr int NPHASE = 20;
__global__ void __launch_bounds__(NT, 2) k_run(P p) {
    extern __shared__ __attribute__((aligned(16))) char smem[];
    XcdBarrier bar; bar.bar = nullptr; bar.x = 0; bar.st = nullptr;
    const bool multi = (p.ph_hi - p.ph_lo) > 1;
    if (multi) {
        volatile LAS unsigned* st = (volatile LAS unsigned*)(smem + LDS_BYTES - 16);
        if (threadIdx.x == 0) { st[0] = 0u; st[1] = 0u; }
        __syncthreads();
        bar = xcd_barrier_post((unsigned*)(p.ws + OFF_BAR), st);
    }
#define RUN(k, call) if (p.ph_lo <= (k) && (k) < p.ph_hi) { call; if (multi && (k) + 1 < p.ph_hi) xcd_barrier(bar); }
    RUN(0, phase_prep(p, smem))
    RUN(1, phase_h0(p))
    RUN(2, phase_inproj(p, 0, smem))
    RUN(3, phase_mixprep(p, 0, smem))
    RUN(4, phase_scan(p, smem))
    RUN(5, phase_post(p, 0))
    RUN(6, phase_outproj(p, 0, smem))
    RUN(7, phase_ln1_route(p, 0, smem))
    RUN(8, phase_moe_up(p, 0, smem))
    RUN(9, phase_moe_down(p, 0, smem))
    RUN(10, phase_ln2(p, 0))
    RUN(11, phase_inproj(p, 1, smem))
    RUN(12, phase_mixprep(p, 1, smem))
    RUN(13, phase_scan(p, smem))
    RUN(14, phase_post(p, 1))
    RUN(15, phase_outproj(p, 1, smem))
    RUN(16, phase_ln1_route(p, 1, smem))
    RUN(17, phase_moe_up(p, 1, smem))
    RUN(18, phase_moe_down(p, 1, smem))
    RUN(19, phase_ln2(p, 1))
#undef RUN
}

extern "C" void kernel_launch(void* const* d_in, const int* in_sizes, int n_in, void* d_out, int out_size, void* d_ws, size_t ws_size,
                              hipStream_t stream) {
    static int grid = 0;
    if (grid == 0) {
        if (n_in != 38 || ws_size < WS_END) { fprintf(stderr, "kernel_launch: unexpected n_in %d or ws_size %zu (< %zu)\n", n_in, ws_size, (size_t)WS_END); grid = -1; return; }
        int dev = 0, cus = 0, per_cu = 0;
        hipGetDevice(&dev);
        hipDeviceGetAttribute(&cus, hipDeviceAttributeMultiprocessorCount, dev);
        hipFuncSetAttribute((const void*)k_run, hipFuncAttributeMaxDynamicSharedMemorySize, LDS_BYTES);
        hipOccupancyMaxActiveBlocksPerMultiprocessor(&per_cu, (const void*)k_run, NT, LDS_BYTES);
        if (per_cu < 1) { fprintf(stderr, "kernel_launch: occupancy query returned %d\n", per_cu); grid = -1; return; }
        if (per_cu > 2) per_cu = 2;
        grid = cus * per_cu;
    }
    if (grid < 0) return;
    hipMemsetAsync((char*)d_ws + WS_CTL, 0, CTL_BYTES, stream);
    P p{};
    for (int i = 0; i < 38; ++i) p.in[i] = (const float*)d_in[i];
    p.pos = (const int*)d_in[2];
    p.out = (float*)d_out; p.ws = (char*)d_ws;
#if MEGA
    p.ph_lo = 0; p.ph_hi = NPHASE;
    void* args[] = {&p};
    hipError_t e = hipLaunchCooperativeKernel((const void*)k_run, dim3(grid), dim3(NT), args, LDS_BYTES, stream);
    if (e != hipSuccess) fprintf(stderr, "cooperative launch failed: %s (grid %d)\n", hipGetErrorString(e), grid);
#else
    for (int ph = 0; ph < NPHASE; ++ph) {
        p.ph_lo = ph; p.ph_hi = ph + 1;
        hipLaunchKernelGGL(k_run, dim3(grid), dim3(NT), LDS_BYTES, stream, p);
    }
#endif
}
```

```cpp
#include <hip/hip_runtime.h>
#include <hip/hip_bf16.h>
#include <stdint.h>
#include <stdio.h>

#ifndef MEGA
#define MEGA 1
#endif

#define DEVI __device__ __forceinline__
#define LAS __attribute__((address_space(3)))

typedef unsigned short bf16;
typedef short bf16x8 __attribute__((ext_vector_type(8)));
typedef float f32x4 __attribute__((ext_vector_type(4)));
typedef unsigned u32x4 __attribute__((ext_vector_type(4)));
typedef unsigned u32x2 __attribute__((ext_vector_type(2)));

constexpr int S = 16384, D = 1024, NIN = 4104, NEXP = 32, DFF = 1024;
constexpr int NPROJ = 4096;
constexpr int NPAD = 4224;
constexpr float DN_ALPHA = 1.4142135623730951f;
constexpr int NT = 256;
constexpr int LDS_BYTES = 67840;

constexpr size_t MiB = 1ull << 20;
constexpr size_t WS_CTL = 0;
constexpr size_t CTL_BYTES = 1 * MiB;
constexpr size_t OFF_BAR = 0;
constexpr size_t OFF_ADA = 64 * 1024;
constexpr size_t OFF_CNT = 128 * 1024;
constexpr size_t WS_ROT = 1 * MiB;
constexpr size_t WS_WIN = WS_ROT + (size_t)S * 64 * 4;
constexpr size_t WS_WOUT = WS_WIN + 2ull * NPAD * D * 2;
constexpr size_t WS_WUP = WS_WOUT + 2ull * D * D * 2;
constexpr size_t WS_WDN = WS_WUP + 2ull * NEXP * 2048 * D * 2;
constexpr size_t WS_HB = WS_WDN + 2ull * NEXP * D * DFF * 2;
constexpr size_t WS_PROJ = WS_HB + (size_t)S * D * 2;
constexpr size_t WS_PEX = WS_PROJ + (size_t)S * NPROJ * 2;
constexpr size_t WS_VFIRST = WS_PEX + (size_t)S * 64 * 4;
constexpr size_t WS_RECR = WS_VFIRST + (size_t)S * 256 * 4;
constexpr size_t WS_RECG = WS_RECR + (size_t)S * 4 * 384 * 4;
constexpr size_t WS_RECT = WS_RECG + (size_t)S * 4 * 392 * 4;
constexpr size_t WS_G = WS_RECT + (size_t)S * 4 * 192 * 4;
constexpr size_t WS_BON = WS_G + (size_t)S * 256 * 4;
constexpr size_t WS_YR = WS_BON + (size_t)S * 4 * 4;
constexpr size_t WS_OG = WS_YR + (size_t)S * 256 * 4;
constexpr size_t WS_ORT = WS_OG + (size_t)S * 512 * 4;
constexpr size_t WS_MIX = WS_ORT + (size_t)S * 256 * 4;
constexpr size_t WS_OPRE = WS_MIX + (size_t)S * D * 2;
constexpr size_t WS_X = WS_OPRE + (size_t)S * D * 4;
constexpr size_t WS_H2 = WS_X + (size_t)S * D * 4;
constexpr size_t WS_LIST = WS_H2 + (size_t)S * D * 2;
constexpr size_t WS_GATE = WS_LIST + (size_t)NEXP * S * 4;
constexpr size_t WS_ACT = WS_GATE + (size_t)S * 4 * 4;
constexpr size_t WS_YB = WS_ACT + ((size_t)S * 4 + 128) * DFF * 2;
constexpr size_t WS_ADAP = WS_YB + (size_t)S * 4 * D * 2;
constexpr size_t WS_RKV = WS_ADAP + 16ull * 12288 * 4;
constexpr size_t WS_RST = WS_RKV + 256ull * 4 * 4096 * 4;
constexpr size_t WS_GP = WS_RST + 256ull * 4 * 4096 * 2;
constexpr size_t WS_GB = WS_GP + 1024ull * 16384 * 2;
constexpr size_t WS_GD = WS_GB + 1024ull * 16384 * 4;
constexpr size_t WS_GQ = WS_GD + 4096;
constexpr size_t WS_GO = WS_GQ + 1024ull * 8192 * 2;
constexpr size_t WS_GS = WS_GO + 1024ull * 8192 * 4;
constexpr size_t WS_WP = WS_GS + 1024ull * 16384 * 2;
constexpr size_t WS_WC = WS_WP + 2048ull * 4096 * 2;
constexpr size_t WS_WD = WS_WC + 2048ull * 4096 * 4;
constexpr size_t WS_WQ = WS_WD + 2048ull * 64 * 4;
constexpr size_t WS_WY = WS_WQ + 2048ull * 2048 * 2;
constexpr size_t WS_WS = WS_WY + 2048ull * 2048 * 4;
constexpr size_t WS_END = WS_WS + 2048ull * 4096 * 2;

struct P {
    const float* in[38];
    const int* pos;
    float* out;
    char* ws;
    int ph_lo, ph_hi;
};

DEVI float bf2f(bf16 v) { return __uint_as_float(((unsigned)v) << 16); }
DEVI unsigned f2bf(float f) { unsigned u = __float_as_uint(f); return (u + 0x7fffu + ((u >> 16) & 1u)) >> 16; }
DEVI unsigned pk2(float lo, float hi) { return f2bf(lo) | (f2bf(hi) << 16); }
DEVI float sigmoidf_(float x) { return 1.f / (1.f + __expf(-x)); }
DEVI float siluf_(float x) { return x * sigmoidf_(x); }
DEVI float softplusf_(float x) { return fmaxf(x, 0.f) + log1pf(__expf(-fabsf(x))); }
DEVI float wave_sum(float v) {
#pragma unroll
    for (int o = 32; o >= 1; o >>= 1) v += __shfl_xor(v, o);
    return v;
}
template <int CTRL> DEVI float dpp_mov(float x) {
    return __int_as_float(__builtin_amdgcn_update_dpp(0, __float_as_int(x), CTRL, 0xf, 0xf, false));
}
DEVI float row16_sum(float x) {
    x += dpp_mov<0x128>(x);
    x += dpp_mov<0x124>(x);
    x += dpp_mov<0x122>(x);
    x += dpp_mov<0x121>(x);
    return x;
}

#define XB_TMO      128
#define XB_XCNT(j)  (256  + 64 * (j))
#define XB_XSUB(j)  (1280 + 64 * (j))
#define XB_XGEN(j)  (2304 + 64 * (j))
#define XB_TOP      3328
#define XB_TOPGEN   3392
#define XCD_BAR_WORDS 3456
#define XB_SPIN_CAP (1u << 22)
DEVI unsigned xb_ld(unsigned* p) { return __hip_atomic_load(p, __ATOMIC_RELAXED, __HIP_MEMORY_SCOPE_AGENT); }
DEVI unsigned xb_add(unsigned* p, unsigned v) { return __hip_atomic_fetch_add(p, v, __ATOMIC_RELAXED, __HIP_MEMORY_SCOPE_AGENT); }
DEVI unsigned xb_xcc_id() { return (unsigned)__builtin_amdgcn_s_getreg((3 << 11) | 20) & 0xFu; }
#define XB_SPIN(cond, bar) do { unsigned _sp = 0; while (cond) { __builtin_amdgcn_s_sleep(1); \
    if ((++_sp & 255u) == 0u) { if (xb_ld(&(bar)[XB_TMO])) break; if (_sp > XB_SPIN_CAP) { atomicAdd(&(bar)[XB_TMO], 1u); break; } } } } while (0)
struct XcdBarrier { unsigned* bar; unsigned x; volatile LAS unsigned* st; };
DEVI XcdBarrier xcd_barrier_post(unsigned* bar, volatile LAS unsigned* st) {
    XcdBarrier b; b.bar = bar; b.x = xb_xcc_id(); b.st = st;
    if (threadIdx.x == 0) (void)xb_add(&bar[XB_XCNT(b.x)], 1u);
    return b;
}
DEVI void xcd_barrier_complete(unsigned* bar, unsigned x, unsigned& nloc, unsigned& nx) {
    const unsigned G = gridDim.x * gridDim.y * gridDim.z;
    unsigned sum, cnt, mine, sp = 0u;
    for (;;) {
        sum = 0u; cnt = 0u; mine = 0u;
#pragma unroll
        for (unsigned j = 0; j < 16; ++j) { const unsigned c = xb_ld(&bar[XB_XCNT(j)]); sum += c; cnt += (c > 0u) ? 1u : 0u; mine = (j == x) ? c : mine; }
        if (sum == G) break;
        __builtin_amdgcn_s_sleep(1);
        if ((++sp & 255u) == 0u) { if (xb_ld(&bar[XB_TMO])) break; if (sp > XB_SPIN_CAP) { atomicAdd(&bar[XB_TMO], 1u); break; } }
    }
    nloc = mine > 0u ? mine : 1u; nx = cnt > 0u ? cnt : 1u;
}
DEVI void xcd_barrier(const XcdBarrier& b) {
    asm volatile("s_waitcnt vmcnt(0)" ::: "memory");
    __syncthreads();
    if (threadIdx.x == 0) {
        unsigned* bar = b.bar;
        __builtin_amdgcn_s_waitcnt(0);
        unsigned nloc = b.st[0], nx = b.st[1];
        if (nloc == 0u) { xcd_barrier_complete(bar, b.x, nloc, nx); b.st[0] = nloc; b.st[1] = nx; }
        const unsigned old = xb_add(&bar[XB_XSUB(b.x)], 1u);
        const unsigned gen = old / nloc;
        if (old + 1u == (gen + 1u) * nloc) {
            __builtin_amdgcn_fence(__ATOMIC_RELEASE, "agent");
            asm volatile("s_waitcnt vmcnt(0)" ::: "memory");
            const unsigned og = xb_add(&bar[XB_TOP], 1u);
            const unsigned tg = og / nx;
            if (og + 1u == (tg + 1u) * nx) xb_add(&bar[XB_TOPGEN], 1u);
            else XB_SPIN(xb_ld(&bar[XB_TOPGEN]) == tg, bar);
            __builtin_amdgcn_fence(__ATOMIC_ACQUIRE, "agent");
            xb_add(&bar[XB_XGEN(b.x)], 1u);
            asm volatile("s_waitcnt vmcnt(0)" ::: "memory");
        } else {
            XB_SPIN(xb_ld(&bar[XB_XGEN(b.x)]) == gen, bar);
            __builtin_amdgcn_fence(__ATOMIC_ACQUIRE, "agent");
            asm volatile("s_waitcnt vmcnt(0)" ::: "memory");
        }
    }
    __syncthreads();
}

DEVI void transpose_item(const float* __restrict__ src, size_t ld, int k0, int ns0, bf16* __restrict__ dst, int kd, int nd0, float* lds) {
    const int tid = threadIdx.x;
#pragma unroll 4
    for (int i = 0; i < 16; ++i) {
        const int kk = i * 4 + (tid >> 6), n = tid & 63;
        lds[kk * 65 + n] = src[(size_t)(k0 + kk) * ld + ns0 + n];
    }
    __syncthreads();
#pragma unroll
    for (int i = 0; i < 2; ++i) {
        const int q = tid + 256 * i, n = q >> 3, kc = q & 7;
        const float* s = lds + (kc * 8) * 65 + n;
        u32x4 o;
        o.x = pk2(s[0 * 65], s[1 * 65]); o.y = pk2(s[2 * 65], s[3 * 65]);
        o.z = pk2(s[4 * 65], s[5 * 65]); o.w = pk2(s[6 * 65], s[7 * 65]);
        *(u32x4*)(dst + (size_t)(nd0 + n) * kd + k0 + kc * 8) = o;
    }
    __syncthreads();
}

DEVI void phase_prep(const P& p, char* smem) {
    float* lds = (float*)smem;
    const int tid = threadIdx.x;
    const int nb = gridDim.x, bid = blockIdx.x;
    bf16* WIN = (bf16*)(p.ws + WS_WIN); bf16* WOUT = (bf16*)(p.ws + WS_WOUT);
    bf16* WUP = (bf16*)(p.ws + WS_WUP); bf16* WDN = (bf16*)(p.ws + WS_WDN);
    constexpr int I_UP = 2 * NEXP * 16 * 32;
    constexpr int I_DN = 2 * NEXP * 16 * 16;
    constexpr int I_IN = 2 * 16 * 64;
    constexpr int I_OUT = 2 * 16 * 16;
    constexpr int I_EX = 2 * 128;
    constexpr int I_ADA = 2 * 24 * 16;
    constexpr int I_ROT = S * 32 / 256;
    constexpr int NITEMS = I_UP + I_DN + I_IN + I_OUT + I_EX + I_ADA + I_ROT;
    for (int it = bid; it < NITEMS; it += nb) {
        int r = it;
        if (r < I_UP) {
            const int le = r / 512, q = r % 512, kt = q / 32, nt = q % 32;
            transpose_item(p.in[32] + (size_t)le * D * 2048, 2048, kt * 64, nt * 64, WUP + (size_t)le * 2048 * D, D, nt * 64, lds);
            continue;
        }
        r -= I_UP;
        if (r < I_DN) {
            const int le = r / 256, q = r % 256, kt = q / 16, nt = q % 16;
            transpose_item(p.in[34] + (size_t)le * DFF * D, D, kt * 64, nt * 64, WDN + (size_t)le * D * DFF, DFF, nt * 64, lds);
            continue;
        }
        r -= I_DN;
        if (r < I_IN) {
            const int l = r / 1024, q = r % 1024, kt = q / 64, nt = q % 64;
            const int nd0 = nt * 64, ns0 = nd0 < 3072 ? nd0 : nd0 + 8;
            transpose_item(p.in[5] + (size_t)l * D * NIN, NIN, kt * 64, ns0, WIN + (size_t)l * NPAD * D, D, nd0, lds);
            continue;
        }
        r -= I_IN;
        if (r < I_OUT) {
            const int l = r / 256, q = r % 256, kt = q / 16, nt = q % 16;
            transpose_item(p.in[27] + (size_t)l * D * D, D, kt * 64, nt * 64, WOUT + (size_t)l * D * D, D, nt * 64, lds);
            continue;
        }
        r -= I_OUT;
        if (r < I_EX) {
            const int l = r / 128, n = r % 128;
            bf16* dst = WIN + ((size_t)l * NPAD + NPROJ + n) * D;
            for (int k = tid; k < D; k += NT) {
                float v = 0.f;
                if (n < 8) v = p.in[5][(size_t)l * D * NIN + (size_t)k * NIN + 3072 + n];
                else if (n < 40 && l == 1) v = p.in[6][(size_t)k * 32 + (n - 8)];
                dst[k] = (bf16)f2bf(v);
            }
            continue;
        }
        r -= I_EX;
        if (r < I_ADA) {
            const int l = r / 384, q = r % 384, nc = q / 16, kc = q % 16;
            const int n = nc * 256 + tid;
            const float* W = p.in[3] + (size_t)l * D * 6144;
            float acc = (kc == 0) ? p.in[4][l * 6144 + n] : 0.f;
            for (int k = kc * 64; k < kc * 64 + 64; ++k) acc += siluf_(p.in[1][k]) * W[(size_t)k * 6144 + n];
            ((float*)(p.ws + WS_ADAP))[(size_t)kc * 12288 + l * 6144 + n] = acc;
            continue;
        }
        r -= I_ADA;
        {
            const int idx = r * 256 + tid;
            const int t = idx >> 5, i = idx & 31;
            const float invf = (float)pow(10000.0, -(double)i / 32.0);
            const float ang = (float)p.pos[t] * invf;
            float sn, cs; sincosf(ang, &sn, &cs);
            float* ROT = (float*)(p.ws + WS_ROT);
            ROT[(size_t)idx * 2] = cs; ROT[(size_t)idx * 2 + 1] = sn;
        }
    }
}

DEVI float ada_sum(const float* ADAP, int idx) {
    float s = 0.f;
#pragma unroll
    for (int kc = 0; kc < 16; ++kc) s += ADAP[(size_t)kc * 12288 + idx];
    return s;
}
DEVI void phase_h0(const P& p) {
    const float* ADAP = (const float*)(p.ws + WS_ADAP);
    float* ADA = (float*)(p.ws + OFF_ADA);
    bf16* HB = (bf16*)(p.ws + WS_HB);
    if (blockIdx.x < 48) ADA[blockIdx.x * 256 + threadIdx.x] = ada_sum(ADAP, blockIdx.x * 256 + threadIdx.x);
    const size_t n4 = (size_t)S * D / 4;
    const int c = (int)(((size_t)blockIdx.x * NT + threadIdx.x) % (D / 4)) * 4;
    f32x4 sh, sc;
    sh.x = ada_sum(ADAP, c); sh.y = ada_sum(ADAP, c + 1); sh.z = ada_sum(ADAP, c + 2); sh.w = ada_sum(ADAP, c + 3);
    sc.x = ada_sum(ADAP, 1024 + c); sc.y = ada_sum(ADAP, 1025 + c); sc.z = ada_sum(ADAP, 1026 + c); sc.w = ada_sum(ADAP, 1027 + c);
    for (size_t i = (size_t)blockIdx.x * NT + threadIdx.x; i < n4; i += (size_t)gridDim.x * NT) {
        const f32x4 x = ((const f32x4*)p.in[0])[i];
        u32x2 o;
        o.x = pk2(x.x * (1.f + sc.x) + sh.x, x.y * (1.f + sc.y) + sh.y);
        o.y = pk2(x.z * (1.f + sc.z) + sh.z, x.w * (1.f + sc.w) + sh.w);
        ((u32x2*)HB)[i] = o;
    }
}

template <class AF, class BF>
DEVI void gemm_tile(char* smem, const bf16* __restrict__ Abase, AF arow, const bf16* __restrict__ Bbase, BF brow, int K, f32x4 (&acc)[4][4]) {
    const int tid = threadIdx.x, wid = tid >> 6, lane = tid & 63, wr = wid >> 1, wc = wid & 1, fr = lane & 15, fq = lane >> 4;
    const int r0 = tid >> 3, swz = ((tid & 7) ^ (r0 & 7)) * 8;
    unsigned pa[4], pb[4];
#pragma unroll
    for (int i = 0; i < 4; ++i) { pa[i] = arow(r0 + 32 * i) + swz; pb[i] = brow(r0 + 32 * i) + swz; }
#pragma unroll
    for (int m = 0; m < 4; ++m)
#pragma unroll
        for (int n = 0; n < 4; ++n) acc[m][n] = (f32x4){0.f, 0.f, 0.f, 0.f};
    const int nk = K / 64;
#define GT_STAGE(buf, kt) do { char* _sa = smem + (buf) * 32768; char* _sb = _sa + 16384; \
        _Pragma("unroll") for (int _i = 0; _i < 4; ++_i) { \
            __builtin_amdgcn_global_load_lds((const unsigned*)(Abase + pa[_i] + (kt) * 64), (unsigned*)(_sa + (tid + 256 * _i) * 16), 16, 0, 0); \
            __builtin_amdgcn_global_load_lds((const unsigned*)(Bbase + pb[_i] + (kt) * 64), (unsigned*)(_sb + (tid + 256 * _i) * 16), 16, 0, 0); } } while (0)
    GT_STAGE(0, 0);
    for (int kt = 0; kt < nk; ++kt) {
        const int cur = kt & 1;
        asm volatile("s_waitcnt vmcnt(0)" ::: "memory");
        __syncthreads();
        if (kt + 1 < nk) GT_STAGE(cur ^ 1, kt + 1);
        const char* SA = smem + cur * 32768; const char* SB = SA + 16384;
#pragma unroll
        for (int ks = 0; ks < 2; ++ks) {
            const int ch = ((ks * 4 + fq) ^ (fr & 7)) * 16;
            bf16x8 af[4], bfr[4];
#pragma unroll
            for (int m = 0; m < 4; ++m) af[m] = *(const bf16x8*)(SA + (wr * 64 + m * 16 + fr) * 128 + ch);
#pragma unroll
            for (int n = 0; n < 4; ++n) bfr[n] = *(const bf16x8*)(SB + (wc * 64 + n * 16 + fr) * 128 + ch);
#pragma unroll
            for (int m = 0; m < 4; ++m)
#pragma unroll
                for (int n = 0; n < 4; ++n)
                    acc[m][n] = __builtin_amdgcn_mfma_f32_16x16x32_bf16(bfr[n], af[m], acc[m][n], 0, 0, 0);
        }
    }
    __syncthreads();
#undef GT_STAGE
}

DEVI void phase_inproj(const P& p, int l, char* smem) {
    const bf16* HB = (const bf16*)(p.ws + WS_HB);
    const bf16* W = (const bf16*)(p.ws + WS_WIN) + (size_t)l * NPAD * D;
    bf16* PROJ = (bf16*)(p.ws + WS_PROJ); float* PEX = (float*)(p.ws + WS_PEX);
    const int lane = threadIdx.x & 63, wid = threadIdx.x >> 6, wr = wid >> 1, wc = wid & 1, fr = lane & 15, fq = lane >> 4;
    constexpr int NTN = NPAD / 128;
    for (int tile = blockIdx.x; tile < (S / 128) * NTN; tile += gridDim.x) {
        const int mt = tile / NTN, nt = tile % NTN;
        f32x4 acc[4][4];
        gemm_tile(smem, HB, [&](int r) { return (unsigned)((mt * 128 + r) * D); }, W, [&](int r) { return (unsigned)((nt * 128 + r) * D); }, D, acc);
#pragma unroll
        for (int m = 0; m < 4; ++m) {
            const int tok = mt * 128 + wr * 64 + m * 16 + fr;
#pragma unroll
            for (int n = 0; n < 4; ++n) {
                const int f = wc * 64 + n * 16 + fq * 4;
                if (nt < 32) {
                    u32x2 o; o.x = pk2(acc[m][n].x, acc[m][n].y); o.y = pk2(acc[m][n].z, acc[m][n].w);
                    *(u32x2*)(PROJ + (size_t)tok * NPROJ + nt * 128 + f) = o;
                } else if (f < 64) {
                    *(f32x4*)(PEX + (size_t)tok * 64 + f) = acc[m][n];
                }
            }
        }
    }
}

DEVI float proj_at(const bf16* PROJ, int t, int col) { return bf2f(PROJ[(size_t)t * NPROJ + col]); }
DEVI float proj_shift(const bf16* PROJ, int t, int col, float mu) {
    const float cur = proj_at(PROJ, t, col);
    const float prv = t > 0 ? proj_at(PROJ, t - 1, col) : 0.f;
    return cur + (prv - cur) * mu;
}

DEVI void phase_mixprep(const P& p, int l, char* smem) {
    const bf16* PROJ = (const bf16*)(p.ws + WS_PROJ); const float* PEX = (const float*)(p.ws + WS_PEX);
    float* VFIRST = (float*)(p.ws + WS_VFIRST);
    float* RECR = (float*)(p.ws + WS_RECR); float* RECG = (float*)(p.ws + WS_RECG); float* RECT = (float*)(p.ws + WS_RECT);
    float* GB = (float*)(p.ws + WS_G); float* BON = (float*)(p.ws + WS_BON);
    const float* ROT = (const float*)(p.ws + WS_ROT);
    constexpr int TT = 8;
    float* L = (float*)smem;
    float* ACC = L + TT * 288;
    const int tid = threadIdx.x, lane = tid & 63, w = tid >> 6;
    for (int item = blockIdx.x; item < S / TT; item += gridDim.x) {
        const int t0 = item * TT;
        {
            const float* mu = p.in[7] + l * 1024; const float* muv = p.in[8];
            for (int idx = tid; idx < TT * 288; idx += NT) {
                const int tt = idx / 288, i = idx % 288, t = t0 + tt;
                float v;
                if (i < 64) v = tanhf(proj_shift(PROJ, t, 768 + i, mu[768 + i]));
                else if (i < 128) v = proj_shift(PROJ, t, 832 + (i - 64), mu[832 + (i - 64)]);
                else if (i < 256) v = sigmoidf_(proj_shift(PROJ, t, 896 + (i - 128), mu[896 + (i - 128)]));
                else {
                    v = 0.f;
                    if (l == 1) {
                        const int j = i - 256;
                        const float cur = PEX[(size_t)t * 64 + 8 + j];
                        const float prv = t > 0 ? PEX[(size_t)(t - 1) * 64 + 8 + j] : 0.f;
                        v = cur + (prv - cur) * muv[j];
                    }
                }
                L[idx] = v;
            }
        }
        __syncthreads();
        {
            const int c = tid;
#pragma unroll 1
            for (int q = 0; q < 4; ++q) {
                const float* W = (q == 0) ? (p.in[10] + l * 64 * 256) : (q == 1) ? (p.in[12] + l * 64 * 256) : (q == 2) ? (p.in[13] + l * 128 * 256) : p.in[20];
                const int nr = (q == 2) ? 128 : (q == 3) ? ((l == 1) ? 32 : 0) : 64;
                const int lo = (q == 0) ? 0 : (q == 1) ? 64 : (q == 2) ? 128 : 256;
                float acc[TT];
#pragma unroll
                for (int tt = 0; tt < TT; ++tt) acc[tt] = 0.f;
#pragma unroll 2
                for (int i = 0; i < nr; i += 4) {
                    const float q0 = W[(i + 0) * 256 + c], q1 = W[(i + 1) * 256 + c], q2 = W[(i + 2) * 256 + c], q3 = W[(i + 3) * 256 + c];
#pragma unroll
                    for (int tt = 0; tt < TT; ++tt) { const f32x4 x = *(const f32x4*)(L + tt * 288 + lo + i); acc[tt] += x.x * q0 + x.y * q1 + x.z * q2 + x.w * q3; }
                }
#pragma unroll
                for (int tt = 0; tt < TT; ++tt) ACC[(q * TT + tt) * 256 + c] = acc[tt];
            }
            const float* mu = p.in[7] + l * 1024;
            const float w0c = p.in[9][l * 256 + c], a0c = p.in[11][l * 256 + c], kkc = p.in[14][l * 256 + c], kac = p.in[15][l * 256 + c], rkc = p.in[16][l * 256 + c];
            const float mur = mu[c], muk = mu[256 + c], muvv = mu[512 + c];
            const float v0c = (l == 1) ? p.in[19][c] : 0.f;
            const int h = w, j = lane;
#pragma unroll 1
            for (int tt = 0; tt < TT; ++tt) {
                const int t = t0 + tt;
                const float r = proj_shift(PROJ, t, c, mur);
                const float k = proj_shift(PROJ, t, 256 + c, muk);
                float v = proj_shift(PROJ, t, 512 + c, muvv);
                const float wpre = w0c + ACC[(0 * TT + tt) * 256 + c];
                const float wl = -softplusf_(-wpre) - 0.5f;
                const float decay = __expf(-__expf(wl));
                const float a = sigmoidf_(a0c + ACC[(1 * TT + tt) * 256 + c]);
                if (l == 0) VFIRST[(size_t)t * 256 + c] = v;
                else { const float vf = VFIRST[(size_t)t * 256 + c]; v = v + (vf - v) * sigmoidf_(v0c + ACC[(3 * TT + tt) * 256 + c]); }
                const float kx = k * kkc;
                const float ss = wave_sum(kx * kx);
                const float kk = kx * rsqrtf(ss + 1e-12f);
                const float k2 = k * (1.f + (a - 1.f) * kac);
                const float bon = wave_sum(r * k2 * rkc);
                float* rec = RECR + ((size_t)t * 4 + h) * 384;
                rec[j] = -kk; rec[64 + j] = decay; rec[128 + j] = kk * a; rec[192 + j] = k2; rec[256 + j] = r; rec[320 + j] = v;
                GB[(size_t)t * 256 + c] = ACC[(2 * TT + tt) * 256 + c];
                if (j == 0) BON[(size_t)t * 4 + h] = bon;
            }
        }
        {
            const float* conv_w = p.in[21] + l * 4 * 1536;
            const int h = w;
            float hist[6][3], cw[6][4];
            int colb[6];
#pragma unroll
            for (int q = 0; q < 6; ++q) {
                const int which = q >> 1, u = q & 1;
                const int ch = which * 512 + h * 128 + lane + 64 * u;
                colb[q] = 1024 + ch;
#pragma unroll
                for (int i = 0; i < 4; ++i) cw[q][i] = conv_w[i * 1536 + ch];
#pragma unroll
                for (int i = 0; i < 3; ++i) { const int t = t0 - 3 + i; hist[q][i] = t >= 0 ? proj_at(PROJ, t, colb[q]) : 0.f; }
            }
            const float nA = -__expf(p.in[22][l * 4 + h]), dtb = p.in[23][l * 4 + h];
#pragma unroll 1
            for (int tt = 0; tt < TT; ++tt) {
                const int t = t0 + tt;
                float y[6];
#pragma unroll
                for (int q = 0; q < 6; ++q) {
                    const float xt = proj_at(PROJ, t, colb[q]);
                    const float cv = cw[q][0] * hist[q][0] + cw[q][1] * hist[q][1] + cw[q][2] * hist[q][2] + cw[q][3] * xt;
                    hist[q][0] = hist[q][1]; hist[q][1] = hist[q][2]; hist[q][2] = xt;
                    y[q] = siluf_(cv);
                }
                const float sq = wave_sum(y[0] * y[0] + y[1] * y[1]);
                const float sk = wave_sum(y[2] * y[2] + y[3] * y[3]);
                const float rq = rsqrtf(sq + 1e-12f) * 0.08838834764831845f;
                const float rk = rsqrtf(sk + 1e-12f);
                float* rec = RECG + ((size_t)t * 4 + h) * 392;
                rec[lane] = y[0] * rq; rec[64 + lane] = y[1] * rq;
                rec[128 + lane] = y[2] * rk; rec[192 + lane] = y[3] * rk;
                rec[256 + lane] = y[4]; rec[320 + lane] = y[5];
                if (lane == 0) {
                    const float av = PEX[(size_t)t * 64 + h], bv = PEX[(size_t)t * 64 + 4 + h];
                    const float g = nA * softplusf_(av + dtb);
                    rec[384] = __expf(g); rec[385] = sigmoidf_(bv); rec[386] = g; rec[387] = 0.f;
                }
            }
        }
        {
            const int h = w, i = lane, c = tid;
#pragma unroll 1
            for (int tt = 0; tt < TT; ++tt) {
                const int t = t0 + tt;
                const float q = proj_at(PROJ, t, 3072 + c), k = proj_at(PROJ, t, 3328 + c), v = proj_at(PROJ, t, 3584 + c);
                const float cs = ROT[((size_t)t * 32 + (i & 31)) * 2], sn = ROT[((size_t)t * 32 + (i & 31)) * 2 + 1];
                const float qo = __shfl_xor(q, 32), ko = __shfl_xor(k, 32);
                const float qr = (i < 32) ? (q * cs - qo * sn) : (qo * sn + q * cs);
                const float kr = (i < 32) ? (k * cs - ko * sn) : (ko * sn + k * cs);
                float* rec = RECT + ((size_t)t * 4 + h) * 192;
                rec[i] = qr; rec[64 + i] = kr * 0.125f; rec[128 + i] = v;
            }
        }
        __syncthreads();
    }
}

DEVI void scan_rwkv(const P& p, int item, char* smem) {
    const float* REC = (const float*)(p.ws + WS_RECR); float* YR = (float*)(p.ws + WS_YR);
    float* L = (float*)smem;
    const int h = item >> 2, rg = item & 3;
    const int tid = threadIdx.x, lane = tid & 63, w = tid >> 6, sub = lane & 15;
    const int i = rg * 16 + w * 4 + (lane >> 4);
    float s0 = 0.f, s1 = 0.f, s2 = 0.f, s3 = 0.f;
    for (int c0 = 0; c0 < S; c0 += 32) {
        for (int idx = tid; idx < 32 * 96; idx += NT) {
            const int tok = idx / 96, f4 = idx % 96;
            ((f32x4*)L)[idx] = *(const f32x4*)(REC + ((size_t)(c0 + tok) * 4 + h) * 384 + f4 * 4);
        }
        __syncthreads();
        for (int tt = 0; tt < 32; ++tt) {
            const float* R = L + tt * 384;
            const f32x4 a = *(const f32x4*)(R + sub * 4), wv = *(const f32x4*)(R + 64 + sub * 4), b = *(const f32x4*)(R + 128 + sub * 4);
            const f32x4 k = *(const f32x4*)(R + 192 + sub * 4), r = *(const f32x4*)(R + 256 + sub * 4);
            const float v = R[320 + i];
            const float sa = row16_sum(s0 * a.x + s1 * a.y + s2 * a.z + s3 * a.w);
            s0 = s0 * wv.x + sa * b.x + v * k.x; s1 = s1 * wv.y + sa * b.y + v * k.y;
            s2 = s2 * wv.z + sa * b.z + v * k.z; s3 = s3 * wv.w + sa * b.w + v * k.w;
            const float y = row16_sum(s0 * r.x + s1 * r.y + s2 * r.z + s3 * r.w);
            if (sub == 0) YR[(size_t)(c0 + tt) * 256 + h * 64 + i] = y;
        }
        __syncthreads();
    }
}
DEVI void scan_gdn(const P& p, int item, char* smem) {
    const float* REC = (const float*)(p.ws + WS_RECG); float* OG = (float*)(p.ws + WS_OG);
    float* L = (float*)smem;
    const int h = item >> 3, eg = item & 7;
    const int tid = threadIdx.x, lane = tid & 63, w = tid >> 6, sub = lane & 15;
    const int e = eg * 16 + w * 4 + (lane >> 4);
    float s[8];
#pragma unroll
    for (int j = 0; j < 8; ++j) s[j] = 0.f;
    for (int c0 = 0; c0 < S; c0 += 32) {
        for (int idx = tid; idx < 32 * 98; idx += NT) {
            const int tok = idx / 98, f4 = idx % 98;
            ((f32x4*)L)[idx] = *(const f32x4*)(REC + ((size_t)(c0 + tok) * 4 + h) * 392 + f4 * 4);
        }
        __syncthreads();
        for (int tt = 0; tt < 32; ++tt) {
            const float* R = L + tt * 392;
            const f32x4 q0 = *(const f32x4*)(R + sub * 8), q1 = *(const f32x4*)(R + sub * 8 + 4);
            const f32x4 k0 = *(const f32x4*)(R + 128 + sub * 8), k1 = *(const f32x4*)(R + 128 + sub * 8 + 4);
            const float v = R[256 + e], dec = R[384], beta = R[385];
#pragma unroll
            for (int j = 0; j < 8; ++j) s[j] *= dec;
            const float kS = row16_sum(s[0] * k0.x + s[1] * k0.y + s[2] * k0.z + s[3] * k0.w + s[4] * k1.x + s[5] * k1.y + s[6] * k1.z + s[7] * k1.w);
            const float cf = beta * (v - kS);
            s[0] += cf * k0.x; s[1] += cf * k0.y; s[2] += cf * k0.z; s[3] += cf * k0.w;
            s[4] += cf * k1.x; s[5] += cf * k1.y; s[6] += cf * k1.z; s[7] += cf * k1.w;
            const float o = row16_sum(s[0] * q0.x + s[1] * q0.y + s[2] * q0.z + s[3] * q0.w + s[4] * q1.x + s[5] * q1.y + s[6] * q1.z + s[7] * q1.w);
            if (sub == 0) OG[(size_t)(c0 + tt) * 512 + h * 128 + e] = o;
        }
        __syncthreads();
    }
}
DEVI void scan_ret(const P& p, int item, char* smem) {
    const float* REC = (const float*)(p.ws + WS_RECT); float* ORT = (float*)(p.ws + WS_ORT);
    float* L = (float*)smem;
    const int h = item >> 2, eg = item & 3;
    const int tid = threadIdx.x, lane = tid & 63, w = tid >> 6, sub = lane & 15;
    const int e = eg * 16 + w * 4 + (lane >> 4);
    const float gam = 1.f - exp2f(-5.f - (float)h);
    float s0 = 0.f, s1 = 0.f, s2 = 0.f, s3 = 0.f;
    for (int c0 = 0; c0 < S; c0 += 32) {
        for (int idx = tid; idx < 32 * 48; idx += NT) {
            const int tok = idx / 48, f4 = idx % 48;
            ((f32x4*)L)[idx] = *(const f32x4*)(REC + ((size_t)(c0 + tok) * 4 + h) * 192 + f4 * 4);
        }
        __syncthreads();
        for (int tt = 0; tt < 32; ++tt) {
            const float* R = L + tt * 192;
            const f32x4 q = *(const f32x4*)(R + sub * 4), k = *(const f32x4*)(R + 64 + sub * 4);
            const float v = R[128 + e];
            s0 = s0 * gam + k.x * v; s1 = s1 * gam + k.y * v; s2 = s2 * gam + k.z * v; s3 = s3 * gam + k.w * v;
            const float o = row16_sum(s0 * q.x + s1 * q.y + s2 * q.z + s3 * q.w);
            if (sub == 0) ORT[(size_t)(c0 + tt) * 256 + h * 64 + e] = o;
        }
        __syncthreads();
    }
}
DEVI bf16x8 ldfrag(const bf16* base, int ld, int row0, int k0, int lane) {
    return *(const bf16x8*)(base + (row0 + (lane & 15)) * ld + k0 + (lane >> 4) * 8);
}
DEVI f32x4 mfma16(bf16x8 a, bf16x8 b, f32x4 c) { return __builtin_amdgcn_mfma_f32_16x16x32_bf16(a, b, c, 0, 0, 0); }

DEVI void retA_item(const P& p, int item, char* smem) {
    const float* REC = (const float*)(p.ws + WS_RECT); float* KV = (float*)(p.ws + WS_RKV);
    bf16* KT = (bf16*)smem; bf16* VT = KT + 64 * 72;
    const int n = item >> 2, h = item & 3;
    int tid = threadIdx.x; asm volatile("" : "+v"(tid));
    const int lane = tid & 63, w = tid >> 6, fr = lane & 15, fq = lane >> 4;
    const float lg = log2f(1.f - exp2f(-5.f - (float)h));
    {
        const int d = lane;
        unsigned kp[8], vp[8];
#pragma unroll
        for (int i = 0; i < 8; ++i) {
            const int c0 = 16 * w + 2 * i;
            const float* r0 = REC + ((size_t)(n * 64 + c0) * 4 + h) * 192;
            const float* r1 = r0 + 4 * 192;
            kp[i] = pk2(r0[64 + d] * exp2f((float)(63 - c0) * lg), r1[64 + d] * exp2f((float)(62 - c0) * lg));
            vp[i] = pk2(r0[128 + d], r1[128 + d]);
        }
        *(u32x4*)(KT + d * 72 + 16 * w) = (u32x4){kp[0], kp[1], kp[2], kp[3]};
        *(u32x4*)(KT + d * 72 + 16 * w + 8) = (u32x4){kp[4], kp[5], kp[6], kp[7]};
        *(u32x4*)(VT + d * 72 + 16 * w) = (u32x4){vp[0], vp[1], vp[2], vp[3]};
        *(u32x4*)(VT + d * 72 + 16 * w + 8) = (u32x4){vp[4], vp[5], vp[6], vp[7]};
    }
    __syncthreads();
    {
        const int dt = w;
        const bf16x8 a0 = ldfrag(KT, 72, 16 * dt, 0, lane), a1 = ldfrag(KT, 72, 16 * dt, 32, lane);
        float* out = KV + (size_t)item * 4096;
        const int s_ = dt >> 1, lane2 = 16 * (2 * (dt & 1) + (fq >> 1)) + fr;
#pragma unroll
        for (int et = 0; et < 4; ++et) {
            f32x4 acc = {0.f, 0.f, 0.f, 0.f};
            acc = mfma16(a0, ldfrag(VT, 72, 16 * et, 0, lane), acc);
            acc = mfma16(a1, ldfrag(VT, 72, 16 * et, 32, lane), acc);
            *(f32x4*)(out + ((et * 2 + s_) * 64 + lane2) * 8 + 4 * (fq & 1)) = acc;
        }
    }
    __syncthreads();
}

DEVI void retS_item(const P& p, int item) {
    const float* KV = (const float*)(p.ws + WS_RKV); bf16* RST = (bf16*)(p.ws + WS_RST);
    const int idx = item * NT + threadIdx.x;
    const int h = idx >> 12, i = idx & 4095;
    const float cd = exp2f(64.f * log2f(1.f - exp2f(-5.f - (float)h)));
    float r = 0.f;
#pragma unroll 8
    for (int n = 0; n < 256; ++n) {
        const float kv = KV[((size_t)n * 4 + h) * 4096 + i];
        RST[((size_t)n * 4 + h) * 4096 + i] = (bf16)f2bf(r);
        r = r * cd + kv;
    }
}

DEVI void retC_item(const P& p, int item, char* smem) {
    const float* REC = (const float*)(p.ws + WS_RECT); const bf16* RST = (const bf16*)(p.ws + WS_RST);
    float* ORT = (float*)(p.ws + WS_ORT);
    bf16* Qs = (bf16*)smem; bf16* Ks = Qs + 64 * 72; bf16* VT = Ks + 64 * 72; bf16* Ps = VT + 64 * 72;
    const int n = item >> 2, h = item & 3;
    int tid = threadIdx.x; asm volatile("" : "+v"(tid));
    const int lane = tid & 63, w = tid >> 6, fr = lane & 15, fq = lane >> 4;
    const float lg = log2f(1.f - exp2f(-5.f - (float)h));
    {
        const int d = lane;
        unsigned vp[8];
#pragma unroll
        for (int i = 0; i < 8; ++i) {
            const int c0 = 16 * w + 2 * i;
            const float* r0 = REC + ((size_t)(n * 64 + c0) * 4 + h) * 192;
            const float* r1 = r0 + 4 * 192;
            Qs[c0 * 72 + d] = (bf16)f2bf(r0[d]); Qs[(c0 + 1) * 72 + d] = (bf16)f2bf(r1[d]);
            Ks[c0 * 72 + d] = (bf16)f2bf(r0[64 + d]); Ks[(c0 + 1) * 72 + d] = (bf16)f2bf(r1[64 + d]);
            vp[i] = pk2(r0[128 + d], r1[128 + d]);
        }
        *(u32x4*)(VT + d * 72 + 16 * w) = (u32x4){vp[0], vp[1], vp[2], vp[3]};
        *(u32x4*)(VT + d * 72 + 16 * w + 8) = (u32x4){vp[4], vp[5], vp[6], vp[7]};
    }
    __syncthreads();
    const int ct = w, c = 16 * ct + fr;
    const bf16x8 q0 = ldfrag(Qs, 72, 16 * ct, 0, lane), q1 = ldfrag(Qs, 72, 16 * ct, 32, lane);
#pragma unroll
    for (int ct2 = 0; ct2 < 4; ++ct2) {
        f32x4 acc = {0.f, 0.f, 0.f, 0.f};
        acc = mfma16(ldfrag(Ks, 72, 16 * ct2, 0, lane), q0, acc);
        acc = mfma16(ldfrag(Ks, 72, 16 * ct2, 32, lane), q1, acc);
        float pv[4];
#pragma unroll
        for (int j = 0; j < 4; ++j) {
            const int c2 = 16 * ct2 + 4 * fq + j;
            pv[j] = (c >= c2) ? acc[j] * exp2f((float)(c - c2) * lg) : 0.f;
        }
        *(u32x2*)(Ps + c * 72 + 16 * ct2 + 4 * fq) = (u32x2){pk2(pv[0], pv[1]), pk2(pv[2], pv[3])};
    }
    __syncthreads();
    {
        const bf16x8 p0 = ldfrag(Ps, 72, 16 * ct, 0, lane), p1 = ldfrag(Ps, 72, 16 * ct, 32, lane);
        const float xi = exp2f((float)(c + 1) * lg);
        const bf16* RF = RST + (size_t)item * 4096;
#pragma unroll
        for (int et = 0; et < 4; ++et) {
            f32x4 ai = {0.f, 0.f, 0.f, 0.f}, ax = {0.f, 0.f, 0.f, 0.f};
            ai = mfma16(ldfrag(VT, 72, 16 * et, 0, lane), p0, ai);
            ai = mfma16(ldfrag(VT, 72, 16 * et, 32, lane), p1, ai);
            const bf16x8 r0 = *(const bf16x8*)(RF + ((et * 2 + 0) * 64 + lane) * 8);
            const bf16x8 r1 = *(const bf16x8*)(RF + ((et * 2 + 1) * 64 + lane) * 8);
            ax = mfma16(r0, q0, ax);
            ax = mfma16(r1, q1, ax);
            const f32x4 o = ai + ax * xi;
            *(f32x4*)(ORT + (size_t)(n * 64 + c) * 256 + h * 64 + 16 * et + 4 * fq) = o;
        }
    }
    __syncthreads();
}

template <int I, int N> struct SolveRow {
    static DEVI void run(float (&x)[N], const float* M) {
        float s = 0.f;
#pragma unroll
        for (int j4 = 0; j4 < (I + 3) / 4; ++j4) {
            const f32x4 m = *(const f32x4*)(M + I * N + 4 * j4);
            s += m.x * x[4 * j4] + m.y * x[4 * j4 + 1] + m.z * x[4 * j4 + 2] + m.w * x[4 * j4 + 3];
        }
        x[I] -= s;
        asm volatile("" : "+v"(x[I]) :: "memory");
        SolveRow<I + 1, N>::run(x, M);
    }
};
template <int N> struct SolveRow<N, N> { static DEVI void run(float (&)[N], const float*) {} };

DEVI void gdnA_item(const P& p, int item, char* smem) {
    const float* REC = (const float*)(p.ws + WS_RECG);
    bf16* GP = (bf16*)(p.ws + WS_GP) + (size_t)item * 16384; float* GB = (float*)(p.ws + WS_GB) + (size_t)item * 16384;
    float* GD = (float*)(p.ws + WS_GD);
    bf16* GQ = (bf16*)(p.ws + WS_GQ) + (size_t)item * 8192; float* GO = (float*)(p.ws + WS_GO) + (size_t)item * 8192;
    bf16* Kb = (bf16*)smem; bf16* Qb = Kb + 64 * 136;
    bf16* WT = (bf16*)smem; bf16* UT = WT + 128 * 72;
    bf16* Vb = (bf16*)(smem + 36864);
    float* M = (float*)(smem + 36864);
    bf16* KdT = (bf16*)(smem + 36864);
    bf16* At = (bf16*)(smem + 55296);
    float* gcs = (float*)(smem + 64512); float* bts = gcs + 64; float* sws = gcs + 128; float* sks = gcs + 192;
    const int n = item >> 2, h = item & 3;
    int tid = threadIdx.x; asm volatile("" : "+v"(tid));
    const int lane = tid & 63, w = tid >> 6, fr = lane & 15, fq = lane >> 4;
    const float* rec0 = REC + ((size_t)(n * 64) * 4 + h) * 392;
    if (w == 0) {
        float x = rec0[(size_t)lane * 1568 + 386];
#pragma unroll
        for (int off = 1; off < 64; off <<= 1) { const float y = __shfl_up(x, off); if (lane >= off) x += y; }
        const float bt = rec0[(size_t)lane * 1568 + 385];
        gcs[lane] = x; bts[lane] = bt; sws[lane] = bt * __expf(x); sks[lane] = __expf(__shfl(x, 63) - x);
    }
#pragma unroll 2
    for (int i = 0; i < 16; ++i) {
        const int c = 16 * w + i;
        const float* r = rec0 + (size_t)c * 1568;
        Qb[c * 136 + lane] = (bf16)f2bf(r[lane]); Qb[c * 136 + 64 + lane] = (bf16)f2bf(r[64 + lane]);
        Kb[c * 136 + lane] = (bf16)f2bf(r[128 + lane]); Kb[c * 136 + 64 + lane] = (bf16)f2bf(r[192 + lane]);
        Vb[c * 136 + lane] = (bf16)f2bf(r[256 + lane]); Vb[c * 136 + 64 + lane] = (bf16)f2bf(r[320 + lane]);
    }
    __syncthreads();
    float x[64];
    unsigned kdp[16];
    {
        const int col = tid & 127;
        int sel_b = (tid < 128) ? 36864 : 0, sel_s = (tid < 128) ? 64 : 128;
        asm volatile("" : "+v"(sel_b), "+v"(sel_s));
        const bf16* srcb = (const bf16*)(smem + sel_b) + col;
        const float* scs = gcs + sel_s;
#pragma unroll
        for (int c = 0; c < 64; ++c) {
            x[c] = scs[c] * bf2f(srcb[c * 136]);
            if ((c & 7) == 7) asm volatile("" : "+v"(x[c]) :: "memory");
        }
        const int half = tid >> 7;
#pragma unroll
        for (int i = 0; i < 16; ++i) {
            const int c = 32 * half + 2 * i;
            kdp[i] = pk2(bf2f(Kb[c * 136 + col]) * sks[c], bf2f(Kb[(c + 1) * 136 + col]) * sks[c + 1]);
            if ((i & 3) == 3) asm volatile("" : "+v"(kdp[i]) :: "memory");
        }
        if (tid == 0) GD[item] = __expf(gcs[63]);
    }
    __syncthreads();
    const int ct = w;
    f32x4 accQ[8];
    {
        const int c = 16 * ct + fr;
        const float gcc = gcs[c];
        {
            bf16x8 ka[4];
#pragma unroll
            for (int s = 0; s < 4; ++s) ka[s] = ldfrag(Kb, 136, 16 * ct, 32 * s, lane);
#pragma unroll
            for (int ct2 = 0; ct2 < 4; ++ct2) {
                f32x4 acc = {0.f, 0.f, 0.f, 0.f};
#pragma unroll
                for (int s = 0; s < 4; ++s) acc = mfma16(ka[s], ldfrag(Kb, 136, 16 * ct2, 32 * s, lane), acc);
                const int c2 = 16 * ct2 + fr; const float g2 = gcs[c2];
#pragma unroll
                for (int j = 0; j < 4; ++j) {
                    const int cc = 16 * ct + 4 * fq + j;
                    M[cc * 64 + c2] = (cc > c2) ? bts[cc] * acc[j] * __expf(gcs[cc] - g2) : 0.f;
                }
            }
        }
        {
            bf16x8 qa[4];
#pragma unroll
            for (int s = 0; s < 4; ++s) qa[s] = ldfrag(Qb, 136, 16 * ct, 32 * s, lane);
#pragma unroll
            for (int ct2 = 0; ct2 < 4; ++ct2) {
                f32x4 acc = {0.f, 0.f, 0.f, 0.f};
#pragma unroll
                for (int s = 0; s < 4; ++s) acc = mfma16(ldfrag(Kb, 136, 16 * ct2, 32 * s, lane), qa[s], acc);
                float pv[4];
#pragma unroll
                for (int j = 0; j < 4; ++j) { const int c2 = 16 * ct2 + 4 * fq + j; pv[j] = (c >= c2) ? acc[j] * __expf(gcc - gcs[c2]) : 0.f; }
                *(u32x2*)(At + c * 72 + 16 * ct2 + 4 * fq) = (u32x2){pk2(pv[0], pv[1]), pk2(pv[2], pv[3])};
            }
        }
        const float eg = __expf(gcc);
#pragma unroll
        for (int dt = 0; dt < 8; ++dt) {
            const u32x2 qv = *(const u32x2*)(Qb + c * 136 + 16 * dt + 4 * fq);
            accQ[dt] = (f32x4){-eg * __uint_as_float(qv.x << 16), -eg * __uint_as_float(qv.x & 0xffff0000u),
                               -eg * __uint_as_float(qv.y << 16), -eg * __uint_as_float(qv.y & 0xffff0000u)};
        }
    }
    __syncthreads();
    {
        SolveRow<1, 64>::run(x, M);
        int sel_d = (tid < 128) ? 128 * 72 : 0;
        asm volatile("" : "+v"(sel_d));
        bf16* dst = WT + sel_d + (tid & 127) * 72;
#pragma unroll
        for (int q = 0; q < 8; ++q)
            *(u32x4*)(dst + 8 * q) = (u32x4){pk2(x[8 * q], x[8 * q + 1]), pk2(x[8 * q + 2], x[8 * q + 3]), pk2(x[8 * q + 4], x[8 * q + 5]), pk2(x[8 * q + 6], x[8 * q + 7])};
    }
    __syncthreads();
    {
        const int d = tid & 127, half = tid >> 7;
#pragma unroll
        for (int q = 0; q < 4; ++q) *(u32x4*)(KdT + d * 72 + 32 * half + 8 * q) = (u32x4){kdp[4 * q], kdp[4 * q + 1], kdp[4 * q + 2], kdp[4 * q + 3]};
    }
    __syncthreads();
    {
#pragma unroll 1
        for (int mi = 0; mi < 2; ++mi) {
            const int mt = 2 * w + mi;
            const bf16x8 kd0 = ldfrag(KdT, 72, 16 * mt, 0, lane), kd1 = ldfrag(KdT, 72, 16 * mt, 32, lane);
#pragma unroll
            for (int sp = 0; sp < 4; ++sp) {
                f32x4 a0 = {0.f, 0.f, 0.f, 0.f}, a1 = {0.f, 0.f, 0.f, 0.f};
                a0 = mfma16(ldfrag(WT, 72, 32 * sp, 0, lane), kd0, a0); a0 = mfma16(ldfrag(WT, 72, 32 * sp, 32, lane), kd1, a0);
                a1 = mfma16(ldfrag(WT, 72, 32 * sp + 16, 0, lane), kd0, a1); a1 = mfma16(ldfrag(WT, 72, 32 * sp + 16, 32, lane), kd1, a1);
                *(u32x4*)(GP + ((mt * 4 + sp) * 64 + lane) * 8) = (u32x4){pk2(-a0.x, -a0.y), pk2(-a0.z, -a0.w), pk2(-a1.x, -a1.y), pk2(-a1.z, -a1.w)};
            }
#pragma unroll
            for (int nt = 0; nt < 8; ++nt) {
                f32x4 a = {0.f, 0.f, 0.f, 0.f};
                a = mfma16(kd0, ldfrag(UT, 72, 16 * nt, 0, lane), a); a = mfma16(kd1, ldfrag(UT, 72, 16 * nt, 32, lane), a);
                *(f32x4*)(GB + ((nt * 8 + mt) * 64 + lane) * 4) = a;
            }
        }
        const bf16x8 at0 = ldfrag(At, 72, 16 * ct, 0, lane), at1 = ldfrag(At, 72, 16 * ct, 32, lane);
#pragma unroll
        for (int sp = 0; sp < 4; ++sp) {
            f32x4 a0 = accQ[2 * sp], a1 = accQ[2 * sp + 1];
            a0 = mfma16(ldfrag(WT, 72, 32 * sp, 0, lane), at0, a0); a0 = mfma16(ldfrag(WT, 72, 32 * sp, 32, lane), at1, a0);
            a1 = mfma16(ldfrag(WT, 72, 32 * sp + 16, 0, lane), at0, a1); a1 = mfma16(ldfrag(WT, 72, 32 * sp + 16, 32, lane), at1, a1);
            *(u32x4*)(GQ + ((ct * 4 + sp) * 64 + lane) * 8) = (u32x4){pk2(-a0.x, -a0.y), pk2(-a0.z, -a0.w), pk2(-a1.x, -a1.y), pk2(-a1.z, -a1.w)};
        }
#pragma unroll
        for (int et = 0; et < 8; ++et) {
            f32x4 a = {0.f, 0.f, 0.f, 0.f};
            a = mfma16(ldfrag(UT, 72, 16 * et, 0, lane), at0, a); a = mfma16(ldfrag(UT, 72, 16 * et, 32, lane), at1, a);
            *(f32x4*)(GO + ((ct * 8 + et) * 64 + lane) * 4) = a;
        }
    }
    __syncthreads();
}

DEVI void gdnS_item(const P& p, int item) {
    const bf16* GP = (const bf16*)(p.ws + WS_GP); const float* GB = (const float*)(p.ws + WS_GB); const float* GD = (const float*)(p.ws + WS_GD);
    bf16* GS = (bf16*)(p.ws + WS_GS);
    const int h = item >> 1, lane = threadIdx.x & 63, ew = (item & 1) * 4 + (threadIdx.x >> 6);
    f32x4 acc[8];
#pragma unroll
    for (int m = 0; m < 8; ++m) acc[m] = (f32x4){0.f, 0.f, 0.f, 0.f};
#pragma unroll 1
    for (int n = 0; n < 256; ++n) {
        const size_t it = (size_t)n * 4 + h;
        const bf16* Pn = GP + it * 16384 + lane * 8; const float* Bn = GB + it * 16384 + (ew * 8 * 64 + lane) * 4;
        bf16x8 pf[32]; f32x4 bfr[8];
#pragma unroll
        for (int i = 0; i < 32; ++i) pf[i] = *(const bf16x8*)(Pn + i * 512);
#pragma unroll
        for (int m = 0; m < 8; ++m) bfr[m] = *(const f32x4*)(Bn + m * 256);
        const float dn = GD[it];
        asm volatile("" ::: "memory");
        bf16x8 sf[4];
#pragma unroll
        for (int s = 0; s < 4; ++s) {
            const u32x4 v = {pk2(acc[2 * s].x, acc[2 * s].y), pk2(acc[2 * s].z, acc[2 * s].w), pk2(acc[2 * s + 1].x, acc[2 * s + 1].y), pk2(acc[2 * s + 1].z, acc[2 * s + 1].w)};
            *(u32x4*)(GS + it * 16384 + ((ew * 4 + s) * 64 + lane) * 8) = v;
            sf[s] = __builtin_bit_cast(bf16x8, v);
        }
#pragma unroll
        for (int m = 0; m < 8; ++m) {
            f32x4 a = acc[m] * dn + bfr[m];
#pragma unroll
            for (int s = 0; s < 4; ++s) a = mfma16(pf[m * 4 + s], sf[s], a);
            acc[m] = a;
        }
    }
}

DEVI void gdnC_item(const P& p, int item) {
    const bf16* GQ = (const bf16*)(p.ws + WS_GQ) + (size_t)item * 8192; const float* GO = (const float*)(p.ws + WS_GO) + (size_t)item * 8192;
    const bf16* GS = (const bf16*)(p.ws + WS_GS) + (size_t)item * 16384;
    float* OG = (float*)(p.ws + WS_OG);
    const int n = item >> 2, h = item & 3;
    const int lane = threadIdx.x & 63, ct = threadIdx.x >> 6, fr = lane & 15, fq = lane >> 4;
    bf16x8 qf[4];
#pragma unroll
    for (int s = 0; s < 4; ++s) qf[s] = *(const bf16x8*)(GQ + ((ct * 4 + s) * 64 + lane) * 8);
    const int c = 16 * ct + fr;
#pragma unroll
    for (int et = 0; et < 8; ++et) {
        f32x4 a = *(const f32x4*)(GO + ((ct * 8 + et) * 64 + lane) * 4);
#pragma unroll
        for (int s = 0; s < 4; ++s) a = mfma16(*(const bf16x8*)(GS + ((et * 4 + s) * 64 + lane) * 8), qf[s], a);
        *(f32x4*)(OG + (size_t)(n * 64 + c) * 512 + h * 128 + 16 * et + 4 * fq) = a;
    }
}

DEVI f32x4 ld_bf4(const bf16* p) {
    const u32x2 v = *(const u32x2*)p;
    return (f32x4){__uint_as_float(v.x << 16), __uint_as_float(v.x & 0xffff0000u), __uint_as_float(v.y << 16), __uint_as_float(v.y & 0xffff0000u)};
}
DEVI void rwkA_item(const P& p, int item, char* smem) {
    const float* REC = (const float*)(p.ws + WS_RECR);
    bf16* WP = (bf16*)(p.ws + WS_WP) + (size_t)item * 4096; float* WC = (float*)(p.ws + WS_WC) + (size_t)item * 4096;
    float* WD = (float*)(p.ws + WS_WD) + (size_t)item * 64;
    bf16* WQ = (bf16*)(p.ws + WS_WQ) + (size_t)item * 2048; float* WY = (float*)(p.ws + WS_WY) + (size_t)item * 2048;
    bf16* At_ = (bf16*)smem; bf16* Rt = At_ + 32 * 72; bf16* Bt = Rt + 32 * 72; bf16* Kt = Bt + 32 * 72;
    float* ZT = (float*)(smem + 9216);
    bf16* BhT = (bf16*)(smem + 18432); bf16* KhT = BhT + 64 * 40; bf16* VT = KhT + 64 * 40; bf16* AhT = VT + 64 * 40; bf16* UhT = AhT + 64 * 40;
    float* M = (float*)(smem + 44032);
    bf16* Aak = (bf16*)(smem + 48128); bf16* Arb = Aak + 32 * 40; bf16* Ark = Arb + 32 * 40;
    float* tot = (float*)(smem + 55808);
    const int n = item >> 2, h = item & 3;
    int tid = threadIdx.x; asm volatile("" : "+v"(tid));
    const int lane = tid & 63, w = tid >> 6, fr = lane & 15, fq = lane >> 4;
    {
        const int d = lane;
        const float* rec = REC + ((size_t)(n * 32 + 8 * w) * 4 + h) * 384 + d;
        float lw[8], lg[8];
        float run = 0.f;
#pragma unroll
        for (int i = 0; i < 8; ++i) { lg[i] = __logf(rec[(size_t)i * 1536 + 64]); run += lg[i]; lw[i] = run; }
        tot[w * 64 + d] = run;
        __syncthreads();
        float off = 0.f, total = 0.f;
#pragma unroll
        for (int q = 0; q < 4; ++q) { const float tq = tot[q * 64 + d]; total += tq; off += (q < w) ? tq : 0.f; }
        unsigned bh[4], kh[4], vv[4];
        float pb = 0.f, pk = 0.f, pv = 0.f;
#pragma unroll
        for (int i = 0; i < 8; ++i) {
            const float* r = rec + (size_t)i * 1536;
            const float a = r[0], b = r[128], k = r[192], rr = r[256], v = r[320];
            const float lc = off + lw[i];
            const float cw = __expf(lc), cwm1 = __expf(lc - lg[i]), inv = __expf(-lc), rat = __expf(total - lc);
            const int t = 8 * w + i;
            At_[t * 72 + d] = (bf16)f2bf(a * cwm1); Rt[t * 72 + d] = (bf16)f2bf(rr * cw);
            Bt[t * 72 + d] = (bf16)f2bf(b * inv); Kt[t * 72 + d] = (bf16)f2bf(k * inv);
            if (i & 1) { bh[i >> 1] = pk2(pb, b * rat); kh[i >> 1] = pk2(pk, k * rat); vv[i >> 1] = pk2(pv, v); }
            else { pb = b * rat; pk = k * rat; pv = v; }
        }
        *(u32x4*)(BhT + d * 40 + 8 * w) = (u32x4){bh[0], bh[1], bh[2], bh[3]};
        *(u32x4*)(KhT + d * 40 + 8 * w) = (u32x4){kh[0], kh[1], kh[2], kh[3]};
        *(u32x4*)(VT + d * 40 + 8 * w) = (u32x4){vv[0], vv[1], vv[2], vv[3]};
        if (w == 0) WD[d] = __expf(total);
    }
    __syncthreads();
    {
        int offA = (w == 0) ? 0 : (w == 1 ? 3 : (w == 2 ? 2 : 3));
        int offB = (w == 0) ? 2 : (w == 1 ? 0 : 1);
        asm volatile("" : "+v"(offA), "+v"(offB));
        const bf16* As = At_ + offA * (32 * 72); const bf16* Bs = At_ + offB * (32 * 72);
#pragma unroll
        for (int ta = 0; ta < 2; ++ta) {
            const bf16x8 a0 = ldfrag(As, 72, 16 * ta, 0, lane), a1 = ldfrag(As, 72, 16 * ta, 32, lane);
#pragma unroll
            for (int tb = 0; tb < 2; ++tb) {
                f32x4 acc = {0.f, 0.f, 0.f, 0.f};
                acc = mfma16(a0, ldfrag(Bs, 72, 16 * tb, 0, lane), acc);
                acc = mfma16(a1, ldfrag(Bs, 72, 16 * tb, 32, lane), acc);
                if (w == 0) {
                    const int s_ = 16 * tb + fr;
#pragma unroll
                    for (int j = 0; j < 4; ++j) { const int t = 16 * ta + 4 * fq + j; M[t * 32 + s_] = (t > s_) ? -acc[j] : 0.f; }
                } else {
                    const int t = 16 * tb + fr;
                    float pv4[4];
#pragma unroll
                    for (int j = 0; j < 4; ++j) { const int s_ = 16 * ta + 4 * fq + j; pv4[j] = ((w == 1) ? (t > s_) : (t >= s_)) ? acc[j] : 0.f; }
                    int offD = w - 1; asm volatile("" : "+v"(offD));
                    *(u32x2*)(Aak + offD * (32 * 40) + t * 40 + 16 * ta + 4 * fq) = (u32x2){pk2(pv4[0], pv4[1]), pk2(pv4[2], pv4[3])};
                }
            }
        }
    }
    __syncthreads();
    {
        const int et = w;
        const bf16x8 vf = ldfrag(VT, 40, 16 * et, 0, lane);
#pragma unroll
        for (int tt = 0; tt < 2; ++tt) {
            f32x4 acc = {0.f, 0.f, 0.f, 0.f};
            acc = mfma16(ldfrag(Aak, 40, 16 * tt, 0, lane), vf, acc);
            *(f32x4*)(ZT + (16 * et + fr) * 36 + 16 * tt + 4 * fq) = acc;
        }
    }
    __syncthreads();
    if (tid < 128) {
        float x[32];
        if (tid < 64) {
#pragma unroll
            for (int t = 0; t < 32; ++t) x[t] = bf2f(At_[t * 72 + tid]);
        } else {
#pragma unroll
            for (int q = 0; q < 8; ++q) { const f32x4 z = *(const f32x4*)(ZT + (tid - 64) * 36 + 4 * q); x[4 * q] = z.x; x[4 * q + 1] = z.y; x[4 * q + 2] = z.z; x[4 * q + 3] = z.w; }
        }
        SolveRow<1, 32>::run(x, M);
        bf16* dst = AhT + tid * 40;
#pragma unroll
        for (int q = 0; q < 4; ++q)
            *(u32x4*)(dst + 8 * q) = (u32x4){pk2(x[8 * q], x[8 * q + 1]), pk2(x[8 * q + 2], x[8 * q + 3]), pk2(x[8 * q + 4], x[8 * q + 5]), pk2(x[8 * q + 6], x[8 * q + 7])};
    }
    __syncthreads();
    {
        const int mt = w;
        const bf16x8 bh = ldfrag(BhT, 40, 16 * mt, 0, lane), kh = ldfrag(KhT, 40, 16 * mt, 0, lane);
#pragma unroll
        for (int sp = 0; sp < 2; ++sp) {
            f32x4 a0 = {0.f, 0.f, 0.f, 0.f}, a1 = {0.f, 0.f, 0.f, 0.f};
            a0 = mfma16(ldfrag(AhT, 40, 32 * sp, 0, lane), bh, a0);
            a1 = mfma16(ldfrag(AhT, 40, 32 * sp + 16, 0, lane), bh, a1);
            *(u32x4*)(WP + ((mt * 2 + sp) * 64 + lane) * 8) = (u32x4){pk2(a0.x, a0.y), pk2(a0.z, a0.w), pk2(a1.x, a1.y), pk2(a1.z, a1.w)};
        }
#pragma unroll
        for (int nt = 0; nt < 4; ++nt) {
            f32x4 a = {0.f, 0.f, 0.f, 0.f};
            a = mfma16(bh, ldfrag(UhT, 40, 16 * nt, 0, lane), a);
            a = mfma16(kh, ldfrag(VT, 40, 16 * nt, 0, lane), a);
            *(f32x4*)(WC + ((nt * 4 + mt) * 64 + lane) * 4) = a;
        }
        {
            const int ct = w & 1, sp = w >> 1, t = 16 * ct + fr;
            const bf16x8 ar = ldfrag(Arb, 40, 16 * ct, 0, lane);
            f32x4 a0 = ld_bf4(Rt + t * 72 + 32 * sp + 4 * fq), a1 = ld_bf4(Rt + t * 72 + 32 * sp + 16 + 4 * fq);
            a0 = mfma16(ldfrag(AhT, 40, 32 * sp, 0, lane), ar, a0);
            a1 = mfma16(ldfrag(AhT, 40, 32 * sp + 16, 0, lane), ar, a1);
            *(u32x4*)(WQ + ((ct * 2 + sp) * 64 + lane) * 8) = (u32x4){pk2(a0.x, a0.y), pk2(a0.z, a0.w), pk2(a1.x, a1.y), pk2(a1.z, a1.w)};
        }
        {
            const int et = w;
            const bf16x8 uf = ldfrag(UhT, 40, 16 * et, 0, lane), vf = ldfrag(VT, 40, 16 * et, 0, lane);
#pragma unroll
            for (int ct = 0; ct < 2; ++ct) {
                f32x4 a = {0.f, 0.f, 0.f, 0.f};
                a = mfma16(uf, ldfrag(Arb, 40, 16 * ct, 0, lane), a);
                a = mfma16(vf, ldfrag(Ark, 40, 16 * ct, 0, lane), a);
                *(f32x4*)(WY + ((ct * 4 + et) * 64 + lane) * 4) = a;
            }
        }
    }
    __syncthreads();
}

struct RwkStep { bf16x8 pf[8]; f32x4 cf[4]; f32x4 dv[4]; };
DEVI void rwk_load(RwkStep& r, const bf16* WP, const float* WC, const float* WD, size_t it, int ew, int lane) {
#pragma unroll
    for (int i = 0; i < 8; ++i) r.pf[i] = *(const bf16x8*)(WP + it * 4096 + (i * 64 + lane) * 8);
#pragma unroll
    for (int m = 0; m < 4; ++m) r.cf[m] = *(const f32x4*)(WC + it * 4096 + ((ew * 4 + m) * 64 + lane) * 4);
#pragma unroll
    for (int m = 0; m < 4; ++m) r.dv[m] = *(const f32x4*)(WD + it * 64 + 16 * m + 4 * (lane >> 4));
}
DEVI void rwk_step(const RwkStep& r, f32x4 (&acc)[4], bf16* WSF, size_t it, int ew, int lane) {
    bf16x8 sf[2];
#pragma unroll
    for (int s = 0; s < 2; ++s) {
        const u32x4 v = {pk2(acc[2 * s].x, acc[2 * s].y), pk2(acc[2 * s].z, acc[2 * s].w), pk2(acc[2 * s + 1].x, acc[2 * s + 1].y), pk2(acc[2 * s + 1].z, acc[2 * s + 1].w)};
        *(u32x4*)(WSF + it * 4096 + ((ew * 2 + s) * 64 + lane) * 8) = v;
        sf[s] = __builtin_bit_cast(bf16x8, v);
    }
#pragma unroll
    for (int m = 0; m < 4; ++m) {
        f32x4 a = acc[m] * r.dv[m] + r.cf[m];
        a = mfma16(r.pf[m * 2], sf[0], a);
        a = mfma16(r.pf[m * 2 + 1], sf[1], a);
        acc[m] = a;
    }
}
DEVI void rwkS_item(const P& p, int h) {
    const bf16* WP = (const bf16*)(p.ws + WS_WP); const float* WC = (const float*)(p.ws + WS_WC); const float* WD = (const float*)(p.ws + WS_WD);
    bf16* WSF = (bf16*)(p.ws + WS_WS);
    const int lane = threadIdx.x & 63, ew = threadIdx.x >> 6;
    f32x4 acc[4];
#pragma unroll
    for (int m = 0; m < 4; ++m) acc[m] = (f32x4){0.f, 0.f, 0.f, 0.f};
    RwkStep A, B;
    rwk_load(A, WP, WC, WD, (size_t)h, ew, lane);
#pragma unroll 1
    for (int n = 0; n < 512; n += 2) {
        rwk_load(B, WP, WC, WD, (size_t)(n + 1) * 4 + h, ew, lane);
        asm volatile("" ::: "memory");
        rwk_step(A, acc, WSF, (size_t)n * 4 + h, ew, lane);
        rwk_load(A, WP, WC, WD, (size_t)((n + 2 < 512) ? n + 2 : n) * 4 + h, ew, lane);
        asm volatile("" ::: "memory");
        rwk_step(B, acc, WSF, (size_t)(n + 1) * 4 + h, ew, lane);
    }
}

DEVI void rwkC_item(const P& p, int n) {
    const int lane = threadIdx.x & 63, h = threadIdx.x >> 6, fr = lane & 15, fq = lane >> 4;
    const size_t it = (size_t)n * 4 + h;
    const bf16* WQ = (const bf16*)(p.ws + WS_WQ) + it * 2048; const float* WY = (const float*)(p.ws + WS_WY) + it * 2048;
    const bf16* WSF = (const bf16*)(p.ws + WS_WS) + it * 4096;
    float* YR = (float*)(p.ws + WS_YR);
#pragma unroll
    for (int ct = 0; ct < 2; ++ct) {
        const bf16x8 q0 = *(const bf16x8*)(WQ + ((ct * 2 + 0) * 64 + lane) * 8), q1 = *(const bf16x8*)(WQ + ((ct * 2 + 1) * 64 + lane) * 8);
#pragma unroll
        for (int et = 0; et < 4; ++et) {
            f32x4 a = *(const f32x4*)(WY + ((ct * 4 + et) * 64 + lane) * 4);
            a = mfma16(*(const bf16x8*)(WSF + ((et * 2 + 0) * 64 + lane) * 8), q0, a);
            a = mfma16(*(const bf16x8*)(WSF + ((et * 2 + 1) * 64 + lane) * 8), q1, a);
            *(f32x4*)(YR + (size_t)(n * 32 + 16 * ct + fr) * 256 + h * 64 + 16 * et + 4 * fq) = a;
        }
    }
}

DEVI void phase_scan(const P& p, char* smem) {
    for (int item = blockIdx.x; item < 12 + 64; item += gridDim.x) {
        if (item < 8) gdnS_item(p, item);
        else if (item < 12) rwkS_item(p, item - 8);
        else retS_item(p, item - 12);
    }
}

DEVI void phase_chunkA(const P& p, char* smem) {
    for (int item = blockIdx.x; item < 4096; item += gridDim.x) { if (item < 1024) gdnA_item(p, item, smem); else if (item < 3072) rwkA_item(p, item - 1024, smem); else retA_item(p, item - 3072, smem); }
}
DEVI void phase_chunkC(const P& p, char* smem) {
    for (int item = blockIdx.x; item < 2560; item += gridDim.x) { if (item < 1024) gdnC_item(p, item); else if (item < 2048) retC_item(p, item - 1024, smem); else rwkC_item(p, item - 2048); }
}

DEVI void phase_post(const P& p, int l) {
    const bf16* PROJ = (const bf16*)(p.ws + WS_PROJ);
    const float* RECR = (const float*)(p.ws + WS_RECR);
    const float* GB = (const float*)(p.ws + WS_G); const float* BON = (const float*)(p.ws + WS_BON);
    const float* YR = (const float*)(p.ws + WS_YR); const float* OG = (const float*)(p.ws + WS_OG); const float* ORT = (const float*)(p.ws + WS_ORT);
    bf16* MIX = (bf16*)(p.ws + WS_MIX);
    const float* ln_g = p.in[17] + l * 256; const float* ln_b = p.in[18] + l * 256;
    const float* gn = p.in[24] + l * 128;
    const float* rg = p.in[25] + l * 256; const float* rb = p.in[26] + l * 256;
    const int tid = threadIdx.x, lane = tid & 63, h = tid >> 6;
    for (int t = blockIdx.x; t < S; t += gridDim.x) {
        {
            const int c = tid;
            const float y = YR[(size_t)t * 256 + c];
            const float mean = wave_sum(y) * (1.f / 64.f);
            const float d = y - mean;
            const float var = wave_sum(d * d) * (1.f / 64.f);
            const float yn = d * rsqrtf(var + 64e-5f) * ln_g[c] + ln_b[c];
            const float v = RECR[((size_t)t * 4 + h) * 384 + 320 + lane];
            const float o = (yn + BON[(size_t)t * 4 + h] * v) * GB[(size_t)t * 256 + c];
            MIX[(size_t)t * D + c] = (bf16)f2bf(o);
        }
        {
            const int c0 = h * 128 + lane, c1 = c0 + 64;
            const float o0 = OG[(size_t)t * 512 + c0], o1 = OG[(size_t)t * 512 + c1];
            const float ms = wave_sum(o0 * o0 + o1 * o1) * (1.f / 128.f);
            const float rs = rsqrtf(ms + 1e-6f);
            const float z0 = proj_at(PROJ, t, 2560 + c0), z1 = proj_at(PROJ, t, 2560 + c1);
            MIX[(size_t)t * D + 256 + c0] = (bf16)f2bf(o0 * rs * gn[lane] * siluf_(z0));
            MIX[(size_t)t * D + 256 + c1] = (bf16)f2bf(o1 * rs * gn[64 + lane] * siluf_(z1));
        }
        {
            const int c = tid;
            const float y = ORT[(size_t)t * 256 + c];
            const float mean = wave_sum(y) * (1.f / 64.f);
            const float d = y - mean;
            const float var = wave_sum(d * d) * (1.f / 64.f);
            const float yn = d * rsqrtf(var + 1e-5f) * rg[c] + rb[c];
            const float gt = proj_at(PROJ, t, 3840 + c);
            MIX[(size_t)t * D + 768 + c] = (bf16)f2bf(yn * siluf_(gt));
        }
    }
}

DEVI void phase_outproj(const P& p, int l, char* smem) {
    const bf16* MIX = (const bf16*)(p.ws + WS_MIX);
    const bf16* W = (const bf16*)(p.ws + WS_WOUT) + (size_t)l * D * D;
    float* OPRE = (float*)(p.ws + WS_OPRE);
    const int lane = threadIdx.x & 63, wid = threadIdx.x >> 6, wr = wid >> 1, wc = wid & 1, fr = lane & 15, fq = lane >> 4;
    for (int tile = blockIdx.x; tile < (S / 128) * 8; tile += gridDim.x) {
        const int mt = tile / 8, nt = tile % 8;
        f32x4 acc[4][4];
        gemm_tile(smem, MIX, [&](int r) { return (unsigned)((mt * 128 + r) * D); }, W, [&](int r) { return (unsigned)((nt * 128 + r) * D); }, D, acc);
#pragma unroll
        for (int m = 0; m < 4; ++m) {
            const int tok = mt * 128 + wr * 64 + m * 16 + fr;
#pragma unroll
            for (int n = 0; n < 4; ++n) *(f32x4*)(OPRE + (size_t)tok * D + nt * 128 + wc * 64 + n * 16 + fq * 4) = acc[m][n];
        }
    }
}

DEVI void phase_ln1_route(const P& p, int l, char* smem) {
    const float* ADA = (const float*)(p.ws + OFF_ADA) + l * 6144;
    const float* xin = (l == 0) ? p.in[0] : (const float*)(p.ws + WS_X);
    const float* OPRE = (const float*)(p.ws + WS_OPRE);
    float* X = (float*)(p.ws + WS_X); bf16* H2 = (bf16*)(p.ws + WS_H2);
    const float* lg = p.in[28] + l * D; const float* lb = p.in[29] + l * D;
    const float* rw = p.in[30] + (size_t)l * D * 32; const float* rbias = p.in[31] + l * 32;
    int* CNT = (int*)(p.ws + OFF_CNT) + l * 32; int* LIST = (int*)(p.ws + WS_LIST); float* GATE = (float*)(p.ws + WS_GATE);
    float* HS = (float*)smem;
    float* RED = HS + 4 * 1024;
    const int tid = threadIdx.x, lane = tid & 63, w = tid >> 6;
    for (int item = blockIdx.x; item < S / 4; item += gridDim.x) {
        const int t = item * 4 + w;
        {
            f32x4 v[4]; float s = 0.f;
#pragma unroll
            for (int j = 0; j < 4; ++j) {
                const int c = j * 256 + lane * 4;
                const f32x4 x = *(const f32x4*)(xin + (size_t)t * D + c);
                const f32x4 o = *(const f32x4*)(OPRE + (size_t)t * D + c);
                const f32x4 gt = *(const f32x4*)(ADA + 2048 + c);
                v[j].x = DN_ALPHA * x.x + (1.f + gt.x) * o.x; v[j].y = DN_ALPHA * x.y + (1.f + gt.y) * o.y;
                v[j].z = DN_ALPHA * x.z + (1.f + gt.z) * o.z; v[j].w = DN_ALPHA * x.w + (1.f + gt.w) * o.w;
                s += (v[j].x + v[j].y) + (v[j].z + v[j].w);
            }
            const float mean = wave_sum(s) * (1.f / D);
            float s2 = 0.f;
#pragma unroll
            for (int j = 0; j < 4; ++j) { v[j] = v[j] - mean; s2 += (v[j].x * v[j].x + v[j].y * v[j].y) + (v[j].z * v[j].z + v[j].w * v[j].w); }
            const float rstd = rsqrtf(wave_sum(s2) * (1.f / D) + 1e-5f);
#pragma unroll
            for (int j = 0; j < 4; ++j) {
                const int c = j * 256 + lane * 4;
                const f32x4 g = *(const f32x4*)(lg + c), b = *(const f32x4*)(lb + c);
                f32x4 xo = v[j] * rstd * g + b;
                *(f32x4*)(X + (size_t)t * D + c) = xo;
                const f32x4 sh = *(const f32x4*)(ADA + 3072 + c), sc = *(const f32x4*)(ADA + 4096 + c);
                f32x4 hh = xo * (1.f + sc) + sh;
                *(f32x4*)(HS + w * 1024 + c) = hh;
                u32x2 o; o.x = pk2(hh.x, hh.y); o.y = pk2(hh.z, hh.w);
                *(u32x2*)(H2 + (size_t)t * D + c) = o;
            }
        }
        __syncthreads();
        {
            const int e = tid & 31, ks = tid >> 5;
            float a0 = 0.f, a1 = 0.f, a2 = 0.f, a3 = 0.f;
            for (int k = ks * 128; k < ks * 128 + 128; k += 4) {
                const float w0 = rw[(k + 0) * 32 + e], w1 = rw[(k + 1) * 32 + e], w2 = rw[(k + 2) * 32 + e], w3 = rw[(k + 3) * 32 + e];
                const f32x4 h0 = *(const f32x4*)(HS + 0 * 1024 + k), h1 = *(const f32x4*)(HS + 1 * 1024 + k);
                const f32x4 h2 = *(const f32x4*)(HS + 2 * 1024 + k), h3 = *(const f32x4*)(HS + 3 * 1024 + k);
                a0 += h0.x * w0 + h0.y * w1 + h0.z * w2 + h0.w * w3;
                a1 += h1.x * w0 + h1.y * w1 + h1.z * w2 + h1.w * w3;
                a2 += h2.x * w0 + h2.y * w1 + h2.z * w2 + h2.w * w3;
                a3 += h3.x * w0 + h3.y * w1 + h3.z * w2 + h3.w * w3;
            }
            RED[(ks * 4 + 0) * 32 + e] = a0; RED[(ks * 4 + 1) * 32 + e] = a1; RED[(ks * 4 + 2) * 32 + e] = a2; RED[(ks * 4 + 3) * 32 + e] = a3;
        }
        __syncthreads();
        if (tid < 128) {
            const int tok = tid >> 5, e = tid & 31, tt = item * 4 + tok;
            float logit = rbias[e];
#pragma unroll
            for (int ks = 0; ks < 8; ++ks) logit += RED[(ks * 4 + tok) * 32 + e];
            bool taken = false;
            float sv[4]; int si[4];
#pragma unroll
            for (int j = 0; j < 4; ++j) {
                float cand = taken ? -3.0e38f : logit; int ci = e;
#pragma unroll
                for (int off = 16; off >= 1; off >>= 1) {
                    const float ov = __shfl_xor(cand, off, 32); const int oi = __shfl_xor(ci, off, 32);
                    if (ov > cand || (ov == cand && oi < ci)) { cand = ov; ci = oi; }
                }
                sv[j] = cand; si[j] = ci; if (ci == e) taken = true;
            }
            const float e0 = 1.f, e1 = __expf(sv[1] - sv[0]), e2 = __expf(sv[2] - sv[0]), e3 = __expf(sv[3] - sv[0]);
            const float inv = 1.f / (e0 + e1 + e2 + e3);
            const float gts[4] = {e0 * inv, e1 * inv, e2 * inv, e3 * inv};
#pragma unroll
            for (int j = 0; j < 4; ++j) {
                if (si[j] == e) {
                    const int pos = atomicAdd(&CNT[e], 1);
                    LIST[(size_t)e * S + pos] = tt * 4 + j;
                    GATE[(size_t)tt * 4 + j] = gts[j];
                }
            }
        }
        __syncthreads();
    }
}

struct MoeMap { int cnt[32]; int off[32]; int tstart[33]; };
DEVI void moe_map(const P& p, int l, MoeMap* mm) {
    const int* CNT = (const int*)(p.ws + OFF_CNT) + l * 32;
    if (threadIdx.x < 32) mm->cnt[threadIdx.x] = __hip_atomic_load(&CNT[threadIdx.x], __ATOMIC_RELAXED, __HIP_MEMORY_SCOPE_AGENT);
    __syncthreads();
    if (threadIdx.x == 0) {
        int o = 0, ts = 0;
        for (int e = 0; e < 32; ++e) { mm->off[e] = o; mm->tstart[e] = ts; o += mm->cnt[e]; ts += (mm->cnt[e] + 127) / 128; }
        mm->tstart[32] = ts;
    }
    __syncthreads();
}

DEVI void phase_moe_up(const P& p, int l, char* smem) {
    MoeMap* mm = (MoeMap*)(smem + 65536);
    int* rows = (int*)(smem + 65536 + 1024);
    moe_map(p, l, mm);
    const bf16* H2 = (const bf16*)(p.ws + WS_H2);
    const bf16* WUP = (const bf16*)(p.ws + WS_WUP) + (size_t)l * NEXP * 2048 * D;
    const float* bup = p.in[33] + (size_t)l * NEXP * 2048;
    const int* LIST = (const int*)(p.ws + WS_LIST);
    bf16* ACT = (bf16*)(p.ws + WS_ACT);
    const int lane = threadIdx.x & 63, wid = threadIdx.x >> 6, wr = wid >> 1, wc = wid & 1, fr = lane & 15, fq = lane >> 4;
    const int ntiles = mm->tstart[32] * 16;
    for (int tile = blockIdx.x; tile < ntiles; tile += gridDim.x) {
        const int mtg = tile / 16, nt = tile % 16;
        int e = 0;
        while (mm->tstart[e + 1] <= mtg) ++e;
        const int m0 = (mtg - mm->tstart[e]) * 128, cnt = mm->cnt[e];
        __syncthreads();
        if (threadIdx.x < 128) { const int r = m0 + threadIdx.x; rows[threadIdx.x] = LIST[(size_t)e * S + (r < cnt ? r : m0)]; }
        __syncthreads();
        const bf16* We = WUP + (size_t)e * 2048 * D;
        f32x4 acc[4][4];
        gemm_tile(smem, H2, [&](int r) { return (unsigned)((rows[r] >> 2) * D); },
                  We, [&](int r) { const int t16 = r >> 4; return (unsigned)((nt * 64 + (t16 >> 1) * 16 + (r & 15) + ((t16 & 1) ? 1024 : 0)) * D); }, D, acc);
        const float* be = bup + (size_t)e * 2048;
#pragma unroll
        for (int m = 0; m < 4; ++m) {
            const int rl = m0 + wr * 64 + m * 16 + fr;
            if (rl < cnt) {
#pragma unroll
                for (int n2 = 0; n2 < 2; ++n2) {
                    const int col = nt * 64 + (wc * 2 + n2) * 16 + fq * 4;
                    const f32x4 bg = *(const f32x4*)(be + col), bl = *(const f32x4*)(be + 1024 + col);
                    float o[4];
#pragma unroll
                    for (int j = 0; j < 4; ++j) {
                        const float glu = fminf(acc[m][2 * n2][j] + bg[j], 7.f);
                        const float lin = fminf(fmaxf(acc[m][2 * n2 + 1][j] + bl[j], -7.f), 7.f);
                        o[j] = glu * sigmoidf_(1.702f * glu) * (lin + 1.f);
                    }
                    u32x2 ov; ov.x = pk2(o[0], o[1]); ov.y = pk2(o[2], o[3]);
                    *(u32x2*)(ACT + (size_t)(mm->off[e] + rl) * DFF + col) = ov;
                }
            }
        }
    }
}

DEVI void phase_moe_down(const P& p, int l, char* smem) {
    MoeMap* mm = (MoeMap*)(smem + 65536);
    int* rows = (int*)(smem + 65536 + 1024);
    moe_map(p, l, mm);
    const bf16* ACT = (const bf16*)(p.ws + WS_ACT);
    const bf16* WDN = (const bf16*)(p.ws + WS_WDN) + (size_t)l * NEXP * D * DFF;
    const float* bdn = p.in[35] + (size_t)l * NEXP * D;
    const int* LIST = (const int*)(p.ws + WS_LIST); const float* GATE = (const float*)(p.ws + WS_GATE);
    bf16* YB = (bf16*)(p.ws + WS_YB);
    const int lane = threadIdx.x & 63, wid = threadIdx.x >> 6, wr = wid >> 1, wc = wid & 1, fr = lane & 15, fq = lane >> 4;
    const int ntiles = mm->tstart[32] * 8;
    for (int tile = blockIdx.x; tile < ntiles; tile += gridDim.x) {
        const int mtg = tile / 8, nt = tile % 8;
        int e = 0;
        while (mm->tstart[e + 1] <= mtg) ++e;
        const int m0 = (mtg - mm->tstart[e]) * 128, cnt = mm->cnt[e];
        __syncthreads();
        if (threadIdx.x < 128) { const int r = m0 + threadIdx.x; rows[threadIdx.x] = LIST[(size_t)e * S + (r < cnt ? r : m0)]; }
        __syncthreads();
        const bf16* We = WDN + (size_t)e * D * DFF;
        const unsigned abase = (unsigned)(mm->off[e] + m0);
        f32x4 acc[4][4];
        gemm_tile(smem, ACT, [&](int r) { return (abase + ((m0 + r) < cnt ? r : 0)) * (unsigned)DFF; },
                  We, [&](int r) { return (unsigned)((nt * 128 + r) * DFF); }, DFF, acc);
        const float* be = bdn + (size_t)e * D;
#pragma unroll
        for (int m = 0; m < 4; ++m) {
            const int rt = wr * 64 + m * 16 + fr;
            if (m0 + rt < cnt) {
                const int ent = rows[rt];
                const float gt = GATE[ent];
#pragma unroll
                for (int n = 0; n < 4; ++n) {
                    const int col = nt * 128 + wc * 64 + n * 16 + fq * 4;
                    const f32x4 b = *(const f32x4*)(be + col);
                    u32x2 ov; ov.x = pk2((acc[m][n].x + b.x) * gt, (acc[m][n].y + b.y) * gt); ov.y = pk2((acc[m][n].z + b.z) * gt, (acc[m][n].w + b.w) * gt);
                    *(u32x2*)(YB + (size_t)ent * D + col) = ov;
                }
            }
        }
    }
}

DEVI void phase_ln2(const P& p, int l) {
    const float* ADA = (const float*)(p.ws + OFF_ADA) + l * 6144;
    const float* ADAn = (const float*)(p.ws + OFF_ADA) + 6144;
    float* X = (float*)(p.ws + WS_X); const bf16* YB = (const bf16*)(p.ws + WS_YB);
    bf16* HB = (bf16*)(p.ws + WS_HB);
    const float* lg = p.in[36] + l * D; const float* lb = p.in[37] + l * D;
    const int tid = threadIdx.x, lane = tid & 63, w = tid >> 6;
    for (int item = blockIdx.x; item < S / 4; item += gridDim.x) {
        const int t = item * 4 + w;
        f32x4 v[4]; float s = 0.f;
#pragma unroll
        for (int j = 0; j < 4; ++j) {
            const int c = j * 256 + lane * 4;
            const f32x4 x = *(const f32x4*)(X + (size_t)t * D + c);
            f32x4 f = {0.f, 0.f, 0.f, 0.f};
#pragma unroll
            for (int q = 0; q < 4; ++q) {
                const u32x2 y = *(const u32x2*)(YB + ((size_t)t * 4 + q) * D + c);
                f.x += __uint_as_float(y.x << 16); f.y += __uint_as_float(y.x & 0xffff0000u);
                f.z += __uint_as_float(y.y << 16); f.w += __uint_as_float(y.y & 0xffff0000u);
            }
            const f32x4 gt = *(const f32x4*)(ADA + 5120 + c);
            v[j] = x * DN_ALPHA + (gt + 1.f) * f;
            s += (v[j].x + v[j].y) + (v[j].z + v[j].w);
        }
        const float mean = wave_sum(s) * (1.f / D);
        float s2 = 0.f;
#pragma unroll
        for (int j = 0; j < 4; ++j) { v[j] = v[j] - mean; s2 += (v[j].x * v[j].x + v[j].y * v[j].y) + (v[j].z * v[j].z + v[j].w * v[j].w); }
        const float rstd = rsqrtf(wave_sum(s2) * (1.f / D) + 1e-5f);
#pragma unroll
        for (int j = 0; j < 4; ++j) {
            const int c = j * 256 + lane * 4;
            const f32x4 g = *(const f32x4*)(lg + c), b = *(const f32x4*)(lb + c);
            const f32x4 xo = v[j] * rstd * g + b;
            if (l == 0) {
                *(f32x4*)(X + (size_t)t * D + c) = xo;
                const f32x4 sh = *(const f32x4*)(ADAn + c), sc = *(const f32x4*)(ADAn + 1024 + c);
                const f32x4 hh = xo * (sc + 1.f) + sh;
                u32x2 o; o.x = pk2(hh.x, hh.y); o.y = pk2(hh.z, hh.w);
                *(u32x2*)(HB + (size_t)t * D + c) = o;
            } else {
                *(f32x4*)(p.out + (size_t)t * D + c) = xo;
            }
        }
    }
}

constexpr int NPHASE = 24;
__global__ void __launch_bounds__(NT, 2) k_run(P p) {
    extern __shared__ __attribute__((aligned(16))) char smem[];
    XcdBarrier bar; bar.bar = nullptr; bar.x = 0; bar.st = nullptr;
    const bool multi = (p.ph_hi - p.ph_lo) > 1;
    if (multi) {
        volatile LAS unsigned* st = (volatile LAS unsigned*)(smem + LDS_BYTES - 16);
        if (threadIdx.x == 0) { st[0] = 0u; st[1] = 0u; }
        __syncthreads();
        bar = xcd_barrier_post((unsigned*)(p.ws + OFF_BAR), st);
    }
#ifndef DUP
#define DUP -1
#endif
#ifndef DUP2
#define DUP2 -1
#endif
#define RUN(k, call) if (p.ph_lo <= (k) && (k) < p.ph_hi) { if ((k) == DUP || (k) == DUP2) { call; xcd_barrier(bar); } call; if (multi && (k) + 1 < p.ph_hi) xcd_barrier(bar); }
    RUN(0, phase_prep(p, smem))
    RUN(1, phase_h0(p))
    RUN(2, phase_inproj(p, 0, smem))
    RUN(3, phase_mixprep(p, 0, smem))
    RUN(4, phase_chunkA(p, smem))
    RUN(5, phase_scan(p, smem))
    RUN(6, phase_chunkC(p, smem))
    RUN(7, phase_post(p, 0))
    RUN(8, phase_outproj(p, 0, smem))
    RUN(9, phase_ln1_route(p, 0, smem))
    RUN(10, phase_moe_up(p, 0, smem))
    RUN(11, phase_moe_down(p, 0, smem))
    RUN(12, phase_ln2(p, 0))
    RUN(13, phase_inproj(p, 1, smem))
    RUN(14, phase_mixprep(p, 1, smem))
    RUN(15, phase_chunkA(p, smem))
    RUN(16, phase_scan(p, smem))
    RUN(17, phase_chunkC(p, smem))
    RUN(18, phase_post(p, 1))
    RUN(19, phase_outproj(p, 1, smem))
    RUN(20, phase_ln1_route(p, 1, smem))
    RUN(21, phase_moe_up(p, 1, smem))
    RUN(22, phase_moe_down(p, 1, smem))
    RUN(23, phase_ln2(p, 1))
#undef RUN
}

extern "C" void kernel_launch(void* const* d_in, const int* in_sizes, int n_in, void* d_out, int out_size, void* d_ws, size_t ws_size,
                              hipStream_t stream) {
    static int grid = 0;
    if (grid == 0) {
        if (n_in != 38 || ws_size < WS_END) { fprintf(stderr, "kernel_launch: unexpected n_in %d or ws_size %zu (< %zu)\n", n_in, ws_size, (size_t)WS_END); grid = -1; return; }
        int dev = 0, cus = 0, per_cu = 0;
        hipGetDevice(&dev);
        hipDeviceGetAttribute(&cus, hipDeviceAttributeMultiprocessorCount, dev);
        hipFuncSetAttribute((const void*)k_run, hipFuncAttributeMaxDynamicSharedMemorySize, LDS_BYTES);
        hipOccupancyMaxActiveBlocksPerMultiprocessor(&per_cu, (const void*)k_run, NT, LDS_BYTES);
        if (per_cu < 1) { fprintf(stderr, "kernel_launch: occupancy query returned %d\n", per_cu); grid = -1; return; }
        if (per_cu > 2) per_cu = 2;
        grid = cus * per_cu;
    }
    if (grid < 0) return;
    hipMemsetAsync((char*)d_ws + WS_CTL, 0, CTL_BYTES, stream);
    P p{};
    for (int i = 0; i < 38; ++i) p.in[i] = (const float*)d_in[i];
    p.pos = (const int*)d_in[2];
    p.out = (float*)d_out; p.ws = (char*)d_ws;
#if MEGA
    p.ph_lo = 0; p.ph_hi = NPHASE;
    void* args[] = {&p};
    hipError_t e = hipLaunchCooperativeKernel((const void*)k_run, dim3(grid), dim3(NT), args, LDS_BYTES, stream);
    if (e != hipSuccess) fprintf(stderr, "cooperative launch failed: %s (grid %d)\n", hipGetErrorString(e), grid);
#else
    for (int ph = 0; ph < NPHASE; ++ph) {
        p.ph_lo = ph; p.ph_hi = ph + 1;
        hipLaunchKernelGGL(k_run, dim3(grid), dim3(NT), LDS_BYTES, stream, p);
    }
#endif
}
```

```cpp
#include <hip/hip_runtime.h>
#include <hip/hip_bf16.h>
#include <stdint.h>
#include <stdio.h>

#ifndef MEGA
#define MEGA 1
#endif

#define DEVI __device__ __forceinline__
#define LAS __attribute__((address_space(3)))

typedef unsigned short bf16;
typedef short bf16x8 __attribute__((ext_vector_type(8)));
typedef float f32x4 __attribute__((ext_vector_type(4)));
typedef unsigned u32x4 __attribute__((ext_vector_type(4)));
typedef unsigned u32x2 __attribute__((ext_vector_type(2)));

constexpr int S = 16384, D = 1024, NIN = 4104, NEXP = 32, DFF = 1024;
constexpr int NPROJ = 4096;
constexpr int NPAD = 4224;
constexpr float DN_ALPHA = 1.4142135623730951f;
constexpr int NT = 256;
constexpr int LDS_BYTES = 67840;

constexpr size_t MiB = 1ull << 20;
constexpr size_t WS_CTL = 0;
constexpr size_t CTL_BYTES = 1 * MiB;
constexpr size_t OFF_BAR = 0;
constexpr size_t OFF_ADA = 64 * 1024;
constexpr size_t OFF_CNT = 128 * 1024;
constexpr size_t WS_ROT = 1 * MiB;
constexpr size_t WS_WIN = WS_ROT + (size_t)S * 64 * 4;
constexpr size_t WS_WOUT = WS_WIN + 2ull * NPAD * D * 2;
constexpr size_t WS_WUP = WS_WOUT + 2ull * D * D * 2;
constexpr size_t WS_WDN = WS_WUP + 2ull * NEXP * 2048 * D * 2;
constexpr size_t WS_HB = WS_WDN + 2ull * NEXP * D * DFF * 2;
constexpr size_t WS_PROJ = WS_HB + (size_t)S * D * 2;
constexpr size_t WS_PEX = WS_PROJ + (size_t)S * NPROJ * 2;
constexpr size_t WS_VFIRST = WS_PEX + (size_t)S * 64 * 4;
constexpr size_t WS_RECR = WS_VFIRST + (size_t)S * 256 * 4;
constexpr size_t WS_RECG = WS_RECR + (size_t)S * 4 * 384 * 4;
constexpr size_t WS_RECT = WS_RECG + (size_t)S * 4 * 392 * 4;
constexpr size_t WS_G = WS_RECT + (size_t)S * 4 * 192 * 4;
constexpr size_t WS_BON = WS_G + (size_t)S * 256 * 4;
constexpr size_t WS_YR = WS_BON + (size_t)S * 4 * 4;
constexpr size_t WS_OG = WS_YR + (size_t)S * 256 * 4;
constexpr size_t WS_ORT = WS_OG + (size_t)S * 512 * 4;
constexpr size_t WS_MIX = WS_ORT + (size_t)S * 256 * 4;
constexpr size_t WS_OPRE = WS_MIX + (size_t)S * D * 2;
constexpr size_t WS_X = WS_OPRE + (size_t)S * D * 4;
constexpr size_t WS_H2 = WS_X + (size_t)S * D * 4;
constexpr size_t WS_LIST = WS_H2 + (size_t)S * D * 2;
constexpr size_t WS_GATE = WS_LIST + (size_t)NEXP * S * 4;
constexpr size_t WS_ACT = WS_GATE + (size_t)S * 4 * 4;
constexpr size_t WS_YB = WS_ACT + ((size_t)S * 4 + 128) * DFF * 2;
constexpr size_t WS_ADAP = WS_YB + (size_t)S * 4 * D * 2;
constexpr size_t WS_RKV = WS_ADAP + 16ull * 12288 * 4;
constexpr size_t WS_RST = WS_RKV + 256ull * 4 * 4096 * 4;
constexpr size_t WS_GP = WS_RST + 256ull * 4 * 4096 * 2;
constexpr size_t WS_GB = WS_GP + 1024ull * 16384 * 2;
constexpr size_t WS_GD = WS_GB + 1024ull * 16384 * 4;
constexpr size_t WS_GQ = WS_GD + 4096;
constexpr size_t WS_GO = WS_GQ + 1024ull * 8192 * 2;
constexpr size_t WS_GS = WS_GO + 1024ull * 8192 * 4;
constexpr size_t WS_WP = WS_GS + 1024ull * 16384 * 2;
constexpr size_t WS_WC = WS_WP + 2048ull * 4096 * 2;
constexpr size_t WS_WD = WS_WC + 2048ull * 4096 * 4;
constexpr size_t WS_WQ = WS_WD + 2048ull * 64 * 4;
constexpr size_t WS_WY = WS_WQ + 2048ull * 2048 * 2;
constexpr size_t WS_WS = WS_WY + 2048ull * 2048 * 4;
constexpr size_t WS_GR = WS_WS + 2048ull * 4096 * 2;
constexpr size_t WS_GE0 = WS_GR + 1024ull * 8192 * 2;
constexpr size_t WS_GTE = WS_GE0 + 64ull * 16384 * 4;
constexpr size_t WS_GSG = WS_GTE + 64ull * 16384 * 2;
constexpr size_t WS_WR = WS_GSG + 64ull * 16384 * 2;
constexpr size_t WS_WE0 = WS_WR + 2048ull * 2048 * 2;
constexpr size_t WS_WTE = WS_WE0 + 64ull * 4096 * 4;
constexpr size_t WS_WSG = WS_WTE + 64ull * 4096 * 2;
constexpr size_t WS_END = WS_WSG + 64ull * 4096 * 2;

struct P {
    const float* in[38];
    const int* pos;
    float* out;
    char* ws;
    int ph_lo, ph_hi;
};

DEVI float bf2f(bf16 v) { return __uint_as_float(((unsigned)v) << 16); }
DEVI unsigned f2bf(float f) { unsigned u = __float_as_uint(f); return (u + 0x7fffu + ((u >> 16) & 1u)) >> 16; }
DEVI unsigned pk2(float lo, float hi) { return f2bf(lo) | (f2bf(hi) << 16); }
DEVI float sigmoidf_(float x) { return 1.f / (1.f + __expf(-x)); }
DEVI float siluf_(float x) { return x * sigmoidf_(x); }
DEVI float softplusf_(float x) { return fmaxf(x, 0.f) + log1pf(__expf(-fabsf(x))); }
DEVI float wave_sum(float v) {
#pragma unroll
    for (int o = 32; o >= 1; o >>= 1) v += __shfl_xor(v, o);
    return v;
}
template <int CTRL> DEVI float dpp_mov(float x) {
    return __int_as_float(__builtin_amdgcn_update_dpp(0, __float_as_int(x), CTRL, 0xf, 0xf, false));
}
DEVI float row16_sum(float x) {
    x += dpp_mov<0x128>(x);
    x += dpp_mov<0x124>(x);
    x += dpp_mov<0x122>(x);
    x += dpp_mov<0x121>(x);
    return x;
}

#define XB_TMO      128
#define XB_XCNT(j)  (256  + 64 * (j))
#define XB_XSUB(j)  (1280 + 64 * (j))
#define XB_XGEN(j)  (2304 + 64 * (j))
#define XB_TOP      3328
#define XB_TOPGEN   3392
#define XCD_BAR_WORDS 3456
#define XB_SPIN_CAP (1u << 22)
DEVI unsigned xb_ld(unsigned* p) { return __hip_atomic_load(p, __ATOMIC_RELAXED, __HIP_MEMORY_SCOPE_AGENT); }
DEVI unsigned xb_add(unsigned* p, unsigned v) { return __hip_atomic_fetch_add(p, v, __ATOMIC_RELAXED, __HIP_MEMORY_SCOPE_AGENT); }
DEVI unsigned xb_xcc_id() { return (unsigned)__builtin_amdgcn_s_getreg((3 << 11) | 20) & 0xFu; }
#define XB_SPIN(cond, bar) do { unsigned _sp = 0; while (cond) { __builtin_amdgcn_s_sleep(1); \
    if ((++_sp & 255u) == 0u) { if (xb_ld(&(bar)[XB_TMO])) break; if (_sp > XB_SPIN_CAP) { atomicAdd(&(bar)[XB_TMO], 1u); break; } } } } while (0)
struct XcdBarrier { unsigned* bar; unsigned x; volatile LAS unsigned* st; };
DEVI XcdBarrier xcd_barrier_post(unsigned* bar, volatile LAS unsigned* st) {
    XcdBarrier b; b.bar = bar; b.x = xb_xcc_id(); b.st = st;
    if (threadIdx.x == 0) (void)xb_add(&bar[XB_XCNT(b.x)], 1u);
    return b;
}
DEVI void xcd_barrier_complete(unsigned* bar, unsigned x, unsigned& nloc, unsigned& nx) {
    const unsigned G = gridDim.x * gridDim.y * gridDim.z;
    unsigned sum, cnt, mine, sp = 0u;
    for (;;) {
        sum = 0u; cnt = 0u; mine = 0u;
#pragma unroll
        for (unsigned j = 0; j < 16; ++j) { const unsigned c = xb_ld(&bar[XB_XCNT(j)]); sum += c; cnt += (c > 0u) ? 1u : 0u; mine = (j == x) ? c : mine; }
        if (sum == G) break;
        __builtin_amdgcn_s_sleep(1);
        if ((++sp & 255u) == 0u) { if (xb_ld(&bar[XB_TMO])) break; if (sp > XB_SPIN_CAP) { atomicAdd(&bar[XB_TMO], 1u); break; } }
    }
    nloc = mine > 0u ? mine : 1u; nx = cnt > 0u ? cnt : 1u;
}
DEVI void xcd_barrier(const XcdBarrier& b) {
    asm volatile("s_waitcnt vmcnt(0)" ::: "memory");
    __syncthreads();
    if (threadIdx.x == 0) {
        unsigned* bar = b.bar;
        __builtin_amdgcn_s_waitcnt(0);
        unsigned nloc = b.st[0], nx = b.st[1];
        if (nloc == 0u) { xcd_barrier_complete(bar, b.x, nloc, nx); b.st[0] = nloc; b.st[1] = nx; }
        const unsigned old = xb_add(&bar[XB_XSUB(b.x)], 1u);
        const unsigned gen = old / nloc;
        if (old + 1u == (gen + 1u) * nloc) {
            __builtin_amdgcn_fence(__ATOMIC_RELEASE, "agent");
            asm volatile("s_waitcnt vmcnt(0)" ::: "memory");
            const unsigned og = xb_add(&bar[XB_TOP], 1u);
            const unsigned tg = og / nx;
            if (og + 1u == (tg + 1u) * nx) xb_add(&bar[XB_TOPGEN], 1u);
            else XB_SPIN(xb_ld(&bar[XB_TOPGEN]) == tg, bar);
            __builtin_amdgcn_fence(__ATOMIC_ACQUIRE, "agent");
            xb_add(&bar[XB_XGEN(b.x)], 1u);
            asm volatile("s_waitcnt vmcnt(0)" ::: "memory");
        } else {
            XB_SPIN(xb_ld(&bar[XB_XGEN(b.x)]) == gen, bar);
            __builtin_amdgcn_fence(__ATOMIC_ACQUIRE, "agent");
            asm volatile("s_waitcnt vmcnt(0)" ::: "memory");
        }
    }
    __syncthreads();
}

DEVI void transpose_item(const float* __restrict__ src, size_t ld, int k0, int ns0, bf16* __restrict__ dst, int kd, int nd0, float* lds) {
    const int tid = threadIdx.x;
#pragma unroll 4
    for (int i = 0; i < 16; ++i) {
        const int kk = i * 4 + (tid >> 6), n = tid & 63;
        lds[kk * 65 + n] = src[(size_t)(k0 + kk) * ld + ns0 + n];
    }
    __syncthreads();
#pragma unroll
    for (int i = 0; i < 2; ++i) {
        const int q = tid + 256 * i, n = q >> 3, kc = q & 7;
        const float* s = lds + (kc * 8) * 65 + n;
        u32x4 o;
        o.x = pk2(s[0 * 65], s[1 * 65]); o.y = pk2(s[2 * 65], s[3 * 65]);
        o.z = pk2(s[4 * 65], s[5 * 65]); o.w = pk2(s[6 * 65], s[7 * 65]);
        *(u32x4*)(dst + (size_t)(nd0 + n) * kd + k0 + kc * 8) = o;
    }
    __syncthreads();
}

DEVI void phase_prep(const P& p, char* smem) {
    float* lds = (float*)smem;
    const int tid = threadIdx.x;
    const int nb = gridDim.x, bid = blockIdx.x;
    bf16* WIN = (bf16*)(p.ws + WS_WIN); bf16* WOUT = (bf16*)(p.ws + WS_WOUT);
    bf16* WUP = (bf16*)(p.ws + WS_WUP); bf16* WDN = (bf16*)(p.ws + WS_WDN);
    constexpr int I_UP = 2 * NEXP * 16 * 32;
    constexpr int I_DN = 2 * NEXP * 16 * 16;
    constexpr int I_IN = 2 * 16 * 64;
    constexpr int I_OUT = 2 * 16 * 16;
    constexpr int I_EX = 2 * 128;
    constexpr int I_ADA = 2 * 24 * 16;
    constexpr int I_ROT = S * 32 / 256;
    constexpr int NITEMS = I_UP + I_DN + I_IN + I_OUT + I_EX + I_ADA + I_ROT;
    for (int it = bid; it < NITEMS; it += nb) {
        int r = it;
        if (r < I_UP) {
            const int le = r / 512, q = r % 512, kt = q / 32, nt = q % 32;
            transpose_item(p.in[32] + (size_t)le * D * 2048, 2048, kt * 64, nt * 64, WUP + (size_t)le * 2048 * D, D, nt * 64, lds);
            continue;
        }
        r -= I_UP;
        if (r < I_DN) {
            const int le = r / 256, q = r % 256, kt = q / 16, nt = q % 16;
            transpose_item(p.in[34] + (size_t)le * DFF * D, D, kt * 64, nt * 64, WDN + (size_t)le * D * DFF, DFF, nt * 64, lds);
            continue;
        }
        r -= I_DN;
        if (r < I_IN) {
            const int l = r / 1024, q = r % 1024, kt = q / 64, nt = q % 64;
            const int nd0 = nt * 64, ns0 = nd0 < 3072 ? nd0 : nd0 + 8;
            transpose_item(p.in[5] + (size_t)l * D * NIN, NIN, kt * 64, ns0, WIN + (size_t)l * NPAD * D, D, nd0, lds);
            continue;
        }
        r -= I_IN;
        if (r < I_OUT) {
            const int l = r / 256, q = r % 256, kt = q / 16, nt = q % 16;
            transpose_item(p.in[27] + (size_t)l * D * D, D, kt * 64, nt * 64, WOUT + (size_t)l * D * D, D, nt * 64, lds);
            continue;
        }
        r -= I_OUT;
        if (r < I_EX) {
            const int l = r / 128, n = r % 128;
            bf16* dst = WIN + ((size_t)l * NPAD + NPROJ + n) * D;
            for (int k = tid; k < D; k += NT) {
                float v = 0.f;
                if (n < 8) v = p.in[5][(size_t)l * D * NIN + (size_t)k * NIN + 3072 + n];
                else if (n < 40 && l == 1) v = p.in[6][(size_t)k * 32 + (n - 8)];
                dst[k] = (bf16)f2bf(v);
            }
            continue;
        }
        r -= I_EX;
        if (r < I_ADA) {
            const int l = r / 384, q = r % 384, nc = q / 16, kc = q % 16;
            const int n = nc * 256 + tid;
            const float* W = p.in[3] + (size_t)l * D * 6144;
            float acc = (kc == 0) ? p.in[4][l * 6144 + n] : 0.f;
            for (int k = kc * 64; k < kc * 64 + 64; ++k) acc += siluf_(p.in[1][k]) * W[(size_t)k * 6144 + n];
            ((float*)(p.ws + WS_ADAP))[(size_t)kc * 12288 + l * 6144 + n] = acc;
            continue;
        }
        r -= I_ADA;
        {
            const int idx = r * 256 + tid;
            const int t = idx >> 5, i = idx & 31;
            const float invf = (float)pow(10000.0, -(double)i / 32.0);
            const float ang = (float)p.pos[t] * invf;
            float sn, cs; sincosf(ang, &sn, &cs);
            float* ROT = (float*)(p.ws + WS_ROT);
            ROT[(size_t)idx * 2] = cs; ROT[(size_t)idx * 2 + 1] = sn;
        }
    }
}

DEVI float ada_sum(const float* ADAP, int idx) {
    float s = 0.f;
#pragma unroll
    for (int kc = 0; kc < 16; ++kc) s += ADAP[(size_t)kc * 12288 + idx];
    return s;
}
DEVI void phase_h0(const P& p) {
    const float* ADAP = (const float*)(p.ws + WS_ADAP);
    float* ADA = (float*)(p.ws + OFF_ADA);
    bf16* HB = (bf16*)(p.ws + WS_HB);
    if (blockIdx.x < 48) ADA[blockIdx.x * 256 + threadIdx.x] = ada_sum(ADAP, blockIdx.x * 256 + threadIdx.x);
    const size_t n4 = (size_t)S * D / 4;
    const int c = (int)(((size_t)blockIdx.x * NT + threadIdx.x) % (D / 4)) * 4;
    f32x4 sh, sc;
    sh.x = ada_sum(ADAP, c); sh.y = ada_sum(ADAP, c + 1); sh.z = ada_sum(ADAP, c + 2); sh.w = ada_sum(ADAP, c + 3);
    sc.x = ada_sum(ADAP, 1024 + c); sc.y = ada_sum(ADAP, 1025 + c); sc.z = ada_sum(ADAP, 1026 + c); sc.w = ada_sum(ADAP, 1027 + c);
    for (size_t i = (size_t)blockIdx.x * NT + threadIdx.x; i < n4; i += (size_t)gridDim.x * NT) {
        const f32x4 x = ((const f32x4*)p.in[0])[i];
        u32x2 o;
        o.x = pk2(x.x * (1.f + sc.x) + sh.x, x.y * (1.f + sc.y) + sh.y);
        o.y = pk2(x.z * (1.f + sc.z) + sh.z, x.w * (1.f + sc.w) + sh.w);
        ((u32x2*)HB)[i] = o;
    }
}

template <class AF, class BF>
DEVI void gemm_tile(char* smem, const bf16* __restrict__ Abase, AF arow, const bf16* __restrict__ Bbase, BF brow, int K, f32x4 (&acc)[4][4]) {
    const int tid = threadIdx.x, wid = tid >> 6, lane = tid & 63, wr = wid >> 1, wc = wid & 1, fr = lane & 15, fq = lane >> 4;
    const int r0 = tid >> 3, swz = ((tid & 7) ^ (r0 & 7)) * 8;
    unsigned pa[4], pb[4];
#pragma unroll
    for (int i = 0; i < 4; ++i) { pa[i] = arow(r0 + 32 * i) + swz; pb[i] = brow(r0 + 32 * i) + swz; }
#pragma unroll
    for (int m = 0; m < 4; ++m)
#pragma unroll
        for (int n = 0; n < 4; ++n) acc[m][n] = (f32x4){0.f, 0.f, 0.f, 0.f};
    const int nk = K / 64;
#define GT_STAGE(buf, kt) do { char* _sa = smem + (buf) * 32768; char* _sb = _sa + 16384; \
        _Pragma("unroll") for (int _i = 0; _i < 4; ++_i) { \
            __builtin_amdgcn_global_load_lds((const unsigned*)(Abase + pa[_i] + (kt) * 64), (unsigned*)(_sa + (tid + 256 * _i) * 16), 16, 0, 0); \
            __builtin_amdgcn_global_load_lds((const unsigned*)(Bbase + pb[_i] + (kt) * 64), (unsigned*)(_sb + (tid + 256 * _i) * 16), 16, 0, 0); } } while (0)
    GT_STAGE(0, 0);
    for (int kt = 0; kt < nk; ++kt) {
        const int cur = kt & 1;
        asm volatile("s_waitcnt vmcnt(0)" ::: "memory");
        __syncthreads();
        if (kt + 1 < nk) GT_STAGE(cur ^ 1, kt + 1);
        const char* SA = smem + cur * 32768; const char* SB = SA + 16384;
#pragma unroll
        for (int ks = 0; ks < 2; ++ks) {
            const int ch = ((ks * 4 + fq) ^ (fr & 7)) * 16;
            bf16x8 af[4], bfr[4];
#pragma unroll
            for (int m = 0; m < 4; ++m) af[m] = *(const bf16x8*)(SA + (wr * 64 + m * 16 + fr) * 128 + ch);
#pragma unroll
            for (int n = 0; n < 4; ++n) bfr[n] = *(const bf16x8*)(SB + (wc * 64 + n * 16 + fr) * 128 + ch);
#pragma unroll
            for (int m = 0; m < 4; ++m)
#pragma unroll
                for (int n = 0; n < 4; ++n)
                    acc[m][n] = __builtin_amdgcn_mfma_f32_16x16x32_bf16(bfr[n], af[m], acc[m][n], 0, 0, 0);
        }
    }
    __syncthreads();
#undef GT_STAGE
}

DEVI void phase_inproj(const P& p, int l, char* smem) {
    const bf16* HB = (const bf16*)(p.ws + WS_HB);
    const bf16* W = (const bf16*)(p.ws + WS_WIN) + (size_t)l * NPAD * D;
    bf16* PROJ = (bf16*)(p.ws + WS_PROJ); float* PEX = (float*)(p.ws + WS_PEX);
    const int lane = threadIdx.x & 63, wid = threadIdx.x >> 6, wr = wid >> 1, wc = wid & 1, fr = lane & 15, fq = lane >> 4;
    constexpr int NTN = NPAD / 128;
    for (int tile = blockIdx.x; tile < (S / 128) * NTN; tile += gridDim.x) {
        const int mt = tile / NTN, nt = tile % NTN;
        f32x4 acc[4][4];
        gemm_tile(smem, HB, [&](int r) { return (unsigned)((mt * 128 + r) * D); }, W, [&](int r) { return (unsigned)((nt * 128 + r) * D); }, D, acc);
#pragma unroll
        for (int m = 0; m < 4; ++m) {
            const int tok = mt * 128 + wr * 64 + m * 16 + fr;
#pragma unroll
            for (int n = 0; n < 4; ++n) {
                const int f = wc * 64 + n * 16 + fq * 4;
                if (nt < 32) {
                    u32x2 o; o.x = pk2(acc[m][n].x, acc[m][n].y); o.y = pk2(acc[m][n].z, acc[m][n].w);
                    *(u32x2*)(PROJ + (size_t)tok * NPROJ + nt * 128 + f) = o;
                } else if (f < 64) {
                    *(f32x4*)(PEX + (size_t)tok * 64 + f) = acc[m][n];
                }
            }
        }
    }
}

DEVI float proj_at(const bf16* PROJ, int t, int col) { return bf2f(PROJ[(size_t)t * NPROJ + col]); }
DEVI float proj_shift(const bf16* PROJ, int t, int col, float mu) {
    const float cur = proj_at(PROJ, t, col);
    const float prv = t > 0 ? proj_at(PROJ, t - 1, col) : 0.f;
    return cur + (prv - cur) * mu;
}

DEVI void phase_mixprep(const P& p, int l, char* smem) {
    const bf16* PROJ = (const bf16*)(p.ws + WS_PROJ); const float* PEX = (const float*)(p.ws + WS_PEX);
    float* VFIRST = (float*)(p.ws + WS_VFIRST);
    float* RECR = (float*)(p.ws + WS_RECR); float* RECG = (float*)(p.ws + WS_RECG); float* RECT = (float*)(p.ws + WS_RECT);
    float* GB = (float*)(p.ws + WS_G); float* BON = (float*)(p.ws + WS_BON);
    const float* ROT = (const float*)(p.ws + WS_ROT);
    constexpr int TT = 8;
    float* L = (float*)smem;
    float* ACC = L + TT * 288;
    const int tid = threadIdx.x, lane = tid & 63, w = tid >> 6;
    for (int item = blockIdx.x; item < S / TT; item += gridDim.x) {
        const int t0 = item * TT;
        {
            const float* mu = p.in[7] + l * 1024; const float* muv = p.in[8];
            for (int idx = tid; idx < TT * 288; idx += NT) {
                const int tt = idx / 288, i = idx % 288, t = t0 + tt;
                float v;
                if (i < 64) v = tanhf(proj_shift(PROJ, t, 768 + i, mu[768 + i]));
                else if (i < 128) v = proj_shift(PROJ, t, 832 + (i - 64), mu[832 + (i - 64)]);
                else if (i < 256) v = sigmoidf_(proj_shift(PROJ, t, 896 + (i - 128), mu[896 + (i - 128)]));
                else {
                    v = 0.f;
                    if (l == 1) {
                        const int j = i - 256;
                        const float cur = PEX[(size_t)t * 64 + 8 + j];
                        const float prv = t > 0 ? PEX[(size_t)(t - 1) * 64 + 8 + j] : 0.f;
                        v = cur + (prv - cur) * muv[j];
                    }
                }
                L[idx] = v;
            }
        }
        __syncthreads();
        {
            const int c = tid;
#pragma unroll 1
            for (int q = 0; q < 4; ++q) {
                const float* W = (q == 0) ? (p.in[10] + l * 64 * 256) : (q == 1) ? (p.in[12] + l * 64 * 256) : (q == 2) ? (p.in[13] + l * 128 * 256) : p.in[20];
                const int nr = (q == 2) ? 128 : (q == 3) ? ((l == 1) ? 32 : 0) : 64;
                const int lo = (q == 0) ? 0 : (q == 1) ? 64 : (q == 2) ? 128 : 256;
                float acc[TT];
#pragma unroll
                for (int tt = 0; tt < TT; ++tt) acc[tt] = 0.f;
#pragma unroll 2
                for (int i = 0; i < nr; i += 4) {
                    const float q0 = W[(i + 0) * 256 + c], q1 = W[(i + 1) * 256 + c], q2 = W[(i + 2) * 256 + c], q3 = W[(i + 3) * 256 + c];
#pragma unroll
                    for (int tt = 0; tt < TT; ++tt) { const f32x4 x = *(const f32x4*)(L + tt * 288 + lo + i); acc[tt] += x.x * q0 + x.y * q1 + x.z * q2 + x.w * q3; }
                }
#pragma unroll
                for (int tt = 0; tt < TT; ++tt) ACC[(q * TT + tt) * 256 + c] = acc[tt];
            }
            const float* mu = p.in[7] + l * 1024;
            const float w0c = p.in[9][l * 256 + c], a0c = p.in[11][l * 256 + c], kkc = p.in[14][l * 256 + c], kac = p.in[15][l * 256 + c], rkc = p.in[16][l * 256 + c];
            const float mur = mu[c], muk = mu[256 + c], muvv = mu[512 + c];
            const float v0c = (l == 1) ? p.in[19][c] : 0.f;
            const int h = w, j = lane;
#pragma unroll 1
            for (int tt = 0; tt < TT; ++tt) {
                const int t = t0 + tt;
                const float r = proj_shift(PROJ, t, c, mur);
                const float k = proj_shift(PROJ, t, 256 + c, muk);
                float v = proj_shift(PROJ, t, 512 + c, muvv);
                const float wpre = w0c + ACC[(0 * TT + tt) * 256 + c];
                const float wl = -softplusf_(-wpre) - 0.5f;
                const float decay = __expf(-__expf(wl));
                const float a = sigmoidf_(a0c + ACC[(1 * TT + tt) * 256 + c]);
                if (l == 0) VFIRST[(size_t)t * 256 + c] = v;
                else { const float vf = VFIRST[(size_t)t * 256 + c]; v = v + (vf - v) * sigmoidf_(v0c + ACC[(3 * TT + tt) * 256 + c]); }
                const float kx = k * kkc;
                const float ss = wave_sum(kx * kx);
                const float kk = kx * rsqrtf(ss + 1e-12f);
                const float k2 = k * (1.f + (a - 1.f) * kac);
                const float bon = wave_sum(r * k2 * rkc);
                float* rec = RECR + ((size_t)t * 4 + h) * 384;
                rec[j] = -kk; rec[64 + j] = decay; rec[128 + j] = kk * a; rec[192 + j] = k2; rec[256 + j] = r; rec[320 + j] = v;
                GB[(size_t)t * 256 + c] = ACC[(2 * TT + tt) * 256 + c];
                if (j == 0) BON[(size_t)t * 4 + h] = bon;
            }
        }
        {
            const float* conv_w = p.in[21] + l * 4 * 1536;
            const int h = w;
            float hist[6][3], cw[6][4];
            int colb[6];
#pragma unroll
            for (int q = 0; q < 6; ++q) {
                const int which = q >> 1, u = q & 1;
                const int ch = which * 512 + h * 128 + lane + 64 * u;
                colb[q] = 1024 + ch;
#pragma unroll
                for (int i = 0; i < 4; ++i) cw[q][i] = conv_w[i * 1536 + ch];
#pragma unroll
                for (int i = 0; i < 3; ++i) { const int t = t0 - 3 + i; hist[q][i] = t >= 0 ? proj_at(PROJ, t, colb[q]) : 0.f; }
            }
            const float nA = -__expf(p.in[22][l * 4 + h]), dtb = p.in[23][l * 4 + h];
#pragma unroll 1
            for (int tt = 0; tt < TT; ++tt) {
                const int t = t0 + tt;
                float y[6];
#pragma unroll
                for (int q = 0; q < 6; ++q) {
                    const float xt = proj_at(PROJ, t, colb[q]);
                    const float cv = cw[q][0] * hist[q][0] + cw[q][1] * hist[q][1] + cw[q][2] * hist[q][2] + cw[q][3] * xt;
                    hist[q][0] = hist[q][1]; hist[q][1] = hist[q][2]; hist[q][2] = xt;
                    y[q] = siluf_(cv);
                }
                const float sq = wave_sum(y[0] * y[0] + y[1] * y[1]);
                const float sk = wave_sum(y[2] * y[2] + y[3] * y[3]);
                const float rq = rsqrtf(sq + 1e-12f) * 0.08838834764831845f;
                const float rk = rsqrtf(sk + 1e-12f);
                float* rec = RECG + ((size_t)t * 4 + h) * 392;
                rec[lane] = y[0] * rq; rec[64 + lane] = y[1] * rq;
                rec[128 + lane] = y[2] * rk; rec[192 + lane] = y[3] * rk;
                rec[256 + lane] = y[4]; rec[320 + lane] = y[5];
                if (lane == 0) {
                    const float av = PEX[(size_t)t * 64 + h], bv = PEX[(size_t)t * 64 + 4 + h];
                    const float g = nA * softplusf_(av + dtb);
                    rec[384] = __expf(g); rec[385] = sigmoidf_(bv); rec[386] = g; rec[387] = 0.f;
                }
            }
        }
        {
            const int h = w, i = lane, c = tid;
#pragma unroll 1
            for (int tt = 0; tt < TT; ++tt) {
                const int t = t0 + tt;
                const float q = proj_at(PROJ, t, 3072 + c), k = proj_at(PROJ, t, 3328 + c), v = proj_at(PROJ, t, 3584 + c);
                const float cs = ROT[((size_t)t * 32 + (i & 31)) * 2], sn = ROT[((size_t)t * 32 + (i & 31)) * 2 + 1];
                const float qo = __shfl_xor(q, 32), ko = __shfl_xor(k, 32);
                const float qr = (i < 32) ? (q * cs - qo * sn) : (qo * sn + q * cs);
                const float kr = (i < 32) ? (k * cs - ko * sn) : (ko * sn + k * cs);
                float* rec = RECT + ((size_t)t * 4 + h) * 192;
                rec[i] = qr; rec[64 + i] = kr * 0.125f; rec[128 + i] = v;
            }
        }
        __syncthreads();
    }
}

DEVI void scan_rwkv(const P& p, int item, char* smem) {
    const float* REC = (const float*)(p.ws + WS_RECR); float* YR = (float*)(p.ws + WS_YR);
    float* L = (float*)smem;
    const int h = item >> 2, rg = item & 3;
    const int tid = threadIdx.x, lane = tid & 63, w = tid >> 6, sub = lane & 15;
    const int i = rg * 16 + w * 4 + (lane >> 4);
    float s0 = 0.f, s1 = 0.f, s2 = 0.f, s3 = 0.f;
    for (int c0 = 0; c0 < S; c0 += 32) {
        for (int idx = tid; idx < 32 * 96; idx += NT) {
            const int tok = idx / 96, f4 = idx % 96;
            ((f32x4*)L)[idx] = *(const f32x4*)(REC + ((size_t)(c0 + tok) * 4 + h) * 384 + f4 * 4);
        }
        __syncthreads();
        for (int tt = 0; tt < 32; ++tt) {
            const float* R = L + tt * 384;
            const f32x4 a = *(const f32x4*)(R + sub * 4), wv = *(const f32x4*)(R + 64 + sub * 4), b = *(const f32x4*)(R + 128 + sub * 4);
            const f32x4 k = *(const f32x4*)(R + 192 + sub * 4), r = *(const f32x4*)(R + 256 + sub * 4);
            const float v = R[320 + i];
            const float sa = row16_sum(s0 * a.x + s1 * a.y + s2 * a.z + s3 * a.w);
            s0 = s0 * wv.x + sa * b.x + v * k.x; s1 = s1 * wv.y + sa * b.y + v * k.y;
            s2 = s2 * wv.z + sa * b.z + v * k.z; s3 = s3 * wv.w + sa * b.w + v * k.w;
            const float y = row16_sum(s0 * r.x + s1 * r.y + s2 * r.z + s3 * r.w);
            if (sub == 0) YR[(size_t)(c0 + tt) * 256 + h * 64 + i] = y;
        }
        __syncthreads();
    }
}
DEVI void scan_gdn(const P& p, int item, char* smem) {
    const float* REC = (const float*)(p.ws + WS_RECG); float* OG = (float*)(p.ws + WS_OG);
    float* L = (float*)smem;
    const int h = item >> 3, eg = item & 7;
    const int tid = threadIdx.x, lane = tid & 63, w = tid >> 6, sub = lane & 15;
    const int e = eg * 16 + w * 4 + (lane >> 4);
    float s[8];
#pragma unroll
    for (int j = 0; j < 8; ++j) s[j] = 0.f;
    for (int c0 = 0; c0 < S; c0 += 32) {
        for (int idx = tid; idx < 32 * 98; idx += NT) {
            const int tok = idx / 98, f4 = idx % 98;
            ((f32x4*)L)[idx] = *(const f32x4*)(REC + ((size_t)(c0 + tok) * 4 + h) * 392 + f4 * 4);
        }
        __syncthreads();
        for (int tt = 0; tt < 32; ++tt) {
            const float* R = L + tt * 392;
            const f32x4 q0 = *(const f32x4*)(R + sub * 8), q1 = *(const f32x4*)(R + sub * 8 + 4);
            const f32x4 k0 = *(const f32x4*)(R + 128 + sub * 8), k1 = *(const f32x4*)(R + 128 + sub * 8 + 4);
            const float v = R[256 + e], dec = R[384], beta = R[385];
#pragma unroll
            for (int j = 0; j < 8; ++j) s[j] *= dec;
            const float kS = row16_sum(s[0] * k0.x + s[1] * k0.y + s[2] * k0.z + s[3] * k0.w + s[4] * k1.x + s[5] * k1.y + s[6] * k1.z + s[7] * k1.w);
            const float cf = beta * (v - kS);
            s[0] += cf * k0.x; s[1] += cf * k0.y; s[2] += cf * k0.z; s[3] += cf * k0.w;
            s[4] += cf * k1.x; s[5] += cf * k1.y; s[6] += cf * k1.z; s[7] += cf * k1.w;
            const float o = row16_sum(s[0] * q0.x + s[1] * q0.y + s[2] * q0.z + s[3] * q0.w + s[4] * q1.x + s[5] * q1.y + s[6] * q1.z + s[7] * q1.w);
            if (sub == 0) OG[(size_t)(c0 + tt) * 512 + h * 128 + e] = o;
        }
        __syncthreads();
    }
}
DEVI void scan_ret(const P& p, int item, char* smem) {
    const float* REC = (const float*)(p.ws + WS_RECT); float* ORT = (float*)(p.ws + WS_ORT);
    float* L = (float*)smem;
    const int h = item >> 2, eg = item & 3;
    const int tid = threadIdx.x, lane = tid & 63, w = tid >> 6, sub = lane & 15;
    const int e = eg * 16 + w * 4 + (lane >> 4);
    const float gam = 1.f - exp2f(-5.f - (float)h);
    float s0 = 0.f, s1 = 0.f, s2 = 0.f, s3 = 0.f;
    for (int c0 = 0; c0 < S; c0 += 32) {
        for (int idx = tid; idx < 32 * 48; idx += NT) {
            const int tok = idx / 48, f4 = idx % 48;
            ((f32x4*)L)[idx] = *(const f32x4*)(REC + ((size_t)(c0 + tok) * 4 + h) * 192 + f4 * 4);
        }
        __syncthreads();
        for (int tt = 0; tt < 32; ++tt) {
            const float* R = L + tt * 192;
            const f32x4 q = *(const f32x4*)(R + sub * 4), k = *(const f32x4*)(R + 64 + sub * 4);
            const float v = R[128 + e];
            s0 = s0 * gam + k.x * v; s1 = s1 * gam + k.y * v; s2 = s2 * gam + k.z * v; s3 = s3 * gam + k.w * v;
            const float o = row16_sum(s0 * q.x + s1 * q.y + s2 * q.z + s3 * q.w);
            if (sub == 0) ORT[(size_t)(c0 + tt) * 256 + h * 64 + e] = o;
        }
        __syncthreads();
    }
}
DEVI bf16x8 ldfrag(const bf16* base, int ld, int row0, int k0, int lane) {
    return *(const bf16x8*)(base + (row0 + (lane & 15)) * ld + k0 + (lane >> 4) * 8);
}
DEVI f32x4 ld_bf4(const bf16* p) {
    const u32x2 v = *(const u32x2*)p;
    return (f32x4){__uint_as_float(v.x << 16), __uint_as_float(v.x & 0xffff0000u), __uint_as_float(v.y << 16), __uint_as_float(v.y & 0xffff0000u)};
}
DEVI float quad_sum(float v) { v += __shfl_xor(v, 16); v += __shfl_xor(v, 32); return v; }
DEVI f32x4 mfma16(bf16x8 a, bf16x8 b, f32x4 c) { return __builtin_amdgcn_mfma_f32_16x16x32_bf16(a, b, c, 0, 0, 0); }

DEVI void retA_item(const P& p, int item, char* smem) {
    const float* REC = (const float*)(p.ws + WS_RECT); float* KV = (float*)(p.ws + WS_RKV);
    bf16* KT = (bf16*)smem; bf16* VT = KT + 64 * 72;
    const int n = item >> 2, h = item & 3;
    int tid = threadIdx.x; asm volatile("" : "+v"(tid));
    const int lane = tid & 63, w = tid >> 6, fr = lane & 15, fq = lane >> 4;
    const float lg = log2f(1.f - exp2f(-5.f - (float)h));
    {
        const int d = lane;
        unsigned kp[8], vp[8];
#pragma unroll
        for (int i = 0; i < 8; ++i) {
            const int c0 = 16 * w + 2 * i;
            const float* r0 = REC + ((size_t)(n * 64 + c0) * 4 + h) * 192;
            const float* r1 = r0 + 4 * 192;
            kp[i] = pk2(r0[64 + d] * exp2f((float)(63 - c0) * lg), r1[64 + d] * exp2f((float)(62 - c0) * lg));
            vp[i] = pk2(r0[128 + d], r1[128 + d]);
        }
        *(u32x4*)(KT + d * 72 + 16 * w) = (u32x4){kp[0], kp[1], kp[2], kp[3]};
        *(u32x4*)(KT + d * 72 + 16 * w + 8) = (u32x4){kp[4], kp[5], kp[6], kp[7]};
        *(u32x4*)(VT + d * 72 + 16 * w) = (u32x4){vp[0], vp[1], vp[2], vp[3]};
        *(u32x4*)(VT + d * 72 + 16 * w + 8) = (u32x4){vp[4], vp[5], vp[6], vp[7]};
    }
    __syncthreads();
    {
        const int dt = w;
        const bf16x8 a0 = ldfrag(KT, 72, 16 * dt, 0, lane), a1 = ldfrag(KT, 72, 16 * dt, 32, lane);
        float* out = KV + (size_t)item * 4096;
        const int s_ = dt >> 1, lane2 = 16 * (2 * (dt & 1) + (fq >> 1)) + fr;
#pragma unroll
        for (int et = 0; et < 4; ++et) {
            f32x4 acc = {0.f, 0.f, 0.f, 0.f};
            acc = mfma16(a0, ldfrag(VT, 72, 16 * et, 0, lane), acc);
            acc = mfma16(a1, ldfrag(VT, 72, 16 * et, 32, lane), acc);
            *(f32x4*)(out + ((et * 2 + s_) * 64 + lane2) * 8 + 4 * (fq & 1)) = acc;
        }
    }
    __syncthreads();
}

DEVI void retS_item(const P& p, int item) {
    const float* KV = (const float*)(p.ws + WS_RKV); bf16* RST = (bf16*)(p.ws + WS_RST);
    const int idx = item * NT + threadIdx.x;
    const int h = idx >> 12, i = idx & 4095;
    const float cd = exp2f(64.f * log2f(1.f - exp2f(-5.f - (float)h)));
    float r = 0.f;
#pragma unroll 8
    for (int n = 0; n < 256; ++n) {
        const float kv = KV[((size_t)n * 4 + h) * 4096 + i];
        RST[((size_t)n * 4 + h) * 4096 + i] = (bf16)f2bf(r);
        r = r * cd + kv;
    }
}

DEVI void retC_item(const P& p, int item, int l, char* smem) {
    const float* REC = (const float*)(p.ws + WS_RECT); const bf16* RST = (const bf16*)(p.ws + WS_RST);
    const bf16* PROJ = (const bf16*)(p.ws + WS_PROJ); bf16* MIX = (bf16*)(p.ws + WS_MIX);
    const float* rgn = p.in[25] + l * 256; const float* rbn = p.in[26] + l * 256;
    bf16* Qs = (bf16*)smem; bf16* Ks = Qs + 64 * 72; bf16* VT = Ks + 64 * 72; bf16* Ps = VT + 64 * 72;
    const int n = item >> 2, h = item & 3;
    int tid = threadIdx.x; asm volatile("" : "+v"(tid));
    const int lane = tid & 63, w = tid >> 6, fr = lane & 15, fq = lane >> 4;
    const float lg = log2f(1.f - exp2f(-5.f - (float)h));
    {
        const int d = lane;
        unsigned vp[8];
#pragma unroll
        for (int i = 0; i < 8; ++i) {
            const int c0 = 16 * w + 2 * i;
            const float* r0 = REC + ((size_t)(n * 64 + c0) * 4 + h) * 192;
            const float* r1 = r0 + 4 * 192;
            Qs[c0 * 72 + d] = (bf16)f2bf(r0[d]); Qs[(c0 + 1) * 72 + d] = (bf16)f2bf(r1[d]);
            Ks[c0 * 72 + d] = (bf16)f2bf(r0[64 + d]); Ks[(c0 + 1) * 72 + d] = (bf16)f2bf(r1[64 + d]);
            vp[i] = pk2(r0[128 + d], r1[128 + d]);
        }
        *(u32x4*)(VT + d * 72 + 16 * w) = (u32x4){vp[0], vp[1], vp[2], vp[3]};
        *(u32x4*)(VT + d * 72 + 16 * w + 8) = (u32x4){vp[4], vp[5], vp[6], vp[7]};
    }
    __syncthreads();
    const int ct = w, c = 16 * ct + fr;
    const bf16x8 q0 = ldfrag(Qs, 72, 16 * ct, 0, lane), q1 = ldfrag(Qs, 72, 16 * ct, 32, lane);
#pragma unroll
    for (int ct2 = 0; ct2 < 4; ++ct2) {
        f32x4 acc = {0.f, 0.f, 0.f, 0.f};
        acc = mfma16(ldfrag(Ks, 72, 16 * ct2, 0, lane), q0, acc);
        acc = mfma16(ldfrag(Ks, 72, 16 * ct2, 32, lane), q1, acc);
        float pv[4];
#pragma unroll
        for (int j = 0; j < 4; ++j) {
            const int c2 = 16 * ct2 + 4 * fq + j;
            pv[j] = (c >= c2) ? acc[j] * exp2f((float)(c - c2) * lg) : 0.f;
        }
        *(u32x2*)(Ps + c * 72 + 16 * ct2 + 4 * fq) = (u32x2){pk2(pv[0], pv[1]), pk2(pv[2], pv[3])};
    }
    __syncthreads();
    {
        const bf16x8 p0 = ldfrag(Ps, 72, 16 * ct, 0, lane), p1 = ldfrag(Ps, 72, 16 * ct, 32, lane);
        const float xi = exp2f((float)(c + 1) * lg);
        const bf16* RF = RST + (size_t)item * 4096;
        f32x4 o[4];
        float sm = 0.f;
#pragma unroll
        for (int et = 0; et < 4; ++et) {
            f32x4 ai = {0.f, 0.f, 0.f, 0.f}, ax = {0.f, 0.f, 0.f, 0.f};
            ai = mfma16(ldfrag(VT, 72, 16 * et, 0, lane), p0, ai);
            ai = mfma16(ldfrag(VT, 72, 16 * et, 32, lane), p1, ai);
            const bf16x8 r0 = *(const bf16x8*)(RF + ((et * 2 + 0) * 64 + lane) * 8);
            const bf16x8 r1 = *(const bf16x8*)(RF + ((et * 2 + 1) * 64 + lane) * 8);
            ax = mfma16(r0, q0, ax);
            ax = mfma16(r1, q1, ax);
            o[et] = ai + ax * xi;
            sm += (o[et].x + o[et].y) + (o[et].z + o[et].w);
        }
        const float mean = quad_sum(sm) * (1.f / 64.f);
        float sv = 0.f;
#pragma unroll
        for (int et = 0; et < 4; ++et) { o[et] = o[et] - mean; sv += o[et].x * o[et].x + o[et].y * o[et].y + o[et].z * o[et].z + o[et].w * o[et].w; }
        const float rs = rsqrtf(quad_sum(sv) * (1.f / 64.f) + 1e-5f);
        const int t = n * 64 + c;
#pragma unroll
        for (int et = 0; et < 4; ++et) {
            const int e = h * 64 + 16 * et + 4 * fq;
            const f32x4 g = *(const f32x4*)(rgn + e), b = *(const f32x4*)(rbn + e);
            const f32x4 gt = ld_bf4(PROJ + (size_t)t * NPROJ + 3840 + e);
            const f32x4 y = o[et] * rs * g + b;
            *(u32x2*)(MIX + (size_t)t * D + 768 + e) = (u32x2){pk2(y.x * siluf_(gt.x), y.y * siluf_(gt.y)), pk2(y.z * siluf_(gt.z), y.w * siluf_(gt.w))};
        }
    }
    __syncthreads();
}

template <int I, int N> struct SolveRow {
    static DEVI void run(float (&x)[N], const float* M) {
        float s = 0.f;
#pragma unroll
        for (int j4 = 0; j4 < (I + 3) / 4; ++j4) {
            const f32x4 m = *(const f32x4*)(M + I * N + 4 * j4);
            s += m.x * x[4 * j4] + m.y * x[4 * j4 + 1] + m.z * x[4 * j4 + 2] + m.w * x[4 * j4 + 3];
        }
        x[I] -= s;
        asm volatile("" : "+v"(x[I]) :: "memory");
        SolveRow<I + 1, N>::run(x, M);
    }
};
template <int N> struct SolveRow<N, N> { static DEVI void run(float (&)[N], const float*) {} };

DEVI void gdnA_item(const P& p, int item, char* smem) {
    const float* REC = (const float*)(p.ws + WS_RECG);
    bf16* GP = (bf16*)(p.ws + WS_GP) + (size_t)item * 16384; float* GB = (float*)(p.ws + WS_GB) + (size_t)item * 16384;
    float* GD = (float*)(p.ws + WS_GD);
    bf16* GQ = (bf16*)(p.ws + WS_GQ) + (size_t)item * 8192; float* GO = (float*)(p.ws + WS_GO) + (size_t)item * 8192;
    bf16* Kb = (bf16*)smem; bf16* Qb = Kb + 64 * 136;
    bf16* WT = (bf16*)smem; bf16* UT = WT + 128 * 72;
    bf16* Vb = (bf16*)(smem + 36864);
    float* M = (float*)(smem + 36864);
    bf16* KdT = (bf16*)(smem + 36864);
    bf16* At = (bf16*)(smem + 55296);
    float* gcs = (float*)(smem + 64512); float* bts = gcs + 64; float* sws = gcs + 128; float* sks = gcs + 192;
    const int n = item >> 2, h = item & 3;
    int tid = threadIdx.x; asm volatile("" : "+v"(tid));
    const int lane = tid & 63, w = tid >> 6, fr = lane & 15, fq = lane >> 4;
    const float* rec0 = REC + ((size_t)(n * 64) * 4 + h) * 392;
    if (w == 0) {
        float x = rec0[(size_t)lane * 1568 + 386];
#pragma unroll
        for (int off = 1; off < 64; off <<= 1) { const float y = __shfl_up(x, off); if (lane >= off) x += y; }
        const float bt = rec0[(size_t)lane * 1568 + 385];
        gcs[lane] = x; bts[lane] = bt; sws[lane] = bt * __expf(x); sks[lane] = __expf(__shfl(x, 63) - x);
    }
#pragma unroll 2
    for (int i = 0; i < 16; ++i) {
        const int c = 16 * w + i;
        const float* r = rec0 + (size_t)c * 1568;
        Qb[c * 136 + lane] = (bf16)f2bf(r[lane]); Qb[c * 136 + 64 + lane] = (bf16)f2bf(r[64 + lane]);
        Kb[c * 136 + lane] = (bf16)f2bf(r[128 + lane]); Kb[c * 136 + 64 + lane] = (bf16)f2bf(r[192 + lane]);
        Vb[c * 136 + lane] = (bf16)f2bf(r[256 + lane]); Vb[c * 136 + 64 + lane] = (bf16)f2bf(r[320 + lane]);
    }
    __syncthreads();
    float x[64];
    unsigned kdp[16];
    {
        const int col = tid & 127;
        int sel_b = (tid < 128) ? 36864 : 0, sel_s = (tid < 128) ? 64 : 128;
        asm volatile("" : "+v"(sel_b), "+v"(sel_s));
        const bf16* srcb = (const bf16*)(smem + sel_b) + col;
        const float* scs = gcs + sel_s;
#pragma unroll
        for (int c = 0; c < 64; ++c) {
            x[c] = scs[c] * bf2f(srcb[c * 136]);
            if ((c & 7) == 7) asm volatile("" : "+v"(x[c]) :: "memory");
        }
        const int half = tid >> 7;
#pragma unroll
        for (int i = 0; i < 16; ++i) {
            const int c = 32 * half + 2 * i;
            kdp[i] = pk2(bf2f(Kb[c * 136 + col]) * sks[c], bf2f(Kb[(c + 1) * 136 + col]) * sks[c + 1]);
            if ((i & 3) == 3) asm volatile("" : "+v"(kdp[i]) :: "memory");
        }
        if (tid == 0) GD[item] = __expf(gcs[63]);
    }
    __syncthreads();
    const int ct = w;
    f32x4 accQ[8];
    {
        const int c = 16 * ct + fr;
        const float gcc = gcs[c];
        {
            bf16x8 ka[4];
#pragma unroll
            for (int s = 0; s < 4; ++s) ka[s] = ldfrag(Kb, 136, 16 * ct, 32 * s, lane);
#pragma unroll
            for (int ct2 = 0; ct2 < 4; ++ct2) {
                f32x4 acc = {0.f, 0.f, 0.f, 0.f};
#pragma unroll
                for (int s = 0; s < 4; ++s) acc = mfma16(ka[s], ldfrag(Kb, 136, 16 * ct2, 32 * s, lane), acc);
                const int c2 = 16 * ct2 + fr; const float g2 = gcs[c2];
#pragma unroll
                for (int j = 0; j < 4; ++j) {
                    const int cc = 16 * ct + 4 * fq + j;
                    M[cc * 64 + c2] = (cc > c2) ? bts[cc] * acc[j] * __expf(gcs[cc] - g2) : 0.f;
                }
            }
        }
        {
            bf16x8 qa[4];
#pragma unroll
            for (int s = 0; s < 4; ++s) qa[s] = ldfrag(Qb, 136, 16 * ct, 32 * s, lane);
#pragma unroll
            for (int ct2 = 0; ct2 < 4; ++ct2) {
                f32x4 acc = {0.f, 0.f, 0.f, 0.f};
#pragma unroll
                for (int s = 0; s < 4; ++s) acc = mfma16(ldfrag(Kb, 136, 16 * ct2, 32 * s, lane), qa[s], acc);
                float pv[4];
#pragma unroll
                for (int j = 0; j < 4; ++j) { const int c2 = 16 * ct2 + 4 * fq + j; pv[j] = (c >= c2) ? acc[j] * __expf(gcc - gcs[c2]) : 0.f; }
                *(u32x2*)(At + c * 72 + 16 * ct2 + 4 * fq) = (u32x2){pk2(pv[0], pv[1]), pk2(pv[2], pv[3])};
            }
        }
        const float eg = __expf(gcc);
#pragma unroll
        for (int dt = 0; dt < 8; ++dt) {
            const u32x2 qv = *(const u32x2*)(Qb + c * 136 + 16 * dt + 4 * fq);
            accQ[dt] = (f32x4){-eg * __uint_as_float(qv.x << 16), -eg * __uint_as_float(qv.x & 0xffff0000u),
                               -eg * __uint_as_float(qv.y << 16), -eg * __uint_as_float(qv.y & 0xffff0000u)};
        }
    }
    __syncthreads();
    {
        SolveRow<1, 64>::run(x, M);
        int sel_d = (tid < 128) ? 128 * 72 : 0;
        asm volatile("" : "+v"(sel_d));
        bf16* dst = WT + sel_d + (tid & 127) * 72;
#pragma unroll
        for (int q = 0; q < 8; ++q)
            *(u32x4*)(dst + 8 * q) = (u32x4){pk2(x[8 * q], x[8 * q + 1]), pk2(x[8 * q + 2], x[8 * q + 3]), pk2(x[8 * q + 4], x[8 * q + 5]), pk2(x[8 * q + 6], x[8 * q + 7])};
    }
    __syncthreads();
    {
        const int d = tid & 127, half = tid >> 7;
#pragma unroll
        for (int q = 0; q < 4; ++q) *(u32x4*)(KdT + d * 72 + 32 * half + 8 * q) = (u32x4){kdp[4 * q], kdp[4 * q + 1], kdp[4 * q + 2], kdp[4 * q + 3]};
    }
    __syncthreads();
    {
#pragma unroll 1
        for (int mi = 0; mi < 2; ++mi) {
            const int mt = 2 * w + mi;
            const bf16x8 kd0 = ldfrag(KdT, 72, 16 * mt, 0, lane), kd1 = ldfrag(KdT, 72, 16 * mt, 32, lane);
#pragma unroll
            for (int sp = 0; sp < 4; ++sp) {
                f32x4 a0 = {0.f, 0.f, 0.f, 0.f}, a1 = {0.f, 0.f, 0.f, 0.f};
                a0 = mfma16(ldfrag(WT, 72, 32 * sp, 0, lane), kd0, a0); a0 = mfma16(ldfrag(WT, 72, 32 * sp, 32, lane), kd1, a0);
                a1 = mfma16(ldfrag(WT, 72, 32 * sp + 16, 0, lane), kd0, a1); a1 = mfma16(ldfrag(WT, 72, 32 * sp + 16, 32, lane), kd1, a1);
                *(u32x4*)(GP + ((mt * 4 + sp) * 64 + lane) * 8) = (u32x4){pk2(-a0.x, -a0.y), pk2(-a0.z, -a0.w), pk2(-a1.x, -a1.y), pk2(-a1.z, -a1.w)};
            }
#pragma unroll
            for (int nt = 0; nt < 8; ++nt) {
                f32x4 a = {0.f, 0.f, 0.f, 0.f};
                a = mfma16(kd0, ldfrag(UT, 72, 16 * nt, 0, lane), a); a = mfma16(kd1, ldfrag(UT, 72, 16 * nt, 32, lane), a);
                *(f32x4*)(GB + ((nt * 8 + mt) * 64 + lane) * 4) = a;
            }
        }
        const bf16x8 at0 = ldfrag(At, 72, 16 * ct, 0, lane), at1 = ldfrag(At, 72, 16 * ct, 32, lane);
#pragma unroll
        for (int sp = 0; sp < 4; ++sp) {
            f32x4 a0 = accQ[2 * sp], a1 = accQ[2 * sp + 1];
            a0 = mfma16(ldfrag(WT, 72, 32 * sp, 0, lane), at0, a0); a0 = mfma16(ldfrag(WT, 72, 32 * sp, 32, lane), at1, a0);
            a1 = mfma16(ldfrag(WT, 72, 32 * sp + 16, 0, lane), at0, a1); a1 = mfma16(ldfrag(WT, 72, 32 * sp + 16, 32, lane), at1, a1);
            *(u32x4*)(GQ + ((ct * 4 + sp) * 64 + lane) * 8) = (u32x4){pk2(-a0.x, -a0.y), pk2(-a0.z, -a0.w), pk2(-a1.x, -a1.y), pk2(-a1.z, -a1.w)};
        }
#pragma unroll
        for (int et = 0; et < 8; ++et) {
            f32x4 a = {0.f, 0.f, 0.f, 0.f};
            a = mfma16(ldfrag(UT, 72, 16 * et, 0, lane), at0, a); a = mfma16(ldfrag(UT, 72, 16 * et, 32, lane), at1, a);
            *(f32x4*)(GO + ((ct * 8 + et) * 64 + lane) * 4) = a;
        }
    }
    __syncthreads();
}

DEVI bf16x8 pack_frag(const f32x4& a, const f32x4& b) {
    const u32x4 v = {pk2(a.x, a.y), pk2(a.z, a.w), pk2(b.x, b.y), pk2(b.z, b.w)};
    return __builtin_bit_cast(bf16x8, v);
}
DEVI void gdnL1_item(const P& p, int item) {
    const bf16* GP = (const bf16*)(p.ws + WS_GP); const float* GB = (const float*)(p.ws + WS_GB); const float* GD = (const float*)(p.ws + WS_GD);
    const int half = item & 1, kind = (item >> 1) & 1, g = (item >> 2) & 15, h = item >> 6;
    const int lane = threadIdx.x & 63, ew = half * 4 + (threadIdx.x >> 6), fr = lane & 15, fq = lane >> 4;
    f32x4 acc[8];
    if (kind == 0) {
        bf16* GS = (bf16*)(p.ws + WS_GS);
#pragma unroll
        for (int m = 0; m < 8; ++m) acc[m] = (f32x4){0.f, 0.f, 0.f, 0.f};
#pragma unroll 1
        for (int n = g * 16; n < g * 16 + 16; ++n) {
            const size_t it = (size_t)n * 4 + h;
            const bf16* Pn = GP + it * 16384 + lane * 8; const float* Bn = GB + it * 16384 + (ew * 8 * 64 + lane) * 4;
            bf16x8 pf[32]; f32x4 bfr[8];
#pragma unroll
            for (int i = 0; i < 32; ++i) pf[i] = *(const bf16x8*)(Pn + i * 512);
#pragma unroll
            for (int m = 0; m < 8; ++m) bfr[m] = *(const f32x4*)(Bn + m * 256);
            const float dn = GD[it];
            asm volatile("" ::: "memory");
            bf16x8 sf[4];
#pragma unroll
            for (int s = 0; s < 4; ++s) {
                sf[s] = pack_frag(acc[2 * s], acc[2 * s + 1]);
                *(bf16x8*)(GS + it * 16384 + ((ew * 4 + s) * 64 + lane) * 8) = sf[s];
            }
#pragma unroll
            for (int m = 0; m < 8; ++m) {
                f32x4 a = acc[m] * dn + bfr[m];
#pragma unroll
                for (int s = 0; s < 4; ++s) a = mfma16(pf[m * 4 + s], sf[s], a);
                acc[m] = a;
            }
        }
        float* E0 = (float*)(p.ws + WS_GE0) + (size_t)(h * 16 + g) * 16384 + (ew * 8 * 64 + lane) * 4;
#pragma unroll
        for (int m = 0; m < 8; ++m) *(f32x4*)(E0 + m * 256) = acc[m];
    } else {
        const bf16* GQ = (const bf16*)(p.ws + WS_GQ); bf16* GR = (bf16*)(p.ws + WS_GR);
#pragma unroll
        for (int m = 0; m < 8; ++m)
#pragma unroll
            for (int j = 0; j < 4; ++j) acc[m][j] = (m == ew && 4 * fq + j == fr) ? 1.f : 0.f;
#pragma unroll 1
        for (int n = g * 16; n < g * 16 + 16; ++n) {
            const size_t it = (size_t)n * 4 + h;
            const bf16* Pn = GP + it * 16384 + lane * 8;
            bf16x8 pf[32];
#pragma unroll
            for (int i = 0; i < 32; ++i) pf[i] = *(const bf16x8*)(Pn + i * 512);
            const float dn = GD[it];
            bf16x8 qf[16];
#pragma unroll
            for (int i = 0; i < 16; ++i) qf[i] = *(const bf16x8*)(GQ + it * 8192 + (i * 64 + lane) * 8);
            asm volatile("" ::: "memory");
            bf16x8 tf[4];
#pragma unroll
            for (int s = 0; s < 4; ++s) tf[s] = pack_frag(acc[2 * s], acc[2 * s + 1]);
#pragma unroll
            for (int tt = 0; tt < 4; ++tt) {
                f32x4 r = {0.f, 0.f, 0.f, 0.f};
#pragma unroll
                for (int s = 0; s < 4; ++s) r = mfma16(tf[s], qf[tt * 4 + s], r);
                *(u32x2*)(GR + it * 8192 + ((tt * 4 + (ew >> 1)) * 64 + lane) * 8 + 4 * (ew & 1)) = (u32x2){pk2(r.x, r.y), pk2(r.z, r.w)};
            }
#pragma unroll
            for (int m = 0; m < 8; ++m) {
                f32x4 a = acc[m] * dn;
#pragma unroll
                for (int s = 0; s < 4; ++s) a = mfma16(pf[m * 4 + s], tf[s], a);
                acc[m] = a;
            }
        }
        bf16* TE = (bf16*)(p.ws + WS_GTE) + (size_t)(h * 16 + g) * 16384;
        const int s_ = ew >> 1, jj = 4 * (ew & 1) + (fr & 3), lg = fr >> 2;
#pragma unroll
        for (int m = 0; m < 8; ++m)
#pragma unroll
            for (int j = 0; j < 4; ++j) TE[((m * 4 + s_) * 64 + (4 * fq + j) + 16 * lg) * 8 + jj] = (bf16)f2bf(acc[m][j]);
    }
}
DEVI void gdnL2_item(const P& p, int item) {
    const bf16* TE = (const bf16*)(p.ws + WS_GTE); const float* E0 = (const float*)(p.ws + WS_GE0); bf16* SG = (bf16*)(p.ws + WS_GSG);
    const int h = item >> 1, lane = threadIdx.x & 63, ew = (item & 1) * 4 + (threadIdx.x >> 6);
    f32x4 acc[8];
#pragma unroll
    for (int m = 0; m < 8; ++m) acc[m] = (f32x4){0.f, 0.f, 0.f, 0.f};
#pragma unroll 1
    for (int g = 0; g < 16; ++g) {
        const size_t hg = (size_t)h * 16 + g;
        const bf16* Tn = TE + hg * 16384 + lane * 8; const float* En = E0 + hg * 16384 + (ew * 8 * 64 + lane) * 4;
        bf16x8 pf[32]; f32x4 bfr[8];
#pragma unroll
        for (int i = 0; i < 32; ++i) pf[i] = *(const bf16x8*)(Tn + i * 512);
#pragma unroll
        for (int m = 0; m < 8; ++m) bfr[m] = *(const f32x4*)(En + m * 256);
        asm volatile("" ::: "memory");
        bf16x8 sf[4];
#pragma unroll
        for (int s = 0; s < 4; ++s) {
            sf[s] = pack_frag(acc[2 * s], acc[2 * s + 1]);
            *(bf16x8*)(SG + hg * 16384 + ((ew * 4 + s) * 64 + lane) * 8) = sf[s];
        }
#pragma unroll
        for (int m = 0; m < 8; ++m) {
            f32x4 a = bfr[m];
#pragma unroll
            for (int s = 0; s < 4; ++s) a = mfma16(pf[m * 4 + s], sf[s], a);
            acc[m] = a;
        }
    }
}

DEVI void gdnC_item(const P& p, int item, int l) {
    const bf16* GQ = (const bf16*)(p.ws + WS_GQ) + (size_t)item * 8192; const float* GO = (const float*)(p.ws + WS_GO) + (size_t)item * 8192;
    const bf16* GS = (const bf16*)(p.ws + WS_GS) + (size_t)item * 16384;
    const bf16* PROJ = (const bf16*)(p.ws + WS_PROJ); bf16* MIX = (bf16*)(p.ws + WS_MIX);
    const float* gn = p.in[24] + l * 128;
    const int n = item >> 2, h = item & 3;
    const int lane = threadIdx.x & 63, ct = threadIdx.x >> 6, fr = lane & 15, fq = lane >> 4;
    const bf16* GR = (const bf16*)(p.ws + WS_GR) + (size_t)item * 8192;
    const bf16* SG = (const bf16*)(p.ws + WS_GSG) + (size_t)(h * 16 + (n >> 4)) * 16384;
    bf16x8 qf[4], rf[4];
#pragma unroll
    for (int s = 0; s < 4; ++s) { qf[s] = *(const bf16x8*)(GQ + ((ct * 4 + s) * 64 + lane) * 8); rf[s] = *(const bf16x8*)(GR + ((ct * 4 + s) * 64 + lane) * 8); }
    const int t = n * 64 + 16 * ct + fr;
    f32x4 a[8];
    float ss = 0.f;
#pragma unroll
    for (int et = 0; et < 8; ++et) {
        f32x4 acc = *(const f32x4*)(GO + ((ct * 8 + et) * 64 + lane) * 4);
#pragma unroll
        for (int s = 0; s < 4; ++s) acc = mfma16(*(const bf16x8*)(GS + ((et * 4 + s) * 64 + lane) * 8), qf[s], acc);
#pragma unroll
        for (int s = 0; s < 4; ++s) acc = mfma16(*(const bf16x8*)(SG + ((et * 4 + s) * 64 + lane) * 8), rf[s], acc);
        a[et] = acc;
        ss += acc.x * acc.x + acc.y * acc.y + acc.z * acc.z + acc.w * acc.w;
    }
    const float rs = rsqrtf(quad_sum(ss) * (1.f / 128.f) + 1e-6f);
#pragma unroll
    for (int et = 0; et < 8; ++et) {
        const int e = 16 * et + 4 * fq;
        const f32x4 z = ld_bf4(PROJ + (size_t)t * NPROJ + 2560 + h * 128 + e);
        const f32x4 g = *(const f32x4*)(gn + e);
        const f32x4 o = a[et] * rs * g;
        *(u32x2*)(MIX + (size_t)t * D + 256 + h * 128 + e) = (u32x2){pk2(o.x * siluf_(z.x), o.y * siluf_(z.y)), pk2(o.z * siluf_(z.z), o.w * siluf_(z.w))};
    }
}

DEVI void rwkA_item(const P& p, int item, char* smem) {
    const float* REC = (const float*)(p.ws + WS_RECR);
    bf16* WP = (bf16*)(p.ws + WS_WP) + (size_t)item * 4096; float* WC = (float*)(p.ws + WS_WC) + (size_t)item * 4096;
    float* WD = (float*)(p.ws + WS_WD) + (size_t)item * 64;
    bf16* WQ = (bf16*)(p.ws + WS_WQ) + (size_t)item * 2048; float* WY = (float*)(p.ws + WS_WY) + (size_t)item * 2048;
    bf16* At_ = (bf16*)smem; bf16* Rt = At_ + 32 * 72; bf16* Bt = Rt + 32 * 72; bf16* Kt = Bt + 32 * 72;
    float* ZT = (float*)(smem + 9216);
    bf16* BhT = (bf16*)(smem + 18432); bf16* KhT = BhT + 64 * 40; bf16* VT = KhT + 64 * 40; bf16* AhT = VT + 64 * 40; bf16* UhT = AhT + 64 * 40;
    float* M = (float*)(smem + 44032);
    bf16* Aak = (bf16*)(smem + 48128); bf16* Arb = Aak + 32 * 40; bf16* Ark = Arb + 32 * 40;
    float* tot = (float*)(smem + 55808);
    const int n = item >> 2, h = item & 3;
    int tid = threadIdx.x; asm volatile("" : "+v"(tid));
    const int lane = tid & 63, w = tid >> 6, fr = lane & 15, fq = lane >> 4;
    {
        const int d = lane;
        const float* rec = REC + ((size_t)(n * 32 + 8 * w) * 4 + h) * 384 + d;
        float lw[8], lg[8];
        float run = 0.f;
#pragma unroll
        for (int i = 0; i < 8; ++i) { lg[i] = __logf(rec[(size_t)i * 1536 + 64]); run += lg[i]; lw[i] = run; }
        tot[w * 64 + d] = run;
        __syncthreads();
        float off = 0.f, total = 0.f;
#pragma unroll
        for (int q = 0; q < 4; ++q) { const float tq = tot[q * 64 + d]; total += tq; off += (q < w) ? tq : 0.f; }
        unsigned bh[4], kh[4], vv[4];
        float pb = 0.f, pk = 0.f, pv = 0.f;
#pragma unroll
        for (int i = 0; i < 8; ++i) {
            const float* r = rec + (size_t)i * 1536;
            const float a = r[0], b = r[128], k = r[192], rr = r[256], v = r[320];
            const float lc = off + lw[i];
            const float cw = __expf(lc), cwm1 = __expf(lc - lg[i]), inv = __expf(-lc), rat = __expf(total - lc);
            const int t = 8 * w + i;
            At_[t * 72 + d] = (bf16)f2bf(a * cwm1); Rt[t * 72 + d] = (bf16)f2bf(rr * cw);
            Bt[t * 72 + d] = (bf16)f2bf(b * inv); Kt[t * 72 + d] = (bf16)f2bf(k * inv);
            if (i & 1) { bh[i >> 1] = pk2(pb, b * rat); kh[i >> 1] = pk2(pk, k * rat); vv[i >> 1] = pk2(pv, v); }
            else { pb = b * rat; pk = k * rat; pv = v; }
        }
        *(u32x4*)(BhT + d * 40 + 8 * w) = (u32x4){bh[0], bh[1], bh[2], bh[3]};
        *(u32x4*)(KhT + d * 40 + 8 * w) = (u32x4){kh[0], kh[1], kh[2], kh[3]};
        *(u32x4*)(VT + d * 40 + 8 * w) = (u32x4){vv[0], vv[1], vv[2], vv[3]};
        if (w == 0) WD[d] = __expf(total);
    }
    __syncthreads();
    {
        int offA = (w == 0) ? 0 : (w == 1 ? 3 : (w == 2 ? 2 : 3));
        int offB = (w == 0) ? 2 : (w == 1 ? 0 : 1);
        asm volatile("" : "+v"(offA), "+v"(offB));
        const bf16* As = At_ + offA * (32 * 72); const bf16* Bs = At_ + offB * (32 * 72);
#pragma unroll
        for (int ta = 0; ta < 2; ++ta) {
            const bf16x8 a0 = ldfrag(As, 72, 16 * ta, 0, lane), a1 = ldfrag(As, 72, 16 * ta, 32, lane);
#pragma unroll
            for (int tb = 0; tb < 2; ++tb) {
                f32x4 acc = {0.f, 0.f, 0.f, 0.f};
                acc = mfma16(a0, ldfrag(Bs, 72, 16 * tb, 0, lane), acc);
                acc = mfma16(a1, ldfrag(Bs, 72, 16 * tb, 32, lane), acc);
                if (w == 0) {
                    const int s_ = 16 * tb + fr;
#pragma unroll
                    for (int j = 0; j < 4; ++j) { const int t = 16 * ta + 4 * fq + j; M[t * 32 + s_] = (t > s_) ? -acc[j] : 0.f; }
                } else {
                    const int t = 16 * tb + fr;
                    float pv4[4];
#pragma unroll
                    for (int j = 0; j < 4; ++j) { const int s_ = 16 * ta + 4 * fq + j; pv4[j] = ((w == 1) ? (t > s_) : (t >= s_)) ? acc[j] : 0.f; }
                    int offD = w - 1; asm volatile("" : "+v"(offD));
                    *(u32x2*)(Aak + offD * (32 * 40) + t * 40 + 16 * ta + 4 * fq) = (u32x2){pk2(pv4[0], pv4[1]), pk2(pv4[2], pv4[3])};
                }
            }
        }
    }
    __syncthreads();
    {
        const int et = w;
        const bf16x8 vf = ldfrag(VT, 40, 16 * et, 0, lane);
#pragma unroll
        for (int tt = 0; tt < 2; ++tt) {
            f32x4 acc = {0.f, 0.f, 0.f, 0.f};
            acc = mfma16(ldfrag(Aak, 40, 16 * tt, 0, lane), vf, acc);
            *(f32x4*)(ZT + (16 * et + fr) * 36 + 16 * tt + 4 * fq) = acc;
        }
    }
    __syncthreads();
    if (tid < 128) {
        float x[32];
        if (tid < 64) {
#pragma unroll
            for (int t = 0; t < 32; ++t) x[t] = bf2f(At_[t * 72 + tid]);
        } else {
#pragma unroll
            for (int q = 0; q < 8; ++q) { const f32x4 z = *(const f32x4*)(ZT + (tid - 64) * 36 + 4 * q); x[4 * q] = z.x; x[4 * q + 1] = z.y; x[4 * q + 2] = z.z; x[4 * q + 3] = z.w; }
        }
        SolveRow<1, 32>::run(x, M);
        bf16* dst = AhT + tid * 40;
#pragma unroll
        for (int q = 0; q < 4; ++q)
            *(u32x4*)(dst + 8 * q) = (u32x4){pk2(x[8 * q], x[8 * q + 1]), pk2(x[8 * q + 2], x[8 * q + 3]), pk2(x[8 * q + 4], x[8 * q + 5]), pk2(x[8 * q + 6], x[8 * q + 7])};
    }
    __syncthreads();
    {
        const int mt = w;
        const bf16x8 bh = ldfrag(BhT, 40, 16 * mt, 0, lane), kh = ldfrag(KhT, 40, 16 * mt, 0, lane);
#pragma unroll
        for (int sp = 0; sp < 2; ++sp) {
            f32x4 a0 = {0.f, 0.f, 0.f, 0.f}, a1 = {0.f, 0.f, 0.f, 0.f};
            a0 = mfma16(ldfrag(AhT, 40, 32 * sp, 0, lane), bh, a0);
            a1 = mfma16(ldfrag(AhT, 40, 32 * sp + 16, 0, lane), bh, a1);
            *(u32x4*)(WP + ((mt * 2 + sp) * 64 + lane) * 8) = (u32x4){pk2(a0.x, a0.y), pk2(a0.z, a0.w), pk2(a1.x, a1.y), pk2(a1.z, a1.w)};
        }
#pragma unroll
        for (int nt = 0; nt < 4; ++nt) {
            f32x4 a = {0.f, 0.f, 0.f, 0.f};
            a = mfma16(bh, ldfrag(UhT, 40, 16 * nt, 0, lane), a);
            a = mfma16(kh, ldfrag(VT, 40, 16 * nt, 0, lane), a);
            *(f32x4*)(WC + ((nt * 4 + mt) * 64 + lane) * 4) = a;
        }
        {
            const int ct = w & 1, sp = w >> 1, t = 16 * ct + fr;
            const bf16x8 ar = ldfrag(Arb, 40, 16 * ct, 0, lane);
            f32x4 a0 = ld_bf4(Rt + t * 72 + 32 * sp + 4 * fq), a1 = ld_bf4(Rt + t * 72 + 32 * sp + 16 + 4 * fq);
            a0 = mfma16(ldfrag(AhT, 40, 32 * sp, 0, lane), ar, a0);
            a1 = mfma16(ldfrag(AhT, 40, 32 * sp + 16, 0, lane), ar, a1);
            *(u32x4*)(WQ + ((ct * 2 + sp) * 64 + lane) * 8) = (u32x4){pk2(a0.x, a0.y), pk2(a0.z, a0.w), pk2(a1.x, a1.y), pk2(a1.z, a1.w)};
        }
        {
            const int et = w;
            const bf16x8 uf = ldfrag(UhT, 40, 16 * et, 0, lane), vf = ldfrag(VT, 40, 16 * et, 0, lane);
#pragma unroll
            for (int ct = 0; ct < 2; ++ct) {
                f32x4 a = {0.f, 0.f, 0.f, 0.f};
                a = mfma16(uf, ldfrag(Arb, 40, 16 * ct, 0, lane), a);
                a = mfma16(vf, ldfrag(Ark, 40, 16 * ct, 0, lane), a);
                *(f32x4*)(WY + ((ct * 4 + et) * 64 + lane) * 4) = a;
            }
        }
    }
    __syncthreads();
}

struct RwkStep { bf16x8 pf[8]; f32x4 cf[4]; f32x4 dv[4]; };
DEVI void rwk_load(RwkStep& r, const bf16* WP, const float* WC, const float* WD, size_t it, int ew, int lane) {
#pragma unroll
    for (int i = 0; i < 8; ++i) r.pf[i] = *(const bf16x8*)(WP + it * 4096 + (i * 64 + lane) * 8);
#pragma unroll
    for (int m = 0; m < 4; ++m) r.cf[m] = *(const f32x4*)(WC + it * 4096 + ((ew * 4 + m) * 64 + lane) * 4);
#pragma unroll
    for (int m = 0; m < 4; ++m) r.dv[m] = *(const f32x4*)(WD + it * 64 + 16 * m + 4 * (lane >> 4));
}
DEVI void rwk_step(const RwkStep& r, f32x4 (&acc)[4], bf16* WSF, size_t it, int ew, int lane) {
    bf16x8 sf[2];
#pragma unroll
    for (int s = 0; s < 2; ++s) {
        const u32x4 v = {pk2(acc[2 * s].x, acc[2 * s].y), pk2(acc[2 * s].z, acc[2 * s].w), pk2(acc[2 * s + 1].x, acc[2 * s + 1].y), pk2(acc[2 * s + 1].z, acc[2 * s + 1].w)};
        *(u32x4*)(WSF + it * 4096 + ((ew * 2 + s) * 64 + lane) * 8) = v;
        sf[s] = __builtin_bit_cast(bf16x8, v);
    }
#pragma unroll
    for (int m = 0; m < 4; ++m) {
        f32x4 a = acc[m] * r.dv[m] + r.cf[m];
        a = mfma16(r.pf[m * 2], sf[0], a);
        a = mfma16(r.pf[m * 2 + 1], sf[1], a);
        acc[m] = a;
    }
}
DEVI void rwkL1_item(const P& p, int item) {
    const bf16* WP = (const bf16*)(p.ws + WS_WP); const float* WC = (const float*)(p.ws + WS_WC); const float* WD = (const float*)(p.ws + WS_WD);
    const int kind = item & 1, g = (item >> 1) & 15, h = item >> 5;
    const int lane = threadIdx.x & 63, ew = threadIdx.x >> 6, fr = lane & 15, fq = lane >> 4;
    f32x4 acc[4];
    if (kind == 0) {
        bf16* WSF = (bf16*)(p.ws + WS_WS);
#pragma unroll
        for (int m = 0; m < 4; ++m) acc[m] = (f32x4){0.f, 0.f, 0.f, 0.f};
        RwkStep A, B;
        const int n0 = g * 32;
        rwk_load(A, WP, WC, WD, (size_t)n0 * 4 + h, ew, lane);
#pragma unroll 1
        for (int n = n0; n < n0 + 32; n += 2) {
            rwk_load(B, WP, WC, WD, (size_t)(n + 1) * 4 + h, ew, lane);
            asm volatile("" ::: "memory");
            rwk_step(A, acc, WSF, (size_t)n * 4 + h, ew, lane);
            rwk_load(A, WP, WC, WD, (size_t)((n + 2 < n0 + 32) ? n + 2 : n) * 4 + h, ew, lane);
            asm volatile("" ::: "memory");
            rwk_step(B, acc, WSF, (size_t)(n + 1) * 4 + h, ew, lane);
        }
        float* E0 = (float*)(p.ws + WS_WE0) + (size_t)(h * 16 + g) * 4096 + (ew * 4 * 64 + lane) * 4;
#pragma unroll
        for (int m = 0; m < 4; ++m) *(f32x4*)(E0 + m * 256) = acc[m];
    } else {
        const bf16* WQ = (const bf16*)(p.ws + WS_WQ); bf16* WR = (bf16*)(p.ws + WS_WR);
#pragma unroll
        for (int m = 0; m < 4; ++m)
#pragma unroll
            for (int j = 0; j < 4; ++j) acc[m][j] = (m == ew && 4 * fq + j == fr) ? 1.f : 0.f;
#pragma unroll 1
        for (int n = g * 32; n < g * 32 + 32; ++n) {
            const size_t it = (size_t)n * 4 + h;
            bf16x8 pf[8], qf[4]; f32x4 dv[4];
#pragma unroll
            for (int i = 0; i < 8; ++i) pf[i] = *(const bf16x8*)(WP + it * 4096 + (i * 64 + lane) * 8);
#pragma unroll
            for (int i = 0; i < 4; ++i) qf[i] = *(const bf16x8*)(WQ + it * 2048 + (i * 64 + lane) * 8);
#pragma unroll
            for (int m = 0; m < 4; ++m) dv[m] = *(const f32x4*)(WD + it * 64 + 16 * m + 4 * fq);
            asm volatile("" ::: "memory");
            bf16x8 tf[2];
#pragma unroll
            for (int s = 0; s < 2; ++s) tf[s] = pack_frag(acc[2 * s], acc[2 * s + 1]);
#pragma unroll
            for (int tt = 0; tt < 2; ++tt) {
                f32x4 r = {0.f, 0.f, 0.f, 0.f};
                r = mfma16(tf[0], qf[tt * 2], r); r = mfma16(tf[1], qf[tt * 2 + 1], r);
                *(u32x2*)(WR + it * 2048 + ((tt * 2 + (ew >> 1)) * 64 + lane) * 8 + 4 * (ew & 1)) = (u32x2){pk2(r.x, r.y), pk2(r.z, r.w)};
            }
#pragma unroll
            for (int m = 0; m < 4; ++m) {
                f32x4 a = acc[m] * dv[m];
                a = mfma16(pf[m * 2], tf[0], a); a = mfma16(pf[m * 2 + 1], tf[1], a);
                acc[m] = a;
            }
        }
        bf16* TE = (bf16*)(p.ws + WS_WTE) + (size_t)(h * 16 + g) * 4096;
        const int s_ = ew >> 1, jj = 4 * (ew & 1) + (fr & 3), lg = fr >> 2;
#pragma unroll
        for (int m = 0; m < 4; ++m)
#pragma unroll
            for (int j = 0; j < 4; ++j) TE[((m * 2 + s_) * 64 + (4 * fq + j) + 16 * lg) * 8 + jj] = (bf16)f2bf(acc[m][j]);
    }
}
DEVI void rwkL2_item(const P& p, int h) {
    const bf16* TE = (const bf16*)(p.ws + WS_WTE); const float* E0 = (const float*)(p.ws + WS_WE0); bf16* SG = (bf16*)(p.ws + WS_WSG);
    const int lane = threadIdx.x & 63, ew = threadIdx.x >> 6;
    f32x4 acc[4];
#pragma unroll
    for (int m = 0; m < 4; ++m) acc[m] = (f32x4){0.f, 0.f, 0.f, 0.f};
#pragma unroll 1
    for (int g = 0; g < 16; ++g) {
        const size_t hg = (size_t)h * 16 + g;
        bf16x8 pf[8]; f32x4 bfr[4];
#pragma unroll
        for (int i = 0; i < 8; ++i) pf[i] = *(const bf16x8*)(TE + hg * 4096 + (i * 64 + lane) * 8);
#pragma unroll
        for (int m = 0; m < 4; ++m) bfr[m] = *(const f32x4*)(E0 + hg * 4096 + ((ew * 4 + m) * 64 + lane) * 4);
        asm volatile("" ::: "memory");
        bf16x8 sf[2];
#pragma unroll
        for (int s = 0; s < 2; ++s) {
            sf[s] = pack_frag(acc[2 * s], acc[2 * s + 1]);
            *(bf16x8*)(SG + hg * 4096 + ((ew * 2 + s) * 64 + lane) * 8) = sf[s];
        }
#pragma unroll
        for (int m = 0; m < 4; ++m) {
            f32x4 a = bfr[m];
            a = mfma16(pf[m * 2], sf[0], a); a = mfma16(pf[m * 2 + 1], sf[1], a);
            acc[m] = a;
        }
    }
}

DEVI void rwkC_item(const P& p, int n, int l) {
    const int lane = threadIdx.x & 63, h = threadIdx.x >> 6, fr = lane & 15, fq = lane >> 4;
    const size_t it = (size_t)n * 4 + h;
    const bf16* WQ = (const bf16*)(p.ws + WS_WQ) + it * 2048; const float* WY = (const float*)(p.ws + WS_WY) + it * 2048;
    const bf16* WSF = (const bf16*)(p.ws + WS_WS) + it * 4096;
    const bf16* WR = (const bf16*)(p.ws + WS_WR) + it * 2048; const bf16* WSG = (const bf16*)(p.ws + WS_WSG) + (size_t)(h * 16 + (n >> 5)) * 4096;
    const float* RECR = (const float*)(p.ws + WS_RECR); const float* GB = (const float*)(p.ws + WS_G); const float* BON = (const float*)(p.ws + WS_BON);
    bf16* MIX = (bf16*)(p.ws + WS_MIX);
    const float* ln_g = p.in[17] + l * 256 + h * 64; const float* ln_b = p.in[18] + l * 256 + h * 64;
#pragma unroll
    for (int ct = 0; ct < 2; ++ct) {
        const bf16x8 q0 = *(const bf16x8*)(WQ + ((ct * 2 + 0) * 64 + lane) * 8), q1 = *(const bf16x8*)(WQ + ((ct * 2 + 1) * 64 + lane) * 8);
        const bf16x8 r0 = *(const bf16x8*)(WR + ((ct * 2 + 0) * 64 + lane) * 8), r1 = *(const bf16x8*)(WR + ((ct * 2 + 1) * 64 + lane) * 8);
        const int t = n * 32 + 16 * ct + fr;
        f32x4 a[4];
        float sm = 0.f;
#pragma unroll
        for (int et = 0; et < 4; ++et) {
            f32x4 acc = *(const f32x4*)(WY + ((ct * 4 + et) * 64 + lane) * 4);
            acc = mfma16(*(const bf16x8*)(WSF + ((et * 2 + 0) * 64 + lane) * 8), q0, acc);
            acc = mfma16(*(const bf16x8*)(WSF + ((et * 2 + 1) * 64 + lane) * 8), q1, acc);
            acc = mfma16(*(const bf16x8*)(WSG + ((et * 2 + 0) * 64 + lane) * 8), r0, acc);
            acc = mfma16(*(const bf16x8*)(WSG + ((et * 2 + 1) * 64 + lane) * 8), r1, acc);
            a[et] = acc; sm += (acc.x + acc.y) + (acc.z + acc.w);
        }
        const float mean = quad_sum(sm) * (1.f / 64.f);
        float sv = 0.f;
#pragma unroll
        for (int et = 0; et < 4; ++et) { a[et] = a[et] - mean; sv += a[et].x * a[et].x + a[et].y * a[et].y + a[et].z * a[et].z + a[et].w * a[et].w; }
        const float rs = rsqrtf(quad_sum(sv) * (1.f / 64.f) + 64e-5f);
        const float bon = BON[(size_t)t * 4 + h];
#pragma unroll
        for (int et = 0; et < 4; ++et) {
            const int e = 16 * et + 4 * fq;
            const f32x4 g = *(const f32x4*)(ln_g + e), b = *(const f32x4*)(ln_b + e);
            const f32x4 v = *(const f32x4*)(RECR + ((size_t)t * 4 + h) * 384 + 320 + e);
            const f32x4 gate = *(const f32x4*)(GB + (size_t)t * 256 + h * 64 + e);
            const f32x4 o = (a[et] * rs * g + b + v * bon) * gate;
            *(u32x2*)(MIX + (size_t)t * D + h * 64 + e) = (u32x2){pk2(o.x, o.y), pk2(o.z, o.w)};
        }
    }
}

DEVI void phase_scanL1(const P& p) {
    for (int item = blockIdx.x; item < 448; item += gridDim.x) {
        if (item < 256) gdnL1_item(p, item);
        else if (item < 384) rwkL1_item(p, item - 256);
        else retS_item(p, item - 384);
    }
}
DEVI void phase_scanL2(const P& p) {
    for (int item = blockIdx.x; item < 12; item += gridDim.x) {
        if (item < 8) gdnL2_item(p, item);
        else rwkL2_item(p, item - 8);
    }
}
DEVI void phase_chunkA(const P& p, char* smem) {
    for (int item = blockIdx.x; item < 4096; item += gridDim.x) { if (item < 1024) gdnA_item(p, item, smem); else if (item < 3072) rwkA_item(p, item - 1024, smem); else retA_item(p, item - 3072, smem); }
}
DEVI void phase_chunkC(const P& p, int l, char* smem) {
    for (int item = blockIdx.x; item < 2560; item += gridDim.x) { if (item < 1024) gdnC_item(p, item, l); else if (item < 2048) retC_item(p, item - 1024, l, smem); else rwkC_item(p, item - 2048, l); }
}

DEVI void phase_post(const P& p, int l) {
    const bf16* PROJ = (const bf16*)(p.ws + WS_PROJ);
    const float* RECR = (const float*)(p.ws + WS_RECR);
    const float* GB = (const float*)(p.ws + WS_G); const float* BON = (const float*)(p.ws + WS_BON);
    const float* YR = (const float*)(p.ws + WS_YR); const float* OG = (const float*)(p.ws + WS_OG); const float* ORT = (const float*)(p.ws + WS_ORT);
    bf16* MIX = (bf16*)(p.ws + WS_MIX);
    const float* ln_g = p.in[17] + l * 256; const float* ln_b = p.in[18] + l * 256;
    const float* gn = p.in[24] + l * 128;
    const float* rg = p.in[25] + l * 256; const float* rb = p.in[26] + l * 256;
    const int tid = threadIdx.x, lane = tid & 63, h = tid >> 6;
    for (int t = blockIdx.x; t < S; t += gridDim.x) {
        {
            const int c = tid;
            const float y = YR[(size_t)t * 256 + c];
            const float mean = wave_sum(y) * (1.f / 64.f);
            const float d = y - mean;
            const float var = wave_sum(d * d) * (1.f / 64.f);
            const float yn = d * rsqrtf(var + 64e-5f) * ln_g[c] + ln_b[c];
            const float v = RECR[((size_t)t * 4 + h) * 384 + 320 + lane];
            const float o = (yn + BON[(size_t)t * 4 + h] * v) * GB[(size_t)t * 256 + c];
            MIX[(size_t)t * D + c] = (bf16)f2bf(o);
        }
        {
            const int c0 = h * 128 + lane, c1 = c0 + 64;
            const float o0 = OG[(size_t)t * 512 + c0], o1 = OG[(size_t)t * 512 + c1];
            const float ms = wave_sum(o0 * o0 + o1 * o1) * (1.f / 128.f);
            const float rs = rsqrtf(ms + 1e-6f);
            const float z0 = proj_at(PROJ, t, 2560 + c0), z1 = proj_at(PROJ, t, 2560 + c1);
            MIX[(size_t)t * D + 256 + c0] = (bf16)f2bf(o0 * rs * gn[lane] * siluf_(z0));
            MIX[(size_t)t * D + 256 + c1] = (bf16)f2bf(o1 * rs * gn[64 + lane] * siluf_(z1));
        }
        {
            const int c = tid;
            const float y = ORT[(size_t)t * 256 + c];
            const float mean = wave_sum(y) * (1.f / 64.f);
            const float d = y - mean;
            const float var = wave_sum(d * d) * (1.f / 64.f);
            const float yn = d * rsqrtf(var + 1e-5f) * rg[c] + rb[c];
            const float gt = proj_at(PROJ, t, 3840 + c);
            MIX[(size_t)t * D + 768 + c] = (bf16)f2bf(yn * siluf_(gt));
        }
    }
}

DEVI void phase_outproj(const P& p, int l, char* smem) {
    const bf16* MIX = (const bf16*)(p.ws + WS_MIX);
    const bf16* W = (const bf16*)(p.ws + WS_WOUT) + (size_t)l * D * D;
    float* OPRE = (float*)(p.ws + WS_OPRE);
    const int lane = threadIdx.x & 63, wid = threadIdx.x >> 6, wr = wid >> 1, wc = wid & 1, fr = lane & 15, fq = lane >> 4;
    for (int tile = blockIdx.x; tile < (S / 128) * 8; tile += gridDim.x) {
        const int mt = tile / 8, nt = tile % 8;
        f32x4 acc[4][4];
        gemm_tile(smem, MIX, [&](int r) { return (unsigned)((mt * 128 + r) * D); }, W, [&](int r) { return (unsigned)((nt * 128 + r) * D); }, D, acc);
#pragma unroll
        for (int m = 0; m < 4; ++m) {
            const int tok = mt * 128 + wr * 64 + m * 16 + fr;
#pragma unroll
            for (int n = 0; n < 4; ++n) *(f32x4*)(OPRE + (size_t)tok * D + nt * 128 + wc * 64 + n * 16 + fq * 4) = acc[m][n];
        }
    }
}

DEVI void phase_ln1_route(const P& p, int l, char* smem, bool commit = true) {
    const float* ADA = (const float*)(p.ws + OFF_ADA) + l * 6144;
    const float* xin = (l == 0) ? p.in[0] : (const float*)(p.ws + WS_X);
    const float* OPRE = (const float*)(p.ws + WS_OPRE);
    float* X = (float*)(p.ws + WS_X); bf16* H2 = (bf16*)(p.ws + WS_H2);
    const float* lg = p.in[28] + l * D; const float* lb = p.in[29] + l * D;
    const float* rw = p.in[30] + (size_t)l * D * 32; const float* rbias = p.in[31] + l * 32;
    int* CNT = (int*)(p.ws + OFF_CNT) + l * 32 * 64; int* LIST = (int*)(p.ws + WS_LIST); float* GATE = (float*)(p.ws + WS_GATE);
    float* HS = (float*)smem;
    float* RED = HS + 4 * 1024;
    int* SEL = (int*)(RED + 1024);
    int* RNK = SEL + 256;
    int* BASE = RNK + 256;
    int nasg = 0;
    const int tid = threadIdx.x, lane = tid & 63, w = tid >> 6;
    for (int item = blockIdx.x; item < S / 4; item += gridDim.x) {
        const int t = item * 4 + w;
        {
            f32x4 v[4]; float s = 0.f;
#pragma unroll
            for (int j = 0; j < 4; ++j) {
                const int c = j * 256 + lane * 4;
                const f32x4 x = *(const f32x4*)(xin + (size_t)t * D + c);
                const f32x4 o = *(const f32x4*)(OPRE + (size_t)t * D + c);
                const f32x4 gt = *(const f32x4*)(ADA + 2048 + c);
                v[j].x = DN_ALPHA * x.x + (1.f + gt.x) * o.x; v[j].y = DN_ALPHA * x.y + (1.f + gt.y) * o.y;
                v[j].z = DN_ALPHA * x.z + (1.f + gt.z) * o.z; v[j].w = DN_ALPHA * x.w + (1.f + gt.w) * o.w;
                s += (v[j].x + v[j].y) + (v[j].z + v[j].w);
            }
            const float mean = wave_sum(s) * (1.f / D);
            float s2 = 0.f;
#pragma unroll
            for (int j = 0; j < 4; ++j) { v[j] = v[j] - mean; s2 += (v[j].x * v[j].x + v[j].y * v[j].y) + (v[j].z * v[j].z + v[j].w * v[j].w); }
            const float rstd = rsqrtf(wave_sum(s2) * (1.f / D) + 1e-5f);
#pragma unroll
            for (int j = 0; j < 4; ++j) {
                const int c = j * 256 + lane * 4;
                const f32x4 g = *(const f32x4*)(lg + c), b = *(const f32x4*)(lb + c);
                f32x4 xo = v[j] * rstd * g + b;
                *(f32x4*)(X + (size_t)t * D + c) = xo;
                const f32x4 sh = *(const f32x4*)(ADA + 3072 + c), sc = *(const f32x4*)(ADA + 4096 + c);
                f32x4 hh = xo * (1.f + sc) + sh;
                *(f32x4*)(HS + w * 1024 + c) = hh;
                u32x2 o; o.x = pk2(hh.x, hh.y); o.y = pk2(hh.z, hh.w);
                *(u32x2*)(H2 + (size_t)t * D + c) = o;
            }
        }
        __syncthreads();
        {
            const int e = tid & 31, ks = tid >> 5;
            float a0 = 0.f, a1 = 0.f, a2 = 0.f, a3 = 0.f;
#pragma unroll 4
            for (int k = ks * 128; k < ks * 128 + 128; k += 4) {
                const float w0 = rw[(k + 0) * 32 + e], w1 = rw[(k + 1) * 32 + e], w2 = rw[(k + 2) * 32 + e], w3 = rw[(k + 3) * 32 + e];
                const f32x4 h0 = *(const f32x4*)(HS + 0 * 1024 + k), h1 = *(const f32x4*)(HS + 1 * 1024 + k);
                const f32x4 h2 = *(const f32x4*)(HS + 2 * 1024 + k), h3 = *(const f32x4*)(HS + 3 * 1024 + k);
                a0 += h0.x * w0 + h0.y * w1 + h0.z * w2 + h0.w * w3;
                a1 += h1.x * w0 + h1.y * w1 + h1.z * w2 + h1.w * w3;
                a2 += h2.x * w0 + h2.y * w1 + h2.z * w2 + h2.w * w3;
                a3 += h3.x * w0 + h3.y * w1 + h3.z * w2 + h3.w * w3;
            }
            RED[(ks * 4 + 0) * 32 + e] = a0; RED[(ks * 4 + 1) * 32 + e] = a1; RED[(ks * 4 + 2) * 32 + e] = a2; RED[(ks * 4 + 3) * 32 + e] = a3;
        }
        __syncthreads();
        if (tid < 128) {
            const int tok = tid >> 5, e = tid & 31, tt = item * 4 + tok;
            float logit = rbias[e];
#pragma unroll
            for (int ks = 0; ks < 8; ++ks) logit += RED[(ks * 4 + tok) * 32 + e];
            bool taken = false;
            float sv[4]; int si[4];
#pragma unroll
            for (int j = 0; j < 4; ++j) {
                float cand = taken ? -3.0e38f : logit; int ci = e;
#pragma unroll
                for (int off = 16; off >= 1; off >>= 1) {
                    const float ov = __shfl_xor(cand, off, 32); const int oi = __shfl_xor(ci, off, 32);
                    if (ov > cand || (ov == cand && oi < ci)) { cand = ov; ci = oi; }
                }
                sv[j] = cand; si[j] = ci; if (ci == e) taken = true;
            }
            const float e0 = 1.f, e1 = __expf(sv[1] - sv[0]), e2 = __expf(sv[2] - sv[0]), e3 = __expf(sv[3] - sv[0]);
            const float inv = 1.f / (e0 + e1 + e2 + e3);
            const float gts[4] = {e0 * inv, e1 * inv, e2 * inv, e3 * inv};
#pragma unroll
            for (int j = 0; j < 4; ++j) {
                if (si[j] == e) {
                    SEL[nasg + tok * 4 + j] = ((tt * 4 + j) << 5) | e;
                    GATE[(size_t)tt * 4 + j] = gts[j];
                }
            }
        }
        nasg += 16;
        __syncthreads();
    }
    if (!commit) return;
    if (tid < 32) {
        int c = 0;
        for (int a = 0; a < nasg; ++a) { if ((SEL[a] & 31) == tid) { RNK[a] = c; ++c; } }
        BASE[tid] = c ? atomicAdd(&CNT[tid * 64], c) : 0;
    }
    __syncthreads();
    for (int a = tid; a < nasg; a += NT) { const int v = SEL[a], e = v & 31; LIST[(size_t)e * S + BASE[e] + RNK[a]] = v >> 5; }
    __syncthreads();
}

struct MoeMap { int cnt[32]; int off[32]; int tstart[33]; };
DEVI void moe_map(const P& p, int l, MoeMap* mm) {
    const int* CNT = (const int*)(p.ws + OFF_CNT) + l * 32 * 64;
    if (threadIdx.x < 32) mm->cnt[threadIdx.x] = __hip_atomic_load(&CNT[threadIdx.x * 64], __ATOMIC_RELAXED, __HIP_MEMORY_SCOPE_AGENT);
    __syncthreads();
    if (threadIdx.x == 0) {
        int o = 0, ts = 0;
        for (int e = 0; e < 32; ++e) { mm->off[e] = o; mm->tstart[e] = ts; o += mm->cnt[e]; ts += (mm->cnt[e] + 127) / 128; }
        mm->tstart[32] = ts;
    }
    __syncthreads();
}

DEVI void phase_moe_up(const P& p, int l, char* smem) {
    MoeMap* mm = (MoeMap*)(smem + 65536);
    int* rows = (int*)(smem + 65536 + 1024);
    moe_map(p, l, mm);
    const bf16* H2 = (const bf16*)(p.ws + WS_H2);
    const bf16* WUP = (const bf16*)(p.ws + WS_WUP) + (size_t)l * NEXP * 2048 * D;
    const float* bup = p.in[33] + (size_t)l * NEXP * 2048;
    const int* LIST = (const int*)(p.ws + WS_LIST);
    bf16* ACT = (bf16*)(p.ws + WS_ACT);
    const int lane = threadIdx.x & 63, wid = threadIdx.x >> 6, wr = wid >> 1, wc = wid & 1, fr = lane & 15, fq = lane >> 4;
    const int ntiles = mm->tstart[32] * 16;
    for (int tile = blockIdx.x; tile < ntiles; tile += gridDim.x) {
        const int mtg = tile / 16, nt = tile % 16;
        int e = 0;
        while (mm->tstart[e + 1] <= mtg) ++e;
        const int m0 = (mtg - mm->tstart[e]) * 128, cnt = mm->cnt[e];
        __syncthreads();
        if (threadIdx.x < 128) { const int r = m0 + threadIdx.x; rows[threadIdx.x] = LIST[(size_t)e * S + (r < cnt ? r : m0)]; }
        __syncthreads();
        const bf16* We = WUP + (size_t)e * 2048 * D;
        f32x4 acc[4][4];
        gemm_tile(smem, H2, [&](int r) { return (unsigned)((rows[r] >> 2) * D); },
                  We, [&](int r) { const int t16 = r >> 4; return (unsigned)((nt * 64 + (t16 >> 1) * 16 + (r & 15) + ((t16 & 1) ? 1024 : 0)) * D); }, D, acc);
        const float* be = bup + (size_t)e * 2048;
#pragma unroll
        for (int m = 0; m < 4; ++m) {
            const int rl = m0 + wr * 64 + m * 16 + fr;
            if (rl < cnt) {
#pragma unroll
                for (int n2 = 0; n2 < 2; ++n2) {
                    const int col = nt * 64 + (wc * 2 + n2) * 16 + fq * 4;
                    const f32x4 bg = *(const f32x4*)(be + col), bl = *(const f32x4*)(be + 1024 + col);
                    float o[4];
#pragma unroll
                    for (int j = 0; j < 4; ++j) {
                        const float glu = fminf(acc[m][2 * n2][j] + bg[j], 7.f);
                        const float lin = fminf(fmaxf(acc[m][2 * n2 + 1][j] + bl[j], -7.f), 7.f);
                        o[j] = glu * sigmoidf_(1.702f * glu) * (lin + 1.f);
                    }
                    u32x2 ov; ov.x = pk2(o[0], o[1]); ov.y = pk2(o[2], o[3]);
                    *(u32x2*)(ACT + (size_t)(mm->off[e] + rl) * DFF + col) = ov;
                }
            }
        }
    }
}

DEVI void phase_moe_down(const P& p, int l, char* smem) {
    MoeMap* mm = (MoeMap*)(smem + 65536);
    int* rows = (int*)(smem + 65536 + 1024);
    moe_map(p, l, mm);
    const bf16* ACT = (const bf16*)(p.ws + WS_ACT);
    const bf16* WDN = (const bf16*)(p.ws + WS_WDN) + (size_t)l * NEXP * D * DFF;
    const float* bdn = p.in[35] + (size_t)l * NEXP * D;
    const int* LIST = (const int*)(p.ws + WS_LIST); const float* GATE = (const float*)(p.ws + WS_GATE);
    bf16* YB = (bf16*)(p.ws + WS_YB);
    const int lane = threadIdx.x & 63, wid = threadIdx.x >> 6, wr = wid >> 1, wc = wid & 1, fr = lane & 15, fq = lane >> 4;
    const int ntiles = mm->tstart[32] * 8;
    for (int tile = blockIdx.x; tile < ntiles; tile += gridDim.x) {
        const int mtg = tile / 8, nt = tile % 8;
        int e = 0;
        while (mm->tstart[e + 1] <= mtg) ++e;
        const int m0 = (mtg - mm->tstart[e]) * 128, cnt = mm->cnt[e];
        __syncthreads();
        if (threadIdx.x < 128) { const int r = m0 + threadIdx.x; rows[threadIdx.x] = LIST[(size_t)e * S + (r < cnt ? r : m0)]; }
        __syncthreads();
        const bf16* We = WDN + (size_t)e * D * DFF;
        const unsigned abase = (unsigned)(mm->off[e] + m0);
        f32x4 acc[4][4];
        gemm_tile(smem, ACT, [&](int r) { return (abase + ((m0 + r) < cnt ? r : 0)) * (unsigned)DFF; },
                  We, [&](int r) { return (unsigned)((nt * 128 + r) * DFF); }, DFF, acc);
        const float* be = bdn + (size_t)e * D;
#pragma unroll
        for (int m = 0; m < 4; ++m) {
            const int rt = wr * 64 + m * 16 + fr;
            if (m0 + rt < cnt) {
                const int ent = rows[rt];
                const float gt = GATE[ent];
#pragma unroll
                for (int n = 0; n < 4; ++n) {
                    const int col = nt * 128 + wc * 64 + n * 16 + fq * 4;
                    const f32x4 b = *(const f32x4*)(be + col);
                    u32x2 ov; ov.x = pk2((acc[m][n].x + b.x) * gt, (acc[m][n].y + b.y) * gt); ov.y = pk2((acc[m][n].z + b.z) * gt, (acc[m][n].w + b.w) * gt);
                    *(u32x2*)(YB + (size_t)ent * D + col) = ov;
                }
            }
        }
    }
}

DEVI void phase_ln2(const P& p, int l) {
    const float* ADA = (const float*)(p.ws + OFF_ADA) + l * 6144;
    const float* ADAn = (const float*)(p.ws + OFF_ADA) + 6144;
    float* X = (float*)(p.ws + WS_X); const bf16* YB = (const bf16*)(p.ws + WS_YB);
    bf16* HB = (bf16*)(p.ws + WS_HB);
    const float* lg = p.in[36] + l * D; const float* lb = p.in[37] + l * D;
    const int tid = threadIdx.x, lane = tid & 63, w = tid >> 6;
    for (int item = blockIdx.x; item < S / 4; item += gridDim.x) {
        const int t = item * 4 + w;
        f32x4 v[4]; float s = 0.f;
#pragma unroll
        for (int j = 0; j < 4; ++j) {
            const int c = j * 256 + lane * 4;
            const f32x4 x = *(const f32x4*)(X + (size_t)t * D + c);
            f32x4 f = {0.f, 0.f, 0.f, 0.f};
#pragma unroll
            for (int q = 0; q < 4; ++q) {
                const u32x2 y = *(const u32x2*)(YB + ((size_t)t * 4 + q) * D + c);
                f.x += __uint_as_float(y.x << 16); f.y += __uint_as_float(y.x & 0xffff0000u);
                f.z += __uint_as_float(y.y << 16); f.w += __uint_as_float(y.y & 0xffff0000u);
            }
            const f32x4 gt = *(const f32x4*)(ADA + 5120 + c);
            v[j] = x * DN_ALPHA + (gt + 1.f) * f;
            s += (v[j].x + v[j].y) + (v[j].z + v[j].w);
        }
        const float mean = wave_sum(s) * (1.f / D);
        float s2 = 0.f;
#pragma unroll
        for (int j = 0; j < 4; ++j) { v[j] = v[j] - mean; s2 += (v[j].x * v[j].x + v[j].y * v[j].y) + (v[j].z * v[j].z + v[j].w * v[j].w); }
        const float rstd = rsqrtf(wave_sum(s2) * (1.f / D) + 1e-5f);
#pragma unroll
        for (int j = 0; j < 4; ++j) {
            const int c = j * 256 + lane * 4;
            const f32x4 g = *(const f32x4*)(lg + c), b = *(const f32x4*)(lb + c);
            const f32x4 xo = v[j] * rstd * g + b;
            if (l == 0) {
                *(f32x4*)(X + (size_t)t * D + c) = xo;
                const f32x4 sh = *(const f32x4*)(ADAn + c), sc = *(const f32x4*)(ADAn + 1024 + c);
                const f32x4 hh = xo * (sc + 1.f) + sh;
                u32x2 o; o.x = pk2(hh.x, hh.y); o.y = pk2(hh.z, hh.w);
                *(u32x2*)(HB + (size_t)t * D + c) = o;
            } else {
                *(f32x4*)(p.out + (size_t)t * D + c) = xo;
            }
        }
    }
}

constexpr int NPHASE = 24;
__global__ void __launch_bounds__(NT, 2) k_run(P p) {
    extern __shared__ __attribute__((aligned(16))) char smem[];
    XcdBarrier bar; bar.bar = nullptr; bar.x = 0; bar.st = nullptr;
    const bool multi = (p.ph_hi - p.ph_lo) > 1;
    if (multi) {
        volatile LAS unsigned* st = (volatile LAS unsigned*)(smem + LDS_BYTES - 16);
        if (threadIdx.x == 0) { st[0] = 0u; st[1] = 0u; }
        __syncthreads();
        bar = xcd_barrier_post((unsigned*)(p.ws + OFF_BAR), st);
    }
#ifndef DUP
#define DUP -1
#endif
#ifndef DUP2
#define DUP2 -1
#endif
#define RUN(k, call) if (p.ph_lo <= (k) && (k) < p.ph_hi) { for (int _rep = ((k) == DUP || (k) == DUP2) ? 2 : 1; _rep > 0; --_rep) { call; if (multi && ((k) + 1 < p.ph_hi || _rep > 1)) xcd_barrier(bar); } }
    RUN(0, phase_prep(p, smem))
    RUN(1, phase_h0(p))
    RUN(2, phase_inproj(p, 0, smem))
    RUN(3, phase_mixprep(p, 0, smem))
    RUN(4, phase_chunkA(p, smem))
    RUN(5, phase_scanL1(p))
    RUN(6, phase_scanL2(p))
    RUN(7, phase_chunkC(p, 0, smem))
    RUN(8, phase_outproj(p, 0, smem))
    RUN(9, phase_ln1_route(p, 0, smem, _rep == 1))
    RUN(10, phase_moe_up(p, 0, smem))
    RUN(11, phase_moe_down(p, 0, smem))
    RUN(12, phase_ln2(p, 0))
    RUN(13, phase_inproj(p, 1, smem))
    RUN(14, phase_mixprep(p, 1, smem))
    RUN(15, phase_chunkA(p, smem))
    RUN(16, phase_scanL1(p))
    RUN(17, phase_scanL2(p))
    RUN(18, phase_chunkC(p, 1, smem))
    RUN(19, phase_outproj(p, 1, smem))
    RUN(20, phase_ln1_route(p, 1, smem))
    RUN(21, phase_moe_up(p, 1, smem))
    RUN(22, phase_moe_down(p, 1, smem))
    RUN(23, phase_ln2(p, 1))
#undef RUN
}

extern "C" void kernel_launch(void* const* d_in, const int* in_sizes, int n_in, void* d_out, int out_size, void* d_ws, size_t ws_size,
                              hipStream_t stream) {
    static int grid = 0;
    if (grid == 0) {
        if (n_in != 38 || ws_size < WS_END) { fprintf(stderr, "kernel_launch: unexpected n_in %d or ws_size %zu (< %zu)\n", n_in, ws_size, (size_t)WS_END); grid = -1; return; }
        int dev = 0, cus = 0, per_cu = 0;
        hipGetDevice(&dev);
        hipDeviceGetAttribute(&cus, hipDeviceAttributeMultiprocessorCount, dev);
        hipFuncSetAttribute((const void*)k_run, hipFuncAttributeMaxDynamicSharedMemorySize, LDS_BYTES);
        hipOccupancyMaxActiveBlocksPerMultiprocessor(&per_cu, (const void*)k_run, NT, LDS_BYTES);
        if (per_cu < 1) { fprintf(stderr, "kernel_launch: occupancy query returned %d\n", per_cu); grid = -1; return; }
        if (per_cu > 2) per_cu = 2;
        grid = cus * per_cu;
    }
    if (grid < 0) return;
    hipMemsetAsync((char*)d_ws + WS_CTL, 0, CTL_BYTES, stream);
    P p{};
    for (int i = 0; i < 38; ++i) p.in[i] = (const float*)d_in[i];
    p.pos = (const int*)d_in[2];
    p.out = (float*)d_out; p.ws = (char*)d_ws;
#if MEGA
    p.ph_lo = 0; p.ph_hi = NPHASE;
    void* args[] = {&p};
    hipError_t e = hipLaunchCooperativeKernel((const void*)k_run, dim3(grid), dim3(NT), args, LDS_BYTES, stream);
    if (e != hipSuccess) fprintf(stderr, "cooperative launch failed: %s (grid %d)\n", hipGetErrorString(e), grid);
#else
    for (int ph = 0; ph < NPHASE; ++ph) {
        p.ph_lo = ph; p.ph_hi = ph + 1;
        hipLaunchKernelGGL(k_run, dim3(grid), dim3(NT), LDS_BYTES, stream, p);
    }
#endif
}
```

```cpp
#include <hip/hip_runtime.h>
#include <hip/hip_bf16.h>
#include <stdint.h>
#include <stdio.h>

#ifndef MEGA
#define MEGA 1
#endif

#define DEVI __device__ __forceinline__
#define LAS __attribute__((address_space(3)))

typedef unsigned short bf16;
typedef short bf16x8 __attribute__((ext_vector_type(8)));
typedef float f32x4 __attribute__((ext_vector_type(4)));
typedef unsigned u32x4 __attribute__((ext_vector_type(4)));
typedef unsigned u32x2 __attribute__((ext_vector_type(2)));

constexpr int S = 16384, D = 1024, NIN = 4104, NEXP = 32, DFF = 1024;
constexpr int NPROJ = 4096;
constexpr int NPAD = 4352;
constexpr float DN_ALPHA = 1.4142135623730951f;
constexpr int NT = 256;
constexpr int LDS_BYTES = 76032;

constexpr size_t MiB = 1ull << 20;
constexpr size_t WS_CTL = 0;
constexpr size_t CTL_BYTES = 1 * MiB;
constexpr size_t OFF_BAR = 0;
constexpr size_t OFF_ADA = 64 * 1024;
constexpr size_t OFF_CNT = 128 * 1024;
constexpr size_t WS_ROT = 1 * MiB;
constexpr size_t WS_WIN = WS_ROT + (size_t)S * 64 * 4;
constexpr size_t WS_WOUT = WS_WIN + 2ull * NPAD * D * 2;
constexpr size_t WS_WUP = WS_WOUT + 2ull * D * D * 2;
constexpr size_t WS_WDN = WS_WUP + 2ull * NEXP * 2048 * D * 2;
constexpr size_t WS_HB = WS_WDN + 2ull * NEXP * D * DFF * 2;
constexpr size_t WS_PROJ = WS_HB + (size_t)S * D * 2;
constexpr size_t WS_PEX = WS_PROJ + (size_t)S * NPROJ * 2;
constexpr size_t WS_VFIRST = WS_PEX + (size_t)S * 64 * 4;
constexpr size_t WS_RECR = WS_VFIRST + (size_t)S * 256 * 4;
constexpr size_t WS_RECG = WS_RECR + (size_t)S * 4 * 384 * 4;
constexpr size_t WS_RECT = WS_RECG + (size_t)S * 4 * 392 * 4;
constexpr size_t WS_G = WS_RECT + (size_t)S * 4 * 192 * 4;
constexpr size_t WS_BON = WS_G + (size_t)S * 256 * 4;
constexpr size_t WS_YR = WS_BON + (size_t)S * 4 * 4;
constexpr size_t WS_OG = WS_YR + (size_t)S * 256 * 4;
constexpr size_t WS_ORT = WS_OG + (size_t)S * 512 * 4;
constexpr size_t WS_MIX = WS_ORT + (size_t)S * 256 * 4;
constexpr size_t WS_OPRE = WS_MIX + (size_t)S * D * 2;
constexpr size_t WS_X = WS_OPRE + (size_t)S * D * 4;
constexpr size_t WS_H2 = WS_X + (size_t)S * D * 4;
constexpr size_t WS_LIST = WS_H2 + (size_t)S * D * 2;
constexpr size_t WS_GATE = WS_LIST + (size_t)NEXP * S * 4;
constexpr size_t WS_ACT = WS_GATE + (size_t)S * 4 * 4;
constexpr size_t WS_YB = WS_ACT + ((size_t)S * 4 + 128) * DFF * 2;
constexpr size_t WS_ADAP = WS_YB + (size_t)S * 4 * D * 2;
constexpr size_t WS_RKV = WS_ADAP + 16ull * 12288 * 4;
constexpr size_t WS_RST = WS_RKV + 256ull * 4 * 4096 * 4;
constexpr size_t WS_GP = WS_RST + 256ull * 4 * 4096 * 2;
constexpr size_t WS_GB = WS_GP + 1024ull * 16384 * 2;
constexpr size_t WS_GD = WS_GB + 1024ull * 16384 * 4;
constexpr size_t WS_GQ = WS_GD + 4096;
constexpr size_t WS_GO = WS_GQ + 1024ull * 8192 * 2;
constexpr size_t WS_GS = WS_GO + 1024ull * 8192 * 4;
constexpr size_t WS_WP = WS_GS + 1024ull * 16384 * 2;
constexpr size_t WS_WC = WS_WP + 2048ull * 4096 * 2;
constexpr size_t WS_WD = WS_WC + 2048ull * 4096 * 4;
constexpr size_t WS_WQ = WS_WD + 2048ull * 64 * 4;
constexpr size_t WS_WY = WS_WQ + 2048ull * 2048 * 2;
constexpr size_t WS_WS = WS_WY + 2048ull * 2048 * 4;
constexpr size_t WS_GR = WS_WS + 2048ull * 4096 * 2;
constexpr size_t WS_GE0 = WS_GR + 1024ull * 8192 * 2;
constexpr size_t WS_GTE = WS_GE0 + 64ull * 16384 * 4;
constexpr size_t WS_GSG = WS_GTE + 64ull * 16384 * 2;
constexpr size_t WS_WR = WS_GSG + 64ull * 16384 * 2;
constexpr size_t WS_WE0 = WS_WR + 2048ull * 2048 * 2;
constexpr size_t WS_WTE = WS_WE0 + 64ull * 4096 * 4;
constexpr size_t WS_WSG = WS_WTE + 64ull * 4096 * 2;
constexpr size_t WS_LRT = WS_WSG + 64ull * 4096 * 2;
constexpr size_t WS_END = WS_LRT + 2ull * 73728 * 2;

struct P {
    const float* in[38];
    const int* pos;
    float* out;
    char* ws;
    int ph_lo, ph_hi;
};

DEVI float bf2f(bf16 v) { return __uint_as_float(((unsigned)v) << 16); }
DEVI unsigned f2bf(float f) { unsigned u = __float_as_uint(f); return (u + 0x7fffu + ((u >> 16) & 1u)) >> 16; }
DEVI unsigned pk2(float lo, float hi) { return f2bf(lo) | (f2bf(hi) << 16); }
DEVI float sigmoidf_(float x) { return 1.f / (1.f + __expf(-x)); }
DEVI float siluf_(float x) { return x * sigmoidf_(x); }
DEVI float softplusf_(float x) { return fmaxf(x, 0.f) + log1pf(__expf(-fabsf(x))); }
DEVI float wave_sum(float v) {
#pragma unroll
    for (int o = 32; o >= 1; o >>= 1) v += __shfl_xor(v, o);
    return v;
}
template <int CTRL> DEVI float dpp_mov(float x) {
    return __int_as_float(__builtin_amdgcn_update_dpp(0, __float_as_int(x), CTRL, 0xf, 0xf, false));
}
DEVI float row16_sum(float x) {
    x += dpp_mov<0x128>(x);
    x += dpp_mov<0x124>(x);
    x += dpp_mov<0x122>(x);
    x += dpp_mov<0x121>(x);
    return x;
}

DEVI bf16x8 ldfrag(const bf16* base, int ld, int row0, int k0, int lane) {
    return *(const bf16x8*)(base + (row0 + (lane & 15)) * ld + k0 + (lane >> 4) * 8);
}
DEVI f32x4 ld_bf4(const bf16* p) {
    const u32x2 v = *(const u32x2*)p;
    return (f32x4){__uint_as_float(v.x << 16), __uint_as_float(v.x & 0xffff0000u), __uint_as_float(v.y << 16), __uint_as_float(v.y & 0xffff0000u)};
}
DEVI float quad_sum(float v) { v += __shfl_xor(v, 16); v += __shfl_xor(v, 32); return v; }
DEVI f32x4 mfma16(bf16x8 a, bf16x8 b, f32x4 c) { return __builtin_amdgcn_mfma_f32_16x16x32_bf16(a, b, c, 0, 0, 0); }

#define XB_TMO      128
#define XB_XCNT(j)  (256  + 64 * (j))
#define XB_XSUB(j)  (1280 + 64 * (j))
#define XB_XGEN(j)  (2304 + 64 * (j))
#define XB_TOP      3328
#define XB_TOPGEN   3392
#define XCD_BAR_WORDS 3456
#define XB_SPIN_CAP (1u << 22)
DEVI unsigned xb_ld(unsigned* p) { return __hip_atomic_load(p, __ATOMIC_RELAXED, __HIP_MEMORY_SCOPE_AGENT); }
DEVI unsigned xb_add(unsigned* p, unsigned v) { return __hip_atomic_fetch_add(p, v, __ATOMIC_RELAXED, __HIP_MEMORY_SCOPE_AGENT); }
DEVI unsigned xb_xcc_id() { return (unsigned)__builtin_amdgcn_s_getreg((3 << 11) | 20) & 0xFu; }
#define XB_SPIN(cond, bar) do { unsigned _sp = 0; while (cond) { __builtin_amdgcn_s_sleep(1); \
    if ((++_sp & 255u) == 0u) { if (xb_ld(&(bar)[XB_TMO])) break; if (_sp > XB_SPIN_CAP) { atomicAdd(&(bar)[XB_TMO], 1u); break; } } } } while (0)
struct XcdBarrier { unsigned* bar; unsigned x; volatile LAS unsigned* st; };
DEVI XcdBarrier xcd_barrier_post(unsigned* bar, volatile LAS unsigned* st) {
    XcdBarrier b; b.bar = bar; b.x = xb_xcc_id(); b.st = st;
    if (threadIdx.x == 0) (void)xb_add(&bar[XB_XCNT(b.x)], 1u);
    return b;
}
DEVI void xcd_barrier_complete(unsigned* bar, unsigned x, unsigned& nloc, unsigned& nx) {
    const unsigned G = gridDim.x * gridDim.y * gridDim.z;
    unsigned sum, cnt, mine, sp = 0u;
    for (;;) {
        sum = 0u; cnt = 0u; mine = 0u;
#pragma unroll
        for (unsigned j = 0; j < 16; ++j) { const unsigned c = xb_ld(&bar[XB_XCNT(j)]); sum += c; cnt += (c > 0u) ? 1u : 0u; mine = (j == x) ? c : mine; }
        if (sum == G) break;
        __builtin_amdgcn_s_sleep(1);
        if ((++sp & 255u) == 0u) { if (xb_ld(&bar[XB_TMO])) break; if (sp > XB_SPIN_CAP) { atomicAdd(&bar[XB_TMO], 1u); break; } }
    }
    nloc = mine > 0u ? mine : 1u; nx = cnt > 0u ? cnt : 1u;
}
DEVI void xcd_barrier(const XcdBarrier& b) {
    asm volatile("s_waitcnt vmcnt(0)" ::: "memory");
    __syncthreads();
    if (threadIdx.x == 0) {
        unsigned* bar = b.bar;
        __builtin_amdgcn_s_waitcnt(0);
        unsigned nloc = b.st[0], nx = b.st[1];
        if (nloc == 0u) { xcd_barrier_complete(bar, b.x, nloc, nx); b.st[0] = nloc; b.st[1] = nx; }
        const unsigned old = xb_add(&bar[XB_XSUB(b.x)], 1u);
        const unsigned gen = old / nloc;
        if (old + 1u == (gen + 1u) * nloc) {
            __builtin_amdgcn_fence(__ATOMIC_RELEASE, "agent");
            asm volatile("s_waitcnt vmcnt(0)" ::: "memory");
            const unsigned og = xb_add(&bar[XB_TOP], 1u);
            const unsigned tg = og / nx;
            if (og + 1u == (tg + 1u) * nx) xb_add(&bar[XB_TOPGEN], 1u);
            else XB_SPIN(xb_ld(&bar[XB_TOPGEN]) == tg, bar);
            __builtin_amdgcn_fence(__ATOMIC_ACQUIRE, "agent");
            xb_add(&bar[XB_XGEN(b.x)], 1u);
            asm volatile("s_waitcnt vmcnt(0)" ::: "memory");
        } else {
            XB_SPIN(xb_ld(&bar[XB_XGEN(b.x)]) == gen, bar);
            __builtin_amdgcn_fence(__ATOMIC_ACQUIRE, "agent");
            asm volatile("s_waitcnt vmcnt(0)" ::: "memory");
        }
    }
    __syncthreads();
}

DEVI void transpose_item(const float* __restrict__ src, size_t ld, int k0, int ns0, bf16* __restrict__ dst, int kd, int nd0, float* lds) {
    const int tid = threadIdx.x;
#pragma unroll 4
    for (int i = 0; i < 16; ++i) {
        const int kk = i * 4 + (tid >> 6), n = tid & 63;
        lds[kk * 65 + n] = src[(size_t)(k0 + kk) * ld + ns0 + n];
    }
    __syncthreads();
#pragma unroll
    for (int i = 0; i < 2; ++i) {
        const int q = tid + 256 * i, n = q >> 3, kc = q & 7;
        const float* s = lds + (kc * 8) * 65 + n;
        u32x4 o;
        o.x = pk2(s[0 * 65], s[1 * 65]); o.y = pk2(s[2 * 65], s[3 * 65]);
        o.z = pk2(s[4 * 65], s[5 * 65]); o.w = pk2(s[6 * 65], s[7 * 65]);
        *(u32x4*)(dst + (size_t)(nd0 + n) * kd + k0 + kc * 8) = o;
    }
    __syncthreads();
}

DEVI void phase_prep(const P& p, char* smem) {
    float* lds = (float*)smem;
    const int tid = threadIdx.x;
    const int nb = gridDim.x, bid = blockIdx.x;
    bf16* WIN = (bf16*)(p.ws + WS_WIN); bf16* WOUT = (bf16*)(p.ws + WS_WOUT);
    bf16* WUP = (bf16*)(p.ws + WS_WUP); bf16* WDN = (bf16*)(p.ws + WS_WDN);
    constexpr int I_UP = 2 * NEXP * 16 * 32;
    constexpr int I_DN = 2 * NEXP * 16 * 16;
    constexpr int I_IN = 2 * 16 * 64;
    constexpr int I_OUT = 2 * 16 * 16;
    constexpr int I_EX = 2 * 256;
    constexpr int I_ADA = 2 * 24 * 16;
    constexpr int I_ROT = S * 32 / 256;
    constexpr int I_LR = 2 * 288;
    constexpr int NITEMS = I_UP + I_DN + I_IN + I_OUT + I_EX + I_ADA + I_ROT + I_LR;
    for (int it = bid; it < NITEMS; it += nb) {
        int r = it;
        if (r < I_UP) {
            const int le = r / 512, q = r % 512, kt = q / 32, nt = q % 32;
            transpose_item(p.in[32] + (size_t)le * D * 2048, 2048, kt * 64, nt * 64, WUP + (size_t)le * 2048 * D, D, nt * 64, lds);
            continue;
        }
        r -= I_UP;
        if (r < I_DN) {
            const int le = r / 256, q = r % 256, kt = q / 16, nt = q % 16;
            transpose_item(p.in[34] + (size_t)le * DFF * D, D, kt * 64, nt * 64, WDN + (size_t)le * D * DFF, DFF, nt * 64, lds);
            continue;
        }
        r -= I_DN;
        if (r < I_IN) {
            const int l = r / 1024, q = r % 1024, kt = q / 64, nt = q % 64;
            const int nd0 = nt * 64, ns0 = nd0 < 3072 ? nd0 : nd0 + 8;
            transpose_item(p.in[5] + (size_t)l * D * NIN, NIN, kt * 64, ns0, WIN + (size_t)l * NPAD * D, D, nd0, lds);
            continue;
        }
        r -= I_IN;
        if (r < I_OUT) {
            const int l = r / 256, q = r % 256, kt = q / 16, nt = q % 16;
            transpose_item(p.in[27] + (size_t)l * D * D, D, kt * 64, nt * 64, WOUT + (size_t)l * D * D, D, nt * 64, lds);
            continue;
        }
        r -= I_OUT;
        if (r < I_EX) {
            const int l = r / 256, n = r % 256;
            bf16* dst = WIN + ((size_t)l * NPAD + NPROJ + n) * D;
            for (int k = tid; k < D; k += NT) {
                float v = 0.f;
                if (n < 8) v = p.in[5][(size_t)l * D * NIN + (size_t)k * NIN + 3072 + n];
                else if (n < 40 && l == 1) v = p.in[6][(size_t)k * 32 + (n - 8)];
                dst[k] = (bf16)f2bf(v);
            }
            continue;
        }
        r -= I_EX;
        if (r < I_ADA) {
            const int l = r / 384, q = r % 384, nc = q / 16, kc = q % 16;
            const int n = nc * 256 + tid;
            const float* W = p.in[3] + (size_t)l * D * 6144;
            float acc = (kc == 0) ? p.in[4][l * 6144 + n] : 0.f;
            for (int k = kc * 64; k < kc * 64 + 64; ++k) acc += siluf_(p.in[1][k]) * W[(size_t)k * 6144 + n];
            ((float*)(p.ws + WS_ADAP))[(size_t)kc * 12288 + l * 6144 + n] = acc;
            continue;
        }
        r -= I_ADA;
        if (r >= I_ROT) {
            r -= I_ROT;
            const int l = r / 288, kk = r % 288, c = tid;
            bf16* LRT = (bf16*)(p.ws + WS_LRT) + (size_t)l * 73728;
            if (kk < 64) LRT[c * 64 + kk] = (bf16)f2bf(p.in[10][(l * 64 + kk) * 256 + c]);
            else if (kk < 128) LRT[16384 + c * 64 + (kk - 64)] = (bf16)f2bf(p.in[12][(l * 64 + kk - 64) * 256 + c]);
            else if (kk < 256) LRT[32768 + c * 128 + (kk - 128)] = (bf16)f2bf(p.in[13][(l * 128 + kk - 128) * 256 + c]);
            else LRT[65536 + c * 32 + (kk - 256)] = (bf16)f2bf(l == 1 ? p.in[20][(kk - 256) * 256 + c] : 0.f);
            continue;
        }
        {
            const int idx = r * 256 + tid;
            const int t = idx >> 5, i = idx & 31;
            const float invf = (float)pow(10000.0, -(double)i / 32.0);
            const float ang = (float)p.pos[t] * invf;
            float sn, cs; sincosf(ang, &sn, &cs);
            float* ROT = (float*)(p.ws + WS_ROT);
            ROT[(size_t)idx * 2] = cs; ROT[(size_t)idx * 2 + 1] = sn;
        }
    }
}

DEVI float ada_sum(const float* ADAP, int idx) {
    float s = 0.f;
#pragma unroll
    for (int kc = 0; kc < 16; ++kc) s += ADAP[(size_t)kc * 12288 + idx];
    return s;
}
DEVI void phase_h0(const P& p) {
    const float* ADAP = (const float*)(p.ws + WS_ADAP);
    float* ADA = (float*)(p.ws + OFF_ADA);
    bf16* HB = (bf16*)(p.ws + WS_HB);
    if (blockIdx.x < 48) ADA[blockIdx.x * 256 + threadIdx.x] = ada_sum(ADAP, blockIdx.x * 256 + threadIdx.x);
    const size_t n4 = (size_t)S * D / 4;
    const int c = (int)(((size_t)blockIdx.x * NT + threadIdx.x) % (D / 4)) * 4;
    f32x4 sh, sc;
    sh.x = ada_sum(ADAP, c); sh.y = ada_sum(ADAP, c + 1); sh.z = ada_sum(ADAP, c + 2); sh.w = ada_sum(ADAP, c + 3);
    sc.x = ada_sum(ADAP, 1024 + c); sc.y = ada_sum(ADAP, 1025 + c); sc.z = ada_sum(ADAP, 1026 + c); sc.w = ada_sum(ADAP, 1027 + c);
    for (size_t i = (size_t)blockIdx.x * NT + threadIdx.x; i < n4; i += (size_t)gridDim.x * NT) {
        const f32x4 x = ((const f32x4*)p.in[0])[i];
        u32x2 o;
        o.x = pk2(x.x * (1.f + sc.x) + sh.x, x.y * (1.f + sc.y) + sh.y);
        o.y = pk2(x.z * (1.f + sc.z) + sh.z, x.w * (1.f + sc.w) + sh.w);
        ((u32x2*)HB)[i] = o;
    }
}

template <class AF, class BF>
DEVI void gemm_tile(char* smem, const bf16* __restrict__ Abase, AF arow, const bf16* __restrict__ Bbase, BF brow, int K, f32x4 (&acc)[4][8]) {
    const int tid = threadIdx.x, wid = tid >> 6, lane = tid & 63, wr = wid >> 1, wc = wid & 1, fr = lane & 15, fq = lane >> 4;
    const int r0 = tid >> 2;
    const int swz = ((tid & 3) ^ ((0x1320 >> (4 * ((tid >> 4) & 3))) & 3)) * 8;
    unsigned pa[2], pb[4];
#pragma unroll
    for (int i = 0; i < 2; ++i) pa[i] = arow(r0 + 64 * i) + swz;
#pragma unroll
    for (int i = 0; i < 4; ++i) pb[i] = brow(r0 + 64 * i) + swz;
#pragma unroll
    for (int m = 0; m < 4; ++m)
#pragma unroll
        for (int n = 0; n < 8; ++n) acc[m][n] = (f32x4){0.f, 0.f, 0.f, 0.f};
    const int nk = K / 32;
    const int ch = (fq ^ ((0x1320 >> (4 * ((fr >> 2) & 3))) & 3)) * 16;
#define GT_STAGE(kt) do { char* _sa = smem + ((kt) % 3) * 24576; char* _sb = _sa + 8192; \
        _Pragma("unroll") for (int _i = 0; _i < 2; ++_i) \
            __builtin_amdgcn_global_load_lds((const unsigned*)(Abase + pa[_i] + (kt) * 32), (unsigned*)(_sa + (tid + 256 * _i) * 16), 16, 0, 0); \
        _Pragma("unroll") for (int _i = 0; _i < 4; ++_i) \
            __builtin_amdgcn_global_load_lds((const unsigned*)(Bbase + pb[_i] + (kt) * 32), (unsigned*)(_sb + (tid + 256 * _i) * 16), 16, 0, 0); } while (0)
    asm volatile("s_waitcnt vmcnt(0)" ::: "memory");
    GT_STAGE(0); GT_STAGE(1);
    for (int kt = 0; kt < nk; ++kt) {
        if (kt + 1 < nk) asm volatile("s_waitcnt vmcnt(6)" ::: "memory");
        else asm volatile("s_waitcnt vmcnt(0)" ::: "memory");
        asm volatile("s_waitcnt lgkmcnt(0)" ::: "memory");
        __builtin_amdgcn_s_barrier();
        if (kt + 2 < nk) GT_STAGE(kt + 2);
        const char* SA = smem + (kt % 3) * 24576; const char* SB = SA + 8192;
        bf16x8 af[4], bfr[8];
#pragma unroll
        for (int m = 0; m < 4; ++m) af[m] = *(const bf16x8*)(SA + (wr * 64 + m * 16 + fr) * 64 + ch);
#pragma unroll
        for (int n = 0; n < 8; ++n) bfr[n] = *(const bf16x8*)(SB + (wc * 128 + n * 16 + fr) * 64 + ch);
#pragma unroll
        for (int m = 0; m < 4; ++m)
#pragma unroll
            for (int n = 0; n < 8; ++n)
                acc[m][n] = __builtin_amdgcn_mfma_f32_16x16x32_bf16(bfr[n], af[m], acc[m][n], 0, 0, 0);
    }
    asm volatile("s_waitcnt lgkmcnt(0)" ::: "memory");
    __builtin_amdgcn_s_barrier();
#undef GT_STAGE
}

DEVI void phase_inproj(const P& p, int l, char* smem) {
    const bf16* HB = (const bf16*)(p.ws + WS_HB);
    const bf16* W = (const bf16*)(p.ws + WS_WIN) + (size_t)l * NPAD * D;
    bf16* PROJ = (bf16*)(p.ws + WS_PROJ); float* PEX = (float*)(p.ws + WS_PEX);
    const int lane = threadIdx.x & 63, wid = threadIdx.x >> 6, wr = wid >> 1, wc = wid & 1, fr = lane & 15, fq = lane >> 4;
    constexpr int NMAIN = (S / 128) * 16;
    for (int tile = blockIdx.x; tile < NMAIN + S / 128; tile += gridDim.x) {
        int mt, nt;
        if (tile < NMAIN) { const int x = tile & 7, q = tile >> 3; nt = x + 8 * (q & 1); mt = q >> 1; }
        else { mt = tile - NMAIN; nt = 16; }
        f32x4 acc[4][8];
        gemm_tile(smem, HB, [&](int r) { return (unsigned)((mt * 128 + r) * D); }, W, [&](int r) { return (unsigned)((nt * 256 + r) * D); }, D, acc);
#pragma unroll
        for (int m = 0; m < 4; ++m) {
            const int tok = mt * 128 + wr * 64 + m * 16 + fr;
#pragma unroll
            for (int n = 0; n < 8; ++n) {
                const int f = wc * 128 + n * 16 + fq * 4;
                if (nt < 16) {
                    u32x2 o; o.x = pk2(acc[m][n].x, acc[m][n].y); o.y = pk2(acc[m][n].z, acc[m][n].w);
                    *(u32x2*)(PROJ + (size_t)tok * NPROJ + nt * 256 + f) = o;
                } else if (f < 64) {
                    *(f32x4*)(PEX + (size_t)tok * 64 + f) = acc[m][n];
                }
            }
        }
    }
}

DEVI float proj_at(const bf16* PROJ, int t, int col) { return bf2f(PROJ[(size_t)t * NPROJ + col]); }
DEVI float proj_shift(const bf16* PROJ, int t, int col, float mu) {
    const float cur = proj_at(PROJ, t, col);
    const float prv = t > 0 ? proj_at(PROJ, t - 1, col) : 0.f;
    return cur + (prv - cur) * mu;
}

DEVI f32x4 shift4(const bf16* PROJ, int t, int col, const f32x4& mu) {
    const f32x4 cur = ld_bf4(PROJ + (size_t)t * NPROJ + col);
    f32x4 prv = {0.f, 0.f, 0.f, 0.f};
    if (t > 0) prv = ld_bf4(PROJ + (size_t)(t - 1) * NPROJ + col);
    return cur + (prv - cur) * mu;
}
DEVI float fsig(float x) { return 1.f / (1.f + __expf(-x)); }
DEVI void phase_mixprep(const P& p, int l, char* smem) {
    const bf16* PROJ = (const bf16*)(p.ws + WS_PROJ); const float* PEX = (const float*)(p.ws + WS_PEX);
    float* VFIRST = (float*)(p.ws + WS_VFIRST);
    float* RECR = (float*)(p.ws + WS_RECR); float* RECG = (float*)(p.ws + WS_RECG); float* RECT = (float*)(p.ws + WS_RECT);
    float* GB = (float*)(p.ws + WS_G); float* BON = (float*)(p.ws + WS_BON);
    const float* ROT = (const float*)(p.ws + WS_ROT);
    const bf16* LRT = (const bf16*)(p.ws + WS_LRT) + (size_t)l * 73728;
    bf16* L = (bf16*)smem;
    const float* mu = p.in[7] + l * 1024;
    for (int item = blockIdx.x; item < S / 16; item += gridDim.x) {
        int tid = threadIdx.x; asm volatile("" : "+v"(tid));
        const int lane = tid & 63, w = tid >> 6, fr = lane & 15, fq = lane >> 4;
        const int t0 = item * 16;
        for (int g = tid; g < 16 * 72; g += NT) {
            const int tt = g / 72, i4 = (g % 72) * 4, t = t0 + tt;
            f32x4 v;
            if (i4 < 256) {
                const int col = 768 + i4;
                v = shift4(PROJ, t, col, *(const f32x4*)(mu + col));
                if (i4 < 64) { v.x = tanhf(v.x); v.y = tanhf(v.y); v.z = tanhf(v.z); v.w = tanhf(v.w); }
                else if (i4 >= 128) { v.x = fsig(v.x); v.y = fsig(v.y); v.z = fsig(v.z); v.w = fsig(v.w); }
            } else {
                v = (f32x4){0.f, 0.f, 0.f, 0.f};
                if (l == 1) {
                    const int j = i4 - 256;
                    const f32x4 cur = *(const f32x4*)(PEX + (size_t)t * 64 + 8 + j);
                    f32x4 prv = {0.f, 0.f, 0.f, 0.f};
                    if (t > 0) prv = *(const f32x4*)(PEX + (size_t)(t - 1) * 64 + 8 + j);
                    v = cur + (prv - cur) * *(const f32x4*)(p.in[8] + j);
                }
            }
            *(u32x2*)(L + tt * 296 + i4) = (u32x2){pk2(v.x, v.y), pk2(v.z, v.w)};
        }
        __syncthreads();
        const int t = t0 + fr, h = w;
        {
            f32x4 aw[4], aa[4], ag[4], av[4];
#pragma unroll
            for (int i = 0; i < 4; ++i) { aw[i] = (f32x4){0.f, 0.f, 0.f, 0.f}; aa[i] = aw[i]; ag[i] = aw[i]; av[i] = aw[i]; }
            bf16x8 lf[9];
#pragma unroll
            for (int ks = 0; ks < 9; ++ks) lf[ks] = *(const bf16x8*)(L + fr * 296 + ks * 32 + fq * 8);
#pragma unroll
            for (int i = 0; i < 4; ++i) {
                const int c = 64 * h + 16 * i + fr;
#pragma unroll
                for (int ks = 0; ks < 2; ++ks) aw[i] = mfma16(*(const bf16x8*)(LRT + c * 64 + ks * 32 + fq * 8), lf[ks], aw[i]);
#pragma unroll
                for (int ks = 0; ks < 2; ++ks) aa[i] = mfma16(*(const bf16x8*)(LRT + 16384 + c * 64 + ks * 32 + fq * 8), lf[2 + ks], aa[i]);
#pragma unroll
                for (int ks = 0; ks < 4; ++ks) ag[i] = mfma16(*(const bf16x8*)(LRT + 32768 + c * 128 + ks * 32 + fq * 8), lf[4 + ks], ag[i]);
                if (l == 1) av[i] = mfma16(*(const bf16x8*)(LRT + 65536 + c * 32 + fq * 8), lf[8], av[i]);
            }
            float* rec = RECR + ((size_t)t * 4 + h) * 384;
            f32x4 kx[4], as_[4];
            float ss = 0.f, bsum = 0.f;
#pragma unroll
            for (int i = 0; i < 4; ++i) {
                const int j = 16 * i + 4 * fq, c = 64 * h + j;
                const f32x4 r = shift4(PROJ, t, c, *(const f32x4*)(mu + c));
                const f32x4 k = shift4(PROJ, t, 256 + c, *(const f32x4*)(mu + 256 + c));
                f32x4 v = shift4(PROJ, t, 512 + c, *(const f32x4*)(mu + 512 + c));
                const f32x4 w0 = *(const f32x4*)(p.in[9] + l * 256 + c), a0 = *(const f32x4*)(p.in[11] + l * 256 + c);
                const f32x4 kkc = *(const f32x4*)(p.in[14] + l * 256 + c), kac = *(const f32x4*)(p.in[15] + l * 256 + c), rkc = *(const f32x4*)(p.in[16] + l * 256 + c);
                f32x4 dec, a;
#pragma unroll
                for (int q = 0; q < 4; ++q) {
                    const float wl = -softplusf_(-(w0[q] + aw[i][q])) - 0.5f;
                    dec[q] = __expf(-__expf(wl));
                    a[q] = fsig(a0[q] + aa[i][q]);
                }
                if (l == 0) *(f32x4*)(VFIRST + (size_t)t * 256 + c) = v;
                else {
                    const f32x4 vf = *(const f32x4*)(VFIRST + (size_t)t * 256 + c), v0 = *(const f32x4*)(p.in[19] + c);
#pragma unroll
                    for (int q = 0; q < 4; ++q) v[q] = v[q] + (vf[q] - v[q]) * fsig(v0[q] + av[i][q]);
                }
                kx[i] = k * kkc; as_[i] = a;
                const f32x4 k2 = k * ((a - 1.f) * kac + 1.f);
                ss += kx[i].x * kx[i].x + kx[i].y * kx[i].y + kx[i].z * kx[i].z + kx[i].w * kx[i].w;
                const f32x4 rb = r * k2 * rkc;
                bsum += (rb.x + rb.y) + (rb.z + rb.w);
                *(f32x4*)(rec + 64 + j) = dec; *(f32x4*)(rec + 192 + j) = k2; *(f32x4*)(rec + 256 + j) = r; *(f32x4*)(rec + 320 + j) = v;
                *(f32x4*)(GB + (size_t)t * 256 + c) = ag[i];
            }
            const float rn = rsqrtf(quad_sum(ss) + 1e-12f);
            bsum = quad_sum(bsum);
            if (fq == 0) BON[(size_t)t * 4 + h] = bsum;
#pragma unroll
            for (int i = 0; i < 4; ++i) {
                const int j = 16 * i + 4 * fq;
                const f32x4 kk = kx[i] * rn;
                *(f32x4*)(rec + j) = -kk; *(f32x4*)(rec + 128 + j) = kk * as_[i];
            }
        }
        {
            const float* conv_w = p.in[21] + l * 4 * 1536;
            float* rec = RECG + ((size_t)t * 4 + h) * 392;
            f32x4 yq[8], yk[8];
            float sq = 0.f, sk = 0.f;
#pragma unroll
            for (int which = 0; which < 3; ++which) {
#pragma unroll
                for (int i = 0; i < 8; ++i) {
                    const int j = 16 * i + 4 * fq, ch = which * 512 + h * 128 + j, col = 1024 + ch;
                    f32x4 cv = ld_bf4(PROJ + (size_t)t * NPROJ + col) * *(const f32x4*)(conv_w + 3 * 1536 + ch);
#pragma unroll
                    for (int tap = 0; tap < 3; ++tap) {
                        const int tp = t - 3 + tap;
                        if (tp >= 0) cv = cv + ld_bf4(PROJ + (size_t)tp * NPROJ + col) * *(const f32x4*)(conv_w + tap * 1536 + ch);
                    }
                    f32x4 y; y.x = siluf_(cv.x); y.y = siluf_(cv.y); y.z = siluf_(cv.z); y.w = siluf_(cv.w);
                    if (which == 0) { yq[i] = y; sq += y.x * y.x + y.y * y.y + y.z * y.z + y.w * y.w; }
                    else if (which == 1) { yk[i] = y; sk += y.x * y.x + y.y * y.y + y.z * y.z + y.w * y.w; }
                    else *(f32x4*)(rec + 256 + j) = y;
                }
            }
            const float rq = rsqrtf(quad_sum(sq) + 1e-12f) * 0.08838834764831845f, rk = rsqrtf(quad_sum(sk) + 1e-12f);
#pragma unroll
            for (int i = 0; i < 8; ++i) { const int j = 16 * i + 4 * fq; *(f32x4*)(rec + j) = yq[i] * rq; *(f32x4*)(rec + 128 + j) = yk[i] * rk; }
            if (fq == 0) {
                const float av = PEX[(size_t)t * 64 + h], bv = PEX[(size_t)t * 64 + 4 + h];
                const float g = -__expf(p.in[22][l * 4 + h]) * softplusf_(av + p.in[23][l * 4 + h]);
                *(f32x4*)(rec + 384) = (f32x4){__expf(g), fsig(bv), g, 0.f};
            }
        }
        {
            float* rec = RECT + ((size_t)t * 4 + h) * 192;
#pragma unroll
            for (int u = 0; u < 2; ++u) {
                const int i = 16 * u + 4 * fq;
                const f32x4 c0 = *(const f32x4*)(ROT + ((size_t)t * 32 + i) * 2), c1 = *(const f32x4*)(ROT + ((size_t)t * 32 + i) * 2 + 4);
                const f32x4 cs = {c0.x, c0.z, c1.x, c1.z}, sn = {c0.y, c0.w, c1.y, c1.w};
                const f32x4 q1 = ld_bf4(PROJ + (size_t)t * NPROJ + 3072 + h * 64 + i), q2 = ld_bf4(PROJ + (size_t)t * NPROJ + 3072 + h * 64 + 32 + i);
                const f32x4 k1 = ld_bf4(PROJ + (size_t)t * NPROJ + 3328 + h * 64 + i), k2 = ld_bf4(PROJ + (size_t)t * NPROJ + 3328 + h * 64 + 32 + i);
                *(f32x4*)(rec + i) = q1 * cs - q2 * sn; *(f32x4*)(rec + 32 + i) = q1 * sn + q2 * cs;
                *(f32x4*)(rec + 64 + i) = (k1 * cs - k2 * sn) * 0.125f; *(f32x4*)(rec + 96 + i) = (k1 * sn + k2 * cs) * 0.125f;
            }
#pragma unroll
            for (int i = 0; i < 4; ++i) { const int j = 16 * i + 4 * fq; *(f32x4*)(rec + 128 + j) = ld_bf4(PROJ + (size_t)t * NPROJ + 3584 + h * 64 + j); }
        }
        __syncthreads();
    }
}

DEVI void scan_rwkv(const P& p, int item, char* smem) {
    const float* REC = (const float*)(p.ws + WS_RECR); float* YR = (float*)(p.ws + WS_YR);
    float* L = (float*)smem;
    const int h = item >> 2, rg = item & 3;
    const int tid = threadIdx.x, lane = tid & 63, w = tid >> 6, sub = lane & 15;
    const int i = rg * 16 + w * 4 + (lane >> 4);
    float s0 = 0.f, s1 = 0.f, s2 = 0.f, s3 = 0.f;
    for (int c0 = 0; c0 < S; c0 += 32) {
        for (int idx = tid; idx < 32 * 96; idx += NT) {
            const int tok = idx / 96, f4 = idx % 96;
            ((f32x4*)L)[idx] = *(const f32x4*)(REC + ((size_t)(c0 + tok) * 4 + h) * 384 + f4 * 4);
        }
        __syncthreads();
        for (int tt = 0; tt < 32; ++tt) {
            const float* R = L + tt * 384;
            const f32x4 a = *(const f32x4*)(R + sub * 4), wv = *(const f32x4*)(R + 64 + sub * 4), b = *(const f32x4*)(R + 128 + sub * 4);
            const f32x4 k = *(const f32x4*)(R + 192 + sub * 4), r = *(const f32x4*)(R + 256 + sub * 4);
            const float v = R[320 + i];
            const float sa = row16_sum(s0 * a.x + s1 * a.y + s2 * a.z + s3 * a.w);
            s0 = s0 * wv.x + sa * b.x + v * k.x; s1 = s1 * wv.y + sa * b.y + v * k.y;
            s2 = s2 * wv.z + sa * b.z + v * k.z; s3 = s3 * wv.w + sa * b.w + v * k.w;
            const float y = row16_sum(s0 * r.x + s1 * r.y + s2 * r.z + s3 * r.w);
            if (sub == 0) YR[(size_t)(c0 + tt) * 256 + h * 64 + i] = y;
        }
        __syncthreads();
    }
}
DEVI void scan_gdn(const P& p, int item, char* smem) {
    const float* REC = (const float*)(p.ws + WS_RECG); float* OG = (float*)(p.ws + WS_OG);
    float* L = (float*)smem;
    const int h = item >> 3, eg = item & 7;
    const int tid = threadIdx.x, lane = tid & 63, w = tid >> 6, sub = lane & 15;
    const int e = eg * 16 + w * 4 + (lane >> 4);
    float s[8];
#pragma unroll
    for (int j = 0; j < 8; ++j) s[j] = 0.f;
    for (int c0 = 0; c0 < S; c0 += 32) {
        for (int idx = tid; idx < 32 * 98; idx += NT) {
            const int tok = idx / 98, f4 = idx % 98;
            ((f32x4*)L)[idx] = *(const f32x4*)(REC + ((size_t)(c0 + tok) * 4 + h) * 392 + f4 * 4);
        }
        __syncthreads();
        for (int tt = 0; tt < 32; ++tt) {
            const float* R = L + tt * 392;
            const f32x4 q0 = *(const f32x4*)(R + sub * 8), q1 = *(const f32x4*)(R + sub * 8 + 4);
            const f32x4 k0 = *(const f32x4*)(R + 128 + sub * 8), k1 = *(const f32x4*)(R + 128 + sub * 8 + 4);
            const float v = R[256 + e], dec = R[384], beta = R[385];
#pragma unroll
            for (int j = 0; j < 8; ++j) s[j] *= dec;
            const float kS = row16_sum(s[0] * k0.x + s[1] * k0.y + s[2] * k0.z + s[3] * k0.w + s[4] * k1.x + s[5] * k1.y + s[6] * k1.z + s[7] * k1.w);
            const float cf = beta * (v - kS);
            s[0] += cf * k0.x; s[1] += cf * k0.y; s[2] += cf * k0.z; s[3] += cf * k0.w;
            s[4] += cf * k1.x; s[5] += cf * k1.y; s[6] += cf * k1.z; s[7] += cf * k1.w;
            const float o = row16_sum(s[0] * q0.x + s[1] * q0.y + s[2] * q0.z + s[3] * q0.w + s[4] * q1.x + s[5] * q1.y + s[6] * q1.z + s[7] * q1.w);
            if (sub == 0) OG[(size_t)(c0 + tt) * 512 + h * 128 + e] = o;
        }
        __syncthreads();
    }
}
DEVI void scan_ret(const P& p, int item, char* smem) {
    const float* REC = (const float*)(p.ws + WS_RECT); float* ORT = (float*)(p.ws + WS_ORT);
    float* L = (float*)smem;
    const int h = item >> 2, eg = item & 3;
    const int tid = threadIdx.x, lane = tid & 63, w = tid >> 6, sub = lane & 15;
    const int e = eg * 16 + w * 4 + (lane >> 4);
    const float gam = 1.f - exp2f(-5.f - (float)h);
    float s0 = 0.f, s1 = 0.f, s2 = 0.f, s3 = 0.f;
    for (int c0 = 0; c0 < S; c0 += 32) {
        for (int idx = tid; idx < 32 * 48; idx += NT) {
            const int tok = idx / 48, f4 = idx % 48;
            ((f32x4*)L)[idx] = *(const f32x4*)(REC + ((size_t)(c0 + tok) * 4 + h) * 192 + f4 * 4);
        }
        __syncthreads();
        for (int tt = 0; tt < 32; ++tt) {
            const float* R = L + tt * 192;
            const f32x4 q = *(const f32x4*)(R + sub * 4), k = *(const f32x4*)(R + 64 + sub * 4);
            const float v = R[128 + e];
            s0 = s0 * gam + k.x * v; s1 = s1 * gam + k.y * v; s2 = s2 * gam + k.z * v; s3 = s3 * gam + k.w * v;
            const float o = row16_sum(s0 * q.x + s1 * q.y + s2 * q.z + s3 * q.w);
            if (sub == 0) ORT[(size_t)(c0 + tt) * 256 + h * 64 + e] = o;
        }
        __syncthreads();
    }
}
DEVI void retA_item(const P& p, int item, char* smem) {
    const float* REC = (const float*)(p.ws + WS_RECT); float* KV = (float*)(p.ws + WS_RKV);
    bf16* KT = (bf16*)smem; bf16* VT = KT + 64 * 72;
    const int n = item >> 2, h = item & 3;
    int tid = threadIdx.x; asm volatile("" : "+v"(tid));
    const int lane = tid & 63, w = tid >> 6, fr = lane & 15, fq = lane >> 4;
    const float lg = log2f(1.f - exp2f(-5.f - (float)h));
    {
        const int d = lane;
        unsigned kp[8], vp[8];
#pragma unroll
        for (int i = 0; i < 8; ++i) {
            const int c0 = 16 * w + 2 * i;
            const float* r0 = REC + ((size_t)(n * 64 + c0) * 4 + h) * 192;
            const float* r1 = r0 + 4 * 192;
            kp[i] = pk2(r0[64 + d] * exp2f((float)(63 - c0) * lg), r1[64 + d] * exp2f((float)(62 - c0) * lg));
            vp[i] = pk2(r0[128 + d], r1[128 + d]);
        }
        *(u32x4*)(KT + d * 72 + 16 * w) = (u32x4){kp[0], kp[1], kp[2], kp[3]};
        *(u32x4*)(KT + d * 72 + 16 * w + 8) = (u32x4){kp[4], kp[5], kp[6], kp[7]};
        *(u32x4*)(VT + d * 72 + 16 * w) = (u32x4){vp[0], vp[1], vp[2], vp[3]};
        *(u32x4*)(VT + d * 72 + 16 * w + 8) = (u32x4){vp[4], vp[5], vp[6], vp[7]};
    }
    __syncthreads();
    {
        const int dt = w;
        const bf16x8 a0 = ldfrag(KT, 72, 16 * dt, 0, lane), a1 = ldfrag(KT, 72, 16 * dt, 32, lane);
        float* out = KV + (size_t)item * 4096;
        const int s_ = dt >> 1, lane2 = 16 * (2 * (dt & 1) + (fq >> 1)) + fr;
#pragma unroll
        for (int et = 0; et < 4; ++et) {
            f32x4 acc = {0.f, 0.f, 0.f, 0.f};
            acc = mfma16(a0, ldfrag(VT, 72, 16 * et, 0, lane), acc);
            acc = mfma16(a1, ldfrag(VT, 72, 16 * et, 32, lane), acc);
            *(f32x4*)(out + ((et * 2 + s_) * 64 + lane2) * 8 + 4 * (fq & 1)) = acc;
        }
    }
    __syncthreads();
}

DEVI void retS_item(const P& p, int item) {
    const float* KV = (const float*)(p.ws + WS_RKV); bf16* RST = (bf16*)(p.ws + WS_RST);
    const int idx = item * NT + threadIdx.x;
    const int h = idx >> 12, i = idx & 4095;
    const float cd = exp2f(64.f * log2f(1.f - exp2f(-5.f - (float)h)));
    float r = 0.f;
#pragma unroll 8
    for (int n = 0; n < 256; ++n) {
        const float kv = KV[((size_t)n * 4 + h) * 4096 + i];
        RST[((size_t)n * 4 + h) * 4096 + i] = (bf16)f2bf(r);
        r = r * cd + kv;
    }
}

DEVI void retC_item(const P& p, int item, int l, char* smem) {
    const float* REC = (const float*)(p.ws + WS_RECT); const bf16* RST = (const bf16*)(p.ws + WS_RST);
    const bf16* PROJ = (const bf16*)(p.ws + WS_PROJ); bf16* MIX = (bf16*)(p.ws + WS_MIX);
    const float* rgn = p.in[25] + l * 256; const float* rbn = p.in[26] + l * 256;
    bf16* Qs = (bf16*)smem; bf16* Ks = Qs + 64 * 72; bf16* VT = Ks + 64 * 72; bf16* Ps = VT + 64 * 72;
    const int n = item >> 2, h = item & 3;
    int tid = threadIdx.x; asm volatile("" : "+v"(tid));
    const int lane = tid & 63, w = tid >> 6, fr = lane & 15, fq = lane >> 4;
    const float lg = log2f(1.f - exp2f(-5.f - (float)h));
    {
        const int d = lane;
        unsigned vp[8];
#pragma unroll
        for (int i = 0; i < 8; ++i) {
            const int c0 = 16 * w + 2 * i;
            const float* r0 = REC + ((size_t)(n * 64 + c0) * 4 + h) * 192;
            const float* r1 = r0 + 4 * 192;
            Qs[c0 * 72 + d] = (bf16)f2bf(r0[d]); Qs[(c0 + 1) * 72 + d] = (bf16)f2bf(r1[d]);
            Ks[c0 * 72 + d] = (bf16)f2bf(r0[64 + d]); Ks[(c0 + 1) * 72 + d] = (bf16)f2bf(r1[64 + d]);
            vp[i] = pk2(r0[128 + d], r1[128 + d]);
        }
        *(u32x4*)(VT + d * 72 + 16 * w) = (u32x4){vp[0], vp[1], vp[2], vp[3]};
        *(u32x4*)(VT + d * 72 + 16 * w + 8) = (u32x4){vp[4], vp[5], vp[6], vp[7]};
    }
    __syncthreads();
    const int ct = w, c = 16 * ct + fr;
    const bf16x8 q0 = ldfrag(Qs, 72, 16 * ct, 0, lane), q1 = ldfrag(Qs, 72, 16 * ct, 32, lane);
#pragma unroll
    for (int ct2 = 0; ct2 < 4; ++ct2) {
        f32x4 acc = {0.f, 0.f, 0.f, 0.f};
        acc = mfma16(ldfrag(Ks, 72, 16 * ct2, 0, lane), q0, acc);
        acc = mfma16(ldfrag(Ks, 72, 16 * ct2, 32, lane), q1, acc);
        float pv[4];
#pragma unroll
        for (int j = 0; j < 4; ++j) {
            const int c2 = 16 * ct2 + 4 * fq + j;
            pv[j] = (c >= c2) ? acc[j] * exp2f((float)(c - c2) * lg) : 0.f;
        }
        *(u32x2*)(Ps + c * 72 + 16 * ct2 + 4 * fq) = (u32x2){pk2(pv[0], pv[1]), pk2(pv[2], pv[3])};
    }
    __syncthreads();
    {
        const bf16x8 p0 = ldfrag(Ps, 72, 16 * ct, 0, lane), p1 = ldfrag(Ps, 72, 16 * ct, 32, lane);
        const float xi = exp2f((float)(c + 1) * lg);
        const bf16* RF = RST + (size_t)item * 4096;
        f32x4 o[4];
        float sm = 0.f;
#pragma unroll
        for (int et = 0; et < 4; ++et) {
            f32x4 ai = {0.f, 0.f, 0.f, 0.f}, ax = {0.f, 0.f, 0.f, 0.f};
            ai = mfma16(ldfrag(VT, 72, 16 * et, 0, lane), p0, ai);
            ai = mfma16(ldfrag(VT, 72, 16 * et, 32, lane), p1, ai);
            const bf16x8 r0 = *(const bf16x8*)(RF + ((et * 2 + 0) * 64 + lane) * 8);
            const bf16x8 r1 = *(const bf16x8*)(RF + ((et * 2 + 1) * 64 + lane) * 8);
            ax = mfma16(r0, q0, ax);
            ax = mfma16(r1, q1, ax);
            o[et] = ai + ax * xi;
            sm += (o[et].x + o[et].y) + (o[et].z + o[et].w);
        }
        const float mean = quad_sum(sm) * (1.f / 64.f);
        float sv = 0.f;
#pragma unroll
        for (int et = 0; et < 4; ++et) { o[et] = o[et] - mean; sv += o[et].x * o[et].x + o[et].y * o[et].y + o[et].z * o[et].z + o[et].w * o[et].w; }
        const float rs = rsqrtf(quad_sum(sv) * (1.f / 64.f) + 1e-5f);
        const int t = n * 64 + c;
#pragma unroll
        for (int et = 0; et < 4; ++et) {
            const int e = h * 64 + 16 * et + 4 * fq;
            const f32x4 g = *(const f32x4*)(rgn + e), b = *(const f32x4*)(rbn + e);
            const f32x4 gt = ld_bf4(PROJ + (size_t)t * NPROJ + 3840 + e);
            const f32x4 y = o[et] * rs * g + b;
            *(u32x2*)(MIX + (size_t)t * D + 768 + e) = (u32x2){pk2(y.x * siluf_(gt.x), y.y * siluf_(gt.y)), pk2(y.z * siluf_(gt.z), y.w * siluf_(gt.w))};
        }
    }
    __syncthreads();
}

template <int I, int N> struct SolveRow {
    static DEVI void run(float (&x)[N], const float* M) {
        float s = 0.f;
#pragma unroll
        for (int j4 = 0; j4 < (I + 3) / 4; ++j4) {
            const f32x4 m = *(const f32x4*)(M + I * N + 4 * j4);
            s += m.x * x[4 * j4] + m.y * x[4 * j4 + 1] + m.z * x[4 * j4 + 2] + m.w * x[4 * j4 + 3];
        }
        x[I] -= s;
        asm volatile("" : "+v"(x[I]) :: "memory");
        SolveRow<I + 1, N>::run(x, M);
    }
};
template <int N> struct SolveRow<N, N> { static DEVI void run(float (&)[N], const float*) {} };

DEVI void gdnA_item(const P& p, int item, char* smem) {
    const float* REC = (const float*)(p.ws + WS_RECG);
    bf16* GP = (bf16*)(p.ws + WS_GP) + (size_t)item * 16384; float* GB = (float*)(p.ws + WS_GB) + (size_t)item * 16384;
    float* GD = (float*)(p.ws + WS_GD);
    bf16* GQ = (bf16*)(p.ws + WS_GQ) + (size_t)item * 8192; float* GO = (float*)(p.ws + WS_GO) + (size_t)item * 8192;
    bf16* Kb = (bf16*)smem; bf16* Qb = Kb + 64 * 136;
    bf16* WT = (bf16*)smem; bf16* UT = WT + 128 * 72;
    bf16* Vb = (bf16*)(smem + 36864);
    float* M = (float*)(smem + 36864);
    bf16* KdT = (bf16*)(smem + 36864);
    bf16* At = (bf16*)(smem + 55296);
    float* gcs = (float*)(smem + 64512); float* bts = gcs + 64; float* sws = gcs + 128; float* sks = gcs + 192;
    const int n = item >> 2, h = item & 3;
    int tid = threadIdx.x; asm volatile("" : "+v"(tid));
    const int lane = tid & 63, w = tid >> 6, fr = lane & 15, fq = lane >> 4;
    const float* rec0 = REC + ((size_t)(n * 64) * 4 + h) * 392;
    if (w == 0) {
        float x = rec0[(size_t)lane * 1568 + 386];
#pragma unroll
        for (int off = 1; off < 64; off <<= 1) { const float y = __shfl_up(x, off); if (lane >= off) x += y; }
        const float bt = rec0[(size_t)lane * 1568 + 385];
        gcs[lane] = x; bts[lane] = bt; sws[lane] = bt * __expf(x); sks[lane] = __expf(__shfl(x, 63) - x);
    }
#pragma unroll 2
    for (int i = 0; i < 16; ++i) {
        const int c = 16 * w + i;
        const float* r = rec0 + (size_t)c * 1568;
        Qb[c * 136 + lane] = (bf16)f2bf(r[lane]); Qb[c * 136 + 64 + lane] = (bf16)f2bf(r[64 + lane]);
        Kb[c * 136 + lane] = (bf16)f2bf(r[128 + lane]); Kb[c * 136 + 64 + lane] = (bf16)f2bf(r[192 + lane]);
        Vb[c * 136 + lane] = (bf16)f2bf(r[256 + lane]); Vb[c * 136 + 64 + lane] = (bf16)f2bf(r[320 + lane]);
    }
    __syncthreads();
    float x[64];
    unsigned kdp[16];
    {
        const int col = tid & 127;
        int sel_b = (tid < 128) ? 36864 : 0, sel_s = (tid < 128) ? 64 : 128;
        asm volatile("" : "+v"(sel_b), "+v"(sel_s));
        const bf16* srcb = (const bf16*)(smem + sel_b) + col;
        const float* scs = gcs + sel_s;
#pragma unroll
        for (int c = 0; c < 64; ++c) {
            x[c] = scs[c] * bf2f(srcb[c * 136]);
            if ((c & 7) == 7) asm volatile("" : "+v"(x[c]) :: "memory");
        }
        const int half = tid >> 7;
#pragma unroll
        for (int i = 0; i < 16; ++i) {
            const int c = 32 * half + 2 * i;
            kdp[i] = pk2(bf2f(Kb[c * 136 + col]) * sks[c], bf2f(Kb[(c + 1) * 136 + col]) * sks[c + 1]);
            if ((i & 3) == 3) asm volatile("" : "+v"(kdp[i]) :: "memory");
        }
        if (tid == 0) GD[item] = __expf(gcs[63]);
    }
    __syncthreads();
    const int ct = w;
    f32x4 accQ[8];
    {
        const int c = 16 * ct + fr;
        const float gcc = gcs[c];
        {
            bf16x8 ka[4];
#pragma unroll
            for (int s = 0; s < 4; ++s) ka[s] = ldfrag(Kb, 136, 16 * ct, 32 * s, lane);
#pragma unroll
            for (int ct2 = 0; ct2 < 4; ++ct2) {
                f32x4 acc = {0.f, 0.f, 0.f, 0.f};
#pragma unroll
                for (int s = 0; s < 4; ++s) acc = mfma16(ka[s], ldfrag(Kb, 136, 16 * ct2, 32 * s, lane), acc);
                const int c2 = 16 * ct2 + fr; const float g2 = gcs[c2];
#pragma unroll
                for (int j = 0; j < 4; ++j) {
                    const int cc = 16 * ct + 4 * fq + j;
                    M[cc * 64 + c2] = (cc > c2) ? bts[cc] * acc[j] * __expf(gcs[cc] - g2) : 0.f;
                }
            }
        }
        {
            bf16x8 qa[4];
#pragma unroll
            for (int s = 0; s < 4; ++s) qa[s] = ldfrag(Qb, 136, 16 * ct, 32 * s, lane);
#pragma unroll
            for (int ct2 = 0; ct2 < 4; ++ct2) {
                f32x4 acc = {0.f, 0.f, 0.f, 0.f};
#pragma unroll
                for (int s = 0; s < 4; ++s) acc = mfma16(ldfrag(Kb, 136, 16 * ct2, 32 * s, lane), qa[s], acc);
                float pv[4];
#pragma unroll
                for (int j = 0; j < 4; ++j) { const int c2 = 16 * ct2 + 4 * fq + j; pv[j] = (c >= c2) ? acc[j] * __expf(gcc - gcs[c2]) : 0.f; }
                *(u32x2*)(At + c * 72 + 16 * ct2 + 4 * fq) = (u32x2){pk2(pv[0], pv[1]), pk2(pv[2], pv[3])};
            }
        }
        const float eg = __expf(gcc);
#pragma unroll
        for (int dt = 0; dt < 8; ++dt) {
            const u32x2 qv = *(const u32x2*)(Qb + c * 136 + 16 * dt + 4 * fq);
            accQ[dt] = (f32x4){-eg * __uint_as_float(qv.x << 16), -eg * __uint_as_float(qv.x & 0xffff0000u),
                               -eg * __uint_as_float(qv.y << 16), -eg * __uint_as_float(qv.y & 0xffff0000u)};
        }
    }
    __syncthreads();
    {
        SolveRow<1, 64>::run(x, M);
        int sel_d = (tid < 128) ? 128 * 72 : 0;
        asm volatile("" : "+v"(sel_d));
        bf16* dst = WT + sel_d + (tid & 127) * 72;
#pragma unroll
        for (int q = 0; q < 8; ++q)
            *(u32x4*)(dst + 8 * q) = (u32x4){pk2(x[8 * q], x[8 * q + 1]), pk2(x[8 * q + 2], x[8 * q + 3]), pk2(x[8 * q + 4], x[8 * q + 5]), pk2(x[8 * q + 6], x[8 * q + 7])};
    }
    __syncthreads();
    {
        const int d = tid & 127, half = tid >> 7;
#pragma unroll
        for (int q = 0; q < 4; ++q) *(u32x4*)(KdT + d * 72 + 32 * half + 8 * q) = (u32x4){kdp[4 * q], kdp[4 * q + 1], kdp[4 * q + 2], kdp[4 * q + 3]};
    }
    __syncthreads();
    {
#pragma unroll 1
        for (int mi = 0; mi < 2; ++mi) {
            const int mt = 2 * w + mi;
            const bf16x8 kd0 = ldfrag(KdT, 72, 16 * mt, 0, lane), kd1 = ldfrag(KdT, 72, 16 * mt, 32, lane);
#pragma unroll
            for (int sp = 0; sp < 4; ++sp) {
                f32x4 a0 = {0.f, 0.f, 0.f, 0.f}, a1 = {0.f, 0.f, 0.f, 0.f};
                a0 = mfma16(ldfrag(WT, 72, 32 * sp, 0, lane), kd0, a0); a0 = mfma16(ldfrag(WT, 72, 32 * sp, 32, lane), kd1, a0);
                a1 = mfma16(ldfrag(WT, 72, 32 * sp + 16, 0, lane), kd0, a1); a1 = mfma16(ldfrag(WT, 72, 32 * sp + 16, 32, lane), kd1, a1);
                *(u32x4*)(GP + ((mt * 4 + sp) * 64 + lane) * 8) = (u32x4){pk2(-a0.x, -a0.y), pk2(-a0.z, -a0.w), pk2(-a1.x, -a1.y), pk2(-a1.z, -a1.w)};
            }
#pragma unroll
            for (int nt = 0; nt < 8; ++nt) {
                f32x4 a = {0.f, 0.f, 0.f, 0.f};
                a = mfma16(kd0, ldfrag(UT, 72, 16 * nt, 0, lane), a); a = mfma16(kd1, ldfrag(UT, 72, 16 * nt, 32, lane), a);
                *(f32x4*)(GB + ((nt * 8 + mt) * 64 + lane) * 4) = a;
            }
        }
        const bf16x8 at0 = ldfrag(At, 72, 16 * ct, 0, lane), at1 = ldfrag(At, 72, 16 * ct, 32, lane);
#pragma unroll
        for (int sp = 0; sp < 4; ++sp) {
            f32x4 a0 = accQ[2 * sp], a1 = accQ[2 * sp + 1];
            a0 = mfma16(ldfrag(WT, 72, 32 * sp, 0, lane), at0, a0); a0 = mfma16(ldfrag(WT, 72, 32 * sp, 32, lane), at1, a0);
            a1 = mfma16(ldfrag(WT, 72, 32 * sp + 16, 0, lane), at0, a1); a1 = mfma16(ldfrag(WT, 72, 32 * sp + 16, 32, lane), at1, a1);
            *(u32x4*)(GQ + ((ct * 4 + sp) * 64 + lane) * 8) = (u32x4){pk2(-a0.x, -a0.y), pk2(-a0.z, -a0.w), pk2(-a1.x, -a1.y), pk2(-a1.z, -a1.w)};
        }
#pragma unroll
        for (int et = 0; et < 8; ++et) {
            f32x4 a = {0.f, 0.f, 0.f, 0.f};
            a = mfma16(ldfrag(UT, 72, 16 * et, 0, lane), at0, a); a = mfma16(ldfrag(UT, 72, 16 * et, 32, lane), at1, a);
            *(f32x4*)(GO + ((ct * 8 + et) * 64 + lane) * 4) = a;
        }
    }
    __syncthreads();
}

DEVI bf16x8 pack_frag(const f32x4& a, const f32x4& b) {
    const u32x4 v = {pk2(a.x, a.y), pk2(a.z, a.w), pk2(b.x, b.y), pk2(b.z, b.w)};
    return __builtin_bit_cast(bf16x8, v);
}
DEVI void gdnL1_item(const P& p, int item) {
    const bf16* GP = (const bf16*)(p.ws + WS_GP); const float* GB = (const float*)(p.ws + WS_GB); const float* GD = (const float*)(p.ws + WS_GD);
    const int half = item & 1, kind = (item >> 1) & 1, g = (item >> 2) & 15, h = item >> 6;
    const int lane = threadIdx.x & 63, ew = half * 4 + (threadIdx.x >> 6), fr = lane & 15, fq = lane >> 4;
    f32x4 acc[8];
    if (kind == 0) {
        bf16* GS = (bf16*)(p.ws + WS_GS);
#pragma unroll
        for (int m = 0; m < 8; ++m) acc[m] = (f32x4){0.f, 0.f, 0.f, 0.f};
#pragma unroll 1
        for (int n = g * 16; n < g * 16 + 16; ++n) {
            const size_t it = (size_t)n * 4 + h;
            const bf16* Pn = GP + it * 16384 + lane * 8; const float* Bn = GB + it * 16384 + (ew * 8 * 64 + lane) * 4;
            bf16x8 pf[32]; f32x4 bfr[8];
#pragma unroll
            for (int i = 0; i < 32; ++i) pf[i] = *(const bf16x8*)(Pn + i * 512);
#pragma unroll
            for (int m = 0; m < 8; ++m) bfr[m] = *(const f32x4*)(Bn + m * 256);
            const float dn = GD[it];
            asm volatile("" ::: "memory");
            bf16x8 sf[4];
#pragma unroll
            for (int s = 0; s < 4; ++s) {
                sf[s] = pack_frag(acc[2 * s], acc[2 * s + 1]);
                *(bf16x8*)(GS + it * 16384 + ((ew * 4 + s) * 64 + lane) * 8) = sf[s];
            }
#pragma unroll
            for (int m = 0; m < 8; ++m) {
                f32x4 a = acc[m] * dn + bfr[m];
#pragma unroll
                for (int s = 0; s < 4; ++s) a = mfma16(pf[m * 4 + s], sf[s], a);
                acc[m] = a;
            }
        }
        float* E0 = (float*)(p.ws + WS_GE0) + (size_t)(h * 16 + g) * 16384 + (ew * 8 * 64 + lane) * 4;
#pragma unroll
        for (int m = 0; m < 8; ++m) *(f32x4*)(E0 + m * 256) = acc[m];
    } else {
        const bf16* GQ = (const bf16*)(p.ws + WS_GQ); bf16* GR = (bf16*)(p.ws + WS_GR);
#pragma unroll
        for (int m = 0; m < 8; ++m)
#pragma unroll
            for (int j = 0; j < 4; ++j) acc[m][j] = (m == ew && 4 * fq + j == fr) ? 1.f : 0.f;
#pragma unroll 1
        for (int n = g * 16; n < g * 16 + 16; ++n) {
            const size_t it = (size_t)n * 4 + h;
            const bf16* Pn = GP + it * 16384 + lane * 8;
            bf16x8 pf[16], qf[16];
#pragma unroll
            for (int i = 0; i < 16; ++i) pf[i] = *(const bf16x8*)(Pn + i * 512);
            const float dn = GD[it];
#pragma unroll
            for (int i = 0; i < 16; ++i) qf[i] = *(const bf16x8*)(GQ + it * 8192 + (i * 64 + lane) * 8);
            asm volatile("" ::: "memory");
            bf16x8 tf[4];
#pragma unroll
            for (int s = 0; s < 4; ++s) tf[s] = pack_frag(acc[2 * s], acc[2 * s + 1]);
#pragma unroll
            for (int tt = 0; tt < 4; ++tt) {
                f32x4 r = {0.f, 0.f, 0.f, 0.f};
#pragma unroll
                for (int s = 0; s < 4; ++s) r = mfma16(tf[s], qf[tt * 4 + s], r);
                *(u32x2*)(GR + it * 8192 + ((tt * 4 + (ew >> 1)) * 64 + lane) * 8 + 4 * (ew & 1)) = (u32x2){pk2(r.x, r.y), pk2(r.z, r.w)};
            }
            bf16x8 ph[16];
#pragma unroll
            for (int i = 0; i < 16; ++i) ph[i] = *(const bf16x8*)(Pn + (16 + i) * 512);
            asm volatile("" ::: "memory");
#pragma unroll
            for (int m = 0; m < 4; ++m) {
                f32x4 a = acc[m] * dn;
#pragma unroll
                for (int s = 0; s < 4; ++s) a = mfma16(pf[m * 4 + s], tf[s], a);
                acc[m] = a;
            }
#pragma unroll
            for (int m = 4; m < 8; ++m) {
                f32x4 a = acc[m] * dn;
#pragma unroll
                for (int s = 0; s < 4; ++s) a = mfma16(ph[(m - 4) * 4 + s], tf[s], a);
                acc[m] = a;
            }
        }
        bf16* TE = (bf16*)(p.ws + WS_GTE) + (size_t)(h * 16 + g) * 16384;
        int lane2 = threadIdx.x & 63; asm volatile("" : "+v"(lane2));
        const int fr2 = lane2 & 15, fq2 = lane2 >> 4;
        const int s_ = ew >> 1, jj = 4 * (ew & 1) + (fr2 & 3), lg = fr2 >> 2;
#pragma unroll
        for (int m = 0; m < 8; ++m)
#pragma unroll
            for (int j = 0; j < 4; ++j) TE[((m * 4 + s_) * 64 + (4 * fq2 + j) + 16 * lg) * 8 + jj] = (bf16)f2bf(acc[m][j]);
    }
}
DEVI void gdnL2_item(const P& p, int item) {
    const bf16* TE = (const bf16*)(p.ws + WS_GTE); const float* E0 = (const float*)(p.ws + WS_GE0); bf16* SG = (bf16*)(p.ws + WS_GSG);
    const int h = item >> 1, lane = threadIdx.x & 63, ew = (item & 1) * 4 + (threadIdx.x >> 6);
    f32x4 acc[8];
#pragma unroll
    for (int m = 0; m < 8; ++m) acc[m] = (f32x4){0.f, 0.f, 0.f, 0.f};
#pragma unroll 1
    for (int g = 0; g < 16; ++g) {
        const size_t hg = (size_t)h * 16 + g;
        const bf16* Tn = TE + hg * 16384 + lane * 8; const float* En = E0 + hg * 16384 + (ew * 8 * 64 + lane) * 4;
        bf16x8 pf[32]; f32x4 bfr[8];
#pragma unroll
        for (int i = 0; i < 32; ++i) pf[i] = *(const bf16x8*)(Tn + i * 512);
#pragma unroll
        for (int m = 0; m < 8; ++m) bfr[m] = *(const f32x4*)(En + m * 256);
        asm volatile("" ::: "memory");
        bf16x8 sf[4];
#pragma unroll
        for (int s = 0; s < 4; ++s) {
            sf[s] = pack_frag(acc[2 * s], acc[2 * s + 1]);
            *(bf16x8*)(SG + hg * 16384 + ((ew * 4 + s) * 64 + lane) * 8) = sf[s];
        }
#pragma unroll
        for (int m = 0; m < 8; ++m) {
            f32x4 a = bfr[m];
#pragma unroll
            for (int s = 0; s < 4; ++s) a = mfma16(pf[m * 4 + s], sf[s], a);
            acc[m] = a;
        }
    }
}

DEVI void gdnC_item(const P& p, int item, int l) {
    const bf16* GQ = (const bf16*)(p.ws + WS_GQ) + (size_t)item * 8192; const float* GO = (const float*)(p.ws + WS_GO) + (size_t)item * 8192;
    const bf16* GS = (const bf16*)(p.ws + WS_GS) + (size_t)item * 16384;
    const bf16* PROJ = (const bf16*)(p.ws + WS_PROJ); bf16* MIX = (bf16*)(p.ws + WS_MIX);
    const float* gn = p.in[24] + l * 128;
    const int n = item >> 2, h = item & 3;
    const int lane = threadIdx.x & 63, ct = threadIdx.x >> 6, fr = lane & 15, fq = lane >> 4;
    const bf16* GR = (const bf16*)(p.ws + WS_GR) + (size_t)item * 8192;
    const bf16* SG = (const bf16*)(p.ws + WS_GSG) + (size_t)(h * 16 + (n >> 4)) * 16384;
    bf16x8 qf[4], rf[4];
#pragma unroll
    for (int s = 0; s < 4; ++s) { qf[s] = *(const bf16x8*)(GQ + ((ct * 4 + s) * 64 + lane) * 8); rf[s] = *(const bf16x8*)(GR + ((ct * 4 + s) * 64 + lane) * 8); }
    const int t = n * 64 + 16 * ct + fr;
    f32x4 a[8];
    float ss = 0.f;
#pragma unroll
    for (int et = 0; et < 8; ++et) {
        f32x4 acc = *(const f32x4*)(GO + ((ct * 8 + et) * 64 + lane) * 4);
#pragma unroll
        for (int s = 0; s < 4; ++s) acc = mfma16(*(const bf16x8*)(GS + ((et * 4 + s) * 64 + lane) * 8), qf[s], acc);
#pragma unroll
        for (int s = 0; s < 4; ++s) acc = mfma16(*(const bf16x8*)(SG + ((et * 4 + s) * 64 + lane) * 8), rf[s], acc);
        a[et] = acc;
        ss += acc.x * acc.x + acc.y * acc.y + acc.z * acc.z + acc.w * acc.w;
    }
    const float rs = rsqrtf(quad_sum(ss) * (1.f / 128.f) + 1e-6f);
#pragma unroll
    for (int et = 0; et < 8; ++et) {
        const int e = 16 * et + 4 * fq;
        const f32x4 z = ld_bf4(PROJ + (size_t)t * NPROJ + 2560 + h * 128 + e);
        const f32x4 g = *(const f32x4*)(gn + e);
        const f32x4 o = a[et] * rs * g;
        *(u32x2*)(MIX + (size_t)t * D + 256 + h * 128 + e) = (u32x2){pk2(o.x * siluf_(z.x), o.y * siluf_(z.y)), pk2(o.z * siluf_(z.z), o.w * siluf_(z.w))};
    }
}

DEVI void rwkA_item(const P& p, int item, char* smem) {
    const float* REC = (const float*)(p.ws + WS_RECR);
    bf16* WP = (bf16*)(p.ws + WS_WP) + (size_t)item * 4096; float* WC = (float*)(p.ws + WS_WC) + (size_t)item * 4096;
    float* WD = (float*)(p.ws + WS_WD) + (size_t)item * 64;
    bf16* WQ = (bf16*)(p.ws + WS_WQ) + (size_t)item * 2048; float* WY = (float*)(p.ws + WS_WY) + (size_t)item * 2048;
    bf16* At_ = (bf16*)smem; bf16* Rt = At_ + 32 * 72; bf16* Bt = Rt + 32 * 72; bf16* Kt = Bt + 32 * 72;
    float* ZT = (float*)(smem + 9216);
    bf16* BhT = (bf16*)(smem + 18432); bf16* KhT = BhT + 64 * 40; bf16* VT = KhT + 64 * 40; bf16* AhT = VT + 64 * 40; bf16* UhT = AhT + 64 * 40;
    float* M = (float*)(smem + 44032);
    bf16* Aak = (bf16*)(smem + 48128); bf16* Arb = Aak + 32 * 40; bf16* Ark = Arb + 32 * 40;
    float* tot = (float*)(smem + 55808);
    const int n = item >> 2, h = item & 3;
    int tid = threadIdx.x; asm volatile("" : "+v"(tid));
    const int lane = tid & 63, w = tid >> 6, fr = lane & 15, fq = lane >> 4;
    {
        const int d = lane;
        const float* rec = REC + ((size_t)(n * 32 + 8 * w) * 4 + h) * 384 + d;
        float lw[8], lg[8];
        float run = 0.f;
#pragma unroll
        for (int i = 0; i < 8; ++i) { lg[i] = __logf(rec[(size_t)i * 1536 + 64]); run += lg[i]; lw[i] = run; }
        tot[w * 64 + d] = run;
        __syncthreads();
        float off = 0.f, total = 0.f;
#pragma unroll
        for (int q = 0; q < 4; ++q) { const float tq = tot[q * 64 + d]; total += tq; off += (q < w) ? tq : 0.f; }
        unsigned bh[4], kh[4], vv[4];
        float pb = 0.f, pk = 0.f, pv = 0.f;
#pragma unroll
        for (int i = 0; i < 8; ++i) {
            const float* r = rec + (size_t)i * 1536;
            const float a = r[0], b = r[128], k = r[192], rr = r[256], v = r[320];
            const float lc = off + lw[i];
            const float cw = __expf(lc), cwm1 = __expf(lc - lg[i]), inv = __expf(-lc), rat = __expf(total - lc);
            const int t = 8 * w + i;
            At_[t * 72 + d] = (bf16)f2bf(a * cwm1); Rt[t * 72 + d] = (bf16)f2bf(rr * cw);
            Bt[t * 72 + d] = (bf16)f2bf(b * inv); Kt[t * 72 + d] = (bf16)f2bf(k * inv);
            if (i & 1) { bh[i >> 1] = pk2(pb, b * rat); kh[i >> 1] = pk2(pk, k * rat); vv[i >> 1] = pk2(pv, v); }
            else { pb = b * rat; pk = k * rat; pv = v; }
        }
        *(u32x4*)(BhT + d * 40 + 8 * w) = (u32x4){bh[0], bh[1], bh[2], bh[3]};
        *(u32x4*)(KhT + d * 40 + 8 * w) = (u32x4){kh[0], kh[1], kh[2], kh[3]};
        *(u32x4*)(VT + d * 40 + 8 * w) = (u32x4){vv[0], vv[1], vv[2], vv[3]};
        if (w == 0) WD[d] = __expf(total);
    }
    __syncthreads();
    {
        int offA = (w == 0) ? 0 : (w == 1 ? 3 : (w == 2 ? 2 : 3));
        int offB = (w == 0) ? 2 : (w == 1 ? 0 : 1);
        asm volatile("" : "+v"(offA), "+v"(offB));
        const bf16* As = At_ + offA * (32 * 72); const bf16* Bs = At_ + offB * (32 * 72);
#pragma unroll
        for (int ta = 0; ta < 2; ++ta) {
            const bf16x8 a0 = ldfrag(As, 72, 16 * ta, 0, lane), a1 = ldfrag(As, 72, 16 * ta, 32, lane);
#pragma unroll
            for (int tb = 0; tb < 2; ++tb) {
                f32x4 acc = {0.f, 0.f, 0.f, 0.f};
                acc = mfma16(a0, ldfrag(Bs, 72, 16 * tb, 0, lane), acc);
                acc = mfma16(a1, ldfrag(Bs, 72, 16 * tb, 32, lane), acc);
                if (w == 0) {
                    const int s_ = 16 * tb + fr;
#pragma unroll
                    for (int j = 0; j < 4; ++j) { const int t = 16 * ta + 4 * fq + j; M[t * 32 + s_] = (t > s_) ? -acc[j] : 0.f; }
                } else {
                    const int t = 16 * tb + fr;
                    float pv4[4];
#pragma unroll
                    for (int j = 0; j < 4; ++j) { const int s_ = 16 * ta + 4 * fq + j; pv4[j] = ((w == 1) ? (t > s_) : (t >= s_)) ? acc[j] : 0.f; }
                    int offD = w - 1; asm volatile("" : "+v"(offD));
                    *(u32x2*)(Aak + offD * (32 * 40) + t * 40 + 16 * ta + 4 * fq) = (u32x2){pk2(pv4[0], pv4[1]), pk2(pv4[2], pv4[3])};
                }
            }
        }
    }
    __syncthreads();
    {
        const int et = w;
        const bf16x8 vf = ldfrag(VT, 40, 16 * et, 0, lane);
#pragma unroll
        for (int tt = 0; tt < 2; ++tt) {
            f32x4 acc = {0.f, 0.f, 0.f, 0.f};
            acc = mfma16(ldfrag(Aak, 40, 16 * tt, 0, lane), vf, acc);
            *(f32x4*)(ZT + (16 * et + fr) * 36 + 16 * tt + 4 * fq) = acc;
        }
    }
    __syncthreads();
    if (tid < 128) {
        float x[32];
        if (tid < 64) {
#pragma unroll
            for (int t = 0; t < 32; ++t) x[t] = bf2f(At_[t * 72 + tid]);
        } else {
#pragma unroll
            for (int q = 0; q < 8; ++q) { const f32x4 z = *(const f32x4*)(ZT + (tid - 64) * 36 + 4 * q); x[4 * q] = z.x; x[4 * q + 1] = z.y; x[4 * q + 2] = z.z; x[4 * q + 3] = z.w; }
        }
        SolveRow<1, 32>::run(x, M);
        bf16* dst = AhT + tid * 40;
#pragma unroll
        for (int q = 0; q < 4; ++q)
            *(u32x4*)(dst + 8 * q) = (u32x4){pk2(x[8 * q], x[8 * q + 1]), pk2(x[8 * q + 2], x[8 * q + 3]), pk2(x[8 * q + 4], x[8 * q + 5]), pk2(x[8 * q + 6], x[8 * q + 7])};
    }
    __syncthreads();
    {
        const int mt = w;
        const bf16x8 bh = ldfrag(BhT, 40, 16 * mt, 0, lane), kh = ldfrag(KhT, 40, 16 * mt, 0, lane);
#pragma unroll
        for (int sp = 0; sp < 2; ++sp) {
            f32x4 a0 = {0.f, 0.f, 0.f, 0.f}, a1 = {0.f, 0.f, 0.f, 0.f};
            a0 = mfma16(ldfrag(AhT, 40, 32 * sp, 0, lane), bh, a0);
            a1 = mfma16(ldfrag(AhT, 40, 32 * sp + 16, 0, lane), bh, a1);
            *(u32x4*)(WP + ((mt * 2 + sp) * 64 + lane) * 8) = (u32x4){pk2(a0.x, a0.y), pk2(a0.z, a0.w), pk2(a1.x, a1.y), pk2(a1.z, a1.w)};
        }
#pragma unroll
        for (int nt = 0; nt < 4; ++nt) {
            f32x4 a = {0.f, 0.f, 0.f, 0.f};
            a = mfma16(bh, ldfrag(UhT, 40, 16 * nt, 0, lane), a);
            a = mfma16(kh, ldfrag(VT, 40, 16 * nt, 0, lane), a);
            *(f32x4*)(WC + ((nt * 4 + mt) * 64 + lane) * 4) = a;
        }
        {
            const int ct = w & 1, sp = w >> 1, t = 16 * ct + fr;
            const bf16x8 ar = ldfrag(Arb, 40, 16 * ct, 0, lane);
            f32x4 a0 = ld_bf4(Rt + t * 72 + 32 * sp + 4 * fq), a1 = ld_bf4(Rt + t * 72 + 32 * sp + 16 + 4 * fq);
            a0 = mfma16(ldfrag(AhT, 40, 32 * sp, 0, lane), ar, a0);
            a1 = mfma16(ldfrag(AhT, 40, 32 * sp + 16, 0, lane), ar, a1);
            *(u32x4*)(WQ + ((ct * 2 + sp) * 64 + lane) * 8) = (u32x4){pk2(a0.x, a0.y), pk2(a0.z, a0.w), pk2(a1.x, a1.y), pk2(a1.z, a1.w)};
        }
        {
            const int et = w;
            const bf16x8 uf = ldfrag(UhT, 40, 16 * et, 0, lane), vf = ldfrag(VT, 40, 16 * et, 0, lane);
#pragma unroll
            for (int ct = 0; ct < 2; ++ct) {
                f32x4 a = {0.f, 0.f, 0.f, 0.f};
                a = mfma16(uf, ldfrag(Arb, 40, 16 * ct, 0, lane), a);
                a = mfma16(vf, ldfrag(Ark, 40, 16 * ct, 0, lane), a);
                *(f32x4*)(WY + ((ct * 4 + et) * 64 + lane) * 4) = a;
            }
        }
    }
    __syncthreads();
}

struct RwkStep { bf16x8 pf[8]; f32x4 cf[4]; f32x4 dv[4]; };
DEVI void rwk_load(RwkStep& r, const bf16* WP, const float* WC, const float* WD, size_t it, int ew, int lane) {
#pragma unroll
    for (int i = 0; i < 8; ++i) r.pf[i] = *(const bf16x8*)(WP + it * 4096 + (i * 64 + lane) * 8);
#pragma unroll
    for (int m = 0; m < 4; ++m) r.cf[m] = *(const f32x4*)(WC + it * 4096 + ((ew * 4 + m) * 64 + lane) * 4);
#pragma unroll
    for (int m = 0; m < 4; ++m) r.dv[m] = *(const f32x4*)(WD + it * 64 + 16 * m + 4 * (lane >> 4));
}
DEVI void rwk_step(const RwkStep& r, f32x4 (&acc)[4], bf16* WSF, size_t it, int ew, int lane) {
    bf16x8 sf[2];
#pragma unroll
    for (int s = 0; s < 2; ++s) {
        const u32x4 v = {pk2(acc[2 * s].x, acc[2 * s].y), pk2(acc[2 * s].z, acc[2 * s].w), pk2(acc[2 * s + 1].x, acc[2 * s + 1].y), pk2(acc[2 * s + 1].z, acc[2 * s + 1].w)};
        *(u32x4*)(WSF + it * 4096 + ((ew * 2 + s) * 64 + lane) * 8) = v;
        sf[s] = __builtin_bit_cast(bf16x8, v);
    }
#pragma unroll
    for (int m = 0; m < 4; ++m) {
        f32x4 a = acc[m] * r.dv[m] + r.cf[m];
        a = mfma16(r.pf[m * 2], sf[0], a);
        a = mfma16(r.pf[m * 2 + 1], sf[1], a);
        acc[m] = a;
    }
}
DEVI void rwkL1_item(const P& p, int item) {
    const bf16* WP = (const bf16*)(p.ws + WS_WP); const float* WC = (const float*)(p.ws + WS_WC); const float* WD = (const float*)(p.ws + WS_WD);
    const int kind = item & 1, g = (item >> 1) & 15, h = item >> 5;
    const int lane = threadIdx.x & 63, ew = threadIdx.x >> 6, fr = lane & 15, fq = lane >> 4;
    f32x4 acc[4];
    if (kind == 0) {
        bf16* WSF = (bf16*)(p.ws + WS_WS);
#pragma unroll
        for (int m = 0; m < 4; ++m) acc[m] = (f32x4){0.f, 0.f, 0.f, 0.f};
        RwkStep A, B;
        const int n0 = g * 32;
        rwk_load(A, WP, WC, WD, (size_t)n0 * 4 + h, ew, lane);
#pragma unroll 1
        for (int n = n0; n < n0 + 32; n += 2) {
            rwk_load(B, WP, WC, WD, (size_t)(n + 1) * 4 + h, ew, lane);
            asm volatile("" ::: "memory");
            rwk_step(A, acc, WSF, (size_t)n * 4 + h, ew, lane);
            rwk_load(A, WP, WC, WD, (size_t)((n + 2 < n0 + 32) ? n + 2 : n) * 4 + h, ew, lane);
            asm volatile("" ::: "memory");
            rwk_step(B, acc, WSF, (size_t)(n + 1) * 4 + h, ew, lane);
        }
        float* E0 = (float*)(p.ws + WS_WE0) + (size_t)(h * 16 + g) * 4096 + (ew * 4 * 64 + lane) * 4;
#pragma unroll
        for (int m = 0; m < 4; ++m) *(f32x4*)(E0 + m * 256) = acc[m];
    } else {
        const bf16* WQ = (const bf16*)(p.ws + WS_WQ); bf16* WR = (bf16*)(p.ws + WS_WR);
#pragma unroll
        for (int m = 0; m < 4; ++m)
#pragma unroll
            for (int j = 0; j < 4; ++j) acc[m][j] = (m == ew && 4 * fq + j == fr) ? 1.f : 0.f;
#pragma unroll 1
        for (int n = g * 32; n < g * 32 + 32; ++n) {
            const size_t it = (size_t)n * 4 + h;
            bf16x8 pf[8], qf[4]; f32x4 dv[4];
#pragma unroll
            for (int i = 0; i < 8; ++i) pf[i] = *(const bf16x8*)(WP + it * 4096 + (i * 64 + lane) * 8);
#pragma unroll
            for (int i = 0; i < 4; ++i) qf[i] = *(const bf16x8*)(WQ + it * 2048 + (i * 64 + lane) * 8);
#pragma unroll
            for (int m = 0; m < 4; ++m) dv[m] = *(const f32x4*)(WD + it * 64 + 16 * m + 4 * fq);
            asm volatile("" ::: "memory");
            bf16x8 tf[2];
#pragma unroll
            for (int s = 0; s < 2; ++s) tf[s] = pack_frag(acc[2 * s], acc[2 * s + 1]);
#pragma unroll
            for (int tt = 0; tt < 2; ++tt) {
                f32x4 r = {0.f, 0.f, 0.f, 0.f};
                r = mfma16(tf[0], qf[tt * 2], r); r = mfma16(tf[1], qf[tt * 2 + 1], r);
                *(u32x2*)(WR + it * 2048 + ((tt * 2 + (ew >> 1)) * 64 + lane) * 8 + 4 * (ew & 1)) = (u32x2){pk2(r.x, r.y), pk2(r.z, r.w)};
            }
#pragma unroll
            for (int m = 0; m < 4; ++m) {
                f32x4 a = acc[m] * dv[m];
                a = mfma16(pf[m * 2], tf[0], a); a = mfma16(pf[m * 2 + 1], tf[1], a);
                acc[m] = a;
            }
        }
        bf16* TE = (bf16*)(p.ws + WS_WTE) + (size_t)(h * 16 + g) * 4096;
        const int s_ = ew >> 1, jj = 4 * (ew & 1) + (fr & 3), lg = fr >> 2;
#pragma unroll
        for (int m = 0; m < 4; ++m)
#pragma unroll
            for (int j = 0; j < 4; ++j) TE[((m * 2 + s_) * 64 + (4 * fq + j) + 16 * lg) * 8 + jj] = (bf16)f2bf(acc[m][j]);
    }
}
DEVI void rwkL2_item(const P& p, int h) {
    const bf16* TE = (const bf16*)(p.ws + WS_WTE); const float* E0 = (const float*)(p.ws + WS_WE0); bf16* SG = (bf16*)(p.ws + WS_WSG);
    const int lane = threadIdx.x & 63, ew = threadIdx.x >> 6;
    f32x4 acc[4];
#pragma unroll
    for (int m = 0; m < 4; ++m) acc[m] = (f32x4){0.f, 0.f, 0.f, 0.f};
#pragma unroll 1
    for (int g = 0; g < 16; ++g) {
        const size_t hg = (size_t)h * 16 + g;
        bf16x8 pf[8]; f32x4 bfr[4];
#pragma unroll
        for (int i = 0; i < 8; ++i) pf[i] = *(const bf16x8*)(TE + hg * 4096 + (i * 64 + lane) * 8);
#pragma unroll
        for (int m = 0; m < 4; ++m) bfr[m] = *(const f32x4*)(E0 + hg * 4096 + ((ew * 4 + m) * 64 + lane) * 4);
        asm volatile("" ::: "memory");
        bf16x8 sf[2];
#pragma unroll
        for (int s = 0; s < 2; ++s) {
            sf[s] = pack_frag(acc[2 * s], acc[2 * s + 1]);
            *(bf16x8*)(SG + hg * 4096 + ((ew * 2 + s) * 64 + lane) * 8) = sf[s];
        }
#pragma unroll
        for (int m = 0; m < 4; ++m) {
            f32x4 a = bfr[m];
            a = mfma16(pf[m * 2], sf[0], a); a = mfma16(pf[m * 2 + 1], sf[1], a);
            acc[m] = a;
        }
    }
}

DEVI void rwkC_item(const P& p, int n, int l) {
    const int lane = threadIdx.x & 63, h = threadIdx.x >> 6, fr = lane & 15, fq = lane >> 4;
    const size_t it = (size_t)n * 4 + h;
    const bf16* WQ = (const bf16*)(p.ws + WS_WQ) + it * 2048; const float* WY = (const float*)(p.ws + WS_WY) + it * 2048;
    const bf16* WSF = (const bf16*)(p.ws + WS_WS) + it * 4096;
    const bf16* WR = (const bf16*)(p.ws + WS_WR) + it * 2048; const bf16* WSG = (const bf16*)(p.ws + WS_WSG) + (size_t)(h * 16 + (n >> 5)) * 4096;
    const float* RECR = (const float*)(p.ws + WS_RECR); const float* GB = (const float*)(p.ws + WS_G); const float* BON = (const float*)(p.ws + WS_BON);
    bf16* MIX = (bf16*)(p.ws + WS_MIX);
    const float* ln_g = p.in[17] + l * 256 + h * 64; const float* ln_b = p.in[18] + l * 256 + h * 64;
#pragma unroll
    for (int ct = 0; ct < 2; ++ct) {
        const bf16x8 q0 = *(const bf16x8*)(WQ + ((ct * 2 + 0) * 64 + lane) * 8), q1 = *(const bf16x8*)(WQ + ((ct * 2 + 1) * 64 + lane) * 8);
        const bf16x8 r0 = *(const bf16x8*)(WR + ((ct * 2 + 0) * 64 + lane) * 8), r1 = *(const bf16x8*)(WR + ((ct * 2 + 1) * 64 + lane) * 8);
        const int t = n * 32 + 16 * ct + fr;
        f32x4 a[4];
        float sm = 0.f;
#pragma unroll
        for (int et = 0; et < 4; ++et) {
            f32x4 acc = *(const f32x4*)(WY + ((ct * 4 + et) * 64 + lane) * 4);
            acc = mfma16(*(const bf16x8*)(WSF + ((et * 2 + 0) * 64 + lane) * 8), q0, acc);
            acc = mfma16(*(const bf16x8*)(WSF + ((et * 2 + 1) * 64 + lane) * 8), q1, acc);
            acc = mfma16(*(const bf16x8*)(WSG + ((et * 2 + 0) * 64 + lane) * 8), r0, acc);
            acc = mfma16(*(const bf16x8*)(WSG + ((et * 2 + 1) * 64 + lane) * 8), r1, acc);
            a[et] = acc; sm += (acc.x + acc.y) + (acc.z + acc.w);
        }
        const float mean = quad_sum(sm) * (1.f / 64.f);
        float sv = 0.f;
#pragma unroll
        for (int et = 0; et < 4; ++et) { a[et] = a[et] - mean; sv += a[et].x * a[et].x + a[et].y * a[et].y + a[et].z * a[et].z + a[et].w * a[et].w; }
        const float rs = rsqrtf(quad_sum(sv) * (1.f / 64.f) + 64e-5f);
        const float bon = BON[(size_t)t * 4 + h];
#pragma unroll
        for (int et = 0; et < 4; ++et) {
            const int e = 16 * et + 4 * fq;
            const f32x4 g = *(const f32x4*)(ln_g + e), b = *(const f32x4*)(ln_b + e);
            const f32x4 v = *(const f32x4*)(RECR + ((size_t)t * 4 + h) * 384 + 320 + e);
            const f32x4 gate = *(const f32x4*)(GB + (size_t)t * 256 + h * 64 + e);
            const f32x4 o = (a[et] * rs * g + b + v * bon) * gate;
            *(u32x2*)(MIX + (size_t)t * D + h * 64 + e) = (u32x2){pk2(o.x, o.y), pk2(o.z, o.w)};
        }
    }
}

DEVI void phase_scanL1(const P& p) {
    for (int item = blockIdx.x; item < 448; item += gridDim.x) {
        if (item < 256) gdnL1_item(p, item);
        else if (item < 384) rwkL1_item(p, item - 256);
        else retS_item(p, item - 384);
    }
}
DEVI void phase_scanL2(const P& p) {
    for (int item = blockIdx.x; item < 12; item += gridDim.x) {
        if (item < 8) gdnL2_item(p, item);
        else rwkL2_item(p, item - 8);
    }
}
DEVI void phase_chunkA(const P& p, char* smem) {
    for (int item = blockIdx.x; item < 4096; item += gridDim.x) { if (item < 1024) gdnA_item(p, item, smem); else if (item < 3072) rwkA_item(p, item - 1024, smem); else retA_item(p, item - 3072, smem); }
}
DEVI void phase_chunkC(const P& p, int l, char* smem) {
    for (int item = blockIdx.x; item < 2560; item += gridDim.x) { if (item < 1024) gdnC_item(p, item, l); else if (item < 2048) retC_item(p, item - 1024, l, smem); else rwkC_item(p, item - 2048, l); }
}

DEVI void phase_post(const P& p, int l) {
    const bf16* PROJ = (const bf16*)(p.ws + WS_PROJ);
    const float* RECR = (const float*)(p.ws + WS_RECR);
    const float* GB = (const float*)(p.ws + WS_G); const float* BON = (const float*)(p.ws + WS_BON);
    const float* YR = (const float*)(p.ws + WS_YR); const float* OG = (const float*)(p.ws + WS_OG); const float* ORT = (const float*)(p.ws + WS_ORT);
    bf16* MIX = (bf16*)(p.ws + WS_MIX);
    const float* ln_g = p.in[17] + l * 256; const float* ln_b = p.in[18] + l * 256;
    const float* gn = p.in[24] + l * 128;
    const float* rg = p.in[25] + l * 256; const float* rb = p.in[26] + l * 256;
    const int tid = threadIdx.x, lane = tid & 63, h = tid >> 6;
    for (int t = blockIdx.x; t < S; t += gridDim.x) {
        {
            const int c = tid;
            const float y = YR[(size_t)t * 256 + c];
            const float mean = wave_sum(y) * (1.f / 64.f);
            const float d = y - mean;
            const float var = wave_sum(d * d) * (1.f / 64.f);
            const float yn = d * rsqrtf(var + 64e-5f) * ln_g[c] + ln_b[c];
            const float v = RECR[((size_t)t * 4 + h) * 384 + 320 + lane];
            const float o = (yn + BON[(size_t)t * 4 + h] * v) * GB[(size_t)t * 256 + c];
            MIX[(size_t)t * D + c] = (bf16)f2bf(o);
        }
        {
            const int c0 = h * 128 + lane, c1 = c0 + 64;
            const float o0 = OG[(size_t)t * 512 + c0], o1 = OG[(size_t)t * 512 + c1];
            const float ms = wave_sum(o0 * o0 + o1 * o1) * (1.f / 128.f);
            const float rs = rsqrtf(ms + 1e-6f);
            const float z0 = proj_at(PROJ, t, 2560 + c0), z1 = proj_at(PROJ, t, 2560 + c1);
            MIX[(size_t)t * D + 256 + c0] = (bf16)f2bf(o0 * rs * gn[lane] * siluf_(z0));
            MIX[(size_t)t * D + 256 + c1] = (bf16)f2bf(o1 * rs * gn[64 + lane] * siluf_(z1));
        }
        {
            const int c = tid;
            const float y = ORT[(size_t)t * 256 + c];
            const float mean = wave_sum(y) * (1.f / 64.f);
            const float d = y - mean;
            const float var = wave_sum(d * d) * (1.f / 64.f);
            const float yn = d * rsqrtf(var + 1e-5f) * rg[c] + rb[c];
            const float gt = proj_at(PROJ, t, 3840 + c);
            MIX[(size_t)t * D + 768 + c] = (bf16)f2bf(yn * siluf_(gt));
        }
    }
}

DEVI void phase_outproj(const P& p, int l, char* smem) {
    const bf16* MIX = (const bf16*)(p.ws + WS_MIX);
    const bf16* W = (const bf16*)(p.ws + WS_WOUT) + (size_t)l * D * D;
    float* OPRE = (float*)(p.ws + WS_OPRE);
    const int lane = threadIdx.x & 63, wid = threadIdx.x >> 6, wr = wid >> 1, wc = wid & 1, fr = lane & 15, fq = lane >> 4;
    for (int tile = blockIdx.x; tile < (S / 128) * 4; tile += gridDim.x) {
        const int mt = tile >> 2, nt = tile & 3;
        f32x4 acc[4][8];
        gemm_tile(smem, MIX, [&](int r) { return (unsigned)((mt * 128 + r) * D); }, W, [&](int r) { return (unsigned)((nt * 256 + r) * D); }, D, acc);
#pragma unroll
        for (int m = 0; m < 4; ++m) {
            const int tok = mt * 128 + wr * 64 + m * 16 + fr;
#pragma unroll
            for (int n = 0; n < 8; ++n) *(f32x4*)(OPRE + (size_t)tok * D + nt * 256 + wc * 128 + n * 16 + fq * 4) = acc[m][n];
        }
    }
}

DEVI void phase_ln1_route(const P& p, int l, char* smem, bool commit = true) {
    const float* ADA = (const float*)(p.ws + OFF_ADA) + l * 6144;
    const float* xin = (l == 0) ? p.in[0] : (const float*)(p.ws + WS_X);
    const float* OPRE = (const float*)(p.ws + WS_OPRE);
    float* X = (float*)(p.ws + WS_X); bf16* H2 = (bf16*)(p.ws + WS_H2);
    const float* lg = p.in[28] + l * D; const float* lb = p.in[29] + l * D;
    const float* rw = p.in[30] + (size_t)l * D * 32; const float* rbias = p.in[31] + l * 32;
    int* CNT = (int*)(p.ws + OFF_CNT) + l * 32 * 64; int* LIST = (int*)(p.ws + WS_LIST); float* GATE = (float*)(p.ws + WS_GATE);
    float* HS = (float*)smem;
    float* RED = HS + 4 * 1024;
    int* SEL = (int*)(RED + 1024);
    int* RNK = SEL + 256;
    int* BASE = RNK + 256;
    int nasg = 0;
    const int tid = threadIdx.x, lane = tid & 63, w = tid >> 6;
    for (int item = blockIdx.x; item < S / 4; item += gridDim.x) {
        const int t = item * 4 + w;
        {
            f32x4 v[4]; float s = 0.f;
#pragma unroll
            for (int j = 0; j < 4; ++j) {
                const int c = j * 256 + lane * 4;
                const f32x4 x = *(const f32x4*)(xin + (size_t)t * D + c);
                const f32x4 o = *(const f32x4*)(OPRE + (size_t)t * D + c);
                const f32x4 gt = *(const f32x4*)(ADA + 2048 + c);
                v[j].x = DN_ALPHA * x.x + (1.f + gt.x) * o.x; v[j].y = DN_ALPHA * x.y + (1.f + gt.y) * o.y;
                v[j].z = DN_ALPHA * x.z + (1.f + gt.z) * o.z; v[j].w = DN_ALPHA * x.w + (1.f + gt.w) * o.w;
                s += (v[j].x + v[j].y) + (v[j].z + v[j].w);
            }
            const float mean = wave_sum(s) * (1.f / D);
            float s2 = 0.f;
#pragma unroll
            for (int j = 0; j < 4; ++j) { v[j] = v[j] - mean; s2 += (v[j].x * v[j].x + v[j].y * v[j].y) + (v[j].z * v[j].z + v[j].w * v[j].w); }
            const float rstd = rsqrtf(wave_sum(s2) * (1.f / D) + 1e-5f);
#pragma unroll
            for (int j = 0; j < 4; ++j) {
                const int c = j * 256 + lane * 4;
                const f32x4 g = *(const f32x4*)(lg + c), b = *(const f32x4*)(lb + c);
                f32x4 xo = v[j] * rstd * g + b;
                *(f32x4*)(X + (size_t)t * D + c) = xo;
                const f32x4 sh = *(const f32x4*)(ADA + 3072 + c), sc = *(const f32x4*)(ADA + 4096 + c);
                f32x4 hh = xo * (1.f + sc) + sh;
                *(f32x4*)(HS + w * 1024 + c) = hh;
                u32x2 o; o.x = pk2(hh.x, hh.y); o.y = pk2(hh.z, hh.w);
                *(u32x2*)(H2 + (size_t)t * D + c) = o;
            }
        }
        __syncthreads();
        {
            const int e = tid & 31, ks = tid >> 5;
            float a0 = 0.f, a1 = 0.f, a2 = 0.f, a3 = 0.f;
#pragma unroll 4
            for (int k = ks * 128; k < ks * 128 + 128; k += 4) {
                const float w0 = rw[(k + 0) * 32 + e], w1 = rw[(k + 1) * 32 + e], w2 = rw[(k + 2) * 32 + e], w3 = rw[(k + 3) * 32 + e];
                const f32x4 h0 = *(const f32x4*)(HS + 0 * 1024 + k), h1 = *(const f32x4*)(HS + 1 * 1024 + k);
                const f32x4 h2 = *(const f32x4*)(HS + 2 * 1024 + k), h3 = *(const f32x4*)(HS + 3 * 1024 + k);
                a0 += h0.x * w0 + h0.y * w1 + h0.z * w2 + h0.w * w3;
                a1 += h1.x * w0 + h1.y * w1 + h1.z * w2 + h1.w * w3;
                a2 += h2.x * w0 + h2.y * w1 + h2.z * w2 + h2.w * w3;
                a3 += h3.x * w0 + h3.y * w1 + h3.z * w2 + h3.w * w3;
            }
            RED[(ks * 4 + 0) * 32 + e] = a0; RED[(ks * 4 + 1) * 32 + e] = a1; RED[(ks * 4 + 2) * 32 + e] = a2; RED[(ks * 4 + 3) * 32 + e] = a3;
        }
        __syncthreads();
        if (tid < 128) {
            const int tok = tid >> 5, e = tid & 31, tt = item * 4 + tok;
            float logit = rbias[e];
#pragma unroll
            for (int ks = 0; ks < 8; ++ks) logit += RED[(ks * 4 + tok) * 32 + e];
            bool taken = false;
            float sv[4]; int si[4];
#pragma unroll
            for (int j = 0; j < 4; ++j) {
                float cand = taken ? -3.0e38f : logit; int ci = e;
#pragma unroll
                for (int off = 16; off >= 1; off >>= 1) {
                    const float ov = __shfl_xor(cand, off, 32); const int oi = __shfl_xor(ci, off, 32);
                    if (ov > cand || (ov == cand && oi < ci)) { cand = ov; ci = oi; }
                }
                sv[j] = cand; si[j] = ci; if (ci == e) taken = true;
            }
            const float e0 = 1.f, e1 = __expf(sv[1] - sv[0]), e2 = __expf(sv[2] - sv[0]), e3 = __expf(sv[3] - sv[0]);
            const float inv = 1.f / (e0 + e1 + e2 + e3);
            const float gts[4] = {e0 * inv, e1 * inv, e2 * inv, e3 * inv};
#pragma unroll
            for (int j = 0; j < 4; ++j) {
                if (si[j] == e) {
                    SEL[nasg + tok * 4 + j] = ((tt * 4 + j) << 5) | e;
                    GATE[(size_t)tt * 4 + j] = gts[j];
                }
            }
        }
        nasg += 16;
        __syncthreads();
    }
    if (!commit) return;
    if (tid < 32) {
        int c = 0;
        for (int a = 0; a < nasg; ++a) { if ((SEL[a] & 31) == tid) { RNK[a] = c; ++c; } }
        BASE[tid] = c ? atomicAdd(&CNT[tid * 64], c) : 0;
    }
    __syncthreads();
    for (int a = tid; a < nasg; a += NT) { const int v = SEL[a], e = v & 31; LIST[(size_t)e * S + BASE[e] + RNK[a]] = v >> 5; }
    __syncthreads();
}

struct MoeMap { int cnt[32]; int off[32]; int tstart[33]; };
DEVI void moe_map(const P& p, int l, MoeMap* mm) {
    const int* CNT = (const int*)(p.ws + OFF_CNT) + l * 32 * 64;
    if (threadIdx.x < 32) mm->cnt[threadIdx.x] = __hip_atomic_load(&CNT[threadIdx.x * 64], __ATOMIC_RELAXED, __HIP_MEMORY_SCOPE_AGENT);
    __syncthreads();
    if (threadIdx.x == 0) {
        int o = 0, ts = 0;
        for (int e = 0; e < 32; ++e) { mm->off[e] = o; mm->tstart[e] = ts; o += mm->cnt[e]; ts += (mm->cnt[e] + 127) / 128; }
        mm->tstart[32] = ts;
    }
    __syncthreads();
}

DEVI void phase_moe_up(const P& p, int l, char* smem) {
    MoeMap* mm = (MoeMap*)(smem + 73728);
    int* rows = (int*)(smem + 73728 + 1024);
    moe_map(p, l, mm);
    const bf16* H2 = (const bf16*)(p.ws + WS_H2);
    const bf16* WUP = (const bf16*)(p.ws + WS_WUP) + (size_t)l * NEXP * 2048 * D;
    const float* bup = p.in[33] + (size_t)l * NEXP * 2048;
    const int* LIST = (const int*)(p.ws + WS_LIST);
    bf16* ACT = (bf16*)(p.ws + WS_ACT);
    const int lane = threadIdx.x & 63, wid = threadIdx.x >> 6, wr = wid >> 1, wc = wid & 1, fr = lane & 15, fq = lane >> 4;
    const int ntiles = mm->tstart[32] * 8;
    for (int tile = blockIdx.x; tile < ntiles; tile += gridDim.x) {
        const int mtg = tile >> 3, nt = tile & 7;
        int e = 0;
        while (mm->tstart[e + 1] <= mtg) ++e;
        const int m0 = (mtg - mm->tstart[e]) * 128, cnt = mm->cnt[e];
        __syncthreads();
        if (threadIdx.x < 128) { const int r = m0 + threadIdx.x; rows[threadIdx.x] = LIST[(size_t)e * S + (r < cnt ? r : m0)]; }
        __syncthreads();
        const bf16* We = WUP + (size_t)e * 2048 * D;
        f32x4 acc[4][8];
        gemm_tile(smem, H2, [&](int r) { return (unsigned)((rows[r] >> 2) * D); },
                  We, [&](int r) { const int t16 = r >> 4; return (unsigned)((nt * 128 + (t16 >> 1) * 16 + (r & 15) + ((t16 & 1) ? 1024 : 0)) * D); }, D, acc);
        const float* be = bup + (size_t)e * 2048;
#pragma unroll
        for (int m = 0; m < 4; ++m) {
            const int rl = m0 + wr * 64 + m * 16 + fr;
            if (rl < cnt) {
#pragma unroll
                for (int n2 = 0; n2 < 4; ++n2) {
                    const int col = nt * 128 + (wc * 4 + n2) * 16 + fq * 4;
                    const f32x4 bg = *(const f32x4*)(be + col), bl = *(const f32x4*)(be + 1024 + col);
                    float o[4];
#pragma unroll
                    for (int j = 0; j < 4; ++j) {
                        const float glu = fminf(acc[m][2 * n2][j] + bg[j], 7.f);
                        const float lin = fminf(fmaxf(acc[m][2 * n2 + 1][j] + bl[j], -7.f), 7.f);
                        o[j] = glu * sigmoidf_(1.702f * glu) * (lin + 1.f);
                    }
                    u32x2 ov; ov.x = pk2(o[0], o[1]); ov.y = pk2(o[2], o[3]);
                    *(u32x2*)(ACT + (size_t)(mm->off[e] + rl) * DFF + col) = ov;
                }
            }
        }
    }
}

DEVI void phase_moe_down(const P& p, int l, char* smem) {
    MoeMap* mm = (MoeMap*)(smem + 73728);
    int* rows = (int*)(smem + 73728 + 1024);
    moe_map(p, l, mm);
    const bf16* ACT = (const bf16*)(p.ws + WS_ACT);
    const bf16* WDN = (const bf16*)(p.ws + WS_WDN) + (size_t)l * NEXP * D * DFF;
    const float* bdn = p.in[35] + (size_t)l * NEXP * D;
    const int* LIST = (const int*)(p.ws + WS_LIST); const float* GATE = (const float*)(p.ws + WS_GATE);
    bf16* YB = (bf16*)(p.ws + WS_YB);
    const int lane = threadIdx.x & 63, wid = threadIdx.x >> 6, wr = wid >> 1, wc = wid & 1, fr = lane & 15, fq = lane >> 4;
    const int ntiles = mm->tstart[32] * 4;
    for (int tile = blockIdx.x; tile < ntiles; tile += gridDim.x) {
        const int mtg = tile >> 2, nt = tile & 3;
        int e = 0;
        while (mm->tstart[e + 1] <= mtg) ++e;
        const int m0 = (mtg - mm->tstart[e]) * 128, cnt = mm->cnt[e];
        __syncthreads();
        if (threadIdx.x < 128) { const int r = m0 + threadIdx.x; rows[threadIdx.x] = LIST[(size_t)e * S + (r < cnt ? r : m0)]; }
        __syncthreads();
        const bf16* We = WDN + (size_t)e * D * DFF;
        const unsigned abase = (unsigned)(mm->off[e] + m0);
        f32x4 acc[4][8];
        gemm_tile(smem, ACT, [&](int r) { return (abase + ((m0 + r) < cnt ? r : 0)) * (unsigned)DFF; },
                  We, [&](int r) { return (unsigned)((nt * 256 + r) * DFF); }, DFF, acc);
        const float* be = bdn + (size_t)e * D;
#pragma unroll
        for (int m = 0; m < 4; ++m) {
            const int rt = wr * 64 + m * 16 + fr;
            if (m0 + rt < cnt) {
                const int ent = rows[rt];
                const float gt = GATE[ent];
#pragma unroll
                for (int n = 0; n < 8; ++n) {
                    const int col = nt * 256 + wc * 128 + n * 16 + fq * 4;
                    const f32x4 b = *(const f32x4*)(be + col);
                    u32x2 ov; ov.x = pk2((acc[m][n].x + b.x) * gt, (acc[m][n].y + b.y) * gt); ov.y = pk2((acc[m][n].z + b.z) * gt, (acc[m][n].w + b.w) * gt);
                    *(u32x2*)(YB + (size_t)ent * D + col) = ov;
                }
            }
        }
    }
}

DEVI void phase_ln2(const P& p, int l) {
    const float* ADA = (const float*)(p.ws + OFF_ADA) + l * 6144;
    const float* ADAn = (const float*)(p.ws + OFF_ADA) + 6144;
    float* X = (float*)(p.ws + WS_X); const bf16* YB = (const bf16*)(p.ws + WS_YB);
    bf16* HB = (bf16*)(p.ws + WS_HB);
    const float* lg = p.in[36] + l * D; const float* lb = p.in[37] + l * D;
    const int tid = threadIdx.x, lane = tid & 63, w = tid >> 6;
    for (int item = blockIdx.x; item < S / 4; item += gridDim.x) {
        const int t = item * 4 + w;
        f32x4 v[4]; float s = 0.f;
#pragma unroll
        for (int j = 0; j < 4; ++j) {
            const int c = j * 256 + lane * 4;
            const f32x4 x = *(const f32x4*)(X + (size_t)t * D + c);
            f32x4 f = {0.f, 0.f, 0.f, 0.f};
#pragma unroll
            for (int q = 0; q < 4; ++q) {
                const u32x2 y = *(const u32x2*)(YB + ((size_t)t * 4 + q) * D + c);
                f.x += __uint_as_float(y.x << 16); f.y += __uint_as_float(y.x & 0xffff0000u);
                f.z += __uint_as_float(y.y << 16); f.w += __uint_as_float(y.y & 0xffff0000u);
            }
            const f32x4 gt = *(const f32x4*)(ADA + 5120 + c);
            v[j] = x * DN_ALPHA + (gt + 1.f) * f;
            s += (v[j].x + v[j].y) + (v[j].z + v[j].w);
        }
        const float mean = wave_sum(s) * (1.f / D);
        float s2 = 0.f;
#pragma unroll
        for (int j = 0; j < 4; ++j) { v[j] = v[j] - mean; s2 += (v[j].x * v[j].x + v[j].y * v[j].y) + (v[j].z * v[j].z + v[j].w * v[j].w); }
        const float rstd = rsqrtf(wave_sum(s2) * (1.f / D) + 1e-5f);
#pragma unroll
        for (int j = 0; j < 4; ++j) {
            const int c = j * 256 + lane * 4;
            const f32x4 g = *(const f32x4*)(lg + c), b = *(const f32x4*)(lb + c);
            const f32x4 xo = v[j] * rstd * g + b;
            if (l == 0) {
                *(f32x4*)(X + (size_t)t * D + c) = xo;
                const f32x4 sh = *(const f32x4*)(ADAn + c), sc = *(const f32x4*)(ADAn + 1024 + c);
                const f32x4 hh = xo * (sc + 1.f) + sh;
                u32x2 o; o.x = pk2(hh.x, hh.y); o.y = pk2(hh.z, hh.w);
                *(u32x2*)(HB + (size_t)t * D + c) = o;
            } else {
                *(f32x4*)(p.out + (size_t)t * D + c) = xo;
            }
        }
    }
}

constexpr int NPHASE = 24;
__global__ void __launch_bounds__(NT, 2) k_run(P p) {
    extern __shared__ __attribute__((aligned(16))) char smem[];
    XcdBarrier bar; bar.bar = nullptr; bar.x = 0; bar.st = nullptr;
    const bool multi = (p.ph_hi - p.ph_lo) > 1;
    if (multi) {
        volatile LAS unsigned* st = (volatile LAS unsigned*)(smem + LDS_BYTES - 16);
        if (threadIdx.x == 0) { st[0] = 0u; st[1] = 0u; }
        __syncthreads();
        bar = xcd_barrier_post((unsigned*)(p.ws + OFF_BAR), st);
    }
#ifndef DUP
#define DUP -1
#endif
#ifndef DUP2
#define DUP2 -1
#endif
#define RUN(k, call) if (p.ph_lo <= (k) && (k) < p.ph_hi) { for (int _rep = ((k) == DUP || (k) == DUP2) ? 2 : 1; _rep > 0; --_rep) { call; if (multi && ((k) + 1 < p.ph_hi || _rep > 1)) xcd_barrier(bar); } }
    RUN(0, phase_prep(p, smem))
    RUN(1, phase_h0(p))
    RUN(2, phase_inproj(p, 0, smem))
    RUN(3, phase_mixprep(p, 0, smem))
    RUN(4, phase_chunkA(p, smem))
    RUN(5, phase_scanL1(p))
    RUN(6, phase_scanL2(p))
    RUN(7, phase_chunkC(p, 0, smem))
    RUN(8, phase_outproj(p, 0, smem))
    RUN(9, phase_ln1_route(p, 0, smem, _rep == 1))
    RUN(10, phase_moe_up(p, 0, smem))
    RUN(11, phase_moe_down(p, 0, smem))
    RUN(12, phase_ln2(p, 0))
    RUN(13, phase_inproj(p, 1, smem))
    RUN(14, phase_mixprep(p, 1, smem))
    RUN(15, phase_chunkA(p, smem))
    RUN(16, phase_scanL1(p))
    RUN(17, phase_scanL2(p))
    RUN(18, phase_chunkC(p, 1, smem))
    RUN(19, phase_outproj(p, 1, smem))
    RUN(20, phase_ln1_route(p, 1, smem))
    RUN(21, phase_moe_up(p, 1, smem))
    RUN(22, phase_moe_down(p, 1, smem))
    RUN(23, phase_ln2(p, 1))
#undef RUN
}

extern "C" void kernel_launch(void* const* d_in, const int* in_sizes, int n_in, void* d_out, int out_size, void* d_ws, size_t ws_size,
                              hipStream_t stream) {
    static int grid = 0;
    if (grid == 0) {
        if (n_in != 38 || ws_size < WS_END) { fprintf(stderr, "kernel_launch: unexpected n_in %d or ws_size %zu (< %zu)\n", n_in, ws_size, (size_t)WS_END); grid = -1; return; }
        int dev = 0, cus = 0, per_cu = 0;
        hipGetDevice(&dev);
        hipDeviceGetAttribute(&cus, hipDeviceAttributeMultiprocessorCount, dev);
        hipFuncSetAttribute((const void*)k_run, hipFuncAttributeMaxDynamicSharedMemorySize, LDS_BYTES);
        hipOccupancyMaxActiveBlocksPerMultiprocessor(&per_cu, (const void*)k_run, NT, LDS_BYTES);
        if (per_cu < 1) { fprintf(stderr, "kernel_launch: occupancy query returned %d\n", per_cu); grid = -1; return; }
        if (per_cu > 2) per_cu = 2;
        grid = cus * per_cu;
    }
    if (grid < 0) return;
    hipMemsetAsync((char*)d_ws + WS_CTL, 0, CTL_BYTES, stream);
    P p{};
    for (int i = 0; i < 38; ++i) p.in[i] = (const float*)d_in[i];
    p.pos = (const int*)d_in[2];
    p.out = (float*)d_out; p.ws = (char*)d_ws;
#if MEGA
    p.ph_lo = 0; p.ph_hi = NPHASE;
    void* args[] = {&p};
    hipError_t e = hipLaunchCooperativeKernel((const void*)k_run, dim3(grid), dim3(NT), args, LDS_BYTES, stream);
    if (e != hipSuccess) fprintf(stderr, "cooperative launch failed: %s (grid %d)\n", hipGetErrorString(e), grid);
#else
    for (int ph = 0; ph < NPHASE; ++ph) {
        p.ph_lo = ph; p.ph_hi = ph + 1;
        hipLaunchKernelGGL(k_run, dim3(grid), dim3(NT), LDS_BYTES, stream, p);
    }
#endif
}
```

```cpp
#include <hip/hip_runtime.h>
#include <hip/hip_bf16.h>
#include <stdint.h>
#include <stdio.h>

#ifndef MEGA
#define MEGA 1
#endif

#define DEVI __device__ __forceinline__
#define LAS __attribute__((address_space(3)))

typedef unsigned short bf16;
typedef short bf16x8 __attribute__((ext_vector_type(8)));
typedef float f32x4 __attribute__((ext_vector_type(4)));
typedef unsigned u32x4 __attribute__((ext_vector_type(4)));
typedef unsigned u32x2 __attribute__((ext_vector_type(2)));

constexpr int S = 16384, D = 1024, NIN = 4104, NEXP = 32, DFF = 1024;
constexpr int NPROJ = 4096;
constexpr int NPAD = 4352;
constexpr float DN_ALPHA = 1.4142135623730951f;
constexpr int NT = 256;
constexpr int LDS_BYTES = 76032;

constexpr size_t MiB = 1ull << 20;
constexpr size_t WS_CTL = 0;
constexpr size_t CTL_BYTES = 1 * MiB;
constexpr size_t OFF_BAR = 0;
constexpr size_t OFF_ADA = 64 * 1024;
constexpr size_t OFF_CNT = 128 * 1024;
constexpr size_t WS_ROT = 1 * MiB;
constexpr size_t WS_WIN = WS_ROT + (size_t)S * 64 * 4;
constexpr size_t WS_WOUT = WS_WIN + 2ull * NPAD * D * 2;
constexpr size_t WS_WUP = WS_WOUT + 2ull * D * D * 2;
constexpr size_t WS_WDN = WS_WUP + 2ull * NEXP * 2048 * D * 2;
constexpr size_t WS_HB = WS_WDN + 2ull * NEXP * D * DFF * 2;
constexpr size_t WS_PROJ = WS_HB + (size_t)S * D * 2;
constexpr size_t WS_PEX = WS_PROJ + (size_t)S * NPROJ * 2;
constexpr size_t WS_VFIRST = WS_PEX + (size_t)S * 64 * 4;
constexpr size_t WS_RECR = WS_VFIRST + (size_t)S * 256 * 4;
constexpr size_t WS_RECG = WS_RECR + (size_t)S * 4 * 384 * 4;
constexpr size_t WS_RECT = WS_RECG + (size_t)S * 4 * 392 * 4;
constexpr size_t WS_G = WS_RECT + (size_t)S * 4 * 192 * 4;
constexpr size_t WS_BON = WS_G + (size_t)S * 256 * 4;
constexpr size_t WS_YR = WS_BON + (size_t)S * 4 * 4;
constexpr size_t WS_OG = WS_YR + (size_t)S * 256 * 4;
constexpr size_t WS_ORT = WS_OG + (size_t)S * 512 * 4;
constexpr size_t WS_MIX = WS_ORT + (size_t)S * 256 * 4;
constexpr size_t WS_OPRE = WS_MIX + (size_t)S * D * 2;
constexpr size_t WS_X = WS_OPRE + (size_t)S * D * 4;
constexpr size_t WS_H2 = WS_X + (size_t)S * D * 4;
constexpr size_t WS_LIST = WS_H2 + (size_t)S * D * 2;
constexpr size_t WS_GATE = WS_LIST + (size_t)NEXP * S * 4;
constexpr size_t WS_ACT = WS_GATE + (size_t)S * 4 * 4;
constexpr size_t WS_YB = WS_ACT + ((size_t)S * 4 + 256) * DFF * 2;
constexpr size_t WS_ADAP = WS_YB + (size_t)S * 4 * D * 2;
constexpr size_t WS_RKV = WS_ADAP + 16ull * 12288 * 4;
constexpr size_t WS_RST = WS_RKV + 256ull * 4 * 4096 * 4;
constexpr size_t WS_GP = WS_RST + 256ull * 4 * 4096 * 2;
constexpr size_t WS_GB = WS_GP + 1024ull * 16384 * 2;
constexpr size_t WS_GD = WS_GB + 1024ull * 16384 * 4;
constexpr size_t WS_GQ = WS_GD + 4096;
constexpr size_t WS_GO = WS_GQ + 1024ull * 8192 * 2;
constexpr size_t WS_GS = WS_GO + 1024ull * 8192 * 4;
constexpr size_t WS_WP = WS_GS + 1024ull * 16384 * 2;
constexpr size_t WS_WC = WS_WP + 2048ull * 4096 * 2;
constexpr size_t WS_WD = WS_WC + 2048ull * 4096 * 4;
constexpr size_t WS_WQ = WS_WD + 2048ull * 64 * 4;
constexpr size_t WS_WY = WS_WQ + 2048ull * 2048 * 2;
constexpr size_t WS_WS = WS_WY + 2048ull * 2048 * 4;
constexpr size_t WS_GR = WS_WS + 2048ull * 4096 * 2;
constexpr size_t WS_GE0 = WS_GR + 1024ull * 8192 * 2;
constexpr size_t WS_GTE = WS_GE0 + 64ull * 16384 * 4;
constexpr size_t WS_GSG = WS_GTE + 64ull * 16384 * 2;
constexpr size_t WS_WR = WS_GSG + 64ull * 16384 * 2;
constexpr size_t WS_WE0 = WS_WR + 2048ull * 2048 * 2;
constexpr size_t WS_WTE = WS_WE0 + 64ull * 4096 * 4;
constexpr size_t WS_WSG = WS_WTE + 64ull * 4096 * 2;
constexpr size_t WS_LRT = WS_WSG + 64ull * 4096 * 2;
constexpr size_t WS_HG = WS_LRT + 2ull * 73728 * 2;
constexpr size_t WS_DUMP = WS_HG + ((size_t)S * 4 + 256) * D * 2;
constexpr size_t WS_END = WS_DUMP + 4096;

struct P {
    const float* in[38];
    const int* pos;
    float* out;
    char* ws;
    int ph_lo, ph_hi;
};

DEVI float bf2f(bf16 v) { return __uint_as_float(((unsigned)v) << 16); }
DEVI unsigned f2bf(float f) { unsigned u = __float_as_uint(f); return (u + 0x7fffu + ((u >> 16) & 1u)) >> 16; }
typedef float f32x2_t __attribute__((ext_vector_type(2)));
typedef __bf16 bf16x2_t __attribute__((ext_vector_type(2)));
DEVI unsigned pk2(float lo, float hi) { const f32x2_t v = {lo, hi}; return __builtin_bit_cast(unsigned, __builtin_convertvector(v, bf16x2_t)); }
DEVI float sigmoidf_(float x) { return __builtin_amdgcn_rcpf(1.f + __builtin_amdgcn_exp2f(-1.4426950408889634f * x)); }
DEVI float siluf_(float x) { return x * sigmoidf_(x); }
DEVI float softplusf_(float x) { return fmaxf(x, 0.f) + log1pf(__expf(-fabsf(x))); }
DEVI float wave_sum(float v) {
#pragma unroll
    for (int o = 32; o >= 1; o >>= 1) v += __shfl_xor(v, o);
    return v;
}
template <int CTRL> DEVI float dpp_mov(float x) {
    return __int_as_float(__builtin_amdgcn_update_dpp(0, __float_as_int(x), CTRL, 0xf, 0xf, false));
}
DEVI float row16_sum(float x) {
    x += dpp_mov<0x128>(x);
    x += dpp_mov<0x124>(x);
    x += dpp_mov<0x122>(x);
    x += dpp_mov<0x121>(x);
    return x;
}

DEVI bf16x8 ldfrag(const bf16* base, int ld, int row0, int k0, int lane) {
    return *(const bf16x8*)(base + (row0 + (lane & 15)) * ld + k0 + (lane >> 4) * 8);
}
DEVI f32x4 ld_bf4(const bf16* p) {
    const u32x2 v = *(const u32x2*)p;
    return (f32x4){__uint_as_float(v.x << 16), __uint_as_float(v.x & 0xffff0000u), __uint_as_float(v.y << 16), __uint_as_float(v.y & 0xffff0000u)};
}
DEVI float quad_sum(float v) { v += __shfl_xor(v, 16); v += __shfl_xor(v, 32); return v; }
DEVI f32x4 mfma16(bf16x8 a, bf16x8 b, f32x4 c) { return __builtin_amdgcn_mfma_f32_16x16x32_bf16(a, b, c, 0, 0, 0); }

#define VTID ((int)(threadIdx.x & 255))
#define VBID ((int)(blockIdx.x * 2 + __builtin_amdgcn_readfirstlane((int)(threadIdx.x >> 8))))
#define VNB ((int)(gridDim.x * 2))
constexpr int VB_LDS = 76032;

#define XB_TMO      128
#define XB_XCNT(j)  (256  + 64 * (j))
#define XB_XSUB(j)  (1280 + 64 * (j))
#define XB_XGEN(j)  (2304 + 64 * (j))
#define XB_TOP      3328
#define XB_TOPGEN   3392
#define XCD_BAR_WORDS 3456
#define XB_SPIN_CAP (1u << 22)
DEVI unsigned xb_ld(unsigned* p) { return __hip_atomic_load(p, __ATOMIC_RELAXED, __HIP_MEMORY_SCOPE_AGENT); }
DEVI unsigned xb_add(unsigned* p, unsigned v) { return __hip_atomic_fetch_add(p, v, __ATOMIC_RELAXED, __HIP_MEMORY_SCOPE_AGENT); }
DEVI unsigned xb_xcc_id() { return (unsigned)__builtin_amdgcn_s_getreg((3 << 11) | 20) & 0xFu; }
#define XB_SPIN(cond, bar) do { unsigned _sp = 0; while (cond) { __builtin_amdgcn_s_sleep(1); \
    if ((++_sp & 255u) == 0u) { if (xb_ld(&(bar)[XB_TMO])) break; if (_sp > XB_SPIN_CAP) { atomicAdd(&(bar)[XB_TMO], 1u); break; } } } } while (0)
struct XcdBarrier { unsigned* bar; unsigned x; volatile LAS unsigned* st; };
DEVI XcdBarrier xcd_barrier_post(unsigned* bar, volatile LAS unsigned* st) {
    XcdBarrier b; b.bar = bar; b.x = xb_xcc_id(); b.st = st;
    if (threadIdx.x == 0) (void)xb_add(&bar[XB_XCNT(b.x)], 1u);
    return b;
}
DEVI void xcd_barrier_complete(unsigned* bar, unsigned x, unsigned& nloc, unsigned& nx) {
    const unsigned G = gridDim.x * gridDim.y * gridDim.z;
    unsigned sum, cnt, mine, sp = 0u;
    for (;;) {
        sum = 0u; cnt = 0u; mine = 0u;
#pragma unroll
        for (unsigned j = 0; j < 16; ++j) { const unsigned c = xb_ld(&bar[XB_XCNT(j)]); sum += c; cnt += (c > 0u) ? 1u : 0u; mine = (j == x) ? c : mine; }
        if (sum == G) break;
        __builtin_amdgcn_s_sleep(1);
        if ((++sp & 255u) == 0u) { if (xb_ld(&bar[XB_TMO])) break; if (sp > XB_SPIN_CAP) { atomicAdd(&bar[XB_TMO], 1u); break; } }
    }
    nloc = mine > 0u ? mine : 1u; nx = cnt > 0u ? cnt : 1u;
}
DEVI void xcd_barrier(const XcdBarrier& b) {
    asm volatile("s_waitcnt vmcnt(0)" ::: "memory");
    __syncthreads();
    if (threadIdx.x == 0) {
        unsigned* bar = b.bar;
        __builtin_amdgcn_s_waitcnt(0);
        unsigned nloc = b.st[0], nx = b.st[1];
        if (nloc == 0u) { xcd_barrier_complete(bar, b.x, nloc, nx); b.st[0] = nloc; b.st[1] = nx; }
        const unsigned old = xb_add(&bar[XB_XSUB(b.x)], 1u);
        const unsigned gen = old / nloc;
        if (old + 1u == (gen + 1u) * nloc) {
            __builtin_amdgcn_fence(__ATOMIC_RELEASE, "agent");
            asm volatile("s_waitcnt vmcnt(0)" ::: "memory");
            const unsigned og = xb_add(&bar[XB_TOP], 1u);
            const unsigned tg = og / nx;
            if (og + 1u == (tg + 1u) * nx) xb_add(&bar[XB_TOPGEN], 1u);
            else XB_SPIN(xb_ld(&bar[XB_TOPGEN]) == tg, bar);
            __builtin_amdgcn_fence(__ATOMIC_ACQUIRE, "agent");
            xb_add(&bar[XB_XGEN(b.x)], 1u);
            asm volatile("s_waitcnt vmcnt(0)" ::: "memory");
        } else {
            XB_SPIN(xb_ld(&bar[XB_XGEN(b.x)]) == gen, bar);
            __builtin_amdgcn_fence(__ATOMIC_ACQUIRE, "agent");
            asm volatile("s_waitcnt vmcnt(0)" ::: "memory");
        }
    }
    __syncthreads();
}

DEVI void transpose_item(const float* __restrict__ src, size_t ld, int k0, int ns0, bf16* __restrict__ dst, int kd, int nd0, float* lds) {
    const int tid = VTID;
#pragma unroll 4
    for (int i = 0; i < 16; ++i) {
        const int kk = i * 4 + (tid >> 6), n = tid & 63;
        lds[kk * 65 + n] = src[(size_t)(k0 + kk) * ld + ns0 + n];
    }
    __syncthreads();
#pragma unroll
    for (int i = 0; i < 2; ++i) {
        const int q = tid + 256 * i, n = q >> 3, kc = q & 7;
        const float* s = lds + (kc * 8) * 65 + n;
        u32x4 o;
        o.x = pk2(s[0 * 65], s[1 * 65]); o.y = pk2(s[2 * 65], s[3 * 65]);
        o.z = pk2(s[4 * 65], s[5 * 65]); o.w = pk2(s[6 * 65], s[7 * 65]);
        *(u32x4*)(dst + (size_t)(nd0 + n) * kd + k0 + kc * 8) = o;
    }
    __syncthreads();
}

DEVI void phase_prep(const P& p, char* smem) {
    float* lds = (float*)smem;
    const int tid = VTID;
    const int nb = VNB, bid = VBID;
    bf16* WIN = (bf16*)(p.ws + WS_WIN); bf16* WOUT = (bf16*)(p.ws + WS_WOUT);
    bf16* WUP = (bf16*)(p.ws + WS_WUP); bf16* WDN = (bf16*)(p.ws + WS_WDN);
    constexpr int I_UP = 2 * NEXP * 16 * 32;
    constexpr int I_DN = 2 * NEXP * 16 * 16;
    constexpr int I_IN = 2 * 16 * 64;
    constexpr int I_OUT = 2 * 16 * 16;
    constexpr int I_EX = 2 * 256;
    constexpr int I_ADA = 2 * 24 * 16;
    constexpr int I_ROT = S * 32 / 256;
    constexpr int I_LR = 2 * 288;
    constexpr int NITEMS = I_UP + I_DN + I_IN + I_OUT + I_EX + I_ADA + I_ROT + I_LR;
    constexpr int I_TR = I_UP + I_DN + I_IN + I_OUT;
    static_assert(I_TR % 512 == 0, "transpose items must split evenly over 512 virtual blocks (they contain barriers)");
    for (int it = bid; it < NITEMS; it += nb) {
        int r = it;
        if (r < I_UP) {
            const int le = r / 512, q = r % 512, kt = q / 32, nt = q % 32;
            transpose_item(p.in[32] + (size_t)le * D * 2048, 2048, kt * 64, nt * 64, WUP + (size_t)le * 2048 * D, D, nt * 64, lds);
            continue;
        }
        r -= I_UP;
        if (r < I_DN) {
            const int le = r / 256, q = r % 256, kt = q / 16, nt = q % 16;
            transpose_item(p.in[34] + (size_t)le * DFF * D, D, kt * 64, nt * 64, WDN + (size_t)le * D * DFF, DFF, nt * 64, lds);
            continue;
        }
        r -= I_DN;
        if (r < I_IN) {
            const int l = r / 1024, q = r % 1024, kt = q / 64, nt = q % 64;
            const int nd0 = nt * 64, ns0 = nd0 < 3072 ? nd0 : nd0 + 8;
            transpose_item(p.in[5] + (size_t)l * D * NIN, NIN, kt * 64, ns0, WIN + (size_t)l * NPAD * D, D, nd0, lds);
            continue;
        }
        r -= I_IN;
        if (r < I_OUT) {
            const int l = r / 256, q = r % 256, kt = q / 16, nt = q % 16;
            transpose_item(p.in[27] + (size_t)l * D * D, D, kt * 64, nt * 64, WOUT + (size_t)l * D * D, D, nt * 64, lds);
            continue;
        }
        r -= I_OUT;
        if (r < I_EX) {
            const int l = r / 256, n = r % 256;
            bf16* dst = WIN + ((size_t)l * NPAD + NPROJ + n) * D;
            for (int k = tid; k < D; k += NT) {
                float v = 0.f;
                if (n < 8) v = p.in[5][(size_t)l * D * NIN + (size_t)k * NIN + 3072 + n];
                else if (n < 40 && l == 1) v = p.in[6][(size_t)k * 32 + (n - 8)];
                dst[k] = (bf16)f2bf(v);
            }
            continue;
        }
        r -= I_EX;
        if (r < I_ADA) {
            const int l = r / 384, q = r % 384, nc = q / 16, kc = q % 16;
            const int n = nc * 256 + tid;
            const float* W = p.in[3] + (size_t)l * D * 6144;
            float acc = (kc == 0) ? p.in[4][l * 6144 + n] : 0.f;
            for (int k = kc * 64; k < kc * 64 + 64; ++k) acc += siluf_(p.in[1][k]) * W[(size_t)k * 6144 + n];
            ((float*)(p.ws + WS_ADAP))[(size_t)kc * 12288 + l * 6144 + n] = acc;
            continue;
        }
        r -= I_ADA;
        if (r >= I_ROT) {
            r -= I_ROT;
            const int l = r / 288, kk = r % 288, c = tid;
            bf16* LRT = (bf16*)(p.ws + WS_LRT) + (size_t)l * 73728;
            if (kk < 64) LRT[c * 64 + kk] = (bf16)f2bf(p.in[10][(l * 64 + kk) * 256 + c]);
            else if (kk < 128) LRT[16384 + c * 64 + (kk - 64)] = (bf16)f2bf(p.in[12][(l * 64 + kk - 64) * 256 + c]);
            else if (kk < 256) LRT[32768 + c * 128 + (kk - 128)] = (bf16)f2bf(p.in[13][(l * 128 + kk - 128) * 256 + c]);
            else LRT[65536 + c * 32 + (kk - 256)] = (bf16)f2bf(l == 1 ? p.in[20][(kk - 256) * 256 + c] : 0.f);
            continue;
        }
        {
            const int idx = r * 256 + tid;
            const int t = idx >> 5, i = idx & 31;
            const float invf = (float)pow(10000.0, -(double)i / 32.0);
            const float ang = (float)p.pos[t] * invf;
            float sn, cs; sincosf(ang, &sn, &cs);
            float* ROT = (float*)(p.ws + WS_ROT);
            ROT[(size_t)idx * 2] = cs; ROT[(size_t)idx * 2 + 1] = sn;
        }
    }
}

DEVI float ada_sum(const float* ADAP, int idx) {
    float s = 0.f;
#pragma unroll
    for (int kc = 0; kc < 16; ++kc) s += ADAP[(size_t)kc * 12288 + idx];
    return s;
}
DEVI void phase_h0(const P& p) {
    const float* ADAP = (const float*)(p.ws + WS_ADAP);
    float* ADA = (float*)(p.ws + OFF_ADA);
    bf16* HB = (bf16*)(p.ws + WS_HB);
    if (VBID < 48) ADA[VBID * 256 + VTID] = ada_sum(ADAP, VBID * 256 + VTID);
    const size_t n4 = (size_t)S * D / 4;
    const int c = (int)(((size_t)VBID * NT + VTID) % (D / 4)) * 4;
    f32x4 sh, sc;
    sh.x = ada_sum(ADAP, c); sh.y = ada_sum(ADAP, c + 1); sh.z = ada_sum(ADAP, c + 2); sh.w = ada_sum(ADAP, c + 3);
    sc.x = ada_sum(ADAP, 1024 + c); sc.y = ada_sum(ADAP, 1025 + c); sc.z = ada_sum(ADAP, 1026 + c); sc.w = ada_sum(ADAP, 1027 + c);
    for (size_t i = (size_t)VBID * NT + VTID; i < n4; i += (size_t)VNB * NT) {
        const f32x4 x = ((const f32x4*)p.in[0])[i];
        u32x2 o;
        o.x = pk2(x.x * (1.f + sc.x) + sh.x, x.y * (1.f + sc.y) + sh.y);
        o.y = pk2(x.z * (1.f + sc.z) + sh.z, x.w * (1.f + sc.w) + sh.w);
        ((u32x2*)HB)[i] = o;
    }
}

template <class AF, class BF>
DEVI void gemm_tile(char* smem, const bf16* __restrict__ Abase, AF arow, const bf16* __restrict__ Bbase, BF brow, int K, f32x4 (&acc)[4][8]) {
    const int tid = VTID, wid = tid >> 6, lane = tid & 63, wr = wid >> 1, wc = wid & 1, fr = lane & 15, fq = lane >> 4;
    const int r0 = tid >> 2;
    const int swz = ((tid & 3) ^ ((0x1320 >> (4 * ((tid >> 4) & 3))) & 3)) * 8;
    unsigned pa[2], pb[4];
#pragma unroll
    for (int i = 0; i < 2; ++i) pa[i] = arow(r0 + 64 * i) + swz;
#pragma unroll
    for (int i = 0; i < 4; ++i) pb[i] = brow(r0 + 64 * i) + swz;
#pragma unroll
    for (int m = 0; m < 4; ++m)
#pragma unroll
        for (int n = 0; n < 8; ++n) acc[m][n] = (f32x4){0.f, 0.f, 0.f, 0.f};
    const int nk = K / 32;
    const int ch = (fq ^ ((0x1320 >> (4 * ((fr >> 2) & 3))) & 3)) * 16;
#define GT_STAGE(kt) do { char* _sa = smem + ((kt) % 3) * 24576; char* _sb = _sa + 8192; \
        _Pragma("unroll") for (int _i = 0; _i < 2; ++_i) \
            __builtin_amdgcn_global_load_lds((const unsigned*)(Abase + pa[_i] + (kt) * 32), (unsigned*)(_sa + (tid + 256 * _i) * 16), 16, 0, 0); \
        _Pragma("unroll") for (int _i = 0; _i < 4; ++_i) \
            __builtin_amdgcn_global_load_lds((const unsigned*)(Bbase + pb[_i] + (kt) * 32), (unsigned*)(_sb + (tid + 256 * _i) * 16), 16, 0, 0); } while (0)
    asm volatile("s_waitcnt vmcnt(0)" ::: "memory");
    GT_STAGE(0); GT_STAGE(1);
    for (int kt = 0; kt < nk; ++kt) {
        if (kt + 1 < nk) asm volatile("s_waitcnt vmcnt(6)" ::: "memory");
        else asm volatile("s_waitcnt vmcnt(0)" ::: "memory");
        asm volatile("s_waitcnt lgkmcnt(0)" ::: "memory");
        __builtin_amdgcn_s_barrier();
        if (kt + 2 < nk) GT_STAGE(kt + 2);
        const char* SA = smem + (kt % 3) * 24576; const char* SB = SA + 8192;
        bf16x8 af[4], bfr[8];
#pragma unroll
        for (int m = 0; m < 4; ++m) af[m] = *(const bf16x8*)(SA + (wr * 64 + m * 16 + fr) * 64 + ch);
#pragma unroll
        for (int n = 0; n < 8; ++n) bfr[n] = *(const bf16x8*)(SB + (wc * 128 + n * 16 + fr) * 64 + ch);
#pragma unroll
        for (int m = 0; m < 4; ++m)
#pragma unroll
            for (int n = 0; n < 8; ++n)
                acc[m][n] = __builtin_amdgcn_mfma_f32_16x16x32_bf16(bfr[n], af[m], acc[m][n], 0, 0, 0);
    }
    asm volatile("s_waitcnt lgkmcnt(0)" ::: "memory");
    __builtin_amdgcn_s_barrier();
#undef GT_STAGE
}

DEVI void phase_inproj(const P& p, int l, char* smem) {
    const bf16* HB = (const bf16*)(p.ws + WS_HB);
    const bf16* W = (const bf16*)(p.ws + WS_WIN) + (size_t)l * NPAD * D;
    bf16* PROJ = (bf16*)(p.ws + WS_PROJ); float* PEX = (float*)(p.ws + WS_PEX);
    const int lane = VTID & 63, wid = VTID >> 6, wr = wid >> 1, wc = wid & 1, fr = lane & 15, fq = lane >> 4;
    constexpr int NMAIN = (S / 128) * 16;
    for (int tile = VBID; tile < NMAIN + S / 128; tile += VNB) {
        int mt, nt;
        if (tile < NMAIN) { const int x = tile & 7, q = tile >> 3; nt = x + 8 * (q & 1); mt = q >> 1; }
        else { mt = tile - NMAIN; nt = 16; }
        f32x4 acc[4][8];
        gemm_tile(smem, HB, [&](int r) { return (unsigned)((mt * 128 + r) * D); }, W, [&](int r) { return (unsigned)((nt * 256 + r) * D); }, D, acc);
#pragma unroll
        for (int m = 0; m < 4; ++m) {
            const int tok = mt * 128 + wr * 64 + m * 16 + fr;
#pragma unroll
            for (int n = 0; n < 8; ++n) {
                const int f = wc * 128 + n * 16 + fq * 4;
                if (nt < 16) {
                    u32x2 o; o.x = pk2(acc[m][n].x, acc[m][n].y); o.y = pk2(acc[m][n].z, acc[m][n].w);
                    *(u32x2*)(PROJ + (size_t)tok * NPROJ + nt * 256 + f) = o;
                } else if (f < 64) {
                    *(f32x4*)(PEX + (size_t)tok * 64 + f) = acc[m][n];
                }
            }
        }
    }
}

DEVI float proj_at(const bf16* PROJ, int t, int col) { return bf2f(PROJ[(size_t)t * NPROJ + col]); }
DEVI float proj_shift(const bf16* PROJ, int t, int col, float mu) {
    const float cur = proj_at(PROJ, t, col);
    const float prv = t > 0 ? proj_at(PROJ, t - 1, col) : 0.f;
    return cur + (prv - cur) * mu;
}

DEVI f32x4 shift4(const bf16* PROJ, int t, int col, const f32x4& mu) {
    const f32x4 cur = ld_bf4(PROJ + (size_t)t * NPROJ + col);
    f32x4 prv = {0.f, 0.f, 0.f, 0.f};
    if (t > 0) prv = ld_bf4(PROJ + (size_t)(t - 1) * NPROJ + col);
    return cur + (prv - cur) * mu;
}
DEVI float fsig(float x) { return sigmoidf_(x); }
DEVI void phase_mixprep(const P& p, int l, char* smem) {
    const bf16* PROJ = (const bf16*)(p.ws + WS_PROJ); const float* PEX = (const float*)(p.ws + WS_PEX);
    float* VFIRST = (float*)(p.ws + WS_VFIRST);
    float* RECR = (float*)(p.ws + WS_RECR); float* RECG = (float*)(p.ws + WS_RECG); float* RECT = (float*)(p.ws + WS_RECT);
    float* GB = (float*)(p.ws + WS_G); float* BON = (float*)(p.ws + WS_BON);
    const float* ROT = (const float*)(p.ws + WS_ROT);
    const bf16* LRT = (const bf16*)(p.ws + WS_LRT) + (size_t)l * 73728;
    bf16* L = (bf16*)smem;
    const float* mu = p.in[7] + l * 1024;
    for (int item = VBID; item < S / 16; item += VNB) {
        int tid = VTID; asm volatile("" : "+v"(tid));
        const int lane = tid & 63, w = tid >> 6, fr = lane & 15, fq = lane >> 4;
        const int t0 = item * 16;
        for (int g = tid; g < 16 * 72; g += NT) {
            const int tt = g / 72, i4 = (g % 72) * 4, t = t0 + tt;
            f32x4 v;
            if (i4 < 256) {
                const int col = 768 + i4;
                v = shift4(PROJ, t, col, *(const f32x4*)(mu + col));
                if (i4 < 64) { v.x = tanhf(v.x); v.y = tanhf(v.y); v.z = tanhf(v.z); v.w = tanhf(v.w); }
                else if (i4 >= 128) { v.x = fsig(v.x); v.y = fsig(v.y); v.z = fsig(v.z); v.w = fsig(v.w); }
            } else {
                v = (f32x4){0.f, 0.f, 0.f, 0.f};
                if (l == 1) {
                    const int j = i4 - 256;
                    const f32x4 cur = *(const f32x4*)(PEX + (size_t)t * 64 + 8 + j);
                    f32x4 prv = {0.f, 0.f, 0.f, 0.f};
                    if (t > 0) prv = *(const f32x4*)(PEX + (size_t)(t - 1) * 64 + 8 + j);
                    v = cur + (prv - cur) * *(const f32x4*)(p.in[8] + j);
                }
            }
            *(u32x2*)(L + tt * 296 + i4) = (u32x2){pk2(v.x, v.y), pk2(v.z, v.w)};
        }
        __syncthreads();
        const int t = t0 + fr, h = w;
        {
            f32x4 aw[4], aa[4], ag[4], av[4];
#pragma unroll
            for (int i = 0; i < 4; ++i) { aw[i] = (f32x4){0.f, 0.f, 0.f, 0.f}; aa[i] = aw[i]; ag[i] = aw[i]; av[i] = aw[i]; }
            bf16x8 lf[9];
#pragma unroll
            for (int ks = 0; ks < 9; ++ks) lf[ks] = *(const bf16x8*)(L + fr * 296 + ks * 32 + fq * 8);
#pragma unroll
            for (int i = 0; i < 4; ++i) {
                const int c = 64 * h + 16 * i + fr;
#pragma unroll
                for (int ks = 0; ks < 2; ++ks) aw[i] = mfma16(*(const bf16x8*)(LRT + c * 64 + ks * 32 + fq * 8), lf[ks], aw[i]);
#pragma unroll
                for (int ks = 0; ks < 2; ++ks) aa[i] = mfma16(*(const bf16x8*)(LRT + 16384 + c * 64 + ks * 32 + fq * 8), lf[2 + ks], aa[i]);
#pragma unroll
                for (int ks = 0; ks < 4; ++ks) ag[i] = mfma16(*(const bf16x8*)(LRT + 32768 + c * 128 + ks * 32 + fq * 8), lf[4 + ks], ag[i]);
                if (l == 1) av[i] = mfma16(*(const bf16x8*)(LRT + 65536 + c * 32 + fq * 8), lf[8], av[i]);
            }
            float* rec = RECR + ((size_t)t * 4 + h) * 384;
            f32x4 kx[4], as_[4];
            float ss = 0.f, bsum = 0.f;
#pragma unroll
            for (int i = 0; i < 4; ++i) {
                const int j = 16 * i + 4 * fq, c = 64 * h + j;
                const f32x4 r = shift4(PROJ, t, c, *(const f32x4*)(mu + c));
                const f32x4 k = shift4(PROJ, t, 256 + c, *(const f32x4*)(mu + 256 + c));
                f32x4 v = shift4(PROJ, t, 512 + c, *(const f32x4*)(mu + 512 + c));
                const f32x4 w0 = *(const f32x4*)(p.in[9] + l * 256 + c), a0 = *(const f32x4*)(p.in[11] + l * 256 + c);
                const f32x4 kkc = *(const f32x4*)(p.in[14] + l * 256 + c), kac = *(const f32x4*)(p.in[15] + l * 256 + c), rkc = *(const f32x4*)(p.in[16] + l * 256 + c);
                f32x4 dec, a;
#pragma unroll
                for (int q = 0; q < 4; ++q) {
                    const float wl = -softplusf_(-(w0[q] + aw[i][q])) - 0.5f;
                    dec[q] = __expf(-__expf(wl));
                    a[q] = fsig(a0[q] + aa[i][q]);
                }
                if (l == 0) *(f32x4*)(VFIRST + (size_t)t * 256 + c) = v;
                else {
                    const f32x4 vf = *(const f32x4*)(VFIRST + (size_t)t * 256 + c), v0 = *(const f32x4*)(p.in[19] + c);
#pragma unroll
                    for (int q = 0; q < 4; ++q) v[q] = v[q] + (vf[q] - v[q]) * fsig(v0[q] + av[i][q]);
                }
                kx[i] = k * kkc; as_[i] = a;
                const f32x4 k2 = k * ((a - 1.f) * kac + 1.f);
                ss += kx[i].x * kx[i].x + kx[i].y * kx[i].y + kx[i].z * kx[i].z + kx[i].w * kx[i].w;
                const f32x4 rb = r * k2 * rkc;
                bsum += (rb.x + rb.y) + (rb.z + rb.w);
                *(f32x4*)(rec + 64 + j) = dec; *(f32x4*)(rec + 192 + j) = k2; *(f32x4*)(rec + 256 + j) = r; *(f32x4*)(rec + 320 + j) = v;
                *(f32x4*)(GB + (size_t)t * 256 + c) = ag[i];
            }
            const float rn = rsqrtf(quad_sum(ss) + 1e-12f);
            bsum = quad_sum(bsum);
            if (fq == 0) BON[(size_t)t * 4 + h] = bsum;
#pragma unroll
            for (int i = 0; i < 4; ++i) {
                const int j = 16 * i + 4 * fq;
                const f32x4 kk = kx[i] * rn;
                *(f32x4*)(rec + j) = -kk; *(f32x4*)(rec + 128 + j) = kk * as_[i];
            }
        }
        {
            const float* conv_w = p.in[21] + l * 4 * 1536;
            float* rec = RECG + ((size_t)t * 4 + h) * 392;
            f32x4 yq[8], yk[8];
            float sq = 0.f, sk = 0.f;
#pragma unroll
            for (int which = 0; which < 3; ++which) {
#pragma unroll
                for (int i = 0; i < 8; ++i) {
                    const int j = 16 * i + 4 * fq, ch = which * 512 + h * 128 + j, col = 1024 + ch;
                    f32x4 cv = ld_bf4(PROJ + (size_t)t * NPROJ + col) * *(const f32x4*)(conv_w + 3 * 1536 + ch);
#pragma unroll
                    for (int tap = 0; tap < 3; ++tap) {
                        const int tp = t - 3 + tap;
                        if (tp >= 0) cv = cv + ld_bf4(PROJ + (size_t)tp * NPROJ + col) * *(const f32x4*)(conv_w + tap * 1536 + ch);
                    }
                    f32x4 y; y.x = siluf_(cv.x); y.y = siluf_(cv.y); y.z = siluf_(cv.z); y.w = siluf_(cv.w);
                    if (which == 0) { yq[i] = y; sq += y.x * y.x + y.y * y.y + y.z * y.z + y.w * y.w; }
                    else if (which == 1) { yk[i] = y; sk += y.x * y.x + y.y * y.y + y.z * y.z + y.w * y.w; }
                    else *(f32x4*)(rec + 256 + j) = y;
                }
            }
            const float rq = rsqrtf(quad_sum(sq) + 1e-12f) * 0.08838834764831845f, rk = rsqrtf(quad_sum(sk) + 1e-12f);
#pragma unroll
            for (int i = 0; i < 8; ++i) { const int j = 16 * i + 4 * fq; *(f32x4*)(rec + j) = yq[i] * rq; *(f32x4*)(rec + 128 + j) = yk[i] * rk; }
            if (fq == 0) {
                const float av = PEX[(size_t)t * 64 + h], bv = PEX[(size_t)t * 64 + 4 + h];
                const float g = -__expf(p.in[22][l * 4 + h]) * softplusf_(av + p.in[23][l * 4 + h]);
                *(f32x4*)(rec + 384) = (f32x4){__expf(g), fsig(bv), g, 0.f};
            }
        }
        {
            float* rec = RECT + ((size_t)t * 4 + h) * 192;
#pragma unroll
            for (int u = 0; u < 2; ++u) {
                const int i = 16 * u + 4 * fq;
                const f32x4 c0 = *(const f32x4*)(ROT + ((size_t)t * 32 + i) * 2), c1 = *(const f32x4*)(ROT + ((size_t)t * 32 + i) * 2 + 4);
                const f32x4 cs = {c0.x, c0.z, c1.x, c1.z}, sn = {c0.y, c0.w, c1.y, c1.w};
                const f32x4 q1 = ld_bf4(PROJ + (size_t)t * NPROJ + 3072 + h * 64 + i), q2 = ld_bf4(PROJ + (size_t)t * NPROJ + 3072 + h * 64 + 32 + i);
                const f32x4 k1 = ld_bf4(PROJ + (size_t)t * NPROJ + 3328 + h * 64 + i), k2 = ld_bf4(PROJ + (size_t)t * NPROJ + 3328 + h * 64 + 32 + i);
                *(f32x4*)(rec + i) = q1 * cs - q2 * sn; *(f32x4*)(rec + 32 + i) = q1 * sn + q2 * cs;
                *(f32x4*)(rec + 64 + i) = (k1 * cs - k2 * sn) * 0.125f; *(f32x4*)(rec + 96 + i) = (k1 * sn + k2 * cs) * 0.125f;
            }
#pragma unroll
            for (int i = 0; i < 4; ++i) { const int j = 16 * i + 4 * fq; *(f32x4*)(rec + 128 + j) = ld_bf4(PROJ + (size_t)t * NPROJ + 3584 + h * 64 + j); }
        }
        __syncthreads();
    }
}

DEVI void scan_rwkv(const P& p, int item, char* smem) {
    const float* REC = (const float*)(p.ws + WS_RECR); float* YR = (float*)(p.ws + WS_YR);
    float* L = (float*)smem;
    const int h = item >> 2, rg = item & 3;
    const int tid = VTID, lane = tid & 63, w = tid >> 6, sub = lane & 15;
    const int i = rg * 16 + w * 4 + (lane >> 4);
    float s0 = 0.f, s1 = 0.f, s2 = 0.f, s3 = 0.f;
    for (int c0 = 0; c0 < S; c0 += 32) {
        for (int idx = tid; idx < 32 * 96; idx += NT) {
            const int tok = idx / 96, f4 = idx % 96;
            ((f32x4*)L)[idx] = *(const f32x4*)(REC + ((size_t)(c0 + tok) * 4 + h) * 384 + f4 * 4);
        }
        __syncthreads();
        for (int tt = 0; tt < 32; ++tt) {
            const float* R = L + tt * 384;
            const f32x4 a = *(const f32x4*)(R + sub * 4), wv = *(const f32x4*)(R + 64 + sub * 4), b = *(const f32x4*)(R + 128 + sub * 4);
            const f32x4 k = *(const f32x4*)(R + 192 + sub * 4), r = *(const f32x4*)(R + 256 + sub * 4);
            const float v = R[320 + i];
            const float sa = row16_sum(s0 * a.x + s1 * a.y + s2 * a.z + s3 * a.w);
            s0 = s0 * wv.x + sa * b.x + v * k.x; s1 = s1 * wv.y + sa * b.y + v * k.y;
            s2 = s2 * wv.z + sa * b.z + v * k.z; s3 = s3 * wv.w + sa * b.w + v * k.w;
            const float y = row16_sum(s0 * r.x + s1 * r.y + s2 * r.z + s3 * r.w);
            if (sub == 0) YR[(size_t)(c0 + tt) * 256 + h * 64 + i] = y;
        }
        __syncthreads();
    }
}
DEVI void scan_gdn(const P& p, int item, char* smem) {
    const float* REC = (const float*)(p.ws + WS_RECG); float* OG = (float*)(p.ws + WS_OG);
    float* L = (float*)smem;
    const int h = item >> 3, eg = item & 7;
    const int tid = VTID, lane = tid & 63, w = tid >> 6, sub = lane & 15;
    const int e = eg * 16 + w * 4 + (lane >> 4);
    float s[8];
#pragma unroll
    for (int j = 0; j < 8; ++j) s[j] = 0.f;
    for (int c0 = 0; c0 < S; c0 += 32) {
        for (int idx = tid; idx < 32 * 98; idx += NT) {
            const int tok = idx / 98, f4 = idx % 98;
            ((f32x4*)L)[idx] = *(const f32x4*)(REC + ((size_t)(c0 + tok) * 4 + h) * 392 + f4 * 4);
        }
        __syncthreads();
        for (int tt = 0; tt < 32; ++tt) {
            const float* R = L + tt * 392;
            const f32x4 q0 = *(const f32x4*)(R + sub * 8), q1 = *(const f32x4*)(R + sub * 8 + 4);
            const f32x4 k0 = *(const f32x4*)(R + 128 + sub * 8), k1 = *(const f32x4*)(R + 128 + sub * 8 + 4);
            const float v = R[256 + e], dec = R[384], beta = R[385];
#pragma unroll
            for (int j = 0; j < 8; ++j) s[j] *= dec;
            const float kS = row16_sum(s[0] * k0.x + s[1] * k0.y + s[2] * k0.z + s[3] * k0.w + s[4] * k1.x + s[5] * k1.y + s[6] * k1.z + s[7] * k1.w);
            const float cf = beta * (v - kS);
            s[0] += cf * k0.x; s[1] += cf * k0.y; s[2] += cf * k0.z; s[3] += cf * k0.w;
            s[4] += cf * k1.x; s[5] += cf * k1.y; s[6] += cf * k1.z; s[7] += cf * k1.w;
            const float o = row16_sum(s[0] * q0.x + s[1] * q0.y + s[2] * q0.z + s[3] * q0.w + s[4] * q1.x + s[5] * q1.y + s[6] * q1.z + s[7] * q1.w);
            if (sub == 0) OG[(size_t)(c0 + tt) * 512 + h * 128 + e] = o;
        }
        __syncthreads();
    }
}
DEVI void scan_ret(const P& p, int item, char* smem) {
    const float* REC = (const float*)(p.ws + WS_RECT); float* ORT = (float*)(p.ws + WS_ORT);
    float* L = (float*)smem;
    const int h = item >> 2, eg = item & 3;
    const int tid = VTID, lane = tid & 63, w = tid >> 6, sub = lane & 15;
    const int e = eg * 16 + w * 4 + (lane >> 4);
    const float gam = 1.f - exp2f(-5.f - (float)h);
    float s0 = 0.f, s1 = 0.f, s2 = 0.f, s3 = 0.f;
    for (int c0 = 0; c0 < S; c0 += 32) {
        for (int idx = tid; idx < 32 * 48; idx += NT) {
            const int tok = idx / 48, f4 = idx % 48;
            ((f32x4*)L)[idx] = *(const f32x4*)(REC + ((size_t)(c0 + tok) * 4 + h) * 192 + f4 * 4);
        }
        __syncthreads();
        for (int tt = 0; tt < 32; ++tt) {
            const float* R = L + tt * 192;
            const f32x4 q = *(const f32x4*)(R + sub * 4), k = *(const f32x4*)(R + 64 + sub * 4);
            const float v = R[128 + e];
            s0 = s0 * gam + k.x * v; s1 = s1 * gam + k.y * v; s2 = s2 * gam + k.z * v; s3 = s3 * gam + k.w * v;
            const float o = row16_sum(s0 * q.x + s1 * q.y + s2 * q.z + s3 * q.w);
            if (sub == 0) ORT[(size_t)(c0 + tt) * 256 + h * 64 + e] = o;
        }
        __syncthreads();
    }
}
DEVI void retA_item(const P& p, int item, char* smem) {
    const float* REC = (const float*)(p.ws + WS_RECT); float* KV = (float*)(p.ws + WS_RKV);
    bf16* KT = (bf16*)smem; bf16* VT = KT + 64 * 72;
    const int n = item >> 2, h = item & 3;
    int tid = VTID; asm volatile("" : "+v"(tid));
    const int lane = tid & 63, w = tid >> 6, fr = lane & 15, fq = lane >> 4;
    const float lg = log2f(1.f - exp2f(-5.f - (float)h));
    {
        const int d = lane;
        unsigned kp[8], vp[8];
#pragma unroll
        for (int i = 0; i < 8; ++i) {
            const int c0 = 16 * w + 2 * i;
            const float* r0 = REC + ((size_t)(n * 64 + c0) * 4 + h) * 192;
            const float* r1 = r0 + 4 * 192;
            kp[i] = pk2(r0[64 + d] * exp2f((float)(63 - c0) * lg), r1[64 + d] * exp2f((float)(62 - c0) * lg));
            vp[i] = pk2(r0[128 + d], r1[128 + d]);
        }
        *(u32x4*)(KT + d * 72 + 16 * w) = (u32x4){kp[0], kp[1], kp[2], kp[3]};
        *(u32x4*)(KT + d * 72 + 16 * w + 8) = (u32x4){kp[4], kp[5], kp[6], kp[7]};
        *(u32x4*)(VT + d * 72 + 16 * w) = (u32x4){vp[0], vp[1], vp[2], vp[3]};
        *(u32x4*)(VT + d * 72 + 16 * w + 8) = (u32x4){vp[4], vp[5], vp[6], vp[7]};
    }
    __syncthreads();
    {
        const int dt = w;
        const bf16x8 a0 = ldfrag(KT, 72, 16 * dt, 0, lane), a1 = ldfrag(KT, 72, 16 * dt, 32, lane);
        float* out = KV + (size_t)item * 4096;
        const int s_ = dt >> 1, lane2 = 16 * (2 * (dt & 1) + (fq >> 1)) + fr;
#pragma unroll
        for (int et = 0; et < 4; ++et) {
            f32x4 acc = {0.f, 0.f, 0.f, 0.f};
            acc = mfma16(a0, ldfrag(VT, 72, 16 * et, 0, lane), acc);
            acc = mfma16(a1, ldfrag(VT, 72, 16 * et, 32, lane), acc);
            *(f32x4*)(out + ((et * 2 + s_) * 64 + lane2) * 8 + 4 * (fq & 1)) = acc;
        }
    }
    __syncthreads();
}

DEVI void retS_item(const P& p, int item) {
    const float* KV = (const float*)(p.ws + WS_RKV); bf16* RST = (bf16*)(p.ws + WS_RST);
    const int idx = item * NT + VTID;
    const int h = idx >> 12, i = idx & 4095;
    const float cd = exp2f(64.f * log2f(1.f - exp2f(-5.f - (float)h)));
    float r = 0.f;
#pragma unroll 8
    for (int n = 0; n < 256; ++n) {
        const float kv = KV[((size_t)n * 4 + h) * 4096 + i];
        RST[((size_t)n * 4 + h) * 4096 + i] = (bf16)f2bf(r);
        r = r * cd + kv;
    }
}

DEVI void retC_item(const P& p, int item, int l, char* smem) {
    const float* REC = (const float*)(p.ws + WS_RECT); const bf16* RST = (const bf16*)(p.ws + WS_RST);
    const bf16* PROJ = (const bf16*)(p.ws + WS_PROJ); bf16* MIX = (bf16*)(p.ws + WS_MIX);
    const float* rgn = p.in[25] + l * 256; const float* rbn = p.in[26] + l * 256;
    bf16* Qs = (bf16*)smem; bf16* Ks = Qs + 64 * 72; bf16* VT = Ks + 64 * 72; bf16* Ps = VT + 64 * 72;
    const int n = item >> 2, h = item & 3;
    int tid = VTID; asm volatile("" : "+v"(tid));
    const int lane = tid & 63, w = tid >> 6, fr = lane & 15, fq = lane >> 4;
    const float lg = log2f(1.f - exp2f(-5.f - (float)h));
    {
        const int d = lane;
        unsigned vp[8];
#pragma unroll
        for (int i = 0; i < 8; ++i) {
            const int c0 = 16 * w + 2 * i;
            const float* r0 = REC + ((size_t)(n * 64 + c0) * 4 + h) * 192;
            const float* r1 = r0 + 4 * 192;
            Qs[c0 * 72 + d] = (bf16)f2bf(r0[d]); Qs[(c0 + 1) * 72 + d] = (bf16)f2bf(r1[d]);
            Ks[c0 * 72 + d] = (bf16)f2bf(r0[64 + d]); Ks[(c0 + 1) * 72 + d] = (bf16)f2bf(r1[64 + d]);
            vp[i] = pk2(r0[128 + d], r1[128 + d]);
        }
        *(u32x4*)(VT + d * 72 + 16 * w) = (u32x4){vp[0], vp[1], vp[2], vp[3]};
        *(u32x4*)(VT + d * 72 + 16 * w + 8) = (u32x4){vp[4], vp[5], vp[6], vp[7]};
    }
    __syncthreads();
    const int ct = w, c = 16 * ct + fr;
    const bf16x8 q0 = ldfrag(Qs, 72, 16 * ct, 0, lane), q1 = ldfrag(Qs, 72, 16 * ct, 32, lane);
#pragma unroll
    for (int ct2 = 0; ct2 < 4; ++ct2) {
        f32x4 acc = {0.f, 0.f, 0.f, 0.f};
        acc = mfma16(ldfrag(Ks, 72, 16 * ct2, 0, lane), q0, acc);
        acc = mfma16(ldfrag(Ks, 72, 16 * ct2, 32, lane), q1, acc);
        float pv[4];
#pragma unroll
        for (int j = 0; j < 4; ++j) {
            const int c2 = 16 * ct2 + 4 * fq + j;
            pv[j] = (c >= c2) ? acc[j] * exp2f((float)(c - c2) * lg) : 0.f;
        }
        *(u32x2*)(Ps + c * 72 + 16 * ct2 + 4 * fq) = (u32x2){pk2(pv[0], pv[1]), pk2(pv[2], pv[3])};
    }
    __syncthreads();
    {
        const bf16x8 p0 = ldfrag(Ps, 72, 16 * ct, 0, lane), p1 = ldfrag(Ps, 72, 16 * ct, 32, lane);
        const float xi = exp2f((float)(c + 1) * lg);
        const bf16* RF = RST + (size_t)item * 4096;
        f32x4 o[4];
        float sm = 0.f;
#pragma unroll
        for (int et = 0; et < 4; ++et) {
            f32x4 ai = {0.f, 0.f, 0.f, 0.f}, ax = {0.f, 0.f, 0.f, 0.f};
            ai = mfma16(ldfrag(VT, 72, 16 * et, 0, lane), p0, ai);
            ai = mfma16(ldfrag(VT, 72, 16 * et, 32, lane), p1, ai);
            const bf16x8 r0 = *(const bf16x8*)(RF + ((et * 2 + 0) * 64 + lane) * 8);
            const bf16x8 r1 = *(const bf16x8*)(RF + ((et * 2 + 1) * 64 + lane) * 8);
            ax = mfma16(r0, q0, ax);
            ax = mfma16(r1, q1, ax);
            o[et] = ai + ax * xi;
            sm += (o[et].x + o[et].y) + (o[et].z + o[et].w);
        }
        const float mean = quad_sum(sm) * (1.f / 64.f);
        float sv = 0.f;
#pragma unroll
        for (int et = 0; et < 4; ++et) { o[et] = o[et] - mean; sv += o[et].x * o[et].x + o[et].y * o[et].y + o[et].z * o[et].z + o[et].w * o[et].w; }
        const float rs = rsqrtf(quad_sum(sv) * (1.f / 64.f) + 1e-5f);
        const int t = n * 64 + c;
#pragma unroll
        for (int et = 0; et < 4; ++et) {
            const int e = h * 64 + 16 * et + 4 * fq;
            const f32x4 g = *(const f32x4*)(rgn + e), b = *(const f32x4*)(rbn + e);
            const f32x4 gt = ld_bf4(PROJ + (size_t)t * NPROJ + 3840 + e);
            const f32x4 y = o[et] * rs * g + b;
            *(u32x2*)(MIX + (size_t)t * D + 768 + e) = (u32x2){pk2(y.x * siluf_(gt.x), y.y * siluf_(gt.y)), pk2(y.z * siluf_(gt.z), y.w * siluf_(gt.w))};
        }
    }
    __syncthreads();
}

template <int I, int N> struct SolveRow {
    static DEVI void run(float (&x)[N], const float* M) {
        float s = 0.f;
#pragma unroll
        for (int j4 = 0; j4 < (I + 3) / 4; ++j4) {
            const f32x4 m = *(const f32x4*)(M + I * N + 4 * j4);
            s += m.x * x[4 * j4] + m.y * x[4 * j4 + 1] + m.z * x[4 * j4 + 2] + m.w * x[4 * j4 + 3];
        }
        x[I] -= s;
        asm volatile("" : "+v"(x[I]) :: "memory");
        SolveRow<I + 1, N>::run(x, M);
    }
};
template <int N> struct SolveRow<N, N> { static DEVI void run(float (&)[N], const float*) {} };

DEVI void gdnA_item(const P& p, int item, char* smem) {
    const float* REC = (const float*)(p.ws + WS_RECG);
    bf16* GP = (bf16*)(p.ws + WS_GP) + (size_t)item * 16384; float* GB = (float*)(p.ws + WS_GB) + (size_t)item * 16384;
    float* GD = (float*)(p.ws + WS_GD);
    bf16* GQ = (bf16*)(p.ws + WS_GQ) + (size_t)item * 8192; float* GO = (float*)(p.ws + WS_GO) + (size_t)item * 8192;
    bf16* Kb = (bf16*)smem; bf16* Qb = Kb + 64 * 136;
    bf16* WT = (bf16*)smem; bf16* UT = WT + 128 * 72;
    bf16* Vb = (bf16*)(smem + 36864);
    float* M = (float*)(smem + 36864);
    bf16* KdT = (bf16*)(smem + 36864);
    bf16* At = (bf16*)(smem + 55296);
    float* gcs = (float*)(smem + 64512); float* bts = gcs + 64; float* sws = gcs + 128; float* sks = gcs + 192;
    const int n = item >> 2, h = item & 3;
    int tid = VTID; asm volatile("" : "+v"(tid));
    const int lane = tid & 63, w = tid >> 6, fr = lane & 15, fq = lane >> 4;
    const float* rec0 = REC + ((size_t)(n * 64) * 4 + h) * 392;
    if (w == 0) {
        float x = rec0[(size_t)lane * 1568 + 386];
#pragma unroll
        for (int off = 1; off < 64; off <<= 1) { const float y = __shfl_up(x, off); if (lane >= off) x += y; }
        const float bt = rec0[(size_t)lane * 1568 + 385];
        gcs[lane] = x; bts[lane] = bt; sws[lane] = bt * __expf(x); sks[lane] = __expf(__shfl(x, 63) - x);
    }
#pragma unroll 2
    for (int i = 0; i < 16; ++i) {
        const int c = 16 * w + i;
        const float* r = rec0 + (size_t)c * 1568;
        Qb[c * 136 + lane] = (bf16)f2bf(r[lane]); Qb[c * 136 + 64 + lane] = (bf16)f2bf(r[64 + lane]);
        Kb[c * 136 + lane] = (bf16)f2bf(r[128 + lane]); Kb[c * 136 + 64 + lane] = (bf16)f2bf(r[192 + lane]);
        Vb[c * 136 + lane] = (bf16)f2bf(r[256 + lane]); Vb[c * 136 + 64 + lane] = (bf16)f2bf(r[320 + lane]);
    }
    __syncthreads();
    float x[64];
    unsigned kdp[16];
    {
        const int col = tid & 127;
        int sel_b = (tid < 128) ? 36864 : 0, sel_s = (tid < 128) ? 64 : 128;
        asm volatile("" : "+v"(sel_b), "+v"(sel_s));
        const bf16* srcb = (const bf16*)(smem + sel_b) + col;
        const float* scs = gcs + sel_s;
#pragma unroll
        for (int c = 0; c < 64; ++c) {
            x[c] = scs[c] * bf2f(srcb[c * 136]);
            if ((c & 7) == 7) asm volatile("" : "+v"(x[c]) :: "memory");
        }
        const int half = tid >> 7;
#pragma unroll
        for (int i = 0; i < 16; ++i) {
            const int c = 32 * half + 2 * i;
            kdp[i] = pk2(bf2f(Kb[c * 136 + col]) * sks[c], bf2f(Kb[(c + 1) * 136 + col]) * sks[c + 1]);
            if ((i & 3) == 3) asm volatile("" : "+v"(kdp[i]) :: "memory");
        }
        if (tid == 0) GD[item] = __expf(gcs[63]);
    }
    __syncthreads();
    const int ct = w;
    f32x4 accQ[8];
    {
        const int c = 16 * ct + fr;
        const float gcc = gcs[c];
        {
            bf16x8 ka[4];
#pragma unroll
            for (int s = 0; s < 4; ++s) ka[s] = ldfrag(Kb, 136, 16 * ct, 32 * s, lane);
#pragma unroll
            for (int ct2 = 0; ct2 < 4; ++ct2) {
                f32x4 acc = {0.f, 0.f, 0.f, 0.f};
#pragma unroll
                for (int s = 0; s < 4; ++s) acc = mfma16(ka[s], ldfrag(Kb, 136, 16 * ct2, 32 * s, lane), acc);
                const int c2 = 16 * ct2 + fr; const float g2 = gcs[c2];
#pragma unroll
                for (int j = 0; j < 4; ++j) {
                    const int cc = 16 * ct + 4 * fq + j;
                    M[cc * 64 + c2] = (cc > c2) ? bts[cc] * acc[j] * __expf(gcs[cc] - g2) : 0.f;
                }
            }
        }
        {
            bf16x8 qa[4];
#pragma unroll
            for (int s = 0; s < 4; ++s) qa[s] = ldfrag(Qb, 136, 16 * ct, 32 * s, lane);
#pragma unroll
            for (int ct2 = 0; ct2 < 4; ++ct2) {
                f32x4 acc = {0.f, 0.f, 0.f, 0.f};
#pragma unroll
                for (int s = 0; s < 4; ++s) acc = mfma16(ldfrag(Kb, 136, 16 * ct2, 32 * s, lane), qa[s], acc);
                float pv[4];
#pragma unroll
                for (int j = 0; j < 4; ++j) { const int c2 = 16 * ct2 + 4 * fq + j; pv[j] = (c >= c2) ? acc[j] * __expf(gcc - gcs[c2]) : 0.f; }
                *(u32x2*)(At + c * 72 + 16 * ct2 + 4 * fq) = (u32x2){pk2(pv[0], pv[1]), pk2(pv[2], pv[3])};
            }
        }
    }
    __syncthreads();
    {
        SolveRow<1, 64>::run(x, M);
        unsigned xp[32];
#pragma unroll
        for (int q = 0; q < 32; ++q) xp[q] = pk2(x[2 * q], x[2 * q + 1]);
        {
            const int c = 16 * ct + fr;
            const float eg = __expf(gcs[c]);
#pragma unroll
            for (int dt = 0; dt < 8; ++dt) accQ[dt] = ld_bf4(Qb + c * 136 + 16 * dt + 4 * fq) * (-eg);
        }
        __syncthreads();
        int sel_d = (tid < 128) ? 128 * 72 : 0;
        asm volatile("" : "+v"(sel_d));
        bf16* dst = WT + sel_d + (tid & 127) * 72;
#pragma unroll
        for (int q = 0; q < 8; ++q) *(u32x4*)(dst + 8 * q) = (u32x4){xp[4 * q], xp[4 * q + 1], xp[4 * q + 2], xp[4 * q + 3]};
    }
    __syncthreads();
    {
        const int d = tid & 127, half = tid >> 7;
#pragma unroll
        for (int q = 0; q < 4; ++q) *(u32x4*)(KdT + d * 72 + 32 * half + 8 * q) = (u32x4){kdp[4 * q], kdp[4 * q + 1], kdp[4 * q + 2], kdp[4 * q + 3]};
    }
    __syncthreads();
    {
#pragma unroll 1
        for (int mi = 0; mi < 2; ++mi) {
            const int mt = 2 * w + mi;
            const bf16x8 kd0 = ldfrag(KdT, 72, 16 * mt, 0, lane), kd1 = ldfrag(KdT, 72, 16 * mt, 32, lane);
#pragma unroll
            for (int sp = 0; sp < 4; ++sp) {
                f32x4 a0 = {0.f, 0.f, 0.f, 0.f}, a1 = {0.f, 0.f, 0.f, 0.f};
                a0 = mfma16(ldfrag(WT, 72, 32 * sp, 0, lane), kd0, a0); a0 = mfma16(ldfrag(WT, 72, 32 * sp, 32, lane), kd1, a0);
                a1 = mfma16(ldfrag(WT, 72, 32 * sp + 16, 0, lane), kd0, a1); a1 = mfma16(ldfrag(WT, 72, 32 * sp + 16, 32, lane), kd1, a1);
                *(u32x4*)(GP + ((mt * 4 + sp) * 64 + lane) * 8) = (u32x4){pk2(-a0.x, -a0.y), pk2(-a0.z, -a0.w), pk2(-a1.x, -a1.y), pk2(-a1.z, -a1.w)};
            }
#pragma unroll
            for (int nt = 0; nt < 8; ++nt) {
                f32x4 a = {0.f, 0.f, 0.f, 0.f};
                a = mfma16(kd0, ldfrag(UT, 72, 16 * nt, 0, lane), a); a = mfma16(kd1, ldfrag(UT, 72, 16 * nt, 32, lane), a);
                *(f32x4*)(GB + ((nt * 8 + mt) * 64 + lane) * 4) = a;
            }
        }
        const bf16x8 at0 = ldfrag(At, 72, 16 * ct, 0, lane), at1 = ldfrag(At, 72, 16 * ct, 32, lane);
#pragma unroll
        for (int sp = 0; sp < 4; ++sp) {
            f32x4 a0 = accQ[2 * sp], a1 = accQ[2 * sp + 1];
            a0 = mfma16(ldfrag(WT, 72, 32 * sp, 0, lane), at0, a0); a0 = mfma16(ldfrag(WT, 72, 32 * sp, 32, lane), at1, a0);
            a1 = mfma16(ldfrag(WT, 72, 32 * sp + 16, 0, lane), at0, a1); a1 = mfma16(ldfrag(WT, 72, 32 * sp + 16, 32, lane), at1, a1);
            *(u32x4*)(GQ + ((ct * 4 + sp) * 64 + lane) * 8) = (u32x4){pk2(-a0.x, -a0.y), pk2(-a0.z, -a0.w), pk2(-a1.x, -a1.y), pk2(-a1.z, -a1.w)};
        }
#pragma unroll
        for (int et = 0; et < 8; ++et) {
            f32x4 a = {0.f, 0.f, 0.f, 0.f};
            a = mfma16(ldfrag(UT, 72, 16 * et, 0, lane), at0, a); a = mfma16(ldfrag(UT, 72, 16 * et, 32, lane), at1, a);
            *(f32x4*)(GO + ((ct * 8 + et) * 64 + lane) * 4) = a;
        }
    }
    __syncthreads();
}

DEVI bf16x8 pack_frag(const f32x4& a, const f32x4& b) {
    const u32x4 v = {pk2(a.x, a.y), pk2(a.z, a.w), pk2(b.x, b.y), pk2(b.z, b.w)};
    return __builtin_bit_cast(bf16x8, v);
}
DEVI void gdnL1_item(const P& p, int item) {
    const bf16* GP = (const bf16*)(p.ws + WS_GP); const float* GB = (const float*)(p.ws + WS_GB); const float* GD = (const float*)(p.ws + WS_GD);
    const int half = item & 1, kind = (item >> 1) & 1, g = (item >> 2) & 15, h = item >> 6;
    const int lane = VTID & 63, ew = half * 4 + (VTID >> 6), fr = lane & 15, fq = lane >> 4;
    f32x4 acc[8];
    if (kind == 0) {
        bf16* GS = (bf16*)(p.ws + WS_GS);
#pragma unroll
        for (int m = 0; m < 8; ++m) acc[m] = (f32x4){0.f, 0.f, 0.f, 0.f};
#pragma unroll 1
        for (int n = g * 16; n < g * 16 + 16; ++n) {
            const size_t it = (size_t)n * 4 + h;
            const bf16* Pn = GP + it * 16384 + lane * 8; const float* Bn = GB + it * 16384 + (ew * 8 * 64 + lane) * 4;
            bf16x8 pf[16]; f32x4 bfr[8];
#pragma unroll
            for (int i = 0; i < 16; ++i) pf[i] = *(const bf16x8*)(Pn + i * 512);
#pragma unroll
            for (int m = 0; m < 8; ++m) bfr[m] = *(const f32x4*)(Bn + m * 256);
            const float dn = GD[it];
            asm volatile("" ::: "memory");
            bf16x8 sf[4];
#pragma unroll
            for (int s = 0; s < 4; ++s) {
                sf[s] = pack_frag(acc[2 * s], acc[2 * s + 1]);
                *(bf16x8*)(GS + it * 16384 + ((ew * 4 + s) * 64 + lane) * 8) = sf[s];
            }
            bf16x8 ph[16];
#pragma unroll
            for (int i = 0; i < 16; ++i) ph[i] = *(const bf16x8*)(Pn + (16 + i) * 512);
            asm volatile("" ::: "memory");
#pragma unroll
            for (int m = 0; m < 4; ++m) {
                f32x4 a = acc[m] * dn + bfr[m];
#pragma unroll
                for (int s = 0; s < 4; ++s) a = mfma16(pf[m * 4 + s], sf[s], a);
                acc[m] = a;
            }
#pragma unroll
            for (int m = 4; m < 8; ++m) {
                f32x4 a = acc[m] * dn + bfr[m];
#pragma unroll
                for (int s = 0; s < 4; ++s) a = mfma16(ph[(m - 4) * 4 + s], sf[s], a);
                acc[m] = a;
            }
        }
        float* E0 = (float*)(p.ws + WS_GE0) + (size_t)(h * 16 + g) * 16384 + (ew * 8 * 64 + lane) * 4;
#pragma unroll
        for (int m = 0; m < 8; ++m) *(f32x4*)(E0 + m * 256) = acc[m];
    } else {
        const bf16* GQ = (const bf16*)(p.ws + WS_GQ); bf16* GR = (bf16*)(p.ws + WS_GR);
#pragma unroll
        for (int m = 0; m < 8; ++m)
#pragma unroll
            for (int j = 0; j < 4; ++j) acc[m][j] = (m == ew && 4 * fq + j == fr) ? 1.f : 0.f;
#pragma unroll 1
        for (int n = g * 16; n < g * 16 + 16; ++n) {
            const size_t it = (size_t)n * 4 + h;
            const bf16* Pn = GP + it * 16384 + lane * 8;
            bf16x8 pf[16], qf[16];
#pragma unroll
            for (int i = 0; i < 16; ++i) pf[i] = *(const bf16x8*)(Pn + i * 512);
            const float dn = GD[it];
#pragma unroll
            for (int i = 0; i < 16; ++i) qf[i] = *(const bf16x8*)(GQ + it * 8192 + (i * 64 + lane) * 8);
            asm volatile("" ::: "memory");
            bf16x8 tf[4];
#pragma unroll
            for (int s = 0; s < 4; ++s) tf[s] = pack_frag(acc[2 * s], acc[2 * s + 1]);
#pragma unroll
            for (int tt = 0; tt < 4; ++tt) {
                f32x4 r = {0.f, 0.f, 0.f, 0.f};
#pragma unroll
                for (int s = 0; s < 4; ++s) r = mfma16(tf[s], qf[tt * 4 + s], r);
                *(u32x2*)(GR + it * 8192 + ((tt * 4 + (ew >> 1)) * 64 + lane) * 8 + 4 * (ew & 1)) = (u32x2){pk2(r.x, r.y), pk2(r.z, r.w)};
            }
            bf16x8 ph[16];
#pragma unroll
            for (int i = 0; i < 16; ++i) ph[i] = *(const bf16x8*)(Pn + (16 + i) * 512);
            asm volatile("" ::: "memory");
#pragma unroll
            for (int m = 0; m < 4; ++m) {
                f32x4 a = acc[m] * dn;
#pragma unroll
                for (int s = 0; s < 4; ++s) a = mfma16(pf[m * 4 + s], tf[s], a);
                acc[m] = a;
            }
#pragma unroll
            for (int m = 4; m < 8; ++m) {
                f32x4 a = acc[m] * dn;
#pragma unroll
                for (int s = 0; s < 4; ++s) a = mfma16(ph[(m - 4) * 4 + s], tf[s], a);
                acc[m] = a;
            }
        }
        bf16* TE = (bf16*)(p.ws + WS_GTE) + (size_t)(h * 16 + g) * 16384;
        int lane2 = VTID & 63; asm volatile("" : "+v"(lane2));
        const int fr2 = lane2 & 15, fq2 = lane2 >> 4;
        const int s_ = ew >> 1, jj = 4 * (ew & 1) + (fr2 & 3), lg = fr2 >> 2;
#pragma unroll
        for (int m = 0; m < 8; ++m)
#pragma unroll
            for (int j = 0; j < 4; ++j) TE[((m * 4 + s_) * 64 + (4 * fq2 + j) + 16 * lg) * 8 + jj] = (bf16)f2bf(acc[m][j]);
    }
}
DEVI void gdnL2_item(const P& p, int item) {
    const bf16* TE = (const bf16*)(p.ws + WS_GTE); const float* E0 = (const float*)(p.ws + WS_GE0); bf16* SG = (bf16*)(p.ws + WS_GSG);
    const int h = item >> 1, lane = VTID & 63, ew = (item & 1) * 4 + (VTID >> 6);
    f32x4 acc[8];
#pragma unroll
    for (int m = 0; m < 8; ++m) acc[m] = (f32x4){0.f, 0.f, 0.f, 0.f};
#pragma unroll 1
    for (int g = 0; g < 16; ++g) {
        const size_t hg = (size_t)h * 16 + g;
        const bf16* Tn = TE + hg * 16384 + lane * 8; const float* En = E0 + hg * 16384 + (ew * 8 * 64 + lane) * 4;
        bf16x8 pf[16]; f32x4 bfr[8];
#pragma unroll
        for (int i = 0; i < 16; ++i) pf[i] = *(const bf16x8*)(Tn + i * 512);
#pragma unroll
        for (int m = 0; m < 8; ++m) bfr[m] = *(const f32x4*)(En + m * 256);
        asm volatile("" ::: "memory");
        bf16x8 sf[4];
#pragma unroll
        for (int s = 0; s < 4; ++s) {
            sf[s] = pack_frag(acc[2 * s], acc[2 * s + 1]);
            *(bf16x8*)(SG + hg * 16384 + ((ew * 4 + s) * 64 + lane) * 8) = sf[s];
        }
        bf16x8 ph[16];
#pragma unroll
        for (int i = 0; i < 16; ++i) ph[i] = *(const bf16x8*)(Tn + (16 + i) * 512);
        asm volatile("" ::: "memory");
#pragma unroll
        for (int m = 0; m < 4; ++m) {
            f32x4 a = bfr[m];
#pragma unroll
            for (int s = 0; s < 4; ++s) a = mfma16(pf[m * 4 + s], sf[s], a);
            acc[m] = a;
        }
#pragma unroll
        for (int m = 4; m < 8; ++m) {
            f32x4 a = bfr[m];
#pragma unroll
            for (int s = 0; s < 4; ++s) a = mfma16(ph[(m - 4) * 4 + s], sf[s], a);
            acc[m] = a;
        }
    }
}

DEVI void gdnC_item(const P& p, int item, int l) {
    const bf16* GQ = (const bf16*)(p.ws + WS_GQ) + (size_t)item * 8192; const float* GO = (const float*)(p.ws + WS_GO) + (size_t)item * 8192;
    const bf16* GS = (const bf16*)(p.ws + WS_GS) + (size_t)item * 16384;
    const bf16* PROJ = (const bf16*)(p.ws + WS_PROJ); bf16* MIX = (bf16*)(p.ws + WS_MIX);
    const float* gn = p.in[24] + l * 128;
    const int n = item >> 2, h = item & 3;
    const int lane = VTID & 63, ct = VTID >> 6, fr = lane & 15, fq = lane >> 4;
    const bf16* GR = (const bf16*)(p.ws + WS_GR) + (size_t)item * 8192;
    const bf16* SG = (const bf16*)(p.ws + WS_GSG) + (size_t)(h * 16 + (n >> 4)) * 16384;
    bf16x8 qf[4], rf[4];
#pragma unroll
    for (int s = 0; s < 4; ++s) { qf[s] = *(const bf16x8*)(GQ + ((ct * 4 + s) * 64 + lane) * 8); rf[s] = *(const bf16x8*)(GR + ((ct * 4 + s) * 64 + lane) * 8); }
    const int t = n * 64 + 16 * ct + fr;
    f32x4 a[8];
    float ss = 0.f;
#pragma unroll
    for (int et = 0; et < 8; ++et) {
        f32x4 acc = *(const f32x4*)(GO + ((ct * 8 + et) * 64 + lane) * 4);
#pragma unroll
        for (int s = 0; s < 4; ++s) acc = mfma16(*(const bf16x8*)(GS + ((et * 4 + s) * 64 + lane) * 8), qf[s], acc);
#pragma unroll
        for (int s = 0; s < 4; ++s) acc = mfma16(*(const bf16x8*)(SG + ((et * 4 + s) * 64 + lane) * 8), rf[s], acc);
        a[et] = acc;
        ss += acc.x * acc.x + acc.y * acc.y + acc.z * acc.z + acc.w * acc.w;
    }
    const float rs = rsqrtf(quad_sum(ss) * (1.f / 128.f) + 1e-6f);
#pragma unroll
    for (int et = 0; et < 8; ++et) {
        const int e = 16 * et + 4 * fq;
        const f32x4 z = ld_bf4(PROJ + (size_t)t * NPROJ + 2560 + h * 128 + e);
        const f32x4 g = *(const f32x4*)(gn + e);
        const f32x4 o = a[et] * rs * g;
        *(u32x2*)(MIX + (size_t)t * D + 256 + h * 128 + e) = (u32x2){pk2(o.x * siluf_(z.x), o.y * siluf_(z.y)), pk2(o.z * siluf_(z.z), o.w * siluf_(z.w))};
    }
}

DEVI void rwkA_item(const P& p, int item, char* smem) {
    const float* REC = (const float*)(p.ws + WS_RECR);
    bf16* WP = (bf16*)(p.ws + WS_WP) + (size_t)item * 4096; float* WC = (float*)(p.ws + WS_WC) + (size_t)item * 4096;
    float* WD = (float*)(p.ws + WS_WD) + (size_t)item * 64;
    bf16* WQ = (bf16*)(p.ws + WS_WQ) + (size_t)item * 2048; float* WY = (float*)(p.ws + WS_WY) + (size_t)item * 2048;
    bf16* At_ = (bf16*)smem; bf16* Rt = At_ + 32 * 72; bf16* Bt = Rt + 32 * 72; bf16* Kt = Bt + 32 * 72;
    float* ZT = (float*)(smem + 9216);
    bf16* BhT = (bf16*)(smem + 18432); bf16* KhT = BhT + 64 * 40; bf16* VT = KhT + 64 * 40; bf16* AhT = VT + 64 * 40; bf16* UhT = AhT + 64 * 40;
    float* M = (float*)(smem + 44032);
    bf16* Aak = (bf16*)(smem + 48128); bf16* Arb = Aak + 32 * 40; bf16* Ark = Arb + 32 * 40;
    float* tot = (float*)(smem + 55808);
    const int n = item >> 2, h = item & 3;
    int tid = VTID; asm volatile("" : "+v"(tid));
    const int lane = tid & 63, w = tid >> 6, fr = lane & 15, fq = lane >> 4;
    {
        const int d = lane;
        const float* rec = REC + ((size_t)(n * 32 + 8 * w) * 4 + h) * 384 + d;
        float lw[8], lg[8];
        float run = 0.f;
#pragma unroll
        for (int i = 0; i < 8; ++i) { lg[i] = __logf(rec[(size_t)i * 1536 + 64]); run += lg[i]; lw[i] = run; }
        tot[w * 64 + d] = run;
        __syncthreads();
        float off = 0.f, total = 0.f;
#pragma unroll
        for (int q = 0; q < 4; ++q) { const float tq = tot[q * 64 + d]; total += tq; off += (q < w) ? tq : 0.f; }
        unsigned bh[4], kh[4], vv[4];
        float pb = 0.f, pk = 0.f, pv = 0.f;
#pragma unroll
        for (int i = 0; i < 8; ++i) {
            const float* r = rec + (size_t)i * 1536;
            const float a = r[0], b = r[128], k = r[192], rr = r[256], v = r[320];
            const float lc = off + lw[i];
            const float cw = __expf(lc), cwm1 = __expf(lc - lg[i]), inv = __expf(-lc), rat = __expf(total - lc);
            const int t = 8 * w + i;
            At_[t * 72 + d] = (bf16)f2bf(a * cwm1); Rt[t * 72 + d] = (bf16)f2bf(rr * cw);
            Bt[t * 72 + d] = (bf16)f2bf(b * inv); Kt[t * 72 + d] = (bf16)f2bf(k * inv);
            if (i & 1) { bh[i >> 1] = pk2(pb, b * rat); kh[i >> 1] = pk2(pk, k * rat); vv[i >> 1] = pk2(pv, v); }
            else { pb = b * rat; pk = k * rat; pv = v; }
        }
        *(u32x4*)(BhT + d * 40 + 8 * w) = (u32x4){bh[0], bh[1], bh[2], bh[3]};
        *(u32x4*)(KhT + d * 40 + 8 * w) = (u32x4){kh[0], kh[1], kh[2], kh[3]};
        *(u32x4*)(VT + d * 40 + 8 * w) = (u32x4){vv[0], vv[1], vv[2], vv[3]};
        if (w == 0) WD[d] = __expf(total);
    }
    __syncthreads();
    {
        int offA = (w == 0) ? 0 : (w == 1 ? 3 : (w == 2 ? 2 : 3));
        int offB = (w == 0) ? 2 : (w == 1 ? 0 : 1);
        asm volatile("" : "+v"(offA), "+v"(offB));
        const bf16* As = At_ + offA * (32 * 72); const bf16* Bs = At_ + offB * (32 * 72);
#pragma unroll
        for (int ta = 0; ta < 2; ++ta) {
            const bf16x8 a0 = ldfrag(As, 72, 16 * ta, 0, lane), a1 = ldfrag(As, 72, 16 * ta, 32, lane);
#pragma unroll
            for (int tb = 0; tb < 2; ++tb) {
                f32x4 acc = {0.f, 0.f, 0.f, 0.f};
                acc = mfma16(a0, ldfrag(Bs, 72, 16 * tb, 0, lane), acc);
                acc = mfma16(a1, ldfrag(Bs, 72, 16 * tb, 32, lane), acc);
                if (w == 0) {
                    const int s_ = 16 * tb + fr;
#pragma unroll
                    for (int j = 0; j < 4; ++j) { const int t = 16 * ta + 4 * fq + j; M[t * 32 + s_] = (t > s_) ? -acc[j] : 0.f; }
                } else {
                    const int t = 16 * tb + fr;
                    float pv4[4];
#pragma unroll
                    for (int j = 0; j < 4; ++j) { const int s_ = 16 * ta + 4 * fq + j; pv4[j] = ((w == 1) ? (t > s_) : (t >= s_)) ? acc[j] : 0.f; }
                    int offD = w - 1; asm volatile("" : "+v"(offD));
                    *(u32x2*)(Aak + offD * (32 * 40) + t * 40 + 16 * ta + 4 * fq) = (u32x2){pk2(pv4[0], pv4[1]), pk2(pv4[2], pv4[3])};
                }
            }
        }
    }
    __syncthreads();
    {
        const int et = w;
        const bf16x8 vf = ldfrag(VT, 40, 16 * et, 0, lane);
#pragma unroll
        for (int tt = 0; tt < 2; ++tt) {
            f32x4 acc = {0.f, 0.f, 0.f, 0.f};
            acc = mfma16(ldfrag(Aak, 40, 16 * tt, 0, lane), vf, acc);
            *(f32x4*)(ZT + (16 * et + fr) * 36 + 16 * tt + 4 * fq) = acc;
        }
    }
    __syncthreads();
    if (tid < 128) {
        float x[32];
        if (tid < 64) {
#pragma unroll
            for (int t = 0; t < 32; ++t) x[t] = bf2f(At_[t * 72 + tid]);
        } else {
#pragma unroll
            for (int q = 0; q < 8; ++q) { const f32x4 z = *(const f32x4*)(ZT + (tid - 64) * 36 + 4 * q); x[4 * q] = z.x; x[4 * q + 1] = z.y; x[4 * q + 2] = z.z; x[4 * q + 3] = z.w; }
        }
        SolveRow<1, 32>::run(x, M);
        bf16* dst = AhT + tid * 40;
#pragma unroll
        for (int q = 0; q < 4; ++q)
            *(u32x4*)(dst + 8 * q) = (u32x4){pk2(x[8 * q], x[8 * q + 1]), pk2(x[8 * q + 2], x[8 * q + 3]), pk2(x[8 * q + 4], x[8 * q + 5]), pk2(x[8 * q + 6], x[8 * q + 7])};
    }
    __syncthreads();
    {
        const int mt = w;
        const bf16x8 bh = ldfrag(BhT, 40, 16 * mt, 0, lane), kh = ldfrag(KhT, 40, 16 * mt, 0, lane);
#pragma unroll
        for (int sp = 0; sp < 2; ++sp) {
            f32x4 a0 = {0.f, 0.f, 0.f, 0.f}, a1 = {0.f, 0.f, 0.f, 0.f};
            a0 = mfma16(ldfrag(AhT, 40, 32 * sp, 0, lane), bh, a0);
            a1 = mfma16(ldfrag(AhT, 40, 32 * sp + 16, 0, lane), bh, a1);
            *(u32x4*)(WP + ((mt * 2 + sp) * 64 + lane) * 8) = (u32x4){pk2(a0.x, a0.y), pk2(a0.z, a0.w), pk2(a1.x, a1.y), pk2(a1.z, a1.w)};
        }
#pragma unroll
        for (int nt = 0; nt < 4; ++nt) {
            f32x4 a = {0.f, 0.f, 0.f, 0.f};
            a = mfma16(bh, ldfrag(UhT, 40, 16 * nt, 0, lane), a);
            a = mfma16(kh, ldfrag(VT, 40, 16 * nt, 0, lane), a);
            *(f32x4*)(WC + ((nt * 4 + mt) * 64 + lane) * 4) = a;
        }
        {
            const int ct = w & 1, sp = w >> 1, t = 16 * ct + fr;
            const bf16x8 ar = ldfrag(Arb, 40, 16 * ct, 0, lane);
            f32x4 a0 = ld_bf4(Rt + t * 72 + 32 * sp + 4 * fq), a1 = ld_bf4(Rt + t * 72 + 32 * sp + 16 + 4 * fq);
            a0 = mfma16(ldfrag(AhT, 40, 32 * sp, 0, lane), ar, a0);
            a1 = mfma16(ldfrag(AhT, 40, 32 * sp + 16, 0, lane), ar, a1);
            *(u32x4*)(WQ + ((ct * 2 + sp) * 64 + lane) * 8) = (u32x4){pk2(a0.x, a0.y), pk2(a0.z, a0.w), pk2(a1.x, a1.y), pk2(a1.z, a1.w)};
        }
        {
            const int et = w;
            const bf16x8 uf = ldfrag(UhT, 40, 16 * et, 0, lane), vf = ldfrag(VT, 40, 16 * et, 0, lane);
#pragma unroll
            for (int ct = 0; ct < 2; ++ct) {
                f32x4 a = {0.f, 0.f, 0.f, 0.f};
                a = mfma16(uf, ldfrag(Arb, 40, 16 * ct, 0, lane), a);
                a = mfma16(vf, ldfrag(Ark, 40, 16 * ct, 0, lane), a);
                *(f32x4*)(WY + ((ct * 4 + et) * 64 + lane) * 4) = a;
            }
        }
    }
    __syncthreads();
}

struct RwkStep { bf16x8 pf[8]; f32x4 cf[4]; f32x4 dv[4]; };
DEVI void rwk_load(RwkStep& r, const bf16* WP, const float* WC, const float* WD, size_t it, int ew, int lane) {
#pragma unroll
    for (int i = 0; i < 8; ++i) r.pf[i] = *(const bf16x8*)(WP + it * 4096 + (i * 64 + lane) * 8);
#pragma unroll
    for (int m = 0; m < 4; ++m) r.cf[m] = *(const f32x4*)(WC + it * 4096 + ((ew * 4 + m) * 64 + lane) * 4);
#pragma unroll
    for (int m = 0; m < 4; ++m) r.dv[m] = *(const f32x4*)(WD + it * 64 + 16 * m + 4 * (lane >> 4));
}
DEVI void rwk_step(const RwkStep& r, f32x4 (&acc)[4], bf16* WSF, size_t it, int ew, int lane) {
    bf16x8 sf[2];
#pragma unroll
    for (int s = 0; s < 2; ++s) {
        const u32x4 v = {pk2(acc[2 * s].x, acc[2 * s].y), pk2(acc[2 * s].z, acc[2 * s].w), pk2(acc[2 * s + 1].x, acc[2 * s + 1].y), pk2(acc[2 * s + 1].z, acc[2 * s + 1].w)};
        *(u32x4*)(WSF + it * 4096 + ((ew * 2 + s) * 64 + lane) * 8) = v;
        sf[s] = __builtin_bit_cast(bf16x8, v);
    }
#pragma unroll
    for (int m = 0; m < 4; ++m) {
        f32x4 a = acc[m] * r.dv[m] + r.cf[m];
        a = mfma16(r.pf[m * 2], sf[0], a);
        a = mfma16(r.pf[m * 2 + 1], sf[1], a);
        acc[m] = a;
    }
}
DEVI void rwkL1_item(const P& p, int item) {
    const bf16* WP = (const bf16*)(p.ws + WS_WP); const float* WC = (const float*)(p.ws + WS_WC); const float* WD = (const float*)(p.ws + WS_WD);
    const int kind = item & 1, g = (item >> 1) & 15, h = item >> 5;
    const int lane = VTID & 63, ew = VTID >> 6, fr = lane & 15, fq = lane >> 4;
    f32x4 acc[4];
    if (kind == 0) {
        bf16* WSF = (bf16*)(p.ws + WS_WS);
#pragma unroll
        for (int m = 0; m < 4; ++m) acc[m] = (f32x4){0.f, 0.f, 0.f, 0.f};
        RwkStep A, B;
        const int n0 = g * 32;
        rwk_load(A, WP, WC, WD, (size_t)n0 * 4 + h, ew, lane);
#pragma unroll 1
        for (int n = n0; n < n0 + 32; n += 2) {
            rwk_load(B, WP, WC, WD, (size_t)(n + 1) * 4 + h, ew, lane);
            asm volatile("" ::: "memory");
            rwk_step(A, acc, WSF, (size_t)n * 4 + h, ew, lane);
            rwk_load(A, WP, WC, WD, (size_t)((n + 2 < n0 + 32) ? n + 2 : n) * 4 + h, ew, lane);
            asm volatile("" ::: "memory");
            rwk_step(B, acc, WSF, (size_t)(n + 1) * 4 + h, ew, lane);
        }
        float* E0 = (float*)(p.ws + WS_WE0) + (size_t)(h * 16 + g) * 4096 + (ew * 4 * 64 + lane) * 4;
#pragma unroll
        for (int m = 0; m < 4; ++m) *(f32x4*)(E0 + m * 256) = acc[m];
    } else {
        const bf16* WQ = (const bf16*)(p.ws + WS_WQ); bf16* WR = (bf16*)(p.ws + WS_WR);
#pragma unroll
        for (int m = 0; m < 4; ++m)
#pragma unroll
            for (int j = 0; j < 4; ++j) acc[m][j] = (m == ew && 4 * fq + j == fr) ? 1.f : 0.f;
#pragma unroll 1
        for (int n = g * 32; n < g * 32 + 32; ++n) {
            const size_t it = (size_t)n * 4 + h;
            bf16x8 pf[8], qf[4]; f32x4 dv[4];
#pragma unroll
            for (int i = 0; i < 8; ++i) pf[i] = *(const bf16x8*)(WP + it * 4096 + (i * 64 + lane) * 8);
#pragma unroll
            for (int i = 0; i < 4; ++i) qf[i] = *(const bf16x8*)(WQ + it * 2048 + (i * 64 + lane) * 8);
#pragma unroll
            for (int m = 0; m < 4; ++m) dv[m] = *(const f32x4*)(WD + it * 64 + 16 * m + 4 * fq);
            asm volatile("" ::: "memory");
            bf16x8 tf[2];
#pragma unroll
            for (int s = 0; s < 2; ++s) tf[s] = pack_frag(acc[2 * s], acc[2 * s + 1]);
#pragma unroll
            for (int tt = 0; tt < 2; ++tt) {
                f32x4 r = {0.f, 0.f, 0.f, 0.f};
                r = mfma16(tf[0], qf[tt * 2], r); r = mfma16(tf[1], qf[tt * 2 + 1], r);
                *(u32x2*)(WR + it * 2048 + ((tt * 2 + (ew >> 1)) * 64 + lane) * 8 + 4 * (ew & 1)) = (u32x2){pk2(r.x, r.y), pk2(r.z, r.w)};
            }
#pragma unroll
            for (int m = 0; m < 4; ++m) {
                f32x4 a = acc[m] * dv[m];
                a = mfma16(pf[m * 2], tf[0], a); a = mfma16(pf[m * 2 + 1], tf[1], a);
                acc[m] = a;
            }
        }
        bf16* TE = (bf16*)(p.ws + WS_WTE) + (size_t)(h * 16 + g) * 4096;
        const int s_ = ew >> 1, jj = 4 * (ew & 1) + (fr & 3), lg = fr >> 2;
#pragma unroll
        for (int m = 0; m < 4; ++m)
#pragma unroll
            for (int j = 0; j < 4; ++j) TE[((m * 2 + s_) * 64 + (4 * fq + j) + 16 * lg) * 8 + jj] = (bf16)f2bf(acc[m][j]);
    }
}
DEVI void rwkL2_item(const P& p, int h) {
    const bf16* TE = (const bf16*)(p.ws + WS_WTE); const float* E0 = (const float*)(p.ws + WS_WE0); bf16* SG = (bf16*)(p.ws + WS_WSG);
    const int lane = VTID & 63, ew = VTID >> 6;
    f32x4 acc[4];
#pragma unroll
    for (int m = 0; m < 4; ++m) acc[m] = (f32x4){0.f, 0.f, 0.f, 0.f};
#pragma unroll 1
    for (int g = 0; g < 16; ++g) {
        const size_t hg = (size_t)h * 16 + g;
        bf16x8 pf[8]; f32x4 bfr[4];
#pragma unroll
        for (int i = 0; i < 8; ++i) pf[i] = *(const bf16x8*)(TE + hg * 4096 + (i * 64 + lane) * 8);
#pragma unroll
        for (int m = 0; m < 4; ++m) bfr[m] = *(const f32x4*)(E0 + hg * 4096 + ((ew * 4 + m) * 64 + lane) * 4);
        asm volatile("" ::: "memory");
        bf16x8 sf[2];
#pragma unroll
        for (int s = 0; s < 2; ++s) {
            sf[s] = pack_frag(acc[2 * s], acc[2 * s + 1]);
            *(bf16x8*)(SG + hg * 4096 + ((ew * 2 + s) * 64 + lane) * 8) = sf[s];
        }
#pragma unroll
        for (int m = 0; m < 4; ++m) {
            f32x4 a = bfr[m];
            a = mfma16(pf[m * 2], sf[0], a); a = mfma16(pf[m * 2 + 1], sf[1], a);
            acc[m] = a;
        }
    }
}

DEVI void rwkC_item(const P& p, int n, int l) {
    const int lane = VTID & 63, h = VTID >> 6, fr = lane & 15, fq = lane >> 4;
    const size_t it = (size_t)n * 4 + h;
    const bf16* WQ = (const bf16*)(p.ws + WS_WQ) + it * 2048; const float* WY = (const float*)(p.ws + WS_WY) + it * 2048;
    const bf16* WSF = (const bf16*)(p.ws + WS_WS) + it * 4096;
    const bf16* WR = (const bf16*)(p.ws + WS_WR) + it * 2048; const bf16* WSG = (const bf16*)(p.ws + WS_WSG) + (size_t)(h * 16 + (n >> 5)) * 4096;
    const float* RECR = (const float*)(p.ws + WS_RECR); const float* GB = (const float*)(p.ws + WS_G); const float* BON = (const float*)(p.ws + WS_BON);
    bf16* MIX = (bf16*)(p.ws + WS_MIX);
    const float* ln_g = p.in[17] + l * 256 + h * 64; const float* ln_b = p.in[18] + l * 256 + h * 64;
#pragma unroll
    for (int ct = 0; ct < 2; ++ct) {
        const bf16x8 q0 = *(const bf16x8*)(WQ + ((ct * 2 + 0) * 64 + lane) * 8), q1 = *(const bf16x8*)(WQ + ((ct * 2 + 1) * 64 + lane) * 8);
        const bf16x8 r0 = *(const bf16x8*)(WR + ((ct * 2 + 0) * 64 + lane) * 8), r1 = *(const bf16x8*)(WR + ((ct * 2 + 1) * 64 + lane) * 8);
        const int t = n * 32 + 16 * ct + fr;
        f32x4 a[4];
        float sm = 0.f;
#pragma unroll
        for (int et = 0; et < 4; ++et) {
            f32x4 acc = *(const f32x4*)(WY + ((ct * 4 + et) * 64 + lane) * 4);
            acc = mfma16(*(const bf16x8*)(WSF + ((et * 2 + 0) * 64 + lane) * 8), q0, acc);
            acc = mfma16(*(const bf16x8*)(WSF + ((et * 2 + 1) * 64 + lane) * 8), q1, acc);
            acc = mfma16(*(const bf16x8*)(WSG + ((et * 2 + 0) * 64 + lane) * 8), r0, acc);
            acc = mfma16(*(const bf16x8*)(WSG + ((et * 2 + 1) * 64 + lane) * 8), r1, acc);
            a[et] = acc; sm += (acc.x + acc.y) + (acc.z + acc.w);
        }
        const float mean = quad_sum(sm) * (1.f / 64.f);
        float sv = 0.f;
#pragma unroll
        for (int et = 0; et < 4; ++et) { a[et] = a[et] - mean; sv += a[et].x * a[et].x + a[et].y * a[et].y + a[et].z * a[et].z + a[et].w * a[et].w; }
        const float rs = rsqrtf(quad_sum(sv) * (1.f / 64.f) + 64e-5f);
        const float bon = BON[(size_t)t * 4 + h];
#pragma unroll
        for (int et = 0; et < 4; ++et) {
            const int e = 16 * et + 4 * fq;
            const f32x4 g = *(const f32x4*)(ln_g + e), b = *(const f32x4*)(ln_b + e);
            const f32x4 v = *(const f32x4*)(RECR + ((size_t)t * 4 + h) * 384 + 320 + e);
            const f32x4 gate = *(const f32x4*)(GB + (size_t)t * 256 + h * 64 + e);
            const f32x4 o = (a[et] * rs * g + b + v * bon) * gate;
            *(u32x2*)(MIX + (size_t)t * D + h * 64 + e) = (u32x2){pk2(o.x, o.y), pk2(o.z, o.w)};
        }
    }
}

DEVI void phase_scanL1(const P& p) {
    for (int item = VBID; item < 448; item += VNB) {
        if (item < 256) gdnL1_item(p, item);
        else if (item < 384) rwkL1_item(p, item - 256);
        else retS_item(p, item - 384);
    }
}
DEVI void phase_scanL2(const P& p) {
    for (int item = VBID; item < 12; item += VNB) {
        if (item < 8) gdnL2_item(p, item);
        else rwkL2_item(p, item - 8);
    }
}
DEVI void phase_chunkA(const P& p, char* smem) {
    for (int item = VBID; item < 4096; item += VNB) { if (item < 1024) gdnA_item(p, item, smem); else if (item < 3072) rwkA_item(p, item - 1024, smem); else retA_item(p, item - 3072, smem); }
}
DEVI void phase_chunkC(const P& p, int l, char* smem) {
    for (int item = VBID; item < 2560; item += VNB) { if (item < 1024) gdnC_item(p, item, l); else if (item < 2048) retC_item(p, item - 1024, l, smem); else rwkC_item(p, item - 2048, l); }
}

DEVI void phase_post(const P& p, int l) {
    const bf16* PROJ = (const bf16*)(p.ws + WS_PROJ);
    const float* RECR = (const float*)(p.ws + WS_RECR);
    const float* GB = (const float*)(p.ws + WS_G); const float* BON = (const float*)(p.ws + WS_BON);
    const float* YR = (const float*)(p.ws + WS_YR); const float* OG = (const float*)(p.ws + WS_OG); const float* ORT = (const float*)(p.ws + WS_ORT);
    bf16* MIX = (bf16*)(p.ws + WS_MIX);
    const float* ln_g = p.in[17] + l * 256; const float* ln_b = p.in[18] + l * 256;
    const float* gn = p.in[24] + l * 128;
    const float* rg = p.in[25] + l * 256; const float* rb = p.in[26] + l * 256;
    const int tid = VTID, lane = tid & 63, h = tid >> 6;
    for (int t = VBID; t < S; t += VNB) {
        {
            const int c = tid;
            const float y = YR[(size_t)t * 256 + c];
            const float mean = wave_sum(y) * (1.f / 64.f);
            const float d = y - mean;
            const float var = wave_sum(d * d) * (1.f / 64.f);
            const float yn = d * rsqrtf(var + 64e-5f) * ln_g[c] + ln_b[c];
            const float v = RECR[((size_t)t * 4 + h) * 384 + 320 + lane];
            const float o = (yn + BON[(size_t)t * 4 + h] * v) * GB[(size_t)t * 256 + c];
            MIX[(size_t)t * D + c] = (bf16)f2bf(o);
        }
        {
            const int c0 = h * 128 + lane, c1 = c0 + 64;
            const float o0 = OG[(size_t)t * 512 + c0], o1 = OG[(size_t)t * 512 + c1];
            const float ms = wave_sum(o0 * o0 + o1 * o1) * (1.f / 128.f);
            const float rs = rsqrtf(ms + 1e-6f);
            const float z0 = proj_at(PROJ, t, 2560 + c0), z1 = proj_at(PROJ, t, 2560 + c1);
            MIX[(size_t)t * D + 256 + c0] = (bf16)f2bf(o0 * rs * gn[lane] * siluf_(z0));
            MIX[(size_t)t * D + 256 + c1] = (bf16)f2bf(o1 * rs * gn[64 + lane] * siluf_(z1));
        }
        {
            const int c = tid;
            const float y = ORT[(size_t)t * 256 + c];
            const float mean = wave_sum(y) * (1.f / 64.f);
            const float d = y - mean;
            const float var = wave_sum(d * d) * (1.f / 64.f);
            const float yn = d * rsqrtf(var + 1e-5f) * rg[c] + rb[c];
            const float gt = proj_at(PROJ, t, 3840 + c);
            MIX[(size_t)t * D + 768 + c] = (bf16)f2bf(yn * siluf_(gt));
        }
    }
}

DEVI void phase_outproj(const P& p, int l, char* smem) {
    const bf16* MIX = (const bf16*)(p.ws + WS_MIX);
    const bf16* W = (const bf16*)(p.ws + WS_WOUT) + (size_t)l * D * D;
    float* OPRE = (float*)(p.ws + WS_OPRE);
    const int lane = VTID & 63, wid = VTID >> 6, wr = wid >> 1, wc = wid & 1, fr = lane & 15, fq = lane >> 4;
    for (int tile = VBID; tile < (S / 128) * 4; tile += VNB) {
        const int mt = tile >> 2, nt = tile & 3;
        f32x4 acc[4][8];
        gemm_tile(smem, MIX, [&](int r) { return (unsigned)((mt * 128 + r) * D); }, W, [&](int r) { return (unsigned)((nt * 256 + r) * D); }, D, acc);
#pragma unroll
        for (int m = 0; m < 4; ++m) {
            const int tok = mt * 128 + wr * 64 + m * 16 + fr;
#pragma unroll
            for (int n = 0; n < 8; ++n) *(f32x4*)(OPRE + (size_t)tok * D + nt * 256 + wc * 128 + n * 16 + fq * 4) = acc[m][n];
        }
    }
}

DEVI void phase_ln1_route(const P& p, int l, char* smem, bool commit = true) {
    const float* ADA = (const float*)(p.ws + OFF_ADA) + l * 6144;
    const float* xin = (l == 0) ? p.in[0] : (const float*)(p.ws + WS_X);
    const float* OPRE = (const float*)(p.ws + WS_OPRE);
    float* X = (float*)(p.ws + WS_X); bf16* H2 = (bf16*)(p.ws + WS_H2);
    const float* lg = p.in[28] + l * D; const float* lb = p.in[29] + l * D;
    const float* rw = p.in[30] + (size_t)l * D * 32; const float* rbias = p.in[31] + l * 32;
    int* CNT = (int*)(p.ws + OFF_CNT) + l * 32 * 64; int* LIST = (int*)(p.ws + WS_LIST); float* GATE = (float*)(p.ws + WS_GATE);
    float* HS = (float*)smem;
    float* RED = HS + 4 * 1024;
    int* SEL = (int*)(RED + 1024);
    int* RNK = SEL + 256;
    int* BASE = RNK + 256;
    int nasg = 0;
    const int tid = VTID, lane = tid & 63, w = tid >> 6;
    for (int item = VBID; item < S / 4; item += VNB) {
        const int t = item * 4 + w;
        {
            f32x4 v[4]; float s = 0.f;
#pragma unroll
            for (int j = 0; j < 4; ++j) {
                const int c = j * 256 + lane * 4;
                const f32x4 x = *(const f32x4*)(xin + (size_t)t * D + c);
                const f32x4 o = *(const f32x4*)(OPRE + (size_t)t * D + c);
                const f32x4 gt = *(const f32x4*)(ADA + 2048 + c);
                v[j].x = DN_ALPHA * x.x + (1.f + gt.x) * o.x; v[j].y = DN_ALPHA * x.y + (1.f + gt.y) * o.y;
                v[j].z = DN_ALPHA * x.z + (1.f + gt.z) * o.z; v[j].w = DN_ALPHA * x.w + (1.f + gt.w) * o.w;
                s += (v[j].x + v[j].y) + (v[j].z + v[j].w);
            }
            const float mean = wave_sum(s) * (1.f / D);
            float s2 = 0.f;
#pragma unroll
            for (int j = 0; j < 4; ++j) { v[j] = v[j] - mean; s2 += (v[j].x * v[j].x + v[j].y * v[j].y) + (v[j].z * v[j].z + v[j].w * v[j].w); }
            const float rstd = rsqrtf(wave_sum(s2) * (1.f / D) + 1e-5f);
#pragma unroll
            for (int j = 0; j < 4; ++j) {
                const int c = j * 256 + lane * 4;
                const f32x4 g = *(const f32x4*)(lg + c), b = *(const f32x4*)(lb + c);
                f32x4 xo = v[j] * rstd * g + b;
                *(f32x4*)(X + (size_t)t * D + c) = xo;
                const f32x4 sh = *(const f32x4*)(ADA + 3072 + c), sc = *(const f32x4*)(ADA + 4096 + c);
                f32x4 hh = xo * (1.f + sc) + sh;
                *(f32x4*)(HS + w * 1024 + c) = hh;
                u32x2 o; o.x = pk2(hh.x, hh.y); o.y = pk2(hh.z, hh.w);
                *(u32x2*)(H2 + (size_t)t * D + c) = o;
            }
        }
        __syncthreads();
        {
            const int e = tid & 31, ks = tid >> 5;
            float a0 = 0.f, a1 = 0.f, a2 = 0.f, a3 = 0.f;
#pragma unroll 4
            for (int k = ks * 128; k < ks * 128 + 128; k += 4) {
                const float w0 = rw[(k + 0) * 32 + e], w1 = rw[(k + 1) * 32 + e], w2 = rw[(k + 2) * 32 + e], w3 = rw[(k + 3) * 32 + e];
                const f32x4 h0 = *(const f32x4*)(HS + 0 * 1024 + k), h1 = *(const f32x4*)(HS + 1 * 1024 + k);
                const f32x4 h2 = *(const f32x4*)(HS + 2 * 1024 + k), h3 = *(const f32x4*)(HS + 3 * 1024 + k);
                a0 += h0.x * w0 + h0.y * w1 + h0.z * w2 + h0.w * w3;
                a1 += h1.x * w0 + h1.y * w1 + h1.z * w2 + h1.w * w3;
                a2 += h2.x * w0 + h2.y * w1 + h2.z * w2 + h2.w * w3;
                a3 += h3.x * w0 + h3.y * w1 + h3.z * w2 + h3.w * w3;
            }
            RED[(ks * 4 + 0) * 32 + e] = a0; RED[(ks * 4 + 1) * 32 + e] = a1; RED[(ks * 4 + 2) * 32 + e] = a2; RED[(ks * 4 + 3) * 32 + e] = a3;
        }
        __syncthreads();
        if (tid < 128) {
            const int tok = tid >> 5, e = tid & 31, tt = item * 4 + tok;
            float logit = rbias[e];
#pragma unroll
            for (int ks = 0; ks < 8; ++ks) logit += RED[(ks * 4 + tok) * 32 + e];
            bool taken = false;
            float sv[4]; int si[4];
#pragma unroll
            for (int j = 0; j < 4; ++j) {
                float cand = taken ? -3.0e38f : logit; int ci = e;
#pragma unroll
                for (int off = 16; off >= 1; off >>= 1) {
                    const float ov = __shfl_xor(cand, off, 32); const int oi = __shfl_xor(ci, off, 32);
                    if (ov > cand || (ov == cand && oi < ci)) { cand = ov; ci = oi; }
                }
                sv[j] = cand; si[j] = ci; if (ci == e) taken = true;
            }
            const float e0 = 1.f, e1 = __expf(sv[1] - sv[0]), e2 = __expf(sv[2] - sv[0]), e3 = __expf(sv[3] - sv[0]);
            const float inv = 1.f / (e0 + e1 + e2 + e3);
            const float gts[4] = {e0 * inv, e1 * inv, e2 * inv, e3 * inv};
#pragma unroll
            for (int j = 0; j < 4; ++j) {
                if (si[j] == e) {
                    SEL[nasg + tok * 4 + j] = ((tt * 4 + j) << 5) | e;
                    GATE[(size_t)tt * 4 + j] = gts[j];
                }
            }
        }
        nasg += 16;
        __syncthreads();
    }
    if (!commit) return;
    if (tid < 32) {
        int c = 0;
        for (int a = 0; a < nasg; ++a) { if ((SEL[a] & 31) == tid) { RNK[a] = c; ++c; } }
        BASE[tid] = c ? atomicAdd(&CNT[tid * 64], c) : 0;
    }
    __syncthreads();
    for (int a = tid; a < nasg; a += NT) { const int v = SEL[a], e = v & 31; LIST[(size_t)e * S + BASE[e] + RNK[a]] = v >> 5; }
    __syncthreads();
}

struct MoeMap { int cnt[32]; int off[32]; int tstart[33]; };
DEVI void moe_map(const P& p, int l, MoeMap* mm) {
    const int* CNT = (const int*)(p.ws + OFF_CNT) + l * 32 * 64;
    if (VTID < 32) mm->cnt[VTID] = __hip_atomic_load(&CNT[VTID * 64], __ATOMIC_RELAXED, __HIP_MEMORY_SCOPE_AGENT);
    __syncthreads();
    if (VTID == 0) {
        int o = 0, ts = 0;
        for (int e = 0; e < 32; ++e) { mm->off[e] = o; mm->tstart[e] = ts; o += mm->cnt[e]; ts += (mm->cnt[e] + 127) / 128; }
        mm->tstart[32] = ts;
    }
    __syncthreads();
}

DEVI void phase_moe_up(const P& p, int l, char* smem) {
    MoeMap* mm = (MoeMap*)(smem + 73728);
    int* rows = (int*)(smem + 73728 + 1024);
    moe_map(p, l, mm);
    const bf16* H2 = (const bf16*)(p.ws + WS_H2);
    const bf16* WUP = (const bf16*)(p.ws + WS_WUP) + (size_t)l * NEXP * 2048 * D;
    const float* bup = p.in[33] + (size_t)l * NEXP * 2048;
    const int* LIST = (const int*)(p.ws + WS_LIST);
    bf16* ACT = (bf16*)(p.ws + WS_ACT);
    const int lane = VTID & 63, wid = VTID >> 6, wr = wid >> 1, wc = wid & 1, fr = lane & 15, fq = lane >> 4;
    const int ntiles = mm->tstart[32] * 8;
    const int ntrips = (ntiles - (VBID & ~1) + VNB - 1) / VNB;
    for (int trip = 0; trip < ntrips; ++trip) {
        const int tile = min(VBID + trip * VNB, ntiles - 1);
        const int mtg = tile >> 3, nt = tile & 7;
        int e = 0;
        while (mm->tstart[e + 1] <= mtg) ++e;
        const int m0 = (mtg - mm->tstart[e]) * 128, cnt = mm->cnt[e];
        __syncthreads();
        if (VTID < 128) { const int r = m0 + VTID; rows[VTID] = LIST[(size_t)e * S + (r < cnt ? r : m0)]; }
        __syncthreads();
        const bf16* We = WUP + (size_t)e * 2048 * D;
        f32x4 acc[4][8];
        gemm_tile(smem, H2, [&](int r) { return (unsigned)((rows[r] >> 2) * D); },
                  We, [&](int r) { const int t16 = r >> 4; return (unsigned)((nt * 128 + (t16 >> 1) * 16 + (r & 15) + ((t16 & 1) ? 1024 : 0)) * D); }, D, acc);
        const float* be = bup + (size_t)e * 2048;
#pragma unroll
        for (int m = 0; m < 4; ++m) {
            const int rl = m0 + wr * 64 + m * 16 + fr;
            if (rl < cnt) {
#pragma unroll
                for (int n2 = 0; n2 < 4; ++n2) {
                    const int col = nt * 128 + (wc * 4 + n2) * 16 + fq * 4;
                    const f32x4 bg = *(const f32x4*)(be + col), bl = *(const f32x4*)(be + 1024 + col);
                    float o[4];
#pragma unroll
                    for (int j = 0; j < 4; ++j) {
                        const float glu = fminf(acc[m][2 * n2][j] + bg[j], 7.f);
                        const float lin = fminf(fmaxf(acc[m][2 * n2 + 1][j] + bl[j], -7.f), 7.f);
                        o[j] = glu * sigmoidf_(1.702f * glu) * (lin + 1.f);
                    }
                    u32x2 ov; ov.x = pk2(o[0], o[1]); ov.y = pk2(o[2], o[3]);
                    *(u32x2*)(ACT + (size_t)(mm->off[e] + rl) * DFF + col) = ov;
                }
            }
        }
    }
}

DEVI void phase_moe_down(const P& p, int l, char* smem) {
    MoeMap* mm = (MoeMap*)(smem + 73728);
    int* rows = (int*)(smem + 73728 + 1024);
    moe_map(p, l, mm);
    const bf16* ACT = (const bf16*)(p.ws + WS_ACT);
    const bf16* WDN = (const bf16*)(p.ws + WS_WDN) + (size_t)l * NEXP * D * DFF;
    const float* bdn = p.in[35] + (size_t)l * NEXP * D;
    const int* LIST = (const int*)(p.ws + WS_LIST); const float* GATE = (const float*)(p.ws + WS_GATE);
    bf16* YB = (bf16*)(p.ws + WS_YB);
    const int lane = VTID & 63, wid = VTID >> 6, wr = wid >> 1, wc = wid & 1, fr = lane & 15, fq = lane >> 4;
    const int ntiles = mm->tstart[32] * 4;
    const int ntrips = (ntiles - (VBID & ~1) + VNB - 1) / VNB;
    for (int trip = 0; trip < ntrips; ++trip) {
        const int tile = min(VBID + trip * VNB, ntiles - 1);
        const int mtg = tile >> 2, nt = tile & 3;
        int e = 0;
        while (mm->tstart[e + 1] <= mtg) ++e;
        const int m0 = (mtg - mm->tstart[e]) * 128, cnt = mm->cnt[e];
        __syncthreads();
        if (VTID < 128) { const int r = m0 + VTID; rows[VTID] = LIST[(size_t)e * S + (r < cnt ? r : m0)]; }
        __syncthreads();
        const bf16* We = WDN + (size_t)e * D * DFF;
        const unsigned abase = (unsigned)(mm->off[e] + m0);
        f32x4 acc[4][8];
        gemm_tile(smem, ACT, [&](int r) { return (abase + ((m0 + r) < cnt ? r : 0)) * (unsigned)DFF; },
                  We, [&](int r) { return (unsigned)((nt * 256 + r) * DFF); }, DFF, acc);
        const float* be = bdn + (size_t)e * D;
#pragma unroll
        for (int m = 0; m < 4; ++m) {
            const int rt = wr * 64 + m * 16 + fr;
            if (m0 + rt < cnt) {
                const int ent = rows[rt];
                const float gt = GATE[ent];
#pragma unroll
                for (int n = 0; n < 8; ++n) {
                    const int col = nt * 256 + wc * 128 + n * 16 + fq * 4;
                    const f32x4 b = *(const f32x4*)(be + col);
                    u32x2 ov; ov.x = pk2((acc[m][n].x + b.x) * gt, (acc[m][n].y + b.y) * gt); ov.y = pk2((acc[m][n].z + b.z) * gt, (acc[m][n].w + b.w) * gt);
                    *(u32x2*)(YB + (size_t)ent * D + col) = ov;
                }
            }
        }
    }
}

DEVI void phase_ln2(const P& p, int l) {
    const float* ADA = (const float*)(p.ws + OFF_ADA) + l * 6144;
    const float* ADAn = (const float*)(p.ws + OFF_ADA) + 6144;
    float* X = (float*)(p.ws + WS_X); const bf16* YB = (const bf16*)(p.ws + WS_YB);
    bf16* HB = (bf16*)(p.ws + WS_HB);
    const float* lg = p.in[36] + l * D; const float* lb = p.in[37] + l * D;
    const int tid = VTID, lane = tid & 63, w = tid >> 6;
    for (int item = VBID; item < S / 4; item += VNB) {
        const int t = item * 4 + w;
        f32x4 v[4]; float s = 0.f;
#pragma unroll
        for (int j = 0; j < 4; ++j) {
            const int c = j * 256 + lane * 4;
            const f32x4 x = *(const f32x4*)(X + (size_t)t * D + c);
            f32x4 f = {0.f, 0.f, 0.f, 0.f};
#pragma unroll
            for (int q = 0; q < 4; ++q) {
                const u32x2 y = *(const u32x2*)(YB + ((size_t)t * 4 + q) * D + c);
                f.x += __uint_as_float(y.x << 16); f.y += __uint_as_float(y.x & 0xffff0000u);
                f.z += __uint_as_float(y.y << 16); f.w += __uint_as_float(y.y & 0xffff0000u);
            }
            const f32x4 gt = *(const f32x4*)(ADA + 5120 + c);
            v[j] = x * DN_ALPHA + (gt + 1.f) * f;
            s += (v[j].x + v[j].y) + (v[j].z + v[j].w);
        }
        const float mean = wave_sum(s) * (1.f / D);
        float s2 = 0.f;
#pragma unroll
        for (int j = 0; j < 4; ++j) { v[j] = v[j] - mean; s2 += (v[j].x * v[j].x + v[j].y * v[j].y) + (v[j].z * v[j].z + v[j].w * v[j].w); }
        const float rstd = rsqrtf(wave_sum(s2) * (1.f / D) + 1e-5f);
#pragma unroll
        for (int j = 0; j < 4; ++j) {
            const int c = j * 256 + lane * 4;
            const f32x4 g = *(const f32x4*)(lg + c), b = *(const f32x4*)(lb + c);
            const f32x4 xo = v[j] * rstd * g + b;
            if (l == 0) {
                *(f32x4*)(X + (size_t)t * D + c) = xo;
                const f32x4 sh = *(const f32x4*)(ADAn + c), sc = *(const f32x4*)(ADAn + 1024 + c);
                const f32x4 hh = xo * (sc + 1.f) + sh;
                u32x2 o; o.x = pk2(hh.x, hh.y); o.y = pk2(hh.z, hh.w);
                *(u32x2*)(HB + (size_t)t * D + c) = o;
            } else {
                *(f32x4*)(p.out + (size_t)t * D + c) = xo;
            }
        }
    }
}

namespace pg8 {
constexpr int BK = 64, HALF = 128, HTB = HALF * BK * 2, STAGE_BYTES = 8 * HTB;
DEVI int lds_byte(int r, int c) { const int st = (r >> 4) * 2 + (c >> 5), rr = r & 15, cc = c & 31, ob = rr * 64 + cc * 2; return st * 1024 + (ob ^ (((ob >> 9) & 1) << 5)); }
DEVI void stage_rc(int b, int& R, int& C) { const int st = b / 1024, sb = b % 1024, swz = sb ^ (((sb >> 9) & 1) << 5); R = (st >> 1) * 16 + swz / 64; C = (st & 1) * 32 + (swz % 64) / 2; }
struct Unit { const char* a; const char* b; int x0, x1, x2, x3; };

template <class Epi, class Sched>
DEVI void gemm_phase(LAS unsigned char* lds, const int K, const Sched& S, const Epi& E) {
    const int tid = threadIdx.x, wid = __builtin_amdgcn_readfirstlane(tid >> 6), lane = tid & 63, wr = wid >> 2, wc = wid & 3, fr = lane & 15, fq = lane >> 4;
    const int nt = K / BK;
    unsigned voffA[2], voffB[2];
#pragma unroll
    for (int i = 0; i < 2; ++i) { int R, C; stage_rc(tid * 16 + i * 8192, R, C); voffA[i] = (unsigned)(R * K + C) * 2u; voffB[i] = (unsigned)(Epi::brow(R) * K + C) * 2u; }
    const size_t kstep = (size_t)(BK * 2);
    const size_t hstepA = (size_t)HALF * K * 2, hstepB = (size_t)Epi::BHALF * K * 2;
    const unsigned ldsw = (unsigned)wid * 1024u;
    const int aoff = lds_byte(wr * 64 + fr, fq * 8), boff = lds_byte(wc * 32 + fr, fq * 8);
#define PG8_SA(b, h) (((b) * 2 + (h)) * HTB)
#define PG8_SB(b, h) ((4 + (b) * 2 + (h)) * HTB)
#define PG8_STAGE(bufoff, gbase, voff) do { _Pragma("unroll") for (int _i = 0; _i < 2; ++_i) \
        __builtin_amdgcn_global_load_lds((const unsigned*)((const char*)(gbase) + (voff)[_i]), (LAS unsigned*)(lds + (bufoff) + ldsw + _i * 8192), 16, 0, 0); } while (0)
#define PG8_LDA(dst, b, h) do { _Pragma("unroll") for (int m = 0; m < 4; ++m) _Pragma("unroll") for (int k = 0; k < 2; ++k) dst[m][k] = *(const LAS bf16x8*)(lds + PG8_SA(b, h) + aoff + m * 2048 + k * 1024); } while (0)
#define PG8_LDB(dst, b, h) do { _Pragma("unroll") for (int n = 0; n < 2; ++n) _Pragma("unroll") for (int k = 0; k < 2; ++k) dst[n][k] = *(const LAS bf16x8*)(lds + PG8_SB(b, h) + boff + n * 2048 + k * 1024); } while (0)
#define PG8_MMA(ai, bj, At, Bt) do { __builtin_amdgcn_s_setprio(1); _Pragma("unroll") for (int m = 0; m < 4; ++m) _Pragma("unroll") for (int n = 0; n < 2; ++n) _Pragma("unroll") for (int k = 0; k < 2; ++k) \
        acc[ai][bj][m][n] = __builtin_amdgcn_mfma_f32_16x16x32_bf16(Bt[n][k], At[m][k], acc[ai][bj][m][n], 0, 0, 0); __builtin_amdgcn_s_setprio(0); } while (0)
#define PG8_WAIT_V(n) asm volatile("s_waitcnt vmcnt(" #n ")" ::: "memory")
#define PG8_WAIT_L(n) asm volatile("s_waitcnt lgkmcnt(" #n ")" ::: "memory")
#define PG8_BAR __builtin_amdgcn_s_barrier()
#define PG8_SCHED __builtin_amdgcn_sched_barrier(0)
    Unit cur, nxt; int ui = 0;
    if (!S.next(0, cur)) return;
    f32x4 acc[2][2][4][2];
#pragma unroll
    for (int a = 0; a < 2; ++a)
#pragma unroll
        for (int b = 0; b < 2; ++b)
#pragma unroll
            for (int m = 0; m < 4; ++m)
#pragma unroll
                for (int n = 0; n < 2; ++n) acc[a][b][m][n] = (f32x4){0.f, 0.f, 0.f, 0.f};
    bf16x8 At[4][2], B0[2][2], B1[2][2];
    const char* cA = cur.a; const char* cB = cur.b;
    PG8_WAIT_V(0);
    PG8_STAGE(PG8_SB(0, 0), cB, voffB); PG8_STAGE(PG8_SA(0, 0), cA, voffA); PG8_STAGE(PG8_SB(0, 1), cB + hstepB, voffB); PG8_STAGE(PG8_SA(0, 1), cA + hstepA, voffA);
    if (wr == 1) PG8_BAR;
    PG8_WAIT_V(4); PG8_BAR;
    PG8_STAGE(PG8_SB(1, 0), cB + kstep, voffB); PG8_STAGE(PG8_SA(1, 0), cA + kstep, voffA); PG8_STAGE(PG8_SB(1, 1), cB + hstepB + kstep, voffB);
    PG8_WAIT_V(6); PG8_BAR;
    for (;;) {
        const bool has_next = S.next(ui + 1, nxt);
        const char* nA = has_next ? nxt.a : cA; const char* nB = has_next ? nxt.b : cB;
        for (int t = 0; t < nt; t += 2) {
            const bool last = (t == nt - 2);
            const char* a1 = cA + (size_t)(t + 1) * kstep;
            const char* a2 = last ? nA : cA + (size_t)(t + 2) * kstep; const char* b2 = last ? nB : cB + (size_t)(t + 2) * kstep;
            const char* a3 = a2 + kstep; const char* b3 = b2 + kstep;
            PG8_LDB(B0, 0, 0); PG8_SCHED; PG8_LDA(At, 0, 0); PG8_STAGE(PG8_SA(1, 1), a1 + hstepA, voffA);
            PG8_WAIT_L(8); PG8_BAR; PG8_WAIT_L(0); PG8_MMA(0, 0, At, B0); PG8_BAR; PG8_SCHED;
            PG8_LDB(B1, 0, 1); PG8_STAGE(PG8_SB(0, 0), b2, voffB);
            PG8_BAR; PG8_WAIT_L(0); PG8_MMA(0, 1, At, B1); PG8_BAR;
            PG8_LDA(At, 0, 1); PG8_STAGE(PG8_SA(0, 0), a2, voffA);
            PG8_BAR; PG8_WAIT_L(0); PG8_MMA(1, 0, At, B0); PG8_BAR; PG8_SCHED;
            PG8_STAGE(PG8_SB(0, 1), b2 + hstepB, voffB);
            PG8_WAIT_V(6); PG8_BAR; PG8_MMA(1, 1, At, B1); PG8_BAR;
            PG8_LDB(B0, 1, 0); PG8_SCHED; PG8_LDA(At, 1, 0); PG8_STAGE(PG8_SA(0, 1), a2 + hstepA, voffA);
            PG8_WAIT_L(8); PG8_BAR; PG8_WAIT_L(0); PG8_MMA(0, 0, At, B0); PG8_BAR; PG8_SCHED;
            PG8_LDB(B1, 1, 1); PG8_STAGE(PG8_SB(1, 0), b3, voffB);
            PG8_BAR; PG8_WAIT_L(0); PG8_MMA(0, 1, At, B1); PG8_BAR;
            PG8_LDA(At, 1, 1); PG8_STAGE(PG8_SA(1, 0), a3, voffA);
            PG8_BAR; PG8_WAIT_L(0); PG8_MMA(1, 0, At, B0); PG8_BAR; PG8_SCHED;
            PG8_STAGE(PG8_SB(1, 1), b3 + hstepB, voffB);
            PG8_WAIT_V(6); PG8_BAR; PG8_MMA(1, 1, At, B1); PG8_BAR;
        }
        E(acc, cur, wr, wc, fr, fq);
        if (!has_next) break;
#pragma unroll
        for (int a = 0; a < 2; ++a)
#pragma unroll
            for (int b = 0; b < 2; ++b)
#pragma unroll
                for (int m = 0; m < 4; ++m)
#pragma unroll
                    for (int n = 0; n < 2; ++n) acc[a][b][m][n] = (f32x4){0.f, 0.f, 0.f, 0.f};
        cur = nxt; cA = nA; cB = nB; ++ui;
    }
    PG8_WAIT_V(0);
    if (wr == 0) PG8_BAR;
    PG8_BAR;
#undef PG8_SA
#undef PG8_SB
#undef PG8_STAGE
#undef PG8_LDA
#undef PG8_LDB
#undef PG8_MMA
#undef PG8_WAIT_V
#undef PG8_WAIT_L
#undef PG8_BAR
#undef PG8_SCHED
}
}

struct SchedDense {
    const char* A; const char* B; int K; int mode;
    DEVI bool next(int i, pg8::Unit& u) const {
        const int c = blockIdx.x, x = c & 7; int pm, pn;
        if (mode == 0) { if (i > 0) return false; pn = x & 3; pm = (c >> 3) * 2 + (x >> 2); }
        else { if (i > 3) return false; pn = x + 8 * (i & 1); pm = (c >> 3) + 32 * (i >> 1); }
        u.a = A + (size_t)pm * 256 * K * 2; u.b = B + (size_t)pn * 256 * K * 2; u.x0 = pm; u.x1 = pn; u.x2 = 0; u.x3 = 0;
        return true;
    }
};
struct EpiOutF32 {
    static constexpr int BHALF = 128; static DEVI int brow(int R) { return R; }
    float* C;
    DEVI void operator()(const f32x4 (&acc)[2][2][4][2], const pg8::Unit& u, int wr, int wc, int fr, int fq) const {
#pragma unroll
        for (int ai = 0; ai < 2; ++ai)
#pragma unroll
            for (int m = 0; m < 4; ++m) {
                float* rowp = C + (size_t)(u.x0 * 256 + ai * 128 + wr * 64 + m * 16 + fr) * D + u.x1 * 256 + wc * 32 + 4 * fq;
#pragma unroll
                for (int bj = 0; bj < 2; ++bj)
#pragma unroll
                    for (int n = 0; n < 2; ++n) *(f32x4*)(rowp + bj * 128 + n * 16) = acc[ai][bj][m][n];
            }
    }
};
struct EpiProjBf16 {
    static constexpr int BHALF = 128; static DEVI int brow(int R) { return R; }
    bf16* C;
    DEVI void operator()(const f32x4 (&acc)[2][2][4][2], const pg8::Unit& u, int wr, int wc, int fr, int fq) const {
#pragma unroll
        for (int ai = 0; ai < 2; ++ai)
#pragma unroll
            for (int m = 0; m < 4; ++m) {
                bf16* rowp = C + (size_t)(u.x0 * 256 + ai * 128 + wr * 64 + m * 16 + fr) * NPROJ + u.x1 * 256 + wc * 32 + 4 * fq;
#pragma unroll
                for (int bj = 0; bj < 2; ++bj)
#pragma unroll
                    for (int n = 0; n < 2; ++n) { const f32x4 v = acc[ai][bj][m][n]; *(u32x2*)(rowp + bj * 128 + n * 16) = (u32x2){pk2(v.x, v.y), pk2(v.z, v.w)}; }
            }
    }
};
DEVI void phase_outproj8(const P& p, int l, char* smem_all) {
    SchedDense Sd{(const char*)(p.ws + WS_MIX), (const char*)(p.ws + WS_WOUT) + (size_t)l * D * D * 2, D, 0};
    EpiOutF32 E{(float*)(p.ws + WS_OPRE)};
    pg8::gemm_phase(( LAS unsigned char*)smem_all, D, Sd, E);
}
DEVI void phase_inproj8(const P& p, int l, char* smem_all) {
    SchedDense Sd{(const char*)(p.ws + WS_HB), (const char*)(p.ws + WS_WIN) + (size_t)l * NPAD * D * 2, D, 1};
    EpiProjBf16 E{(bf16*)(p.ws + WS_PROJ)};
    pg8::gemm_phase((LAS unsigned char*)smem_all, D, Sd, E);
}
DEVI void phase_inproj_extras(const P& p, int l, char* smem) {
    const bf16* HB = (const bf16*)(p.ws + WS_HB);
    const bf16* W = (const bf16*)(p.ws + WS_WIN) + (size_t)l * NPAD * D;
    float* PEX = (float*)(p.ws + WS_PEX);
    const int lane = VTID & 63, wid = VTID >> 6, wr = wid >> 1, wc = wid & 1, fr = lane & 15, fq = lane >> 4;
    for (int mt = VBID; mt < S / 128; mt += VNB) {
        f32x4 acc[4][8];
        gemm_tile(smem, HB, [&](int r) { return (unsigned)((mt * 128 + r) * D); }, W, [&](int r) { return (unsigned)((16 * 256 + r) * D); }, D, acc);
        if (wc == 0) {
#pragma unroll
            for (int m = 0; m < 4; ++m) {
                const int tok = mt * 128 + wr * 64 + m * 16 + fr;
#pragma unroll
                for (int n = 0; n < 4; ++n) *(f32x4*)(PEX + (size_t)tok * 64 + n * 16 + fq * 4) = acc[m][n];
            }
        }
    }
}

struct MoeMap8 { int cnt[32]; int off[32]; int tstart[33]; };
DEVI void moe_map8(const P& p, int l, MoeMap8* mm) {
    const int* CNT = (const int*)(p.ws + OFF_CNT) + l * 32 * 64;
    if (threadIdx.x < 32) mm->cnt[threadIdx.x] = __hip_atomic_load(&CNT[threadIdx.x * 64], __ATOMIC_RELAXED, __HIP_MEMORY_SCOPE_AGENT);
    __syncthreads();
    if (threadIdx.x == 0) {
        int o = 0, ts = 0;
        for (int e = 0; e < 32; ++e) { mm->off[e] = o; mm->tstart[e] = ts; o += mm->cnt[e]; ts += (mm->cnt[e] + 255) / 256; }
        mm->tstart[32] = ts;
    }
    __syncthreads();
}
DEVI void phase_moe_gather(const P& p, int l, char* smem_all) {
    MoeMap8* mm = (MoeMap8*)(smem_all + 131072);
    moe_map8(p, l, mm);
    const bf16* H2 = (const bf16*)(p.ws + WS_H2); bf16* HG = (bf16*)(p.ws + WS_HG);
    const int* LIST = (const int*)(p.ws + WS_LIST);
    const int wave = (int)(blockIdx.x * 8 + (threadIdx.x >> 6)), lane = threadIdx.x & 63;
    int mytok = 0;
    {
        const int pr = wave * 32 + (lane & 31);
        int e = 0;
        while (e < 31 && mm->off[e + 1] <= pr) ++e;
        mytok = LIST[(size_t)e * S + (pr - mm->off[e])] >> 2;
    }
#pragma unroll 1
    for (int r0 = 0; r0 < 32; r0 += 8) {
        u32x4 v[8][2];
#pragma unroll
        for (int i = 0; i < 8; ++i) {
            const int tok = __shfl(mytok, r0 + i);
            const u32x4* s = (const u32x4*)(H2 + (size_t)tok * D);
            v[i][0] = s[lane]; v[i][1] = s[lane + 64];
        }
#pragma unroll
        for (int i = 0; i < 8; ++i) { u32x4* d = (u32x4*)(HG + (size_t)(wave * 32 + r0 + i) * D); d[lane] = v[i][0]; d[lane + 64] = v[i][1]; }
    }
}
struct MoeUnits { int n; int pad[3]; int e[32]; int m0[32]; int pn[32]; };
struct SchedMoe {
    const MoeMap8* mm; const MoeUnits* mu; const char* A; const char* Bw; int K;
    size_t bexp, bpn;
    DEVI bool next(int i, pg8::Unit& u) const {
        if (i >= mu->n) return false;
        const int e = mu->e[i], m0 = mu->m0[i], pn = mu->pn[i], off = mm->off[e];
        u.a = A + (size_t)(off + m0) * K * 2; u.b = Bw + (size_t)e * bexp + (size_t)pn * bpn;
        u.x0 = e; u.x1 = m0; u.x2 = pn; u.x3 = off;
        return true;
    }
};
DEVI void moe_units(const MoeMap8* mm, MoeUnits* mu, int npn_log) {
    if (threadIdx.x < 32) {
        const int L = (int)threadIdx.x * 256 + (int)blockIdx.x, total = mm->tstart[32] << npn_log;
        if (L < total) {
            const int pn = L & ((1 << npn_log) - 1), rt = L >> npn_log;
            int e = 0;
            while (mm->tstart[e + 1] <= rt) ++e;
            mu->e[threadIdx.x] = e; mu->m0[threadIdx.x] = (rt - mm->tstart[e]) * 256; mu->pn[threadIdx.x] = pn;
        }
        if (threadIdx.x == 0) { const int mine = total > (int)blockIdx.x ? (total - (int)blockIdx.x + 255) >> 8 : 0; mu->n = mine < 32 ? mine : 32; }
    }
    __syncthreads();
}
struct EpiMoeUp {
    static constexpr int BHALF = 64;
    static DEVI int brow(int R) { return ((R >> 5) & 3) * 16 + (R & 15) + (((R >> 4) & 1) ? 1024 : 0); }
    const MoeMap8* mm; bf16* ACT; const float* bup; bf16* dump;
    DEVI void operator()(const f32x4 (&acc)[2][2][4][2], const pg8::Unit& u, int wr, int wc, int fr, int fq) const {
        const int e = u.x0, cnt = mm->cnt[e];
        const float* be = bup + (size_t)e * 2048;
        f32x4 bg[2], bl[2];
#pragma unroll
        for (int bj = 0; bj < 2; ++bj) { const int col = u.x2 * 128 + (bj * 4 + wc) * 16 + 4 * fq; bg[bj] = *(const f32x4*)(be + col); bl[bj] = *(const f32x4*)(be + 1024 + col); }
#pragma unroll
        for (int ai = 0; ai < 2; ++ai)
#pragma unroll
            for (int m = 0; m < 4; ++m) {
                const int r = u.x1 + ai * 128 + wr * 64 + m * 16 + fr;
                bf16* rowp = (r < cnt) ? ACT + (size_t)(u.x3 + r) * DFF + u.x2 * 128 + wc * 16 + 4 * fq : dump + 4 * fq;
#pragma unroll
                for (int bj = 0; bj < 2; ++bj) {
                    float o[4];
#pragma unroll
                    for (int j = 0; j < 4; ++j) {
                        const float glu = fminf(acc[ai][bj][m][0][j] + bg[bj][j], 7.f);
                        const float lin = fminf(fmaxf(acc[ai][bj][m][1][j] + bl[bj][j], -7.f), 7.f);
                        o[j] = glu * sigmoidf_(1.702f * glu) * (lin + 1.f);
                    }
                    *(u32x2*)(rowp + bj * 64) = (u32x2){pk2(o[0], o[1]), pk2(o[2], o[3])};
                }
            }
    }
};
struct EpiMoeDown {
    static constexpr int BHALF = 128; static DEVI int brow(int R) { return R; }
    const MoeMap8* mm; bf16* YB; const float* bdn; const int* LIST; const float* GATE; bf16* dump;
    DEVI void operator()(const f32x4 (&acc)[2][2][4][2], const pg8::Unit& u, int wr, int wc, int fr, int fq) const {
        const int e = u.x0, cnt = mm->cnt[e];
        const float* be = bdn + (size_t)e * D + u.x2 * 256 + wc * 32 + 4 * fq;
        f32x4 bv[2][2];
#pragma unroll
        for (int bj = 0; bj < 2; ++bj)
#pragma unroll
            for (int n = 0; n < 2; ++n) bv[bj][n] = *(const f32x4*)(be + bj * 128 + n * 16);
        int ent[8]; float gt[8];
#pragma unroll
        for (int q = 0; q < 8; ++q) { const int r = u.x1 + (q >> 2) * 128 + wr * 64 + (q & 3) * 16 + fr; ent[q] = LIST[(size_t)e * S + (r < cnt ? r : cnt - 1)]; }
#pragma unroll
        for (int q = 0; q < 8; ++q) gt[q] = GATE[ent[q]];
#pragma unroll
        for (int ai = 0; ai < 2; ++ai)
#pragma unroll
            for (int m = 0; m < 4; ++m) {
                const int q = ai * 4 + m, r = u.x1 + ai * 128 + wr * 64 + m * 16 + fr;
                bf16* rowp = (r < cnt) ? YB + (size_t)ent[q] * D + u.x2 * 256 + wc * 32 + 4 * fq : dump + 4 * fq;
#pragma unroll
                for (int bj = 0; bj < 2; ++bj)
#pragma unroll
                    for (int n = 0; n < 2; ++n) {
                        const f32x4 v = (acc[ai][bj][m][n] + bv[bj][n]) * gt[q];
                        *(u32x2*)(rowp + bj * 128 + n * 16) = (u32x2){pk2(v.x, v.y), pk2(v.z, v.w)};
                    }
            }
    }
};
DEVI void phase_moe_up8(const P& p, int l, char* smem_all) {
    MoeMap8* mm = (MoeMap8*)(smem_all + 131072);
    moe_map8(p, l, mm);
    MoeUnits* mu = (MoeUnits*)(smem_all + 131072 + 512);
    moe_units(mm, mu, 3);
    SchedMoe Sm{mm, mu, (const char*)(p.ws + WS_HG), (const char*)(p.ws + WS_WUP) + (size_t)l * NEXP * 2048 * D * 2, D, (size_t)2048 * D * 2, (size_t)128 * D * 2};
    EpiMoeUp E{mm, (bf16*)(p.ws + WS_ACT), p.in[33] + (size_t)l * NEXP * 2048, (bf16*)(p.ws + WS_DUMP)};
    pg8::gemm_phase((LAS unsigned char*)smem_all, D, Sm, E);
}
DEVI void phase_moe_down8(const P& p, int l, char* smem_all) {
    MoeMap8* mm = (MoeMap8*)(smem_all + 131072);
    moe_map8(p, l, mm);
    MoeUnits* mu = (MoeUnits*)(smem_all + 131072 + 512);
    moe_units(mm, mu, 2);
    SchedMoe Sm{mm, mu, (const char*)(p.ws + WS_ACT), (const char*)(p.ws + WS_WDN) + (size_t)l * NEXP * D * DFF * 2, DFF, (size_t)D * DFF * 2, (size_t)256 * DFF * 2};
    EpiMoeDown E{mm, (bf16*)(p.ws + WS_YB), p.in[35] + (size_t)l * NEXP * D, (const int*)(p.ws + WS_LIST), (const float*)(p.ws + WS_GATE), (bf16*)(p.ws + WS_DUMP)};
    pg8::gemm_phase((LAS unsigned char*)smem_all, DFF, Sm, E);
}

constexpr int NPHASE = 26;
constexpr int KT = 512;
constexpr int LDS_TOTAL = 2 * VB_LDS + 64;
__global__ void __launch_bounds__(KT, 2) k_run(P p) {
    extern __shared__ __attribute__((aligned(16))) char smem_all[];
    char* smem = smem_all + __builtin_amdgcn_readfirstlane((int)(threadIdx.x >> 8)) * VB_LDS;
    XcdBarrier bar; bar.bar = nullptr; bar.x = 0; bar.st = nullptr;
    const bool multi = (p.ph_hi - p.ph_lo) > 1;
    if (multi) {
        volatile LAS unsigned* st = (volatile LAS unsigned*)(smem_all + 2 * VB_LDS);
        if (threadIdx.x == 0) { st[0] = 0u; st[1] = 0u; }
        __syncthreads();
        bar = xcd_barrier_post((unsigned*)(p.ws + OFF_BAR), st);
    }
#ifndef DUP
#define DUP -1
#endif
#ifndef DUP2
#define DUP2 -1
#endif
#define RUN(k, call) if (p.ph_lo <= (k) && (k) < p.ph_hi) { for (int _rep = ((k) == DUP || (k) == DUP2) ? 2 : 1; _rep > 0; --_rep) { call; if (multi && ((k) + 1 < p.ph_hi || _rep > 1)) xcd_barrier(bar); } }
    RUN(0, phase_prep(p, smem))
    RUN(1, phase_h0(p))
    RUN(2, { phase_inproj8(p, 0, smem_all); phase_inproj_extras(p, 0, smem); })
    RUN(3, phase_mixprep(p, 0, smem))
    RUN(4, phase_chunkA(p, smem))
    RUN(5, phase_scanL1(p))
    RUN(6, phase_scanL2(p))
    RUN(7, phase_chunkC(p, 0, smem))
    RUN(8, phase_outproj8(p, 0, smem_all))
    RUN(9, phase_ln1_route(p, 0, smem, _rep == 1))
    RUN(10, phase_moe_gather(p, 0, smem_all))
    RUN(11, phase_moe_up8(p, 0, smem_all))
    RUN(12, phase_moe_down8(p, 0, smem_all))
    RUN(13, phase_ln2(p, 0))
    RUN(14, { phase_inproj8(p, 1, smem_all); phase_inproj_extras(p, 1, smem); })
    RUN(15, phase_mixprep(p, 1, smem))
    RUN(16, phase_chunkA(p, smem))
    RUN(17, phase_scanL1(p))
    RUN(18, phase_scanL2(p))
    RUN(19, phase_chunkC(p, 1, smem))
    RUN(20, phase_outproj8(p, 1, smem_all))
    RUN(21, phase_ln1_route(p, 1, smem))
    RUN(22, phase_moe_gather(p, 1, smem_all))
    RUN(23, phase_moe_up8(p, 1, smem_all))
    RUN(24, phase_moe_down8(p, 1, smem_all))
    RUN(25, phase_ln2(p, 1))
#undef RUN
}

extern "C" void kernel_launch(void* const* d_in, const int* in_sizes, int n_in, void* d_out, int out_size, void* d_ws, size_t ws_size,
                              hipStream_t stream) {
    static int grid = 0;
    if (grid == 0) {
        if (n_in != 38 || ws_size < WS_END) { fprintf(stderr, "kernel_launch: unexpected n_in %d or ws_size %zu (< %zu)\n", n_in, ws_size, (size_t)WS_END); grid = -1; return; }
        int dev = 0, cus = 0, per_cu = 0;
        hipGetDevice(&dev);
        hipDeviceGetAttribute(&cus, hipDeviceAttributeMultiprocessorCount, dev);
        hipFuncSetAttribute((const void*)k_run, hipFuncAttributeMaxDynamicSharedMemorySize, LDS_TOTAL);
        hipOccupancyMaxActiveBlocksPerMultiprocessor(&per_cu, (const void*)k_run, KT, LDS_TOTAL);
        if (per_cu < 1) { fprintf(stderr, "kernel_launch: occupancy query returned %d\n", per_cu); grid = -1; return; }
        if (cus != 256) { fprintf(stderr, "kernel_launch: built for 256 CUs (one workgroup per CU), device has %d\n", cus); grid = -1; return; }
        grid = cus;
    }
    if (grid < 0) return;
    hipMemsetAsync((char*)d_ws + WS_CTL, 0, CTL_BYTES, stream);
    P p{};
    for (int i = 0; i < 38; ++i) p.in[i] = (const float*)d_in[i];
    p.pos = (const int*)d_in[2];
    p.out = (float*)d_out; p.ws = (char*)d_ws;
#if MEGA
    p.ph_lo = 0; p.ph_hi = NPHASE;
    void* args[] = {&p};
    hipError_t e = hipLaunchCooperativeKernel((const void*)k_run, dim3(grid), dim3(KT), args, LDS_TOTAL, stream);
    if (e != hipSuccess) fprintf(stderr, "cooperative launch failed: %s (grid %d)\n", hipGetErrorString(e), grid);
#else
    for (int ph = 0; ph < NPHASE; ++ph) {
        p.ph_lo = ph; p.ph_hi = ph + 1;
        hipLaunchKernelGGL(k_run, dim3(grid), dim3(KT), LDS_TOTAL, stream, p);
    }
#endif
}
```

```cpp
#include <hip/hip_runtime.h>
#include <hip/hip_bf16.h>
#include <stdint.h>
#include <stdio.h>

#ifndef MEGA
#define MEGA 1
#endif

#define DEVI __device__ __forceinline__
#define LAS __attribute__((address_space(3)))

typedef unsigned short bf16;
typedef short bf16x8 __attribute__((ext_vector_type(8)));
typedef float f32x4 __attribute__((ext_vector_type(4)));
typedef unsigned u32x4 __attribute__((ext_vector_type(4)));
typedef unsigned u32x2 __attribute__((ext_vector_type(2)));

constexpr int S = 16384, D = 1024, NIN = 4104, NEXP = 32, DFF = 1024;
constexpr int NPROJ = 4096;
constexpr int NPAD = 4352;
constexpr float DN_ALPHA = 1.4142135623730951f;
constexpr int NT = 256;
constexpr int LDS_BYTES = 76032;

constexpr size_t MiB = 1ull << 20;
constexpr size_t WS_CTL = 0;
constexpr size_t CTL_BYTES = 1 * MiB;
constexpr size_t OFF_BAR = 0;
constexpr size_t OFF_ADA = 64 * 1024;
constexpr size_t OFF_CNT = 128 * 1024;
constexpr size_t WS_ROT = 1 * MiB;
constexpr size_t WS_WIN = WS_ROT + (size_t)S * 64 * 4;
constexpr size_t WS_WOUT = WS_WIN + 2ull * NPAD * D * 2;
constexpr size_t WS_WUP = WS_WOUT + 2ull * D * D * 2;
constexpr size_t WS_WDN = WS_WUP + 2ull * NEXP * 2048 * D * 2;
constexpr size_t WS_HB = WS_WDN + 2ull * NEXP * D * DFF * 2;
constexpr size_t WS_PROJ = WS_HB + (size_t)S * D * 2;
constexpr size_t WS_PEX = WS_PROJ + (size_t)S * NPROJ * 2;
constexpr size_t WS_VFIRST = WS_PEX + (size_t)S * 64 * 4;
constexpr size_t WS_RECR = WS_VFIRST + (size_t)S * 256 * 4;
constexpr size_t WS_RECG = WS_RECR + (size_t)S * 4 * 384 * 2;
constexpr size_t WS_RECT = WS_RECG + (size_t)S * 4 * 392 * 2;
constexpr size_t WS_WDEC = WS_RECT + (size_t)S * 4 * 192 * 2;
constexpr size_t WS_GSC = WS_WDEC + (size_t)S * 256 * 4;
constexpr size_t WS_G = WS_GSC + (size_t)S * 16 * 4;
constexpr size_t WS_BON = WS_G + (size_t)S * 256 * 4;
constexpr size_t WS_YR = WS_BON + (size_t)S * 4 * 4;
constexpr size_t WS_OG = WS_YR + (size_t)S * 256 * 4;
constexpr size_t WS_ORT = WS_OG + (size_t)S * 512 * 4;
constexpr size_t WS_MIX = WS_ORT + (size_t)S * 256 * 4;
constexpr size_t WS_OPRE = WS_MIX + (size_t)S * D * 2;
constexpr size_t WS_X = WS_OPRE + (size_t)S * D * 4;
constexpr size_t WS_H2 = WS_X + (size_t)S * D * 4;
constexpr size_t WS_LIST = WS_H2 + (size_t)S * D * 2;
constexpr size_t WS_GATE = WS_LIST + (size_t)NEXP * S * 4;
constexpr size_t WS_ACT = WS_GATE + (size_t)S * 4 * 4;
constexpr size_t WS_YB = WS_ACT + ((size_t)S * 4 + 256) * DFF * 2;
constexpr size_t WS_ADAP = WS_YB + (size_t)S * 4 * D * 2;
constexpr size_t WS_RKV = WS_ADAP + 16ull * 12288 * 4;
constexpr size_t WS_RST = WS_RKV + 256ull * 4 * 4096 * 4;
constexpr size_t WS_GP = WS_RST + 256ull * 4 * 4096 * 2;
constexpr size_t WS_GB = WS_GP + 1024ull * 16384 * 2;
constexpr size_t WS_GD = WS_GB + 1024ull * 16384 * 4;
constexpr size_t WS_GQ = WS_GD + 4096;
constexpr size_t WS_GO = WS_GQ + 1024ull * 8192 * 2;
constexpr size_t WS_GS = WS_GO + 1024ull * 8192 * 4;
constexpr size_t WS_WP = WS_GS + 1024ull * 16384 * 2;
constexpr size_t WS_WC = WS_WP + 2048ull * 4096 * 2;
constexpr size_t WS_WD = WS_WC + 2048ull * 4096 * 4;
constexpr size_t WS_WQ = WS_WD + 2048ull * 64 * 4;
constexpr size_t WS_WY = WS_WQ + 2048ull * 2048 * 2;
constexpr size_t WS_WS = WS_WY + 2048ull * 2048 * 4;
constexpr size_t WS_GR = WS_WS + 2048ull * 4096 * 2;
constexpr size_t WS_GE0 = WS_GR + 1024ull * 8192 * 2;
constexpr size_t WS_GTE = WS_GE0 + 64ull * 16384 * 4;
constexpr size_t WS_GSG = WS_GTE + 64ull * 16384 * 2;
constexpr size_t WS_WR = WS_GSG + 64ull * 16384 * 2;
constexpr size_t WS_WE0 = WS_WR + 2048ull * 2048 * 2;
constexpr size_t WS_WTE = WS_WE0 + 64ull * 4096 * 4;
constexpr size_t WS_WSG = WS_WTE + 64ull * 4096 * 2;
constexpr size_t WS_LRT = WS_WSG + 64ull * 4096 * 2;
constexpr size_t WS_HG = WS_LRT + 2ull * 73728 * 2;
constexpr size_t WS_DUMP = WS_HG + ((size_t)S * 4 + 256) * D * 2;
constexpr size_t WS_END = WS_DUMP + 4096;

struct P {
    const float* in[38];
    const int* pos;
    float* out;
    char* ws;
    int ph_lo, ph_hi;
};

DEVI float bf2f(bf16 v) { return __uint_as_float(((unsigned)v) << 16); }
DEVI unsigned f2bf(float f) { unsigned u = __float_as_uint(f); return (u + 0x7fffu + ((u >> 16) & 1u)) >> 16; }
typedef float f32x2_t __attribute__((ext_vector_type(2)));
typedef __bf16 bf16x2_t __attribute__((ext_vector_type(2)));
DEVI unsigned pk2(float lo, float hi) { const f32x2_t v = {lo, hi}; return __builtin_bit_cast(unsigned, __builtin_convertvector(v, bf16x2_t)); }
DEVI float sigmoidf_(float x) { return __builtin_amdgcn_rcpf(1.f + __builtin_amdgcn_exp2f(-1.4426950408889634f * x)); }
DEVI float siluf_(float x) { return x * sigmoidf_(x); }
DEVI float softplusf_(float x) { return fmaxf(x, 0.f) + log1pf(__expf(-fabsf(x))); }
DEVI float wave_sum(float v) {
#pragma unroll
    for (int o = 32; o >= 1; o >>= 1) v += __shfl_xor(v, o);
    return v;
}
template <int CTRL> DEVI float dpp_mov(float x) {
    return __int_as_float(__builtin_amdgcn_update_dpp(0, __float_as_int(x), CTRL, 0xf, 0xf, false));
}
DEVI float row16_sum(float x) {
    x += dpp_mov<0x128>(x);
    x += dpp_mov<0x124>(x);
    x += dpp_mov<0x122>(x);
    x += dpp_mov<0x121>(x);
    return x;
}

DEVI bf16x8 ldfrag(const bf16* base, int ld, int row0, int k0, int lane) {
    return *(const bf16x8*)(base + (row0 + (lane & 15)) * ld + k0 + (lane >> 4) * 8);
}
DEVI f32x4 ld_bf4(const bf16* p) {
    const u32x2 v = *(const u32x2*)p;
    return (f32x4){__uint_as_float(v.x << 16), __uint_as_float(v.x & 0xffff0000u), __uint_as_float(v.y << 16), __uint_as_float(v.y & 0xffff0000u)};
}
DEVI void st_bf4(bf16* p, const f32x4& v) { *(u32x2*)p = (u32x2){pk2(v.x, v.y), pk2(v.z, v.w)}; }
DEVI float quad_sum(float v) { v += __shfl_xor(v, 16); v += __shfl_xor(v, 32); return v; }
DEVI f32x4 mfma16(bf16x8 a, bf16x8 b, f32x4 c) { return __builtin_amdgcn_mfma_f32_16x16x32_bf16(a, b, c, 0, 0, 0); }

#define VTID ((int)(threadIdx.x & 255))
#define VBID ((int)(blockIdx.x * 2 + __builtin_amdgcn_readfirstlane((int)(threadIdx.x >> 8))))
#define VNB ((int)(gridDim.x * 2))
constexpr int VB_LDS = 76032;
constexpr int KT = 512;

#define XB_TMO      128
#define XB_XCNT(j)  (256  + 64 * (j))
#define XB_XSUB(j)  (1280 + 64 * (j))
#define XB_XGEN(j)  (2304 + 64 * (j))
#define XB_TOP      3328
#define XB_TOPGEN   3392
#define XCD_BAR_WORDS 3456
#define XB_SPIN_CAP (1u << 22)
DEVI unsigned xb_ld(unsigned* p) { return __hip_atomic_load(p, __ATOMIC_RELAXED, __HIP_MEMORY_SCOPE_AGENT); }
DEVI unsigned xb_add(unsigned* p, unsigned v) { return __hip_atomic_fetch_add(p, v, __ATOMIC_RELAXED, __HIP_MEMORY_SCOPE_AGENT); }
DEVI unsigned xb_xcc_id() { return (unsigned)__builtin_amdgcn_s_getreg((3 << 11) | 20) & 0xFu; }
#define XB_SPIN(cond, bar) do { unsigned _sp = 0; while (cond) { __builtin_amdgcn_s_sleep(1); \
    if ((++_sp & 255u) == 0u) { if (xb_ld(&(bar)[XB_TMO])) break; if (_sp > XB_SPIN_CAP) { atomicAdd(&(bar)[XB_TMO], 1u); break; } } } } while (0)
struct XcdBarrier { unsigned* bar; unsigned x; volatile LAS unsigned* st; };
DEVI XcdBarrier xcd_barrier_post(unsigned* bar, volatile LAS unsigned* st) {
    XcdBarrier b; b.bar = bar; b.x = xb_xcc_id(); b.st = st;
    if (threadIdx.x == 0) (void)xb_add(&bar[XB_XCNT(b.x)], 1u);
    return b;
}
DEVI void xcd_barrier_complete(unsigned* bar, unsigned x, unsigned& nloc, unsigned& nx) {
    const unsigned G = gridDim.x * gridDim.y * gridDim.z;
    unsigned sum, cnt, mine, sp = 0u;
    for (;;) {
        sum = 0u; cnt = 0u; mine = 0u;
#pragma unroll
        for (unsigned j = 0; j < 16; ++j) { const unsigned c = xb_ld(&bar[XB_XCNT(j)]); sum += c; cnt += (c > 0u) ? 1u : 0u; mine = (j == x) ? c : mine; }
        if (sum == G) break;
        __builtin_amdgcn_s_sleep(1);
        if ((++sp & 255u) == 0u) { if (xb_ld(&bar[XB_TMO])) break; if (sp > XB_SPIN_CAP) { atomicAdd(&bar[XB_TMO], 1u); break; } }
    }
    nloc = mine > 0u ? mine : 1u; nx = cnt > 0u ? cnt : 1u;
}
DEVI void xcd_barrier(const XcdBarrier& b) {
    asm volatile("s_waitcnt vmcnt(0)" ::: "memory");
    __syncthreads();
    if (threadIdx.x == 0) {
        unsigned* bar = b.bar;
        __builtin_amdgcn_s_waitcnt(0);
        unsigned nloc = b.st[0], nx = b.st[1];
        if (nloc == 0u) { xcd_barrier_complete(bar, b.x, nloc, nx); b.st[0] = nloc; b.st[1] = nx; }
        const unsigned old = xb_add(&bar[XB_XSUB(b.x)], 1u);
        const unsigned gen = old / nloc;
        if (old + 1u == (gen + 1u) * nloc) {
            __builtin_amdgcn_fence(__ATOMIC_RELEASE, "agent");
            asm volatile("s_waitcnt vmcnt(0)" ::: "memory");
            const unsigned og = xb_add(&bar[XB_TOP], 1u);
            const unsigned tg = og / nx;
            if (og + 1u == (tg + 1u) * nx) xb_add(&bar[XB_TOPGEN], 1u);
            else XB_SPIN(xb_ld(&bar[XB_TOPGEN]) == tg, bar);
            __builtin_amdgcn_fence(__ATOMIC_ACQUIRE, "agent");
            xb_add(&bar[XB_XGEN(b.x)], 1u);
            asm volatile("s_waitcnt vmcnt(0)" ::: "memory");
        } else {
            XB_SPIN(xb_ld(&bar[XB_XGEN(b.x)]) == gen, bar);
            __builtin_amdgcn_fence(__ATOMIC_ACQUIRE, "agent");
            asm volatile("s_waitcnt vmcnt(0)" ::: "memory");
        }
    }
    __syncthreads();
}

DEVI void transpose_item(const float* __restrict__ src, size_t ld, int k0, int ns0, bf16* __restrict__ dst, int kd, int nd0, float* lds) {
    const int tid = VTID;
#pragma unroll 4
    for (int i = 0; i < 16; ++i) {
        const int kk = i * 4 + (tid >> 6), n = tid & 63;
        lds[kk * 65 + n] = src[(size_t)(k0 + kk) * ld + ns0 + n];
    }
    __syncthreads();
#pragma unroll
    for (int i = 0; i < 2; ++i) {
        const int q = tid + 256 * i, n = q >> 3, kc = q & 7;
        const float* s = lds + (kc * 8) * 65 + n;
        u32x4 o;
        o.x = pk2(s[0 * 65], s[1 * 65]); o.y = pk2(s[2 * 65], s[3 * 65]);
        o.z = pk2(s[4 * 65], s[5 * 65]); o.w = pk2(s[6 * 65], s[7 * 65]);
        *(u32x4*)(dst + (size_t)(nd0 + n) * kd + k0 + kc * 8) = o;
    }
    __syncthreads();
}

DEVI void phase_prep(const P& p, char* smem) {
    float* lds = (float*)smem;
    const int tid = VTID;
    const int nb = VNB, bid = VBID;
    bf16* WIN = (bf16*)(p.ws + WS_WIN); bf16* WOUT = (bf16*)(p.ws + WS_WOUT);
    bf16* WUP = (bf16*)(p.ws + WS_WUP); bf16* WDN = (bf16*)(p.ws + WS_WDN);
    constexpr int I_UP = 2 * NEXP * 16 * 32;
    constexpr int I_DN = 2 * NEXP * 16 * 16;
    constexpr int I_IN = 2 * 16 * 64;
    constexpr int I_OUT = 2 * 16 * 16;
    constexpr int I_EX = 2 * 256;
    constexpr int I_ADA = 2 * 24 * 16;
    constexpr int I_ROT = S * 32 / 256;
    constexpr int I_LR = 2 * 288;
    constexpr int NITEMS = I_UP + I_DN + I_IN + I_OUT + I_EX + I_ADA + I_ROT + I_LR;
    constexpr int I_TR = I_UP + I_DN + I_IN + I_OUT;
    static_assert(I_TR % 512 == 0, "transpose items must split evenly over 512 virtual blocks (they contain barriers)");
    for (int it = bid; it < NITEMS; it += nb) {
        int r = it;
        if (r < I_UP) {
            const int le = r / 512, q = r % 512, kt = q / 32, nt = q % 32;
            transpose_item(p.in[32] + (size_t)le * D * 2048, 2048, kt * 64, nt * 64, WUP + (size_t)le * 2048 * D, D, nt * 64, lds);
            continue;
        }
        r -= I_UP;
        if (r < I_DN) {
            const int le = r / 256, q = r % 256, kt = q / 16, nt = q % 16;
            transpose_item(p.in[34] + (size_t)le * DFF * D, D, kt * 64, nt * 64, WDN + (size_t)le * D * DFF, DFF, nt * 64, lds);
            continue;
        }
        r -= I_DN;
        if (r < I_IN) {
            const int l = r / 1024, q = r % 1024, kt = q / 64, nt = q % 64;
            const int nd0 = nt * 64, ns0 = nd0 < 3072 ? nd0 : nd0 + 8;
            transpose_item(p.in[5] + (size_t)l * D * NIN, NIN, kt * 64, ns0, WIN + (size_t)l * NPAD * D, D, nd0, lds);
            continue;
        }
        r -= I_IN;
        if (r < I_OUT) {
            const int l = r / 256, q = r % 256, kt = q / 16, nt = q % 16;
            transpose_item(p.in[27] + (size_t)l * D * D, D, kt * 64, nt * 64, WOUT + (size_t)l * D * D, D, nt * 64, lds);
            continue;
        }
        r -= I_OUT;
        if (r < I_EX) {
            const int l = r / 256, n = r % 256;
            bf16* dst = WIN + ((size_t)l * NPAD + NPROJ + n) * D;
            for (int k = tid; k < D; k += NT) {
                float v = 0.f;
                if (n < 8) v = p.in[5][(size_t)l * D * NIN + (size_t)k * NIN + 3072 + n];
                else if (n < 40 && l == 1) v = p.in[6][(size_t)k * 32 + (n - 8)];
                dst[k] = (bf16)f2bf(v);
            }
            continue;
        }
        r -= I_EX;
        if (r < I_ADA) {
            const int l = r / 384, q = r % 384, nc = q / 16, kc = q % 16;
            const int n = nc * 256 + tid;
            const float* W = p.in[3] + (size_t)l * D * 6144;
            float acc = (kc == 0) ? p.in[4][l * 6144 + n] : 0.f;
            for (int k = kc * 64; k < kc * 64 + 64; ++k) acc += siluf_(p.in[1][k]) * W[(size_t)k * 6144 + n];
            ((float*)(p.ws + WS_ADAP))[(size_t)kc * 12288 + l * 6144 + n] = acc;
            continue;
        }
        r -= I_ADA;
        if (r >= I_ROT) {
            r -= I_ROT;
            const int l = r / 288, kk = r % 288, c = tid;
            bf16* LRT = (bf16*)(p.ws + WS_LRT) + (size_t)l * 73728;
            if (kk < 64) LRT[c * 64 + kk] = (bf16)f2bf(p.in[10][(l * 64 + kk) * 256 + c]);
            else if (kk < 128) LRT[16384 + c * 64 + (kk - 64)] = (bf16)f2bf(p.in[12][(l * 64 + kk - 64) * 256 + c]);
            else if (kk < 256) LRT[32768 + c * 128 + (kk - 128)] = (bf16)f2bf(p.in[13][(l * 128 + kk - 128) * 256 + c]);
            else LRT[65536 + c * 32 + (kk - 256)] = (bf16)f2bf(l == 1 ? p.in[20][(kk - 256) * 256 + c] : 0.f);
            continue;
        }
        {
            const int idx = r * 256 + tid;
            const int t = idx >> 5, i = idx & 31;
            const float invf = (float)pow(10000.0, -(double)i / 32.0);
            const float ang = (float)p.pos[t] * invf;
            float sn, cs; sincosf(ang, &sn, &cs);
            float* ROT = (float*)(p.ws + WS_ROT);
            ROT[(size_t)idx * 2] = cs; ROT[(size_t)idx * 2 + 1] = sn;
        }
    }
}

DEVI float ada_sum(const float* ADAP, int idx) {
    float s = 0.f;
#pragma unroll
    for (int kc = 0; kc < 16; ++kc) s += ADAP[(size_t)kc * 12288 + idx];
    return s;
}
DEVI void phase_h0(const P& p) {
    const float* ADAP = (const float*)(p.ws + WS_ADAP);
    float* ADA = (float*)(p.ws + OFF_ADA);
    bf16* HB = (bf16*)(p.ws + WS_HB);
    if (VBID < 48) ADA[VBID * 256 + VTID] = ada_sum(ADAP, VBID * 256 + VTID);
    const size_t n4 = (size_t)S * D / 4;
    const int c = (int)(((size_t)VBID * NT + VTID) % (D / 4)) * 4;
    f32x4 sh, sc;
    sh.x = ada_sum(ADAP, c); sh.y = ada_sum(ADAP, c + 1); sh.z = ada_sum(ADAP, c + 2); sh.w = ada_sum(ADAP, c + 3);
    sc.x = ada_sum(ADAP, 1024 + c); sc.y = ada_sum(ADAP, 1025 + c); sc.z = ada_sum(ADAP, 1026 + c); sc.w = ada_sum(ADAP, 1027 + c);
    for (size_t i = (size_t)VBID * NT + VTID; i < n4; i += (size_t)VNB * NT) {
        const f32x4 x = ((const f32x4*)p.in[0])[i];
        u32x2 o;
        o.x = pk2(x.x * (1.f + sc.x) + sh.x, x.y * (1.f + sc.y) + sh.y);
        o.y = pk2(x.z * (1.f + sc.z) + sh.z, x.w * (1.f + sc.w) + sh.w);
        ((u32x2*)HB)[i] = o;
    }
}

template <class AF, class BF>
DEVI void gemm_tile(char* smem, const bf16* __restrict__ Abase, AF arow, const bf16* __restrict__ Bbase, BF brow, int K, f32x4 (&acc)[4][8]) {
    const int tid = VTID, wid = tid >> 6, lane = tid & 63, wr = wid >> 1, wc = wid & 1, fr = lane & 15, fq = lane >> 4;
    const int r0 = tid >> 2;
    const int swz = ((tid & 3) ^ ((0x1320 >> (4 * ((tid >> 4) & 3))) & 3)) * 8;
    unsigned pa[2], pb[4];
#pragma unroll
    for (int i = 0; i < 2; ++i) pa[i] = arow(r0 + 64 * i) + swz;
#pragma unroll
    for (int i = 0; i < 4; ++i) pb[i] = brow(r0 + 64 * i) + swz;
#pragma unroll
    for (int m = 0; m < 4; ++m)
#pragma unroll
        for (int n = 0; n < 8; ++n) acc[m][n] = (f32x4){0.f, 0.f, 0.f, 0.f};
    const int nk = K / 32;
    const int ch = (fq ^ ((0x1320 >> (4 * ((fr >> 2) & 3))) & 3)) * 16;
#define GT_STAGE(kt) do { char* _sa = smem + ((kt) % 3) * 24576; char* _sb = _sa + 8192; \
        _Pragma("unroll") for (int _i = 0; _i < 2; ++_i) \
            __builtin_amdgcn_global_load_lds((const unsigned*)(Abase + pa[_i] + (kt) * 32), (unsigned*)(_sa + (tid + 256 * _i) * 16), 16, 0, 0); \
        _Pragma("unroll") for (int _i = 0; _i < 4; ++_i) \
            __builtin_amdgcn_global_load_lds((const unsigned*)(Bbase + pb[_i] + (kt) * 32), (unsigned*)(_sb + (tid + 256 * _i) * 16), 16, 0, 0); } while (0)
    asm volatile("s_waitcnt vmcnt(0)" ::: "memory");
    GT_STAGE(0); GT_STAGE(1);
    for (int kt = 0; kt < nk; ++kt) {
        if (kt + 1 < nk) asm volatile("s_waitcnt vmcnt(6)" ::: "memory");
        else asm volatile("s_waitcnt vmcnt(0)" ::: "memory");
        asm volatile("s_waitcnt lgkmcnt(0)" ::: "memory");
        __builtin_amdgcn_s_barrier();
        if (kt + 2 < nk) GT_STAGE(kt + 2);
        const char* SA = smem + (kt % 3) * 24576; const char* SB = SA + 8192;
        bf16x8 af[4], bfr[8];
#pragma unroll
        for (int m = 0; m < 4; ++m) af[m] = *(const bf16x8*)(SA + (wr * 64 + m * 16 + fr) * 64 + ch);
#pragma unroll
        for (int n = 0; n < 8; ++n) bfr[n] = *(const bf16x8*)(SB + (wc * 128 + n * 16 + fr) * 64 + ch);
#pragma unroll
        for (int m = 0; m < 4; ++m)
#pragma unroll
            for (int n = 0; n < 8; ++n)
                acc[m][n] = __builtin_amdgcn_mfma_f32_16x16x32_bf16(bfr[n], af[m], acc[m][n], 0, 0, 0);
    }
    asm volatile("s_waitcnt lgkmcnt(0)" ::: "memory");
    __builtin_amdgcn_s_barrier();
#undef GT_STAGE
}

DEVI float proj_at(const bf16* PROJ, int t, int col) { return bf2f(PROJ[(size_t)t * NPROJ + col]); }
DEVI float proj_shift(const bf16* PROJ, int t, int col, float mu) {
    const float cur = proj_at(PROJ, t, col);
    const float prv = t > 0 ? proj_at(PROJ, t - 1, col) : 0.f;
    return cur + (prv - cur) * mu;
}

DEVI f32x4 shift4(const bf16* PROJ, int t, int col, const f32x4& mu) {
    const f32x4 cur = ld_bf4(PROJ + (size_t)t * NPROJ + col);
    f32x4 prv = {0.f, 0.f, 0.f, 0.f};
    if (t > 0) prv = ld_bf4(PROJ + (size_t)(t - 1) * NPROJ + col);
    return cur + (prv - cur) * mu;
}
DEVI float fsig(float x) { return sigmoidf_(x); }
DEVI void phase_mixprep(const P& p, int l, char* smem) {
    const bf16* PROJ = (const bf16*)(p.ws + WS_PROJ); const float* PEX = (const float*)(p.ws + WS_PEX);
    float* VFIRST = (float*)(p.ws + WS_VFIRST);
    bf16* RECR = (bf16*)(p.ws + WS_RECR); bf16* RECG = (bf16*)(p.ws + WS_RECG); bf16* RECT = (bf16*)(p.ws + WS_RECT);
    float* WDEC = (float*)(p.ws + WS_WDEC); float* GSC = (float*)(p.ws + WS_GSC);
    float* GB = (float*)(p.ws + WS_G); float* BON = (float*)(p.ws + WS_BON);
    const float* ROT = (const float*)(p.ws + WS_ROT);
    const bf16* LRT = (const bf16*)(p.ws + WS_LRT) + (size_t)l * 73728;
    bf16* L = (bf16*)smem;
    const float* mu = p.in[7] + l * 1024;
    for (int item = VBID; item < S / 16; item += VNB) {
        int tid = VTID; asm volatile("" : "+v"(tid));
        const int lane = tid & 63, w = tid >> 6, fr = lane & 15, fq = lane >> 4;
        const int t0 = item * 16;
        for (int g = tid; g < 16 * 72; g += NT) {
            const int tt = g / 72, i4 = (g % 72) * 4, t = t0 + tt;
            f32x4 v;
            if (i4 < 256) {
                const int col = 768 + i4;
                v = shift4(PROJ, t, col, *(const f32x4*)(mu + col));
                if (i4 < 64) { v.x = tanhf(v.x); v.y = tanhf(v.y); v.z = tanhf(v.z); v.w = tanhf(v.w); }
                else if (i4 >= 128) { v.x = fsig(v.x); v.y = fsig(v.y); v.z = fsig(v.z); v.w = fsig(v.w); }
            } else {
                v = (f32x4){0.f, 0.f, 0.f, 0.f};
                if (l == 1) {
                    const int j = i4 - 256;
                    const f32x4 cur = *(const f32x4*)(PEX + (size_t)t * 64 + 8 + j);
                    f32x4 prv = {0.f, 0.f, 0.f, 0.f};
                    if (t > 0) prv = *(const f32x4*)(PEX + (size_t)(t - 1) * 64 + 8 + j);
                    v = cur + (prv - cur) * *(const f32x4*)(p.in[8] + j);
                }
            }
            *(u32x2*)(L + tt * 296 + i4) = (u32x2){pk2(v.x, v.y), pk2(v.z, v.w)};
        }
        __syncthreads();
        const int t = t0 + fr, h = w;
        {
            f32x4 aw[4], aa[4], ag[4], av[4];
#pragma unroll
            for (int i = 0; i < 4; ++i) { aw[i] = (f32x4){0.f, 0.f, 0.f, 0.f}; aa[i] = aw[i]; ag[i] = aw[i]; av[i] = aw[i]; }
            bf16x8 lf[9];
#pragma unroll
            for (int ks = 0; ks < 9; ++ks) lf[ks] = *(const bf16x8*)(L + fr * 296 + ks * 32 + fq * 8);
#pragma unroll
            for (int i = 0; i < 4; ++i) {
                const int c = 64 * h + 16 * i + fr;
#pragma unroll
                for (int ks = 0; ks < 2; ++ks) aw[i] = mfma16(*(const bf16x8*)(LRT + c * 64 + ks * 32 + fq * 8), lf[ks], aw[i]);
#pragma unroll
                for (int ks = 0; ks < 2; ++ks) aa[i] = mfma16(*(const bf16x8*)(LRT + 16384 + c * 64 + ks * 32 + fq * 8), lf[2 + ks], aa[i]);
#pragma unroll
                for (int ks = 0; ks < 4; ++ks) ag[i] = mfma16(*(const bf16x8*)(LRT + 32768 + c * 128 + ks * 32 + fq * 8), lf[4 + ks], ag[i]);
                if (l == 1) av[i] = mfma16(*(const bf16x8*)(LRT + 65536 + c * 32 + fq * 8), lf[8], av[i]);
            }
            bf16* rec = RECR + ((size_t)t * 4 + h) * 384;
            f32x4 kx[4], as_[4];
            float ss = 0.f, bsum = 0.f;
#pragma unroll
            for (int i = 0; i < 4; ++i) {
                const int j = 16 * i + 4 * fq, c = 64 * h + j;
                const f32x4 r = shift4(PROJ, t, c, *(const f32x4*)(mu + c));
                const f32x4 k = shift4(PROJ, t, 256 + c, *(const f32x4*)(mu + 256 + c));
                f32x4 v = shift4(PROJ, t, 512 + c, *(const f32x4*)(mu + 512 + c));
                const f32x4 w0 = *(const f32x4*)(p.in[9] + l * 256 + c), a0 = *(const f32x4*)(p.in[11] + l * 256 + c);
                const f32x4 kkc = *(const f32x4*)(p.in[14] + l * 256 + c), kac = *(const f32x4*)(p.in[15] + l * 256 + c), rkc = *(const f32x4*)(p.in[16] + l * 256 + c);
                f32x4 dec, a;
#pragma unroll
                for (int q = 0; q < 4; ++q) {
                    const float wl = -softplusf_(-(w0[q] + aw[i][q])) - 0.5f;
                    dec[q] = __expf(-__expf(wl));
                    a[q] = fsig(a0[q] + aa[i][q]);
                }
                if (l == 0) *(f32x4*)(VFIRST + (size_t)t * 256 + c) = v;
                else {
                    const f32x4 vf = *(const f32x4*)(VFIRST + (size_t)t * 256 + c), v0 = *(const f32x4*)(p.in[19] + c);
#pragma unroll
                    for (int q = 0; q < 4; ++q) v[q] = v[q] + (vf[q] - v[q]) * fsig(v0[q] + av[i][q]);
                }
                kx[i] = k * kkc; as_[i] = a;
                const f32x4 k2 = k * ((a - 1.f) * kac + 1.f);
                ss += kx[i].x * kx[i].x + kx[i].y * kx[i].y + kx[i].z * kx[i].z + kx[i].w * kx[i].w;
                const f32x4 rb = r * k2 * rkc;
                bsum += (rb.x + rb.y) + (rb.z + rb.w);
                *(f32x4*)(WDEC + (size_t)t * 256 + c) = dec; st_bf4(rec + 192 + j, k2); st_bf4(rec + 256 + j, r); st_bf4(rec + 320 + j, v);
                *(f32x4*)(GB + (size_t)t * 256 + c) = ag[i];
            }
            const float rn = rsqrtf(quad_sum(ss) + 1e-12f);
            bsum = quad_sum(bsum);
            if (fq == 0) BON[(size_t)t * 4 + h] = bsum;
#pragma unroll
            for (int i = 0; i < 4; ++i) {
                const int j = 16 * i + 4 * fq;
                const f32x4 kk = kx[i] * rn;
                st_bf4(rec + j, -kk); st_bf4(rec + 128 + j, kk * as_[i]);
            }
        }
        {
            const float* conv_w = p.in[21] + l * 4 * 1536;
            bf16* rec = RECG + ((size_t)t * 4 + h) * 392;
            f32x4 yq[8], yk[8];
            float sq = 0.f, sk = 0.f;
#pragma unroll
            for (int which = 0; which < 3; ++which) {
#pragma unroll
                for (int i = 0; i < 8; ++i) {
                    const int j = 16 * i + 4 * fq, ch = which * 512 + h * 128 + j, col = 1024 + ch;
                    f32x4 cv = ld_bf4(PROJ + (size_t)t * NPROJ + col) * *(const f32x4*)(conv_w + 3 * 1536 + ch);
#pragma unroll
                    for (int tap = 0; tap < 3; ++tap) {
                        const int tp = t - 3 + tap;
                        if (tp >= 0) cv = cv + ld_bf4(PROJ + (size_t)tp * NPROJ + col) * *(const f32x4*)(conv_w + tap * 1536 + ch);
                    }
                    f32x4 y; y.x = siluf_(cv.x); y.y = siluf_(cv.y); y.z = siluf_(cv.z); y.w = siluf_(cv.w);
                    if (which == 0) { yq[i] = y; sq += y.x * y.x + y.y * y.y + y.z * y.z + y.w * y.w; }
                    else if (which == 1) { yk[i] = y; sk += y.x * y.x + y.y * y.y + y.z * y.z + y.w * y.w; }
                    else st_bf4(rec + 256 + j, y);
                }
            }
            const float rq = rsqrtf(quad_sum(sq) + 1e-12f) * 0.08838834764831845f, rk = rsqrtf(quad_sum(sk) + 1e-12f);
#pragma unroll
            for (int i = 0; i < 8; ++i) { const int j = 16 * i + 4 * fq; st_bf4(rec + j, yq[i] * rq); st_bf4(rec + 128 + j, yk[i] * rk); }
            if (fq == 0) {
                const float av = PEX[(size_t)t * 64 + h], bv = PEX[(size_t)t * 64 + 4 + h];
                const float g = -__expf(p.in[22][l * 4 + h]) * softplusf_(av + p.in[23][l * 4 + h]);
                *(f32x4*)(GSC + ((size_t)t * 4 + h) * 4) = (f32x4){__expf(g), fsig(bv), g, 0.f};
            }
        }
        {
            bf16* rec = RECT + ((size_t)t * 4 + h) * 192;
#pragma unroll
            for (int u = 0; u < 2; ++u) {
                const int i = 16 * u + 4 * fq;
                const f32x4 c0 = *(const f32x4*)(ROT + ((size_t)t * 32 + i) * 2), c1 = *(const f32x4*)(ROT + ((size_t)t * 32 + i) * 2 + 4);
                const f32x4 cs = {c0.x, c0.z, c1.x, c1.z}, sn = {c0.y, c0.w, c1.y, c1.w};
                const f32x4 q1 = ld_bf4(PROJ + (size_t)t * NPROJ + 3072 + h * 64 + i), q2 = ld_bf4(PROJ + (size_t)t * NPROJ + 3072 + h * 64 + 32 + i);
                const f32x4 k1 = ld_bf4(PROJ + (size_t)t * NPROJ + 3328 + h * 64 + i), k2 = ld_bf4(PROJ + (size_t)t * NPROJ + 3328 + h * 64 + 32 + i);
                st_bf4(rec + i, q1 * cs - q2 * sn); st_bf4(rec + 32 + i, q1 * sn + q2 * cs);
                st_bf4(rec + 64 + i, (k1 * cs - k2 * sn) * 0.125f); st_bf4(rec + 96 + i, (k1 * sn + k2 * cs) * 0.125f);
            }
#pragma unroll
            for (int i = 0; i < 4; ++i) { const int j = 16 * i + 4 * fq; *(u32x2*)(rec + 128 + j) = *(const u32x2*)(PROJ + (size_t)t * NPROJ + 3584 + h * 64 + j); }
        }
        __syncthreads();
    }
}

DEVI void retA_item(const P& p, int item, char* smem) {
    const bf16* REC = (const bf16*)(p.ws + WS_RECT); float* KV = (float*)(p.ws + WS_RKV);
    bf16* KT = (bf16*)smem; bf16* VT = KT + 64 * 72;
    const int n = item >> 2, h = item & 3;
    int tid = VTID; asm volatile("" : "+v"(tid));
    const int lane = tid & 63, w = tid >> 6, fr = lane & 15, fq = lane >> 4;
    const float lg = log2f(1.f - exp2f(-5.f - (float)h));
    {
        u32x4 v[4];
#pragma unroll
        for (int i = 0; i < 4; ++i) { const int idx = tid + 256 * i, c = idx >> 4, j = idx & 15; v[i] = *(const u32x4*)(REC + ((size_t)(n * 64 + c) * 4 + h) * 192 + 64 + j * 8); }
#pragma unroll
        for (int i = 0; i < 4; ++i) {
            const int idx = tid + 256 * i, c = idx >> 4, j = idx & 15;
            const float sc = (j < 8) ? exp2f((float)(63 - c) * lg) : 1.f;
            bf16* dst = ((j < 8) ? KT : VT) + ((j & 7) * 8) * 72 + c;
#pragma unroll
            for (int q = 0; q < 4; ++q) {
                const unsigned u = v[i][q];
                dst[(2 * q) * 72] = (j < 8) ? (bf16)f2bf(__uint_as_float(u << 16) * sc) : (bf16)(u & 0xffffu);
                dst[(2 * q + 1) * 72] = (j < 8) ? (bf16)f2bf(__uint_as_float(u & 0xffff0000u) * sc) : (bf16)(u >> 16);
            }
        }
    }
    __syncthreads();
    {
        const int dt = w;
        const bf16x8 a0 = ldfrag(KT, 72, 16 * dt, 0, lane), a1 = ldfrag(KT, 72, 16 * dt, 32, lane);
        float* out = KV + (size_t)item * 4096;
        const int s_ = dt >> 1, lane2 = 16 * (2 * (dt & 1) + (fq >> 1)) + fr;
#pragma unroll
        for (int et = 0; et < 4; ++et) {
            f32x4 acc = {0.f, 0.f, 0.f, 0.f};
            acc = mfma16(a0, ldfrag(VT, 72, 16 * et, 0, lane), acc);
            acc = mfma16(a1, ldfrag(VT, 72, 16 * et, 32, lane), acc);
            *(f32x4*)(out + ((et * 2 + s_) * 64 + lane2) * 8 + 4 * (fq & 1)) = acc;
        }
    }
    __syncthreads();
}

DEVI void retS_item(const P& p, int item) {
    const float* KV = (const float*)(p.ws + WS_RKV); bf16* RST = (bf16*)(p.ws + WS_RST);
    const int idx = item * NT + VTID;
    const int h = idx >> 12, i = idx & 4095;
    const float cd = exp2f(64.f * log2f(1.f - exp2f(-5.f - (float)h)));
    float r = 0.f;
#pragma unroll 1
    for (int n0 = 0; n0 < 256; n0 += 32) {
        float kv[32];
#pragma unroll
        for (int q = 0; q < 32; ++q) kv[q] = KV[((size_t)(n0 + q) * 4 + h) * 4096 + i];
#pragma unroll
        for (int q = 0; q < 32; ++q) { RST[((size_t)(n0 + q) * 4 + h) * 4096 + i] = (bf16)f2bf(r); r = r * cd + kv[q]; }
    }
}

DEVI void retC_item(const P& p, int item, int l, char* smem) {
    const bf16* REC = (const bf16*)(p.ws + WS_RECT); const bf16* RST = (const bf16*)(p.ws + WS_RST);
    const bf16* PROJ = (const bf16*)(p.ws + WS_PROJ); bf16* MIX = (bf16*)(p.ws + WS_MIX);
    const float* rgn = p.in[25] + l * 256; const float* rbn = p.in[26] + l * 256;
    bf16* Qs = (bf16*)smem; bf16* Ks = Qs + 64 * 72; bf16* VT = Ks + 64 * 72; bf16* Ps = VT + 64 * 72;
    const int n = item >> 2, h = item & 3;
    int tid = VTID; asm volatile("" : "+v"(tid));
    const int lane = tid & 63, w = tid >> 6, fr = lane & 15, fq = lane >> 4;
    const float lg = log2f(1.f - exp2f(-5.f - (float)h));
    {
        u32x4 v[6];
#pragma unroll
        for (int i = 0; i < 6; ++i) { const int idx = tid + 256 * i, c = idx / 24, j = idx - c * 24; v[i] = *(const u32x4*)(REC + ((size_t)(n * 64 + c) * 4 + h) * 192 + j * 8); }
#pragma unroll
        for (int i = 0; i < 6; ++i) {
            const int idx = tid + 256 * i, c = idx / 24, j = idx - c * 24;
            if (j < 16) *(u32x4*)(((j < 8) ? Qs : Ks) + c * 72 + (j & 7) * 8) = v[i];
            else {
                bf16* dst = VT + ((j & 7) * 8) * 72 + c;
#pragma unroll
                for (int q = 0; q < 4; ++q) { const unsigned u = v[i][q]; dst[(2 * q) * 72] = (bf16)(u & 0xffffu); dst[(2 * q + 1) * 72] = (bf16)(u >> 16); }
            }
        }
    }
    __syncthreads();
    const int ct = w, c = 16 * ct + fr;
    const bf16x8 q0 = ldfrag(Qs, 72, 16 * ct, 0, lane), q1 = ldfrag(Qs, 72, 16 * ct, 32, lane);
#pragma unroll
    for (int ct2 = 0; ct2 < 4; ++ct2) {
        f32x4 acc = {0.f, 0.f, 0.f, 0.f};
        acc = mfma16(ldfrag(Ks, 72, 16 * ct2, 0, lane), q0, acc);
        acc = mfma16(ldfrag(Ks, 72, 16 * ct2, 32, lane), q1, acc);
        float pv[4];
#pragma unroll
        for (int j = 0; j < 4; ++j) {
            const int c2 = 16 * ct2 + 4 * fq + j;
            pv[j] = (c >= c2) ? acc[j] * exp2f((float)(c - c2) * lg) : 0.f;
        }
        *(u32x2*)(Ps + c * 72 + 16 * ct2 + 4 * fq) = (u32x2){pk2(pv[0], pv[1]), pk2(pv[2], pv[3])};
    }
    __syncthreads();
    {
        const bf16x8 p0 = ldfrag(Ps, 72, 16 * ct, 0, lane), p1 = ldfrag(Ps, 72, 16 * ct, 32, lane);
        const float xi = exp2f((float)(c + 1) * lg);
        const bf16* RF = RST + (size_t)item * 4096;
        f32x4 o[4];
        float sm = 0.f;
#pragma unroll
        for (int et = 0; et < 4; ++et) {
            f32x4 ai = {0.f, 0.f, 0.f, 0.f}, ax = {0.f, 0.f, 0.f, 0.f};
            ai = mfma16(ldfrag(VT, 72, 16 * et, 0, lane), p0, ai);
            ai = mfma16(ldfrag(VT, 72, 16 * et, 32, lane), p1, ai);
            const bf16x8 r0 = *(const bf16x8*)(RF + ((et * 2 + 0) * 64 + lane) * 8);
            const bf16x8 r1 = *(const bf16x8*)(RF + ((et * 2 + 1) * 64 + lane) * 8);
            ax = mfma16(r0, q0, ax);
            ax = mfma16(r1, q1, ax);
            o[et] = ai + ax * xi;
            sm += (o[et].x + o[et].y) + (o[et].z + o[et].w);
        }
        const float mean = quad_sum(sm) * (1.f / 64.f);
        float sv = 0.f;
#pragma unroll
        for (int et = 0; et < 4; ++et) { o[et] = o[et] - mean; sv += o[et].x * o[et].x + o[et].y * o[et].y + o[et].z * o[et].z + o[et].w * o[et].w; }
        const float rs = rsqrtf(quad_sum(sv) * (1.f / 64.f) + 1e-5f);
        const int t = n * 64 + c;
#pragma unroll
        for (int et = 0; et < 4; ++et) {
            const int e = h * 64 + 16 * et + 4 * fq;
            const f32x4 g = *(const f32x4*)(rgn + e), b = *(const f32x4*)(rbn + e);
            const f32x4 gt = ld_bf4(PROJ + (size_t)t * NPROJ + 3840 + e);
            const f32x4 y = o[et] * rs * g + b;
            *(u32x2*)(MIX + (size_t)t * D + 768 + e) = (u32x2){pk2(y.x * siluf_(gt.x), y.y * siluf_(gt.y)), pk2(y.z * siluf_(gt.z), y.w * siluf_(gt.w))};
        }
    }
    __syncthreads();
}

template <int I, int N> struct SolveRow {
    static DEVI void run(float (&x)[N], const float* M) {
        float s = 0.f;
#pragma unroll
        for (int j4 = 0; j4 < (I + 3) / 4; ++j4) {
            const f32x4 m = *(const f32x4*)(M + I * N + 4 * j4);
            s += m.x * x[4 * j4] + m.y * x[4 * j4 + 1] + m.z * x[4 * j4 + 2] + m.w * x[4 * j4 + 3];
        }
        x[I] -= s;
        asm volatile("" : "+v"(x[I]) :: "memory");
        SolveRow<I + 1, N>::run(x, M);
    }
};
template <int N> struct SolveRow<N, N> { static DEVI void run(float (&)[N], const float*) {} };

DEVI void gdnA_item(const P& p, int item, char* smem) {
    const bf16* REC = (const bf16*)(p.ws + WS_RECG); const float* GSC = (const float*)(p.ws + WS_GSC) + ((size_t)(item >> 2) * 64 * 4 + (item & 3)) * 4;
    bf16* GP = (bf16*)(p.ws + WS_GP) + (size_t)item * 16384; float* GB = (float*)(p.ws + WS_GB) + (size_t)item * 16384;
    float* GD = (float*)(p.ws + WS_GD);
    bf16* GQ = (bf16*)(p.ws + WS_GQ) + (size_t)item * 8192; float* GO = (float*)(p.ws + WS_GO) + (size_t)item * 8192;
    bf16* Kb = (bf16*)smem; bf16* Qb = Kb + 64 * 136;
    bf16* WT = (bf16*)smem; bf16* UT = WT + 128 * 72;
    bf16* Vb = (bf16*)(smem + 36864);
    float* M = (float*)(smem + 36864);
    bf16* KdT = (bf16*)(smem + 36864);
    bf16* At = (bf16*)(smem + 55296);
    float* gcs = (float*)(smem + 64512); float* bts = gcs + 64; float* sws = gcs + 128; float* sks = gcs + 192;
    const int n = item >> 2, h = item & 3;
    int tid = VTID; asm volatile("" : "+v"(tid));
    const int lane = tid & 63, w = tid >> 6, fr = lane & 15, fq = lane >> 4;
    const bf16* rec0 = REC + ((size_t)(n * 64) * 4 + h) * 392;
    if (w == 0) {
        float x = GSC[lane * 16 + 2];
#pragma unroll
        for (int off = 1; off < 64; off <<= 1) { const float y = __shfl_up(x, off); if (lane >= off) x += y; }
        const float bt = GSC[lane * 16 + 1];
        gcs[lane] = x; bts[lane] = bt; sws[lane] = bt * __expf(x); sks[lane] = __expf(__shfl(x, 63) - x);
    }
    {
        u32x4 v[12];
#pragma unroll
        for (int i = 0; i < 12; ++i) { const int idx = tid + 256 * i, c = idx / 48, j = idx - c * 48; v[i] = *(const u32x4*)(rec0 + (size_t)c * 1568 + j * 8); }
#pragma unroll
        for (int i = 0; i < 12; ++i) {
            const int idx = tid + 256 * i, c = idx / 48, j = idx - c * 48, which = j >> 4;
            const int boff = (which == 0 ? 17408 : 0) + (which == 2 ? 36864 : 0);
            *(u32x4*)(smem + boff + (c * 136 + (j & 15) * 8) * 2) = v[i];
        }
    }
    __syncthreads();
    float x[64];
    unsigned kdp[16];
    {
        const int col = tid & 127;
        int sel_b = (tid < 128) ? 36864 : 0, sel_s = (tid < 128) ? 64 : 128;
        asm volatile("" : "+v"(sel_b), "+v"(sel_s));
        const bf16* srcb = (const bf16*)(smem + sel_b) + col;
        const float* scs = gcs + sel_s;
#pragma unroll
        for (int c = 0; c < 64; ++c) {
            x[c] = scs[c] * bf2f(srcb[c * 136]);
            if ((c & 7) == 7) asm volatile("" : "+v"(x[c]) :: "memory");
        }
        const int half = tid >> 7;
#pragma unroll
        for (int i = 0; i < 16; ++i) {
            const int c = 32 * half + 2 * i;
            kdp[i] = pk2(bf2f(Kb[c * 136 + col]) * sks[c], bf2f(Kb[(c + 1) * 136 + col]) * sks[c + 1]);
            if ((i & 3) == 3) asm volatile("" : "+v"(kdp[i]) :: "memory");
        }
        if (tid == 0) GD[item] = __expf(gcs[63]);
    }
    __syncthreads();
    const int ct = w;
    f32x4 accQ[8];
    {
        const int c = 16 * ct + fr;
        const float gcc = gcs[c];
        {
            bf16x8 ka[4];
#pragma unroll
            for (int s = 0; s < 4; ++s) ka[s] = ldfrag(Kb, 136, 16 * ct, 32 * s, lane);
#pragma unroll
            for (int ct2 = 0; ct2 < 4; ++ct2) {
                f32x4 acc = {0.f, 0.f, 0.f, 0.f};
#pragma unroll
                for (int s = 0; s < 4; ++s) acc = mfma16(ka[s], ldfrag(Kb, 136, 16 * ct2, 32 * s, lane), acc);
                const int c2 = 16 * ct2 + fr; const float g2 = gcs[c2];
#pragma unroll
                for (int j = 0; j < 4; ++j) {
                    const int cc = 16 * ct + 4 * fq + j;
                    M[cc * 64 + c2] = (cc > c2) ? bts[cc] * acc[j] * __expf(gcs[cc] - g2) : 0.f;
                }
            }
        }
        {
            bf16x8 qa[4];
#pragma unroll
            for (int s = 0; s < 4; ++s) qa[s] = ldfrag(Qb, 136, 16 * ct, 32 * s, lane);
#pragma unroll
            for (int ct2 = 0; ct2 < 4; ++ct2) {
                f32x4 acc = {0.f, 0.f, 0.f, 0.f};
#pragma unroll
                for (int s = 0; s < 4; ++s) acc = mfma16(ldfrag(Kb, 136, 16 * ct2, 32 * s, lane), qa[s], acc);
                float pv[4];
#pragma unroll
                for (int j = 0; j < 4; ++j) { const int c2 = 16 * ct2 + 4 * fq + j; pv[j] = (c >= c2) ? acc[j] * __expf(gcc - gcs[c2]) : 0.f; }
                *(u32x2*)(At + c * 72 + 16 * ct2 + 4 * fq) = (u32x2){pk2(pv[0], pv[1]), pk2(pv[2], pv[3])};
            }
        }
    }
    __syncthreads();
    {
        SolveRow<1, 64>::run(x, M);
        unsigned xp[32];
#pragma unroll
        for (int q = 0; q < 32; ++q) xp[q] = pk2(x[2 * q], x[2 * q + 1]);
        {
            const int c = 16 * ct + fr;
            const float eg = __expf(gcs[c]);
#pragma unroll
            for (int dt = 0; dt < 8; ++dt) accQ[dt] = ld_bf4(Qb + c * 136 + 16 * dt + 4 * fq) * (-eg);
        }
        __syncthreads();
        int sel_d = (tid < 128) ? 128 * 72 : 0;
        asm volatile("" : "+v"(sel_d));
        bf16* dst = WT + sel_d + (tid & 127) * 72;
#pragma unroll
        for (int q = 0; q < 8; ++q) *(u32x4*)(dst + 8 * q) = (u32x4){xp[4 * q], xp[4 * q + 1], xp[4 * q + 2], xp[4 * q + 3]};
    }
    __syncthreads();
    {
        const int d = tid & 127, half = tid >> 7;
#pragma unroll
        for (int q = 0; q < 4; ++q) *(u32x4*)(KdT + d * 72 + 32 * half + 8 * q) = (u32x4){kdp[4 * q], kdp[4 * q + 1], kdp[4 * q + 2], kdp[4 * q + 3]};
    }
    __syncthreads();
    {
#pragma unroll 1
        for (int mi = 0; mi < 2; ++mi) {
            const int mt = 2 * w + mi;
            const bf16x8 kd0 = ldfrag(KdT, 72, 16 * mt, 0, lane), kd1 = ldfrag(KdT, 72, 16 * mt, 32, lane);
#pragma unroll
            for (int sp = 0; sp < 4; ++sp) {
                f32x4 a0 = {0.f, 0.f, 0.f, 0.f}, a1 = {0.f, 0.f, 0.f, 0.f};
                a0 = mfma16(ldfrag(WT, 72, 32 * sp, 0, lane), kd0, a0); a0 = mfma16(ldfrag(WT, 72, 32 * sp, 32, lane), kd1, a0);
                a1 = mfma16(ldfrag(WT, 72, 32 * sp + 16, 0, lane), kd0, a1); a1 = mfma16(ldfrag(WT, 72, 32 * sp + 16, 32, lane), kd1, a1);
                *(u32x4*)(GP + ((mt * 4 + sp) * 64 + lane) * 8) = (u32x4){pk2(-a0.x, -a0.y), pk2(-a0.z, -a0.w), pk2(-a1.x, -a1.y), pk2(-a1.z, -a1.w)};
            }
#pragma unroll
            for (int nt = 0; nt < 8; ++nt) {
                f32x4 a = {0.f, 0.f, 0.f, 0.f};
                a = mfma16(kd0, ldfrag(UT, 72, 16 * nt, 0, lane), a); a = mfma16(kd1, ldfrag(UT, 72, 16 * nt, 32, lane), a);
                *(f32x4*)(GB + ((nt * 8 + mt) * 64 + lane) * 4) = a;
            }
        }
        const bf16x8 at0 = ldfrag(At, 72, 16 * ct, 0, lane), at1 = ldfrag(At, 72, 16 * ct, 32, lane);
#pragma unroll
        for (int sp = 0; sp < 4; ++sp) {
            f32x4 a0 = accQ[2 * sp], a1 = accQ[2 * sp + 1];
            a0 = mfma16(ldfrag(WT, 72, 32 * sp, 0, lane), at0, a0); a0 = mfma16(ldfrag(WT, 72, 32 * sp, 32, lane), at1, a0);
            a1 = mfma16(ldfrag(WT, 72, 32 * sp + 16, 0, lane), at0, a1); a1 = mfma16(ldfrag(WT, 72, 32 * sp + 16, 32, lane), at1, a1);
            *(u32x4*)(GQ + ((ct * 4 + sp) * 64 + lane) * 8) = (u32x4){pk2(-a0.x, -a0.y), pk2(-a0.z, -a0.w), pk2(-a1.x, -a1.y), pk2(-a1.z, -a1.w)};
        }
#pragma unroll
        for (int et = 0; et < 8; ++et) {
            f32x4 a = {0.f, 0.f, 0.f, 0.f};
            a = mfma16(ldfrag(UT, 72, 16 * et, 0, lane), at0, a); a = mfma16(ldfrag(UT, 72, 16 * et, 32, lane), at1, a);
            *(f32x4*)(GO + ((ct * 8 + et) * 64 + lane) * 4) = a;
        }
    }
    __syncthreads();
}

DEVI bf16x8 pack_frag(const f32x4& a, const f32x4& b) {
    const u32x4 v = {pk2(a.x, a.y), pk2(a.z, a.w), pk2(b.x, b.y), pk2(b.z, b.w)};
    return __builtin_bit_cast(bf16x8, v);
}
DEVI void gdnL1_item(const P& p, int item, char* smem) {
    const bf16* GP = (const bf16*)(p.ws + WS_GP); const float* GB = (const float*)(p.ws + WS_GB); const float* GD = (const float*)(p.ws + WS_GD);
    const int half = item & 1, kind = (item >> 1) & 1, g = (item >> 2) & 15, h = item >> 6;
    const int tid = VTID, lane = tid & 63, ew = half * 4 + (tid >> 6), fr = lane & 15, fq = lane >> 4;
    const int n0 = g * 16;
#define L1_DMA(n) do { const bf16* _s = GP + ((size_t)(n) * 4 + h) * 16384 + tid * 8; char* _d = smem + ((n) & 1) * 32768 + tid * 16; \
        _Pragma("unroll") for (int _i = 0; _i < 8; ++_i) __builtin_amdgcn_global_load_lds((const unsigned*)(_s + _i * 2048), (unsigned*)(_d + _i * 4096), 16, 0, 0); } while (0)
    f32x4 acc[8];
    L1_DMA(n0);
    if (kind == 0) {
        bf16* GS = (bf16*)(p.ws + WS_GS);
#pragma unroll
        for (int m = 0; m < 8; ++m) acc[m] = (f32x4){0.f, 0.f, 0.f, 0.f};
        f32x4 bcur[8], bnxt[8]; float dcur, dnxt = 0.f;
        {
            const float* Bn = GB + ((size_t)n0 * 4 + h) * 16384 + (ew * 8 * 64 + lane) * 4;
#pragma unroll
            for (int m = 0; m < 8; ++m) bcur[m] = *(const f32x4*)(Bn + m * 256);
            dcur = GD[(size_t)n0 * 4 + h];
        }
#pragma unroll 1
        for (int n = n0; n < n0 + 16; ++n) {
            const size_t it = (size_t)n * 4 + h;
            asm volatile("s_waitcnt vmcnt(0)" ::: "memory");
            __syncthreads();
            if (n + 1 < n0 + 16) {
                L1_DMA(n + 1);
                const float* Bn = GB + (it + 4) * 16384 + (ew * 8 * 64 + lane) * 4;
#pragma unroll
                for (int m = 0; m < 8; ++m) bnxt[m] = *(const f32x4*)(Bn + m * 256);
                dnxt = GD[it + 4];
            }
            const char* ring = smem + (n & 1) * 32768 + lane * 16;
            bf16x8 sf[4];
#pragma unroll
            for (int s = 0; s < 4; ++s) {
                sf[s] = pack_frag(acc[2 * s], acc[2 * s + 1]);
                *(bf16x8*)(GS + it * 16384 + ((ew * 4 + s) * 64 + lane) * 8) = sf[s];
            }
#pragma unroll
            for (int m = 0; m < 8; ++m) {
                f32x4 a = acc[m] * dcur + bcur[m];
#pragma unroll
                for (int s = 0; s < 4; ++s) a = mfma16(*(const bf16x8*)(ring + (m * 4 + s) * 1024), sf[s], a);
                acc[m] = a;
            }
#pragma unroll
            for (int m = 0; m < 8; ++m) bcur[m] = bnxt[m];
            dcur = dnxt;
        }
        float* E0 = (float*)(p.ws + WS_GE0) + (size_t)(h * 16 + g) * 16384 + (ew * 8 * 64 + lane) * 4;
#pragma unroll
        for (int m = 0; m < 8; ++m) *(f32x4*)(E0 + m * 256) = acc[m];
    } else {
        const bf16* GQ = (const bf16*)(p.ws + WS_GQ); bf16* GR = (bf16*)(p.ws + WS_GR);
#pragma unroll
        for (int m = 0; m < 8; ++m)
#pragma unroll
            for (int j = 0; j < 4; ++j) acc[m][j] = (m == ew && 4 * fq + j == fr) ? 1.f : 0.f;
#pragma unroll 1
        for (int n = n0; n < n0 + 16; ++n) {
            const size_t it = (size_t)n * 4 + h;
            asm volatile("s_waitcnt vmcnt(0)" ::: "memory");
            __syncthreads();
            if (n + 1 < n0 + 16) L1_DMA(n + 1);
            bf16x8 qf[16];
#pragma unroll
            for (int i = 0; i < 16; ++i) qf[i] = *(const bf16x8*)(GQ + it * 8192 + (i * 64 + lane) * 8);
            const float dn = GD[it];
            const char* ring = smem + (n & 1) * 32768 + lane * 16;
            bf16x8 tf[4];
#pragma unroll
            for (int s = 0; s < 4; ++s) tf[s] = pack_frag(acc[2 * s], acc[2 * s + 1]);
#pragma unroll
            for (int m = 0; m < 8; ++m) {
                f32x4 a = acc[m] * dn;
#pragma unroll
                for (int s = 0; s < 4; ++s) a = mfma16(*(const bf16x8*)(ring + (m * 4 + s) * 1024), tf[s], a);
                acc[m] = a;
            }
#pragma unroll
            for (int tt = 0; tt < 4; ++tt) {
                f32x4 r = {0.f, 0.f, 0.f, 0.f};
#pragma unroll
                for (int s = 0; s < 4; ++s) r = mfma16(tf[s], qf[tt * 4 + s], r);
                *(u32x2*)(GR + it * 8192 + ((tt * 4 + (ew >> 1)) * 64 + lane) * 8 + 4 * (ew & 1)) = (u32x2){pk2(r.x, r.y), pk2(r.z, r.w)};
            }
        }
        bf16* TE = (bf16*)(p.ws + WS_GTE) + (size_t)(h * 16 + g) * 16384;
        const int s_ = ew >> 1, jj = 4 * (ew & 1) + (fr & 3), lg = fr >> 2;
#pragma unroll
        for (int m = 0; m < 8; ++m)
#pragma unroll
            for (int j = 0; j < 4; ++j) TE[((m * 4 + s_) * 64 + (4 * fq + j) + 16 * lg) * 8 + jj] = (bf16)f2bf(acc[m][j]);
    }
    asm volatile("s_waitcnt vmcnt(0)" ::: "memory");
    __syncthreads();
#undef L1_DMA
}
DEVI void gdnL2_item(const P& p, int item, char* smem) {
    const bf16* TE = (const bf16*)(p.ws + WS_GTE); const float* E0 = (const float*)(p.ws + WS_GE0); bf16* SG = (bf16*)(p.ws + WS_GSG);
    const int h = item >> 1, tid = VTID, lane = tid & 63, ew = (item & 1) * 4 + (tid >> 6);
#define L2_DMA(g) do { const bf16* _s = TE + ((size_t)h * 16 + (g)) * 16384 + tid * 8; char* _d = smem + ((g) & 1) * 32768 + tid * 16; \
        _Pragma("unroll") for (int _i = 0; _i < 8; ++_i) __builtin_amdgcn_global_load_lds((const unsigned*)(_s + _i * 2048), (unsigned*)(_d + _i * 4096), 16, 0, 0); } while (0)
    f32x4 acc[8];
#pragma unroll
    for (int m = 0; m < 8; ++m) acc[m] = (f32x4){0.f, 0.f, 0.f, 0.f};
    L2_DMA(0);
    f32x4 bcur[8], bnxt[8];
    {
        const float* En = E0 + (size_t)h * 16 * 16384 + (ew * 8 * 64 + lane) * 4;
#pragma unroll
        for (int m = 0; m < 8; ++m) bcur[m] = *(const f32x4*)(En + m * 256);
    }
#pragma unroll 1
    for (int g = 0; g < 16; ++g) {
        const size_t hg = (size_t)h * 16 + g;
        asm volatile("s_waitcnt vmcnt(0)" ::: "memory");
        __syncthreads();
        if (g + 1 < 16) {
            L2_DMA(g + 1);
            const float* En = E0 + (hg + 1) * 16384 + (ew * 8 * 64 + lane) * 4;
#pragma unroll
            for (int m = 0; m < 8; ++m) bnxt[m] = *(const f32x4*)(En + m * 256);
        }
        const char* ring = smem + (g & 1) * 32768 + lane * 16;
        bf16x8 sf[4];
#pragma unroll
        for (int s = 0; s < 4; ++s) {
            sf[s] = pack_frag(acc[2 * s], acc[2 * s + 1]);
            *(bf16x8*)(SG + hg * 16384 + ((ew * 4 + s) * 64 + lane) * 8) = sf[s];
        }
#pragma unroll
        for (int m = 0; m < 8; ++m) {
            f32x4 a = bcur[m];
#pragma unroll
            for (int s = 0; s < 4; ++s) a = mfma16(*(const bf16x8*)(ring + (m * 4 + s) * 1024), sf[s], a);
            acc[m] = a;
        }
#pragma unroll
        for (int m = 0; m < 8; ++m) bcur[m] = bnxt[m];
    }
    asm volatile("s_waitcnt vmcnt(0)" ::: "memory");
    __syncthreads();
#undef L2_DMA
}

DEVI void gdnC_item(const P& p, int item, int l) {
    const bf16* GQ = (const bf16*)(p.ws + WS_GQ) + (size_t)item * 8192; const float* GO = (const float*)(p.ws + WS_GO) + (size_t)item * 8192;
    const bf16* GS = (const bf16*)(p.ws + WS_GS) + (size_t)item * 16384;
    const bf16* PROJ = (const bf16*)(p.ws + WS_PROJ); bf16* MIX = (bf16*)(p.ws + WS_MIX);
    const float* gn = p.in[24] + l * 128;
    const int n = item >> 2, h = item & 3;
    const int lane = VTID & 63, ct = VTID >> 6, fr = lane & 15, fq = lane >> 4;
    const bf16* GR = (const bf16*)(p.ws + WS_GR) + (size_t)item * 8192;
    const bf16* SG = (const bf16*)(p.ws + WS_GSG) + (size_t)(h * 16 + (n >> 4)) * 16384;
    bf16x8 qf[4], rf[4];
#pragma unroll
    for (int s = 0; s < 4; ++s) { qf[s] = *(const bf16x8*)(GQ + ((ct * 4 + s) * 64 + lane) * 8); rf[s] = *(const bf16x8*)(GR + ((ct * 4 + s) * 64 + lane) * 8); }
    const int t = n * 64 + 16 * ct + fr;
    f32x4 a[8];
    float ss = 0.f;
#pragma unroll
    for (int et = 0; et < 8; ++et) {
        f32x4 acc = *(const f32x4*)(GO + ((ct * 8 + et) * 64 + lane) * 4);
#pragma unroll
        for (int s = 0; s < 4; ++s) acc = mfma16(*(const bf16x8*)(GS + ((et * 4 + s) * 64 + lane) * 8), qf[s], acc);
#pragma unroll
        for (int s = 0; s < 4; ++s) acc = mfma16(*(const bf16x8*)(SG + ((et * 4 + s) * 64 + lane) * 8), rf[s], acc);
        a[et] = acc;
        ss += acc.x * acc.x + acc.y * acc.y + acc.z * acc.z + acc.w * acc.w;
    }
    const float rs = rsqrtf(quad_sum(ss) * (1.f / 128.f) + 1e-6f);
#pragma unroll
    for (int et = 0; et < 8; ++et) {
        const int e = 16 * et + 4 * fq;
        const f32x4 z = ld_bf4(PROJ + (size_t)t * NPROJ + 2560 + h * 128 + e);
        const f32x4 g = *(const f32x4*)(gn + e);
        const f32x4 o = a[et] * rs * g;
        *(u32x2*)(MIX + (size_t)t * D + 256 + h * 128 + e) = (u32x2){pk2(o.x * siluf_(z.x), o.y * siluf_(z.y)), pk2(o.z * siluf_(z.z), o.w * siluf_(z.w))};
    }
}

DEVI void rwkA_item(const P& p, int item, char* smem) {
    const bf16* REC = (const bf16*)(p.ws + WS_RECR); const float* WDEC = (const float*)(p.ws + WS_WDEC);
    bf16* WP = (bf16*)(p.ws + WS_WP) + (size_t)item * 4096; float* WC = (float*)(p.ws + WS_WC) + (size_t)item * 4096;
    float* WD = (float*)(p.ws + WS_WD) + (size_t)item * 64;
    bf16* WQ = (bf16*)(p.ws + WS_WQ) + (size_t)item * 2048; float* WY = (float*)(p.ws + WS_WY) + (size_t)item * 2048;
    bf16* At_ = (bf16*)smem; bf16* Rt = At_ + 32 * 72; bf16* Bt = Rt + 32 * 72; bf16* Kt = Bt + 32 * 72;
    float* ZT = (float*)(smem + 9216);
    bf16* BhT = (bf16*)(smem + 18432); bf16* KhT = BhT + 64 * 40; bf16* VT = KhT + 64 * 40; bf16* AhT = VT + 64 * 40; bf16* UhT = AhT + 64 * 40;
    float* M = (float*)(smem + 44032);
    bf16* Aak = (bf16*)(smem + 48128); bf16* Arb = Aak + 32 * 40; bf16* Ark = Arb + 32 * 40;
    float* tot = (float*)(smem + 55808);
    const int n = item >> 2, h = item & 3;
    int tid = VTID; asm volatile("" : "+v"(tid));
    const int lane = tid & 63, w = tid >> 6, fr = lane & 15, fq = lane >> 4;
    {
        const int d = lane;
        const bf16* rec = REC + ((size_t)(n * 32 + 8 * w) * 4 + h) * 384 + d;
        const float* dcy = WDEC + (size_t)(n * 32 + 8 * w) * 256 + h * 64 + d;
        float lw[8], lg[8];
        float run = 0.f;
#pragma unroll
        for (int i = 0; i < 8; ++i) { lg[i] = __logf(dcy[i * 256]); run += lg[i]; lw[i] = run; }
        tot[w * 64 + d] = run;
        __syncthreads();
        float off = 0.f, total = 0.f;
#pragma unroll
        for (int q = 0; q < 4; ++q) { const float tq = tot[q * 64 + d]; total += tq; off += (q < w) ? tq : 0.f; }
        unsigned bh[4], kh[4], vv[4];
        float pb = 0.f, pk = 0.f, pv = 0.f;
#pragma unroll
        for (int i = 0; i < 8; ++i) {
            const bf16* r = rec + (size_t)i * 1536;
            const float a = bf2f(r[0]), b = bf2f(r[128]), k = bf2f(r[192]), rr = bf2f(r[256]), v = bf2f(r[320]);
            const float lc = off + lw[i];
            const float cw = __expf(lc), cwm1 = __expf(lc - lg[i]), inv = __expf(-lc), rat = __expf(total - lc);
            const int t = 8 * w + i;
            At_[t * 72 + d] = (bf16)f2bf(a * cwm1); Rt[t * 72 + d] = (bf16)f2bf(rr * cw);
            Bt[t * 72 + d] = (bf16)f2bf(b * inv); Kt[t * 72 + d] = (bf16)f2bf(k * inv);
            if (i & 1) { bh[i >> 1] = pk2(pb, b * rat); kh[i >> 1] = pk2(pk, k * rat); vv[i >> 1] = pk2(pv, v); }
            else { pb = b * rat; pk = k * rat; pv = v; }
        }
        *(u32x4*)(BhT + d * 40 + 8 * w) = (u32x4){bh[0], bh[1], bh[2], bh[3]};
        *(u32x4*)(KhT + d * 40 + 8 * w) = (u32x4){kh[0], kh[1], kh[2], kh[3]};
        *(u32x4*)(VT + d * 40 + 8 * w) = (u32x4){vv[0], vv[1], vv[2], vv[3]};
        if (w == 0) WD[d] = __expf(total);
    }
    __syncthreads();
    {
        int offA = (w == 0) ? 0 : (w == 1 ? 3 : (w == 2 ? 2 : 3));
        int offB = (w == 0) ? 2 : (w == 1 ? 0 : 1);
        asm volatile("" : "+v"(offA), "+v"(offB));
        const bf16* As = At_ + offA * (32 * 72); const bf16* Bs = At_ + offB * (32 * 72);
#pragma unroll
        for (int ta = 0; ta < 2; ++ta) {
            const bf16x8 a0 = ldfrag(As, 72, 16 * ta, 0, lane), a1 = ldfrag(As, 72, 16 * ta, 32, lane);
#pragma unroll
            for (int tb = 0; tb < 2; ++tb) {
                f32x4 acc = {0.f, 0.f, 0.f, 0.f};
                acc = mfma16(a0, ldfrag(Bs, 72, 16 * tb, 0, lane), acc);
                acc = mfma16(a1, ldfrag(Bs, 72, 16 * tb, 32, lane), acc);
                if (w == 0) {
                    const int s_ = 16 * tb + fr;
#pragma unroll
                    for (int j = 0; j < 4; ++j) { const int t = 16 * ta + 4 * fq + j; M[t * 32 + s_] = (t > s_) ? -acc[j] : 0.f; }
                } else {
                    const int t = 16 * tb + fr;
                    float pv4[4];
#pragma unroll
                    for (int j = 0; j < 4; ++j) { const int s_ = 16 * ta + 4 * fq + j; pv4[j] = ((w == 1) ? (t > s_) : (t >= s_)) ? acc[j] : 0.f; }
                    int offD = w - 1; asm volatile("" : "+v"(offD));
                    *(u32x2*)(Aak + offD * (32 * 40) + t * 40 + 16 * ta + 4 * fq) = (u32x2){pk2(pv4[0], pv4[1]), pk2(pv4[2], pv4[3])};
                }
            }
        }
    }
    __syncthreads();
    {
        const int et = w;
        const bf16x8 vf = ldfrag(VT, 40, 16 * et, 0, lane);
#pragma unroll
        for (int tt = 0; tt < 2; ++tt) {
            f32x4 acc = {0.f, 0.f, 0.f, 0.f};
            acc = mfma16(ldfrag(Aak, 40, 16 * tt, 0, lane), vf, acc);
            *(f32x4*)(ZT + (16 * et + fr) * 36 + 16 * tt + 4 * fq) = acc;
        }
    }
    __syncthreads();
    if (tid < 128) {
        float x[32];
        if (tid < 64) {
#pragma unroll
            for (int t = 0; t < 32; ++t) x[t] = bf2f(At_[t * 72 + tid]);
        } else {
#pragma unroll
            for (int q = 0; q < 8; ++q) { const f32x4 z = *(const f32x4*)(ZT + (tid - 64) * 36 + 4 * q); x[4 * q] = z.x; x[4 * q + 1] = z.y; x[4 * q + 2] = z.z; x[4 * q + 3] = z.w; }
        }
        SolveRow<1, 32>::run(x, M);
        bf16* dst = AhT + tid * 40;
#pragma unroll
        for (int q = 0; q < 4; ++q)
            *(u32x4*)(dst + 8 * q) = (u32x4){pk2(x[8 * q], x[8 * q + 1]), pk2(x[8 * q + 2], x[8 * q + 3]), pk2(x[8 * q + 4], x[8 * q + 5]), pk2(x[8 * q + 6], x[8 * q + 7])};
    }
    __syncthreads();
    {
        const int mt = w;
        const bf16x8 bh = ldfrag(BhT, 40, 16 * mt, 0, lane), kh = ldfrag(KhT, 40, 16 * mt, 0, lane);
#pragma unroll
        for (int sp = 0; sp < 2; ++sp) {
            f32x4 a0 = {0.f, 0.f, 0.f, 0.f}, a1 = {0.f, 0.f, 0.f, 0.f};
            a0 = mfma16(ldfrag(AhT, 40, 32 * sp, 0, lane), bh, a0);
            a1 = mfma16(ldfrag(AhT, 40, 32 * sp + 16, 0, lane), bh, a1);
            *(u32x4*)(WP + ((mt * 2 + sp) * 64 + lane) * 8) = (u32x4){pk2(a0.x, a0.y), pk2(a0.z, a0.w), pk2(a1.x, a1.y), pk2(a1.z, a1.w)};
        }
#pragma unroll
        for (int nt = 0; nt < 4; ++nt) {
            f32x4 a = {0.f, 0.f, 0.f, 0.f};
            a = mfma16(bh, ldfrag(UhT, 40, 16 * nt, 0, lane), a);
            a = mfma16(kh, ldfrag(VT, 40, 16 * nt, 0, lane), a);
            *(f32x4*)(WC + ((nt * 4 + mt) * 64 + lane) * 4) = a;
        }
        {
            const int ct = w & 1, sp = w >> 1, t = 16 * ct + fr;
            const bf16x8 ar = ldfrag(Arb, 40, 16 * ct, 0, lane);
            f32x4 a0 = ld_bf4(Rt + t * 72 + 32 * sp + 4 * fq), a1 = ld_bf4(Rt + t * 72 + 32 * sp + 16 + 4 * fq);
            a0 = mfma16(ldfrag(AhT, 40, 32 * sp, 0, lane), ar, a0);
            a1 = mfma16(ldfrag(AhT, 40, 32 * sp + 16, 0, lane), ar, a1);
            *(u32x4*)(WQ + ((ct * 2 + sp) * 64 + lane) * 8) = (u32x4){pk2(a0.x, a0.y), pk2(a0.z, a0.w), pk2(a1.x, a1.y), pk2(a1.z, a1.w)};
        }
        {
            const int et = w;
            const bf16x8 uf = ldfrag(UhT, 40, 16 * et, 0, lane), vf = ldfrag(VT, 40, 16 * et, 0, lane);
#pragma unroll
            for (int ct = 0; ct < 2; ++ct) {
                f32x4 a = {0.f, 0.f, 0.f, 0.f};
                a = mfma16(uf, ldfrag(Arb, 40, 16 * ct, 0, lane), a);
                a = mfma16(vf, ldfrag(Ark, 40, 16 * ct, 0, lane), a);
                *(f32x4*)(WY + ((ct * 4 + et) * 64 + lane) * 4) = a;
            }
        }
    }
    __syncthreads();
}

struct RwkStep { bf16x8 pf[8]; f32x4 cf[4]; f32x4 dv[4]; };
DEVI void rwk_load(RwkStep& r, const bf16* WP, const float* WC, const float* WD, size_t it, int ew, int lane) {
#pragma unroll
    for (int i = 0; i < 8; ++i) r.pf[i] = *(const bf16x8*)(WP + it * 4096 + (i * 64 + lane) * 8);
#pragma unroll
    for (int m = 0; m < 4; ++m) r.cf[m] = *(const f32x4*)(WC + it * 4096 + ((ew * 4 + m) * 64 + lane) * 4);
#pragma unroll
    for (int m = 0; m < 4; ++m) r.dv[m] = *(const f32x4*)(WD + it * 64 + 16 * m + 4 * (lane >> 4));
}
DEVI void rwk_step(const RwkStep& r, f32x4 (&acc)[4], bf16* WSF, size_t it, int ew, int lane) {
    bf16x8 sf[2];
#pragma unroll
    for (int s = 0; s < 2; ++s) {
        const u32x4 v = {pk2(acc[2 * s].x, acc[2 * s].y), pk2(acc[2 * s].z, acc[2 * s].w), pk2(acc[2 * s + 1].x, acc[2 * s + 1].y), pk2(acc[2 * s + 1].z, acc[2 * s + 1].w)};
        *(u32x4*)(WSF + it * 4096 + ((ew * 2 + s) * 64 + lane) * 8) = v;
        sf[s] = __builtin_bit_cast(bf16x8, v);
    }
#pragma unroll
    for (int m = 0; m < 4; ++m) {
        f32x4 a = acc[m] * r.dv[m] + r.cf[m];
        a = mfma16(r.pf[m * 2], sf[0], a);
        a = mfma16(r.pf[m * 2 + 1], sf[1], a);
        acc[m] = a;
    }
}
DEVI void rwkL1_item(const P& p, int item) {
    const bf16* WP = (const bf16*)(p.ws + WS_WP); const float* WC = (const float*)(p.ws + WS_WC); const float* WD = (const float*)(p.ws + WS_WD);
    const int kind = item & 1, g = (item >> 1) & 15, h = item >> 5;
    const int lane = VTID & 63, ew = VTID >> 6, fr = lane & 15, fq = lane >> 4;
    f32x4 acc[4];
    if (kind == 0) {
        bf16* WSF = (bf16*)(p.ws + WS_WS);
#pragma unroll
        for (int m = 0; m < 4; ++m) acc[m] = (f32x4){0.f, 0.f, 0.f, 0.f};
        RwkStep A, B;
        const int n0 = g * 32;
        rwk_load(A, WP, WC, WD, (size_t)n0 * 4 + h, ew, lane);
#pragma unroll 1
        for (int n = n0; n < n0 + 32; n += 2) {
            rwk_load(B, WP, WC, WD, (size_t)(n + 1) * 4 + h, ew, lane);
            asm volatile("" ::: "memory");
            rwk_step(A, acc, WSF, (size_t)n * 4 + h, ew, lane);
            rwk_load(A, WP, WC, WD, (size_t)((n + 2 < n0 + 32) ? n + 2 : n) * 4 + h, ew, lane);
            asm volatile("" ::: "memory");
            rwk_step(B, acc, WSF, (size_t)(n + 1) * 4 + h, ew, lane);
        }
        float* E0 = (float*)(p.ws + WS_WE0) + (size_t)(h * 16 + g) * 4096 + (ew * 4 * 64 + lane) * 4;
#pragma unroll
        for (int m = 0; m < 4; ++m) *(f32x4*)(E0 + m * 256) = acc[m];
    } else {
        const bf16* WQ = (const bf16*)(p.ws + WS_WQ); bf16* WR = (bf16*)(p.ws + WS_WR);
#pragma unroll
        for (int m = 0; m < 4; ++m)
#pragma unroll
            for (int j = 0; j < 4; ++j) acc[m][j] = (m == ew && 4 * fq + j == fr) ? 1.f : 0.f;
#pragma unroll 1
        for (int n = g * 32; n < g * 32 + 32; ++n) {
            const size_t it = (size_t)n * 4 + h;
            bf16x8 pf[8], qf[4]; f32x4 dv[4];
#pragma unroll
            for (int i = 0; i < 8; ++i) pf[i] = *(const bf16x8*)(WP + it * 4096 + (i * 64 + lane) * 8);
#pragma unroll
            for (int i = 0; i < 4; ++i) qf[i] = *(const bf16x8*)(WQ + it * 2048 + (i * 64 + lane) * 8);
#pragma unroll
            for (int m = 0; m < 4; ++m) dv[m] = *(const f32x4*)(WD + it * 64 + 16 * m + 4 * fq);
            asm volatile("" ::: "memory");
            bf16x8 tf[2];
#pragma unroll
            for (int s = 0; s < 2; ++s) tf[s] = pack_frag(acc[2 * s], acc[2 * s + 1]);
#pragma unroll
            for (int tt = 0; tt < 2; ++tt) {
                f32x4 r = {0.f, 0.f, 0.f, 0.f};
                r = mfma16(tf[0], qf[tt * 2], r); r = mfma16(tf[1], qf[tt * 2 + 1], r);
                *(u32x2*)(WR + it * 2048 + ((tt * 2 + (ew >> 1)) * 64 + lane) * 8 + 4 * (ew & 1)) = (u32x2){pk2(r.x, r.y), pk2(r.z, r.w)};
            }
#pragma unroll
            for (int m = 0; m < 4; ++m) {
                f32x4 a = acc[m] * dv[m];
                a = mfma16(pf[m * 2], tf[0], a); a = mfma16(pf[m * 2 + 1], tf[1], a);
                acc[m] = a;
            }
        }
        bf16* TE = (bf16*)(p.ws + WS_WTE) + (size_t)(h * 16 + g) * 4096;
        const int s_ = ew >> 1, jj = 4 * (ew & 1) + (fr & 3), lg = fr >> 2;
#pragma unroll
        for (int m = 0; m < 4; ++m)
#pragma unroll
            for (int j = 0; j < 4; ++j) TE[((m * 2 + s_) * 64 + (4 * fq + j) + 16 * lg) * 8 + jj] = (bf16)f2bf(acc[m][j]);
    }
}
DEVI void rwkL2_item(const P& p, int h) {
    const bf16* TE = (const bf16*)(p.ws + WS_WTE); const float* E0 = (const float*)(p.ws + WS_WE0); bf16* SG = (bf16*)(p.ws + WS_WSG);
    const int lane = VTID & 63, ew = VTID >> 6;
    f32x4 acc[4];
#pragma unroll
    for (int m = 0; m < 4; ++m) acc[m] = (f32x4){0.f, 0.f, 0.f, 0.f};
#pragma unroll 1
    for (int g = 0; g < 16; ++g) {
        const size_t hg = (size_t)h * 16 + g;
        bf16x8 pf[8]; f32x4 bfr[4];
#pragma unroll
        for (int i = 0; i < 8; ++i) pf[i] = *(const bf16x8*)(TE + hg * 4096 + (i * 64 + lane) * 8);
#pragma unroll
        for (int m = 0; m < 4; ++m) bfr[m] = *(const f32x4*)(E0 + hg * 4096 + ((ew * 4 + m) * 64 + lane) * 4);
        asm volatile("" ::: "memory");
        bf16x8 sf[2];
#pragma unroll
        for (int s = 0; s < 2; ++s) {
            sf[s] = pack_frag(acc[2 * s], acc[2 * s + 1]);
            *(bf16x8*)(SG + hg * 4096 + ((ew * 2 + s) * 64 + lane) * 8) = sf[s];
        }
#pragma unroll
        for (int m = 0; m < 4; ++m) {
            f32x4 a = bfr[m];
            a = mfma16(pf[m * 2], sf[0], a); a = mfma16(pf[m * 2 + 1], sf[1], a);
            acc[m] = a;
        }
    }
}

DEVI void rwkC_item(const P& p, int n, int l) {
    const int lane = VTID & 63, h = VTID >> 6, fr = lane & 15, fq = lane >> 4;
    const size_t it = (size_t)n * 4 + h;
    const bf16* WQ = (const bf16*)(p.ws + WS_WQ) + it * 2048; const float* WY = (const float*)(p.ws + WS_WY) + it * 2048;
    const bf16* WSF = (const bf16*)(p.ws + WS_WS) + it * 4096;
    const bf16* WR = (const bf16*)(p.ws + WS_WR) + it * 2048; const bf16* WSG = (const bf16*)(p.ws + WS_WSG) + (size_t)(h * 16 + (n >> 5)) * 4096;
    const bf16* RECR = (const bf16*)(p.ws + WS_RECR); const float* GB = (const float*)(p.ws + WS_G); const float* BON = (const float*)(p.ws + WS_BON);
    bf16* MIX = (bf16*)(p.ws + WS_MIX);
    const float* ln_g = p.in[17] + l * 256 + h * 64; const float* ln_b = p.in[18] + l * 256 + h * 64;
#pragma unroll
    for (int ct = 0; ct < 2; ++ct) {
        const bf16x8 q0 = *(const bf16x8*)(WQ + ((ct * 2 + 0) * 64 + lane) * 8), q1 = *(const bf16x8*)(WQ + ((ct * 2 + 1) * 64 + lane) * 8);
        const bf16x8 r0 = *(const bf16x8*)(WR + ((ct * 2 + 0) * 64 + lane) * 8), r1 = *(const bf16x8*)(WR + ((ct * 2 + 1) * 64 + lane) * 8);
        const int t = n * 32 + 16 * ct + fr;
        f32x4 a[4];
        float sm = 0.f;
#pragma unroll
        for (int et = 0; et < 4; ++et) {
            f32x4 acc = *(const f32x4*)(WY + ((ct * 4 + et) * 64 + lane) * 4);
            acc = mfma16(*(const bf16x8*)(WSF + ((et * 2 + 0) * 64 + lane) * 8), q0, acc);
            acc = mfma16(*(const bf16x8*)(WSF + ((et * 2 + 1) * 64 + lane) * 8), q1, acc);
            acc = mfma16(*(const bf16x8*)(WSG + ((et * 2 + 0) * 64 + lane) * 8), r0, acc);
            acc = mfma16(*(const bf16x8*)(WSG + ((et * 2 + 1) * 64 + lane) * 8), r1, acc);
            a[et] = acc; sm += (acc.x + acc.y) + (acc.z + acc.w);
        }
        const float mean = quad_sum(sm) * (1.f / 64.f);
        float sv = 0.f;
#pragma unroll
        for (int et = 0; et < 4; ++et) { a[et] = a[et] - mean; sv += a[et].x * a[et].x + a[et].y * a[et].y + a[et].z * a[et].z + a[et].w * a[et].w; }
        const float rs = rsqrtf(quad_sum(sv) * (1.f / 64.f) + 64e-5f);
        const float bon = BON[(size_t)t * 4 + h];
#pragma unroll
        for (int et = 0; et < 4; ++et) {
            const int e = 16 * et + 4 * fq;
            const f32x4 g = *(const f32x4*)(ln_g + e), b = *(const f32x4*)(ln_b + e);
            const f32x4 v = ld_bf4(RECR + ((size_t)t * 4 + h) * 384 + 320 + e);
            const f32x4 gate = *(const f32x4*)(GB + (size_t)t * 256 + h * 64 + e);
            const f32x4 o = (a[et] * rs * g + b + v * bon) * gate;
            *(u32x2*)(MIX + (size_t)t * D + h * 64 + e) = (u32x2){pk2(o.x, o.y), pk2(o.z, o.w)};
        }
    }
}

DEVI void phase_scanL1(const P& p, char* smem) {
    for (int item = VBID; item < 448; item += VNB) {
        if (item < 256) gdnL1_item(p, item, smem);
        else if (item < 384) rwkL1_item(p, item - 256);
        else retS_item(p, item - 384);
    }
}
DEVI void retC_item(const P& p, int item, int l, char* smem);
DEVI void phase_scanL2(const P& p, int l, char* smem) {
    if (VBID < 12) { if (VBID < 8) gdnL2_item(p, VBID, smem); else rwkL2_item(p, VBID - 8); }
    else { for (int item = VBID - 12; item < 1024; item += VNB - 12) retC_item(p, item, l, smem); }
}
DEVI void phase_chunkA(const P& p, char* smem) {
    for (int item = VBID; item < 4096; item += VNB) { if (item < 1024) gdnA_item(p, item, smem); else if (item < 3072) rwkA_item(p, item - 1024, smem); else retA_item(p, item - 3072, smem); }
}
DEVI void phase_chunkC(const P& p, int l, char* smem) {
    for (int item = VBID; item < 1536; item += VNB) { if (item < 1024) gdnC_item(p, item, l); else rwkC_item(p, item - 1024, l); }
}

DEVI void phase_ln1_route(const P& p, int l, char* smem, bool commit = true) {
    const float* ADA = (const float*)(p.ws + OFF_ADA) + l * 6144;
    const float* xin = (l == 0) ? p.in[0] : (const float*)(p.ws + WS_X);
    const float* OPRE = (const float*)(p.ws + WS_OPRE);
    float* X = (float*)(p.ws + WS_X); bf16* H2 = (bf16*)(p.ws + WS_H2);
    const float* lg = p.in[28] + l * D; const float* lb = p.in[29] + l * D;
    const float* rw = p.in[30] + (size_t)l * D * 32; const float* rbias = p.in[31] + l * 32;
    int* CNT = (int*)(p.ws + OFF_CNT) + l * 32 * 64; int* LIST = (int*)(p.ws + WS_LIST); float* GATE = (float*)(p.ws + WS_GATE);
    float* HS = (float*)smem;
    float* RED = HS + 4 * 1024;
    int* SEL = (int*)(RED + 1024);
    int* RNK = SEL + 256;
    int* BASE = RNK + 256;
    int nasg = 0;
    const int tid = VTID, lane = tid & 63, w = tid >> 6;
    for (int item = VBID; item < S / 4; item += VNB) {
        const int t = item * 4 + w;
        {
            f32x4 v[4]; float s = 0.f;
#pragma unroll
            for (int j = 0; j < 4; ++j) {
                const int c = j * 256 + lane * 4;
                const f32x4 x = *(const f32x4*)(xin + (size_t)t * D + c);
                const f32x4 o = *(const f32x4*)(OPRE + (size_t)t * D + c);
                const f32x4 gt = *(const f32x4*)(ADA + 2048 + c);
                v[j].x = DN_ALPHA * x.x + (1.f + gt.x) * o.x; v[j].y = DN_ALPHA * x.y + (1.f + gt.y) * o.y;
                v[j].z = DN_ALPHA * x.z + (1.f + gt.z) * o.z; v[j].w = DN_ALPHA * x.w + (1.f + gt.w) * o.w;
                s += (v[j].x + v[j].y) + (v[j].z + v[j].w);
            }
            const float mean = wave_sum(s) * (1.f / D);
            float s2 = 0.f;
#pragma unroll
            for (int j = 0; j < 4; ++j) { v[j] = v[j] - mean; s2 += (v[j].x * v[j].x + v[j].y * v[j].y) + (v[j].z * v[j].z + v[j].w * v[j].w); }
            const float rstd = rsqrtf(wave_sum(s2) * (1.f / D) + 1e-5f);
#pragma unroll
            for (int j = 0; j < 4; ++j) {
                const int c = j * 256 + lane * 4;
                const f32x4 g = *(const f32x4*)(lg + c), b = *(const f32x4*)(lb + c);
                f32x4 xo = v[j] * rstd * g + b;
                *(f32x4*)(X + (size_t)t * D + c) = xo;
                const f32x4 sh = *(const f32x4*)(ADA + 3072 + c), sc = *(const f32x4*)(ADA + 4096 + c);
                f32x4 hh = xo * (1.f + sc) + sh;
                *(f32x4*)(HS + w * 1024 + c) = hh;
                u32x2 o; o.x = pk2(hh.x, hh.y); o.y = pk2(hh.z, hh.w);
                *(u32x2*)(H2 + (size_t)t * D + c) = o;
            }
        }
        __syncthreads();
        {
            const int e = tid & 31, ks = tid >> 5;
            float a0 = 0.f, a1 = 0.f, a2 = 0.f, a3 = 0.f;
#pragma unroll 4
            for (int k = ks * 128; k < ks * 128 + 128; k += 4) {
                const float w0 = rw[(k + 0) * 32 + e], w1 = rw[(k + 1) * 32 + e], w2 = rw[(k + 2) * 32 + e], w3 = rw[(k + 3) * 32 + e];
                const f32x4 h0 = *(const f32x4*)(HS + 0 * 1024 + k), h1 = *(const f32x4*)(HS + 1 * 1024 + k);
                const f32x4 h2 = *(const f32x4*)(HS + 2 * 1024 + k), h3 = *(const f32x4*)(HS + 3 * 1024 + k);
                a0 += h0.x * w0 + h0.y * w1 + h0.z * w2 + h0.w * w3;
                a1 += h1.x * w0 + h1.y * w1 + h1.z * w2 + h1.w * w3;
                a2 += h2.x * w0 + h2.y * w1 + h2.z * w2 + h2.w * w3;
                a3 += h3.x * w0 + h3.y * w1 + h3.z * w2 + h3.w * w3;
            }
            RED[(ks * 4 + 0) * 32 + e] = a0; RED[(ks * 4 + 1) * 32 + e] = a1; RED[(ks * 4 + 2) * 32 + e] = a2; RED[(ks * 4 + 3) * 32 + e] = a3;
        }
        __syncthreads();
        if (tid < 128) {
            const int tok = tid >> 5, e = tid & 31, tt = item * 4 + tok;
            float logit = rbias[e];
#pragma unroll
            for (int ks = 0; ks < 8; ++ks) logit += RED[(ks * 4 + tok) * 32 + e];
            bool taken = false;
            float sv[4]; int si[4];
#pragma unroll
            for (int j = 0; j < 4; ++j) {
                float cand = taken ? -3.0e38f : logit; int ci = e;
#pragma unroll
                for (int off = 16; off >= 1; off >>= 1) {
                    const float ov = __shfl_xor(cand, off, 32); const int oi = __shfl_xor(ci, off, 32);
                    if (ov > cand || (ov == cand && oi < ci)) { cand = ov; ci = oi; }
                }
                sv[j] = cand; si[j] = ci; if (ci == e) taken = true;
            }
            const float e0 = 1.f, e1 = __expf(sv[1] - sv[0]), e2 = __expf(sv[2] - sv[0]), e3 = __expf(sv[3] - sv[0]);
            const float inv = 1.f / (e0 + e1 + e2 + e3);
            const float gts[4] = {e0 * inv, e1 * inv, e2 * inv, e3 * inv};
#pragma unroll
            for (int j = 0; j < 4; ++j) {
                if (si[j] == e) {
                    SEL[nasg + tok * 4 + j] = ((tt * 4 + j) << 5) | e;
                    GATE[(size_t)tt * 4 + j] = gts[j];
                }
            }
        }
        nasg += 16;
        __syncthreads();
    }
    if (!commit) return;
    if (tid < 32) {
        int c = 0;
        for (int a = 0; a < nasg; ++a) { if ((SEL[a] & 31) == tid) { RNK[a] = c; ++c; } }
        BASE[tid] = c ? atomicAdd(&CNT[tid * 64], c) : 0;
    }
    __syncthreads();
    for (int a = tid; a < nasg; a += NT) { const int v = SEL[a], e = v & 31; LIST[(size_t)e * S + BASE[e] + RNK[a]] = v >> 5; }
    __syncthreads();
}

DEVI void phase_ln2(const P& p, int l) {
    const float* ADA = (const float*)(p.ws + OFF_ADA) + l * 6144;
    const float* ADAn = (const float*)(p.ws + OFF_ADA) + 6144;
    float* X = (float*)(p.ws + WS_X); const bf16* YB = (const bf16*)(p.ws + WS_YB);
    bf16* HB = (bf16*)(p.ws + WS_HB);
    const float* lg = p.in[36] + l * D; const float* lb = p.in[37] + l * D;
    const int tid = VTID, lane = tid & 63, w = tid >> 6;
    for (int item = VBID; item < S / 4; item += VNB) {
        const int t = item * 4 + w;
        f32x4 v[4]; float s = 0.f;
#pragma unroll
        for (int j = 0; j < 4; ++j) {
            const int c = j * 256 + lane * 4;
            const f32x4 x = *(const f32x4*)(X + (size_t)t * D + c);
            f32x4 f = {0.f, 0.f, 0.f, 0.f};
#pragma unroll
            for (int q = 0; q < 4; ++q) {
                const u32x2 y = *(const u32x2*)(YB + ((size_t)t * 4 + q) * D + c);
                f.x += __uint_as_float(y.x << 16); f.y += __uint_as_float(y.x & 0xffff0000u);
                f.z += __uint_as_float(y.y << 16); f.w += __uint_as_float(y.y & 0xffff0000u);
            }
            const f32x4 gt = *(const f32x4*)(ADA + 5120 + c);
            v[j] = x * DN_ALPHA + (gt + 1.f) * f;
            s += (v[j].x + v[j].y) + (v[j].z + v[j].w);
        }
        const float mean = wave_sum(s) * (1.f / D);
        float s2 = 0.f;
#pragma unroll
        for (int j = 0; j < 4; ++j) { v[j] = v[j] - mean; s2 += (v[j].x * v[j].x + v[j].y * v[j].y) + (v[j].z * v[j].z + v[j].w * v[j].w); }
        const float rstd = rsqrtf(wave_sum(s2) * (1.f / D) + 1e-5f);
#pragma unroll
        for (int j = 0; j < 4; ++j) {
            const int c = j * 256 + lane * 4;
            const f32x4 g = *(const f32x4*)(lg + c), b = *(const f32x4*)(lb + c);
            const f32x4 xo = v[j] * rstd * g + b;
            if (l == 0) {
                *(f32x4*)(X + (size_t)t * D + c) = xo;
                const f32x4 sh = *(const f32x4*)(ADAn + c), sc = *(const f32x4*)(ADAn + 1024 + c);
                const f32x4 hh = xo * (sc + 1.f) + sh;
                u32x2 o; o.x = pk2(hh.x, hh.y); o.y = pk2(hh.z, hh.w);
                *(u32x2*)(HB + (size_t)t * D + c) = o;
            } else {
                *(f32x4*)(p.out + (size_t)t * D + c) = xo;
            }
        }
    }
}

namespace pg8 {
constexpr int BK = 64, HALF = 128, HTB = HALF * BK * 2, STAGE_BYTES = 8 * HTB;
DEVI int lds_byte(int r, int c) { const int st = (r >> 4) * 2 + (c >> 5), rr = r & 15, cc = c & 31, ob = rr * 64 + cc * 2; return st * 1024 + (ob ^ (((ob >> 9) & 1) << 5)); }
DEVI void stage_rc(int b, int& R, int& C) { const int st = b / 1024, sb = b % 1024, swz = sb ^ (((sb >> 9) & 1) << 5); R = (st >> 1) * 16 + swz / 64; C = (st & 1) * 32 + (swz % 64) / 2; }
struct Unit { const char* a; const char* b; int x0, x1, x2, x3; };

template <class Epi, class Sched>
DEVI void gemm_phase(LAS unsigned char* lds, const int K, const Sched& S, const Epi& E) {
    const int tid = threadIdx.x, wid = __builtin_amdgcn_readfirstlane(tid >> 6), lane = tid & 63, wr = wid >> 2, wc = wid & 3, fr = lane & 15, fq = lane >> 4;
    const int nt = K / BK;
    unsigned voffA[2], voffB[2];
    int gR[2], gC[2];
#pragma unroll
    for (int i = 0; i < 2; ++i) { int R, C; stage_rc(tid * 16 + i * 8192, R, C); gR[i] = R; gC[i] = C; voffA[i] = (unsigned)(R * K + C) * 2u; voffB[i] = (unsigned)(Epi::brow(R) * K + C) * 2u; }
    unsigned co[2][2], no[2][2];
#define PG8_GOFF(dst, tab) do { _Pragma("unroll") for (int _h = 0; _h < 2; ++_h) _Pragma("unroll") for (int _i = 0; _i < 2; ++_i) \
        dst[_h][_i] = (unsigned)((tab)[_h * 128 + gR[_i]] * K + gC[_i]) * 2u; } while (0)
    const size_t kstep = (size_t)(BK * 2);
    const size_t hstepA = (size_t)HALF * K * 2, hstepB = (size_t)Epi::BHALF * K * 2;
    const unsigned ldsw = (unsigned)wid * 1024u;
    const int aoff = lds_byte(wr * 64 + fr, fq * 8), boff = lds_byte(wc * 32 + fr, fq * 8);
#define PG8_SA(b, h) (((b) * 2 + (h)) * HTB)
#define PG8_SB(b, h) ((4 + (b) * 2 + (h)) * HTB)
#define PG8_STAGE(bufoff, gbase, voff) do { _Pragma("unroll") for (int _i = 0; _i < 2; ++_i) \
        __builtin_amdgcn_global_load_lds((const unsigned*)((const char*)(gbase) + (voff)[_i]), (LAS unsigned*)(lds + (bufoff) + ldsw + _i * 8192), 16, 0, 0); } while (0)
#define PG8_LDA(dst, b, h) do { _Pragma("unroll") for (int m = 0; m < 4; ++m) _Pragma("unroll") for (int k = 0; k < 2; ++k) dst[m][k] = *(const LAS bf16x8*)(lds + PG8_SA(b, h) + aoff + m * 2048 + k * 1024); } while (0)
#define PG8_LDB(dst, b, h) do { _Pragma("unroll") for (int n = 0; n < 2; ++n) _Pragma("unroll") for (int k = 0; k < 2; ++k) dst[n][k] = *(const LAS bf16x8*)(lds + PG8_SB(b, h) + boff + n * 2048 + k * 1024); } while (0)
#define PG8_MMA(ai, bj, At, Bt) do { __builtin_amdgcn_s_setprio(1); _Pragma("unroll") for (int m = 0; m < 4; ++m) _Pragma("unroll") for (int n = 0; n < 2; ++n) _Pragma("unroll") for (int k = 0; k < 2; ++k) \
        acc[ai][bj][m][n] = __builtin_amdgcn_mfma_f32_16x16x32_bf16(Bt[n][k], At[m][k], acc[ai][bj][m][n], 0, 0, 0); __builtin_amdgcn_s_setprio(0); } while (0)
#define PG8_WAIT_V(n) asm volatile("s_waitcnt vmcnt(" #n ")" ::: "memory")
#define PG8_WAIT_L(n) asm volatile("s_waitcnt lgkmcnt(" #n ")" ::: "memory")
#define PG8_BAR __builtin_amdgcn_s_barrier()
#define PG8_SCHED __builtin_amdgcn_sched_barrier(0)
    Unit cur, nxt; int ui = 0;
    if (!S.next(0, cur)) return;
    f32x4 acc[2][2][4][2];
#pragma unroll
    for (int a = 0; a < 2; ++a)
#pragma unroll
        for (int b = 0; b < 2; ++b)
#pragma unroll
            for (int m = 0; m < 4; ++m)
#pragma unroll
                for (int n = 0; n < 2; ++n) acc[a][b][m][n] = (f32x4){0.f, 0.f, 0.f, 0.f};
    bf16x8 At[4][2], B0[2][2], B1[2][2];
    const char* cA = cur.a; const char* cB = cur.b;
    if constexpr (Epi::GATHER_A) { PG8_GOFF(co, S.rows(0)); PG8_WAIT_L(0); }
    else {
#pragma unroll
        for (int i = 0; i < 2; ++i) { co[0][i] = voffA[i]; co[1][i] = voffA[i] + (unsigned)hstepA; no[0][i] = co[0][i]; no[1][i] = co[1][i]; }
    }
    PG8_WAIT_V(0);
    PG8_STAGE(PG8_SB(0, 0), cB, voffB); PG8_STAGE(PG8_SA(0, 0), cA, co[0]); PG8_STAGE(PG8_SB(0, 1), cB + hstepB, voffB); PG8_STAGE(PG8_SA(0, 1), cA, co[1]);
    if (wr == 1) PG8_BAR;
    PG8_WAIT_V(4); PG8_BAR;
    PG8_STAGE(PG8_SB(1, 0), cB + kstep, voffB); PG8_STAGE(PG8_SA(1, 0), cA + kstep, co[0]); PG8_STAGE(PG8_SB(1, 1), cB + hstepB + kstep, voffB);
    PG8_WAIT_V(6); PG8_BAR;
    for (;;) {
        const bool has_next = S.next(ui + 1, nxt);
        const char* nA = has_next ? nxt.a : cA; const char* nB = has_next ? nxt.b : cB;
        if constexpr (Epi::GATHER_A) { if (has_next) PG8_GOFF(no, S.rows(ui + 1)); else { no[0][0] = co[0][0]; no[0][1] = co[0][1]; no[1][0] = co[1][0]; no[1][1] = co[1][1]; } }
        for (int t = 0; t < nt; t += 2) {
            const bool last = (t == nt - 2);
            const char* a1 = cA + (size_t)(t + 1) * kstep;
            const char* a2 = last ? nA : cA + (size_t)(t + 2) * kstep; const char* b2 = last ? nB : cB + (size_t)(t + 2) * kstep;
            const char* a3 = a2 + kstep; const char* b3 = b2 + kstep;
            unsigned fo[2][2];
#pragma unroll
            for (int h = 0; h < 2; ++h)
#pragma unroll
                for (int i = 0; i < 2; ++i) fo[h][i] = last ? no[h][i] : co[h][i];
            PG8_LDB(B0, 0, 0); PG8_SCHED; PG8_LDA(At, 0, 0); PG8_STAGE(PG8_SA(1, 1), a1, co[1]);
            PG8_WAIT_L(8); PG8_BAR; PG8_WAIT_L(0); PG8_MMA(0, 0, At, B0); PG8_BAR; PG8_SCHED;
            PG8_LDB(B1, 0, 1); PG8_STAGE(PG8_SB(0, 0), b2, voffB);
            PG8_BAR; PG8_WAIT_L(0); PG8_MMA(0, 1, At, B1); PG8_BAR;
            PG8_LDA(At, 0, 1); PG8_STAGE(PG8_SA(0, 0), a2, fo[0]);
            PG8_BAR; PG8_WAIT_L(0); PG8_MMA(1, 0, At, B0); PG8_BAR; PG8_SCHED;
            PG8_STAGE(PG8_SB(0, 1), b2 + hstepB, voffB);
            PG8_WAIT_V(6); PG8_BAR; PG8_MMA(1, 1, At, B1); PG8_BAR;
            PG8_LDB(B0, 1, 0); PG8_SCHED; PG8_LDA(At, 1, 0); PG8_STAGE(PG8_SA(0, 1), a2, fo[1]);
            PG8_WAIT_L(8); PG8_BAR; PG8_WAIT_L(0); PG8_MMA(0, 0, At, B0); PG8_BAR; PG8_SCHED;
            PG8_LDB(B1, 1, 1); PG8_STAGE(PG8_SB(1, 0), b3, voffB);
            PG8_BAR; PG8_WAIT_L(0); PG8_MMA(0, 1, At, B1); PG8_BAR;
            PG8_LDA(At, 1, 1); PG8_STAGE(PG8_SA(1, 0), a3, fo[0]);
            PG8_BAR; PG8_WAIT_L(0); PG8_MMA(1, 0, At, B0); PG8_BAR; PG8_SCHED;
            PG8_STAGE(PG8_SB(1, 1), b3 + hstepB, voffB);
            PG8_WAIT_V(6); PG8_BAR; PG8_MMA(1, 1, At, B1); PG8_BAR;
        }
        E(acc, cur, wr, wc, fr, fq);
        if (!has_next) break;
#pragma unroll
        for (int a = 0; a < 2; ++a)
#pragma unroll
            for (int b = 0; b < 2; ++b)
#pragma unroll
                for (int m = 0; m < 4; ++m)
#pragma unroll
                    for (int n = 0; n < 2; ++n) acc[a][b][m][n] = (f32x4){0.f, 0.f, 0.f, 0.f};
        cur = nxt; cA = nA; cB = nB; ++ui;
#pragma unroll
        for (int h = 0; h < 2; ++h) { co[h][0] = no[h][0]; co[h][1] = no[h][1]; }
    }
    PG8_WAIT_V(0);
    if (wr == 0) PG8_BAR;
    PG8_BAR;
#undef PG8_SA
#undef PG8_GOFF
#undef PG8_SB
#undef PG8_STAGE
#undef PG8_LDA
#undef PG8_LDB
#undef PG8_MMA
#undef PG8_WAIT_V
#undef PG8_WAIT_L
#undef PG8_BAR
#undef PG8_SCHED
}
}

struct SchedDense {
    const char* A; const char* B; int K; int mode;
    DEVI const int* rows(int) const { return nullptr; }
    DEVI bool next(int i, pg8::Unit& u) const {
        const int c = blockIdx.x, x = c & 7; int pm, pn;
        if (mode == 0) { if (i > 0) return false; pn = x & 3; pm = (c >> 3) * 2 + (x >> 2); }
        else { if (i > 3) return false; pn = x + 8 * (i & 1); pm = (c >> 3) + 32 * (i >> 1); }
        u.a = A + (size_t)pm * 256 * K * 2; u.b = B + (size_t)pn * 256 * K * 2; u.x0 = pm; u.x1 = pn; u.x2 = 0; u.x3 = 0;
        return true;
    }
};
struct EpiOutF32 {
    static constexpr bool GATHER_A = false; static constexpr int BHALF = 128; static DEVI int brow(int R) { return R; }
    float* C;
    DEVI void operator()(const f32x4 (&acc)[2][2][4][2], const pg8::Unit& u, int wr, int wc, int fr, int fq) const {
#pragma unroll
        for (int ai = 0; ai < 2; ++ai)
#pragma unroll
            for (int m = 0; m < 4; ++m) {
                float* rowp = C + (size_t)(u.x0 * 256 + ai * 128 + wr * 64 + m * 16 + fr) * D + u.x1 * 256 + wc * 32 + 4 * fq;
#pragma unroll
                for (int bj = 0; bj < 2; ++bj)
#pragma unroll
                    for (int n = 0; n < 2; ++n) *(f32x4*)(rowp + bj * 128 + n * 16) = acc[ai][bj][m][n];
            }
    }
};
struct EpiProjBf16 {
    static constexpr bool GATHER_A = false; static constexpr int BHALF = 128; static DEVI int brow(int R) { return R; }
    bf16* C;
    DEVI void operator()(const f32x4 (&acc)[2][2][4][2], const pg8::Unit& u, int wr, int wc, int fr, int fq) const {
#pragma unroll
        for (int ai = 0; ai < 2; ++ai)
#pragma unroll
            for (int m = 0; m < 4; ++m) {
                bf16* rowp = C + (size_t)(u.x0 * 256 + ai * 128 + wr * 64 + m * 16 + fr) * NPROJ + u.x1 * 256 + wc * 32 + 4 * fq;
#pragma unroll
                for (int bj = 0; bj < 2; ++bj)
#pragma unroll
                    for (int n = 0; n < 2; ++n) { const f32x4 v = acc[ai][bj][m][n]; *(u32x2*)(rowp + bj * 128 + n * 16) = (u32x2){pk2(v.x, v.y), pk2(v.z, v.w)}; }
            }
    }
};
DEVI void phase_outproj8(const P& p, int l, char* smem_all) {
    SchedDense Sd{(const char*)(p.ws + WS_MIX), (const char*)(p.ws + WS_WOUT) + (size_t)l * D * D * 2, D, 0};
    EpiOutF32 E{(float*)(p.ws + WS_OPRE)};
    pg8::gemm_phase(( LAS unsigned char*)smem_all, D, Sd, E);
}
DEVI void phase_inproj8(const P& p, int l, char* smem_all) {
    SchedDense Sd{(const char*)(p.ws + WS_HB), (const char*)(p.ws + WS_WIN) + (size_t)l * NPAD * D * 2, D, 1};
    EpiProjBf16 E{(bf16*)(p.ws + WS_PROJ)};
    pg8::gemm_phase((LAS unsigned char*)smem_all, D, Sd, E);
}
DEVI void phase_inproj_extras(const P& p, int l, char* smem) {
    const bf16* HB = (const bf16*)(p.ws + WS_HB);
    const bf16* W = (const bf16*)(p.ws + WS_WIN) + (size_t)l * NPAD * D;
    float* PEX = (float*)(p.ws + WS_PEX);
    const int lane = VTID & 63, wid = VTID >> 6, wr = wid >> 1, wc = wid & 1, fr = lane & 15, fq = lane >> 4;
    for (int mt = VBID; mt < S / 128; mt += VNB) {
        f32x4 acc[4][8];
        gemm_tile(smem, HB, [&](int r) { return (unsigned)((mt * 128 + r) * D); }, W, [&](int r) { return (unsigned)((16 * 256 + r) * D); }, D, acc);
        if (wc == 0) {
#pragma unroll
            for (int m = 0; m < 4; ++m) {
                const int tok = mt * 128 + wr * 64 + m * 16 + fr;
#pragma unroll
                for (int n = 0; n < 4; ++n) *(f32x4*)(PEX + (size_t)tok * 64 + n * 16 + fq * 4) = acc[m][n];
            }
        }
    }
}

struct MoeMap8 { int cnt[32]; int off[32]; int tstart[33]; };
DEVI void moe_map8(const P& p, int l, MoeMap8* mm) {
    const int* CNT = (const int*)(p.ws + OFF_CNT) + l * 32 * 64;
    if (threadIdx.x < 32) mm->cnt[threadIdx.x] = __hip_atomic_load(&CNT[threadIdx.x * 64], __ATOMIC_RELAXED, __HIP_MEMORY_SCOPE_AGENT);
    __syncthreads();
    if (threadIdx.x == 0) {
        int o = 0, ts = 0;
        for (int e = 0; e < 32; ++e) { mm->off[e] = o; mm->tstart[e] = ts; o += mm->cnt[e]; ts += (mm->cnt[e] + 255) / 256; }
        mm->tstart[32] = ts;
    }
    __syncthreads();
}
DEVI void phase_moe_gather(const P& p, int l, char* smem_all) {
    MoeMap8* mm = (MoeMap8*)(smem_all + 131072);
    moe_map8(p, l, mm);
    const bf16* H2 = (const bf16*)(p.ws + WS_H2); bf16* HG = (bf16*)(p.ws + WS_HG);
    const int* LIST = (const int*)(p.ws + WS_LIST);
    const int wave = (int)(blockIdx.x * 8 + (threadIdx.x >> 6)), lane = threadIdx.x & 63;
    int mytok = 0;
    {
        const int pr = wave * 32 + (lane & 31);
        int e = 0;
        while (e < 31 && mm->off[e + 1] <= pr) ++e;
        mytok = LIST[(size_t)e * S + (pr - mm->off[e])] >> 2;
    }
#pragma unroll 1
    for (int r0 = 0; r0 < 32; r0 += 8) {
        u32x4 v[8][2];
#pragma unroll
        for (int i = 0; i < 8; ++i) {
            const int tok = __shfl(mytok, r0 + i);
            const u32x4* s = (const u32x4*)(H2 + (size_t)tok * D);
            v[i][0] = s[lane]; v[i][1] = s[lane + 64];
        }
#pragma unroll
        for (int i = 0; i < 8; ++i) { u32x4* d = (u32x4*)(HG + (size_t)(wave * 32 + r0 + i) * D); d[lane] = v[i][0]; d[lane + 64] = v[i][1]; }
    }
}
struct MoeUnits { int n; int pad[3]; int e[32]; int m0[32]; int pn[32]; };
struct SchedMoe {
    const MoeMap8* mm; const MoeUnits* mu; const char* A; const char* Bw; int K;
    size_t bexp, bpn;
    const int* rowtab; bool gather;
    DEVI const int* rows(int i) const { return rowtab + 256 * i; }
    DEVI bool next(int i, pg8::Unit& u) const {
        if (i >= mu->n) return false;
        const int e = mu->e[i], m0 = mu->m0[i], pn = mu->pn[i], off = mm->off[e];
        u.a = gather ? A : A + (size_t)(off + m0) * K * 2; u.b = Bw + (size_t)e * bexp + (size_t)pn * bpn;
        u.x0 = e; u.x1 = m0; u.x2 = pn; u.x3 = off;
        return true;
    }
};
DEVI void moe_units(const MoeMap8* mm, MoeUnits* mu, int npn_log) {
    if (threadIdx.x < 32) {
        const int L = (int)threadIdx.x * 256 + (int)blockIdx.x, total = mm->tstart[32] << npn_log;
        if (L < total) {
            const int pn = L & ((1 << npn_log) - 1), rt = L >> npn_log;
            int e = 0;
            while (mm->tstart[e + 1] <= rt) ++e;
            mu->e[threadIdx.x] = e; mu->m0[threadIdx.x] = (rt - mm->tstart[e]) * 256; mu->pn[threadIdx.x] = pn;
        }
        if (threadIdx.x == 0) { const int mine = total > (int)blockIdx.x ? (total - (int)blockIdx.x + 255) >> 8 : 0; mu->n = mine < 32 ? mine : 32; }
    }
    __syncthreads();
}
struct EpiMoeUp {
    static constexpr bool GATHER_A = true;
    static constexpr int BHALF = 64;
    static DEVI int brow(int R) { return ((R >> 5) & 3) * 16 + (R & 15) + (((R >> 4) & 1) ? 1024 : 0); }
    const MoeMap8* mm; bf16* ACT; const float* bup; bf16* dump;
    DEVI void operator()(const f32x4 (&acc)[2][2][4][2], const pg8::Unit& u, int wr, int wc, int fr, int fq) const {
        const int e = u.x0, cnt = mm->cnt[e];
        const float* be = bup + (size_t)e * 2048;
        f32x4 bg[2], bl[2];
#pragma unroll
        for (int bj = 0; bj < 2; ++bj) { const int col = u.x2 * 128 + (bj * 4 + wc) * 16 + 4 * fq; bg[bj] = *(const f32x4*)(be + col); bl[bj] = *(const f32x4*)(be + 1024 + col); }
#pragma unroll
        for (int ai = 0; ai < 2; ++ai)
#pragma unroll
            for (int m = 0; m < 4; ++m) {
                const int r = u.x1 + ai * 128 + wr * 64 + m * 16 + fr;
                bf16* rowp = (r < cnt) ? ACT + (size_t)(u.x3 + r) * DFF + u.x2 * 128 + wc * 16 + 4 * fq : dump + 4 * fq;
#pragma unroll
                for (int bj = 0; bj < 2; ++bj) {
                    float o[4];
#pragma unroll
                    for (int j = 0; j < 4; ++j) {
                        const float glu = fminf(acc[ai][bj][m][0][j] + bg[bj][j], 7.f);
                        const float lin = fminf(fmaxf(acc[ai][bj][m][1][j] + bl[bj][j], -7.f), 7.f);
                        o[j] = glu * sigmoidf_(1.702f * glu) * (lin + 1.f);
                    }
                    *(u32x2*)(rowp + bj * 64) = (u32x2){pk2(o[0], o[1]), pk2(o[2], o[3])};
                }
            }
    }
};
struct EpiMoeDown {
    static constexpr bool GATHER_A = false; static constexpr int BHALF = 128; static DEVI int brow(int R) { return R; }
    const MoeMap8* mm; bf16* YB; const float* bdn; const int* LIST; const float* GATE; bf16* dump;
    DEVI void operator()(const f32x4 (&acc)[2][2][4][2], const pg8::Unit& u, int wr, int wc, int fr, int fq) const {
        const int e = u.x0, cnt = mm->cnt[e];
        const float* be = bdn + (size_t)e * D + u.x2 * 256 + wc * 32 + 4 * fq;
        f32x4 bv[2][2];
#pragma unroll
        for (int bj = 0; bj < 2; ++bj)
#pragma unroll
            for (int n = 0; n < 2; ++n) bv[bj][n] = *(const f32x4*)(be + bj * 128 + n * 16);
        int ent[8]; float gt[8];
#pragma unroll
        for (int q = 0; q < 8; ++q) { const int r = u.x1 + (q >> 2) * 128 + wr * 64 + (q & 3) * 16 + fr; ent[q] = LIST[(size_t)e * S + (r < cnt ? r : cnt - 1)]; }
#pragma unroll
        for (int q = 0; q < 8; ++q) gt[q] = GATE[ent[q]];
#pragma unroll
        for (int ai = 0; ai < 2; ++ai)
#pragma unroll
            for (int m = 0; m < 4; ++m) {
                const int q = ai * 4 + m, r = u.x1 + ai * 128 + wr * 64 + m * 16 + fr;
                bf16* rowp = (r < cnt) ? YB + (size_t)ent[q] * D + u.x2 * 256 + wc * 32 + 4 * fq : dump + 4 * fq;
#pragma unroll
                for (int bj = 0; bj < 2; ++bj)
#pragma unroll
                    for (int n = 0; n < 2; ++n) {
                        const f32x4 v = (acc[ai][bj][m][n] + bv[bj][n]) * gt[q];
                        *(u32x2*)(rowp + bj * 128 + n * 16) = (u32x2){pk2(v.x, v.y), pk2(v.z, v.w)};
                    }
            }
    }
};
DEVI void phase_moe_up8(const P& p, int l, char* smem_all) {
    MoeMap8* mm = (MoeMap8*)(smem_all + 131072);
    moe_map8(p, l, mm);
    MoeUnits* mu = (MoeUnits*)(smem_all + 131072 + 512);
    moe_units(mm, mu, 3);
    int* rowtab = (int*)(smem_all + 131072 + 1024);
    {
        const int* LIST = (const int*)(p.ws + WS_LIST);
        const int nu = mu->n < 12 ? mu->n : 12;
        for (int idx = threadIdx.x; idx < nu * 256; idx += KT) {
            const int i = idx >> 8, r = idx & 255, e = mu->e[i], cnt = mm->cnt[e], rr = mu->m0[i] + r;
            rowtab[idx] = LIST[(size_t)e * S + (rr < cnt ? rr : cnt - 1)] >> 2;
        }
        __syncthreads();
    }
    SchedMoe Sm{mm, mu, (const char*)(p.ws + WS_H2), (const char*)(p.ws + WS_WUP) + (size_t)l * NEXP * 2048 * D * 2, D, (size_t)2048 * D * 2, (size_t)128 * D * 2, rowtab, true};
    EpiMoeUp E{mm, (bf16*)(p.ws + WS_ACT), p.in[33] + (size_t)l * NEXP * 2048, (bf16*)(p.ws + WS_DUMP)};
    pg8::gemm_phase((LAS unsigned char*)smem_all, D, Sm, E);
}
DEVI void phase_moe_down8(const P& p, int l, char* smem_all) {
    MoeMap8* mm = (MoeMap8*)(smem_all + 131072);
    moe_map8(p, l, mm);
    MoeUnits* mu = (MoeUnits*)(smem_all + 131072 + 512);
    moe_units(mm, mu, 2);
    SchedMoe Sm{mm, mu, (const char*)(p.ws + WS_ACT), (const char*)(p.ws + WS_WDN) + (size_t)l * NEXP * D * DFF * 2, DFF, (size_t)D * DFF * 2, (size_t)256 * DFF * 2, nullptr, false};
    EpiMoeDown E{mm, (bf16*)(p.ws + WS_YB), p.in[35] + (size_t)l * NEXP * D, (const int*)(p.ws + WS_LIST), (const float*)(p.ws + WS_GATE), (bf16*)(p.ws + WS_DUMP)};
    pg8::gemm_phase((LAS unsigned char*)smem_all, DFF, Sm, E);
}

constexpr int NPHASE = 24;
constexpr int LDS_TOTAL = 2 * VB_LDS + 64;
__global__ void __launch_bounds__(KT, 2) k_run(P p) {
    extern __shared__ __attribute__((aligned(16))) char smem_all[];
    char* smem = smem_all + __builtin_amdgcn_readfirstlane((int)(threadIdx.x >> 8)) * VB_LDS;
    XcdBarrier bar; bar.bar = nullptr; bar.x = 0; bar.st = nullptr;
    const bool multi = (p.ph_hi - p.ph_lo) > 1;
    if (multi) {
        volatile LAS unsigned* st = (volatile LAS unsigned*)(smem_all + 2 * VB_LDS);
        if (threadIdx.x == 0) { st[0] = 0u; st[1] = 0u; }
        __syncthreads();
        bar = xcd_barrier_post((unsigned*)(p.ws + OFF_BAR), st);
    }
#ifndef DUP
#define DUP -1
#endif
#ifndef DUP2
#define DUP2 -1
#endif
#define RUN(k, call) if (p.ph_lo <= (k) && (k) < p.ph_hi) { for (int _rep = ((k) == DUP || (k) == DUP2) ? 2 : 1; _rep > 0; --_rep) { call; if (multi && ((k) + 1 < p.ph_hi || _rep > 1)) xcd_barrier(bar); } }
    RUN(0, phase_prep(p, smem))
    RUN(1, phase_h0(p))
    RUN(2, { phase_inproj8(p, 0, smem_all); phase_inproj_extras(p, 0, smem); })
    RUN(3, phase_mixprep(p, 0, smem))
    RUN(4, phase_chunkA(p, smem))
    RUN(5, phase_scanL1(p, smem))
    RUN(6, phase_scanL2(p, 0, smem))
    RUN(7, phase_chunkC(p, 0, smem))
    RUN(8, phase_outproj8(p, 0, smem_all))
    RUN(9, phase_ln1_route(p, 0, smem, _rep == 1))
    RUN(10, phase_moe_up8(p, 0, smem_all))
    RUN(11, phase_moe_down8(p, 0, smem_all))
    RUN(12, phase_ln2(p, 0))
    RUN(13, { phase_inproj8(p, 1, smem_all); phase_inproj_extras(p, 1, smem); })
    RUN(14, phase_mixprep(p, 1, smem))
    RUN(15, phase_chunkA(p, smem))
    RUN(16, phase_scanL1(p, smem))
    RUN(17, phase_scanL2(p, 1, smem))
    RUN(18, phase_chunkC(p, 1, smem))
    RUN(19, phase_outproj8(p, 1, smem_all))
    RUN(20, phase_ln1_route(p, 1, smem))
    RUN(21, phase_moe_up8(p, 1, smem_all))
    RUN(22, phase_moe_down8(p, 1, smem_all))
    RUN(23, phase_ln2(p, 1))
#undef RUN
}

extern "C" void kernel_launch(void* const* d_in, const int* in_sizes, int n_in, void* d_out, int out_size, void* d_ws, size_t ws_size,
                              hipStream_t stream) {
    static int grid = 0;
    if (grid == 0) {
        if (n_in != 38 || ws_size < WS_END) { fprintf(stderr, "kernel_launch: unexpected n_in %d or ws_size %zu (< %zu)\n", n_in, ws_size, (size_t)WS_END); grid = -1; return; }
        int dev = 0, cus = 0, per_cu = 0;
        hipGetDevice(&dev);
        hipDeviceGetAttribute(&cus, hipDeviceAttributeMultiprocessorCount, dev);
        hipFuncSetAttribute((const void*)k_run, hipFuncAttributeMaxDynamicSharedMemorySize, LDS_TOTAL);
        hipOccupancyMaxActiveBlocksPerMultiprocessor(&per_cu, (const void*)k_run, KT, LDS_TOTAL);
        if (per_cu < 1) { fprintf(stderr, "kernel_launch: occupancy query returned %d\n", per_cu); grid = -1; return; }
        if (cus != 256) { fprintf(stderr, "kernel_launch: built for 256 CUs (one workgroup per CU), device has %d\n", cus); grid = -1; return; }
        grid = cus;
    }
    if (grid < 0) return;
    hipMemsetAsync((char*)d_ws + WS_CTL, 0, CTL_BYTES, stream);
    P p{};
    for (int i = 0; i < 38; ++i) p.in[i] = (const float*)d_in[i];
    p.pos = (const int*)d_in[2];
    p.out = (float*)d_out; p.ws = (char*)d_ws;
#if MEGA
    p.ph_lo = 0; p.ph_hi = NPHASE;
    void* args[] = {&p};
    hipError_t e = hipLaunchCooperativeKernel((const void*)k_run, dim3(grid), dim3(KT), args, LDS_TOTAL, stream);
    if (e != hipSuccess) fprintf(stderr, "cooperative launch failed: %s (grid %d)\n", hipGetErrorString(e), grid);
#else
    for (int ph = 0; ph < NPHASE; ++ph) {
        p.ph_lo = ph; p.ph_hi = ph + 1;
        hipLaunchKernelGGL(k_run, dim3(grid), dim3(KT), LDS_TOTAL, stream, p);
    }
#endif
}
```

```cpp
#include <hip/hip_runtime.h>
#include <hip/hip_bf16.h>
#include <stdint.h>
#include <stdio.h>

#ifndef MEGA
#define MEGA 1
#endif

#define DEVI __device__ __forceinline__
#define LAS __attribute__((address_space(3)))

typedef unsigned short bf16;
typedef short bf16x8 __attribute__((ext_vector_type(8)));
typedef float f32x4 __attribute__((ext_vector_type(4)));
typedef unsigned u32x4 __attribute__((ext_vector_type(4)));
typedef unsigned u32x2 __attribute__((ext_vector_type(2)));

constexpr int S = 16384, D = 1024, NIN = 4104, NEXP = 32, DFF = 1024;
constexpr int NPROJ = 4096;
constexpr int NPAD = 4352;
constexpr float DN_ALPHA = 1.4142135623730951f;
constexpr int NT = 256;
constexpr int LDS_BYTES = 76032;

constexpr size_t MiB = 1ull << 20;
constexpr size_t WS_CTL = 0;
constexpr size_t CTL_BYTES = 1 * MiB;
constexpr size_t OFF_BAR = 0;
constexpr size_t OFF_ADA = 64 * 1024;
constexpr size_t OFF_CNT = 128 * 1024;
constexpr size_t WS_ROT = 1 * MiB;
constexpr size_t WS_WIN = WS_ROT + (size_t)S * 64 * 4;
constexpr size_t WS_WOUT = WS_WIN + 2ull * NPAD * D * 2;
constexpr size_t WS_WUP = WS_WOUT + 2ull * D * D * 2;
constexpr size_t WS_WDN = WS_WUP + 2ull * NEXP * 2048 * D * 2;
constexpr size_t WS_HB = WS_WDN + 2ull * NEXP * D * DFF * 2;
constexpr size_t WS_PROJ = WS_HB + (size_t)S * D * 2;
constexpr size_t WS_PEX = WS_PROJ + (size_t)S * NPROJ * 2;
constexpr size_t WS_VFIRST = WS_PEX + (size_t)S * 64 * 4;
constexpr size_t WS_RECR = WS_VFIRST + (size_t)S * 256 * 4;
constexpr size_t WS_RECG = WS_RECR + (size_t)S * 4 * 384 * 2;
constexpr size_t WS_RECT = WS_RECG + (size_t)S * 4 * 392 * 2;
constexpr size_t WS_WDEC = WS_RECT + (size_t)S * 4 * 192 * 2;
constexpr size_t WS_GSC = WS_WDEC + (size_t)S * 256 * 4;
constexpr size_t WS_G = WS_GSC + (size_t)S * 16 * 4;
constexpr size_t WS_BON = WS_G + (size_t)S * 256 * 4;
constexpr size_t WS_YR = WS_BON + (size_t)S * 4 * 4;
constexpr size_t WS_OG = WS_YR + (size_t)S * 256 * 4;
constexpr size_t WS_ORT = WS_OG + (size_t)S * 512 * 4;
constexpr size_t WS_MIX = WS_ORT + (size_t)S * 256 * 4;
constexpr size_t WS_OPRE = WS_MIX + (size_t)S * D * 2;
constexpr size_t WS_X = WS_OPRE + (size_t)S * D * 4;
constexpr size_t WS_H2 = WS_X + (size_t)S * D * 4;
constexpr size_t WS_LIST = WS_H2 + (size_t)S * D * 2;
constexpr size_t WS_GATE = WS_LIST + (size_t)NEXP * S * 4;
constexpr size_t WS_ACT = WS_GATE + (size_t)S * 4 * 4;
constexpr size_t WS_YB = WS_ACT + ((size_t)S * 4 + 256) * DFF * 2;
constexpr size_t WS_ADAP = WS_YB + (size_t)S * 4 * D * 2;
constexpr size_t WS_RKV = WS_ADAP + 16ull * 12288 * 4;
constexpr size_t WS_RST = WS_RKV + 256ull * 4 * 4096 * 4;
constexpr size_t WS_GP = WS_RST + 256ull * 4 * 4096 * 2;
constexpr size_t WS_GB = WS_GP + 1024ull * 16384 * 2;
constexpr size_t WS_GD = WS_GB + 1024ull * 16384 * 4;
constexpr size_t WS_GQ = WS_GD + 4096;
constexpr size_t WS_GO = WS_GQ + 1024ull * 8192 * 2;
constexpr size_t WS_GS = WS_GO + 1024ull * 8192 * 4;
constexpr size_t WS_WP = WS_GS + 1024ull * 16384 * 2;
constexpr size_t WS_WC = WS_WP + 2048ull * 4096 * 2;
constexpr size_t WS_WD = WS_WC + 2048ull * 4096 * 4;
constexpr size_t WS_WQ = WS_WD + 2048ull * 64 * 4;
constexpr size_t WS_WY = WS_WQ + 2048ull * 2048 * 2;
constexpr size_t WS_WS = WS_WY + 2048ull * 2048 * 4;
constexpr size_t WS_GR = WS_WS + 2048ull * 4096 * 2;
constexpr size_t WS_GE0 = WS_GR + 1024ull * 8192 * 2;
constexpr size_t WS_GTE = WS_GE0 + 64ull * 16384 * 4;
constexpr size_t WS_GSG = WS_GTE + 64ull * 16384 * 2;
constexpr size_t WS_WR = WS_GSG + 64ull * 16384 * 2;
constexpr size_t WS_WE0 = WS_WR + 2048ull * 2048 * 2;
constexpr size_t WS_WTE = WS_WE0 + 64ull * 4096 * 4;
constexpr size_t WS_WSG = WS_WTE + 64ull * 4096 * 2;
constexpr size_t WS_LRT = WS_WSG + 64ull * 4096 * 2;
constexpr size_t WS_HG = WS_LRT + 2ull * 73728 * 2;
constexpr size_t WS_DUMP = WS_HG + ((size_t)S * 4 + 256) * D * 2;
constexpr size_t WS_END = WS_DUMP + 4096;

struct P {
    const float* in[38];
    const int* pos;
    float* out;
    char* ws;
    int ph_lo, ph_hi;
};

DEVI float bf2f(bf16 v) { return __uint_as_float(((unsigned)v) << 16); }
DEVI unsigned f2bf(float f) { unsigned u = __float_as_uint(f); return (u + 0x7fffu + ((u >> 16) & 1u)) >> 16; }
typedef float f32x2_t __attribute__((ext_vector_type(2)));
typedef __bf16 bf16x2_t __attribute__((ext_vector_type(2)));
DEVI unsigned pk2(float lo, float hi) { const f32x2_t v = {lo, hi}; return __builtin_bit_cast(unsigned, __builtin_convertvector(v, bf16x2_t)); }
DEVI float sigmoidf_(float x) { return __builtin_amdgcn_rcpf(1.f + __builtin_amdgcn_exp2f(-1.4426950408889634f * x)); }
DEVI float siluf_(float x) { return x * sigmoidf_(x); }
DEVI float softplusf_(float x) { return fmaxf(x, 0.f) + log1pf(__expf(-fabsf(x))); }
DEVI float wave_sum(float v) {
#pragma unroll
    for (int o = 32; o >= 1; o >>= 1) v += __shfl_xor(v, o);
    return v;
}
template <int CTRL> DEVI float dpp_mov(float x) {
    return __int_as_float(__builtin_amdgcn_update_dpp(0, __float_as_int(x), CTRL, 0xf, 0xf, false));
}
DEVI float row16_sum(float x) {
    x += dpp_mov<0x128>(x);
    x += dpp_mov<0x124>(x);
    x += dpp_mov<0x122>(x);
    x += dpp_mov<0x121>(x);
    return x;
}

DEVI bf16x8 ldfrag(const bf16* base, int ld, int row0, int k0, int lane) {
    return *(const bf16x8*)(base + (row0 + (lane & 15)) * ld + k0 + (lane >> 4) * 8);
}
DEVI f32x4 ld_bf4(const bf16* p) {
    const u32x2 v = *(const u32x2*)p;
    return (f32x4){__uint_as_float(v.x << 16), __uint_as_float(v.x & 0xffff0000u), __uint_as_float(v.y << 16), __uint_as_float(v.y & 0xffff0000u)};
}
DEVI void st_bf4(bf16* p, const f32x4& v) { *(u32x2*)p = (u32x2){pk2(v.x, v.y), pk2(v.z, v.w)}; }
DEVI float quad_sum(float v) { v += __shfl_xor(v, 16); v += __shfl_xor(v, 32); return v; }
DEVI f32x4 mfma16(bf16x8 a, bf16x8 b, f32x4 c) { return __builtin_amdgcn_mfma_f32_16x16x32_bf16(a, b, c, 0, 0, 0); }

#define VTID ((int)(threadIdx.x & 255))
#define VBID ((int)(blockIdx.x * 2 + __builtin_amdgcn_readfirstlane((int)(threadIdx.x >> 8))))
#define VNB ((int)(gridDim.x * 2))
constexpr int VB_LDS = 76032;
constexpr int KT = 512;

#define XB_TMO      128
#define XB_XCNT(j)  (256  + 64 * (j))
#define XB_XSUB(j)  (1280 + 64 * (j))
#define XB_XGEN(j)  (2304 + 64 * (j))
#define XB_TOP      3328
#define XB_TOPGEN   3392
#define XCD_BAR_WORDS 3456
#define XB_SPIN_CAP (1u << 22)
DEVI unsigned xb_ld(unsigned* p) { return __hip_atomic_load(p, __ATOMIC_RELAXED, __HIP_MEMORY_SCOPE_AGENT); }
DEVI unsigned xb_add(unsigned* p, unsigned v) { return __hip_atomic_fetch_add(p, v, __ATOMIC_RELAXED, __HIP_MEMORY_SCOPE_AGENT); }
DEVI unsigned xb_xcc_id() { return (unsigned)__builtin_amdgcn_s_getreg((3 << 11) | 20) & 0xFu; }
#define XB_SPIN(cond, bar) do { unsigned _sp = 0; while (cond) { __builtin_amdgcn_s_sleep(1); \
    if ((++_sp & 255u) == 0u) { if (xb_ld(&(bar)[XB_TMO])) break; if (_sp > XB_SPIN_CAP) { atomicAdd(&(bar)[XB_TMO], 1u); break; } } } } while (0)
struct XcdBarrier { unsigned* bar; unsigned x; volatile LAS unsigned* st; };
DEVI XcdBarrier xcd_barrier_post(unsigned* bar, volatile LAS unsigned* st) {
    XcdBarrier b; b.bar = bar; b.x = xb_xcc_id(); b.st = st;
    if (threadIdx.x == 0) (void)xb_add(&bar[XB_XCNT(b.x)], 1u);
    return b;
}
DEVI void xcd_barrier_complete(unsigned* bar, unsigned x, unsigned& nloc, unsigned& nx) {
    const unsigned G = gridDim.x * gridDim.y * gridDim.z;
    unsigned sum, cnt, mine, sp = 0u;
    for (;;) {
        sum = 0u; cnt = 0u; mine = 0u;
#pragma unroll
        for (unsigned j = 0; j < 16; ++j) { const unsigned c = xb_ld(&bar[XB_XCNT(j)]); sum += c; cnt += (c > 0u) ? 1u : 0u; mine = (j == x) ? c : mine; }
        if (sum == G) break;
        __builtin_amdgcn_s_sleep(1);
        if ((++sp & 255u) == 0u) { if (xb_ld(&bar[XB_TMO])) break; if (sp > XB_SPIN_CAP) { atomicAdd(&bar[XB_TMO], 1u); break; } }
    }
    nloc = mine > 0u ? mine : 1u; nx = cnt > 0u ? cnt : 1u;
}
DEVI void xcd_barrier(const XcdBarrier& b) {
    asm volatile("s_waitcnt vmcnt(0)" ::: "memory");
    __syncthreads();
    if (threadIdx.x == 0) {
        unsigned* bar = b.bar;
        __builtin_amdgcn_s_waitcnt(0);
        unsigned nloc = b.st[0], nx = b.st[1];
        if (nloc == 0u) { xcd_barrier_complete(bar, b.x, nloc, nx); b.st[0] = nloc; b.st[1] = nx; }
        const unsigned old = xb_add(&bar[XB_XSUB(b.x)], 1u);
        const unsigned gen = old / nloc;
        if (old + 1u == (gen + 1u) * nloc) {
            __builtin_amdgcn_fence(__ATOMIC_RELEASE, "agent");
            asm volatile("s_waitcnt vmcnt(0)" ::: "memory");
            const unsigned og = xb_add(&bar[XB_TOP], 1u);
            const unsigned tg = og / nx;
            if (og + 1u == (tg + 1u) * nx) xb_add(&bar[XB_TOPGEN], 1u);
            else XB_SPIN(xb_ld(&bar[XB_TOPGEN]) == tg, bar);
            __builtin_amdgcn_fence(__ATOMIC_ACQUIRE, "agent");
            xb_add(&bar[XB_XGEN(b.x)], 1u);
            asm volatile("s_waitcnt vmcnt(0)" ::: "memory");
        } else {
            XB_SPIN(xb_ld(&bar[XB_XGEN(b.x)]) == gen, bar);
            __builtin_amdgcn_fence(__ATOMIC_ACQUIRE, "agent");
            asm volatile("s_waitcnt vmcnt(0)" ::: "memory");
        }
    }
    __syncthreads();
}

DEVI void transpose_item(const float* __restrict__ src, size_t ld, int k0, int ns0, bf16* __restrict__ dst, int kd, int nd0, float* lds) {
    const int tid = VTID;
#pragma unroll 4
    for (int i = 0; i < 16; ++i) {
        const int kk = i * 4 + (tid >> 6), n = tid & 63;
        lds[kk * 65 + n] = src[(size_t)(k0 + kk) * ld + ns0 + n];
    }
    __syncthreads();
#pragma unroll
    for (int i = 0; i < 2; ++i) {
        const int q = tid + 256 * i, n = q >> 3, kc = q & 7;
        const float* s = lds + (kc * 8) * 65 + n;
        u32x4 o;
        o.x = pk2(s[0 * 65], s[1 * 65]); o.y = pk2(s[2 * 65], s[3 * 65]);
        o.z = pk2(s[4 * 65], s[5 * 65]); o.w = pk2(s[6 * 65], s[7 * 65]);
        *(u32x4*)(dst + (size_t)(nd0 + n) * kd + k0 + kc * 8) = o;
    }
    __syncthreads();
}

DEVI void phase_prep(const P& p, char* smem) {
    float* lds = (float*)smem;
    const int tid = VTID;
    const int nb = VNB, bid = VBID;
    bf16* WIN = (bf16*)(p.ws + WS_WIN); bf16* WOUT = (bf16*)(p.ws + WS_WOUT);
    bf16* WUP = (bf16*)(p.ws + WS_WUP); bf16* WDN = (bf16*)(p.ws + WS_WDN);
    constexpr int I_UP = 2 * NEXP * 16 * 32;
    constexpr int I_DN = 2 * NEXP * 16 * 16;
    constexpr int I_IN = 2 * 16 * 64;
    constexpr int I_OUT = 2 * 16 * 16;
    constexpr int I_EX = 2 * 256;
    constexpr int I_ADA = 2 * 24 * 16;
    constexpr int I_ROT = S * 32 / 256;
    constexpr int I_LR = 2 * 288;
    constexpr int NITEMS = I_UP + I_DN + I_IN + I_OUT + I_EX + I_ADA + I_ROT + I_LR;
    constexpr int I_TR = I_UP + I_DN + I_IN + I_OUT;
    static_assert(I_TR % 512 == 0, "transpose items must split evenly over 512 virtual blocks (they contain barriers)");
    for (int it = bid; it < NITEMS; it += nb) {
        int r = it;
        if (r < I_UP) {
            const int le = r / 512, q = r % 512, kt = q / 32, nt = q % 32;
            transpose_item(p.in[32] + (size_t)le * D * 2048, 2048, kt * 64, nt * 64, WUP + (size_t)le * 2048 * D, D, nt * 64, lds);
            continue;
        }
        r -= I_UP;
        if (r < I_DN) {
            const int le = r / 256, q = r % 256, kt = q / 16, nt = q % 16;
            transpose_item(p.in[34] + (size_t)le * DFF * D, D, kt * 64, nt * 64, WDN + (size_t)le * D * DFF, DFF, nt * 64, lds);
            continue;
        }
        r -= I_DN;
        if (r < I_IN) {
            const int l = r / 1024, q = r % 1024, kt = q / 64, nt = q % 64;
            const int nd0 = nt * 64, ns0 = nd0 < 3072 ? nd0 : nd0 + 8;
            transpose_item(p.in[5] + (size_t)l * D * NIN, NIN, kt * 64, ns0, WIN + (size_t)l * NPAD * D, D, nd0, lds);
            continue;
        }
        r -= I_IN;
        if (r < I_OUT) {
            const int l = r / 256, q = r % 256, kt = q / 16, nt = q % 16;
            transpose_item(p.in[27] + (size_t)l * D * D, D, kt * 64, nt * 64, WOUT + (size_t)l * D * D, D, nt * 64, lds);
            continue;
        }
        r -= I_OUT;
        if (r < I_EX) {
            const int l = r / 256, n = r % 256;
            bf16* dst = WIN + ((size_t)l * NPAD + NPROJ + n) * D;
            for (int k = tid; k < D; k += NT) {
                float v = 0.f;
                if (n < 8) v = p.in[5][(size_t)l * D * NIN + (size_t)k * NIN + 3072 + n];
                else if (n < 40 && l == 1) v = p.in[6][(size_t)k * 32 + (n - 8)];
                dst[k] = (bf16)f2bf(v);
            }
            continue;
        }
        r -= I_EX;
        if (r < I_ADA) {
            const int l = r / 384, q = r % 384, nc = q / 16, kc = q % 16;
            const int n = nc * 256 + tid;
            const float* W = p.in[3] + (size_t)l * D * 6144;
            float acc = (kc == 0) ? p.in[4][l * 6144 + n] : 0.f;
            for (int k = kc * 64; k < kc * 64 + 64; ++k) acc += siluf_(p.in[1][k]) * W[(size_t)k * 6144 + n];
            ((float*)(p.ws + WS_ADAP))[(size_t)kc * 12288 + l * 6144 + n] = acc;
            continue;
        }
        r -= I_ADA;
        if (r >= I_ROT) {
            r -= I_ROT;
            const int l = r / 288, kk = r % 288, c = tid;
            bf16* LRT = (bf16*)(p.ws + WS_LRT) + (size_t)l * 73728;
            if (kk < 64) LRT[c * 64 + kk] = (bf16)f2bf(p.in[10][(l * 64 + kk) * 256 + c]);
            else if (kk < 128) LRT[16384 + c * 64 + (kk - 64)] = (bf16)f2bf(p.in[12][(l * 64 + kk - 64) * 256 + c]);
            else if (kk < 256) LRT[32768 + c * 128 + (kk - 128)] = (bf16)f2bf(p.in[13][(l * 128 + kk - 128) * 256 + c]);
            else LRT[65536 + c * 32 + (kk - 256)] = (bf16)f2bf(l == 1 ? p.in[20][(kk - 256) * 256 + c] : 0.f);
            continue;
        }
        {
            const int idx = r * 256 + tid;
            const int t = idx >> 5, i = idx & 31;
            const float invf = (float)pow(10000.0, -(double)i / 32.0);
            const float ang = (float)p.pos[t] * invf;
            float sn, cs; sincosf(ang, &sn, &cs);
            float* ROT = (float*)(p.ws + WS_ROT);
            ROT[(size_t)idx * 2] = cs; ROT[(size_t)idx * 2 + 1] = sn;
        }
    }
}

DEVI float ada_sum(const float* ADAP, int idx) {
    float s = 0.f;
#pragma unroll
    for (int kc = 0; kc < 16; ++kc) s += ADAP[(size_t)kc * 12288 + idx];
    return s;
}
DEVI void phase_h0(const P& p) {
    const float* ADAP = (const float*)(p.ws + WS_ADAP);
    float* ADA = (float*)(p.ws + OFF_ADA);
    bf16* HB = (bf16*)(p.ws + WS_HB);
    if (VBID < 48) ADA[VBID * 256 + VTID] = ada_sum(ADAP, VBID * 256 + VTID);
    const size_t n4 = (size_t)S * D / 4;
    const int c = (int)(((size_t)VBID * NT + VTID) % (D / 4)) * 4;
    f32x4 sh, sc;
    sh.x = ada_sum(ADAP, c); sh.y = ada_sum(ADAP, c + 1); sh.z = ada_sum(ADAP, c + 2); sh.w = ada_sum(ADAP, c + 3);
    sc.x = ada_sum(ADAP, 1024 + c); sc.y = ada_sum(ADAP, 1025 + c); sc.z = ada_sum(ADAP, 1026 + c); sc.w = ada_sum(ADAP, 1027 + c);
    for (size_t i = (size_t)VBID * NT + VTID; i < n4; i += (size_t)VNB * NT) {
        const f32x4 x = ((const f32x4*)p.in[0])[i];
        u32x2 o;
        o.x = pk2(x.x * (1.f + sc.x) + sh.x, x.y * (1.f + sc.y) + sh.y);
        o.y = pk2(x.z * (1.f + sc.z) + sh.z, x.w * (1.f + sc.w) + sh.w);
        ((u32x2*)HB)[i] = o;
    }
}

template <class AF, class BF>
DEVI void gemm_tile(char* smem, const bf16* __restrict__ Abase, AF arow, const bf16* __restrict__ Bbase, BF brow, int K, f32x4 (&acc)[4][8]) {
    const int tid = VTID, wid = tid >> 6, lane = tid & 63, wr = wid >> 1, wc = wid & 1, fr = lane & 15, fq = lane >> 4;
    const int r0 = tid >> 2;
    const int swz = ((tid & 3) ^ ((0x1320 >> (4 * ((tid >> 4) & 3))) & 3)) * 8;
    unsigned pa[2], pb[4];
#pragma unroll
    for (int i = 0; i < 2; ++i) pa[i] = arow(r0 + 64 * i) + swz;
#pragma unroll
    for (int i = 0; i < 4; ++i) pb[i] = brow(r0 + 64 * i) + swz;
#pragma unroll
    for (int m = 0; m < 4; ++m)
#pragma unroll
        for (int n = 0; n < 8; ++n) acc[m][n] = (f32x4){0.f, 0.f, 0.f, 0.f};
    const int nk = K / 32;
    const int ch = (fq ^ ((0x1320 >> (4 * ((fr >> 2) & 3))) & 3)) * 16;
#define GT_STAGE(kt) do { char* _sa = smem + ((kt) % 3) * 24576; char* _sb = _sa + 8192; \
        _Pragma("unroll") for (int _i = 0; _i < 2; ++_i) \
            __builtin_amdgcn_global_load_lds((const unsigned*)(Abase + pa[_i] + (kt) * 32), (unsigned*)(_sa + (tid + 256 * _i) * 16), 16, 0, 0); \
        _Pragma("unroll") for (int _i = 0; _i < 4; ++_i) \
            __builtin_amdgcn_global_load_lds((const unsigned*)(Bbase + pb[_i] + (kt) * 32), (unsigned*)(_sb + (tid + 256 * _i) * 16), 16, 0, 0); } while (0)
    asm volatile("s_waitcnt vmcnt(0)" ::: "memory");
    GT_STAGE(0); GT_STAGE(1);
    for (int kt = 0; kt < nk; ++kt) {
        if (kt + 1 < nk) asm volatile("s_waitcnt vmcnt(6)" ::: "memory");
        else asm volatile("s_waitcnt vmcnt(0)" ::: "memory");
        asm volatile("s_waitcnt lgkmcnt(0)" ::: "memory");
        __builtin_amdgcn_s_barrier();
        if (kt + 2 < nk) GT_STAGE(kt + 2);
        const char* SA = smem + (kt % 3) * 24576; const char* SB = SA + 8192;
        bf16x8 af[4], bfr[8];
#pragma unroll
        for (int m = 0; m < 4; ++m) af[m] = *(const bf16x8*)(SA + (wr * 64 + m * 16 + fr) * 64 + ch);
#pragma unroll
        for (int n = 0; n < 8; ++n) bfr[n] = *(const bf16x8*)(SB + (wc * 128 + n * 16 + fr) * 64 + ch);
#pragma unroll
        for (int m = 0; m < 4; ++m)
#pragma unroll
            for (int n = 0; n < 8; ++n)
                acc[m][n] = __builtin_amdgcn_mfma_f32_16x16x32_bf16(bfr[n], af[m], acc[m][n], 0, 0, 0);
    }
    asm volatile("s_waitcnt lgkmcnt(0)" ::: "memory");
    __builtin_amdgcn_s_barrier();
#undef GT_STAGE
}

DEVI float proj_at(const bf16* PROJ, int t, int col) { return bf2f(PROJ[(size_t)t * NPROJ + col]); }
DEVI float proj_shift(const bf16* PROJ, int t, int col, float mu) {
    const float cur = proj_at(PROJ, t, col);
    const float prv = t > 0 ? proj_at(PROJ, t - 1, col) : 0.f;
    return cur + (prv - cur) * mu;
}

DEVI f32x4 shift4(const bf16* PROJ, int t, int col, const f32x4& mu) {
    const f32x4 cur = ld_bf4(PROJ + (size_t)t * NPROJ + col);
    f32x4 prv = ld_bf4(PROJ + (size_t)(t > 0 ? t - 1 : 0) * NPROJ + col);
    const float keep = t > 0 ? 1.f : 0.f;
    prv = prv * keep;
    return cur + (prv - cur) * mu;
}
DEVI float fsig(float x) { return sigmoidf_(x); }
DEVI void phase_mixprep(const P& p, int l, char* smem) {
    const bf16* PROJ = (const bf16*)(p.ws + WS_PROJ); const float* PEX = (const float*)(p.ws + WS_PEX);
    float* VFIRST = (float*)(p.ws + WS_VFIRST);
    bf16* RECR = (bf16*)(p.ws + WS_RECR); bf16* RECG = (bf16*)(p.ws + WS_RECG); bf16* RECT = (bf16*)(p.ws + WS_RECT);
    float* WDEC = (float*)(p.ws + WS_WDEC); float* GSC = (float*)(p.ws + WS_GSC);
    float* GB = (float*)(p.ws + WS_G); float* BON = (float*)(p.ws + WS_BON);
    const float* ROT = (const float*)(p.ws + WS_ROT);
    const bf16* LRT = (const bf16*)(p.ws + WS_LRT) + (size_t)l * 73728;
    bf16* L = (bf16*)smem;
    float* CW = (float*)(smem + 9728);
    float* MU = CW + 6144;
    float* PW0 = MU + 1024; float* PA0 = PW0 + 256; float* PKK = PA0 + 256; float* PKA = PKK + 256; float* PRK = PKA + 256; float* PV0 = PRK + 256;
    {
        const int tid = VTID;
        for (int i = tid; i < 6144; i += NT) CW[i] = p.in[21][l * 6144 + i];
        for (int i = tid; i < 1024; i += NT) MU[i] = p.in[7][l * 1024 + i];
        PW0[tid] = p.in[9][l * 256 + tid]; PA0[tid] = p.in[11][l * 256 + tid]; PKK[tid] = p.in[14][l * 256 + tid];
        PKA[tid] = p.in[15][l * 256 + tid]; PRK[tid] = p.in[16][l * 256 + tid]; PV0[tid] = (l == 1) ? p.in[19][tid] : 0.f;
    }
    __syncthreads();
    for (int item = VBID; item < S / 16; item += VNB) {
        int tid = VTID; asm volatile("" : "+v"(tid));
        const int lane = tid & 63, w = tid >> 6, fr = lane & 15, fq = lane >> 4;
        const int t0 = item * 16;
        {
            u32x2 cur[5], prv[5]; f32x4 xc[5], xp[5];
#pragma unroll
            for (int q = 0; q < 5; ++q) {
                const int g = tid + 256 * q, gg = g < 1152 ? g : 1151, tt = gg / 72, i4 = (gg % 72) * 4, t = t0 + tt, tp = t > 0 ? t - 1 : 0;
                const int ia = i4 < 256 ? i4 : 252, ib = i4 < 256 ? 0 : i4 - 256;
                cur[q] = *(const u32x2*)(PROJ + (size_t)t * NPROJ + 768 + ia); prv[q] = *(const u32x2*)(PROJ + (size_t)tp * NPROJ + 768 + ia);
                xc[q] = *(const f32x4*)(PEX + (size_t)t * 64 + 8 + ib); xp[q] = *(const f32x4*)(PEX + (size_t)tp * 64 + 8 + ib);
            }
            asm volatile("" ::: "memory");
#pragma unroll
            for (int q = 0; q < 5; ++q) {
                const int g = tid + 256 * q, gg = g < 1152 ? g : 1151, tt = gg / 72, i4 = (gg % 72) * 4, t = t0 + tt;
                const float keep = t > 0 ? 1.f : 0.f;
                f32x4 v;
                if (i4 < 256) {
                    const f32x4 c4 = {__uint_as_float(cur[q].x << 16), __uint_as_float(cur[q].x & 0xffff0000u), __uint_as_float(cur[q].y << 16), __uint_as_float(cur[q].y & 0xffff0000u)};
                    const f32x4 p4 = (f32x4){__uint_as_float(prv[q].x << 16), __uint_as_float(prv[q].x & 0xffff0000u), __uint_as_float(prv[q].y << 16), __uint_as_float(prv[q].y & 0xffff0000u)} * keep;
                    v = c4 + (p4 - c4) * *(const f32x4*)(MU + 768 + i4);
                    if (i4 < 64) { v.x = tanhf(v.x); v.y = tanhf(v.y); v.z = tanhf(v.z); v.w = tanhf(v.w); }
                    else if (i4 >= 128) { v.x = fsig(v.x); v.y = fsig(v.y); v.z = fsig(v.z); v.w = fsig(v.w); }
                } else {
                    v = (f32x4){0.f, 0.f, 0.f, 0.f};
                    if (l == 1) v = xc[q] + (xp[q] * keep - xc[q]) * *(const f32x4*)(p.in[8] + (i4 - 256));
                }
                if (g < 1152) *(u32x2*)(L + tt * 296 + i4) = (u32x2){pk2(v.x, v.y), pk2(v.z, v.w)};
            }
        }
        __syncthreads();
        const int t = t0 + fr, h = w, tpv = t > 0 ? t - 1 : 0;
        const float keep = t > 0 ? 1.f : 0.f;
        {
            f32x4 aw[4], aa[4], ag[4], av[4];
#pragma unroll
            for (int i = 0; i < 4; ++i) { aw[i] = (f32x4){0.f, 0.f, 0.f, 0.f}; aa[i] = aw[i]; ag[i] = aw[i]; av[i] = aw[i]; }
            bf16x8 lf[9];
#pragma unroll
            for (int ks = 0; ks < 9; ++ks) lf[ks] = *(const bf16x8*)(L + fr * 296 + ks * 32 + fq * 8);
#pragma unroll
            for (int i = 0; i < 4; ++i) {
                const int c = 64 * h + 16 * i + fr;
#pragma unroll
                for (int ks = 0; ks < 2; ++ks) aw[i] = mfma16(*(const bf16x8*)(LRT + c * 64 + ks * 32 + fq * 8), lf[ks], aw[i]);
#pragma unroll
                for (int ks = 0; ks < 2; ++ks) aa[i] = mfma16(*(const bf16x8*)(LRT + 16384 + c * 64 + ks * 32 + fq * 8), lf[2 + ks], aa[i]);
#pragma unroll
                for (int ks = 0; ks < 4; ++ks) ag[i] = mfma16(*(const bf16x8*)(LRT + 32768 + c * 128 + ks * 32 + fq * 8), lf[4 + ks], ag[i]);
                if (l == 1) av[i] = mfma16(*(const bf16x8*)(LRT + 65536 + c * 32 + fq * 8), lf[8], av[i]);
            }
            bf16* rec = RECR + ((size_t)t * 4 + h) * 384;
            f32x4 kx[4], as_[4];
            float ss = 0.f, bsum = 0.f;
#define UNPK4(u) ((f32x4){__uint_as_float((u).x << 16), __uint_as_float((u).x & 0xffff0000u), __uint_as_float((u).y << 16), __uint_as_float((u).y & 0xffff0000u)})
            u32x2 rc[4], rp[4], kc[4], kp[4], vc[4], vp[4]; f32x4 vf4[4];
#pragma unroll
            for (int i = 0; i < 4; ++i) {
                const int j = 16 * i + 4 * fq, c = 64 * h + j;
                if ((i & 1) == 0) {
#pragma unroll
                    for (int i2 = i; i2 < i + 2; ++i2) {
                        const int c2 = 64 * h + 16 * i2 + 4 * fq;
                        rc[i2] = *(const u32x2*)(PROJ + (size_t)t * NPROJ + c2); rp[i2] = *(const u32x2*)(PROJ + (size_t)tpv * NPROJ + c2);
                        kc[i2] = *(const u32x2*)(PROJ + (size_t)t * NPROJ + 256 + c2); kp[i2] = *(const u32x2*)(PROJ + (size_t)tpv * NPROJ + 256 + c2);
                        vc[i2] = *(const u32x2*)(PROJ + (size_t)t * NPROJ + 512 + c2); vp[i2] = *(const u32x2*)(PROJ + (size_t)tpv * NPROJ + 512 + c2);
                        if (l == 1) vf4[i2] = *(const f32x4*)(VFIRST + (size_t)t * 256 + c2);
                    }
                    asm volatile("" ::: "memory");
                }
                const f32x4 r0 = UNPK4(rc[i]), k0 = UNPK4(kc[i]), v0_ = UNPK4(vc[i]);
                const f32x4 r = r0 + (UNPK4(rp[i]) * keep - r0) * *(const f32x4*)(MU + c);
                const f32x4 k = k0 + (UNPK4(kp[i]) * keep - k0) * *(const f32x4*)(MU + 256 + c);
                f32x4 v = v0_ + (UNPK4(vp[i]) * keep - v0_) * *(const f32x4*)(MU + 512 + c);
                const f32x4 w0 = *(const f32x4*)(PW0 + c), a0 = *(const f32x4*)(PA0 + c);
                const f32x4 kkc = *(const f32x4*)(PKK + c), kac = *(const f32x4*)(PKA + c), rkc = *(const f32x4*)(PRK + c);
                f32x4 dec, a;
#pragma unroll
                for (int q = 0; q < 4; ++q) {
                    const float wl = -softplusf_(-(w0[q] + aw[i][q])) - 0.5f;
                    dec[q] = __expf(-__expf(wl));
                    a[q] = fsig(a0[q] + aa[i][q]);
                }
                if (l == 0) *(f32x4*)(VFIRST + (size_t)t * 256 + c) = v;
                else {
                    const f32x4 v0 = *(const f32x4*)(PV0 + c);
#pragma unroll
                    for (int q = 0; q < 4; ++q) v[q] = v[q] + (vf4[i][q] - v[q]) * fsig(v0[q] + av[i][q]);
                }
                kx[i] = k * kkc; as_[i] = a;
                const f32x4 k2 = k * ((a - 1.f) * kac + 1.f);
                ss += kx[i].x * kx[i].x + kx[i].y * kx[i].y + kx[i].z * kx[i].z + kx[i].w * kx[i].w;
                const f32x4 rb = r * k2 * rkc;
                bsum += (rb.x + rb.y) + (rb.z + rb.w);
                *(f32x4*)(WDEC + (size_t)t * 256 + c) = dec; st_bf4(rec + 192 + j, k2); st_bf4(rec + 256 + j, r); st_bf4(rec + 320 + j, v);
                *(f32x4*)(GB + (size_t)t * 256 + c) = ag[i];
            }
            const float rn = rsqrtf(quad_sum(ss) + 1e-12f);
            bsum = quad_sum(bsum);
            if (fq == 0) BON[(size_t)t * 4 + h] = bsum;
#pragma unroll
            for (int i = 0; i < 4; ++i) {
                const int j = 16 * i + 4 * fq;
                const f32x4 kk = kx[i] * rn;
                st_bf4(rec + j, -kk); st_bf4(rec + 128 + j, kk * as_[i]);
            }
        }
        {
            bf16* rec = RECG + ((size_t)t * 4 + h) * 392;
            f32x4 yq[8], yk[8];
            float sq = 0.f, sk = 0.f;
            size_t rowo[4];
            float tapm[4];
#pragma unroll
            for (int tap = 0; tap < 4; ++tap) { const int tp = t - 3 + tap; rowo[tap] = (size_t)(tp >= 0 ? tp : 0) * NPROJ; tapm[tap] = tp >= 0 ? 1.f : 0.f; }
#pragma unroll
            for (int which = 0; which < 3; ++which) {
                u32x2 raw[8][4];
#pragma unroll
                for (int i = 0; i < 8; ++i) {
                    if ((i & 3) == 0) {
#pragma unroll
                        for (int i2 = i; i2 < i + 4; ++i2)
#pragma unroll
                            for (int tap = 0; tap < 4; ++tap) raw[i2][tap] = *(const u32x2*)(PROJ + rowo[tap] + 1024 + which * 512 + h * 128 + 16 * i2 + 4 * fq);
                        asm volatile("" ::: "memory");
                    }
                    const int j = 16 * i + 4 * fq, ch = which * 512 + h * 128 + j;
                    f32x4 cv = {0.f, 0.f, 0.f, 0.f};
#pragma unroll
                    for (int tap = 0; tap < 4; ++tap) cv = cv + UNPK4(raw[i][tap]) * (*(const f32x4*)(CW + tap * 1536 + ch) * tapm[tap]);
                    f32x4 y; y.x = siluf_(cv.x); y.y = siluf_(cv.y); y.z = siluf_(cv.z); y.w = siluf_(cv.w);
                    if (which == 0) { yq[i] = y; sq += y.x * y.x + y.y * y.y + y.z * y.z + y.w * y.w; }
                    else if (which == 1) { yk[i] = y; sk += y.x * y.x + y.y * y.y + y.z * y.z + y.w * y.w; }
                    else st_bf4(rec + 256 + j, y);
                }
            }
            const float rq = rsqrtf(quad_sum(sq) + 1e-12f) * 0.08838834764831845f, rk = rsqrtf(quad_sum(sk) + 1e-12f);
#pragma unroll
            for (int i = 0; i < 8; ++i) { const int j = 16 * i + 4 * fq; st_bf4(rec + j, yq[i] * rq); st_bf4(rec + 128 + j, yk[i] * rk); }
            if (fq == 0) {
                const float av = PEX[(size_t)t * 64 + h], bv = PEX[(size_t)t * 64 + 4 + h];
                const float g = -__expf(p.in[22][l * 4 + h]) * softplusf_(av + p.in[23][l * 4 + h]);
                *(f32x4*)(GSC + ((size_t)t * 4 + h) * 4) = (f32x4){__expf(g), fsig(bv), g, 0.f};
            }
        }
        {
            bf16* rec = RECT + ((size_t)t * 4 + h) * 192;
            u32x2 q1r[2], q2r[2], k1r[2], k2r[2], vr[4]; f32x4 c0r[2], c1r[2];
#pragma unroll
            for (int u = 0; u < 2; ++u) {
                const int i = 16 * u + 4 * fq;
                c0r[u] = *(const f32x4*)(ROT + ((size_t)t * 32 + i) * 2); c1r[u] = *(const f32x4*)(ROT + ((size_t)t * 32 + i) * 2 + 4);
                q1r[u] = *(const u32x2*)(PROJ + (size_t)t * NPROJ + 3072 + h * 64 + i); q2r[u] = *(const u32x2*)(PROJ + (size_t)t * NPROJ + 3072 + h * 64 + 32 + i);
                k1r[u] = *(const u32x2*)(PROJ + (size_t)t * NPROJ + 3328 + h * 64 + i); k2r[u] = *(const u32x2*)(PROJ + (size_t)t * NPROJ + 3328 + h * 64 + 32 + i);
            }
#pragma unroll
            for (int i = 0; i < 4; ++i) vr[i] = *(const u32x2*)(PROJ + (size_t)t * NPROJ + 3584 + h * 64 + 16 * i + 4 * fq);
            asm volatile("" ::: "memory");
#pragma unroll
            for (int u = 0; u < 2; ++u) {
                const int i = 16 * u + 4 * fq;
                const f32x4 cs = {c0r[u].x, c0r[u].z, c1r[u].x, c1r[u].z}, sn = {c0r[u].y, c0r[u].w, c1r[u].y, c1r[u].w};
                const f32x4 q1 = UNPK4(q1r[u]), q2 = UNPK4(q2r[u]), k1 = UNPK4(k1r[u]), k2 = UNPK4(k2r[u]);
                st_bf4(rec + i, q1 * cs - q2 * sn); st_bf4(rec + 32 + i, q1 * sn + q2 * cs);
                st_bf4(rec + 64 + i, (k1 * cs - k2 * sn) * 0.125f); st_bf4(rec + 96 + i, (k1 * sn + k2 * cs) * 0.125f);
            }
#pragma unroll
            for (int i = 0; i < 4; ++i) *(u32x2*)(rec + 128 + 16 * i + 4 * fq) = vr[i];
        }
#undef UNPK4
        __syncthreads();
    }
}

DEVI void retA_item(const P& p, int item, char* smem) {
    const bf16* REC = (const bf16*)(p.ws + WS_RECT); float* KV = (float*)(p.ws + WS_RKV);
    bf16* KT = (bf16*)smem; bf16* VT = KT + 64 * 72;
    const int n = item >> 2, h = item & 3;
    int tid = VTID; asm volatile("" : "+v"(tid));
    const int lane = tid & 63, w = tid >> 6, fr = lane & 15, fq = lane >> 4;
    const float lg = log2f(1.f - exp2f(-5.f - (float)h));
    {
        u32x4 v[4];
#pragma unroll
        for (int i = 0; i < 4; ++i) { const int idx = tid + 256 * i, c = idx >> 4, j = idx & 15; v[i] = *(const u32x4*)(REC + ((size_t)(n * 64 + c) * 4 + h) * 192 + 64 + j * 8); }
#pragma unroll
        for (int i = 0; i < 4; ++i) {
            const int idx = tid + 256 * i, c = idx >> 4, j = idx & 15;
            const float sc = (j < 8) ? exp2f((float)(63 - c) * lg) : 1.f;
            bf16* dst = ((j < 8) ? KT : VT) + ((j & 7) * 8) * 72 + c;
#pragma unroll
            for (int q = 0; q < 4; ++q) {
                const unsigned u = v[i][q];
                dst[(2 * q) * 72] = (j < 8) ? (bf16)f2bf(__uint_as_float(u << 16) * sc) : (bf16)(u & 0xffffu);
                dst[(2 * q + 1) * 72] = (j < 8) ? (bf16)f2bf(__uint_as_float(u & 0xffff0000u) * sc) : (bf16)(u >> 16);
            }
        }
    }
    __syncthreads();
    {
        const int dt = w;
        const bf16x8 a0 = ldfrag(KT, 72, 16 * dt, 0, lane), a1 = ldfrag(KT, 72, 16 * dt, 32, lane);
        float* out = KV + (size_t)item * 4096;
        const int s_ = dt >> 1, lane2 = 16 * (2 * (dt & 1) + (fq >> 1)) + fr;
#pragma unroll
        for (int et = 0; et < 4; ++et) {
            f32x4 acc = {0.f, 0.f, 0.f, 0.f};
            acc = mfma16(a0, ldfrag(VT, 72, 16 * et, 0, lane), acc);
            acc = mfma16(a1, ldfrag(VT, 72, 16 * et, 32, lane), acc);
            *(f32x4*)(out + ((et * 2 + s_) * 64 + lane2) * 8 + 4 * (fq & 1)) = acc;
        }
    }
    __syncthreads();
}

DEVI void retS_item(const P& p, int item) {
    const float* KV = (const float*)(p.ws + WS_RKV); bf16* RST = (bf16*)(p.ws + WS_RST);
    const int idx = item * NT + VTID;
    const int h = idx >> 12, i = idx & 4095;
    const float cd = exp2f(64.f * log2f(1.f - exp2f(-5.f - (float)h)));
    float r = 0.f;
#pragma unroll 1
    for (int n0 = 0; n0 < 256; n0 += 32) {
        float kv[32];
#pragma unroll
        for (int q = 0; q < 32; ++q) kv[q] = KV[((size_t)(n0 + q) * 4 + h) * 4096 + i];
#pragma unroll
        for (int q = 0; q < 32; ++q) { RST[((size_t)(n0 + q) * 4 + h) * 4096 + i] = (bf16)f2bf(r); r = r * cd + kv[q]; }
    }
}

DEVI void retC_item(const P& p, int item, int l, char* smem) {
    const bf16* REC = (const bf16*)(p.ws + WS_RECT); const bf16* RST = (const bf16*)(p.ws + WS_RST);
    const bf16* PROJ = (const bf16*)(p.ws + WS_PROJ); bf16* MIX = (bf16*)(p.ws + WS_MIX);
    const float* rgn = p.in[25] + l * 256; const float* rbn = p.in[26] + l * 256;
    bf16* Qs = (bf16*)smem; bf16* Ks = Qs + 64 * 72; bf16* VT = Ks + 64 * 72; bf16* Ps = VT + 64 * 72;
    const int n = item >> 2, h = item & 3;
    int tid = VTID; asm volatile("" : "+v"(tid));
    const int lane = tid & 63, w = tid >> 6, fr = lane & 15, fq = lane >> 4;
    const float lg = log2f(1.f - exp2f(-5.f - (float)h));
    {
        u32x4 v[6];
#pragma unroll
        for (int i = 0; i < 6; ++i) { const int idx = tid + 256 * i, c = idx / 24, j = idx - c * 24; v[i] = *(const u32x4*)(REC + ((size_t)(n * 64 + c) * 4 + h) * 192 + j * 8); }
#pragma unroll
        for (int i = 0; i < 6; ++i) {
            const int idx = tid + 256 * i, c = idx / 24, j = idx - c * 24;
            if (j < 16) *(u32x4*)(((j < 8) ? Qs : Ks) + c * 72 + (j & 7) * 8) = v[i];
            else {
                bf16* dst = VT + ((j & 7) * 8) * 72 + c;
#pragma unroll
                for (int q = 0; q < 4; ++q) { const unsigned u = v[i][q]; dst[(2 * q) * 72] = (bf16)(u & 0xffffu); dst[(2 * q + 1) * 72] = (bf16)(u >> 16); }
            }
        }
    }
    __syncthreads();
    const int ct = w, c = 16 * ct + fr;
    const bf16x8 q0 = ldfrag(Qs, 72, 16 * ct, 0, lane), q1 = ldfrag(Qs, 72, 16 * ct, 32, lane);
#pragma unroll
    for (int ct2 = 0; ct2 < 4; ++ct2) {
        f32x4 acc = {0.f, 0.f, 0.f, 0.f};
        acc = mfma16(ldfrag(Ks, 72, 16 * ct2, 0, lane), q0, acc);
        acc = mfma16(ldfrag(Ks, 72, 16 * ct2, 32, lane), q1, acc);
        float pv[4];
#pragma unroll
        for (int j = 0; j < 4; ++j) {
            const int c2 = 16 * ct2 + 4 * fq + j;
            pv[j] = (c >= c2) ? acc[j] * exp2f((float)(c - c2) * lg) : 0.f;
        }
        *(u32x2*)(Ps + c * 72 + 16 * ct2 + 4 * fq) = (u32x2){pk2(pv[0], pv[1]), pk2(pv[2], pv[3])};
    }
    __syncthreads();
    {
        const bf16x8 p0 = ldfrag(Ps, 72, 16 * ct, 0, lane), p1 = ldfrag(Ps, 72, 16 * ct, 32, lane);
        const float xi = exp2f((float)(c + 1) * lg);
        const bf16* RF = RST + (size_t)item * 4096;
        f32x4 o[4];
        float sm = 0.f;
#pragma unroll
        for (int et = 0; et < 4; ++et) {
            f32x4 ai = {0.f, 0.f, 0.f, 0.f}, ax = {0.f, 0.f, 0.f, 0.f};
            ai = mfma16(ldfrag(VT, 72, 16 * et, 0, lane), p0, ai);
            ai = mfma16(ldfrag(VT, 72, 16 * et, 32, lane), p1, ai);
            const bf16x8 r0 = *(const bf16x8*)(RF + ((et * 2 + 0) * 64 + lane) * 8);
            const bf16x8 r1 = *(const bf16x8*)(RF + ((et * 2 + 1) * 64 + lane) * 8);
            ax = mfma16(r0, q0, ax);
            ax = mfma16(r1, q1, ax);
            o[et] = ai + ax * xi;
            sm += (o[et].x + o[et].y) + (o[et].z + o[et].w);
        }
        const float mean = quad_sum(sm) * (1.f / 64.f);
        float sv = 0.f;
#pragma unroll
        for (int et = 0; et < 4; ++et) { o[et] = o[et] - mean; sv += o[et].x * o[et].x + o[et].y * o[et].y + o[et].z * o[et].z + o[et].w * o[et].w; }
        const float rs = rsqrtf(quad_sum(sv) * (1.f / 64.f) + 1e-5f);
        const int t = n * 64 + c;
#pragma unroll
        for (int et = 0; et < 4; ++et) {
            const int e = h * 64 + 16 * et + 4 * fq;
            const f32x4 g = *(const f32x4*)(rgn + e), b = *(const f32x4*)(rbn + e);
            const f32x4 gt = ld_bf4(PROJ + (size_t)t * NPROJ + 3840 + e);
            const f32x4 y = o[et] * rs * g + b;
            *(u32x2*)(MIX + (size_t)t * D + 768 + e) = (u32x2){pk2(y.x * siluf_(gt.x), y.y * siluf_(gt.y)), pk2(y.z * siluf_(gt.z), y.w * siluf_(gt.w))};
        }
    }
    __syncthreads();
}

template <int I, int N> struct SolveRow {
    static DEVI void run(float (&x)[N], const float* M) {
        float s = 0.f;
#pragma unroll
        for (int j4 = 0; j4 < (I + 3) / 4; ++j4) {
            const f32x4 m = *(const f32x4*)(M + I * N + 4 * j4);
            s += m.x * x[4 * j4] + m.y * x[4 * j4 + 1] + m.z * x[4 * j4 + 2] + m.w * x[4 * j4 + 3];
        }
        x[I] -= s;
        asm volatile("" : "+v"(x[I]) :: "memory");
        SolveRow<I + 1, N>::run(x, M);
    }
};
template <int N> struct SolveRow<N, N> { static DEVI void run(float (&)[N], const float*) {} };

DEVI void gdnA_item(const P& p, int item, char* smem) {
    const bf16* REC = (const bf16*)(p.ws + WS_RECG); const float* GSC = (const float*)(p.ws + WS_GSC) + ((size_t)(item >> 2) * 64 * 4 + (item & 3)) * 4;
    bf16* GP = (bf16*)(p.ws + WS_GP) + (size_t)item * 16384; float* GB = (float*)(p.ws + WS_GB) + (size_t)item * 16384;
    float* GD = (float*)(p.ws + WS_GD);
    bf16* GQ = (bf16*)(p.ws + WS_GQ) + (size_t)item * 8192; float* GO = (float*)(p.ws + WS_GO) + (size_t)item * 8192;
    bf16* Kb = (bf16*)smem; bf16* Qb = Kb + 64 * 136;
    bf16* WT = (bf16*)smem; bf16* UT = WT + 128 * 72;
    bf16* Vb = (bf16*)(smem + 36864);
    float* M = (float*)(smem + 36864);
    bf16* KdT = (bf16*)(smem + 36864);
    bf16* At = (bf16*)(smem + 55296);
    float* gcs = (float*)(smem + 64512); float* bts = gcs + 64; float* sws = gcs + 128; float* sks = gcs + 192;
    const int n = item >> 2, h = item & 3;
    int tid = VTID; asm volatile("" : "+v"(tid));
    const int lane = tid & 63, w = tid >> 6, fr = lane & 15, fq = lane >> 4;
    const bf16* rec0 = REC + ((size_t)(n * 64) * 4 + h) * 392;
    if (w == 0) {
        float x = GSC[lane * 16 + 2];
#pragma unroll
        for (int off = 1; off < 64; off <<= 1) { const float y = __shfl_up(x, off); if (lane >= off) x += y; }
        const float bt = GSC[lane * 16 + 1];
        gcs[lane] = x; bts[lane] = bt; sws[lane] = bt * __expf(x); sks[lane] = __expf(__shfl(x, 63) - x);
    }
    {
        u32x4 v[12];
#pragma unroll
        for (int i = 0; i < 12; ++i) { const int idx = tid + 256 * i, c = idx / 48, j = idx - c * 48; v[i] = *(const u32x4*)(rec0 + (size_t)c * 1568 + j * 8); }
#pragma unroll
        for (int i = 0; i < 12; ++i) {
            const int idx = tid + 256 * i, c = idx / 48, j = idx - c * 48, which = j >> 4;
            const int boff = (which == 0 ? 17408 : 0) + (which == 2 ? 36864 : 0);
            *(u32x4*)(smem + boff + (c * 136 + (j & 15) * 8) * 2) = v[i];
        }
    }
    __syncthreads();
    float x[64];
    unsigned kdp[16];
    {
        const int col = tid & 127;
        int sel_b = (tid < 128) ? 36864 : 0, sel_s = (tid < 128) ? 64 : 128;
        asm volatile("" : "+v"(sel_b), "+v"(sel_s));
        const bf16* srcb = (const bf16*)(smem + sel_b) + col;
        const float* scs = gcs + sel_s;
#pragma unroll
        for (int c = 0; c < 64; ++c) {
            x[c] = scs[c] * bf2f(srcb[c * 136]);
            if ((c & 7) == 7) asm volatile("" : "+v"(x[c]) :: "memory");
        }
        const int half = tid >> 7;
#pragma unroll
        for (int i = 0; i < 16; ++i) {
            const int c = 32 * half + 2 * i;
            kdp[i] = pk2(bf2f(Kb[c * 136 + col]) * sks[c], bf2f(Kb[(c + 1) * 136 + col]) * sks[c + 1]);
            if ((i & 3) == 3) asm volatile("" : "+v"(kdp[i]) :: "memory");
        }
        if (tid == 0) GD[item] = __expf(gcs[63]);
    }
    __syncthreads();
    const int ct = w;
    f32x4 accQ[8];
    {
        const int c = 16 * ct + fr;
        const float gcc = gcs[c];
        {
            bf16x8 ka[4];
#pragma unroll
            for (int s = 0; s < 4; ++s) ka[s] = ldfrag(Kb, 136, 16 * ct, 32 * s, lane);
#pragma unroll
            for (int ct2 = 0; ct2 < 4; ++ct2) {
                f32x4 acc = {0.f, 0.f, 0.f, 0.f};
#pragma unroll
                for (int s = 0; s < 4; ++s) acc = mfma16(ka[s], ldfrag(Kb, 136, 16 * ct2, 32 * s, lane), acc);
                const int c2 = 16 * ct2 + fr; const float g2 = gcs[c2];
#pragma unroll
                for (int j = 0; j < 4; ++j) {
                    const int cc = 16 * ct + 4 * fq + j;
                    M[cc * 64 + c2] = (cc > c2) ? bts[cc] * acc[j] * __expf(gcs[cc] - g2) : 0.f;
                }
            }
        }
        {
            bf16x8 qa[4];
#pragma unroll
            for (int s = 0; s < 4; ++s) qa[s] = ldfrag(Qb, 136, 16 * ct, 32 * s, lane);
#pragma unroll
            for (int ct2 = 0; ct2 < 4; ++ct2) {
                f32x4 acc = {0.f, 0.f, 0.f, 0.f};
#pragma unroll
                for (int s = 0; s < 4; ++s) acc = mfma16(ldfrag(Kb, 136, 16 * ct2, 32 * s, lane), qa[s], acc);
                float pv[4];
#pragma unroll
                for (int j = 0; j < 4; ++j) { const int c2 = 16 * ct2 + 4 * fq + j; pv[j] = (c >= c2) ? acc[j] * __expf(gcc - gcs[c2]) : 0.f; }
                *(u32x2*)(At + c * 72 + 16 * ct2 + 4 * fq) = (u32x2){pk2(pv[0], pv[1]), pk2(pv[2], pv[3])};
            }
        }
    }
    __syncthreads();
    {
        SolveRow<1, 64>::run(x, M);
        unsigned xp[32];
#pragma unroll
        for (int q = 0; q < 32; ++q) xp[q] = pk2(x[2 * q], x[2 * q + 1]);
        {
            const int c = 16 * ct + fr;
            const float eg = __expf(gcs[c]);
#pragma unroll
            for (int dt = 0; dt < 8; ++dt) accQ[dt] = ld_bf4(Qb + c * 136 + 16 * dt + 4 * fq) * (-eg);
        }
        __syncthreads();
        int sel_d = (tid < 128) ? 128 * 72 : 0;
        asm volatile("" : "+v"(sel_d));
        bf16* dst = WT + sel_d + (tid & 127) * 72;
#pragma unroll
        for (int q = 0; q < 8; ++q) *(u32x4*)(dst + 8 * q) = (u32x4){xp[4 * q], xp[4 * q + 1], xp[4 * q + 2], xp[4 * q + 3]};
    }
    __syncthreads();
    {
        const int d = tid & 127, half = tid >> 7;
#pragma unroll
        for (int q = 0; q < 4; ++q) *(u32x4*)(KdT + d * 72 + 32 * half + 8 * q) = (u32x4){kdp[4 * q], kdp[4 * q + 1], kdp[4 * q + 2], kdp[4 * q + 3]};
    }
    __syncthreads();
    {
#pragma unroll 1
        for (int mi = 0; mi < 2; ++mi) {
            const int mt = 2 * w + mi;
            const bf16x8 kd0 = ldfrag(KdT, 72, 16 * mt, 0, lane), kd1 = ldfrag(KdT, 72, 16 * mt, 32, lane);
#pragma unroll
            for (int sp = 0; sp < 4; ++sp) {
                f32x4 a0 = {0.f, 0.f, 0.f, 0.f}, a1 = {0.f, 0.f, 0.f, 0.f};
                a0 = mfma16(ldfrag(WT, 72, 32 * sp, 0, lane), kd0, a0); a0 = mfma16(ldfrag(WT, 72, 32 * sp, 32, lane), kd1, a0);
                a1 = mfma16(ldfrag(WT, 72, 32 * sp + 16, 0, lane), kd0, a1); a1 = mfma16(ldfrag(WT, 72, 32 * sp + 16, 32, lane), kd1, a1);
                *(u32x4*)(GP + ((mt * 4 + sp) * 64 + lane) * 8) = (u32x4){pk2(-a0.x, -a0.y), pk2(-a0.z, -a0.w), pk2(-a1.x, -a1.y), pk2(-a1.z, -a1.w)};
            }
#pragma unroll
            for (int nt = 0; nt < 8; ++nt) {
                f32x4 a = {0.f, 0.f, 0.f, 0.f};
                a = mfma16(kd0, ldfrag(UT, 72, 16 * nt, 0, lane), a); a = mfma16(kd1, ldfrag(UT, 72, 16 * nt, 32, lane), a);
                *(f32x4*)(GB + ((nt * 8 + mt) * 64 + lane) * 4) = a;
            }
        }
        const bf16x8 at0 = ldfrag(At, 72, 16 * ct, 0, lane), at1 = ldfrag(At, 72, 16 * ct, 32, lane);
#pragma unroll
        for (int sp = 0; sp < 4; ++sp) {
            f32x4 a0 = accQ[2 * sp], a1 = accQ[2 * sp + 1];
            a0 = mfma16(ldfrag(WT, 72, 32 * sp, 0, lane), at0, a0); a0 = mfma16(ldfrag(WT, 72, 32 * sp, 32, lane), at1, a0);
            a1 = mfma16(ldfrag(WT, 72, 32 * sp + 16, 0, lane), at0, a1); a1 = mfma16(ldfrag(WT, 72, 32 * sp + 16, 32, lane), at1, a1);
            *(u32x4*)(GQ + ((ct * 4 + sp) * 64 + lane) * 8) = (u32x4){pk2(-a0.x, -a0.y), pk2(-a0.z, -a0.w), pk2(-a1.x, -a1.y), pk2(-a1.z, -a1.w)};
        }
#pragma unroll
        for (int et = 0; et < 8; ++et) {
            f32x4 a = {0.f, 0.f, 0.f, 0.f};
            a = mfma16(ldfrag(UT, 72, 16 * et, 0, lane), at0, a); a = mfma16(ldfrag(UT, 72, 16 * et, 32, lane), at1, a);
            *(f32x4*)(GO + ((ct * 8 + et) * 64 + lane) * 4) = a;
        }
    }
    __syncthreads();
}

DEVI bf16x8 pack_frag(const f32x4& a, const f32x4& b) {
    const u32x4 v = {pk2(a.x, a.y), pk2(a.z, a.w), pk2(b.x, b.y), pk2(b.z, b.w)};
    return __builtin_bit_cast(bf16x8, v);
}
DEVI void gdnL1_item(const P& p, int item, char* smem) {
    const bf16* GP = (const bf16*)(p.ws + WS_GP); const float* GB = (const float*)(p.ws + WS_GB); const float* GD = (const float*)(p.ws + WS_GD);
    const int half = item & 1, kind = (item >> 1) & 1, g = (item >> 2) & 15, h = item >> 6;
    const int tid = VTID, lane = tid & 63, ew = half * 4 + (tid >> 6), fr = lane & 15, fq = lane >> 4;
    const int n0 = g * 16;
#define L1_DMA(n) do { const bf16* _s = GP + ((size_t)(n) * 4 + h) * 16384 + tid * 8; char* _d = smem + ((n) & 1) * 32768 + tid * 16; \
        _Pragma("unroll") for (int _i = 0; _i < 8; ++_i) __builtin_amdgcn_global_load_lds((const unsigned*)(_s + _i * 2048), (unsigned*)(_d + _i * 4096), 16, 0, 0); } while (0)
    f32x4 acc[8];
    L1_DMA(n0);
    if (kind == 0) {
        bf16* GS = (bf16*)(p.ws + WS_GS);
#pragma unroll
        for (int m = 0; m < 8; ++m) acc[m] = (f32x4){0.f, 0.f, 0.f, 0.f};
        f32x4 bcur[8], bnxt[8]; float dcur, dnxt = 0.f;
        {
            const float* Bn = GB + ((size_t)n0 * 4 + h) * 16384 + (ew * 8 * 64 + lane) * 4;
#pragma unroll
            for (int m = 0; m < 8; ++m) bcur[m] = *(const f32x4*)(Bn + m * 256);
            dcur = GD[(size_t)n0 * 4 + h];
        }
#pragma unroll 1
        for (int n = n0; n < n0 + 16; ++n) {
            const size_t it = (size_t)n * 4 + h;
            asm volatile("s_waitcnt vmcnt(0)" ::: "memory");
            __syncthreads();
            if (n + 1 < n0 + 16) {
                L1_DMA(n + 1);
                const float* Bn = GB + (it + 4) * 16384 + (ew * 8 * 64 + lane) * 4;
#pragma unroll
                for (int m = 0; m < 8; ++m) bnxt[m] = *(const f32x4*)(Bn + m * 256);
                dnxt = GD[it + 4];
            }
            const char* ring = smem + (n & 1) * 32768 + lane * 16;
            bf16x8 sf[4];
#pragma unroll
            for (int s = 0; s < 4; ++s) {
                sf[s] = pack_frag(acc[2 * s], acc[2 * s + 1]);
                *(bf16x8*)(GS + it * 16384 + ((ew * 4 + s) * 64 + lane) * 8) = sf[s];
            }
#pragma unroll
            for (int m = 0; m < 8; ++m) {
                f32x4 a = acc[m] * dcur + bcur[m];
#pragma unroll
                for (int s = 0; s < 4; ++s) a = mfma16(*(const bf16x8*)(ring + (m * 4 + s) * 1024), sf[s], a);
                acc[m] = a;
            }
#pragma unroll
            for (int m = 0; m < 8; ++m) bcur[m] = bnxt[m];
            dcur = dnxt;
        }
        float* E0 = (float*)(p.ws + WS_GE0) + (size_t)(h * 16 + g) * 16384 + (ew * 8 * 64 + lane) * 4;
#pragma unroll
        for (int m = 0; m < 8; ++m) *(f32x4*)(E0 + m * 256) = acc[m];
    } else {
        const bf16* GQ = (const bf16*)(p.ws + WS_GQ); bf16* GR = (bf16*)(p.ws + WS_GR);
#pragma unroll
        for (int m = 0; m < 8; ++m)
#pragma unroll
            for (int j = 0; j < 4; ++j) acc[m][j] = (m == ew && 4 * fq + j == fr) ? 1.f : 0.f;
#pragma unroll 1
        for (int n = n0; n < n0 + 16; ++n) {
            const size_t it = (size_t)n * 4 + h;
            asm volatile("s_waitcnt vmcnt(0)" ::: "memory");
            __syncthreads();
            if (n + 1 < n0 + 16) L1_DMA(n + 1);
            bf16x8 qf[16];
#pragma unroll
            for (int i = 0; i < 16; ++i) qf[i] = *(const bf16x8*)(GQ + it * 8192 + (i * 64 + lane) * 8);
            const float dn = GD[it];
            const char* ring = smem + (n & 1) * 32768 + lane * 16;
            bf16x8 tf[4];
#pragma unroll
            for (int s = 0; s < 4; ++s) tf[s] = pack_frag(acc[2 * s], acc[2 * s + 1]);
#pragma unroll
            for (int m = 0; m < 8; ++m) {
                f32x4 a = acc[m] * dn;
#pragma unroll
                for (int s = 0; s < 4; ++s) a = mfma16(*(const bf16x8*)(ring + (m * 4 + s) * 1024), tf[s], a);
                acc[m] = a;
            }
#pragma unroll
            for (int tt = 0; tt < 4; ++tt) {
                f32x4 r = {0.f, 0.f, 0.f, 0.f};
#pragma unroll
                for (int s = 0; s < 4; ++s) r = mfma16(tf[s], qf[tt * 4 + s], r);
                *(u32x2*)(GR + it * 8192 + ((tt * 4 + (ew >> 1)) * 64 + lane) * 8 + 4 * (ew & 1)) = (u32x2){pk2(r.x, r.y), pk2(r.z, r.w)};
            }
        }
        bf16* TE = (bf16*)(p.ws + WS_GTE) + (size_t)(h * 16 + g) * 16384;
        const int s_ = ew >> 1, jj = 4 * (ew & 1) + (fr & 3), lg = fr >> 2;
#pragma unroll
        for (int m = 0; m < 8; ++m)
#pragma unroll
            for (int j = 0; j < 4; ++j) TE[((m * 4 + s_) * 64 + (4 * fq + j) + 16 * lg) * 8 + jj] = (bf16)f2bf(acc[m][j]);
    }
    asm volatile("s_waitcnt vmcnt(0)" ::: "memory");
    __syncthreads();
#undef L1_DMA
}
DEVI void gdnL2_item(const P& p, int item, char* smem) {
    const bf16* TE = (const bf16*)(p.ws + WS_GTE); const float* E0 = (const float*)(p.ws + WS_GE0); bf16* SG = (bf16*)(p.ws + WS_GSG);
    const int h = item >> 1, tid = VTID, lane = tid & 63, ew = (item & 1) * 4 + (tid >> 6);
#define L2_DMA(g) do { const bf16* _s = TE + ((size_t)h * 16 + (g)) * 16384 + tid * 8; char* _d = smem + ((g) & 1) * 32768 + tid * 16; \
        _Pragma("unroll") for (int _i = 0; _i < 8; ++_i) __builtin_amdgcn_global_load_lds((const unsigned*)(_s + _i * 2048), (unsigned*)(_d + _i * 4096), 16, 0, 0); } while (0)
    f32x4 acc[8];
#pragma unroll
    for (int m = 0; m < 8; ++m) acc[m] = (f32x4){0.f, 0.f, 0.f, 0.f};
    L2_DMA(0);
    f32x4 bcur[8], bnxt[8];
    {
        const float* En = E0 + (size_t)h * 16 * 16384 + (ew * 8 * 64 + lane) * 4;
#pragma unroll
        for (int m = 0; m < 8; ++m) bcur[m] = *(const f32x4*)(En + m * 256);
    }
#pragma unroll 1
    for (int g = 0; g < 16; ++g) {
        const size_t hg = (size_t)h * 16 + g;
        asm volatile("s_waitcnt vmcnt(0)" ::: "memory");
        __syncthreads();
        if (g + 1 < 16) {
            L2_DMA(g + 1);
            const float* En = E0 + (hg + 1) * 16384 + (ew * 8 * 64 + lane) * 4;
#pragma unroll
            for (int m = 0; m < 8; ++m) bnxt[m] = *(const f32x4*)(En + m * 256);
        }
        const char* ring = smem + (g & 1) * 32768 + lane * 16;
        bf16x8 sf[4];
#pragma unroll
        for (int s = 0; s < 4; ++s) {
            sf[s] = pack_frag(acc[2 * s], acc[2 * s + 1]);
            *(bf16x8*)(SG + hg * 16384 + ((ew * 4 + s) * 64 + lane) * 8) = sf[s];
        }
#pragma unroll
        for (int m = 0; m < 8; ++m) {
            f32x4 a = bcur[m];
#pragma unroll
            for (int s = 0; s < 4; ++s) a = mfma16(*(const bf16x8*)(ring + (m * 4 + s) * 1024), sf[s], a);
            acc[m] = a;
        }
#pragma unroll
        for (int m = 0; m < 8; ++m) bcur[m] = bnxt[m];
    }
    asm volatile("s_waitcnt vmcnt(0)" ::: "memory");
    __syncthreads();
#undef L2_DMA
}

DEVI void gdnC_item(const P& p, int item, int l) {
    const bf16* GQ = (const bf16*)(p.ws + WS_GQ) + (size_t)item * 8192; const float* GO = (const float*)(p.ws + WS_GO) + (size_t)item * 8192;
    const bf16* GS = (const bf16*)(p.ws + WS_GS) + (size_t)item * 16384;
    const bf16* PROJ = (const bf16*)(p.ws + WS_PROJ); bf16* MIX = (bf16*)(p.ws + WS_MIX);
    const float* gn = p.in[24] + l * 128;
    const int n = item >> 2, h = item & 3;
    const int lane = VTID & 63, ct = VTID >> 6, fr = lane & 15, fq = lane >> 4;
    const bf16* GR = (const bf16*)(p.ws + WS_GR) + (size_t)item * 8192;
    const bf16* SG = (const bf16*)(p.ws + WS_GSG) + (size_t)(h * 16 + (n >> 4)) * 16384;
    bf16x8 qf[4], rf[4];
#pragma unroll
    for (int s = 0; s < 4; ++s) { qf[s] = *(const bf16x8*)(GQ + ((ct * 4 + s) * 64 + lane) * 8); rf[s] = *(const bf16x8*)(GR + ((ct * 4 + s) * 64 + lane) * 8); }
    const int t = n * 64 + 16 * ct + fr;
    f32x4 a[8];
    float ss = 0.f;
#pragma unroll
    for (int et = 0; et < 8; ++et) {
        f32x4 acc = *(const f32x4*)(GO + ((ct * 8 + et) * 64 + lane) * 4);
#pragma unroll
        for (int s = 0; s < 4; ++s) acc = mfma16(*(const bf16x8*)(GS + ((et * 4 + s) * 64 + lane) * 8), qf[s], acc);
#pragma unroll
        for (int s = 0; s < 4; ++s) acc = mfma16(*(const bf16x8*)(SG + ((et * 4 + s) * 64 + lane) * 8), rf[s], acc);
        a[et] = acc;
        ss += acc.x * acc.x + acc.y * acc.y + acc.z * acc.z + acc.w * acc.w;
    }
    const float rs = rsqrtf(quad_sum(ss) * (1.f / 128.f) + 1e-6f);
#pragma unroll
    for (int et = 0; et < 8; ++et) {
        const int e = 16 * et + 4 * fq;
        const f32x4 z = ld_bf4(PROJ + (size_t)t * NPROJ + 2560 + h * 128 + e);
        const f32x4 g = *(const f32x4*)(gn + e);
        const f32x4 o = a[et] * rs * g;
        *(u32x2*)(MIX + (size_t)t * D + 256 + h * 128 + e) = (u32x2){pk2(o.x * siluf_(z.x), o.y * siluf_(z.y)), pk2(o.z * siluf_(z.z), o.w * siluf_(z.w))};
    }
}

DEVI void rwkA_item(const P& p, int item, char* smem) {
    const bf16* REC = (const bf16*)(p.ws + WS_RECR); const float* WDEC = (const float*)(p.ws + WS_WDEC);
    bf16* WP = (bf16*)(p.ws + WS_WP) + (size_t)item * 4096; float* WC = (float*)(p.ws + WS_WC) + (size_t)item * 4096;
    float* WD = (float*)(p.ws + WS_WD) + (size_t)item * 64;
    bf16* WQ = (bf16*)(p.ws + WS_WQ) + (size_t)item * 2048; float* WY = (float*)(p.ws + WS_WY) + (size_t)item * 2048;
    bf16* At_ = (bf16*)smem; bf16* Rt = At_ + 32 * 72; bf16* Bt = Rt + 32 * 72; bf16* Kt = Bt + 32 * 72;
    float* ZT = (float*)(smem + 9216);
    bf16* BhT = (bf16*)(smem + 18432); bf16* KhT = BhT + 64 * 40; bf16* VT = KhT + 64 * 40; bf16* AhT = VT + 64 * 40; bf16* UhT = AhT + 64 * 40;
    float* M = (float*)(smem + 44032);
    bf16* Aak = (bf16*)(smem + 48128); bf16* Arb = Aak + 32 * 40; bf16* Ark = Arb + 32 * 40;
    float* tot = (float*)(smem + 55808);
    const int n = item >> 2, h = item & 3;
    int tid = VTID; asm volatile("" : "+v"(tid));
    const int lane = tid & 63, w = tid >> 6, fr = lane & 15, fq = lane >> 4;
    {
        const int d = lane;
        const bf16* rec = REC + ((size_t)(n * 32 + 8 * w) * 4 + h) * 384 + d;
        const float* dcy = WDEC + (size_t)(n * 32 + 8 * w) * 256 + h * 64 + d;
        float lw[8], lg[8];
        float run = 0.f;
#pragma unroll
        for (int i = 0; i < 8; ++i) { lg[i] = __logf(dcy[i * 256]); run += lg[i]; lw[i] = run; }
        tot[w * 64 + d] = run;
        __syncthreads();
        float off = 0.f, total = 0.f;
#pragma unroll
        for (int q = 0; q < 4; ++q) { const float tq = tot[q * 64 + d]; total += tq; off += (q < w) ? tq : 0.f; }
        unsigned bh[4], kh[4], vv[4];
        float pb = 0.f, pk = 0.f, pv = 0.f;
#pragma unroll
        for (int i = 0; i < 8; ++i) {
            const bf16* r = rec + (size_t)i * 1536;
            const float a = bf2f(r[0]), b = bf2f(r[128]), k = bf2f(r[192]), rr = bf2f(r[256]), v = bf2f(r[320]);
            const float lc = off + lw[i];
            const float cw = __expf(lc), cwm1 = __expf(lc - lg[i]), inv = __expf(-lc), rat = __expf(total - lc);
            const int t = 8 * w + i;
            At_[t * 72 + d] = (bf16)f2bf(a * cwm1); Rt[t * 72 + d] = (bf16)f2bf(rr * cw);
            Bt[t * 72 + d] = (bf16)f2bf(b * inv); Kt[t * 72 + d] = (bf16)f2bf(k * inv);
            if (i & 1) { bh[i >> 1] = pk2(pb, b * rat); kh[i >> 1] = pk2(pk, k * rat); vv[i >> 1] = pk2(pv, v); }
            else { pb = b * rat; pk = k * rat; pv = v; }
        }
        *(u32x4*)(BhT + d * 40 + 8 * w) = (u32x4){bh[0], bh[1], bh[2], bh[3]};
        *(u32x4*)(KhT + d * 40 + 8 * w) = (u32x4){kh[0], kh[1], kh[2], kh[3]};
        *(u32x4*)(VT + d * 40 + 8 * w) = (u32x4){vv[0], vv[1], vv[2], vv[3]};
        if (w == 0) WD[d] = __expf(total);
    }
    __syncthreads();
    {
        int offA = (w == 0) ? 0 : (w == 1 ? 3 : (w == 2 ? 2 : 3));
        int offB = (w == 0) ? 2 : (w == 1 ? 0 : 1);
        asm volatile("" : "+v"(offA), "+v"(offB));
        const bf16* As = At_ + offA * (32 * 72); const bf16* Bs = At_ + offB * (32 * 72);
#pragma unroll
        for (int ta = 0; ta < 2; ++ta) {
            const bf16x8 a0 = ldfrag(As, 72, 16 * ta, 0, lane), a1 = ldfrag(As, 72, 16 * ta, 32, lane);
#pragma unroll
            for (int tb = 0; tb < 2; ++tb) {
                f32x4 acc = {0.f, 0.f, 0.f, 0.f};
                acc = mfma16(a0, ldfrag(Bs, 72, 16 * tb, 0, lane), acc);
                acc = mfma16(a1, ldfrag(Bs, 72, 16 * tb, 32, lane), acc);
                if (w == 0) {
                    const int s_ = 16 * tb + fr;
#pragma unroll
                    for (int j = 0; j < 4; ++j) { const int t = 16 * ta + 4 * fq + j; M[t * 32 + s_] = (t > s_) ? -acc[j] : 0.f; }
                } else {
                    const int t = 16 * tb + fr;
                    float pv4[4];
#pragma unroll
                    for (int j = 0; j < 4; ++j) { const int s_ = 16 * ta + 4 * fq + j; pv4[j] = ((w == 1) ? (t > s_) : (t >= s_)) ? acc[j] : 0.f; }
                    int offD = w - 1; asm volatile("" : "+v"(offD));
                    *(u32x2*)(Aak + offD * (32 * 40) + t * 40 + 16 * ta + 4 * fq) = (u32x2){pk2(pv4[0], pv4[1]), pk2(pv4[2], pv4[3])};
                }
            }
        }
    }
    __syncthreads();
    {
        const int et = w;
        const bf16x8 vf = ldfrag(VT, 40, 16 * et, 0, lane);
#pragma unroll
        for (int tt = 0; tt < 2; ++tt) {
            f32x4 acc = {0.f, 0.f, 0.f, 0.f};
            acc = mfma16(ldfrag(Aak, 40, 16 * tt, 0, lane), vf, acc);
            *(f32x4*)(ZT + (16 * et + fr) * 36 + 16 * tt + 4 * fq) = acc;
        }
    }
    __syncthreads();
    if (tid < 128) {
        float x[32];
        if (tid < 64) {
#pragma unroll
            for (int t = 0; t < 32; ++t) x[t] = bf2f(At_[t * 72 + tid]);
        } else {
#pragma unroll
            for (int q = 0; q < 8; ++q) { const f32x4 z = *(const f32x4*)(ZT + (tid - 64) * 36 + 4 * q); x[4 * q] = z.x; x[4 * q + 1] = z.y; x[4 * q + 2] = z.z; x[4 * q + 3] = z.w; }
        }
        SolveRow<1, 32>::run(x, M);
        bf16* dst = AhT + tid * 40;
#pragma unroll
        for (int q = 0; q < 4; ++q)
            *(u32x4*)(dst + 8 * q) = (u32x4){pk2(x[8 * q], x[8 * q + 1]), pk2(x[8 * q + 2], x[8 * q + 3]), pk2(x[8 * q + 4], x[8 * q + 5]), pk2(x[8 * q + 6], x[8 * q + 7])};
    }
    __syncthreads();
    {
        const int mt = w;
        const bf16x8 bh = ldfrag(BhT, 40, 16 * mt, 0, lane), kh = ldfrag(KhT, 40, 16 * mt, 0, lane);
#pragma unroll
        for (int sp = 0; sp < 2; ++sp) {
            f32x4 a0 = {0.f, 0.f, 0.f, 0.f}, a1 = {0.f, 0.f, 0.f, 0.f};
            a0 = mfma16(ldfrag(AhT, 40, 32 * sp, 0, lane), bh, a0);
            a1 = mfma16(ldfrag(AhT, 40, 32 * sp + 16, 0, lane), bh, a1);
            *(u32x4*)(WP + ((mt * 2 + sp) * 64 + lane) * 8) = (u32x4){pk2(a0.x, a0.y), pk2(a0.z, a0.w), pk2(a1.x, a1.y), pk2(a1.z, a1.w)};
        }
#pragma unroll
        for (int nt = 0; nt < 4; ++nt) {
            f32x4 a = {0.f, 0.f, 0.f, 0.f};
            a = mfma16(bh, ldfrag(UhT, 40, 16 * nt, 0, lane), a);
            a = mfma16(kh, ldfrag(VT, 40, 16 * nt, 0, lane), a);
            *(f32x4*)(WC + ((nt * 4 + mt) * 64 + lane) * 4) = a;
        }
        {
            const int ct = w & 1, sp = w >> 1, t = 16 * ct + fr;
            const bf16x8 ar = ldfrag(Arb, 40, 16 * ct, 0, lane);
            f32x4 a0 = ld_bf4(Rt + t * 72 + 32 * sp + 4 * fq), a1 = ld_bf4(Rt + t * 72 + 32 * sp + 16 + 4 * fq);
            a0 = mfma16(ldfrag(AhT, 40, 32 * sp, 0, lane), ar, a0);
            a1 = mfma16(ldfrag(AhT, 40, 32 * sp + 16, 0, lane), ar, a1);
            *(u32x4*)(WQ + ((ct * 2 + sp) * 64 + lane) * 8) = (u32x4){pk2(a0.x, a0.y), pk2(a0.z, a0.w), pk2(a1.x, a1.y), pk2(a1.z, a1.w)};
        }
        {
            const int et = w;
            const bf16x8 uf = ldfrag(UhT, 40, 16 * et, 0, lane), vf = ldfrag(VT, 40, 16 * et, 0, lane);
#pragma unroll
            for (int ct = 0; ct < 2; ++ct) {
                f32x4 a = {0.f, 0.f, 0.f, 0.f};
                a = mfma16(uf, ldfrag(Arb, 40, 16 * ct, 0, lane), a);
                a = mfma16(vf, ldfrag(Ark, 40, 16 * ct, 0, lane), a);
                *(f32x4*)(WY + ((ct * 4 + et) * 64 + lane) * 4) = a;
            }
        }
    }
    __syncthreads();
}

struct RwkStep { bf16x8 pf[8]; f32x4 cf[4]; f32x4 dv[4]; };
DEVI void rwk_load(RwkStep& r, const bf16* WP, const float* WC, const float* WD, size_t it, int ew, int lane) {
#pragma unroll
    for (int i = 0; i < 8; ++i) r.pf[i] = *(const bf16x8*)(WP + it * 4096 + (i * 64 + lane) * 8);
#pragma unroll
    for (int m = 0; m < 4; ++m) r.cf[m] = *(const f32x4*)(WC + it * 4096 + ((ew * 4 + m) * 64 + lane) * 4);
#pragma unroll
    for (int m = 0; m < 4; ++m) r.dv[m] = *(const f32x4*)(WD + it * 64 + 16 * m + 4 * (lane >> 4));
}
DEVI void rwk_step(const RwkStep& r, f32x4 (&acc)[4], bf16* WSF, size_t it, int ew, int lane) {
    bf16x8 sf[2];
#pragma unroll
    for (int s = 0; s < 2; ++s) {
        const u32x4 v = {pk2(acc[2 * s].x, acc[2 * s].y), pk2(acc[2 * s].z, acc[2 * s].w), pk2(acc[2 * s + 1].x, acc[2 * s + 1].y), pk2(acc[2 * s + 1].z, acc[2 * s + 1].w)};
        *(u32x4*)(WSF + it * 4096 + ((ew * 2 + s) * 64 + lane) * 8) = v;
        sf[s] = __builtin_bit_cast(bf16x8, v);
    }
#pragma unroll
    for (int m = 0; m < 4; ++m) {
        f32x4 a = acc[m] * r.dv[m] + r.cf[m];
        a = mfma16(r.pf[m * 2], sf[0], a);
        a = mfma16(r.pf[m * 2 + 1], sf[1], a);
        acc[m] = a;
    }
}
DEVI void rwkL1_item(const P& p, int item) {
    const bf16* WP = (const bf16*)(p.ws + WS_WP); const float* WC = (const float*)(p.ws + WS_WC); const float* WD = (const float*)(p.ws + WS_WD);
    const int kind = item & 1, g = (item >> 1) & 15, h = item >> 5;
    const int lane = VTID & 63, ew = VTID >> 6, fr = lane & 15, fq = lane >> 4;
    f32x4 acc[4];
    if (kind == 0) {
        bf16* WSF = (bf16*)(p.ws + WS_WS);
#pragma unroll
        for (int m = 0; m < 4; ++m) acc[m] = (f32x4){0.f, 0.f, 0.f, 0.f};
        RwkStep A, B;
        const int n0 = g * 32;
        rwk_load(A, WP, WC, WD, (size_t)n0 * 4 + h, ew, lane);
#pragma unroll 1
        for (int n = n0; n < n0 + 32; n += 2) {
            rwk_load(B, WP, WC, WD, (size_t)(n + 1) * 4 + h, ew, lane);
            asm volatile("" ::: "memory");
            rwk_step(A, acc, WSF, (size_t)n * 4 + h, ew, lane);
            rwk_load(A, WP, WC, WD, (size_t)((n + 2 < n0 + 32) ? n + 2 : n) * 4 + h, ew, lane);
            asm volatile("" ::: "memory");
            rwk_step(B, acc, WSF, (size_t)(n + 1) * 4 + h, ew, lane);
        }
        float* E0 = (float*)(p.ws + WS_WE0) + (size_t)(h * 16 + g) * 4096 + (ew * 4 * 64 + lane) * 4;
#pragma unroll
        for (int m = 0; m < 4; ++m) *(f32x4*)(E0 + m * 256) = acc[m];
    } else {
        const bf16* WQ = (const bf16*)(p.ws + WS_WQ); bf16* WR = (bf16*)(p.ws + WS_WR);
#pragma unroll
        for (int m = 0; m < 4; ++m)
#pragma unroll
            for (int j = 0; j < 4; ++j) acc[m][j] = (m == ew && 4 * fq + j == fr) ? 1.f : 0.f;
#pragma unroll 1
        for (int n = g * 32; n < g * 32 + 32; ++n) {
            const size_t it = (size_t)n * 4 + h;
            bf16x8 pf[8], qf[4]; f32x4 dv[4];
#pragma unroll
            for (int i = 0; i < 8; ++i) pf[i] = *(const bf16x8*)(WP + it * 4096 + (i * 64 + lane) * 8);
#pragma unroll
            for (int i = 0; i < 4; ++i) qf[i] = *(const bf16x8*)(WQ + it * 2048 + (i * 64 + lane) * 8);
#pragma unroll
            for (int m = 0; m < 4; ++m) dv[m] = *(const f32x4*)(WD + it * 64 + 16 * m + 4 * fq);
            asm volatile("" ::: "memory");
            bf16x8 tf[2];
#pragma unroll
            for (int s = 0; s < 2; ++s) tf[s] = pack_frag(acc[2 * s], acc[2 * s + 1]);
#pragma unroll
            for (int tt = 0; tt < 2; ++tt) {
                f32x4 r = {0.f, 0.f, 0.f, 0.f};
                r = mfma16(tf[0], qf[tt * 2], r); r = mfma16(tf[1], qf[tt * 2 + 1], r);
                *(u32x2*)(WR + it * 2048 + ((tt * 2 + (ew >> 1)) * 64 + lane) * 8 + 4 * (ew & 1)) = (u32x2){pk2(r.x, r.y), pk2(r.z, r.w)};
            }
#pragma unroll
            for (int m = 0; m < 4; ++m) {
                f32x4 a = acc[m] * dv[m];
                a = mfma16(pf[m * 2], tf[0], a); a = mfma16(pf[m * 2 + 1], tf[1], a);
                acc[m] = a;
            }
        }
        bf16* TE = (bf16*)(p.ws + WS_WTE) + (size_t)(h * 16 + g) * 4096;
        const int s_ = ew >> 1, jj = 4 * (ew & 1) + (fr & 3), lg = fr >> 2;
#pragma unroll
        for (int m = 0; m < 4; ++m)
#pragma unroll
            for (int j = 0; j < 4; ++j) TE[((m * 2 + s_) * 64 + (4 * fq + j) + 16 * lg) * 8 + jj] = (bf16)f2bf(acc[m][j]);
    }
}
DEVI void rwkL2_item(const P& p, int h) {
    const bf16* TE = (const bf16*)(p.ws + WS_WTE); const float* E0 = (const float*)(p.ws + WS_WE0); bf16* SG = (bf16*)(p.ws + WS_WSG);
    const int lane = VTID & 63, ew = VTID >> 6;
    f32x4 acc[4];
#pragma unroll
    for (int m = 0; m < 4; ++m) acc[m] = (f32x4){0.f, 0.f, 0.f, 0.f};
#pragma unroll 1
    for (int g = 0; g < 16; ++g) {
        const size_t hg = (size_t)h * 16 + g;
        bf16x8 pf[8]; f32x4 bfr[4];
#pragma unroll
        for (int i = 0; i < 8; ++i) pf[i] = *(const bf16x8*)(TE + hg * 4096 + (i * 64 + lane) * 8);
#pragma unroll
        for (int m = 0; m < 4; ++m) bfr[m] = *(const f32x4*)(E0 + hg * 4096 + ((ew * 4 + m) * 64 + lane) * 4);
        asm volatile("" ::: "memory");
        bf16x8 sf[2];
#pragma unroll
        for (int s = 0; s < 2; ++s) {
            sf[s] = pack_frag(acc[2 * s], acc[2 * s + 1]);
            *(bf16x8*)(SG + hg * 4096 + ((ew * 2 + s) * 64 + lane) * 8) = sf[s];
        }
#pragma unroll
        for (int m = 0; m < 4; ++m) {
            f32x4 a = bfr[m];
            a = mfma16(pf[m * 2], sf[0], a); a = mfma16(pf[m * 2 + 1], sf[1], a);
            acc[m] = a;
        }
    }
}

DEVI void rwkC_item(const P& p, int n, int l) {
    const int lane = VTID & 63, h = VTID >> 6, fr = lane & 15, fq = lane >> 4;
    const size_t it = (size_t)n * 4 + h;
    const bf16* WQ = (const bf16*)(p.ws + WS_WQ) + it * 2048; const float* WY = (const float*)(p.ws + WS_WY) + it * 2048;
    const bf16* WSF = (const bf16*)(p.ws + WS_WS) + it * 4096;
    const bf16* WR = (const bf16*)(p.ws + WS_WR) + it * 2048; const bf16* WSG = (const bf16*)(p.ws + WS_WSG) + (size_t)(h * 16 + (n >> 5)) * 4096;
    const bf16* RECR = (const bf16*)(p.ws + WS_RECR); const float* GB = (const float*)(p.ws + WS_G); const float* BON = (const float*)(p.ws + WS_BON);
    bf16* MIX = (bf16*)(p.ws + WS_MIX);
    const float* ln_g = p.in[17] + l * 256 + h * 64; const float* ln_b = p.in[18] + l * 256 + h * 64;
#pragma unroll
    for (int ct = 0; ct < 2; ++ct) {
        const bf16x8 q0 = *(const bf16x8*)(WQ + ((ct * 2 + 0) * 64 + lane) * 8), q1 = *(const bf16x8*)(WQ + ((ct * 2 + 1) * 64 + lane) * 8);
        const bf16x8 r0 = *(const bf16x8*)(WR + ((ct * 2 + 0) * 64 + lane) * 8), r1 = *(const bf16x8*)(WR + ((ct * 2 + 1) * 64 + lane) * 8);
        const int t = n * 32 + 16 * ct + fr;
        f32x4 a[4];
        float sm = 0.f;
#pragma unroll
        for (int et = 0; et < 4; ++et) {
            f32x4 acc = *(const f32x4*)(WY + ((ct * 4 + et) * 64 + lane) * 4);
            acc = mfma16(*(const bf16x8*)(WSF + ((et * 2 + 0) * 64 + lane) * 8), q0, acc);
            acc = mfma16(*(const bf16x8*)(WSF + ((et * 2 + 1) * 64 + lane) * 8), q1, acc);
            acc = mfma16(*(const bf16x8*)(WSG + ((et * 2 + 0) * 64 + lane) * 8), r0, acc);
            acc = mfma16(*(const bf16x8*)(WSG + ((et * 2 + 1) * 64 + lane) * 8), r1, acc);
            a[et] = acc; sm += (acc.x + acc.y) + (acc.z + acc.w);
        }
        const float mean = quad_sum(sm) * (1.f / 64.f);
        float sv = 0.f;
#pragma unroll
        for (int et = 0; et < 4; ++et) { a[et] = a[et] - mean; sv += a[et].x * a[et].x + a[et].y * a[et].y + a[et].z * a[et].z + a[et].w * a[et].w; }
        const float rs = rsqrtf(quad_sum(sv) * (1.f / 64.f) + 64e-5f);
        const float bon = BON[(size_t)t * 4 + h];
#pragma unroll
        for (int et = 0; et < 4; ++et) {
            const int e = 16 * et + 4 * fq;
            const f32x4 g = *(const f32x4*)(ln_g + e), b = *(const f32x4*)(ln_b + e);
            const f32x4 v = ld_bf4(RECR + ((size_t)t * 4 + h) * 384 + 320 + e);
            const f32x4 gate = *(const f32x4*)(GB + (size_t)t * 256 + h * 64 + e);
            const f32x4 o = (a[et] * rs * g + b + v * bon) * gate;
            *(u32x2*)(MIX + (size_t)t * D + h * 64 + e) = (u32x2){pk2(o.x, o.y), pk2(o.z, o.w)};
        }
    }
}

DEVI void phase_scanL1(const P& p, char* smem) {
    for (int item = VBID; item < 448; item += VNB) {
        if (item < 256) gdnL1_item(p, item, smem);
        else if (item < 384) rwkL1_item(p, item - 256);
        else retS_item(p, item - 384);
    }
}
DEVI void retC_item(const P& p, int item, int l, char* smem);
DEVI void phase_scanL2(const P& p, int l, char* smem) {
    if (VBID < 12) { if (VBID < 8) gdnL2_item(p, VBID, smem); else rwkL2_item(p, VBID - 8); }
    else { for (int item = VBID - 12; item < 1024; item += VNB - 12) retC_item(p, item, l, smem); }
}
DEVI void phase_chunkA(const P& p, char* smem) {
    for (int item = VBID; item < 4096; item += VNB) { if (item < 1024) gdnA_item(p, item, smem); else if (item < 3072) rwkA_item(p, item - 1024, smem); else retA_item(p, item - 3072, smem); }
}
DEVI void phase_chunkC(const P& p, int l, char* smem) {
    for (int item = VBID; item < 1536; item += VNB) { if (item < 1024) gdnC_item(p, item, l); else rwkC_item(p, item - 1024, l); }
}

DEVI void phase_ln1_route(const P& p, int l, char* smem, bool commit = true) {
    const float* ADA = (const float*)(p.ws + OFF_ADA) + l * 6144;
    const float* xin = (l == 0) ? p.in[0] : (const float*)(p.ws + WS_X);
    const float* OPRE = (const float*)(p.ws + WS_OPRE);
    float* X = (float*)(p.ws + WS_X); bf16* H2 = (bf16*)(p.ws + WS_H2);
    const float* lg = p.in[28] + l * D; const float* lb = p.in[29] + l * D;
    const float* rw = p.in[30] + (size_t)l * D * 32; const float* rbias = p.in[31] + l * 32;
    int* CNT = (int*)(p.ws + OFF_CNT) + l * 32 * 64; int* LIST = (int*)(p.ws + WS_LIST); float* GATE = (float*)(p.ws + WS_GATE);
    float* HS = (float*)smem;
    float* RED = HS + 4 * 1024;
    int* SEL = (int*)(RED + 1024);
    int* RNK = SEL + 256;
    int* BASE = RNK + 256;
    int nasg = 0;
    const int tid = VTID, lane = tid & 63, w = tid >> 6;
    for (int item = VBID; item < S / 4; item += VNB) {
        const int t = item * 4 + w;
        {
            f32x4 v[4]; float s = 0.f;
#pragma unroll
            for (int j = 0; j < 4; ++j) {
                const int c = j * 256 + lane * 4;
                const f32x4 x = *(const f32x4*)(xin + (size_t)t * D + c);
                const f32x4 o = *(const f32x4*)(OPRE + (size_t)t * D + c);
                const f32x4 gt = *(const f32x4*)(ADA + 2048 + c);
                v[j].x = DN_ALPHA * x.x + (1.f + gt.x) * o.x; v[j].y = DN_ALPHA * x.y + (1.f + gt.y) * o.y;
                v[j].z = DN_ALPHA * x.z + (1.f + gt.z) * o.z; v[j].w = DN_ALPHA * x.w + (1.f + gt.w) * o.w;
                s += (v[j].x + v[j].y) + (v[j].z + v[j].w);
            }
            const float mean = wave_sum(s) * (1.f / D);
            float s2 = 0.f;
#pragma unroll
            for (int j = 0; j < 4; ++j) { v[j] = v[j] - mean; s2 += (v[j].x * v[j].x + v[j].y * v[j].y) + (v[j].z * v[j].z + v[j].w * v[j].w); }
            const float rstd = rsqrtf(wave_sum(s2) * (1.f / D) + 1e-5f);
#pragma unroll
            for (int j = 0; j < 4; ++j) {
                const int c = j * 256 + lane * 4;
                const f32x4 g = *(const f32x4*)(lg + c), b = *(const f32x4*)(lb + c);
                f32x4 xo = v[j] * rstd * g + b;
                *(f32x4*)(X + (size_t)t * D + c) = xo;
                const f32x4 sh = *(const f32x4*)(ADA + 3072 + c), sc = *(const f32x4*)(ADA + 4096 + c);
                f32x4 hh = xo * (1.f + sc) + sh;
                *(f32x4*)(HS + w * 1024 + c) = hh;
                u32x2 o; o.x = pk2(hh.x, hh.y); o.y = pk2(hh.z, hh.w);
                *(u32x2*)(H2 + (size_t)t * D + c) = o;
            }
        }
        __syncthreads();
        {
            const int e = tid & 31, ks = tid >> 5;
            float a0 = 0.f, a1 = 0.f, a2 = 0.f, a3 = 0.f;
#pragma unroll 4
            for (int k = ks * 128; k < ks * 128 + 128; k += 4) {
                const float w0 = rw[(k + 0) * 32 + e], w1 = rw[(k + 1) * 32 + e], w2 = rw[(k + 2) * 32 + e], w3 = rw[(k + 3) * 32 + e];
                const f32x4 h0 = *(const f32x4*)(HS + 0 * 1024 + k), h1 = *(const f32x4*)(HS + 1 * 1024 + k);
                const f32x4 h2 = *(const f32x4*)(HS + 2 * 1024 + k), h3 = *(const f32x4*)(HS + 3 * 1024 + k);
                a0 += h0.x * w0 + h0.y * w1 + h0.z * w2 + h0.w * w3;
                a1 += h1.x * w0 + h1.y * w1 + h1.z * w2 + h1.w * w3;
                a2 += h2.x * w0 + h2.y * w1 + h2.z * w2 + h2.w * w3;
                a3 += h3.x * w0 + h3.y * w1 + h3.z * w2 + h3.w * w3;
            }
            RED[(ks * 4 + 0) * 32 + e] = a0; RED[(ks * 4 + 1) * 32 + e] = a1; RED[(ks * 4 + 2) * 32 + e] = a2; RED[(ks * 4 + 3) * 32 + e] = a3;
        }
        __syncthreads();
        if (tid < 128) {
            const int tok = tid >> 5, e = tid & 31, tt = item * 4 + tok;
            float logit = rbias[e];
#pragma unroll
            for (int ks = 0; ks < 8; ++ks) logit += RED[(ks * 4 + tok) * 32 + e];
            bool taken = false;
            float sv[4]; int si[4];
#pragma unroll
            for (int j = 0; j < 4; ++j) {
                float cand = taken ? -3.0e38f : logit; int ci = e;
#pragma unroll
                for (int off = 16; off >= 1; off >>= 1) {
                    const float ov = __shfl_xor(cand, off, 32); const int oi = __shfl_xor(ci, off, 32);
                    if (ov > cand || (ov == cand && oi < ci)) { cand = ov; ci = oi; }
                }
                sv[j] = cand; si[j] = ci; if (ci == e) taken = true;
            }
            const float e0 = 1.f, e1 = __expf(sv[1] - sv[0]), e2 = __expf(sv[2] - sv[0]), e3 = __expf(sv[3] - sv[0]);
            const float inv = 1.f / (e0 + e1 + e2 + e3);
            const float gts[4] = {e0 * inv, e1 * inv, e2 * inv, e3 * inv};
#pragma unroll
            for (int j = 0; j < 4; ++j) {
                if (si[j] == e) {
                    SEL[nasg + tok * 4 + j] = ((tt * 4 + j) << 5) | e;
                    GATE[(size_t)tt * 4 + j] = gts[j];
                }
            }
        }
        nasg += 16;
        __syncthreads();
    }
    if (!commit) return;
    if (tid < 32) {
        int c = 0;
        for (int a = 0; a < nasg; ++a) { if ((SEL[a] & 31) == tid) { RNK[a] = c; ++c; } }
        BASE[tid] = c ? atomicAdd(&CNT[tid * 64], c) : 0;
    }
    __syncthreads();
    for (int a = tid; a < nasg; a += NT) { const int v = SEL[a], e = v & 31; LIST[(size_t)e * S + BASE[e] + RNK[a]] = v >> 5; }
    __syncthreads();
}

DEVI void phase_ln2(const P& p, int l) {
    const float* ADA = (const float*)(p.ws + OFF_ADA) + l * 6144;
    const float* ADAn = (const float*)(p.ws + OFF_ADA) + 6144;
    float* X = (float*)(p.ws + WS_X); const bf16* YB = (const bf16*)(p.ws + WS_YB);
    bf16* HB = (bf16*)(p.ws + WS_HB);
    const float* lg = p.in[36] + l * D; const float* lb = p.in[37] + l * D;
    const int tid = VTID, lane = tid & 63, w = tid >> 6;
    for (int item = VBID; item < S / 4; item += VNB) {
        const int t = item * 4 + w;
        f32x4 v[4]; float s = 0.f;
#pragma unroll
        for (int j = 0; j < 4; ++j) {
            const int c = j * 256 + lane * 4;
            const f32x4 x = *(const f32x4*)(X + (size_t)t * D + c);
            f32x4 f = {0.f, 0.f, 0.f, 0.f};
#pragma unroll
            for (int q = 0; q < 4; ++q) {
                const u32x2 y = *(const u32x2*)(YB + ((size_t)t * 4 + q) * D + c);
                f.x += __uint_as_float(y.x << 16); f.y += __uint_as_float(y.x & 0xffff0000u);
                f.z += __uint_as_float(y.y << 16); f.w += __uint_as_float(y.y & 0xffff0000u);
            }
            const f32x4 gt = *(const f32x4*)(ADA + 5120 + c);
            v[j] = x * DN_ALPHA + (gt + 1.f) * f;
            s += (v[j].x + v[j].y) + (v[j].z + v[j].w);
        }
        const float mean = wave_sum(s) * (1.f / D);
        float s2 = 0.f;
#pragma unroll
        for (int j = 0; j < 4; ++j) { v[j] = v[j] - mean; s2 += (v[j].x * v[j].x + v[j].y * v[j].y) + (v[j].z * v[j].z + v[j].w * v[j].w); }
        const float rstd = rsqrtf(wave_sum(s2) * (1.f / D) + 1e-5f);
#pragma unroll
        for (int j = 0; j < 4; ++j) {
            const int c = j * 256 + lane * 4;
            const f32x4 g = *(const f32x4*)(lg + c), b = *(const f32x4*)(lb + c);
            const f32x4 xo = v[j] * rstd * g + b;
            if (l == 0) {
                *(f32x4*)(X + (size_t)t * D + c) = xo;
                const f32x4 sh = *(const f32x4*)(ADAn + c), sc = *(const f32x4*)(ADAn + 1024 + c);
                const f32x4 hh = xo * (sc + 1.f) + sh;
                u32x2 o; o.x = pk2(hh.x, hh.y); o.y = pk2(hh.z, hh.w);
                *(u32x2*)(HB + (size_t)t * D + c) = o;
            } else {
                *(f32x4*)(p.out + (size_t)t * D + c) = xo;
            }
        }
    }
}

namespace pg8 {
constexpr int BK = 64, HALF = 128, HTB = HALF * BK * 2, STAGE_BYTES = 8 * HTB;
DEVI int lds_byte(int r, int c) { const int st = (r >> 4) * 2 + (c >> 5), rr = r & 15, cc = c & 31, ob = rr * 64 + cc * 2; return st * 1024 + (ob ^ (((ob >> 9) & 1) << 5)); }
DEVI void stage_rc(int b, int& R, int& C) { const int st = b / 1024, sb = b % 1024, swz = sb ^ (((sb >> 9) & 1) << 5); R = (st >> 1) * 16 + swz / 64; C = (st & 1) * 32 + (swz % 64) / 2; }
struct Unit { const char* a; const char* b; int x0, x1, x2, x3; };

template <class Epi, class Sched>
DEVI void gemm_phase(LAS unsigned char* lds, const int K, const Sched& S, const Epi& E) {
    const int tid = threadIdx.x, wid = __builtin_amdgcn_readfirstlane(tid >> 6), lane = tid & 63, wr = wid >> 2, wc = wid & 3, fr = lane & 15, fq = lane >> 4;
    const int nt = K / BK;
    unsigned voffA[2], voffB[2];
    int gR[2], gC[2];
#pragma unroll
    for (int i = 0; i < 2; ++i) { int R, C; stage_rc(tid * 16 + i * 8192, R, C); gR[i] = R; gC[i] = C; voffA[i] = (unsigned)(R * K + C) * 2u; voffB[i] = (unsigned)(Epi::brow(R) * K + C) * 2u; }
    unsigned co[2][2], no[2][2];
#define PG8_GOFF(dst, tab) do { _Pragma("unroll") for (int _h = 0; _h < 2; ++_h) _Pragma("unroll") for (int _i = 0; _i < 2; ++_i) \
        dst[_h][_i] = (unsigned)((tab)[_h * 128 + gR[_i]] * K + gC[_i]) * 2u; } while (0)
    const size_t kstep = (size_t)(BK * 2);
    const size_t hstepA = (size_t)HALF * K * 2, hstepB = (size_t)Epi::BHALF * K * 2;
    const unsigned ldsw = (unsigned)wid * 1024u;
    const int aoff = lds_byte(wr * 64 + fr, fq * 8), boff = lds_byte(wc * 32 + fr, fq * 8);
#define PG8_SA(b, h) (((b) * 2 + (h)) * HTB)
#define PG8_SB(b, h) ((4 + (b) * 2 + (h)) * HTB)
#define PG8_STAGE(bufoff, gbase, voff) do { _Pragma("unroll") for (int _i = 0; _i < 2; ++_i) \
        __builtin_amdgcn_global_load_lds((const unsigned*)((const char*)(gbase) + (voff)[_i]), (LAS unsigned*)(lds + (bufoff) + ldsw + _i * 8192), 16, 0, 0); } while (0)
#define PG8_LDA(dst, b, h) do { _Pragma("unroll") for (int m = 0; m < 4; ++m) _Pragma("unroll") for (int k = 0; k < 2; ++k) dst[m][k] = *(const LAS bf16x8*)(lds + PG8_SA(b, h) + aoff + m * 2048 + k * 1024); } while (0)
#define PG8_LDB(dst, b, h) do { _Pragma("unroll") for (int n = 0; n < 2; ++n) _Pragma("unroll") for (int k = 0; k < 2; ++k) dst[n][k] = *(const LAS bf16x8*)(lds + PG8_SB(b, h) + boff + n * 2048 + k * 1024); } while (0)
#define PG8_MMA(ai, bj, At, Bt) do { __builtin_amdgcn_s_setprio(1); _Pragma("unroll") for (int m = 0; m < 4; ++m) _Pragma("unroll") for (int n = 0; n < 2; ++n) _Pragma("unroll") for (int k = 0; k < 2; ++k) \
        acc[ai][bj][m][n] = __builtin_amdgcn_mfma_f32_16x16x32_bf16(Bt[n][k], At[m][k], acc[ai][bj][m][n], 0, 0, 0); __builtin_amdgcn_s_setprio(0); } while (0)
#define PG8_WAIT_V(n) asm volatile("s_waitcnt vmcnt(" #n ")" ::: "memory")
#define PG8_WAIT_L(n) asm volatile("s_waitcnt lgkmcnt(" #n ")" ::: "memory")
#define PG8_BAR __builtin_amdgcn_s_barrier()
#define PG8_SCHED __builtin_amdgcn_sched_barrier(0)
    Unit cur, nxt; int ui = 0;
    if (!S.next(0, cur)) return;
    f32x4 acc[2][2][4][2];
#pragma unroll
    for (int a = 0; a < 2; ++a)
#pragma unroll
        for (int b = 0; b < 2; ++b)
#pragma unroll
            for (int m = 0; m < 4; ++m)
#pragma unroll
                for (int n = 0; n < 2; ++n) acc[a][b][m][n] = (f32x4){0.f, 0.f, 0.f, 0.f};
    bf16x8 At[4][2], B0[2][2], B1[2][2];
    const char* cA = cur.a; const char* cB = cur.b;
    if constexpr (Epi::GATHER_A) { PG8_GOFF(co, S.rows(0)); PG8_WAIT_L(0); }
    else {
#pragma unroll
        for (int i = 0; i < 2; ++i) { co[0][i] = voffA[i]; co[1][i] = voffA[i] + (unsigned)hstepA; no[0][i] = co[0][i]; no[1][i] = co[1][i]; }
    }
    PG8_WAIT_V(0);
    PG8_STAGE(PG8_SB(0, 0), cB, voffB); PG8_STAGE(PG8_SA(0, 0), cA, co[0]); PG8_STAGE(PG8_SB(0, 1), cB + hstepB, voffB); PG8_STAGE(PG8_SA(0, 1), cA, co[1]);
    if (wr == 1) PG8_BAR;
    PG8_WAIT_V(4); PG8_BAR;
    PG8_STAGE(PG8_SB(1, 0), cB + kstep, voffB); PG8_STAGE(PG8_SA(1, 0), cA + kstep, co[0]); PG8_STAGE(PG8_SB(1, 1), cB + hstepB + kstep, voffB);
    PG8_WAIT_V(6); PG8_BAR;
    for (;;) {
        const bool has_next = S.next(ui + 1, nxt);
        const char* nA = has_next ? nxt.a : cA; const char* nB = has_next ? nxt.b : cB;
        if constexpr (Epi::GATHER_A) { if (has_next) PG8_GOFF(no, S.rows(ui + 1)); else { no[0][0] = co[0][0]; no[0][1] = co[0][1]; no[1][0] = co[1][0]; no[1][1] = co[1][1]; } }
        for (int t = 0; t < nt; t += 2) {
            const bool last = (t == nt - 2);
            const char* a1 = cA + (size_t)(t + 1) * kstep;
            const char* a2 = last ? nA : cA + (size_t)(t + 2) * kstep; const char* b2 = last ? nB : cB + (size_t)(t + 2) * kstep;
            const char* a3 = a2 + kstep; const char* b3 = b2 + kstep;
            unsigned fo[2][2];
#pragma unroll
            for (int h = 0; h < 2; ++h)
#pragma unroll
                for (int i = 0; i < 2; ++i) fo[h][i] = last ? no[h][i] : co[h][i];
            PG8_LDB(B0, 0, 0); PG8_SCHED; PG8_LDA(At, 0, 0); PG8_STAGE(PG8_SA(1, 1), a1, co[1]);
            PG8_WAIT_L(8); PG8_BAR; PG8_WAIT_L(0); PG8_MMA(0, 0, At, B0); PG8_BAR; PG8_SCHED;
            PG8_LDB(B1, 0, 1); PG8_STAGE(PG8_SB(0, 0), b2, voffB);
            PG8_BAR; PG8_WAIT_L(0); PG8_MMA(0, 1, At, B1); PG8_BAR;
            PG8_LDA(At, 0, 1); PG8_STAGE(PG8_SA(0, 0), a2, fo[0]);
            PG8_BAR; PG8_WAIT_L(0); PG8_MMA(1, 0, At, B0); PG8_BAR; PG8_SCHED;
            PG8_STAGE(PG8_SB(0, 1), b2 + hstepB, voffB);
            PG8_WAIT_V(6); PG8_BAR; PG8_MMA(1, 1, At, B1); PG8_BAR;
            PG8_LDB(B0, 1, 0); PG8_SCHED; PG8_LDA(At, 1, 0); PG8_STAGE(PG8_SA(0, 1), a2, fo[1]);
            PG8_WAIT_L(8); PG8_BAR; PG8_WAIT_L(0); PG8_MMA(0, 0, At, B0); PG8_BAR; PG8_SCHED;
            PG8_LDB(B1, 1, 1); PG8_STAGE(PG8_SB(1, 0), b3, voffB);
            PG8_BAR; PG8_WAIT_L(0); PG8_MMA(0, 1, At, B1); PG8_BAR;
            PG8_LDA(At, 1, 1); PG8_STAGE(PG8_SA(1, 0), a3, fo[0]);
            PG8_BAR; PG8_WAIT_L(0); PG8_MMA(1, 0, At, B0); PG8_BAR; PG8_SCHED;
            PG8_STAGE(PG8_SB(1, 1), b3 + hstepB, voffB);
            PG8_WAIT_V(6); PG8_BAR; PG8_MMA(1, 1, At, B1); PG8_BAR;
        }
        E(acc, cur, wr, wc, fr, fq);
        if (!has_next) break;
#pragma unroll
        for (int a = 0; a < 2; ++a)
#pragma unroll
            for (int b = 0; b < 2; ++b)
#pragma unroll
                for (int m = 0; m < 4; ++m)
#pragma unroll
                    for (int n = 0; n < 2; ++n) acc[a][b][m][n] = (f32x4){0.f, 0.f, 0.f, 0.f};
        cur = nxt; cA = nA; cB = nB; ++ui;
#pragma unroll
        for (int h = 0; h < 2; ++h) { co[h][0] = no[h][0]; co[h][1] = no[h][1]; }
    }
    PG8_WAIT_V(0);
    if (wr == 0) PG8_BAR;
    PG8_BAR;
#undef PG8_SA
#undef PG8_GOFF
#undef PG8_SB
#undef PG8_STAGE
#undef PG8_LDA
#undef PG8_LDB
#undef PG8_MMA
#undef PG8_WAIT_V
#undef PG8_WAIT_L
#undef PG8_BAR
#undef PG8_SCHED
}
}

struct SchedDense {
    const char* A; const char* B; int K; int mode;
    DEVI const int* rows(int) const { return nullptr; }
    DEVI bool next(int i, pg8::Unit& u) const {
        const int c = blockIdx.x, x = c & 7; int pm, pn;
        if (mode == 0) { if (i > 0) return false; pn = x & 3; pm = (c >> 3) * 2 + (x >> 2); }
        else { if (i > 3) return false; pn = x + 8 * (i & 1); pm = (c >> 3) + 32 * (i >> 1); }
        u.a = A + (size_t)pm * 256 * K * 2; u.b = B + (size_t)pn * 256 * K * 2; u.x0 = pm; u.x1 = pn; u.x2 = 0; u.x3 = 0;
        return true;
    }
};
struct EpiOutF32 {
    static constexpr bool GATHER_A = false; static constexpr int BHALF = 128; static DEVI int brow(int R) { return R; }
    float* C;
    DEVI void operator()(const f32x4 (&acc)[2][2][4][2], const pg8::Unit& u, int wr, int wc, int fr, int fq) const {
#pragma unroll
        for (int ai = 0; ai < 2; ++ai)
#pragma unroll
            for (int m = 0; m < 4; ++m) {
                float* rowp = C + (size_t)(u.x0 * 256 + ai * 128 + wr * 64 + m * 16 + fr) * D + u.x1 * 256 + wc * 32 + 4 * fq;
#pragma unroll
                for (int bj = 0; bj < 2; ++bj)
#pragma unroll
                    for (int n = 0; n < 2; ++n) *(f32x4*)(rowp + bj * 128 + n * 16) = acc[ai][bj][m][n];
            }
    }
};
struct EpiProjBf16 {
    static constexpr bool GATHER_A = false; static constexpr int BHALF = 128; static DEVI int brow(int R) { return R; }
    bf16* C;
    DEVI void operator()(const f32x4 (&acc)[2][2][4][2], const pg8::Unit& u, int wr, int wc, int fr, int fq) const {
#pragma unroll
        for (int ai = 0; ai < 2; ++ai)
#pragma unroll
            for (int m = 0; m < 4; ++m) {
                bf16* rowp = C + (size_t)(u.x0 * 256 + ai * 128 + wr * 64 + m * 16 + fr) * NPROJ + u.x1 * 256 + wc * 32 + 4 * fq;
#pragma unroll
                for (int bj = 0; bj < 2; ++bj)
#pragma unroll
                    for (int n = 0; n < 2; ++n) { const f32x4 v = acc[ai][bj][m][n]; *(u32x2*)(rowp + bj * 128 + n * 16) = (u32x2){pk2(v.x, v.y), pk2(v.z, v.w)}; }
            }
    }
};
DEVI void phase_outproj8(const P& p, int l, char* smem_all) {
    SchedDense Sd{(const char*)(p.ws + WS_MIX), (const char*)(p.ws + WS_WOUT) + (size_t)l * D * D * 2, D, 0};
    EpiOutF32 E{(float*)(p.ws + WS_OPRE)};
    pg8::gemm_phase(( LAS unsigned char*)smem_all, D, Sd, E);
}
DEVI void phase_inproj8(const P& p, int l, char* smem_all) {
    SchedDense Sd{(const char*)(p.ws + WS_HB), (const char*)(p.ws + WS_WIN) + (size_t)l * NPAD * D * 2, D, 1};
    EpiProjBf16 E{(bf16*)(p.ws + WS_PROJ)};
    pg8::gemm_phase((LAS unsigned char*)smem_all, D, Sd, E);
}
DEVI void phase_inproj_extras(const P& p, int l, char* smem) {
    const bf16* HB = (const bf16*)(p.ws + WS_HB);
    const bf16* W = (const bf16*)(p.ws + WS_WIN) + (size_t)l * NPAD * D;
    float* PEX = (float*)(p.ws + WS_PEX);
    const int lane = VTID & 63, wid = VTID >> 6, wr = wid >> 1, wc = wid & 1, fr = lane & 15, fq = lane >> 4;
    for (int mt = VBID; mt < S / 128; mt += VNB) {
        f32x4 acc[4][8];
        gemm_tile(smem, HB, [&](int r) { return (unsigned)((mt * 128 + r) * D); }, W, [&](int r) { return (unsigned)((16 * 256 + r) * D); }, D, acc);
        if (wc == 0) {
#pragma unroll
            for (int m = 0; m < 4; ++m) {
                const int tok = mt * 128 + wr * 64 + m * 16 + fr;
#pragma unroll
                for (int n = 0; n < 4; ++n) *(f32x4*)(PEX + (size_t)tok * 64 + n * 16 + fq * 4) = acc[m][n];
            }
        }
    }
}

struct MoeMap8 { int cnt[32]; int off[32]; int tstart[33]; };
DEVI void moe_map8(const P& p, int l, MoeMap8* mm) {
    const int* CNT = (const int*)(p.ws + OFF_CNT) + l * 32 * 64;
    if (threadIdx.x < 32) mm->cnt[threadIdx.x] = __hip_atomic_load(&CNT[threadIdx.x * 64], __ATOMIC_RELAXED, __HIP_MEMORY_SCOPE_AGENT);
    __syncthreads();
    if (threadIdx.x == 0) {
        int o = 0, ts = 0;
        for (int e = 0; e < 32; ++e) { mm->off[e] = o; mm->tstart[e] = ts; o += mm->cnt[e]; ts += (mm->cnt[e] + 255) / 256; }
        mm->tstart[32] = ts;
    }
    __syncthreads();
}
DEVI void phase_moe_gather(const P& p, int l, char* smem_all) {
    MoeMap8* mm = (MoeMap8*)(smem_all + 131072);
    moe_map8(p, l, mm);
    const bf16* H2 = (const bf16*)(p.ws + WS_H2); bf16* HG = (bf16*)(p.ws + WS_HG);
    const int* LIST = (const int*)(p.ws + WS_LIST);
    const int wave = (int)(blockIdx.x * 8 + (threadIdx.x >> 6)), lane = threadIdx.x & 63;
    int mytok = 0;
    {
        const int pr = wave * 32 + (lane & 31);
        int e = 0;
        while (e < 31 && mm->off[e + 1] <= pr) ++e;
        mytok = LIST[(size_t)e * S + (pr - mm->off[e])] >> 2;
    }
#pragma unroll 1
    for (int r0 = 0; r0 < 32; r0 += 8) {
        u32x4 v[8][2];
#pragma unroll
        for (int i = 0; i < 8; ++i) {
            const int tok = __shfl(mytok, r0 + i);
            const u32x4* s = (const u32x4*)(H2 + (size_t)tok * D);
            v[i][0] = s[lane]; v[i][1] = s[lane + 64];
        }
#pragma unroll
        for (int i = 0; i < 8; ++i) { u32x4* d = (u32x4*)(HG + (size_t)(wave * 32 + r0 + i) * D); d[lane] = v[i][0]; d[lane + 64] = v[i][1]; }
    }
}
struct MoeUnits { int n; int pad[3]; int e[32]; int m0[32]; int pn[32]; };
struct SchedMoe {
    const MoeMap8* mm; const MoeUnits* mu; const char* A; const char* Bw; int K;
    size_t bexp, bpn;
    const int* rowtab; bool gather;
    DEVI const int* rows(int i) const { return rowtab + 256 * i; }
    DEVI bool next(int i, pg8::Unit& u) const {
        if (i >= mu->n) return false;
        const int e = mu->e[i], m0 = mu->m0[i], pn = mu->pn[i], off = mm->off[e];
        u.a = gather ? A : A + (size_t)(off + m0) * K * 2; u.b = Bw + (size_t)e * bexp + (size_t)pn * bpn;
        u.x0 = e; u.x1 = m0; u.x2 = pn; u.x3 = off;
        return true;
    }
};
DEVI void moe_units(const MoeMap8* mm, MoeUnits* mu, int npn_log) {
    if (threadIdx.x < 32) {
        const int L = (int)threadIdx.x * 256 + (int)blockIdx.x, total = mm->tstart[32] << npn_log;
        if (L < total) {
            const int pn = L & ((1 << npn_log) - 1), rt = L >> npn_log;
            int e = 0;
            while (mm->tstart[e + 1] <= rt) ++e;
            mu->e[threadIdx.x] = e; mu->m0[threadIdx.x] = (rt - mm->tstart[e]) * 256; mu->pn[threadIdx.x] = pn;
        }
        if (threadIdx.x == 0) { const int mine = total > (int)blockIdx.x ? (total - (int)blockIdx.x + 255) >> 8 : 0; mu->n = mine < 32 ? mine : 32; }
    }
    __syncthreads();
}
struct EpiMoeUp {
    static constexpr bool GATHER_A = true;
    static constexpr int BHALF = 64;
    static DEVI int brow(int R) { return ((R >> 5) & 3) * 16 + (R & 15) + (((R >> 4) & 1) ? 1024 : 0); }
    const MoeMap8* mm; bf16* ACT; const float* bup; bf16* dump;
    DEVI void operator()(const f32x4 (&acc)[2][2][4][2], const pg8::Unit& u, int wr, int wc, int fr, int fq) const {
        const int e = u.x0, cnt = mm->cnt[e];
        const float* be = bup + (size_t)e * 2048;
        f32x4 bg[2], bl[2];
#pragma unroll
        for (int bj = 0; bj < 2; ++bj) { const int col = u.x2 * 128 + (bj * 4 + wc) * 16 + 4 * fq; bg[bj] = *(const f32x4*)(be + col); bl[bj] = *(const f32x4*)(be + 1024 + col); }
#pragma unroll
        for (int ai = 0; ai < 2; ++ai)
#pragma unroll
            for (int m = 0; m < 4; ++m) {
                const int r = u.x1 + ai * 128 + wr * 64 + m * 16 + fr;
                bf16* rowp = (r < cnt) ? ACT + (size_t)(u.x3 + r) * DFF + u.x2 * 128 + wc * 16 + 4 * fq : dump + 4 * fq;
#pragma unroll
                for (int bj = 0; bj < 2; ++bj) {
                    float o[4];
#pragma unroll
                    for (int j = 0; j < 4; ++j) {
                        const float glu = fminf(acc[ai][bj][m][0][j] + bg[bj][j], 7.f);
                        const float lin = fminf(fmaxf(acc[ai][bj][m][1][j] + bl[bj][j], -7.f), 7.f);
                        o[j] = glu * sigmoidf_(1.702f * glu) * (lin + 1.f);
                    }
                    *(u32x2*)(rowp + bj * 64) = (u32x2){pk2(o[0], o[1]), pk2(o[2], o[3])};
                }
            }
    }
};
struct EpiMoeDown {
    static constexpr bool GATHER_A = false; static constexpr int BHALF = 128; static DEVI int brow(int R) { return R; }
    const MoeMap8* mm; bf16* YB; const float* bdn; const int* LIST; const float* GATE; bf16* dump;
    DEVI void operator()(const f32x4 (&acc)[2][2][4][2], const pg8::Unit& u, int wr, int wc, int fr, int fq) const {
        const int e = u.x0, cnt = mm->cnt[e];
        const float* be = bdn + (size_t)e * D + u.x2 * 256 + wc * 32 + 4 * fq;
        f32x4 bv[2][2];
#pragma unroll
        for (int bj = 0; bj < 2; ++bj)
#pragma unroll
            for (int n = 0; n < 2; ++n) bv[bj][n] = *(const f32x4*)(be + bj * 128 + n * 16);
        int ent[8]; float gt[8];
#pragma unroll
        for (int q = 0; q < 8; ++q) { const int r = u.x1 + (q >> 2) * 128 + wr * 64 + (q & 3) * 16 + fr; ent[q] = LIST[(size_t)e * S + (r < cnt ? r : cnt - 1)]; }
#pragma unroll
        for (int q = 0; q < 8; ++q) gt[q] = GATE[ent[q]];
#pragma unroll
        for (int ai = 0; ai < 2; ++ai)
#pragma unroll
            for (int m = 0; m < 4; ++m) {
                const int q = ai * 4 + m, r = u.x1 + ai * 128 + wr * 64 + m * 16 + fr;
                bf16* rowp = (r < cnt) ? YB + (size_t)ent[q] * D + u.x2 * 256 + wc * 32 + 4 * fq : dump + 4 * fq;
#pragma unroll
                for (int bj = 0; bj < 2; ++bj)
#pragma unroll
                    for (int n = 0; n < 2; ++n) {
                        const f32x4 v = (acc[ai][bj][m][n] + bv[bj][n]) * gt[q];
                        *(u32x2*)(rowp + bj * 128 + n * 16) = (u32x2){pk2(v.x, v.y), pk2(v.z, v.w)};
                    }
            }
    }
};
DEVI void phase_moe_up8(const P& p, int l, char* smem_all) {
    MoeMap8* mm = (MoeMap8*)(smem_all + 131072);
    moe_map8(p, l, mm);
    MoeUnits* mu = (MoeUnits*)(smem_all + 131072 + 512);
    moe_units(mm, mu, 3);
    int* rowtab = (int*)(smem_all + 131072 + 1024);
    {
        const int* LIST = (const int*)(p.ws + WS_LIST);
        const int nu = mu->n < 12 ? mu->n : 12;
        for (int idx = threadIdx.x; idx < nu * 256; idx += KT) {
            const int i = idx >> 8, r = idx & 255, e = mu->e[i], cnt = mm->cnt[e], rr = mu->m0[i] + r;
            rowtab[idx] = LIST[(size_t)e * S + (rr < cnt ? rr : cnt - 1)] >> 2;
        }
        __syncthreads();
    }
    SchedMoe Sm{mm, mu, (const char*)(p.ws + WS_H2), (const char*)(p.ws + WS_WUP) + (size_t)l * NEXP * 2048 * D * 2, D, (size_t)2048 * D * 2, (size_t)128 * D * 2, rowtab, true};
    EpiMoeUp E{mm, (bf16*)(p.ws + WS_ACT), p.in[33] + (size_t)l * NEXP * 2048, (bf16*)(p.ws + WS_DUMP)};
    pg8::gemm_phase((LAS unsigned char*)smem_all, D, Sm, E);
}
DEVI void phase_moe_down8(const P& p, int l, char* smem_all) {
    MoeMap8* mm = (MoeMap8*)(smem_all + 131072);
    moe_map8(p, l, mm);
    MoeUnits* mu = (MoeUnits*)(smem_all + 131072 + 512);
    moe_units(mm, mu, 2);
    SchedMoe Sm{mm, mu, (const char*)(p.ws + WS_ACT), (const char*)(p.ws + WS_WDN) + (size_t)l * NEXP * D * DFF * 2, DFF, (size_t)D * DFF * 2, (size_t)256 * DFF * 2, nullptr, false};
    EpiMoeDown E{mm, (bf16*)(p.ws + WS_YB), p.in[35] + (size_t)l * NEXP * D, (const int*)(p.ws + WS_LIST), (const float*)(p.ws + WS_GATE), (bf16*)(p.ws + WS_DUMP)};
    pg8::gemm_phase((LAS unsigned char*)smem_all, DFF, Sm, E);
}

constexpr int NPHASE = 24;
constexpr int LDS_TOTAL = 2 * VB_LDS + 64;
__global__ void __launch_bounds__(KT, 2) k_run(P p) {
    extern __shared__ __attribute__((aligned(16))) char smem_all[];
    char* smem = smem_all + __builtin_amdgcn_readfirstlane((int)(threadIdx.x >> 8)) * VB_LDS;
    XcdBarrier bar; bar.bar = nullptr; bar.x = 0; bar.st = nullptr;
    const bool multi = (p.ph_hi - p.ph_lo) > 1;
    if (multi) {
        volatile LAS unsigned* st = (volatile LAS unsigned*)(smem_all + 2 * VB_LDS);
        if (threadIdx.x == 0) { st[0] = 0u; st[1] = 0u; }
        __syncthreads();
        bar = xcd_barrier_post((unsigned*)(p.ws + OFF_BAR), st);
    }
#ifndef DUP
#define DUP -1
#endif
#ifndef DUP2
#define DUP2 -1
#endif
#define RUN(k, call) if (p.ph_lo <= (k) && (k) < p.ph_hi) { for (int _rep = ((k) == DUP || (k) == DUP2) ? 2 : 1; _rep > 0; --_rep) { call; if (multi && ((k) + 1 < p.ph_hi || _rep > 1)) xcd_barrier(bar); } }
    RUN(0, phase_prep(p, smem))
    RUN(1, phase_h0(p))
    RUN(2, { phase_inproj8(p, 0, smem_all); phase_inproj_extras(p, 0, smem); })
    RUN(3, phase_mixprep(p, 0, smem))
    RUN(4, phase_chunkA(p, smem))
    RUN(5, phase_scanL1(p, smem))
    RUN(6, phase_scanL2(p, 0, smem))
    RUN(7, phase_chunkC(p, 0, smem))
    RUN(8, phase_outproj8(p, 0, smem_all))
    RUN(9, phase_ln1_route(p, 0, smem, _rep == 1))
    RUN(10, phase_moe_up8(p, 0, smem_all))
    RUN(11, phase_moe_down8(p, 0, smem_all))
    RUN(12, phase_ln2(p, 0))
    RUN(13, { phase_inproj8(p, 1, smem_all); phase_inproj_extras(p, 1, smem); })
    RUN(14, phase_mixprep(p, 1, smem))
    RUN(15, phase_chunkA(p, smem))
    RUN(16, phase_scanL1(p, smem))
    RUN(17, phase_scanL2(p, 1, smem))
    RUN(18, phase_chunkC(p, 1, smem))
    RUN(19, phase_outproj8(p, 1, smem_all))
    RUN(20, phase_ln1_route(p, 1, smem))
    RUN(21, phase_moe_up8(p, 1, smem_all))
    RUN(22, phase_moe_down8(p, 1, smem_all))
    RUN(23, phase_ln2(p, 1))
#undef RUN
}

extern "C" void kernel_launch(void* const* d_in, const int* in_sizes, int n_in, void* d_out, int out_size, void* d_ws, size_t ws_size,
                              hipStream_t stream) {
    static int grid = 0;
    if (grid == 0) {
        if (n_in != 38 || ws_size < WS_END) { fprintf(stderr, "kernel_launch: unexpected n_in %d or ws_size %zu (< %zu)\n", n_in, ws_size, (size_t)WS_END); grid = -1; return; }
        int dev = 0, cus = 0, per_cu = 0;
        hipGetDevice(&dev);
        hipDeviceGetAttribute(&cus, hipDeviceAttributeMultiprocessorCount, dev);
        hipFuncSetAttribute((const void*)k_run, hipFuncAttributeMaxDynamicSharedMemorySize, LDS_TOTAL);
        hipOccupancyMaxActiveBlocksPerMultiprocessor(&per_cu, (const void*)k_run, KT, LDS_TOTAL);
        if (per_cu < 1) { fprintf(stderr, "kernel_launch: occupancy query returned %d\n", per_cu); grid = -1; return; }
        if (cus != 256) { fprintf(stderr, "kernel_launch: built for 256 CUs (one workgroup per CU), device has %d\n", cus); grid = -1; return; }
        grid = cus;
    }
    if (grid < 0) return;
    hipMemsetAsync((char*)d_ws + WS_CTL, 0, CTL_BYTES, stream);
    P p{};
    for (int i = 0; i < 38; ++i) p.in[i] = (const float*)d_in[i];
    p.pos = (const int*)d_in[2];
    p.out = (float*)d_out; p.ws = (char*)d_ws;
#if MEGA
    p.ph_lo = 0; p.ph_hi = NPHASE;
    void* args[] = {&p};
    hipError_t e = hipLaunchCooperativeKernel((const void*)k_run, dim3(grid), dim3(KT), args, LDS_TOTAL, stream);
    if (e != hipSuccess) fprintf(stderr, "cooperative launch failed: %s (grid %d)\n", hipGetErrorString(e), grid);
#else
    for (int ph = 0; ph < NPHASE; ++ph) {
        p.ph_lo = ph; p.ph_hi = ph + 1;
        hipLaunchKernelGGL(k_run, dim3(grid), dim3(KT), LDS_TOTAL, stream, p);
    }
#endif
}
```

```cpp
#include <hip/hip_runtime.h>
#include <hip/hip_bf16.h>
#include <stdint.h>
#include <stdio.h>

#ifndef MEGA
#define MEGA 1
#endif

#define DEVI __device__ __forceinline__
#define LAS __attribute__((address_space(3)))

typedef unsigned short bf16;
typedef short bf16x8 __attribute__((ext_vector_type(8)));
typedef float f32x4 __attribute__((ext_vector_type(4)));
typedef unsigned u32x4 __attribute__((ext_vector_type(4)));
typedef unsigned u32x2 __attribute__((ext_vector_type(2)));

constexpr int S = 16384, D = 1024, NIN = 4104, NEXP = 32, DFF = 1024;
constexpr int NPROJ = 4096;
constexpr int NPAD = 4352;
constexpr float DN_ALPHA = 1.4142135623730951f;
constexpr int NT = 256;
constexpr int LDS_BYTES = 76032;

constexpr size_t MiB = 1ull << 20;
constexpr size_t WS_CTL = 0;
constexpr size_t CTL_BYTES = 1 * MiB;
constexpr size_t OFF_BAR = 0;
constexpr size_t OFF_ADA = 64 * 1024;
constexpr size_t OFF_CNT = 128 * 1024;
constexpr size_t WS_ROT = 1 * MiB;
constexpr size_t WS_WIN = WS_ROT + (size_t)S * 64 * 4;
constexpr size_t WS_WOUT = WS_WIN + 2ull * NPAD * D * 2;
constexpr size_t WS_WUP = WS_WOUT + 2ull * D * D * 2;
constexpr size_t WS_WDN = WS_WUP + 2ull * NEXP * 2048 * D * 2;
constexpr size_t WS_HB = WS_WDN + 2ull * NEXP * D * DFF * 2;
constexpr size_t WS_PROJ = WS_HB + (size_t)S * D * 2;
constexpr size_t WS_PEX = WS_PROJ + (size_t)S * NPROJ * 2;
constexpr size_t WS_VFIRST = WS_PEX + (size_t)S * 64 * 4;
constexpr size_t WS_RECR = WS_VFIRST + (size_t)S * 256 * 4;
constexpr size_t WS_RECG = WS_RECR + (size_t)S * 4 * 384 * 2;
constexpr size_t WS_RECT = WS_RECG + (size_t)S * 4 * 392 * 2;
constexpr size_t WS_WDEC = WS_RECT + (size_t)S * 4 * 192 * 2;
constexpr size_t WS_GSC = WS_WDEC + (size_t)S * 256 * 4;
constexpr size_t WS_G = WS_GSC + (size_t)S * 16 * 4;
constexpr size_t WS_BON = WS_G + (size_t)S * 256 * 4;
constexpr size_t WS_YR = WS_BON + (size_t)S * 4 * 4;
constexpr size_t WS_OG = WS_YR + (size_t)S * 256 * 4;
constexpr size_t WS_ORT = WS_OG + (size_t)S * 512 * 4;
constexpr size_t WS_MIX = WS_ORT + (size_t)S * 256 * 4;
constexpr size_t WS_OPRE = WS_MIX + (size_t)S * D * 2;
constexpr size_t WS_X = WS_OPRE + (size_t)S * D * 4;
constexpr size_t WS_H2 = WS_X + (size_t)S * D * 4;
constexpr size_t WS_LIST = WS_H2 + (size_t)S * D * 2;
constexpr size_t WS_GATE = WS_LIST + (size_t)NEXP * S * 4;
constexpr size_t WS_ACT = WS_GATE + (size_t)S * 4 * 4;
constexpr size_t WS_YB = WS_ACT + ((size_t)S * 4 + 256) * DFF * 2;
constexpr size_t WS_ADAP = WS_YB + (size_t)S * 4 * D * 2;
constexpr size_t WS_RKV = WS_ADAP + 16ull * 12288 * 4;
constexpr size_t WS_RST = WS_RKV + 256ull * 4 * 4096 * 4;
constexpr size_t WS_GP = WS_RST + 256ull * 4 * 4096 * 2;
constexpr size_t WS_GB = WS_GP + 1024ull * 16384 * 2;
constexpr size_t WS_GD = WS_GB + 1024ull * 16384 * 4;
constexpr size_t WS_GQ = WS_GD + 4096;
constexpr size_t WS_GO = WS_GQ + 1024ull * 8192 * 2;
constexpr size_t WS_GS = WS_GO + 1024ull * 8192 * 4;
constexpr size_t WS_WP = WS_GS + 1024ull * 16384 * 2;
constexpr size_t WS_WC = WS_WP + 2048ull * 4096 * 2;
constexpr size_t WS_WD = WS_WC + 2048ull * 4096 * 4;
constexpr size_t WS_WQ = WS_WD + 2048ull * 64 * 4;
constexpr size_t WS_WY = WS_WQ + 2048ull * 2048 * 2;
constexpr size_t WS_WS = WS_WY + 2048ull * 2048 * 4;
constexpr size_t WS_GR = WS_WS + 2048ull * 4096 * 2;
constexpr size_t WS_GE0 = WS_GR + 1024ull * 8192 * 2;
constexpr size_t WS_GTE = WS_GE0 + 64ull * 16384 * 4;
constexpr size_t WS_GSG = WS_GTE + 64ull * 16384 * 2;
constexpr size_t WS_WR = WS_GSG + 64ull * 16384 * 2;
constexpr size_t WS_WE0 = WS_WR + 2048ull * 2048 * 2;
constexpr size_t WS_WTE = WS_WE0 + 64ull * 4096 * 4;
constexpr size_t WS_WSG = WS_WTE + 64ull * 4096 * 2;
constexpr size_t WS_LRT = WS_WSG + 64ull * 4096 * 2;
constexpr size_t WS_HG = WS_LRT + 2ull * 73728 * 2;
constexpr size_t WS_DUMP = WS_HG + ((size_t)S * 4 + 256) * D * 2;
constexpr size_t WS_END = WS_DUMP + 4096;

struct P {
    const float* in[38];
    const int* pos;
    float* out;
    char* ws;
    int ph_lo, ph_hi;
};

DEVI float bf2f(bf16 v) { return __uint_as_float(((unsigned)v) << 16); }
DEVI unsigned f2bf(float f) { unsigned u = __float_as_uint(f); return (u + 0x7fffu + ((u >> 16) & 1u)) >> 16; }
typedef float f32x2_t __attribute__((ext_vector_type(2)));
typedef __bf16 bf16x2_t __attribute__((ext_vector_type(2)));
DEVI unsigned pk2(float lo, float hi) { const f32x2_t v = {lo, hi}; return __builtin_bit_cast(unsigned, __builtin_convertvector(v, bf16x2_t)); }
DEVI float sigmoidf_(float x) { return __builtin_amdgcn_rcpf(1.f + __builtin_amdgcn_exp2f(-1.4426950408889634f * x)); }
DEVI float siluf_(float x) { return x * sigmoidf_(x); }
DEVI float softplusf_(float x) { return fmaxf(x, 0.f) + log1pf(__expf(-fabsf(x))); }
DEVI float wave_sum(float v) {
#pragma unroll
    for (int o = 32; o >= 1; o >>= 1) v += __shfl_xor(v, o);
    return v;
}
template <int CTRL> DEVI float dpp_mov(float x) {
    return __int_as_float(__builtin_amdgcn_update_dpp(0, __float_as_int(x), CTRL, 0xf, 0xf, false));
}
DEVI float row16_sum(float x) {
    x += dpp_mov<0x128>(x);
    x += dpp_mov<0x124>(x);
    x += dpp_mov<0x122>(x);
    x += dpp_mov<0x121>(x);
    return x;
}

DEVI bf16x8 ldfrag(const bf16* base, int ld, int row0, int k0, int lane) {
    return *(const bf16x8*)(base + (row0 + (lane & 15)) * ld + k0 + (lane >> 4) * 8);
}
DEVI f32x4 ld_bf4(const bf16* p) {
    const u32x2 v = *(const u32x2*)p;
    return (f32x4){__uint_as_float(v.x << 16), __uint_as_float(v.x & 0xffff0000u), __uint_as_float(v.y << 16), __uint_as_float(v.y & 0xffff0000u)};
}
DEVI void st_bf4(bf16* p, const f32x4& v) { *(u32x2*)p = (u32x2){pk2(v.x, v.y), pk2(v.z, v.w)}; }
DEVI float quad_sum(float v) { v += __shfl_xor(v, 16); v += __shfl_xor(v, 32); return v; }
DEVI f32x4 mfma16(bf16x8 a, bf16x8 b, f32x4 c) { return __builtin_amdgcn_mfma_f32_16x16x32_bf16(a, b, c, 0, 0, 0); }

#define VTID ((int)(threadIdx.x & 255))
#define VBID ((int)(blockIdx.x * 2 + __builtin_amdgcn_readfirstlane((int)(threadIdx.x >> 8))))
#define VNB ((int)(gridDim.x * 2))
constexpr int VB_LDS = 76032;
constexpr int KT = 512;

#define XB_TMO      128
#define XB_XCNT(j)  (256  + 64 * (j))
#define XB_XSUB(j)  (1280 + 64 * (j))
#define XB_XGEN(j)  (2304 + 64 * (j))
#define XB_TOP      3328
#define XB_TOPGEN   3392
#define XCD_BAR_WORDS 3456
#define XB_SPIN_CAP (1u << 22)
DEVI unsigned xb_ld(unsigned* p) { return __hip_atomic_load(p, __ATOMIC_RELAXED, __HIP_MEMORY_SCOPE_AGENT); }
DEVI unsigned xb_add(unsigned* p, unsigned v) { return __hip_atomic_fetch_add(p, v, __ATOMIC_RELAXED, __HIP_MEMORY_SCOPE_AGENT); }
DEVI unsigned xb_xcc_id() { return (unsigned)__builtin_amdgcn_s_getreg((3 << 11) | 20) & 0xFu; }
#define XB_SPIN(cond, bar) do { unsigned _sp = 0; while (cond) { __builtin_amdgcn_s_sleep(1); \
    if ((++_sp & 255u) == 0u) { if (xb_ld(&(bar)[XB_TMO])) break; if (_sp > XB_SPIN_CAP) { atomicAdd(&(bar)[XB_TMO], 1u); break; } } } } while (0)
struct XcdBarrier { unsigned* bar; unsigned x; volatile LAS unsigned* st; };
DEVI XcdBarrier xcd_barrier_post(unsigned* bar, volatile LAS unsigned* st) {
    XcdBarrier b; b.bar = bar; b.x = xb_xcc_id(); b.st = st;
    if (threadIdx.x == 0) (void)xb_add(&bar[XB_XCNT(b.x)], 1u);
    return b;
}
DEVI void xcd_barrier_complete(unsigned* bar, unsigned x, unsigned& nloc, unsigned& nx) {
    const unsigned G = gridDim.x * gridDim.y * gridDim.z;
    unsigned sum, cnt, mine, sp = 0u;
    for (;;) {
        sum = 0u; cnt = 0u; mine = 0u;
#pragma unroll
        for (unsigned j = 0; j < 16; ++j) { const unsigned c = xb_ld(&bar[XB_XCNT(j)]); sum += c; cnt += (c > 0u) ? 1u : 0u; mine = (j == x) ? c : mine; }
        if (sum == G) break;
        __builtin_amdgcn_s_sleep(1);
        if ((++sp & 255u) == 0u) { if (xb_ld(&bar[XB_TMO])) break; if (sp > XB_SPIN_CAP) { atomicAdd(&bar[XB_TMO], 1u); break; } }
    }
    nloc = mine > 0u ? mine : 1u; nx = cnt > 0u ? cnt : 1u;
}
DEVI void xcd_barrier(const XcdBarrier& b) {
    asm volatile("s_waitcnt vmcnt(0)" ::: "memory");
    __syncthreads();
    if (threadIdx.x == 0) {
        unsigned* bar = b.bar;
        __builtin_amdgcn_s_waitcnt(0);
        unsigned nloc = b.st[0], nx = b.st[1];
        if (nloc == 0u) { xcd_barrier_complete(bar, b.x, nloc, nx); b.st[0] = nloc; b.st[1] = nx; }
        const unsigned old = xb_add(&bar[XB_XSUB(b.x)], 1u);
        const unsigned gen = old / nloc;
        if (old + 1u == (gen + 1u) * nloc) {
            __builtin_amdgcn_fence(__ATOMIC_RELEASE, "agent");
            asm volatile("s_waitcnt vmcnt(0)" ::: "memory");
            const unsigned og = xb_add(&bar[XB_TOP], 1u);
            const unsigned tg = og / nx;
            if (og + 1u == (tg + 1u) * nx) xb_add(&bar[XB_TOPGEN], 1u);
            else XB_SPIN(xb_ld(&bar[XB_TOPGEN]) == tg, bar);
            __builtin_amdgcn_fence(__ATOMIC_ACQUIRE, "agent");
            xb_add(&bar[XB_XGEN(b.x)], 1u);
            asm volatile("s_waitcnt vmcnt(0)" ::: "memory");
        } else {
            XB_SPIN(xb_ld(&bar[XB_XGEN(b.x)]) == gen, bar);
            __builtin_amdgcn_fence(__ATOMIC_ACQUIRE, "agent");
            asm volatile("s_waitcnt vmcnt(0)" ::: "memory");
        }
    }
    __syncthreads();
}

DEVI void transpose_item(const float* __restrict__ src, size_t ld, int k0, int ns0, bf16* __restrict__ dst, int kd, int nd0, float* lds) {
    const int tid = VTID;
    float tv[16];
#pragma unroll
    for (int i = 0; i < 16; ++i) tv[i] = src[(size_t)(k0 + i * 4 + (tid >> 6)) * ld + ns0 + (tid & 63)];
    asm volatile("" ::: "memory");
#pragma unroll
    for (int i = 0; i < 16; ++i) lds[(i * 4 + (tid >> 6)) * 65 + (tid & 63)] = tv[i];
    __syncthreads();
#pragma unroll
    for (int i = 0; i < 2; ++i) {
        const int q = tid + 256 * i, n = q >> 3, kc = q & 7;
        const float* s = lds + (kc * 8) * 65 + n;
        u32x4 o;
        o.x = pk2(s[0 * 65], s[1 * 65]); o.y = pk2(s[2 * 65], s[3 * 65]);
        o.z = pk2(s[4 * 65], s[5 * 65]); o.w = pk2(s[6 * 65], s[7 * 65]);
        *(u32x4*)(dst + (size_t)(nd0 + n) * kd + k0 + kc * 8) = o;
    }
    __syncthreads();
}

DEVI void phase_prep(const P& p, char* smem) {
    float* lds = (float*)smem;
    const int tid = VTID;
    const int nb = VNB, bid = VBID;
    bf16* WIN = (bf16*)(p.ws + WS_WIN); bf16* WOUT = (bf16*)(p.ws + WS_WOUT);
    bf16* WUP = (bf16*)(p.ws + WS_WUP); bf16* WDN = (bf16*)(p.ws + WS_WDN);
    constexpr int I_UP = 2 * NEXP * 16 * 32;
    constexpr int I_DN = 2 * NEXP * 16 * 16;
    constexpr int I_IN = 2 * 16 * 64;
    constexpr int I_OUT = 2 * 16 * 16;
    constexpr int I_EX = 2 * 256;
    constexpr int I_ADA = 2 * 24 * 16;
    constexpr int I_ROT = S * 32 / 256;
    constexpr int I_LR = 2 * 288;
    constexpr int NITEMS = I_UP + I_DN + I_IN + I_OUT + I_EX + I_ADA + I_ROT + I_LR;
    constexpr int I_TR = I_UP + I_DN + I_IN + I_OUT;
    static_assert(I_TR % 512 == 0, "transpose items must split evenly over 512 virtual blocks (they contain barriers)");
    for (int it = bid; it < NITEMS; it += nb) {
        int r = it;
        if (r < I_UP) {
            const int le = r / 512, q = r % 512, kt = q / 32, nt = q % 32;
            transpose_item(p.in[32] + (size_t)le * D * 2048, 2048, kt * 64, nt * 64, WUP + (size_t)le * 2048 * D, D, nt * 64, lds);
            continue;
        }
        r -= I_UP;
        if (r < I_DN) {
            const int le = r / 256, q = r % 256, kt = q / 16, nt = q % 16;
            transpose_item(p.in[34] + (size_t)le * DFF * D, D, kt * 64, nt * 64, WDN + (size_t)le * D * DFF, DFF, nt * 64, lds);
            continue;
        }
        r -= I_DN;
        if (r < I_IN) {
            const int l = r / 1024, q = r % 1024, kt = q / 64, nt = q % 64;
            const int nd0 = nt * 64, ns0 = nd0 < 3072 ? nd0 : nd0 + 8;
            transpose_item(p.in[5] + (size_t)l * D * NIN, NIN, kt * 64, ns0, WIN + (size_t)l * NPAD * D, D, nd0, lds);
            continue;
        }
        r -= I_IN;
        if (r < I_OUT) {
            const int l = r / 256, q = r % 256, kt = q / 16, nt = q % 16;
            transpose_item(p.in[27] + (size_t)l * D * D, D, kt * 64, nt * 64, WOUT + (size_t)l * D * D, D, nt * 64, lds);
            continue;
        }
        r -= I_OUT;
        if (r < I_EX) {
            const int l = r / 256, n = r % 256;
            bf16* dst = WIN + ((size_t)l * NPAD + NPROJ + n) * D;
            for (int k = tid; k < D; k += NT) {
                float v = 0.f;
                if (n < 8) v = p.in[5][(size_t)l * D * NIN + (size_t)k * NIN + 3072 + n];
                else if (n < 40 && l == 1) v = p.in[6][(size_t)k * 32 + (n - 8)];
                dst[k] = (bf16)f2bf(v);
            }
            continue;
        }
        r -= I_EX;
        if (r < I_ADA) {
            const int l = r / 384, q = r % 384, nc = q / 16, kc = q % 16;
            const int n = nc * 256 + tid;
            const float* W = p.in[3] + (size_t)l * D * 6144;
            float acc = (kc == 0) ? p.in[4][l * 6144 + n] : 0.f;
            for (int k = kc * 64; k < kc * 64 + 64; ++k) acc += siluf_(p.in[1][k]) * W[(size_t)k * 6144 + n];
            ((float*)(p.ws + WS_ADAP))[(size_t)kc * 12288 + l * 6144 + n] = acc;
            continue;
        }
        r -= I_ADA;
        if (r >= I_ROT) {
            r -= I_ROT;
            const int l = r / 288, kk = r % 288, c = tid;
            bf16* LRT = (bf16*)(p.ws + WS_LRT) + (size_t)l * 73728;
            if (kk < 64) LRT[c * 64 + kk] = (bf16)f2bf(p.in[10][(l * 64 + kk) * 256 + c]);
            else if (kk < 128) LRT[16384 + c * 64 + (kk - 64)] = (bf16)f2bf(p.in[12][(l * 64 + kk - 64) * 256 + c]);
            else if (kk < 256) LRT[32768 + c * 128 + (kk - 128)] = (bf16)f2bf(p.in[13][(l * 128 + kk - 128) * 256 + c]);
            else LRT[65536 + c * 32 + (kk - 256)] = (bf16)f2bf(l == 1 ? p.in[20][(kk - 256) * 256 + c] : 0.f);
            continue;
        }
        {
            const int idx = r * 256 + tid;
            const int t = idx >> 5, i = idx & 31;
            const float invf = (float)pow(10000.0, -(double)i / 32.0);
            const float ang = (float)p.pos[t] * invf;
            float sn, cs; sincosf(ang, &sn, &cs);
            float* ROT = (float*)(p.ws + WS_ROT);
            ROT[(size_t)idx * 2] = cs; ROT[(size_t)idx * 2 + 1] = sn;
        }
    }
}

DEVI float ada_sum(const float* ADAP, int idx) {
    float s = 0.f;
#pragma unroll
    for (int kc = 0; kc < 16; ++kc) s += ADAP[(size_t)kc * 12288 + idx];
    return s;
}
DEVI void phase_h0(const P& p) {
    const float* ADAP = (const float*)(p.ws + WS_ADAP);
    float* ADA = (float*)(p.ws + OFF_ADA);
    bf16* HB = (bf16*)(p.ws + WS_HB);
    if (VBID < 48) ADA[VBID * 256 + VTID] = ada_sum(ADAP, VBID * 256 + VTID);
    const size_t n4 = (size_t)S * D / 4;
    const int c = (int)(((size_t)VBID * NT + VTID) % (D / 4)) * 4;
    f32x4 sh, sc;
    sh.x = ada_sum(ADAP, c); sh.y = ada_sum(ADAP, c + 1); sh.z = ada_sum(ADAP, c + 2); sh.w = ada_sum(ADAP, c + 3);
    sc.x = ada_sum(ADAP, 1024 + c); sc.y = ada_sum(ADAP, 1025 + c); sc.z = ada_sum(ADAP, 1026 + c); sc.w = ada_sum(ADAP, 1027 + c);
    for (size_t i = (size_t)VBID * NT + VTID; i < n4; i += (size_t)VNB * NT) {
        const f32x4 x = ((const f32x4*)p.in[0])[i];
        u32x2 o;
        o.x = pk2(x.x * (1.f + sc.x) + sh.x, x.y * (1.f + sc.y) + sh.y);
        o.y = pk2(x.z * (1.f + sc.z) + sh.z, x.w * (1.f + sc.w) + sh.w);
        ((u32x2*)HB)[i] = o;
    }
}

template <class AF, class BF>
DEVI void gemm_tile(char* smem, const bf16* __restrict__ Abase, AF arow, const bf16* __restrict__ Bbase, BF brow, int K, f32x4 (&acc)[4][8]) {
    const int tid = VTID, wid = tid >> 6, lane = tid & 63, wr = wid >> 1, wc = wid & 1, fr = lane & 15, fq = lane >> 4;
    const int r0 = tid >> 2;
    const int swz = ((tid & 3) ^ ((0x1320 >> (4 * ((tid >> 4) & 3))) & 3)) * 8;
    unsigned pa[2], pb[4];
#pragma unroll
    for (int i = 0; i < 2; ++i) pa[i] = arow(r0 + 64 * i) + swz;
#pragma unroll
    for (int i = 0; i < 4; ++i) pb[i] = brow(r0 + 64 * i) + swz;
#pragma unroll
    for (int m = 0; m < 4; ++m)
#pragma unroll
        for (int n = 0; n < 8; ++n) acc[m][n] = (f32x4){0.f, 0.f, 0.f, 0.f};
    const int nk = K / 32;
    const int ch = (fq ^ ((0x1320 >> (4 * ((fr >> 2) & 3))) & 3)) * 16;
#define GT_STAGE(kt) do { char* _sa = smem + ((kt) % 3) * 24576; char* _sb = _sa + 8192; \
        _Pragma("unroll") for (int _i = 0; _i < 2; ++_i) \
            __builtin_amdgcn_global_load_lds((const unsigned*)(Abase + pa[_i] + (kt) * 32), (unsigned*)(_sa + (tid + 256 * _i) * 16), 16, 0, 0); \
        _Pragma("unroll") for (int _i = 0; _i < 4; ++_i) \
            __builtin_amdgcn_global_load_lds((const unsigned*)(Bbase + pb[_i] + (kt) * 32), (unsigned*)(_sb + (tid + 256 * _i) * 16), 16, 0, 0); } while (0)
    asm volatile("s_waitcnt vmcnt(0)" ::: "memory");
    GT_STAGE(0); GT_STAGE(1);
    for (int kt = 0; kt < nk; ++kt) {
        if (kt + 1 < nk) asm volatile("s_waitcnt vmcnt(6)" ::: "memory");
        else asm volatile("s_waitcnt vmcnt(0)" ::: "memory");
        asm volatile("s_waitcnt lgkmcnt(0)" ::: "memory");
        __builtin_amdgcn_s_barrier();
        if (kt + 2 < nk) GT_STAGE(kt + 2);
        const char* SA = smem + (kt % 3) * 24576; const char* SB = SA + 8192;
        bf16x8 af[4], bfr[8];
#pragma unroll
        for (int m = 0; m < 4; ++m) af[m] = *(const bf16x8*)(SA + (wr * 64 + m * 16 + fr) * 64 + ch);
#pragma unroll
        for (int n = 0; n < 8; ++n) bfr[n] = *(const bf16x8*)(SB + (wc * 128 + n * 16 + fr) * 64 + ch);
#pragma unroll
        for (int m = 0; m < 4; ++m)
#pragma unroll
            for (int n = 0; n < 8; ++n)
                acc[m][n] = __builtin_amdgcn_mfma_f32_16x16x32_bf16(bfr[n], af[m], acc[m][n], 0, 0, 0);
    }
    asm volatile("s_waitcnt lgkmcnt(0)" ::: "memory");
    __builtin_amdgcn_s_barrier();
#undef GT_STAGE
}

DEVI float proj_at(const bf16* PROJ, int t, int col) { return bf2f(PROJ[(size_t)t * NPROJ + col]); }
DEVI float proj_shift(const bf16* PROJ, int t, int col, float mu) {
    const float cur = proj_at(PROJ, t, col);
    const float prv = t > 0 ? proj_at(PROJ, t - 1, col) : 0.f;
    return cur + (prv - cur) * mu;
}

DEVI f32x4 shift4(const bf16* PROJ, int t, int col, const f32x4& mu) {
    const f32x4 cur = ld_bf4(PROJ + (size_t)t * NPROJ + col);
    f32x4 prv = ld_bf4(PROJ + (size_t)(t > 0 ? t - 1 : 0) * NPROJ + col);
    const float keep = t > 0 ? 1.f : 0.f;
    prv = prv * keep;
    return cur + (prv - cur) * mu;
}
DEVI float fsig(float x) { return sigmoidf_(x); }
DEVI void phase_mixprep(const P& p, int l, char* smem) {
    const bf16* PROJ = (const bf16*)(p.ws + WS_PROJ); const float* PEX = (const float*)(p.ws + WS_PEX);
    float* VFIRST = (float*)(p.ws + WS_VFIRST);
    bf16* RECR = (bf16*)(p.ws + WS_RECR); bf16* RECG = (bf16*)(p.ws + WS_RECG); bf16* RECT = (bf16*)(p.ws + WS_RECT);
    float* WDEC = (float*)(p.ws + WS_WDEC); float* GSC = (float*)(p.ws + WS_GSC);
    float* GB = (float*)(p.ws + WS_G); float* BON = (float*)(p.ws + WS_BON);
    const float* ROT = (const float*)(p.ws + WS_ROT);
    const bf16* LRT = (const bf16*)(p.ws + WS_LRT) + (size_t)l * 73728;
    bf16* L = (bf16*)smem;
    float* CW = (float*)(smem + 9728);
    float* MU = CW + 6144;
    float* PW0 = MU + 1024; float* PA0 = PW0 + 256; float* PKK = PA0 + 256; float* PKA = PKK + 256; float* PRK = PKA + 256; float* PV0 = PRK + 256;
    {
        const int tid = VTID;
        for (int i = tid; i < 6144; i += NT) CW[i] = p.in[21][l * 6144 + i];
        for (int i = tid; i < 1024; i += NT) MU[i] = p.in[7][l * 1024 + i];
        PW0[tid] = p.in[9][l * 256 + tid]; PA0[tid] = p.in[11][l * 256 + tid]; PKK[tid] = p.in[14][l * 256 + tid];
        PKA[tid] = p.in[15][l * 256 + tid]; PRK[tid] = p.in[16][l * 256 + tid]; PV0[tid] = (l == 1) ? p.in[19][tid] : 0.f;
    }
    __syncthreads();
    for (int item = VBID; item < S / 16; item += VNB) {
        int tid = VTID; asm volatile("" : "+v"(tid));
        const int lane = tid & 63, w = tid >> 6, fr = lane & 15, fq = lane >> 4;
        const int t0 = item * 16;
        {
            u32x2 cur[5], prv[5]; f32x4 xc[5], xp[5];
#pragma unroll
            for (int q = 0; q < 5; ++q) {
                const int g = tid + 256 * q, gg = g < 1152 ? g : 1151, tt = gg / 72, i4 = (gg % 72) * 4, t = t0 + tt, tp = t > 0 ? t - 1 : 0;
                const int ia = i4 < 256 ? i4 : 252, ib = i4 < 256 ? 0 : i4 - 256;
                cur[q] = *(const u32x2*)(PROJ + (size_t)t * NPROJ + 768 + ia); prv[q] = *(const u32x2*)(PROJ + (size_t)tp * NPROJ + 768 + ia);
                xc[q] = *(const f32x4*)(PEX + (size_t)t * 64 + 8 + ib); xp[q] = *(const f32x4*)(PEX + (size_t)tp * 64 + 8 + ib);
            }
            asm volatile("" ::: "memory");
#pragma unroll
            for (int q = 0; q < 5; ++q) {
                const int g = tid + 256 * q, gg = g < 1152 ? g : 1151, tt = gg / 72, i4 = (gg % 72) * 4, t = t0 + tt;
                const float keep = t > 0 ? 1.f : 0.f;
                f32x4 v;
                if (i4 < 256) {
                    const f32x4 c4 = {__uint_as_float(cur[q].x << 16), __uint_as_float(cur[q].x & 0xffff0000u), __uint_as_float(cur[q].y << 16), __uint_as_float(cur[q].y & 0xffff0000u)};
                    const f32x4 p4 = (f32x4){__uint_as_float(prv[q].x << 16), __uint_as_float(prv[q].x & 0xffff0000u), __uint_as_float(prv[q].y << 16), __uint_as_float(prv[q].y & 0xffff0000u)} * keep;
                    v = c4 + (p4 - c4) * *(const f32x4*)(MU + 768 + i4);
                    if (i4 < 64) { v.x = tanhf(v.x); v.y = tanhf(v.y); v.z = tanhf(v.z); v.w = tanhf(v.w); }
                    else if (i4 >= 128) { v.x = fsig(v.x); v.y = fsig(v.y); v.z = fsig(v.z); v.w = fsig(v.w); }
                } else {
                    v = (f32x4){0.f, 0.f, 0.f, 0.f};
                    if (l == 1) v = xc[q] + (xp[q] * keep - xc[q]) * *(const f32x4*)(p.in[8] + (i4 - 256));
                }
                if (g < 1152) *(u32x2*)(L + tt * 296 + i4) = (u32x2){pk2(v.x, v.y), pk2(v.z, v.w)};
            }
        }
        __syncthreads();
        const int t = t0 + fr, h = w, tpv = t > 0 ? t - 1 : 0;
        const float keep = t > 0 ? 1.f : 0.f;
        {
            f32x4 aw[4], aa[4], ag[4], av[4];
#pragma unroll
            for (int i = 0; i < 4; ++i) { aw[i] = (f32x4){0.f, 0.f, 0.f, 0.f}; aa[i] = aw[i]; ag[i] = aw[i]; av[i] = aw[i]; }
            bf16x8 lf[9];
#pragma unroll
            for (int ks = 0; ks < 9; ++ks) lf[ks] = *(const bf16x8*)(L + fr * 296 + ks * 32 + fq * 8);
#pragma unroll
            for (int i = 0; i < 4; ++i) {
                const int c = 64 * h + 16 * i + fr;
#pragma unroll
                for (int ks = 0; ks < 2; ++ks) aw[i] = mfma16(*(const bf16x8*)(LRT + c * 64 + ks * 32 + fq * 8), lf[ks], aw[i]);
#pragma unroll
                for (int ks = 0; ks < 2; ++ks) aa[i] = mfma16(*(const bf16x8*)(LRT + 16384 + c * 64 + ks * 32 + fq * 8), lf[2 + ks], aa[i]);
#pragma unroll
                for (int ks = 0; ks < 4; ++ks) ag[i] = mfma16(*(const bf16x8*)(LRT + 32768 + c * 128 + ks * 32 + fq * 8), lf[4 + ks], ag[i]);
                if (l == 1) av[i] = mfma16(*(const bf16x8*)(LRT + 65536 + c * 32 + fq * 8), lf[8], av[i]);
            }
            bf16* rec = RECR + ((size_t)t * 4 + h) * 384;
            f32x4 kx[4], as_[4];
            float ss = 0.f, bsum = 0.f;
#define UNPK4(u) ((f32x4){__uint_as_float((u).x << 16), __uint_as_float((u).x & 0xffff0000u), __uint_as_float((u).y << 16), __uint_as_float((u).y & 0xffff0000u)})
            u32x2 rc[4], rp[4], kc[4], kp[4], vc[4], vp[4]; f32x4 vf4[4];
#pragma unroll
            for (int i = 0; i < 4; ++i) {
                const int j = 16 * i + 4 * fq, c = 64 * h + j;
                if ((i & 1) == 0) {
#pragma unroll
                    for (int i2 = i; i2 < i + 2; ++i2) {
                        const int c2 = 64 * h + 16 * i2 + 4 * fq;
                        rc[i2] = *(const u32x2*)(PROJ + (size_t)t * NPROJ + c2); rp[i2] = *(const u32x2*)(PROJ + (size_t)tpv * NPROJ + c2);
                        kc[i2] = *(const u32x2*)(PROJ + (size_t)t * NPROJ + 256 + c2); kp[i2] = *(const u32x2*)(PROJ + (size_t)tpv * NPROJ + 256 + c2);
                        vc[i2] = *(const u32x2*)(PROJ + (size_t)t * NPROJ + 512 + c2); vp[i2] = *(const u32x2*)(PROJ + (size_t)tpv * NPROJ + 512 + c2);
                        if (l == 1) vf4[i2] = *(const f32x4*)(VFIRST + (size_t)t * 256 + c2);
                    }
                    asm volatile("" ::: "memory");
                }
                const f32x4 r0 = UNPK4(rc[i]), k0 = UNPK4(kc[i]), v0_ = UNPK4(vc[i]);
                const f32x4 r = r0 + (UNPK4(rp[i]) * keep - r0) * *(const f32x4*)(MU + c);
                const f32x4 k = k0 + (UNPK4(kp[i]) * keep - k0) * *(const f32x4*)(MU + 256 + c);
                f32x4 v = v0_ + (UNPK4(vp[i]) * keep - v0_) * *(const f32x4*)(MU + 512 + c);
                const f32x4 w0 = *(const f32x4*)(PW0 + c), a0 = *(const f32x4*)(PA0 + c);
                const f32x4 kkc = *(const f32x4*)(PKK + c), kac = *(const f32x4*)(PKA + c), rkc = *(const f32x4*)(PRK + c);
                f32x4 dec, a;
#pragma unroll
                for (int q = 0; q < 4; ++q) {
                    const float wl = -softplusf_(-(w0[q] + aw[i][q])) - 0.5f;
                    dec[q] = __expf(-__expf(wl));
                    a[q] = fsig(a0[q] + aa[i][q]);
                }
                if (l == 0) *(f32x4*)(VFIRST + (size_t)t * 256 + c) = v;
                else {
                    const f32x4 v0 = *(const f32x4*)(PV0 + c);
#pragma unroll
                    for (int q = 0; q < 4; ++q) v[q] = v[q] + (vf4[i][q] - v[q]) * fsig(v0[q] + av[i][q]);
                }
                kx[i] = k * kkc; as_[i] = a;
                const f32x4 k2 = k * ((a - 1.f) * kac + 1.f);
                ss += kx[i].x * kx[i].x + kx[i].y * kx[i].y + kx[i].z * kx[i].z + kx[i].w * kx[i].w;
                const f32x4 rb = r * k2 * rkc;
                bsum += (rb.x + rb.y) + (rb.z + rb.w);
                *(f32x4*)(WDEC + (size_t)t * 256 + c) = dec; st_bf4(rec + 192 + j, k2); st_bf4(rec + 256 + j, r); st_bf4(rec + 320 + j, v);
                *(f32x4*)(GB + (size_t)t * 256 + c) = ag[i];
            }
            const float rn = rsqrtf(quad_sum(ss) + 1e-12f);
            bsum = quad_sum(bsum);
            if (fq == 0) BON[(size_t)t * 4 + h] = bsum;
#pragma unroll
            for (int i = 0; i < 4; ++i) {
                const int j = 16 * i + 4 * fq;
                const f32x4 kk = kx[i] * rn;
                st_bf4(rec + j, -kk); st_bf4(rec + 128 + j, kk * as_[i]);
            }
        }
        {
            bf16* rec = RECG + ((size_t)t * 4 + h) * 392;
            f32x4 yq[8], yk[8];
            float sq = 0.f, sk = 0.f;
            size_t rowo[4];
            float tapm[4];
#pragma unroll
            for (int tap = 0; tap < 4; ++tap) { const int tp = t - 3 + tap; rowo[tap] = (size_t)(tp >= 0 ? tp : 0) * NPROJ; tapm[tap] = tp >= 0 ? 1.f : 0.f; }
#pragma unroll
            for (int which = 0; which < 3; ++which) {
                u32x2 raw[8][4];
#pragma unroll
                for (int i = 0; i < 8; ++i) {
                    if ((i & 3) == 0) {
#pragma unroll
                        for (int i2 = i; i2 < i + 4; ++i2)
#pragma unroll
                            for (int tap = 0; tap < 4; ++tap) raw[i2][tap] = *(const u32x2*)(PROJ + rowo[tap] + 1024 + which * 512 + h * 128 + 16 * i2 + 4 * fq);
                        asm volatile("" ::: "memory");
                    }
                    const int j = 16 * i + 4 * fq, ch = which * 512 + h * 128 + j;
                    f32x4 cv = {0.f, 0.f, 0.f, 0.f};
#pragma unroll
                    for (int tap = 0; tap < 4; ++tap) cv = cv + UNPK4(raw[i][tap]) * (*(const f32x4*)(CW + tap * 1536 + ch) * tapm[tap]);
                    f32x4 y; y.x = siluf_(cv.x); y.y = siluf_(cv.y); y.z = siluf_(cv.z); y.w = siluf_(cv.w);
                    if (which == 0) { yq[i] = y; sq += y.x * y.x + y.y * y.y + y.z * y.z + y.w * y.w; }
                    else if (which == 1) { yk[i] = y; sk += y.x * y.x + y.y * y.y + y.z * y.z + y.w * y.w; }
                    else st_bf4(rec + 256 + j, y);
                }
            }
            const float rq = rsqrtf(quad_sum(sq) + 1e-12f) * 0.08838834764831845f, rk = rsqrtf(quad_sum(sk) + 1e-12f);
#pragma unroll
            for (int i = 0; i < 8; ++i) { const int j = 16 * i + 4 * fq; st_bf4(rec + j, yq[i] * rq); st_bf4(rec + 128 + j, yk[i] * rk); }
            if (fq == 0) {
                const float av = PEX[(size_t)t * 64 + h], bv = PEX[(size_t)t * 64 + 4 + h];
                const float g = -__expf(p.in[22][l * 4 + h]) * softplusf_(av + p.in[23][l * 4 + h]);
                *(f32x4*)(GSC + ((size_t)t * 4 + h) * 4) = (f32x4){__expf(g), fsig(bv), g, 0.f};
            }
        }
        {
            bf16* rec = RECT + ((size_t)t * 4 + h) * 192;
            u32x2 q1r[2], q2r[2], k1r[2], k2r[2], vr[4]; f32x4 c0r[2], c1r[2];
#pragma unroll
            for (int u = 0; u < 2; ++u) {
                const int i = 16 * u + 4 * fq;
                c0r[u] = *(const f32x4*)(ROT + ((size_t)t * 32 + i) * 2); c1r[u] = *(const f32x4*)(ROT + ((size_t)t * 32 + i) * 2 + 4);
                q1r[u] = *(const u32x2*)(PROJ + (size_t)t * NPROJ + 3072 + h * 64 + i); q2r[u] = *(const u32x2*)(PROJ + (size_t)t * NPROJ + 3072 + h * 64 + 32 + i);
                k1r[u] = *(const u32x2*)(PROJ + (size_t)t * NPROJ + 3328 + h * 64 + i); k2r[u] = *(const u32x2*)(PROJ + (size_t)t * NPROJ + 3328 + h * 64 + 32 + i);
            }
#pragma unroll
            for (int i = 0; i < 4; ++i) vr[i] = *(const u32x2*)(PROJ + (size_t)t * NPROJ + 3584 + h * 64 + 16 * i + 4 * fq);
            asm volatile("" ::: "memory");
#pragma unroll
            for (int u = 0; u < 2; ++u) {
                const int i = 16 * u + 4 * fq;
                const f32x4 cs = {c0r[u].x, c0r[u].z, c1r[u].x, c1r[u].z}, sn = {c0r[u].y, c0r[u].w, c1r[u].y, c1r[u].w};
                const f32x4 q1 = UNPK4(q1r[u]), q2 = UNPK4(q2r[u]), k1 = UNPK4(k1r[u]), k2 = UNPK4(k2r[u]);
                st_bf4(rec + i, q1 * cs - q2 * sn); st_bf4(rec + 32 + i, q1 * sn + q2 * cs);
                st_bf4(rec + 64 + i, (k1 * cs - k2 * sn) * 0.125f); st_bf4(rec + 96 + i, (k1 * sn + k2 * cs) * 0.125f);
            }
#pragma unroll
            for (int i = 0; i < 4; ++i) *(u32x2*)(rec + 128 + 16 * i + 4 * fq) = vr[i];
        }
#undef UNPK4
        __syncthreads();
    }
}

DEVI void retA_item(const P& p, int item, char* smem) {
    const bf16* REC = (const bf16*)(p.ws + WS_RECT); float* KV = (float*)(p.ws + WS_RKV);
    bf16* KT = (bf16*)smem; bf16* VT = KT + 64 * 72;
    const int n = item >> 2, h = item & 3;
    int tid = VTID; asm volatile("" : "+v"(tid));
    const int lane = tid & 63, w = tid >> 6, fr = lane & 15, fq = lane >> 4;
    const float lg = log2f(1.f - exp2f(-5.f - (float)h));
    {
        u32x4 v[4];
#pragma unroll
        for (int i = 0; i < 4; ++i) { const int idx = tid + 256 * i, c = idx >> 4, j = idx & 15; v[i] = *(const u32x4*)(REC + ((size_t)(n * 64 + c) * 4 + h) * 192 + 64 + j * 8); }
#pragma unroll
        for (int i = 0; i < 4; ++i) {
            const int idx = tid + 256 * i, c = idx >> 4, j = idx & 15;
            const float sc = (j < 8) ? exp2f((float)(63 - c) * lg) : 1.f;
            bf16* dst = ((j < 8) ? KT : VT) + ((j & 7) * 8) * 72 + c;
#pragma unroll
            for (int q = 0; q < 4; ++q) {
                const unsigned u = v[i][q];
                dst[(2 * q) * 72] = (j < 8) ? (bf16)f2bf(__uint_as_float(u << 16) * sc) : (bf16)(u & 0xffffu);
                dst[(2 * q + 1) * 72] = (j < 8) ? (bf16)f2bf(__uint_as_float(u & 0xffff0000u) * sc) : (bf16)(u >> 16);
            }
        }
    }
    __syncthreads();
    {
        const int dt = w;
        const bf16x8 a0 = ldfrag(KT, 72, 16 * dt, 0, lane), a1 = ldfrag(KT, 72, 16 * dt, 32, lane);
        float* out = KV + (size_t)item * 4096;
        const int s_ = dt >> 1, lane2 = 16 * (2 * (dt & 1) + (fq >> 1)) + fr;
#pragma unroll
        for (int et = 0; et < 4; ++et) {
            f32x4 acc = {0.f, 0.f, 0.f, 0.f};
            acc = mfma16(a0, ldfrag(VT, 72, 16 * et, 0, lane), acc);
            acc = mfma16(a1, ldfrag(VT, 72, 16 * et, 32, lane), acc);
            *(f32x4*)(out + ((et * 2 + s_) * 64 + lane2) * 8 + 4 * (fq & 1)) = acc;
        }
    }
    __syncthreads();
}

DEVI void retS_item(const P& p, int item) {
    const float* KV = (const float*)(p.ws + WS_RKV); bf16* RST = (bf16*)(p.ws + WS_RST);
    const int idx = item * NT + VTID;
    const int h = idx >> 12, i = idx & 4095;
    const float cd = exp2f(64.f * log2f(1.f - exp2f(-5.f - (float)h)));
    float r = 0.f;
#pragma unroll 1
    for (int n0 = 0; n0 < 256; n0 += 32) {
        float kv[32];
#pragma unroll
        for (int q = 0; q < 32; ++q) kv[q] = KV[((size_t)(n0 + q) * 4 + h) * 4096 + i];
#pragma unroll
        for (int q = 0; q < 32; ++q) { RST[((size_t)(n0 + q) * 4 + h) * 4096 + i] = (bf16)f2bf(r); r = r * cd + kv[q]; }
    }
}

DEVI void retC_item(const P& p, int item, int l, char* smem) {
    const bf16* REC = (const bf16*)(p.ws + WS_RECT); const bf16* RST = (const bf16*)(p.ws + WS_RST);
    const bf16* PROJ = (const bf16*)(p.ws + WS_PROJ); bf16* MIX = (bf16*)(p.ws + WS_MIX);
    const float* rgn = p.in[25] + l * 256; const float* rbn = p.in[26] + l * 256;
    bf16* Qs = (bf16*)smem; bf16* Ks = Qs + 64 * 72; bf16* VT = Ks + 64 * 72; bf16* Ps = VT + 64 * 72;
    const int n = item >> 2, h = item & 3;
    int tid = VTID; asm volatile("" : "+v"(tid));
    const int lane = tid & 63, w = tid >> 6, fr = lane & 15, fq = lane >> 4;
    const float lg = log2f(1.f - exp2f(-5.f - (float)h));
    {
        u32x4 v[6];
#pragma unroll
        for (int i = 0; i < 6; ++i) { const int idx = tid + 256 * i, c = idx / 24, j = idx - c * 24; v[i] = *(const u32x4*)(REC + ((size_t)(n * 64 + c) * 4 + h) * 192 + j * 8); }
#pragma unroll
        for (int i = 0; i < 6; ++i) {
            const int idx = tid + 256 * i, c = idx / 24, j = idx - c * 24;
            if (j < 16) *(u32x4*)(((j < 8) ? Qs : Ks) + c * 72 + (j & 7) * 8) = v[i];
            else {
                bf16* dst = VT + ((j & 7) * 8) * 72 + c;
#pragma unroll
                for (int q = 0; q < 4; ++q) { const unsigned u = v[i][q]; dst[(2 * q) * 72] = (bf16)(u & 0xffffu); dst[(2 * q + 1) * 72] = (bf16)(u >> 16); }
            }
        }
    }
    __syncthreads();
    const int ct = w, c = 16 * ct + fr;
    const bf16x8 q0 = ldfrag(Qs, 72, 16 * ct, 0, lane), q1 = ldfrag(Qs, 72, 16 * ct, 32, lane);
#pragma unroll
    for (int ct2 = 0; ct2 < 4; ++ct2) {
        f32x4 acc = {0.f, 0.f, 0.f, 0.f};
        acc = mfma16(ldfrag(Ks, 72, 16 * ct2, 0, lane), q0, acc);
        acc = mfma16(ldfrag(Ks, 72, 16 * ct2, 32, lane), q1, acc);
        float pv[4];
#pragma unroll
        for (int j = 0; j < 4; ++j) {
            const int c2 = 16 * ct2 + 4 * fq + j;
            pv[j] = (c >= c2) ? acc[j] * exp2f((float)(c - c2) * lg) : 0.f;
        }
        *(u32x2*)(Ps + c * 72 + 16 * ct2 + 4 * fq) = (u32x2){pk2(pv[0], pv[1]), pk2(pv[2], pv[3])};
    }
    __syncthreads();
    {
        const bf16x8 p0 = ldfrag(Ps, 72, 16 * ct, 0, lane), p1 = ldfrag(Ps, 72, 16 * ct, 32, lane);
        const float xi = exp2f((float)(c + 1) * lg);
        const bf16* RF = RST + (size_t)item * 4096;
        f32x4 o[4];
        float sm = 0.f;
        bf16x8 rfr[4][2];
#pragma unroll
        for (int et = 0; et < 4; ++et) { rfr[et][0] = *(const bf16x8*)(RF + ((et * 2 + 0) * 64 + lane) * 8); rfr[et][1] = *(const bf16x8*)(RF + ((et * 2 + 1) * 64 + lane) * 8); }
        asm volatile("" ::: "memory");
#pragma unroll
        for (int et = 0; et < 4; ++et) {
            f32x4 ai = {0.f, 0.f, 0.f, 0.f}, ax = {0.f, 0.f, 0.f, 0.f};
            ai = mfma16(ldfrag(VT, 72, 16 * et, 0, lane), p0, ai);
            ai = mfma16(ldfrag(VT, 72, 16 * et, 32, lane), p1, ai);
            ax = mfma16(rfr[et][0], q0, ax);
            ax = mfma16(rfr[et][1], q1, ax);
            o[et] = ai + ax * xi;
            sm += (o[et].x + o[et].y) + (o[et].z + o[et].w);
        }
        const float mean = quad_sum(sm) * (1.f / 64.f);
        float sv = 0.f;
#pragma unroll
        for (int et = 0; et < 4; ++et) { o[et] = o[et] - mean; sv += o[et].x * o[et].x + o[et].y * o[et].y + o[et].z * o[et].z + o[et].w * o[et].w; }
        const float rs = rsqrtf(quad_sum(sv) * (1.f / 64.f) + 1e-5f);
        const int t = n * 64 + c;
#pragma unroll
        for (int et = 0; et < 4; ++et) {
            const int e = h * 64 + 16 * et + 4 * fq;
            const f32x4 g = *(const f32x4*)(rgn + e), b = *(const f32x4*)(rbn + e);
            const f32x4 gt = ld_bf4(PROJ + (size_t)t * NPROJ + 3840 + e);
            const f32x4 y = o[et] * rs * g + b;
            *(u32x2*)(MIX + (size_t)t * D + 768 + e) = (u32x2){pk2(y.x * siluf_(gt.x), y.y * siluf_(gt.y)), pk2(y.z * siluf_(gt.z), y.w * siluf_(gt.w))};
        }
    }
    __syncthreads();
}

template <int I, int N> struct SolveRow {
    static DEVI void run(float (&x)[N], const float* M) {
        float s = 0.f;
#pragma unroll
        for (int j4 = 0; j4 < (I + 3) / 4; ++j4) {
            const f32x4 m = *(const f32x4*)(M + I * N + 4 * j4);
            s += m.x * x[4 * j4] + m.y * x[4 * j4 + 1] + m.z * x[4 * j4 + 2] + m.w * x[4 * j4 + 3];
        }
        x[I] -= s;
        asm volatile("" : "+v"(x[I]) :: "memory");
        SolveRow<I + 1, N>::run(x, M);
    }
};
template <int N> struct SolveRow<N, N> { static DEVI void run(float (&)[N], const float*) {} };

DEVI void gdnA_item(const P& p, int item, char* smem) {
    const bf16* REC = (const bf16*)(p.ws + WS_RECG); const float* GSC = (const float*)(p.ws + WS_GSC) + ((size_t)(item >> 2) * 64 * 4 + (item & 3)) * 4;
    bf16* GP = (bf16*)(p.ws + WS_GP) + (size_t)item * 16384; float* GB = (float*)(p.ws + WS_GB) + (size_t)item * 16384;
    float* GD = (float*)(p.ws + WS_GD);
    bf16* GQ = (bf16*)(p.ws + WS_GQ) + (size_t)item * 8192; float* GO = (float*)(p.ws + WS_GO) + (size_t)item * 8192;
    bf16* Kb = (bf16*)smem; bf16* Qb = Kb + 64 * 136;
    bf16* WT = (bf16*)smem; bf16* UT = WT + 128 * 72;
    bf16* Vb = (bf16*)(smem + 36864);
    float* M = (float*)(smem + 36864);
    bf16* KdT = (bf16*)(smem + 36864);
    bf16* At = (bf16*)(smem + 55296);
    float* gcs = (float*)(smem + 64512); float* bts = gcs + 64; float* sws = gcs + 128; float* sks = gcs + 192;
    const int n = item >> 2, h = item & 3;
    int tid = VTID; asm volatile("" : "+v"(tid));
    const int lane = tid & 63, w = tid >> 6, fr = lane & 15, fq = lane >> 4;
    const bf16* rec0 = REC + ((size_t)(n * 64) * 4 + h) * 392;
    if (w == 0) {
        float x = GSC[lane * 16 + 2];
#pragma unroll
        for (int off = 1; off < 64; off <<= 1) { const float y = __shfl_up(x, off); if (lane >= off) x += y; }
        const float bt = GSC[lane * 16 + 1];
        gcs[lane] = x; bts[lane] = bt; sws[lane] = bt * __expf(x); sks[lane] = __expf(__shfl(x, 63) - x);
    }
    {
        u32x4 v[12];
#pragma unroll
        for (int i = 0; i < 12; ++i) { const int idx = tid + 256 * i, c = idx / 48, j = idx - c * 48; v[i] = *(const u32x4*)(rec0 + (size_t)c * 1568 + j * 8); }
#pragma unroll
        for (int i = 0; i < 12; ++i) {
            const int idx = tid + 256 * i, c = idx / 48, j = idx - c * 48, which = j >> 4;
            const int boff = (which == 0 ? 17408 : 0) + (which == 2 ? 36864 : 0);
            *(u32x4*)(smem + boff + (c * 136 + (j & 15) * 8) * 2) = v[i];
        }
    }
    __syncthreads();
    float x[64];
    unsigned kdp[16];
    {
        const int col = tid & 127;
        int sel_b = (tid < 128) ? 36864 : 0, sel_s = (tid < 128) ? 64 : 128;
        asm volatile("" : "+v"(sel_b), "+v"(sel_s));
        const bf16* srcb = (const bf16*)(smem + sel_b) + col;
        const float* scs = gcs + sel_s;
#pragma unroll
        for (int c = 0; c < 64; ++c) {
            x[c] = scs[c] * bf2f(srcb[c * 136]);
            if ((c & 7) == 7) asm volatile("" : "+v"(x[c]) :: "memory");
        }
        const int half = tid >> 7;
#pragma unroll
        for (int i = 0; i < 16; ++i) {
            const int c = 32 * half + 2 * i;
            kdp[i] = pk2(bf2f(Kb[c * 136 + col]) * sks[c], bf2f(Kb[(c + 1) * 136 + col]) * sks[c + 1]);
            if ((i & 3) == 3) asm volatile("" : "+v"(kdp[i]) :: "memory");
        }
        if (tid == 0) GD[item] = __expf(gcs[63]);
    }
    __syncthreads();
    const int ct = w;
    f32x4 accQ[8];
    {
        const int c = 16 * ct + fr;
        const float gcc = gcs[c];
        {
            bf16x8 ka[4];
#pragma unroll
            for (int s = 0; s < 4; ++s) ka[s] = ldfrag(Kb, 136, 16 * ct, 32 * s, lane);
#pragma unroll
            for (int ct2 = 0; ct2 < 4; ++ct2) {
                f32x4 acc = {0.f, 0.f, 0.f, 0.f};
#pragma unroll
                for (int s = 0; s < 4; ++s) acc = mfma16(ka[s], ldfrag(Kb, 136, 16 * ct2, 32 * s, lane), acc);
                const int c2 = 16 * ct2 + fr; const float g2 = gcs[c2];
#pragma unroll
                for (int j = 0; j < 4; ++j) {
                    const int cc = 16 * ct + 4 * fq + j;
                    M[cc * 64 + c2] = (cc > c2) ? bts[cc] * acc[j] * __expf(gcs[cc] - g2) : 0.f;
                }
            }
        }
        {
            bf16x8 qa[4];
#pragma unroll
            for (int s = 0; s < 4; ++s) qa[s] = ldfrag(Qb, 136, 16 * ct, 32 * s, lane);
#pragma unroll
            for (int ct2 = 0; ct2 < 4; ++ct2) {
                f32x4 acc = {0.f, 0.f, 0.f, 0.f};
#pragma unroll
                for (int s = 0; s < 4; ++s) acc = mfma16(ldfrag(Kb, 136, 16 * ct2, 32 * s, lane), qa[s], acc);
                float pv[4];
#pragma unroll
                for (int j = 0; j < 4; ++j) { const int c2 = 16 * ct2 + 4 * fq + j; pv[j] = (c >= c2) ? acc[j] * __expf(gcc - gcs[c2]) : 0.f; }
                *(u32x2*)(At + c * 72 + 16 * ct2 + 4 * fq) = (u32x2){pk2(pv[0], pv[1]), pk2(pv[2], pv[3])};
            }
        }
    }
    __syncthreads();
    {
        SolveRow<1, 64>::run(x, M);
        unsigned xp[32];
#pragma unroll
        for (int q = 0; q < 32; ++q) xp[q] = pk2(x[2 * q], x[2 * q + 1]);
        {
            const int c = 16 * ct + fr;
            const float eg = __expf(gcs[c]);
#pragma unroll
            for (int dt = 0; dt < 8; ++dt) accQ[dt] = ld_bf4(Qb + c * 136 + 16 * dt + 4 * fq) * (-eg);
        }
        __syncthreads();
        int sel_d = (tid < 128) ? 128 * 72 : 0;
        asm volatile("" : "+v"(sel_d));
        bf16* dst = WT + sel_d + (tid & 127) * 72;
#pragma unroll
        for (int q = 0; q < 8; ++q) *(u32x4*)(dst + 8 * q) = (u32x4){xp[4 * q], xp[4 * q + 1], xp[4 * q + 2], xp[4 * q + 3]};
    }
    __syncthreads();
    {
        const int d = tid & 127, half = tid >> 7;
#pragma unroll
        for (int q = 0; q < 4; ++q) *(u32x4*)(KdT + d * 72 + 32 * half + 8 * q) = (u32x4){kdp[4 * q], kdp[4 * q + 1], kdp[4 * q + 2], kdp[4 * q + 3]};
    }
    __syncthreads();
    {
#pragma unroll 1
        for (int mi = 0; mi < 2; ++mi) {
            const int mt = 2 * w + mi;
            const bf16x8 kd0 = ldfrag(KdT, 72, 16 * mt, 0, lane), kd1 = ldfrag(KdT, 72, 16 * mt, 32, lane);
#pragma unroll
            for (int sp = 0; sp < 4; ++sp) {
                f32x4 a0 = {0.f, 0.f, 0.f, 0.f}, a1 = {0.f, 0.f, 0.f, 0.f};
                a0 = mfma16(ldfrag(WT, 72, 32 * sp, 0, lane), kd0, a0); a0 = mfma16(ldfrag(WT, 72, 32 * sp, 32, lane), kd1, a0);
                a1 = mfma16(ldfrag(WT, 72, 32 * sp + 16, 0, lane), kd0, a1); a1 = mfma16(ldfrag(WT, 72, 32 * sp + 16, 32, lane), kd1, a1);
                *(u32x4*)(GP + ((mt * 4 + sp) * 64 + lane) * 8) = (u32x4){pk2(-a0.x, -a0.y), pk2(-a0.z, -a0.w), pk2(-a1.x, -a1.y), pk2(-a1.z, -a1.w)};
            }
#pragma unroll
            for (int nt = 0; nt < 8; ++nt) {
                f32x4 a = {0.f, 0.f, 0.f, 0.f};
                a = mfma16(kd0, ldfrag(UT, 72, 16 * nt, 0, lane), a); a = mfma16(kd1, ldfrag(UT, 72, 16 * nt, 32, lane), a);
                *(f32x4*)(GB + ((nt * 8 + mt) * 64 + lane) * 4) = a;
            }
        }
        const bf16x8 at0 = ldfrag(At, 72, 16 * ct, 0, lane), at1 = ldfrag(At, 72, 16 * ct, 32, lane);
#pragma unroll
        for (int sp = 0; sp < 4; ++sp) {
            f32x4 a0 = accQ[2 * sp], a1 = accQ[2 * sp + 1];
            a0 = mfma16(ldfrag(WT, 72, 32 * sp, 0, lane), at0, a0); a0 = mfma16(ldfrag(WT, 72, 32 * sp, 32, lane), at1, a0);
            a1 = mfma16(ldfrag(WT, 72, 32 * sp + 16, 0, lane), at0, a1); a1 = mfma16(ldfrag(WT, 72, 32 * sp + 16, 32, lane), at1, a1);
            *(u32x4*)(GQ + ((ct * 4 + sp) * 64 + lane) * 8) = (u32x4){pk2(-a0.x, -a0.y), pk2(-a0.z, -a0.w), pk2(-a1.x, -a1.y), pk2(-a1.z, -a1.w)};
        }
#pragma unroll
        for (int et = 0; et < 8; ++et) {
            f32x4 a = {0.f, 0.f, 0.f, 0.f};
            a = mfma16(ldfrag(UT, 72, 16 * et, 0, lane), at0, a); a = mfma16(ldfrag(UT, 72, 16 * et, 32, lane), at1, a);
            *(f32x4*)(GO + ((ct * 8 + et) * 64 + lane) * 4) = a;
        }
    }
    __syncthreads();
}

DEVI bf16x8 pack_frag(const f32x4& a, const f32x4& b) {
    const u32x4 v = {pk2(a.x, a.y), pk2(a.z, a.w), pk2(b.x, b.y), pk2(b.z, b.w)};
    return __builtin_bit_cast(bf16x8, v);
}
DEVI void gdnL1_item(const P& p, int item, char* smem) {
    const bf16* GP = (const bf16*)(p.ws + WS_GP); const float* GB = (const float*)(p.ws + WS_GB); const float* GD = (const float*)(p.ws + WS_GD);
    const int half = item & 1, kind = (item >> 1) & 1, g = (item >> 2) & 15, h = item >> 6;
    const int tid = VTID, lane = tid & 63, ew = half * 4 + (tid >> 6), fr = lane & 15, fq = lane >> 4;
    const int n0 = g * 16;
#define L1_DMA(n) do { const bf16* _s = GP + ((size_t)(n) * 4 + h) * 16384 + tid * 8; char* _d = smem + ((n) & 1) * 32768 + tid * 16; \
        _Pragma("unroll") for (int _i = 0; _i < 8; ++_i) __builtin_amdgcn_global_load_lds((const unsigned*)(_s + _i * 2048), (unsigned*)(_d + _i * 4096), 16, 0, 0); } while (0)
    f32x4 acc[8];
    L1_DMA(n0);
    if (kind == 0) {
        bf16* GS = (bf16*)(p.ws + WS_GS);
#pragma unroll
        for (int m = 0; m < 8; ++m) acc[m] = (f32x4){0.f, 0.f, 0.f, 0.f};
        f32x4 bcur[8], bnxt[8]; float dcur, dnxt = 0.f;
        {
            const float* Bn = GB + ((size_t)n0 * 4 + h) * 16384 + (ew * 8 * 64 + lane) * 4;
#pragma unroll
            for (int m = 0; m < 8; ++m) bcur[m] = *(const f32x4*)(Bn + m * 256);
            dcur = GD[(size_t)n0 * 4 + h];
        }
#pragma unroll 1
        for (int n = n0; n < n0 + 16; ++n) {
            const size_t it = (size_t)n * 4 + h;
            asm volatile("s_waitcnt vmcnt(0)" ::: "memory");
            __syncthreads();
            if (n + 1 < n0 + 16) {
                L1_DMA(n + 1);
                const float* Bn = GB + (it + 4) * 16384 + (ew * 8 * 64 + lane) * 4;
#pragma unroll
                for (int m = 0; m < 8; ++m) bnxt[m] = *(const f32x4*)(Bn + m * 256);
                dnxt = GD[it + 4];
            }
            const char* ring = smem + (n & 1) * 32768 + lane * 16;
            bf16x8 sf[4];
#pragma unroll
            for (int s = 0; s < 4; ++s) {
                sf[s] = pack_frag(acc[2 * s], acc[2 * s + 1]);
                *(bf16x8*)(GS + it * 16384 + ((ew * 4 + s) * 64 + lane) * 8) = sf[s];
            }
#pragma unroll
            for (int m = 0; m < 8; ++m) {
                f32x4 a = acc[m] * dcur + bcur[m];
#pragma unroll
                for (int s = 0; s < 4; ++s) a = mfma16(*(const bf16x8*)(ring + (m * 4 + s) * 1024), sf[s], a);
                acc[m] = a;
            }
#pragma unroll
            for (int m = 0; m < 8; ++m) bcur[m] = bnxt[m];
            dcur = dnxt;
        }
        float* E0 = (float*)(p.ws + WS_GE0) + (size_t)(h * 16 + g) * 16384 + (ew * 8 * 64 + lane) * 4;
#pragma unroll
        for (int m = 0; m < 8; ++m) *(f32x4*)(E0 + m * 256) = acc[m];
    } else {
        const bf16* GQ = (const bf16*)(p.ws + WS_GQ); bf16* GR = (bf16*)(p.ws + WS_GR);
#pragma unroll
        for (int m = 0; m < 8; ++m)
#pragma unroll
            for (int j = 0; j < 4; ++j) acc[m][j] = (m == ew && 4 * fq + j == fr) ? 1.f : 0.f;
#pragma unroll 1
        for (int n = n0; n < n0 + 16; ++n) {
            const size_t it = (size_t)n * 4 + h;
            asm volatile("s_waitcnt vmcnt(0)" ::: "memory");
            __syncthreads();
            if (n + 1 < n0 + 16) L1_DMA(n + 1);
            bf16x8 qf[16];
#pragma unroll
            for (int i = 0; i < 16; ++i) qf[i] = *(const bf16x8*)(GQ + it * 8192 + (i * 64 + lane) * 8);
            const float dn = GD[it];
            const char* ring = smem + (n & 1) * 32768 + lane * 16;
            bf16x8 tf[4];
#pragma unroll
            for (int s = 0; s < 4; ++s) tf[s] = pack_frag(acc[2 * s], acc[2 * s + 1]);
#pragma unroll
            for (int m = 0; m < 8; ++m) {
                f32x4 a = acc[m] * dn;
#pragma unroll
                for (int s = 0; s < 4; ++s) a = mfma16(*(const bf16x8*)(ring + (m * 4 + s) * 1024), tf[s], a);
                acc[m] = a;
            }
#pragma unroll
            for (int tt = 0; tt < 4; ++tt) {
                f32x4 r = {0.f, 0.f, 0.f, 0.f};
#pragma unroll
                for (int s = 0; s < 4; ++s) r = mfma16(tf[s], qf[tt * 4 + s], r);
                *(u32x2*)(GR + it * 8192 + ((tt * 4 + (ew >> 1)) * 64 + lane) * 8 + 4 * (ew & 1)) = (u32x2){pk2(r.x, r.y), pk2(r.z, r.w)};
            }
        }
        bf16* TE = (bf16*)(p.ws + WS_GTE) + (size_t)(h * 16 + g) * 16384;
        const int s_ = ew >> 1, jj = 4 * (ew & 1) + (fr & 3), lg = fr >> 2;
#pragma unroll
        for (int m = 0; m < 8; ++m)
#pragma unroll
            for (int j = 0; j < 4; ++j) TE[((m * 4 + s_) * 64 + (4 * fq + j) + 16 * lg) * 8 + jj] = (bf16)f2bf(acc[m][j]);
    }
    asm volatile("s_waitcnt vmcnt(0)" ::: "memory");
    __syncthreads();
#undef L1_DMA
}
DEVI void gdnL2_item(const P& p, int item, char* smem) {
    const bf16* TE = (const bf16*)(p.ws + WS_GTE); const float* E0 = (const float*)(p.ws + WS_GE0); bf16* SG = (bf16*)(p.ws + WS_GSG);
    const int h = item >> 1, tid = VTID, lane = tid & 63, ew = (item & 1) * 4 + (tid >> 6);
#define L2_DMA(g) do { const bf16* _s = TE + ((size_t)h * 16 + (g)) * 16384 + tid * 8; char* _d = smem + ((g) & 1) * 32768 + tid * 16; \
        _Pragma("unroll") for (int _i = 0; _i < 8; ++_i) __builtin_amdgcn_global_load_lds((const unsigned*)(_s + _i * 2048), (unsigned*)(_d + _i * 4096), 16, 0, 0); } while (0)
    f32x4 acc[8];
#pragma unroll
    for (int m = 0; m < 8; ++m) acc[m] = (f32x4){0.f, 0.f, 0.f, 0.f};
    L2_DMA(0);
    f32x4 bcur[8], bnxt[8];
    {
        const float* En = E0 + (size_t)h * 16 * 16384 + (ew * 8 * 64 + lane) * 4;
#pragma unroll
        for (int m = 0; m < 8; ++m) bcur[m] = *(const f32x4*)(En + m * 256);
    }
#pragma unroll 1
    for (int g = 0; g < 16; ++g) {
        const size_t hg = (size_t)h * 16 + g;
        asm volatile("s_waitcnt vmcnt(0)" ::: "memory");
        __syncthreads();
        if (g + 1 < 16) {
            L2_DMA(g + 1);
            const float* En = E0 + (hg + 1) * 16384 + (ew * 8 * 64 + lane) * 4;
#pragma unroll
            for (int m = 0; m < 8; ++m) bnxt[m] = *(const f32x4*)(En + m * 256);
        }
        const char* ring = smem + (g & 1) * 32768 + lane * 16;
        bf16x8 sf[4];
#pragma unroll
        for (int s = 0; s < 4; ++s) {
            sf[s] = pack_frag(acc[2 * s], acc[2 * s + 1]);
            *(bf16x8*)(SG + hg * 16384 + ((ew * 4 + s) * 64 + lane) * 8) = sf[s];
        }
#pragma unroll
        for (int m = 0; m < 8; ++m) {
            f32x4 a = bcur[m];
#pragma unroll
            for (int s = 0; s < 4; ++s) a = mfma16(*(const bf16x8*)(ring + (m * 4 + s) * 1024), sf[s], a);
            acc[m] = a;
        }
#pragma unroll
        for (int m = 0; m < 8; ++m) bcur[m] = bnxt[m];
    }
    asm volatile("s_waitcnt vmcnt(0)" ::: "memory");
    __syncthreads();
#undef L2_DMA
}

DEVI void gdnC_item(const P& p, int item, int l) {
    const bf16* GQ = (const bf16*)(p.ws + WS_GQ) + (size_t)item * 8192; const float* GO = (const float*)(p.ws + WS_GO) + (size_t)item * 8192;
    const bf16* GS = (const bf16*)(p.ws + WS_GS) + (size_t)item * 16384;
    const bf16* PROJ = (const bf16*)(p.ws + WS_PROJ); bf16* MIX = (bf16*)(p.ws + WS_MIX);
    const float* gn = p.in[24] + l * 128;
    const int n = item >> 2, h = item & 3;
    const int lane = VTID & 63, ct = VTID >> 6, fr = lane & 15, fq = lane >> 4;
    const bf16* GR = (const bf16*)(p.ws + WS_GR) + (size_t)item * 8192;
    const bf16* SG = (const bf16*)(p.ws + WS_GSG) + (size_t)(h * 16 + (n >> 4)) * 16384;
    bf16x8 qf[4], rf[4];
#pragma unroll
    for (int s = 0; s < 4; ++s) { qf[s] = *(const bf16x8*)(GQ + ((ct * 4 + s) * 64 + lane) * 8); rf[s] = *(const bf16x8*)(GR + ((ct * 4 + s) * 64 + lane) * 8); }
    const int t = n * 64 + 16 * ct + fr;
    f32x4 a[8];
    float ss = 0.f;
    u32x2 zr[8]; f32x4 gv[8];
#pragma unroll
    for (int et = 0; et < 8; ++et) { zr[et] = *(const u32x2*)(PROJ + (size_t)t * NPROJ + 2560 + h * 128 + 16 * et + 4 * fq); gv[et] = *(const f32x4*)(gn + 16 * et + 4 * fq); }
#pragma unroll
    for (int e2 = 0; e2 < 4; ++e2) {
        f32x4 c0[2]; bf16x8 gs[2][4], sg[2][4];
#pragma unroll
        for (int u = 0; u < 2; ++u) {
            const int et = 2 * e2 + u;
            c0[u] = *(const f32x4*)(GO + ((ct * 8 + et) * 64 + lane) * 4);
#pragma unroll
            for (int s = 0; s < 4; ++s) { gs[u][s] = *(const bf16x8*)(GS + ((et * 4 + s) * 64 + lane) * 8); sg[u][s] = *(const bf16x8*)(SG + ((et * 4 + s) * 64 + lane) * 8); }
        }
        asm volatile("" ::: "memory");
#pragma unroll
        for (int u = 0; u < 2; ++u) {
            f32x4 acc = c0[u];
#pragma unroll
            for (int s = 0; s < 4; ++s) acc = mfma16(gs[u][s], qf[s], acc);
#pragma unroll
            for (int s = 0; s < 4; ++s) acc = mfma16(sg[u][s], rf[s], acc);
            a[2 * e2 + u] = acc;
            ss += acc.x * acc.x + acc.y * acc.y + acc.z * acc.z + acc.w * acc.w;
        }
    }
    const float rs = rsqrtf(quad_sum(ss) * (1.f / 128.f) + 1e-6f);
#pragma unroll
    for (int et = 0; et < 8; ++et) {
        const int e = 16 * et + 4 * fq;
        const f32x4 z = {__uint_as_float(zr[et].x << 16), __uint_as_float(zr[et].x & 0xffff0000u), __uint_as_float(zr[et].y << 16), __uint_as_float(zr[et].y & 0xffff0000u)};
        const f32x4 o = a[et] * rs * gv[et];
        *(u32x2*)(MIX + (size_t)t * D + 256 + h * 128 + e) = (u32x2){pk2(o.x * siluf_(z.x), o.y * siluf_(z.y)), pk2(o.z * siluf_(z.z), o.w * siluf_(z.w))};
    }
}

DEVI void rwkA_item(const P& p, int item, char* smem) {
    const bf16* REC = (const bf16*)(p.ws + WS_RECR); const float* WDEC = (const float*)(p.ws + WS_WDEC);
    bf16* WP = (bf16*)(p.ws + WS_WP) + (size_t)item * 4096; float* WC = (float*)(p.ws + WS_WC) + (size_t)item * 4096;
    float* WD = (float*)(p.ws + WS_WD) + (size_t)item * 64;
    bf16* WQ = (bf16*)(p.ws + WS_WQ) + (size_t)item * 2048; float* WY = (float*)(p.ws + WS_WY) + (size_t)item * 2048;
    bf16* At_ = (bf16*)smem; bf16* Rt = At_ + 32 * 72; bf16* Bt = Rt + 32 * 72; bf16* Kt = Bt + 32 * 72;
    float* ZT = (float*)(smem + 9216);
    bf16* BhT = (bf16*)(smem + 18432); bf16* KhT = BhT + 64 * 40; bf16* VT = KhT + 64 * 40; bf16* AhT = VT + 64 * 40; bf16* UhT = AhT + 64 * 40;
    float* M = (float*)(smem + 44032);
    bf16* Aak = (bf16*)(smem + 48128); bf16* Arb = Aak + 32 * 40; bf16* Ark = Arb + 32 * 40;
    float* tot = (float*)(smem + 55808);
    const int n = item >> 2, h = item & 3;
    int tid = VTID; asm volatile("" : "+v"(tid));
    const int lane = tid & 63, w = tid >> 6, fr = lane & 15, fq = lane >> 4;
    {
        const int d = lane;
        const bf16* rec = REC + ((size_t)(n * 32 + 8 * w) * 4 + h) * 384 + d;
        const float* dcy = WDEC + (size_t)(n * 32 + 8 * w) * 256 + h * 64 + d;
        float lw[8], lg[8];
        float run = 0.f;
        float dcv[8]; bf16 ra[8], rb[8], rk[8], rr_[8], rv[8];
#pragma unroll
        for (int i = 0; i < 8; ++i) {
            const bf16* r = rec + (size_t)i * 1536;
            dcv[i] = dcy[i * 256]; ra[i] = r[0]; rb[i] = r[128]; rk[i] = r[192]; rr_[i] = r[256]; rv[i] = r[320];
        }
        asm volatile("" ::: "memory");
#pragma unroll
        for (int i = 0; i < 8; ++i) { lg[i] = __logf(dcv[i]); run += lg[i]; lw[i] = run; }
        tot[w * 64 + d] = run;
        __syncthreads();
        float off = 0.f, total = 0.f;
#pragma unroll
        for (int q = 0; q < 4; ++q) { const float tq = tot[q * 64 + d]; total += tq; off += (q < w) ? tq : 0.f; }
        unsigned bh[4], kh[4], vv[4];
        float pb = 0.f, pk = 0.f, pv = 0.f;
#pragma unroll
        for (int i = 0; i < 8; ++i) {
            const float a = bf2f(ra[i]), b = bf2f(rb[i]), k = bf2f(rk[i]), rr = bf2f(rr_[i]), v = bf2f(rv[i]);
            const float lc = off + lw[i];
            const float cw = __expf(lc), cwm1 = __expf(lc - lg[i]), inv = __expf(-lc), rat = __expf(total - lc);
            const int t = 8 * w + i;
            At_[t * 72 + d] = (bf16)f2bf(a * cwm1); Rt[t * 72 + d] = (bf16)f2bf(rr * cw);
            Bt[t * 72 + d] = (bf16)f2bf(b * inv); Kt[t * 72 + d] = (bf16)f2bf(k * inv);
            if (i & 1) { bh[i >> 1] = pk2(pb, b * rat); kh[i >> 1] = pk2(pk, k * rat); vv[i >> 1] = pk2(pv, v); }
            else { pb = b * rat; pk = k * rat; pv = v; }
        }
        *(u32x4*)(BhT + d * 40 + 8 * w) = (u32x4){bh[0], bh[1], bh[2], bh[3]};
        *(u32x4*)(KhT + d * 40 + 8 * w) = (u32x4){kh[0], kh[1], kh[2], kh[3]};
        *(u32x4*)(VT + d * 40 + 8 * w) = (u32x4){vv[0], vv[1], vv[2], vv[3]};
        if (w == 0) WD[d] = __expf(total);
    }
    __syncthreads();
    {
        int offA = (w == 0) ? 0 : (w == 1 ? 3 : (w == 2 ? 2 : 3));
        int offB = (w == 0) ? 2 : (w == 1 ? 0 : 1);
        asm volatile("" : "+v"(offA), "+v"(offB));
        const bf16* As = At_ + offA * (32 * 72); const bf16* Bs = At_ + offB * (32 * 72);
#pragma unroll
        for (int ta = 0; ta < 2; ++ta) {
            const bf16x8 a0 = ldfrag(As, 72, 16 * ta, 0, lane), a1 = ldfrag(As, 72, 16 * ta, 32, lane);
#pragma unroll
            for (int tb = 0; tb < 2; ++tb) {
                f32x4 acc = {0.f, 0.f, 0.f, 0.f};
                acc = mfma16(a0, ldfrag(Bs, 72, 16 * tb, 0, lane), acc);
                acc = mfma16(a1, ldfrag(Bs, 72, 16 * tb, 32, lane), acc);
                if (w == 0) {
                    const int s_ = 16 * tb + fr;
#pragma unroll
                    for (int j = 0; j < 4; ++j) { const int t = 16 * ta + 4 * fq + j; M[t * 32 + s_] = (t > s_) ? -acc[j] : 0.f; }
                } else {
                    const int t = 16 * tb + fr;
                    float pv4[4];
#pragma unroll
                    for (int j = 0; j < 4; ++j) { const int s_ = 16 * ta + 4 * fq + j; pv4[j] = ((w == 1) ? (t > s_) : (t >= s_)) ? acc[j] : 0.f; }
                    int offD = w - 1; asm volatile("" : "+v"(offD));
                    *(u32x2*)(Aak + offD * (32 * 40) + t * 40 + 16 * ta + 4 * fq) = (u32x2){pk2(pv4[0], pv4[1]), pk2(pv4[2], pv4[3])};
                }
            }
        }
    }
    __syncthreads();
    {
        const int et = w;
        const bf16x8 vf = ldfrag(VT, 40, 16 * et, 0, lane);
#pragma unroll
        for (int tt = 0; tt < 2; ++tt) {
            f32x4 acc = {0.f, 0.f, 0.f, 0.f};
            acc = mfma16(ldfrag(Aak, 40, 16 * tt, 0, lane), vf, acc);
            *(f32x4*)(ZT + (16 * et + fr) * 36 + 16 * tt + 4 * fq) = acc;
        }
    }
    __syncthreads();
    if (tid < 128) {
        float x[32];
        if (tid < 64) {
#pragma unroll
            for (int t = 0; t < 32; ++t) x[t] = bf2f(At_[t * 72 + tid]);
        } else {
#pragma unroll
            for (int q = 0; q < 8; ++q) { const f32x4 z = *(const f32x4*)(ZT + (tid - 64) * 36 + 4 * q); x[4 * q] = z.x; x[4 * q + 1] = z.y; x[4 * q + 2] = z.z; x[4 * q + 3] = z.w; }
        }
        SolveRow<1, 32>::run(x, M);
        bf16* dst = AhT + tid * 40;
#pragma unroll
        for (int q = 0; q < 4; ++q)
            *(u32x4*)(dst + 8 * q) = (u32x4){pk2(x[8 * q], x[8 * q + 1]), pk2(x[8 * q + 2], x[8 * q + 3]), pk2(x[8 * q + 4], x[8 * q + 5]), pk2(x[8 * q + 6], x[8 * q + 7])};
    }
    __syncthreads();
    {
        const int mt = w;
        const bf16x8 bh = ldfrag(BhT, 40, 16 * mt, 0, lane), kh = ldfrag(KhT, 40, 16 * mt, 0, lane);
#pragma unroll
        for (int sp = 0; sp < 2; ++sp) {
            f32x4 a0 = {0.f, 0.f, 0.f, 0.f}, a1 = {0.f, 0.f, 0.f, 0.f};
            a0 = mfma16(ldfrag(AhT, 40, 32 * sp, 0, lane), bh, a0);
            a1 = mfma16(ldfrag(AhT, 40, 32 * sp + 16, 0, lane), bh, a1);
            *(u32x4*)(WP + ((mt * 2 + sp) * 64 + lane) * 8) = (u32x4){pk2(a0.x, a0.y), pk2(a0.z, a0.w), pk2(a1.x, a1.y), pk2(a1.z, a1.w)};
        }
#pragma unroll
        for (int nt = 0; nt < 4; ++nt) {
            f32x4 a = {0.f, 0.f, 0.f, 0.f};
            a = mfma16(bh, ldfrag(UhT, 40, 16 * nt, 0, lane), a);
            a = mfma16(kh, ldfrag(VT, 40, 16 * nt, 0, lane), a);
            *(f32x4*)(WC + ((nt * 4 + mt) * 64 + lane) * 4) = a;
        }
        {
            const int ct = w & 1, sp = w >> 1, t = 16 * ct + fr;
            const bf16x8 ar = ldfrag(Arb, 40, 16 * ct, 0, lane);
            f32x4 a0 = ld_bf4(Rt + t * 72 + 32 * sp + 4 * fq), a1 = ld_bf4(Rt + t * 72 + 32 * sp + 16 + 4 * fq);
            a0 = mfma16(ldfrag(AhT, 40, 32 * sp, 0, lane), ar, a0);
            a1 = mfma16(ldfrag(AhT, 40, 32 * sp + 16, 0, lane), ar, a1);
            *(u32x4*)(WQ + ((ct * 2 + sp) * 64 + lane) * 8) = (u32x4){pk2(a0.x, a0.y), pk2(a0.z, a0.w), pk2(a1.x, a1.y), pk2(a1.z, a1.w)};
        }
        {
            const int et = w;
            const bf16x8 uf = ldfrag(UhT, 40, 16 * et, 0, lane), vf = ldfrag(VT, 40, 16 * et, 0, lane);
#pragma unroll
            for (int ct = 0; ct < 2; ++ct) {
                f32x4 a = {0.f, 0.f, 0.f, 0.f};
                a = mfma16(uf, ldfrag(Arb, 40, 16 * ct, 0, lane), a);
                a = mfma16(vf, ldfrag(Ark, 40, 16 * ct, 0, lane), a);
                *(f32x4*)(WY + ((ct * 4 + et) * 64 + lane) * 4) = a;
            }
        }
    }
    __syncthreads();
}

struct RwkStep { bf16x8 pf[8]; f32x4 cf[4]; f32x4 dv[4]; };
DEVI void rwk_load(RwkStep& r, const bf16* WP, const float* WC, const float* WD, size_t it, int ew, int lane) {
#pragma unroll
    for (int i = 0; i < 8; ++i) r.pf[i] = *(const bf16x8*)(WP + it * 4096 + (i * 64 + lane) * 8);
#pragma unroll
    for (int m = 0; m < 4; ++m) r.cf[m] = *(const f32x4*)(WC + it * 4096 + ((ew * 4 + m) * 64 + lane) * 4);
#pragma unroll
    for (int m = 0; m < 4; ++m) r.dv[m] = *(const f32x4*)(WD + it * 64 + 16 * m + 4 * (lane >> 4));
}
DEVI void rwk_step(const RwkStep& r, f32x4 (&acc)[4], bf16* WSF, size_t it, int ew, int lane) {
    bf16x8 sf[2];
#pragma unroll
    for (int s = 0; s < 2; ++s) {
        const u32x4 v = {pk2(acc[2 * s].x, acc[2 * s].y), pk2(acc[2 * s].z, acc[2 * s].w), pk2(acc[2 * s + 1].x, acc[2 * s + 1].y), pk2(acc[2 * s + 1].z, acc[2 * s + 1].w)};
        *(u32x4*)(WSF + it * 4096 + ((ew * 2 + s) * 64 + lane) * 8) = v;
        sf[s] = __builtin_bit_cast(bf16x8, v);
    }
#pragma unroll
    for (int m = 0; m < 4; ++m) {
        f32x4 a = acc[m] * r.dv[m] + r.cf[m];
        a = mfma16(r.pf[m * 2], sf[0], a);
        a = mfma16(r.pf[m * 2 + 1], sf[1], a);
        acc[m] = a;
    }
}
DEVI void rwkL1_item(const P& p, int item) {
    const bf16* WP = (const bf16*)(p.ws + WS_WP); const float* WC = (const float*)(p.ws + WS_WC); const float* WD = (const float*)(p.ws + WS_WD);
    const int kind = item & 1, g = (item >> 1) & 15, h = item >> 5;
    const int lane = VTID & 63, ew = VTID >> 6, fr = lane & 15, fq = lane >> 4;
    f32x4 acc[4];
    if (kind == 0) {
        bf16* WSF = (bf16*)(p.ws + WS_WS);
#pragma unroll
        for (int m = 0; m < 4; ++m) acc[m] = (f32x4){0.f, 0.f, 0.f, 0.f};
        RwkStep A, B;
        const int n0 = g * 32;
        rwk_load(A, WP, WC, WD, (size_t)n0 * 4 + h, ew, lane);
#pragma unroll 1
        for (int n = n0; n < n0 + 32; n += 2) {
            rwk_load(B, WP, WC, WD, (size_t)(n + 1) * 4 + h, ew, lane);
            asm volatile("" ::: "memory");
            rwk_step(A, acc, WSF, (size_t)n * 4 + h, ew, lane);
            rwk_load(A, WP, WC, WD, (size_t)((n + 2 < n0 + 32) ? n + 2 : n) * 4 + h, ew, lane);
            asm volatile("" ::: "memory");
            rwk_step(B, acc, WSF, (size_t)(n + 1) * 4 + h, ew, lane);
        }
        float* E0 = (float*)(p.ws + WS_WE0) + (size_t)(h * 16 + g) * 4096 + (ew * 4 * 64 + lane) * 4;
#pragma unroll
        for (int m = 0; m < 4; ++m) *(f32x4*)(E0 + m * 256) = acc[m];
    } else {
        const bf16* WQ = (const bf16*)(p.ws + WS_WQ); bf16* WR = (bf16*)(p.ws + WS_WR);
#pragma unroll
        for (int m = 0; m < 4; ++m)
#pragma unroll
            for (int j = 0; j < 4; ++j) acc[m][j] = (m == ew && 4 * fq + j == fr) ? 1.f : 0.f;
#pragma unroll 1
        for (int n = g * 32; n < g * 32 + 32; ++n) {
            const size_t it = (size_t)n * 4 + h;
            bf16x8 pf[8], qf[4]; f32x4 dv[4];
#pragma unroll
            for (int i = 0; i < 8; ++i) pf[i] = *(const bf16x8*)(WP + it * 4096 + (i * 64 + lane) * 8);
#pragma unroll
            for (int i = 0; i < 4; ++i) qf[i] = *(const bf16x8*)(WQ + it * 2048 + (i * 64 + lane) * 8);
#pragma unroll
            for (int m = 0; m < 4; ++m) dv[m] = *(const f32x4*)(WD + it * 64 + 16 * m + 4 * fq);
            asm volatile("" ::: "memory");
            bf16x8 tf[2];
#pragma unroll
            for (int s = 0; s < 2; ++s) tf[s] = pack_frag(acc[2 * s], acc[2 * s + 1]);
#pragma unroll
            for (int tt = 0; tt < 2; ++tt) {
                f32x4 r = {0.f, 0.f, 0.f, 0.f};
                r = mfma16(tf[0], qf[tt * 2], r); r = mfma16(tf[1], qf[tt * 2 + 1], r);
                *(u32x2*)(WR + it * 2048 + ((tt * 2 + (ew >> 1)) * 64 + lane) * 8 + 4 * (ew & 1)) = (u32x2){pk2(r.x, r.y), pk2(r.z, r.w)};
            }
#pragma unroll
            for (int m = 0; m < 4; ++m) {
                f32x4 a = acc[m] * dv[m];
                a = mfma16(pf[m * 2], tf[0], a); a = mfma16(pf[m * 2 + 1], tf[1], a);
                acc[m] = a;
            }
        }
        bf16* TE = (bf16*)(p.ws + WS_WTE) + (size_t)(h * 16 + g) * 4096;
        const int s_ = ew >> 1, jj = 4 * (ew & 1) + (fr & 3), lg = fr >> 2;
#pragma unroll
        for (int m = 0; m < 4; ++m)
#pragma unroll
            for (int j = 0; j < 4; ++j) TE[((m * 2 + s_) * 64 + (4 * fq + j) + 16 * lg) * 8 + jj] = (bf16)f2bf(acc[m][j]);
    }
}
DEVI void rwkL2_item(const P& p, int h) {
    const bf16* TE = (const bf16*)(p.ws + WS_WTE); const float* E0 = (const float*)(p.ws + WS_WE0); bf16* SG = (bf16*)(p.ws + WS_WSG);
    const int lane = VTID & 63, ew = VTID >> 6;
    f32x4 acc[4];
#pragma unroll
    for (int m = 0; m < 4; ++m) acc[m] = (f32x4){0.f, 0.f, 0.f, 0.f};
#pragma unroll 1
    for (int g = 0; g < 16; ++g) {
        const size_t hg = (size_t)h * 16 + g;
        bf16x8 pf[8]; f32x4 bfr[4];
#pragma unroll
        for (int i = 0; i < 8; ++i) pf[i] = *(const bf16x8*)(TE + hg * 4096 + (i * 64 + lane) * 8);
#pragma unroll
        for (int m = 0; m < 4; ++m) bfr[m] = *(const f32x4*)(E0 + hg * 4096 + ((ew * 4 + m) * 64 + lane) * 4);
        asm volatile("" ::: "memory");
        bf16x8 sf[2];
#pragma unroll
        for (int s = 0; s < 2; ++s) {
            sf[s] = pack_frag(acc[2 * s], acc[2 * s + 1]);
            *(bf16x8*)(SG + hg * 4096 + ((ew * 2 + s) * 64 + lane) * 8) = sf[s];
        }
#pragma unroll
        for (int m = 0; m < 4; ++m) {
            f32x4 a = bfr[m];
            a = mfma16(pf[m * 2], sf[0], a); a = mfma16(pf[m * 2 + 1], sf[1], a);
            acc[m] = a;
        }
    }
}

DEVI void rwkC_item(const P& p, int n, int l) {
    const int lane = VTID & 63, h = VTID >> 6, fr = lane & 15, fq = lane >> 4;
    const size_t it = (size_t)n * 4 + h;
    const bf16* WQ = (const bf16*)(p.ws + WS_WQ) + it * 2048; const float* WY = (const float*)(p.ws + WS_WY) + it * 2048;
    const bf16* WSF = (const bf16*)(p.ws + WS_WS) + it * 4096;
    const bf16* WR = (const bf16*)(p.ws + WS_WR) + it * 2048; const bf16* WSG = (const bf16*)(p.ws + WS_WSG) + (size_t)(h * 16 + (n >> 5)) * 4096;
    const bf16* RECR = (const bf16*)(p.ws + WS_RECR); const float* GB = (const float*)(p.ws + WS_G); const float* BON = (const float*)(p.ws + WS_BON);
    bf16* MIX = (bf16*)(p.ws + WS_MIX);
    const float* ln_g = p.in[17] + l * 256 + h * 64; const float* ln_b = p.in[18] + l * 256 + h * 64;
#pragma unroll
    for (int ct = 0; ct < 2; ++ct) {
        const bf16x8 q0 = *(const bf16x8*)(WQ + ((ct * 2 + 0) * 64 + lane) * 8), q1 = *(const bf16x8*)(WQ + ((ct * 2 + 1) * 64 + lane) * 8);
        const bf16x8 r0 = *(const bf16x8*)(WR + ((ct * 2 + 0) * 64 + lane) * 8), r1 = *(const bf16x8*)(WR + ((ct * 2 + 1) * 64 + lane) * 8);
        const int t = n * 32 + 16 * ct + fr;
        f32x4 a[4];
        float sm = 0.f;
        f32x4 y0[4]; bf16x8 sfr[4][2], sgr[4][2];
#pragma unroll
        for (int et = 0; et < 4; ++et) {
            y0[et] = *(const f32x4*)(WY + ((ct * 4 + et) * 64 + lane) * 4);
#pragma unroll
            for (int s = 0; s < 2; ++s) { sfr[et][s] = *(const bf16x8*)(WSF + ((et * 2 + s) * 64 + lane) * 8); sgr[et][s] = *(const bf16x8*)(WSG + ((et * 2 + s) * 64 + lane) * 8); }
        }
        asm volatile("" ::: "memory");
#pragma unroll
        for (int et = 0; et < 4; ++et) {
            f32x4 acc = y0[et];
            acc = mfma16(sfr[et][0], q0, acc);
            acc = mfma16(sfr[et][1], q1, acc);
            acc = mfma16(sgr[et][0], r0, acc);
            acc = mfma16(sgr[et][1], r1, acc);
            a[et] = acc; sm += (acc.x + acc.y) + (acc.z + acc.w);
        }
        const float mean = quad_sum(sm) * (1.f / 64.f);
        float sv = 0.f;
#pragma unroll
        for (int et = 0; et < 4; ++et) { a[et] = a[et] - mean; sv += a[et].x * a[et].x + a[et].y * a[et].y + a[et].z * a[et].z + a[et].w * a[et].w; }
        const float rs = rsqrtf(quad_sum(sv) * (1.f / 64.f) + 64e-5f);
        const float bon = BON[(size_t)t * 4 + h];
        f32x4 gq[4], bq[4], vq[4], gateq[4];
#pragma unroll
        for (int et = 0; et < 4; ++et) {
            const int e = 16 * et + 4 * fq;
            gq[et] = *(const f32x4*)(ln_g + e); bq[et] = *(const f32x4*)(ln_b + e);
            vq[et] = ld_bf4(RECR + ((size_t)t * 4 + h) * 384 + 320 + e);
            gateq[et] = *(const f32x4*)(GB + (size_t)t * 256 + h * 64 + e);
        }
        asm volatile("" ::: "memory");
#pragma unroll
        for (int et = 0; et < 4; ++et) {
            const int e = 16 * et + 4 * fq;
            const f32x4 g = gq[et], b = bq[et];
            const f32x4 v = vq[et];
            const f32x4 gate = gateq[et];
            const f32x4 o = (a[et] * rs * g + b + v * bon) * gate;
            *(u32x2*)(MIX + (size_t)t * D + h * 64 + e) = (u32x2){pk2(o.x, o.y), pk2(o.z, o.w)};
        }
    }
}

DEVI void phase_scanL1(const P& p, char* smem) {
    for (int item = VBID; item < 448; item += VNB) {
        if (item < 256) gdnL1_item(p, item, smem);
        else if (item < 384) rwkL1_item(p, item - 256);
        else retS_item(p, item - 384);
    }
}
DEVI void retC_item(const P& p, int item, int l, char* smem);
DEVI void phase_scanL2(const P& p, int l, char* smem) {
    if (VBID < 12) { if (VBID < 8) gdnL2_item(p, VBID, smem); else rwkL2_item(p, VBID - 8); }
    else { for (int item = VBID - 12; item < 1024; item += VNB - 12) retC_item(p, item, l, smem); }
}
DEVI void phase_chunkA(const P& p, char* smem) {
    for (int item = VBID; item < 4096; item += VNB) { if (item < 1024) gdnA_item(p, item, smem); else if (item < 3072) rwkA_item(p, item - 1024, smem); else retA_item(p, item - 3072, smem); }
}
DEVI void phase_chunkC(const P& p, int l, char* smem) {
    for (int item = VBID; item < 1536; item += VNB) { if (item < 1024) gdnC_item(p, item, l); else rwkC_item(p, item - 1024, l); }
}

DEVI void phase_ln1_route(const P& p, int l, char* smem, bool commit = true) {
    const float* ADA = (const float*)(p.ws + OFF_ADA) + l * 6144;
    const float* xin = (l == 0) ? p.in[0] : (const float*)(p.ws + WS_X);
    const float* OPRE = (const float*)(p.ws + WS_OPRE);
    float* X = (float*)(p.ws + WS_X); bf16* H2 = (bf16*)(p.ws + WS_H2);
    const float* lg = p.in[28] + l * D; const float* lb = p.in[29] + l * D;
    const float* rw = p.in[30] + (size_t)l * D * 32; const float* rbias = p.in[31] + l * 32;
    int* CNT = (int*)(p.ws + OFF_CNT) + l * 32 * 64; int* LIST = (int*)(p.ws + WS_LIST); float* GATE = (float*)(p.ws + WS_GATE);
    float* HS = (float*)smem;
    float* RED = HS + 4 * 1024;
    int* SEL = (int*)(RED + 1024);
    int* RNK = SEL + 256;
    int* BASE = RNK + 256;
    int nasg = 0;
    const int tid = VTID, lane = tid & 63, w = tid >> 6;
    for (int item = VBID; item < S / 4; item += VNB) {
        const int t = item * 4 + w;
        {
            f32x4 v[4]; float s = 0.f;
#pragma unroll
            for (int j = 0; j < 4; ++j) {
                const int c = j * 256 + lane * 4;
                const f32x4 x = *(const f32x4*)(xin + (size_t)t * D + c);
                const f32x4 o = *(const f32x4*)(OPRE + (size_t)t * D + c);
                const f32x4 gt = *(const f32x4*)(ADA + 2048 + c);
                v[j].x = DN_ALPHA * x.x + (1.f + gt.x) * o.x; v[j].y = DN_ALPHA * x.y + (1.f + gt.y) * o.y;
                v[j].z = DN_ALPHA * x.z + (1.f + gt.z) * o.z; v[j].w = DN_ALPHA * x.w + (1.f + gt.w) * o.w;
                s += (v[j].x + v[j].y) + (v[j].z + v[j].w);
            }
            const float mean = wave_sum(s) * (1.f / D);
            float s2 = 0.f;
#pragma unroll
            for (int j = 0; j < 4; ++j) { v[j] = v[j] - mean; s2 += (v[j].x * v[j].x + v[j].y * v[j].y) + (v[j].z * v[j].z + v[j].w * v[j].w); }
            const float rstd = rsqrtf(wave_sum(s2) * (1.f / D) + 1e-5f);
#pragma unroll
            for (int j = 0; j < 4; ++j) {
                const int c = j * 256 + lane * 4;
                const f32x4 g = *(const f32x4*)(lg + c), b = *(const f32x4*)(lb + c);
                f32x4 xo = v[j] * rstd * g + b;
                *(f32x4*)(X + (size_t)t * D + c) = xo;
                const f32x4 sh = *(const f32x4*)(ADA + 3072 + c), sc = *(const f32x4*)(ADA + 4096 + c);
                f32x4 hh = xo * (1.f + sc) + sh;
                *(f32x4*)(HS + w * 1024 + c) = hh;
                u32x2 o; o.x = pk2(hh.x, hh.y); o.y = pk2(hh.z, hh.w);
                *(u32x2*)(H2 + (size_t)t * D + c) = o;
            }
        }
        __syncthreads();
        {
            const int e = tid & 31, ks = tid >> 5;
            float a0 = 0.f, a1 = 0.f, a2 = 0.f, a3 = 0.f;
#pragma unroll 4
            for (int k = ks * 128; k < ks * 128 + 128; k += 4) {
                const float w0 = rw[(k + 0) * 32 + e], w1 = rw[(k + 1) * 32 + e], w2 = rw[(k + 2) * 32 + e], w3 = rw[(k + 3) * 32 + e];
                const f32x4 h0 = *(const f32x4*)(HS + 0 * 1024 + k), h1 = *(const f32x4*)(HS + 1 * 1024 + k);
                const f32x4 h2 = *(const f32x4*)(HS + 2 * 1024 + k), h3 = *(const f32x4*)(HS + 3 * 1024 + k);
                a0 += h0.x * w0 + h0.y * w1 + h0.z * w2 + h0.w * w3;
                a1 += h1.x * w0 + h1.y * w1 + h1.z * w2 + h1.w * w3;
                a2 += h2.x * w0 + h2.y * w1 + h2.z * w2 + h2.w * w3;
                a3 += h3.x * w0 + h3.y * w1 + h3.z * w2 + h3.w * w3;
            }
            RED[(ks * 4 + 0) * 32 + e] = a0; RED[(ks * 4 + 1) * 32 + e] = a1; RED[(ks * 4 + 2) * 32 + e] = a2; RED[(ks * 4 + 3) * 32 + e] = a3;
        }
        __syncthreads();
        if (tid < 128) {
            const int tok = tid >> 5, e = tid & 31, tt = item * 4 + tok;
            float logit = rbias[e];
#pragma unroll
            for (int ks = 0; ks < 8; ++ks) logit += RED[(ks * 4 + tok) * 32 + e];
            bool taken = false;
            float sv[4]; int si[4];
#pragma unroll
            for (int j = 0; j < 4; ++j) {
                float cand = taken ? -3.0e38f : logit; int ci = e;
#pragma unroll
                for (int off = 16; off >= 1; off >>= 1) {
                    const float ov = __shfl_xor(cand, off, 32); const int oi = __shfl_xor(ci, off, 32);
                    if (ov > cand || (ov == cand && oi < ci)) { cand = ov; ci = oi; }
                }
                sv[j] = cand; si[j] = ci; if (ci == e) taken = true;
            }
            const float e0 = 1.f, e1 = __expf(sv[1] - sv[0]), e2 = __expf(sv[2] - sv[0]), e3 = __expf(sv[3] - sv[0]);
            const float inv = 1.f / (e0 + e1 + e2 + e3);
            const float gts[4] = {e0 * inv, e1 * inv, e2 * inv, e3 * inv};
#pragma unroll
            for (int j = 0; j < 4; ++j) {
                if (si[j] == e) {
                    SEL[nasg + tok * 4 + j] = ((tt * 4 + j) << 5) | e;
                    GATE[(size_t)tt * 4 + j] = gts[j];
                }
            }
        }
        nasg += 16;
        __syncthreads();
    }
    if (!commit) return;
    if (tid < 32) {
        int c = 0;
        for (int a = 0; a < nasg; ++a) { if ((SEL[a] & 31) == tid) { RNK[a] = c; ++c; } }
        BASE[tid] = c ? atomicAdd(&CNT[tid * 64], c) : 0;
    }
    __syncthreads();
    for (int a = tid; a < nasg; a += NT) { const int v = SEL[a], e = v & 31; LIST[(size_t)e * S + BASE[e] + RNK[a]] = v >> 5; }
    __syncthreads();
}

DEVI void phase_ln2(const P& p, int l) {
    const float* ADA = (const float*)(p.ws + OFF_ADA) + l * 6144;
    const float* ADAn = (const float*)(p.ws + OFF_ADA) + 6144;
    float* X = (float*)(p.ws + WS_X); const bf16* YB = (const bf16*)(p.ws + WS_YB);
    bf16* HB = (bf16*)(p.ws + WS_HB);
    const float* lg = p.in[36] + l * D; const float* lb = p.in[37] + l * D;
    const int tid = VTID, lane = tid & 63, w = tid >> 6;
    for (int item = VBID; item < S / 4; item += VNB) {
        const int t = item * 4 + w;
        f32x4 v[4]; float s = 0.f;
#pragma unroll
        for (int j = 0; j < 4; ++j) {
            const int c = j * 256 + lane * 4;
            const f32x4 x = *(const f32x4*)(X + (size_t)t * D + c);
            f32x4 f = {0.f, 0.f, 0.f, 0.f};
#pragma unroll
            for (int q = 0; q < 4; ++q) {
                const u32x2 y = *(const u32x2*)(YB + ((size_t)t * 4 + q) * D + c);
                f.x += __uint_as_float(y.x << 16); f.y += __uint_as_float(y.x & 0xffff0000u);
                f.z += __uint_as_float(y.y << 16); f.w += __uint_as_float(y.y & 0xffff0000u);
            }
            const f32x4 gt = *(const f32x4*)(ADA + 5120 + c);
            v[j] = x * DN_ALPHA + (gt + 1.f) * f;
            s += (v[j].x + v[j].y) + (v[j].z + v[j].w);
        }
        const float mean = wave_sum(s) * (1.f / D);
        float s2 = 0.f;
#pragma unroll
        for (int j = 0; j < 4; ++j) { v[j] = v[j] - mean; s2 += (v[j].x * v[j].x + v[j].y * v[j].y) + (v[j].z * v[j].z + v[j].w * v[j].w); }
        const float rstd = rsqrtf(wave_sum(s2) * (1.f / D) + 1e-5f);
#pragma unroll
        for (int j = 0; j < 4; ++j) {
            const int c = j * 256 + lane * 4;
            const f32x4 g = *(const f32x4*)(lg + c), b = *(const f32x4*)(lb + c);
            const f32x4 xo = v[j] * rstd * g + b;
            if (l == 0) {
                *(f32x4*)(X + (size_t)t * D + c) = xo;
                const f32x4 sh = *(const f32x4*)(ADAn + c), sc = *(const f32x4*)(ADAn + 1024 + c);
                const f32x4 hh = xo * (sc + 1.f) + sh;
                u32x2 o; o.x = pk2(hh.x, hh.y); o.y = pk2(hh.z, hh.w);
                *(u32x2*)(HB + (size_t)t * D + c) = o;
            } else {
                *(f32x4*)(p.out + (size_t)t * D + c) = xo;
            }
        }
    }
}

namespace pg8 {
constexpr int BK = 64, HALF = 128, HTB = HALF * BK * 2, STAGE_BYTES = 8 * HTB;
DEVI int lds_byte(int r, int c) { const int st = (r >> 4) * 2 + (c >> 5), rr = r & 15, cc = c & 31, ob = rr * 64 + cc * 2; return st * 1024 + (ob ^ (((ob >> 9) & 1) << 5)); }
DEVI void stage_rc(int b, int& R, int& C) { const int st = b / 1024, sb = b % 1024, swz = sb ^ (((sb >> 9) & 1) << 5); R = (st >> 1) * 16 + swz / 64; C = (st & 1) * 32 + (swz % 64) / 2; }
struct Unit { const char* a; const char* b; int x0, x1, x2, x3; };

template <class Epi, class Sched>
DEVI void gemm_phase(LAS unsigned char* lds, const int K, const Sched& S, const Epi& E) {
    const int tid = threadIdx.x, wid = __builtin_amdgcn_readfirstlane(tid >> 6), lane = tid & 63, wr = wid >> 2, wc = wid & 3, fr = lane & 15, fq = lane >> 4;
    const int nt = K / BK;
    unsigned voffA[2], voffB[2];
    int gR[2], gC[2];
#pragma unroll
    for (int i = 0; i < 2; ++i) { int R, C; stage_rc(tid * 16 + i * 8192, R, C); gR[i] = R; gC[i] = C; voffA[i] = (unsigned)(R * K + C) * 2u; voffB[i] = (unsigned)(Epi::brow(R) * K + C) * 2u; }
    unsigned co[2][2], no[2][2];
#define PG8_GOFF(dst, tab) do { _Pragma("unroll") for (int _h = 0; _h < 2; ++_h) _Pragma("unroll") for (int _i = 0; _i < 2; ++_i) \
        dst[_h][_i] = (unsigned)((tab)[_h * 128 + gR[_i]] * K + gC[_i]) * 2u; } while (0)
    const size_t kstep = (size_t)(BK * 2);
    const size_t hstepA = (size_t)HALF * K * 2, hstepB = (size_t)Epi::BHALF * K * 2;
    const unsigned ldsw = (unsigned)wid * 1024u;
    const int aoff = lds_byte(wr * 64 + fr, fq * 8), boff = lds_byte(wc * 32 + fr, fq * 8);
#define PG8_SA(b, h) (((b) * 2 + (h)) * HTB)
#define PG8_SB(b, h) ((4 + (b) * 2 + (h)) * HTB)
#define PG8_STAGE(bufoff, gbase, voff) do { _Pragma("unroll") for (int _i = 0; _i < 2; ++_i) \
        __builtin_amdgcn_global_load_lds((const unsigned*)((const char*)(gbase) + (voff)[_i]), (LAS unsigned*)(lds + (bufoff) + ldsw + _i * 8192), 16, 0, 0); } while (0)
#define PG8_LDA(dst, b, h) do { _Pragma("unroll") for (int m = 0; m < 4; ++m) _Pragma("unroll") for (int k = 0; k < 2; ++k) dst[m][k] = *(const LAS bf16x8*)(lds + PG8_SA(b, h) + aoff + m * 2048 + k * 1024); } while (0)
#define PG8_LDB(dst, b, h) do { _Pragma("unroll") for (int n = 0; n < 2; ++n) _Pragma("unroll") for (int k = 0; k < 2; ++k) dst[n][k] = *(const LAS bf16x8*)(lds + PG8_SB(b, h) + boff + n * 2048 + k * 1024); } while (0)
#define PG8_MMA(ai, bj, At, Bt) do { __builtin_amdgcn_s_setprio(1); _Pragma("unroll") for (int m = 0; m < 4; ++m) _Pragma("unroll") for (int n = 0; n < 2; ++n) _Pragma("unroll") for (int k = 0; k < 2; ++k) \
        acc[ai][bj][m][n] = __builtin_amdgcn_mfma_f32_16x16x32_bf16(Bt[n][k], At[m][k], acc[ai][bj][m][n], 0, 0, 0); __builtin_amdgcn_s_setprio(0); } while (0)
#define PG8_WAIT_V(n) asm volatile("s_waitcnt vmcnt(" #n ")" ::: "memory")
#define PG8_WAIT_L(n) asm volatile("s_waitcnt lgkmcnt(" #n ")" ::: "memory")
#define PG8_BAR __builtin_amdgcn_s_barrier()
#define PG8_SCHED __builtin_amdgcn_sched_barrier(0)
    Unit cur, nxt; int ui = 0;
    if (!S.next(0, cur)) return;
    f32x4 acc[2][2][4][2];
#pragma unroll
    for (int a = 0; a < 2; ++a)
#pragma unroll
        for (int b = 0; b < 2; ++b)
#pragma unroll
            for (int m = 0; m < 4; ++m)
#pragma unroll
                for (int n = 0; n < 2; ++n) acc[a][b][m][n] = (f32x4){0.f, 0.f, 0.f, 0.f};
    bf16x8 At[4][2], B0[2][2], B1[2][2];
    const char* cA = cur.a; const char* cB = cur.b;
    if constexpr (Epi::GATHER_A) { PG8_GOFF(co, S.rows(0)); PG8_WAIT_L(0); }
    else {
#pragma unroll
        for (int i = 0; i < 2; ++i) { co[0][i] = voffA[i]; co[1][i] = voffA[i] + (unsigned)hstepA; no[0][i] = co[0][i]; no[1][i] = co[1][i]; }
    }
    PG8_WAIT_V(0);
    PG8_STAGE(PG8_SB(0, 0), cB, voffB); PG8_STAGE(PG8_SA(0, 0), cA, co[0]); PG8_STAGE(PG8_SB(0, 1), cB + hstepB, voffB); PG8_STAGE(PG8_SA(0, 1), cA, co[1]);
    if (wr == 1) PG8_BAR;
    PG8_WAIT_V(4); PG8_BAR;
    PG8_STAGE(PG8_SB(1, 0), cB + kstep, voffB); PG8_STAGE(PG8_SA(1, 0), cA + kstep, co[0]); PG8_STAGE(PG8_SB(1, 1), cB + hstepB + kstep, voffB);
    PG8_WAIT_V(6); PG8_BAR;
    for (;;) {
        const bool has_next = S.next(ui + 1, nxt);
        const char* nA = has_next ? nxt.a : cA; const char* nB = has_next ? nxt.b : cB;
        if constexpr (Epi::GATHER_A) { if (has_next) PG8_GOFF(no, S.rows(ui + 1)); else { no[0][0] = co[0][0]; no[0][1] = co[0][1]; no[1][0] = co[1][0]; no[1][1] = co[1][1]; } }
        for (int t = 0; t < nt; t += 2) {
            const bool last = (t == nt - 2);
            const char* a1 = cA + (size_t)(t + 1) * kstep;
            const char* a2 = last ? nA : cA + (size_t)(t + 2) * kstep; const char* b2 = last ? nB : cB + (size_t)(t + 2) * kstep;
            const char* a3 = a2 + kstep; const char* b3 = b2 + kstep;
            unsigned fo[2][2];
#pragma unroll
            for (int h = 0; h < 2; ++h)
#pragma unroll
                for (int i = 0; i < 2; ++i) fo[h][i] = last ? no[h][i] : co[h][i];
            PG8_LDB(B0, 0, 0); PG8_SCHED; PG8_LDA(At, 0, 0); PG8_STAGE(PG8_SA(1, 1), a1, co[1]);
            PG8_WAIT_L(8); PG8_BAR; PG8_WAIT_L(0); PG8_MMA(0, 0, At, B0); PG8_BAR; PG8_SCHED;
            PG8_LDB(B1, 0, 1); PG8_STAGE(PG8_SB(0, 0), b2, voffB);
            PG8_BAR; PG8_WAIT_L(0); PG8_MMA(0, 1, At, B1); PG8_BAR;
            PG8_LDA(At, 0, 1); PG8_STAGE(PG8_SA(0, 0), a2, fo[0]);
            PG8_BAR; PG8_WAIT_L(0); PG8_MMA(1, 0, At, B0); PG8_BAR; PG8_SCHED;
            PG8_STAGE(PG8_SB(0, 1), b2 + hstepB, voffB);
            PG8_WAIT_V(6); PG8_BAR; PG8_MMA(1, 1, At, B1); PG8_BAR;
            PG8_LDB(B0, 1, 0); PG8_SCHED; PG8_LDA(At, 1, 0); PG8_STAGE(PG8_SA(0, 1), a2, fo[1]);
            PG8_WAIT_L(8); PG8_BAR; PG8_WAIT_L(0); PG8_MMA(0, 0, At, B0); PG8_BAR; PG8_SCHED;
            PG8_LDB(B1, 1, 1); PG8_STAGE(PG8_SB(1, 0), b3, voffB);
            PG8_BAR; PG8_WAIT_L(0); PG8_MMA(0, 1, At, B1); PG8_BAR;
            PG8_LDA(At, 1, 1); PG8_STAGE(PG8_SA(1, 0), a3, fo[0]);
            PG8_BAR; PG8_WAIT_L(0); PG8_MMA(1, 0, At, B0); PG8_BAR; PG8_SCHED;
            PG8_STAGE(PG8_SB(1, 1), b3 + hstepB, voffB);
            PG8_WAIT_V(6); PG8_BAR; PG8_MMA(1, 1, At, B1); PG8_BAR;
        }
        E(acc, cur, wr, wc, fr, fq);
        if (!has_next) break;
#pragma unroll
        for (int a = 0; a < 2; ++a)
#pragma unroll
            for (int b = 0; b < 2; ++b)
#pragma unroll
                for (int m = 0; m < 4; ++m)
#pragma unroll
                    for (int n = 0; n < 2; ++n) acc[a][b][m][n] = (f32x4){0.f, 0.f, 0.f, 0.f};
        cur = nxt; cA = nA; cB = nB; ++ui;
#pragma unroll
        for (int h = 0; h < 2; ++h) { co[h][0] = no[h][0]; co[h][1] = no[h][1]; }
    }
    PG8_WAIT_V(0);
    if (wr == 0) PG8_BAR;
    PG8_BAR;
#undef PG8_SA
#undef PG8_GOFF
#undef PG8_SB
#undef PG8_STAGE
#undef PG8_LDA
#undef PG8_LDB
#undef PG8_MMA
#undef PG8_WAIT_V
#undef PG8_WAIT_L
#undef PG8_BAR
#undef PG8_SCHED
}
}

struct SchedDense {
    const char* A; const char* B; int K; int mode;
    DEVI const int* rows(int) const { return nullptr; }
    DEVI bool next(int i, pg8::Unit& u) const {
        const int c = blockIdx.x, x = c & 7; int pm, pn;
        if (mode == 0) { if (i > 0) return false; pn = x & 3; pm = (c >> 3) * 2 + (x >> 2); }
        else { if (i > 3) return false; pn = x + 8 * (i & 1); pm = (c >> 3) + 32 * (i >> 1); }
        u.a = A + (size_t)pm * 256 * K * 2; u.b = B + (size_t)pn * 256 * K * 2; u.x0 = pm; u.x1 = pn; u.x2 = 0; u.x3 = 0;
        return true;
    }
};
struct EpiOutF32 {
    static constexpr bool GATHER_A = false; static constexpr int BHALF = 128; static DEVI int brow(int R) { return R; }
    float* C;
    DEVI void operator()(const f32x4 (&acc)[2][2][4][2], const pg8::Unit& u, int wr, int wc, int fr, int fq) const {
#pragma unroll
        for (int ai = 0; ai < 2; ++ai)
#pragma unroll
            for (int m = 0; m < 4; ++m) {
                float* rowp = C + (size_t)(u.x0 * 256 + ai * 128 + wr * 64 + m * 16 + fr) * D + u.x1 * 256 + wc * 32 + 4 * fq;
#pragma unroll
                for (int bj = 0; bj < 2; ++bj)
#pragma unroll
                    for (int n = 0; n < 2; ++n) *(f32x4*)(rowp + bj * 128 + n * 16) = acc[ai][bj][m][n];
            }
    }
};
struct EpiProjBf16 {
    static constexpr bool GATHER_A = false; static constexpr int BHALF = 128; static DEVI int brow(int R) { return R; }
    bf16* C;
    DEVI void operator()(const f32x4 (&acc)[2][2][4][2], const pg8::Unit& u, int wr, int wc, int fr, int fq) const {
#pragma unroll
        for (int ai = 0; ai < 2; ++ai)
#pragma unroll
            for (int m = 0; m < 4; ++m) {
                bf16* rowp = C + (size_t)(u.x0 * 256 + ai * 128 + wr * 64 + m * 16 + fr) * NPROJ + u.x1 * 256 + wc * 32 + 4 * fq;
#pragma unroll
                for (int bj = 0; bj < 2; ++bj)
#pragma unroll
                    for (int n = 0; n < 2; ++n) { const f32x4 v = acc[ai][bj][m][n]; *(u32x2*)(rowp + bj * 128 + n * 16) = (u32x2){pk2(v.x, v.y), pk2(v.z, v.w)}; }
            }
    }
};
DEVI void phase_outproj8(const P& p, int l, char* smem_all) {
    SchedDense Sd{(const char*)(p.ws + WS_MIX), (const char*)(p.ws + WS_WOUT) + (size_t)l * D * D * 2, D, 0};
    EpiOutF32 E{(float*)(p.ws + WS_OPRE)};
    pg8::gemm_phase(( LAS unsigned char*)smem_all, D, Sd, E);
}
DEVI void phase_inproj8(const P& p, int l, char* smem_all) {
    SchedDense Sd{(const char*)(p.ws + WS_HB), (const char*)(p.ws + WS_WIN) + (size_t)l * NPAD * D * 2, D, 1};
    EpiProjBf16 E{(bf16*)(p.ws + WS_PROJ)};
    pg8::gemm_phase((LAS unsigned char*)smem_all, D, Sd, E);
}
DEVI void phase_inproj_extras(const P& p, int l, char* smem) {
    const bf16* HB = (const bf16*)(p.ws + WS_HB);
    const bf16* W = (const bf16*)(p.ws + WS_WIN) + (size_t)l * NPAD * D;
    float* PEX = (float*)(p.ws + WS_PEX);
    const int lane = VTID & 63, wid = VTID >> 6, wr = wid >> 1, wc = wid & 1, fr = lane & 15, fq = lane >> 4;
    for (int mt = VBID; mt < S / 128; mt += VNB) {
        f32x4 acc[4][8];
        gemm_tile(smem, HB, [&](int r) { return (unsigned)((mt * 128 + r) * D); }, W, [&](int r) { return (unsigned)((16 * 256 + r) * D); }, D, acc);
        if (wc == 0) {
#pragma unroll
            for (int m = 0; m < 4; ++m) {
                const int tok = mt * 128 + wr * 64 + m * 16 + fr;
#pragma unroll
                for (int n = 0; n < 4; ++n) *(f32x4*)(PEX + (size_t)tok * 64 + n * 16 + fq * 4) = acc[m][n];
            }
        }
    }
}

struct MoeMap8 { int cnt[32]; int off[32]; int tstart[33]; };
DEVI void moe_map8(const P& p, int l, MoeMap8* mm) {
    const int* CNT = (const int*)(p.ws + OFF_CNT) + l * 32 * 64;
    if (threadIdx.x < 32) mm->cnt[threadIdx.x] = __hip_atomic_load(&CNT[threadIdx.x * 64], __ATOMIC_RELAXED, __HIP_MEMORY_SCOPE_AGENT);
    __syncthreads();
    if (threadIdx.x == 0) {
        int o = 0, ts = 0;
        for (int e = 0; e < 32; ++e) { mm->off[e] = o; mm->tstart[e] = ts; o += mm->cnt[e]; ts += (mm->cnt[e] + 255) / 256; }
        mm->tstart[32] = ts;
    }
    __syncthreads();
}
DEVI void phase_moe_gather(const P& p, int l, char* smem_all) {
    MoeMap8* mm = (MoeMap8*)(smem_all + 131072);
    moe_map8(p, l, mm);
    const bf16* H2 = (const bf16*)(p.ws + WS_H2); bf16* HG = (bf16*)(p.ws + WS_HG);
    const int* LIST = (const int*)(p.ws + WS_LIST);
    const int wave = (int)(blockIdx.x * 8 + (threadIdx.x >> 6)), lane = threadIdx.x & 63;
    int mytok = 0;
    {
        const int pr = wave * 32 + (lane & 31);
        int e = 0;
        while (e < 31 && mm->off[e + 1] <= pr) ++e;
        mytok = LIST[(size_t)e * S + (pr - mm->off[e])] >> 2;
    }
#pragma unroll 1
    for (int r0 = 0; r0 < 32; r0 += 8) {
        u32x4 v[8][2];
#pragma unroll
        for (int i = 0; i < 8; ++i) {
            const int tok = __shfl(mytok, r0 + i);
            const u32x4* s = (const u32x4*)(H2 + (size_t)tok * D);
            v[i][0] = s[lane]; v[i][1] = s[lane + 64];
        }
#pragma unroll
        for (int i = 0; i < 8; ++i) { u32x4* d = (u32x4*)(HG + (size_t)(wave * 32 + r0 + i) * D); d[lane] = v[i][0]; d[lane + 64] = v[i][1]; }
    }
}
struct MoeUnits { int n; int pad[3]; int e[32]; int m0[32]; int pn[32]; };
struct SchedMoe {
    const MoeMap8* mm; const MoeUnits* mu; const char* A; const char* Bw; int K;
    size_t bexp, bpn;
    const int* rowtab; bool gather;
    DEVI const int* rows(int i) const { return rowtab + 256 * i; }
    DEVI bool next(int i, pg8::Unit& u) const {
        if (i >= mu->n) return false;
        const int e = mu->e[i], m0 = mu->m0[i], pn = mu->pn[i], off = mm->off[e];
        u.a = gather ? A : A + (size_t)(off + m0) * K * 2; u.b = Bw + (size_t)e * bexp + (size_t)pn * bpn;
        u.x0 = e; u.x1 = m0; u.x2 = pn; u.x3 = off;
        return true;
    }
};
DEVI void moe_units(const MoeMap8* mm, MoeUnits* mu, int npn_log) {
    if (threadIdx.x < 32) {
        const int L = (int)threadIdx.x * 256 + (int)blockIdx.x, total = mm->tstart[32] << npn_log;
        if (L < total) {
            const int pn = L & ((1 << npn_log) - 1), rt = L >> npn_log;
            int e = 0;
            while (mm->tstart[e + 1] <= rt) ++e;
            mu->e[threadIdx.x] = e; mu->m0[threadIdx.x] = (rt - mm->tstart[e]) * 256; mu->pn[threadIdx.x] = pn;
        }
        if (threadIdx.x == 0) { const int mine = total > (int)blockIdx.x ? (total - (int)blockIdx.x + 255) >> 8 : 0; mu->n = mine < 32 ? mine : 32; }
    }
    __syncthreads();
}
struct EpiMoeUp {
    static constexpr bool GATHER_A = true;
    static constexpr int BHALF = 64;
    static DEVI int brow(int R) { return ((R >> 5) & 3) * 16 + (R & 15) + (((R >> 4) & 1) ? 1024 : 0); }
    const MoeMap8* mm; bf16* ACT; const float* bup; bf16* dump;
    DEVI void operator()(const f32x4 (&acc)[2][2][4][2], const pg8::Unit& u, int wr, int wc, int fr, int fq) const {
        const int e = u.x0, cnt = mm->cnt[e];
        const float* be = bup + (size_t)e * 2048;
        f32x4 bg[2], bl[2];
#pragma unroll
        for (int bj = 0; bj < 2; ++bj) { const int col = u.x2 * 128 + (bj * 4 + wc) * 16 + 4 * fq; bg[bj] = *(const f32x4*)(be + col); bl[bj] = *(const f32x4*)(be + 1024 + col); }
#pragma unroll
        for (int ai = 0; ai < 2; ++ai)
#pragma unroll
            for (int m = 0; m < 4; ++m) {
                const int r = u.x1 + ai * 128 + wr * 64 + m * 16 + fr;
                bf16* rowp = (r < cnt) ? ACT + (size_t)(u.x3 + r) * DFF + u.x2 * 128 + wc * 16 + 4 * fq : dump + 4 * fq;
#pragma unroll
                for (int bj = 0; bj < 2; ++bj) {
                    float o[4];
#pragma unroll
                    for (int j = 0; j < 4; ++j) {
                        const float glu = fminf(acc[ai][bj][m][0][j] + bg[bj][j], 7.f);
                        const float lin = fminf(fmaxf(acc[ai][bj][m][1][j] + bl[bj][j], -7.f), 7.f);
                        o[j] = glu * sigmoidf_(1.702f * glu) * (lin + 1.f);
                    }
                    *(u32x2*)(rowp + bj * 64) = (u32x2){pk2(o[0], o[1]), pk2(o[2], o[3])};
                }
            }
    }
};
struct EpiMoeDown {
    static constexpr bool GATHER_A = false; static constexpr int BHALF = 128; static DEVI int brow(int R) { return R; }
    const MoeMap8* mm; bf16* YB; const float* bdn; const int* LIST; const float* GATE; bf16* dump;
    DEVI void operator()(const f32x4 (&acc)[2][2][4][2], const pg8::Unit& u, int wr, int wc, int fr, int fq) const {
        const int e = u.x0, cnt = mm->cnt[e];
        const float* be = bdn + (size_t)e * D + u.x2 * 256 + wc * 32 + 4 * fq;
        f32x4 bv[2][2];
#pragma unroll
        for (int bj = 0; bj < 2; ++bj)
#pragma unroll
            for (int n = 0; n < 2; ++n) bv[bj][n] = *(const f32x4*)(be + bj * 128 + n * 16);
        int ent[8]; float gt[8];
#pragma unroll
        for (int q = 0; q < 8; ++q) { const int r = u.x1 + (q >> 2) * 128 + wr * 64 + (q & 3) * 16 + fr; ent[q] = LIST[(size_t)e * S + (r < cnt ? r : cnt - 1)]; }
#pragma unroll
        for (int q = 0; q < 8; ++q) gt[q] = GATE[ent[q]];
#pragma unroll
        for (int ai = 0; ai < 2; ++ai)
#pragma unroll
            for (int m = 0; m < 4; ++m) {
                const int q = ai * 4 + m, r = u.x1 + ai * 128 + wr * 64 + m * 16 + fr;
                bf16* rowp = (r < cnt) ? YB + (size_t)ent[q] * D + u.x2 * 256 + wc * 32 + 4 * fq : dump + 4 * fq;
#pragma unroll
                for (int bj = 0; bj < 2; ++bj)
#pragma unroll
                    for (int n = 0; n < 2; ++n) {
                        const f32x4 v = (acc[ai][bj][m][n] + bv[bj][n]) * gt[q];
                        *(u32x2*)(rowp + bj * 128 + n * 16) = (u32x2){pk2(v.x, v.y), pk2(v.z, v.w)};
                    }
            }
    }
};
DEVI void phase_moe_up8(const P& p, int l, char* smem_all) {
    MoeMap8* mm = (MoeMap8*)(smem_all + 131072);
    moe_map8(p, l, mm);
    MoeUnits* mu = (MoeUnits*)(smem_all + 131072 + 512);
    moe_units(mm, mu, 3);
    int* rowtab = (int*)(smem_all + 131072 + 1024);
    {
        const int* LIST = (const int*)(p.ws + WS_LIST);
        const int nu = mu->n < 12 ? mu->n : 12;
        for (int idx = threadIdx.x; idx < nu * 256; idx += KT) {
            const int i = idx >> 8, r = idx & 255, e = mu->e[i], cnt = mm->cnt[e], rr = mu->m0[i] + r;
            rowtab[idx] = LIST[(size_t)e * S + (rr < cnt ? rr : cnt - 1)] >> 2;
        }
        __syncthreads();
    }
    SchedMoe Sm{mm, mu, (const char*)(p.ws + WS_H2), (const char*)(p.ws + WS_WUP) + (size_t)l * NEXP * 2048 * D * 2, D, (size_t)2048 * D * 2, (size_t)128 * D * 2, rowtab, true};
    EpiMoeUp E{mm, (bf16*)(p.ws + WS_ACT), p.in[33] + (size_t)l * NEXP * 2048, (bf16*)(p.ws + WS_DUMP)};
    pg8::gemm_phase((LAS unsigned char*)smem_all, D, Sm, E);
}
DEVI void phase_moe_down8(const P& p, int l, char* smem_all) {
    MoeMap8* mm = (MoeMap8*)(smem_all + 131072);
    moe_map8(p, l, mm);
    MoeUnits* mu = (MoeUnits*)(smem_all + 131072 + 512);
    moe_units(mm, mu, 2);
    SchedMoe Sm{mm, mu, (const char*)(p.ws + WS_ACT), (const char*)(p.ws + WS_WDN) + (size_t)l * NEXP * D * DFF * 2, DFF, (size_t)D * DFF * 2, (size_t)256 * DFF * 2, nullptr, false};
    EpiMoeDown E{mm, (bf16*)(p.ws + WS_YB), p.in[35] + (size_t)l * NEXP * D, (const int*)(p.ws + WS_LIST), (const float*)(p.ws + WS_GATE), (bf16*)(p.ws + WS_DUMP)};
    pg8::gemm_phase((LAS unsigned char*)smem_all, DFF, Sm, E);
}

constexpr int NPHASE = 24;
constexpr int LDS_TOTAL = 2 * VB_LDS + 64;
__global__ void __launch_bounds__(KT, 2) k_run(P p) {
    extern __shared__ __attribute__((aligned(16))) char smem_all[];
    char* smem = smem_all + __builtin_amdgcn_readfirstlane((int)(threadIdx.x >> 8)) * VB_LDS;
    XcdBarrier bar; bar.bar = nullptr; bar.x = 0; bar.st = nullptr;
    const bool multi = (p.ph_hi - p.ph_lo) > 1;
    if (multi) {
        volatile LAS unsigned* st = (volatile LAS unsigned*)(smem_all + 2 * VB_LDS);
        if (threadIdx.x == 0) { st[0] = 0u; st[1] = 0u; }
        __syncthreads();
        bar = xcd_barrier_post((unsigned*)(p.ws + OFF_BAR), st);
    }
#ifndef DUP
#define DUP -1
#endif
#ifndef DUP2
#define DUP2 -1
#endif
#define RUN(k, call) if (p.ph_lo <= (k) && (k) < p.ph_hi) { for (int _rep = ((k) == DUP || (k) == DUP2) ? 2 : 1; _rep > 0; --_rep) { call; if (multi && ((k) + 1 < p.ph_hi || _rep > 1)) xcd_barrier(bar); } }
    RUN(0, phase_prep(p, smem))
    RUN(1, phase_h0(p))
    RUN(2, { phase_inproj8(p, 0, smem_all); phase_inproj_extras(p, 0, smem); })
    RUN(3, phase_mixprep(p, 0, smem))
    RUN(4, phase_chunkA(p, smem))
    RUN(5, phase_scanL1(p, smem))
    RUN(6, phase_scanL2(p, 0, smem))
    RUN(7, phase_chunkC(p, 0, smem))
    RUN(8, phase_outproj8(p, 0, smem_all))
    RUN(9, phase_ln1_route(p, 0, smem, _rep == 1))
    RUN(10, phase_moe_up8(p, 0, smem_all))
    RUN(11, phase_moe_down8(p, 0, smem_all))
    RUN(12, phase_ln2(p, 0))
    RUN(13, { phase_inproj8(p, 1, smem_all); phase_inproj_extras(p, 1, smem); })
    RUN(14, phase_mixprep(p, 1, smem))
    RUN(15, phase_chunkA(p, smem))
    RUN(16, phase_scanL1(p, smem))
    RUN(17, phase_scanL2(p, 1, smem))
    RUN(18, phase_chunkC(p, 1, smem))
    RUN(19, phase_outproj8(p, 1, smem_all))
    RUN(20, phase_ln1_route(p, 1, smem))
    RUN(21, phase_moe_up8(p, 1, smem_all))
    RUN(22, phase_moe_down8(p, 1, smem_all))
    RUN(23, phase_ln2(p, 1))
#undef RUN
}

extern "C" void kernel_launch(void* const* d_in, const int* in_sizes, int n_in, void* d_out, int out_size, void* d_ws, size_t ws_size,
                              hipStream_t stream) {
    static int grid = 0;
    if (grid == 0) {
        if (n_in != 38 || ws_size < WS_END) { fprintf(stderr, "kernel_launch: unexpected n_in %d or ws_size %zu (< %zu)\n", n_in, ws_size, (size_t)WS_END); grid = -1; return; }
        int dev = 0, cus = 0, per_cu = 0;
        hipGetDevice(&dev);
        hipDeviceGetAttribute(&cus, hipDeviceAttributeMultiprocessorCount, dev);
        hipFuncSetAttribute((const void*)k_run, hipFuncAttributeMaxDynamicSharedMemorySize, LDS_TOTAL);
        hipOccupancyMaxActiveBlocksPerMultiprocessor(&per_cu, (const void*)k_run, KT, LDS_TOTAL);
        if (per_cu < 1) { fprintf(stderr, "kernel_launch: occupancy query returned %d\n", per_cu); grid = -1; return; }
        if (cus != 256) { fprintf(stderr, "kernel_launch: built for 256 CUs (one workgroup per CU), device has %d\n", cus); grid = -1; return; }
        grid = cus;
    }
    if (grid < 0) return;
    hipMemsetAsync((char*)d_ws + WS_CTL, 0, CTL_BYTES, stream);
    P p{};
    for (int i = 0; i < 38; ++i) p.in[i] = (const float*)d_in[i];
    p.pos = (const int*)d_in[2];
    p.out = (float*)d_out; p.ws = (char*)d_ws;
#if MEGA
    p.ph_lo = 0; p.ph_hi = NPHASE;
    void* args[] = {&p};
    hipError_t e = hipLaunchCooperativeKernel((const void*)k_run, dim3(grid), dim3(KT), args, LDS_TOTAL, stream);
    if (e != hipSuccess) fprintf(stderr, "cooperative launch failed: %s (grid %d)\n", hipGetErrorString(e), grid);
#else
    for (int ph = 0; ph < NPHASE; ++ph) {
        p.ph_lo = ph; p.ph_hi = ph + 1;
        hipLaunchKernelGGL(k_run, dim3(grid), dim3(KT), LDS_TOTAL, stream, p);
    }
#endif
}
```

```cpp
#include <hip/hip_runtime.h>
#include <hip/hip_bf16.h>
#include <stdint.h>
#include <stdio.h>

#ifndef MEGA
#define MEGA 1
#endif

#define DEVI __device__ __forceinline__
#define LAS __attribute__((address_space(3)))

typedef unsigned short bf16;
typedef short bf16x8 __attribute__((ext_vector_type(8)));
typedef float f32x4 __attribute__((ext_vector_type(4)));
typedef unsigned u32x4 __attribute__((ext_vector_type(4)));
typedef unsigned u32x2 __attribute__((ext_vector_type(2)));

constexpr int S = 16384, D = 1024, NIN = 4104, NEXP = 32, DFF = 1024;
constexpr int NPROJ = 4096;
constexpr int NPAD = 4352;
constexpr float DN_ALPHA = 1.4142135623730951f;
constexpr int NT = 256;
constexpr int LDS_BYTES = 76032;

constexpr size_t MiB = 1ull << 20;
constexpr size_t WS_CTL = 0;
constexpr size_t CTL_BYTES = 1 * MiB;
constexpr size_t OFF_BAR = 0;
constexpr size_t OFF_ADA = 64 * 1024;
constexpr size_t OFF_CNT = 128 * 1024;
constexpr size_t WS_ROT = 1 * MiB;
constexpr size_t WS_WIN = WS_ROT + (size_t)S * 64 * 4;
constexpr size_t WS_WOUT = WS_WIN + 2ull * NPAD * D * 2;
constexpr size_t WS_WUP = WS_WOUT + 2ull * D * D * 2;
constexpr size_t WS_WDN = WS_WUP + 2ull * NEXP * 2048 * D * 2;
constexpr size_t WS_HB = WS_WDN + 2ull * NEXP * D * DFF * 2;
constexpr size_t WS_PROJ = WS_HB + (size_t)S * D * 2;
constexpr size_t WS_PEX = WS_PROJ + (size_t)S * NPROJ * 2;
constexpr size_t WS_VFIRST = WS_PEX + (size_t)S * 64 * 4;
constexpr size_t WS_RECR = WS_VFIRST + (size_t)S * 256 * 4;
constexpr size_t WS_RECG = WS_RECR + (size_t)S * 4 * 384 * 2;
constexpr size_t WS_RECT = WS_RECG + (size_t)S * 4 * 392 * 2;
constexpr size_t WS_WDEC = WS_RECT + (size_t)S * 4 * 192 * 2;
constexpr size_t WS_GSC = WS_WDEC + (size_t)S * 256 * 4;
constexpr size_t WS_G = WS_GSC + (size_t)S * 16 * 4;
constexpr size_t WS_BON = WS_G + (size_t)S * 256 * 4;
constexpr size_t WS_YR = WS_BON + (size_t)S * 4 * 4;
constexpr size_t WS_OG = WS_YR + (size_t)S * 256 * 4;
constexpr size_t WS_ORT = WS_OG + (size_t)S * 512 * 4;
constexpr size_t WS_MIX = WS_ORT + (size_t)S * 256 * 4;
constexpr size_t WS_OPRE = WS_MIX + (size_t)S * D * 2;
constexpr size_t WS_X = WS_OPRE + (size_t)S * D * 4;
constexpr size_t WS_H2 = WS_X + (size_t)S * D * 4;
constexpr size_t WS_LIST = WS_H2 + (size_t)S * D * 2;
constexpr size_t WS_GATE = WS_LIST + (size_t)NEXP * S * 4;
constexpr size_t WS_ACT = WS_GATE + (size_t)S * 4 * 4;
constexpr size_t WS_YB = WS_ACT + ((size_t)S * 4 + 256) * DFF * 2;
constexpr size_t WS_ADAP = WS_YB + (size_t)S * 4 * D * 2;
constexpr size_t WS_RKV = WS_ADAP + 16ull * 12288 * 4;
constexpr size_t WS_RST = WS_RKV + 256ull * 4 * 4096 * 4;
constexpr size_t WS_GP = WS_RST + 256ull * 4 * 4096 * 2;
constexpr size_t WS_GB = WS_GP + 1024ull * 16384 * 2;
constexpr size_t WS_GD = WS_GB + 1024ull * 16384 * 4;
constexpr size_t WS_GQ = WS_GD + 4096;
constexpr size_t WS_GO = WS_GQ + 1024ull * 8192 * 2;
constexpr size_t WS_GS = WS_GO + 1024ull * 8192 * 4;
constexpr size_t WS_WP = WS_GS + 1024ull * 16384 * 2;
constexpr size_t WS_WC = WS_WP + 2048ull * 4096 * 2;
constexpr size_t WS_WD = WS_WC + 2048ull * 4096 * 4;
constexpr size_t WS_WQ = WS_WD + 2048ull * 64 * 4;
constexpr size_t WS_WY = WS_WQ + 2048ull * 2048 * 2;
constexpr size_t WS_WS = WS_WY + 2048ull * 2048 * 4;
constexpr size_t WS_GR = WS_WS + 2048ull * 4096 * 2;
constexpr size_t WS_GE0 = WS_GR + 1024ull * 8192 * 2;
constexpr size_t WS_GTE = WS_GE0 + 64ull * 16384 * 4;
constexpr size_t WS_GSG = WS_GTE + 64ull * 16384 * 2;
constexpr size_t WS_WR = WS_GSG + 64ull * 16384 * 2;
constexpr size_t WS_WE0 = WS_WR + 2048ull * 2048 * 2;
constexpr size_t WS_WTE = WS_WE0 + 64ull * 4096 * 4;
constexpr size_t WS_WSG = WS_WTE + 64ull * 4096 * 2;
constexpr size_t WS_LRT = WS_WSG + 64ull * 4096 * 2;
constexpr size_t WS_DUMP = WS_LRT + 2ull * 73728 * 2;
constexpr size_t WS_END = WS_DUMP + 4096;

struct P {
    const float* in[38];
    const int* pos;
    float* out;
    char* ws;
    int ph_lo, ph_hi;
};

DEVI float bf2f(bf16 v) { return __uint_as_float(((unsigned)v) << 16); }
DEVI unsigned f2bf(float f) { unsigned u = __float_as_uint(f); return (u + 0x7fffu + ((u >> 16) & 1u)) >> 16; }
typedef float f32x2_t __attribute__((ext_vector_type(2)));
typedef __bf16 bf16x2_t __attribute__((ext_vector_type(2)));
DEVI unsigned pk2(float lo, float hi) { const f32x2_t v = {lo, hi}; return __builtin_bit_cast(unsigned, __builtin_convertvector(v, bf16x2_t)); }
DEVI float sigmoidf_(float x) { return __builtin_amdgcn_rcpf(1.f + __builtin_amdgcn_exp2f(-1.4426950408889634f * x)); }
DEVI float siluf_(float x) { return x * sigmoidf_(x); }
DEVI float softplusf_(float x) { return fmaxf(x, 0.f) + log1pf(__expf(-fabsf(x))); }
DEVI float wave_sum(float v) {
#pragma unroll
    for (int o = 32; o >= 1; o >>= 1) v += __shfl_xor(v, o);
    return v;
}
template <int CTRL> DEVI float dpp_mov(float x) {
    return __int_as_float(__builtin_amdgcn_update_dpp(0, __float_as_int(x), CTRL, 0xf, 0xf, false));
}
DEVI float row16_sum(float x) {
    x += dpp_mov<0x128>(x);
    x += dpp_mov<0x124>(x);
    x += dpp_mov<0x122>(x);
    x += dpp_mov<0x121>(x);
    return x;
}

DEVI bf16x8 ldfrag(const bf16* base, int ld, int row0, int k0, int lane) {
    return *(const bf16x8*)(base + (row0 + (lane & 15)) * ld + k0 + (lane >> 4) * 8);
}
DEVI f32x4 ld_bf4(const bf16* p) {
    const u32x2 v = *(const u32x2*)p;
    return (f32x4){__uint_as_float(v.x << 16), __uint_as_float(v.x & 0xffff0000u), __uint_as_float(v.y << 16), __uint_as_float(v.y & 0xffff0000u)};
}
DEVI void st_bf4(bf16* p, const f32x4& v) { *(u32x2*)p = (u32x2){pk2(v.x, v.y), pk2(v.z, v.w)}; }
DEVI float quad_sum(float v) { v += __shfl_xor(v, 16); v += __shfl_xor(v, 32); return v; }
DEVI f32x4 mfma16(bf16x8 a, bf16x8 b, f32x4 c) { return __builtin_amdgcn_mfma_f32_16x16x32_bf16(a, b, c, 0, 0, 0); }

#define VTID ((int)(threadIdx.x & 255))
#define VBID ((int)(blockIdx.x * 2 + __builtin_amdgcn_readfirstlane((int)(threadIdx.x >> 8))))
#define VNB ((int)(gridDim.x * 2))
constexpr int VB_LDS = 76032;
constexpr int KT = 512;

#define XB_TMO      128
#define XB_XCNT(j)  (256  + 64 * (j))
#define XB_XSUB(j)  (1280 + 64 * (j))
#define XB_XGEN(j)  (2304 + 64 * (j))
#define XB_TOP      3328
#define XB_TOPGEN   3392
#define XCD_BAR_WORDS 3456
#define XB_SPIN_CAP (1u << 22)
DEVI unsigned xb_ld(unsigned* p) { return __hip_atomic_load(p, __ATOMIC_RELAXED, __HIP_MEMORY_SCOPE_AGENT); }
DEVI unsigned xb_add(unsigned* p, unsigned v) { return __hip_atomic_fetch_add(p, v, __ATOMIC_RELAXED, __HIP_MEMORY_SCOPE_AGENT); }
DEVI unsigned xb_xcc_id() { return (unsigned)__builtin_amdgcn_s_getreg((3 << 11) | 20) & 0xFu; }
#define XB_SPIN(cond, bar) do { unsigned _sp = 0; while (cond) { __builtin_amdgcn_s_sleep(1); \
    if ((++_sp & 255u) == 0u) { if (xb_ld(&(bar)[XB_TMO])) break; if (_sp > XB_SPIN_CAP) { atomicAdd(&(bar)[XB_TMO], 1u); break; } } } } while (0)
struct XcdBarrier { unsigned* bar; unsigned x; volatile LAS unsigned* st; };
DEVI XcdBarrier xcd_barrier_post(unsigned* bar, volatile LAS unsigned* st) {
    XcdBarrier b; b.bar = bar; b.x = xb_xcc_id(); b.st = st;
    if (threadIdx.x == 0) (void)xb_add(&bar[XB_XCNT(b.x)], 1u);
    return b;
}
DEVI void xcd_barrier_complete(unsigned* bar, unsigned x, unsigned& nloc, unsigned& nx) {
    const unsigned G = gridDim.x * gridDim.y * gridDim.z;
    unsigned sum, cnt, mine, sp = 0u;
    for (;;) {
        sum = 0u; cnt = 0u; mine = 0u;
#pragma unroll
        for (unsigned j = 0; j < 16; ++j) { const unsigned c = xb_ld(&bar[XB_XCNT(j)]); sum += c; cnt += (c > 0u) ? 1u : 0u; mine = (j == x) ? c : mine; }
        if (sum == G) break;
        __builtin_amdgcn_s_sleep(1);
        if ((++sp & 255u) == 0u) { if (xb_ld(&bar[XB_TMO])) break; if (sp > XB_SPIN_CAP) { atomicAdd(&bar[XB_TMO], 1u); break; } }
    }
    nloc = mine > 0u ? mine : 1u; nx = cnt > 0u ? cnt : 1u;
}
DEVI void xcd_barrier(const XcdBarrier& b) {
    asm volatile("s_waitcnt vmcnt(0)" ::: "memory");
    __syncthreads();
    if (threadIdx.x == 0) {
        unsigned* bar = b.bar;
        __builtin_amdgcn_s_waitcnt(0);
        unsigned nloc = b.st[0], nx = b.st[1];
        if (nloc == 0u) { xcd_barrier_complete(bar, b.x, nloc, nx); b.st[0] = nloc; b.st[1] = nx; }
        const unsigned old = xb_add(&bar[XB_XSUB(b.x)], 1u);
        const unsigned gen = old / nloc;
        if (old + 1u == (gen + 1u) * nloc) {
            __builtin_amdgcn_fence(__ATOMIC_RELEASE, "agent");
            asm volatile("s_waitcnt vmcnt(0)" ::: "memory");
            const unsigned og = xb_add(&bar[XB_TOP], 1u);
            const unsigned tg = og / nx;
            if (og + 1u == (tg + 1u) * nx) xb_add(&bar[XB_TOPGEN], 1u);
            else XB_SPIN(xb_ld(&bar[XB_TOPGEN]) == tg, bar);
            __builtin_amdgcn_fence(__ATOMIC_ACQUIRE, "agent");
            xb_add(&bar[XB_XGEN(b.x)], 1u);
            asm volatile("s_waitcnt vmcnt(0)" ::: "memory");
        } else {
            XB_SPIN(xb_ld(&bar[XB_XGEN(b.x)]) == gen, bar);
            __builtin_amdgcn_fence(__ATOMIC_ACQUIRE, "agent");
            asm volatile("s_waitcnt vmcnt(0)" ::: "memory");
        }
    }
    __syncthreads();
}

DEVI void transpose_item(const float* __restrict__ src, size_t ld, int k0, int ns0, bf16* __restrict__ dst, int kd, int nd0, float* lds) {
    const int tid = VTID;
    float tv[32];
#pragma unroll
    for (int i = 0; i < 32; ++i) tv[i] = __builtin_nontemporal_load(&src[(size_t)(k0 + i * 4 + (tid >> 6)) * ld + ns0 + (tid & 63)]);
    asm volatile("" ::: "memory");
#pragma unroll
    for (int i = 0; i < 32; ++i) lds[(i * 4 + (tid >> 6)) * 65 + (tid & 63)] = tv[i];
    __syncthreads();
#pragma unroll
    for (int i = 0; i < 4; ++i) {
        const int q = tid + 256 * i, n = q >> 4, kc = q & 15;
        const float* s = lds + (kc * 8) * 65 + n;
        u32x4 o;
        o.x = pk2(s[0 * 65], s[1 * 65]); o.y = pk2(s[2 * 65], s[3 * 65]);
        o.z = pk2(s[4 * 65], s[5 * 65]); o.w = pk2(s[6 * 65], s[7 * 65]);
        *(u32x4*)(dst + (size_t)(nd0 + n) * kd + k0 + kc * 8) = o;
    }
    __syncthreads();
}

DEVI void phase_prep(const P& p, char* smem) {
    float* lds = (float*)smem;
    const int tid = VTID;
    const int nb = VNB, bid = VBID;
    bf16* WIN = (bf16*)(p.ws + WS_WIN); bf16* WOUT = (bf16*)(p.ws + WS_WOUT);
    bf16* WUP = (bf16*)(p.ws + WS_WUP); bf16* WDN = (bf16*)(p.ws + WS_WDN);
    constexpr int I_UP = 2 * NEXP * 8 * 32;
    constexpr int I_DN = 2 * NEXP * 8 * 16;
    constexpr int I_IN = 2 * 8 * 64;
    constexpr int I_OUT = 2 * 8 * 16;
    constexpr int I_EX = 2 * 256;
    constexpr int I_ADA = 2 * 24 * 16;
    constexpr int I_ROT = S * 32 / 256;
    constexpr int I_LR = 2 * 288;
    constexpr int NITEMS = I_UP + I_DN + I_IN + I_OUT + I_EX + I_ADA + I_ROT + I_LR;
    constexpr int I_TR = I_UP + I_DN + I_IN + I_OUT;
    static_assert((I_TR % 512) % 2 == 0, "the two halves of every workgroup must run the same number of transpose items (they contain barriers)");
    for (int it = bid; it < NITEMS; it += nb) {
        int r = it;
        if (r < I_UP) {
            const int le = r / 256, q = r % 256, kt = q / 32, nt = q % 32;
            transpose_item(p.in[32] + (size_t)le * D * 2048, 2048, kt * 128, nt * 64, WUP + (size_t)le * 2048 * D, D, nt * 64, lds);
            continue;
        }
        r -= I_UP;
        if (r < I_DN) {
            const int le = r / 128, q = r % 128, kt = q / 16, nt = q % 16;
            transpose_item(p.in[34] + (size_t)le * DFF * D, D, kt * 128, nt * 64, WDN + (size_t)le * D * DFF, DFF, nt * 64, lds);
            continue;
        }
        r -= I_DN;
        if (r < I_IN) {
            const int l = r / 512, q = r % 512, kt = q / 64, nt = q % 64;
            const int nd0 = nt * 64, ns0 = nd0 < 3072 ? nd0 : nd0 + 8;
            transpose_item(p.in[5] + (size_t)l * D * NIN, NIN, kt * 128, ns0, WIN + (size_t)l * NPAD * D, D, nd0, lds);
            continue;
        }
        r -= I_IN;
        if (r < I_OUT) {
            const int l = r / 128, q = r % 128, kt = q / 16, nt = q % 16;
            transpose_item(p.in[27] + (size_t)l * D * D, D, kt * 128, nt * 64, WOUT + (size_t)l * D * D, D, nt * 64, lds);
            continue;
        }
        r -= I_OUT;
        if (r < I_EX) {
            const int l = r / 256, n = r % 256;
            bf16* dst = WIN + ((size_t)l * NPAD + NPROJ + n) * D;
            for (int k = tid; k < D; k += NT) {
                float v = 0.f;
                if (n < 8) v = p.in[5][(size_t)l * D * NIN + (size_t)k * NIN + 3072 + n];
                else if (n < 40 && l == 1) v = p.in[6][(size_t)k * 32 + (n - 8)];
                dst[k] = (bf16)f2bf(v);
            }
            continue;
        }
        r -= I_EX;
        if (r < I_ADA) {
            const int l = r / 384, q = r % 384, nc = q / 16, kc = q % 16;
            const int n = nc * 256 + tid;
            const float* W = p.in[3] + (size_t)l * D * 6144;
            float acc = (kc == 0) ? p.in[4][l * 6144 + n] : 0.f;
            for (int k = kc * 64; k < kc * 64 + 64; ++k) acc += siluf_(p.in[1][k]) * W[(size_t)k * 6144 + n];
            ((float*)(p.ws + WS_ADAP))[(size_t)kc * 12288 + l * 6144 + n] = acc;
            continue;
        }
        r -= I_ADA;
        if (r >= I_ROT) {
            r -= I_ROT;
            const int l = r / 288, kk = r % 288, c = tid;
            bf16* LRT = (bf16*)(p.ws + WS_LRT) + (size_t)l * 73728;
            if (kk < 64) LRT[c * 64 + kk] = (bf16)f2bf(p.in[10][(l * 64 + kk) * 256 + c]);
            else if (kk < 128) LRT[16384 + c * 64 + (kk - 64)] = (bf16)f2bf(p.in[12][(l * 64 + kk - 64) * 256 + c]);
            else if (kk < 256) LRT[32768 + c * 128 + (kk - 128)] = (bf16)f2bf(p.in[13][(l * 128 + kk - 128) * 256 + c]);
            else LRT[65536 + c * 32 + (kk - 256)] = (bf16)f2bf(l == 1 ? p.in[20][(kk - 256) * 256 + c] : 0.f);
            continue;
        }
        {
            const int idx = r * 256 + tid;
            const int t = idx >> 5, i = idx & 31;
            const float invf = (float)pow(10000.0, -(double)i / 32.0);
            const float ang = (float)p.pos[t] * invf;
            float sn, cs; sincosf(ang, &sn, &cs);
            float* ROT = (float*)(p.ws + WS_ROT);
            ROT[(size_t)idx * 2] = cs; ROT[(size_t)idx * 2 + 1] = sn;
        }
    }
}

DEVI float ada_sum(const float* ADAP, int idx) {
    float s = 0.f;
#pragma unroll
    for (int kc = 0; kc < 16; ++kc) s += ADAP[(size_t)kc * 12288 + idx];
    return s;
}
DEVI void phase_h0(const P& p) {
    const float* ADAP = (const float*)(p.ws + WS_ADAP);
    float* ADA = (float*)(p.ws + OFF_ADA);
    bf16* HB = (bf16*)(p.ws + WS_HB);
    if (VBID < 48) ADA[VBID * 256 + VTID] = ada_sum(ADAP, VBID * 256 + VTID);
    const size_t n4 = (size_t)S * D / 4;
    const int c = (int)(((size_t)VBID * NT + VTID) % (D / 4)) * 4;
    f32x4 sh, sc;
    sh.x = ada_sum(ADAP, c); sh.y = ada_sum(ADAP, c + 1); sh.z = ada_sum(ADAP, c + 2); sh.w = ada_sum(ADAP, c + 3);
    sc.x = ada_sum(ADAP, 1024 + c); sc.y = ada_sum(ADAP, 1025 + c); sc.z = ada_sum(ADAP, 1026 + c); sc.w = ada_sum(ADAP, 1027 + c);
    for (size_t i = (size_t)VBID * NT + VTID; i < n4; i += (size_t)VNB * NT) {
        const f32x4 x = ((const f32x4*)p.in[0])[i];
        u32x2 o;
        o.x = pk2(x.x * (1.f + sc.x) + sh.x, x.y * (1.f + sc.y) + sh.y);
        o.y = pk2(x.z * (1.f + sc.z) + sh.z, x.w * (1.f + sc.w) + sh.w);
        ((u32x2*)HB)[i] = o;
    }
}

template <class AF, class BF>
DEVI void gemm_tile(char* smem, const bf16* __restrict__ Abase, AF arow, const bf16* __restrict__ Bbase, BF brow, int K, f32x4 (&acc)[4][8]) {
    const int tid = VTID, wid = tid >> 6, lane = tid & 63, wr = wid >> 1, wc = wid & 1, fr = lane & 15, fq = lane >> 4;
    const int r0 = tid >> 2;
    const int swz = ((tid & 3) ^ ((0x1320 >> (4 * ((tid >> 4) & 3))) & 3)) * 8;
    unsigned pa[2], pb[4];
#pragma unroll
    for (int i = 0; i < 2; ++i) pa[i] = arow(r0 + 64 * i) + swz;
#pragma unroll
    for (int i = 0; i < 4; ++i) pb[i] = brow(r0 + 64 * i) + swz;
#pragma unroll
    for (int m = 0; m < 4; ++m)
#pragma unroll
        for (int n = 0; n < 8; ++n) acc[m][n] = (f32x4){0.f, 0.f, 0.f, 0.f};
    const int nk = K / 32;
    const int ch = (fq ^ ((0x1320 >> (4 * ((fr >> 2) & 3))) & 3)) * 16;
#define GT_STAGE(kt) do { char* _sa = smem + ((kt) % 3) * 24576; char* _sb = _sa + 8192; \
        _Pragma("unroll") for (int _i = 0; _i < 2; ++_i) \
            __builtin_amdgcn_global_load_lds((const unsigned*)(Abase + pa[_i] + (kt) * 32), (unsigned*)(_sa + (tid + 256 * _i) * 16), 16, 0, 0); \
        _Pragma("unroll") for (int _i = 0; _i < 4; ++_i) \
            __builtin_amdgcn_global_load_lds((const unsigned*)(Bbase + pb[_i] + (kt) * 32), (unsigned*)(_sb + (tid + 256 * _i) * 16), 16, 0, 0); } while (0)
    asm volatile("s_waitcnt vmcnt(0)" ::: "memory");
    GT_STAGE(0); GT_STAGE(1);
    for (int kt = 0; kt < nk; ++kt) {
        if (kt + 1 < nk) asm volatile("s_waitcnt vmcnt(6)" ::: "memory");
        else asm volatile("s_waitcnt vmcnt(0)" ::: "memory");
        asm volatile("s_waitcnt lgkmcnt(0)" ::: "memory");
        __builtin_amdgcn_s_barrier();
        if (kt + 2 < nk) GT_STAGE(kt + 2);
        const char* SA = smem + (kt % 3) * 24576; const char* SB = SA + 8192;
        bf16x8 af[4], bfr[8];
#pragma unroll
        for (int m = 0; m < 4; ++m) af[m] = *(const bf16x8*)(SA + (wr * 64 + m * 16 + fr) * 64 + ch);
#pragma unroll
        for (int n = 0; n < 8; ++n) bfr[n] = *(const bf16x8*)(SB + (wc * 128 + n * 16 + fr) * 64 + ch);
#pragma unroll
        for (int m = 0; m < 4; ++m)
#pragma unroll
            for (int n = 0; n < 8; ++n)
                acc[m][n] = __builtin_amdgcn_mfma_f32_16x16x32_bf16(bfr[n], af[m], acc[m][n], 0, 0, 0);
    }
    asm volatile("s_waitcnt lgkmcnt(0)" ::: "memory");
    __builtin_amdgcn_s_barrier();
#undef GT_STAGE
}

DEVI float proj_at(const bf16* PROJ, int t, int col) { return bf2f(PROJ[(size_t)t * NPROJ + col]); }
DEVI float proj_shift(const bf16* PROJ, int t, int col, float mu) {
    const float cur = proj_at(PROJ, t, col);
    const float prv = t > 0 ? proj_at(PROJ, t - 1, col) : 0.f;
    return cur + (prv - cur) * mu;
}

DEVI f32x4 shift4(const bf16* PROJ, int t, int col, const f32x4& mu) {
    const f32x4 cur = ld_bf4(PROJ + (size_t)t * NPROJ + col);
    f32x4 prv = ld_bf4(PROJ + (size_t)(t > 0 ? t - 1 : 0) * NPROJ + col);
    const float keep = t > 0 ? 1.f : 0.f;
    prv = prv * keep;
    return cur + (prv - cur) * mu;
}
DEVI float fsig(float x) { return sigmoidf_(x); }
DEVI void phase_mixprep(const P& p, int l, char* smem) {
    const bf16* PROJ = (const bf16*)(p.ws + WS_PROJ); const float* PEX = (const float*)(p.ws + WS_PEX);
    float* VFIRST = (float*)(p.ws + WS_VFIRST);
    bf16* RECR = (bf16*)(p.ws + WS_RECR); bf16* RECG = (bf16*)(p.ws + WS_RECG); bf16* RECT = (bf16*)(p.ws + WS_RECT);
    float* WDEC = (float*)(p.ws + WS_WDEC); float* GSC = (float*)(p.ws + WS_GSC);
    float* GB = (float*)(p.ws + WS_G); float* BON = (float*)(p.ws + WS_BON);
    const float* ROT = (const float*)(p.ws + WS_ROT);
    const bf16* LRT = (const bf16*)(p.ws + WS_LRT) + (size_t)l * 73728;
    bf16* L = (bf16*)smem;
    float* CW = (float*)(smem + 9728);
    float* MU = CW + 6144;
    float* PW0 = MU + 1024; float* PA0 = PW0 + 256; float* PKK = PA0 + 256; float* PKA = PKK + 256; float* PRK = PKA + 256; float* PV0 = PRK + 256;
    {
        const int tid = VTID;
        for (int i = tid; i < 6144; i += NT) CW[i] = p.in[21][l * 6144 + i];
        for (int i = tid; i < 1024; i += NT) MU[i] = p.in[7][l * 1024 + i];
        PW0[tid] = p.in[9][l * 256 + tid]; PA0[tid] = p.in[11][l * 256 + tid]; PKK[tid] = p.in[14][l * 256 + tid];
        PKA[tid] = p.in[15][l * 256 + tid]; PRK[tid] = p.in[16][l * 256 + tid]; PV0[tid] = (l == 1) ? p.in[19][tid] : 0.f;
    }
    __syncthreads();
    for (int item = VBID; item < S / 16; item += VNB) {
        int tid = VTID; asm volatile("" : "+v"(tid));
        const int lane = tid & 63, w = tid >> 6, fr = lane & 15, fq = lane >> 4;
        const int t0 = item * 16;
        {
            u32x2 cur[5], prv[5]; f32x4 xc[5], xp[5];
#pragma unroll
            for (int q = 0; q < 5; ++q) {
                const int g = tid + 256 * q, gg = g < 1152 ? g : 1151, tt = gg / 72, i4 = (gg % 72) * 4, t = t0 + tt, tp = t > 0 ? t - 1 : 0;
                const int ia = i4 < 256 ? i4 : 252, ib = i4 < 256 ? 0 : i4 - 256;
                cur[q] = *(const u32x2*)(PROJ + (size_t)t * NPROJ + 768 + ia); prv[q] = *(const u32x2*)(PROJ + (size_t)tp * NPROJ + 768 + ia);
                xc[q] = *(const f32x4*)(PEX + (size_t)t * 64 + 8 + ib); xp[q] = *(const f32x4*)(PEX + (size_t)tp * 64 + 8 + ib);
            }
            asm volatile("" ::: "memory");
#pragma unroll
            for (int q = 0; q < 5; ++q) {
                const int g = tid + 256 * q, gg = g < 1152 ? g : 1151, tt = gg / 72, i4 = (gg % 72) * 4, t = t0 + tt;
                const float keep = t > 0 ? 1.f : 0.f;
                f32x4 v;
                if (i4 < 256) {
                    const f32x4 c4 = {__uint_as_float(cur[q].x << 16), __uint_as_float(cur[q].x & 0xffff0000u), __uint_as_float(cur[q].y << 16), __uint_as_float(cur[q].y & 0xffff0000u)};
                    const f32x4 p4 = (f32x4){__uint_as_float(prv[q].x << 16), __uint_as_float(prv[q].x & 0xffff0000u), __uint_as_float(prv[q].y << 16), __uint_as_float(prv[q].y & 0xffff0000u)} * keep;
                    v = c4 + (p4 - c4) * *(const f32x4*)(MU + 768 + i4);
                    if (i4 < 64) { v.x = tanhf(v.x); v.y = tanhf(v.y); v.z = tanhf(v.z); v.w = tanhf(v.w); }
                    else if (i4 >= 128) { v.x = fsig(v.x); v.y = fsig(v.y); v.z = fsig(v.z); v.w = fsig(v.w); }
                } else {
                    v = (f32x4){0.f, 0.f, 0.f, 0.f};
                    if (l == 1) v = xc[q] + (xp[q] * keep - xc[q]) * *(const f32x4*)(p.in[8] + (i4 - 256));
                }
                if (g < 1152) *(u32x2*)(L + tt * 296 + i4) = (u32x2){pk2(v.x, v.y), pk2(v.z, v.w)};
            }
        }
        __syncthreads();
        const int t = t0 + fr, h = w, tpv = t > 0 ? t - 1 : 0;
        const float keep = t > 0 ? 1.f : 0.f;
        {
            f32x4 aw[4], aa[4], ag[4], av[4];
#pragma unroll
            for (int i = 0; i < 4; ++i) { aw[i] = (f32x4){0.f, 0.f, 0.f, 0.f}; aa[i] = aw[i]; ag[i] = aw[i]; av[i] = aw[i]; }
            bf16x8 lf[9];
#pragma unroll
            for (int ks = 0; ks < 9; ++ks) lf[ks] = *(const bf16x8*)(L + fr * 296 + ks * 32 + fq * 8);
#pragma unroll
            for (int i = 0; i < 4; ++i) {
                const int c = 64 * h + 16 * i + fr;
#pragma unroll
                for (int ks = 0; ks < 2; ++ks) aw[i] = mfma16(*(const bf16x8*)(LRT + c * 64 + ks * 32 + fq * 8), lf[ks], aw[i]);
#pragma unroll
                for (int ks = 0; ks < 2; ++ks) aa[i] = mfma16(*(const bf16x8*)(LRT + 16384 + c * 64 + ks * 32 + fq * 8), lf[2 + ks], aa[i]);
#pragma unroll
                for (int ks = 0; ks < 4; ++ks) ag[i] = mfma16(*(const bf16x8*)(LRT + 32768 + c * 128 + ks * 32 + fq * 8), lf[4 + ks], ag[i]);
                if (l == 1) av[i] = mfma16(*(const bf16x8*)(LRT + 65536 + c * 32 + fq * 8), lf[8], av[i]);
            }
            bf16* rec = RECR + ((size_t)t * 4 + h) * 384;
            f32x4 kx[4], as_[4];
            float ss = 0.f, bsum = 0.f;
#define UNPK4(u) ((f32x4){__uint_as_float((u).x << 16), __uint_as_float((u).x & 0xffff0000u), __uint_as_float((u).y << 16), __uint_as_float((u).y & 0xffff0000u)})
            u32x2 rc[4], rp[4], kc[4], kp[4], vc[4], vp[4]; f32x4 vf4[4];
#pragma unroll
            for (int i = 0; i < 4; ++i) {
                const int j = 16 * i + 4 * fq, c = 64 * h + j;
                if ((i & 1) == 0) {
#pragma unroll
                    for (int i2 = i; i2 < i + 2; ++i2) {
                        const int c2 = 64 * h + 16 * i2 + 4 * fq;
                        rc[i2] = *(const u32x2*)(PROJ + (size_t)t * NPROJ + c2); rp[i2] = *(const u32x2*)(PROJ + (size_t)tpv * NPROJ + c2);
                        kc[i2] = *(const u32x2*)(PROJ + (size_t)t * NPROJ + 256 + c2); kp[i2] = *(const u32x2*)(PROJ + (size_t)tpv * NPROJ + 256 + c2);
                        vc[i2] = *(const u32x2*)(PROJ + (size_t)t * NPROJ + 512 + c2); vp[i2] = *(const u32x2*)(PROJ + (size_t)tpv * NPROJ + 512 + c2);
                        if (l == 1) vf4[i2] = *(const f32x4*)(VFIRST + (size_t)t * 256 + c2);
                    }
                    asm volatile("" ::: "memory");
                }
                const f32x4 r0 = UNPK4(rc[i]), k0 = UNPK4(kc[i]), v0_ = UNPK4(vc[i]);
                const f32x4 r = r0 + (UNPK4(rp[i]) * keep - r0) * *(const f32x4*)(MU + c);
                const f32x4 k = k0 + (UNPK4(kp[i]) * keep - k0) * *(const f32x4*)(MU + 256 + c);
                f32x4 v = v0_ + (UNPK4(vp[i]) * keep - v0_) * *(const f32x4*)(MU + 512 + c);
                const f32x4 w0 = *(const f32x4*)(PW0 + c), a0 = *(const f32x4*)(PA0 + c);
                const f32x4 kkc = *(const f32x4*)(PKK + c), kac = *(const f32x4*)(PKA + c), rkc = *(const f32x4*)(PRK + c);
                f32x4 dec, a;
#pragma unroll
                for (int q = 0; q < 4; ++q) {
                    const float wl = -softplusf_(-(w0[q] + aw[i][q])) - 0.5f;
                    dec[q] = __expf(-__expf(wl));
                    a[q] = fsig(a0[q] + aa[i][q]);
                }
                if (l == 0) *(f32x4*)(VFIRST + (size_t)t * 256 + c) = v;
                else {
                    const f32x4 v0 = *(const f32x4*)(PV0 + c);
#pragma unroll
                    for (int q = 0; q < 4; ++q) v[q] = v[q] + (vf4[i][q] - v[q]) * fsig(v0[q] + av[i][q]);
                }
                kx[i] = k * kkc; as_[i] = a;
                const f32x4 k2 = k * ((a - 1.f) * kac + 1.f);
                ss += kx[i].x * kx[i].x + kx[i].y * kx[i].y + kx[i].z * kx[i].z + kx[i].w * kx[i].w;
                const f32x4 rb = r * k2 * rkc;
                bsum += (rb.x + rb.y) + (rb.z + rb.w);
                *(f32x4*)(WDEC + (size_t)t * 256 + c) = dec; st_bf4(rec + 192 + j, k2); st_bf4(rec + 256 + j, r); st_bf4(rec + 320 + j, v);
                *(f32x4*)(GB + (size_t)t * 256 + c) = ag[i];
            }
            const float rn = rsqrtf(quad_sum(ss) + 1e-12f);
            bsum = quad_sum(bsum);
            if (fq == 0) BON[(size_t)t * 4 + h] = bsum;
#pragma unroll
            for (int i = 0; i < 4; ++i) {
                const int j = 16 * i + 4 * fq;
                const f32x4 kk = kx[i] * rn;
                st_bf4(rec + j, -kk); st_bf4(rec + 128 + j, kk * as_[i]);
            }
        }
        {
            bf16* rec = RECG + ((size_t)t * 4 + h) * 392;
            f32x4 yq[8], yk[8];
            float sq = 0.f, sk = 0.f;
            size_t rowo[4];
            float tapm[4];
#pragma unroll
            for (int tap = 0; tap < 4; ++tap) { const int tp = t - 3 + tap; rowo[tap] = (size_t)(tp >= 0 ? tp : 0) * NPROJ; tapm[tap] = tp >= 0 ? 1.f : 0.f; }
#pragma unroll
            for (int which = 0; which < 3; ++which) {
                u32x2 raw[8][4];
#pragma unroll
                for (int i = 0; i < 8; ++i) {
                    if ((i & 3) == 0) {
#pragma unroll
                        for (int i2 = i; i2 < i + 4; ++i2)
#pragma unroll
                            for (int tap = 0; tap < 4; ++tap) raw[i2][tap] = *(const u32x2*)(PROJ + rowo[tap] + 1024 + which * 512 + h * 128 + 16 * i2 + 4 * fq);
                        asm volatile("" ::: "memory");
                    }
                    const int j = 16 * i + 4 * fq, ch = which * 512 + h * 128 + j;
                    f32x4 cv = {0.f, 0.f, 0.f, 0.f};
#pragma unroll
                    for (int tap = 0; tap < 4; ++tap) cv = cv + UNPK4(raw[i][tap]) * (*(const f32x4*)(CW + tap * 1536 + ch) * tapm[tap]);
                    f32x4 y; y.x = siluf_(cv.x); y.y = siluf_(cv.y); y.z = siluf_(cv.z); y.w = siluf_(cv.w);
                    if (which == 0) { yq[i] = y; sq += y.x * y.x + y.y * y.y + y.z * y.z + y.w * y.w; }
                    else if (which == 1) { yk[i] = y; sk += y.x * y.x + y.y * y.y + y.z * y.z + y.w * y.w; }
                    else st_bf4(rec + 256 + j, y);
                }
            }
            const float rq = rsqrtf(quad_sum(sq) + 1e-12f) * 0.08838834764831845f, rk = rsqrtf(quad_sum(sk) + 1e-12f);
#pragma unroll
            for (int i = 0; i < 8; ++i) { const int j = 16 * i + 4 * fq; st_bf4(rec + j, yq[i] * rq); st_bf4(rec + 128 + j, yk[i] * rk); }
            if (fq == 0) {
                const float av = PEX[(size_t)t * 64 + h], bv = PEX[(size_t)t * 64 + 4 + h];
                const float g = -__expf(p.in[22][l * 4 + h]) * softplusf_(av + p.in[23][l * 4 + h]);
                *(f32x4*)(GSC + ((size_t)t * 4 + h) * 4) = (f32x4){__expf(g), fsig(bv), g, 0.f};
            }
        }
        {
            bf16* rec = RECT + ((size_t)t * 4 + h) * 192;
            u32x2 q1r[2], q2r[2], k1r[2], k2r[2], vr[4]; f32x4 c0r[2], c1r[2];
#pragma unroll
            for (int u = 0; u < 2; ++u) {
                const int i = 16 * u + 4 * fq;
                c0r[u] = *(const f32x4*)(ROT + ((size_t)t * 32 + i) * 2); c1r[u] = *(const f32x4*)(ROT + ((size_t)t * 32 + i) * 2 + 4);
                q1r[u] = *(const u32x2*)(PROJ + (size_t)t * NPROJ + 3072 + h * 64 + i); q2r[u] = *(const u32x2*)(PROJ + (size_t)t * NPROJ + 3072 + h * 64 + 32 + i);
                k1r[u] = *(const u32x2*)(PROJ + (size_t)t * NPROJ + 3328 + h * 64 + i); k2r[u] = *(const u32x2*)(PROJ + (size_t)t * NPROJ + 3328 + h * 64 + 32 + i);
            }
#pragma unroll
            for (int i = 0; i < 4; ++i) vr[i] = *(const u32x2*)(PROJ + (size_t)t * NPROJ + 3584 + h * 64 + 16 * i + 4 * fq);
            asm volatile("" ::: "memory");
#pragma unroll
            for (int u = 0; u < 2; ++u) {
                const int i = 16 * u + 4 * fq;
                const f32x4 cs = {c0r[u].x, c0r[u].z, c1r[u].x, c1r[u].z}, sn = {c0r[u].y, c0r[u].w, c1r[u].y, c1r[u].w};
                const f32x4 q1 = UNPK4(q1r[u]), q2 = UNPK4(q2r[u]), k1 = UNPK4(k1r[u]), k2 = UNPK4(k2r[u]);
                st_bf4(rec + i, q1 * cs - q2 * sn); st_bf4(rec + 32 + i, q1 * sn + q2 * cs);
                st_bf4(rec + 64 + i, (k1 * cs - k2 * sn) * 0.125f); st_bf4(rec + 96 + i, (k1 * sn + k2 * cs) * 0.125f);
            }
#pragma unroll
            for (int i = 0; i < 4; ++i) *(u32x2*)(rec + 128 + 16 * i + 4 * fq) = vr[i];
        }
#undef UNPK4
        __syncthreads();
    }
}

DEVI void retA_item(const P& p, int item, char* smem) {
    const bf16* REC = (const bf16*)(p.ws + WS_RECT); float* KV = (float*)(p.ws + WS_RKV);
    bf16* KT = (bf16*)smem; bf16* VT = KT + 64 * 72;
    const int n = item >> 2, h = item & 3;
    int tid = VTID; asm volatile("" : "+v"(tid));
    const int lane = tid & 63, w = tid >> 6, fr = lane & 15, fq = lane >> 4;
    const float lg = log2f(1.f - exp2f(-5.f - (float)h));
    {
        u32x4 v[4];
#pragma unroll
        for (int i = 0; i < 4; ++i) { const int idx = tid + 256 * i, c = idx >> 4, j = idx & 15; v[i] = *(const u32x4*)(REC + ((size_t)(n * 64 + c) * 4 + h) * 192 + 64 + j * 8); }
#pragma unroll
        for (int i = 0; i < 4; ++i) {
            const int idx = tid + 256 * i, c = idx >> 4, j = idx & 15;
            const float sc = (j < 8) ? exp2f((float)(63 - c) * lg) : 1.f;
            bf16* dst = ((j < 8) ? KT : VT) + ((j & 7) * 8) * 72 + c;
#pragma unroll
            for (int q = 0; q < 4; ++q) {
                const unsigned u = v[i][q];
                dst[(2 * q) * 72] = (j < 8) ? (bf16)f2bf(__uint_as_float(u << 16) * sc) : (bf16)(u & 0xffffu);
                dst[(2 * q + 1) * 72] = (j < 8) ? (bf16)f2bf(__uint_as_float(u & 0xffff0000u) * sc) : (bf16)(u >> 16);
            }
        }
    }
    __syncthreads();
    {
        const int dt = w;
        const bf16x8 a0 = ldfrag(KT, 72, 16 * dt, 0, lane), a1 = ldfrag(KT, 72, 16 * dt, 32, lane);
        float* out = KV + (size_t)item * 4096;
        const int s_ = dt >> 1, lane2 = 16 * (2 * (dt & 1) + (fq >> 1)) + fr;
#pragma unroll
        for (int et = 0; et < 4; ++et) {
            f32x4 acc = {0.f, 0.f, 0.f, 0.f};
            acc = mfma16(a0, ldfrag(VT, 72, 16 * et, 0, lane), acc);
            acc = mfma16(a1, ldfrag(VT, 72, 16 * et, 32, lane), acc);
            *(f32x4*)(out + ((et * 2 + s_) * 64 + lane2) * 8 + 4 * (fq & 1)) = acc;
        }
    }
    __syncthreads();
}

DEVI void retS_item(const P& p, int item) {
    const float* KV = (const float*)(p.ws + WS_RKV); bf16* RST = (bf16*)(p.ws + WS_RST);
    const int idx = item * NT + VTID;
    const int h = idx >> 12, i = idx & 4095;
    const float cd = exp2f(64.f * log2f(1.f - exp2f(-5.f - (float)h)));
    float r = 0.f;
#pragma unroll 1
    for (int n0 = 0; n0 < 256; n0 += 32) {
        float kv[32];
#pragma unroll
        for (int q = 0; q < 32; ++q) kv[q] = KV[((size_t)(n0 + q) * 4 + h) * 4096 + i];
#pragma unroll
        for (int q = 0; q < 32; ++q) { RST[((size_t)(n0 + q) * 4 + h) * 4096 + i] = (bf16)f2bf(r); r = r * cd + kv[q]; }
    }
}

DEVI void retC_item(const P& p, int item, int l, char* smem) {
    const bf16* REC = (const bf16*)(p.ws + WS_RECT); const bf16* RST = (const bf16*)(p.ws + WS_RST);
    const bf16* PROJ = (const bf16*)(p.ws + WS_PROJ); bf16* MIX = (bf16*)(p.ws + WS_MIX);
    const float* rgn = p.in[25] + l * 256; const float* rbn = p.in[26] + l * 256;
    bf16* Qs = (bf16*)smem; bf16* Ks = Qs + 64 * 72; bf16* VT = Ks + 64 * 72; bf16* Ps = VT + 64 * 72;
    const int n = item >> 2, h = item & 3;
    int tid = VTID; asm volatile("" : "+v"(tid));
    const int lane = tid & 63, w = tid >> 6, fr = lane & 15, fq = lane >> 4;
    const float lg = log2f(1.f - exp2f(-5.f - (float)h));
    {
        u32x4 v[6];
#pragma unroll
        for (int i = 0; i < 6; ++i) { const int idx = tid + 256 * i, c = idx / 24, j = idx - c * 24; v[i] = *(const u32x4*)(REC + ((size_t)(n * 64 + c) * 4 + h) * 192 + j * 8); }
#pragma unroll
        for (int i = 0; i < 6; ++i) {
            const int idx = tid + 256 * i, c = idx / 24, j = idx - c * 24;
            if (j < 16) *(u32x4*)(((j < 8) ? Qs : Ks) + c * 72 + (j & 7) * 8) = v[i];
            else {
                bf16* dst = VT + ((j & 7) * 8) * 72 + c;
#pragma unroll
                for (int q = 0; q < 4; ++q) { const unsigned u = v[i][q]; dst[(2 * q) * 72] = (bf16)(u & 0xffffu); dst[(2 * q + 1) * 72] = (bf16)(u >> 16); }
            }
        }
    }
    __syncthreads();
    const int ct = w, c = 16 * ct + fr;
    const bf16x8 q0 = ldfrag(Qs, 72, 16 * ct, 0, lane), q1 = ldfrag(Qs, 72, 16 * ct, 32, lane);
#pragma unroll
    for (int ct2 = 0; ct2 < 4; ++ct2) {
        f32x4 acc = {0.f, 0.f, 0.f, 0.f};
        acc = mfma16(ldfrag(Ks, 72, 16 * ct2, 0, lane), q0, acc);
        acc = mfma16(ldfrag(Ks, 72, 16 * ct2, 32, lane), q1, acc);
        float pv[4];
#pragma unroll
        for (int j = 0; j < 4; ++j) {
            const int c2 = 16 * ct2 + 4 * fq + j;
            pv[j] = (c >= c2) ? acc[j] * exp2f((float)(c - c2) * lg) : 0.f;
        }
        *(u32x2*)(Ps + c * 72 + 16 * ct2 + 4 * fq) = (u32x2){pk2(pv[0], pv[1]), pk2(pv[2], pv[3])};
    }
    __syncthreads();
    {
        const bf16x8 p0 = ldfrag(Ps, 72, 16 * ct, 0, lane), p1 = ldfrag(Ps, 72, 16 * ct, 32, lane);
        const float xi = exp2f((float)(c + 1) * lg);
        const bf16* RF = RST + (size_t)item * 4096;
        f32x4 o[4];
        float sm = 0.f;
        bf16x8 rfr[4][2];
#pragma unroll
        for (int et = 0; et < 4; ++et) { rfr[et][0] = *(const bf16x8*)(RF + ((et * 2 + 0) * 64 + lane) * 8); rfr[et][1] = *(const bf16x8*)(RF + ((et * 2 + 1) * 64 + lane) * 8); }
        asm volatile("" ::: "memory");
#pragma unroll
        for (int et = 0; et < 4; ++et) {
            f32x4 ai = {0.f, 0.f, 0.f, 0.f}, ax = {0.f, 0.f, 0.f, 0.f};
            ai = mfma16(ldfrag(VT, 72, 16 * et, 0, lane), p0, ai);
            ai = mfma16(ldfrag(VT, 72, 16 * et, 32, lane), p1, ai);
            ax = mfma16(rfr[et][0], q0, ax);
            ax = mfma16(rfr[et][1], q1, ax);
            o[et] = ai + ax * xi;
            sm += (o[et].x + o[et].y) + (o[et].z + o[et].w);
        }
        const float mean = quad_sum(sm) * (1.f / 64.f);
        float sv = 0.f;
#pragma unroll
        for (int et = 0; et < 4; ++et) { o[et] = o[et] - mean; sv += o[et].x * o[et].x + o[et].y * o[et].y + o[et].z * o[et].z + o[et].w * o[et].w; }
        const float rs = rsqrtf(quad_sum(sv) * (1.f / 64.f) + 1e-5f);
        const int t = n * 64 + c;
#pragma unroll
        for (int et = 0; et < 4; ++et) {
            const int e = h * 64 + 16 * et + 4 * fq;
            const f32x4 g = *(const f32x4*)(rgn + e), b = *(const f32x4*)(rbn + e);
            const f32x4 gt = ld_bf4(PROJ + (size_t)t * NPROJ + 3840 + e);
            const f32x4 y = o[et] * rs * g + b;
            *(u32x2*)(MIX + (size_t)t * D + 768 + e) = (u32x2){pk2(y.x * siluf_(gt.x), y.y * siluf_(gt.y)), pk2(y.z * siluf_(gt.z), y.w * siluf_(gt.w))};
        }
    }
    __syncthreads();
}

template <int I, int N> struct SolveRow {
    static DEVI void run(float (&x)[N], const float* M) {
        float s = 0.f;
#pragma unroll
        for (int j4 = 0; j4 < (I + 3) / 4; ++j4) {
            const f32x4 m = *(const f32x4*)(M + I * N + 4 * j4);
            s += m.x * x[4 * j4] + m.y * x[4 * j4 + 1] + m.z * x[4 * j4 + 2] + m.w * x[4 * j4 + 3];
        }
        x[I] -= s;
        asm volatile("" : "+v"(x[I]) :: "memory");
        SolveRow<I + 1, N>::run(x, M);
    }
};
template <int N> struct SolveRow<N, N> { static DEVI void run(float (&)[N], const float*) {} };

DEVI void gdnA_item(const P& p, int item, char* smem) {
    const bf16* REC = (const bf16*)(p.ws + WS_RECG); const float* GSC = (const float*)(p.ws + WS_GSC) + ((size_t)(item >> 2) * 64 * 4 + (item & 3)) * 4;
    bf16* GP = (bf16*)(p.ws + WS_GP) + (size_t)item * 16384; float* GB = (float*)(p.ws + WS_GB) + (size_t)item * 16384;
    float* GD = (float*)(p.ws + WS_GD);
    bf16* GQ = (bf16*)(p.ws + WS_GQ) + (size_t)item * 8192; float* GO = (float*)(p.ws + WS_GO) + (size_t)item * 8192;
    bf16* Kb = (bf16*)smem; bf16* Qb = Kb + 64 * 136;
    bf16* WT = (bf16*)smem; bf16* UT = WT + 128 * 72;
    bf16* Vb = (bf16*)(smem + 36864);
    float* M = (float*)(smem + 36864);
    bf16* KdT = (bf16*)(smem + 36864);
    bf16* At = (bf16*)(smem + 55296);
    float* gcs = (float*)(smem + 64512); float* bts = gcs + 64; float* sws = gcs + 128; float* sks = gcs + 192;
    const int n = item >> 2, h = item & 3;
    int tid = VTID; asm volatile("" : "+v"(tid));
    const int lane = tid & 63, w = tid >> 6, fr = lane & 15, fq = lane >> 4;
    const bf16* rec0 = REC + ((size_t)(n * 64) * 4 + h) * 392;
    if (w == 0) {
        float x = GSC[lane * 16 + 2];
#pragma unroll
        for (int off = 1; off < 64; off <<= 1) { const float y = __shfl_up(x, off); if (lane >= off) x += y; }
        const float bt = GSC[lane * 16 + 1];
        gcs[lane] = x; bts[lane] = bt; sws[lane] = bt * __expf(x); sks[lane] = __expf(__shfl(x, 63) - x);
    }
    {
        u32x4 v[12];
#pragma unroll
        for (int i = 0; i < 12; ++i) { const int idx = tid + 256 * i, c = idx / 48, j = idx - c * 48; v[i] = *(const u32x4*)(rec0 + (size_t)c * 1568 + j * 8); }
#pragma unroll
        for (int i = 0; i < 12; ++i) {
            const int idx = tid + 256 * i, c = idx / 48, j = idx - c * 48, which = j >> 4;
            const int boff = (which == 0 ? 17408 : 0) + (which == 2 ? 36864 : 0);
            *(u32x4*)(smem + boff + (c * 136 + (j & 15) * 8) * 2) = v[i];
        }
    }
    __syncthreads();
    float x[64];
    unsigned kdp[16];
    {
        const int col = tid & 127;
        int sel_b = (tid < 128) ? 36864 : 0, sel_s = (tid < 128) ? 64 : 128;
        asm volatile("" : "+v"(sel_b), "+v"(sel_s));
        const bf16* srcb = (const bf16*)(smem + sel_b) + col;
        const float* scs = gcs + sel_s;
#pragma unroll
        for (int c = 0; c < 64; ++c) {
            x[c] = scs[c] * bf2f(srcb[c * 136]);
            if ((c & 7) == 7) asm volatile("" : "+v"(x[c]) :: "memory");
        }
        const int half = tid >> 7;
#pragma unroll
        for (int i = 0; i < 16; ++i) {
            const int c = 32 * half + 2 * i;
            kdp[i] = pk2(bf2f(Kb[c * 136 + col]) * sks[c], bf2f(Kb[(c + 1) * 136 + col]) * sks[c + 1]);
            if ((i & 3) == 3) asm volatile("" : "+v"(kdp[i]) :: "memory");
        }
        if (tid == 0) GD[item] = __expf(gcs[63]);
    }
    __syncthreads();
    const int ct = w;
    f32x4 accQ[8];
    {
        const int c = 16 * ct + fr;
        const float gcc = gcs[c];
        {
            bf16x8 ka[4];
#pragma unroll
            for (int s = 0; s < 4; ++s) ka[s] = ldfrag(Kb, 136, 16 * ct, 32 * s, lane);
#pragma unroll
            for (int ct2 = 0; ct2 < 4; ++ct2) {
                f32x4 acc = {0.f, 0.f, 0.f, 0.f};
#pragma unroll
                for (int s = 0; s < 4; ++s) acc = mfma16(ka[s], ldfrag(Kb, 136, 16 * ct2, 32 * s, lane), acc);
                const int c2 = 16 * ct2 + fr; const float g2 = gcs[c2];
#pragma unroll
                for (int j = 0; j < 4; ++j) {
                    const int cc = 16 * ct + 4 * fq + j;
                    M[cc * 64 + c2] = (cc > c2) ? bts[cc] * acc[j] * __expf(gcs[cc] - g2) : 0.f;
                }
            }
        }
        {
            bf16x8 qa[4];
#pragma unroll
            for (int s = 0; s < 4; ++s) qa[s] = ldfrag(Qb, 136, 16 * ct, 32 * s, lane);
#pragma unroll
            for (int ct2 = 0; ct2 < 4; ++ct2) {
                f32x4 acc = {0.f, 0.f, 0.f, 0.f};
#pragma unroll
                for (int s = 0; s < 4; ++s) acc = mfma16(ldfrag(Kb, 136, 16 * ct2, 32 * s, lane), qa[s], acc);
                float pv[4];
#pragma unroll
                for (int j = 0; j < 4; ++j) { const int c2 = 16 * ct2 + 4 * fq + j; pv[j] = (c >= c2) ? acc[j] * __expf(gcc - gcs[c2]) : 0.f; }
                *(u32x2*)(At + c * 72 + 16 * ct2 + 4 * fq) = (u32x2){pk2(pv[0], pv[1]), pk2(pv[2], pv[3])};
            }
        }
    }
    __syncthreads();
    {
        SolveRow<1, 64>::run(x, M);
        unsigned xp[32];
#pragma unroll
        for (int q = 0; q < 32; ++q) xp[q] = pk2(x[2 * q], x[2 * q + 1]);
        {
            const int c = 16 * ct + fr;
            const float eg = __expf(gcs[c]);
#pragma unroll
            for (int dt = 0; dt < 8; ++dt) accQ[dt] = ld_bf4(Qb + c * 136 + 16 * dt + 4 * fq) * (-eg);
        }
        __syncthreads();
        int sel_d = (tid < 128) ? 128 * 72 : 0;
        asm volatile("" : "+v"(sel_d));
        bf16* dst = WT + sel_d + (tid & 127) * 72;
#pragma unroll
        for (int q = 0; q < 8; ++q) *(u32x4*)(dst + 8 * q) = (u32x4){xp[4 * q], xp[4 * q + 1], xp[4 * q + 2], xp[4 * q + 3]};
    }
    __syncthreads();
    {
        const int d = tid & 127, half = tid >> 7;
#pragma unroll
        for (int q = 0; q < 4; ++q) *(u32x4*)(KdT + d * 72 + 32 * half + 8 * q) = (u32x4){kdp[4 * q], kdp[4 * q + 1], kdp[4 * q + 2], kdp[4 * q + 3]};
    }
    __syncthreads();
    {
#pragma unroll 1
        for (int mi = 0; mi < 2; ++mi) {
            const int mt = 2 * w + mi;
            const bf16x8 kd0 = ldfrag(KdT, 72, 16 * mt, 0, lane), kd1 = ldfrag(KdT, 72, 16 * mt, 32, lane);
#pragma unroll
            for (int sp = 0; sp < 4; ++sp) {
                f32x4 a0 = {0.f, 0.f, 0.f, 0.f}, a1 = {0.f, 0.f, 0.f, 0.f};
                a0 = mfma16(ldfrag(WT, 72, 32 * sp, 0, lane), kd0, a0); a0 = mfma16(ldfrag(WT, 72, 32 * sp, 32, lane), kd1, a0);
                a1 = mfma16(ldfrag(WT, 72, 32 * sp + 16, 0, lane), kd0, a1); a1 = mfma16(ldfrag(WT, 72, 32 * sp + 16, 32, lane), kd1, a1);
                *(u32x4*)(GP + ((mt * 4 + sp) * 64 + lane) * 8) = (u32x4){pk2(-a0.x, -a0.y), pk2(-a0.z, -a0.w), pk2(-a1.x, -a1.y), pk2(-a1.z, -a1.w)};
            }
#pragma unroll
            for (int nt = 0; nt < 8; ++nt) {
                f32x4 a = {0.f, 0.f, 0.f, 0.f};
                a = mfma16(kd0, ldfrag(UT, 72, 16 * nt, 0, lane), a); a = mfma16(kd1, ldfrag(UT, 72, 16 * nt, 32, lane), a);
                *(f32x4*)(GB + ((nt * 8 + mt) * 64 + lane) * 4) = a;
            }
        }
        const bf16x8 at0 = ldfrag(At, 72, 16 * ct, 0, lane), at1 = ldfrag(At, 72, 16 * ct, 32, lane);
#pragma unroll
        for (int sp = 0; sp < 4; ++sp) {
            f32x4 a0 = accQ[2 * sp], a1 = accQ[2 * sp + 1];
            a0 = mfma16(ldfrag(WT, 72, 32 * sp, 0, lane), at0, a0); a0 = mfma16(ldfrag(WT, 72, 32 * sp, 32, lane), at1, a0);
            a1 = mfma16(ldfrag(WT, 72, 32 * sp + 16, 0, lane), at0, a1); a1 = mfma16(ldfrag(WT, 72, 32 * sp + 16, 32, lane), at1, a1);
            *(u32x4*)(GQ + ((ct * 4 + sp) * 64 + lane) * 8) = (u32x4){pk2(-a0.x, -a0.y), pk2(-a0.z, -a0.w), pk2(-a1.x, -a1.y), pk2(-a1.z, -a1.w)};
        }
#pragma unroll
        for (int et = 0; et < 8; ++et) {
            f32x4 a = {0.f, 0.f, 0.f, 0.f};
            a = mfma16(ldfrag(UT, 72, 16 * et, 0, lane), at0, a); a = mfma16(ldfrag(UT, 72, 16 * et, 32, lane), at1, a);
            *(f32x4*)(GO + ((ct * 8 + et) * 64 + lane) * 4) = a;
        }
    }
    __syncthreads();
}

DEVI bf16x8 pack_frag(const f32x4& a, const f32x4& b) {
    const u32x4 v = {pk2(a.x, a.y), pk2(a.z, a.w), pk2(b.x, b.y), pk2(b.z, b.w)};
    return __builtin_bit_cast(bf16x8, v);
}
DEVI void gdnL1_item(const P& p, int item, char* smem) {
    const bf16* GP = (const bf16*)(p.ws + WS_GP); const float* GB = (const float*)(p.ws + WS_GB); const float* GD = (const float*)(p.ws + WS_GD);
    const int half = item & 1, kind = (item >> 1) & 1, g = (item >> 2) & 15, h = item >> 6;
    const int tid = VTID, lane = tid & 63, ew = half * 4 + (tid >> 6), fr = lane & 15, fq = lane >> 4;
    const int n0 = g * 16;
#define L1_DMA(n) do { const bf16* _s = GP + ((size_t)(n) * 4 + h) * 16384 + tid * 8; char* _d = smem + ((n) & 1) * 32768 + tid * 16; \
        _Pragma("unroll") for (int _i = 0; _i < 8; ++_i) __builtin_amdgcn_global_load_lds((const unsigned*)(_s + _i * 2048), (unsigned*)(_d + _i * 4096), 16, 0, 0); } while (0)
    f32x4 acc[8];
    L1_DMA(n0);
    if (kind == 0) {
        bf16* GS = (bf16*)(p.ws + WS_GS);
#pragma unroll
        for (int m = 0; m < 8; ++m) acc[m] = (f32x4){0.f, 0.f, 0.f, 0.f};
        f32x4 bcur[8], bnxt[8]; float dcur, dnxt = 0.f;
        {
            const float* Bn = GB + ((size_t)n0 * 4 + h) * 16384 + (ew * 8 * 64 + lane) * 4;
#pragma unroll
            for (int m = 0; m < 8; ++m) bcur[m] = *(const f32x4*)(Bn + m * 256);
            dcur = GD[(size_t)n0 * 4 + h];
        }
#pragma unroll 1
        for (int n = n0; n < n0 + 16; ++n) {
            const size_t it = (size_t)n * 4 + h;
            asm volatile("s_waitcnt vmcnt(0)" ::: "memory");
            __syncthreads();
            if (n + 1 < n0 + 16) {
                L1_DMA(n + 1);
                const float* Bn = GB + (it + 4) * 16384 + (ew * 8 * 64 + lane) * 4;
#pragma unroll
                for (int m = 0; m < 8; ++m) bnxt[m] = *(const f32x4*)(Bn + m * 256);
                dnxt = GD[it + 4];
            }
            const char* ring = smem + (n & 1) * 32768 + lane * 16;
            bf16x8 sf[4];
#pragma unroll
            for (int s = 0; s < 4; ++s) {
                sf[s] = pack_frag(acc[2 * s], acc[2 * s + 1]);
                *(bf16x8*)(GS + it * 16384 + ((ew * 4 + s) * 64 + lane) * 8) = sf[s];
            }
#pragma unroll
            for (int m = 0; m < 8; ++m) {
                f32x4 a = acc[m] * dcur + bcur[m];
#pragma unroll
                for (int s = 0; s < 4; ++s) a = mfma16(*(const bf16x8*)(ring + (m * 4 + s) * 1024), sf[s], a);
                acc[m] = a;
            }
#pragma unroll
            for (int m = 0; m < 8; ++m) bcur[m] = bnxt[m];
            dcur = dnxt;
        }
        float* E0 = (float*)(p.ws + WS_GE0) + (size_t)(h * 16 + g) * 16384 + (ew * 8 * 64 + lane) * 4;
#pragma unroll
        for (int m = 0; m < 8; ++m) *(f32x4*)(E0 + m * 256) = acc[m];
    } else {
        const bf16* GQ = (const bf16*)(p.ws + WS_GQ); bf16* GR = (bf16*)(p.ws + WS_GR);
#pragma unroll
        for (int m = 0; m < 8; ++m)
#pragma unroll
            for (int j = 0; j < 4; ++j) acc[m][j] = (m == ew && 4 * fq + j == fr) ? 1.f : 0.f;
#pragma unroll 1
        for (int n = n0; n < n0 + 16; ++n) {
            const size_t it = (size_t)n * 4 + h;
            asm volatile("s_waitcnt vmcnt(0)" ::: "memory");
            __syncthreads();
            if (n + 1 < n0 + 16) L1_DMA(n + 1);
            bf16x8 qf[16];
#pragma unroll
            for (int i = 0; i < 16; ++i) qf[i] = *(const bf16x8*)(GQ + it * 8192 + (i * 64 + lane) * 8);
            const float dn = GD[it];
            const char* ring = smem + (n & 1) * 32768 + lane * 16;
            bf16x8 tf[4];
#pragma unroll
            for (int s = 0; s < 4; ++s) tf[s] = pack_frag(acc[2 * s], acc[2 * s + 1]);
#pragma unroll
            for (int m = 0; m < 8; ++m) {
                f32x4 a = acc[m] * dn;
#pragma unroll
                for (int s = 0; s < 4; ++s) a = mfma16(*(const bf16x8*)(ring + (m * 4 + s) * 1024), tf[s], a);
                acc[m] = a;
            }
#pragma unroll
            for (int tt = 0; tt < 4; ++tt) {
                f32x4 r = {0.f, 0.f, 0.f, 0.f};
#pragma unroll
                for (int s = 0; s < 4; ++s) r = mfma16(tf[s], qf[tt * 4 + s], r);
                *(u32x2*)(GR + it * 8192 + ((tt * 4 + (ew >> 1)) * 64 + lane) * 8 + 4 * (ew & 1)) = (u32x2){pk2(r.x, r.y), pk2(r.z, r.w)};
            }
        }
        bf16* TE = (bf16*)(p.ws + WS_GTE) + (size_t)(h * 16 + g) * 16384;
        const int s_ = ew >> 1, jj = 4 * (ew & 1) + (fr & 3), lg = fr >> 2;
#pragma unroll
        for (int m = 0; m < 8; ++m)
#pragma unroll
            for (int j = 0; j < 4; ++j) TE[((m * 4 + s_) * 64 + (4 * fq + j) + 16 * lg) * 8 + jj] = (bf16)f2bf(acc[m][j]);
    }
    asm volatile("s_waitcnt vmcnt(0)" ::: "memory");
    __syncthreads();
#undef L1_DMA
}
DEVI void gdnL2_item(const P& p, int item, char* smem) {
    const bf16* TE = (const bf16*)(p.ws + WS_GTE); const float* E0 = (const float*)(p.ws + WS_GE0); bf16* SG = (bf16*)(p.ws + WS_GSG);
    const int h = item >> 1, tid = VTID, lane = tid & 63, ew = (item & 1) * 4 + (tid >> 6);
#define L2_DMA(g) do { const bf16* _s = TE + ((size_t)h * 16 + (g)) * 16384 + tid * 8; char* _d = smem + ((g) & 1) * 32768 + tid * 16; \
        _Pragma("unroll") for (int _i = 0; _i < 8; ++_i) __builtin_amdgcn_global_load_lds((const unsigned*)(_s + _i * 2048), (unsigned*)(_d + _i * 4096), 16, 0, 0); } while (0)
    f32x4 acc[8];
#pragma unroll
    for (int m = 0; m < 8; ++m) acc[m] = (f32x4){0.f, 0.f, 0.f, 0.f};
    L2_DMA(0);
    f32x4 bcur[8], bnxt[8];
    {
        const float* En = E0 + (size_t)h * 16 * 16384 + (ew * 8 * 64 + lane) * 4;
#pragma unroll
        for (int m = 0; m < 8; ++m) bcur[m] = *(const f32x4*)(En + m * 256);
    }
#pragma unroll 1
    for (int g = 0; g < 16; ++g) {
        const size_t hg = (size_t)h * 16 + g;
        asm volatile("s_waitcnt vmcnt(0)" ::: "memory");
        __syncthreads();
        if (g + 1 < 16) {
            L2_DMA(g + 1);
            const float* En = E0 + (hg + 1) * 16384 + (ew * 8 * 64 + lane) * 4;
#pragma unroll
            for (int m = 0; m < 8; ++m) bnxt[m] = *(const f32x4*)(En + m * 256);
        }
        const char* ring = smem + (g & 1) * 32768 + lane * 16;
        bf16x8 sf[4];
#pragma unroll
        for (int s = 0; s < 4; ++s) {
            sf[s] = pack_frag(acc[2 * s], acc[2 * s + 1]);
            *(bf16x8*)(SG + hg * 16384 + ((ew * 4 + s) * 64 + lane) * 8) = sf[s];
        }
#pragma unroll
        for (int m = 0; m < 8; ++m) {
            f32x4 a = bcur[m];
#pragma unroll
            for (int s = 0; s < 4; ++s) a = mfma16(*(const bf16x8*)(ring + (m * 4 + s) * 1024), sf[s], a);
            acc[m] = a;
        }
#pragma unroll
        for (int m = 0; m < 8; ++m) bcur[m] = bnxt[m];
    }
    asm volatile("s_waitcnt vmcnt(0)" ::: "memory");
    __syncthreads();
#undef L2_DMA
}

DEVI void gdnC_item(const P& p, int item, int l) {
    const bf16* GQ = (const bf16*)(p.ws + WS_GQ) + (size_t)item * 8192; const float* GO = (const float*)(p.ws + WS_GO) + (size_t)item * 8192;
    const bf16* GS = (const bf16*)(p.ws + WS_GS) + (size_t)item * 16384;
    const bf16* PROJ = (const bf16*)(p.ws + WS_PROJ); bf16* MIX = (bf16*)(p.ws + WS_MIX);
    const float* gn = p.in[24] + l * 128;
    const int n = item >> 2, h = item & 3;
    const int lane = VTID & 63, ct = VTID >> 6, fr = lane & 15, fq = lane >> 4;
    const bf16* GR = (const bf16*)(p.ws + WS_GR) + (size_t)item * 8192;
    const bf16* SG = (const bf16*)(p.ws + WS_GSG) + (size_t)(h * 16 + (n >> 4)) * 16384;
    bf16x8 qf[4], rf[4];
#pragma unroll
    for (int s = 0; s < 4; ++s) { qf[s] = *(const bf16x8*)(GQ + ((ct * 4 + s) * 64 + lane) * 8); rf[s] = *(const bf16x8*)(GR + ((ct * 4 + s) * 64 + lane) * 8); }
    const int t = n * 64 + 16 * ct + fr;
    f32x4 a[8];
    float ss = 0.f;
    u32x2 zr[8]; f32x4 gv[8];
#pragma unroll
    for (int et = 0; et < 8; ++et) { zr[et] = *(const u32x2*)(PROJ + (size_t)t * NPROJ + 2560 + h * 128 + 16 * et + 4 * fq); gv[et] = *(const f32x4*)(gn + 16 * et + 4 * fq); }
#pragma unroll
    for (int e2 = 0; e2 < 4; ++e2) {
        f32x4 c0[2]; bf16x8 gs[2][4], sg[2][4];
#pragma unroll
        for (int u = 0; u < 2; ++u) {
            const int et = 2 * e2 + u;
            c0[u] = *(const f32x4*)(GO + ((ct * 8 + et) * 64 + lane) * 4);
#pragma unroll
            for (int s = 0; s < 4; ++s) { gs[u][s] = *(const bf16x8*)(GS + ((et * 4 + s) * 64 + lane) * 8); sg[u][s] = *(const bf16x8*)(SG + ((et * 4 + s) * 64 + lane) * 8); }
        }
        asm volatile("" ::: "memory");
#pragma unroll
        for (int u = 0; u < 2; ++u) {
            f32x4 acc = c0[u];
#pragma unroll
            for (int s = 0; s < 4; ++s) acc = mfma16(gs[u][s], qf[s], acc);
#pragma unroll
            for (int s = 0; s < 4; ++s) acc = mfma16(sg[u][s], rf[s], acc);
            a[2 * e2 + u] = acc;
            ss += acc.x * acc.x + acc.y * acc.y + acc.z * acc.z + acc.w * acc.w;
        }
    }
    const float rs = rsqrtf(quad_sum(ss) * (1.f / 128.f) + 1e-6f);
#pragma unroll
    for (int et = 0; et < 8; ++et) {
        const int e = 16 * et + 4 * fq;
        const f32x4 z = {__uint_as_float(zr[et].x << 16), __uint_as_float(zr[et].x & 0xffff0000u), __uint_as_float(zr[et].y << 16), __uint_as_float(zr[et].y & 0xffff0000u)};
        const f32x4 o = a[et] * rs * gv[et];
        *(u32x2*)(MIX + (size_t)t * D + 256 + h * 128 + e) = (u32x2){pk2(o.x * siluf_(z.x), o.y * siluf_(z.y)), pk2(o.z * siluf_(z.z), o.w * siluf_(z.w))};
    }
}

DEVI void rwkA_item(const P& p, int item, char* smem) {
    const bf16* REC = (const bf16*)(p.ws + WS_RECR); const float* WDEC = (const float*)(p.ws + WS_WDEC);
    bf16* WP = (bf16*)(p.ws + WS_WP) + (size_t)item * 4096; float* WC = (float*)(p.ws + WS_WC) + (size_t)item * 4096;
    float* WD = (float*)(p.ws + WS_WD) + (size_t)item * 64;
    bf16* WQ = (bf16*)(p.ws + WS_WQ) + (size_t)item * 2048; float* WY = (float*)(p.ws + WS_WY) + (size_t)item * 2048;
    bf16* At_ = (bf16*)smem; bf16* Rt = At_ + 32 * 72; bf16* Bt = Rt + 32 * 72; bf16* Kt = Bt + 32 * 72;
    float* ZT = (float*)(smem + 9216);
    bf16* BhT = (bf16*)(smem + 18432); bf16* KhT = BhT + 64 * 40; bf16* VT = KhT + 64 * 40; bf16* AhT = VT + 64 * 40; bf16* UhT = AhT + 64 * 40;
    float* M = (float*)(smem + 44032);
    bf16* Aak = (bf16*)(smem + 48128); bf16* Arb = Aak + 32 * 40; bf16* Ark = Arb + 32 * 40;
    float* tot = (float*)(smem + 55808);
    const int n = item >> 2, h = item & 3;
    int tid = VTID; asm volatile("" : "+v"(tid));
    const int lane = tid & 63, w = tid >> 6, fr = lane & 15, fq = lane >> 4;
    {
        const int d = lane;
        const bf16* rec = REC + ((size_t)(n * 32 + 8 * w) * 4 + h) * 384 + d;
        const float* dcy = WDEC + (size_t)(n * 32 + 8 * w) * 256 + h * 64 + d;
        float lw[8], lg[8];
        float run = 0.f;
        float dcv[8]; bf16 ra[8], rb[8], rk[8], rr_[8], rv[8];
#pragma unroll
        for (int i = 0; i < 8; ++i) {
            const bf16* r = rec + (size_t)i * 1536;
            dcv[i] = dcy[i * 256]; ra[i] = r[0]; rb[i] = r[128]; rk[i] = r[192]; rr_[i] = r[256]; rv[i] = r[320];
        }
        asm volatile("" ::: "memory");
#pragma unroll
        for (int i = 0; i < 8; ++i) { lg[i] = __logf(dcv[i]); run += lg[i]; lw[i] = run; }
        tot[w * 64 + d] = run;
        __syncthreads();
        float off = 0.f, total = 0.f;
#pragma unroll
        for (int q = 0; q < 4; ++q) { const float tq = tot[q * 64 + d]; total += tq; off += (q < w) ? tq : 0.f; }
        unsigned bh[4], kh[4], vv[4];
        float pb = 0.f, pk = 0.f, pv = 0.f;
#pragma unroll
        for (int i = 0; i < 8; ++i) {
            const float a = bf2f(ra[i]), b = bf2f(rb[i]), k = bf2f(rk[i]), rr = bf2f(rr_[i]), v = bf2f(rv[i]);
            const float lc = off + lw[i];
            const float cw = __expf(lc), cwm1 = __expf(lc - lg[i]), inv = __expf(-lc), rat = __expf(total - lc);
            const int t = 8 * w + i;
            At_[t * 72 + d] = (bf16)f2bf(a * cwm1); Rt[t * 72 + d] = (bf16)f2bf(rr * cw);
            Bt[t * 72 + d] = (bf16)f2bf(b * inv); Kt[t * 72 + d] = (bf16)f2bf(k * inv);
            if (i & 1) { bh[i >> 1] = pk2(pb, b * rat); kh[i >> 1] = pk2(pk, k * rat); vv[i >> 1] = pk2(pv, v); }
            else { pb = b * rat; pk = k * rat; pv = v; }
        }
        *(u32x4*)(BhT + d * 40 + 8 * w) = (u32x4){bh[0], bh[1], bh[2], bh[3]};
        *(u32x4*)(KhT + d * 40 + 8 * w) = (u32x4){kh[0], kh[1], kh[2], kh[3]};
        *(u32x4*)(VT + d * 40 + 8 * w) = (u32x4){vv[0], vv[1], vv[2], vv[3]};
        if (w == 0) WD[d] = __expf(total);
    }
    __syncthreads();
    {
        int offA = (w == 0) ? 0 : (w == 1 ? 3 : (w == 2 ? 2 : 3));
        int offB = (w == 0) ? 2 : (w == 1 ? 0 : 1);
        asm volatile("" : "+v"(offA), "+v"(offB));
        const bf16* As = At_ + offA * (32 * 72); const bf16* Bs = At_ + offB * (32 * 72);
#pragma unroll
        for (int ta = 0; ta < 2; ++ta) {
            const bf16x8 a0 = ldfrag(As, 72, 16 * ta, 0, lane), a1 = ldfrag(As, 72, 16 * ta, 32, lane);
#pragma unroll
            for (int tb = 0; tb < 2; ++tb) {
                f32x4 acc = {0.f, 0.f, 0.f, 0.f};
                acc = mfma16(a0, ldfrag(Bs, 72, 16 * tb, 0, lane), acc);
                acc = mfma16(a1, ldfrag(Bs, 72, 16 * tb, 32, lane), acc);
                if (w == 0) {
                    const int s_ = 16 * tb + fr;
#pragma unroll
                    for (int j = 0; j < 4; ++j) { const int t = 16 * ta + 4 * fq + j; M[t * 32 + s_] = (t > s_) ? -acc[j] : 0.f; }
                } else {
                    const int t = 16 * tb + fr;
                    float pv4[4];
#pragma unroll
                    for (int j = 0; j < 4; ++j) { const int s_ = 16 * ta + 4 * fq + j; pv4[j] = ((w == 1) ? (t > s_) : (t >= s_)) ? acc[j] : 0.f; }
                    int offD = w - 1; asm volatile("" : "+v"(offD));
                    *(u32x2*)(Aak + offD * (32 * 40) + t * 40 + 16 * ta + 4 * fq) = (u32x2){pk2(pv4[0], pv4[1]), pk2(pv4[2], pv4[3])};
                }
            }
        }
    }
    __syncthreads();
    {
        const int et = w;
        const bf16x8 vf = ldfrag(VT, 40, 16 * et, 0, lane);
#pragma unroll
        for (int tt = 0; tt < 2; ++tt) {
            f32x4 acc = {0.f, 0.f, 0.f, 0.f};
            acc = mfma16(ldfrag(Aak, 40, 16 * tt, 0, lane), vf, acc);
            *(f32x4*)(ZT + (16 * et + fr) * 36 + 16 * tt + 4 * fq) = acc;
        }
    }
    __syncthreads();
    if (tid < 128) {
        float x[32];
        if (tid < 64) {
#pragma unroll
            for (int t = 0; t < 32; ++t) x[t] = bf2f(At_[t * 72 + tid]);
        } else {
#pragma unroll
            for (int q = 0; q < 8; ++q) { const f32x4 z = *(const f32x4*)(ZT + (tid - 64) * 36 + 4 * q); x[4 * q] = z.x; x[4 * q + 1] = z.y; x[4 * q + 2] = z.z; x[4 * q + 3] = z.w; }
        }
        SolveRow<1, 32>::run(x, M);
        bf16* dst = AhT + tid * 40;
#pragma unroll
        for (int q = 0; q < 4; ++q)
            *(u32x4*)(dst + 8 * q) = (u32x4){pk2(x[8 * q], x[8 * q + 1]), pk2(x[8 * q + 2], x[8 * q + 3]), pk2(x[8 * q + 4], x[8 * q + 5]), pk2(x[8 * q + 6], x[8 * q + 7])};
    }
    __syncthreads();
    {
        const int mt = w;
        const bf16x8 bh = ldfrag(BhT, 40, 16 * mt, 0, lane), kh = ldfrag(KhT, 40, 16 * mt, 0, lane);
#pragma unroll
        for (int sp = 0; sp < 2; ++sp) {
            f32x4 a0 = {0.f, 0.f, 0.f, 0.f}, a1 = {0.f, 0.f, 0.f, 0.f};
            a0 = mfma16(ldfrag(AhT, 40, 32 * sp, 0, lane), bh, a0);
            a1 = mfma16(ldfrag(AhT, 40, 32 * sp + 16, 0, lane), bh, a1);
            *(u32x4*)(WP + ((mt * 2 + sp) * 64 + lane) * 8) = (u32x4){pk2(a0.x, a0.y), pk2(a0.z, a0.w), pk2(a1.x, a1.y), pk2(a1.z, a1.w)};
        }
#pragma unroll
        for (int nt = 0; nt < 4; ++nt) {
            f32x4 a = {0.f, 0.f, 0.f, 0.f};
            a = mfma16(bh, ldfrag(UhT, 40, 16 * nt, 0, lane), a);
            a = mfma16(kh, ldfrag(VT, 40, 16 * nt, 0, lane), a);
            *(f32x4*)(WC + ((nt * 4 + mt) * 64 + lane) * 4) = a;
        }
        {
            const int ct = w & 1, sp = w >> 1, t = 16 * ct + fr;
            const bf16x8 ar = ldfrag(Arb, 40, 16 * ct, 0, lane);
            f32x4 a0 = ld_bf4(Rt + t * 72 + 32 * sp + 4 * fq), a1 = ld_bf4(Rt + t * 72 + 32 * sp + 16 + 4 * fq);
            a0 = mfma16(ldfrag(AhT, 40, 32 * sp, 0, lane), ar, a0);
            a1 = mfma16(ldfrag(AhT, 40, 32 * sp + 16, 0, lane), ar, a1);
            *(u32x4*)(WQ + ((ct * 2 + sp) * 64 + lane) * 8) = (u32x4){pk2(a0.x, a0.y), pk2(a0.z, a0.w), pk2(a1.x, a1.y), pk2(a1.z, a1.w)};
        }
        {
            const int et = w;
            const bf16x8 uf = ldfrag(UhT, 40, 16 * et, 0, lane), vf = ldfrag(VT, 40, 16 * et, 0, lane);
#pragma unroll
            for (int ct = 0; ct < 2; ++ct) {
                f32x4 a = {0.f, 0.f, 0.f, 0.f};
                a = mfma16(uf, ldfrag(Arb, 40, 16 * ct, 0, lane), a);
                a = mfma16(vf, ldfrag(Ark, 40, 16 * ct, 0, lane), a);
                *(f32x4*)(WY + ((ct * 4 + et) * 64 + lane) * 4) = a;
            }
        }
    }
    __syncthreads();
}

struct RwkStep { bf16x8 pf[8]; f32x4 cf[4]; f32x4 dv[4]; };
DEVI void rwk_load(RwkStep& r, const bf16* WP, const float* WC, const float* WD, size_t it, int ew, int lane) {
#pragma unroll
    for (int i = 0; i < 8; ++i) r.pf[i] = *(const bf16x8*)(WP + it * 4096 + (i * 64 + lane) * 8);
#pragma unroll
    for (int m = 0; m < 4; ++m) r.cf[m] = *(const f32x4*)(WC + it * 4096 + ((ew * 4 + m) * 64 + lane) * 4);
#pragma unroll
    for (int m = 0; m < 4; ++m) r.dv[m] = *(const f32x4*)(WD + it * 64 + 16 * m + 4 * (lane >> 4));
}
DEVI void rwk_step(const RwkStep& r, f32x4 (&acc)[4], bf16* WSF, size_t it, int ew, int lane) {
    bf16x8 sf[2];
#pragma unroll
    for (int s = 0; s < 2; ++s) {
        const u32x4 v = {pk2(acc[2 * s].x, acc[2 * s].y), pk2(acc[2 * s].z, acc[2 * s].w), pk2(acc[2 * s + 1].x, acc[2 * s + 1].y), pk2(acc[2 * s + 1].z, acc[2 * s + 1].w)};
        *(u32x4*)(WSF + it * 4096 + ((ew * 2 + s) * 64 + lane) * 8) = v;
        sf[s] = __builtin_bit_cast(bf16x8, v);
    }
#pragma unroll
    for (int m = 0; m < 4; ++m) {
        f32x4 a = acc[m] * r.dv[m] + r.cf[m];
        a = mfma16(r.pf[m * 2], sf[0], a);
        a = mfma16(r.pf[m * 2 + 1], sf[1], a);
        acc[m] = a;
    }
}
DEVI void rwkL1_item(const P& p, int item) {
    const bf16* WP = (const bf16*)(p.ws + WS_WP); const float* WC = (const float*)(p.ws + WS_WC); const float* WD = (const float*)(p.ws + WS_WD);
    const int kind = item & 1, g = (item >> 1) & 15, h = item >> 5;
    const int lane = VTID & 63, ew = VTID >> 6, fr = lane & 15, fq = lane >> 4;
    f32x4 acc[4];
    if (kind == 0) {
        bf16* WSF = (bf16*)(p.ws + WS_WS);
#pragma unroll
        for (int m = 0; m < 4; ++m) acc[m] = (f32x4){0.f, 0.f, 0.f, 0.f};
        RwkStep A, B;
        const int n0 = g * 32;
        rwk_load(A, WP, WC, WD, (size_t)n0 * 4 + h, ew, lane);
#pragma unroll 1
        for (int n = n0; n < n0 + 32; n += 2) {
            rwk_load(B, WP, WC, WD, (size_t)(n + 1) * 4 + h, ew, lane);
            asm volatile("" ::: "memory");
            rwk_step(A, acc, WSF, (size_t)n * 4 + h, ew, lane);
            rwk_load(A, WP, WC, WD, (size_t)((n + 2 < n0 + 32) ? n + 2 : n) * 4 + h, ew, lane);
            asm volatile("" ::: "memory");
            rwk_step(B, acc, WSF, (size_t)(n + 1) * 4 + h, ew, lane);
        }
        float* E0 = (float*)(p.ws + WS_WE0) + (size_t)(h * 16 + g) * 4096 + (ew * 4 * 64 + lane) * 4;
#pragma unroll
        for (int m = 0; m < 4; ++m) *(f32x4*)(E0 + m * 256) = acc[m];
    } else {
        const bf16* WQ = (const bf16*)(p.ws + WS_WQ); bf16* WR = (bf16*)(p.ws + WS_WR);
#pragma unroll
        for (int m = 0; m < 4; ++m)
#pragma unroll
            for (int j = 0; j < 4; ++j) acc[m][j] = (m == ew && 4 * fq + j == fr) ? 1.f : 0.f;
#pragma unroll 1
        for (int n = g * 32; n < g * 32 + 32; ++n) {
            const size_t it = (size_t)n * 4 + h;
            bf16x8 pf[8], qf[4]; f32x4 dv[4];
#pragma unroll
            for (int i = 0; i < 8; ++i) pf[i] = *(const bf16x8*)(WP + it * 4096 + (i * 64 + lane) * 8);
#pragma unroll
            for (int i = 0; i < 4; ++i) qf[i] = *(const bf16x8*)(WQ + it * 2048 + (i * 64 + lane) * 8);
#pragma unroll
            for (int m = 0; m < 4; ++m) dv[m] = *(const f32x4*)(WD + it * 64 + 16 * m + 4 * fq);
            asm volatile("" ::: "memory");
            bf16x8 tf[2];
#pragma unroll
            for (int s = 0; s < 2; ++s) tf[s] = pack_frag(acc[2 * s], acc[2 * s + 1]);
#pragma unroll
            for (int tt = 0; tt < 2; ++tt) {
                f32x4 r = {0.f, 0.f, 0.f, 0.f};
                r = mfma16(tf[0], qf[tt * 2], r); r = mfma16(tf[1], qf[tt * 2 + 1], r);
                *(u32x2*)(WR + it * 2048 + ((tt * 2 + (ew >> 1)) * 64 + lane) * 8 + 4 * (ew & 1)) = (u32x2){pk2(r.x, r.y), pk2(r.z, r.w)};
            }
#pragma unroll
            for (int m = 0; m < 4; ++m) {
                f32x4 a = acc[m] * dv[m];
                a = mfma16(pf[m * 2], tf[0], a); a = mfma16(pf[m * 2 + 1], tf[1], a);
                acc[m] = a;
            }
        }
        bf16* TE = (bf16*)(p.ws + WS_WTE) + (size_t)(h * 16 + g) * 4096;
        const int s_ = ew >> 1, jj = 4 * (ew & 1) + (fr & 3), lg = fr >> 2;
#pragma unroll
        for (int m = 0; m < 4; ++m)
#pragma unroll
            for (int j = 0; j < 4; ++j) TE[((m * 2 + s_) * 64 + (4 * fq + j) + 16 * lg) * 8 + jj] = (bf16)f2bf(acc[m][j]);
    }
}
DEVI void rwkL2_item(const P& p, int h) {
    const bf16* TE = (const bf16*)(p.ws + WS_WTE); const float* E0 = (const float*)(p.ws + WS_WE0); bf16* SG = (bf16*)(p.ws + WS_WSG);
    const int lane = VTID & 63, ew = VTID >> 6;
    f32x4 acc[4];
#pragma unroll
    for (int m = 0; m < 4; ++m) acc[m] = (f32x4){0.f, 0.f, 0.f, 0.f};
#pragma unroll 1
    for (int g = 0; g < 16; ++g) {
        const size_t hg = (size_t)h * 16 + g;
        bf16x8 pf[8]; f32x4 bfr[4];
#pragma unroll
        for (int i = 0; i < 8; ++i) pf[i] = *(const bf16x8*)(TE + hg * 4096 + (i * 64 + lane) * 8);
#pragma unroll
        for (int m = 0; m < 4; ++m) bfr[m] = *(const f32x4*)(E0 + hg * 4096 + ((ew * 4 + m) * 64 + lane) * 4);
        asm volatile("" ::: "memory");
        bf16x8 sf[2];
#pragma unroll
        for (int s = 0; s < 2; ++s) {
            sf[s] = pack_frag(acc[2 * s], acc[2 * s + 1]);
            *(bf16x8*)(SG + hg * 4096 + ((ew * 2 + s) * 64 + lane) * 8) = sf[s];
        }
#pragma unroll
        for (int m = 0; m < 4; ++m) {
            f32x4 a = bfr[m];
            a = mfma16(pf[m * 2], sf[0], a); a = mfma16(pf[m * 2 + 1], sf[1], a);
            acc[m] = a;
        }
    }
}

DEVI void rwkC_item(const P& p, int n, int l) {
    const int lane = VTID & 63, h = VTID >> 6, fr = lane & 15, fq = lane >> 4;
    const size_t it = (size_t)n * 4 + h;
    const bf16* WQ = (const bf16*)(p.ws + WS_WQ) + it * 2048; const float* WY = (const float*)(p.ws + WS_WY) + it * 2048;
    const bf16* WSF = (const bf16*)(p.ws + WS_WS) + it * 4096;
    const bf16* WR = (const bf16*)(p.ws + WS_WR) + it * 2048; const bf16* WSG = (const bf16*)(p.ws + WS_WSG) + (size_t)(h * 16 + (n >> 5)) * 4096;
    const bf16* RECR = (const bf16*)(p.ws + WS_RECR); const float* GB = (const float*)(p.ws + WS_G); const float* BON = (const float*)(p.ws + WS_BON);
    bf16* MIX = (bf16*)(p.ws + WS_MIX);
    const float* ln_g = p.in[17] + l * 256 + h * 64; const float* ln_b = p.in[18] + l * 256 + h * 64;
#pragma unroll
    for (int ct = 0; ct < 2; ++ct) {
        const bf16x8 q0 = *(const bf16x8*)(WQ + ((ct * 2 + 0) * 64 + lane) * 8), q1 = *(const bf16x8*)(WQ + ((ct * 2 + 1) * 64 + lane) * 8);
        const bf16x8 r0 = *(const bf16x8*)(WR + ((ct * 2 + 0) * 64 + lane) * 8), r1 = *(const bf16x8*)(WR + ((ct * 2 + 1) * 64 + lane) * 8);
        const int t = n * 32 + 16 * ct + fr;
        f32x4 a[4];
        float sm = 0.f;
        f32x4 y0[4]; bf16x8 sfr[4][2], sgr[4][2];
#pragma unroll
        for (int et = 0; et < 4; ++et) {
            y0[et] = *(const f32x4*)(WY + ((ct * 4 + et) * 64 + lane) * 4);
#pragma unroll
            for (int s = 0; s < 2; ++s) { sfr[et][s] = *(const bf16x8*)(WSF + ((et * 2 + s) * 64 + lane) * 8); sgr[et][s] = *(const bf16x8*)(WSG + ((et * 2 + s) * 64 + lane) * 8); }
        }
        asm volatile("" ::: "memory");
#pragma unroll
        for (int et = 0; et < 4; ++et) {
            f32x4 acc = y0[et];
            acc = mfma16(sfr[et][0], q0, acc);
            acc = mfma16(sfr[et][1], q1, acc);
            acc = mfma16(sgr[et][0], r0, acc);
            acc = mfma16(sgr[et][1], r1, acc);
            a[et] = acc; sm += (acc.x + acc.y) + (acc.z + acc.w);
        }
        const float mean = quad_sum(sm) * (1.f / 64.f);
        float sv = 0.f;
#pragma unroll
        for (int et = 0; et < 4; ++et) { a[et] = a[et] - mean; sv += a[et].x * a[et].x + a[et].y * a[et].y + a[et].z * a[et].z + a[et].w * a[et].w; }
        const float rs = rsqrtf(quad_sum(sv) * (1.f / 64.f) + 64e-5f);
        const float bon = BON[(size_t)t * 4 + h];
        f32x4 gq[4], bq[4], vq[4], gateq[4];
#pragma unroll
        for (int et = 0; et < 4; ++et) {
            const int e = 16 * et + 4 * fq;
            gq[et] = *(const f32x4*)(ln_g + e); bq[et] = *(const f32x4*)(ln_b + e);
            vq[et] = ld_bf4(RECR + ((size_t)t * 4 + h) * 384 + 320 + e);
            gateq[et] = *(const f32x4*)(GB + (size_t)t * 256 + h * 64 + e);
        }
        asm volatile("" ::: "memory");
#pragma unroll
        for (int et = 0; et < 4; ++et) {
            const int e = 16 * et + 4 * fq;
            const f32x4 g = gq[et], b = bq[et];
            const f32x4 v = vq[et];
            const f32x4 gate = gateq[et];
            const f32x4 o = (a[et] * rs * g + b + v * bon) * gate;
            *(u32x2*)(MIX + (size_t)t * D + h * 64 + e) = (u32x2){pk2(o.x, o.y), pk2(o.z, o.w)};
        }
    }
}

DEVI void phase_scanL1(const P& p, char* smem) {
    for (int item = VBID; item < 448; item += VNB) {
        if (item < 256) gdnL1_item(p, item, smem);
        else if (item < 384) rwkL1_item(p, item - 256);
        else retS_item(p, item - 384);
    }
}
DEVI void retC_item(const P& p, int item, int l, char* smem);
DEVI void phase_scanL2(const P& p, int l, char* smem) {
    if (VBID < 12) { if (VBID < 8) gdnL2_item(p, VBID, smem); else rwkL2_item(p, VBID - 8); }
    else { for (int item = VBID - 12; item < 1024; item += VNB - 12) retC_item(p, item, l, smem); }
}
DEVI void phase_chunkA(const P& p, char* smem) {
    for (int item = VBID; item < 4096; item += VNB) { if (item < 1024) gdnA_item(p, item, smem); else if (item < 3072) rwkA_item(p, item - 1024, smem); else retA_item(p, item - 3072, smem); }
}
DEVI void phase_chunkC(const P& p, int l, char* smem) {
    for (int item = VBID; item < 1536; item += VNB) { if (item < 1024) gdnC_item(p, item, l); else rwkC_item(p, item - 1024, l); }
}

DEVI void phase_ln1_route(const P& p, int l, char* smem, bool commit = true) {
    const float* ADA = (const float*)(p.ws + OFF_ADA) + l * 6144;
    const float* xin = (l == 0) ? p.in[0] : (const float*)(p.ws + WS_X);
    const float* OPRE = (const float*)(p.ws + WS_OPRE);
    float* X = (float*)(p.ws + WS_X); bf16* H2 = (bf16*)(p.ws + WS_H2);
    const float* lg = p.in[28] + l * D; const float* lb = p.in[29] + l * D;
    const float* rw = p.in[30] + (size_t)l * D * 32; const float* rbias = p.in[31] + l * 32;
    int* CNT = (int*)(p.ws + OFF_CNT) + l * 32 * 64; int* LIST = (int*)(p.ws + WS_LIST); float* GATE = (float*)(p.ws + WS_GATE);
    float* HS = (float*)smem;
    float* RED = HS + 4 * 1024;
    int* SEL = (int*)(RED + 1024);
    int* RNK = SEL + 256;
    int* BASE = RNK + 256;
    int nasg = 0;
    const int tid = VTID, lane = tid & 63, w = tid >> 6;
    for (int item = VBID; item < S / 4; item += VNB) {
        const int t = item * 4 + w;
        {
            f32x4 v[4]; float s = 0.f;
#pragma unroll
            for (int j = 0; j < 4; ++j) {
                const int c = j * 256 + lane * 4;
                const f32x4 x = *(const f32x4*)(xin + (size_t)t * D + c);
                const f32x4 o = *(const f32x4*)(OPRE + (size_t)t * D + c);
                const f32x4 gt = *(const f32x4*)(ADA + 2048 + c);
                v[j].x = DN_ALPHA * x.x + (1.f + gt.x) * o.x; v[j].y = DN_ALPHA * x.y + (1.f + gt.y) * o.y;
                v[j].z = DN_ALPHA * x.z + (1.f + gt.z) * o.z; v[j].w = DN_ALPHA * x.w + (1.f + gt.w) * o.w;
                s += (v[j].x + v[j].y) + (v[j].z + v[j].w);
            }
            const float mean = wave_sum(s) * (1.f / D);
            float s2 = 0.f;
#pragma unroll
            for (int j = 0; j < 4; ++j) { v[j] = v[j] - mean; s2 += (v[j].x * v[j].x + v[j].y * v[j].y) + (v[j].z * v[j].z + v[j].w * v[j].w); }
            const float rstd = rsqrtf(wave_sum(s2) * (1.f / D) + 1e-5f);
#pragma unroll
            for (int j = 0; j < 4; ++j) {
                const int c = j * 256 + lane * 4;
                const f32x4 g = *(const f32x4*)(lg + c), b = *(const f32x4*)(lb + c);
                f32x4 xo = v[j] * rstd * g + b;
                *(f32x4*)(X + (size_t)t * D + c) = xo;
                const f32x4 sh = *(const f32x4*)(ADA + 3072 + c), sc = *(const f32x4*)(ADA + 4096 + c);
                f32x4 hh = xo * (1.f + sc) + sh;
                *(f32x4*)(HS + w * 1024 + c) = hh;
                u32x2 o; o.x = pk2(hh.x, hh.y); o.y = pk2(hh.z, hh.w);
                *(u32x2*)(H2 + (size_t)t * D + c) = o;
            }
        }
        __syncthreads();
        {
            const int e = tid & 31, ks = tid >> 5;
            float a0 = 0.f, a1 = 0.f, a2 = 0.f, a3 = 0.f;
#pragma unroll 4
            for (int k = ks * 128; k < ks * 128 + 128; k += 4) {
                const float w0 = rw[(k + 0) * 32 + e], w1 = rw[(k + 1) * 32 + e], w2 = rw[(k + 2) * 32 + e], w3 = rw[(k + 3) * 32 + e];
                const f32x4 h0 = *(const f32x4*)(HS + 0 * 1024 + k), h1 = *(const f32x4*)(HS + 1 * 1024 + k);
                const f32x4 h2 = *(const f32x4*)(HS + 2 * 1024 + k), h3 = *(const f32x4*)(HS + 3 * 1024 + k);
                a0 += h0.x * w0 + h0.y * w1 + h0.z * w2 + h0.w * w3;
                a1 += h1.x * w0 + h1.y * w1 + h1.z * w2 + h1.w * w3;
                a2 += h2.x * w0 + h2.y * w1 + h2.z * w2 + h2.w * w3;
                a3 += h3.x * w0 + h3.y * w1 + h3.z * w2 + h3.w * w3;
            }
            RED[(ks * 4 + 0) * 32 + e] = a0; RED[(ks * 4 + 1) * 32 + e] = a1; RED[(ks * 4 + 2) * 32 + e] = a2; RED[(ks * 4 + 3) * 32 + e] = a3;
        }
        __syncthreads();
        if (tid < 128) {
            const int tok = tid >> 5, e = tid & 31, tt = item * 4 + tok;
            float logit = rbias[e];
#pragma unroll
            for (int ks = 0; ks < 8; ++ks) logit += RED[(ks * 4 + tok) * 32 + e];
            bool taken = false;
            float sv[4]; int si[4];
#pragma unroll
            for (int j = 0; j < 4; ++j) {
                float cand = taken ? -3.0e38f : logit; int ci = e;
#pragma unroll
                for (int off = 16; off >= 1; off >>= 1) {
                    const float ov = __shfl_xor(cand, off, 32); const int oi = __shfl_xor(ci, off, 32);
                    if (ov > cand || (ov == cand && oi < ci)) { cand = ov; ci = oi; }
                }
                sv[j] = cand; si[j] = ci; if (ci == e) taken = true;
            }
            const float e0 = 1.f, e1 = __expf(sv[1] - sv[0]), e2 = __expf(sv[2] - sv[0]), e3 = __expf(sv[3] - sv[0]);
            const float inv = 1.f / (e0 + e1 + e2 + e3);
            const float gts[4] = {e0 * inv, e1 * inv, e2 * inv, e3 * inv};
#pragma unroll
            for (int j = 0; j < 4; ++j) {
                if (si[j] == e) {
                    SEL[nasg + tok * 4 + j] = ((tt * 4 + j) << 5) | e;
                    GATE[(size_t)tt * 4 + j] = gts[j];
                }
            }
        }
        nasg += 16;
        __syncthreads();
    }
    if (!commit) return;
    if (tid < 32) {
        int c = 0;
        for (int a = 0; a < nasg; ++a) { if ((SEL[a] & 31) == tid) { RNK[a] = c; ++c; } }
        BASE[tid] = c ? atomicAdd(&CNT[tid * 64], c) : 0;
    }
    __syncthreads();
    for (int a = tid; a < nasg; a += NT) { const int v = SEL[a], e = v & 31; LIST[(size_t)e * S + BASE[e] + RNK[a]] = v >> 5; }
    __syncthreads();
}

DEVI void phase_ln2(const P& p, int l) {
    const float* ADA = (const float*)(p.ws + OFF_ADA) + l * 6144;
    const float* ADAn = (const float*)(p.ws + OFF_ADA) + 6144;
    float* X = (float*)(p.ws + WS_X); const bf16* YB = (const bf16*)(p.ws + WS_YB);
    bf16* HB = (bf16*)(p.ws + WS_HB);
    const float* lg = p.in[36] + l * D; const float* lb = p.in[37] + l * D;
    const int tid = VTID, lane = tid & 63, w = tid >> 6;
    for (int item = VBID; item < S / 4; item += VNB) {
        const int t = item * 4 + w;
        f32x4 v[4]; float s = 0.f;
#pragma unroll
        for (int j = 0; j < 4; ++j) {
            const int c = j * 256 + lane * 4;
            const f32x4 x = *(const f32x4*)(X + (size_t)t * D + c);
            f32x4 f = {0.f, 0.f, 0.f, 0.f};
#pragma unroll
            for (int q = 0; q < 4; ++q) {
                const u32x2 y = *(const u32x2*)(YB + ((size_t)t * 4 + q) * D + c);
                f.x += __uint_as_float(y.x << 16); f.y += __uint_as_float(y.x & 0xffff0000u);
                f.z += __uint_as_float(y.y << 16); f.w += __uint_as_float(y.y & 0xffff0000u);
            }
            const f32x4 gt = *(const f32x4*)(ADA + 5120 + c);
            v[j] = x * DN_ALPHA + (gt + 1.f) * f;
            s += (v[j].x + v[j].y) + (v[j].z + v[j].w);
        }
        const float mean = wave_sum(s) * (1.f / D);
        float s2 = 0.f;
#pragma unroll
        for (int j = 0; j < 4; ++j) { v[j] = v[j] - mean; s2 += (v[j].x * v[j].x + v[j].y * v[j].y) + (v[j].z * v[j].z + v[j].w * v[j].w); }
        const float rstd = rsqrtf(wave_sum(s2) * (1.f / D) + 1e-5f);
#pragma unroll
        for (int j = 0; j < 4; ++j) {
            const int c = j * 256 + lane * 4;
            const f32x4 g = *(const f32x4*)(lg + c), b = *(const f32x4*)(lb + c);
            const f32x4 xo = v[j] * rstd * g + b;
            if (l == 0) {
                *(f32x4*)(X + (size_t)t * D + c) = xo;
                const f32x4 sh = *(const f32x4*)(ADAn + c), sc = *(const f32x4*)(ADAn + 1024 + c);
                const f32x4 hh = xo * (sc + 1.f) + sh;
                u32x2 o; o.x = pk2(hh.x, hh.y); o.y = pk2(hh.z, hh.w);
                *(u32x2*)(HB + (size_t)t * D + c) = o;
            } else {
                *(f32x4*)(p.out + (size_t)t * D + c) = xo;
            }
        }
    }
}

namespace pg8 {
constexpr int BK = 64, HALF = 128, HTB = HALF * BK * 2, STAGE_BYTES = 8 * HTB;
DEVI int lds_byte(int r, int c) { const int st = (r >> 4) * 2 + (c >> 5), rr = r & 15, cc = c & 31, ob = rr * 64 + cc * 2; return st * 1024 + (ob ^ (((ob >> 9) & 1) << 5)); }
DEVI void stage_rc(int b, int& R, int& C) { const int st = b / 1024, sb = b % 1024, swz = sb ^ (((sb >> 9) & 1) << 5); R = (st >> 1) * 16 + swz / 64; C = (st & 1) * 32 + (swz % 64) / 2; }
struct Unit { const char* a; const char* b; int x0, x1, x2, x3; };

template <class Epi, class Sched>
DEVI void gemm_phase(LAS unsigned char* lds, const int K, const Sched& S, const Epi& E) {
    const int tid = threadIdx.x, wid = __builtin_amdgcn_readfirstlane(tid >> 6), lane = tid & 63, wr = wid >> 2, wc = wid & 3, fr = lane & 15, fq = lane >> 4;
    const int nt = K / BK;
    unsigned voffA[2], voffB[2];
    int gR[2], gC[2];
#pragma unroll
    for (int i = 0; i < 2; ++i) { int R, C; stage_rc(tid * 16 + i * 8192, R, C); gR[i] = R; gC[i] = C; voffA[i] = (unsigned)(R * K + C) * 2u; voffB[i] = (unsigned)(Epi::brow(R) * K + C) * 2u; }
    unsigned co[2][2], no[2][2];
#define PG8_GOFF(dst, tab) do { _Pragma("unroll") for (int _h = 0; _h < 2; ++_h) _Pragma("unroll") for (int _i = 0; _i < 2; ++_i) \
        dst[_h][_i] = (unsigned)((tab)[_h * 128 + gR[_i]] * K + gC[_i]) * 2u; } while (0)
    const size_t kstep = (size_t)(BK * 2);
    const size_t hstepA = (size_t)HALF * K * 2, hstepB = (size_t)Epi::BHALF * K * 2;
    const unsigned ldsw = (unsigned)wid * 1024u;
    const int aoff = lds_byte(wr * 64 + fr, fq * 8), boff = lds_byte(wc * 32 + fr, fq * 8);
#define PG8_SA(b, h) (((b) * 2 + (h)) * HTB)
#define PG8_SB(b, h) ((4 + (b) * 2 + (h)) * HTB)
#define PG8_STAGE(bufoff, gbase, voff) do { _Pragma("unroll") for (int _i = 0; _i < 2; ++_i) \
        __builtin_amdgcn_global_load_lds((const unsigned*)((const char*)(gbase) + (voff)[_i]), (LAS unsigned*)(lds + (bufoff) + ldsw + _i * 8192), 16, 0, 0); } while (0)
#define PG8_LDA(dst, b, h) do { _Pragma("unroll") for (int m = 0; m < 4; ++m) _Pragma("unroll") for (int k = 0; k < 2; ++k) dst[m][k] = *(const LAS bf16x8*)(lds + PG8_SA(b, h) + aoff + m * 2048 + k * 1024); } while (0)
#define PG8_LDB(dst, b, h) do { _Pragma("unroll") for (int n = 0; n < 2; ++n) _Pragma("unroll") for (int k = 0; k < 2; ++k) dst[n][k] = *(const LAS bf16x8*)(lds + PG8_SB(b, h) + boff + n * 2048 + k * 1024); } while (0)
#define PG8_MMA(ai, bj, At, Bt) do { __builtin_amdgcn_s_setprio(1); _Pragma("unroll") for (int m = 0; m < 4; ++m) _Pragma("unroll") for (int n = 0; n < 2; ++n) _Pragma("unroll") for (int k = 0; k < 2; ++k) \
        acc[ai][bj][m][n] = __builtin_amdgcn_mfma_f32_16x16x32_bf16(Bt[n][k], At[m][k], acc[ai][bj][m][n], 0, 0, 0); __builtin_amdgcn_s_setprio(0); } while (0)
#define PG8_WAIT_V(n) asm volatile("s_waitcnt vmcnt(" #n ")" ::: "memory")
#define PG8_WAIT_L(n) asm volatile("s_waitcnt lgkmcnt(" #n ")" ::: "memory")
#define PG8_BAR __builtin_amdgcn_s_barrier()
#define PG8_SCHED __builtin_amdgcn_sched_barrier(0)
    Unit cur, nxt; int ui = 0;
    if (!S.next(0, cur)) return;
    f32x4 acc[2][2][4][2];
#pragma unroll
    for (int a = 0; a < 2; ++a)
#pragma unroll
        for (int b = 0; b < 2; ++b)
#pragma unroll
            for (int m = 0; m < 4; ++m)
#pragma unroll
                for (int n = 0; n < 2; ++n) acc[a][b][m][n] = (f32x4){0.f, 0.f, 0.f, 0.f};
    bf16x8 At[4][2], B0[2][2], B1[2][2];
    const char* cA = cur.a; const char* cB = cur.b;
    if constexpr (Epi::GATHER_A) { PG8_GOFF(co, S.rows(0)); PG8_WAIT_L(0); }
    else {
#pragma unroll
        for (int i = 0; i < 2; ++i) { co[0][i] = voffA[i]; co[1][i] = voffA[i] + (unsigned)hstepA; no[0][i] = co[0][i]; no[1][i] = co[1][i]; }
    }
    PG8_WAIT_V(0);
    PG8_STAGE(PG8_SB(0, 0), cB, voffB); PG8_STAGE(PG8_SA(0, 0), cA, co[0]); PG8_STAGE(PG8_SB(0, 1), cB + hstepB, voffB); PG8_STAGE(PG8_SA(0, 1), cA, co[1]);
    if (wr == 1) PG8_BAR;
    PG8_WAIT_V(4); PG8_BAR;
    PG8_STAGE(PG8_SB(1, 0), cB + kstep, voffB); PG8_STAGE(PG8_SA(1, 0), cA + kstep, co[0]); PG8_STAGE(PG8_SB(1, 1), cB + hstepB + kstep, voffB);
    PG8_WAIT_V(6); PG8_BAR;
    for (;;) {
        const bool has_next = S.next(ui + 1, nxt);
        const char* nA = has_next ? nxt.a : cA; const char* nB = has_next ? nxt.b : cB;
        if constexpr (Epi::GATHER_A) { if (has_next) PG8_GOFF(no, S.rows(ui + 1)); else { no[0][0] = co[0][0]; no[0][1] = co[0][1]; no[1][0] = co[1][0]; no[1][1] = co[1][1]; } }
        for (int t = 0; t < nt; t += 2) {
            const bool last = (t == nt - 2);
            const char* a1 = cA + (size_t)(t + 1) * kstep;
            const char* a2 = last ? nA : cA + (size_t)(t + 2) * kstep; const char* b2 = last ? nB : cB + (size_t)(t + 2) * kstep;
            const char* a3 = a2 + kstep; const char* b3 = b2 + kstep;
            unsigned fo[2][2];
#pragma unroll
            for (int h = 0; h < 2; ++h)
#pragma unroll
                for (int i = 0; i < 2; ++i) fo[h][i] = last ? no[h][i] : co[h][i];
            PG8_LDB(B0, 0, 0); PG8_SCHED; PG8_LDA(At, 0, 0); PG8_STAGE(PG8_SA(1, 1), a1, co[1]);
            PG8_WAIT_L(8); PG8_BAR; PG8_WAIT_L(0); PG8_MMA(0, 0, At, B0); PG8_BAR; PG8_SCHED;
            PG8_LDB(B1, 0, 1); PG8_STAGE(PG8_SB(0, 0), b2, voffB);
            PG8_BAR; PG8_WAIT_L(0); PG8_MMA(0, 1, At, B1); PG8_BAR;
            PG8_LDA(At, 0, 1); PG8_STAGE(PG8_SA(0, 0), a2, fo[0]);
            PG8_BAR; PG8_WAIT_L(0); PG8_MMA(1, 0, At, B0); PG8_BAR; PG8_SCHED;
            PG8_STAGE(PG8_SB(0, 1), b2 + hstepB, voffB);
            PG8_WAIT_V(6); PG8_BAR; PG8_MMA(1, 1, At, B1); PG8_BAR;
            PG8_LDB(B0, 1, 0); PG8_SCHED; PG8_LDA(At, 1, 0); PG8_STAGE(PG8_SA(0, 1), a2, fo[1]);
            PG8_WAIT_L(8); PG8_BAR; PG8_WAIT_L(0); PG8_MMA(0, 0, At, B0); PG8_BAR; PG8_SCHED;
            PG8_LDB(B1, 1, 1); PG8_STAGE(PG8_SB(1, 0), b3, voffB);
            PG8_BAR; PG8_WAIT_L(0); PG8_MMA(0, 1, At, B1); PG8_BAR;
            PG8_LDA(At, 1, 1); PG8_STAGE(PG8_SA(1, 0), a3, fo[0]);
            PG8_BAR; PG8_WAIT_L(0); PG8_MMA(1, 0, At, B0); PG8_BAR; PG8_SCHED;
            PG8_STAGE(PG8_SB(1, 1), b3 + hstepB, voffB);
            PG8_WAIT_V(6); PG8_BAR; PG8_MMA(1, 1, At, B1); PG8_BAR;
        }
        E(acc, cur, wr, wc, fr, fq);
        if (!has_next) break;
#pragma unroll
        for (int a = 0; a < 2; ++a)
#pragma unroll
            for (int b = 0; b < 2; ++b)
#pragma unroll
                for (int m = 0; m < 4; ++m)
#pragma unroll
                    for (int n = 0; n < 2; ++n) acc[a][b][m][n] = (f32x4){0.f, 0.f, 0.f, 0.f};
        cur = nxt; cA = nA; cB = nB; ++ui;
#pragma unroll
        for (int h = 0; h < 2; ++h) { co[h][0] = no[h][0]; co[h][1] = no[h][1]; }
    }
    PG8_WAIT_V(0);
    if (wr == 0) PG8_BAR;
    PG8_BAR;
#undef PG8_SA
#undef PG8_GOFF
#undef PG8_SB
#undef PG8_STAGE
#undef PG8_LDA
#undef PG8_LDB
#undef PG8_MMA
#undef PG8_WAIT_V
#undef PG8_WAIT_L
#undef PG8_BAR
#undef PG8_SCHED
}
}

struct SchedDense {
    const char* A; const char* B; int K; int mode;
    DEVI const int* rows(int) const { return nullptr; }
    DEVI bool next(int i, pg8::Unit& u) const {
        const int c = blockIdx.x, x = c & 7; int pm, pn;
        if (mode == 0) { if (i > 0) return false; pn = x & 3; pm = (c >> 3) * 2 + (x >> 2); }
        else { if (i > 3) return false; pn = x + 8 * (i & 1); pm = (c >> 3) + 32 * (i >> 1); }
        u.a = A + (size_t)pm * 256 * K * 2; u.b = B + (size_t)pn * 256 * K * 2; u.x0 = pm; u.x1 = pn; u.x2 = 0; u.x3 = 0;
        return true;
    }
};
struct EpiOutF32 {
    static constexpr bool GATHER_A = false; static constexpr int BHALF = 128; static DEVI int brow(int R) { return R; }
    float* C;
    DEVI void operator()(const f32x4 (&acc)[2][2][4][2], const pg8::Unit& u, int wr, int wc, int fr, int fq) const {
#pragma unroll
        for (int ai = 0; ai < 2; ++ai)
#pragma unroll
            for (int m = 0; m < 4; ++m) {
                float* rowp = C + (size_t)(u.x0 * 256 + ai * 128 + wr * 64 + m * 16 + fr) * D + u.x1 * 256 + wc * 32 + 4 * fq;
#pragma unroll
                for (int bj = 0; bj < 2; ++bj)
#pragma unroll
                    for (int n = 0; n < 2; ++n) *(f32x4*)(rowp + bj * 128 + n * 16) = acc[ai][bj][m][n];
            }
    }
};
struct EpiProjBf16 {
    static constexpr bool GATHER_A = false; static constexpr int BHALF = 128; static DEVI int brow(int R) { return R; }
    bf16* C;
    DEVI void operator()(const f32x4 (&acc)[2][2][4][2], const pg8::Unit& u, int wr, int wc, int fr, int fq) const {
#pragma unroll
        for (int ai = 0; ai < 2; ++ai)
#pragma unroll
            for (int m = 0; m < 4; ++m) {
                bf16* rowp = C + (size_t)(u.x0 * 256 + ai * 128 + wr * 64 + m * 16 + fr) * NPROJ + u.x1 * 256 + wc * 32 + 4 * fq;
#pragma unroll
                for (int bj = 0; bj < 2; ++bj)
#pragma unroll
                    for (int n = 0; n < 2; ++n) { const f32x4 v = acc[ai][bj][m][n]; *(u32x2*)(rowp + bj * 128 + n * 16) = (u32x2){pk2(v.x, v.y), pk2(v.z, v.w)}; }
            }
    }
};
DEVI void phase_outproj8(const P& p, int l, char* smem_all) {
    SchedDense Sd{(const char*)(p.ws + WS_MIX), (const char*)(p.ws + WS_WOUT) + (size_t)l * D * D * 2, D, 0};
    EpiOutF32 E{(float*)(p.ws + WS_OPRE)};
    pg8::gemm_phase(( LAS unsigned char*)smem_all, D, Sd, E);
}
DEVI void phase_inproj8(const P& p, int l, char* smem_all) {
    SchedDense Sd{(const char*)(p.ws + WS_HB), (const char*)(p.ws + WS_WIN) + (size_t)l * NPAD * D * 2, D, 1};
    EpiProjBf16 E{(bf16*)(p.ws + WS_PROJ)};
    pg8::gemm_phase((LAS unsigned char*)smem_all, D, Sd, E);
}
DEVI void phase_inproj_extras(const P& p, int l, char* smem) {
    const bf16* HB = (const bf16*)(p.ws + WS_HB);
    const bf16* W = (const bf16*)(p.ws + WS_WIN) + (size_t)l * NPAD * D;
    float* PEX = (float*)(p.ws + WS_PEX);
    const int lane = VTID & 63, wid = VTID >> 6, wr = wid >> 1, wc = wid & 1, fr = lane & 15, fq = lane >> 4;
    for (int mt = VBID; mt < S / 128; mt += VNB) {
        f32x4 acc[4][8];
        gemm_tile(smem, HB, [&](int r) { return (unsigned)((mt * 128 + r) * D); }, W, [&](int r) { return (unsigned)((16 * 256 + r) * D); }, D, acc);
        if (wc == 0) {
#pragma unroll
            for (int m = 0; m < 4; ++m) {
                const int tok = mt * 128 + wr * 64 + m * 16 + fr;
#pragma unroll
                for (int n = 0; n < 4; ++n) *(f32x4*)(PEX + (size_t)tok * 64 + n * 16 + fq * 4) = acc[m][n];
            }
        }
    }
}

struct MoeMap8 { int cnt[32]; int off[32]; int tstart[33]; };
DEVI void moe_map8(const P& p, int l, MoeMap8* mm) {
    const int* CNT = (const int*)(p.ws + OFF_CNT) + l * 32 * 64;
    if (threadIdx.x < 32) mm->cnt[threadIdx.x] = __hip_atomic_load(&CNT[threadIdx.x * 64], __ATOMIC_RELAXED, __HIP_MEMORY_SCOPE_AGENT);
    __syncthreads();
    if (threadIdx.x == 0) {
        int o = 0, ts = 0;
        for (int e = 0; e < 32; ++e) { mm->off[e] = o; mm->tstart[e] = ts; o += mm->cnt[e]; ts += (mm->cnt[e] + 255) / 256; }
        mm->tstart[32] = ts;
    }
    __syncthreads();
}
struct MoeUnits { int n; int pad[3]; int e[32]; int m0[32]; int pn[32]; };
struct SchedMoe {
    const MoeMap8* mm; const MoeUnits* mu; const char* A; const char* Bw; int K;
    size_t bexp, bpn;
    const int* rowtab; bool gather;
    DEVI const int* rows(int i) const { return rowtab + 256 * i; }
    DEVI bool next(int i, pg8::Unit& u) const {
        if (i >= mu->n) return false;
        const int e = mu->e[i], m0 = mu->m0[i], pn = mu->pn[i], off = mm->off[e];
        u.a = gather ? A : A + (size_t)(off + m0) * K * 2; u.b = Bw + (size_t)e * bexp + (size_t)pn * bpn;
        u.x0 = e; u.x1 = m0; u.x2 = pn; u.x3 = off;
        return true;
    }
};
DEVI void moe_units(const MoeMap8* mm, MoeUnits* mu, int npn_log) {
    if (threadIdx.x < 32) {
        const int L = (int)threadIdx.x * 256 + (int)blockIdx.x, total = mm->tstart[32] << npn_log;
        if (L < total) {
            const int pn = L & ((1 << npn_log) - 1), rt = L >> npn_log;
            int e = 0;
            while (mm->tstart[e + 1] <= rt) ++e;
            mu->e[threadIdx.x] = e; mu->m0[threadIdx.x] = (rt - mm->tstart[e]) * 256; mu->pn[threadIdx.x] = pn;
        }
        if (threadIdx.x == 0) { const int mine = total > (int)blockIdx.x ? (total - (int)blockIdx.x + 255) >> 8 : 0; mu->n = mine < 32 ? mine : 32; }
    }
    __syncthreads();
}
struct EpiMoeUp {
    static constexpr bool GATHER_A = true;
    static constexpr int BHALF = 64;
    static DEVI int brow(int R) { return ((R >> 5) & 3) * 16 + (R & 15) + (((R >> 4) & 1) ? 1024 : 0); }
    const MoeMap8* mm; bf16* ACT; const float* bup; bf16* dump;
    DEVI void operator()(const f32x4 (&acc)[2][2][4][2], const pg8::Unit& u, int wr, int wc, int fr, int fq) const {
        const int e = u.x0, cnt = mm->cnt[e];
        const float* be = bup + (size_t)e * 2048;
        f32x4 bg[2], bl[2];
#pragma unroll
        for (int bj = 0; bj < 2; ++bj) { const int col = u.x2 * 128 + (bj * 4 + wc) * 16 + 4 * fq; bg[bj] = *(const f32x4*)(be + col); bl[bj] = *(const f32x4*)(be + 1024 + col); }
#pragma unroll
        for (int ai = 0; ai < 2; ++ai)
#pragma unroll
            for (int m = 0; m < 4; ++m) {
                const int r = u.x1 + ai * 128 + wr * 64 + m * 16 + fr;
                bf16* rowp = (r < cnt) ? ACT + (size_t)(u.x3 + r) * DFF + u.x2 * 128 + wc * 16 + 4 * fq : dump + 4 * fq;
#pragma unroll
                for (int bj = 0; bj < 2; ++bj) {
                    float o[4];
#pragma unroll
                    for (int j = 0; j < 4; ++j) {
                        const float glu = fminf(acc[ai][bj][m][0][j] + bg[bj][j], 7.f);
                        const float lin = fminf(fmaxf(acc[ai][bj][m][1][j] + bl[bj][j], -7.f), 7.f);
                        o[j] = glu * sigmoidf_(1.702f * glu) * (lin + 1.f);
                    }
                    *(u32x2*)(rowp + bj * 64) = (u32x2){pk2(o[0], o[1]), pk2(o[2], o[3])};
                }
            }
    }
};
struct EpiMoeDown {
    static constexpr bool GATHER_A = false; static constexpr int BHALF = 128; static DEVI int brow(int R) { return R; }
    const MoeMap8* mm; bf16* YB; const float* bdn; const int* LIST; const float* GATE; bf16* dump;
    DEVI void operator()(const f32x4 (&acc)[2][2][4][2], const pg8::Unit& u, int wr, int wc, int fr, int fq) const {
        const int e = u.x0, cnt = mm->cnt[e];
        const float* be = bdn + (size_t)e * D + u.x2 * 256 + wc * 32 + 4 * fq;
        f32x4 bv[2][2];
#pragma unroll
        for (int bj = 0; bj < 2; ++bj)
#pragma unroll
            for (int n = 0; n < 2; ++n) bv[bj][n] = *(const f32x4*)(be + bj * 128 + n * 16);
        int ent[8]; float gt[8];
#pragma unroll
        for (int q = 0; q < 8; ++q) { const int r = u.x1 + (q >> 2) * 128 + wr * 64 + (q & 3) * 16 + fr; ent[q] = LIST[(size_t)e * S + (r < cnt ? r : cnt - 1)]; }
#pragma unroll
        for (int q = 0; q < 8; ++q) gt[q] = GATE[ent[q]];
#pragma unroll
        for (int ai = 0; ai < 2; ++ai)
#pragma unroll
            for (int m = 0; m < 4; ++m) {
                const int q = ai * 4 + m, r = u.x1 + ai * 128 + wr * 64 + m * 16 + fr;
                bf16* rowp = (r < cnt) ? YB + (size_t)ent[q] * D + u.x2 * 256 + wc * 32 + 4 * fq : dump + 4 * fq;
#pragma unroll
                for (int bj = 0; bj < 2; ++bj)
#pragma unroll
                    for (int n = 0; n < 2; ++n) {
                        const f32x4 v = (acc[ai][bj][m][n] + bv[bj][n]) * gt[q];
                        *(u32x2*)(rowp + bj * 128 + n * 16) = (u32x2){pk2(v.x, v.y), pk2(v.z, v.w)};
                    }
            }
    }
};
DEVI void phase_moe_up8(const P& p, int l, char* smem_all) {
    MoeMap8* mm = (MoeMap8*)(smem_all + 131072);
    moe_map8(p, l, mm);
    MoeUnits* mu = (MoeUnits*)(smem_all + 131072 + 512);
    moe_units(mm, mu, 3);
    int* rowtab = (int*)(smem_all + 131072 + 1024);
    {
        const int* LIST = (const int*)(p.ws + WS_LIST);
        const int nu = mu->n < 12 ? mu->n : 12;
        for (int idx = threadIdx.x; idx < nu * 256; idx += KT) {
            const int i = idx >> 8, r = idx & 255, e = mu->e[i], cnt = mm->cnt[e], rr = mu->m0[i] + r;
            rowtab[idx] = LIST[(size_t)e * S + (rr < cnt ? rr : cnt - 1)] >> 2;
        }
        __syncthreads();
    }
    SchedMoe Sm{mm, mu, (const char*)(p.ws + WS_H2), (const char*)(p.ws + WS_WUP) + (size_t)l * NEXP * 2048 * D * 2, D, (size_t)2048 * D * 2, (size_t)128 * D * 2, rowtab, true};
    EpiMoeUp E{mm, (bf16*)(p.ws + WS_ACT), p.in[33] + (size_t)l * NEXP * 2048, (bf16*)(p.ws + WS_DUMP)};
    pg8::gemm_phase((LAS unsigned char*)smem_all, D, Sm, E);
}
DEVI void phase_moe_down8(const P& p, int l, char* smem_all) {
    MoeMap8* mm = (MoeMap8*)(smem_all + 131072);
    moe_map8(p, l, mm);
    MoeUnits* mu = (MoeUnits*)(smem_all + 131072 + 512);
    moe_units(mm, mu, 2);
    SchedMoe Sm{mm, mu, (const char*)(p.ws + WS_ACT), (const char*)(p.ws + WS_WDN) + (size_t)l * NEXP * D * DFF * 2, DFF, (size_t)D * DFF * 2, (size_t)256 * DFF * 2, nullptr, false};
    EpiMoeDown E{mm, (bf16*)(p.ws + WS_YB), p.in[35] + (size_t)l * NEXP * D, (const int*)(p.ws + WS_LIST), (const float*)(p.ws + WS_GATE), (bf16*)(p.ws + WS_DUMP)};
    pg8::gemm_phase((LAS unsigned char*)smem_all, DFF, Sm, E);
}

constexpr int NPHASE = 24;
constexpr int LDS_TOTAL = 2 * VB_LDS + 64;
__global__ void __launch_bounds__(KT, 2) k_run(P p) {
    extern __shared__ __attribute__((aligned(16))) char smem_all[];
    char* smem = smem_all + __builtin_amdgcn_readfirstlane((int)(threadIdx.x >> 8)) * VB_LDS;
    XcdBarrier bar; bar.bar = nullptr; bar.x = 0; bar.st = nullptr;
    const bool multi = (p.ph_hi - p.ph_lo) > 1;
    if (multi) {
        volatile LAS unsigned* st = (volatile LAS unsigned*)(smem_all + 2 * VB_LDS);
        if (threadIdx.x == 0) { st[0] = 0u; st[1] = 0u; }
        __syncthreads();
        bar = xcd_barrier_post((unsigned*)(p.ws + OFF_BAR), st);
    }
#ifndef DUP
#define DUP -1
#endif
#ifndef DUP2
#define DUP2 -1
#endif
#define RUN(k, call) if (p.ph_lo <= (k) && (k) < p.ph_hi) { for (int _rep = ((k) == DUP || (k) == DUP2) ? 2 : 1; _rep > 0; --_rep) { call; if (multi && ((k) + 1 < p.ph_hi || _rep > 1)) xcd_barrier(bar); } }
    RUN(0, phase_prep(p, smem))
    RUN(1, phase_h0(p))
    RUN(2, { phase_inproj8(p, 0, smem_all); phase_inproj_extras(p, 0, smem); })
    RUN(3, phase_mixprep(p, 0, smem))
    RUN(4, phase_chunkA(p, smem))
    RUN(5, phase_scanL1(p, smem))
    RUN(6, phase_scanL2(p, 0, smem))
    RUN(7, phase_chunkC(p, 0, smem))
    RUN(8, phase_outproj8(p, 0, smem_all))
    RUN(9, phase_ln1_route(p, 0, smem, _rep == 1))
    RUN(10, phase_moe_up8(p, 0, smem_all))
    RUN(11, phase_moe_down8(p, 0, smem_all))
    RUN(12, phase_ln2(p, 0))
    RUN(13, { phase_inproj8(p, 1, smem_all); phase_inproj_extras(p, 1, smem); })
    RUN(14, phase_mixprep(p, 1, smem))
    RUN(15, phase_chunkA(p, smem))
    RUN(16, phase_scanL1(p, smem))
    RUN(17, phase_scanL2(p, 1, smem))
    RUN(18, phase_chunkC(p, 1, smem))
    RUN(19, phase_outproj8(p, 1, smem_all))
    RUN(20, phase_ln1_route(p, 1, smem))
    RUN(21, phase_moe_up8(p, 1, smem_all))
    RUN(22, phase_moe_down8(p, 1, smem_all))
    RUN(23, phase_ln2(p, 1))
#undef RUN
}

extern "C" void kernel_launch(void* const* d_in, const int* in_sizes, int n_in, void* d_out, int out_size, void* d_ws, size_t ws_size,
                              hipStream_t stream) {
    static int grid = 0;
    if (grid == 0) {
        if (n_in != 38 || ws_size < WS_END) { fprintf(stderr, "kernel_launch: unexpected n_in %d or ws_size %zu (< %zu)\n", n_in, ws_size, (size_t)WS_END); grid = -1; return; }
        int dev = 0, cus = 0, per_cu = 0;
        hipGetDevice(&dev);
        hipDeviceGetAttribute(&cus, hipDeviceAttributeMultiprocessorCount, dev);
        hipFuncSetAttribute((const void*)k_run, hipFuncAttributeMaxDynamicSharedMemorySize, LDS_TOTAL);
        hipOccupancyMaxActiveBlocksPerMultiprocessor(&per_cu, (const void*)k_run, KT, LDS_TOTAL);
        if (per_cu < 1) { fprintf(stderr, "kernel_launch: occupancy query returned %d\n", per_cu); grid = -1; return; }
        if (cus != 256) { fprintf(stderr, "kernel_launch: built for 256 CUs (one workgroup per CU), device has %d\n", cus); grid = -1; return; }
        grid = cus;
    }
    if (grid < 0) return;
    hipMemsetAsync((char*)d_ws + WS_CTL, 0, CTL_BYTES, stream);
    P p{};
    for (int i = 0; i < 38; ++i) p.in[i] = (const float*)d_in[i];
    p.pos = (const int*)d_in[2];
    p.out = (float*)d_out; p.ws = (char*)d_ws;
#if MEGA
    p.ph_lo = 0; p.ph_hi = NPHASE;
    void* args[] = {&p};
    hipError_t e = hipLaunchCooperativeKernel((const void*)k_run, dim3(grid), dim3(KT), args, LDS_TOTAL, stream);
    if (e != hipSuccess) fprintf(stderr, "cooperative launch failed: %s (grid %d)\n", hipGetErrorString(e), grid);
#else
    for (int ph = 0; ph < NPHASE; ++ph) {
        p.ph_lo = ph; p.ph_hi = ph + 1;
        hipLaunchKernelGGL(k_run, dim3(grid), dim3(KT), LDS_TOTAL, stream, p);
    }
#endif
}
```

```cpp
#include <hip/hip_runtime.h>
#include <hip/hip_bf16.h>
#include <stdint.h>
#include <stdio.h>

#ifndef MEGA
#define MEGA 1
#endif

#define DEVI __device__ __forceinline__
#define LAS __attribute__((address_space(3)))

typedef unsigned short bf16;
typedef short bf16x8 __attribute__((ext_vector_type(8)));
typedef float f32x4 __attribute__((ext_vector_type(4)));
typedef unsigned u32x4 __attribute__((ext_vector_type(4)));
typedef unsigned u32x2 __attribute__((ext_vector_type(2)));

constexpr int S = 16384, D = 1024, NIN = 4104, NEXP = 32, DFF = 1024;
constexpr int NPROJ = 4096;
constexpr int NPAD = 4352;
constexpr float DN_ALPHA = 1.4142135623730951f;
constexpr int NT = 256;
constexpr int LDS_BYTES = 76032;

constexpr size_t MiB = 1ull << 20;
constexpr size_t WS_CTL = 0;
constexpr size_t CTL_BYTES = 1 * MiB;
constexpr size_t OFF_BAR = 0;
constexpr size_t OFF_ADA = 64 * 1024;
constexpr size_t OFF_CNT = 128 * 1024;
constexpr size_t WS_ROT = 1 * MiB;
constexpr size_t WS_WIN = WS_ROT + (size_t)S * 64 * 4;
constexpr size_t WS_WOUT = WS_WIN + 2ull * NPAD * D * 2;
constexpr size_t WS_WUP = WS_WOUT + 2ull * D * D * 2;
constexpr size_t WS_WDN = WS_WUP + 2ull * NEXP * 2048 * D * 2;
constexpr size_t WS_HB = WS_WDN + 2ull * NEXP * D * DFF * 2;
constexpr size_t WS_PROJ = WS_HB + (size_t)S * D * 2;
constexpr size_t WS_PEX = WS_PROJ + (size_t)S * NPROJ * 2;
constexpr size_t WS_VFIRST = WS_PEX + (size_t)S * 64 * 4;
constexpr size_t WS_RECR = WS_VFIRST + (size_t)S * 256 * 4;
constexpr size_t WS_RECG = WS_RECR + (size_t)S * 4 * 384 * 2;
constexpr size_t WS_RECT = WS_RECG + (size_t)S * 4 * 392 * 2;
constexpr size_t WS_WDEC = WS_RECT + (size_t)S * 4 * 192 * 2;
constexpr size_t WS_GSC = WS_WDEC + (size_t)S * 256 * 4;
constexpr size_t WS_G = WS_GSC + (size_t)S * 16 * 4;
constexpr size_t WS_BON = WS_G + (size_t)S * 256 * 4;
constexpr size_t WS_YR = WS_BON + (size_t)S * 4 * 4;
constexpr size_t WS_OG = WS_YR + (size_t)S * 256 * 4;
constexpr size_t WS_ORT = WS_OG + (size_t)S * 512 * 4;
constexpr size_t WS_MIX = WS_ORT + (size_t)S * 256 * 4;
constexpr size_t WS_OPRE = WS_MIX + (size_t)S * D * 2;
constexpr size_t WS_X = WS_OPRE + (size_t)S * D * 4;
constexpr size_t WS_H2 = WS_X + (size_t)S * D * 4;
constexpr size_t WS_LIST = WS_H2 + (size_t)S * D * 2;
constexpr size_t WS_GATE = WS_LIST + (size_t)NEXP * S * 4;
constexpr size_t WS_ACT = WS_GATE + (size_t)S * 4 * 4;
constexpr size_t WS_YB = WS_ACT + ((size_t)S * 4 + 256) * DFF * 2;
constexpr size_t WS_ADAP = WS_YB + (size_t)S * 4 * D * 2;
constexpr size_t WS_RKV = WS_ADAP + 16ull * 12288 * 4;
constexpr size_t WS_RST = WS_RKV + 256ull * 4 * 4096 * 4;
constexpr size_t WS_GP = WS_RST + 256ull * 4 * 4096 * 2;
constexpr size_t WS_GB = WS_GP + 1024ull * 16384 * 2;
constexpr size_t WS_GD = WS_GB + 1024ull * 16384 * 4;
constexpr size_t WS_GQ = WS_GD + 4096;
constexpr size_t WS_GO = WS_GQ + 1024ull * 8192 * 2;
constexpr size_t WS_GS = WS_GO + 1024ull * 8192 * 4;
constexpr size_t WS_WP = WS_GS + 1024ull * 16384 * 2;
constexpr size_t WS_WC = WS_WP + 2048ull * 4096 * 2;
constexpr size_t WS_WD = WS_WC + 2048ull * 4096 * 4;
constexpr size_t WS_WQ = WS_WD + 2048ull * 64 * 4;
constexpr size_t WS_WY = WS_WQ + 2048ull * 2048 * 2;
constexpr size_t WS_WS = WS_WY + 2048ull * 2048 * 4;
constexpr size_t WS_GR = WS_WS + 2048ull * 4096 * 2;
constexpr size_t WS_GE0 = WS_GR + 1024ull * 8192 * 2;
constexpr size_t WS_GTE = WS_GE0 + 64ull * 16384 * 4;
constexpr size_t WS_GSG = WS_GTE + 64ull * 16384 * 2;
constexpr size_t WS_WR = WS_GSG + 64ull * 16384 * 2;
constexpr size_t WS_WE0 = WS_WR + 2048ull * 2048 * 2;
constexpr size_t WS_WTE = WS_WE0 + 64ull * 4096 * 4;
constexpr size_t WS_WSG = WS_WTE + 64ull * 4096 * 2;
constexpr size_t WS_LRT = WS_WSG + 64ull * 4096 * 2;
constexpr size_t WS_DUMP = WS_LRT + 2ull * 73728 * 2;
constexpr size_t WS_END = WS_DUMP + 4096;

struct P {
    const float* in[38];
    const int* pos;
    float* out;
    char* ws;
    int ph_lo, ph_hi;
};

DEVI float bf2f(bf16 v) { return __uint_as_float(((unsigned)v) << 16); }
DEVI unsigned f2bf(float f) { unsigned u = __float_as_uint(f); return (u + 0x7fffu + ((u >> 16) & 1u)) >> 16; }
typedef float f32x2_t __attribute__((ext_vector_type(2)));
typedef __bf16 bf16x2_t __attribute__((ext_vector_type(2)));
DEVI unsigned pk2(float lo, float hi) { const f32x2_t v = {lo, hi}; return __builtin_bit_cast(unsigned, __builtin_convertvector(v, bf16x2_t)); }
DEVI float sigmoidf_(float x) { return __builtin_amdgcn_rcpf(1.f + __builtin_amdgcn_exp2f(-1.4426950408889634f * x)); }
DEVI float siluf_(float x) { return x * sigmoidf_(x); }
DEVI float softplusf_(float x) { return fmaxf(x, 0.f) + log1pf(__expf(-fabsf(x))); }
DEVI float wave_sum(float v) {
#pragma unroll
    for (int o = 32; o >= 1; o >>= 1) v += __shfl_xor(v, o);
    return v;
}
template <int CTRL> DEVI float dpp_mov(float x) {
    return __int_as_float(__builtin_amdgcn_update_dpp(0, __float_as_int(x), CTRL, 0xf, 0xf, false));
}
DEVI float row16_sum(float x) {
    x += dpp_mov<0x128>(x);
    x += dpp_mov<0x124>(x);
    x += dpp_mov<0x122>(x);
    x += dpp_mov<0x121>(x);
    return x;
}

DEVI bf16x8 ldfrag(const bf16* base, int ld, int row0, int k0, int lane) {
    return *(const bf16x8*)(base + (row0 + (lane & 15)) * ld + k0 + (lane >> 4) * 8);
}
DEVI f32x4 ld_bf4(const bf16* p) {
    const u32x2 v = *(const u32x2*)p;
    return (f32x4){__uint_as_float(v.x << 16), __uint_as_float(v.x & 0xffff0000u), __uint_as_float(v.y << 16), __uint_as_float(v.y & 0xffff0000u)};
}
DEVI void st_bf4(bf16* p, const f32x4& v) { *(u32x2*)p = (u32x2){pk2(v.x, v.y), pk2(v.z, v.w)}; }
DEVI float quad_sum(float v) { v += __shfl_xor(v, 16); v += __shfl_xor(v, 32); return v; }
DEVI f32x4 mfma16(bf16x8 a, bf16x8 b, f32x4 c) { return __builtin_amdgcn_mfma_f32_16x16x32_bf16(a, b, c, 0, 0, 0); }

#define VTID ((int)(threadIdx.x & 255))
#define VBID ((int)(blockIdx.x * 2 + __builtin_amdgcn_readfirstlane((int)(threadIdx.x >> 8))))
#define VNB ((int)(gridDim.x * 2))
constexpr int VB_LDS = 76032;
constexpr int KT = 512;

#define XB_TMO      128
#define XB_XCNT(j)  (256  + 64 * (j))
#define XB_XSUB(j)  (1280 + 64 * (j))
#define XB_XGEN(j)  (2304 + 64 * (j))
#define XB_TOP      3328
#define XB_TOPGEN   3392
#define XCD_BAR_WORDS 3456
#define XB_SPIN_CAP (1u << 22)
DEVI unsigned xb_ld(unsigned* p) { return __hip_atomic_load(p, __ATOMIC_RELAXED, __HIP_MEMORY_SCOPE_AGENT); }
DEVI unsigned xb_add(unsigned* p, unsigned v) { return __hip_atomic_fetch_add(p, v, __ATOMIC_RELAXED, __HIP_MEMORY_SCOPE_AGENT); }
DEVI unsigned xb_xcc_id() { return (unsigned)__builtin_amdgcn_s_getreg((3 << 11) | 20) & 0xFu; }
#define XB_SPIN(cond, bar) do { unsigned _sp = 0; while (cond) { __builtin_amdgcn_s_sleep(1); \
    if ((++_sp & 255u) == 0u) { if (xb_ld(&(bar)[XB_TMO])) break; if (_sp > XB_SPIN_CAP) { atomicAdd(&(bar)[XB_TMO], 1u); break; } } } } while (0)
struct XcdBarrier { unsigned* bar; unsigned x; volatile LAS unsigned* st; };
DEVI XcdBarrier xcd_barrier_post(unsigned* bar, volatile LAS unsigned* st) {
    XcdBarrier b; b.bar = bar; b.x = xb_xcc_id(); b.st = st;
    if (threadIdx.x == 0) (void)xb_add(&bar[XB_XCNT(b.x)], 1u);
    return b;
}
DEVI void xcd_barrier_complete(unsigned* bar, unsigned x, unsigned& nloc, unsigned& nx) {
    const unsigned G = gridDim.x * gridDim.y * gridDim.z;
    unsigned sum, cnt, mine, sp = 0u;
    for (;;) {
        sum = 0u; cnt = 0u; mine = 0u;
#pragma unroll
        for (unsigned j = 0; j < 16; ++j) { const unsigned c = xb_ld(&bar[XB_XCNT(j)]); sum += c; cnt += (c > 0u) ? 1u : 0u; mine = (j == x) ? c : mine; }
        if (sum == G) break;
        __builtin_amdgcn_s_sleep(1);
        if ((++sp & 255u) == 0u) { if (xb_ld(&bar[XB_TMO])) break; if (sp > XB_SPIN_CAP) { atomicAdd(&bar[XB_TMO], 1u); break; } }
    }
    nloc = mine > 0u ? mine : 1u; nx = cnt > 0u ? cnt : 1u;
}
DEVI void xcd_barrier(const XcdBarrier& b) {
    asm volatile("s_waitcnt vmcnt(0)" ::: "memory");
    __syncthreads();
    if (threadIdx.x == 0) {
        unsigned* bar = b.bar;
        __builtin_amdgcn_s_waitcnt(0);
        unsigned nloc = b.st[0], nx = b.st[1];
        if (nloc == 0u) { xcd_barrier_complete(bar, b.x, nloc, nx); b.st[0] = nloc; b.st[1] = nx; }
        const unsigned old = xb_add(&bar[XB_XSUB(b.x)], 1u);
        const unsigned gen = old / nloc;
        if (old + 1u == (gen + 1u) * nloc) {
            __builtin_amdgcn_fence(__ATOMIC_RELEASE, "agent");
            asm volatile("s_waitcnt vmcnt(0)" ::: "memory");
            const unsigned og = xb_add(&bar[XB_TOP], 1u);
            const unsigned tg = og / nx;
            if (og + 1u == (tg + 1u) * nx) xb_add(&bar[XB_TOPGEN], 1u);
            else XB_SPIN(xb_ld(&bar[XB_TOPGEN]) == tg, bar);
            __builtin_amdgcn_fence(__ATOMIC_ACQUIRE, "agent");
            xb_add(&bar[XB_XGEN(b.x)], 1u);
            asm volatile("s_waitcnt vmcnt(0)" ::: "memory");
        } else {
            XB_SPIN(xb_ld(&bar[XB_XGEN(b.x)]) == gen, bar);
            __builtin_amdgcn_fence(__ATOMIC_ACQUIRE, "agent");
            asm volatile("s_waitcnt vmcnt(0)" ::: "memory");
        }
    }
    __syncthreads();
}

DEVI void transpose_item(const float* __restrict__ src, size_t ld, int k0, int ns0, bf16* __restrict__ dst, int kd, int nd0, float* lds) {
    const int tid = VTID;
    float tv[32];
#pragma unroll
    for (int i = 0; i < 32; ++i) tv[i] = __builtin_nontemporal_load(&src[(size_t)(k0 + i * 4 + (tid >> 6)) * ld + ns0 + (tid & 63)]);
    asm volatile("" ::: "memory");
#pragma unroll
    for (int i = 0; i < 32; ++i) lds[(i * 4 + (tid >> 6)) * 65 + (tid & 63)] = tv[i];
    __syncthreads();
#pragma unroll
    for (int i = 0; i < 4; ++i) {
        const int q = tid + 256 * i, n = q >> 4, kc = q & 15;
        const float* s = lds + (kc * 8) * 65 + n;
        u32x4 o;
        o.x = pk2(s[0 * 65], s[1 * 65]); o.y = pk2(s[2 * 65], s[3 * 65]);
        o.z = pk2(s[4 * 65], s[5 * 65]); o.w = pk2(s[6 * 65], s[7 * 65]);
        *(u32x4*)(dst + (size_t)(nd0 + n) * kd + k0 + kc * 8) = o;
    }
    __syncthreads();
}

DEVI void phase_prep(const P& p, char* smem) {
    float* lds = (float*)smem;
    const int tid = VTID;
    const int nb = VNB, bid = VBID;
    bf16* WIN = (bf16*)(p.ws + WS_WIN); bf16* WOUT = (bf16*)(p.ws + WS_WOUT);
    bf16* WUP = (bf16*)(p.ws + WS_WUP); bf16* WDN = (bf16*)(p.ws + WS_WDN);
    constexpr int I_UP = 2 * NEXP * 8 * 32;
    constexpr int I_DN = 2 * NEXP * 8 * 16;
    constexpr int I_IN = 2 * 8 * 64;
    constexpr int I_OUT = 2 * 8 * 16;
    constexpr int I_EX = 2 * 256;
    constexpr int I_ADA = 2 * 24 * 16;
    constexpr int I_ROT = S * 32 / 256;
    constexpr int I_LR = 2 * 288;
    constexpr int NITEMS = I_UP + I_DN + I_IN + I_OUT + I_EX + I_ADA + I_ROT + I_LR;
    constexpr int I_TR = I_UP + I_DN + I_IN + I_OUT;
    static_assert((I_TR % 512) % 2 == 0, "the two halves of every workgroup must run the same number of transpose items (they contain barriers)");
    for (int it = bid; it < NITEMS; it += nb) {
        int r = it;
        if (r < I_UP) {
            const int le = r / 256, q = r % 256, kt = q / 32, nt = q % 32;
            transpose_item(p.in[32] + (size_t)le * D * 2048, 2048, kt * 128, nt * 64, WUP + (size_t)le * 2048 * D, D, nt * 64, lds);
            continue;
        }
        r -= I_UP;
        if (r < I_DN) {
            const int le = r / 128, q = r % 128, kt = q / 16, nt = q % 16;
            transpose_item(p.in[34] + (size_t)le * DFF * D, D, kt * 128, nt * 64, WDN + (size_t)le * D * DFF, DFF, nt * 64, lds);
            continue;
        }
        r -= I_DN;
        if (r < I_IN) {
            const int l = r / 512, q = r % 512, kt = q / 64, nt = q % 64;
            const int nd0 = nt * 64, ns0 = nd0 < 3072 ? nd0 : nd0 + 8;
            transpose_item(p.in[5] + (size_t)l * D * NIN, NIN, kt * 128, ns0, WIN + (size_t)l * NPAD * D, D, nd0, lds);
            continue;
        }
        r -= I_IN;
        if (r < I_OUT) {
            const int l = r / 128, q = r % 128, kt = q / 16, nt = q % 16;
            transpose_item(p.in[27] + (size_t)l * D * D, D, kt * 128, nt * 64, WOUT + (size_t)l * D * D, D, nt * 64, lds);
            continue;
        }
        r -= I_OUT;
        if (r < I_EX) {
            const int l = r / 256, n = r % 256;
            bf16* dst = WIN + ((size_t)l * NPAD + NPROJ + n) * D;
            for (int k = tid; k < D; k += NT) {
                float v = 0.f;
                if (n < 8) v = p.in[5][(size_t)l * D * NIN + (size_t)k * NIN + 3072 + n];
                else if (n < 40 && l == 1) v = p.in[6][(size_t)k * 32 + (n - 8)];
                dst[k] = (bf16)f2bf(v);
            }
            continue;
        }
        r -= I_EX;
        if (r < I_ADA) {
            const int l = r / 384, q = r % 384, nc = q / 16, kc = q % 16;
            const int n = nc * 256 + tid;
            const float* W = p.in[3] + (size_t)l * D * 6144;
            float acc = (kc == 0) ? p.in[4][l * 6144 + n] : 0.f;
            for (int k = kc * 64; k < kc * 64 + 64; ++k) acc += siluf_(p.in[1][k]) * W[(size_t)k * 6144 + n];
            ((float*)(p.ws + WS_ADAP))[(size_t)kc * 12288 + l * 6144 + n] = acc;
            continue;
        }
        r -= I_ADA;
        if (r >= I_ROT) {
            r -= I_ROT;
            const int l = r / 288, kk = r % 288, c = tid;
            bf16* LRT = (bf16*)(p.ws + WS_LRT) + (size_t)l * 73728;
            if (kk < 64) LRT[c * 64 + kk] = (bf16)f2bf(p.in[10][(l * 64 + kk) * 256 + c]);
            else if (kk < 128) LRT[16384 + c * 64 + (kk - 64)] = (bf16)f2bf(p.in[12][(l * 64 + kk - 64) * 256 + c]);
            else if (kk < 256) LRT[32768 + c * 128 + (kk - 128)] = (bf16)f2bf(p.in[13][(l * 128 + kk - 128) * 256 + c]);
            else LRT[65536 + c * 32 + (kk - 256)] = (bf16)f2bf(l == 1 ? p.in[20][(kk - 256) * 256 + c] : 0.f);
            continue;
        }
        {
            const int idx = r * 256 + tid;
            const int t = idx >> 5, i = idx & 31;
            const float invf = (float)pow(10000.0, -(double)i / 32.0);
            const float ang = (float)p.pos[t] * invf;
            float sn, cs; sincosf(ang, &sn, &cs);
            float* ROT = (float*)(p.ws + WS_ROT);
            ROT[(size_t)idx * 2] = cs; ROT[(size_t)idx * 2 + 1] = sn;
        }
    }
}

DEVI float ada_sum(const float* ADAP, int idx) {
    float s = 0.f;
#pragma unroll
    for (int kc = 0; kc < 16; ++kc) s += ADAP[(size_t)kc * 12288 + idx];
    return s;
}
DEVI void phase_h0(const P& p) {
    const float* ADAP = (const float*)(p.ws + WS_ADAP);
    float* ADA = (float*)(p.ws + OFF_ADA);
    bf16* HB = (bf16*)(p.ws + WS_HB);
    if (VBID < 48) ADA[VBID * 256 + VTID] = ada_sum(ADAP, VBID * 256 + VTID);
    const size_t n4 = (size_t)S * D / 4;
    const int c = (int)(((size_t)VBID * NT + VTID) % (D / 4)) * 4;
    f32x4 sh, sc;
    sh.x = ada_sum(ADAP, c); sh.y = ada_sum(ADAP, c + 1); sh.z = ada_sum(ADAP, c + 2); sh.w = ada_sum(ADAP, c + 3);
    sc.x = ada_sum(ADAP, 1024 + c); sc.y = ada_sum(ADAP, 1025 + c); sc.z = ada_sum(ADAP, 1026 + c); sc.w = ada_sum(ADAP, 1027 + c);
    for (size_t i = (size_t)VBID * NT + VTID; i < n4; i += (size_t)VNB * NT) {
        const f32x4 x = ((const f32x4*)p.in[0])[i];
        u32x2 o;
        o.x = pk2(x.x * (1.f + sc.x) + sh.x, x.y * (1.f + sc.y) + sh.y);
        o.y = pk2(x.z * (1.f + sc.z) + sh.z, x.w * (1.f + sc.w) + sh.w);
        ((u32x2*)HB)[i] = o;
    }
}

template <class AF, class BF>
DEVI void gemm_tile(char* smem, const bf16* __restrict__ Abase, AF arow, const bf16* __restrict__ Bbase, BF brow, int K, f32x4 (&acc)[4][8]) {
    const int tid = VTID, wid = tid >> 6, lane = tid & 63, wr = wid >> 1, wc = wid & 1, fr = lane & 15, fq = lane >> 4;
    const int r0 = tid >> 2;
    const int swz = ((tid & 3) ^ ((0x1320 >> (4 * ((tid >> 4) & 3))) & 3)) * 8;
    unsigned pa[2], pb[4];
#pragma unroll
    for (int i = 0; i < 2; ++i) pa[i] = arow(r0 + 64 * i) + swz;
#pragma unroll
    for (int i = 0; i < 4; ++i) pb[i] = brow(r0 + 64 * i) + swz;
#pragma unroll
    for (int m = 0; m < 4; ++m)
#pragma unroll
        for (int n = 0; n < 8; ++n) acc[m][n] = (f32x4){0.f, 0.f, 0.f, 0.f};
    const int nk = K / 32;
    const int ch = (fq ^ ((0x1320 >> (4 * ((fr >> 2) & 3))) & 3)) * 16;
#define GT_STAGE(kt) do { char* _sa = smem + ((kt) % 3) * 24576; char* _sb = _sa + 8192; \
        _Pragma("unroll") for (int _i = 0; _i < 2; ++_i) \
            __builtin_amdgcn_global_load_lds((const unsigned*)(Abase + pa[_i] + (kt) * 32), (unsigned*)(_sa + (tid + 256 * _i) * 16), 16, 0, 0); \
        _Pragma("unroll") for (int _i = 0; _i < 4; ++_i) \
            __builtin_amdgcn_global_load_lds((const unsigned*)(Bbase + pb[_i] + (kt) * 32), (unsigned*)(_sb + (tid + 256 * _i) * 16), 16, 0, 0); } while (0)
    asm volatile("s_waitcnt vmcnt(0)" ::: "memory");
    GT_STAGE(0); GT_STAGE(1);
    for (int kt = 0; kt < nk; ++kt) {
        if (kt + 1 < nk) asm volatile("s_waitcnt vmcnt(6)" ::: "memory");
        else asm volatile("s_waitcnt vmcnt(0)" ::: "memory");
        asm volatile("s_waitcnt lgkmcnt(0)" ::: "memory");
        __builtin_amdgcn_s_barrier();
        if (kt + 2 < nk) GT_STAGE(kt + 2);
        const char* SA = smem + (kt % 3) * 24576; const char* SB = SA + 8192;
        bf16x8 af[4], bfr[8];
#pragma unroll
        for (int m = 0; m < 4; ++m) af[m] = *(const bf16x8*)(SA + (wr * 64 + m * 16 + fr) * 64 + ch);
#pragma unroll
        for (int n = 0; n < 8; ++n) bfr[n] = *(const bf16x8*)(SB + (wc * 128 + n * 16 + fr) * 64 + ch);
#pragma unroll
        for (int m = 0; m < 4; ++m)
#pragma unroll
            for (int n = 0; n < 8; ++n)
                acc[m][n] = __builtin_amdgcn_mfma_f32_16x16x32_bf16(bfr[n], af[m], acc[m][n], 0, 0, 0);
    }
    asm volatile("s_waitcnt lgkmcnt(0)" ::: "memory");
    __builtin_amdgcn_s_barrier();
#undef GT_STAGE
}

DEVI float proj_at(const bf16* PROJ, int t, int col) { return bf2f(PROJ[(size_t)t * NPROJ + col]); }
DEVI float proj_shift(const bf16* PROJ, int t, int col, float mu) {
    const float cur = proj_at(PROJ, t, col);
    const float prv = t > 0 ? proj_at(PROJ, t - 1, col) : 0.f;
    return cur + (prv - cur) * mu;
}

DEVI f32x4 shift4(const bf16* PROJ, int t, int col, const f32x4& mu) {
    const f32x4 cur = ld_bf4(PROJ + (size_t)t * NPROJ + col);
    f32x4 prv = ld_bf4(PROJ + (size_t)(t > 0 ? t - 1 : 0) * NPROJ + col);
    const float keep = t > 0 ? 1.f : 0.f;
    prv = prv * keep;
    return cur + (prv - cur) * mu;
}
DEVI float fsig(float x) { return sigmoidf_(x); }
DEVI void phase_mixprep(const P& p, int l, char* smem) {
    const bf16* PROJ = (const bf16*)(p.ws + WS_PROJ); const float* PEX = (const float*)(p.ws + WS_PEX);
    float* VFIRST = (float*)(p.ws + WS_VFIRST);
    bf16* RECR = (bf16*)(p.ws + WS_RECR); bf16* RECG = (bf16*)(p.ws + WS_RECG); bf16* RECT = (bf16*)(p.ws + WS_RECT);
    float* WDEC = (float*)(p.ws + WS_WDEC); float* GSC = (float*)(p.ws + WS_GSC);
    float* GB = (float*)(p.ws + WS_G); float* BON = (float*)(p.ws + WS_BON);
    const float* ROT = (const float*)(p.ws + WS_ROT);
    const bf16* LRT = (const bf16*)(p.ws + WS_LRT) + (size_t)l * 73728;
    bf16* L = (bf16*)smem;
    float* CW = (float*)(smem + 9728);
    float* MU = CW + 6144;
    float* PW0 = MU + 1024; float* PA0 = PW0 + 256; float* PKK = PA0 + 256; float* PKA = PKK + 256; float* PRK = PKA + 256; float* PV0 = PRK + 256;
    {
        const int tid = VTID;
        for (int i = tid; i < 6144; i += NT) CW[i] = p.in[21][l * 6144 + i];
        for (int i = tid; i < 1024; i += NT) MU[i] = p.in[7][l * 1024 + i];
        PW0[tid] = p.in[9][l * 256 + tid]; PA0[tid] = p.in[11][l * 256 + tid]; PKK[tid] = p.in[14][l * 256 + tid];
        PKA[tid] = p.in[15][l * 256 + tid]; PRK[tid] = p.in[16][l * 256 + tid]; PV0[tid] = (l == 1) ? p.in[19][tid] : 0.f;
    }
    __syncthreads();
    for (int item = VBID; item < S / 16; item += VNB) {
        int tid = VTID; asm volatile("" : "+v"(tid));
        const int lane = tid & 63, w = tid >> 6, fr = lane & 15, fq = lane >> 4;
        const int t0 = item * 16;
        {
            u32x2 cur[5], prv[5]; f32x4 xc[5], xp[5];
#pragma unroll
            for (int q = 0; q < 5; ++q) {
                const int g = tid + 256 * q, gg = g < 1152 ? g : 1151, tt = gg / 72, i4 = (gg % 72) * 4, t = t0 + tt, tp = t > 0 ? t - 1 : 0;
                const int ia = i4 < 256 ? i4 : 252, ib = i4 < 256 ? 0 : i4 - 256;
                cur[q] = *(const u32x2*)(PROJ + (size_t)t * NPROJ + 768 + ia); prv[q] = *(const u32x2*)(PROJ + (size_t)tp * NPROJ + 768 + ia);
                xc[q] = *(const f32x4*)(PEX + (size_t)t * 64 + 8 + ib); xp[q] = *(const f32x4*)(PEX + (size_t)tp * 64 + 8 + ib);
            }
            asm volatile("" ::: "memory");
#pragma unroll
            for (int q = 0; q < 5; ++q) {
                const int g = tid + 256 * q, gg = g < 1152 ? g : 1151, tt = gg / 72, i4 = (gg % 72) * 4, t = t0 + tt;
                const float keep = t > 0 ? 1.f : 0.f;
                f32x4 v;
                if (i4 < 256) {
                    const f32x4 c4 = {__uint_as_float(cur[q].x << 16), __uint_as_float(cur[q].x & 0xffff0000u), __uint_as_float(cur[q].y << 16), __uint_as_float(cur[q].y & 0xffff0000u)};
                    const f32x4 p4 = (f32x4){__uint_as_float(prv[q].x << 16), __uint_as_float(prv[q].x & 0xffff0000u), __uint_as_float(prv[q].y << 16), __uint_as_float(prv[q].y & 0xffff0000u)} * keep;
                    v = c4 + (p4 - c4) * *(const f32x4*)(MU + 768 + i4);
                    if (i4 < 64) { v.x = tanhf(v.x); v.y = tanhf(v.y); v.z = tanhf(v.z); v.w = tanhf(v.w); }
                    else if (i4 >= 128) { v.x = fsig(v.x); v.y = fsig(v.y); v.z = fsig(v.z); v.w = fsig(v.w); }
                } else {
                    v = (f32x4){0.f, 0.f, 0.f, 0.f};
                    if (l == 1) v = xc[q] + (xp[q] * keep - xc[q]) * *(const f32x4*)(p.in[8] + (i4 - 256));
                }
                if (g < 1152) *(u32x2*)(L + tt * 296 + i4) = (u32x2){pk2(v.x, v.y), pk2(v.z, v.w)};
            }
        }
        __syncthreads();
        const int t = t0 + fr, h = w, tpv = t > 0 ? t - 1 : 0;
        const float keep = t > 0 ? 1.f : 0.f;
        {
            f32x4 aw[4], aa[4], ag[4], av[4];
#pragma unroll
            for (int i = 0; i < 4; ++i) { aw[i] = (f32x4){0.f, 0.f, 0.f, 0.f}; aa[i] = aw[i]; ag[i] = aw[i]; av[i] = aw[i]; }
            bf16x8 lf[9];
#pragma unroll
            for (int ks = 0; ks < 9; ++ks) lf[ks] = *(const bf16x8*)(L + fr * 296 + ks * 32 + fq * 8);
#pragma unroll
            for (int i = 0; i < 4; ++i) {
                const int c = 64 * h + 16 * i + fr;
#pragma unroll
                for (int ks = 0; ks < 2; ++ks) aw[i] = mfma16(*(const bf16x8*)(LRT + c * 64 + ks * 32 + fq * 8), lf[ks], aw[i]);
#pragma unroll
                for (int ks = 0; ks < 2; ++ks) aa[i] = mfma16(*(const bf16x8*)(LRT + 16384 + c * 64 + ks * 32 + fq * 8), lf[2 + ks], aa[i]);
#pragma unroll
                for (int ks = 0; ks < 4; ++ks) ag[i] = mfma16(*(const bf16x8*)(LRT + 32768 + c * 128 + ks * 32 + fq * 8), lf[4 + ks], ag[i]);
                if (l == 1) av[i] = mfma16(*(const bf16x8*)(LRT + 65536 + c * 32 + fq * 8), lf[8], av[i]);
            }
            bf16* rec = RECR + ((size_t)t * 4 + h) * 384;
            f32x4 kx[4], as_[4];
            float ss = 0.f, bsum = 0.f;
#define UNPK4(u) ((f32x4){__uint_as_float((u).x << 16), __uint_as_float((u).x & 0xffff0000u), __uint_as_float((u).y << 16), __uint_as_float((u).y & 0xffff0000u)})
            u32x2 rc[4], rp[4], kc[4], kp[4], vc[4], vp[4]; f32x4 vf4[4];
#pragma unroll
            for (int i = 0; i < 4; ++i) {
                const int j = 16 * i + 4 * fq, c = 64 * h + j;
                if ((i & 1) == 0) {
#pragma unroll
                    for (int i2 = i; i2 < i + 2; ++i2) {
                        const int c2 = 64 * h + 16 * i2 + 4 * fq;
                        rc[i2] = *(const u32x2*)(PROJ + (size_t)t * NPROJ + c2); rp[i2] = *(const u32x2*)(PROJ + (size_t)tpv * NPROJ + c2);
                        kc[i2] = *(const u32x2*)(PROJ + (size_t)t * NPROJ + 256 + c2); kp[i2] = *(const u32x2*)(PROJ + (size_t)tpv * NPROJ + 256 + c2);
                        vc[i2] = *(const u32x2*)(PROJ + (size_t)t * NPROJ + 512 + c2); vp[i2] = *(const u32x2*)(PROJ + (size_t)tpv * NPROJ + 512 + c2);
                        if (l == 1) vf4[i2] = *(const f32x4*)(VFIRST + (size_t)t * 256 + c2);
                    }
                    asm volatile("" ::: "memory");
                }
                const f32x4 r0 = UNPK4(rc[i]), k0 = UNPK4(kc[i]), v0_ = UNPK4(vc[i]);
                const f32x4 r = r0 + (UNPK4(rp[i]) * keep - r0) * *(const f32x4*)(MU + c);
                const f32x4 k = k0 + (UNPK4(kp[i]) * keep - k0) * *(const f32x4*)(MU + 256 + c);
                f32x4 v = v0_ + (UNPK4(vp[i]) * keep - v0_) * *(const f32x4*)(MU + 512 + c);
                const f32x4 w0 = *(const f32x4*)(PW0 + c), a0 = *(const f32x4*)(PA0 + c);
                const f32x4 kkc = *(const f32x4*)(PKK + c), kac = *(const f32x4*)(PKA + c), rkc = *(const f32x4*)(PRK + c);
                f32x4 dec, a;
#pragma unroll
                for (int q = 0; q < 4; ++q) {
                    const float wl = -softplusf_(-(w0[q] + aw[i][q])) - 0.5f;
                    dec[q] = __expf(-__expf(wl));
                    a[q] = fsig(a0[q] + aa[i][q]);
                }
                if (l == 0) *(f32x4*)(VFIRST + (size_t)t * 256 + c) = v;
                else {
                    const f32x4 v0 = *(const f32x4*)(PV0 + c);
#pragma unroll
                    for (int q = 0; q < 4; ++q) v[q] = v[q] + (vf4[i][q] - v[q]) * fsig(v0[q] + av[i][q]);
                }
                kx[i] = k * kkc; as_[i] = a;
                const f32x4 k2 = k * ((a - 1.f) * kac + 1.f);
                ss += kx[i].x * kx[i].x + kx[i].y * kx[i].y + kx[i].z * kx[i].z + kx[i].w * kx[i].w;
                const f32x4 rb = r * k2 * rkc;
                bsum += (rb.x + rb.y) + (rb.z + rb.w);
                *(f32x4*)(WDEC + (size_t)t * 256 + c) = dec; st_bf4(rec + 192 + j, k2); st_bf4(rec + 256 + j, r); st_bf4(rec + 320 + j, v);
                *(f32x4*)(GB + (size_t)t * 256 + c) = ag[i];
            }
            const float rn = rsqrtf(quad_sum(ss) + 1e-12f);
            bsum = quad_sum(bsum);
            if (fq == 0) BON[(size_t)t * 4 + h] = bsum;
#pragma unroll
            for (int i = 0; i < 4; ++i) {
                const int j = 16 * i + 4 * fq;
                const f32x4 kk = kx[i] * rn;
                st_bf4(rec + j, -kk); st_bf4(rec + 128 + j, kk * as_[i]);
            }
        }
        {
            bf16* rec = RECG + ((size_t)t * 4 + h) * 392;
            f32x4 yq[8], yk[8];
            float sq = 0.f, sk = 0.f;
            size_t rowo[4];
            float tapm[4];
#pragma unroll
            for (int tap = 0; tap < 4; ++tap) { const int tp = t - 3 + tap; rowo[tap] = (size_t)(tp >= 0 ? tp : 0) * NPROJ; tapm[tap] = tp >= 0 ? 1.f : 0.f; }
#pragma unroll
            for (int which = 0; which < 3; ++which) {
                u32x2 raw[8][4];
#pragma unroll
                for (int i = 0; i < 8; ++i) {
                    if ((i & 3) == 0) {
#pragma unroll
                        for (int i2 = i; i2 < i + 4; ++i2)
#pragma unroll
                            for (int tap = 0; tap < 4; ++tap) raw[i2][tap] = *(const u32x2*)(PROJ + rowo[tap] + 1024 + which * 512 + h * 128 + 16 * i2 + 4 * fq);
                        asm volatile("" ::: "memory");
                    }
                    const int j = 16 * i + 4 * fq, ch = which * 512 + h * 128 + j;
                    f32x4 cv = {0.f, 0.f, 0.f, 0.f};
#pragma unroll
                    for (int tap = 0; tap < 4; ++tap) cv = cv + UNPK4(raw[i][tap]) * (*(const f32x4*)(CW + tap * 1536 + ch) * tapm[tap]);
                    f32x4 y; y.x = siluf_(cv.x); y.y = siluf_(cv.y); y.z = siluf_(cv.z); y.w = siluf_(cv.w);
                    if (which == 0) { yq[i] = y; sq += y.x * y.x + y.y * y.y + y.z * y.z + y.w * y.w; }
                    else if (which == 1) { yk[i] = y; sk += y.x * y.x + y.y * y.y + y.z * y.z + y.w * y.w; }
                    else st_bf4(rec + 256 + j, y);
                }
            }
            const float rq = rsqrtf(quad_sum(sq) + 1e-12f) * 0.08838834764831845f, rk = rsqrtf(quad_sum(sk) + 1e-12f);
#pragma unroll
            for (int i = 0; i < 8; ++i) { const int j = 16 * i + 4 * fq; st_bf4(rec + j, yq[i] * rq); st_bf4(rec + 128 + j, yk[i] * rk); }
            if (fq == 0) {
                const float av = PEX[(size_t)t * 64 + h], bv = PEX[(size_t)t * 64 + 4 + h];
                const float g = -__expf(p.in[22][l * 4 + h]) * softplusf_(av + p.in[23][l * 4 + h]);
                *(f32x4*)(GSC + ((size_t)t * 4 + h) * 4) = (f32x4){__expf(g), fsig(bv), g, 0.f};
            }
        }
        {
            bf16* rec = RECT + ((size_t)t * 4 + h) * 192;
            u32x2 q1r[2], q2r[2], k1r[2], k2r[2], vr[4]; f32x4 c0r[2], c1r[2];
#pragma unroll
            for (int u = 0; u < 2; ++u) {
                const int i = 16 * u + 4 * fq;
                c0r[u] = *(const f32x4*)(ROT + ((size_t)t * 32 + i) * 2); c1r[u] = *(const f32x4*)(ROT + ((size_t)t * 32 + i) * 2 + 4);
                q1r[u] = *(const u32x2*)(PROJ + (size_t)t * NPROJ + 3072 + h * 64 + i); q2r[u] = *(const u32x2*)(PROJ + (size_t)t * NPROJ + 3072 + h * 64 + 32 + i);
                k1r[u] = *(const u32x2*)(PROJ + (size_t)t * NPROJ + 3328 + h * 64 + i); k2r[u] = *(const u32x2*)(PROJ + (size_t)t * NPROJ + 3328 + h * 64 + 32 + i);
            }
#pragma unroll
            for (int i = 0; i < 4; ++i) vr[i] = *(const u32x2*)(PROJ + (size_t)t * NPROJ + 3584 + h * 64 + 16 * i + 4 * fq);
            asm volatile("" ::: "memory");
#pragma unroll
            for (int u = 0; u < 2; ++u) {
                const int i = 16 * u + 4 * fq;
                const f32x4 cs = {c0r[u].x, c0r[u].z, c1r[u].x, c1r[u].z}, sn = {c0r[u].y, c0r[u].w, c1r[u].y, c1r[u].w};
                const f32x4 q1 = UNPK4(q1r[u]), q2 = UNPK4(q2r[u]), k1 = UNPK4(k1r[u]), k2 = UNPK4(k2r[u]);
                st_bf4(rec + i, q1 * cs - q2 * sn); st_bf4(rec + 32 + i, q1 * sn + q2 * cs);
                st_bf4(rec + 64 + i, (k1 * cs - k2 * sn) * 0.125f); st_bf4(rec + 96 + i, (k1 * sn + k2 * cs) * 0.125f);
            }
#pragma unroll
            for (int i = 0; i < 4; ++i) *(u32x2*)(rec + 128 + 16 * i + 4 * fq) = vr[i];
        }
#undef UNPK4
        __syncthreads();
    }
}

DEVI void retA_item(const P& p, int item, char* smem) {
    const bf16* REC = (const bf16*)(p.ws + WS_RECT); float* KV = (float*)(p.ws + WS_RKV);
    bf16* KT = (bf16*)smem; bf16* VT = KT + 64 * 72;
    const int n = item >> 2, h = item & 3;
    int tid = VTID; asm volatile("" : "+v"(tid));
    const int lane = tid & 63, w = tid >> 6, fr = lane & 15, fq = lane >> 4;
    const float lg = log2f(1.f - exp2f(-5.f - (float)h));
    {
        u32x4 v[4];
#pragma unroll
        for (int i = 0; i < 4; ++i) { const int idx = tid + 256 * i, c = idx >> 4, j = idx & 15; v[i] = *(const u32x4*)(REC + ((size_t)(n * 64 + c) * 4 + h) * 192 + 64 + j * 8); }
#pragma unroll
        for (int i = 0; i < 4; ++i) {
            const int idx = tid + 256 * i, c = idx >> 4, j = idx & 15;
            const float sc = (j < 8) ? exp2f((float)(63 - c) * lg) : 1.f;
            bf16* dst = ((j < 8) ? KT : VT) + ((j & 7) * 8) * 72 + c;
#pragma unroll
            for (int q = 0; q < 4; ++q) {
                const unsigned u = v[i][q];
                dst[(2 * q) * 72] = (j < 8) ? (bf16)f2bf(__uint_as_float(u << 16) * sc) : (bf16)(u & 0xffffu);
                dst[(2 * q + 1) * 72] = (j < 8) ? (bf16)f2bf(__uint_as_float(u & 0xffff0000u) * sc) : (bf16)(u >> 16);
            }
        }
    }
    __syncthreads();
    {
        const int dt = w;
        const bf16x8 a0 = ldfrag(KT, 72, 16 * dt, 0, lane), a1 = ldfrag(KT, 72, 16 * dt, 32, lane);
        float* out = KV + (size_t)item * 4096;
        const int s_ = dt >> 1, lane2 = 16 * (2 * (dt & 1) + (fq >> 1)) + fr;
#pragma unroll
        for (int et = 0; et < 4; ++et) {
            f32x4 acc = {0.f, 0.f, 0.f, 0.f};
            acc = mfma16(a0, ldfrag(VT, 72, 16 * et, 0, lane), acc);
            acc = mfma16(a1, ldfrag(VT, 72, 16 * et, 32, lane), acc);
            *(f32x4*)(out + ((et * 2 + s_) * 64 + lane2) * 8 + 4 * (fq & 1)) = acc;
        }
    }
    __syncthreads();
}

DEVI void retS_item(const P& p, int item) {
    const float* KV = (const float*)(p.ws + WS_RKV); bf16* RST = (bf16*)(p.ws + WS_RST);
    const int idx = item * NT + VTID;
    const int h = idx >> 12, i = idx & 4095;
    const float cd = exp2f(64.f * log2f(1.f - exp2f(-5.f - (float)h)));
    float r = 0.f;
#pragma unroll 1
    for (int n0 = 0; n0 < 256; n0 += 32) {
        float kv[32];
#pragma unroll
        for (int q = 0; q < 32; ++q) kv[q] = KV[((size_t)(n0 + q) * 4 + h) * 4096 + i];
#pragma unroll
        for (int q = 0; q < 32; ++q) { RST[((size_t)(n0 + q) * 4 + h) * 4096 + i] = (bf16)f2bf(r); r = r * cd + kv[q]; }
    }
}

DEVI void retC_item(const P& p, int item, int l, char* smem) {
    const bf16* REC = (const bf16*)(p.ws + WS_RECT); const bf16* RST = (const bf16*)(p.ws + WS_RST);
    const bf16* PROJ = (const bf16*)(p.ws + WS_PROJ); bf16* MIX = (bf16*)(p.ws + WS_MIX);
    const float* rgn = p.in[25] + l * 256; const float* rbn = p.in[26] + l * 256;
    bf16* Qs = (bf16*)smem; bf16* Ks = Qs + 64 * 72; bf16* VT = Ks + 64 * 72; bf16* Ps = VT + 64 * 72;
    const int n = item >> 2, h = item & 3;
    int tid = VTID; asm volatile("" : "+v"(tid));
    const int lane = tid & 63, w = tid >> 6, fr = lane & 15, fq = lane >> 4;
    const float lg = log2f(1.f - exp2f(-5.f - (float)h));
    {
        u32x4 v[6];
#pragma unroll
        for (int i = 0; i < 6; ++i) { const int idx = tid + 256 * i, c = idx / 24, j = idx - c * 24; v[i] = *(const u32x4*)(REC + ((size_t)(n * 64 + c) * 4 + h) * 192 + j * 8); }
#pragma unroll
        for (int i = 0; i < 6; ++i) {
            const int idx = tid + 256 * i, c = idx / 24, j = idx - c * 24;
            if (j < 16) *(u32x4*)(((j < 8) ? Qs : Ks) + c * 72 + (j & 7) * 8) = v[i];
            else {
                bf16* dst = VT + ((j & 7) * 8) * 72 + c;
#pragma unroll
                for (int q = 0; q < 4; ++q) { const unsigned u = v[i][q]; dst[(2 * q) * 72] = (bf16)(u & 0xffffu); dst[(2 * q + 1) * 72] = (bf16)(u >> 16); }
            }
        }
    }
    __syncthreads();
    const int ct = w, c = 16 * ct + fr;
    const bf16x8 q0 = ldfrag(Qs, 72, 16 * ct, 0, lane), q1 = ldfrag(Qs, 72, 16 * ct, 32, lane);
#pragma unroll
    for (int ct2 = 0; ct2 < 4; ++ct2) {
        f32x4 acc = {0.f, 0.f, 0.f, 0.f};
        acc = mfma16(ldfrag(Ks, 72, 16 * ct2, 0, lane), q0, acc);
        acc = mfma16(ldfrag(Ks, 72, 16 * ct2, 32, lane), q1, acc);
        float pv[4];
#pragma unroll
        for (int j = 0; j < 4; ++j) {
            const int c2 = 16 * ct2 + 4 * fq + j;
            pv[j] = (c >= c2) ? acc[j] * exp2f((float)(c - c2) * lg) : 0.f;
        }
        *(u32x2*)(Ps + c * 72 + 16 * ct2 + 4 * fq) = (u32x2){pk2(pv[0], pv[1]), pk2(pv[2], pv[3])};
    }
    __syncthreads();
    {
        const bf16x8 p0 = ldfrag(Ps, 72, 16 * ct, 0, lane), p1 = ldfrag(Ps, 72, 16 * ct, 32, lane);
        const float xi = exp2f((float)(c + 1) * lg);
        const bf16* RF = RST + (size_t)item * 4096;
        f32x4 o[4];
        float sm = 0.f;
        bf16x8 rfr[4][2];
#pragma unroll
        for (int et = 0; et < 4; ++et) { rfr[et][0] = *(const bf16x8*)(RF + ((et * 2 + 0) * 64 + lane) * 8); rfr[et][1] = *(const bf16x8*)(RF + ((et * 2 + 1) * 64 + lane) * 8); }
        asm volatile("" ::: "memory");
#pragma unroll
        for (int et = 0; et < 4; ++et) {
            f32x4 ai = {0.f, 0.f, 0.f, 0.f}, ax = {0.f, 0.f, 0.f, 0.f};
            ai = mfma16(ldfrag(VT, 72, 16 * et, 0, lane), p0, ai);
            ai = mfma16(ldfrag(VT, 72, 16 * et, 32, lane), p1, ai);
            ax = mfma16(rfr[et][0], q0, ax);
            ax = mfma16(rfr[et][1], q1, ax);
            o[et] = ai + ax * xi;
            sm += (o[et].x + o[et].y) + (o[et].z + o[et].w);
        }
        const float mean = quad_sum(sm) * (1.f / 64.f);
        float sv = 0.f;
#pragma unroll
        for (int et = 0; et < 4; ++et) { o[et] = o[et] - mean; sv += o[et].x * o[et].x + o[et].y * o[et].y + o[et].z * o[et].z + o[et].w * o[et].w; }
        const float rs = rsqrtf(quad_sum(sv) * (1.f / 64.f) + 1e-5f);
        const int t = n * 64 + c;
#pragma unroll
        for (int et = 0; et < 4; ++et) {
            const int e = h * 64 + 16 * et + 4 * fq;
            const f32x4 g = *(const f32x4*)(rgn + e), b = *(const f32x4*)(rbn + e);
            const f32x4 gt = ld_bf4(PROJ + (size_t)t * NPROJ + 3840 + e);
            const f32x4 y = o[et] * rs * g + b;
            *(u32x2*)(MIX + (size_t)t * D + 768 + e) = (u32x2){pk2(y.x * siluf_(gt.x), y.y * siluf_(gt.y)), pk2(y.z * siluf_(gt.z), y.w * siluf_(gt.w))};
        }
    }
    __syncthreads();
}

template <int I, int N> struct SolveRow {
    static DEVI void run(float (&x)[N], const float* M) {
        float s = 0.f;
#pragma unroll
        for (int j4 = 0; j4 < (I + 3) / 4; ++j4) {
            const f32x4 m = *(const f32x4*)(M + I * N + 4 * j4);
            s += m.x * x[4 * j4] + m.y * x[4 * j4 + 1] + m.z * x[4 * j4 + 2] + m.w * x[4 * j4 + 3];
        }
        x[I] -= s;
        asm volatile("" : "+v"(x[I]) :: "memory");
        SolveRow<I + 1, N>::run(x, M);
    }
};
template <int N> struct SolveRow<N, N> { static DEVI void run(float (&)[N], const float*) {} };

DEVI void gdnA_item(const P& p, int item, char* smem) {
    const bf16* REC = (const bf16*)(p.ws + WS_RECG); const float* GSC = (const float*)(p.ws + WS_GSC) + ((size_t)(item >> 2) * 64 * 4 + (item & 3)) * 4;
    bf16* GP = (bf16*)(p.ws + WS_GP) + (size_t)item * 16384; float* GB = (float*)(p.ws + WS_GB) + (size_t)item * 16384;
    float* GD = (float*)(p.ws + WS_GD);
    bf16* GQ = (bf16*)(p.ws + WS_GQ) + (size_t)item * 8192; float* GO = (float*)(p.ws + WS_GO) + (size_t)item * 8192;
    bf16* Kb = (bf16*)smem; bf16* Qb = Kb + 64 * 136;
    bf16* WT = (bf16*)smem; bf16* UT = WT + 128 * 72;
    bf16* Vb = (bf16*)(smem + 36864);
    float* M = (float*)(smem + 36864);
    bf16* KdT = (bf16*)(smem + 36864);
    bf16* At = (bf16*)(smem + 55296);
    float* gcs = (float*)(smem + 64512); float* bts = gcs + 64; float* sws = gcs + 128; float* sks = gcs + 192;
    const int n = item >> 2, h = item & 3;
    int tid = VTID; asm volatile("" : "+v"(tid));
    const int lane = tid & 63, w = tid >> 6, fr = lane & 15, fq = lane >> 4;
    const bf16* rec0 = REC + ((size_t)(n * 64) * 4 + h) * 392;
    if (w == 0) {
        float x = GSC[lane * 16 + 2];
#pragma unroll
        for (int off = 1; off < 64; off <<= 1) { const float y = __shfl_up(x, off); if (lane >= off) x += y; }
        const float bt = GSC[lane * 16 + 1];
        gcs[lane] = x; bts[lane] = bt; sws[lane] = bt * __expf(x); sks[lane] = __expf(__shfl(x, 63) - x);
    }
    {
        u32x4 v[12];
#pragma unroll
        for (int i = 0; i < 12; ++i) { const int idx = tid + 256 * i, c = idx / 48, j = idx - c * 48; v[i] = *(const u32x4*)(rec0 + (size_t)c * 1568 + j * 8); }
#pragma unroll
        for (int i = 0; i < 12; ++i) {
            const int idx = tid + 256 * i, c = idx / 48, j = idx - c * 48, which = j >> 4;
            const int boff = (which == 0 ? 17408 : 0) + (which == 2 ? 36864 : 0);
            *(u32x4*)(smem + boff + (c * 136 + (j & 15) * 8) * 2) = v[i];
        }
    }
    __syncthreads();
    float x[64];
    unsigned kdp[16];
    {
        const int col = tid & 127;
        int sel_b = (tid < 128) ? 36864 : 0, sel_s = (tid < 128) ? 64 : 128;
        asm volatile("" : "+v"(sel_b), "+v"(sel_s));
        const bf16* srcb = (const bf16*)(smem + sel_b) + col;
        const float* scs = gcs + sel_s;
#pragma unroll
        for (int c = 0; c < 64; ++c) {
            x[c] = scs[c] * bf2f(srcb[c * 136]);
            if ((c & 7) == 7) asm volatile("" : "+v"(x[c]) :: "memory");
        }
        const int half = tid >> 7;
#pragma unroll
        for (int i = 0; i < 16; ++i) {
            const int c = 32 * half + 2 * i;
            kdp[i] = pk2(bf2f(Kb[c * 136 + col]) * sks[c], bf2f(Kb[(c + 1) * 136 + col]) * sks[c + 1]);
            if ((i & 3) == 3) asm volatile("" : "+v"(kdp[i]) :: "memory");
        }
        if (tid == 0) GD[item] = __expf(gcs[63]);
    }
    __syncthreads();
    const int ct = w;
    f32x4 accQ[8];
    {
        const int c = 16 * ct + fr;
        const float gcc = gcs[c];
        {
            bf16x8 ka[4];
#pragma unroll
            for (int s = 0; s < 4; ++s) ka[s] = ldfrag(Kb, 136, 16 * ct, 32 * s, lane);
#pragma unroll
            for (int ct2 = 0; ct2 < 4; ++ct2) {
                f32x4 acc = {0.f, 0.f, 0.f, 0.f};
#pragma unroll
                for (int s = 0; s < 4; ++s) acc = mfma16(ka[s], ldfrag(Kb, 136, 16 * ct2, 32 * s, lane), acc);
                const int c2 = 16 * ct2 + fr; const float g2 = gcs[c2];
#pragma unroll
                for (int j = 0; j < 4; ++j) {
                    const int cc = 16 * ct + 4 * fq + j;
                    M[cc * 64 + c2] = (cc > c2) ? bts[cc] * acc[j] * __expf(gcs[cc] - g2) : 0.f;
                }
            }
        }
        {
            bf16x8 qa[4];
#pragma unroll
            for (int s = 0; s < 4; ++s) qa[s] = ldfrag(Qb, 136, 16 * ct, 32 * s, lane);
#pragma unroll
            for (int ct2 = 0; ct2 < 4; ++ct2) {
                f32x4 acc = {0.f, 0.f, 0.f, 0.f};
#pragma unroll
                for (int s = 0; s < 4; ++s) acc = mfma16(ldfrag(Kb, 136, 16 * ct2, 32 * s, lane), qa[s], acc);
                float pv[4];
#pragma unroll
                for (int j = 0; j < 4; ++j) { const int c2 = 16 * ct2 + 4 * fq + j; pv[j] = (c >= c2) ? acc[j] * __expf(gcc - gcs[c2]) : 0.f; }
                *(u32x2*)(At + c * 72 + 16 * ct2 + 4 * fq) = (u32x2){pk2(pv[0], pv[1]), pk2(pv[2], pv[3])};
            }
        }
    }
    __syncthreads();
    {
        SolveRow<1, 64>::run(x, M);
        unsigned xp[32];
#pragma unroll
        for (int q = 0; q < 32; ++q) xp[q] = pk2(x[2 * q], x[2 * q + 1]);
        {
            const int c = 16 * ct + fr;
            const float eg = __expf(gcs[c]);
#pragma unroll
            for (int dt = 0; dt < 8; ++dt) accQ[dt] = ld_bf4(Qb + c * 136 + 16 * dt + 4 * fq) * (-eg);
        }
        __syncthreads();
        int sel_d = (tid < 128) ? 128 * 72 : 0;
        asm volatile("" : "+v"(sel_d));
        bf16* dst = WT + sel_d + (tid & 127) * 72;
#pragma unroll
        for (int q = 0; q < 8; ++q) *(u32x4*)(dst + 8 * q) = (u32x4){xp[4 * q], xp[4 * q + 1], xp[4 * q + 2], xp[4 * q + 3]};
    }
    __syncthreads();
    {
        const int d = tid & 127, half = tid >> 7;
#pragma unroll
        for (int q = 0; q < 4; ++q) *(u32x4*)(KdT + d * 72 + 32 * half + 8 * q) = (u32x4){kdp[4 * q], kdp[4 * q + 1], kdp[4 * q + 2], kdp[4 * q + 3]};
    }
    __syncthreads();
    {
#pragma unroll 1
        for (int mi = 0; mi < 2; ++mi) {
            const int mt = 2 * w + mi;
            const bf16x8 kd0 = ldfrag(KdT, 72, 16 * mt, 0, lane), kd1 = ldfrag(KdT, 72, 16 * mt, 32, lane);
#pragma unroll
            for (int sp = 0; sp < 4; ++sp) {
                f32x4 a0 = {0.f, 0.f, 0.f, 0.f}, a1 = {0.f, 0.f, 0.f, 0.f};
                a0 = mfma16(ldfrag(WT, 72, 32 * sp, 0, lane), kd0, a0); a0 = mfma16(ldfrag(WT, 72, 32 * sp, 32, lane), kd1, a0);
                a1 = mfma16(ldfrag(WT, 72, 32 * sp + 16, 0, lane), kd0, a1); a1 = mfma16(ldfrag(WT, 72, 32 * sp + 16, 32, lane), kd1, a1);
                *(u32x4*)(GP + ((mt * 4 + sp) * 64 + lane) * 8) = (u32x4){pk2(-a0.x, -a0.y), pk2(-a0.z, -a0.w), pk2(-a1.x, -a1.y), pk2(-a1.z, -a1.w)};
            }
#pragma unroll
            for (int nt = 0; nt < 8; ++nt) {
                f32x4 a = {0.f, 0.f, 0.f, 0.f};
                a = mfma16(kd0, ldfrag(UT, 72, 16 * nt, 0, lane), a); a = mfma16(kd1, ldfrag(UT, 72, 16 * nt, 32, lane), a);
                *(f32x4*)(GB + ((nt * 8 + mt) * 64 + lane) * 4) = a;
            }
        }
        const bf16x8 at0 = ldfrag(At, 72, 16 * ct, 0, lane), at1 = ldfrag(At, 72, 16 * ct, 32, lane);
#pragma unroll
        for (int sp = 0; sp < 4; ++sp) {
            f32x4 a0 = accQ[2 * sp], a1 = accQ[2 * sp + 1];
            a0 = mfma16(ldfrag(WT, 72, 32 * sp, 0, lane), at0, a0); a0 = mfma16(ldfrag(WT, 72, 32 * sp, 32, lane), at1, a0);
            a1 = mfma16(ldfrag(WT, 72, 32 * sp + 16, 0, lane), at0, a1); a1 = mfma16(ldfrag(WT, 72, 32 * sp + 16, 32, lane), at1, a1);
            *(u32x4*)(GQ + ((ct * 4 + sp) * 64 + lane) * 8) = (u32x4){pk2(-a0.x, -a0.y), pk2(-a0.z, -a0.w), pk2(-a1.x, -a1.y), pk2(-a1.z, -a1.w)};
        }
#pragma unroll
        for (int et = 0; et < 8; ++et) {
            f32x4 a = {0.f, 0.f, 0.f, 0.f};
            a = mfma16(ldfrag(UT, 72, 16 * et, 0, lane), at0, a); a = mfma16(ldfrag(UT, 72, 16 * et, 32, lane), at1, a);
            *(f32x4*)(GO + ((ct * 8 + et) * 64 + lane) * 4) = a;
        }
    }
    __syncthreads();
}

DEVI bf16x8 pack_frag(const f32x4& a, const f32x4& b) {
    const u32x4 v = {pk2(a.x, a.y), pk2(a.z, a.w), pk2(b.x, b.y), pk2(b.z, b.w)};
    return __builtin_bit_cast(bf16x8, v);
}
DEVI void gdnL1_item(const P& p, int item, char* smem) {
    const bf16* GP = (const bf16*)(p.ws + WS_GP); const float* GB = (const float*)(p.ws + WS_GB); const float* GD = (const float*)(p.ws + WS_GD);
    const int half = item & 1, kind = (item >> 1) & 1, g = (item >> 2) & 15, h = item >> 6;
    const int tid = VTID, lane = tid & 63, ew = half * 4 + (tid >> 6), fr = lane & 15, fq = lane >> 4;
    const int n0 = g * 16;
#define L1_DMA(n) do { const bf16* _s = GP + ((size_t)(n) * 4 + h) * 16384 + tid * 8; char* _d = smem + ((n) & 1) * 32768 + tid * 16; \
        _Pragma("unroll") for (int _i = 0; _i < 8; ++_i) __builtin_amdgcn_global_load_lds((const unsigned*)(_s + _i * 2048), (unsigned*)(_d + _i * 4096), 16, 0, 0); } while (0)
    f32x4 acc[8];
    L1_DMA(n0);
    if (kind == 0) {
        bf16* GS = (bf16*)(p.ws + WS_GS);
#pragma unroll
        for (int m = 0; m < 8; ++m) acc[m] = (f32x4){0.f, 0.f, 0.f, 0.f};
        f32x4 bcur[8], bnxt[8]; float dcur, dnxt = 0.f;
        {
            const float* Bn = GB + ((size_t)n0 * 4 + h) * 16384 + (ew * 8 * 64 + lane) * 4;
#pragma unroll
            for (int m = 0; m < 8; ++m) bcur[m] = *(const f32x4*)(Bn + m * 256);
            dcur = GD[(size_t)n0 * 4 + h];
        }
#pragma unroll 1
        for (int n = n0; n < n0 + 16; ++n) {
            const size_t it = (size_t)n * 4 + h;
            asm volatile("s_waitcnt vmcnt(0)" ::: "memory");
            __syncthreads();
            if (n + 1 < n0 + 16) {
                L1_DMA(n + 1);
                const float* Bn = GB + (it + 4) * 16384 + (ew * 8 * 64 + lane) * 4;
#pragma unroll
                for (int m = 0; m < 8; ++m) bnxt[m] = *(const f32x4*)(Bn + m * 256);
                dnxt = GD[it + 4];
            }
            const char* ring = smem + (n & 1) * 32768 + lane * 16;
            bf16x8 sf[4];
#pragma unroll
            for (int s = 0; s < 4; ++s) {
                sf[s] = pack_frag(acc[2 * s], acc[2 * s + 1]);
                *(bf16x8*)(GS + it * 16384 + ((ew * 4 + s) * 64 + lane) * 8) = sf[s];
            }
#pragma unroll
            for (int m = 0; m < 8; ++m) {
                f32x4 a = acc[m] * dcur + bcur[m];
#pragma unroll
                for (int s = 0; s < 4; ++s) a = mfma16(*(const bf16x8*)(ring + (m * 4 + s) * 1024), sf[s], a);
                acc[m] = a;
            }
#pragma unroll
            for (int m = 0; m < 8; ++m) bcur[m] = bnxt[m];
            dcur = dnxt;
        }
        float* E0 = (float*)(p.ws + WS_GE0) + (size_t)(h * 16 + g) * 16384 + (ew * 8 * 64 + lane) * 4;
#pragma unroll
        for (int m = 0; m < 8; ++m) *(f32x4*)(E0 + m * 256) = acc[m];
    } else {
        const bf16* GQ = (const bf16*)(p.ws + WS_GQ); bf16* GR = (bf16*)(p.ws + WS_GR);
#pragma unroll
        for (int m = 0; m < 8; ++m)
#pragma unroll
            for (int j = 0; j < 4; ++j) acc[m][j] = (m == ew && 4 * fq + j == fr) ? 1.f : 0.f;
#pragma unroll 1
        for (int n = n0; n < n0 + 16; ++n) {
            const size_t it = (size_t)n * 4 + h;
            asm volatile("s_waitcnt vmcnt(0)" ::: "memory");
            __syncthreads();
            if (n + 1 < n0 + 16) L1_DMA(n + 1);
            bf16x8 qf[16];
#pragma unroll
            for (int i = 0; i < 16; ++i) qf[i] = *(const bf16x8*)(GQ + it * 8192 + (i * 64 + lane) * 8);
            const float dn = GD[it];
            const char* ring = smem + (n & 1) * 32768 + lane * 16;
            bf16x8 tf[4];
#pragma unroll
            for (int s = 0; s < 4; ++s) tf[s] = pack_frag(acc[2 * s], acc[2 * s + 1]);
#pragma unroll
            for (int m = 0; m < 8; ++m) {
                f32x4 a = acc[m] * dn;
#pragma unroll
                for (int s = 0; s < 4; ++s) a = mfma16(*(const bf16x8*)(ring + (m * 4 + s) * 1024), tf[s], a);
                acc[m] = a;
            }
#pragma unroll
            for (int tt = 0; tt < 4; ++tt) {
                f32x4 r = {0.f, 0.f, 0.f, 0.f};
#pragma unroll
                for (int s = 0; s < 4; ++s) r = mfma16(tf[s], qf[tt * 4 + s], r);
                *(u32x2*)(GR + it * 8192 + ((tt * 4 + (ew >> 1)) * 64 + lane) * 8 + 4 * (ew & 1)) = (u32x2){pk2(r.x, r.y), pk2(r.z, r.w)};
            }
        }
        bf16* TE = (bf16*)(p.ws + WS_GTE) + (size_t)(h * 16 + g) * 16384;
        const int s_ = ew >> 1, jj = 4 * (ew & 1) + (fr & 3), lg = fr >> 2;
#pragma unroll
        for (int m = 0; m < 8; ++m)
#pragma unroll
            for (int j = 0; j < 4; ++j) TE[((m * 4 + s_) * 64 + (4 * fq + j) + 16 * lg) * 8 + jj] = (bf16)f2bf(acc[m][j]);
    }
    asm volatile("s_waitcnt vmcnt(0)" ::: "memory");
    __syncthreads();
#undef L1_DMA
}
DEVI void gdnL2_item(const P& p, int item, char* smem) {
    const bf16* TE = (const bf16*)(p.ws + WS_GTE); const float* E0 = (const float*)(p.ws + WS_GE0); bf16* SG = (bf16*)(p.ws + WS_GSG);
    const int h = item >> 1, tid = VTID, lane = tid & 63, ew = (item & 1) * 4 + (tid >> 6);
#define L2_DMA(g) do { const bf16* _s = TE + ((size_t)h * 16 + (g)) * 16384 + tid * 8; char* _d = smem + ((g) & 1) * 32768 + tid * 16; \
        _Pragma("unroll") for (int _i = 0; _i < 8; ++_i) __builtin_amdgcn_global_load_lds((const unsigned*)(_s + _i * 2048), (unsigned*)(_d + _i * 4096), 16, 0, 0); } while (0)
    f32x4 acc[8];
#pragma unroll
    for (int m = 0; m < 8; ++m) acc[m] = (f32x4){0.f, 0.f, 0.f, 0.f};
    L2_DMA(0);
    f32x4 bcur[8], bnxt[8];
    {
        const float* En = E0 + (size_t)h * 16 * 16384 + (ew * 8 * 64 + lane) * 4;
#pragma unroll
        for (int m = 0; m < 8; ++m) bcur[m] = *(const f32x4*)(En + m * 256);
    }
#pragma unroll 1
    for (int g = 0; g < 16; ++g) {
        const size_t hg = (size_t)h * 16 + g;
        asm volatile("s_waitcnt vmcnt(0)" ::: "memory");
        __syncthreads();
        if (g + 1 < 16) {
            L2_DMA(g + 1);
            const float* En = E0 + (hg + 1) * 16384 + (ew * 8 * 64 + lane) * 4;
#pragma unroll
            for (int m = 0; m < 8; ++m) bnxt[m] = *(const f32x4*)(En + m * 256);
        }
        const char* ring = smem + (g & 1) * 32768 + lane * 16;
        bf16x8 sf[4];
#pragma unroll
        for (int s = 0; s < 4; ++s) {
            sf[s] = pack_frag(acc[2 * s], acc[2 * s + 1]);
            *(bf16x8*)(SG + hg * 16384 + ((ew * 4 + s) * 64 + lane) * 8) = sf[s];
        }
#pragma unroll
        for (int m = 0; m < 8; ++m) {
            f32x4 a = bcur[m];
#pragma unroll
            for (int s = 0; s < 4; ++s) a = mfma16(*(const bf16x8*)(ring + (m * 4 + s) * 1024), sf[s], a);
            acc[m] = a;
        }
#pragma unroll
        for (int m = 0; m < 8; ++m) bcur[m] = bnxt[m];
    }
    asm volatile("s_waitcnt vmcnt(0)" ::: "memory");
    __syncthreads();
#undef L2_DMA
}

DEVI void gdnC_item(const P& p, int item, int l) {
    const bf16* GQ = (const bf16*)(p.ws + WS_GQ) + (size_t)item * 8192; const float* GO = (const float*)(p.ws + WS_GO) + (size_t)item * 8192;
    const bf16* GS = (const bf16*)(p.ws + WS_GS) + (size_t)item * 16384;
    const bf16* PROJ = (const bf16*)(p.ws + WS_PROJ); bf16* MIX = (bf16*)(p.ws + WS_MIX);
    const float* gn = p.in[24] + l * 128;
    const int n = item >> 2, h = item & 3;
    const int lane = VTID & 63, ct = VTID >> 6, fr = lane & 15, fq = lane >> 4;
    const bf16* GR = (const bf16*)(p.ws + WS_GR) + (size_t)item * 8192;
    const bf16* SG = (const bf16*)(p.ws + WS_GSG) + (size_t)(h * 16 + (n >> 4)) * 16384;
    bf16x8 qf[4], rf[4];
#pragma unroll
    for (int s = 0; s < 4; ++s) { qf[s] = *(const bf16x8*)(GQ + ((ct * 4 + s) * 64 + lane) * 8); rf[s] = *(const bf16x8*)(GR + ((ct * 4 + s) * 64 + lane) * 8); }
    const int t = n * 64 + 16 * ct + fr;
    f32x4 a[8];
    float ss = 0.f;
    u32x2 zr[8]; f32x4 gv[8];
#pragma unroll
    for (int et = 0; et < 8; ++et) { zr[et] = *(const u32x2*)(PROJ + (size_t)t * NPROJ + 2560 + h * 128 + 16 * et + 4 * fq); gv[et] = *(const f32x4*)(gn + 16 * et + 4 * fq); }
#pragma unroll
    for (int e2 = 0; e2 < 4; ++e2) {
        f32x4 c0[2]; bf16x8 gs[2][4], sg[2][4];
#pragma unroll
        for (int u = 0; u < 2; ++u) {
            const int et = 2 * e2 + u;
            c0[u] = *(const f32x4*)(GO + ((ct * 8 + et) * 64 + lane) * 4);
#pragma unroll
            for (int s = 0; s < 4; ++s) { gs[u][s] = *(const bf16x8*)(GS + ((et * 4 + s) * 64 + lane) * 8); sg[u][s] = *(const bf16x8*)(SG + ((et * 4 + s) * 64 + lane) * 8); }
        }
        asm volatile("" ::: "memory");
#pragma unroll
        for (int u = 0; u < 2; ++u) {
            f32x4 acc = c0[u];
#pragma unroll
            for (int s = 0; s < 4; ++s) acc = mfma16(gs[u][s], qf[s], acc);
#pragma unroll
            for (int s = 0; s < 4; ++s) acc = mfma16(sg[u][s], rf[s], acc);
            a[2 * e2 + u] = acc;
            ss += acc.x * acc.x + acc.y * acc.y + acc.z * acc.z + acc.w * acc.w;
        }
    }
    const float rs = rsqrtf(quad_sum(ss) * (1.f / 128.f) + 1e-6f);
#pragma unroll
    for (int et = 0; et < 8; ++et) {
        const int e = 16 * et + 4 * fq;
        const f32x4 z = {__uint_as_float(zr[et].x << 16), __uint_as_float(zr[et].x & 0xffff0000u), __uint_as_float(zr[et].y << 16), __uint_as_float(zr[et].y & 0xffff0000u)};
        const f32x4 o = a[et] * rs * gv[et];
        *(u32x2*)(MIX + (size_t)t * D + 256 + h * 128 + e) = (u32x2){pk2(o.x * siluf_(z.x), o.y * siluf_(z.y)), pk2(o.z * siluf_(z.z), o.w * siluf_(z.w))};
    }
}

DEVI void rwkA_item(const P& p, int item, char* smem) {
    const bf16* REC = (const bf16*)(p.ws + WS_RECR); const float* WDEC = (const float*)(p.ws + WS_WDEC);
    bf16* WP = (bf16*)(p.ws + WS_WP) + (size_t)item * 4096; float* WC = (float*)(p.ws + WS_WC) + (size_t)item * 4096;
    float* WD = (float*)(p.ws + WS_WD) + (size_t)item * 64;
    bf16* WQ = (bf16*)(p.ws + WS_WQ) + (size_t)item * 2048; float* WY = (float*)(p.ws + WS_WY) + (size_t)item * 2048;
    bf16* At_ = (bf16*)smem; bf16* Rt = At_ + 32 * 72; bf16* Bt = Rt + 32 * 72; bf16* Kt = Bt + 32 * 72;
    float* ZT = (float*)(smem + 9216);
    bf16* BhT = (bf16*)(smem + 18432); bf16* KhT = BhT + 64 * 40; bf16* VT = KhT + 64 * 40; bf16* AhT = VT + 64 * 40; bf16* UhT = AhT + 64 * 40;
    float* M = (float*)(smem + 44032);
    bf16* Aak = (bf16*)(smem + 48128); bf16* Arb = Aak + 32 * 40; bf16* Ark = Arb + 32 * 40;
    float* tot = (float*)(smem + 55808);
    const int n = item >> 2, h = item & 3;
    int tid = VTID; asm volatile("" : "+v"(tid));
    const int lane = tid & 63, w = tid >> 6, fr = lane & 15, fq = lane >> 4;
    {
        const int d = lane;
        const bf16* rec = REC + ((size_t)(n * 32 + 8 * w) * 4 + h) * 384 + d;
        const float* dcy = WDEC + (size_t)(n * 32 + 8 * w) * 256 + h * 64 + d;
        float lw[8], lg[8];
        float run = 0.f;
        float dcv[8]; bf16 ra[8], rb[8], rk[8], rr_[8], rv[8];
#pragma unroll
        for (int i = 0; i < 8; ++i) {
            const bf16* r = rec + (size_t)i * 1536;
            dcv[i] = dcy[i * 256]; ra[i] = r[0]; rb[i] = r[128]; rk[i] = r[192]; rr_[i] = r[256]; rv[i] = r[320];
        }
        asm volatile("" ::: "memory");
#pragma unroll
        for (int i = 0; i < 8; ++i) { lg[i] = __logf(dcv[i]); run += lg[i]; lw[i] = run; }
        tot[w * 64 + d] = run;
        __syncthreads();
        float off = 0.f, total = 0.f;
#pragma unroll
        for (int q = 0; q < 4; ++q) { const float tq = tot[q * 64 + d]; total += tq; off += (q < w) ? tq : 0.f; }
        unsigned bh[4], kh[4], vv[4];
        float pb = 0.f, pk = 0.f, pv = 0.f;
#pragma unroll
        for (int i = 0; i < 8; ++i) {
            const float a = bf2f(ra[i]), b = bf2f(rb[i]), k = bf2f(rk[i]), rr = bf2f(rr_[i]), v = bf2f(rv[i]);
            const float lc = off + lw[i];
            const float cw = __expf(lc), cwm1 = __expf(lc - lg[i]), inv = __expf(-lc), rat = __expf(total - lc);
            const int t = 8 * w + i;
            At_[t * 72 + d] = (bf16)f2bf(a * cwm1); Rt[t * 72 + d] = (bf16)f2bf(rr * cw);
            Bt[t * 72 + d] = (bf16)f2bf(b * inv); Kt[t * 72 + d] = (bf16)f2bf(k * inv);
            if (i & 1) { bh[i >> 1] = pk2(pb, b * rat); kh[i >> 1] = pk2(pk, k * rat); vv[i >> 1] = pk2(pv, v); }
            else { pb = b * rat; pk = k * rat; pv = v; }
        }
        *(u32x4*)(BhT + d * 40 + 8 * w) = (u32x4){bh[0], bh[1], bh[2], bh[3]};
        *(u32x4*)(KhT + d * 40 + 8 * w) = (u32x4){kh[0], kh[1], kh[2], kh[3]};
        *(u32x4*)(VT + d * 40 + 8 * w) = (u32x4){vv[0], vv[1], vv[2], vv[3]};
        if (w == 0) WD[d] = __expf(total);
    }
    __syncthreads();
    {
        int offA = (w == 0) ? 0 : (w == 1 ? 3 : (w == 2 ? 2 : 3));
        int offB = (w == 0) ? 2 : (w == 1 ? 0 : 1);
        asm volatile("" : "+v"(offA), "+v"(offB));
        const bf16* As = At_ + offA * (32 * 72); const bf16* Bs = At_ + offB * (32 * 72);
#pragma unroll
        for (int ta = 0; ta < 2; ++ta) {
            const bf16x8 a0 = ldfrag(As, 72, 16 * ta, 0, lane), a1 = ldfrag(As, 72, 16 * ta, 32, lane);
#pragma unroll
            for (int tb = 0; tb < 2; ++tb) {
                f32x4 acc = {0.f, 0.f, 0.f, 0.f};
                acc = mfma16(a0, ldfrag(Bs, 72, 16 * tb, 0, lane), acc);
                acc = mfma16(a1, ldfrag(Bs, 72, 16 * tb, 32, lane), acc);
                if (w == 0) {
                    const int s_ = 16 * tb + fr;
#pragma unroll
                    for (int j = 0; j < 4; ++j) { const int t = 16 * ta + 4 * fq + j; M[t * 32 + s_] = (t > s_) ? -acc[j] : 0.f; }
                } else {
                    const int t = 16 * tb + fr;
                    float pv4[4];
#pragma unroll
                    for (int j = 0; j < 4; ++j) { const int s_ = 16 * ta + 4 * fq + j; pv4[j] = ((w == 1) ? (t > s_) : (t >= s_)) ? acc[j] : 0.f; }
                    int offD = w - 1; asm volatile("" : "+v"(offD));
                    *(u32x2*)(Aak + offD * (32 * 40) + t * 40 + 16 * ta + 4 * fq) = (u32x2){pk2(pv4[0], pv4[1]), pk2(pv4[2], pv4[3])};
                }
            }
        }
    }
    __syncthreads();
    {
        const int et = w;
        const bf16x8 vf = ldfrag(VT, 40, 16 * et, 0, lane);
#pragma unroll
        for (int tt = 0; tt < 2; ++tt) {
            f32x4 acc = {0.f, 0.f, 0.f, 0.f};
            acc = mfma16(ldfrag(Aak, 40, 16 * tt, 0, lane), vf, acc);
            *(f32x4*)(ZT + (16 * et + fr) * 36 + 16 * tt + 4 * fq) = acc;
        }
    }
    __syncthreads();
    if (tid < 128) {
        float x[32];
        if (tid < 64) {
#pragma unroll
            for (int t = 0; t < 32; ++t) x[t] = bf2f(At_[t * 72 + tid]);
        } else {
#pragma unroll
            for (int q = 0; q < 8; ++q) { const f32x4 z = *(const f32x4*)(ZT + (tid - 64) * 36 + 4 * q); x[4 * q] = z.x; x[4 * q + 1] = z.y; x[4 * q + 2] = z.z; x[4 * q + 3] = z.w; }
        }
        SolveRow<1, 32>::run(x, M);
        bf16* dst = AhT + tid * 40;
#pragma unroll
        for (int q = 0; q < 4; ++q)
            *(u32x4*)(dst + 8 * q) = (u32x4){pk2(x[8 * q], x[8 * q + 1]), pk2(x[8 * q + 2], x[8 * q + 3]), pk2(x[8 * q + 4], x[8 * q + 5]), pk2(x[8 * q + 6], x[8 * q + 7])};
    }
    __syncthreads();
    {
        const int mt = w;
        const bf16x8 bh = ldfrag(BhT, 40, 16 * mt, 0, lane), kh = ldfrag(KhT, 40, 16 * mt, 0, lane);
#pragma unroll
        for (int sp = 0; sp < 2; ++sp) {
            f32x4 a0 = {0.f, 0.f, 0.f, 0.f}, a1 = {0.f, 0.f, 0.f, 0.f};
            a0 = mfma16(ldfrag(AhT, 40, 32 * sp, 0, lane), bh, a0);
            a1 = mfma16(ldfrag(AhT, 40, 32 * sp + 16, 0, lane), bh, a1);
            *(u32x4*)(WP + ((mt * 2 + sp) * 64 + lane) * 8) = (u32x4){pk2(a0.x, a0.y), pk2(a0.z, a0.w), pk2(a1.x, a1.y), pk2(a1.z, a1.w)};
        }
#pragma unroll
        for (int nt = 0; nt < 4; ++nt) {
            f32x4 a = {0.f, 0.f, 0.f, 0.f};
            a = mfma16(bh, ldfrag(UhT, 40, 16 * nt, 0, lane), a);
            a = mfma16(kh, ldfrag(VT, 40, 16 * nt, 0, lane), a);
            *(f32x4*)(WC + ((nt * 4 + mt) * 64 + lane) * 4) = a;
        }
        {
            const int ct = w & 1, sp = w >> 1, t = 16 * ct + fr;
            const bf16x8 ar = ldfrag(Arb, 40, 16 * ct, 0, lane);
            f32x4 a0 = ld_bf4(Rt + t * 72 + 32 * sp + 4 * fq), a1 = ld_bf4(Rt + t * 72 + 32 * sp + 16 + 4 * fq);
            a0 = mfma16(ldfrag(AhT, 40, 32 * sp, 0, lane), ar, a0);
            a1 = mfma16(ldfrag(AhT, 40, 32 * sp + 16, 0, lane), ar, a1);
            *(u32x4*)(WQ + ((ct * 2 + sp) * 64 + lane) * 8) = (u32x4){pk2(a0.x, a0.y), pk2(a0.z, a0.w), pk2(a1.x, a1.y), pk2(a1.z, a1.w)};
        }
        {
            const int et = w;
            const bf16x8 uf = ldfrag(UhT, 40, 16 * et, 0, lane), vf = ldfrag(VT, 40, 16 * et, 0, lane);
#pragma unroll
            for (int ct = 0; ct < 2; ++ct) {
                f32x4 a = {0.f, 0.f, 0.f, 0.f};
                a = mfma16(uf, ldfrag(Arb, 40, 16 * ct, 0, lane), a);
                a = mfma16(vf, ldfrag(Ark, 40, 16 * ct, 0, lane), a);
                *(f32x4*)(WY + ((ct * 4 + et) * 64 + lane) * 4) = a;
            }
        }
    }
    __syncthreads();
}

struct RwkStep { bf16x8 pf[8]; f32x4 cf[4]; f32x4 dv[4]; };
DEVI void rwk_load(RwkStep& r, const bf16* WP, const float* WC, const float* WD, size_t it, int ew, int lane) {
#pragma unroll
    for (int i = 0; i < 8; ++i) r.pf[i] = *(const bf16x8*)(WP + it * 4096 + (i * 64 + lane) * 8);
#pragma unroll
    for (int m = 0; m < 4; ++m) r.cf[m] = *(const f32x4*)(WC + it * 4096 + ((ew * 4 + m) * 64 + lane) * 4);
#pragma unroll
    for (int m = 0; m < 4; ++m) r.dv[m] = *(const f32x4*)(WD + it * 64 + 16 * m + 4 * (lane >> 4));
}
DEVI void rwk_step(const RwkStep& r, f32x4 (&acc)[4], bf16* WSF, size_t it, int ew, int lane) {
    bf16x8 sf[2];
#pragma unroll
    for (int s = 0; s < 2; ++s) {
        const u32x4 v = {pk2(acc[2 * s].x, acc[2 * s].y), pk2(acc[2 * s].z, acc[2 * s].w), pk2(acc[2 * s + 1].x, acc[2 * s + 1].y), pk2(acc[2 * s + 1].z, acc[2 * s + 1].w)};
        *(u32x4*)(WSF + it * 4096 + ((ew * 2 + s) * 64 + lane) * 8) = v;
        sf[s] = __builtin_bit_cast(bf16x8, v);
    }
#pragma unroll
    for (int m = 0; m < 4; ++m) {
        f32x4 a = acc[m] * r.dv[m] + r.cf[m];
        a = mfma16(r.pf[m * 2], sf[0], a);
        a = mfma16(r.pf[m * 2 + 1], sf[1], a);
        acc[m] = a;
    }
}
DEVI void rwkL1_item(const P& p, int item) {
    const bf16* WP = (const bf16*)(p.ws + WS_WP); const float* WC = (const float*)(p.ws + WS_WC); const float* WD = (const float*)(p.ws + WS_WD);
    const int kind = item & 1, g = (item >> 1) & 15, h = item >> 5;
    const int lane = VTID & 63, ew = VTID >> 6, fr = lane & 15, fq = lane >> 4;
    f32x4 acc[4];
    if (kind == 0) {
        bf16* WSF = (bf16*)(p.ws + WS_WS);
#pragma unroll
        for (int m = 0; m < 4; ++m) acc[m] = (f32x4){0.f, 0.f, 0.f, 0.f};
        RwkStep A, B;
        const int n0 = g * 32;
        rwk_load(A, WP, WC, WD, (size_t)n0 * 4 + h, ew, lane);
#pragma unroll 1
        for (int n = n0; n < n0 + 32; n += 2) {
            rwk_load(B, WP, WC, WD, (size_t)(n + 1) * 4 + h, ew, lane);
            asm volatile("" ::: "memory");
            rwk_step(A, acc, WSF, (size_t)n * 4 + h, ew, lane);
            rwk_load(A, WP, WC, WD, (size_t)((n + 2 < n0 + 32) ? n + 2 : n) * 4 + h, ew, lane);
            asm volatile("" ::: "memory");
            rwk_step(B, acc, WSF, (size_t)(n + 1) * 4 + h, ew, lane);
        }
        float* E0 = (float*)(p.ws + WS_WE0) + (size_t)(h * 16 + g) * 4096 + (ew * 4 * 64 + lane) * 4;
#pragma unroll
        for (int m = 0; m < 4; ++m) *(f32x4*)(E0 + m * 256) = acc[m];
    } else {
        const bf16* WQ = (const bf16*)(p.ws + WS_WQ); bf16* WR = (bf16*)(p.ws + WS_WR);
#pragma unroll
        for (int m = 0; m < 4; ++m)
#pragma unroll
            for (int j = 0; j < 4; ++j) acc[m][j] = (m == ew && 4 * fq + j == fr) ? 1.f : 0.f;
#pragma unroll 1
        for (int n = g * 32; n < g * 32 + 32; ++n) {
            const size_t it = (size_t)n * 4 + h;
            bf16x8 pf[8], qf[4]; f32x4 dv[4];
#pragma unroll
            for (int i = 0; i < 8; ++i) pf[i] = *(const bf16x8*)(WP + it * 4096 + (i * 64 + lane) * 8);
#pragma unroll
            for (int i = 0; i < 4; ++i) qf[i] = *(const bf16x8*)(WQ + it * 2048 + (i * 64 + lane) * 8);
#pragma unroll
            for (int m = 0; m < 4; ++m) dv[m] = *(const f32x4*)(WD + it * 64 + 16 * m + 4 * fq);
            asm volatile("" ::: "memory");
            bf16x8 tf[2];
#pragma unroll
            for (int s = 0; s < 2; ++s) tf[s] = pack_frag(acc[2 * s], acc[2 * s + 1]);
#pragma unroll
            for (int tt = 0; tt < 2; ++tt) {
                f32x4 r = {0.f, 0.f, 0.f, 0.f};
                r = mfma16(tf[0], qf[tt * 2], r); r = mfma16(tf[1], qf[tt * 2 + 1], r);
                *(u32x2*)(WR + it * 2048 + ((tt * 2 + (ew >> 1)) * 64 + lane) * 8 + 4 * (ew & 1)) = (u32x2){pk2(r.x, r.y), pk2(r.z, r.w)};
            }
#pragma unroll
            for (int m = 0; m < 4; ++m) {
                f32x4 a = acc[m] * dv[m];
                a = mfma16(pf[m * 2], tf[0], a); a = mfma16(pf[m * 2 + 1], tf[1], a);
                acc[m] = a;
            }
        }
        bf16* TE = (bf16*)(p.ws + WS_WTE) + (size_t)(h * 16 + g) * 4096;
        const int s_ = ew >> 1, jj = 4 * (ew & 1) + (fr & 3), lg = fr >> 2;
#pragma unroll
        for (int m = 0; m < 4; ++m)
#pragma unroll
            for (int j = 0; j < 4; ++j) TE[((m * 2 + s_) * 64 + (4 * fq + j) + 16 * lg) * 8 + jj] = (bf16)f2bf(acc[m][j]);
    }
}
DEVI void rwkL2_item(const P& p, int h) {
    const bf16* TE = (const bf16*)(p.ws + WS_WTE); const float* E0 = (const float*)(p.ws + WS_WE0); bf16* SG = (bf16*)(p.ws + WS_WSG);
    const int lane = VTID & 63, ew = VTID >> 6;
    f32x4 acc[4];
#pragma unroll
    for (int m = 0; m < 4; ++m) acc[m] = (f32x4){0.f, 0.f, 0.f, 0.f};
#pragma unroll 1
    for (int g = 0; g < 16; ++g) {
        const size_t hg = (size_t)h * 16 + g;
        bf16x8 pf[8]; f32x4 bfr[4];
#pragma unroll
        for (int i = 0; i < 8; ++i) pf[i] = *(const bf16x8*)(TE + hg * 4096 + (i * 64 + lane) * 8);
#pragma unroll
        for (int m = 0; m < 4; ++m) bfr[m] = *(const f32x4*)(E0 + hg * 4096 + ((ew * 4 + m) * 64 + lane) * 4);
        asm volatile("" ::: "memory");
        bf16x8 sf[2];
#pragma unroll
        for (int s = 0; s < 2; ++s) {
            sf[s] = pack_frag(acc[2 * s], acc[2 * s + 1]);
            *(bf16x8*)(SG + hg * 4096 + ((ew * 2 + s) * 64 + lane) * 8) = sf[s];
        }
#pragma unroll
        for (int m = 0; m < 4; ++m) {
            f32x4 a = bfr[m];
            a = mfma16(pf[m * 2], sf[0], a); a = mfma16(pf[m * 2 + 1], sf[1], a);
            acc[m] = a;
        }
    }
}

DEVI void rwkC_item(const P& p, int n, int l) {
    const int lane = VTID & 63, h = VTID >> 6, fr = lane & 15, fq = lane >> 4;
    const size_t it = (size_t)n * 4 + h;
    const bf16* WQ = (const bf16*)(p.ws + WS_WQ) + it * 2048; const float* WY = (const float*)(p.ws + WS_WY) + it * 2048;
    const bf16* WSF = (const bf16*)(p.ws + WS_WS) + it * 4096;
    const bf16* WR = (const bf16*)(p.ws + WS_WR) + it * 2048; const bf16* WSG = (const bf16*)(p.ws + WS_WSG) + (size_t)(h * 16 + (n >> 5)) * 4096;
    const bf16* RECR = (const bf16*)(p.ws + WS_RECR); const float* GB = (const float*)(p.ws + WS_G); const float* BON = (const float*)(p.ws + WS_BON);
    bf16* MIX = (bf16*)(p.ws + WS_MIX);
    const float* ln_g = p.in[17] + l * 256 + h * 64; const float* ln_b = p.in[18] + l * 256 + h * 64;
#pragma unroll
    for (int ct = 0; ct < 2; ++ct) {
        const bf16x8 q0 = *(const bf16x8*)(WQ + ((ct * 2 + 0) * 64 + lane) * 8), q1 = *(const bf16x8*)(WQ + ((ct * 2 + 1) * 64 + lane) * 8);
        const bf16x8 r0 = *(const bf16x8*)(WR + ((ct * 2 + 0) * 64 + lane) * 8), r1 = *(const bf16x8*)(WR + ((ct * 2 + 1) * 64 + lane) * 8);
        const int t = n * 32 + 16 * ct + fr;
        f32x4 a[4];
        float sm = 0.f;
        f32x4 y0[4]; bf16x8 sfr[4][2], sgr[4][2];
#pragma unroll
        for (int et = 0; et < 4; ++et) {
            y0[et] = *(const f32x4*)(WY + ((ct * 4 + et) * 64 + lane) * 4);
#pragma unroll
            for (int s = 0; s < 2; ++s) { sfr[et][s] = *(const bf16x8*)(WSF + ((et * 2 + s) * 64 + lane) * 8); sgr[et][s] = *(const bf16x8*)(WSG + ((et * 2 + s) * 64 + lane) * 8); }
        }
        asm volatile("" ::: "memory");
#pragma unroll
        for (int et = 0; et < 4; ++et) {
            f32x4 acc = y0[et];
            acc = mfma16(sfr[et][0], q0, acc);
            acc = mfma16(sfr[et][1], q1, acc);
            acc = mfma16(sgr[et][0], r0, acc);
            acc = mfma16(sgr[et][1], r1, acc);
            a[et] = acc; sm += (acc.x + acc.y) + (acc.z + acc.w);
        }
        const float mean = quad_sum(sm) * (1.f / 64.f);
        float sv = 0.f;
#pragma unroll
        for (int et = 0; et < 4; ++et) { a[et] = a[et] - mean; sv += a[et].x * a[et].x + a[et].y * a[et].y + a[et].z * a[et].z + a[et].w * a[et].w; }
        const float rs = rsqrtf(quad_sum(sv) * (1.f / 64.f) + 64e-5f);
        const float bon = BON[(size_t)t * 4 + h];
        f32x4 gq[4], bq[4], vq[4], gateq[4];
#pragma unroll
        for (int et = 0; et < 4; ++et) {
            const int e = 16 * et + 4 * fq;
            gq[et] = *(const f32x4*)(ln_g + e); bq[et] = *(const f32x4*)(ln_b + e);
            vq[et] = ld_bf4(RECR + ((size_t)t * 4 + h) * 384 + 320 + e);
            gateq[et] = *(const f32x4*)(GB + (size_t)t * 256 + h * 64 + e);
        }
        asm volatile("" ::: "memory");
#pragma unroll
        for (int et = 0; et < 4; ++et) {
            const int e = 16 * et + 4 * fq;
            const f32x4 g = gq[et], b = bq[et];
            const f32x4 v = vq[et];
            const f32x4 gate = gateq[et];
            const f32x4 o = (a[et] * rs * g + b + v * bon) * gate;
            *(u32x2*)(MIX + (size_t)t * D + h * 64 + e) = (u32x2){pk2(o.x, o.y), pk2(o.z, o.w)};
        }
    }
}

DEVI void phase_scanL1(const P& p, char* smem) {
    for (int item = VBID; item < 448; item += VNB) {
        if (item < 256) gdnL1_item(p, item, smem);
        else if (item < 384) rwkL1_item(p, item - 256);
        else retS_item(p, item - 384);
    }
}
DEVI void retC_item(const P& p, int item, int l, char* smem);
DEVI void phase_scanL2(const P& p, int l, char* smem) {
    if (VBID < 12) { if (VBID < 8) gdnL2_item(p, VBID, smem); else rwkL2_item(p, VBID - 8); }
    else { for (int item = VBID - 12; item < 1024; item += VNB - 12) retC_item(p, item, l, smem); }
}
DEVI void phase_chunkA(const P& p, char* smem) {
    for (int item = VBID; item < 4096; item += VNB) { if (item < 1024) gdnA_item(p, item, smem); else if (item < 3072) rwkA_item(p, item - 1024, smem); else retA_item(p, item - 3072, smem); }
}
DEVI void phase_chunkC(const P& p, int l, char* smem) {
    for (int item = VBID; item < 1536; item += VNB) { if (item < 1024) gdnC_item(p, item, l); else rwkC_item(p, item - 1024, l); }
}

DEVI void phase_ln1_route(const P& p, int l, char* smem, bool commit = true) {
    const float* ADA = (const float*)(p.ws + OFF_ADA) + l * 6144;
    const float* xin = (l == 0) ? p.in[0] : (const float*)(p.ws + WS_X);
    const float* OPRE = (const float*)(p.ws + WS_OPRE);
    float* X = (float*)(p.ws + WS_X); bf16* H2 = (bf16*)(p.ws + WS_H2);
    const float* lg = p.in[28] + l * D; const float* lb = p.in[29] + l * D;
    const float* rw = p.in[30] + (size_t)l * D * 32; const float* rbias = p.in[31] + l * 32;
    int* CNT = (int*)(p.ws + OFF_CNT) + l * 32 * 64; int* LIST = (int*)(p.ws + WS_LIST); float* GATE = (float*)(p.ws + WS_GATE);
    float* HS = (float*)smem;
    float* RED = HS;
    int* SEL = (int*)(HS + 16 * 1024);
    int* RNK = SEL + 256;
    int* BASE = RNK + 256;
    int nasg = 0;
    const int tid = VTID, lane = tid & 63, w = tid >> 6;
    for (int item = VBID; item < S / 16; item += VNB) {
#pragma unroll 1
        for (int sub = 0; sub < 4; ++sub) {
            const int t = item * 16 + sub * 4 + w;
            f32x4 v[4]; float s = 0.f;
#pragma unroll
            for (int j = 0; j < 4; ++j) {
                const int c = j * 256 + lane * 4;
                const f32x4 x = *(const f32x4*)(xin + (size_t)t * D + c);
                const f32x4 o = *(const f32x4*)(OPRE + (size_t)t * D + c);
                const f32x4 gt = *(const f32x4*)(ADA + 2048 + c);
                v[j].x = DN_ALPHA * x.x + (1.f + gt.x) * o.x; v[j].y = DN_ALPHA * x.y + (1.f + gt.y) * o.y;
                v[j].z = DN_ALPHA * x.z + (1.f + gt.z) * o.z; v[j].w = DN_ALPHA * x.w + (1.f + gt.w) * o.w;
                s += (v[j].x + v[j].y) + (v[j].z + v[j].w);
            }
            const float mean = wave_sum(s) * (1.f / D);
            float s2 = 0.f;
#pragma unroll
            for (int j = 0; j < 4; ++j) { v[j] = v[j] - mean; s2 += (v[j].x * v[j].x + v[j].y * v[j].y) + (v[j].z * v[j].z + v[j].w * v[j].w); }
            const float rstd = rsqrtf(wave_sum(s2) * (1.f / D) + 1e-5f);
#pragma unroll
            for (int j = 0; j < 4; ++j) {
                const int c = j * 256 + lane * 4;
                const f32x4 g = *(const f32x4*)(lg + c), b = *(const f32x4*)(lb + c);
                f32x4 xo = v[j] * rstd * g + b;
                *(f32x4*)(X + (size_t)t * D + c) = xo;
                const f32x4 sh = *(const f32x4*)(ADA + 3072 + c), sc = *(const f32x4*)(ADA + 4096 + c);
                f32x4 hh = xo * (1.f + sc) + sh;
                *(f32x4*)(HS + (sub * 4 + w) * 1024 + c) = hh;
                u32x2 o; o.x = pk2(hh.x, hh.y); o.y = pk2(hh.z, hh.w);
                *(u32x2*)(H2 + (size_t)t * D + c) = o;
            }
        }
        __syncthreads();
        float ac[16];
        {
            const int e = tid & 31, ks = tid >> 5;
#pragma unroll
            for (int q = 0; q < 16; ++q) ac[q] = 0.f;
#pragma unroll 2
            for (int k = ks * 128; k < ks * 128 + 128; k += 4) {
                const float w0 = rw[(k + 0) * 32 + e], w1 = rw[(k + 1) * 32 + e], w2 = rw[(k + 2) * 32 + e], w3 = rw[(k + 3) * 32 + e];
#pragma unroll
                for (int q = 0; q < 16; ++q) { const f32x4 hq = *(const f32x4*)(HS + q * 1024 + k); ac[q] += hq.x * w0 + hq.y * w1 + hq.z * w2 + hq.w * w3; }
            }
        }
        __syncthreads();
        {
            const int e = tid & 31, ks = tid >> 5;
#pragma unroll
            for (int q = 0; q < 16; ++q) RED[(ks * 16 + q) * 32 + e] = ac[q];
        }
        __syncthreads();
#pragma unroll 1
        for (int rnd = 0; rnd < 2; ++rnd) {
            const int tok = rnd * 8 + (tid >> 5), e = tid & 31, tt = item * 16 + tok;
            float logit = rbias[e];
#pragma unroll
            for (int ks = 0; ks < 8; ++ks) logit += RED[(ks * 16 + tok) * 32 + e];
            bool taken = false;
            float sv[4]; int si[4];
#pragma unroll
            for (int j = 0; j < 4; ++j) {
                float cand = taken ? -3.0e38f : logit; int ci = e;
#pragma unroll
                for (int off = 16; off >= 1; off >>= 1) {
                    const float ov = __shfl_xor(cand, off, 32); const int oi = __shfl_xor(ci, off, 32);
                    if (ov > cand || (ov == cand && oi < ci)) { cand = ov; ci = oi; }
                }
                sv[j] = cand; si[j] = ci; if (ci == e) taken = true;
            }
            const float e0 = 1.f, e1 = __expf(sv[1] - sv[0]), e2 = __expf(sv[2] - sv[0]), e3 = __expf(sv[3] - sv[0]);
            const float inv = 1.f / (e0 + e1 + e2 + e3);
            const float gts[4] = {e0 * inv, e1 * inv, e2 * inv, e3 * inv};
#pragma unroll
            for (int j = 0; j < 4; ++j) {
                if (si[j] == e) {
                    SEL[nasg + tok * 4 + j] = ((tt * 4 + j) << 5) | e;
                    GATE[(size_t)tt * 4 + j] = gts[j];
                }
            }
        }
        nasg += 64;
        __syncthreads();
    }
    if (!commit) return;
    if (tid < 32) {
        int c = 0;
        for (int a = 0; a < nasg; ++a) { if ((SEL[a] & 31) == tid) { RNK[a] = c; ++c; } }
        BASE[tid] = c ? atomicAdd(&CNT[tid * 64], c) : 0;
    }
    __syncthreads();
    for (int a = tid; a < nasg; a += NT) { const int v = SEL[a], e = v & 31; LIST[(size_t)e * S + BASE[e] + RNK[a]] = v >> 5; }
    __syncthreads();
}

DEVI void phase_ln2(const P& p, int l) {
    const float* ADA = (const float*)(p.ws + OFF_ADA) + l * 6144;
    const float* ADAn = (const float*)(p.ws + OFF_ADA) + 6144;
    float* X = (float*)(p.ws + WS_X); const bf16* YB = (const bf16*)(p.ws + WS_YB);
    bf16* HB = (bf16*)(p.ws + WS_HB);
    const float* lg = p.in[36] + l * D; const float* lb = p.in[37] + l * D;
    const int tid = VTID, lane = tid & 63, w = tid >> 6;
    for (int item = VBID; item < S / 4; item += VNB) {
        const int t = item * 4 + w;
        f32x4 v[4]; float s = 0.f;
#pragma unroll
        for (int j = 0; j < 4; ++j) {
            const int c = j * 256 + lane * 4;
            const f32x4 x = *(const f32x4*)(X + (size_t)t * D + c);
            f32x4 f = {0.f, 0.f, 0.f, 0.f};
#pragma unroll
            for (int q = 0; q < 4; ++q) {
                const u32x2 y = *(const u32x2*)(YB + ((size_t)t * 4 + q) * D + c);
                f.x += __uint_as_float(y.x << 16); f.y += __uint_as_float(y.x & 0xffff0000u);
                f.z += __uint_as_float(y.y << 16); f.w += __uint_as_float(y.y & 0xffff0000u);
            }
            const f32x4 gt = *(const f32x4*)(ADA + 5120 + c);
            v[j] = x * DN_ALPHA + (gt + 1.f) * f;
            s += (v[j].x + v[j].y) + (v[j].z + v[j].w);
        }
        const float mean = wave_sum(s) * (1.f / D);
        float s2 = 0.f;
#pragma unroll
        for (int j = 0; j < 4; ++j) { v[j] = v[j] - mean; s2 += (v[j].x * v[j].x + v[j].y * v[j].y) + (v[j].z * v[j].z + v[j].w * v[j].w); }
        const float rstd = rsqrtf(wave_sum(s2) * (1.f / D) + 1e-5f);
#pragma unroll
        for (int j = 0; j < 4; ++j) {
            const int c = j * 256 + lane * 4;
            const f32x4 g = *(const f32x4*)(lg + c), b = *(const f32x4*)(lb + c);
            const f32x4 xo = v[j] * rstd * g + b;
            if (l == 0) {
                *(f32x4*)(X + (size_t)t * D + c) = xo;
                const f32x4 sh = *(const f32x4*)(ADAn + c), sc = *(const f32x4*)(ADAn + 1024 + c);
                const f32x4 hh = xo * (sc + 1.f) + sh;
                u32x2 o; o.x = pk2(hh.x, hh.y); o.y = pk2(hh.z, hh.w);
                *(u32x2*)(HB + (size_t)t * D + c) = o;
            } else {
                *(f32x4*)(p.out + (size_t)t * D + c) = xo;
            }
        }
    }
}

namespace pg8 {
constexpr int BK = 64, HALF = 128, HTB = HALF * BK * 2, STAGE_BYTES = 8 * HTB;
DEVI int lds_byte(int r, int c) { const int st = (r >> 4) * 2 + (c >> 5), rr = r & 15, cc = c & 31, ob = rr * 64 + cc * 2; return st * 1024 + (ob ^ (((ob >> 9) & 1) << 5)); }
DEVI void stage_rc(int b, int& R, int& C) { const int st = b / 1024, sb = b % 1024, swz = sb ^ (((sb >> 9) & 1) << 5); R = (st >> 1) * 16 + swz / 64; C = (st & 1) * 32 + (swz % 64) / 2; }
struct Unit { const char* a; const char* b; int x0, x1, x2, x3; };

template <class Epi, class Sched>
DEVI void gemm_phase(LAS unsigned char* lds, const int K, const Sched& S, const Epi& E) {
    const int tid = threadIdx.x, wid = __builtin_amdgcn_readfirstlane(tid >> 6), lane = tid & 63, wr = wid >> 2, wc = wid & 3, fr = lane & 15, fq = lane >> 4;
    const int nt = K / BK;
    unsigned voffA[2], voffB[2];
    int gR[2], gC[2];
#pragma unroll
    for (int i = 0; i < 2; ++i) { int R, C; stage_rc(tid * 16 + i * 8192, R, C); gR[i] = R; gC[i] = C; voffA[i] = (unsigned)(R * K + C) * 2u; voffB[i] = (unsigned)(Epi::brow(R) * K + C) * 2u; }
    unsigned co[2][2], no[2][2];
#define PG8_GOFF(dst, tab) do { _Pragma("unroll") for (int _h = 0; _h < 2; ++_h) _Pragma("unroll") for (int _i = 0; _i < 2; ++_i) \
        dst[_h][_i] = (unsigned)((tab)[_h * 128 + gR[_i]] * K + gC[_i]) * 2u; } while (0)
    const size_t kstep = (size_t)(BK * 2);
    const size_t hstepA = (size_t)HALF * K * 2, hstepB = (size_t)Epi::BHALF * K * 2;
    const unsigned ldsw = (unsigned)wid * 1024u;
    const int aoff = lds_byte(wr * 64 + fr, fq * 8), boff = lds_byte(wc * 32 + fr, fq * 8);
#define PG8_SA(b, h) (((b) * 2 + (h)) * HTB)
#define PG8_SB(b, h) ((4 + (b) * 2 + (h)) * HTB)
#define PG8_STAGE(bufoff, gbase, voff) do { _Pragma("unroll") for (int _i = 0; _i < 2; ++_i) \
        __builtin_amdgcn_global_load_lds((const unsigned*)((const char*)(gbase) + (voff)[_i]), (LAS unsigned*)(lds + (bufoff) + ldsw + _i * 8192), 16, 0, 0); } while (0)
#define PG8_LDA(dst, b, h) do { _Pragma("unroll") for (int m = 0; m < 4; ++m) _Pragma("unroll") for (int k = 0; k < 2; ++k) dst[m][k] = *(const LAS bf16x8*)(lds + PG8_SA(b, h) + aoff + m * 2048 + k * 1024); } while (0)
#define PG8_LDB(dst, b, h) do { _Pragma("unroll") for (int n = 0; n < 2; ++n) _Pragma("unroll") for (int k = 0; k < 2; ++k) dst[n][k] = *(const LAS bf16x8*)(lds + PG8_SB(b, h) + boff + n * 2048 + k * 1024); } while (0)
#define PG8_MMA(ai, bj, At, Bt) do { __builtin_amdgcn_s_setprio(1); _Pragma("unroll") for (int m = 0; m < 4; ++m) _Pragma("unroll") for (int n = 0; n < 2; ++n) _Pragma("unroll") for (int k = 0; k < 2; ++k) \
        acc[ai][bj][m][n] = __builtin_amdgcn_mfma_f32_16x16x32_bf16(Bt[n][k], At[m][k], acc[ai][bj][m][n], 0, 0, 0); __builtin_amdgcn_s_setprio(0); } while (0)
#define PG8_WAIT_V(n) asm volatile("s_waitcnt vmcnt(" #n ")" ::: "memory")
#define PG8_WAIT_L(n) asm volatile("s_waitcnt lgkmcnt(" #n ")" ::: "memory")
#define PG8_BAR __builtin_amdgcn_s_barrier()
#define PG8_SCHED __builtin_amdgcn_sched_barrier(0)
    Unit cur, nxt; int ui = 0;
    if (!S.next(0, cur)) return;
    f32x4 acc[2][2][4][2];
#pragma unroll
    for (int a = 0; a < 2; ++a)
#pragma unroll
        for (int b = 0; b < 2; ++b)
#pragma unroll
            for (int m = 0; m < 4; ++m)
#pragma unroll
                for (int n = 0; n < 2; ++n) acc[a][b][m][n] = (f32x4){0.f, 0.f, 0.f, 0.f};
    bf16x8 At[4][2], B0[2][2], B1[2][2];
    const char* cA = cur.a; const char* cB = cur.b;
    if constexpr (Epi::GATHER_A) { PG8_GOFF(co, S.rows(0)); PG8_WAIT_L(0); }
    else {
#pragma unroll
        for (int i = 0; i < 2; ++i) { co[0][i] = voffA[i]; co[1][i] = voffA[i] + (unsigned)hstepA; no[0][i] = co[0][i]; no[1][i] = co[1][i]; }
    }
    PG8_WAIT_V(0);
    PG8_STAGE(PG8_SB(0, 0), cB, voffB); PG8_STAGE(PG8_SA(0, 0), cA, co[0]); PG8_STAGE(PG8_SB(0, 1), cB + hstepB, voffB); PG8_STAGE(PG8_SA(0, 1), cA, co[1]);
    if (wr == 1) PG8_BAR;
    PG8_WAIT_V(4); PG8_BAR;
    PG8_STAGE(PG8_SB(1, 0), cB + kstep, voffB); PG8_STAGE(PG8_SA(1, 0), cA + kstep, co[0]); PG8_STAGE(PG8_SB(1, 1), cB + hstepB + kstep, voffB);
    PG8_WAIT_V(6); PG8_BAR;
    for (;;) {
        const bool has_next = S.next(ui + 1, nxt);
        const char* nA = has_next ? nxt.a : cA; const char* nB = has_next ? nxt.b : cB;
        if constexpr (Epi::GATHER_A) { if (has_next) PG8_GOFF(no, S.rows(ui + 1)); else { no[0][0] = co[0][0]; no[0][1] = co[0][1]; no[1][0] = co[1][0]; no[1][1] = co[1][1]; } }
        for (int t = 0; t < nt; t += 2) {
            const bool last = (t == nt - 2);
            const char* a1 = cA + (size_t)(t + 1) * kstep;
            const char* a2 = last ? nA : cA + (size_t)(t + 2) * kstep; const char* b2 = last ? nB : cB + (size_t)(t + 2) * kstep;
            const char* a3 = a2 + kstep; const char* b3 = b2 + kstep;
            unsigned fo[2][2];
#pragma unroll
            for (int h = 0; h < 2; ++h)
#pragma unroll
                for (int i = 0; i < 2; ++i) fo[h][i] = last ? no[h][i] : co[h][i];
            PG8_LDB(B0, 0, 0); PG8_SCHED; PG8_LDA(At, 0, 0); PG8_STAGE(PG8_SA(1, 1), a1, co[1]);
            PG8_WAIT_L(8); PG8_BAR; PG8_WAIT_L(0); PG8_MMA(0, 0, At, B0); PG8_BAR; PG8_SCHED;
            PG8_LDB(B1, 0, 1); PG8_STAGE(PG8_SB(0, 0), b2, voffB);
            PG8_BAR; PG8_WAIT_L(0); PG8_MMA(0, 1, At, B1); PG8_BAR;
            PG8_LDA(At, 0, 1); PG8_STAGE(PG8_SA(0, 0), a2, fo[0]);
            PG8_BAR; PG8_WAIT_L(0); PG8_MMA(1, 0, At, B0); PG8_BAR; PG8_SCHED;
            PG8_STAGE(PG8_SB(0, 1), b2 + hstepB, voffB);
            PG8_WAIT_V(6); PG8_BAR; PG8_MMA(1, 1, At, B1); PG8_BAR;
            PG8_LDB(B0, 1, 0); PG8_SCHED; PG8_LDA(At, 1, 0); PG8_STAGE(PG8_SA(0, 1), a2, fo[1]);
            PG8_WAIT_L(8); PG8_BAR; PG8_WAIT_L(0); PG8_MMA(0, 0, At, B0); PG8_BAR; PG8_SCHED;
            PG8_LDB(B1, 1, 1); PG8_STAGE(PG8_SB(1, 0), b3, voffB);
            PG8_BAR; PG8_WAIT_L(0); PG8_MMA(0, 1, At, B1); PG8_BAR;
            PG8_LDA(At, 1, 1); PG8_STAGE(PG8_SA(1, 0), a3, fo[0]);
            PG8_BAR; PG8_WAIT_L(0); PG8_MMA(1, 0, At, B0); PG8_BAR; PG8_SCHED;
            PG8_STAGE(PG8_SB(1, 1), b3 + hstepB, voffB);
            PG8_WAIT_V(6); PG8_BAR; PG8_MMA(1, 1, At, B1); PG8_BAR;
        }
        E(acc, cur, wr, wc, fr, fq);
        if (!has_next) break;
#pragma unroll
        for (int a = 0; a < 2; ++a)
#pragma unroll
            for (int b = 0; b < 2; ++b)
#pragma unroll
                for (int m = 0; m < 4; ++m)
#pragma unroll
                    for (int n = 0; n < 2; ++n) acc[a][b][m][n] = (f32x4){0.f, 0.f, 0.f, 0.f};
        cur = nxt; cA = nA; cB = nB; ++ui;
#pragma unroll
        for (int h = 0; h < 2; ++h) { co[h][0] = no[h][0]; co[h][1] = no[h][1]; }
    }
    PG8_WAIT_V(0);
    if (wr == 0) PG8_BAR;
    PG8_BAR;
#undef PG8_SA
#undef PG8_GOFF
#undef PG8_SB
#undef PG8_STAGE
#undef PG8_LDA
#undef PG8_LDB
#undef PG8_MMA
#undef PG8_WAIT_V
#undef PG8_WAIT_L
#undef PG8_BAR
#undef PG8_SCHED
}
}

struct SchedDense {
    const char* A; const char* B; int K; int mode;
    DEVI const int* rows(int) const { return nullptr; }
    DEVI bool next(int i, pg8::Unit& u) const {
        const int c = blockIdx.x, x = c & 7; int pm, pn;
        if (mode == 0) { if (i > 0) return false; const int j = c >> 3; pn = j & 3; pm = 8 * x + (j >> 2); }
        else { if (i > 3) return false; const int bk = i * 8 + x, j = c >> 3; pn = 8 * (bk & 1) + (j & 7); pm = 4 * (bk >> 1) + (j >> 3); }
        u.a = A + (size_t)pm * 256 * K * 2; u.b = B + (size_t)pn * 256 * K * 2; u.x0 = pm; u.x1 = pn; u.x2 = 0; u.x3 = 0;
        return true;
    }
};
struct EpiOutF32 {
    static constexpr bool GATHER_A = false; static constexpr int BHALF = 128; static DEVI int brow(int R) { return R; }
    float* C;
    DEVI void operator()(const f32x4 (&acc)[2][2][4][2], const pg8::Unit& u, int wr, int wc, int fr, int fq) const {
#pragma unroll
        for (int ai = 0; ai < 2; ++ai)
#pragma unroll
            for (int m = 0; m < 4; ++m) {
                float* rowp = C + (size_t)(u.x0 * 256 + ai * 128 + wr * 64 + m * 16 + fr) * D + u.x1 * 256 + wc * 32 + 4 * fq;
#pragma unroll
                for (int bj = 0; bj < 2; ++bj)
#pragma unroll
                    for (int n = 0; n < 2; ++n) *(f32x4*)(rowp + bj * 128 + n * 16) = acc[ai][bj][m][n];
            }
    }
};
struct EpiProjBf16 {
    static constexpr bool GATHER_A = false; static constexpr int BHALF = 128; static DEVI int brow(int R) { return R; }
    bf16* C;
    DEVI void operator()(const f32x4 (&acc)[2][2][4][2], const pg8::Unit& u, int wr, int wc, int fr, int fq) const {
#pragma unroll
        for (int ai = 0; ai < 2; ++ai)
#pragma unroll
            for (int m = 0; m < 4; ++m) {
                bf16* rowp = C + (size_t)(u.x0 * 256 + ai * 128 + wr * 64 + m * 16 + fr) * NPROJ + u.x1 * 256 + wc * 32 + 4 * fq;
#pragma unroll
                for (int bj = 0; bj < 2; ++bj)
#pragma unroll
                    for (int n = 0; n < 2; ++n) { const f32x4 v = acc[ai][bj][m][n]; *(u32x2*)(rowp + bj * 128 + n * 16) = (u32x2){pk2(v.x, v.y), pk2(v.z, v.w)}; }
            }
    }
};
DEVI void phase_outproj8(const P& p, int l, char* smem_all) {
    SchedDense Sd{(const char*)(p.ws + WS_MIX), (const char*)(p.ws + WS_WOUT) + (size_t)l * D * D * 2, D, 0};
    EpiOutF32 E{(float*)(p.ws + WS_OPRE)};
    pg8::gemm_phase(( LAS unsigned char*)smem_all, D, Sd, E);
}
DEVI void phase_inproj8(const P& p, int l, char* smem_all) {
    SchedDense Sd{(const char*)(p.ws + WS_HB), (const char*)(p.ws + WS_WIN) + (size_t)l * NPAD * D * 2, D, 1};
    EpiProjBf16 E{(bf16*)(p.ws + WS_PROJ)};
    pg8::gemm_phase((LAS unsigned char*)smem_all, D, Sd, E);
}
DEVI void phase_inproj_extras(const P& p, int l, char* smem) {
    const bf16* HB = (const bf16*)(p.ws + WS_HB);
    const bf16* W = (const bf16*)(p.ws + WS_WIN) + (size_t)l * NPAD * D;
    float* PEX = (float*)(p.ws + WS_PEX);
    const int lane = VTID & 63, wid = VTID >> 6, wr = wid >> 1, wc = wid & 1, fr = lane & 15, fq = lane >> 4;
    for (int mt = VBID; mt < S / 128; mt += VNB) {
        f32x4 acc[4][8];
        gemm_tile(smem, HB, [&](int r) { return (unsigned)((mt * 128 + r) * D); }, W, [&](int r) { return (unsigned)((16 * 256 + r) * D); }, D, acc);
        if (wc == 0) {
#pragma unroll
            for (int m = 0; m < 4; ++m) {
                const int tok = mt * 128 + wr * 64 + m * 16 + fr;
#pragma unroll
                for (int n = 0; n < 4; ++n) *(f32x4*)(PEX + (size_t)tok * 64 + n * 16 + fq * 4) = acc[m][n];
            }
        }
    }
}

struct MoeMap8 { int cnt[32]; int off[32]; int tstart[33]; };
DEVI void moe_map8(const P& p, int l, MoeMap8* mm) {
    const int* CNT = (const int*)(p.ws + OFF_CNT) + l * 32 * 64;
    if (threadIdx.x < 32) mm->cnt[threadIdx.x] = __hip_atomic_load(&CNT[threadIdx.x * 64], __ATOMIC_RELAXED, __HIP_MEMORY_SCOPE_AGENT);
    __syncthreads();
    if (threadIdx.x == 0) {
        int o = 0, ts = 0;
        for (int e = 0; e < 32; ++e) { mm->off[e] = o; mm->tstart[e] = ts; o += mm->cnt[e]; ts += (mm->cnt[e] + 255) / 256; }
        mm->tstart[32] = ts;
    }
    __syncthreads();
}
struct MoeUnits { int n; int pad[3]; int e[32]; int m0[32]; int pn[32]; };
struct SchedMoe {
    const MoeMap8* mm; const MoeUnits* mu; const char* A; const char* Bw; int K;
    size_t bexp, bpn;
    const int* rowtab; bool gather;
    DEVI const int* rows(int i) const { return rowtab + 256 * i; }
    DEVI bool next(int i, pg8::Unit& u) const {
        if (i >= mu->n) return false;
        const int e = mu->e[i], m0 = mu->m0[i], pn = mu->pn[i], off = mm->off[e];
        u.a = gather ? A : A + (size_t)(off + m0) * K * 2; u.b = Bw + (size_t)e * bexp + (size_t)pn * bpn;
        u.x0 = e; u.x1 = m0; u.x2 = pn; u.x3 = off;
        return true;
    }
};
DEVI void moe_units(const MoeMap8* mm, MoeUnits* mu, int npn_log) {
    if (threadIdx.x < 32) {
        const int x = (int)blockIdx.x & 7, j = (int)blockIdx.x >> 3, RT = mm->tstart[32], rpb = 32 >> npn_log;
        const int rt = rpb * ((int)threadIdx.x * 8 + x) + (j >> npn_log), pn = j & ((1 << npn_log) - 1);
        const bool ok = rt < RT;
        if (ok) {
            int e = 0;
            while (mm->tstart[e + 1] <= rt) ++e;
            mu->e[threadIdx.x] = e; mu->m0[threadIdx.x] = (rt - mm->tstart[e]) * 256; mu->pn[threadIdx.x] = pn;
        }
        const unsigned long long okm = __ballot(ok);
        if (threadIdx.x == 0) mu->n = __popcll(okm & 0xffffffffull);
    }
    __syncthreads();
}
struct EpiMoeUp {
    static constexpr bool GATHER_A = true;
    static constexpr int BHALF = 64;
    static DEVI int brow(int R) { return ((R >> 5) & 3) * 16 + (R & 15) + (((R >> 4) & 1) ? 1024 : 0); }
    const MoeMap8* mm; bf16* ACT; const float* bup; bf16* dump;
    DEVI void operator()(const f32x4 (&acc)[2][2][4][2], const pg8::Unit& u, int wr, int wc, int fr, int fq) const {
        const int e = u.x0, cnt = mm->cnt[e];
        const float* be = bup + (size_t)e * 2048;
        f32x4 bg[2], bl[2];
#pragma unroll
        for (int bj = 0; bj < 2; ++bj) { const int col = u.x2 * 128 + (bj * 4 + wc) * 16 + 4 * fq; bg[bj] = *(const f32x4*)(be + col); bl[bj] = *(const f32x4*)(be + 1024 + col); }
#pragma unroll
        for (int ai = 0; ai < 2; ++ai)
#pragma unroll
            for (int m = 0; m < 4; ++m) {
                const int r = u.x1 + ai * 128 + wr * 64 + m * 16 + fr;
                bf16* rowp = (r < cnt) ? ACT + (size_t)(u.x3 + r) * DFF + u.x2 * 128 + wc * 16 + 4 * fq : dump + 4 * fq;
#pragma unroll
                for (int bj = 0; bj < 2; ++bj) {
                    float o[4];
#pragma unroll
                    for (int j = 0; j < 4; ++j) {
                        const float glu = fminf(acc[ai][bj][m][0][j] + bg[bj][j], 7.f);
                        const float lin = fminf(fmaxf(acc[ai][bj][m][1][j] + bl[bj][j], -7.f), 7.f);
                        o[j] = glu * sigmoidf_(1.702f * glu) * (lin + 1.f);
                    }
                    *(u32x2*)(rowp + bj * 64) = (u32x2){pk2(o[0], o[1]), pk2(o[2], o[3])};
                }
            }
    }
};
struct EpiMoeDown {
    static constexpr bool GATHER_A = false; static constexpr int BHALF = 128; static DEVI int brow(int R) { return R; }
    const MoeMap8* mm; bf16* YB; const float* bdn; const int* LIST; const float* GATE; bf16* dump;
    DEVI void operator()(const f32x4 (&acc)[2][2][4][2], const pg8::Unit& u, int wr, int wc, int fr, int fq) const {
        const int e = u.x0, cnt = mm->cnt[e];
        const float* be = bdn + (size_t)e * D + u.x2 * 256 + wc * 32 + 4 * fq;
        f32x4 bv[2][2];
#pragma unroll
        for (int bj = 0; bj < 2; ++bj)
#pragma unroll
            for (int n = 0; n < 2; ++n) bv[bj][n] = *(const f32x4*)(be + bj * 128 + n * 16);
        int ent[8]; float gt[8];
#pragma unroll
        for (int q = 0; q < 8; ++q) { const int r = u.x1 + (q >> 2) * 128 + wr * 64 + (q & 3) * 16 + fr; ent[q] = LIST[(size_t)e * S + (r < cnt ? r : cnt - 1)]; }
#pragma unroll
        for (int q = 0; q < 8; ++q) gt[q] = GATE[ent[q]];
#pragma unroll
        for (int ai = 0; ai < 2; ++ai)
#pragma unroll
            for (int m = 0; m < 4; ++m) {
                const int q = ai * 4 + m, r = u.x1 + ai * 128 + wr * 64 + m * 16 + fr;
                bf16* rowp = (r < cnt) ? YB + (size_t)ent[q] * D + u.x2 * 256 + wc * 32 + 4 * fq : dump + 4 * fq;
#pragma unroll
                for (int bj = 0; bj < 2; ++bj)
#pragma unroll
                    for (int n = 0; n < 2; ++n) {
                        const f32x4 v = (acc[ai][bj][m][n] + bv[bj][n]) * gt[q];
                        *(u32x2*)(rowp + bj * 128 + n * 16) = (u32x2){pk2(v.x, v.y), pk2(v.z, v.w)};
                    }
            }
    }
};
DEVI void phase_moe_up8(const P& p, int l, char* smem_all) {
    MoeMap8* mm = (MoeMap8*)(smem_all + 131072);
    moe_map8(p, l, mm);
    MoeUnits* mu = (MoeUnits*)(smem_all + 131072 + 512);
    moe_units(mm, mu, 3);
    int* rowtab = (int*)(smem_all + 131072 + 1024);
    {
        const int* LIST = (const int*)(p.ws + WS_LIST);
        const int nu = mu->n < 12 ? mu->n : 12;
        for (int idx = threadIdx.x; idx < nu * 256; idx += KT) {
            const int i = idx >> 8, r = idx & 255, e = mu->e[i], cnt = mm->cnt[e], rr = mu->m0[i] + r;
            rowtab[idx] = LIST[(size_t)e * S + (rr < cnt ? rr : cnt - 1)] >> 2;
        }
        __syncthreads();
    }
    SchedMoe Sm{mm, mu, (const char*)(p.ws + WS_H2), (const char*)(p.ws + WS_WUP) + (size_t)l * NEXP * 2048 * D * 2, D, (size_t)2048 * D * 2, (size_t)128 * D * 2, rowtab, true};
    EpiMoeUp E{mm, (bf16*)(p.ws + WS_ACT), p.in[33] + (size_t)l * NEXP * 2048, (bf16*)(p.ws + WS_DUMP)};
    pg8::gemm_phase((LAS unsigned char*)smem_all, D, Sm, E);
}
DEVI void phase_moe_down8(const P& p, int l, char* smem_all) {
    MoeMap8* mm = (MoeMap8*)(smem_all + 131072);
    moe_map8(p, l, mm);
    MoeUnits* mu = (MoeUnits*)(smem_all + 131072 + 512);
    moe_units(mm, mu, 2);
    SchedMoe Sm{mm, mu, (const char*)(p.ws + WS_ACT), (const char*)(p.ws + WS_WDN) + (size_t)l * NEXP * D * DFF * 2, DFF, (size_t)D * DFF * 2, (size_t)256 * DFF * 2, nullptr, false};
    EpiMoeDown E{mm, (bf16*)(p.ws + WS_YB), p.in[35] + (size_t)l * NEXP * D, (const int*)(p.ws + WS_LIST), (const float*)(p.ws + WS_GATE), (bf16*)(p.ws + WS_DUMP)};
    pg8::gemm_phase((LAS unsigned char*)smem_all, DFF, Sm, E);
}

constexpr int NPHASE = 24;
constexpr int LDS_TOTAL = 2 * VB_LDS + 64;
__global__ void __launch_bounds__(KT, 2) k_run(P p) {
    extern __shared__ __attribute__((aligned(16))) char smem_all[];
    char* smem = smem_all + __builtin_amdgcn_readfirstlane((int)(threadIdx.x >> 8)) * VB_LDS;
    XcdBarrier bar; bar.bar = nullptr; bar.x = 0; bar.st = nullptr;
    const bool multi = (p.ph_hi - p.ph_lo) > 1;
    if (multi) {
        volatile LAS unsigned* st = (volatile LAS unsigned*)(smem_all + 2 * VB_LDS);
        if (threadIdx.x == 0) { st[0] = 0u; st[1] = 0u; }
        __syncthreads();
        bar = xcd_barrier_post((unsigned*)(p.ws + OFF_BAR), st);
    }
#ifndef DUP
#define DUP -1
#endif
#ifndef DUP2
#define DUP2 -1
#endif
#define RUN(k, call) if (p.ph_lo <= (k) && (k) < p.ph_hi) { for (int _rep = ((k) == DUP || (k) == DUP2) ? 2 : 1; _rep > 0; --_rep) { call; if (multi && ((k) + 1 < p.ph_hi || _rep > 1)) xcd_barrier(bar); } }
    RUN(0, phase_prep(p, smem))
    RUN(1, phase_h0(p))
    RUN(2, { phase_inproj8(p, 0, smem_all); phase_inproj_extras(p, 0, smem); })
    RUN(3, phase_mixprep(p, 0, smem))
    RUN(4, phase_chunkA(p, smem))
    RUN(5, phase_scanL1(p, smem))
    RUN(6, phase_scanL2(p, 0, smem))
    RUN(7, phase_chunkC(p, 0, smem))
    RUN(8, phase_outproj8(p, 0, smem_all))
    RUN(9, phase_ln1_route(p, 0, smem, _rep == 1))
    RUN(10, phase_moe_up8(p, 0, smem_all))
    RUN(11, phase_moe_down8(p, 0, smem_all))
    RUN(12, phase_ln2(p, 0))
    RUN(13, { phase_inproj8(p, 1, smem_all); phase_inproj_extras(p, 1, smem); })
    RUN(14, phase_mixprep(p, 1, smem))
    RUN(15, phase_chunkA(p, smem))
    RUN(16, phase_scanL1(p, smem))
    RUN(17, phase_scanL2(p, 1, smem))
    RUN(18, phase_chunkC(p, 1, smem))
    RUN(19, phase_outproj8(p, 1, smem_all))
    RUN(20, phase_ln1_route(p, 1, smem))
    RUN(21, phase_moe_up8(p, 1, smem_all))
    RUN(22, phase_moe_down8(p, 1, smem_all))
    RUN(23, phase_ln2(p, 1))
#undef RUN
}

extern "C" void kernel_launch(void* const* d_in, const int* in_sizes, int n_in, void* d_out, int out_size, void* d_ws, size_t ws_size,
                              hipStream_t stream) {
    static int grid = 0;
    if (grid == 0) {
        if (n_in != 38 || ws_size < WS_END) { fprintf(stderr, "kernel_launch: unexpected n_in %d or ws_size %zu (< %zu)\n", n_in, ws_size, (size_t)WS_END); grid = -1; return; }
        int dev = 0, cus = 0, per_cu = 0;
        hipGetDevice(&dev);
        hipDeviceGetAttribute(&cus, hipDeviceAttributeMultiprocessorCount, dev);
        hipFuncSetAttribute((const void*)k_run, hipFuncAttributeMaxDynamicSharedMemorySize, LDS_TOTAL);
        hipOccupancyMaxActiveBlocksPerMultiprocessor(&per_cu, (const void*)k_run, KT, LDS_TOTAL);
        if (per_cu < 1) { fprintf(stderr, "kernel_launch: occupancy query returned %d\n", per_cu); grid = -1; return; }
        if (cus != 256) { fprintf(stderr, "kernel_launch: built for 256 CUs (one workgroup per CU), device has %d\n", cus); grid = -1; return; }
        grid = cus;
    }
    if (grid < 0) return;
    hipMemsetAsync((char*)d_ws + WS_CTL, 0, CTL_BYTES, stream);
    P p{};
    for (int i = 0; i < 38; ++i) p.in[i] = (const float*)d_in[i];
    p.pos = (const int*)d_in[2];
    p.out = (float*)d_out; p.ws = (char*)d_ws;
#if MEGA
    p.ph_lo = 0; p.ph_hi = NPHASE;
    void* args[] = {&p};
    hipError_t e = hipLaunchCooperativeKernel((const void*)k_run, dim3(grid), dim3(KT), args, LDS_TOTAL, stream);
    if (e != hipSuccess) fprintf(stderr, "cooperative launch failed: %s (grid %d)\n", hipGetErrorString(e), grid);
#else
    for (int ph = 0; ph < NPHASE; ++ph) {
        p.ph_lo = ph; p.ph_hi = ph + 1;
        hipLaunchKernelGGL(k_run, dim3(grid), dim3(KT), LDS_TOTAL, stream, p);
    }
#endif
}
```

```cpp
#include <hip/hip_runtime.h>
#include <hip/hip_bf16.h>
#include <stdint.h>
#include <stdio.h>

#ifndef MEGA
#define MEGA 1
#endif

#define DEVI __device__ __forceinline__
#define LAS __attribute__((address_space(3)))

typedef unsigned short bf16;
typedef short bf16x8 __attribute__((ext_vector_type(8)));
typedef float f32x4 __attribute__((ext_vector_type(4)));
typedef unsigned u32x4 __attribute__((ext_vector_type(4)));
typedef unsigned u32x2 __attribute__((ext_vector_type(2)));

constexpr int S = 16384, D = 1024, NIN = 4104, NEXP = 32, DFF = 1024;
constexpr int NPROJ = 4096;
constexpr int NPAD = 4352;
constexpr float DN_ALPHA = 1.4142135623730951f;
constexpr int NT = 256;
constexpr int LDS_BYTES = 76032;

constexpr size_t MiB = 1ull << 20;
constexpr size_t WS_CTL = 0;
constexpr size_t CTL_BYTES = 1 * MiB;
constexpr size_t OFF_BAR = 0;
constexpr size_t OFF_ADA = 64 * 1024;
constexpr size_t OFF_CNT = 128 * 1024;
constexpr size_t WS_ROT = 1 * MiB;
constexpr size_t WS_WIN = WS_ROT + (size_t)S * 64 * 4;
constexpr size_t WS_WOUT = WS_WIN + 2ull * NPAD * D * 2;
constexpr size_t WS_WUP = WS_WOUT + 2ull * D * D * 2;
constexpr size_t WS_WDN = WS_WUP + 2ull * NEXP * 2048 * D * 2;
constexpr size_t WS_HB = WS_WDN + 2ull * NEXP * D * DFF * 2;
constexpr size_t WS_PROJ = WS_HB + (size_t)S * D * 2;
constexpr size_t WS_PEX = WS_PROJ + (size_t)S * NPROJ * 2;
constexpr size_t WS_VFIRST = WS_PEX + (size_t)S * 64 * 4;
constexpr size_t WS_RECR = WS_VFIRST + (size_t)S * 256 * 4;
constexpr size_t WS_RECG = WS_RECR + (size_t)S * 4 * 384 * 2;
constexpr size_t WS_RECT = WS_RECG + (size_t)S * 4 * 392 * 2;
constexpr size_t WS_WDEC = WS_RECT + (size_t)S * 4 * 192 * 2;
constexpr size_t WS_GSC = WS_WDEC + (size_t)S * 256 * 4;
constexpr size_t WS_G = WS_GSC + (size_t)S * 16 * 4;
constexpr size_t WS_BON = WS_G + (size_t)S * 256 * 4;
constexpr size_t WS_YR = WS_BON + (size_t)S * 4 * 4;
constexpr size_t WS_OG = WS_YR + (size_t)S * 256 * 4;
constexpr size_t WS_ORT = WS_OG + (size_t)S * 512 * 4;
constexpr size_t WS_MIX = WS_ORT + (size_t)S * 256 * 4;
constexpr size_t WS_OPRE = WS_MIX + (size_t)S * D * 2;
constexpr size_t WS_X = WS_OPRE + (size_t)S * D * 4;
constexpr size_t WS_H2 = WS_X + (size_t)S * D * 4;
constexpr size_t WS_LIST = WS_H2 + (size_t)S * D * 2;
constexpr size_t WS_GATE = WS_LIST + (size_t)NEXP * S * 4;
constexpr size_t WS_ACT = WS_GATE + (size_t)S * 4 * 4;
constexpr size_t WS_YB = WS_ACT + ((size_t)S * 4 + 256) * DFF * 2;
constexpr size_t WS_ADAP = WS_YB + (size_t)S * 4 * D * 2;
constexpr size_t WS_RKV = WS_ADAP + 16ull * 12288 * 4;
constexpr size_t WS_RST = WS_RKV + 256ull * 4 * 4096 * 4;
constexpr size_t WS_GP = WS_RST + 256ull * 4 * 4096 * 2;
constexpr size_t WS_GB = WS_GP + 1024ull * 16384 * 2;
constexpr size_t WS_GD = WS_GB + 1024ull * 16384 * 4;
constexpr size_t WS_GQ = WS_GD + 4096;
constexpr size_t WS_GO = WS_GQ + 1024ull * 8192 * 2;
constexpr size_t WS_GS = WS_GO + 1024ull * 8192 * 4;
constexpr size_t WS_WP = WS_GS + 1024ull * 16384 * 2;
constexpr size_t WS_WC = WS_WP + 2048ull * 4096 * 2;
constexpr size_t WS_WD = WS_WC + 2048ull * 4096 * 4;
constexpr size_t WS_WQ = WS_WD + 2048ull * 64 * 4;
constexpr size_t WS_WY = WS_WQ + 2048ull * 2048 * 2;
constexpr size_t WS_WS = WS_WY + 2048ull * 2048 * 4;
constexpr size_t WS_GR = WS_WS + 2048ull * 4096 * 2;
constexpr size_t WS_GE0 = WS_GR + 1024ull * 8192 * 2;
constexpr size_t WS_GTE = WS_GE0 + 64ull * 16384 * 4;
constexpr size_t WS_GSG = WS_GTE + 64ull * 16384 * 2;
constexpr size_t WS_WR = WS_GSG + 64ull * 16384 * 2;
constexpr size_t WS_WE0 = WS_WR + 2048ull * 2048 * 2;
constexpr size_t WS_WTE = WS_WE0 + 64ull * 4096 * 4;
constexpr size_t WS_WSG = WS_WTE + 64ull * 4096 * 2;
constexpr size_t WS_LRT = WS_WSG + 64ull * 4096 * 2;
constexpr size_t WS_DUMP = WS_LRT + 2ull * 73728 * 2;
constexpr size_t WS_RWF = WS_DUMP + 4096;
constexpr size_t WS_END = WS_RWF + 2ull * 32 * 2 * 2 * 64 * 16;

struct P {
    const float* in[38];
    const int* pos;
    float* out;
    char* ws;
    int ph_lo, ph_hi;
};

DEVI float bf2f(bf16 v) { return __uint_as_float(((unsigned)v) << 16); }
DEVI unsigned f2bf(float f) { unsigned u = __float_as_uint(f); return (u + 0x7fffu + ((u >> 16) & 1u)) >> 16; }
typedef float f32x2_t __attribute__((ext_vector_type(2)));
typedef __bf16 bf16x2_t __attribute__((ext_vector_type(2)));
DEVI unsigned pk2(float lo, float hi) { const f32x2_t v = {lo, hi}; return __builtin_bit_cast(unsigned, __builtin_convertvector(v, bf16x2_t)); }
DEVI float sigmoidf_(float x) { return __builtin_amdgcn_rcpf(1.f + __builtin_amdgcn_exp2f(-1.4426950408889634f * x)); }
DEVI float siluf_(float x) { return x * sigmoidf_(x); }
DEVI float softplusf_(float x) { return fmaxf(x, 0.f) + log1pf(__expf(-fabsf(x))); }
DEVI float wave_sum(float v) {
#pragma unroll
    for (int o = 32; o >= 1; o >>= 1) v += __shfl_xor(v, o);
    return v;
}
template <int CTRL> DEVI float dpp_mov(float x) {
    return __int_as_float(__builtin_amdgcn_update_dpp(0, __float_as_int(x), CTRL, 0xf, 0xf, false));
}
DEVI float row16_sum(float x) {
    x += dpp_mov<0x128>(x);
    x += dpp_mov<0x124>(x);
    x += dpp_mov<0x122>(x);
    x += dpp_mov<0x121>(x);
    return x;
}

DEVI bf16x8 ldfrag(const bf16* base, int ld, int row0, int k0, int lane) {
    return *(const bf16x8*)(base + (row0 + (lane & 15)) * ld + k0 + (lane >> 4) * 8);
}
DEVI f32x4 ld_bf4(const bf16* p) {
    const u32x2 v = *(const u32x2*)p;
    return (f32x4){__uint_as_float(v.x << 16), __uint_as_float(v.x & 0xffff0000u), __uint_as_float(v.y << 16), __uint_as_float(v.y & 0xffff0000u)};
}
DEVI void st_bf4(bf16* p, const f32x4& v) { *(u32x2*)p = (u32x2){pk2(v.x, v.y), pk2(v.z, v.w)}; }
DEVI float quad_sum(float v) { v += __shfl_xor(v, 16); v += __shfl_xor(v, 32); return v; }
DEVI f32x4 mfma16(bf16x8 a, bf16x8 b, f32x4 c) { return __builtin_amdgcn_mfma_f32_16x16x32_bf16(a, b, c, 0, 0, 0); }

#define VTID ((int)(threadIdx.x & 255))
#define VBID ((int)(blockIdx.x * 2 + __builtin_amdgcn_readfirstlane((int)(threadIdx.x >> 8))))
#define VNB ((int)(gridDim.x * 2))
constexpr int VB_LDS = 76032;
constexpr int KT = 512;

#define XB_TMO      128
#define XB_XCNT(j)  (256  + 64 * (j))
#define XB_XSUB(j)  (1280 + 64 * (j))
#define XB_XGEN(j)  (2304 + 64 * (j))
#define XB_TOP      3328
#define XB_TOPGEN   3392
#define XCD_BAR_WORDS 3456
#define XB_SPIN_CAP (1u << 22)
DEVI unsigned xb_ld(unsigned* p) { return __hip_atomic_load(p, __ATOMIC_RELAXED, __HIP_MEMORY_SCOPE_AGENT); }
DEVI unsigned xb_add(unsigned* p, unsigned v) { return __hip_atomic_fetch_add(p, v, __ATOMIC_RELAXED, __HIP_MEMORY_SCOPE_AGENT); }
DEVI unsigned xb_xcc_id() { return (unsigned)__builtin_amdgcn_s_getreg((3 << 11) | 20) & 0xFu; }
#define XB_SPIN(cond, bar) do { unsigned _sp = 0; while (cond) { __builtin_amdgcn_s_sleep(1); \
    if ((++_sp & 255u) == 0u) { if (xb_ld(&(bar)[XB_TMO])) break; if (_sp > XB_SPIN_CAP) { atomicAdd(&(bar)[XB_TMO], 1u); break; } } } } while (0)
struct XcdBarrier { unsigned* bar; unsigned x; volatile LAS unsigned* st; };
DEVI XcdBarrier xcd_barrier_post(unsigned* bar, volatile LAS unsigned* st) {
    XcdBarrier b; b.bar = bar; b.x = xb_xcc_id(); b.st = st;
    if (threadIdx.x == 0) (void)xb_add(&bar[XB_XCNT(b.x)], 1u);
    return b;
}
DEVI void xcd_barrier_complete(unsigned* bar, unsigned x, unsigned& nloc, unsigned& nx) {
    const unsigned G = gridDim.x * gridDim.y * gridDim.z;
    unsigned sum, cnt, mine, sp = 0u;
    for (;;) {
        sum = 0u; cnt = 0u; mine = 0u;
#pragma unroll
        for (unsigned j = 0; j < 16; ++j) { const unsigned c = xb_ld(&bar[XB_XCNT(j)]); sum += c; cnt += (c > 0u) ? 1u : 0u; mine = (j == x) ? c : mine; }
        if (sum == G) break;
        __builtin_amdgcn_s_sleep(1);
        if ((++sp & 255u) == 0u) { if (xb_ld(&bar[XB_TMO])) break; if (sp > XB_SPIN_CAP) { atomicAdd(&bar[XB_TMO], 1u); break; } }
    }
    nloc = mine > 0u ? mine : 1u; nx = cnt > 0u ? cnt : 1u;
}
DEVI void xcd_barrier(const XcdBarrier& b) {
    asm volatile("s_waitcnt vmcnt(0)" ::: "memory");
    __syncthreads();
    if (threadIdx.x == 0) {
        unsigned* bar = b.bar;
        __builtin_amdgcn_s_waitcnt(0);
        unsigned nloc = b.st[0], nx = b.st[1];
        if (nloc == 0u) { xcd_barrier_complete(bar, b.x, nloc, nx); b.st[0] = nloc; b.st[1] = nx; }
        const unsigned old = xb_add(&bar[XB_XSUB(b.x)], 1u);
        const unsigned gen = old / nloc;
        if (old + 1u == (gen + 1u) * nloc) {
            __builtin_amdgcn_fence(__ATOMIC_RELEASE, "agent");
            asm volatile("s_waitcnt vmcnt(0)" ::: "memory");
            const unsigned og = xb_add(&bar[XB_TOP], 1u);
            const unsigned tg = og / nx;
            if (og + 1u == (tg + 1u) * nx) xb_add(&bar[XB_TOPGEN], 1u);
            else XB_SPIN(xb_ld(&bar[XB_TOPGEN]) == tg, bar);
            __builtin_amdgcn_fence(__ATOMIC_ACQUIRE, "agent");
            xb_add(&bar[XB_XGEN(b.x)], 1u);
            asm volatile("s_waitcnt vmcnt(0)" ::: "memory");
        } else {
            XB_SPIN(xb_ld(&bar[XB_XGEN(b.x)]) == gen, bar);
            __builtin_amdgcn_fence(__ATOMIC_ACQUIRE, "agent");
            asm volatile("s_waitcnt vmcnt(0)" ::: "memory");
        }
    }
    __syncthreads();
}

DEVI void transpose_item(const float* __restrict__ src, size_t ld, int k0, int ns0, bf16* __restrict__ dst, int kd, int nd0, float* lds) {
    const int tid = VTID;
    float tv[32];
#pragma unroll
    for (int i = 0; i < 32; ++i) tv[i] = __builtin_nontemporal_load(&src[(size_t)(k0 + i * 4 + (tid >> 6)) * ld + ns0 + (tid & 63)]);
    asm volatile("" ::: "memory");
#pragma unroll
    for (int i = 0; i < 32; ++i) lds[(i * 4 + (tid >> 6)) * 65 + (tid & 63)] = tv[i];
    __syncthreads();
#pragma unroll
    for (int i = 0; i < 4; ++i) {
        const int q = tid + 256 * i, n = q >> 4, kc = q & 15;
        const float* s = lds + (kc * 8) * 65 + n;
        u32x4 o;
        o.x = pk2(s[0 * 65], s[1 * 65]); o.y = pk2(s[2 * 65], s[3 * 65]);
        o.z = pk2(s[4 * 65], s[5 * 65]); o.w = pk2(s[6 * 65], s[7 * 65]);
        *(u32x4*)(dst + (size_t)(nd0 + n) * kd + k0 + kc * 8) = o;
    }
    __syncthreads();
}

DEVI void phase_prep(const P& p, char* smem) {
    float* lds = (float*)smem;
    const int tid = VTID;
    const int nb = VNB, bid = VBID;
    bf16* WIN = (bf16*)(p.ws + WS_WIN); bf16* WOUT = (bf16*)(p.ws + WS_WOUT);
    bf16* WUP = (bf16*)(p.ws + WS_WUP); bf16* WDN = (bf16*)(p.ws + WS_WDN);
    constexpr int I_UP = 2 * NEXP * 8 * 32;
    constexpr int I_DN = 2 * NEXP * 8 * 16;
    constexpr int I_IN = 2 * 8 * 64;
    constexpr int I_OUT = 2 * 8 * 16;
    constexpr int I_EX = 2 * 256;
    constexpr int I_ADA = 2 * 24 * 16;
    constexpr int I_ROT = S * 32 / 256;
    constexpr int I_LR = 2 * 288;
    constexpr int I_RW = 2 * 16;
    constexpr int NITEMS = I_UP + I_DN + I_IN + I_OUT + I_EX + I_ADA + I_ROT + I_LR + I_RW;
    constexpr int I_TR = I_UP + I_DN + I_IN + I_OUT;
    static_assert((I_TR % 512) % 2 == 0, "the two halves of every workgroup must run the same number of transpose items (they contain barriers)");
    for (int it = bid; it < NITEMS; it += nb) {
        int r = it;
        if (r < I_UP) {
            const int le = r / 256, q = r % 256, kt = q / 32, nt = q % 32;
            transpose_item(p.in[32] + (size_t)le * D * 2048, 2048, kt * 128, nt * 64, WUP + (size_t)le * 2048 * D, D, nt * 64, lds);
            continue;
        }
        r -= I_UP;
        if (r < I_DN) {
            const int le = r / 128, q = r % 128, kt = q / 16, nt = q % 16;
            transpose_item(p.in[34] + (size_t)le * DFF * D, D, kt * 128, nt * 64, WDN + (size_t)le * D * DFF, DFF, nt * 64, lds);
            continue;
        }
        r -= I_DN;
        if (r < I_IN) {
            const int l = r / 512, q = r % 512, kt = q / 64, nt = q % 64;
            const int nd0 = nt * 64, ns0 = nd0 < 3072 ? nd0 : nd0 + 8;
            transpose_item(p.in[5] + (size_t)l * D * NIN, NIN, kt * 128, ns0, WIN + (size_t)l * NPAD * D, D, nd0, lds);
            continue;
        }
        r -= I_IN;
        if (r < I_OUT) {
            const int l = r / 128, q = r % 128, kt = q / 16, nt = q % 16;
            transpose_item(p.in[27] + (size_t)l * D * D, D, kt * 128, nt * 64, WOUT + (size_t)l * D * D, D, nt * 64, lds);
            continue;
        }
        r -= I_OUT;
        if (r < I_EX) {
            const int l = r / 256, n = r % 256;
            bf16* dst = WIN + ((size_t)l * NPAD + NPROJ + n) * D;
            for (int k = tid; k < D; k += NT) {
                float v = 0.f;
                if (n < 8) v = p.in[5][(size_t)l * D * NIN + (size_t)k * NIN + 3072 + n];
                else if (n < 40 && l == 1) v = p.in[6][(size_t)k * 32 + (n - 8)];
                dst[k] = (bf16)f2bf(v);
            }
            continue;
        }
        r -= I_EX;
        if (r < I_ADA) {
            const int l = r / 384, q = r % 384, nc = q / 16, kc = q % 16;
            const int n = nc * 256 + tid;
            const float* W = p.in[3] + (size_t)l * D * 6144;
            float acc = (kc == 0) ? p.in[4][l * 6144 + n] : 0.f;
            for (int k = kc * 64; k < kc * 64 + 64; ++k) acc += siluf_(p.in[1][k]) * W[(size_t)k * 6144 + n];
            ((float*)(p.ws + WS_ADAP))[(size_t)kc * 12288 + l * 6144 + n] = acc;
            continue;
        }
        r -= I_ADA;
        if (r >= I_ROT + I_LR) {
            r -= I_ROT + I_LR;
            const int l = r >> 4, idx = (r & 15) * 256 + tid, kk = idx >> 7, n = (idx >> 6) & 1, ln = idx & 63;
            const float* rw = p.in[30] + (size_t)l * D * 32 + (size_t)(32 * kk + 8 * (ln >> 4)) * 32 + 16 * n + (ln & 15);
            unsigned hi[4], lo[4];
#pragma unroll
            for (int q = 0; q < 4; ++q) {
                const float a = rw[(2 * q) * 32], b = rw[(2 * q + 1) * 32];
                hi[q] = pk2(a, b);
                lo[q] = pk2(a - __uint_as_float(hi[q] << 16), b - __uint_as_float(hi[q] & 0xffff0000u));
            }
            u32x4* dst = (u32x4*)(p.ws + WS_RWF) + ((size_t)((l * 32 + kk) * 2 + n) * 2) * 64 + ln;
            dst[0] = (u32x4){hi[0], hi[1], hi[2], hi[3]}; dst[64] = (u32x4){lo[0], lo[1], lo[2], lo[3]};
            continue;
        }
        if (r >= I_ROT) {
            r -= I_ROT;
            const int l = r / 288, kk = r % 288, c = tid;
            bf16* LRT = (bf16*)(p.ws + WS_LRT) + (size_t)l * 73728;
            if (kk < 64) LRT[c * 64 + kk] = (bf16)f2bf(p.in[10][(l * 64 + kk) * 256 + c]);
            else if (kk < 128) LRT[16384 + c * 64 + (kk - 64)] = (bf16)f2bf(p.in[12][(l * 64 + kk - 64) * 256 + c]);
            else if (kk < 256) LRT[32768 + c * 128 + (kk - 128)] = (bf16)f2bf(p.in[13][(l * 128 + kk - 128) * 256 + c]);
            else LRT[65536 + c * 32 + (kk - 256)] = (bf16)f2bf(l == 1 ? p.in[20][(kk - 256) * 256 + c] : 0.f);
            continue;
        }
        {
            const int idx = r * 256 + tid;
            const int t = idx >> 5, i = idx & 31;
            const float invf = (float)pow(10000.0, -(double)i / 32.0);
            const float ang = (float)p.pos[t] * invf;
            float sn, cs; sincosf(ang, &sn, &cs);
            float* ROT = (float*)(p.ws + WS_ROT);
            ROT[(size_t)idx * 2] = cs; ROT[(size_t)idx * 2 + 1] = sn;
        }
    }
}

DEVI float ada_sum(const float* ADAP, int idx) {
    float s = 0.f;
#pragma unroll
    for (int kc = 0; kc < 16; ++kc) s += ADAP[(size_t)kc * 12288 + idx];
    return s;
}
DEVI void phase_h0(const P& p) {
    const float* ADAP = (const float*)(p.ws + WS_ADAP);
    float* ADA = (float*)(p.ws + OFF_ADA);
    bf16* HB = (bf16*)(p.ws + WS_HB);
    if (VBID < 48) ADA[VBID * 256 + VTID] = ada_sum(ADAP, VBID * 256 + VTID);
    const size_t n4 = (size_t)S * D / 4;
    const int c = (int)(((size_t)VBID * NT + VTID) % (D / 4)) * 4;
    f32x4 sh, sc;
    sh.x = ada_sum(ADAP, c); sh.y = ada_sum(ADAP, c + 1); sh.z = ada_sum(ADAP, c + 2); sh.w = ada_sum(ADAP, c + 3);
    sc.x = ada_sum(ADAP, 1024 + c); sc.y = ada_sum(ADAP, 1025 + c); sc.z = ada_sum(ADAP, 1026 + c); sc.w = ada_sum(ADAP, 1027 + c);
    for (size_t i = (size_t)VBID * NT + VTID; i < n4; i += (size_t)VNB * NT) {
        const f32x4 x = ((const f32x4*)p.in[0])[i];
        u32x2 o;
        o.x = pk2(x.x * (1.f + sc.x) + sh.x, x.y * (1.f + sc.y) + sh.y);
        o.y = pk2(x.z * (1.f + sc.z) + sh.z, x.w * (1.f + sc.w) + sh.w);
        ((u32x2*)HB)[i] = o;
    }
}

template <class AF, class BF>
DEVI void gemm_tile(char* smem, const bf16* __restrict__ Abase, AF arow, const bf16* __restrict__ Bbase, BF brow, int K, f32x4 (&acc)[4][8]) {
    const int tid = VTID, wid = tid >> 6, lane = tid & 63, wr = wid >> 1, wc = wid & 1, fr = lane & 15, fq = lane >> 4;
    const int r0 = tid >> 2;
    const int swz = ((tid & 3) ^ ((0x1320 >> (4 * ((tid >> 4) & 3))) & 3)) * 8;
    unsigned pa[2], pb[4];
#pragma unroll
    for (int i = 0; i < 2; ++i) pa[i] = arow(r0 + 64 * i) + swz;
#pragma unroll
    for (int i = 0; i < 4; ++i) pb[i] = brow(r0 + 64 * i) + swz;
#pragma unroll
    for (int m = 0; m < 4; ++m)
#pragma unroll
        for (int n = 0; n < 8; ++n) acc[m][n] = (f32x4){0.f, 0.f, 0.f, 0.f};
    const int nk = K / 32;
    const int ch = (fq ^ ((0x1320 >> (4 * ((fr >> 2) & 3))) & 3)) * 16;
#define GT_STAGE(kt) do { char* _sa = smem + ((kt) % 3) * 24576; char* _sb = _sa + 8192; \
        _Pragma("unroll") for (int _i = 0; _i < 2; ++_i) \
            __builtin_amdgcn_global_load_lds((const unsigned*)(Abase + pa[_i] + (kt) * 32), (unsigned*)(_sa + (tid + 256 * _i) * 16), 16, 0, 0); \
        _Pragma("unroll") for (int _i = 0; _i < 4; ++_i) \
            __builtin_amdgcn_global_load_lds((const unsigned*)(Bbase + pb[_i] + (kt) * 32), (unsigned*)(_sb + (tid + 256 * _i) * 16), 16, 0, 0); } while (0)
    asm volatile("s_waitcnt vmcnt(0)" ::: "memory");
    GT_STAGE(0); GT_STAGE(1);
    for (int kt = 0; kt < nk; ++kt) {
        if (kt + 1 < nk) asm volatile("s_waitcnt vmcnt(6)" ::: "memory");
        else asm volatile("s_waitcnt vmcnt(0)" ::: "memory");
        asm volatile("s_waitcnt lgkmcnt(0)" ::: "memory");
        __builtin_amdgcn_s_barrier();
        if (kt + 2 < nk) GT_STAGE(kt + 2);
        const char* SA = smem + (kt % 3) * 24576; const char* SB = SA + 8192;
        bf16x8 af[4], bfr[8];
#pragma unroll
        for (int m = 0; m < 4; ++m) af[m] = *(const bf16x8*)(SA + (wr * 64 + m * 16 + fr) * 64 + ch);
#pragma unroll
        for (int n = 0; n < 8; ++n) bfr[n] = *(const bf16x8*)(SB + (wc * 128 + n * 16 + fr) * 64 + ch);
#pragma unroll
        for (int m = 0; m < 4; ++m)
#pragma unroll
            for (int n = 0; n < 8; ++n)
                acc[m][n] = __builtin_amdgcn_mfma_f32_16x16x32_bf16(bfr[n], af[m], acc[m][n], 0, 0, 0);
    }
    asm volatile("s_waitcnt lgkmcnt(0)" ::: "memory");
    __builtin_amdgcn_s_barrier();
#undef GT_STAGE
}

DEVI float proj_at(const bf16* PROJ, int t, int col) { return bf2f(PROJ[(size_t)t * NPROJ + col]); }
DEVI float proj_shift(const bf16* PROJ, int t, int col, float mu) {
    const float cur = proj_at(PROJ, t, col);
    const float prv = t > 0 ? proj_at(PROJ, t - 1, col) : 0.f;
    return cur + (prv - cur) * mu;
}

DEVI f32x4 shift4(const bf16* PROJ, int t, int col, const f32x4& mu) {
    const f32x4 cur = ld_bf4(PROJ + (size_t)t * NPROJ + col);
    f32x4 prv = ld_bf4(PROJ + (size_t)(t > 0 ? t - 1 : 0) * NPROJ + col);
    const float keep = t > 0 ? 1.f : 0.f;
    prv = prv * keep;
    return cur + (prv - cur) * mu;
}
DEVI float fsig(float x) { return sigmoidf_(x); }
DEVI void phase_mixprep(const P& p, int l, char* smem) {
    const bf16* PROJ = (const bf16*)(p.ws + WS_PROJ); const float* PEX = (const float*)(p.ws + WS_PEX);
    float* VFIRST = (float*)(p.ws + WS_VFIRST);
    bf16* RECR = (bf16*)(p.ws + WS_RECR); bf16* RECG = (bf16*)(p.ws + WS_RECG); bf16* RECT = (bf16*)(p.ws + WS_RECT);
    float* WDEC = (float*)(p.ws + WS_WDEC); float* GSC = (float*)(p.ws + WS_GSC);
    float* GB = (float*)(p.ws + WS_G); float* BON = (float*)(p.ws + WS_BON);
    const float* ROT = (const float*)(p.ws + WS_ROT);
    const bf16* LRT = (const bf16*)(p.ws + WS_LRT) + (size_t)l * 73728;
    bf16* L = (bf16*)smem;
    float* CW = (float*)(smem + 9728);
    float* MU = CW + 6144;
    float* PW0 = MU + 1024; float* PA0 = PW0 + 256; float* PKK = PA0 + 256; float* PKA = PKK + 256; float* PRK = PKA + 256; float* PV0 = PRK + 256;
    {
        const int tid = VTID;
        for (int i = tid; i < 6144; i += NT) CW[i] = p.in[21][l * 6144 + i];
        for (int i = tid; i < 1024; i += NT) MU[i] = p.in[7][l * 1024 + i];
        PW0[tid] = p.in[9][l * 256 + tid]; PA0[tid] = p.in[11][l * 256 + tid]; PKK[tid] = p.in[14][l * 256 + tid];
        PKA[tid] = p.in[15][l * 256 + tid]; PRK[tid] = p.in[16][l * 256 + tid]; PV0[tid] = (l == 1) ? p.in[19][tid] : 0.f;
    }
    __syncthreads();
    for (int item = VBID; item < S / 16; item += VNB) {
        int tid = VTID; asm volatile("" : "+v"(tid));
        const int lane = tid & 63, w = tid >> 6, fr = lane & 15, fq = lane >> 4;
        const int t0 = item * 16;
        {
            u32x2 cur[5], prv[5]; f32x4 xc[5], xp[5];
#pragma unroll
            for (int q = 0; q < 5; ++q) {
                const int g = tid + 256 * q, gg = g < 1152 ? g : 1151, tt = gg / 72, i4 = (gg % 72) * 4, t = t0 + tt, tp = t > 0 ? t - 1 : 0;
                const int ia = i4 < 256 ? i4 : 252, ib = i4 < 256 ? 0 : i4 - 256;
                cur[q] = *(const u32x2*)(PROJ + (size_t)t * NPROJ + 768 + ia); prv[q] = *(const u32x2*)(PROJ + (size_t)tp * NPROJ + 768 + ia);
                xc[q] = *(const f32x4*)(PEX + (size_t)t * 64 + 8 + ib); xp[q] = *(const f32x4*)(PEX + (size_t)tp * 64 + 8 + ib);
            }
            asm volatile("" ::: "memory");
#pragma unroll
            for (int q = 0; q < 5; ++q) {
                const int g = tid + 256 * q, gg = g < 1152 ? g : 1151, tt = gg / 72, i4 = (gg % 72) * 4, t = t0 + tt;
                const float keep = t > 0 ? 1.f : 0.f;
                f32x4 v;
                if (i4 < 256) {
                    const f32x4 c4 = {__uint_as_float(cur[q].x << 16), __uint_as_float(cur[q].x & 0xffff0000u), __uint_as_float(cur[q].y << 16), __uint_as_float(cur[q].y & 0xffff0000u)};
                    const f32x4 p4 = (f32x4){__uint_as_float(prv[q].x << 16), __uint_as_float(prv[q].x & 0xffff0000u), __uint_as_float(prv[q].y << 16), __uint_as_float(prv[q].y & 0xffff0000u)} * keep;
                    v = c4 + (p4 - c4) * *(const f32x4*)(MU + 768 + i4);
                    if (i4 < 64) { v.x = tanhf(v.x); v.y = tanhf(v.y); v.z = tanhf(v.z); v.w = tanhf(v.w); }
                    else if (i4 >= 128) { v.x = fsig(v.x); v.y = fsig(v.y); v.z = fsig(v.z); v.w = fsig(v.w); }
                } else {
                    v = (f32x4){0.f, 0.f, 0.f, 0.f};
                    if (l == 1) v = xc[q] + (xp[q] * keep - xc[q]) * *(const f32x4*)(p.in[8] + (i4 - 256));
                }
                if (g < 1152) *(u32x2*)(L + tt * 296 + i4) = (u32x2){pk2(v.x, v.y), pk2(v.z, v.w)};
            }
        }
        __syncthreads();
        const int t = t0 + fr, h = w, tpv = t > 0 ? t - 1 : 0;
        const float keep = t > 0 ? 1.f : 0.f;
        {
            f32x4 aw[4], aa[4], ag[4], av[4];
#pragma unroll
            for (int i = 0; i < 4; ++i) { aw[i] = (f32x4){0.f, 0.f, 0.f, 0.f}; aa[i] = aw[i]; ag[i] = aw[i]; av[i] = aw[i]; }
            bf16x8 lf[9];
#pragma unroll
            for (int ks = 0; ks < 9; ++ks) lf[ks] = *(const bf16x8*)(L + fr * 296 + ks * 32 + fq * 8);
#pragma unroll
            for (int i = 0; i < 4; ++i) {
                const int c = 64 * h + 16 * i + fr;
#pragma unroll
                for (int ks = 0; ks < 2; ++ks) aw[i] = mfma16(*(const bf16x8*)(LRT + c * 64 + ks * 32 + fq * 8), lf[ks], aw[i]);
#pragma unroll
                for (int ks = 0; ks < 2; ++ks) aa[i] = mfma16(*(const bf16x8*)(LRT + 16384 + c * 64 + ks * 32 + fq * 8), lf[2 + ks], aa[i]);
#pragma unroll
                for (int ks = 0; ks < 4; ++ks) ag[i] = mfma16(*(const bf16x8*)(LRT + 32768 + c * 128 + ks * 32 + fq * 8), lf[4 + ks], ag[i]);
                if (l == 1) av[i] = mfma16(*(const bf16x8*)(LRT + 65536 + c * 32 + fq * 8), lf[8], av[i]);
            }
            bf16* rec = RECR + ((size_t)t * 4 + h) * 384;
            f32x4 kx[4], as_[4];
            float ss = 0.f, bsum = 0.f;
#define UNPK4(u) ((f32x4){__uint_as_float((u).x << 16), __uint_as_float((u).x & 0xffff0000u), __uint_as_float((u).y << 16), __uint_as_float((u).y & 0xffff0000u)})
            u32x2 rc[4], rp[4], kc[4], kp[4], vc[4], vp[4]; f32x4 vf4[4];
#pragma unroll
            for (int i = 0; i < 4; ++i) {
                const int j = 16 * i + 4 * fq, c = 64 * h + j;
                if ((i & 1) == 0) {
#pragma unroll
                    for (int i2 = i; i2 < i + 2; ++i2) {
                        const int c2 = 64 * h + 16 * i2 + 4 * fq;
                        rc[i2] = *(const u32x2*)(PROJ + (size_t)t * NPROJ + c2); rp[i2] = *(const u32x2*)(PROJ + (size_t)tpv * NPROJ + c2);
                        kc[i2] = *(const u32x2*)(PROJ + (size_t)t * NPROJ + 256 + c2); kp[i2] = *(const u32x2*)(PROJ + (size_t)tpv * NPROJ + 256 + c2);
                        vc[i2] = *(const u32x2*)(PROJ + (size_t)t * NPROJ + 512 + c2); vp[i2] = *(const u32x2*)(PROJ + (size_t)tpv * NPROJ + 512 + c2);
                        if (l == 1) vf4[i2] = *(const f32x4*)(VFIRST + (size_t)t * 256 + c2);
                    }
                    asm volatile("" ::: "memory");
                }
                const f32x4 r0 = UNPK4(rc[i]), k0 = UNPK4(kc[i]), v0_ = UNPK4(vc[i]);
                const f32x4 r = r0 + (UNPK4(rp[i]) * keep - r0) * *(const f32x4*)(MU + c);
                const f32x4 k = k0 + (UNPK4(kp[i]) * keep - k0) * *(const f32x4*)(MU + 256 + c);
                f32x4 v = v0_ + (UNPK4(vp[i]) * keep - v0_) * *(const f32x4*)(MU + 512 + c);
                const f32x4 w0 = *(const f32x4*)(PW0 + c), a0 = *(const f32x4*)(PA0 + c);
                const f32x4 kkc = *(const f32x4*)(PKK + c), kac = *(const f32x4*)(PKA + c), rkc = *(const f32x4*)(PRK + c);
                f32x4 dec, a;
#pragma unroll
                for (int q = 0; q < 4; ++q) {
                    const float wl = -softplusf_(-(w0[q] + aw[i][q])) - 0.5f;
                    dec[q] = __expf(-__expf(wl));
                    a[q] = fsig(a0[q] + aa[i][q]);
                }
                if (l == 0) *(f32x4*)(VFIRST + (size_t)t * 256 + c) = v;
                else {
                    const f32x4 v0 = *(const f32x4*)(PV0 + c);
#pragma unroll
                    for (int q = 0; q < 4; ++q) v[q] = v[q] + (vf4[i][q] - v[q]) * fsig(v0[q] + av[i][q]);
                }
                kx[i] = k * kkc; as_[i] = a;
                const f32x4 k2 = k * ((a - 1.f) * kac + 1.f);
                ss += kx[i].x * kx[i].x + kx[i].y * kx[i].y + kx[i].z * kx[i].z + kx[i].w * kx[i].w;
                const f32x4 rb = r * k2 * rkc;
                bsum += (rb.x + rb.y) + (rb.z + rb.w);
                *(f32x4*)(WDEC + (size_t)t * 256 + c) = dec; st_bf4(rec + 192 + j, k2); st_bf4(rec + 256 + j, r); st_bf4(rec + 320 + j, v);
                *(f32x4*)(GB + (size_t)t * 256 + c) = ag[i];
            }
            const float rn = rsqrtf(quad_sum(ss) + 1e-12f);
            bsum = quad_sum(bsum);
            if (fq == 0) BON[(size_t)t * 4 + h] = bsum;
#pragma unroll
            for (int i = 0; i < 4; ++i) {
                const int j = 16 * i + 4 * fq;
                const f32x4 kk = kx[i] * rn;
                st_bf4(rec + j, -kk); st_bf4(rec + 128 + j, kk * as_[i]);
            }
        }
        {
            bf16* rec = RECG + ((size_t)t * 4 + h) * 392;
            f32x4 yq[8], yk[8];
            float sq = 0.f, sk = 0.f;
            size_t rowo[4];
            float tapm[4];
#pragma unroll
            for (int tap = 0; tap < 4; ++tap) { const int tp = t - 3 + tap; rowo[tap] = (size_t)(tp >= 0 ? tp : 0) * NPROJ; tapm[tap] = tp >= 0 ? 1.f : 0.f; }
#pragma unroll
            for (int which = 0; which < 3; ++which) {
                u32x2 raw[8][4];
#pragma unroll
                for (int i = 0; i < 8; ++i) {
                    if ((i & 3) == 0) {
#pragma unroll
                        for (int i2 = i; i2 < i + 4; ++i2)
#pragma unroll
                            for (int tap = 0; tap < 4; ++tap) raw[i2][tap] = *(const u32x2*)(PROJ + rowo[tap] + 1024 + which * 512 + h * 128 + 16 * i2 + 4 * fq);
                        asm volatile("" ::: "memory");
                    }
                    const int j = 16 * i + 4 * fq, ch = which * 512 + h * 128 + j;
                    f32x4 cv = {0.f, 0.f, 0.f, 0.f};
#pragma unroll
                    for (int tap = 0; tap < 4; ++tap) cv = cv + UNPK4(raw[i][tap]) * (*(const f32x4*)(CW + tap * 1536 + ch) * tapm[tap]);
                    f32x4 y; y.x = siluf_(cv.x); y.y = siluf_(cv.y); y.z = siluf_(cv.z); y.w = siluf_(cv.w);
                    if (which == 0) { yq[i] = y; sq += y.x * y.x + y.y * y.y + y.z * y.z + y.w * y.w; }
                    else if (which == 1) { yk[i] = y; sk += y.x * y.x + y.y * y.y + y.z * y.z + y.w * y.w; }
                    else st_bf4(rec + 256 + j, y);
                }
            }
            const float rq = rsqrtf(quad_sum(sq) + 1e-12f) * 0.08838834764831845f, rk = rsqrtf(quad_sum(sk) + 1e-12f);
#pragma unroll
            for (int i = 0; i < 8; ++i) { const int j = 16 * i + 4 * fq; st_bf4(rec + j, yq[i] * rq); st_bf4(rec + 128 + j, yk[i] * rk); }
            if (fq == 0) {
                const float av = PEX[(size_t)t * 64 + h], bv = PEX[(size_t)t * 64 + 4 + h];
                const float g = -__expf(p.in[22][l * 4 + h]) * softplusf_(av + p.in[23][l * 4 + h]);
                *(f32x4*)(GSC + ((size_t)t * 4 + h) * 4) = (f32x4){__expf(g), fsig(bv), g, 0.f};
            }
        }
        {
            bf16* rec = RECT + ((size_t)t * 4 + h) * 192;
            u32x2 q1r[2], q2r[2], k1r[2], k2r[2], vr[4]; f32x4 c0r[2], c1r[2];
#pragma unroll
            for (int u = 0; u < 2; ++u) {
                const int i = 16 * u + 4 * fq;
                c0r[u] = *(const f32x4*)(ROT + ((size_t)t * 32 + i) * 2); c1r[u] = *(const f32x4*)(ROT + ((size_t)t * 32 + i) * 2 + 4);
                q1r[u] = *(const u32x2*)(PROJ + (size_t)t * NPROJ + 3072 + h * 64 + i); q2r[u] = *(const u32x2*)(PROJ + (size_t)t * NPROJ + 3072 + h * 64 + 32 + i);
                k1r[u] = *(const u32x2*)(PROJ + (size_t)t * NPROJ + 3328 + h * 64 + i); k2r[u] = *(const u32x2*)(PROJ + (size_t)t * NPROJ + 3328 + h * 64 + 32 + i);
            }
#pragma unroll
            for (int i = 0; i < 4; ++i) vr[i] = *(const u32x2*)(PROJ + (size_t)t * NPROJ + 3584 + h * 64 + 16 * i + 4 * fq);
            asm volatile("" ::: "memory");
#pragma unroll
            for (int u = 0; u < 2; ++u) {
                const int i = 16 * u + 4 * fq;
                const f32x4 cs = {c0r[u].x, c0r[u].z, c1r[u].x, c1r[u].z}, sn = {c0r[u].y, c0r[u].w, c1r[u].y, c1r[u].w};
                const f32x4 q1 = UNPK4(q1r[u]), q2 = UNPK4(q2r[u]), k1 = UNPK4(k1r[u]), k2 = UNPK4(k2r[u]);
                st_bf4(rec + i, q1 * cs - q2 * sn); st_bf4(rec + 32 + i, q1 * sn + q2 * cs);
                st_bf4(rec + 64 + i, (k1 * cs - k2 * sn) * 0.125f); st_bf4(rec + 96 + i, (k1 * sn + k2 * cs) * 0.125f);
            }
#pragma unroll
            for (int i = 0; i < 4; ++i) *(u32x2*)(rec + 128 + 16 * i + 4 * fq) = vr[i];
        }
#undef UNPK4
        __syncthreads();
    }
}

DEVI void retA_item(const P& p, int item, char* smem) {
    const bf16* REC = (const bf16*)(p.ws + WS_RECT); float* KV = (float*)(p.ws + WS_RKV);
    bf16* KT = (bf16*)smem; bf16* VT = KT + 64 * 72;
    const int n = item >> 2, h = item & 3;
    int tid = VTID; asm volatile("" : "+v"(tid));
    const int lane = tid & 63, w = tid >> 6, fr = lane & 15, fq = lane >> 4;
    const float lg = log2f(1.f - exp2f(-5.f - (float)h));
    {
        u32x4 v[4];
#pragma unroll
        for (int i = 0; i < 4; ++i) { const int idx = tid + 256 * i, c = idx >> 4, j = idx & 15; v[i] = *(const u32x4*)(REC + ((size_t)(n * 64 + c) * 4 + h) * 192 + 64 + j * 8); }
#pragma unroll
        for (int i = 0; i < 4; ++i) {
            const int idx = tid + 256 * i, c = idx >> 4, j = idx & 15;
            const float sc = (j < 8) ? exp2f((float)(63 - c) * lg) : 1.f;
            bf16* dst = ((j < 8) ? KT : VT) + ((j & 7) * 8) * 72 + c;
#pragma unroll
            for (int q = 0; q < 4; ++q) {
                const unsigned u = v[i][q];
                dst[(2 * q) * 72] = (j < 8) ? (bf16)f2bf(__uint_as_float(u << 16) * sc) : (bf16)(u & 0xffffu);
                dst[(2 * q + 1) * 72] = (j < 8) ? (bf16)f2bf(__uint_as_float(u & 0xffff0000u) * sc) : (bf16)(u >> 16);
            }
        }
    }
    __syncthreads();
    {
        const int dt = w;
        const bf16x8 a0 = ldfrag(KT, 72, 16 * dt, 0, lane), a1 = ldfrag(KT, 72, 16 * dt, 32, lane);
        float* out = KV + (size_t)item * 4096;
        const int s_ = dt >> 1, lane2 = 16 * (2 * (dt & 1) + (fq >> 1)) + fr;
#pragma unroll
        for (int et = 0; et < 4; ++et) {
            f32x4 acc = {0.f, 0.f, 0.f, 0.f};
            acc = mfma16(a0, ldfrag(VT, 72, 16 * et, 0, lane), acc);
            acc = mfma16(a1, ldfrag(VT, 72, 16 * et, 32, lane), acc);
            *(f32x4*)(out + ((et * 2 + s_) * 64 + lane2) * 8 + 4 * (fq & 1)) = acc;
        }
    }
    __syncthreads();
}

DEVI void retS_item(const P& p, int item) {
    const float* KV = (const float*)(p.ws + WS_RKV); bf16* RST = (bf16*)(p.ws + WS_RST);
    const int idx = item * NT + VTID;
    const int h = idx >> 12, i = idx & 4095;
    const float cd = exp2f(64.f * log2f(1.f - exp2f(-5.f - (float)h)));
    float r = 0.f;
#pragma unroll 1
    for (int n0 = 0; n0 < 256; n0 += 32) {
        float kv[32];
#pragma unroll
        for (int q = 0; q < 32; ++q) kv[q] = KV[((size_t)(n0 + q) * 4 + h) * 4096 + i];
#pragma unroll
        for (int q = 0; q < 32; ++q) { RST[((size_t)(n0 + q) * 4 + h) * 4096 + i] = (bf16)f2bf(r); r = r * cd + kv[q]; }
    }
}

DEVI void retC_item(const P& p, int item, int l, char* smem) {
    const bf16* REC = (const bf16*)(p.ws + WS_RECT); const bf16* RST = (const bf16*)(p.ws + WS_RST);
    const bf16* PROJ = (const bf16*)(p.ws + WS_PROJ); bf16* MIX = (bf16*)(p.ws + WS_MIX);
    const float* rgn = p.in[25] + l * 256; const float* rbn = p.in[26] + l * 256;
    bf16* Qs = (bf16*)smem; bf16* Ks = Qs + 64 * 72; bf16* VT = Ks + 64 * 72; bf16* Ps = VT + 64 * 72;
    const int n = item >> 2, h = item & 3;
    int tid = VTID; asm volatile("" : "+v"(tid));
    const int lane = tid & 63, w = tid >> 6, fr = lane & 15, fq = lane >> 4;
    const float lg = log2f(1.f - exp2f(-5.f - (float)h));
    {
        u32x4 v[6];
#pragma unroll
        for (int i = 0; i < 6; ++i) { const int idx = tid + 256 * i, c = idx / 24, j = idx - c * 24; v[i] = *(const u32x4*)(REC + ((size_t)(n * 64 + c) * 4 + h) * 192 + j * 8); }
#pragma unroll
        for (int i = 0; i < 6; ++i) {
            const int idx = tid + 256 * i, c = idx / 24, j = idx - c * 24;
            if (j < 16) *(u32x4*)(((j < 8) ? Qs : Ks) + c * 72 + (j & 7) * 8) = v[i];
            else {
                bf16* dst = VT + ((j & 7) * 8) * 72 + c;
#pragma unroll
                for (int q = 0; q < 4; ++q) { const unsigned u = v[i][q]; dst[(2 * q) * 72] = (bf16)(u & 0xffffu); dst[(2 * q + 1) * 72] = (bf16)(u >> 16); }
            }
        }
    }
    __syncthreads();
    const int ct = w, c = 16 * ct + fr;
    const bf16x8 q0 = ldfrag(Qs, 72, 16 * ct, 0, lane), q1 = ldfrag(Qs, 72, 16 * ct, 32, lane);
#pragma unroll
    for (int ct2 = 0; ct2 < 4; ++ct2) {
        f32x4 acc = {0.f, 0.f, 0.f, 0.f};
        acc = mfma16(ldfrag(Ks, 72, 16 * ct2, 0, lane), q0, acc);
        acc = mfma16(ldfrag(Ks, 72, 16 * ct2, 32, lane), q1, acc);
        float pv[4];
#pragma unroll
        for (int j = 0; j < 4; ++j) {
            const int c2 = 16 * ct2 + 4 * fq + j;
            pv[j] = (c >= c2) ? acc[j] * exp2f((float)(c - c2) * lg) : 0.f;
        }
        *(u32x2*)(Ps + c * 72 + 16 * ct2 + 4 * fq) = (u32x2){pk2(pv[0], pv[1]), pk2(pv[2], pv[3])};
    }
    __syncthreads();
    {
        const bf16x8 p0 = ldfrag(Ps, 72, 16 * ct, 0, lane), p1 = ldfrag(Ps, 72, 16 * ct, 32, lane);
        const float xi = exp2f((float)(c + 1) * lg);
        const bf16* RF = RST + (size_t)item * 4096;
        f32x4 o[4];
        float sm = 0.f;
        bf16x8 rfr[4][2];
#pragma unroll
        for (int et = 0; et < 4; ++et) { rfr[et][0] = *(const bf16x8*)(RF + ((et * 2 + 0) * 64 + lane) * 8); rfr[et][1] = *(const bf16x8*)(RF + ((et * 2 + 1) * 64 + lane) * 8); }
        asm volatile("" ::: "memory");
#pragma unroll
        for (int et = 0; et < 4; ++et) {
            f32x4 ai = {0.f, 0.f, 0.f, 0.f}, ax = {0.f, 0.f, 0.f, 0.f};
            ai = mfma16(ldfrag(VT, 72, 16 * et, 0, lane), p0, ai);
            ai = mfma16(ldfrag(VT, 72, 16 * et, 32, lane), p1, ai);
            ax = mfma16(rfr[et][0], q0, ax);
            ax = mfma16(rfr[et][1], q1, ax);
            o[et] = ai + ax * xi;
            sm += (o[et].x + o[et].y) + (o[et].z + o[et].w);
        }
        const float mean = quad_sum(sm) * (1.f / 64.f);
        float sv = 0.f;
#pragma unroll
        for (int et = 0; et < 4; ++et) { o[et] = o[et] - mean; sv += o[et].x * o[et].x + o[et].y * o[et].y + o[et].z * o[et].z + o[et].w * o[et].w; }
        const float rs = rsqrtf(quad_sum(sv) * (1.f / 64.f) + 1e-5f);
        const int t = n * 64 + c;
#pragma unroll
        for (int et = 0; et < 4; ++et) {
            const int e = h * 64 + 16 * et + 4 * fq;
            const f32x4 g = *(const f32x4*)(rgn + e), b = *(const f32x4*)(rbn + e);
            const f32x4 gt = ld_bf4(PROJ + (size_t)t * NPROJ + 3840 + e);
            const f32x4 y = o[et] * rs * g + b;
            *(u32x2*)(MIX + (size_t)t * D + 768 + e) = (u32x2){pk2(y.x * siluf_(gt.x), y.y * siluf_(gt.y)), pk2(y.z * siluf_(gt.z), y.w * siluf_(gt.w))};
        }
    }
    __syncthreads();
}

template <int I, int N> struct SolveRow {
    static DEVI void run(float (&x)[N], const float* M) {
        float s0 = 0.f, s1 = 0.f, s2 = 0.f, s3 = 0.f;
#pragma unroll
        for (int j4 = 0; j4 < (I + 3) / 4; ++j4) {
            const f32x4 m = *(const f32x4*)(M + I * N + 4 * j4);
            s0 += m.x * x[4 * j4]; s1 += m.y * x[4 * j4 + 1]; s2 += m.z * x[4 * j4 + 2]; s3 += m.w * x[4 * j4 + 3];
        }
        x[I] -= (s0 + s1) + (s2 + s3);
        asm volatile("" : "+v"(x[I]) :: "memory");
        SolveRow<I + 1, N>::run(x, M);
    }
};
template <int N> struct SolveRow<N, N> { static DEVI void run(float (&)[N], const float*) {} };

DEVI void gdnA_item(const P& p, int item, char* smem) {
    const bf16* REC = (const bf16*)(p.ws + WS_RECG); const float* GSC = (const float*)(p.ws + WS_GSC) + ((size_t)(item >> 2) * 64 * 4 + (item & 3)) * 4;
    bf16* GP = (bf16*)(p.ws + WS_GP) + (size_t)item * 16384; float* GB = (float*)(p.ws + WS_GB) + (size_t)item * 16384;
    float* GD = (float*)(p.ws + WS_GD);
    bf16* GQ = (bf16*)(p.ws + WS_GQ) + (size_t)item * 8192; float* GO = (float*)(p.ws + WS_GO) + (size_t)item * 8192;
    bf16* Kb = (bf16*)smem; bf16* Qb = Kb + 64 * 136;
    bf16* WT = (bf16*)smem; bf16* UT = WT + 128 * 72;
    bf16* Vb = (bf16*)(smem + 36864);
    float* M = (float*)(smem + 36864);
    bf16* KdT = (bf16*)(smem + 36864);
    bf16* At = (bf16*)(smem + 55296);
    float* gcs = (float*)(smem + 64512); float* bts = gcs + 64; float* sws = gcs + 128; float* sks = gcs + 192;
    const int n = item >> 2, h = item & 3;
    int tid = VTID; asm volatile("" : "+v"(tid));
    const int lane = tid & 63, w = tid >> 6, fr = lane & 15, fq = lane >> 4;
    const bf16* rec0 = REC + ((size_t)(n * 64) * 4 + h) * 392;
    if (w == 0) {
        float x = GSC[lane * 16 + 2];
#pragma unroll
        for (int off = 1; off < 64; off <<= 1) { const float y = __shfl_up(x, off); if (lane >= off) x += y; }
        const float bt = GSC[lane * 16 + 1];
        gcs[lane] = x; bts[lane] = bt; sws[lane] = bt * __expf(x); sks[lane] = __expf(__shfl(x, 63) - x);
    }
    {
        u32x4 v[12];
#pragma unroll
        for (int i = 0; i < 12; ++i) { const int idx = tid + 256 * i, c = idx / 48, j = idx - c * 48; v[i] = *(const u32x4*)(rec0 + (size_t)c * 1568 + j * 8); }
#pragma unroll
        for (int i = 0; i < 12; ++i) {
            const int idx = tid + 256 * i, c = idx / 48, j = idx - c * 48, which = j >> 4;
            const int boff = (which == 0 ? 17408 : 0) + (which == 2 ? 36864 : 0);
            *(u32x4*)(smem + boff + (c * 136 + (j & 15) * 8) * 2) = v[i];
        }
    }
    __syncthreads();
    float x[64];
    unsigned kdp[16];
    {
        const int col = tid & 127;
        int sel_b = (tid < 128) ? 36864 : 0, sel_s = (tid < 128) ? 64 : 128;
        asm volatile("" : "+v"(sel_b), "+v"(sel_s));
        const bf16* srcb = (const bf16*)(smem + sel_b) + col;
        const float* scs = gcs + sel_s;
#pragma unroll
        for (int c = 0; c < 64; ++c) {
            x[c] = scs[c] * bf2f(srcb[c * 136]);
            if ((c & 7) == 7) asm volatile("" : "+v"(x[c]) :: "memory");
        }
        const int half = tid >> 7;
#pragma unroll
        for (int i = 0; i < 16; ++i) {
            const int c = 32 * half + 2 * i;
            kdp[i] = pk2(bf2f(Kb[c * 136 + col]) * sks[c], bf2f(Kb[(c + 1) * 136 + col]) * sks[c + 1]);
            if ((i & 3) == 3) asm volatile("" : "+v"(kdp[i]) :: "memory");
        }
        if (tid == 0) GD[item] = __expf(gcs[63]);
    }
    __syncthreads();
    const int ct = w;
    f32x4 accQ[8];
    {
        const int c = 16 * ct + fr;
        const float gcc = gcs[c];
        {
            bf16x8 ka[4];
#pragma unroll
            for (int s = 0; s < 4; ++s) ka[s] = ldfrag(Kb, 136, 16 * ct, 32 * s, lane);
#pragma unroll
            for (int ct2 = 0; ct2 < 4; ++ct2) {
                f32x4 acc = {0.f, 0.f, 0.f, 0.f};
#pragma unroll
                for (int s = 0; s < 4; ++s) acc = mfma16(ka[s], ldfrag(Kb, 136, 16 * ct2, 32 * s, lane), acc);
                const int c2 = 16 * ct2 + fr; const float g2 = gcs[c2];
#pragma unroll
                for (int j = 0; j < 4; ++j) {
                    const int cc = 16 * ct + 4 * fq + j;
                    M[cc * 64 + c2] = (cc > c2) ? bts[cc] * acc[j] * __expf(gcs[cc] - g2) : 0.f;
                }
            }
        }
        {
            bf16x8 qa[4];
#pragma unroll
            for (int s = 0; s < 4; ++s) qa[s] = ldfrag(Qb, 136, 16 * ct, 32 * s, lane);
#pragma unroll
            for (int ct2 = 0; ct2 < 4; ++ct2) {
                f32x4 acc = {0.f, 0.f, 0.f, 0.f};
#pragma unroll
                for (int s = 0; s < 4; ++s) acc = mfma16(ldfrag(Kb, 136, 16 * ct2, 32 * s, lane), qa[s], acc);
                float pv[4];
#pragma unroll
                for (int j = 0; j < 4; ++j) { const int c2 = 16 * ct2 + 4 * fq + j; pv[j] = (c >= c2) ? acc[j] * __expf(gcc - gcs[c2]) : 0.f; }
                *(u32x2*)(At + c * 72 + 16 * ct2 + 4 * fq) = (u32x2){pk2(pv[0], pv[1]), pk2(pv[2], pv[3])};
            }
        }
    }
    __syncthreads();
    {
        SolveRow<1, 64>::run(x, M);
        unsigned xp[32];
#pragma unroll
        for (int q = 0; q < 32; ++q) xp[q] = pk2(x[2 * q], x[2 * q + 1]);
        {
            const int c = 16 * ct + fr;
            const float eg = __expf(gcs[c]);
#pragma unroll
            for (int dt = 0; dt < 8; ++dt) accQ[dt] = ld_bf4(Qb + c * 136 + 16 * dt + 4 * fq) * (-eg);
        }
        __syncthreads();
        int sel_d = (tid < 128) ? 128 * 72 : 0;
        asm volatile("" : "+v"(sel_d));
        bf16* dst = WT + sel_d + (tid & 127) * 72;
#pragma unroll
        for (int q = 0; q < 8; ++q) *(u32x4*)(dst + 8 * q) = (u32x4){xp[4 * q], xp[4 * q + 1], xp[4 * q + 2], xp[4 * q + 3]};
    }
    __syncthreads();
    {
        const int d = tid & 127, half = tid >> 7;
#pragma unroll
        for (int q = 0; q < 4; ++q) *(u32x4*)(KdT + d * 72 + 32 * half + 8 * q) = (u32x4){kdp[4 * q], kdp[4 * q + 1], kdp[4 * q + 2], kdp[4 * q + 3]};
    }
    __syncthreads();
    {
#pragma unroll 1
        for (int mi = 0; mi < 2; ++mi) {
            const int mt = 2 * w + mi;
            const bf16x8 kd0 = ldfrag(KdT, 72, 16 * mt, 0, lane), kd1 = ldfrag(KdT, 72, 16 * mt, 32, lane);
#pragma unroll
            for (int sp = 0; sp < 4; ++sp) {
                f32x4 a0 = {0.f, 0.f, 0.f, 0.f}, a1 = {0.f, 0.f, 0.f, 0.f};
                a0 = mfma16(ldfrag(WT, 72, 32 * sp, 0, lane), kd0, a0); a0 = mfma16(ldfrag(WT, 72, 32 * sp, 32, lane), kd1, a0);
                a1 = mfma16(ldfrag(WT, 72, 32 * sp + 16, 0, lane), kd0, a1); a1 = mfma16(ldfrag(WT, 72, 32 * sp + 16, 32, lane), kd1, a1);
                *(u32x4*)(GP + ((mt * 4 + sp) * 64 + lane) * 8) = (u32x4){pk2(-a0.x, -a0.y), pk2(-a0.z, -a0.w), pk2(-a1.x, -a1.y), pk2(-a1.z, -a1.w)};
            }
#pragma unroll
            for (int nt = 0; nt < 8; ++nt) {
                f32x4 a = {0.f, 0.f, 0.f, 0.f};
                a = mfma16(kd0, ldfrag(UT, 72, 16 * nt, 0, lane), a); a = mfma16(kd1, ldfrag(UT, 72, 16 * nt, 32, lane), a);
                *(f32x4*)(GB + ((nt * 8 + mt) * 64 + lane) * 4) = a;
            }
        }
        const bf16x8 at0 = ldfrag(At, 72, 16 * ct, 0, lane), at1 = ldfrag(At, 72, 16 * ct, 32, lane);
#pragma unroll
        for (int sp = 0; sp < 4; ++sp) {
            f32x4 a0 = accQ[2 * sp], a1 = accQ[2 * sp + 1];
            a0 = mfma16(ldfrag(WT, 72, 32 * sp, 0, lane), at0, a0); a0 = mfma16(ldfrag(WT, 72, 32 * sp, 32, lane), at1, a0);
            a1 = mfma16(ldfrag(WT, 72, 32 * sp + 16, 0, lane), at0, a1); a1 = mfma16(ldfrag(WT, 72, 32 * sp + 16, 32, lane), at1, a1);
            *(u32x4*)(GQ + ((ct * 4 + sp) * 64 + lane) * 8) = (u32x4){pk2(-a0.x, -a0.y), pk2(-a0.z, -a0.w), pk2(-a1.x, -a1.y), pk2(-a1.z, -a1.w)};
        }
#pragma unroll
        for (int et = 0; et < 8; ++et) {
            f32x4 a = {0.f, 0.f, 0.f, 0.f};
            a = mfma16(ldfrag(UT, 72, 16 * et, 0, lane), at0, a); a = mfma16(ldfrag(UT, 72, 16 * et, 32, lane), at1, a);
            *(f32x4*)(GO + ((ct * 8 + et) * 64 + lane) * 4) = a;
        }
    }
    __syncthreads();
}

DEVI bf16x8 pack_frag(const f32x4& a, const f32x4& b) {
    const u32x4 v = {pk2(a.x, a.y), pk2(a.z, a.w), pk2(b.x, b.y), pk2(b.z, b.w)};
    return __builtin_bit_cast(bf16x8, v);
}
DEVI void gdnL1_item(const P& p, int item, char* smem) {
    const bf16* GP = (const bf16*)(p.ws + WS_GP); const float* GB = (const float*)(p.ws + WS_GB); const float* GD = (const float*)(p.ws + WS_GD);
    const int half = item & 1, kind = (item >> 1) & 1, g = (item >> 2) & 15, h = item >> 6;
    const int tid = VTID, lane = tid & 63, ew = half * 4 + (tid >> 6), fr = lane & 15, fq = lane >> 4;
    const int n0 = g * 16;
#define L1_DMA(n) do { const bf16* _s = GP + ((size_t)(n) * 4 + h) * 16384 + tid * 8; char* _d = smem + ((n) & 1) * 32768 + tid * 16; \
        _Pragma("unroll") for (int _i = 0; _i < 8; ++_i) __builtin_amdgcn_global_load_lds((const unsigned*)(_s + _i * 2048), (unsigned*)(_d + _i * 4096), 16, 0, 0); } while (0)
    f32x4 acc[8];
    L1_DMA(n0);
    if (kind == 0) {
        bf16* GS = (bf16*)(p.ws + WS_GS);
#pragma unroll
        for (int m = 0; m < 8; ++m) acc[m] = (f32x4){0.f, 0.f, 0.f, 0.f};
        f32x4 bcur[8], bnxt[8]; float dcur, dnxt = 0.f;
        {
            const float* Bn = GB + ((size_t)n0 * 4 + h) * 16384 + (ew * 8 * 64 + lane) * 4;
#pragma unroll
            for (int m = 0; m < 8; ++m) bcur[m] = *(const f32x4*)(Bn + m * 256);
            dcur = GD[(size_t)n0 * 4 + h];
        }
#pragma unroll 1
        for (int n = n0; n < n0 + 16; ++n) {
            const size_t it = (size_t)n * 4 + h;
            asm volatile("s_waitcnt vmcnt(0)" ::: "memory");
            __syncthreads();
            if (n + 1 < n0 + 16) {
                L1_DMA(n + 1);
                const float* Bn = GB + (it + 4) * 16384 + (ew * 8 * 64 + lane) * 4;
#pragma unroll
                for (int m = 0; m < 8; ++m) bnxt[m] = *(const f32x4*)(Bn + m * 256);
                dnxt = GD[it + 4];
            }
            const char* ring = smem + (n & 1) * 32768 + lane * 16;
            bf16x8 sf[4];
#pragma unroll
            for (int s = 0; s < 4; ++s) {
                sf[s] = pack_frag(acc[2 * s], acc[2 * s + 1]);
                *(bf16x8*)(GS + it * 16384 + ((ew * 4 + s) * 64 + lane) * 8) = sf[s];
            }
#pragma unroll
            for (int m = 0; m < 8; ++m) {
                f32x4 a = acc[m] * dcur + bcur[m];
#pragma unroll
                for (int s = 0; s < 4; ++s) a = mfma16(*(const bf16x8*)(ring + (m * 4 + s) * 1024), sf[s], a);
                acc[m] = a;
            }
#pragma unroll
            for (int m = 0; m < 8; ++m) bcur[m] = bnxt[m];
            dcur = dnxt;
        }
        float* E0 = (float*)(p.ws + WS_GE0) + (size_t)(h * 16 + g) * 16384 + (ew * 8 * 64 + lane) * 4;
#pragma unroll
        for (int m = 0; m < 8; ++m) *(f32x4*)(E0 + m * 256) = acc[m];
    } else {
        const bf16* GQ = (const bf16*)(p.ws + WS_GQ); bf16* GR = (bf16*)(p.ws + WS_GR);
#pragma unroll
        for (int m = 0; m < 8; ++m)
#pragma unroll
            for (int j = 0; j < 4; ++j) acc[m][j] = (m == ew && 4 * fq + j == fr) ? 1.f : 0.f;
#pragma unroll 1
        for (int n = n0; n < n0 + 16; ++n) {
            const size_t it = (size_t)n * 4 + h;
            asm volatile("s_waitcnt vmcnt(0)" ::: "memory");
            __syncthreads();
            if (n + 1 < n0 + 16) L1_DMA(n + 1);
            bf16x8 qf[16];
#pragma unroll
            for (int i = 0; i < 16; ++i) qf[i] = *(const bf16x8*)(GQ + it * 8192 + (i * 64 + lane) * 8);
            const float dn = GD[it];
            const char* ring = smem + (n & 1) * 32768 + lane * 16;
            bf16x8 tf[4];
#pragma unroll
            for (int s = 0; s < 4; ++s) tf[s] = pack_frag(acc[2 * s], acc[2 * s + 1]);
#pragma unroll
            for (int m = 0; m < 8; ++m) {
                f32x4 a = acc[m] * dn;
#pragma unroll
                for (int s = 0; s < 4; ++s) a = mfma16(*(const bf16x8*)(ring + (m * 4 + s) * 1024), tf[s], a);
                acc[m] = a;
            }
#pragma unroll
            for (int tt = 0; tt < 4; ++tt) {
                f32x4 r = {0.f, 0.f, 0.f, 0.f};
#pragma unroll
                for (int s = 0; s < 4; ++s) r = mfma16(tf[s], qf[tt * 4 + s], r);
                *(u32x2*)(GR + it * 8192 + ((tt * 4 + (ew >> 1)) * 64 + lane) * 8 + 4 * (ew & 1)) = (u32x2){pk2(r.x, r.y), pk2(r.z, r.w)};
            }
        }
        bf16* TE = (bf16*)(p.ws + WS_GTE) + (size_t)(h * 16 + g) * 16384;
        const int s_ = ew >> 1, jj = 4 * (ew & 1) + (fr & 3), lg = fr >> 2;
#pragma unroll
        for (int m = 0; m < 8; ++m)
#pragma unroll
            for (int j = 0; j < 4; ++j) TE[((m * 4 + s_) * 64 + (4 * fq + j) + 16 * lg) * 8 + jj] = (bf16)f2bf(acc[m][j]);
    }
    asm volatile("s_waitcnt vmcnt(0)" ::: "memory");
    __syncthreads();
#undef L1_DMA
}
DEVI void gdnL2_item(const P& p, int item, char* smem) {
    const bf16* TE = (const bf16*)(p.ws + WS_GTE); const float* E0 = (const float*)(p.ws + WS_GE0); bf16* SG = (bf16*)(p.ws + WS_GSG);
    const int h = item >> 1, tid = VTID, lane = tid & 63, ew = (item & 1) * 4 + (tid >> 6);
#define L2_DMA(g) do { const bf16* _s = TE + ((size_t)h * 16 + (g)) * 16384 + tid * 8; char* _d = smem + ((g) & 1) * 32768 + tid * 16; \
        _Pragma("unroll") for (int _i = 0; _i < 8; ++_i) __builtin_amdgcn_global_load_lds((const unsigned*)(_s + _i * 2048), (unsigned*)(_d + _i * 4096), 16, 0, 0); } while (0)
    f32x4 acc[8];
#pragma unroll
    for (int m = 0; m < 8; ++m) acc[m] = (f32x4){0.f, 0.f, 0.f, 0.f};
    L2_DMA(0);
    f32x4 bcur[8], bnxt[8];
    {
        const float* En = E0 + (size_t)h * 16 * 16384 + (ew * 8 * 64 + lane) * 4;
#pragma unroll
        for (int m = 0; m < 8; ++m) bcur[m] = *(const f32x4*)(En + m * 256);
    }
#pragma unroll 1
    for (int g = 0; g < 16; ++g) {
        const size_t hg = (size_t)h * 16 + g;
        asm volatile("s_waitcnt vmcnt(0)" ::: "memory");
        __syncthreads();
        if (g + 1 < 16) {
            L2_DMA(g + 1);
            const float* En = E0 + (hg + 1) * 16384 + (ew * 8 * 64 + lane) * 4;
#pragma unroll
            for (int m = 0; m < 8; ++m) bnxt[m] = *(const f32x4*)(En + m * 256);
        }
        const char* ring = smem + (g & 1) * 32768 + lane * 16;
        bf16x8 sf[4];
#pragma unroll
        for (int s = 0; s < 4; ++s) {
            sf[s] = pack_frag(acc[2 * s], acc[2 * s + 1]);
            *(bf16x8*)(SG + hg * 16384 + ((ew * 4 + s) * 64 + lane) * 8) = sf[s];
        }
#pragma unroll
        for (int m = 0; m < 8; ++m) {
            f32x4 a = bcur[m];
#pragma unroll
            for (int s = 0; s < 4; ++s) a = mfma16(*(const bf16x8*)(ring + (m * 4 + s) * 1024), sf[s], a);
            acc[m] = a;
        }
#pragma unroll
        for (int m = 0; m < 8; ++m) bcur[m] = bnxt[m];
    }
    asm volatile("s_waitcnt vmcnt(0)" ::: "memory");
    __syncthreads();
#undef L2_DMA
}

DEVI void gdnC_item(const P& p, int item, int l) {
    const bf16* GQ = (const bf16*)(p.ws + WS_GQ) + (size_t)item * 8192; const float* GO = (const float*)(p.ws + WS_GO) + (size_t)item * 8192;
    const bf16* GS = (const bf16*)(p.ws + WS_GS) + (size_t)item * 16384;
    const bf16* PROJ = (const bf16*)(p.ws + WS_PROJ); bf16* MIX = (bf16*)(p.ws + WS_MIX);
    const float* gn = p.in[24] + l * 128;
    const int n = item >> 2, h = item & 3;
    const int lane = VTID & 63, ct = VTID >> 6, fr = lane & 15, fq = lane >> 4;
    const bf16* GR = (const bf16*)(p.ws + WS_GR) + (size_t)item * 8192;
    const bf16* SG = (const bf16*)(p.ws + WS_GSG) + (size_t)(h * 16 + (n >> 4)) * 16384;
    bf16x8 qf[4], rf[4];
#pragma unroll
    for (int s = 0; s < 4; ++s) { qf[s] = *(const bf16x8*)(GQ + ((ct * 4 + s) * 64 + lane) * 8); rf[s] = *(const bf16x8*)(GR + ((ct * 4 + s) * 64 + lane) * 8); }
    const int t = n * 64 + 16 * ct + fr;
    f32x4 a[8];
    float ss = 0.f;
    u32x2 zr[8]; f32x4 gv[8];
#pragma unroll
    for (int et = 0; et < 8; ++et) { zr[et] = *(const u32x2*)(PROJ + (size_t)t * NPROJ + 2560 + h * 128 + 16 * et + 4 * fq); gv[et] = *(const f32x4*)(gn + 16 * et + 4 * fq); }
#pragma unroll
    for (int e2 = 0; e2 < 4; ++e2) {
        f32x4 c0[2]; bf16x8 gs[2][4], sg[2][4];
#pragma unroll
        for (int u = 0; u < 2; ++u) {
            const int et = 2 * e2 + u;
            c0[u] = *(const f32x4*)(GO + ((ct * 8 + et) * 64 + lane) * 4);
#pragma unroll
            for (int s = 0; s < 4; ++s) { gs[u][s] = *(const bf16x8*)(GS + ((et * 4 + s) * 64 + lane) * 8); sg[u][s] = *(const bf16x8*)(SG + ((et * 4 + s) * 64 + lane) * 8); }
        }
        asm volatile("" ::: "memory");
#pragma unroll
        for (int u = 0; u < 2; ++u) {
            f32x4 acc = c0[u];
#pragma unroll
            for (int s = 0; s < 4; ++s) acc = mfma16(gs[u][s], qf[s], acc);
#pragma unroll
            for (int s = 0; s < 4; ++s) acc = mfma16(sg[u][s], rf[s], acc);
            a[2 * e2 + u] = acc;
            ss += acc.x * acc.x + acc.y * acc.y + acc.z * acc.z + acc.w * acc.w;
        }
    }
    const float rs = rsqrtf(quad_sum(ss) * (1.f / 128.f) + 1e-6f);
#pragma unroll
    for (int et = 0; et < 8; ++et) {
        const int e = 16 * et + 4 * fq;
        const f32x4 z = {__uint_as_float(zr[et].x << 16), __uint_as_float(zr[et].x & 0xffff0000u), __uint_as_float(zr[et].y << 16), __uint_as_float(zr[et].y & 0xffff0000u)};
        const f32x4 o = a[et] * rs * gv[et];
        *(u32x2*)(MIX + (size_t)t * D + 256 + h * 128 + e) = (u32x2){pk2(o.x * siluf_(z.x), o.y * siluf_(z.y)), pk2(o.z * siluf_(z.z), o.w * siluf_(z.w))};
    }
}

DEVI void rwkA_item(const P& p, int item, char* smem) {
    const bf16* REC = (const bf16*)(p.ws + WS_RECR); const float* WDEC = (const float*)(p.ws + WS_WDEC);
    bf16* WP = (bf16*)(p.ws + WS_WP) + (size_t)item * 4096; float* WC = (float*)(p.ws + WS_WC) + (size_t)item * 4096;
    float* WD = (float*)(p.ws + WS_WD) + (size_t)item * 64;
    bf16* WQ = (bf16*)(p.ws + WS_WQ) + (size_t)item * 2048; float* WY = (float*)(p.ws + WS_WY) + (size_t)item * 2048;
    bf16* At_ = (bf16*)smem; bf16* Rt = At_ + 32 * 72; bf16* Bt = Rt + 32 * 72; bf16* Kt = Bt + 32 * 72;
    float* ZT = (float*)(smem + 9216);
    bf16* BhT = (bf16*)(smem + 18432); bf16* KhT = BhT + 64 * 40; bf16* VT = KhT + 64 * 40; bf16* AhT = VT + 64 * 40; bf16* UhT = AhT + 64 * 40;
    float* M = (float*)(smem + 44032);
    bf16* Aak = (bf16*)(smem + 48128); bf16* Arb = Aak + 32 * 40; bf16* Ark = Arb + 32 * 40;
    float* tot = (float*)(smem + 55808);
    const int n = item >> 2, h = item & 3;
    int tid = VTID; asm volatile("" : "+v"(tid));
    const int lane = tid & 63, w = tid >> 6, fr = lane & 15, fq = lane >> 4;
    {
        const int d = lane;
        const bf16* rec = REC + ((size_t)(n * 32 + 8 * w) * 4 + h) * 384 + d;
        const float* dcy = WDEC + (size_t)(n * 32 + 8 * w) * 256 + h * 64 + d;
        float lw[8], lg[8];
        float run = 0.f;
        float dcv[8]; bf16 ra[8], rb[8], rk[8], rr_[8], rv[8];
#pragma unroll
        for (int i = 0; i < 8; ++i) {
            const bf16* r = rec + (size_t)i * 1536;
            dcv[i] = dcy[i * 256]; ra[i] = r[0]; rb[i] = r[128]; rk[i] = r[192]; rr_[i] = r[256]; rv[i] = r[320];
        }
        asm volatile("" ::: "memory");
#pragma unroll
        for (int i = 0; i < 8; ++i) { lg[i] = __logf(dcv[i]); run += lg[i]; lw[i] = run; }
        tot[w * 64 + d] = run;
        __syncthreads();
        float off = 0.f, total = 0.f;
#pragma unroll
        for (int q = 0; q < 4; ++q) { const float tq = tot[q * 64 + d]; total += tq; off += (q < w) ? tq : 0.f; }
        unsigned bh[4], kh[4], vv[4];
        float pb = 0.f, pk = 0.f, pv = 0.f;
#pragma unroll
        for (int i = 0; i < 8; ++i) {
            const float a = bf2f(ra[i]), b = bf2f(rb[i]), k = bf2f(rk[i]), rr = bf2f(rr_[i]), v = bf2f(rv[i]);
            const float lc = off + lw[i];
            const float cw = __expf(lc), cwm1 = __expf(lc - lg[i]), inv = __expf(-lc), rat = __expf(total - lc);
            const int t = 8 * w + i;
            At_[t * 72 + d] = (bf16)f2bf(a * cwm1); Rt[t * 72 + d] = (bf16)f2bf(rr * cw);
            Bt[t * 72 + d] = (bf16)f2bf(b * inv); Kt[t * 72 + d] = (bf16)f2bf(k * inv);
            if (i & 1) { bh[i >> 1] = pk2(pb, b * rat); kh[i >> 1] = pk2(pk, k * rat); vv[i >> 1] = pk2(pv, v); }
            else { pb = b * rat; pk = k * rat; pv = v; }
        }
        *(u32x4*)(BhT + d * 40 + 8 * w) = (u32x4){bh[0], bh[1], bh[2], bh[3]};
        *(u32x4*)(KhT + d * 40 + 8 * w) = (u32x4){kh[0], kh[1], kh[2], kh[3]};
        *(u32x4*)(VT + d * 40 + 8 * w) = (u32x4){vv[0], vv[1], vv[2], vv[3]};
        if (w == 0) WD[d] = __expf(total);
    }
    __syncthreads();
    {
        int offA = (w == 0) ? 0 : (w == 1 ? 3 : (w == 2 ? 2 : 3));
        int offB = (w == 0) ? 2 : (w == 1 ? 0 : 1);
        asm volatile("" : "+v"(offA), "+v"(offB));
        const bf16* As = At_ + offA * (32 * 72); const bf16* Bs = At_ + offB * (32 * 72);
#pragma unroll
        for (int ta = 0; ta < 2; ++ta) {
            const bf16x8 a0 = ldfrag(As, 72, 16 * ta, 0, lane), a1 = ldfrag(As, 72, 16 * ta, 32, lane);
#pragma unroll
            for (int tb = 0; tb < 2; ++tb) {
                f32x4 acc = {0.f, 0.f, 0.f, 0.f};
                acc = mfma16(a0, ldfrag(Bs, 72, 16 * tb, 0, lane), acc);
                acc = mfma16(a1, ldfrag(Bs, 72, 16 * tb, 32, lane), acc);
                if (w == 0) {
                    const int s_ = 16 * tb + fr;
#pragma unroll
                    for (int j = 0; j < 4; ++j) { const int t = 16 * ta + 4 * fq + j; M[t * 32 + s_] = (t > s_) ? -acc[j] : 0.f; }
                } else {
                    const int t = 16 * tb + fr;
                    float pv4[4];
#pragma unroll
                    for (int j = 0; j < 4; ++j) { const int s_ = 16 * ta + 4 * fq + j; pv4[j] = ((w == 1) ? (t > s_) : (t >= s_)) ? acc[j] : 0.f; }
                    int offD = w - 1; asm volatile("" : "+v"(offD));
                    *(u32x2*)(Aak + offD * (32 * 40) + t * 40 + 16 * ta + 4 * fq) = (u32x2){pk2(pv4[0], pv4[1]), pk2(pv4[2], pv4[3])};
                }
            }
        }
    }
    __syncthreads();
    {
        const int et = w;
        const bf16x8 vf = ldfrag(VT, 40, 16 * et, 0, lane);
#pragma unroll
        for (int tt = 0; tt < 2; ++tt) {
            f32x4 acc = {0.f, 0.f, 0.f, 0.f};
            acc = mfma16(ldfrag(Aak, 40, 16 * tt, 0, lane), vf, acc);
            *(f32x4*)(ZT + (16 * et + fr) * 36 + 16 * tt + 4 * fq) = acc;
        }
    }
    __syncthreads();
    if (tid < 128) {
        float x[32];
        if (tid < 64) {
#pragma unroll
            for (int t = 0; t < 32; ++t) x[t] = bf2f(At_[t * 72 + tid]);
        } else {
#pragma unroll
            for (int q = 0; q < 8; ++q) { const f32x4 z = *(const f32x4*)(ZT + (tid - 64) * 36 + 4 * q); x[4 * q] = z.x; x[4 * q + 1] = z.y; x[4 * q + 2] = z.z; x[4 * q + 3] = z.w; }
        }
        SolveRow<1, 32>::run(x, M);
        bf16* dst = AhT + tid * 40;
#pragma unroll
        for (int q = 0; q < 4; ++q)
            *(u32x4*)(dst + 8 * q) = (u32x4){pk2(x[8 * q], x[8 * q + 1]), pk2(x[8 * q + 2], x[8 * q + 3]), pk2(x[8 * q + 4], x[8 * q + 5]), pk2(x[8 * q + 6], x[8 * q + 7])};
    }
    __syncthreads();
    {
        const int mt = w;
        const bf16x8 bh = ldfrag(BhT, 40, 16 * mt, 0, lane), kh = ldfrag(KhT, 40, 16 * mt, 0, lane);
#pragma unroll
        for (int sp = 0; sp < 2; ++sp) {
            f32x4 a0 = {0.f, 0.f, 0.f, 0.f}, a1 = {0.f, 0.f, 0.f, 0.f};
            a0 = mfma16(ldfrag(AhT, 40, 32 * sp, 0, lane), bh, a0);
            a1 = mfma16(ldfrag(AhT, 40, 32 * sp + 16, 0, lane), bh, a1);
            *(u32x4*)(WP + ((mt * 2 + sp) * 64 + lane) * 8) = (u32x4){pk2(a0.x, a0.y), pk2(a0.z, a0.w), pk2(a1.x, a1.y), pk2(a1.z, a1.w)};
        }
#pragma unroll
        for (int nt = 0; nt < 4; ++nt) {
            f32x4 a = {0.f, 0.f, 0.f, 0.f};
            a = mfma16(bh, ldfrag(UhT, 40, 16 * nt, 0, lane), a);
            a = mfma16(kh, ldfrag(VT, 40, 16 * nt, 0, lane), a);
            *(f32x4*)(WC + ((nt * 4 + mt) * 64 + lane) * 4) = a;
        }
        {
            const int ct = w & 1, sp = w >> 1, t = 16 * ct + fr;
            const bf16x8 ar = ldfrag(Arb, 40, 16 * ct, 0, lane);
            f32x4 a0 = ld_bf4(Rt + t * 72 + 32 * sp + 4 * fq), a1 = ld_bf4(Rt + t * 72 + 32 * sp + 16 + 4 * fq);
            a0 = mfma16(ldfrag(AhT, 40, 32 * sp, 0, lane), ar, a0);
            a1 = mfma16(ldfrag(AhT, 40, 32 * sp + 16, 0, lane), ar, a1);
            *(u32x4*)(WQ + ((ct * 2 + sp) * 64 + lane) * 8) = (u32x4){pk2(a0.x, a0.y), pk2(a0.z, a0.w), pk2(a1.x, a1.y), pk2(a1.z, a1.w)};
        }
        {
            const int et = w;
            const bf16x8 uf = ldfrag(UhT, 40, 16 * et, 0, lane), vf = ldfrag(VT, 40, 16 * et, 0, lane);
#pragma unroll
            for (int ct = 0; ct < 2; ++ct) {
                f32x4 a = {0.f, 0.f, 0.f, 0.f};
                a = mfma16(uf, ldfrag(Arb, 40, 16 * ct, 0, lane), a);
                a = mfma16(vf, ldfrag(Ark, 40, 16 * ct, 0, lane), a);
                *(f32x4*)(WY + ((ct * 4 + et) * 64 + lane) * 4) = a;
            }
        }
    }
    __syncthreads();
}

struct RwkStep { bf16x8 pf[8]; f32x4 cf[4]; f32x4 dv[4]; };
DEVI void rwk_load(RwkStep& r, const bf16* WP, const float* WC, const float* WD, size_t it, int ew, int lane) {
#pragma unroll
    for (int i = 0; i < 8; ++i) r.pf[i] = *(const bf16x8*)(WP + it * 4096 + (i * 64 + lane) * 8);
#pragma unroll
    for (int m = 0; m < 4; ++m) r.cf[m] = *(const f32x4*)(WC + it * 4096 + ((ew * 4 + m) * 64 + lane) * 4);
#pragma unroll
    for (int m = 0; m < 4; ++m) r.dv[m] = *(const f32x4*)(WD + it * 64 + 16 * m + 4 * (lane >> 4));
}
DEVI void rwk_step(const RwkStep& r, f32x4 (&acc)[4], bf16* WSF, size_t it, int ew, int lane) {
    bf16x8 sf[2];
#pragma unroll
    for (int s = 0; s < 2; ++s) {
        const u32x4 v = {pk2(acc[2 * s].x, acc[2 * s].y), pk2(acc[2 * s].z, acc[2 * s].w), pk2(acc[2 * s + 1].x, acc[2 * s + 1].y), pk2(acc[2 * s + 1].z, acc[2 * s + 1].w)};
        *(u32x4*)(WSF + it * 4096 + ((ew * 2 + s) * 64 + lane) * 8) = v;
        sf[s] = __builtin_bit_cast(bf16x8, v);
    }
#pragma unroll
    for (int m = 0; m < 4; ++m) {
        f32x4 a = acc[m] * r.dv[m] + r.cf[m];
        a = mfma16(r.pf[m * 2], sf[0], a);
        a = mfma16(r.pf[m * 2 + 1], sf[1], a);
        acc[m] = a;
    }
}
DEVI void rwkL1_item(const P& p, int item) {
    const bf16* WP = (const bf16*)(p.ws + WS_WP); const float* WC = (const float*)(p.ws + WS_WC); const float* WD = (const float*)(p.ws + WS_WD);
    const int kind = item & 1, g = (item >> 1) & 15, h = item >> 5;
    const int lane = VTID & 63, ew = VTID >> 6, fr = lane & 15, fq = lane >> 4;
    f32x4 acc[4];
    if (kind == 0) {
        bf16* WSF = (bf16*)(p.ws + WS_WS);
#pragma unroll
        for (int m = 0; m < 4; ++m) acc[m] = (f32x4){0.f, 0.f, 0.f, 0.f};
        RwkStep A, B;
        const int n0 = g * 32;
        rwk_load(A, WP, WC, WD, (size_t)n0 * 4 + h, ew, lane);
#pragma unroll 1
        for (int n = n0; n < n0 + 32; n += 2) {
            rwk_load(B, WP, WC, WD, (size_t)(n + 1) * 4 + h, ew, lane);
            asm volatile("" ::: "memory");
            rwk_step(A, acc, WSF, (size_t)n * 4 + h, ew, lane);
            rwk_load(A, WP, WC, WD, (size_t)((n + 2 < n0 + 32) ? n + 2 : n) * 4 + h, ew, lane);
            asm volatile("" ::: "memory");
            rwk_step(B, acc, WSF, (size_t)(n + 1) * 4 + h, ew, lane);
        }
        float* E0 = (float*)(p.ws + WS_WE0) + (size_t)(h * 16 + g) * 4096 + (ew * 4 * 64 + lane) * 4;
#pragma unroll
        for (int m = 0; m < 4; ++m) *(f32x4*)(E0 + m * 256) = acc[m];
    } else {
        const bf16* WQ = (const bf16*)(p.ws + WS_WQ); bf16* WR = (bf16*)(p.ws + WS_WR);
#pragma unroll
        for (int m = 0; m < 4; ++m)
#pragma unroll
            for (int j = 0; j < 4; ++j) acc[m][j] = (m == ew && 4 * fq + j == fr) ? 1.f : 0.f;
#pragma unroll 1
        for (int n = g * 32; n < g * 32 + 32; ++n) {
            const size_t it = (size_t)n * 4 + h;
            bf16x8 pf[8], qf[4]; f32x4 dv[4];
#pragma unroll
            for (int i = 0; i < 8; ++i) pf[i] = *(const bf16x8*)(WP + it * 4096 + (i * 64 + lane) * 8);
#pragma unroll
            for (int i = 0; i < 4; ++i) qf[i] = *(const bf16x8*)(WQ + it * 2048 + (i * 64 + lane) * 8);
#pragma unroll
            for (int m = 0; m < 4; ++m) dv[m] = *(const f32x4*)(WD + it * 64 + 16 * m + 4 * fq);
            asm volatile("" ::: "memory");
            bf16x8 tf[2];
#pragma unroll
            for (int s = 0; s < 2; ++s) tf[s] = pack_frag(acc[2 * s], acc[2 * s + 1]);
#pragma unroll
            for (int tt = 0; tt < 2; ++tt) {
                f32x4 r = {0.f, 0.f, 0.f, 0.f};
                r = mfma16(tf[0], qf[tt * 2], r); r = mfma16(tf[1], qf[tt * 2 + 1], r);
                *(u32x2*)(WR + it * 2048 + ((tt * 2 + (ew >> 1)) * 64 + lane) * 8 + 4 * (ew & 1)) = (u32x2){pk2(r.x, r.y), pk2(r.z, r.w)};
            }
#pragma unroll
            for (int m = 0; m < 4; ++m) {
                f32x4 a = acc[m] * dv[m];
                a = mfma16(pf[m * 2], tf[0], a); a = mfma16(pf[m * 2 + 1], tf[1], a);
                acc[m] = a;
            }
        }
        bf16* TE = (bf16*)(p.ws + WS_WTE) + (size_t)(h * 16 + g) * 4096;
        const int s_ = ew >> 1, jj = 4 * (ew & 1) + (fr & 3), lg = fr >> 2;
#pragma unroll
        for (int m = 0; m < 4; ++m)
#pragma unroll
            for (int j = 0; j < 4; ++j) TE[((m * 2 + s_) * 64 + (4 * fq + j) + 16 * lg) * 8 + jj] = (bf16)f2bf(acc[m][j]);
    }
}
DEVI void rwkL2_item(const P& p, int h) {
    const bf16* TE = (const bf16*)(p.ws + WS_WTE); const float* E0 = (const float*)(p.ws + WS_WE0); bf16* SG = (bf16*)(p.ws + WS_WSG);
    const int lane = VTID & 63, ew = VTID >> 6;
    f32x4 acc[4];
#pragma unroll
    for (int m = 0; m < 4; ++m) acc[m] = (f32x4){0.f, 0.f, 0.f, 0.f};
#pragma unroll 1
    for (int g = 0; g < 16; ++g) {
        const size_t hg = (size_t)h * 16 + g;
        bf16x8 pf[8]; f32x4 bfr[4];
#pragma unroll
        for (int i = 0; i < 8; ++i) pf[i] = *(const bf16x8*)(TE + hg * 4096 + (i * 64 + lane) * 8);
#pragma unroll
        for (int m = 0; m < 4; ++m) bfr[m] = *(const f32x4*)(E0 + hg * 4096 + ((ew * 4 + m) * 64 + lane) * 4);
        asm volatile("" ::: "memory");
        bf16x8 sf[2];
#pragma unroll
        for (int s = 0; s < 2; ++s) {
            sf[s] = pack_frag(acc[2 * s], acc[2 * s + 1]);
            *(bf16x8*)(SG + hg * 4096 + ((ew * 2 + s) * 64 + lane) * 8) = sf[s];
        }
#pragma unroll
        for (int m = 0; m < 4; ++m) {
            f32x4 a = bfr[m];
            a = mfma16(pf[m * 2], sf[0], a); a = mfma16(pf[m * 2 + 1], sf[1], a);
            acc[m] = a;
        }
    }
}

DEVI void rwkC_item(const P& p, int n, int l) {
    const int lane = VTID & 63, h = VTID >> 6, fr = lane & 15, fq = lane >> 4;
    const size_t it = (size_t)n * 4 + h;
    const bf16* WQ = (const bf16*)(p.ws + WS_WQ) + it * 2048; const float* WY = (const float*)(p.ws + WS_WY) + it * 2048;
    const bf16* WSF = (const bf16*)(p.ws + WS_WS) + it * 4096;
    const bf16* WR = (const bf16*)(p.ws + WS_WR) + it * 2048; const bf16* WSG = (const bf16*)(p.ws + WS_WSG) + (size_t)(h * 16 + (n >> 5)) * 4096;
    const bf16* RECR = (const bf16*)(p.ws + WS_RECR); const float* GB = (const float*)(p.ws + WS_G); const float* BON = (const float*)(p.ws + WS_BON);
    bf16* MIX = (bf16*)(p.ws + WS_MIX);
    const float* ln_g = p.in[17] + l * 256 + h * 64; const float* ln_b = p.in[18] + l * 256 + h * 64;
#pragma unroll
    for (int ct = 0; ct < 2; ++ct) {
        const bf16x8 q0 = *(const bf16x8*)(WQ + ((ct * 2 + 0) * 64 + lane) * 8), q1 = *(const bf16x8*)(WQ + ((ct * 2 + 1) * 64 + lane) * 8);
        const bf16x8 r0 = *(const bf16x8*)(WR + ((ct * 2 + 0) * 64 + lane) * 8), r1 = *(const bf16x8*)(WR + ((ct * 2 + 1) * 64 + lane) * 8);
        const int t = n * 32 + 16 * ct + fr;
        f32x4 a[4];
        float sm = 0.f;
        f32x4 y0[4]; bf16x8 sfr[4][2], sgr[4][2];
#pragma unroll
        for (int et = 0; et < 4; ++et) {
            y0[et] = *(const f32x4*)(WY + ((ct * 4 + et) * 64 + lane) * 4);
#pragma unroll
            for (int s = 0; s < 2; ++s) { sfr[et][s] = *(const bf16x8*)(WSF + ((et * 2 + s) * 64 + lane) * 8); sgr[et][s] = *(const bf16x8*)(WSG + ((et * 2 + s) * 64 + lane) * 8); }
        }
        asm volatile("" ::: "memory");
#pragma unroll
        for (int et = 0; et < 4; ++et) {
            f32x4 acc = y0[et];
            acc = mfma16(sfr[et][0], q0, acc);
            acc = mfma16(sfr[et][1], q1, acc);
            acc = mfma16(sgr[et][0], r0, acc);
            acc = mfma16(sgr[et][1], r1, acc);
            a[et] = acc; sm += (acc.x + acc.y) + (acc.z + acc.w);
        }
        const float mean = quad_sum(sm) * (1.f / 64.f);
        float sv = 0.f;
#pragma unroll
        for (int et = 0; et < 4; ++et) { a[et] = a[et] - mean; sv += a[et].x * a[et].x + a[et].y * a[et].y + a[et].z * a[et].z + a[et].w * a[et].w; }
        const float rs = rsqrtf(quad_sum(sv) * (1.f / 64.f) + 64e-5f);
        const float bon = BON[(size_t)t * 4 + h];
        f32x4 gq[4], bq[4], vq[4], gateq[4];
#pragma unroll
        for (int et = 0; et < 4; ++et) {
            const int e = 16 * et + 4 * fq;
            gq[et] = *(const f32x4*)(ln_g + e); bq[et] = *(const f32x4*)(ln_b + e);
            vq[et] = ld_bf4(RECR + ((size_t)t * 4 + h) * 384 + 320 + e);
            gateq[et] = *(const f32x4*)(GB + (size_t)t * 256 + h * 64 + e);
        }
        asm volatile("" ::: "memory");
#pragma unroll
        for (int et = 0; et < 4; ++et) {
            const int e = 16 * et + 4 * fq;
            const f32x4 g = gq[et], b = bq[et];
            const f32x4 v = vq[et];
            const f32x4 gate = gateq[et];
            const f32x4 o = (a[et] * rs * g + b + v * bon) * gate;
            *(u32x2*)(MIX + (size_t)t * D + h * 64 + e) = (u32x2){pk2(o.x, o.y), pk2(o.z, o.w)};
        }
    }
}

DEVI void phase_scanL1(const P& p, char* smem) {
    for (int item = VBID; item < 448; item += VNB) {
        if (item < 256) gdnL1_item(p, item, smem);
        else if (item < 384) rwkL1_item(p, item - 256);
        else retS_item(p, item - 384);
    }
}
DEVI void retC_item(const P& p, int item, int l, char* smem);
DEVI void phase_scanL2(const P& p, int l, char* smem) {
    if (VBID < 12) { if (VBID < 8) gdnL2_item(p, VBID, smem); else rwkL2_item(p, VBID - 8); }
    else { for (int item = VBID - 12; item < 1024; item += VNB - 12) retC_item(p, item, l, smem); }
}
DEVI void phase_chunkA(const P& p, char* smem) {
    for (int item = VBID; item < 4096; item += VNB) { if (item < 1024) gdnA_item(p, item, smem); else if (item < 3072) rwkA_item(p, item - 1024, smem); else retA_item(p, item - 3072, smem); }
}
DEVI void phase_chunkC(const P& p, int l, char* smem) {
    for (int item = VBID; item < 1536; item += VNB) { if (item < 1024) gdnC_item(p, item, l); else rwkC_item(p, item - 1024, l); }
}

DEVI void phase_ln1_route(const P& p, int l, char* smem, bool commit = true) {
    const float* ADA = (const float*)(p.ws + OFF_ADA) + l * 6144;
    const float* xin = (l == 0) ? p.in[0] : (const float*)(p.ws + WS_X);
    const float* OPRE = (const float*)(p.ws + WS_OPRE);
    float* X = (float*)(p.ws + WS_X); bf16* H2 = (bf16*)(p.ws + WS_H2);
    const float* lg = p.in[28] + l * D; const float* lb = p.in[29] + l * D;
    const float* rw = p.in[30] + (size_t)l * D * 32; const float* rbias = p.in[31] + l * 32;
    int* CNT = (int*)(p.ws + OFF_CNT) + l * 32 * 64; int* LIST = (int*)(p.ws + WS_LIST); float* GATE = (float*)(p.ws + WS_GATE);
    constexpr int HSS = 1028;
    float* HS = (float*)smem;
    float* RED = HS;
    int* SEL = (int*)(HS + 16 * HSS);
    int* RNK = SEL + 256;
    int* BASE = RNK + 256;
    int nasg = 0;
    const int tid = VTID, lane = tid & 63, w = tid >> 6, fr = lane & 15, fq = lane >> 4;
    f32x4 cg1[4], cg[4], cb[4], cG2[4], cB2[4];
#pragma unroll
    for (int j = 0; j < 4; ++j) {
        const int c = j * 256 + lane * 4;
        const f32x4 gt = *(const f32x4*)(ADA + 2048 + c), sh = *(const f32x4*)(ADA + 3072 + c), sc = *(const f32x4*)(ADA + 4096 + c);
        cg1[j] = gt + 1.f; cg[j] = *(const f32x4*)(lg + c); cb[j] = *(const f32x4*)(lb + c);
        cG2[j] = sc + 1.f; cB2[j] = sh;
    }
    const u32x4* RWF = (const u32x4*)(p.ws + WS_RWF) + (size_t)((l * 32 + w * 8) * 4) * 64 + lane;
    f32x4 xb[4], ob[4];
#define LN1_LOAD(tok) do { const size_t _o = (size_t)(tok) * D + lane * 4; _Pragma("unroll") for (int _j = 0; _j < 4; ++_j) { \
        xb[_j] = *(const f32x4*)(xin + _o + _j * 256); ob[_j] = *(const f32x4*)(OPRE + _o + _j * 256); } } while (0)
    LN1_LOAD(VBID * 16 + w);
    for (int item = VBID; item < S / 16; item += VNB) {
#pragma unroll 1
        for (int sub = 0; sub < 4; ++sub) {
            const int t = item * 16 + sub * 4 + w;
            f32x4 v[4]; float s = 0.f;
#pragma unroll
            for (int j = 0; j < 4; ++j) {
                v[j] = xb[j] * DN_ALPHA + cg1[j] * ob[j];
                s += (v[j].x + v[j].y) + (v[j].z + v[j].w);
            }
            {
                int tn = (sub < 3) ? t + 4 : (item + VNB) * 16 + w;
                if (tn >= S) tn = t;
                asm volatile("" ::: "memory");
                LN1_LOAD(tn);
                asm volatile("" ::: "memory");
            }
            const float mean = wave_sum(s) * (1.f / D);
            float s2 = 0.f;
#pragma unroll
            for (int j = 0; j < 4; ++j) { v[j] = v[j] - mean; s2 += (v[j].x * v[j].x + v[j].y * v[j].y) + (v[j].z * v[j].z + v[j].w * v[j].w); }
            const float rstd = rsqrtf(wave_sum(s2) * (1.f / D) + 1e-5f);
#pragma unroll
            for (int j = 0; j < 4; ++j) {
                const int c = j * 256 + lane * 4;
                f32x4 xo = v[j] * rstd * cg[j] + cb[j];
                *(f32x4*)(X + (size_t)t * D + c) = xo;
                f32x4 hh = xo * cG2[j] + cB2[j];
                *(f32x4*)(HS + (sub * 4 + w) * HSS + c) = hh;
                u32x2 o; o.x = pk2(hh.x, hh.y); o.y = pk2(hh.z, hh.w);
                *(u32x2*)(H2 + (size_t)t * D + c) = o;
            }
        }
        __syncthreads();
        f32x4 lacc[2] = {{0.f, 0.f, 0.f, 0.f}, {0.f, 0.f, 0.f, 0.f}};
        {
            const float* hrow = HS + fr * HSS + w * 256 + 8 * fq;
#pragma unroll
            for (int hb = 0; hb < 4; ++hb) {
                u32x4 bw[2][4];
#pragma unroll
                for (int s4 = 0; s4 < 2; ++s4)
#pragma unroll
                    for (int q = 0; q < 4; ++q) bw[s4][q] = RWF[((hb * 2 + s4) * 4 + q) * 64];
                asm volatile("" ::: "memory");
#pragma unroll
                for (int s4 = 0; s4 < 2; ++s4) {
                    const int ks = hb * 2 + s4;
                    const f32x4 h0 = *(const f32x4*)(hrow + 32 * ks), h1 = *(const f32x4*)(hrow + 32 * ks + 4);
                    const unsigned p0 = pk2(h0.x, h0.y), p1 = pk2(h0.z, h0.w), p2 = pk2(h1.x, h1.y), p3 = pk2(h1.z, h1.w);
                    const unsigned q0 = pk2(h0.x - __uint_as_float(p0 << 16), h0.y - __uint_as_float(p0 & 0xffff0000u));
                    const unsigned q1 = pk2(h0.z - __uint_as_float(p1 << 16), h0.w - __uint_as_float(p1 & 0xffff0000u));
                    const unsigned q2 = pk2(h1.x - __uint_as_float(p2 << 16), h1.y - __uint_as_float(p2 & 0xffff0000u));
                    const unsigned q3 = pk2(h1.z - __uint_as_float(p3 << 16), h1.w - __uint_as_float(p3 & 0xffff0000u));
                    const bf16x8 ahi = __builtin_bit_cast(bf16x8, ((u32x4){p0, p1, p2, p3})), alo = __builtin_bit_cast(bf16x8, ((u32x4){q0, q1, q2, q3}));
#pragma unroll
                    for (int n = 0; n < 2; ++n) {
                        const bf16x8 bhi = __builtin_bit_cast(bf16x8, bw[s4][2 * n]), blo = __builtin_bit_cast(bf16x8, bw[s4][2 * n + 1]);
                        lacc[n] = mfma16(ahi, bhi, lacc[n]); lacc[n] = mfma16(alo, bhi, lacc[n]); lacc[n] = mfma16(ahi, blo, lacc[n]);
                    }
                }
            }
        }
        __syncthreads();
#pragma unroll
        for (int n = 0; n < 2; ++n)
#pragma unroll
            for (int j = 0; j < 4; ++j) RED[(w * 16 + 4 * fq + j) * 32 + 16 * n + fr] = lacc[n][j];
        __syncthreads();
#pragma unroll 1
        for (int rnd = 0; rnd < 2; ++rnd) {
            const int tok = rnd * 8 + (tid >> 5), e = tid & 31, tt = item * 16 + tok;
            float logit = rbias[e];
#pragma unroll
            for (int ks = 0; ks < 4; ++ks) logit += RED[(ks * 16 + tok) * 32 + e];
            bool taken = false;
            float sv[4]; int si[4];
#pragma unroll
            for (int j = 0; j < 4; ++j) {
                float cand = taken ? -3.0e38f : logit; int ci = e;
#pragma unroll
                for (int off = 16; off >= 1; off >>= 1) {
                    const float ov = __shfl_xor(cand, off, 32); const int oi = __shfl_xor(ci, off, 32);
                    if (ov > cand || (ov == cand && oi < ci)) { cand = ov; ci = oi; }
                }
                sv[j] = cand; si[j] = ci; if (ci == e) taken = true;
            }
            const float e0 = 1.f, e1 = __expf(sv[1] - sv[0]), e2 = __expf(sv[2] - sv[0]), e3 = __expf(sv[3] - sv[0]);
            const float inv = 1.f / (e0 + e1 + e2 + e3);
            const float gts[4] = {e0 * inv, e1 * inv, e2 * inv, e3 * inv};
#pragma unroll
            for (int j = 0; j < 4; ++j) {
                if (si[j] == e) {
                    SEL[nasg + tok * 4 + j] = ((tt * 4 + j) << 5) | e;
                    GATE[(size_t)tt * 4 + j] = gts[j];
                }
            }
        }
        nasg += 64;
        __syncthreads();
    }
    if (!commit) return;
    if (tid < 32) {
        int c = 0;
        for (int a = 0; a < nasg; ++a) { if ((SEL[a] & 31) == tid) { RNK[a] = c; ++c; } }
        BASE[tid] = c ? atomicAdd(&CNT[tid * 64], c) : 0;
    }
    __syncthreads();
    for (int a = tid; a < nasg; a += NT) { const int v = SEL[a], e = v & 31; LIST[(size_t)e * S + BASE[e] + RNK[a]] = v >> 5; }
    __syncthreads();
#undef LN1_LOAD
}

DEVI void phase_ln2(const P& p, int l) {
    const float* ADA = (const float*)(p.ws + OFF_ADA) + l * 6144;
    const float* ADAn = (const float*)(p.ws + OFF_ADA) + 6144;
    float* X = (float*)(p.ws + WS_X); const bf16* YB = (const bf16*)(p.ws + WS_YB);
    bf16* HB = (bf16*)(p.ws + WS_HB);
    const float* lg = p.in[36] + l * D; const float* lb = p.in[37] + l * D;
    const int tid = VTID, lane = tid & 63, w = tid >> 6;
    for (int item = VBID; item < S / 4; item += VNB) {
        const int t = item * 4 + w;
        f32x4 v[4]; float s = 0.f;
#pragma unroll
        for (int j = 0; j < 4; ++j) {
            const int c = j * 256 + lane * 4;
            const f32x4 x = *(const f32x4*)(X + (size_t)t * D + c);
            f32x4 f = {0.f, 0.f, 0.f, 0.f};
#pragma unroll
            for (int q = 0; q < 4; ++q) {
                const u32x2 y = *(const u32x2*)(YB + ((size_t)t * 4 + q) * D + c);
                f.x += __uint_as_float(y.x << 16); f.y += __uint_as_float(y.x & 0xffff0000u);
                f.z += __uint_as_float(y.y << 16); f.w += __uint_as_float(y.y & 0xffff0000u);
            }
            const f32x4 gt = *(const f32x4*)(ADA + 5120 + c);
            v[j] = x * DN_ALPHA + (gt + 1.f) * f;
            s += (v[j].x + v[j].y) + (v[j].z + v[j].w);
        }
        const float mean = wave_sum(s) * (1.f / D);
        float s2 = 0.f;
#pragma unroll
        for (int j = 0; j < 4; ++j) { v[j] = v[j] - mean; s2 += (v[j].x * v[j].x + v[j].y * v[j].y) + (v[j].z * v[j].z + v[j].w * v[j].w); }
        const float rstd = rsqrtf(wave_sum(s2) * (1.f / D) + 1e-5f);
#pragma unroll
        for (int j = 0; j < 4; ++j) {
            const int c = j * 256 + lane * 4;
            const f32x4 g = *(const f32x4*)(lg + c), b = *(const f32x4*)(lb + c);
            const f32x4 xo = v[j] * rstd * g + b;
            if (l == 0) {
                *(f32x4*)(X + (size_t)t * D + c) = xo;
                const f32x4 sh = *(const f32x4*)(ADAn + c), sc = *(const f32x4*)(ADAn + 1024 + c);
                const f32x4 hh = xo * (sc + 1.f) + sh;
                u32x2 o; o.x = pk2(hh.x, hh.y); o.y = pk2(hh.z, hh.w);
                *(u32x2*)(HB + (size_t)t * D + c) = o;
            } else {
                *(f32x4*)(p.out + (size_t)t * D + c) = xo;
            }
        }
    }
}

namespace pg8 {
constexpr int BK = 64, HALF = 128, HTB = HALF * BK * 2, STAGE_BYTES = 8 * HTB;
DEVI int lds_byte(int r, int c) { const int st = (r >> 4) * 2 + (c >> 5), rr = r & 15, cc = c & 31, ob = rr * 64 + cc * 2; return st * 1024 + (ob ^ (((ob >> 9) & 1) << 5)); }
DEVI void stage_rc(int b, int& R, int& C) { const int st = b / 1024, sb = b % 1024, swz = sb ^ (((sb >> 9) & 1) << 5); R = (st >> 1) * 16 + swz / 64; C = (st & 1) * 32 + (swz % 64) / 2; }
struct Unit { const char* a; const char* b; int x0, x1, x2, x3; };

template <class Epi, class Sched>
DEVI void gemm_phase(LAS unsigned char* lds, const int K, const Sched& S, const Epi& E) {
    const int tid = threadIdx.x, wid = __builtin_amdgcn_readfirstlane(tid >> 6), lane = tid & 63, wr = wid >> 2, wc = wid & 3, fr = lane & 15, fq = lane >> 4;
    const int nt = K / BK;
    unsigned voffA[2], voffB[2];
    int gR[2], gC[2];
#pragma unroll
    for (int i = 0; i < 2; ++i) { int R, C; stage_rc(tid * 16 + i * 8192, R, C); gR[i] = R; gC[i] = C; voffA[i] = (unsigned)(R * K + C) * 2u; voffB[i] = (unsigned)(Epi::brow(R) * K + C) * 2u; }
    unsigned co[2][2], no[2][2];
#define PG8_GOFF(dst, tab) do { _Pragma("unroll") for (int _h = 0; _h < 2; ++_h) _Pragma("unroll") for (int _i = 0; _i < 2; ++_i) \
        dst[_h][_i] = (unsigned)((tab)[_h * 128 + gR[_i]] * K + gC[_i]) * 2u; } while (0)
    const size_t kstep = (size_t)(BK * 2);
    const size_t hstepA = (size_t)HALF * K * 2, hstepB = (size_t)Epi::BHALF * K * 2;
    const unsigned ldsw = (unsigned)wid * 1024u;
    const int aoff = lds_byte(wr * 64 + fr, fq * 8), boff = lds_byte(wc * 32 + fr, fq * 8);
#define PG8_SA(b, h) (((b) * 2 + (h)) * HTB)
#define PG8_SB(b, h) ((4 + (b) * 2 + (h)) * HTB)
#define PG8_STAGE(bufoff, gbase, voff) do { _Pragma("unroll") for (int _i = 0; _i < 2; ++_i) \
        __builtin_amdgcn_global_load_lds((const unsigned*)((const char*)(gbase) + (voff)[_i]), (LAS unsigned*)(lds + (bufoff) + ldsw + _i * 8192), 16, 0, 0); } while (0)
#define PG8_LDA(dst, b, h) do { _Pragma("unroll") for (int m = 0; m < 4; ++m) _Pragma("unroll") for (int k = 0; k < 2; ++k) dst[m][k] = *(const LAS bf16x8*)(lds + PG8_SA(b, h) + aoff + m * 2048 + k * 1024); } while (0)
#define PG8_LDB(dst, b, h) do { _Pragma("unroll") for (int n = 0; n < 2; ++n) _Pragma("unroll") for (int k = 0; k < 2; ++k) dst[n][k] = *(const LAS bf16x8*)(lds + PG8_SB(b, h) + boff + n * 2048 + k * 1024); } while (0)
#define PG8_MMA(ai, bj, At, Bt) do { __builtin_amdgcn_s_setprio(1); _Pragma("unroll") for (int m = 0; m < 4; ++m) _Pragma("unroll") for (int n = 0; n < 2; ++n) _Pragma("unroll") for (int k = 0; k < 2; ++k) \
        acc[ai][bj][m][n] = __builtin_amdgcn_mfma_f32_16x16x32_bf16(Bt[n][k], At[m][k], acc[ai][bj][m][n], 0, 0, 0); __builtin_amdgcn_s_setprio(0); } while (0)
#define PG8_WAIT_V(n) asm volatile("s_waitcnt vmcnt(" #n ")" ::: "memory")
#define PG8_WAIT_L(n) asm volatile("s_waitcnt lgkmcnt(" #n ")" ::: "memory")
#define PG8_BAR __builtin_amdgcn_s_barrier()
#define PG8_SCHED __builtin_amdgcn_sched_barrier(0)
    Unit cur, nxt; int ui = 0;
    if (!S.next(0, cur)) return;
    f32x4 acc[2][2][4][2];
#pragma unroll
    for (int a = 0; a < 2; ++a)
#pragma unroll
        for (int b = 0; b < 2; ++b)
#pragma unroll
            for (int m = 0; m < 4; ++m)
#pragma unroll
                for (int n = 0; n < 2; ++n) acc[a][b][m][n] = (f32x4){0.f, 0.f, 0.f, 0.f};
    bf16x8 At[4][2], B0[2][2], B1[2][2];
    const char* cA = cur.a; const char* cB = cur.b;
    if constexpr (Epi::GATHER_A) { PG8_GOFF(co, S.rows(0)); PG8_WAIT_L(0); }
    else {
#pragma unroll
        for (int i = 0; i < 2; ++i) { co[0][i] = voffA[i]; co[1][i] = voffA[i] + (unsigned)hstepA; no[0][i] = co[0][i]; no[1][i] = co[1][i]; }
    }
    PG8_WAIT_V(0);
    PG8_STAGE(PG8_SB(0, 0), cB, voffB); PG8_STAGE(PG8_SA(0, 0), cA, co[0]); PG8_STAGE(PG8_SB(0, 1), cB + hstepB, voffB); PG8_STAGE(PG8_SA(0, 1), cA, co[1]);
    if (wr == 1) PG8_BAR;
    PG8_WAIT_V(4); PG8_BAR;
    PG8_STAGE(PG8_SB(1, 0), cB + kstep, voffB); PG8_STAGE(PG8_SA(1, 0), cA + kstep, co[0]); PG8_STAGE(PG8_SB(1, 1), cB + hstepB + kstep, voffB);
    PG8_WAIT_V(6); PG8_BAR;
    for (;;) {
        const bool has_next = S.next(ui + 1, nxt);
        const char* nA = has_next ? nxt.a : cA; const char* nB = has_next ? nxt.b : cB;
        if constexpr (Epi::GATHER_A) { if (has_next) PG8_GOFF(no, S.rows(ui + 1)); else { no[0][0] = co[0][0]; no[0][1] = co[0][1]; no[1][0] = co[1][0]; no[1][1] = co[1][1]; } }
        for (int t = 0; t < nt; t += 2) {
            const bool last = (t == nt - 2);
            const char* a1 = cA + (size_t)(t + 1) * kstep;
            const char* a2 = last ? nA : cA + (size_t)(t + 2) * kstep; const char* b2 = last ? nB : cB + (size_t)(t + 2) * kstep;
            const char* a3 = a2 + kstep; const char* b3 = b2 + kstep;
            unsigned fo[2][2];
#pragma unroll
            for (int h = 0; h < 2; ++h)
#pragma unroll
                for (int i = 0; i < 2; ++i) fo[h][i] = last ? no[h][i] : co[h][i];
            PG8_LDB(B0, 0, 0); PG8_SCHED; PG8_LDA(At, 0, 0); PG8_STAGE(PG8_SA(1, 1), a1, co[1]);
            PG8_WAIT_L(8); PG8_BAR; PG8_WAIT_L(0); PG8_MMA(0, 0, At, B0); PG8_BAR; PG8_SCHED;
            PG8_LDB(B1, 0, 1); PG8_STAGE(PG8_SB(0, 0), b2, voffB);
            PG8_BAR; PG8_WAIT_L(0); PG8_MMA(0, 1, At, B1); PG8_BAR;
            PG8_LDA(At, 0, 1); PG8_STAGE(PG8_SA(0, 0), a2, fo[0]);
            PG8_BAR; PG8_WAIT_L(0); PG8_MMA(1, 0, At, B0); PG8_BAR; PG8_SCHED;
            PG8_STAGE(PG8_SB(0, 1), b2 + hstepB, voffB);
            PG8_WAIT_V(6); PG8_BAR; PG8_MMA(1, 1, At, B1); PG8_BAR;
            PG8_LDB(B0, 1, 0); PG8_SCHED; PG8_LDA(At, 1, 0); PG8_STAGE(PG8_SA(0, 1), a2, fo[1]);
            PG8_WAIT_L(8); PG8_BAR; PG8_WAIT_L(0); PG8_MMA(0, 0, At, B0); PG8_BAR; PG8_SCHED;
            PG8_LDB(B1, 1, 1); PG8_STAGE(PG8_SB(1, 0), b3, voffB);
            PG8_BAR; PG8_WAIT_L(0); PG8_MMA(0, 1, At, B1); PG8_BAR;
            PG8_LDA(At, 1, 1); PG8_STAGE(PG8_SA(1, 0), a3, fo[0]);
            PG8_BAR; PG8_WAIT_L(0); PG8_MMA(1, 0, At, B0); PG8_BAR; PG8_SCHED;
            PG8_STAGE(PG8_SB(1, 1), b3 + hstepB, voffB);
            PG8_WAIT_V(6); PG8_BAR; PG8_MMA(1, 1, At, B1); PG8_BAR;
        }
        E(acc, cur, wr, wc, fr, fq);
        if (!has_next) break;
#pragma unroll
        for (int a = 0; a < 2; ++a)
#pragma unroll
            for (int b = 0; b < 2; ++b)
#pragma unroll
                for (int m = 0; m < 4; ++m)
#pragma unroll
                    for (int n = 0; n < 2; ++n) acc[a][b][m][n] = (f32x4){0.f, 0.f, 0.f, 0.f};
        cur = nxt; cA = nA; cB = nB; ++ui;
#pragma unroll
        for (int h = 0; h < 2; ++h) { co[h][0] = no[h][0]; co[h][1] = no[h][1]; }
    }
    PG8_WAIT_V(0);
    if (wr == 0) PG8_BAR;
    PG8_BAR;
#undef PG8_SA
#undef PG8_GOFF
#undef PG8_SB
#undef PG8_STAGE
#undef PG8_LDA
#undef PG8_LDB
#undef PG8_MMA
#undef PG8_WAIT_V
#undef PG8_WAIT_L
#undef PG8_BAR
#undef PG8_SCHED
}
}

struct SchedDense {
    const char* A; const char* B; int K; int mode;
    DEVI const int* rows(int) const { return nullptr; }
    DEVI bool next(int i, pg8::Unit& u) const {
        const int c = blockIdx.x, x = c & 7; int pm, pn;
        if (mode == 0) { if (i > 0) return false; const int j = c >> 3; pn = j & 3; pm = 8 * x + (j >> 2); }
        else { if (i > 3) return false; const int bk = i * 8 + x, j = c >> 3; pn = 8 * (bk & 1) + (j & 7); pm = 4 * (bk >> 1) + (j >> 3); }
        u.a = A + (size_t)pm * 256 * K * 2; u.b = B + (size_t)pn * 256 * K * 2; u.x0 = pm; u.x1 = pn; u.x2 = 0; u.x3 = 0;
        return true;
    }
};
struct EpiOutF32 {
    static constexpr bool GATHER_A = false; static constexpr int BHALF = 128; static DEVI int brow(int R) { return R; }
    float* C;
    DEVI void operator()(const f32x4 (&acc)[2][2][4][2], const pg8::Unit& u, int wr, int wc, int fr, int fq) const {
#pragma unroll
        for (int ai = 0; ai < 2; ++ai)
#pragma unroll
            for (int m = 0; m < 4; ++m) {
                float* rowp = C + (size_t)(u.x0 * 256 + ai * 128 + wr * 64 + m * 16 + fr) * D + u.x1 * 256 + wc * 32 + 4 * fq;
#pragma unroll
                for (int bj = 0; bj < 2; ++bj)
#pragma unroll
                    for (int n = 0; n < 2; ++n) *(f32x4*)(rowp + bj * 128 + n * 16) = acc[ai][bj][m][n];
            }
    }
};
struct EpiProjBf16 {
    static constexpr bool GATHER_A = false; static constexpr int BHALF = 128; static DEVI int brow(int R) { return R; }
    bf16* C;
    DEVI void operator()(const f32x4 (&acc)[2][2][4][2], const pg8::Unit& u, int wr, int wc, int fr, int fq) const {
#pragma unroll
        for (int ai = 0; ai < 2; ++ai)
#pragma unroll
            for (int m = 0; m < 4; ++m) {
                bf16* rowp = C + (size_t)(u.x0 * 256 + ai * 128 + wr * 64 + m * 16 + fr) * NPROJ + u.x1 * 256 + wc * 32 + 4 * fq;
#pragma unroll
                for (int bj = 0; bj < 2; ++bj)
#pragma unroll
                    for (int n = 0; n < 2; ++n) { const f32x4 v = acc[ai][bj][m][n]; *(u32x2*)(rowp + bj * 128 + n * 16) = (u32x2){pk2(v.x, v.y), pk2(v.z, v.w)}; }
            }
    }
};
DEVI void phase_outproj8(const P& p, int l, char* smem_all) {
    SchedDense Sd{(const char*)(p.ws + WS_MIX), (const char*)(p.ws + WS_WOUT) + (size_t)l * D * D * 2, D, 0};
    EpiOutF32 E{(float*)(p.ws + WS_OPRE)};
    pg8::gemm_phase(( LAS unsigned char*)smem_all, D, Sd, E);
}
DEVI void phase_inproj8(const P& p, int l, char* smem_all) {
    SchedDense Sd{(const char*)(p.ws + WS_HB), (const char*)(p.ws + WS_WIN) + (size_t)l * NPAD * D * 2, D, 1};
    EpiProjBf16 E{(bf16*)(p.ws + WS_PROJ)};
    pg8::gemm_phase((LAS unsigned char*)smem_all, D, Sd, E);
}
DEVI void phase_inproj_extras(const P& p, int l, char* smem) {
    const bf16* HB = (const bf16*)(p.ws + WS_HB);
    const bf16* W = (const bf16*)(p.ws + WS_WIN) + (size_t)l * NPAD * D;
    float* PEX = (float*)(p.ws + WS_PEX);
    const int lane = VTID & 63, wid = VTID >> 6, wr = wid >> 1, wc = wid & 1, fr = lane & 15, fq = lane >> 4;
    for (int mt = VBID; mt < S / 128; mt += VNB) {
        f32x4 acc[4][8];
        gemm_tile(smem, HB, [&](int r) { return (unsigned)((mt * 128 + r) * D); }, W, [&](int r) { return (unsigned)((16 * 256 + r) * D); }, D, acc);
        if (wc == 0) {
#pragma unroll
            for (int m = 0; m < 4; ++m) {
                const int tok = mt * 128 + wr * 64 + m * 16 + fr;
#pragma unroll
                for (int n = 0; n < 4; ++n) *(f32x4*)(PEX + (size_t)tok * 64 + n * 16 + fq * 4) = acc[m][n];
            }
        }
    }
}

struct MoeMap8 { int cnt[32]; int off[32]; int tstart[33]; };
DEVI void moe_map8(const P& p, int l, MoeMap8* mm) {
    const int* CNT = (const int*)(p.ws + OFF_CNT) + l * 32 * 64;
    if (threadIdx.x < 32) mm->cnt[threadIdx.x] = __hip_atomic_load(&CNT[threadIdx.x * 64], __ATOMIC_RELAXED, __HIP_MEMORY_SCOPE_AGENT);
    __syncthreads();
    if (threadIdx.x == 0) {
        int o = 0, ts = 0;
        for (int e = 0; e < 32; ++e) { mm->off[e] = o; mm->tstart[e] = ts; o += mm->cnt[e]; ts += (mm->cnt[e] + 255) / 256; }
        mm->tstart[32] = ts;
    }
    __syncthreads();
}
struct MoeUnits { int n; int pad[3]; int e[32]; int m0[32]; int pn[32]; };
struct SchedMoe {
    const MoeMap8* mm; const MoeUnits* mu; const char* A; const char* Bw; int K;
    size_t bexp, bpn;
    const int* rowtab; bool gather;
    DEVI const int* rows(int i) const { return rowtab + 256 * i; }
    DEVI bool next(int i, pg8::Unit& u) const {
        if (i >= mu->n) return false;
        const int e = mu->e[i], m0 = mu->m0[i], pn = mu->pn[i], off = mm->off[e];
        u.a = gather ? A : A + (size_t)(off + m0) * K * 2; u.b = Bw + (size_t)e * bexp + (size_t)pn * bpn;
        u.x0 = e; u.x1 = m0; u.x2 = pn; u.x3 = off;
        return true;
    }
};
DEVI void moe_units(const MoeMap8* mm, MoeUnits* mu, int npn_log, int pnb_log) {
    if (threadIdx.x < 32) {
        const int x = (int)blockIdx.x & 7, j = (int)blockIdx.x >> 3, RT = mm->tstart[32], rpb = 32 >> pnb_log, nh_log = npn_log - pnb_log;
        const int bk = (int)threadIdx.x * 8 + x, rg = bk >> nh_log, ph = bk & ((1 << nh_log) - 1);
        const int rt = rpb * rg + (j >> pnb_log), pn = (ph << pnb_log) + (j & ((1 << pnb_log) - 1));
        const bool ok = rt < RT;
        if (ok) {
            int e = 0;
            while (mm->tstart[e + 1] <= rt) ++e;
            mu->e[threadIdx.x] = e; mu->m0[threadIdx.x] = (rt - mm->tstart[e]) * 256; mu->pn[threadIdx.x] = pn;
        }
        const unsigned long long okm = __ballot(ok);
        if (threadIdx.x == 0) mu->n = __popcll(okm & 0xffffffffull);
    }
    __syncthreads();
}
struct EpiMoeUp {
    static constexpr bool GATHER_A = true;
    static constexpr int BHALF = 64;
    static DEVI int brow(int R) { return ((R >> 5) & 3) * 16 + (R & 15) + (((R >> 4) & 1) ? 1024 : 0); }
    const MoeMap8* mm; bf16* ACT; const float* bup; bf16* dump;
    DEVI void operator()(const f32x4 (&acc)[2][2][4][2], const pg8::Unit& u, int wr, int wc, int fr, int fq) const {
        const int e = u.x0, cnt = mm->cnt[e];
        const float* be = bup + (size_t)e * 2048;
        f32x4 bg[2], bl[2];
#pragma unroll
        for (int bj = 0; bj < 2; ++bj) { const int col = u.x2 * 128 + (bj * 4 + wc) * 16 + 4 * fq; bg[bj] = *(const f32x4*)(be + col); bl[bj] = *(const f32x4*)(be + 1024 + col); }
#pragma unroll
        for (int ai = 0; ai < 2; ++ai)
#pragma unroll
            for (int m = 0; m < 4; ++m) {
                const int r = u.x1 + ai * 128 + wr * 64 + m * 16 + fr;
                bf16* rowp = (r < cnt) ? ACT + (size_t)(u.x3 + r) * DFF + u.x2 * 128 + wc * 16 + 4 * fq : dump + 4 * fq;
#pragma unroll
                for (int bj = 0; bj < 2; ++bj) {
                    float o[4];
#pragma unroll
                    for (int j = 0; j < 4; ++j) {
                        const float glu = fminf(acc[ai][bj][m][0][j] + bg[bj][j], 7.f);
                        const float lin = fminf(fmaxf(acc[ai][bj][m][1][j] + bl[bj][j], -7.f), 7.f);
                        o[j] = glu * sigmoidf_(1.702f * glu) * (lin + 1.f);
                    }
                    *(u32x2*)(rowp + bj * 64) = (u32x2){pk2(o[0], o[1]), pk2(o[2], o[3])};
                }
            }
    }
};
struct EpiMoeDown {
    static constexpr bool GATHER_A = false; static constexpr int BHALF = 128; static DEVI int brow(int R) { return R; }
    const MoeMap8* mm; bf16* YB; const float* bdn; const int* LIST; const float* GATE; bf16* dump;
    DEVI void operator()(const f32x4 (&acc)[2][2][4][2], const pg8::Unit& u, int wr, int wc, int fr, int fq) const {
        const int e = u.x0, cnt = mm->cnt[e];
        const float* be = bdn + (size_t)e * D + u.x2 * 256 + wc * 32 + 4 * fq;
        f32x4 bv[2][2];
#pragma unroll
        for (int bj = 0; bj < 2; ++bj)
#pragma unroll
            for (int n = 0; n < 2; ++n) bv[bj][n] = *(const f32x4*)(be + bj * 128 + n * 16);
        int ent[8]; float gt[8];
#pragma unroll
        for (int q = 0; q < 8; ++q) { const int r = u.x1 + (q >> 2) * 128 + wr * 64 + (q & 3) * 16 + fr; ent[q] = LIST[(size_t)e * S + (r < cnt ? r : cnt - 1)]; }
#pragma unroll
        for (int q = 0; q < 8; ++q) gt[q] = GATE[ent[q]];
#pragma unroll
        for (int ai = 0; ai < 2; ++ai)
#pragma unroll
            for (int m = 0; m < 4; ++m) {
                const int q = ai * 4 + m, r = u.x1 + ai * 128 + wr * 64 + m * 16 + fr;
                bf16* rowp = (r < cnt) ? YB + (size_t)ent[q] * D + u.x2 * 256 + wc * 32 + 4 * fq : dump + 4 * fq;
#pragma unroll
                for (int bj = 0; bj < 2; ++bj)
#pragma unroll
                    for (int n = 0; n < 2; ++n) {
                        const f32x4 v = (acc[ai][bj][m][n] + bv[bj][n]) * gt[q];
                        *(u32x2*)(rowp + bj * 128 + n * 16) = (u32x2){pk2(v.x, v.y), pk2(v.z, v.w)};
                    }
            }
    }
};
DEVI void phase_moe_up8(const P& p, int l, char* smem_all) {
    MoeMap8* mm = (MoeMap8*)(smem_all + 131072);
    moe_map8(p, l, mm);
    MoeUnits* mu = (MoeUnits*)(smem_all + 131072 + 512);
    moe_units(mm, mu, 3, 3);
    int* rowtab = (int*)(smem_all + 131072 + 1024);
    {
        const int* LIST = (const int*)(p.ws + WS_LIST);
        const int nu = mu->n < 12 ? mu->n : 12;
        for (int idx = threadIdx.x; idx < nu * 256; idx += KT) {
            const int i = idx >> 8, r = idx & 255, e = mu->e[i], cnt = mm->cnt[e], rr = mu->m0[i] + r;
            rowtab[idx] = LIST[(size_t)e * S + (rr < cnt ? rr : cnt - 1)] >> 2;
        }
        __syncthreads();
    }
    SchedMoe Sm{mm, mu, (const char*)(p.ws + WS_H2), (const char*)(p.ws + WS_WUP) + (size_t)l * NEXP * 2048 * D * 2, D, (size_t)2048 * D * 2, (size_t)128 * D * 2, rowtab, true};
    EpiMoeUp E{mm, (bf16*)(p.ws + WS_ACT), p.in[33] + (size_t)l * NEXP * 2048, (bf16*)(p.ws + WS_DUMP)};
    pg8::gemm_phase((LAS unsigned char*)smem_all, D, Sm, E);
}
DEVI void phase_moe_down8(const P& p, int l, char* smem_all) {
    MoeMap8* mm = (MoeMap8*)(smem_all + 131072);
    moe_map8(p, l, mm);
    MoeUnits* mu = (MoeUnits*)(smem_all + 131072 + 512);
    moe_units(mm, mu, 2, 2);
    SchedMoe Sm{mm, mu, (const char*)(p.ws + WS_ACT), (const char*)(p.ws + WS_WDN) + (size_t)l * NEXP * D * DFF * 2, DFF, (size_t)D * DFF * 2, (size_t)256 * DFF * 2, nullptr, false};
    EpiMoeDown E{mm, (bf16*)(p.ws + WS_YB), p.in[35] + (size_t)l * NEXP * D, (const int*)(p.ws + WS_LIST), (const float*)(p.ws + WS_GATE), (bf16*)(p.ws + WS_DUMP)};
    pg8::gemm_phase((LAS unsigned char*)smem_all, DFF, Sm, E);
}

constexpr int NPHASE = 24;
constexpr int LDS_TOTAL = 2 * VB_LDS + 64;
__global__ void __launch_bounds__(KT, 2) k_run(P p) {
    extern __shared__ __attribute__((aligned(16))) char smem_all[];
    char* smem = smem_all + __builtin_amdgcn_readfirstlane((int)(threadIdx.x >> 8)) * VB_LDS;
    XcdBarrier bar; bar.bar = nullptr; bar.x = 0; bar.st = nullptr;
    const bool multi = (p.ph_hi - p.ph_lo) > 1;
    if (multi) {
        volatile LAS unsigned* st = (volatile LAS unsigned*)(smem_all + 2 * VB_LDS);
        if (threadIdx.x == 0) { st[0] = 0u; st[1] = 0u; }
        __syncthreads();
        bar = xcd_barrier_post((unsigned*)(p.ws + OFF_BAR), st);
    }
#ifndef DUP
#define DUP -1
#endif
#ifndef DUP2
#define DUP2 -1
#endif
#define RUN(k, call) if (p.ph_lo <= (k) && (k) < p.ph_hi) { for (int _rep = ((k) == DUP || (k) == DUP2) ? 2 : 1; _rep > 0; --_rep) { call; if (multi && ((k) + 1 < p.ph_hi || _rep > 1)) xcd_barrier(bar); } }
    RUN(0, phase_prep(p, smem))
    RUN(1, phase_h0(p))
    RUN(2, { phase_inproj8(p, 0, smem_all); phase_inproj_extras(p, 0, smem); })
    RUN(3, phase_mixprep(p, 0, smem))
    RUN(4, phase_chunkA(p, smem))
    RUN(5, phase_scanL1(p, smem))
    RUN(6, phase_scanL2(p, 0, smem))
    RUN(7, phase_chunkC(p, 0, smem))
    RUN(8, phase_outproj8(p, 0, smem_all))
    RUN(9, phase_ln1_route(p, 0, smem, _rep == 1))
    RUN(10, phase_moe_up8(p, 0, smem_all))
    RUN(11, phase_moe_down8(p, 0, smem_all))
    RUN(12, phase_ln2(p, 0))
    RUN(13, { phase_inproj8(p, 1, smem_all); phase_inproj_extras(p, 1, smem); })
    RUN(14, phase_mixprep(p, 1, smem))
    RUN(15, phase_chunkA(p, smem))
    RUN(16, phase_scanL1(p, smem))
    RUN(17, phase_scanL2(p, 1, smem))
    RUN(18, phase_chunkC(p, 1, smem))
    RUN(19, phase_outproj8(p, 1, smem_all))
    RUN(20, phase_ln1_route(p, 1, smem))
    RUN(21, phase_moe_up8(p, 1, smem_all))
    RUN(22, phase_moe_down8(p, 1, smem_all))
    RUN(23, phase_ln2(p, 1))
#undef RUN
}

extern "C" void kernel_launch(void* const* d_in, const int* in_sizes, int n_in, void* d_out, int out_size, void* d_ws, size_t ws_size,
                              hipStream_t stream) {
    static int grid = 0;
    if (grid == 0) {
        if (n_in != 38 || ws_size < WS_END) { fprintf(stderr, "kernel_launch: unexpected n_in %d or ws_size %zu (< %zu)\n", n_in, ws_size, (size_t)WS_END); grid = -1; return; }
        int dev = 0, cus = 0, per_cu = 0;
        hipGetDevice(&dev);
        hipDeviceGetAttribute(&cus, hipDeviceAttributeMultiprocessorCount, dev);
        hipFuncSetAttribute((const void*)k_run, hipFuncAttributeMaxDynamicSharedMemorySize, LDS_TOTAL);
        hipOccupancyMaxActiveBlocksPerMultiprocessor(&per_cu, (const void*)k_run, KT, LDS_TOTAL);
        if (per_cu < 1) { fprintf(stderr, "kernel_launch: occupancy query returned %d\n", per_cu); grid = -1; return; }
        if (cus != 256) { fprintf(stderr, "kernel_launch: built for 256 CUs (one workgroup per CU), device has %d\n", cus); grid = -1; return; }
        grid = cus;
    }
    if (grid < 0) return;
    hipMemsetAsync((char*)d_ws + WS_CTL, 0, CTL_BYTES, stream);
    P p{};
    for (int i = 0; i < 38; ++i) p.in[i] = (const float*)d_in[i];
    p.pos = (const int*)d_in[2];
    p.out = (float*)d_out; p.ws = (char*)d_ws;
#if MEGA
    p.ph_lo = 0; p.ph_hi = NPHASE;
    void* args[] = {&p};
    hipError_t e = hipLaunchCooperativeKernel((const void*)k_run, dim3(grid), dim3(KT), args, LDS_TOTAL, stream);
    if (e != hipSuccess) fprintf(stderr, "cooperative launch failed: %s (grid %d)\n", hipGetErrorString(e), grid);
#else
    for (int ph = 0; ph < NPHASE; ++ph) {
        p.ph_lo = ph; p.ph_hi = ph + 1;
        hipLaunchKernelGGL(k_run, dim3(grid), dim3(KT), LDS_TOTAL, stream, p);
    }
#endif
}
```

```cpp
#include <hip/hip_runtime.h>
#include <hip/hip_bf16.h>
#include <stdint.h>
#include <stdio.h>

#ifndef MEGA
#define MEGA 1
#endif

#define DEVI __device__ __forceinline__
#define LAS __attribute__((address_space(3)))

typedef unsigned short bf16;
typedef short bf16x8 __attribute__((ext_vector_type(8)));
typedef float f32x4 __attribute__((ext_vector_type(4)));
typedef unsigned u32x4 __attribute__((ext_vector_type(4)));
typedef unsigned u32x2 __attribute__((ext_vector_type(2)));

constexpr int S = 16384, D = 1024, NIN = 4104, NEXP = 32, DFF = 1024;
constexpr int NPROJ = 4096;
constexpr int NPAD = 4352;
constexpr float DN_ALPHA = 1.4142135623730951f;
constexpr int NT = 256;
constexpr int LDS_BYTES = 76032;

constexpr size_t MiB = 1ull << 20;
constexpr size_t WS_CTL = 0;
constexpr size_t CTL_BYTES = 1 * MiB;
constexpr size_t OFF_BAR = 0;
constexpr size_t OFF_ADA = 64 * 1024;
constexpr size_t OFF_CNT = 128 * 1024;
constexpr size_t WS_ROT = 1 * MiB;
constexpr size_t WS_WIN = WS_ROT + (size_t)S * 64 * 4;
constexpr size_t WS_WOUT = WS_WIN + 2ull * NPAD * D * 2;
constexpr size_t WS_WUP = WS_WOUT + 2ull * D * D * 2;
constexpr size_t WS_WDN = WS_WUP + 2ull * NEXP * 2048 * D * 2;
constexpr size_t WS_HB = WS_WDN + 2ull * NEXP * D * DFF * 2;
constexpr size_t WS_PROJ = WS_HB + (size_t)S * D * 2;
constexpr size_t WS_PEX = WS_PROJ + (size_t)S * NPROJ * 2;
constexpr size_t WS_VFIRST = WS_PEX + (size_t)S * 64 * 4;
constexpr size_t WS_RECR = WS_VFIRST + (size_t)S * 256 * 4;
constexpr size_t WS_RECG = WS_RECR + (size_t)S * 4 * 384 * 2;
constexpr size_t WS_RECT = WS_RECG + (size_t)S * 4 * 392 * 2;
constexpr size_t WS_WDEC = WS_RECT + (size_t)S * 4 * 192 * 2;
constexpr size_t WS_GSC = WS_WDEC + (size_t)S * 256 * 4;
constexpr size_t WS_G = WS_GSC + (size_t)S * 16 * 4;
constexpr size_t WS_BON = WS_G + (size_t)S * 256 * 4;
constexpr size_t WS_YR = WS_BON + (size_t)S * 4 * 4;
constexpr size_t WS_OG = WS_YR + (size_t)S * 256 * 4;
constexpr size_t WS_ORT = WS_OG + (size_t)S * 512 * 4;
constexpr size_t WS_MIX = WS_ORT + (size_t)S * 256 * 4;
constexpr size_t WS_OPRE = WS_MIX + (size_t)S * D * 2;
constexpr size_t WS_X = WS_OPRE + (size_t)S * D * 4;
constexpr size_t WS_H2 = WS_X + (size_t)S * D * 4;
constexpr size_t WS_LIST = WS_H2 + (size_t)S * D * 2;
constexpr size_t WS_GATE = WS_LIST + (size_t)NEXP * S * 4;
constexpr size_t WS_ACT = WS_GATE + (size_t)S * 4 * 4;
constexpr size_t WS_YB = WS_ACT + ((size_t)S * 4 + 256) * DFF * 2;
constexpr size_t WS_ADAP = WS_YB + (size_t)S * 4 * D * 2;
constexpr size_t WS_RKV = WS_ADAP + 16ull * 12288 * 4;
constexpr size_t WS_RST = WS_RKV + 256ull * 4 * 4096 * 4;
constexpr size_t WS_GP = WS_RST + 256ull * 4 * 4096 * 2;
constexpr size_t WS_GB = WS_GP + 1024ull * 16384 * 2;
constexpr size_t WS_GD = WS_GB + 1024ull * 16384 * 4;
constexpr size_t WS_GQ = WS_GD + 4096;
constexpr size_t WS_GO = WS_GQ + 1024ull * 8192 * 2;
constexpr size_t WS_GS = WS_GO + 1024ull * 8192 * 4;
constexpr size_t WS_WP = WS_GS + 1024ull * 16384 * 2;
constexpr size_t WS_WC = WS_WP + 2048ull * 4096 * 2;
constexpr size_t WS_WD = WS_WC + 2048ull * 4096 * 4;
constexpr size_t WS_WQ = WS_WD + 2048ull * 64 * 4;
constexpr size_t WS_WY = WS_WQ + 2048ull * 2048 * 2;
constexpr size_t WS_WS = WS_WY + 2048ull * 2048 * 4;
constexpr size_t WS_GR = WS_WS + 2048ull * 4096 * 2;
constexpr size_t WS_GE0 = WS_GR + 1024ull * 8192 * 2;
constexpr size_t WS_GTE = WS_GE0 + 64ull * 16384 * 4;
constexpr size_t WS_GSG = WS_GTE + 64ull * 16384 * 2;
constexpr size_t WS_WR = WS_GSG + 64ull * 16384 * 2;
constexpr size_t WS_WE0 = WS_WR + 2048ull * 2048 * 2;
constexpr size_t WS_WTE = WS_WE0 + 64ull * 4096 * 4;
constexpr size_t WS_WSG = WS_WTE + 64ull * 4096 * 2;
constexpr size_t WS_LRT = WS_WSG + 64ull * 4096 * 2;
constexpr size_t WS_DUMP = WS_LRT + 2ull * 73728 * 2;
constexpr size_t WS_RWF = WS_DUMP + 4096;
constexpr size_t WS_END = WS_RWF + 2ull * 32 * 2 * 2 * 64 * 16;

struct P {
    const float* in[38];
    const int* pos;
    float* out;
    char* ws;
    int ph_lo, ph_hi;
};

DEVI float bf2f(bf16 v) { return __uint_as_float(((unsigned)v) << 16); }
DEVI unsigned f2bf(float f) { unsigned u = __float_as_uint(f); return (u + 0x7fffu + ((u >> 16) & 1u)) >> 16; }
typedef float f32x2_t __attribute__((ext_vector_type(2)));
typedef __bf16 bf16x2_t __attribute__((ext_vector_type(2)));
DEVI unsigned pk2(float lo, float hi) { const f32x2_t v = {lo, hi}; return __builtin_bit_cast(unsigned, __builtin_convertvector(v, bf16x2_t)); }
DEVI float sigmoidf_(float x) { return __builtin_amdgcn_rcpf(1.f + __builtin_amdgcn_exp2f(-1.4426950408889634f * x)); }
DEVI float siluf_(float x) { return x * sigmoidf_(x); }
DEVI float softplusf_(float x) { return fmaxf(x, 0.f) + log1pf(__expf(-fabsf(x))); }
DEVI float wave_sum(float v) {
#pragma unroll
    for (int o = 32; o >= 1; o >>= 1) v += __shfl_xor(v, o);
    return v;
}
template <int CTRL> DEVI float dpp_mov(float x) {
    return __int_as_float(__builtin_amdgcn_update_dpp(0, __float_as_int(x), CTRL, 0xf, 0xf, false));
}
DEVI float row16_sum(float x) {
    x += dpp_mov<0x128>(x);
    x += dpp_mov<0x124>(x);
    x += dpp_mov<0x122>(x);
    x += dpp_mov<0x121>(x);
    return x;
}

DEVI bf16x8 ldfrag(const bf16* base, int ld, int row0, int k0, int lane) {
    return *(const bf16x8*)(base + (row0 + (lane & 15)) * ld + k0 + (lane >> 4) * 8);
}
DEVI f32x4 ld_bf4(const bf16* p) {
    const u32x2 v = *(const u32x2*)p;
    return (f32x4){__uint_as_float(v.x << 16), __uint_as_float(v.x & 0xffff0000u), __uint_as_float(v.y << 16), __uint_as_float(v.y & 0xffff0000u)};
}
DEVI void st_bf4(bf16* p, const f32x4& v) { *(u32x2*)p = (u32x2){pk2(v.x, v.y), pk2(v.z, v.w)}; }
DEVI float quad_sum(float v) { v += __shfl_xor(v, 16); v += __shfl_xor(v, 32); return v; }
DEVI f32x4 mfma16(bf16x8 a, bf16x8 b, f32x4 c) { return __builtin_amdgcn_mfma_f32_16x16x32_bf16(a, b, c, 0, 0, 0); }

#define VTID ((int)(threadIdx.x & 255))
#define VBID ((int)(blockIdx.x * 2 + __builtin_amdgcn_readfirstlane((int)(threadIdx.x >> 8))))
#define VNB ((int)(gridDim.x * 2))
constexpr int VB_LDS = 76032;
constexpr int KT = 512;

#define XB_TMO      128
#define XB_XCNT(j)  (256  + 64 * (j))
#define XB_XSUB(j)  (1280 + 64 * (j))
#define XB_XGEN(j)  (2304 + 64 * (j))
#define XB_TOP      3328
#define XB_TOPGEN   3392
#define XCD_BAR_WORDS 3456
#define XB_SPIN_CAP (1u << 22)
DEVI unsigned xb_ld(unsigned* p) { return __hip_atomic_load(p, __ATOMIC_RELAXED, __HIP_MEMORY_SCOPE_AGENT); }
DEVI unsigned xb_add(unsigned* p, unsigned v) { return __hip_atomic_fetch_add(p, v, __ATOMIC_RELAXED, __HIP_MEMORY_SCOPE_AGENT); }
DEVI unsigned xb_xcc_id() { return (unsigned)__builtin_amdgcn_s_getreg((3 << 11) | 20) & 0xFu; }
#define XB_SPIN(cond, bar) do { unsigned _sp = 0; while (cond) { __builtin_amdgcn_s_sleep(1); \
    if ((++_sp & 255u) == 0u) { if (xb_ld(&(bar)[XB_TMO])) break; if (_sp > XB_SPIN_CAP) { atomicAdd(&(bar)[XB_TMO], 1u); break; } } } } while (0)
struct XcdBarrier { unsigned* bar; unsigned x; volatile LAS unsigned* st; };
DEVI XcdBarrier xcd_barrier_post(unsigned* bar, volatile LAS unsigned* st) {
    XcdBarrier b; b.bar = bar; b.x = xb_xcc_id(); b.st = st;
    if (threadIdx.x == 0) (void)xb_add(&bar[XB_XCNT(b.x)], 1u);
    return b;
}
DEVI void xcd_barrier_complete(unsigned* bar, unsigned x, unsigned& nloc, unsigned& nx) {
    const unsigned G = gridDim.x * gridDim.y * gridDim.z;
    unsigned sum, cnt, mine, sp = 0u;
    for (;;) {
        sum = 0u; cnt = 0u; mine = 0u;
#pragma unroll
        for (unsigned j = 0; j < 16; ++j) { const unsigned c = xb_ld(&bar[XB_XCNT(j)]); sum += c; cnt += (c > 0u) ? 1u : 0u; mine = (j == x) ? c : mine; }
        if (sum == G) break;
        __builtin_amdgcn_s_sleep(1);
        if ((++sp & 255u) == 0u) { if (xb_ld(&bar[XB_TMO])) break; if (sp > XB_SPIN_CAP) { atomicAdd(&bar[XB_TMO], 1u); break; } }
    }
    nloc = mine > 0u ? mine : 1u; nx = cnt > 0u ? cnt : 1u;
}
DEVI void xcd_barrier(const XcdBarrier& b) {
    asm volatile("s_waitcnt vmcnt(0)" ::: "memory");
    __syncthreads();
    if (threadIdx.x == 0) {
        unsigned* bar = b.bar;
        __builtin_amdgcn_s_waitcnt(0);
        unsigned nloc = b.st[0], nx = b.st[1];
        if (nloc == 0u) { xcd_barrier_complete(bar, b.x, nloc, nx); b.st[0] = nloc; b.st[1] = nx; }
        const unsigned old = xb_add(&bar[XB_XSUB(b.x)], 1u);
        const unsigned gen = old / nloc;
        if (old + 1u == (gen + 1u) * nloc) {
            __builtin_amdgcn_fence(__ATOMIC_RELEASE, "agent");
            asm volatile("s_waitcnt vmcnt(0)" ::: "memory");
            const unsigned og = xb_add(&bar[XB_TOP], 1u);
            const unsigned tg = og / nx;
            if (og + 1u == (tg + 1u) * nx) xb_add(&bar[XB_TOPGEN], 1u);
            else XB_SPIN(xb_ld(&bar[XB_TOPGEN]) == tg, bar);
            __builtin_amdgcn_fence(__ATOMIC_ACQUIRE, "agent");
            xb_add(&bar[XB_XGEN(b.x)], 1u);
            asm volatile("s_waitcnt vmcnt(0)" ::: "memory");
        } else {
            XB_SPIN(xb_ld(&bar[XB_XGEN(b.x)]) == gen, bar);
            __builtin_amdgcn_fence(__ATOMIC_ACQUIRE, "agent");
            asm volatile("s_waitcnt vmcnt(0)" ::: "memory");
        }
    }
    __syncthreads();
}

DEVI void transpose_item(const float* __restrict__ src, size_t ld, int k0, int ns0, bf16* __restrict__ dst, int kd, int nd0, float* lds) {
    const int tid = VTID;
    float tv[32];
#pragma unroll
    for (int i = 0; i < 32; ++i) tv[i] = __builtin_nontemporal_load(&src[(size_t)(k0 + i * 4 + (tid >> 6)) * ld + ns0 + (tid & 63)]);
    asm volatile("" ::: "memory");
#pragma unroll
    for (int i = 0; i < 32; ++i) lds[(i * 4 + (tid >> 6)) * 65 + (tid & 63)] = tv[i];
    __syncthreads();
#pragma unroll
    for (int i = 0; i < 4; ++i) {
        const int q = tid + 256 * i, n = q >> 4, kc = q & 15;
        const float* s = lds + (kc * 8) * 65 + n;
        u32x4 o;
        o.x = pk2(s[0 * 65], s[1 * 65]); o.y = pk2(s[2 * 65], s[3 * 65]);
        o.z = pk2(s[4 * 65], s[5 * 65]); o.w = pk2(s[6 * 65], s[7 * 65]);
        *(u32x4*)(dst + (size_t)(nd0 + n) * kd + k0 + kc * 8) = o;
    }
    __syncthreads();
}

DEVI void phase_prep(const P& p, char* smem) {
    float* lds = (float*)smem;
    const int tid = VTID;
    const int nb = VNB, bid = VBID;
    bf16* WIN = (bf16*)(p.ws + WS_WIN); bf16* WOUT = (bf16*)(p.ws + WS_WOUT);
    bf16* WUP = (bf16*)(p.ws + WS_WUP); bf16* WDN = (bf16*)(p.ws + WS_WDN);
    constexpr int I_UP = 2 * NEXP * 8 * 32;
    constexpr int I_DN = 2 * NEXP * 8 * 16;
    constexpr int I_IN = 2 * 8 * 64;
    constexpr int I_OUT = 2 * 8 * 16;
    constexpr int I_EX = 2 * 256;
    constexpr int I_ADA = 2 * 24 * 16;
    constexpr int I_ROT = S * 32 / 256;
    constexpr int I_LR = 2 * 288;
    constexpr int I_RW = 2 * 16;
    constexpr int NITEMS = I_UP + I_DN + I_IN + I_OUT + I_EX + I_ADA + I_ROT + I_LR + I_RW;
    constexpr int I_TR = I_UP + I_DN + I_IN + I_OUT;
    static_assert((I_TR % 512) % 2 == 0, "the two halves of every workgroup must run the same number of transpose items (they contain barriers)");
    for (int it = bid; it < NITEMS; it += nb) {
        int r = it;
        if (r < I_UP) {
            const int le = r / 256, q = r % 256, kt = q / 32, nt = q % 32;
            transpose_item(p.in[32] + (size_t)le * D * 2048, 2048, kt * 128, nt * 64, WUP + (size_t)le * 2048 * D, D, nt * 64, lds);
            continue;
        }
        r -= I_UP;
        if (r < I_DN) {
            const int le = r / 128, q = r % 128, kt = q / 16, nt = q % 16;
            transpose_item(p.in[34] + (size_t)le * DFF * D, D, kt * 128, nt * 64, WDN + (size_t)le * D * DFF, DFF, nt * 64, lds);
            continue;
        }
        r -= I_DN;
        if (r < I_IN) {
            const int l = r / 512, q = r % 512, kt = q / 64, nt = q % 64;
            const int nd0 = nt * 64, ns0 = nd0 < 3072 ? nd0 : nd0 + 8;
            transpose_item(p.in[5] + (size_t)l * D * NIN, NIN, kt * 128, ns0, WIN + (size_t)l * NPAD * D, D, nd0, lds);
            continue;
        }
        r -= I_IN;
        if (r < I_OUT) {
            const int l = r / 128, q = r % 128, kt = q / 16, nt = q % 16;
            transpose_item(p.in[27] + (size_t)l * D * D, D, kt * 128, nt * 64, WOUT + (size_t)l * D * D, D, nt * 64, lds);
            continue;
        }
        r -= I_OUT;
        if (r < I_EX) {
            const int l = r / 256, n = r % 256;
            bf16* dst = WIN + ((size_t)l * NPAD + NPROJ + n) * D;
            for (int k = tid; k < D; k += NT) {
                float v = 0.f;
                if (n < 8) v = p.in[5][(size_t)l * D * NIN + (size_t)k * NIN + 3072 + n];
                else if (n < 40 && l == 1) v = p.in[6][(size_t)k * 32 + (n - 8)];
                dst[k] = (bf16)f2bf(v);
            }
            continue;
        }
        r -= I_EX;
        if (r < I_ADA) {
            const int l = r / 384, q = r % 384, nc = q / 16, kc = q % 16;
            const int n = nc * 256 + tid;
            const float* W = p.in[3] + (size_t)l * D * 6144;
            float acc = (kc == 0) ? p.in[4][l * 6144 + n] : 0.f;
            for (int k = kc * 64; k < kc * 64 + 64; ++k) acc += siluf_(p.in[1][k]) * W[(size_t)k * 6144 + n];
            ((float*)(p.ws + WS_ADAP))[(size_t)kc * 12288 + l * 6144 + n] = acc;
            continue;
        }
        r -= I_ADA;
        if (r >= I_ROT + I_LR) {
            r -= I_ROT + I_LR;
            const int l = r >> 4, idx = (r & 15) * 256 + tid, kk = idx >> 7, n = (idx >> 6) & 1, ln = idx & 63;
            const float* rw = p.in[30] + (size_t)l * D * 32 + (size_t)(32 * kk + 8 * (ln >> 4)) * 32 + 16 * n + (ln & 15);
            unsigned hi[4], lo[4];
#pragma unroll
            for (int q = 0; q < 4; ++q) {
                const float a = rw[(2 * q) * 32], b = rw[(2 * q + 1) * 32];
                hi[q] = pk2(a, b);
                lo[q] = pk2(a - __uint_as_float(hi[q] << 16), b - __uint_as_float(hi[q] & 0xffff0000u));
            }
            u32x4* dst = (u32x4*)(p.ws + WS_RWF) + ((size_t)((l * 32 + kk) * 2 + n) * 2) * 64 + ln;
            dst[0] = (u32x4){hi[0], hi[1], hi[2], hi[3]}; dst[64] = (u32x4){lo[0], lo[1], lo[2], lo[3]};
            continue;
        }
        if (r >= I_ROT) {
            r -= I_ROT;
            const int l = r / 288, kk = r % 288, c = tid;
            bf16* LRT = (bf16*)(p.ws + WS_LRT) + (size_t)l * 73728;
            if (kk < 64) LRT[c * 64 + kk] = (bf16)f2bf(p.in[10][(l * 64 + kk) * 256 + c]);
            else if (kk < 128) LRT[16384 + c * 64 + (kk - 64)] = (bf16)f2bf(p.in[12][(l * 64 + kk - 64) * 256 + c]);
            else if (kk < 256) LRT[32768 + c * 128 + (kk - 128)] = (bf16)f2bf(p.in[13][(l * 128 + kk - 128) * 256 + c]);
            else LRT[65536 + c * 32 + (kk - 256)] = (bf16)f2bf(l == 1 ? p.in[20][(kk - 256) * 256 + c] : 0.f);
            continue;
        }
        {
            const int idx = r * 256 + tid;
            const int t = idx >> 5, i = idx & 31;
            const float invf = (float)pow(10000.0, -(double)i / 32.0);
            const float ang = (float)p.pos[t] * invf;
            float sn, cs; sincosf(ang, &sn, &cs);
            float* ROT = (float*)(p.ws + WS_ROT);
            ROT[(size_t)idx * 2] = cs; ROT[(size_t)idx * 2 + 1] = sn;
        }
    }
}

DEVI float ada_sum(const float* ADAP, int idx) {
    float s = 0.f;
#pragma unroll
    for (int kc = 0; kc < 16; ++kc) s += ADAP[(size_t)kc * 12288 + idx];
    return s;
}
DEVI void phase_h0(const P& p) {
    const float* ADAP = (const float*)(p.ws + WS_ADAP);
    float* ADA = (float*)(p.ws + OFF_ADA);
    bf16* HB = (bf16*)(p.ws + WS_HB);
    if (VBID < 48) ADA[VBID * 256 + VTID] = ada_sum(ADAP, VBID * 256 + VTID);
    const size_t n4 = (size_t)S * D / 4;
    const int c = (int)(((size_t)VBID * NT + VTID) % (D / 4)) * 4;
    f32x4 sh, sc;
    sh.x = ada_sum(ADAP, c); sh.y = ada_sum(ADAP, c + 1); sh.z = ada_sum(ADAP, c + 2); sh.w = ada_sum(ADAP, c + 3);
    sc.x = ada_sum(ADAP, 1024 + c); sc.y = ada_sum(ADAP, 1025 + c); sc.z = ada_sum(ADAP, 1026 + c); sc.w = ada_sum(ADAP, 1027 + c);
    for (size_t i = (size_t)VBID * NT + VTID; i < n4; i += (size_t)VNB * NT) {
        const f32x4 x = ((const f32x4*)p.in[0])[i];
        u32x2 o;
        o.x = pk2(x.x * (1.f + sc.x) + sh.x, x.y * (1.f + sc.y) + sh.y);
        o.y = pk2(x.z * (1.f + sc.z) + sh.z, x.w * (1.f + sc.w) + sh.w);
        ((u32x2*)HB)[i] = o;
    }
}

template <class AF, class BF>
DEVI void gemm_tile(char* smem, const bf16* __restrict__ Abase, AF arow, const bf16* __restrict__ Bbase, BF brow, int K, f32x4 (&acc)[4][8]) {
    const int tid = VTID, wid = tid >> 6, lane = tid & 63, wr = wid >> 1, wc = wid & 1, fr = lane & 15, fq = lane >> 4;
    const int r0 = tid >> 2;
    const int swz = ((tid & 3) ^ ((0x1320 >> (4 * ((tid >> 4) & 3))) & 3)) * 8;
    unsigned pa[2], pb[4];
#pragma unroll
    for (int i = 0; i < 2; ++i) pa[i] = arow(r0 + 64 * i) + swz;
#pragma unroll
    for (int i = 0; i < 4; ++i) pb[i] = brow(r0 + 64 * i) + swz;
#pragma unroll
    for (int m = 0; m < 4; ++m)
#pragma unroll
        for (int n = 0; n < 8; ++n) acc[m][n] = (f32x4){0.f, 0.f, 0.f, 0.f};
    const int nk = K / 32;
    const int ch = (fq ^ ((0x1320 >> (4 * ((fr >> 2) & 3))) & 3)) * 16;
#define GT_STAGE(kt) do { char* _sa = smem + ((kt) % 3) * 24576; char* _sb = _sa + 8192; \
        _Pragma("unroll") for (int _i = 0; _i < 2; ++_i) \
            __builtin_amdgcn_global_load_lds((const unsigned*)(Abase + pa[_i] + (kt) * 32), (unsigned*)(_sa + (tid + 256 * _i) * 16), 16, 0, 0); \
        _Pragma("unroll") for (int _i = 0; _i < 4; ++_i) \
            __builtin_amdgcn_global_load_lds((const unsigned*)(Bbase + pb[_i] + (kt) * 32), (unsigned*)(_sb + (tid + 256 * _i) * 16), 16, 0, 0); } while (0)
    asm volatile("s_waitcnt vmcnt(0)" ::: "memory");
    GT_STAGE(0); GT_STAGE(1);
    for (int kt = 0; kt < nk; ++kt) {
        if (kt + 1 < nk) asm volatile("s_waitcnt vmcnt(6)" ::: "memory");
        else asm volatile("s_waitcnt vmcnt(0)" ::: "memory");
        asm volatile("s_waitcnt lgkmcnt(0)" ::: "memory");
        __builtin_amdgcn_s_barrier();
        if (kt + 2 < nk) GT_STAGE(kt + 2);
        const char* SA = smem + (kt % 3) * 24576; const char* SB = SA + 8192;
        bf16x8 af[4], bfr[8];
#pragma unroll
        for (int m = 0; m < 4; ++m) af[m] = *(const bf16x8*)(SA + (wr * 64 + m * 16 + fr) * 64 + ch);
#pragma unroll
        for (int n = 0; n < 8; ++n) bfr[n] = *(const bf16x8*)(SB + (wc * 128 + n * 16 + fr) * 64 + ch);
#pragma unroll
        for (int m = 0; m < 4; ++m)
#pragma unroll
            for (int n = 0; n < 8; ++n)
                acc[m][n] = __builtin_amdgcn_mfma_f32_16x16x32_bf16(bfr[n], af[m], acc[m][n], 0, 0, 0);
    }
    asm volatile("s_waitcnt lgkmcnt(0)" ::: "memory");
    __builtin_amdgcn_s_barrier();
#undef GT_STAGE
}

DEVI float proj_at(const bf16* PROJ, int t, int col) { return bf2f(PROJ[(size_t)t * NPROJ + col]); }
DEVI float proj_shift(const bf16* PROJ, int t, int col, float mu) {
    const float cur = proj_at(PROJ, t, col);
    const float prv = t > 0 ? proj_at(PROJ, t - 1, col) : 0.f;
    return cur + (prv - cur) * mu;
}

DEVI f32x4 shift4(const bf16* PROJ, int t, int col, const f32x4& mu) {
    const f32x4 cur = ld_bf4(PROJ + (size_t)t * NPROJ + col);
    f32x4 prv = ld_bf4(PROJ + (size_t)(t > 0 ? t - 1 : 0) * NPROJ + col);
    const float keep = t > 0 ? 1.f : 0.f;
    prv = prv * keep;
    return cur + (prv - cur) * mu;
}
DEVI float fsig(float x) { return sigmoidf_(x); }
DEVI void phase_mixprep(const P& p, int l, char* smem) {
    const bf16* PROJ = (const bf16*)(p.ws + WS_PROJ); const float* PEX = (const float*)(p.ws + WS_PEX);
    float* VFIRST = (float*)(p.ws + WS_VFIRST);
    bf16* RECR = (bf16*)(p.ws + WS_RECR); bf16* RECG = (bf16*)(p.ws + WS_RECG); bf16* RECT = (bf16*)(p.ws + WS_RECT);
    float* WDEC = (float*)(p.ws + WS_WDEC); float* GSC = (float*)(p.ws + WS_GSC);
    float* GB = (float*)(p.ws + WS_G); float* BON = (float*)(p.ws + WS_BON);
    const float* ROT = (const float*)(p.ws + WS_ROT);
    const bf16* LRT = (const bf16*)(p.ws + WS_LRT) + (size_t)l * 73728;
    bf16* L = (bf16*)smem;
    float* CW = (float*)(smem + 9728);
    float* MU = CW + 6144;
    float* PW0 = MU + 1024; float* PA0 = PW0 + 256; float* PKK = PA0 + 256; float* PKA = PKK + 256; float* PRK = PKA + 256; float* PV0 = PRK + 256;
    {
        const int tid = VTID;
        for (int i = tid; i < 6144; i += NT) CW[i] = p.in[21][l * 6144 + i];
        for (int i = tid; i < 1024; i += NT) MU[i] = p.in[7][l * 1024 + i];
        PW0[tid] = p.in[9][l * 256 + tid]; PA0[tid] = p.in[11][l * 256 + tid]; PKK[tid] = p.in[14][l * 256 + tid];
        PKA[tid] = p.in[15][l * 256 + tid]; PRK[tid] = p.in[16][l * 256 + tid]; PV0[tid] = (l == 1) ? p.in[19][tid] : 0.f;
    }
    __syncthreads();
    for (int item = VBID; item < S / 16; item += VNB) {
        int tid = VTID; asm volatile("" : "+v"(tid));
        const int lane = tid & 63, w = tid >> 6, fr = lane & 15, fq = lane >> 4;
        const int t0 = item * 16;
        {
            u32x2 cur[5], prv[5]; f32x4 xc[5], xp[5];
#pragma unroll
            for (int q = 0; q < 5; ++q) {
                const int g = tid + 256 * q, gg = g < 1152 ? g : 1151, tt = gg / 72, i4 = (gg % 72) * 4, t = t0 + tt, tp = t > 0 ? t - 1 : 0;
                const int ia = i4 < 256 ? i4 : 252, ib = i4 < 256 ? 0 : i4 - 256;
                cur[q] = *(const u32x2*)(PROJ + (size_t)t * NPROJ + 768 + ia); prv[q] = *(const u32x2*)(PROJ + (size_t)tp * NPROJ + 768 + ia);
                xc[q] = *(const f32x4*)(PEX + (size_t)t * 64 + 8 + ib); xp[q] = *(const f32x4*)(PEX + (size_t)tp * 64 + 8 + ib);
            }
            asm volatile("" ::: "memory");
#pragma unroll
            for (int q = 0; q < 5; ++q) {
                const int g = tid + 256 * q, gg = g < 1152 ? g : 1151, tt = gg / 72, i4 = (gg % 72) * 4, t = t0 + tt;
                const float keep = t > 0 ? 1.f : 0.f;
                f32x4 v;
                if (i4 < 256) {
                    const f32x4 c4 = {__uint_as_float(cur[q].x << 16), __uint_as_float(cur[q].x & 0xffff0000u), __uint_as_float(cur[q].y << 16), __uint_as_float(cur[q].y & 0xffff0000u)};
                    const f32x4 p4 = (f32x4){__uint_as_float(prv[q].x << 16), __uint_as_float(prv[q].x & 0xffff0000u), __uint_as_float(prv[q].y << 16), __uint_as_float(prv[q].y & 0xffff0000u)} * keep;
                    v = c4 + (p4 - c4) * *(const f32x4*)(MU + 768 + i4);
                    if (i4 < 64) { v.x = tanhf(v.x); v.y = tanhf(v.y); v.z = tanhf(v.z); v.w = tanhf(v.w); }
                    else if (i4 >= 128) { v.x = fsig(v.x); v.y = fsig(v.y); v.z = fsig(v.z); v.w = fsig(v.w); }
                } else {
                    v = (f32x4){0.f, 0.f, 0.f, 0.f};
                    if (l == 1) v = xc[q] + (xp[q] * keep - xc[q]) * *(const f32x4*)(p.in[8] + (i4 - 256));
                }
                if (g < 1152) *(u32x2*)(L + tt * 296 + i4) = (u32x2){pk2(v.x, v.y), pk2(v.z, v.w)};
            }
        }
        __syncthreads();
        const int t = t0 + fr, h = w, tpv = t > 0 ? t - 1 : 0;
        const float keep = t > 0 ? 1.f : 0.f;
        {
            f32x4 aw[4], aa[4], ag[4], av[4];
#pragma unroll
            for (int i = 0; i < 4; ++i) { aw[i] = (f32x4){0.f, 0.f, 0.f, 0.f}; aa[i] = aw[i]; ag[i] = aw[i]; av[i] = aw[i]; }
            bf16x8 lf[9];
#pragma unroll
            for (int ks = 0; ks < 9; ++ks) lf[ks] = *(const bf16x8*)(L + fr * 296 + ks * 32 + fq * 8);
#pragma unroll
            for (int i = 0; i < 4; ++i) {
                const int c = 64 * h + 16 * i + fr;
#pragma unroll
                for (int ks = 0; ks < 2; ++ks) aw[i] = mfma16(*(const bf16x8*)(LRT + c * 64 + ks * 32 + fq * 8), lf[ks], aw[i]);
#pragma unroll
                for (int ks = 0; ks < 2; ++ks) aa[i] = mfma16(*(const bf16x8*)(LRT + 16384 + c * 64 + ks * 32 + fq * 8), lf[2 + ks], aa[i]);
#pragma unroll
                for (int ks = 0; ks < 4; ++ks) ag[i] = mfma16(*(const bf16x8*)(LRT + 32768 + c * 128 + ks * 32 + fq * 8), lf[4 + ks], ag[i]);
                if (l == 1) av[i] = mfma16(*(const bf16x8*)(LRT + 65536 + c * 32 + fq * 8), lf[8], av[i]);
            }
            bf16* rec = RECR + ((size_t)t * 4 + h) * 384;
            f32x4 kx[4], as_[4];
            float ss = 0.f, bsum = 0.f;
#define UNPK4(u) ((f32x4){__uint_as_float((u).x << 16), __uint_as_float((u).x & 0xffff0000u), __uint_as_float((u).y << 16), __uint_as_float((u).y & 0xffff0000u)})
            u32x2 rc[4], rp[4], kc[4], kp[4], vc[4], vp[4]; f32x4 vf4[4];
#pragma unroll
            for (int i = 0; i < 4; ++i) {
                const int j = 16 * i + 4 * fq, c = 64 * h + j;
                if ((i & 1) == 0) {
#pragma unroll
                    for (int i2 = i; i2 < i + 2; ++i2) {
                        const int c2 = 64 * h + 16 * i2 + 4 * fq;
                        rc[i2] = *(const u32x2*)(PROJ + (size_t)t * NPROJ + c2); rp[i2] = *(const u32x2*)(PROJ + (size_t)tpv * NPROJ + c2);
                        kc[i2] = *(const u32x2*)(PROJ + (size_t)t * NPROJ + 256 + c2); kp[i2] = *(const u32x2*)(PROJ + (size_t)tpv * NPROJ + 256 + c2);
                        vc[i2] = *(const u32x2*)(PROJ + (size_t)t * NPROJ + 512 + c2); vp[i2] = *(const u32x2*)(PROJ + (size_t)tpv * NPROJ + 512 + c2);
                        if (l == 1) vf4[i2] = *(const f32x4*)(VFIRST + (size_t)t * 256 + c2);
                    }
                    asm volatile("" ::: "memory");
                }
                const f32x4 r0 = UNPK4(rc[i]), k0 = UNPK4(kc[i]), v0_ = UNPK4(vc[i]);
                const f32x4 r = r0 + (UNPK4(rp[i]) * keep - r0) * *(const f32x4*)(MU + c);
                const f32x4 k = k0 + (UNPK4(kp[i]) * keep - k0) * *(const f32x4*)(MU + 256 + c);
                f32x4 v = v0_ + (UNPK4(vp[i]) * keep - v0_) * *(const f32x4*)(MU + 512 + c);
                const f32x4 w0 = *(const f32x4*)(PW0 + c), a0 = *(const f32x4*)(PA0 + c);
                const f32x4 kkc = *(const f32x4*)(PKK + c), kac = *(const f32x4*)(PKA + c), rkc = *(const f32x4*)(PRK + c);
                f32x4 dec, a;
#pragma unroll
                for (int q = 0; q < 4; ++q) {
                    const float wl = -softplusf_(-(w0[q] + aw[i][q])) - 0.5f;
                    dec[q] = __expf(-__expf(wl));
                    a[q] = fsig(a0[q] + aa[i][q]);
                }
                if (l == 0) *(f32x4*)(VFIRST + (size_t)t * 256 + c) = v;
                else {
                    const f32x4 v0 = *(const f32x4*)(PV0 + c);
#pragma unroll
                    for (int q = 0; q < 4; ++q) v[q] = v[q] + (vf4[i][q] - v[q]) * fsig(v0[q] + av[i][q]);
                }
                kx[i] = k * kkc; as_[i] = a;
                const f32x4 k2 = k * ((a - 1.f) * kac + 1.f);
                ss += kx[i].x * kx[i].x + kx[i].y * kx[i].y + kx[i].z * kx[i].z + kx[i].w * kx[i].w;
                const f32x4 rb = r * k2 * rkc;
                bsum += (rb.x + rb.y) + (rb.z + rb.w);
                *(f32x4*)(WDEC + (size_t)t * 256 + c) = dec; st_bf4(rec + 192 + j, k2); st_bf4(rec + 256 + j, r); st_bf4(rec + 320 + j, v);
                *(f32x4*)(GB + (size_t)t * 256 + c) = ag[i];
            }
            const float rn = rsqrtf(quad_sum(ss) + 1e-12f);
            bsum = quad_sum(bsum);
            if (fq == 0) BON[(size_t)t * 4 + h] = bsum;
#pragma unroll
            for (int i = 0; i < 4; ++i) {
                const int j = 16 * i + 4 * fq;
                const f32x4 kk = kx[i] * rn;
                st_bf4(rec + j, -kk); st_bf4(rec + 128 + j, kk * as_[i]);
            }
        }
        {
            bf16* rec = RECG + ((size_t)t * 4 + h) * 392;
            f32x4 yq[8], yk[8];
            float sq = 0.f, sk = 0.f;
            size_t rowo[4];
            float tapm[4];
#pragma unroll
            for (int tap = 0; tap < 4; ++tap) { const int tp = t - 3 + tap; rowo[tap] = (size_t)(tp >= 0 ? tp : 0) * NPROJ; tapm[tap] = tp >= 0 ? 1.f : 0.f; }
#pragma unroll
            for (int which = 0; which < 3; ++which) {
                u32x2 raw[8][4];
#pragma unroll
                for (int i = 0; i < 8; ++i) {
                    if ((i & 3) == 0) {
#pragma unroll
                        for (int i2 = i; i2 < i + 4; ++i2)
#pragma unroll
                            for (int tap = 0; tap < 4; ++tap) raw[i2][tap] = *(const u32x2*)(PROJ + rowo[tap] + 1024 + which * 512 + h * 128 + 16 * i2 + 4 * fq);
                        asm volatile("" ::: "memory");
                    }
                    const int j = 16 * i + 4 * fq, ch = which * 512 + h * 128 + j;
                    f32x4 cv = {0.f, 0.f, 0.f, 0.f};
#pragma unroll
                    for (int tap = 0; tap < 4; ++tap) cv = cv + UNPK4(raw[i][tap]) * (*(const f32x4*)(CW + tap * 1536 + ch) * tapm[tap]);
                    f32x4 y; y.x = siluf_(cv.x); y.y = siluf_(cv.y); y.z = siluf_(cv.z); y.w = siluf_(cv.w);
                    if (which == 0) { yq[i] = y; sq += y.x * y.x + y.y * y.y + y.z * y.z + y.w * y.w; }
                    else if (which == 1) { yk[i] = y; sk += y.x * y.x + y.y * y.y + y.z * y.z + y.w * y.w; }
                    else st_bf4(rec + 256 + j, y);
                }
            }
            const float rq = rsqrtf(quad_sum(sq) + 1e-12f) * 0.08838834764831845f, rk = rsqrtf(quad_sum(sk) + 1e-12f);
#pragma unroll
            for (int i = 0; i < 8; ++i) { const int j = 16 * i + 4 * fq; st_bf4(rec + j, yq[i] * rq); st_bf4(rec + 128 + j, yk[i] * rk); }
            if (fq == 0) {
                const float av = PEX[(size_t)t * 64 + h], bv = PEX[(size_t)t * 64 + 4 + h];
                const float g = -__expf(p.in[22][l * 4 + h]) * softplusf_(av + p.in[23][l * 4 + h]);
                *(f32x4*)(GSC + ((size_t)t * 4 + h) * 4) = (f32x4){__expf(g), fsig(bv), g, 0.f};
            }
        }
        {
            bf16* rec = RECT + ((size_t)t * 4 + h) * 192;
            u32x2 q1r[2], q2r[2], k1r[2], k2r[2], vr[4]; f32x4 c0r[2], c1r[2];
#pragma unroll
            for (int u = 0; u < 2; ++u) {
                const int i = 16 * u + 4 * fq;
                c0r[u] = *(const f32x4*)(ROT + ((size_t)t * 32 + i) * 2); c1r[u] = *(const f32x4*)(ROT + ((size_t)t * 32 + i) * 2 + 4);
                q1r[u] = *(const u32x2*)(PROJ + (size_t)t * NPROJ + 3072 + h * 64 + i); q2r[u] = *(const u32x2*)(PROJ + (size_t)t * NPROJ + 3072 + h * 64 + 32 + i);
                k1r[u] = *(const u32x2*)(PROJ + (size_t)t * NPROJ + 3328 + h * 64 + i); k2r[u] = *(const u32x2*)(PROJ + (size_t)t * NPROJ + 3328 + h * 64 + 32 + i);
            }
#pragma unroll
            for (int i = 0; i < 4; ++i) vr[i] = *(const u32x2*)(PROJ + (size_t)t * NPROJ + 3584 + h * 64 + 16 * i + 4 * fq);
            asm volatile("" ::: "memory");
#pragma unroll
            for (int u = 0; u < 2; ++u) {
                const int i = 16 * u + 4 * fq;
                const f32x4 cs = {c0r[u].x, c0r[u].z, c1r[u].x, c1r[u].z}, sn = {c0r[u].y, c0r[u].w, c1r[u].y, c1r[u].w};
                const f32x4 q1 = UNPK4(q1r[u]), q2 = UNPK4(q2r[u]), k1 = UNPK4(k1r[u]), k2 = UNPK4(k2r[u]);
                st_bf4(rec + i, q1 * cs - q2 * sn); st_bf4(rec + 32 + i, q1 * sn + q2 * cs);
                st_bf4(rec + 64 + i, (k1 * cs - k2 * sn) * 0.125f); st_bf4(rec + 96 + i, (k1 * sn + k2 * cs) * 0.125f);
            }
#pragma unroll
            for (int i = 0; i < 4; ++i) *(u32x2*)(rec + 128 + 16 * i + 4 * fq) = vr[i];
        }
#undef UNPK4
        __syncthreads();
    }
}

DEVI void retA_item(const P& p, int item, char* smem) {
    const bf16* REC = (const bf16*)(p.ws + WS_RECT); float* KV = (float*)(p.ws + WS_RKV);
    bf16* KT = (bf16*)smem; bf16* VT = KT + 64 * 72;
    const int n = item >> 2, h = item & 3;
    int tid = VTID; asm volatile("" : "+v"(tid));
    const int lane = tid & 63, w = tid >> 6, fr = lane & 15, fq = lane >> 4;
    const float lg = log2f(1.f - exp2f(-5.f - (float)h));
    {
        u32x4 v[4];
#pragma unroll
        for (int i = 0; i < 4; ++i) { const int idx = tid + 256 * i, c = idx >> 4, j = idx & 15; v[i] = *(const u32x4*)(REC + ((size_t)(n * 64 + c) * 4 + h) * 192 + 64 + j * 8); }
#pragma unroll
        for (int i = 0; i < 4; ++i) {
            const int idx = tid + 256 * i, c = idx >> 4, j = idx & 15;
            const float sc = (j < 8) ? exp2f((float)(63 - c) * lg) : 1.f;
            bf16* dst = ((j < 8) ? KT : VT) + ((j & 7) * 8) * 72 + c;
#pragma unroll
            for (int q = 0; q < 4; ++q) {
                const unsigned u = v[i][q];
                dst[(2 * q) * 72] = (j < 8) ? (bf16)f2bf(__uint_as_float(u << 16) * sc) : (bf16)(u & 0xffffu);
                dst[(2 * q + 1) * 72] = (j < 8) ? (bf16)f2bf(__uint_as_float(u & 0xffff0000u) * sc) : (bf16)(u >> 16);
            }
        }
    }
    __syncthreads();
    {
        const int dt = w;
        const bf16x8 a0 = ldfrag(KT, 72, 16 * dt, 0, lane), a1 = ldfrag(KT, 72, 16 * dt, 32, lane);
        float* out = KV + (size_t)item * 4096;
        const int s_ = dt >> 1, lane2 = 16 * (2 * (dt & 1) + (fq >> 1)) + fr;
#pragma unroll
        for (int et = 0; et < 4; ++et) {
            f32x4 acc = {0.f, 0.f, 0.f, 0.f};
            acc = mfma16(a0, ldfrag(VT, 72, 16 * et, 0, lane), acc);
            acc = mfma16(a1, ldfrag(VT, 72, 16 * et, 32, lane), acc);
            *(f32x4*)(out + ((et * 2 + s_) * 64 + lane2) * 8 + 4 * (fq & 1)) = acc;
        }
    }
    __syncthreads();
}

DEVI void retS_item(const P& p, int item) {
    const float* KV = (const float*)(p.ws + WS_RKV); bf16* RST = (bf16*)(p.ws + WS_RST);
    const int idx = item * NT + VTID;
    const int h = idx >> 12, i = idx & 4095;
    const float cd = exp2f(64.f * log2f(1.f - exp2f(-5.f - (float)h)));
    float r = 0.f;
#pragma unroll 1
    for (int n0 = 0; n0 < 256; n0 += 32) {
        float kv[32];
#pragma unroll
        for (int q = 0; q < 32; ++q) kv[q] = KV[((size_t)(n0 + q) * 4 + h) * 4096 + i];
#pragma unroll
        for (int q = 0; q < 32; ++q) { RST[((size_t)(n0 + q) * 4 + h) * 4096 + i] = (bf16)f2bf(r); r = r * cd + kv[q]; }
    }
}

DEVI void retC_item(const P& p, int item, int l, char* smem) {
    const bf16* REC = (const bf16*)(p.ws + WS_RECT); const bf16* RST = (const bf16*)(p.ws + WS_RST);
    const bf16* PROJ = (const bf16*)(p.ws + WS_PROJ); bf16* MIX = (bf16*)(p.ws + WS_MIX);
    const float* rgn = p.in[25] + l * 256; const float* rbn = p.in[26] + l * 256;
    bf16* Qs = (bf16*)smem; bf16* Ks = Qs + 64 * 72; bf16* VT = Ks + 64 * 72; bf16* Ps = VT + 64 * 72;
    const int n = item >> 2, h = item & 3;
    int tid = VTID; asm volatile("" : "+v"(tid));
    const int lane = tid & 63, w = tid >> 6, fr = lane & 15, fq = lane >> 4;
    const float lg = log2f(1.f - exp2f(-5.f - (float)h));
    {
        u32x4 v[6];
#pragma unroll
        for (int i = 0; i < 6; ++i) { const int idx = tid + 256 * i, c = idx / 24, j = idx - c * 24; v[i] = *(const u32x4*)(REC + ((size_t)(n * 64 + c) * 4 + h) * 192 + j * 8); }
#pragma unroll
        for (int i = 0; i < 6; ++i) {
            const int idx = tid + 256 * i, c = idx / 24, j = idx - c * 24;
            if (j < 16) *(u32x4*)(((j < 8) ? Qs : Ks) + c * 72 + (j & 7) * 8) = v[i];
            else {
                bf16* dst = VT + ((j & 7) * 8) * 72 + c;
#pragma unroll
                for (int q = 0; q < 4; ++q) { const unsigned u = v[i][q]; dst[(2 * q) * 72] = (bf16)(u & 0xffffu); dst[(2 * q + 1) * 72] = (bf16)(u >> 16); }
            }
        }
    }
    __syncthreads();
    const int ct = w, c = 16 * ct + fr;
    const bf16x8 q0 = ldfrag(Qs, 72, 16 * ct, 0, lane), q1 = ldfrag(Qs, 72, 16 * ct, 32, lane);
#pragma unroll
    for (int ct2 = 0; ct2 < 4; ++ct2) {
        f32x4 acc = {0.f, 0.f, 0.f, 0.f};
        acc = mfma16(ldfrag(Ks, 72, 16 * ct2, 0, lane), q0, acc);
        acc = mfma16(ldfrag(Ks, 72, 16 * ct2, 32, lane), q1, acc);
        float pv[4];
#pragma unroll
        for (int j = 0; j < 4; ++j) {
            const int c2 = 16 * ct2 + 4 * fq + j;
            pv[j] = (c >= c2) ? acc[j] * exp2f((float)(c - c2) * lg) : 0.f;
        }
        *(u32x2*)(Ps + c * 72 + 16 * ct2 + 4 * fq) = (u32x2){pk2(pv[0], pv[1]), pk2(pv[2], pv[3])};
    }
    __syncthreads();
    {
        const bf16x8 p0 = ldfrag(Ps, 72, 16 * ct, 0, lane), p1 = ldfrag(Ps, 72, 16 * ct, 32, lane);
        const float xi = exp2f((float)(c + 1) * lg);
        const bf16* RF = RST + (size_t)item * 4096;
        f32x4 o[4];
        float sm = 0.f;
        bf16x8 rfr[4][2];
#pragma unroll
        for (int et = 0; et < 4; ++et) { rfr[et][0] = *(const bf16x8*)(RF + ((et * 2 + 0) * 64 + lane) * 8); rfr[et][1] = *(const bf16x8*)(RF + ((et * 2 + 1) * 64 + lane) * 8); }
        asm volatile("" ::: "memory");
#pragma unroll
        for (int et = 0; et < 4; ++et) {
            f32x4 ai = {0.f, 0.f, 0.f, 0.f}, ax = {0.f, 0.f, 0.f, 0.f};
            ai = mfma16(ldfrag(VT, 72, 16 * et, 0, lane), p0, ai);
            ai = mfma16(ldfrag(VT, 72, 16 * et, 32, lane), p1, ai);
            ax = mfma16(rfr[et][0], q0, ax);
            ax = mfma16(rfr[et][1], q1, ax);
            o[et] = ai + ax * xi;
            sm += (o[et].x + o[et].y) + (o[et].z + o[et].w);
        }
        const float mean = quad_sum(sm) * (1.f / 64.f);
        float sv = 0.f;
#pragma unroll
        for (int et = 0; et < 4; ++et) { o[et] = o[et] - mean; sv += o[et].x * o[et].x + o[et].y * o[et].y + o[et].z * o[et].z + o[et].w * o[et].w; }
        const float rs = rsqrtf(quad_sum(sv) * (1.f / 64.f) + 1e-5f);
        const int t = n * 64 + c;
#pragma unroll
        for (int et = 0; et < 4; ++et) {
            const int e = h * 64 + 16 * et + 4 * fq;
            const f32x4 g = *(const f32x4*)(rgn + e), b = *(const f32x4*)(rbn + e);
            const f32x4 gt = ld_bf4(PROJ + (size_t)t * NPROJ + 3840 + e);
            const f32x4 y = o[et] * rs * g + b;
            *(u32x2*)(MIX + (size_t)t * D + 768 + e) = (u32x2){pk2(y.x * siluf_(gt.x), y.y * siluf_(gt.y)), pk2(y.z * siluf_(gt.z), y.w * siluf_(gt.w))};
        }
    }
    __syncthreads();
}

template <int I, int N> struct SolveRow {
    static DEVI void run(float (&x)[N], const float* M) {
        float s0 = 0.f, s1 = 0.f, s2 = 0.f, s3 = 0.f;
#pragma unroll
        for (int j4 = 0; j4 < (I + 3) / 4; ++j4) {
            const f32x4 m = *(const f32x4*)(M + I * N + 4 * j4);
            s0 += m.x * x[4 * j4]; s1 += m.y * x[4 * j4 + 1]; s2 += m.z * x[4 * j4 + 2]; s3 += m.w * x[4 * j4 + 3];
        }
        x[I] -= (s0 + s1) + (s2 + s3);
        asm volatile("" : "+v"(x[I]) :: "memory");
        SolveRow<I + 1, N>::run(x, M);
    }
};
template <int N> struct SolveRow<N, N> { static DEVI void run(float (&)[N], const float*) {} };

DEVI void gdnA_item(const P& p, int item, char* smem) {
    const bf16* REC = (const bf16*)(p.ws + WS_RECG); const float* GSC = (const float*)(p.ws + WS_GSC) + ((size_t)(item >> 2) * 64 * 4 + (item & 3)) * 4;
    bf16* GP = (bf16*)(p.ws + WS_GP) + (size_t)item * 16384; float* GB = (float*)(p.ws + WS_GB) + (size_t)item * 16384;
    float* GD = (float*)(p.ws + WS_GD);
    bf16* GQ = (bf16*)(p.ws + WS_GQ) + (size_t)item * 8192; float* GO = (float*)(p.ws + WS_GO) + (size_t)item * 8192;
    bf16* Kb = (bf16*)smem; bf16* Qb = Kb + 64 * 136;
    bf16* WT = (bf16*)smem; bf16* UT = WT + 128 * 72;
    bf16* Vb = (bf16*)(smem + 36864);
    float* M = (float*)(smem + 36864);
    bf16* KdT = (bf16*)(smem + 36864);
    bf16* At = (bf16*)(smem + 55296);
    float* gcs = (float*)(smem + 64512); float* bts = gcs + 64; float* sws = gcs + 128; float* sks = gcs + 192;
    const int n = item >> 2, h = item & 3;
    int tid = VTID; asm volatile("" : "+v"(tid));
    const int lane = tid & 63, w = tid >> 6, fr = lane & 15, fq = lane >> 4;
    const bf16* rec0 = REC + ((size_t)(n * 64) * 4 + h) * 392;
    if (w == 0) {
        float x = GSC[lane * 16 + 2];
#pragma unroll
        for (int off = 1; off < 64; off <<= 1) { const float y = __shfl_up(x, off); if (lane >= off) x += y; }
        const float bt = GSC[lane * 16 + 1];
        gcs[lane] = x; bts[lane] = bt; sws[lane] = bt * __expf(x); sks[lane] = __expf(__shfl(x, 63) - x);
    }
    {
        u32x4 v[12];
#pragma unroll
        for (int i = 0; i < 12; ++i) { const int idx = tid + 256 * i, c = idx / 48, j = idx - c * 48; v[i] = *(const u32x4*)(rec0 + (size_t)c * 1568 + j * 8); }
#pragma unroll
        for (int i = 0; i < 12; ++i) {
            const int idx = tid + 256 * i, c = idx / 48, j = idx - c * 48, which = j >> 4;
            const int boff = (which == 0 ? 17408 : 0) + (which == 2 ? 36864 : 0);
            *(u32x4*)(smem + boff + (c * 136 + (j & 15) * 8) * 2) = v[i];
        }
    }
    __syncthreads();
    float x[64];
    unsigned kdp[16];
    {
        const int col = tid & 127;
        int sel_b = (tid < 128) ? 36864 : 0, sel_s = (tid < 128) ? 64 : 128;
        asm volatile("" : "+v"(sel_b), "+v"(sel_s));
        const bf16* srcb = (const bf16*)(smem + sel_b) + col;
        const float* scs = gcs + sel_s;
#pragma unroll
        for (int c = 0; c < 64; ++c) {
            x[c] = scs[c] * bf2f(srcb[c * 136]);
            if ((c & 7) == 7) asm volatile("" : "+v"(x[c]) :: "memory");
        }
        const int half = tid >> 7;
#pragma unroll
        for (int i = 0; i < 16; ++i) {
            const int c = 32 * half + 2 * i;
            kdp[i] = pk2(bf2f(Kb[c * 136 + col]) * sks[c], bf2f(Kb[(c + 1) * 136 + col]) * sks[c + 1]);
            if ((i & 3) == 3) asm volatile("" : "+v"(kdp[i]) :: "memory");
        }
        if (tid == 0) GD[item] = __expf(gcs[63]);
    }
    __syncthreads();
    const int ct = w;
    f32x4 accQ[8];
    {
        const int c = 16 * ct + fr;
        const float gcc = gcs[c];
        {
            bf16x8 ka[4];
#pragma unroll
            for (int s = 0; s < 4; ++s) ka[s] = ldfrag(Kb, 136, 16 * ct, 32 * s, lane);
#pragma unroll
            for (int ct2 = 0; ct2 < 4; ++ct2) {
                f32x4 acc = {0.f, 0.f, 0.f, 0.f};
#pragma unroll
                for (int s = 0; s < 4; ++s) acc = mfma16(ka[s], ldfrag(Kb, 136, 16 * ct2, 32 * s, lane), acc);
                const int c2 = 16 * ct2 + fr; const float g2 = gcs[c2];
#pragma unroll
                for (int j = 0; j < 4; ++j) {
                    const int cc = 16 * ct + 4 * fq + j;
                    M[cc * 64 + c2] = (cc > c2) ? bts[cc] * acc[j] * __expf(gcs[cc] - g2) : 0.f;
                }
            }
        }
        {
            bf16x8 qa[4];
#pragma unroll
            for (int s = 0; s < 4; ++s) qa[s] = ldfrag(Qb, 136, 16 * ct, 32 * s, lane);
#pragma unroll
            for (int ct2 = 0; ct2 < 4; ++ct2) {
                f32x4 acc = {0.f, 0.f, 0.f, 0.f};
#pragma unroll
                for (int s = 0; s < 4; ++s) acc = mfma16(ldfrag(Kb, 136, 16 * ct2, 32 * s, lane), qa[s], acc);
                float pv[4];
#pragma unroll
                for (int j = 0; j < 4; ++j) { const int c2 = 16 * ct2 + 4 * fq + j; pv[j] = (c >= c2) ? acc[j] * __expf(gcc - gcs[c2]) : 0.f; }
                *(u32x2*)(At + c * 72 + 16 * ct2 + 4 * fq) = (u32x2){pk2(pv[0], pv[1]), pk2(pv[2], pv[3])};
            }
        }
    }
    __syncthreads();
    {
        SolveRow<1, 64>::run(x, M);
        unsigned xp[32];
#pragma unroll
        for (int q = 0; q < 32; ++q) xp[q] = pk2(x[2 * q], x[2 * q + 1]);
        {
            const int c = 16 * ct + fr;
            const float eg = __expf(gcs[c]);
#pragma unroll
            for (int dt = 0; dt < 8; ++dt) accQ[dt] = ld_bf4(Qb + c * 136 + 16 * dt + 4 * fq) * (-eg);
        }
        __syncthreads();
        int sel_d = (tid < 128) ? 128 * 72 : 0;
        asm volatile("" : "+v"(sel_d));
        bf16* dst = WT + sel_d + (tid & 127) * 72;
#pragma unroll
        for (int q = 0; q < 8; ++q) *(u32x4*)(dst + 8 * q) = (u32x4){xp[4 * q], xp[4 * q + 1], xp[4 * q + 2], xp[4 * q + 3]};
    }
    __syncthreads();
    {
        const int d = tid & 127, half = tid >> 7;
#pragma unroll
        for (int q = 0; q < 4; ++q) *(u32x4*)(KdT + d * 72 + 32 * half + 8 * q) = (u32x4){kdp[4 * q], kdp[4 * q + 1], kdp[4 * q + 2], kdp[4 * q + 3]};
    }
    __syncthreads();
    {
#pragma unroll 1
        for (int mi = 0; mi < 2; ++mi) {
            const int mt = 2 * w + mi;
            const bf16x8 kd0 = ldfrag(KdT, 72, 16 * mt, 0, lane), kd1 = ldfrag(KdT, 72, 16 * mt, 32, lane);
#pragma unroll
            for (int sp = 0; sp < 4; ++sp) {
                f32x4 a0 = {0.f, 0.f, 0.f, 0.f}, a1 = {0.f, 0.f, 0.f, 0.f};
                a0 = mfma16(ldfrag(WT, 72, 32 * sp, 0, lane), kd0, a0); a0 = mfma16(ldfrag(WT, 72, 32 * sp, 32, lane), kd1, a0);
                a1 = mfma16(ldfrag(WT, 72, 32 * sp + 16, 0, lane), kd0, a1); a1 = mfma16(ldfrag(WT, 72, 32 * sp + 16, 32, lane), kd1, a1);
                *(u32x4*)(GP + ((mt * 4 + sp) * 64 + lane) * 8) = (u32x4){pk2(-a0.x, -a0.y), pk2(-a0.z, -a0.w), pk2(-a1.x, -a1.y), pk2(-a1.z, -a1.w)};
            }
#pragma unroll
            for (int nt = 0; nt < 8; ++nt) {
                f32x4 a = {0.f, 0.f, 0.f, 0.f};
                a = mfma16(kd0, ldfrag(UT, 72, 16 * nt, 0, lane), a); a = mfma16(kd1, ldfrag(UT, 72, 16 * nt, 32, lane), a);
                *(f32x4*)(GB + ((nt * 8 + mt) * 64 + lane) * 4) = a;
            }
        }
        const bf16x8 at0 = ldfrag(At, 72, 16 * ct, 0, lane), at1 = ldfrag(At, 72, 16 * ct, 32, lane);
#pragma unroll
        for (int sp = 0; sp < 4; ++sp) {
            f32x4 a0 = accQ[2 * sp], a1 = accQ[2 * sp + 1];
            a0 = mfma16(ldfrag(WT, 72, 32 * sp, 0, lane), at0, a0); a0 = mfma16(ldfrag(WT, 72, 32 * sp, 32, lane), at1, a0);
            a1 = mfma16(ldfrag(WT, 72, 32 * sp + 16, 0, lane), at0, a1); a1 = mfma16(ldfrag(WT, 72, 32 * sp + 16, 32, lane), at1, a1);
            *(u32x4*)(GQ + ((ct * 4 + sp) * 64 + lane) * 8) = (u32x4){pk2(-a0.x, -a0.y), pk2(-a0.z, -a0.w), pk2(-a1.x, -a1.y), pk2(-a1.z, -a1.w)};
        }
#pragma unroll
        for (int et = 0; et < 8; ++et) {
            f32x4 a = {0.f, 0.f, 0.f, 0.f};
            a = mfma16(ldfrag(UT, 72, 16 * et, 0, lane), at0, a); a = mfma16(ldfrag(UT, 72, 16 * et, 32, lane), at1, a);
            *(f32x4*)(GO + ((ct * 8 + et) * 64 + lane) * 4) = a;
        }
    }
    __syncthreads();
}

DEVI bf16x8 pack_frag(const f32x4& a, const f32x4& b) {
    const u32x4 v = {pk2(a.x, a.y), pk2(a.z, a.w), pk2(b.x, b.y), pk2(b.z, b.w)};
    return __builtin_bit_cast(bf16x8, v);
}
DEVI void gdnL1_item(const P& p, int item, char* smem) {
    const bf16* GP = (const bf16*)(p.ws + WS_GP); const float* GB = (const float*)(p.ws + WS_GB); const float* GD = (const float*)(p.ws + WS_GD);
    const int half = item & 1, kind = (item >> 1) & 1, g = (item >> 2) & 15, h = item >> 6;
    const int tid = VTID, lane = tid & 63, ew = half * 4 + (tid >> 6), fr = lane & 15, fq = lane >> 4;
    const int n0 = g * 16;
#define L1_DMA(n) do { const bf16* _s = GP + ((size_t)(n) * 4 + h) * 16384 + tid * 8; char* _d = smem + ((n) & 1) * 32768 + tid * 16; \
        _Pragma("unroll") for (int _i = 0; _i < 8; ++_i) __builtin_amdgcn_global_load_lds((const unsigned*)(_s + _i * 2048), (unsigned*)(_d + _i * 4096), 16, 0, 0); } while (0)
    f32x4 acc[8];
    L1_DMA(n0);
    if (kind == 0) {
        bf16* GS = (bf16*)(p.ws + WS_GS);
#pragma unroll
        for (int m = 0; m < 8; ++m) acc[m] = (f32x4){0.f, 0.f, 0.f, 0.f};
        f32x4 bcur[8], bnxt[8]; float dcur, dnxt = 0.f;
        {
            const float* Bn = GB + ((size_t)n0 * 4 + h) * 16384 + (ew * 8 * 64 + lane) * 4;
#pragma unroll
            for (int m = 0; m < 8; ++m) bcur[m] = *(const f32x4*)(Bn + m * 256);
            dcur = GD[(size_t)n0 * 4 + h];
        }
#pragma unroll 1
        for (int n = n0; n < n0 + 16; ++n) {
            const size_t it = (size_t)n * 4 + h;
            asm volatile("s_waitcnt vmcnt(0)" ::: "memory");
            __syncthreads();
            if (n + 1 < n0 + 16) {
                L1_DMA(n + 1);
                const float* Bn = GB + (it + 4) * 16384 + (ew * 8 * 64 + lane) * 4;
#pragma unroll
                for (int m = 0; m < 8; ++m) bnxt[m] = *(const f32x4*)(Bn + m * 256);
                dnxt = GD[it + 4];
            }
            const char* ring = smem + (n & 1) * 32768 + lane * 16;
            bf16x8 sf[4];
#pragma unroll
            for (int s = 0; s < 4; ++s) {
                sf[s] = pack_frag(acc[2 * s], acc[2 * s + 1]);
                *(bf16x8*)(GS + it * 16384 + ((ew * 4 + s) * 64 + lane) * 8) = sf[s];
            }
#pragma unroll
            for (int m = 0; m < 8; ++m) {
                f32x4 a = acc[m] * dcur + bcur[m];
#pragma unroll
                for (int s = 0; s < 4; ++s) a = mfma16(*(const bf16x8*)(ring + (m * 4 + s) * 1024), sf[s], a);
                acc[m] = a;
            }
#pragma unroll
            for (int m = 0; m < 8; ++m) bcur[m] = bnxt[m];
            dcur = dnxt;
        }
        float* E0 = (float*)(p.ws + WS_GE0) + (size_t)(h * 16 + g) * 16384 + (ew * 8 * 64 + lane) * 4;
#pragma unroll
        for (int m = 0; m < 8; ++m) *(f32x4*)(E0 + m * 256) = acc[m];
    } else {
        const bf16* GQ = (const bf16*)(p.ws + WS_GQ); bf16* GR = (bf16*)(p.ws + WS_GR);
#pragma unroll
        for (int m = 0; m < 8; ++m)
#pragma unroll
            for (int j = 0; j < 4; ++j) acc[m][j] = (m == ew && 4 * fq + j == fr) ? 1.f : 0.f;
#pragma unroll 1
        for (int n = n0; n < n0 + 16; ++n) {
            const size_t it = (size_t)n * 4 + h;
            asm volatile("s_waitcnt vmcnt(0)" ::: "memory");
            __syncthreads();
            if (n + 1 < n0 + 16) L1_DMA(n + 1);
            bf16x8 qf[16];
#pragma unroll
            for (int i = 0; i < 16; ++i) qf[i] = *(const bf16x8*)(GQ + it * 8192 + (i * 64 + lane) * 8);
            const float dn = GD[it];
            const char* ring = smem + (n & 1) * 32768 + lane * 16;
            bf16x8 tf[4];
#pragma unroll
            for (int s = 0; s < 4; ++s) tf[s] = pack_frag(acc[2 * s], acc[2 * s + 1]);
#pragma unroll
            for (int m = 0; m < 8; ++m) {
                f32x4 a = acc[m] * dn;
#pragma unroll
                for (int s = 0; s < 4; ++s) a = mfma16(*(const bf16x8*)(ring + (m * 4 + s) * 1024), tf[s], a);
                acc[m] = a;
            }
#pragma unroll
            for (int tt = 0; tt < 4; ++tt) {
                f32x4 r = {0.f, 0.f, 0.f, 0.f};
#pragma unroll
                for (int s = 0; s < 4; ++s) r = mfma16(tf[s], qf[tt * 4 + s], r);
                *(u32x2*)(GR + it * 8192 + ((tt * 4 + (ew >> 1)) * 64 + lane) * 8 + 4 * (ew & 1)) = (u32x2){pk2(r.x, r.y), pk2(r.z, r.w)};
            }
        }
        bf16* TE = (bf16*)(p.ws + WS_GTE) + (size_t)(h * 16 + g) * 16384;
        const int s_ = ew >> 1, jj = 4 * (ew & 1) + (fr & 3), lg = fr >> 2;
#pragma unroll
        for (int m = 0; m < 8; ++m)
#pragma unroll
            for (int j = 0; j < 4; ++j) TE[((m * 4 + s_) * 64 + (4 * fq + j) + 16 * lg) * 8 + jj] = (bf16)f2bf(acc[m][j]);
    }
    asm volatile("s_waitcnt vmcnt(0)" ::: "memory");
    __syncthreads();
#undef L1_DMA
}
DEVI void gdnL2_item(const P& p, int item, char* smem) {
    const bf16* TE = (const bf16*)(p.ws + WS_GTE); const float* E0 = (const float*)(p.ws + WS_GE0); bf16* SG = (bf16*)(p.ws + WS_GSG);
    const int h = item >> 1, tid = VTID, lane = tid & 63, ew = (item & 1) * 4 + (tid >> 6);
#define L2_DMA(g) do { const bf16* _s = TE + ((size_t)h * 16 + (g)) * 16384 + tid * 8; char* _d = smem + ((g) & 1) * 32768 + tid * 16; \
        _Pragma("unroll") for (int _i = 0; _i < 8; ++_i) __builtin_amdgcn_global_load_lds((const unsigned*)(_s + _i * 2048), (unsigned*)(_d + _i * 4096), 16, 0, 0); } while (0)
    f32x4 acc[8];
#pragma unroll
    for (int m = 0; m < 8; ++m) acc[m] = (f32x4){0.f, 0.f, 0.f, 0.f};
    L2_DMA(0);
    f32x4 bcur[8], bnxt[8];
    {
        const float* En = E0 + (size_t)h * 16 * 16384 + (ew * 8 * 64 + lane) * 4;
#pragma unroll
        for (int m = 0; m < 8; ++m) bcur[m] = *(const f32x4*)(En + m * 256);
    }
#pragma unroll 1
    for (int g = 0; g < 16; ++g) {
        const size_t hg = (size_t)h * 16 + g;
        asm volatile("s_waitcnt vmcnt(0)" ::: "memory");
        __syncthreads();
        if (g + 1 < 16) {
            L2_DMA(g + 1);
            const float* En = E0 + (hg + 1) * 16384 + (ew * 8 * 64 + lane) * 4;
#pragma unroll
            for (int m = 0; m < 8; ++m) bnxt[m] = *(const f32x4*)(En + m * 256);
        }
        const char* ring = smem + (g & 1) * 32768 + lane * 16;
        bf16x8 sf[4];
#pragma unroll
        for (int s = 0; s < 4; ++s) {
            sf[s] = pack_frag(acc[2 * s], acc[2 * s + 1]);
            *(bf16x8*)(SG + hg * 16384 + ((ew * 4 + s) * 64 + lane) * 8) = sf[s];
        }
#pragma unroll
        for (int m = 0; m < 8; ++m) {
            f32x4 a = bcur[m];
#pragma unroll
            for (int s = 0; s < 4; ++s) a = mfma16(*(const bf16x8*)(ring + (m * 4 + s) * 1024), sf[s], a);
            acc[m] = a;
        }
#pragma unroll
        for (int m = 0; m < 8; ++m) bcur[m] = bnxt[m];
    }
    asm volatile("s_waitcnt vmcnt(0)" ::: "memory");
    __syncthreads();
#undef L2_DMA
}

DEVI void gdnC_item(const P& p, int item, int l) {
    const bf16* GQ = (const bf16*)(p.ws + WS_GQ) + (size_t)item * 8192; const float* GO = (const float*)(p.ws + WS_GO) + (size_t)item * 8192;
    const bf16* GS = (const bf16*)(p.ws + WS_GS) + (size_t)item * 16384;
    const bf16* PROJ = (const bf16*)(p.ws + WS_PROJ); bf16* MIX = (bf16*)(p.ws + WS_MIX);
    const float* gn = p.in[24] + l * 128;
    const int n = item >> 2, h = item & 3;
    const int lane = VTID & 63, ct = VTID >> 6, fr = lane & 15, fq = lane >> 4;
    const bf16* GR = (const bf16*)(p.ws + WS_GR) + (size_t)item * 8192;
    const bf16* SG = (const bf16*)(p.ws + WS_GSG) + (size_t)(h * 16 + (n >> 4)) * 16384;
    bf16x8 qf[4], rf[4];
#pragma unroll
    for (int s = 0; s < 4; ++s) { qf[s] = *(const bf16x8*)(GQ + ((ct * 4 + s) * 64 + lane) * 8); rf[s] = *(const bf16x8*)(GR + ((ct * 4 + s) * 64 + lane) * 8); }
    const int t = n * 64 + 16 * ct + fr;
    f32x4 a[8];
    float ss = 0.f;
    u32x2 zr[8]; f32x4 gv[8];
#pragma unroll
    for (int et = 0; et < 8; ++et) { zr[et] = *(const u32x2*)(PROJ + (size_t)t * NPROJ + 2560 + h * 128 + 16 * et + 4 * fq); gv[et] = *(const f32x4*)(gn + 16 * et + 4 * fq); }
#pragma unroll
    for (int e2 = 0; e2 < 4; ++e2) {
        f32x4 c0[2]; bf16x8 gs[2][4], sg[2][4];
#pragma unroll
        for (int u = 0; u < 2; ++u) {
            const int et = 2 * e2 + u;
            c0[u] = *(const f32x4*)(GO + ((ct * 8 + et) * 64 + lane) * 4);
#pragma unroll
            for (int s = 0; s < 4; ++s) { gs[u][s] = *(const bf16x8*)(GS + ((et * 4 + s) * 64 + lane) * 8); sg[u][s] = *(const bf16x8*)(SG + ((et * 4 + s) * 64 + lane) * 8); }
        }
        asm volatile("" ::: "memory");
#pragma unroll
        for (int u = 0; u < 2; ++u) {
            f32x4 acc = c0[u];
#pragma unroll
            for (int s = 0; s < 4; ++s) acc = mfma16(gs[u][s], qf[s], acc);
#pragma unroll
            for (int s = 0; s < 4; ++s) acc = mfma16(sg[u][s], rf[s], acc);
            a[2 * e2 + u] = acc;
            ss += acc.x * acc.x + acc.y * acc.y + acc.z * acc.z + acc.w * acc.w;
        }
    }
    const float rs = rsqrtf(quad_sum(ss) * (1.f / 128.f) + 1e-6f);
#pragma unroll
    for (int et = 0; et < 8; ++et) {
        const int e = 16 * et + 4 * fq;
        const f32x4 z = {__uint_as_float(zr[et].x << 16), __uint_as_float(zr[et].x & 0xffff0000u), __uint_as_float(zr[et].y << 16), __uint_as_float(zr[et].y & 0xffff0000u)};
        const f32x4 o = a[et] * rs * gv[et];
        *(u32x2*)(MIX + (size_t)t * D + 256 + h * 128 + e) = (u32x2){pk2(o.x * siluf_(z.x), o.y * siluf_(z.y)), pk2(o.z * siluf_(z.z), o.w * siluf_(z.w))};
    }
}

DEVI void rwkA_item(const P& p, int item, char* smem) {
    const bf16* REC = (const bf16*)(p.ws + WS_RECR); const float* WDEC = (const float*)(p.ws + WS_WDEC);
    bf16* WP = (bf16*)(p.ws + WS_WP) + (size_t)item * 4096; float* WC = (float*)(p.ws + WS_WC) + (size_t)item * 4096;
    float* WD = (float*)(p.ws + WS_WD) + (size_t)item * 64;
    bf16* WQ = (bf16*)(p.ws + WS_WQ) + (size_t)item * 2048; float* WY = (float*)(p.ws + WS_WY) + (size_t)item * 2048;
    bf16* At_ = (bf16*)smem; bf16* Rt = At_ + 32 * 72; bf16* Bt = Rt + 32 * 72; bf16* Kt = Bt + 32 * 72;
    float* ZT = (float*)(smem + 9216);
    bf16* BhT = (bf16*)(smem + 18432); bf16* KhT = BhT + 64 * 40; bf16* VT = KhT + 64 * 40; bf16* AhT = VT + 64 * 40; bf16* UhT = AhT + 64 * 40;
    float* M = (float*)(smem + 44032);
    bf16* Aak = (bf16*)(smem + 48128); bf16* Arb = Aak + 32 * 40; bf16* Ark = Arb + 32 * 40;
    float* tot = (float*)(smem + 55808);
    const int n = item >> 2, h = item & 3;
    int tid = VTID; asm volatile("" : "+v"(tid));
    const int lane = tid & 63, w = tid >> 6, fr = lane & 15, fq = lane >> 4;
    {
        const int d = lane;
        const bf16* rec = REC + ((size_t)(n * 32 + 8 * w) * 4 + h) * 384 + d;
        const float* dcy = WDEC + (size_t)(n * 32 + 8 * w) * 256 + h * 64 + d;
        float lw[8], lg[8];
        float run = 0.f;
        float dcv[8]; bf16 ra[8], rb[8], rk[8], rr_[8], rv[8];
#pragma unroll
        for (int i = 0; i < 8; ++i) {
            const bf16* r = rec + (size_t)i * 1536;
            dcv[i] = dcy[i * 256]; ra[i] = r[0]; rb[i] = r[128]; rk[i] = r[192]; rr_[i] = r[256]; rv[i] = r[320];
        }
        asm volatile("" ::: "memory");
#pragma unroll
        for (int i = 0; i < 8; ++i) { lg[i] = __logf(dcv[i]); run += lg[i]; lw[i] = run; }
        tot[w * 64 + d] = run;
        __syncthreads();
        float off = 0.f, total = 0.f;
#pragma unroll
        for (int q = 0; q < 4; ++q) { const float tq = tot[q * 64 + d]; total += tq; off += (q < w) ? tq : 0.f; }
        unsigned bh[4], kh[4], vv[4];
        float pb = 0.f, pk = 0.f, pv = 0.f;
#pragma unroll
        for (int i = 0; i < 8; ++i) {
            const float a = bf2f(ra[i]), b = bf2f(rb[i]), k = bf2f(rk[i]), rr = bf2f(rr_[i]), v = bf2f(rv[i]);
            const float lc = off + lw[i];
            const float cw = __expf(lc), cwm1 = __expf(lc - lg[i]), inv = __expf(-lc), rat = __expf(total - lc);
            const int t = 8 * w + i;
            At_[t * 72 + d] = (bf16)f2bf(a * cwm1); Rt[t * 72 + d] = (bf16)f2bf(rr * cw);
            Bt[t * 72 + d] = (bf16)f2bf(b * inv); Kt[t * 72 + d] = (bf16)f2bf(k * inv);
            if (i & 1) { bh[i >> 1] = pk2(pb, b * rat); kh[i >> 1] = pk2(pk, k * rat); vv[i >> 1] = pk2(pv, v); }
            else { pb = b * rat; pk = k * rat; pv = v; }
        }
        *(u32x4*)(BhT + d * 40 + 8 * w) = (u32x4){bh[0], bh[1], bh[2], bh[3]};
        *(u32x4*)(KhT + d * 40 + 8 * w) = (u32x4){kh[0], kh[1], kh[2], kh[3]};
        *(u32x4*)(VT + d * 40 + 8 * w) = (u32x4){vv[0], vv[1], vv[2], vv[3]};
        if (w == 0) WD[d] = __expf(total);
    }
    __syncthreads();
    {
        int offA = (w == 0) ? 0 : (w == 1 ? 3 : (w == 2 ? 2 : 3));
        int offB = (w == 0) ? 2 : (w == 1 ? 0 : 1);
        asm volatile("" : "+v"(offA), "+v"(offB));
        const bf16* As = At_ + offA * (32 * 72); const bf16* Bs = At_ + offB * (32 * 72);
#pragma unroll
        for (int ta = 0; ta < 2; ++ta) {
            const bf16x8 a0 = ldfrag(As, 72, 16 * ta, 0, lane), a1 = ldfrag(As, 72, 16 * ta, 32, lane);
#pragma unroll
            for (int tb = 0; tb < 2; ++tb) {
                f32x4 acc = {0.f, 0.f, 0.f, 0.f};
                acc = mfma16(a0, ldfrag(Bs, 72, 16 * tb, 0, lane), acc);
                acc = mfma16(a1, ldfrag(Bs, 72, 16 * tb, 32, lane), acc);
                if (w == 0) {
                    const int s_ = 16 * tb + fr;
#pragma unroll
                    for (int j = 0; j < 4; ++j) { const int t = 16 * ta + 4 * fq + j; M[t * 32 + s_] = (t > s_) ? -acc[j] : 0.f; }
                } else {
                    const int t = 16 * tb + fr;
                    float pv4[4];
#pragma unroll
                    for (int j = 0; j < 4; ++j) { const int s_ = 16 * ta + 4 * fq + j; pv4[j] = ((w == 1) ? (t > s_) : (t >= s_)) ? acc[j] : 0.f; }
                    int offD = w - 1; asm volatile("" : "+v"(offD));
                    *(u32x2*)(Aak + offD * (32 * 40) + t * 40 + 16 * ta + 4 * fq) = (u32x2){pk2(pv4[0], pv4[1]), pk2(pv4[2], pv4[3])};
                }
            }
        }
    }
    __syncthreads();
    {
        const int et = w;
        const bf16x8 vf = ldfrag(VT, 40, 16 * et, 0, lane);
#pragma unroll
        for (int tt = 0; tt < 2; ++tt) {
            f32x4 acc = {0.f, 0.f, 0.f, 0.f};
            acc = mfma16(ldfrag(Aak, 40, 16 * tt, 0, lane), vf, acc);
            *(f32x4*)(ZT + (16 * et + fr) * 36 + 16 * tt + 4 * fq) = acc;
        }
    }
    __syncthreads();
    if (tid < 128) {
        float x[32];
        if (tid < 64) {
#pragma unroll
            for (int t = 0; t < 32; ++t) x[t] = bf2f(At_[t * 72 + tid]);
        } else {
#pragma unroll
            for (int q = 0; q < 8; ++q) { const f32x4 z = *(const f32x4*)(ZT + (tid - 64) * 36 + 4 * q); x[4 * q] = z.x; x[4 * q + 1] = z.y; x[4 * q + 2] = z.z; x[4 * q + 3] = z.w; }
        }
        SolveRow<1, 32>::run(x, M);
        bf16* dst = AhT + tid * 40;
#pragma unroll
        for (int q = 0; q < 4; ++q)
            *(u32x4*)(dst + 8 * q) = (u32x4){pk2(x[8 * q], x[8 * q + 1]), pk2(x[8 * q + 2], x[8 * q + 3]), pk2(x[8 * q + 4], x[8 * q + 5]), pk2(x[8 * q + 6], x[8 * q + 7])};
    }
    __syncthreads();
    {
        const int mt = w;
        const bf16x8 bh = ldfrag(BhT, 40, 16 * mt, 0, lane), kh = ldfrag(KhT, 40, 16 * mt, 0, lane);
#pragma unroll
        for (int sp = 0; sp < 2; ++sp) {
            f32x4 a0 = {0.f, 0.f, 0.f, 0.f}, a1 = {0.f, 0.f, 0.f, 0.f};
            a0 = mfma16(ldfrag(AhT, 40, 32 * sp, 0, lane), bh, a0);
            a1 = mfma16(ldfrag(AhT, 40, 32 * sp + 16, 0, lane), bh, a1);
            *(u32x4*)(WP + ((mt * 2 + sp) * 64 + lane) * 8) = (u32x4){pk2(a0.x, a0.y), pk2(a0.z, a0.w), pk2(a1.x, a1.y), pk2(a1.z, a1.w)};
        }
#pragma unroll
        for (int nt = 0; nt < 4; ++nt) {
            f32x4 a = {0.f, 0.f, 0.f, 0.f};
            a = mfma16(bh, ldfrag(UhT, 40, 16 * nt, 0, lane), a);
            a = mfma16(kh, ldfrag(VT, 40, 16 * nt, 0, lane), a);
            *(f32x4*)(WC + ((nt * 4 + mt) * 64 + lane) * 4) = a;
        }
        {
            const int ct = w & 1, sp = w >> 1, t = 16 * ct + fr;
            const bf16x8 ar = ldfrag(Arb, 40, 16 * ct, 0, lane);
            f32x4 a0 = ld_bf4(Rt + t * 72 + 32 * sp + 4 * fq), a1 = ld_bf4(Rt + t * 72 + 32 * sp + 16 + 4 * fq);
            a0 = mfma16(ldfrag(AhT, 40, 32 * sp, 0, lane), ar, a0);
            a1 = mfma16(ldfrag(AhT, 40, 32 * sp + 16, 0, lane), ar, a1);
            *(u32x4*)(WQ + ((ct * 2 + sp) * 64 + lane) * 8) = (u32x4){pk2(a0.x, a0.y), pk2(a0.z, a0.w), pk2(a1.x, a1.y), pk2(a1.z, a1.w)};
        }
        {
            const int et = w;
            const bf16x8 uf = ldfrag(UhT, 40, 16 * et, 0, lane), vf = ldfrag(VT, 40, 16 * et, 0, lane);
#pragma unroll
            for (int ct = 0; ct < 2; ++ct) {
                f32x4 a = {0.f, 0.f, 0.f, 0.f};
                a = mfma16(uf, ldfrag(Arb, 40, 16 * ct, 0, lane), a);
                a = mfma16(vf, ldfrag(Ark, 40, 16 * ct, 0, lane), a);
                *(f32x4*)(WY + ((ct * 4 + et) * 64 + lane) * 4) = a;
            }
        }
    }
    __syncthreads();
}

struct RwkStep { bf16x8 pf[8]; f32x4 cf[4]; f32x4 dv[4]; };
DEVI void rwk_load(RwkStep& r, const bf16* WP, const float* WC, const float* WD, size_t it, int ew, int lane) {
#pragma unroll
    for (int i = 0; i < 8; ++i) r.pf[i] = *(const bf16x8*)(WP + it * 4096 + (i * 64 + lane) * 8);
#pragma unroll
    for (int m = 0; m < 4; ++m) r.cf[m] = *(const f32x4*)(WC + it * 4096 + ((ew * 4 + m) * 64 + lane) * 4);
#pragma unroll
    for (int m = 0; m < 4; ++m) r.dv[m] = *(const f32x4*)(WD + it * 64 + 16 * m + 4 * (lane >> 4));
}
DEVI void rwk_step(const RwkStep& r, f32x4 (&acc)[4], bf16* WSF, size_t it, int ew, int lane) {
    bf16x8 sf[2];
#pragma unroll
    for (int s = 0; s < 2; ++s) {
        const u32x4 v = {pk2(acc[2 * s].x, acc[2 * s].y), pk2(acc[2 * s].z, acc[2 * s].w), pk2(acc[2 * s + 1].x, acc[2 * s + 1].y), pk2(acc[2 * s + 1].z, acc[2 * s + 1].w)};
        *(u32x4*)(WSF + it * 4096 + ((ew * 2 + s) * 64 + lane) * 8) = v;
        sf[s] = __builtin_bit_cast(bf16x8, v);
    }
#pragma unroll
    for (int m = 0; m < 4; ++m) {
        f32x4 a = acc[m] * r.dv[m] + r.cf[m];
        a = mfma16(r.pf[m * 2], sf[0], a);
        a = mfma16(r.pf[m * 2 + 1], sf[1], a);
        acc[m] = a;
    }
}
DEVI void rwkL1_item(const P& p, int item) {
    const bf16* WP = (const bf16*)(p.ws + WS_WP); const float* WC = (const float*)(p.ws + WS_WC); const float* WD = (const float*)(p.ws + WS_WD);
    const int kind = item & 1, g = (item >> 1) & 15, h = item >> 5;
    const int lane = VTID & 63, ew = VTID >> 6, fr = lane & 15, fq = lane >> 4;
    f32x4 acc[4];
    if (kind == 0) {
        bf16* WSF = (bf16*)(p.ws + WS_WS);
#pragma unroll
        for (int m = 0; m < 4; ++m) acc[m] = (f32x4){0.f, 0.f, 0.f, 0.f};
        RwkStep A, B;
        const int n0 = g * 32;
        rwk_load(A, WP, WC, WD, (size_t)n0 * 4 + h, ew, lane);
#pragma unroll 1
        for (int n = n0; n < n0 + 32; n += 2) {
            rwk_load(B, WP, WC, WD, (size_t)(n + 1) * 4 + h, ew, lane);
            asm volatile("" ::: "memory");
            rwk_step(A, acc, WSF, (size_t)n * 4 + h, ew, lane);
            rwk_load(A, WP, WC, WD, (size_t)((n + 2 < n0 + 32) ? n + 2 : n) * 4 + h, ew, lane);
            asm volatile("" ::: "memory");
            rwk_step(B, acc, WSF, (size_t)(n + 1) * 4 + h, ew, lane);
        }
        float* E0 = (float*)(p.ws + WS_WE0) + (size_t)(h * 16 + g) * 4096 + (ew * 4 * 64 + lane) * 4;
#pragma unroll
        for (int m = 0; m < 4; ++m) *(f32x4*)(E0 + m * 256) = acc[m];
    } else {
        const bf16* WQ = (const bf16*)(p.ws + WS_WQ); bf16* WR = (bf16*)(p.ws + WS_WR);
#pragma unroll
        for (int m = 0; m < 4; ++m)
#pragma unroll
            for (int j = 0; j < 4; ++j) acc[m][j] = (m == ew && 4 * fq + j == fr) ? 1.f : 0.f;
#pragma unroll 1
        for (int n = g * 32; n < g * 32 + 32; ++n) {
            const size_t it = (size_t)n * 4 + h;
            bf16x8 pf[8], qf[4]; f32x4 dv[4];
#pragma unroll
            for (int i = 0; i < 8; ++i) pf[i] = *(const bf16x8*)(WP + it * 4096 + (i * 64 + lane) * 8);
#pragma unroll
            for (int i = 0; i < 4; ++i) qf[i] = *(const bf16x8*)(WQ + it * 2048 + (i * 64 + lane) * 8);
#pragma unroll
            for (int m = 0; m < 4; ++m) dv[m] = *(const f32x4*)(WD + it * 64 + 16 * m + 4 * fq);
            asm volatile("" ::: "memory");
            bf16x8 tf[2];
#pragma unroll
            for (int s = 0; s < 2; ++s) tf[s] = pack_frag(acc[2 * s], acc[2 * s + 1]);
#pragma unroll
            for (int tt = 0; tt < 2; ++tt) {
                f32x4 r = {0.f, 0.f, 0.f, 0.f};
                r = mfma16(tf[0], qf[tt * 2], r); r = mfma16(tf[1], qf[tt * 2 + 1], r);
                *(u32x2*)(WR + it * 2048 + ((tt * 2 + (ew >> 1)) * 64 + lane) * 8 + 4 * (ew & 1)) = (u32x2){pk2(r.x, r.y), pk2(r.z, r.w)};
            }
#pragma unroll
            for (int m = 0; m < 4; ++m) {
                f32x4 a = acc[m] * dv[m];
                a = mfma16(pf[m * 2], tf[0], a); a = mfma16(pf[m * 2 + 1], tf[1], a);
                acc[m] = a;
            }
        }
        bf16* TE = (bf16*)(p.ws + WS_WTE) + (size_t)(h * 16 + g) * 4096;
        const int s_ = ew >> 1, jj = 4 * (ew & 1) + (fr & 3), lg = fr >> 2;
#pragma unroll
        for (int m = 0; m < 4; ++m)
#pragma unroll
            for (int j = 0; j < 4; ++j) TE[((m * 2 + s_) * 64 + (4 * fq + j) + 16 * lg) * 8 + jj] = (bf16)f2bf(acc[m][j]);
    }
}
DEVI void rwkL2_item(const P& p, int h) {
    const bf16* TE = (const bf16*)(p.ws + WS_WTE); const float* E0 = (const float*)(p.ws + WS_WE0); bf16* SG = (bf16*)(p.ws + WS_WSG);
    const int lane = VTID & 63, ew = VTID >> 6;
    f32x4 acc[4];
#pragma unroll
    for (int m = 0; m < 4; ++m) acc[m] = (f32x4){0.f, 0.f, 0.f, 0.f};
#pragma unroll 1
    for (int g = 0; g < 16; ++g) {
        const size_t hg = (size_t)h * 16 + g;
        bf16x8 pf[8]; f32x4 bfr[4];
#pragma unroll
        for (int i = 0; i < 8; ++i) pf[i] = *(const bf16x8*)(TE + hg * 4096 + (i * 64 + lane) * 8);
#pragma unroll
        for (int m = 0; m < 4; ++m) bfr[m] = *(const f32x4*)(E0 + hg * 4096 + ((ew * 4 + m) * 64 + lane) * 4);
        asm volatile("" ::: "memory");
        bf16x8 sf[2];
#pragma unroll
        for (int s = 0; s < 2; ++s) {
            sf[s] = pack_frag(acc[2 * s], acc[2 * s + 1]);
            *(bf16x8*)(SG + hg * 4096 + ((ew * 2 + s) * 64 + lane) * 8) = sf[s];
        }
#pragma unroll
        for (int m = 0; m < 4; ++m) {
            f32x4 a = bfr[m];
            a = mfma16(pf[m * 2], sf[0], a); a = mfma16(pf[m * 2 + 1], sf[1], a);
            acc[m] = a;
        }
    }
}

DEVI void rwkC_item(const P& p, int n, int l) {
    const int lane = VTID & 63, h = VTID >> 6, fr = lane & 15, fq = lane >> 4;
    const size_t it = (size_t)n * 4 + h;
    const bf16* WQ = (const bf16*)(p.ws + WS_WQ) + it * 2048; const float* WY = (const float*)(p.ws + WS_WY) + it * 2048;
    const bf16* WSF = (const bf16*)(p.ws + WS_WS) + it * 4096;
    const bf16* WR = (const bf16*)(p.ws + WS_WR) + it * 2048; const bf16* WSG = (const bf16*)(p.ws + WS_WSG) + (size_t)(h * 16 + (n >> 5)) * 4096;
    const bf16* RECR = (const bf16*)(p.ws + WS_RECR); const float* GB = (const float*)(p.ws + WS_G); const float* BON = (const float*)(p.ws + WS_BON);
    bf16* MIX = (bf16*)(p.ws + WS_MIX);
    const float* ln_g = p.in[17] + l * 256 + h * 64; const float* ln_b = p.in[18] + l * 256 + h * 64;
#pragma unroll
    for (int ct = 0; ct < 2; ++ct) {
        const bf16x8 q0 = *(const bf16x8*)(WQ + ((ct * 2 + 0) * 64 + lane) * 8), q1 = *(const bf16x8*)(WQ + ((ct * 2 + 1) * 64 + lane) * 8);
        const bf16x8 r0 = *(const bf16x8*)(WR + ((ct * 2 + 0) * 64 + lane) * 8), r1 = *(const bf16x8*)(WR + ((ct * 2 + 1) * 64 + lane) * 8);
        const int t = n * 32 + 16 * ct + fr;
        f32x4 a[4];
        float sm = 0.f;
        f32x4 y0[4]; bf16x8 sfr[4][2], sgr[4][2];
#pragma unroll
        for (int et = 0; et < 4; ++et) {
            y0[et] = *(const f32x4*)(WY + ((ct * 4 + et) * 64 + lane) * 4);
#pragma unroll
            for (int s = 0; s < 2; ++s) { sfr[et][s] = *(const bf16x8*)(WSF + ((et * 2 + s) * 64 + lane) * 8); sgr[et][s] = *(const bf16x8*)(WSG + ((et * 2 + s) * 64 + lane) * 8); }
        }
        asm volatile("" ::: "memory");
#pragma unroll
        for (int et = 0; et < 4; ++et) {
            f32x4 acc = y0[et];
            acc = mfma16(sfr[et][0], q0, acc);
            acc = mfma16(sfr[et][1], q1, acc);
            acc = mfma16(sgr[et][0], r0, acc);
            acc = mfma16(sgr[et][1], r1, acc);
            a[et] = acc; sm += (acc.x + acc.y) + (acc.z + acc.w);
        }
        const float mean = quad_sum(sm) * (1.f / 64.f);
        float sv = 0.f;
#pragma unroll
        for (int et = 0; et < 4; ++et) { a[et] = a[et] - mean; sv += a[et].x * a[et].x + a[et].y * a[et].y + a[et].z * a[et].z + a[et].w * a[et].w; }
        const float rs = rsqrtf(quad_sum(sv) * (1.f / 64.f) + 64e-5f);
        const float bon = BON[(size_t)t * 4 + h];
        f32x4 gq[4], bq[4], vq[4], gateq[4];
#pragma unroll
        for (int et = 0; et < 4; ++et) {
            const int e = 16 * et + 4 * fq;
            gq[et] = *(const f32x4*)(ln_g + e); bq[et] = *(const f32x4*)(ln_b + e);
            vq[et] = ld_bf4(RECR + ((size_t)t * 4 + h) * 384 + 320 + e);
            gateq[et] = *(const f32x4*)(GB + (size_t)t * 256 + h * 64 + e);
        }
        asm volatile("" ::: "memory");
#pragma unroll
        for (int et = 0; et < 4; ++et) {
            const int e = 16 * et + 4 * fq;
            const f32x4 g = gq[et], b = bq[et];
            const f32x4 v = vq[et];
            const f32x4 gate = gateq[et];
            const f32x4 o = (a[et] * rs * g + b + v * bon) * gate;
            *(u32x2*)(MIX + (size_t)t * D + h * 64 + e) = (u32x2){pk2(o.x, o.y), pk2(o.z, o.w)};
        }
    }
}

DEVI void phase_scanL1(const P& p, char* smem) {
    for (int item = VBID; item < 448; item += VNB) {
        if (item < 256) gdnL1_item(p, item, smem);
        else if (item < 384) rwkL1_item(p, item - 256);
        else retS_item(p, item - 384);
    }
}
DEVI void retC_item(const P& p, int item, int l, char* smem);
DEVI void phase_scanL2(const P& p, int l, char* smem) {
    if (VBID < 12) { if (VBID < 8) gdnL2_item(p, VBID, smem); else rwkL2_item(p, VBID - 8); }
    else { for (int item = VBID - 12; item < 1024; item += VNB - 12) retC_item(p, item, l, smem); }
}
DEVI void phase_chunkA(const P& p, char* smem) {
    for (int item = VBID; item < 4096; item += VNB) { if (item < 1024) gdnA_item(p, item, smem); else if (item < 3072) rwkA_item(p, item - 1024, smem); else retA_item(p, item - 3072, smem); }
}
DEVI void phase_chunkC(const P& p, int l, char* smem) {
    for (int item = VBID; item < 1536; item += VNB) { if (item < 1024) gdnC_item(p, item, l); else rwkC_item(p, item - 1024, l); }
}

DEVI void phase_ln1_route(const P& p, int l, char* smem, bool commit = true) {
    const float* ADA = (const float*)(p.ws + OFF_ADA) + l * 6144;
    const float* xin = (l == 0) ? p.in[0] : (const float*)(p.ws + WS_X);
    const float* OPRE = (const float*)(p.ws + WS_OPRE);
    float* X = (float*)(p.ws + WS_X); bf16* H2 = (bf16*)(p.ws + WS_H2);
    const float* lg = p.in[28] + l * D; const float* lb = p.in[29] + l * D;
    const float* rw = p.in[30] + (size_t)l * D * 32; const float* rbias = p.in[31] + l * 32;
    int* CNT = (int*)(p.ws + OFF_CNT) + l * 32 * 64; int* LIST = (int*)(p.ws + WS_LIST); float* GATE = (float*)(p.ws + WS_GATE);
    constexpr int HSS = 1028;
    float* HS = (float*)smem;
    float* RED = HS;
    int* SEL = (int*)(HS + 16 * HSS);
    int* RNK = SEL + 256;
    int* BASE = RNK + 256;
    int nasg = 0;
    const int tid = VTID, lane = tid & 63, w = tid >> 6, fr = lane & 15, fq = lane >> 4;
    f32x4 cg1[4], cg[4], cb[4], cG2[4], cB2[4];
#pragma unroll
    for (int j = 0; j < 4; ++j) {
        const int c = j * 256 + lane * 4;
        const f32x4 gt = *(const f32x4*)(ADA + 2048 + c), sh = *(const f32x4*)(ADA + 3072 + c), sc = *(const f32x4*)(ADA + 4096 + c);
        cg1[j] = gt + 1.f; cg[j] = *(const f32x4*)(lg + c); cb[j] = *(const f32x4*)(lb + c);
        cG2[j] = sc + 1.f; cB2[j] = sh;
    }
    const u32x4* RWF = (const u32x4*)(p.ws + WS_RWF) + (size_t)((l * 32 + w * 8) * 4) * 64 + lane;
    f32x4 xb[4], ob[4];
#define LN1_LOAD(tok) do { const size_t _o = (size_t)(tok) * D + lane * 4; _Pragma("unroll") for (int _j = 0; _j < 4; ++_j) { \
        xb[_j] = *(const f32x4*)(xin + _o + _j * 256); ob[_j] = *(const f32x4*)(OPRE + _o + _j * 256); } } while (0)
    LN1_LOAD(VBID * 16 + w);
    for (int item = VBID; item < S / 16; item += VNB) {
#pragma unroll 1
        for (int sub = 0; sub < 4; ++sub) {
            const int t = item * 16 + sub * 4 + w;
            f32x4 v[4]; float s = 0.f;
#pragma unroll
            for (int j = 0; j < 4; ++j) {
                v[j] = xb[j] * DN_ALPHA + cg1[j] * ob[j];
                s += (v[j].x + v[j].y) + (v[j].z + v[j].w);
            }
            {
                int tn = (sub < 3) ? t + 4 : (item + VNB) * 16 + w;
                if (tn >= S) tn = t;
                asm volatile("" ::: "memory");
                LN1_LOAD(tn);
                asm volatile("" ::: "memory");
            }
            const float mean = wave_sum(s) * (1.f / D);
            float s2 = 0.f;
#pragma unroll
            for (int j = 0; j < 4; ++j) { v[j] = v[j] - mean; s2 += (v[j].x * v[j].x + v[j].y * v[j].y) + (v[j].z * v[j].z + v[j].w * v[j].w); }
            const float rstd = rsqrtf(wave_sum(s2) * (1.f / D) + 1e-5f);
#pragma unroll
            for (int j = 0; j < 4; ++j) {
                const int c = j * 256 + lane * 4;
                f32x4 xo = v[j] * rstd * cg[j] + cb[j];
                *(f32x4*)(X + (size_t)t * D + c) = xo;
                f32x4 hh = xo * cG2[j] + cB2[j];
                *(f32x4*)(HS + (sub * 4 + w) * HSS + c) = hh;
                u32x2 o; o.x = pk2(hh.x, hh.y); o.y = pk2(hh.z, hh.w);
                *(u32x2*)(H2 + (size_t)t * D + c) = o;
            }
        }
        __syncthreads();
        f32x4 lacc[2] = {{0.f, 0.f, 0.f, 0.f}, {0.f, 0.f, 0.f, 0.f}};
        {
            const float* hrow = HS + fr * HSS + w * 256 + 8 * fq;
#pragma unroll
            for (int hb = 0; hb < 4; ++hb) {
                u32x4 bw[2][4];
#pragma unroll
                for (int s4 = 0; s4 < 2; ++s4)
#pragma unroll
                    for (int q = 0; q < 4; ++q) bw[s4][q] = RWF[((hb * 2 + s4) * 4 + q) * 64];
                asm volatile("" ::: "memory");
#pragma unroll
                for (int s4 = 0; s4 < 2; ++s4) {
                    const int ks = hb * 2 + s4;
                    const f32x4 h0 = *(const f32x4*)(hrow + 32 * ks), h1 = *(const f32x4*)(hrow + 32 * ks + 4);
                    const unsigned p0 = pk2(h0.x, h0.y), p1 = pk2(h0.z, h0.w), p2 = pk2(h1.x, h1.y), p3 = pk2(h1.z, h1.w);
                    const unsigned q0 = pk2(h0.x - __uint_as_float(p0 << 16), h0.y - __uint_as_float(p0 & 0xffff0000u));
                    const unsigned q1 = pk2(h0.z - __uint_as_float(p1 << 16), h0.w - __uint_as_float(p1 & 0xffff0000u));
                    const unsigned q2 = pk2(h1.x - __uint_as_float(p2 << 16), h1.y - __uint_as_float(p2 & 0xffff0000u));
                    const unsigned q3 = pk2(h1.z - __uint_as_float(p3 << 16), h1.w - __uint_as_float(p3 & 0xffff0000u));
                    const bf16x8 ahi = __builtin_bit_cast(bf16x8, ((u32x4){p0, p1, p2, p3})), alo = __builtin_bit_cast(bf16x8, ((u32x4){q0, q1, q2, q3}));
#pragma unroll
                    for (int n = 0; n < 2; ++n) {
                        const bf16x8 bhi = __builtin_bit_cast(bf16x8, bw[s4][2 * n]), blo = __builtin_bit_cast(bf16x8, bw[s4][2 * n + 1]);
                        lacc[n] = mfma16(ahi, bhi, lacc[n]); lacc[n] = mfma16(alo, bhi, lacc[n]); lacc[n] = mfma16(ahi, blo, lacc[n]);
                    }
                }
            }
        }
        __syncthreads();
#pragma unroll
        for (int n = 0; n < 2; ++n)
#pragma unroll
            for (int j = 0; j < 4; ++j) RED[(w * 16 + 4 * fq + j) * 32 + 16 * n + fr] = lacc[n][j];
        __syncthreads();
#pragma unroll 1
        for (int rnd = 0; rnd < 2; ++rnd) {
            const int tok = rnd * 8 + (tid >> 5), e = tid & 31, tt = item * 16 + tok;
            float logit = rbias[e];
#pragma unroll
            for (int ks = 0; ks < 4; ++ks) logit += RED[(ks * 16 + tok) * 32 + e];
            bool taken = false;
            float sv[4]; int si[4];
#pragma unroll
            for (int j = 0; j < 4; ++j) {
                float cand = taken ? -3.0e38f : logit; int ci = e;
#pragma unroll
                for (int off = 16; off >= 1; off >>= 1) {
                    const float ov = __shfl_xor(cand, off, 32); const int oi = __shfl_xor(ci, off, 32);
                    if (ov > cand || (ov == cand && oi < ci)) { cand = ov; ci = oi; }
                }
                sv[j] = cand; si[j] = ci; if (ci == e) taken = true;
            }
            const float e0 = 1.f, e1 = __expf(sv[1] - sv[0]), e2 = __expf(sv[2] - sv[0]), e3 = __expf(sv[3] - sv[0]);
            const float inv = 1.f / (e0 + e1 + e2 + e3);
            const float gts[4] = {e0 * inv, e1 * inv, e2 * inv, e3 * inv};
#pragma unroll
            for (int j = 0; j < 4; ++j) {
                if (si[j] == e) {
                    SEL[nasg + tok * 4 + j] = ((tt * 4 + j) << 5) | e;
                    GATE[(size_t)tt * 4 + j] = gts[j];
                }
            }
        }
        nasg += 64;
        __syncthreads();
    }
    if (!commit) return;
    if (tid < 32) {
        int c = 0;
        for (int a = 0; a < nasg; ++a) { if ((SEL[a] & 31) == tid) { RNK[a] = c; ++c; } }
        BASE[tid] = c ? atomicAdd(&CNT[tid * 64], c) : 0;
    }
    __syncthreads();
    for (int a = tid; a < nasg; a += NT) { const int v = SEL[a], e = v & 31; LIST[(size_t)e * S + BASE[e] + RNK[a]] = v >> 5; }
    __syncthreads();
#undef LN1_LOAD
}

DEVI void phase_ln2(const P& p, int l) {
    const float* ADA = (const float*)(p.ws + OFF_ADA) + l * 6144;
    const float* ADAn = (const float*)(p.ws + OFF_ADA) + 6144;
    float* X = (float*)(p.ws + WS_X); const bf16* YB = (const bf16*)(p.ws + WS_YB);
    bf16* HB = (bf16*)(p.ws + WS_HB);
    const float* lg = p.in[36] + l * D; const float* lb = p.in[37] + l * D;
    const int tid = VTID, lane = tid & 63, w = tid >> 6;
    f32x4 cg1[4], cg[4], cb[4], cG2[4], cB2[4];
#pragma unroll
    for (int j = 0; j < 4; ++j) {
        const int c = j * 256 + lane * 4;
        cg1[j] = *(const f32x4*)(ADA + 5120 + c) + 1.f; cg[j] = *(const f32x4*)(lg + c); cb[j] = *(const f32x4*)(lb + c);
        if (l == 0) { cB2[j] = *(const f32x4*)(ADAn + c); cG2[j] = *(const f32x4*)(ADAn + 1024 + c) + 1.f; }
        else { cB2[j] = cb[j]; cG2[j] = cg[j]; }
    }
    f32x4 xq[4]; u32x2 yq[4][4];
#define LN2_LOAD(tok) do { const size_t _o = (size_t)(tok) * D + lane * 4; _Pragma("unroll") for (int _j = 0; _j < 4; ++_j) { \
        xq[_j] = *(const f32x4*)(X + _o + _j * 256); \
        _Pragma("unroll") for (int _q = 0; _q < 4; ++_q) yq[_j][_q] = *(const u32x2*)(YB + ((size_t)(tok) * 4 + _q) * D + lane * 4 + _j * 256); } } while (0)
    LN2_LOAD(VBID * 4 + w);
    for (int item = VBID; item < S / 4; item += VNB) {
        const int t = item * 4 + w;
        f32x4 v[4]; float s = 0.f;
#pragma unroll
        for (int j = 0; j < 4; ++j) {
            f32x4 f = {0.f, 0.f, 0.f, 0.f};
#pragma unroll
            for (int q = 0; q < 4; ++q) {
                const u32x2 y = yq[j][q];
                f.x += __uint_as_float(y.x << 16); f.y += __uint_as_float(y.x & 0xffff0000u);
                f.z += __uint_as_float(y.y << 16); f.w += __uint_as_float(y.y & 0xffff0000u);
            }
            v[j] = xq[j] * DN_ALPHA + cg1[j] * f;
            s += (v[j].x + v[j].y) + (v[j].z + v[j].w);
        }
        {
            int tn = (item + VNB) * 4 + w;
            if (tn >= S) tn = t;
            asm volatile("" ::: "memory");
            LN2_LOAD(tn);
            asm volatile("" ::: "memory");
        }
        const float mean = wave_sum(s) * (1.f / D);
        float s2 = 0.f;
#pragma unroll
        for (int j = 0; j < 4; ++j) { v[j] = v[j] - mean; s2 += (v[j].x * v[j].x + v[j].y * v[j].y) + (v[j].z * v[j].z + v[j].w * v[j].w); }
        const float rstd = rsqrtf(wave_sum(s2) * (1.f / D) + 1e-5f);
#pragma unroll
        for (int j = 0; j < 4; ++j) {
            const int c = j * 256 + lane * 4;
            const f32x4 xo = v[j] * rstd * cg[j] + cb[j];
            if (l == 0) {
                *(f32x4*)(X + (size_t)t * D + c) = xo;
                const f32x4 hh = xo * cG2[j] + cB2[j];
                u32x2 o; o.x = pk2(hh.x, hh.y); o.y = pk2(hh.z, hh.w);
                *(u32x2*)(HB + (size_t)t * D + c) = o;
            } else {
                *(f32x4*)(p.out + (size_t)t * D + c) = xo;
            }
        }
    }
#undef LN2_LOAD
}

namespace pg8 {
constexpr int BK = 64, HALF = 128, HTB = HALF * BK * 2, STAGE_BYTES = 8 * HTB;
DEVI int lds_byte(int r, int c) { const int st = (r >> 4) * 2 + (c >> 5), rr = r & 15, cc = c & 31, ob = rr * 64 + cc * 2; return st * 1024 + (ob ^ (((ob >> 9) & 1) << 5)); }
DEVI void stage_rc(int b, int& R, int& C) { const int st = b / 1024, sb = b % 1024, swz = sb ^ (((sb >> 9) & 1) << 5); R = (st >> 1) * 16 + swz / 64; C = (st & 1) * 32 + (swz % 64) / 2; }
struct Unit { const char* a; const char* b; int x0, x1, x2, x3; };

template <class Epi, class Sched>
DEVI void gemm_phase(LAS unsigned char* lds, const int K, const Sched& S, const Epi& E) {
    const int tid = threadIdx.x, wid = __builtin_amdgcn_readfirstlane(tid >> 6), lane = tid & 63, wr = wid >> 2, wc = wid & 3, fr = lane & 15, fq = lane >> 4;
    const int nt = K / BK;
    unsigned voffA[2], voffB[2];
    int gR[2], gC[2];
#pragma unroll
    for (int i = 0; i < 2; ++i) { int R, C; stage_rc(tid * 16 + i * 8192, R, C); gR[i] = R; gC[i] = C; voffA[i] = (unsigned)(R * K + C) * 2u; voffB[i] = (unsigned)(Epi::brow(R) * K + C) * 2u; }
    unsigned co[2][2], no[2][2];
#define PG8_GOFF(dst, tab) do { _Pragma("unroll") for (int _h = 0; _h < 2; ++_h) _Pragma("unroll") for (int _i = 0; _i < 2; ++_i) \
        dst[_h][_i] = (unsigned)((tab)[_h * 128 + gR[_i]] * K + gC[_i]) * 2u; } while (0)
    const size_t kstep = (size_t)(BK * 2);
    const size_t hstepA = (size_t)HALF * K * 2, hstepB = (size_t)Epi::BHALF * K * 2;
    const unsigned ldsw = (unsigned)wid * 1024u;
    const int aoff = lds_byte(wr * 64 + fr, fq * 8), boff = lds_byte(wc * 32 + fr, fq * 8);
#define PG8_SA(b, h) (((b) * 2 + (h)) * HTB)
#define PG8_SB(b, h) ((4 + (b) * 2 + (h)) * HTB)
#define PG8_STAGE(bufoff, gbase, voff) do { _Pragma("unroll") for (int _i = 0; _i < 2; ++_i) \
        __builtin_amdgcn_global_load_lds((const unsigned*)((const char*)(gbase) + (voff)[_i]), (LAS unsigned*)(lds + (bufoff) + ldsw + _i * 8192), 16, 0, 0); } while (0)
#define PG8_LDA(dst, b, h) do { _Pragma("unroll") for (int m = 0; m < 4; ++m) _Pragma("unroll") for (int k = 0; k < 2; ++k) dst[m][k] = *(const LAS bf16x8*)(lds + PG8_SA(b, h) + aoff + m * 2048 + k * 1024); } while (0)
#define PG8_LDB(dst, b, h) do { _Pragma("unroll") for (int n = 0; n < 2; ++n) _Pragma("unroll") for (int k = 0; k < 2; ++k) dst[n][k] = *(const LAS bf16x8*)(lds + PG8_SB(b, h) + boff + n * 2048 + k * 1024); } while (0)
#define PG8_MMA(ai, bj, At, Bt) do { __builtin_amdgcn_s_setprio(1); _Pragma("unroll") for (int m = 0; m < 4; ++m) _Pragma("unroll") for (int n = 0; n < 2; ++n) _Pragma("unroll") for (int k = 0; k < 2; ++k) \
        acc[ai][bj][m][n] = __builtin_amdgcn_mfma_f32_16x16x32_bf16(Bt[n][k], At[m][k], acc[ai][bj][m][n], 0, 0, 0); __builtin_amdgcn_s_setprio(0); } while (0)
#define PG8_WAIT_V(n) asm volatile("s_waitcnt vmcnt(" #n ")" ::: "memory")
#define PG8_WAIT_L(n) asm volatile("s_waitcnt lgkmcnt(" #n ")" ::: "memory")
#define PG8_BAR __builtin_amdgcn_s_barrier()
#define PG8_SCHED __builtin_amdgcn_sched_barrier(0)
    Unit cur, nxt; int ui = 0;
    if (!S.next(0, cur)) return;
    f32x4 acc[2][2][4][2];
#pragma unroll
    for (int a = 0; a < 2; ++a)
#pragma unroll
        for (int b = 0; b < 2; ++b)
#pragma unroll
            for (int m = 0; m < 4; ++m)
#pragma unroll
                for (int n = 0; n < 2; ++n) acc[a][b][m][n] = (f32x4){0.f, 0.f, 0.f, 0.f};
    bf16x8 At[4][2], B0[2][2], B1[2][2];
    const char* cA = cur.a; const char* cB = cur.b;
    if constexpr (Epi::GATHER_A) { PG8_GOFF(co, S.rows(0)); PG8_WAIT_L(0); }
    else {
#pragma unroll
        for (int i = 0; i < 2; ++i) { co[0][i] = voffA[i]; co[1][i] = voffA[i] + (unsigned)hstepA; no[0][i] = co[0][i]; no[1][i] = co[1][i]; }
    }
    PG8_WAIT_V(0);
    PG8_STAGE(PG8_SB(0, 0), cB, voffB); PG8_STAGE(PG8_SA(0, 0), cA, co[0]); PG8_STAGE(PG8_SB(0, 1), cB + hstepB, voffB); PG8_STAGE(PG8_SA(0, 1), cA, co[1]);
    if (wr == 1) PG8_BAR;
    PG8_WAIT_V(4); PG8_BAR;
    PG8_STAGE(PG8_SB(1, 0), cB + kstep, voffB); PG8_STAGE(PG8_SA(1, 0), cA + kstep, co[0]); PG8_STAGE(PG8_SB(1, 1), cB + hstepB + kstep, voffB);
    PG8_WAIT_V(6); PG8_BAR;
    for (;;) {
        const bool has_next = S.next(ui + 1, nxt);
        const char* nA = has_next ? nxt.a : cA; const char* nB = has_next ? nxt.b : cB;
        if constexpr (Epi::GATHER_A) { if (has_next) PG8_GOFF(no, S.rows(ui + 1)); else { no[0][0] = co[0][0]; no[0][1] = co[0][1]; no[1][0] = co[1][0]; no[1][1] = co[1][1]; } }
        for (int t = 0; t < nt; t += 2) {
            const bool last = (t == nt - 2);
            const char* a1 = cA + (size_t)(t + 1) * kstep;
            const char* a2 = last ? nA : cA + (size_t)(t + 2) * kstep; const char* b2 = last ? nB : cB + (size_t)(t + 2) * kstep;
            const char* a3 = a2 + kstep; const char* b3 = b2 + kstep;
            unsigned fo[2][2];
#pragma unroll
            for (int h = 0; h < 2; ++h)
#pragma unroll
                for (int i = 0; i < 2; ++i) fo[h][i] = last ? no[h][i] : co[h][i];
            PG8_LDB(B0, 0, 0); PG8_SCHED; PG8_LDA(At, 0, 0); PG8_STAGE(PG8_SA(1, 1), a1, co[1]);
            PG8_WAIT_L(8); PG8_BAR; PG8_WAIT_L(0); PG8_MMA(0, 0, At, B0); PG8_BAR; PG8_SCHED;
            PG8_LDB(B1, 0, 1); PG8_STAGE(PG8_SB(0, 0), b2, voffB);
            PG8_BAR; PG8_WAIT_L(0); PG8_MMA(0, 1, At, B1); PG8_BAR;
            PG8_LDA(At, 0, 1); PG8_STAGE(PG8_SA(0, 0), a2, fo[0]);
            PG8_BAR; PG8_WAIT_L(0); PG8_MMA(1, 0, At, B0); PG8_BAR; PG8_SCHED;
            PG8_STAGE(PG8_SB(0, 1), b2 + hstepB, voffB);
            PG8_WAIT_V(6); PG8_BAR; PG8_MMA(1, 1, At, B1); PG8_BAR;
            PG8_LDB(B0, 1, 0); PG8_SCHED; PG8_LDA(At, 1, 0); PG8_STAGE(PG8_SA(0, 1), a2, fo[1]);
            PG8_WAIT_L(8); PG8_BAR; PG8_WAIT_L(0); PG8_MMA(0, 0, At, B0); PG8_BAR; PG8_SCHED;
            PG8_LDB(B1, 1, 1); PG8_STAGE(PG8_SB(1, 0), b3, voffB);
            PG8_BAR; PG8_WAIT_L(0); PG8_MMA(0, 1, At, B1); PG8_BAR;
            PG8_LDA(At, 1, 1); PG8_STAGE(PG8_SA(1, 0), a3, fo[0]);
            PG8_BAR; PG8_WAIT_L(0); PG8_MMA(1, 0, At, B0); PG8_BAR; PG8_SCHED;
            PG8_STAGE(PG8_SB(1, 1), b3 + hstepB, voffB);
            PG8_WAIT_V(6); PG8_BAR; PG8_MMA(1, 1, At, B1); PG8_BAR;
        }
        E(acc, cur, wr, wc, fr, fq);
        if (!has_next) break;
#pragma unroll
        for (int a = 0; a < 2; ++a)
#pragma unroll
            for (int b = 0; b < 2; ++b)
#pragma unroll
                for (int m = 0; m < 4; ++m)
#pragma unroll
                    for (int n = 0; n < 2; ++n) acc[a][b][m][n] = (f32x4){0.f, 0.f, 0.f, 0.f};
        cur = nxt; cA = nA; cB = nB; ++ui;
#pragma unroll
        for (int h = 0; h < 2; ++h) { co[h][0] = no[h][0]; co[h][1] = no[h][1]; }
    }
    PG8_WAIT_V(0);
    if (wr == 0) PG8_BAR;
    PG8_BAR;
#undef PG8_SA
#undef PG8_GOFF
#undef PG8_SB
#undef PG8_STAGE
#undef PG8_LDA
#undef PG8_LDB
#undef PG8_MMA
#undef PG8_WAIT_V
#undef PG8_WAIT_L
#undef PG8_BAR
#undef PG8_SCHED
}
}

struct SchedDense {
    const char* A; const char* B; int K; int mode;
    DEVI const int* rows(int) const { return nullptr; }
    DEVI bool next(int i, pg8::Unit& u) const {
        const int c = blockIdx.x, x = c & 7; int pm, pn;
        if (mode == 0) { if (i > 0) return false; const int j = c >> 3; pn = j & 3; pm = 8 * x + (j >> 2); }
        else { if (i > 3) return false; const int bk = i * 8 + x, j = c >> 3; pn = 8 * (bk & 1) + (j & 7); pm = 4 * (bk >> 1) + (j >> 3); }
        u.a = A + (size_t)pm * 256 * K * 2; u.b = B + (size_t)pn * 256 * K * 2; u.x0 = pm; u.x1 = pn; u.x2 = 0; u.x3 = 0;
        return true;
    }
};
struct EpiOutF32 {
    static constexpr bool GATHER_A = false; static constexpr int BHALF = 128; static DEVI int brow(int R) { return R; }
    float* C;
    DEVI void operator()(const f32x4 (&acc)[2][2][4][2], const pg8::Unit& u, int wr, int wc, int fr, int fq) const {
#pragma unroll
        for (int ai = 0; ai < 2; ++ai)
#pragma unroll
            for (int m = 0; m < 4; ++m) {
                float* rowp = C + (size_t)(u.x0 * 256 + ai * 128 + wr * 64 + m * 16 + fr) * D + u.x1 * 256 + wc * 32 + 4 * fq;
#pragma unroll
                for (int bj = 0; bj < 2; ++bj)
#pragma unroll
                    for (int n = 0; n < 2; ++n) *(f32x4*)(rowp + bj * 128 + n * 16) = acc[ai][bj][m][n];
            }
    }
};
struct EpiProjBf16 {
    static constexpr bool GATHER_A = false; static constexpr int BHALF = 128; static DEVI int brow(int R) { return R; }
    bf16* C;
    DEVI void operator()(const f32x4 (&acc)[2][2][4][2], const pg8::Unit& u, int wr, int wc, int fr, int fq) const {
#pragma unroll
        for (int ai = 0; ai < 2; ++ai)
#pragma unroll
            for (int m = 0; m < 4; ++m) {
                bf16* rowp = C + (size_t)(u.x0 * 256 + ai * 128 + wr * 64 + m * 16 + fr) * NPROJ + u.x1 * 256 + wc * 32 + 4 * fq;
#pragma unroll
                for (int bj = 0; bj < 2; ++bj)
#pragma unroll
                    for (int n = 0; n < 2; ++n) { const f32x4 v = acc[ai][bj][m][n]; *(u32x2*)(rowp + bj * 128 + n * 16) = (u32x2){pk2(v.x, v.y), pk2(v.z, v.w)}; }
            }
    }
};
DEVI void phase_outproj8(const P& p, int l, char* smem_all) {
    SchedDense Sd{(const char*)(p.ws + WS_MIX), (const char*)(p.ws + WS_WOUT) + (size_t)l * D * D * 2, D, 0};
    EpiOutF32 E{(float*)(p.ws + WS_OPRE)};
    pg8::gemm_phase(( LAS unsigned char*)smem_all, D, Sd, E);
}
DEVI void phase_inproj8(const P& p, int l, char* smem_all) {
    SchedDense Sd{(const char*)(p.ws + WS_HB), (const char*)(p.ws + WS_WIN) + (size_t)l * NPAD * D * 2, D, 1};
    EpiProjBf16 E{(bf16*)(p.ws + WS_PROJ)};
    pg8::gemm_phase((LAS unsigned char*)smem_all, D, Sd, E);
}
DEVI void phase_inproj_extras(const P& p, int l, char* smem) {
    const bf16* HB = (const bf16*)(p.ws + WS_HB);
    const bf16* W = (const bf16*)(p.ws + WS_WIN) + (size_t)l * NPAD * D;
    float* PEX = (float*)(p.ws + WS_PEX);
    const int lane = VTID & 63, wid = VTID >> 6, wr = wid >> 1, wc = wid & 1, fr = lane & 15, fq = lane >> 4;
    for (int mt = VBID; mt < S / 128; mt += VNB) {
        f32x4 acc[4][8];
        gemm_tile(smem, HB, [&](int r) { return (unsigned)((mt * 128 + r) * D); }, W, [&](int r) { return (unsigned)((16 * 256 + r) * D); }, D, acc);
        if (wc == 0) {
#pragma unroll
            for (int m = 0; m < 4; ++m) {
                const int tok = mt * 128 + wr * 64 + m * 16 + fr;
#pragma unroll
                for (int n = 0; n < 4; ++n) *(f32x4*)(PEX + (size_t)tok * 64 + n * 16 + fq * 4) = acc[m][n];
            }
        }
    }
}

struct MoeMap8 { int cnt[32]; int off[32]; int tstart[33]; };
DEVI void moe_map8(const P& p, int l, MoeMap8* mm) {
    const int* CNT = (const int*)(p.ws + OFF_CNT) + l * 32 * 64;
    if (threadIdx.x < 32) mm->cnt[threadIdx.x] = __hip_atomic_load(&CNT[threadIdx.x * 64], __ATOMIC_RELAXED, __HIP_MEMORY_SCOPE_AGENT);
    __syncthreads();
    if (threadIdx.x == 0) {
        int o = 0, ts = 0;
        for (int e = 0; e < 32; ++e) { mm->off[e] = o; mm->tstart[e] = ts; o += mm->cnt[e]; ts += (mm->cnt[e] + 255) / 256; }
        mm->tstart[32] = ts;
    }
    __syncthreads();
}
struct MoeUnits { int n; int pad[3]; int e[32]; int m0[32]; int pn[32]; };
struct SchedMoe {
    const MoeMap8* mm; const MoeUnits* mu; const char* A; const char* Bw; int K;
    size_t bexp, bpn;
    const int* rowtab; bool gather;
    DEVI const int* rows(int i) const { return rowtab + 256 * i; }
    DEVI bool next(int i, pg8::Unit& u) const {
        if (i >= mu->n) return false;
        const int e = mu->e[i], m0 = mu->m0[i], pn = mu->pn[i], off = mm->off[e];
        u.a = gather ? A : A + (size_t)(off + m0) * K * 2; u.b = Bw + (size_t)e * bexp + (size_t)pn * bpn;
        u.x0 = e; u.x1 = m0; u.x2 = pn; u.x3 = off;
        return true;
    }
};
DEVI void moe_units(const MoeMap8* mm, MoeUnits* mu, int npn_log, int pnb_log) {
    if (threadIdx.x < 32) {
        const int x = (int)blockIdx.x & 7, j = (int)blockIdx.x >> 3, RT = mm->tstart[32], rpb = 32 >> pnb_log, nh_log = npn_log - pnb_log;
        const int bk = (int)threadIdx.x * 8 + x, rg = bk >> nh_log, ph = bk & ((1 << nh_log) - 1);
        const int rt = rpb * rg + (j >> pnb_log), pn = (ph << pnb_log) + (j & ((1 << pnb_log) - 1));
        const bool ok = rt < RT;
        if (ok) {
            int e = 0;
            while (mm->tstart[e + 1] <= rt) ++e;
            mu->e[threadIdx.x] = e; mu->m0[threadIdx.x] = (rt - mm->tstart[e]) * 256; mu->pn[threadIdx.x] = pn;
        }
        const unsigned long long okm = __ballot(ok);
        if (threadIdx.x == 0) mu->n = __popcll(okm & 0xffffffffull);
    }
    __syncthreads();
}
struct EpiMoeUp {
    static constexpr bool GATHER_A = true;
    static constexpr int BHALF = 64;
    static DEVI int brow(int R) { return ((R >> 5) & 3) * 16 + (R & 15) + (((R >> 4) & 1) ? 1024 : 0); }
    const MoeMap8* mm; bf16* ACT; const float* bup; bf16* dump;
    DEVI void operator()(const f32x4 (&acc)[2][2][4][2], const pg8::Unit& u, int wr, int wc, int fr, int fq) const {
        const int e = u.x0, cnt = mm->cnt[e];
        const float* be = bup + (size_t)e * 2048;
        f32x4 bg[2], bl[2];
#pragma unroll
        for (int bj = 0; bj < 2; ++bj) { const int col = u.x2 * 128 + (bj * 4 + wc) * 16 + 4 * fq; bg[bj] = *(const f32x4*)(be + col); bl[bj] = *(const f32x4*)(be + 1024 + col); }
#pragma unroll
        for (int ai = 0; ai < 2; ++ai)
#pragma unroll
            for (int m = 0; m < 4; ++m) {
                const int r = u.x1 + ai * 128 + wr * 64 + m * 16 + fr;
                bf16* rowp = (r < cnt) ? ACT + (size_t)(u.x3 + r) * DFF + u.x2 * 128 + wc * 16 + 4 * fq : dump + 4 * fq;
#pragma unroll
                for (int bj = 0; bj < 2; ++bj) {
                    float o[4];
#pragma unroll
                    for (int j = 0; j < 4; ++j) {
                        const float glu = fminf(acc[ai][bj][m][0][j] + bg[bj][j], 7.f);
                        const float lin = fminf(fmaxf(acc[ai][bj][m][1][j] + bl[bj][j], -7.f), 7.f);
                        o[j] = glu * sigmoidf_(1.702f * glu) * (lin + 1.f);
                    }
                    *(u32x2*)(rowp + bj * 64) = (u32x2){pk2(o[0], o[1]), pk2(o[2], o[3])};
                }
            }
    }
};
struct EpiMoeDown {
    static constexpr bool GATHER_A = false; static constexpr int BHALF = 128; static DEVI int brow(int R) { return R; }
    const MoeMap8* mm; bf16* YB; const float* bdn; const int* LIST; const float* GATE; bf16* dump;
    DEVI void operator()(const f32x4 (&acc)[2][2][4][2], const pg8::Unit& u, int wr, int wc, int fr, int fq) const {
        const int e = u.x0, cnt = mm->cnt[e];
        const float* be = bdn + (size_t)e * D + u.x2 * 256 + wc * 32 + 4 * fq;
        f32x4 bv[2][2];
#pragma unroll
        for (int bj = 0; bj < 2; ++bj)
#pragma unroll
            for (int n = 0; n < 2; ++n) bv[bj][n] = *(const f32x4*)(be + bj * 128 + n * 16);
        int ent[8]; float gt[8];
#pragma unroll
        for (int q = 0; q < 8; ++q) { const int r = u.x1 + (q >> 2) * 128 + wr * 64 + (q & 3) * 16 + fr; ent[q] = LIST[(size_t)e * S + (r < cnt ? r : cnt - 1)]; }
#pragma unroll
        for (int q = 0; q < 8; ++q) gt[q] = GATE[ent[q]];
#pragma unroll
        for (int ai = 0; ai < 2; ++ai)
#pragma unroll
            for (int m = 0; m < 4; ++m) {
                const int q = ai * 4 + m, r = u.x1 + ai * 128 + wr * 64 + m * 16 + fr;
                bf16* rowp = (r < cnt) ? YB + (size_t)ent[q] * D + u.x2 * 256 + wc * 32 + 4 * fq : dump + 4 * fq;
#pragma unroll
                for (int bj = 0; bj < 2; ++bj)
#pragma unroll
                    for (int n = 0; n < 2; ++n) {
                        const f32x4 v = (acc[ai][bj][m][n] + bv[bj][n]) * gt[q];
                        *(u32x2*)(rowp + bj * 128 + n * 16) = (u32x2){pk2(v.x, v.y), pk2(v.z, v.w)};
                    }
            }
    }
};
DEVI void phase_moe_up8(const P& p, int l, char* smem_all) {
    MoeMap8* mm = (MoeMap8*)(smem_all + 131072);
    moe_map8(p, l, mm);
    MoeUnits* mu = (MoeUnits*)(smem_all + 131072 + 512);
    moe_units(mm, mu, 3, 3);
    int* rowtab = (int*)(smem_all + 131072 + 1024);
    {
        const int* LIST = (const int*)(p.ws + WS_LIST);
        const int nu = mu->n < 12 ? mu->n : 12;
        for (int idx = threadIdx.x; idx < nu * 256; idx += KT) {
            const int i = idx >> 8, r = idx & 255, e = mu->e[i], cnt = mm->cnt[e], rr = mu->m0[i] + r;
            rowtab[idx] = LIST[(size_t)e * S + (rr < cnt ? rr : cnt - 1)] >> 2;
        }
        __syncthreads();
    }
    SchedMoe Sm{mm, mu, (const char*)(p.ws + WS_H2), (const char*)(p.ws + WS_WUP) + (size_t)l * NEXP * 2048 * D * 2, D, (size_t)2048 * D * 2, (size_t)128 * D * 2, rowtab, true};
    EpiMoeUp E{mm, (bf16*)(p.ws + WS_ACT), p.in[33] + (size_t)l * NEXP * 2048, (bf16*)(p.ws + WS_DUMP)};
    pg8::gemm_phase((LAS unsigned char*)smem_all, D, Sm, E);
}
DEVI void phase_moe_down8(const P& p, int l, char* smem_all) {
    MoeMap8* mm = (MoeMap8*)(smem_all + 131072);
    moe_map8(p, l, mm);
    MoeUnits* mu = (MoeUnits*)(smem_all + 131072 + 512);
    moe_units(mm, mu, 2, 2);
    SchedMoe Sm{mm, mu, (const char*)(p.ws + WS_ACT), (const char*)(p.ws + WS_WDN) + (size_t)l * NEXP * D * DFF * 2, DFF, (size_t)D * DFF * 2, (size_t)256 * DFF * 2, nullptr, false};
    EpiMoeDown E{mm, (bf16*)(p.ws + WS_YB), p.in[35] + (size_t)l * NEXP * D, (const int*)(p.ws + WS_LIST), (const float*)(p.ws + WS_GATE), (bf16*)(p.ws + WS_DUMP)};
    pg8::gemm_phase((LAS unsigned char*)smem_all, DFF, Sm, E);
}

constexpr int NPHASE = 24;
constexpr int LDS_TOTAL = 2 * VB_LDS + 64;
__global__ void __launch_bounds__(KT, 2) k_run(P p) {
    extern __shared__ __attribute__((aligned(16))) char smem_all[];
    char* smem = smem_all + __builtin_amdgcn_readfirstlane((int)(threadIdx.x >> 8)) * VB_LDS;
    XcdBarrier bar; bar.bar = nullptr; bar.x = 0; bar.st = nullptr;
    const bool multi = (p.ph_hi - p.ph_lo) > 1;
    if (multi) {
        volatile LAS unsigned* st = (volatile LAS unsigned*)(smem_all + 2 * VB_LDS);
        if (threadIdx.x == 0) { st[0] = 0u; st[1] = 0u; }
        __syncthreads();
        bar = xcd_barrier_post((unsigned*)(p.ws + OFF_BAR), st);
    }
#ifndef DUP
#define DUP -1
#endif
#ifndef DUP2
#define DUP2 -1
#endif
#define RUN(k, call) if (p.ph_lo <= (k) && (k) < p.ph_hi) { for (int _rep = ((k) == DUP || (k) == DUP2) ? 2 : 1; _rep > 0; --_rep) { call; if (multi && ((k) + 1 < p.ph_hi || _rep > 1)) xcd_barrier(bar); } }
    RUN(0, phase_prep(p, smem))
    RUN(1, phase_h0(p))
    RUN(2, { phase_inproj8(p, 0, smem_all); phase_inproj_extras(p, 0, smem); })
    RUN(3, phase_mixprep(p, 0, smem))
    RUN(4, phase_chunkA(p, smem))
    RUN(5, phase_scanL1(p, smem))
    RUN(6, phase_scanL2(p, 0, smem))
    RUN(7, phase_chunkC(p, 0, smem))
    RUN(8, phase_outproj8(p, 0, smem_all))
    RUN(9, phase_ln1_route(p, 0, smem, _rep == 1))
    RUN(10, phase_moe_up8(p, 0, smem_all))
    RUN(11, phase_moe_down8(p, 0, smem_all))
    RUN(12, phase_ln2(p, 0))
    RUN(13, { phase_inproj8(p, 1, smem_all); phase_inproj_extras(p, 1, smem); })
    RUN(14, phase_mixprep(p, 1, smem))
    RUN(15, phase_chunkA(p, smem))
    RUN(16, phase_scanL1(p, smem))
    RUN(17, phase_scanL2(p, 1, smem))
    RUN(18, phase_chunkC(p, 1, smem))
    RUN(19, phase_outproj8(p, 1, smem_all))
    RUN(20, phase_ln1_route(p, 1, smem))
    RUN(21, phase_moe_up8(p, 1, smem_all))
    RUN(22, phase_moe_down8(p, 1, smem_all))
    RUN(23, phase_ln2(p, 1))
#undef RUN
}

extern "C" void kernel_launch(void* const* d_in, const int* in_sizes, int n_in, void* d_out, int out_size, void* d_ws, size_t ws_size,
                              hipStream_t stream) {
    static int grid = 0;
    if (grid == 0) {
        if (n_in != 38 || ws_size < WS_END) { fprintf(stderr, "kernel_launch: unexpected n_in %d or ws_size %zu (< %zu)\n", n_in, ws_size, (size_t)WS_END); grid = -1; return; }
        int dev = 0, cus = 0, per_cu = 0;
        hipGetDevice(&dev);
        hipDeviceGetAttribute(&cus, hipDeviceAttributeMultiprocessorCount, dev);
        hipFuncSetAttribute((const void*)k_run, hipFuncAttributeMaxDynamicSharedMemorySize, LDS_TOTAL);
        hipOccupancyMaxActiveBlocksPerMultiprocessor(&per_cu, (const void*)k_run, KT, LDS_TOTAL);
        if (per_cu < 1) { fprintf(stderr, "kernel_launch: occupancy query returned %d\n", per_cu); grid = -1; return; }
        if (cus != 256) { fprintf(stderr, "kernel_launch: built for 256 CUs (one workgroup per CU), device has %d\n", cus); grid = -1; return; }
        grid = cus;
    }
    if (grid < 0) return;
    hipMemsetAsync((char*)d_ws + WS_CTL, 0, CTL_BYTES, stream);
    P p{};
    for (int i = 0; i < 38; ++i) p.in[i] = (const float*)d_in[i];
    p.pos = (const int*)d_in[2];
    p.out = (float*)d_out; p.ws = (char*)d_ws;
#if MEGA
    p.ph_lo = 0; p.ph_hi = NPHASE;
    void* args[] = {&p};
    hipError_t e = hipLaunchCooperativeKernel((const void*)k_run, dim3(grid), dim3(KT), args, LDS_TOTAL, stream);
    if (e != hipSuccess) fprintf(stderr, "cooperative launch failed: %s (grid %d)\n", hipGetErrorString(e), grid);
#else
    for (int ph = 0; ph < NPHASE; ++ph) {
        p.ph_lo = ph; p.ph_hi = ph + 1;
        hipLaunchKernelGGL(k_run, dim3(grid), dim3(KT), LDS_TOTAL, stream, p);
    }
#endif
}
```

```cpp
#include <hip/hip_runtime.h>
#include <hip/hip_bf16.h>
#include <stdint.h>
#include <stdio.h>

#ifndef MEGA
#define MEGA 1
#endif

#define DEVI __device__ __forceinline__
#define LAS __attribute__((address_space(3)))

typedef unsigned short bf16;
typedef short bf16x8 __attribute__((ext_vector_type(8)));
typedef float f32x4 __attribute__((ext_vector_type(4)));
typedef unsigned u32x4 __attribute__((ext_vector_type(4)));
typedef unsigned u32x2 __attribute__((ext_vector_type(2)));

constexpr int S = 16384, D = 1024, NIN = 4104, NEXP = 32, DFF = 1024;
constexpr int NPROJ = 4096;
constexpr int NPAD = 4352;
constexpr float DN_ALPHA = 1.4142135623730951f;
constexpr int NT = 256;
constexpr int LDS_BYTES = 76032;

constexpr size_t MiB = 1ull << 20;
constexpr size_t WS_CTL = 0;
constexpr size_t CTL_BYTES = 1 * MiB;
constexpr size_t OFF_BAR = 0;
constexpr size_t OFF_ADA = 64 * 1024;
constexpr size_t OFF_CNT = 128 * 1024;
constexpr size_t WS_ROT = 1 * MiB;
constexpr size_t WS_WIN = WS_ROT + (size_t)S * 64 * 4;
constexpr size_t WS_WOUT = WS_WIN + 2ull * NPAD * D * 2;
constexpr size_t WS_WUP = WS_WOUT + 2ull * D * D * 2;
constexpr size_t WS_WDN = WS_WUP + 2ull * NEXP * 2048 * D * 2;
constexpr size_t WS_HB = WS_WDN + 2ull * NEXP * D * DFF * 2;
constexpr size_t WS_PROJ = WS_HB + (size_t)S * D * 2;
constexpr size_t WS_PEX = WS_PROJ + (size_t)S * NPROJ * 2;
constexpr size_t WS_VFIRST = WS_PEX + (size_t)S * 64 * 4;
constexpr size_t WS_RECR = WS_VFIRST + (size_t)S * 256 * 4;
constexpr size_t WS_RECG = WS_RECR + (size_t)S * 4 * 384 * 2;
constexpr size_t WS_RECT = WS_RECG + (size_t)S * 4 * 392 * 2;
constexpr size_t WS_WDEC = WS_RECT + (size_t)S * 4 * 192 * 2;
constexpr size_t WS_GSC = WS_WDEC + (size_t)S * 256 * 4;
constexpr size_t WS_G = WS_GSC + (size_t)S * 16 * 4;
constexpr size_t WS_BON = WS_G + (size_t)S * 256 * 4;
constexpr size_t WS_YR = WS_BON + (size_t)S * 4 * 4;
constexpr size_t WS_OG = WS_YR + (size_t)S * 256 * 4;
constexpr size_t WS_ORT = WS_OG + (size_t)S * 512 * 4;
constexpr size_t WS_MIX = WS_ORT + (size_t)S * 256 * 4;
constexpr size_t WS_OPRE = WS_MIX + (size_t)S * D * 2;
constexpr size_t WS_X = WS_OPRE + (size_t)S * D * 4;
constexpr size_t WS_H2 = WS_X + (size_t)S * D * 4;
constexpr size_t WS_LIST = WS_H2 + (size_t)S * D * 2;
constexpr size_t WS_GATE = WS_LIST + (size_t)NEXP * S * 4;
constexpr size_t WS_ACT = WS_GATE + (size_t)S * 4 * 4;
constexpr size_t WS_YB = WS_ACT + ((size_t)S * 4 + 256) * DFF * 2;
constexpr size_t WS_ADAP = WS_YB + (size_t)S * 4 * D * 2;
constexpr size_t WS_RKV = WS_ADAP + 16ull * 12288 * 4;
constexpr size_t WS_RST = WS_RKV + 256ull * 4 * 4096 * 4;
constexpr size_t WS_GP = WS_RST + 256ull * 4 * 4096 * 2;
constexpr size_t WS_GB = WS_GP + 1024ull * 16384 * 2;
constexpr size_t WS_GD = WS_GB + 1024ull * 16384 * 4;
constexpr size_t WS_GQ = WS_GD + 4096;
constexpr size_t WS_GO = WS_GQ + 1024ull * 8192 * 2;
constexpr size_t WS_GS = WS_GO + 1024ull * 8192 * 4;
constexpr size_t WS_WP = WS_GS + 1024ull * 16384 * 2;
constexpr size_t WS_WC = WS_WP + 2048ull * 4096 * 2;
constexpr size_t WS_WD = WS_WC + 2048ull * 4096 * 4;
constexpr size_t WS_WQ = WS_WD + 2048ull * 64 * 4;
constexpr size_t WS_WY = WS_WQ + 2048ull * 2048 * 2;
constexpr size_t WS_WS = WS_WY + 2048ull * 2048 * 4;
constexpr size_t WS_GR = WS_WS + 2048ull * 4096 * 2;
constexpr size_t WS_GE0 = WS_GR + 1024ull * 8192 * 2;
constexpr size_t WS_GTE = WS_GE0 + 64ull * 16384 * 4;
constexpr size_t WS_GSG = WS_GTE + 64ull * 16384 * 2;
constexpr size_t WS_WR = WS_GSG + 64ull * 16384 * 2;
constexpr size_t WS_WE0 = WS_WR + 2048ull * 2048 * 2;
constexpr size_t WS_WTE = WS_WE0 + 64ull * 4096 * 4;
constexpr size_t WS_WSG = WS_WTE + 64ull * 4096 * 2;
constexpr size_t WS_LRT = WS_WSG + 64ull * 4096 * 2;
constexpr size_t WS_DUMP = WS_LRT + 2ull * 73728 * 2;
constexpr size_t WS_RWF = WS_DUMP + 4096;
constexpr size_t WS_END = WS_RWF + 2ull * 32 * 2 * 2 * 64 * 16;

struct P {
    const float* in[38];
    const int* pos;
    float* out;
    char* ws;
    int ph_lo, ph_hi;
};

DEVI float bf2f(bf16 v) { return __uint_as_float(((unsigned)v) << 16); }
DEVI unsigned f2bf(float f) { unsigned u = __float_as_uint(f); return (u + 0x7fffu + ((u >> 16) & 1u)) >> 16; }
typedef float f32x2_t __attribute__((ext_vector_type(2)));
typedef __bf16 bf16x2_t __attribute__((ext_vector_type(2)));
DEVI unsigned pk2(float lo, float hi) { const f32x2_t v = {lo, hi}; return __builtin_bit_cast(unsigned, __builtin_convertvector(v, bf16x2_t)); }
DEVI float sigmoidf_(float x) { return __builtin_amdgcn_rcpf(1.f + __builtin_amdgcn_exp2f(-1.4426950408889634f * x)); }
DEVI float siluf_(float x) { return x * sigmoidf_(x); }
DEVI float softplusf_(float x) { return fmaxf(x, 0.f) + log1pf(__expf(-fabsf(x))); }
DEVI float wave_sum(float v) {
#pragma unroll
    for (int o = 32; o >= 1; o >>= 1) v += __shfl_xor(v, o);
    return v;
}
template <int CTRL> DEVI float dpp_mov(float x) {
    return __int_as_float(__builtin_amdgcn_update_dpp(0, __float_as_int(x), CTRL, 0xf, 0xf, false));
}
DEVI float row16_sum(float x) {
    x += dpp_mov<0x128>(x);
    x += dpp_mov<0x124>(x);
    x += dpp_mov<0x122>(x);
    x += dpp_mov<0x121>(x);
    return x;
}

DEVI bf16x8 ldfrag(const bf16* base, int ld, int row0, int k0, int lane) {
    return *(const bf16x8*)(base + (row0 + (lane & 15)) * ld + k0 + (lane >> 4) * 8);
}
DEVI f32x4 ld_bf4(const bf16* p) {
    const u32x2 v = *(const u32x2*)p;
    return (f32x4){__uint_as_float(v.x << 16), __uint_as_float(v.x & 0xffff0000u), __uint_as_float(v.y << 16), __uint_as_float(v.y & 0xffff0000u)};
}
DEVI void st_bf4(bf16* p, const f32x4& v) { *(u32x2*)p = (u32x2){pk2(v.x, v.y), pk2(v.z, v.w)}; }
DEVI float quad_sum(float v) { v += __shfl_xor(v, 16); v += __shfl_xor(v, 32); return v; }
DEVI f32x4 mfma16(bf16x8 a, bf16x8 b, f32x4 c) { return __builtin_amdgcn_mfma_f32_16x16x32_bf16(a, b, c, 0, 0, 0); }

#define VTID ((int)(threadIdx.x & 255))
#define VBID ((int)(blockIdx.x * 2 + __builtin_amdgcn_readfirstlane((int)(threadIdx.x >> 8))))
#define VNB ((int)(gridDim.x * 2))
constexpr int VB_LDS = 76032;
constexpr int KT = 512;

#define XB_TMO      128
#define XB_XCNT(j)  (256  + 64 * (j))
#define XB_XSUB(j)  (1280 + 64 * (j))
#define XB_XGEN(j)  (2304 + 64 * (j))
#define XB_TOP      3328
#define XB_TOPGEN   3392
#define XCD_BAR_WORDS 3456
#define XB_SPIN_CAP (1u << 22)
DEVI unsigned xb_ld(unsigned* p) { return __hip_atomic_load(p, __ATOMIC_RELAXED, __HIP_MEMORY_SCOPE_AGENT); }
DEVI unsigned xb_add(unsigned* p, unsigned v) { return __hip_atomic_fetch_add(p, v, __ATOMIC_RELAXED, __HIP_MEMORY_SCOPE_AGENT); }
DEVI unsigned xb_xcc_id() { return (unsigned)__builtin_amdgcn_s_getreg((3 << 11) | 20) & 0xFu; }
#define XB_SPIN(cond, bar) do { unsigned _sp = 0; while (cond) { __builtin_amdgcn_s_sleep(1); \
    if ((++_sp & 255u) == 0u) { if (xb_ld(&(bar)[XB_TMO])) break; if (_sp > XB_SPIN_CAP) { atomicAdd(&(bar)[XB_TMO], 1u); break; } } } } while (0)
struct XcdBarrier { unsigned* bar; unsigned x; volatile LAS unsigned* st; };
DEVI XcdBarrier xcd_barrier_post(unsigned* bar, volatile LAS unsigned* st) {
    XcdBarrier b; b.bar = bar; b.x = xb_xcc_id(); b.st = st;
    if (threadIdx.x == 0) (void)xb_add(&bar[XB_XCNT(b.x)], 1u);
    return b;
}
DEVI void xcd_barrier_complete(unsigned* bar, unsigned x, unsigned& nloc, unsigned& nx) {
    const unsigned G = gridDim.x * gridDim.y * gridDim.z;
    unsigned sum, cnt, mine, sp = 0u;
    for (;;) {
        sum = 0u; cnt = 0u; mine = 0u;
#pragma unroll
        for (unsigned j = 0; j < 16; ++j) { const unsigned c = xb_ld(&bar[XB_XCNT(j)]); sum += c; cnt += (c > 0u) ? 1u : 0u; mine = (j == x) ? c : mine; }
        if (sum == G) break;
        __builtin_amdgcn_s_sleep(1);
        if ((++sp & 255u) == 0u) { if (xb_ld(&bar[XB_TMO])) break; if (sp > XB_SPIN_CAP) { atomicAdd(&bar[XB_TMO], 1u); break; } }
    }
    nloc = mine > 0u ? mine : 1u; nx = cnt > 0u ? cnt : 1u;
}
DEVI void xcd_barrier(const XcdBarrier& b) {
    asm volatile("s_waitcnt vmcnt(0)" ::: "memory");
    __syncthreads();
    if (threadIdx.x == 0) {
        unsigned* bar = b.bar;
        __builtin_amdgcn_s_waitcnt(0);
        unsigned nloc = b.st[0], nx = b.st[1];
        if (nloc == 0u) { xcd_barrier_complete(bar, b.x, nloc, nx); b.st[0] = nloc; b.st[1] = nx; }
        const unsigned old = xb_add(&bar[XB_XSUB(b.x)], 1u);
        const unsigned gen = old / nloc;
        if (old + 1u == (gen + 1u) * nloc) {
            __builtin_amdgcn_fence(__ATOMIC_RELEASE, "agent");
            asm volatile("s_waitcnt vmcnt(0)" ::: "memory");
            const unsigned og = xb_add(&bar[XB_TOP], 1u);
            const unsigned tg = og / nx;
            if (og + 1u == (tg + 1u) * nx) xb_add(&bar[XB_TOPGEN], 1u);
            else XB_SPIN(xb_ld(&bar[XB_TOPGEN]) == tg, bar);
            __builtin_amdgcn_fence(__ATOMIC_ACQUIRE, "agent");
            xb_add(&bar[XB_XGEN(b.x)], 1u);
            asm volatile("s_waitcnt vmcnt(0)" ::: "memory");
        } else {
            XB_SPIN(xb_ld(&bar[XB_XGEN(b.x)]) == gen, bar);
            __builtin_amdgcn_fence(__ATOMIC_ACQUIRE, "agent");
            asm volatile("s_waitcnt vmcnt(0)" ::: "memory");
        }
    }
    __syncthreads();
}

DEVI void transpose_item(const float* __restrict__ src, size_t ld, int k0, int ns0, bf16* __restrict__ dst, int kd, int nd0, float* lds) {
    const int tid = VTID;
    float tv[32];
#pragma unroll
    for (int i = 0; i < 32; ++i) tv[i] = __builtin_nontemporal_load(&src[(size_t)(k0 + i * 4 + (tid >> 6)) * ld + ns0 + (tid & 63)]);
    asm volatile("" ::: "memory");
#pragma unroll
    for (int i = 0; i < 32; ++i) lds[(i * 4 + (tid >> 6)) * 65 + (tid & 63)] = tv[i];
    __syncthreads();
#pragma unroll
    for (int i = 0; i < 4; ++i) {
        const int q = tid + 256 * i, n = q >> 4, kc = q & 15;
        const float* s = lds + (kc * 8) * 65 + n;
        u32x4 o;
        o.x = pk2(s[0 * 65], s[1 * 65]); o.y = pk2(s[2 * 65], s[3 * 65]);
        o.z = pk2(s[4 * 65], s[5 * 65]); o.w = pk2(s[6 * 65], s[7 * 65]);
        *(u32x4*)(dst + (size_t)(nd0 + n) * kd + k0 + kc * 8) = o;
    }
    __syncthreads();
}

DEVI void phase_prep(const P& p, char* smem) {
    float* lds = (float*)smem;
    const int tid = VTID;
    const int nb = VNB, bid = VBID;
    bf16* WIN = (bf16*)(p.ws + WS_WIN); bf16* WOUT = (bf16*)(p.ws + WS_WOUT);
    bf16* WUP = (bf16*)(p.ws + WS_WUP); bf16* WDN = (bf16*)(p.ws + WS_WDN);
    constexpr int I_UP = 2 * NEXP * 8 * 32;
    constexpr int I_DN = 2 * NEXP * 8 * 16;
    constexpr int I_IN = 2 * 8 * 64;
    constexpr int I_OUT = 2 * 8 * 16;
    constexpr int I_EX = 2 * 256;
    constexpr int I_ADA = 2 * 24 * 16;
    constexpr int I_ROT = S * 32 / 256;
    constexpr int I_LR = 2 * 288;
    constexpr int I_RW = 2 * 16;
    constexpr int NITEMS = I_UP + I_DN + I_IN + I_OUT + I_EX + I_ADA + I_ROT + I_LR + I_RW;
    constexpr int I_TR = I_UP + I_DN + I_IN + I_OUT;
    static_assert((I_TR % 512) % 2 == 0, "the two halves of every workgroup must run the same number of transpose items (they contain barriers)");
    for (int it = bid; it < NITEMS; it += nb) {
        int r = it;
        if (r < I_UP) {
            const int le = r / 256, q = r % 256, kt = q / 32, nt = q % 32;
            transpose_item(p.in[32] + (size_t)le * D * 2048, 2048, kt * 128, nt * 64, WUP + (size_t)le * 2048 * D, D, nt * 64, lds);
            continue;
        }
        r -= I_UP;
        if (r < I_DN) {
            const int le = r / 128, q = r % 128, kt = q / 16, nt = q % 16;
            transpose_item(p.in[34] + (size_t)le * DFF * D, D, kt * 128, nt * 64, WDN + (size_t)le * D * DFF, DFF, nt * 64, lds);
            continue;
        }
        r -= I_DN;
        if (r < I_IN) {
            const int l = r / 512, q = r % 512, kt = q / 64, nt = q % 64;
            const int nd0 = nt * 64, ns0 = nd0 < 3072 ? nd0 : nd0 + 8;
            transpose_item(p.in[5] + (size_t)l * D * NIN, NIN, kt * 128, ns0, WIN + (size_t)l * NPAD * D, D, nd0, lds);
            continue;
        }
        r -= I_IN;
        if (r < I_OUT) {
            const int l = r / 128, q = r % 128, kt = q / 16, nt = q % 16;
            transpose_item(p.in[27] + (size_t)l * D * D, D, kt * 128, nt * 64, WOUT + (size_t)l * D * D, D, nt * 64, lds);
            continue;
        }
        r -= I_OUT;
        if (r < I_EX) {
            const int l = r / 256, n = r % 256;
            bf16* dst = WIN + ((size_t)l * NPAD + NPROJ + n) * D;
            for (int k = tid; k < D; k += NT) {
                float v = 0.f;
                if (n < 8) v = p.in[5][(size_t)l * D * NIN + (size_t)k * NIN + 3072 + n];
                else if (n < 40 && l == 1) v = p.in[6][(size_t)k * 32 + (n - 8)];
                dst[k] = (bf16)f2bf(v);
            }
            continue;
        }
        r -= I_EX;
        if (r < I_ADA) {
            const int l = r / 384, q = r % 384, nc = q / 16, kc = q % 16;
            const int n = nc * 256 + tid;
            const float* W = p.in[3] + (size_t)l * D * 6144;
            float acc = (kc == 0) ? p.in[4][l * 6144 + n] : 0.f;
            for (int k = kc * 64; k < kc * 64 + 64; ++k) acc += siluf_(p.in[1][k]) * W[(size_t)k * 6144 + n];
            ((float*)(p.ws + WS_ADAP))[(size_t)kc * 12288 + l * 6144 + n] = acc;
            continue;
        }
        r -= I_ADA;
        if (r >= I_ROT + I_LR) {
            r -= I_ROT + I_LR;
            const int l = r >> 4, idx = (r & 15) * 256 + tid, kk = idx >> 7, n = (idx >> 6) & 1, ln = idx & 63;
            const float* rw = p.in[30] + (size_t)l * D * 32 + (size_t)(32 * kk + 8 * (ln >> 4)) * 32 + 16 * n + (ln & 15);
            unsigned hi[4], lo[4];
#pragma unroll
            for (int q = 0; q < 4; ++q) {
                const float a = rw[(2 * q) * 32], b = rw[(2 * q + 1) * 32];
                hi[q] = pk2(a, b);
                lo[q] = pk2(a - __uint_as_float(hi[q] << 16), b - __uint_as_float(hi[q] & 0xffff0000u));
            }
            u32x4* dst = (u32x4*)(p.ws + WS_RWF) + ((size_t)((l * 32 + kk) * 2 + n) * 2) * 64 + ln;
            dst[0] = (u32x4){hi[0], hi[1], hi[2], hi[3]}; dst[64] = (u32x4){lo[0], lo[1], lo[2], lo[3]};
            continue;
        }
        if (r >= I_ROT) {
            r -= I_ROT;
            const int l = r / 288, kk = r % 288, c = tid;
            bf16* LRT = (bf16*)(p.ws + WS_LRT) + (size_t)l * 73728;
            if (kk < 64) LRT[c * 64 + kk] = (bf16)f2bf(p.in[10][(l * 64 + kk) * 256 + c]);
            else if (kk < 128) LRT[16384 + c * 64 + (kk - 64)] = (bf16)f2bf(p.in[12][(l * 64 + kk - 64) * 256 + c]);
            else if (kk < 256) LRT[32768 + c * 128 + (kk - 128)] = (bf16)f2bf(p.in[13][(l * 128 + kk - 128) * 256 + c]);
            else LRT[65536 + c * 32 + (kk - 256)] = (bf16)f2bf(l == 1 ? p.in[20][(kk - 256) * 256 + c] : 0.f);
            continue;
        }
        {
            const int idx = r * 256 + tid;
            const int t = idx >> 5, i = idx & 31;
            const float invf = (float)pow(10000.0, -(double)i / 32.0);
            const float ang = (float)p.pos[t] * invf;
            float sn, cs; sincosf(ang, &sn, &cs);
            float* ROT = (float*)(p.ws + WS_ROT);
            ROT[(size_t)idx * 2] = cs; ROT[(size_t)idx * 2 + 1] = sn;
        }
    }
}

DEVI float ada_sum(const float* ADAP, int idx) {
    float s = 0.f;
#pragma unroll
    for (int kc = 0; kc < 16; ++kc) s += ADAP[(size_t)kc * 12288 + idx];
    return s;
}
DEVI void phase_h0(const P& p) {
    const float* ADAP = (const float*)(p.ws + WS_ADAP);
    float* ADA = (float*)(p.ws + OFF_ADA);
    bf16* HB = (bf16*)(p.ws + WS_HB);
    if (VBID < 48) ADA[VBID * 256 + VTID] = ada_sum(ADAP, VBID * 256 + VTID);
    const size_t n4 = (size_t)S * D / 4;
    const int c = (int)(((size_t)VBID * NT + VTID) % (D / 4)) * 4;
    f32x4 sh, sc;
    sh.x = ada_sum(ADAP, c); sh.y = ada_sum(ADAP, c + 1); sh.z = ada_sum(ADAP, c + 2); sh.w = ada_sum(ADAP, c + 3);
    sc.x = ada_sum(ADAP, 1024 + c); sc.y = ada_sum(ADAP, 1025 + c); sc.z = ada_sum(ADAP, 1026 + c); sc.w = ada_sum(ADAP, 1027 + c);
    for (size_t i = (size_t)VBID * NT + VTID; i < n4; i += (size_t)VNB * NT) {
        const f32x4 x = ((const f32x4*)p.in[0])[i];
        u32x2 o;
        o.x = pk2(x.x * (1.f + sc.x) + sh.x, x.y * (1.f + sc.y) + sh.y);
        o.y = pk2(x.z * (1.f + sc.z) + sh.z, x.w * (1.f + sc.w) + sh.w);
        ((u32x2*)HB)[i] = o;
    }
}

template <class AF, class BF>
DEVI void gemm_tile(char* smem, const bf16* __restrict__ Abase, AF arow, const bf16* __restrict__ Bbase, BF brow, int K, f32x4 (&acc)[4][8]) {
    const int tid = VTID, wid = tid >> 6, lane = tid & 63, wr = wid >> 1, wc = wid & 1, fr = lane & 15, fq = lane >> 4;
    const int r0 = tid >> 2;
    const int swz = ((tid & 3) ^ ((0x1320 >> (4 * ((tid >> 4) & 3))) & 3)) * 8;
    unsigned pa[2], pb[4];
#pragma unroll
    for (int i = 0; i < 2; ++i) pa[i] = arow(r0 + 64 * i) + swz;
#pragma unroll
    for (int i = 0; i < 4; ++i) pb[i] = brow(r0 + 64 * i) + swz;
#pragma unroll
    for (int m = 0; m < 4; ++m)
#pragma unroll
        for (int n = 0; n < 8; ++n) acc[m][n] = (f32x4){0.f, 0.f, 0.f, 0.f};
    const int nk = K / 32;
    const int ch = (fq ^ ((0x1320 >> (4 * ((fr >> 2) & 3))) & 3)) * 16;
#define GT_STAGE(kt) do { char* _sa = smem + ((kt) % 3) * 24576; char* _sb = _sa + 8192; \
        _Pragma("unroll") for (int _i = 0; _i < 2; ++_i) \
            __builtin_amdgcn_global_load_lds((const unsigned*)(Abase + pa[_i] + (kt) * 32), (unsigned*)(_sa + (tid + 256 * _i) * 16), 16, 0, 0); \
        _Pragma("unroll") for (int _i = 0; _i < 4; ++_i) \
            __builtin_amdgcn_global_load_lds((const unsigned*)(Bbase + pb[_i] + (kt) * 32), (unsigned*)(_sb + (tid + 256 * _i) * 16), 16, 0, 0); } while (0)
    asm volatile("s_waitcnt vmcnt(0)" ::: "memory");
    GT_STAGE(0); GT_STAGE(1);
    for (int kt = 0; kt < nk; ++kt) {
        if (kt + 1 < nk) asm volatile("s_waitcnt vmcnt(6)" ::: "memory");
        else asm volatile("s_waitcnt vmcnt(0)" ::: "memory");
        asm volatile("s_waitcnt lgkmcnt(0)" ::: "memory");
        __builtin_amdgcn_s_barrier();
        if (kt + 2 < nk) GT_STAGE(kt + 2);
        const char* SA = smem + (kt % 3) * 24576; const char* SB = SA + 8192;
        bf16x8 af[4], bfr[8];
#pragma unroll
        for (int m = 0; m < 4; ++m) af[m] = *(const bf16x8*)(SA + (wr * 64 + m * 16 + fr) * 64 + ch);
#pragma unroll
        for (int n = 0; n < 8; ++n) bfr[n] = *(const bf16x8*)(SB + (wc * 128 + n * 16 + fr) * 64 + ch);
#pragma unroll
        for (int m = 0; m < 4; ++m)
#pragma unroll
            for (int n = 0; n < 8; ++n)
                acc[m][n] = __builtin_amdgcn_mfma_f32_16x16x32_bf16(bfr[n], af[m], acc[m][n], 0, 0, 0);
    }
    asm volatile("s_waitcnt lgkmcnt(0)" ::: "memory");
    __builtin_amdgcn_s_barrier();
#undef GT_STAGE
}

DEVI float proj_at(const bf16* PROJ, int t, int col) { return bf2f(PROJ[(size_t)t * NPROJ + col]); }
DEVI float proj_shift(const bf16* PROJ, int t, int col, float mu) {
    const float cur = proj_at(PROJ, t, col);
    const float prv = t > 0 ? proj_at(PROJ, t - 1, col) : 0.f;
    return cur + (prv - cur) * mu;
}

DEVI f32x4 shift4(const bf16* PROJ, int t, int col, const f32x4& mu) {
    const f32x4 cur = ld_bf4(PROJ + (size_t)t * NPROJ + col);
    f32x4 prv = ld_bf4(PROJ + (size_t)(t > 0 ? t - 1 : 0) * NPROJ + col);
    const float keep = t > 0 ? 1.f : 0.f;
    prv = prv * keep;
    return cur + (prv - cur) * mu;
}
DEVI float fsig(float x) { return sigmoidf_(x); }
DEVI void phase_mixprep(const P& p, int l, char* smem) {
    const bf16* PROJ = (const bf16*)(p.ws + WS_PROJ); const float* PEX = (const float*)(p.ws + WS_PEX);
    float* VFIRST = (float*)(p.ws + WS_VFIRST);
    bf16* RECR = (bf16*)(p.ws + WS_RECR); bf16* RECG = (bf16*)(p.ws + WS_RECG); bf16* RECT = (bf16*)(p.ws + WS_RECT);
    float* WDEC = (float*)(p.ws + WS_WDEC); float* GSC = (float*)(p.ws + WS_GSC);
    float* GB = (float*)(p.ws + WS_G); float* BON = (float*)(p.ws + WS_BON);
    const float* ROT = (const float*)(p.ws + WS_ROT);
    const bf16* LRT = (const bf16*)(p.ws + WS_LRT) + (size_t)l * 73728;
    bf16* L = (bf16*)smem;
    float* CW = (float*)(smem + 9728);
    float* MU = CW + 6144;
    float* PW0 = MU + 1024; float* PA0 = PW0 + 256; float* PKK = PA0 + 256; float* PKA = PKK + 256; float* PRK = PKA + 256; float* PV0 = PRK + 256;
    {
        const int tid = VTID;
        for (int i = tid; i < 6144; i += NT) CW[i] = p.in[21][l * 6144 + i];
        for (int i = tid; i < 1024; i += NT) MU[i] = p.in[7][l * 1024 + i];
        PW0[tid] = p.in[9][l * 256 + tid]; PA0[tid] = p.in[11][l * 256 + tid]; PKK[tid] = p.in[14][l * 256 + tid];
        PKA[tid] = p.in[15][l * 256 + tid]; PRK[tid] = p.in[16][l * 256 + tid]; PV0[tid] = (l == 1) ? p.in[19][tid] : 0.f;
    }
    __syncthreads();
    for (int item = VBID; item < S / 16; item += VNB) {
        int tid = VTID; asm volatile("" : "+v"(tid));
        const int lane = tid & 63, w = tid >> 6, fr = lane & 15, fq = lane >> 4;
        const int t0 = item * 16;
        {
            u32x2 cur[5], prv[5]; f32x4 xc[5], xp[5];
#pragma unroll
            for (int q = 0; q < 5; ++q) {
                const int g = tid + 256 * q, gg = g < 1152 ? g : 1151, tt = gg / 72, i4 = (gg % 72) * 4, t = t0 + tt, tp = t > 0 ? t - 1 : 0;
                const int ia = i4 < 256 ? i4 : 252, ib = i4 < 256 ? 0 : i4 - 256;
                cur[q] = *(const u32x2*)(PROJ + (size_t)t * NPROJ + 768 + ia); prv[q] = *(const u32x2*)(PROJ + (size_t)tp * NPROJ + 768 + ia);
                xc[q] = *(const f32x4*)(PEX + (size_t)t * 64 + 8 + ib); xp[q] = *(const f32x4*)(PEX + (size_t)tp * 64 + 8 + ib);
            }
            asm volatile("" ::: "memory");
#pragma unroll
            for (int q = 0; q < 5; ++q) {
                const int g = tid + 256 * q, gg = g < 1152 ? g : 1151, tt = gg / 72, i4 = (gg % 72) * 4, t = t0 + tt;
                const float keep = t > 0 ? 1.f : 0.f;
                f32x4 v;
                if (i4 < 256) {
                    const f32x4 c4 = {__uint_as_float(cur[q].x << 16), __uint_as_float(cur[q].x & 0xffff0000u), __uint_as_float(cur[q].y << 16), __uint_as_float(cur[q].y & 0xffff0000u)};
                    const f32x4 p4 = (f32x4){__uint_as_float(prv[q].x << 16), __uint_as_float(prv[q].x & 0xffff0000u), __uint_as_float(prv[q].y << 16), __uint_as_float(prv[q].y & 0xffff0000u)} * keep;
                    v = c4 + (p4 - c4) * *(const f32x4*)(MU + 768 + i4);
                    if (i4 < 64) { v.x = tanhf(v.x); v.y = tanhf(v.y); v.z = tanhf(v.z); v.w = tanhf(v.w); }
                    else if (i4 >= 128) { v.x = fsig(v.x); v.y = fsig(v.y); v.z = fsig(v.z); v.w = fsig(v.w); }
                } else {
                    v = (f32x4){0.f, 0.f, 0.f, 0.f};
                    if (l == 1) v = xc[q] + (xp[q] * keep - xc[q]) * *(const f32x4*)(p.in[8] + (i4 - 256));
                }
                if (g < 1152) *(u32x2*)(L + tt * 296 + i4) = (u32x2){pk2(v.x, v.y), pk2(v.z, v.w)};
            }
        }
        __syncthreads();
        const int t = t0 + fr, h = w, tpv = t > 0 ? t - 1 : 0;
        const float keep = t > 0 ? 1.f : 0.f;
        {
            f32x4 aw[4], aa[4], ag[4], av[4];
#pragma unroll
            for (int i = 0; i < 4; ++i) { aw[i] = (f32x4){0.f, 0.f, 0.f, 0.f}; aa[i] = aw[i]; ag[i] = aw[i]; av[i] = aw[i]; }
            bf16x8 lf[9];
#pragma unroll
            for (int ks = 0; ks < 9; ++ks) lf[ks] = *(const bf16x8*)(L + fr * 296 + ks * 32 + fq * 8);
#pragma unroll
            for (int i = 0; i < 4; ++i) {
                const int c = 64 * h + 16 * i + fr;
#pragma unroll
                for (int ks = 0; ks < 2; ++ks) aw[i] = mfma16(*(const bf16x8*)(LRT + c * 64 + ks * 32 + fq * 8), lf[ks], aw[i]);
#pragma unroll
                for (int ks = 0; ks < 2; ++ks) aa[i] = mfma16(*(const bf16x8*)(LRT + 16384 + c * 64 + ks * 32 + fq * 8), lf[2 + ks], aa[i]);
#pragma unroll
                for (int ks = 0; ks < 4; ++ks) ag[i] = mfma16(*(const bf16x8*)(LRT + 32768 + c * 128 + ks * 32 + fq * 8), lf[4 + ks], ag[i]);
                if (l == 1) av[i] = mfma16(*(const bf16x8*)(LRT + 65536 + c * 32 + fq * 8), lf[8], av[i]);
            }
            bf16* rec = RECR + ((size_t)t * 4 + h) * 384;
            f32x4 kx[4], as_[4];
            float ss = 0.f, bsum = 0.f;
#define UNPK4(u) ((f32x4){__uint_as_float((u).x << 16), __uint_as_float((u).x & 0xffff0000u), __uint_as_float((u).y << 16), __uint_as_float((u).y & 0xffff0000u)})
            u32x2 rc[4], rp[4], kc[4], kp[4], vc[4], vp[4]; f32x4 vf4[4];
#pragma unroll
            for (int i = 0; i < 4; ++i) {
                const int j = 16 * i + 4 * fq, c = 64 * h + j;
                if ((i & 1) == 0) {
#pragma unroll
                    for (int i2 = i; i2 < i + 2; ++i2) {
                        const int c2 = 64 * h + 16 * i2 + 4 * fq;
                        rc[i2] = *(const u32x2*)(PROJ + (size_t)t * NPROJ + c2); rp[i2] = *(const u32x2*)(PROJ + (size_t)tpv * NPROJ + c2);
                        kc[i2] = *(const u32x2*)(PROJ + (size_t)t * NPROJ + 256 + c2); kp[i2] = *(const u32x2*)(PROJ + (size_t)tpv * NPROJ + 256 + c2);
                        vc[i2] = *(const u32x2*)(PROJ + (size_t)t * NPROJ + 512 + c2); vp[i2] = *(const u32x2*)(PROJ + (size_t)tpv * NPROJ + 512 + c2);
                        if (l == 1) vf4[i2] = *(const f32x4*)(VFIRST + (size_t)t * 256 + c2);
                    }
                    asm volatile("" ::: "memory");
                }
                const f32x4 r0 = UNPK4(rc[i]), k0 = UNPK4(kc[i]), v0_ = UNPK4(vc[i]);
                const f32x4 r = r0 + (UNPK4(rp[i]) * keep - r0) * *(const f32x4*)(MU + c);
                const f32x4 k = k0 + (UNPK4(kp[i]) * keep - k0) * *(const f32x4*)(MU + 256 + c);
                f32x4 v = v0_ + (UNPK4(vp[i]) * keep - v0_) * *(const f32x4*)(MU + 512 + c);
                const f32x4 w0 = *(const f32x4*)(PW0 + c), a0 = *(const f32x4*)(PA0 + c);
                const f32x4 kkc = *(const f32x4*)(PKK + c), kac = *(const f32x4*)(PKA + c), rkc = *(const f32x4*)(PRK + c);
                f32x4 dec, a;
#pragma unroll
                for (int q = 0; q < 4; ++q) {
                    const float wl = -softplusf_(-(w0[q] + aw[i][q])) - 0.5f;
                    dec[q] = __expf(-__expf(wl));
                    a[q] = fsig(a0[q] + aa[i][q]);
                }
                if (l == 0) *(f32x4*)(VFIRST + (size_t)t * 256 + c) = v;
                else {
                    const f32x4 v0 = *(const f32x4*)(PV0 + c);
#pragma unroll
                    for (int q = 0; q < 4; ++q) v[q] = v[q] + (vf4[i][q] - v[q]) * fsig(v0[q] + av[i][q]);
                }
                kx[i] = k * kkc; as_[i] = a;
                const f32x4 k2 = k * ((a - 1.f) * kac + 1.f);
                ss += kx[i].x * kx[i].x + kx[i].y * kx[i].y + kx[i].z * kx[i].z + kx[i].w * kx[i].w;
                const f32x4 rb = r * k2 * rkc;
                bsum += (rb.x + rb.y) + (rb.z + rb.w);
                *(f32x4*)(WDEC + (size_t)t * 256 + c) = dec; st_bf4(rec + 192 + j, k2); st_bf4(rec + 256 + j, r); st_bf4(rec + 320 + j, v);
                *(f32x4*)(GB + (size_t)t * 256 + c) = ag[i];
            }
            const float rn = rsqrtf(quad_sum(ss) + 1e-12f);
            bsum = quad_sum(bsum);
            if (fq == 0) BON[(size_t)t * 4 + h] = bsum;
#pragma unroll
            for (int i = 0; i < 4; ++i) {
                const int j = 16 * i + 4 * fq;
                const f32x4 kk = kx[i] * rn;
                st_bf4(rec + j, -kk); st_bf4(rec + 128 + j, kk * as_[i]);
            }
        }
        {
            bf16* rec = RECG + ((size_t)t * 4 + h) * 392;
            f32x4 yq[8], yk[8];
            float sq = 0.f, sk = 0.f;
            size_t rowo[4];
            float tapm[4];
#pragma unroll
            for (int tap = 0; tap < 4; ++tap) { const int tp = t - 3 + tap; rowo[tap] = (size_t)(tp >= 0 ? tp : 0) * NPROJ; tapm[tap] = tp >= 0 ? 1.f : 0.f; }
#pragma unroll
            for (int which = 0; which < 3; ++which) {
                u32x2 raw[8][4];
#pragma unroll
                for (int i = 0; i < 8; ++i) {
                    if ((i & 3) == 0) {
#pragma unroll
                        for (int i2 = i; i2 < i + 4; ++i2)
#pragma unroll
                            for (int tap = 0; tap < 4; ++tap) raw[i2][tap] = *(const u32x2*)(PROJ + rowo[tap] + 1024 + which * 512 + h * 128 + 16 * i2 + 4 * fq);
                        asm volatile("" ::: "memory");
                    }
                    const int j = 16 * i + 4 * fq, ch = which * 512 + h * 128 + j;
                    f32x4 cv = {0.f, 0.f, 0.f, 0.f};
#pragma unroll
                    for (int tap = 0; tap < 4; ++tap) cv = cv + UNPK4(raw[i][tap]) * (*(const f32x4*)(CW + tap * 1536 + ch) * tapm[tap]);
                    f32x4 y; y.x = siluf_(cv.x); y.y = siluf_(cv.y); y.z = siluf_(cv.z); y.w = siluf_(cv.w);
                    if (which == 0) { yq[i] = y; sq += y.x * y.x + y.y * y.y + y.z * y.z + y.w * y.w; }
                    else if (which == 1) { yk[i] = y; sk += y.x * y.x + y.y * y.y + y.z * y.z + y.w * y.w; }
                    else st_bf4(rec + 256 + j, y);
                }
            }
            const float rq = rsqrtf(quad_sum(sq) + 1e-12f) * 0.08838834764831845f, rk = rsqrtf(quad_sum(sk) + 1e-12f);
#pragma unroll
            for (int i = 0; i < 8; ++i) { const int j = 16 * i + 4 * fq; st_bf4(rec + j, yq[i] * rq); st_bf4(rec + 128 + j, yk[i] * rk); }
            if (fq == 0) {
                const float av = PEX[(size_t)t * 64 + h], bv = PEX[(size_t)t * 64 + 4 + h];
                const float g = -__expf(p.in[22][l * 4 + h]) * softplusf_(av + p.in[23][l * 4 + h]);
                *(f32x4*)(GSC + ((size_t)t * 4 + h) * 4) = (f32x4){__expf(g), fsig(bv), g, 0.f};
            }
        }
        {
            bf16* rec = RECT + ((size_t)t * 4 + h) * 192;
            u32x2 q1r[2], q2r[2], k1r[2], k2r[2], vr[4]; f32x4 c0r[2], c1r[2];
#pragma unroll
            for (int u = 0; u < 2; ++u) {
                const int i = 16 * u + 4 * fq;
                c0r[u] = *(const f32x4*)(ROT + ((size_t)t * 32 + i) * 2); c1r[u] = *(const f32x4*)(ROT + ((size_t)t * 32 + i) * 2 + 4);
                q1r[u] = *(const u32x2*)(PROJ + (size_t)t * NPROJ + 3072 + h * 64 + i); q2r[u] = *(const u32x2*)(PROJ + (size_t)t * NPROJ + 3072 + h * 64 + 32 + i);
                k1r[u] = *(const u32x2*)(PROJ + (size_t)t * NPROJ + 3328 + h * 64 + i); k2r[u] = *(const u32x2*)(PROJ + (size_t)t * NPROJ + 3328 + h * 64 + 32 + i);
            }
#pragma unroll
            for (int i = 0; i < 4; ++i) vr[i] = *(const u32x2*)(PROJ + (size_t)t * NPROJ + 3584 + h * 64 + 16 * i + 4 * fq);
            asm volatile("" ::: "memory");
#pragma unroll
            for (int u = 0; u < 2; ++u) {
                const int i = 16 * u + 4 * fq;
                const f32x4 cs = {c0r[u].x, c0r[u].z, c1r[u].x, c1r[u].z}, sn = {c0r[u].y, c0r[u].w, c1r[u].y, c1r[u].w};
                const f32x4 q1 = UNPK4(q1r[u]), q2 = UNPK4(q2r[u]), k1 = UNPK4(k1r[u]), k2 = UNPK4(k2r[u]);
                st_bf4(rec + i, q1 * cs - q2 * sn); st_bf4(rec + 32 + i, q1 * sn + q2 * cs);
                st_bf4(rec + 64 + i, (k1 * cs - k2 * sn) * 0.125f); st_bf4(rec + 96 + i, (k1 * sn + k2 * cs) * 0.125f);
            }
#pragma unroll
            for (int i = 0; i < 4; ++i) *(u32x2*)(rec + 128 + 16 * i + 4 * fq) = vr[i];
        }
#undef UNPK4
        __syncthreads();
    }
}

DEVI void retA_item(const P& p, int item, char* smem) {
    const bf16* REC = (const bf16*)(p.ws + WS_RECT); float* KV = (float*)(p.ws + WS_RKV);
    bf16* KT = (bf16*)smem; bf16* VT = KT + 64 * 72;
    const int n = item >> 2, h = item & 3;
    int tid = VTID; asm volatile("" : "+v"(tid));
    const int lane = tid & 63, w = tid >> 6, fr = lane & 15, fq = lane >> 4;
    const float lg = log2f(1.f - exp2f(-5.f - (float)h));
    {
        u32x4 v[4];
#pragma unroll
        for (int i = 0; i < 4; ++i) { const int idx = tid + 256 * i, c = idx >> 4, j = idx & 15; v[i] = *(const u32x4*)(REC + ((size_t)(n * 64 + c) * 4 + h) * 192 + 64 + j * 8); }
#pragma unroll
        for (int i = 0; i < 4; ++i) {
            const int idx = tid + 256 * i, c = idx >> 4, j = idx & 15;
            const float sc = (j < 8) ? exp2f((float)(63 - c) * lg) : 1.f;
            bf16* dst = ((j < 8) ? KT : VT) + ((j & 7) * 8) * 72 + c;
#pragma unroll
            for (int q = 0; q < 4; ++q) {
                const unsigned u = v[i][q];
                dst[(2 * q) * 72] = (j < 8) ? (bf16)f2bf(__uint_as_float(u << 16) * sc) : (bf16)(u & 0xffffu);
                dst[(2 * q + 1) * 72] = (j < 8) ? (bf16)f2bf(__uint_as_float(u & 0xffff0000u) * sc) : (bf16)(u >> 16);
            }
        }
    }
    __syncthreads();
    {
        const int dt = w;
        const bf16x8 a0 = ldfrag(KT, 72, 16 * dt, 0, lane), a1 = ldfrag(KT, 72, 16 * dt, 32, lane);
        float* out = KV + (size_t)item * 4096;
        const int s_ = dt >> 1, lane2 = 16 * (2 * (dt & 1) + (fq >> 1)) + fr;
#pragma unroll
        for (int et = 0; et < 4; ++et) {
            f32x4 acc = {0.f, 0.f, 0.f, 0.f};
            acc = mfma16(a0, ldfrag(VT, 72, 16 * et, 0, lane), acc);
            acc = mfma16(a1, ldfrag(VT, 72, 16 * et, 32, lane), acc);
            *(f32x4*)(out + ((et * 2 + s_) * 64 + lane2) * 8 + 4 * (fq & 1)) = acc;
        }
    }
    __syncthreads();
}

DEVI void retS_item(const P& p, int item) {
    const float* KV = (const float*)(p.ws + WS_RKV); bf16* RST = (bf16*)(p.ws + WS_RST);
    const int idx = item * NT + VTID;
    const int h = idx >> 12, i = idx & 4095;
    const float cd = exp2f(64.f * log2f(1.f - exp2f(-5.f - (float)h)));
    float r = 0.f;
#pragma unroll 1
    for (int n0 = 0; n0 < 256; n0 += 32) {
        float kv[32];
#pragma unroll
        for (int q = 0; q < 32; ++q) kv[q] = KV[((size_t)(n0 + q) * 4 + h) * 4096 + i];
#pragma unroll
        for (int q = 0; q < 32; ++q) { RST[((size_t)(n0 + q) * 4 + h) * 4096 + i] = (bf16)f2bf(r); r = r * cd + kv[q]; }
    }
}

DEVI void retC_item(const P& p, int item, int l, char* smem) {
    const bf16* REC = (const bf16*)(p.ws + WS_RECT); const bf16* RST = (const bf16*)(p.ws + WS_RST);
    const bf16* PROJ = (const bf16*)(p.ws + WS_PROJ); bf16* MIX = (bf16*)(p.ws + WS_MIX);
    const float* rgn = p.in[25] + l * 256; const float* rbn = p.in[26] + l * 256;
    bf16* Qs = (bf16*)smem; bf16* Ks = Qs + 64 * 72; bf16* VT = Ks + 64 * 72; bf16* Ps = VT + 64 * 72;
    const int n = item >> 2, h = item & 3;
    int tid = VTID; asm volatile("" : "+v"(tid));
    const int lane = tid & 63, w = tid >> 6, fr = lane & 15, fq = lane >> 4;
    const float lg = log2f(1.f - exp2f(-5.f - (float)h));
    {
        u32x4 v[6];
#pragma unroll
        for (int i = 0; i < 6; ++i) { const int idx = tid + 256 * i, c = idx / 24, j = idx - c * 24; v[i] = *(const u32x4*)(REC + ((size_t)(n * 64 + c) * 4 + h) * 192 + j * 8); }
#pragma unroll
        for (int i = 0; i < 6; ++i) {
            const int idx = tid + 256 * i, c = idx / 24, j = idx - c * 24;
            if (j < 16) *(u32x4*)(((j < 8) ? Qs : Ks) + c * 72 + (j & 7) * 8) = v[i];
            else {
                bf16* dst = VT + ((j & 7) * 8) * 72 + c;
#pragma unroll
                for (int q = 0; q < 4; ++q) { const unsigned u = v[i][q]; dst[(2 * q) * 72] = (bf16)(u & 0xffffu); dst[(2 * q + 1) * 72] = (bf16)(u >> 16); }
            }
        }
    }
    __syncthreads();
    const int ct = w, c = 16 * ct + fr;
    const bf16x8 q0 = ldfrag(Qs, 72, 16 * ct, 0, lane), q1 = ldfrag(Qs, 72, 16 * ct, 32, lane);
#pragma unroll
    for (int ct2 = 0; ct2 < 4; ++ct2) {
        f32x4 acc = {0.f, 0.f, 0.f, 0.f};
        acc = mfma16(ldfrag(Ks, 72, 16 * ct2, 0, lane), q0, acc);
        acc = mfma16(ldfrag(Ks, 72, 16 * ct2, 32, lane), q1, acc);
        float pv[4];
#pragma unroll
        for (int j = 0; j < 4; ++j) {
            const int c2 = 16 * ct2 + 4 * fq + j;
            pv[j] = (c >= c2) ? acc[j] * exp2f((float)(c - c2) * lg) : 0.f;
        }
        *(u32x2*)(Ps + c * 72 + 16 * ct2 + 4 * fq) = (u32x2){pk2(pv[0], pv[1]), pk2(pv[2], pv[3])};
    }
    __syncthreads();
    {
        const bf16x8 p0 = ldfrag(Ps, 72, 16 * ct, 0, lane), p1 = ldfrag(Ps, 72, 16 * ct, 32, lane);
        const float xi = exp2f((float)(c + 1) * lg);
        const bf16* RF = RST + (size_t)item * 4096;
        f32x4 o[4];
        float sm = 0.f;
        bf16x8 rfr[4][2];
#pragma unroll
        for (int et = 0; et < 4; ++et) { rfr[et][0] = *(const bf16x8*)(RF + ((et * 2 + 0) * 64 + lane) * 8); rfr[et][1] = *(const bf16x8*)(RF + ((et * 2 + 1) * 64 + lane) * 8); }
        asm volatile("" ::: "memory");
#pragma unroll
        for (int et = 0; et < 4; ++et) {
            f32x4 ai = {0.f, 0.f, 0.f, 0.f}, ax = {0.f, 0.f, 0.f, 0.f};
            ai = mfma16(ldfrag(VT, 72, 16 * et, 0, lane), p0, ai);
            ai = mfma16(ldfrag(VT, 72, 16 * et, 32, lane), p1, ai);
            ax = mfma16(rfr[et][0], q0, ax);
            ax = mfma16(rfr[et][1], q1, ax);
            o[et] = ai + ax * xi;
            sm += (o[et].x + o[et].y) + (o[et].z + o[et].w);
        }
        const float mean = quad_sum(sm) * (1.f / 64.f);
        float sv = 0.f;
#pragma unroll
        for (int et = 0; et < 4; ++et) { o[et] = o[et] - mean; sv += o[et].x * o[et].x + o[et].y * o[et].y + o[et].z * o[et].z + o[et].w * o[et].w; }
        const float rs = rsqrtf(quad_sum(sv) * (1.f / 64.f) + 1e-5f);
        const int t = n * 64 + c;
#pragma unroll
        for (int et = 0; et < 4; ++et) {
            const int e = h * 64 + 16 * et + 4 * fq;
            const f32x4 g = *(const f32x4*)(rgn + e), b = *(const f32x4*)(rbn + e);
            const f32x4 gt = ld_bf4(PROJ + (size_t)t * NPROJ + 3840 + e);
            const f32x4 y = o[et] * rs * g + b;
            *(u32x2*)(MIX + (size_t)t * D + 768 + e) = (u32x2){pk2(y.x * siluf_(gt.x), y.y * siluf_(gt.y)), pk2(y.z * siluf_(gt.z), y.w * siluf_(gt.w))};
        }
    }
    __syncthreads();
}

template <int I, int N> struct SolveRow {
    static DEVI void run(float (&x)[N], const float* M) {
        float s0 = 0.f, s1 = 0.f, s2 = 0.f, s3 = 0.f;
#pragma unroll
        for (int j4 = 0; j4 < (I + 3) / 4; ++j4) {
            const f32x4 m = *(const f32x4*)(M + I * N + 4 * j4);
            s0 += m.x * x[4 * j4]; s1 += m.y * x[4 * j4 + 1]; s2 += m.z * x[4 * j4 + 2]; s3 += m.w * x[4 * j4 + 3];
        }
        x[I] -= (s0 + s1) + (s2 + s3);
        asm volatile("" : "+v"(x[I]) :: "memory");
        SolveRow<I + 1, N>::run(x, M);
    }
};
template <int N> struct SolveRow<N, N> { static DEVI void run(float (&)[N], const float*) {} };

DEVI void gdnA_item(const P& p, int item, char* smem) {
    const bf16* REC = (const bf16*)(p.ws + WS_RECG); const float* GSC = (const float*)(p.ws + WS_GSC) + ((size_t)(item >> 2) * 64 * 4 + (item & 3)) * 4;
    bf16* GP = (bf16*)(p.ws + WS_GP) + (size_t)item * 16384; float* GB = (float*)(p.ws + WS_GB) + (size_t)item * 16384;
    float* GD = (float*)(p.ws + WS_GD);
    bf16* GQ = (bf16*)(p.ws + WS_GQ) + (size_t)item * 8192; float* GO = (float*)(p.ws + WS_GO) + (size_t)item * 8192;
    bf16* Kb = (bf16*)smem; bf16* Qb = Kb + 64 * 136;
    bf16* WT = (bf16*)smem; bf16* UT = WT + 128 * 72;
    bf16* Vb = (bf16*)(smem + 36864);
    float* M = (float*)(smem + 36864);
    bf16* KdT = (bf16*)(smem + 36864);
    bf16* At = (bf16*)(smem + 55296);
    float* gcs = (float*)(smem + 64512); float* bts = gcs + 64; float* sws = gcs + 128; float* sks = gcs + 192;
    const int n = item >> 2, h = item & 3;
    int tid = VTID; asm volatile("" : "+v"(tid));
    const int lane = tid & 63, w = tid >> 6, fr = lane & 15, fq = lane >> 4;
    const bf16* rec0 = REC + ((size_t)(n * 64) * 4 + h) * 392;
    if (w == 0) {
        float x = GSC[lane * 16 + 2];
#pragma unroll
        for (int off = 1; off < 64; off <<= 1) { const float y = __shfl_up(x, off); if (lane >= off) x += y; }
        const float bt = GSC[lane * 16 + 1];
        gcs[lane] = x; bts[lane] = bt; sws[lane] = bt * __expf(x); sks[lane] = __expf(__shfl(x, 63) - x);
    }
    {
        u32x4 v[12];
#pragma unroll
        for (int i = 0; i < 12; ++i) { const int idx = tid + 256 * i, c = idx / 48, j = idx - c * 48; v[i] = *(const u32x4*)(rec0 + (size_t)c * 1568 + j * 8); }
#pragma unroll
        for (int i = 0; i < 12; ++i) {
            const int idx = tid + 256 * i, c = idx / 48, j = idx - c * 48, which = j >> 4;
            const int boff = (which == 0 ? 17408 : 0) + (which == 2 ? 36864 : 0);
            *(u32x4*)(smem + boff + (c * 136 + (j & 15) * 8) * 2) = v[i];
        }
    }
    __syncthreads();
    float x[64];
    unsigned kdp[16];
    {
        const int col = tid & 127;
        int sel_b = (tid < 128) ? 36864 : 0, sel_s = (tid < 128) ? 64 : 128;
        asm volatile("" : "+v"(sel_b), "+v"(sel_s));
        const bf16* srcb = (const bf16*)(smem + sel_b) + col;
        const float* scs = gcs + sel_s;
#pragma unroll
        for (int c = 0; c < 64; ++c) {
            x[c] = scs[c] * bf2f(srcb[c * 136]);
            if ((c & 7) == 7) asm volatile("" : "+v"(x[c]) :: "memory");
        }
        const int half = tid >> 7;
#pragma unroll
        for (int i = 0; i < 16; ++i) {
            const int c = 32 * half + 2 * i;
            kdp[i] = pk2(bf2f(Kb[c * 136 + col]) * sks[c], bf2f(Kb[(c + 1) * 136 + col]) * sks[c + 1]);
            if ((i & 3) == 3) asm volatile("" : "+v"(kdp[i]) :: "memory");
        }
        if (tid == 0) GD[item] = __expf(gcs[63]);
    }
    __syncthreads();
    const int ct = w;
    f32x4 accQ[8];
    {
        const int c = 16 * ct + fr;
        const float gcc = gcs[c];
        {
            bf16x8 ka[4];
#pragma unroll
            for (int s = 0; s < 4; ++s) ka[s] = ldfrag(Kb, 136, 16 * ct, 32 * s, lane);
#pragma unroll
            for (int ct2 = 0; ct2 < 4; ++ct2) {
                f32x4 acc = {0.f, 0.f, 0.f, 0.f};
#pragma unroll
                for (int s = 0; s < 4; ++s) acc = mfma16(ka[s], ldfrag(Kb, 136, 16 * ct2, 32 * s, lane), acc);
                const int c2 = 16 * ct2 + fr; const float g2 = gcs[c2];
#pragma unroll
                for (int j = 0; j < 4; ++j) {
                    const int cc = 16 * ct + 4 * fq + j;
                    M[cc * 64 + c2] = (cc > c2) ? bts[cc] * acc[j] * __expf(gcs[cc] - g2) : 0.f;
                }
            }
        }
        {
            bf16x8 qa[4];
#pragma unroll
            for (int s = 0; s < 4; ++s) qa[s] = ldfrag(Qb, 136, 16 * ct, 32 * s, lane);
#pragma unroll
            for (int ct2 = 0; ct2 < 4; ++ct2) {
                f32x4 acc = {0.f, 0.f, 0.f, 0.f};
#pragma unroll
                for (int s = 0; s < 4; ++s) acc = mfma16(ldfrag(Kb, 136, 16 * ct2, 32 * s, lane), qa[s], acc);
                float pv[4];
#pragma unroll
                for (int j = 0; j < 4; ++j) { const int c2 = 16 * ct2 + 4 * fq + j; pv[j] = (c >= c2) ? acc[j] * __expf(gcc - gcs[c2]) : 0.f; }
                *(u32x2*)(At + c * 72 + 16 * ct2 + 4 * fq) = (u32x2){pk2(pv[0], pv[1]), pk2(pv[2], pv[3])};
            }
        }
    }
    __syncthreads();
    {
        SolveRow<1, 64>::run(x, M);
        unsigned xp[32];
#pragma unroll
        for (int q = 0; q < 32; ++q) xp[q] = pk2(x[2 * q], x[2 * q + 1]);
        {
            const int c = 16 * ct + fr;
            const float eg = __expf(gcs[c]);
#pragma unroll
            for (int dt = 0; dt < 8; ++dt) accQ[dt] = ld_bf4(Qb + c * 136 + 16 * dt + 4 * fq) * (-eg);
        }
        __syncthreads();
        int sel_d = (tid < 128) ? 128 * 72 : 0;
        asm volatile("" : "+v"(sel_d));
        bf16* dst = WT + sel_d + (tid & 127) * 72;
#pragma unroll
        for (int q = 0; q < 8; ++q) *(u32x4*)(dst + 8 * q) = (u32x4){xp[4 * q], xp[4 * q + 1], xp[4 * q + 2], xp[4 * q + 3]};
    }
    __syncthreads();
    {
        const int d = tid & 127, half = tid >> 7;
#pragma unroll
        for (int q = 0; q < 4; ++q) *(u32x4*)(KdT + d * 72 + 32 * half + 8 * q) = (u32x4){kdp[4 * q], kdp[4 * q + 1], kdp[4 * q + 2], kdp[4 * q + 3]};
    }
    __syncthreads();
    {
#pragma unroll 1
        for (int mi = 0; mi < 2; ++mi) {
            const int mt = 2 * w + mi;
            const bf16x8 kd0 = ldfrag(KdT, 72, 16 * mt, 0, lane), kd1 = ldfrag(KdT, 72, 16 * mt, 32, lane);
#pragma unroll
            for (int sp = 0; sp < 4; ++sp) {
                f32x4 a0 = {0.f, 0.f, 0.f, 0.f}, a1 = {0.f, 0.f, 0.f, 0.f};
                a0 = mfma16(ldfrag(WT, 72, 32 * sp, 0, lane), kd0, a0); a0 = mfma16(ldfrag(WT, 72, 32 * sp, 32, lane), kd1, a0);
                a1 = mfma16(ldfrag(WT, 72, 32 * sp + 16, 0, lane), kd0, a1); a1 = mfma16(ldfrag(WT, 72, 32 * sp + 16, 32, lane), kd1, a1);
                *(u32x4*)(GP + ((mt * 4 + sp) * 64 + lane) * 8) = (u32x4){pk2(-a0.x, -a0.y), pk2(-a0.z, -a0.w), pk2(-a1.x, -a1.y), pk2(-a1.z, -a1.w)};
            }
#pragma unroll
            for (int nt = 0; nt < 8; ++nt) {
                f32x4 a = {0.f, 0.f, 0.f, 0.f};
                a = mfma16(kd0, ldfrag(UT, 72, 16 * nt, 0, lane), a); a = mfma16(kd1, ldfrag(UT, 72, 16 * nt, 32, lane), a);
                *(f32x4*)(GB + ((nt * 8 + mt) * 64 + lane) * 4) = a;
            }
        }
        const bf16x8 at0 = ldfrag(At, 72, 16 * ct, 0, lane), at1 = ldfrag(At, 72, 16 * ct, 32, lane);
#pragma unroll
        for (int sp = 0; sp < 4; ++sp) {
            f32x4 a0 = accQ[2 * sp], a1 = accQ[2 * sp + 1];
            a0 = mfma16(ldfrag(WT, 72, 32 * sp, 0, lane), at0, a0); a0 = mfma16(ldfrag(WT, 72, 32 * sp, 32, lane), at1, a0);
            a1 = mfma16(ldfrag(WT, 72, 32 * sp + 16, 0, lane), at0, a1); a1 = mfma16(ldfrag(WT, 72, 32 * sp + 16, 32, lane), at1, a1);
            *(u32x4*)(GQ + ((ct * 4 + sp) * 64 + lane) * 8) = (u32x4){pk2(-a0.x, -a0.y), pk2(-a0.z, -a0.w), pk2(-a1.x, -a1.y), pk2(-a1.z, -a1.w)};
        }
#pragma unroll
        for (int et = 0; et < 8; ++et) {
            f32x4 a = {0.f, 0.f, 0.f, 0.f};
            a = mfma16(ldfrag(UT, 72, 16 * et, 0, lane), at0, a); a = mfma16(ldfrag(UT, 72, 16 * et, 32, lane), at1, a);
            *(f32x4*)(GO + ((ct * 8 + et) * 64 + lane) * 4) = a;
        }
    }
    __syncthreads();
}

DEVI bf16x8 pack_frag(const f32x4& a, const f32x4& b) {
    const u32x4 v = {pk2(a.x, a.y), pk2(a.z, a.w), pk2(b.x, b.y), pk2(b.z, b.w)};
    return __builtin_bit_cast(bf16x8, v);
}
DEVI void gdnL1_item(const P& p, int item, char* smem) {
    const bf16* GP = (const bf16*)(p.ws + WS_GP); const float* GB = (const float*)(p.ws + WS_GB); const float* GD = (const float*)(p.ws + WS_GD);
    const int half = item & 1, kind = (item >> 1) & 1, g = (item >> 2) & 15, h = item >> 6;
    const int tid = VTID, lane = tid & 63, ew = half * 4 + (tid >> 6), fr = lane & 15, fq = lane >> 4;
    const int n0 = g * 16;
#define L1_DMA(n) do { const bf16* _s = GP + ((size_t)(n) * 4 + h) * 16384 + tid * 8; char* _d = smem + ((n) & 1) * 32768 + tid * 16; \
        _Pragma("unroll") for (int _i = 0; _i < 8; ++_i) __builtin_amdgcn_global_load_lds((const unsigned*)(_s + _i * 2048), (unsigned*)(_d + _i * 4096), 16, 0, 0); } while (0)
    f32x4 acc[8];
    L1_DMA(n0);
    if (kind == 0) {
        bf16* GS = (bf16*)(p.ws + WS_GS);
#pragma unroll
        for (int m = 0; m < 8; ++m) acc[m] = (f32x4){0.f, 0.f, 0.f, 0.f};
        f32x4 bcur[8], bnxt[8]; float dcur, dnxt = 0.f;
        {
            const float* Bn = GB + ((size_t)n0 * 4 + h) * 16384 + (ew * 8 * 64 + lane) * 4;
#pragma unroll
            for (int m = 0; m < 8; ++m) bcur[m] = *(const f32x4*)(Bn + m * 256);
            dcur = GD[(size_t)n0 * 4 + h];
        }
#pragma unroll 1
        for (int n = n0; n < n0 + 16; ++n) {
            const size_t it = (size_t)n * 4 + h;
            asm volatile("s_waitcnt vmcnt(0)" ::: "memory");
            __syncthreads();
            if (n + 1 < n0 + 16) {
                L1_DMA(n + 1);
                const float* Bn = GB + (it + 4) * 16384 + (ew * 8 * 64 + lane) * 4;
#pragma unroll
                for (int m = 0; m < 8; ++m) bnxt[m] = *(const f32x4*)(Bn + m * 256);
                dnxt = GD[it + 4];
            }
            const char* ring = smem + (n & 1) * 32768 + lane * 16;
            bf16x8 sf[4];
#pragma unroll
            for (int s = 0; s < 4; ++s) {
                sf[s] = pack_frag(acc[2 * s], acc[2 * s + 1]);
                *(bf16x8*)(GS + it * 16384 + ((ew * 4 + s) * 64 + lane) * 8) = sf[s];
            }
#pragma unroll
            for (int m = 0; m < 8; ++m) {
                f32x4 a = acc[m] * dcur + bcur[m];
#pragma unroll
                for (int s = 0; s < 4; ++s) a = mfma16(*(const bf16x8*)(ring + (m * 4 + s) * 1024), sf[s], a);
                acc[m] = a;
            }
#pragma unroll
            for (int m = 0; m < 8; ++m) bcur[m] = bnxt[m];
            dcur = dnxt;
        }
        float* E0 = (float*)(p.ws + WS_GE0) + (size_t)(h * 16 + g) * 16384 + (ew * 8 * 64 + lane) * 4;
#pragma unroll
        for (int m = 0; m < 8; ++m) *(f32x4*)(E0 + m * 256) = acc[m];
    } else {
        const bf16* GQ = (const bf16*)(p.ws + WS_GQ); bf16* GR = (bf16*)(p.ws + WS_GR);
#pragma unroll
        for (int m = 0; m < 8; ++m)
#pragma unroll
            for (int j = 0; j < 4; ++j) acc[m][j] = (m == ew && 4 * fq + j == fr) ? 1.f : 0.f;
#pragma unroll 1
        for (int n = n0; n < n0 + 16; ++n) {
            const size_t it = (size_t)n * 4 + h;
            asm volatile("s_waitcnt vmcnt(0)" ::: "memory");
            __syncthreads();
            if (n + 1 < n0 + 16) L1_DMA(n + 1);
            bf16x8 qf[16];
#pragma unroll
            for (int i = 0; i < 16; ++i) qf[i] = *(const bf16x8*)(GQ + it * 8192 + (i * 64 + lane) * 8);
            const float dn = GD[it];
            const char* ring = smem + (n & 1) * 32768 + lane * 16;
            bf16x8 tf[4];
#pragma unroll
            for (int s = 0; s < 4; ++s) tf[s] = pack_frag(acc[2 * s], acc[2 * s + 1]);
#pragma unroll
            for (int m = 0; m < 8; ++m) {
                f32x4 a = acc[m] * dn;
#pragma unroll
                for (int s = 0; s < 4; ++s) a = mfma16(*(const bf16x8*)(ring + (m * 4 + s) * 1024), tf[s], a);
                acc[m] = a;
            }
#pragma unroll
            for (int tt = 0; tt < 4; ++tt) {
                f32x4 r = {0.f, 0.f, 0.f, 0.f};
#pragma unroll
                for (int s = 0; s < 4; ++s) r = mfma16(tf[s], qf[tt * 4 + s], r);
                *(u32x2*)(GR + it * 8192 + ((tt * 4 + (ew >> 1)) * 64 + lane) * 8 + 4 * (ew & 1)) = (u32x2){pk2(r.x, r.y), pk2(r.z, r.w)};
            }
        }
        bf16* TE = (bf16*)(p.ws + WS_GTE) + (size_t)(h * 16 + g) * 16384;
        const int s_ = ew >> 1, jj = 4 * (ew & 1) + (fr & 3), lg = fr >> 2;
#pragma unroll
        for (int m = 0; m < 8; ++m)
#pragma unroll
            for (int j = 0; j < 4; ++j) TE[((m * 4 + s_) * 64 + (4 * fq + j) + 16 * lg) * 8 + jj] = (bf16)f2bf(acc[m][j]);
    }
    asm volatile("s_waitcnt vmcnt(0)" ::: "memory");
    __syncthreads();
#undef L1_DMA
}
DEVI void gdnL2_item(const P& p, int item, char* smem) {
    const bf16* TE = (const bf16*)(p.ws + WS_GTE); const float* E0 = (const float*)(p.ws + WS_GE0); bf16* SG = (bf16*)(p.ws + WS_GSG);
    const int h = item >> 1, tid = VTID, lane = tid & 63, ew = (item & 1) * 4 + (tid >> 6);
#define L2_DMA(g) do { const bf16* _s = TE + ((size_t)h * 16 + (g)) * 16384 + tid * 8; char* _d = smem + ((g) & 1) * 32768 + tid * 16; \
        _Pragma("unroll") for (int _i = 0; _i < 8; ++_i) __builtin_amdgcn_global_load_lds((const unsigned*)(_s + _i * 2048), (unsigned*)(_d + _i * 4096), 16, 0, 0); } while (0)
    f32x4 acc[8];
#pragma unroll
    for (int m = 0; m < 8; ++m) acc[m] = (f32x4){0.f, 0.f, 0.f, 0.f};
    L2_DMA(0);
    f32x4 bcur[8], bnxt[8];
    {
        const float* En = E0 + (size_t)h * 16 * 16384 + (ew * 8 * 64 + lane) * 4;
#pragma unroll
        for (int m = 0; m < 8; ++m) bcur[m] = *(const f32x4*)(En + m * 256);
    }
#pragma unroll 1
    for (int g = 0; g < 16; ++g) {
        const size_t hg = (size_t)h * 16 + g;
        asm volatile("s_waitcnt vmcnt(0)" ::: "memory");
        __syncthreads();
        if (g + 1 < 16) {
            L2_DMA(g + 1);
            const float* En = E0 + (hg + 1) * 16384 + (ew * 8 * 64 + lane) * 4;
#pragma unroll
            for (int m = 0; m < 8; ++m) bnxt[m] = *(const f32x4*)(En + m * 256);
        }
        const char* ring = smem + (g & 1) * 32768 + lane * 16;
        bf16x8 sf[4];
#pragma unroll
        for (int s = 0; s < 4; ++s) {
            sf[s] = pack_frag(acc[2 * s], acc[2 * s + 1]);
            *(bf16x8*)(SG + hg * 16384 + ((ew * 4 + s) * 64 + lane) * 8) = sf[s];
        }
#pragma unroll
        for (int m = 0; m < 8; ++m) {
            f32x4 a = bcur[m];
#pragma unroll
            for (int s = 0; s < 4; ++s) a = mfma16(*(const bf16x8*)(ring + (m * 4 + s) * 1024), sf[s], a);
            acc[m] = a;
        }
#pragma unroll
        for (int m = 0; m < 8; ++m) bcur[m] = bnxt[m];
    }
    asm volatile("s_waitcnt vmcnt(0)" ::: "memory");
    __syncthreads();
#undef L2_DMA
}

DEVI void gdnC_item(const P& p, int item, int l) {
    const bf16* GQ = (const bf16*)(p.ws + WS_GQ) + (size_t)item * 8192; const float* GO = (const float*)(p.ws + WS_GO) + (size_t)item * 8192;
    const bf16* GS = (const bf16*)(p.ws + WS_GS) + (size_t)item * 16384;
    const bf16* PROJ = (const bf16*)(p.ws + WS_PROJ); bf16* MIX = (bf16*)(p.ws + WS_MIX);
    const float* gn = p.in[24] + l * 128;
    const int n = item >> 2, h = item & 3;
    const int lane = VTID & 63, ct = VTID >> 6, fr = lane & 15, fq = lane >> 4;
    const bf16* GR = (const bf16*)(p.ws + WS_GR) + (size_t)item * 8192;
    const bf16* SG = (const bf16*)(p.ws + WS_GSG) + (size_t)(h * 16 + (n >> 4)) * 16384;
    bf16x8 qf[4], rf[4];
#pragma unroll
    for (int s = 0; s < 4; ++s) { qf[s] = *(const bf16x8*)(GQ + ((ct * 4 + s) * 64 + lane) * 8); rf[s] = *(const bf16x8*)(GR + ((ct * 4 + s) * 64 + lane) * 8); }
    const int t = n * 64 + 16 * ct + fr;
    f32x4 a[8];
    float ss = 0.f;
    u32x2 zr[8]; f32x4 gv[8];
#pragma unroll
    for (int et = 0; et < 8; ++et) { zr[et] = *(const u32x2*)(PROJ + (size_t)t * NPROJ + 2560 + h * 128 + 16 * et + 4 * fq); gv[et] = *(const f32x4*)(gn + 16 * et + 4 * fq); }
#pragma unroll
    for (int e2 = 0; e2 < 4; ++e2) {
        f32x4 c0[2]; bf16x8 gs[2][4], sg[2][4];
#pragma unroll
        for (int u = 0; u < 2; ++u) {
            const int et = 2 * e2 + u;
            c0[u] = *(const f32x4*)(GO + ((ct * 8 + et) * 64 + lane) * 4);
#pragma unroll
            for (int s = 0; s < 4; ++s) { gs[u][s] = *(const bf16x8*)(GS + ((et * 4 + s) * 64 + lane) * 8); sg[u][s] = *(const bf16x8*)(SG + ((et * 4 + s) * 64 + lane) * 8); }
        }
        asm volatile("" ::: "memory");
#pragma unroll
        for (int u = 0; u < 2; ++u) {
            f32x4 acc = c0[u];
#pragma unroll
            for (int s = 0; s < 4; ++s) acc = mfma16(gs[u][s], qf[s], acc);
#pragma unroll
            for (int s = 0; s < 4; ++s) acc = mfma16(sg[u][s], rf[s], acc);
            a[2 * e2 + u] = acc;
            ss += acc.x * acc.x + acc.y * acc.y + acc.z * acc.z + acc.w * acc.w;
        }
    }
    const float rs = rsqrtf(quad_sum(ss) * (1.f / 128.f) + 1e-6f);
#pragma unroll
    for (int et = 0; et < 8; ++et) {
        const int e = 16 * et + 4 * fq;
        const f32x4 z = {__uint_as_float(zr[et].x << 16), __uint_as_float(zr[et].x & 0xffff0000u), __uint_as_float(zr[et].y << 16), __uint_as_float(zr[et].y & 0xffff0000u)};
        const f32x4 o = a[et] * rs * gv[et];
        *(u32x2*)(MIX + (size_t)t * D + 256 + h * 128 + e) = (u32x2){pk2(o.x * siluf_(z.x), o.y * siluf_(z.y)), pk2(o.z * siluf_(z.z), o.w * siluf_(z.w))};
    }
}

DEVI void rwkA_item(const P& p, int item, char* smem) {
    const bf16* REC = (const bf16*)(p.ws + WS_RECR); const float* WDEC = (const float*)(p.ws + WS_WDEC);
    bf16* WP = (bf16*)(p.ws + WS_WP) + (size_t)item * 4096; float* WC = (float*)(p.ws + WS_WC) + (size_t)item * 4096;
    float* WD = (float*)(p.ws + WS_WD) + (size_t)item * 64;
    bf16* WQ = (bf16*)(p.ws + WS_WQ) + (size_t)item * 2048; float* WY = (float*)(p.ws + WS_WY) + (size_t)item * 2048;
    bf16* At_ = (bf16*)smem; bf16* Rt = At_ + 32 * 72; bf16* Bt = Rt + 32 * 72; bf16* Kt = Bt + 32 * 72;
    float* ZT = (float*)(smem + 9216);
    bf16* BhT = (bf16*)(smem + 18432); bf16* KhT = BhT + 64 * 40; bf16* VT = KhT + 64 * 40; bf16* AhT = VT + 64 * 40; bf16* UhT = AhT + 64 * 40;
    float* M = (float*)(smem + 44032);
    bf16* Aak = (bf16*)(smem + 48128); bf16* Arb = Aak + 32 * 40; bf16* Ark = Arb + 32 * 40;
    float* tot = (float*)(smem + 55808);
    const int n = item >> 2, h = item & 3;
    int tid = VTID; asm volatile("" : "+v"(tid));
    const int lane = tid & 63, w = tid >> 6, fr = lane & 15, fq = lane >> 4;
    {
        const int d = lane;
        const bf16* rec = REC + ((size_t)(n * 32 + 8 * w) * 4 + h) * 384 + d;
        const float* dcy = WDEC + (size_t)(n * 32 + 8 * w) * 256 + h * 64 + d;
        float lw[8], lg[8];
        float run = 0.f;
        float dcv[8]; bf16 ra[8], rb[8], rk[8], rr_[8], rv[8];
#pragma unroll
        for (int i = 0; i < 8; ++i) {
            const bf16* r = rec + (size_t)i * 1536;
            dcv[i] = dcy[i * 256]; ra[i] = r[0]; rb[i] = r[128]; rk[i] = r[192]; rr_[i] = r[256]; rv[i] = r[320];
        }
        asm volatile("" ::: "memory");
#pragma unroll
        for (int i = 0; i < 8; ++i) { lg[i] = __logf(dcv[i]); run += lg[i]; lw[i] = run; }
        tot[w * 64 + d] = run;
        __syncthreads();
        float off = 0.f, total = 0.f;
#pragma unroll
        for (int q = 0; q < 4; ++q) { const float tq = tot[q * 64 + d]; total += tq; off += (q < w) ? tq : 0.f; }
        unsigned bh[4], kh[4], vv[4];
        float pb = 0.f, pk = 0.f, pv = 0.f;
#pragma unroll
        for (int i = 0; i < 8; ++i) {
            const float a = bf2f(ra[i]), b = bf2f(rb[i]), k = bf2f(rk[i]), rr = bf2f(rr_[i]), v = bf2f(rv[i]);
            const float lc = off + lw[i];
            const float cw = __expf(lc), cwm1 = __expf(lc - lg[i]), inv = __expf(-lc), rat = __expf(total - lc);
            const int t = 8 * w + i;
            At_[t * 72 + d] = (bf16)f2bf(a * cwm1); Rt[t * 72 + d] = (bf16)f2bf(rr * cw);
            Bt[t * 72 + d] = (bf16)f2bf(b * inv); Kt[t * 72 + d] = (bf16)f2bf(k * inv);
            if (i & 1) { bh[i >> 1] = pk2(pb, b * rat); kh[i >> 1] = pk2(pk, k * rat); vv[i >> 1] = pk2(pv, v); }
            else { pb = b * rat; pk = k * rat; pv = v; }
        }
        *(u32x4*)(BhT + d * 40 + 8 * w) = (u32x4){bh[0], bh[1], bh[2], bh[3]};
        *(u32x4*)(KhT + d * 40 + 8 * w) = (u32x4){kh[0], kh[1], kh[2], kh[3]};
        *(u32x4*)(VT + d * 40 + 8 * w) = (u32x4){vv[0], vv[1], vv[2], vv[3]};
        if (w == 0) WD[d] = __expf(total);
    }
    __syncthreads();
    {
        int offA = (w == 0) ? 0 : (w == 1 ? 3 : (w == 2 ? 2 : 3));
        int offB = (w == 0) ? 2 : (w == 1 ? 0 : 1);
        asm volatile("" : "+v"(offA), "+v"(offB));
        const bf16* As = At_ + offA * (32 * 72); const bf16* Bs = At_ + offB * (32 * 72);
#pragma unroll
        for (int ta = 0; ta < 2; ++ta) {
            const bf16x8 a0 = ldfrag(As, 72, 16 * ta, 0, lane), a1 = ldfrag(As, 72, 16 * ta, 32, lane);
#pragma unroll
            for (int tb = 0; tb < 2; ++tb) {
                f32x4 acc = {0.f, 0.f, 0.f, 0.f};
                acc = mfma16(a0, ldfrag(Bs, 72, 16 * tb, 0, lane), acc);
                acc = mfma16(a1, ldfrag(Bs, 72, 16 * tb, 32, lane), acc);
                if (w == 0) {
                    const int s_ = 16 * tb + fr;
#pragma unroll
                    for (int j = 0; j < 4; ++j) { const int t = 16 * ta + 4 * fq + j; M[t * 32 + s_] = (t > s_) ? -acc[j] : 0.f; }
                } else {
                    const int t = 16 * tb + fr;
                    float pv4[4];
#pragma unroll
                    for (int j = 0; j < 4; ++j) { const int s_ = 16 * ta + 4 * fq + j; pv4[j] = ((w == 1) ? (t > s_) : (t >= s_)) ? acc[j] : 0.f; }
                    int offD = w - 1; asm volatile("" : "+v"(offD));
                    *(u32x2*)(Aak + offD * (32 * 40) + t * 40 + 16 * ta + 4 * fq) = (u32x2){pk2(pv4[0], pv4[1]), pk2(pv4[2], pv4[3])};
                }
            }
        }
    }
    __syncthreads();
    {
        const int et = w;
        const bf16x8 vf = ldfrag(VT, 40, 16 * et, 0, lane);
#pragma unroll
        for (int tt = 0; tt < 2; ++tt) {
            f32x4 acc = {0.f, 0.f, 0.f, 0.f};
            acc = mfma16(ldfrag(Aak, 40, 16 * tt, 0, lane), vf, acc);
            *(f32x4*)(ZT + (16 * et + fr) * 36 + 16 * tt + 4 * fq) = acc;
        }
    }
    __syncthreads();
    if (tid < 128) {
        float x[32];
        if (tid < 64) {
#pragma unroll
            for (int t = 0; t < 32; ++t) x[t] = bf2f(At_[t * 72 + tid]);
        } else {
#pragma unroll
            for (int q = 0; q < 8; ++q) { const f32x4 z = *(const f32x4*)(ZT + (tid - 64) * 36 + 4 * q); x[4 * q] = z.x; x[4 * q + 1] = z.y; x[4 * q + 2] = z.z; x[4 * q + 3] = z.w; }
        }
        SolveRow<1, 32>::run(x, M);
        bf16* dst = AhT + tid * 40;
#pragma unroll
        for (int q = 0; q < 4; ++q)
            *(u32x4*)(dst + 8 * q) = (u32x4){pk2(x[8 * q], x[8 * q + 1]), pk2(x[8 * q + 2], x[8 * q + 3]), pk2(x[8 * q + 4], x[8 * q + 5]), pk2(x[8 * q + 6], x[8 * q + 7])};
    }
    __syncthreads();
    {
        const int mt = w;
        const bf16x8 bh = ldfrag(BhT, 40, 16 * mt, 0, lane), kh = ldfrag(KhT, 40, 16 * mt, 0, lane);
#pragma unroll
        for (int sp = 0; sp < 2; ++sp) {
            f32x4 a0 = {0.f, 0.f, 0.f, 0.f}, a1 = {0.f, 0.f, 0.f, 0.f};
            a0 = mfma16(ldfrag(AhT, 40, 32 * sp, 0, lane), bh, a0);
            a1 = mfma16(ldfrag(AhT, 40, 32 * sp + 16, 0, lane), bh, a1);
            *(u32x4*)(WP + ((mt * 2 + sp) * 64 + lane) * 8) = (u32x4){pk2(a0.x, a0.y), pk2(a0.z, a0.w), pk2(a1.x, a1.y), pk2(a1.z, a1.w)};
        }
#pragma unroll
        for (int nt = 0; nt < 4; ++nt) {
            f32x4 a = {0.f, 0.f, 0.f, 0.f};
            a = mfma16(bh, ldfrag(UhT, 40, 16 * nt, 0, lane), a);
            a = mfma16(kh, ldfrag(VT, 40, 16 * nt, 0, lane), a);
            *(f32x4*)(WC + ((nt * 4 + mt) * 64 + lane) * 4) = a;
        }
        {
            const int ct = w & 1, sp = w >> 1, t = 16 * ct + fr;
            const bf16x8 ar = ldfrag(Arb, 40, 16 * ct, 0, lane);
            f32x4 a0 = ld_bf4(Rt + t * 72 + 32 * sp + 4 * fq), a1 = ld_bf4(Rt + t * 72 + 32 * sp + 16 + 4 * fq);
            a0 = mfma16(ldfrag(AhT, 40, 32 * sp, 0, lane), ar, a0);
            a1 = mfma16(ldfrag(AhT, 40, 32 * sp + 16, 0, lane), ar, a1);
            *(u32x4*)(WQ + ((ct * 2 + sp) * 64 + lane) * 8) = (u32x4){pk2(a0.x, a0.y), pk2(a0.z, a0.w), pk2(a1.x, a1.y), pk2(a1.z, a1.w)};
        }
        {
            const int et = w;
            const bf16x8 uf = ldfrag(UhT, 40, 16 * et, 0, lane), vf = ldfrag(VT, 40, 16 * et, 0, lane);
#pragma unroll
            for (int ct = 0; ct < 2; ++ct) {
                f32x4 a = {0.f, 0.f, 0.f, 0.f};
                a = mfma16(uf, ldfrag(Arb, 40, 16 * ct, 0, lane), a);
                a = mfma16(vf, ldfrag(Ark, 40, 16 * ct, 0, lane), a);
                *(f32x4*)(WY + ((ct * 4 + et) * 64 + lane) * 4) = a;
            }
        }
    }
    __syncthreads();
}

struct RwkStep { bf16x8 pf[8]; f32x4 cf[4]; f32x4 dv[4]; };
DEVI void rwk_load(RwkStep& r, const bf16* WP, const float* WC, const float* WD, size_t it, int ew, int lane) {
#pragma unroll
    for (int i = 0; i < 8; ++i) r.pf[i] = *(const bf16x8*)(WP + it * 4096 + (i * 64 + lane) * 8);
#pragma unroll
    for (int m = 0; m < 4; ++m) r.cf[m] = *(const f32x4*)(WC + it * 4096 + ((ew * 4 + m) * 64 + lane) * 4);
#pragma unroll
    for (int m = 0; m < 4; ++m) r.dv[m] = *(const f32x4*)(WD + it * 64 + 16 * m + 4 * (lane >> 4));
}
DEVI void rwk_step(const RwkStep& r, f32x4 (&acc)[4], bf16* WSF, size_t it, int ew, int lane) {
    bf16x8 sf[2];
#pragma unroll
    for (int s = 0; s < 2; ++s) {
        const u32x4 v = {pk2(acc[2 * s].x, acc[2 * s].y), pk2(acc[2 * s].z, acc[2 * s].w), pk2(acc[2 * s + 1].x, acc[2 * s + 1].y), pk2(acc[2 * s + 1].z, acc[2 * s + 1].w)};
        *(u32x4*)(WSF + it * 4096 + ((ew * 2 + s) * 64 + lane) * 8) = v;
        sf[s] = __builtin_bit_cast(bf16x8, v);
    }
#pragma unroll
    for (int m = 0; m < 4; ++m) {
        f32x4 a = acc[m] * r.dv[m] + r.cf[m];
        a = mfma16(r.pf[m * 2], sf[0], a);
        a = mfma16(r.pf[m * 2 + 1], sf[1], a);
        acc[m] = a;
    }
}
DEVI void rwkL1_item(const P& p, int item) {
    const bf16* WP = (const bf16*)(p.ws + WS_WP); const float* WC = (const float*)(p.ws + WS_WC); const float* WD = (const float*)(p.ws + WS_WD);
    const int kind = item & 1, g = (item >> 1) & 15, h = item >> 5;
    const int lane = VTID & 63, ew = VTID >> 6, fr = lane & 15, fq = lane >> 4;
    f32x4 acc[4];
    if (kind == 0) {
        bf16* WSF = (bf16*)(p.ws + WS_WS);
#pragma unroll
        for (int m = 0; m < 4; ++m) acc[m] = (f32x4){0.f, 0.f, 0.f, 0.f};
        RwkStep A, B;
        const int n0 = g * 32;
        rwk_load(A, WP, WC, WD, (size_t)n0 * 4 + h, ew, lane);
#pragma unroll 1
        for (int n = n0; n < n0 + 32; n += 2) {
            rwk_load(B, WP, WC, WD, (size_t)(n + 1) * 4 + h, ew, lane);
            asm volatile("" ::: "memory");
            rwk_step(A, acc, WSF, (size_t)n * 4 + h, ew, lane);
            rwk_load(A, WP, WC, WD, (size_t)((n + 2 < n0 + 32) ? n + 2 : n) * 4 + h, ew, lane);
            asm volatile("" ::: "memory");
            rwk_step(B, acc, WSF, (size_t)(n + 1) * 4 + h, ew, lane);
        }
        float* E0 = (float*)(p.ws + WS_WE0) + (size_t)(h * 16 + g) * 4096 + (ew * 4 * 64 + lane) * 4;
#pragma unroll
        for (int m = 0; m < 4; ++m) *(f32x4*)(E0 + m * 256) = acc[m];
    } else {
        const bf16* WQ = (const bf16*)(p.ws + WS_WQ); bf16* WR = (bf16*)(p.ws + WS_WR);
#pragma unroll
        for (int m = 0; m < 4; ++m)
#pragma unroll
            for (int j = 0; j < 4; ++j) acc[m][j] = (m == ew && 4 * fq + j == fr) ? 1.f : 0.f;
#pragma unroll 1
        for (int n = g * 32; n < g * 32 + 32; ++n) {
            const size_t it = (size_t)n * 4 + h;
            bf16x8 pf[8], qf[4]; f32x4 dv[4];
#pragma unroll
            for (int i = 0; i < 8; ++i) pf[i] = *(const bf16x8*)(WP + it * 4096 + (i * 64 + lane) * 8);
#pragma unroll
            for (int i = 0; i < 4; ++i) qf[i] = *(const bf16x8*)(WQ + it * 2048 + (i * 64 + lane) * 8);
#pragma unroll
            for (int m = 0; m < 4; ++m) dv[m] = *(const f32x4*)(WD + it * 64 + 16 * m + 4 * fq);
            asm volatile("" ::: "memory");
            bf16x8 tf[2];
#pragma unroll
            for (int s = 0; s < 2; ++s) tf[s] = pack_frag(acc[2 * s], acc[2 * s + 1]);
#pragma unroll
            for (int tt = 0; tt < 2; ++tt) {
                f32x4 r = {0.f, 0.f, 0.f, 0.f};
                r = mfma16(tf[0], qf[tt * 2], r); r = mfma16(tf[1], qf[tt * 2 + 1], r);
                *(u32x2*)(WR + it * 2048 + ((tt * 2 + (ew >> 1)) * 64 + lane) * 8 + 4 * (ew & 1)) = (u32x2){pk2(r.x, r.y), pk2(r.z, r.w)};
            }
#pragma unroll
            for (int m = 0; m < 4; ++m) {
                f32x4 a = acc[m] * dv[m];
                a = mfma16(pf[m * 2], tf[0], a); a = mfma16(pf[m * 2 + 1], tf[1], a);
                acc[m] = a;
            }
        }
        bf16* TE = (bf16*)(p.ws + WS_WTE) + (size_t)(h * 16 + g) * 4096;
        const int s_ = ew >> 1, jj = 4 * (ew & 1) + (fr & 3), lg = fr >> 2;
#pragma unroll
        for (int m = 0; m < 4; ++m)
#pragma unroll
            for (int j = 0; j < 4; ++j) TE[((m * 2 + s_) * 64 + (4 * fq + j) + 16 * lg) * 8 + jj] = (bf16)f2bf(acc[m][j]);
    }
}
DEVI void rwkL2_item(const P& p, int h) {
    const bf16* TE = (const bf16*)(p.ws + WS_WTE); const float* E0 = (const float*)(p.ws + WS_WE0); bf16* SG = (bf16*)(p.ws + WS_WSG);
    const int lane = VTID & 63, ew = VTID >> 6;
    f32x4 acc[4];
#pragma unroll
    for (int m = 0; m < 4; ++m) acc[m] = (f32x4){0.f, 0.f, 0.f, 0.f};
#pragma unroll 1
    for (int g = 0; g < 16; ++g) {
        const size_t hg = (size_t)h * 16 + g;
        bf16x8 pf[8]; f32x4 bfr[4];
#pragma unroll
        for (int i = 0; i < 8; ++i) pf[i] = *(const bf16x8*)(TE + hg * 4096 + (i * 64 + lane) * 8);
#pragma unroll
        for (int m = 0; m < 4; ++m) bfr[m] = *(const f32x4*)(E0 + hg * 4096 + ((ew * 4 + m) * 64 + lane) * 4);
        asm volatile("" ::: "memory");
        bf16x8 sf[2];
#pragma unroll
        for (int s = 0; s < 2; ++s) {
            sf[s] = pack_frag(acc[2 * s], acc[2 * s + 1]);
            *(bf16x8*)(SG + hg * 4096 + ((ew * 2 + s) * 64 + lane) * 8) = sf[s];
        }
#pragma unroll
        for (int m = 0; m < 4; ++m) {
            f32x4 a = bfr[m];
            a = mfma16(pf[m * 2], sf[0], a); a = mfma16(pf[m * 2 + 1], sf[1], a);
            acc[m] = a;
        }
    }
}

DEVI void rwkC_item(const P& p, int n, int l) {
    const int lane = VTID & 63, h = VTID >> 6, fr = lane & 15, fq = lane >> 4;
    const size_t it = (size_t)n * 4 + h;
    const bf16* WQ = (const bf16*)(p.ws + WS_WQ) + it * 2048; const float* WY = (const float*)(p.ws + WS_WY) + it * 2048;
    const bf16* WSF = (const bf16*)(p.ws + WS_WS) + it * 4096;
    const bf16* WR = (const bf16*)(p.ws + WS_WR) + it * 2048; const bf16* WSG = (const bf16*)(p.ws + WS_WSG) + (size_t)(h * 16 + (n >> 5)) * 4096;
    const bf16* RECR = (const bf16*)(p.ws + WS_RECR); const float* GB = (const float*)(p.ws + WS_G); const float* BON = (const float*)(p.ws + WS_BON);
    bf16* MIX = (bf16*)(p.ws + WS_MIX);
    const float* ln_g = p.in[17] + l * 256 + h * 64; const float* ln_b = p.in[18] + l * 256 + h * 64;
#pragma unroll
    for (int ct = 0; ct < 2; ++ct) {
        const bf16x8 q0 = *(const bf16x8*)(WQ + ((ct * 2 + 0) * 64 + lane) * 8), q1 = *(const bf16x8*)(WQ + ((ct * 2 + 1) * 64 + lane) * 8);
        const bf16x8 r0 = *(const bf16x8*)(WR + ((ct * 2 + 0) * 64 + lane) * 8), r1 = *(const bf16x8*)(WR + ((ct * 2 + 1) * 64 + lane) * 8);
        const int t = n * 32 + 16 * ct + fr;
        f32x4 a[4];
        float sm = 0.f;
        f32x4 y0[4]; bf16x8 sfr[4][2], sgr[4][2];
#pragma unroll
        for (int et = 0; et < 4; ++et) {
            y0[et] = *(const f32x4*)(WY + ((ct * 4 + et) * 64 + lane) * 4);
#pragma unroll
            for (int s = 0; s < 2; ++s) { sfr[et][s] = *(const bf16x8*)(WSF + ((et * 2 + s) * 64 + lane) * 8); sgr[et][s] = *(const bf16x8*)(WSG + ((et * 2 + s) * 64 + lane) * 8); }
        }
        asm volatile("" ::: "memory");
#pragma unroll
        for (int et = 0; et < 4; ++et) {
            f32x4 acc = y0[et];
            acc = mfma16(sfr[et][0], q0, acc);
            acc = mfma16(sfr[et][1], q1, acc);
            acc = mfma16(sgr[et][0], r0, acc);
            acc = mfma16(sgr[et][1], r1, acc);
            a[et] = acc; sm += (acc.x + acc.y) + (acc.z + acc.w);
        }
        const float mean = quad_sum(sm) * (1.f / 64.f);
        float sv = 0.f;
#pragma unroll
        for (int et = 0; et < 4; ++et) { a[et] = a[et] - mean; sv += a[et].x * a[et].x + a[et].y * a[et].y + a[et].z * a[et].z + a[et].w * a[et].w; }
        const float rs = rsqrtf(quad_sum(sv) * (1.f / 64.f) + 64e-5f);
        const float bon = BON[(size_t)t * 4 + h];
        f32x4 gq[4], bq[4], vq[4], gateq[4];
#pragma unroll
        for (int et = 0; et < 4; ++et) {
            const int e = 16 * et + 4 * fq;
            gq[et] = *(const f32x4*)(ln_g + e); bq[et] = *(const f32x4*)(ln_b + e);
            vq[et] = ld_bf4(RECR + ((size_t)t * 4 + h) * 384 + 320 + e);
            gateq[et] = *(const f32x4*)(GB + (size_t)t * 256 + h * 64 + e);
        }
        asm volatile("" ::: "memory");
#pragma unroll
        for (int et = 0; et < 4; ++et) {
            const int e = 16 * et + 4 * fq;
            const f32x4 g = gq[et], b = bq[et];
            const f32x4 v = vq[et];
            const f32x4 gate = gateq[et];
            const f32x4 o = (a[et] * rs * g + b + v * bon) * gate;
            *(u32x2*)(MIX + (size_t)t * D + h * 64 + e) = (u32x2){pk2(o.x, o.y), pk2(o.z, o.w)};
        }
    }
}

DEVI void phase_scanL1(const P& p, char* smem) {
    for (int item = VBID; item < 448; item += VNB) {
        if (item < 256) gdnL1_item(p, item, smem);
        else if (item < 384) rwkL1_item(p, item - 256);
        else retS_item(p, item - 384);
    }
}
DEVI void retC_item(const P& p, int item, int l, char* smem);
DEVI void phase_scanL2(const P& p, int l, char* smem) {
    if (VBID < 12) { if (VBID < 8) gdnL2_item(p, VBID, smem); else rwkL2_item(p, VBID - 8); }
    else { for (int item = VBID - 12; item < 1024; item += VNB - 12) retC_item(p, item, l, smem); }
}
DEVI void phase_chunkA(const P& p, char* smem) {
    for (int item = VBID; item < 4096; item += VNB) { if (item < 1024) gdnA_item(p, item, smem); else if (item < 3072) rwkA_item(p, item - 1024, smem); else retA_item(p, item - 3072, smem); }
}
DEVI void phase_chunkC(const P& p, int l, char* smem) {
    for (int item = VBID; item < 1536; item += VNB) { if (item < 1024) gdnC_item(p, item, l); else rwkC_item(p, item - 1024, l); }
}

DEVI void phase_ln1_route(const P& p, int l, char* smem, bool commit = true) {
    const float* ADA = (const float*)(p.ws + OFF_ADA) + l * 6144;
    const float* xin = p.in[0];
    const bf16* OPRE = (const bf16*)(p.ws + WS_OPRE);
    bf16* X = (bf16*)(p.ws + WS_X); bf16* H2 = (bf16*)(p.ws + WS_H2);
    const float* lg = p.in[28] + l * D; const float* lb = p.in[29] + l * D;
    const float* rw = p.in[30] + (size_t)l * D * 32; const float* rbias = p.in[31] + l * 32;
    int* CNT = (int*)(p.ws + OFF_CNT) + l * 32 * 64; int* LIST = (int*)(p.ws + WS_LIST); float* GATE = (float*)(p.ws + WS_GATE);
    constexpr int HSS = 1028;
    float* HS = (float*)smem;
    float* RED = HS;
    int* SEL = (int*)(HS + 16 * HSS);
    int* RNK = SEL + 256;
    int* BASE = RNK + 256;
    int nasg = 0;
    const int tid = VTID, lane = tid & 63, w = tid >> 6, fr = lane & 15, fq = lane >> 4;
    f32x4 cg1[4], cg[4], cb[4], cG2[4], cB2[4];
#pragma unroll
    for (int j = 0; j < 4; ++j) {
        const int c = j * 256 + lane * 4;
        const f32x4 gt = *(const f32x4*)(ADA + 2048 + c), sh = *(const f32x4*)(ADA + 3072 + c), sc = *(const f32x4*)(ADA + 4096 + c);
        cg1[j] = gt + 1.f; cg[j] = *(const f32x4*)(lg + c); cb[j] = *(const f32x4*)(lb + c);
        cG2[j] = sc + 1.f; cB2[j] = sh;
    }
    const u32x4* RWF = (const u32x4*)(p.ws + WS_RWF) + (size_t)((l * 32 + w * 8) * 4) * 64 + lane;
    f32x4 xb[4]; u32x2 xh[4], ob[4];
#define LN1_LOAD(tok) do { const size_t _o = (size_t)(tok) * D + lane * 4; _Pragma("unroll") for (int _j = 0; _j < 4; ++_j) { \
        if (l == 0) xb[_j] = *(const f32x4*)(xin + _o + _j * 256); else xh[_j] = *(const u32x2*)(X + _o + _j * 256); \
        ob[_j] = *(const u32x2*)(OPRE + _o + _j * 256); } } while (0)
    LN1_LOAD(VBID * 16 + w);
    for (int item = VBID; item < S / 16; item += VNB) {
#pragma unroll 1
        for (int sub = 0; sub < 4; ++sub) {
            const int t = item * 16 + sub * 4 + w;
            f32x4 v[4]; float s = 0.f;
#pragma unroll
            for (int j = 0; j < 4; ++j) {
                const f32x4 xv = (l == 0) ? xb[j] : (f32x4){__uint_as_float(xh[j].x << 16), __uint_as_float(xh[j].x & 0xffff0000u), __uint_as_float(xh[j].y << 16), __uint_as_float(xh[j].y & 0xffff0000u)};
                const f32x4 ov = {__uint_as_float(ob[j].x << 16), __uint_as_float(ob[j].x & 0xffff0000u), __uint_as_float(ob[j].y << 16), __uint_as_float(ob[j].y & 0xffff0000u)};
                v[j] = xv * DN_ALPHA + cg1[j] * ov;
                s += (v[j].x + v[j].y) + (v[j].z + v[j].w);
            }
            {
                int tn = (sub < 3) ? t + 4 : (item + VNB) * 16 + w;
                if (tn >= S) tn = t;
                asm volatile("" ::: "memory");
                LN1_LOAD(tn);
                asm volatile("" ::: "memory");
            }
            const float mean = wave_sum(s) * (1.f / D);
            float s2 = 0.f;
#pragma unroll
            for (int j = 0; j < 4; ++j) { v[j] = v[j] - mean; s2 += (v[j].x * v[j].x + v[j].y * v[j].y) + (v[j].z * v[j].z + v[j].w * v[j].w); }
            const float rstd = rsqrtf(wave_sum(s2) * (1.f / D) + 1e-5f);
#pragma unroll
            for (int j = 0; j < 4; ++j) {
                const int c = j * 256 + lane * 4;
                f32x4 xo = v[j] * rstd * cg[j] + cb[j];
                *(u32x2*)(X + (size_t)t * D + c) = (u32x2){pk2(xo.x, xo.y), pk2(xo.z, xo.w)};
                f32x4 hh = xo * cG2[j] + cB2[j];
                *(f32x4*)(HS + (sub * 4 + w) * HSS + c) = hh;
                u32x2 o; o.x = pk2(hh.x, hh.y); o.y = pk2(hh.z, hh.w);
                *(u32x2*)(H2 + (size_t)t * D + c) = o;
            }
        }
        __syncthreads();
        f32x4 lacc[2] = {{0.f, 0.f, 0.f, 0.f}, {0.f, 0.f, 0.f, 0.f}};
        {
            const float* hrow = HS + fr * HSS + w * 256 + 8 * fq;
#pragma unroll
            for (int hb = 0; hb < 4; ++hb) {
                u32x4 bw[2][4];
#pragma unroll
                for (int s4 = 0; s4 < 2; ++s4)
#pragma unroll
                    for (int q = 0; q < 4; ++q) bw[s4][q] = RWF[((hb * 2 + s4) * 4 + q) * 64];
                asm volatile("" ::: "memory");
#pragma unroll
                for (int s4 = 0; s4 < 2; ++s4) {
                    const int ks = hb * 2 + s4;
                    const f32x4 h0 = *(const f32x4*)(hrow + 32 * ks), h1 = *(const f32x4*)(hrow + 32 * ks + 4);
                    const unsigned p0 = pk2(h0.x, h0.y), p1 = pk2(h0.z, h0.w), p2 = pk2(h1.x, h1.y), p3 = pk2(h1.z, h1.w);
                    const unsigned q0 = pk2(h0.x - __uint_as_float(p0 << 16), h0.y - __uint_as_float(p0 & 0xffff0000u));
                    const unsigned q1 = pk2(h0.z - __uint_as_float(p1 << 16), h0.w - __uint_as_float(p1 & 0xffff0000u));
                    const unsigned q2 = pk2(h1.x - __uint_as_float(p2 << 16), h1.y - __uint_as_float(p2 & 0xffff0000u));
                    const unsigned q3 = pk2(h1.z - __uint_as_float(p3 << 16), h1.w - __uint_as_float(p3 & 0xffff0000u));
                    const bf16x8 ahi = __builtin_bit_cast(bf16x8, ((u32x4){p0, p1, p2, p3})), alo = __builtin_bit_cast(bf16x8, ((u32x4){q0, q1, q2, q3}));
#pragma unroll
                    for (int n = 0; n < 2; ++n) {
                        const bf16x8 bhi = __builtin_bit_cast(bf16x8, bw[s4][2 * n]), blo = __builtin_bit_cast(bf16x8, bw[s4][2 * n + 1]);
                        lacc[n] = mfma16(ahi, bhi, lacc[n]); lacc[n] = mfma16(alo, bhi, lacc[n]); lacc[n] = mfma16(ahi, blo, lacc[n]);
                    }
                }
            }
        }
        __syncthreads();
#pragma unroll
        for (int n = 0; n < 2; ++n)
#pragma unroll
            for (int j = 0; j < 4; ++j) RED[(w * 16 + 4 * fq + j) * 32 + 16 * n + fr] = lacc[n][j];
        __syncthreads();
#pragma unroll 1
        for (int rnd = 0; rnd < 2; ++rnd) {
            const int tok = rnd * 8 + (tid >> 5), e = tid & 31, tt = item * 16 + tok;
            float logit = rbias[e];
#pragma unroll
            for (int ks = 0; ks < 4; ++ks) logit += RED[(ks * 16 + tok) * 32 + e];
            bool taken = false;
            float sv[4]; int si[4];
#pragma unroll
            for (int j = 0; j < 4; ++j) {
                float cand = taken ? -3.0e38f : logit; int ci = e;
#pragma unroll
                for (int off = 16; off >= 1; off >>= 1) {
                    const float ov = __shfl_xor(cand, off, 32); const int oi = __shfl_xor(ci, off, 32);
                    if (ov > cand || (ov == cand && oi < ci)) { cand = ov; ci = oi; }
                }
                sv[j] = cand; si[j] = ci; if (ci == e) taken = true;
            }
            const float e0 = 1.f, e1 = __expf(sv[1] - sv[0]), e2 = __expf(sv[2] - sv[0]), e3 = __expf(sv[3] - sv[0]);
            const float inv = 1.f / (e0 + e1 + e2 + e3);
            const float gts[4] = {e0 * inv, e1 * inv, e2 * inv, e3 * inv};
#pragma unroll
            for (int j = 0; j < 4; ++j) {
                if (si[j] == e) {
                    SEL[nasg + tok * 4 + j] = ((tt * 4 + j) << 5) | e;
                    GATE[(size_t)tt * 4 + j] = gts[j];
                }
            }
        }
        nasg += 64;
        __syncthreads();
    }
    if (!commit) return;
    if (tid < 32) {
        int c = 0;
        for (int a = 0; a < nasg; ++a) { if ((SEL[a] & 31) == tid) { RNK[a] = c; ++c; } }
        BASE[tid] = c ? atomicAdd(&CNT[tid * 64], c) : 0;
    }
    __syncthreads();
    for (int a = tid; a < nasg; a += NT) { const int v = SEL[a], e = v & 31; LIST[(size_t)e * S + BASE[e] + RNK[a]] = v >> 5; }
    __syncthreads();
#undef LN1_LOAD
}

DEVI void phase_ln2(const P& p, int l) {
    const float* ADA = (const float*)(p.ws + OFF_ADA) + l * 6144;
    const float* ADAn = (const float*)(p.ws + OFF_ADA) + 6144;
    bf16* X = (bf16*)(p.ws + WS_X); const bf16* YB = (const bf16*)(p.ws + WS_YB);
    bf16* HB = (bf16*)(p.ws + WS_HB);
    const float* lg = p.in[36] + l * D; const float* lb = p.in[37] + l * D;
    const int tid = VTID, lane = tid & 63, w = tid >> 6;
    f32x4 cg1[4], cg[4], cb[4], cG2[4], cB2[4];
#pragma unroll
    for (int j = 0; j < 4; ++j) {
        const int c = j * 256 + lane * 4;
        cg1[j] = *(const f32x4*)(ADA + 5120 + c) + 1.f; cg[j] = *(const f32x4*)(lg + c); cb[j] = *(const f32x4*)(lb + c);
        if (l == 0) { cB2[j] = *(const f32x4*)(ADAn + c); cG2[j] = *(const f32x4*)(ADAn + 1024 + c) + 1.f; }
        else { cB2[j] = cb[j]; cG2[j] = cg[j]; }
    }
    u32x2 xq[4]; u32x2 yq[4][4];
#define LN2_LOAD(tok) do { const size_t _o = (size_t)(tok) * D + lane * 4; _Pragma("unroll") for (int _j = 0; _j < 4; ++_j) { \
        xq[_j] = *(const u32x2*)(X + _o + _j * 256); \
        _Pragma("unroll") for (int _q = 0; _q < 4; ++_q) yq[_j][_q] = *(const u32x2*)(YB + ((size_t)(tok) * 4 + _q) * D + lane * 4 + _j * 256); } } while (0)
    LN2_LOAD(VBID * 4 + w);
    for (int item = VBID; item < S / 4; item += VNB) {
        const int t = item * 4 + w;
        f32x4 v[4]; float s = 0.f;
#pragma unroll
        for (int j = 0; j < 4; ++j) {
            f32x4 f = {0.f, 0.f, 0.f, 0.f};
#pragma unroll
            for (int q = 0; q < 4; ++q) {
                const u32x2 y = yq[j][q];
                f.x += __uint_as_float(y.x << 16); f.y += __uint_as_float(y.x & 0xffff0000u);
                f.z += __uint_as_float(y.y << 16); f.w += __uint_as_float(y.y & 0xffff0000u);
            }
            const f32x4 xv = {__uint_as_float(xq[j].x << 16), __uint_as_float(xq[j].x & 0xffff0000u), __uint_as_float(xq[j].y << 16), __uint_as_float(xq[j].y & 0xffff0000u)};
            v[j] = xv * DN_ALPHA + cg1[j] * f;
            s += (v[j].x + v[j].y) + (v[j].z + v[j].w);
        }
        {
            int tn = (item + VNB) * 4 + w;
            if (tn >= S) tn = t;
            asm volatile("" ::: "memory");
            LN2_LOAD(tn);
            asm volatile("" ::: "memory");
        }
        const float mean = wave_sum(s) * (1.f / D);
        float s2 = 0.f;
#pragma unroll
        for (int j = 0; j < 4; ++j) { v[j] = v[j] - mean; s2 += (v[j].x * v[j].x + v[j].y * v[j].y) + (v[j].z * v[j].z + v[j].w * v[j].w); }
        const float rstd = rsqrtf(wave_sum(s2) * (1.f / D) + 1e-5f);
#pragma unroll
        for (int j = 0; j < 4; ++j) {
            const int c = j * 256 + lane * 4;
            const f32x4 xo = v[j] * rstd * cg[j] + cb[j];
            if (l == 0) {
                *(u32x2*)(X + (size_t)t * D + c) = (u32x2){pk2(xo.x, xo.y), pk2(xo.z, xo.w)};
                const f32x4 hh = xo * cG2[j] + cB2[j];
                u32x2 o; o.x = pk2(hh.x, hh.y); o.y = pk2(hh.z, hh.w);
                *(u32x2*)(HB + (size_t)t * D + c) = o;
            } else {
                *(f32x4*)(p.out + (size_t)t * D + c) = xo;
            }
        }
    }
#undef LN2_LOAD
}

namespace pg8 {
constexpr int BK = 64, HALF = 128, HTB = HALF * BK * 2, STAGE_BYTES = 8 * HTB;
DEVI int lds_byte(int r, int c) { const int st = (r >> 4) * 2 + (c >> 5), rr = r & 15, cc = c & 31, ob = rr * 64 + cc * 2; return st * 1024 + (ob ^ (((ob >> 9) & 1) << 5)); }
DEVI void stage_rc(int b, int& R, int& C) { const int st = b / 1024, sb = b % 1024, swz = sb ^ (((sb >> 9) & 1) << 5); R = (st >> 1) * 16 + swz / 64; C = (st & 1) * 32 + (swz % 64) / 2; }
struct Unit { const char* a; const char* b; int x0, x1, x2, x3; };

template <class Epi, class Sched>
DEVI void gemm_phase(LAS unsigned char* lds, const int K, const Sched& S, const Epi& E) {
    const int tid = threadIdx.x, wid = __builtin_amdgcn_readfirstlane(tid >> 6), lane = tid & 63, wr = wid >> 2, wc = wid & 3, fr = lane & 15, fq = lane >> 4;
    const int nt = K / BK;
    unsigned voffA[2], voffB[2];
    int gR[2], gC[2];
#pragma unroll
    for (int i = 0; i < 2; ++i) { int R, C; stage_rc(tid * 16 + i * 8192, R, C); gR[i] = R; gC[i] = C; voffA[i] = (unsigned)(R * K + C) * 2u; voffB[i] = (unsigned)(Epi::brow(R) * K + C) * 2u; }
    unsigned co[2][2], no[2][2];
#define PG8_GOFF(dst, tab) do { _Pragma("unroll") for (int _h = 0; _h < 2; ++_h) _Pragma("unroll") for (int _i = 0; _i < 2; ++_i) \
        dst[_h][_i] = (unsigned)((tab)[_h * 128 + gR[_i]] * K + gC[_i]) * 2u; } while (0)
    const size_t kstep = (size_t)(BK * 2);
    const size_t hstepA = (size_t)HALF * K * 2, hstepB = (size_t)Epi::BHALF * K * 2;
    const unsigned ldsw = (unsigned)wid * 1024u;
    const int aoff = lds_byte(wr * 64 + fr, fq * 8), boff = lds_byte(wc * 32 + fr, fq * 8);
#define PG8_SA(b, h) (((b) * 2 + (h)) * HTB)
#define PG8_SB(b, h) ((4 + (b) * 2 + (h)) * HTB)
#define PG8_STAGE(bufoff, gbase, voff) do { _Pragma("unroll") for (int _i = 0; _i < 2; ++_i) \
        __builtin_amdgcn_global_load_lds((const unsigned*)((const char*)(gbase) + (voff)[_i]), (LAS unsigned*)(lds + (bufoff) + ldsw + _i * 8192), 16, 0, 0); } while (0)
#define PG8_LDA(dst, b, h) do { _Pragma("unroll") for (int m = 0; m < 4; ++m) _Pragma("unroll") for (int k = 0; k < 2; ++k) dst[m][k] = *(const LAS bf16x8*)(lds + PG8_SA(b, h) + aoff + m * 2048 + k * 1024); } while (0)
#define PG8_LDB(dst, b, h) do { _Pragma("unroll") for (int n = 0; n < 2; ++n) _Pragma("unroll") for (int k = 0; k < 2; ++k) dst[n][k] = *(const LAS bf16x8*)(lds + PG8_SB(b, h) + boff + n * 2048 + k * 1024); } while (0)
#define PG8_MMA(ai, bj, At, Bt) do { __builtin_amdgcn_s_setprio(1); _Pragma("unroll") for (int m = 0; m < 4; ++m) _Pragma("unroll") for (int n = 0; n < 2; ++n) _Pragma("unroll") for (int k = 0; k < 2; ++k) \
        acc[ai][bj][m][n] = __builtin_amdgcn_mfma_f32_16x16x32_bf16(Bt[n][k], At[m][k], acc[ai][bj][m][n], 0, 0, 0); __builtin_amdgcn_s_setprio(0); } while (0)
#define PG8_WAIT_V(n) asm volatile("s_waitcnt vmcnt(" #n ")" ::: "memory")
#define PG8_WAIT_L(n) asm volatile("s_waitcnt lgkmcnt(" #n ")" ::: "memory")
#define PG8_BAR __builtin_amdgcn_s_barrier()
#define PG8_SCHED __builtin_amdgcn_sched_barrier(0)
    Unit cur, nxt; int ui = 0;
    if (!S.next(0, cur)) return;
    f32x4 acc[2][2][4][2];
#pragma unroll
    for (int a = 0; a < 2; ++a)
#pragma unroll
        for (int b = 0; b < 2; ++b)
#pragma unroll
            for (int m = 0; m < 4; ++m)
#pragma unroll
                for (int n = 0; n < 2; ++n) acc[a][b][m][n] = (f32x4){0.f, 0.f, 0.f, 0.f};
    bf16x8 At[4][2], B0[2][2], B1[2][2];
    const char* cA = cur.a; const char* cB = cur.b;
    if constexpr (Epi::GATHER_A) { PG8_GOFF(co, S.rows(0)); PG8_WAIT_L(0); }
    else {
#pragma unroll
        for (int i = 0; i < 2; ++i) { co[0][i] = voffA[i]; co[1][i] = voffA[i] + (unsigned)hstepA; no[0][i] = co[0][i]; no[1][i] = co[1][i]; }
    }
    PG8_WAIT_V(0);
    PG8_STAGE(PG8_SB(0, 0), cB, voffB); PG8_STAGE(PG8_SA(0, 0), cA, co[0]); PG8_STAGE(PG8_SB(0, 1), cB + hstepB, voffB); PG8_STAGE(PG8_SA(0, 1), cA, co[1]);
    if (wr == 1) PG8_BAR;
    PG8_WAIT_V(4); PG8_BAR;
    PG8_STAGE(PG8_SB(1, 0), cB + kstep, voffB); PG8_STAGE(PG8_SA(1, 0), cA + kstep, co[0]); PG8_STAGE(PG8_SB(1, 1), cB + hstepB + kstep, voffB);
    PG8_WAIT_V(6); PG8_BAR;
    for (;;) {
        const bool has_next = S.next(ui + 1, nxt);
        const char* nA = has_next ? nxt.a : cA; const char* nB = has_next ? nxt.b : cB;
        if constexpr (Epi::GATHER_A) { if (has_next) PG8_GOFF(no, S.rows(ui + 1)); else { no[0][0] = co[0][0]; no[0][1] = co[0][1]; no[1][0] = co[1][0]; no[1][1] = co[1][1]; } }
        for (int t = 0; t < nt; t += 2) {
            const bool last = (t == nt - 2);
            const char* a1 = cA + (size_t)(t + 1) * kstep;
            const char* a2 = last ? nA : cA + (size_t)(t + 2) * kstep; const char* b2 = last ? nB : cB + (size_t)(t + 2) * kstep;
            const char* a3 = a2 + kstep; const char* b3 = b2 + kstep;
            unsigned fo[2][2];
#pragma unroll
            for (int h = 0; h < 2; ++h)
#pragma unroll
                for (int i = 0; i < 2; ++i) fo[h][i] = last ? no[h][i] : co[h][i];
            PG8_LDB(B0, 0, 0); PG8_SCHED; PG8_LDA(At, 0, 0); PG8_STAGE(PG8_SA(1, 1), a1, co[1]);
            PG8_WAIT_L(8); PG8_BAR; PG8_WAIT_L(0); PG8_MMA(0, 0, At, B0); PG8_BAR; PG8_SCHED;
            PG8_LDB(B1, 0, 1); PG8_STAGE(PG8_SB(0, 0), b2, voffB);
            PG8_BAR; PG8_WAIT_L(0); PG8_MMA(0, 1, At, B1); PG8_BAR;
            PG8_LDA(At, 0, 1); PG8_STAGE(PG8_SA(0, 0), a2, fo[0]);
            PG8_BAR; PG8_WAIT_L(0); PG8_MMA(1, 0, At, B0); PG8_BAR; PG8_SCHED;
            PG8_STAGE(PG8_SB(0, 1), b2 + hstepB, voffB);
            PG8_WAIT_V(6); PG8_BAR; PG8_MMA(1, 1, At, B1); PG8_BAR;
            PG8_LDB(B0, 1, 0); PG8_SCHED; PG8_LDA(At, 1, 0); PG8_STAGE(PG8_SA(0, 1), a2, fo[1]);
            PG8_WAIT_L(8); PG8_BAR; PG8_WAIT_L(0); PG8_MMA(0, 0, At, B0); PG8_BAR; PG8_SCHED;
            PG8_LDB(B1, 1, 1); PG8_STAGE(PG8_SB(1, 0), b3, voffB);
            PG8_BAR; PG8_WAIT_L(0); PG8_MMA(0, 1, At, B1); PG8_BAR;
            PG8_LDA(At, 1, 1); PG8_STAGE(PG8_SA(1, 0), a3, fo[0]);
            PG8_BAR; PG8_WAIT_L(0); PG8_MMA(1, 0, At, B0); PG8_BAR; PG8_SCHED;
            PG8_STAGE(PG8_SB(1, 1), b3 + hstepB, voffB);
            PG8_WAIT_V(6); PG8_BAR; PG8_MMA(1, 1, At, B1); PG8_BAR;
        }
        E(acc, cur, wr, wc, fr, fq);
        if (!has_next) break;
#pragma unroll
        for (int a = 0; a < 2; ++a)
#pragma unroll
            for (int b = 0; b < 2; ++b)
#pragma unroll
                for (int m = 0; m < 4; ++m)
#pragma unroll
                    for (int n = 0; n < 2; ++n) acc[a][b][m][n] = (f32x4){0.f, 0.f, 0.f, 0.f};
        cur = nxt; cA = nA; cB = nB; ++ui;
#pragma unroll
        for (int h = 0; h < 2; ++h) { co[h][0] = no[h][0]; co[h][1] = no[h][1]; }
    }
    PG8_WAIT_V(0);
    if (wr == 0) PG8_BAR;
    PG8_BAR;
#undef PG8_SA
#undef PG8_GOFF
#undef PG8_SB
#undef PG8_STAGE
#undef PG8_LDA
#undef PG8_LDB
#undef PG8_MMA
#undef PG8_WAIT_V
#undef PG8_WAIT_L
#undef PG8_BAR
#undef PG8_SCHED
}
}

struct SchedDense {
    const char* A; const char* B; int K; int mode;
    DEVI const int* rows(int) const { return nullptr; }
    DEVI bool next(int i, pg8::Unit& u) const {
        const int c = blockIdx.x, x = c & 7; int pm, pn;
        if (mode == 0) { if (i > 0) return false; const int j = c >> 3; pn = j & 3; pm = 8 * x + (j >> 2); }
        else { if (i > 3) return false; const int bk = i * 8 + x, j = c >> 3; pn = 8 * (bk & 1) + (j & 7); pm = 4 * (bk >> 1) + (j >> 3); }
        u.a = A + (size_t)pm * 256 * K * 2; u.b = B + (size_t)pn * 256 * K * 2; u.x0 = pm; u.x1 = pn; u.x2 = 0; u.x3 = 0;
        return true;
    }
};
struct EpiOutBf16 {
    static constexpr bool GATHER_A = false; static constexpr int BHALF = 128; static DEVI int brow(int R) { return R; }
    bf16* C;
    DEVI void operator()(const f32x4 (&acc)[2][2][4][2], const pg8::Unit& u, int wr, int wc, int fr, int fq) const {
#pragma unroll
        for (int ai = 0; ai < 2; ++ai)
#pragma unroll
            for (int m = 0; m < 4; ++m) {
                bf16* rowp = C + (size_t)(u.x0 * 256 + ai * 128 + wr * 64 + m * 16 + fr) * D + u.x1 * 256 + wc * 32 + 4 * fq;
#pragma unroll
                for (int bj = 0; bj < 2; ++bj)
#pragma unroll
                    for (int n = 0; n < 2; ++n) { const f32x4 v = acc[ai][bj][m][n]; *(u32x2*)(rowp + bj * 128 + n * 16) = (u32x2){pk2(v.x, v.y), pk2(v.z, v.w)}; }
            }
    }
};
struct EpiProjBf16 {
    static constexpr bool GATHER_A = false; static constexpr int BHALF = 128; static DEVI int brow(int R) { return R; }
    bf16* C;
    DEVI void operator()(const f32x4 (&acc)[2][2][4][2], const pg8::Unit& u, int wr, int wc, int fr, int fq) const {
#pragma unroll
        for (int ai = 0; ai < 2; ++ai)
#pragma unroll
            for (int m = 0; m < 4; ++m) {
                bf16* rowp = C + (size_t)(u.x0 * 256 + ai * 128 + wr * 64 + m * 16 + fr) * NPROJ + u.x1 * 256 + wc * 32 + 4 * fq;
#pragma unroll
                for (int bj = 0; bj < 2; ++bj)
#pragma unroll
                    for (int n = 0; n < 2; ++n) { const f32x4 v = acc[ai][bj][m][n]; *(u32x2*)(rowp + bj * 128 + n * 16) = (u32x2){pk2(v.x, v.y), pk2(v.z, v.w)}; }
            }
    }
};
DEVI void phase_outproj8(const P& p, int l, char* smem_all) {
    SchedDense Sd{(const char*)(p.ws + WS_MIX), (const char*)(p.ws + WS_WOUT) + (size_t)l * D * D * 2, D, 0};
    EpiOutBf16 E{(bf16*)(p.ws + WS_OPRE)};
    pg8::gemm_phase(( LAS unsigned char*)smem_all, D, Sd, E);
}
DEVI void phase_inproj8(const P& p, int l, char* smem_all) {
    SchedDense Sd{(const char*)(p.ws + WS_HB), (const char*)(p.ws + WS_WIN) + (size_t)l * NPAD * D * 2, D, 1};
    EpiProjBf16 E{(bf16*)(p.ws + WS_PROJ)};
    pg8::gemm_phase((LAS unsigned char*)smem_all, D, Sd, E);
}
DEVI void phase_inproj_extras(const P& p, int l, char* smem) {
    const bf16* HB = (const bf16*)(p.ws + WS_HB);
    const bf16* W = (const bf16*)(p.ws + WS_WIN) + (size_t)l * NPAD * D;
    float* PEX = (float*)(p.ws + WS_PEX);
    const int lane = VTID & 63, wid = VTID >> 6, wr = wid >> 1, wc = wid & 1, fr = lane & 15, fq = lane >> 4;
    for (int mt = VBID; mt < S / 128; mt += VNB) {
        f32x4 acc[4][8];
        gemm_tile(smem, HB, [&](int r) { return (unsigned)((mt * 128 + r) * D); }, W, [&](int r) { return (unsigned)((16 * 256 + r) * D); }, D, acc);
        if (wc == 0) {
#pragma unroll
            for (int m = 0; m < 4; ++m) {
                const int tok = mt * 128 + wr * 64 + m * 16 + fr;
#pragma unroll
                for (int n = 0; n < 4; ++n) *(f32x4*)(PEX + (size_t)tok * 64 + n * 16 + fq * 4) = acc[m][n];
            }
        }
    }
}

struct MoeMap8 { int cnt[32]; int off[32]; int tstart[33]; };
DEVI void moe_map8(const P& p, int l, MoeMap8* mm) {
    const int* CNT = (const int*)(p.ws + OFF_CNT) + l * 32 * 64;
    if (threadIdx.x < 32) mm->cnt[threadIdx.x] = __hip_atomic_load(&CNT[threadIdx.x * 64], __ATOMIC_RELAXED, __HIP_MEMORY_SCOPE_AGENT);
    __syncthreads();
    if (threadIdx.x == 0) {
        int o = 0, ts = 0;
        for (int e = 0; e < 32; ++e) { mm->off[e] = o; mm->tstart[e] = ts; o += mm->cnt[e]; ts += (mm->cnt[e] + 255) / 256; }
        mm->tstart[32] = ts;
    }
    __syncthreads();
}
struct MoeUnits { int n; int pad[3]; int e[32]; int m0[32]; int pn[32]; };
struct SchedMoe {
    const MoeMap8* mm; const MoeUnits* mu; const char* A; const char* Bw; int K;
    size_t bexp, bpn;
    const int* rowtab; bool gather;
    DEVI const int* rows(int i) const { return rowtab + 256 * i; }
    DEVI bool next(int i, pg8::Unit& u) const {
        if (i >= mu->n) return false;
        const int e = mu->e[i], m0 = mu->m0[i], pn = mu->pn[i], off = mm->off[e];
        u.a = gather ? A : A + (size_t)(off + m0) * K * 2; u.b = Bw + (size_t)e * bexp + (size_t)pn * bpn;
        u.x0 = e; u.x1 = m0; u.x2 = pn; u.x3 = off;
        return true;
    }
};
DEVI void moe_units(const MoeMap8* mm, MoeUnits* mu, int npn_log, int pnb_log) {
    if (threadIdx.x < 32) {
        const int x = (int)blockIdx.x & 7, j = (int)blockIdx.x >> 3, RT = mm->tstart[32], rpb = 32 >> pnb_log, nh_log = npn_log - pnb_log;
        const int bk = (int)threadIdx.x * 8 + x, rg = bk >> nh_log, ph = bk & ((1 << nh_log) - 1);
        const int rt = rpb * rg + (j >> pnb_log), pn = (ph << pnb_log) + (j & ((1 << pnb_log) - 1));
        const bool ok = rt < RT;
        if (ok) {
            int e = 0;
            while (mm->tstart[e + 1] <= rt) ++e;
            mu->e[threadIdx.x] = e; mu->m0[threadIdx.x] = (rt - mm->tstart[e]) * 256; mu->pn[threadIdx.x] = pn;
        }
        const unsigned long long okm = __ballot(ok);
        if (threadIdx.x == 0) mu->n = __popcll(okm & 0xffffffffull);
    }
    __syncthreads();
}
struct EpiMoeUp {
    static constexpr bool GATHER_A = true;
    static constexpr int BHALF = 64;
    static DEVI int brow(int R) { return ((R >> 5) & 3) * 16 + (R & 15) + (((R >> 4) & 1) ? 1024 : 0); }
    const MoeMap8* mm; bf16* ACT; const float* bup; bf16* dump;
    DEVI void operator()(const f32x4 (&acc)[2][2][4][2], const pg8::Unit& u, int wr, int wc, int fr, int fq) const {
        const int e = u.x0, cnt = mm->cnt[e];
        const float* be = bup + (size_t)e * 2048;
        f32x4 bg[2], bl[2];
#pragma unroll
        for (int bj = 0; bj < 2; ++bj) { const int col = u.x2 * 128 + (bj * 4 + wc) * 16 + 4 * fq; bg[bj] = *(const f32x4*)(be + col); bl[bj] = *(const f32x4*)(be + 1024 + col); }
#pragma unroll
        for (int ai = 0; ai < 2; ++ai)
#pragma unroll
            for (int m = 0; m < 4; ++m) {
                const int r = u.x1 + ai * 128 + wr * 64 + m * 16 + fr;
                bf16* rowp = (r < cnt) ? ACT + (size_t)(u.x3 + r) * DFF + u.x2 * 128 + wc * 16 + 4 * fq : dump + 4 * fq;
#pragma unroll
                for (int bj = 0; bj < 2; ++bj) {
                    float o[4];
#pragma unroll
                    for (int j = 0; j < 4; ++j) {
                        const float glu = fminf(acc[ai][bj][m][0][j] + bg[bj][j], 7.f);
                        const float lin = fminf(fmaxf(acc[ai][bj][m][1][j] + bl[bj][j], -7.f), 7.f);
                        o[j] = glu * sigmoidf_(1.702f * glu) * (lin + 1.f);
                    }
                    *(u32x2*)(rowp + bj * 64) = (u32x2){pk2(o[0], o[1]), pk2(o[2], o[3])};
                }
            }
    }
};
struct EpiMoeDown {
    static constexpr bool GATHER_A = false; static constexpr int BHALF = 128; static DEVI int brow(int R) { return R; }
    const MoeMap8* mm; bf16* YB; const float* bdn; const int* LIST; const float* GATE; bf16* dump;
    DEVI void operator()(const f32x4 (&acc)[2][2][4][2], const pg8::Unit& u, int wr, int wc, int fr, int fq) const {
        const int e = u.x0, cnt = mm->cnt[e];
        const float* be = bdn + (size_t)e * D + u.x2 * 256 + wc * 32 + 4 * fq;
        f32x4 bv[2][2];
#pragma unroll
        for (int bj = 0; bj < 2; ++bj)
#pragma unroll
            for (int n = 0; n < 2; ++n) bv[bj][n] = *(const f32x4*)(be + bj * 128 + n * 16);
        int ent[8]; float gt[8];
#pragma unroll
        for (int q = 0; q < 8; ++q) { const int r = u.x1 + (q >> 2) * 128 + wr * 64 + (q & 3) * 16 + fr; ent[q] = LIST[(size_t)e * S + (r < cnt ? r : cnt - 1)]; }
#pragma unroll
        for (int q = 0; q < 8; ++q) gt[q] = GATE[ent[q]];
#pragma unroll
        for (int ai = 0; ai < 2; ++ai)
#pragma unroll
            for (int m = 0; m < 4; ++m) {
                const int q = ai * 4 + m, r = u.x1 + ai * 128 + wr * 64 + m * 16 + fr;
                bf16* rowp = (r < cnt) ? YB + (size_t)ent[q] * D + u.x2 * 256 + wc * 32 + 4 * fq : dump + 4 * fq;
#pragma unroll
                for (int bj = 0; bj < 2; ++bj)
#pragma unroll
                    for (int n = 0; n < 2; ++n) {
                        const f32x4 v = (acc[ai][bj][m][n] + bv[bj][n]) * gt[q];
                        *(u32x2*)(rowp + bj * 128 + n * 16) = (u32x2){pk2(v.x, v.y), pk2(v.z, v.w)};
                    }
            }
    }
};
DEVI void phase_moe_up8(const P& p, int l, char* smem_all) {
    MoeMap8* mm = (MoeMap8*)(smem_all + 131072);
    moe_map8(p, l, mm);
    MoeUnits* mu = (MoeUnits*)(smem_all + 131072 + 512);
    moe_units(mm, mu, 3, 3);
    int* rowtab = (int*)(smem_all + 131072 + 1024);
    {
        const int* LIST = (const int*)(p.ws + WS_LIST);
        const int nu = mu->n < 12 ? mu->n : 12;
        for (int idx = threadIdx.x; idx < nu * 256; idx += KT) {
            const int i = idx >> 8, r = idx & 255, e = mu->e[i], cnt = mm->cnt[e], rr = mu->m0[i] + r;
            rowtab[idx] = LIST[(size_t)e * S + (rr < cnt ? rr : cnt - 1)] >> 2;
        }
        __syncthreads();
    }
    SchedMoe Sm{mm, mu, (const char*)(p.ws + WS_H2), (const char*)(p.ws + WS_WUP) + (size_t)l * NEXP * 2048 * D * 2, D, (size_t)2048 * D * 2, (size_t)128 * D * 2, rowtab, true};
    EpiMoeUp E{mm, (bf16*)(p.ws + WS_ACT), p.in[33] + (size_t)l * NEXP * 2048, (bf16*)(p.ws + WS_DUMP)};
    pg8::gemm_phase((LAS unsigned char*)smem_all, D, Sm, E);
}
DEVI void phase_moe_down8(const P& p, int l, char* smem_all) {
    MoeMap8* mm = (MoeMap8*)(smem_all + 131072);
    moe_map8(p, l, mm);
    MoeUnits* mu = (MoeUnits*)(smem_all + 131072 + 512);
    moe_units(mm, mu, 2, 2);
    SchedMoe Sm{mm, mu, (const char*)(p.ws + WS_ACT), (const char*)(p.ws + WS_WDN) + (size_t)l * NEXP * D * DFF * 2, DFF, (size_t)D * DFF * 2, (size_t)256 * DFF * 2, nullptr, false};
    EpiMoeDown E{mm, (bf16*)(p.ws + WS_YB), p.in[35] + (size_t)l * NEXP * D, (const int*)(p.ws + WS_LIST), (const float*)(p.ws + WS_GATE), (bf16*)(p.ws + WS_DUMP)};
    pg8::gemm_phase((LAS unsigned char*)smem_all, DFF, Sm, E);
}

constexpr int NPHASE = 24;
constexpr int LDS_TOTAL = 2 * VB_LDS + 64;
__global__ void __launch_bounds__(KT, 2) k_run(P p) {
    extern __shared__ __attribute__((aligned(16))) char smem_all[];
    char* smem = smem_all + __builtin_amdgcn_readfirstlane((int)(threadIdx.x >> 8)) * VB_LDS;
    XcdBarrier bar; bar.bar = nullptr; bar.x = 0; bar.st = nullptr;
    const bool multi = (p.ph_hi - p.ph_lo) > 1;
    if (multi) {
        volatile LAS unsigned* st = (volatile LAS unsigned*)(smem_all + 2 * VB_LDS);
        if (threadIdx.x == 0) { st[0] = 0u; st[1] = 0u; }
        __syncthreads();
        bar = xcd_barrier_post((unsigned*)(p.ws + OFF_BAR), st);
    }
#ifndef DUP
#define DUP -1
#endif
#ifndef DUP2
#define DUP2 -1
#endif
#define RUN(k, call) if (p.ph_lo <= (k) && (k) < p.ph_hi) { for (int _rep = ((k) == DUP || (k) == DUP2) ? 2 : 1; _rep > 0; --_rep) { call; if (multi && ((k) + 1 < p.ph_hi || _rep > 1)) xcd_barrier(bar); } }
    RUN(0, phase_prep(p, smem))
    RUN(1, phase_h0(p))
    RUN(2, { phase_inproj8(p, 0, smem_all); phase_inproj_extras(p, 0, smem); })
    RUN(3, phase_mixprep(p, 0, smem))
    RUN(4, phase_chunkA(p, smem))
    RUN(5, phase_scanL1(p, smem))
    RUN(6, phase_scanL2(p, 0, smem))
    RUN(7, phase_chunkC(p, 0, smem))
    RUN(8, phase_outproj8(p, 0, smem_all))
    RUN(9, phase_ln1_route(p, 0, smem, _rep == 1))
    RUN(10, phase_moe_up8(p, 0, smem_all))
    RUN(11, phase_moe_down8(p, 0, smem_all))
    RUN(12, phase_ln2(p, 0))
    RUN(13, { phase_inproj8(p, 1, smem_all); phase_inproj_extras(p, 1, smem); })
    RUN(14, phase_mixprep(p, 1, smem))
    RUN(15, phase_chunkA(p, smem))
    RUN(16, phase_scanL1(p, smem))
    RUN(17, phase_scanL2(p, 1, smem))
    RUN(18, phase_chunkC(p, 1, smem))
    RUN(19, phase_outproj8(p, 1, smem_all))
    RUN(20, phase_ln1_route(p, 1, smem))
    RUN(21, phase_moe_up8(p, 1, smem_all))
    RUN(22, phase_moe_down8(p, 1, smem_all))
    RUN(23, phase_ln2(p, 1))
#undef RUN
}

extern "C" void kernel_launch(void* const* d_in, const int* in_sizes, int n_in, void* d_out, int out_size, void* d_ws, size_t ws_size,
                              hipStream_t stream) {
    static int grid = 0;
    if (grid == 0) {
        if (n_in != 38 || ws_size < WS_END) { fprintf(stderr, "kernel_launch: unexpected n_in %d or ws_size %zu (< %zu)\n", n_in, ws_size, (size_t)WS_END); grid = -1; return; }
        int dev = 0, cus = 0, per_cu = 0;
        hipGetDevice(&dev);
        hipDeviceGetAttribute(&cus, hipDeviceAttributeMultiprocessorCount, dev);
        hipFuncSetAttribute((const void*)k_run, hipFuncAttributeMaxDynamicSharedMemorySize, LDS_TOTAL);
        hipOccupancyMaxActiveBlocksPerMultiprocessor(&per_cu, (const void*)k_run, KT, LDS_TOTAL);
        if (per_cu < 1) { fprintf(stderr, "kernel_launch: occupancy query returned %d\n", per_cu); grid = -1; return; }
        if (cus != 256) { fprintf(stderr, "kernel_launch: built for 256 CUs (one workgroup per CU), device has %d\n", cus); grid = -1; return; }
        grid = cus;
    }
    if (grid < 0) return;
    hipMemsetAsync((char*)d_ws + WS_CTL, 0, CTL_BYTES, stream);
    P p{};
    for (int i = 0; i < 38; ++i) p.in[i] = (const float*)d_in[i];
    p.pos = (const int*)d_in[2];
    p.out = (float*)d_out; p.ws = (char*)d_ws;
#if MEGA
    p.ph_lo = 0; p.ph_hi = NPHASE;
    void* args[] = {&p};
    hipError_t e = hipLaunchCooperativeKernel((const void*)k_run, dim3(grid), dim3(KT), args, LDS_TOTAL, stream);
    if (e != hipSuccess) fprintf(stderr, "cooperative launch failed: %s (grid %d)\n", hipGetErrorString(e), grid);
#else
    for (int ph = 0; ph < NPHASE; ++ph) {
        p.ph_lo = ph; p.ph_hi = ph + 1;
        hipLaunchKernelGGL(k_run, dim3(grid), dim3(KT), LDS_TOTAL, stream, p);
    }
#endif
}
```

```cpp
#include <hip/hip_runtime.h>
#include <hip/hip_bf16.h>
#include <stdint.h>
#include <stdio.h>

#ifndef MEGA
#define MEGA 1
#endif

#define DEVI __device__ __forceinline__
#define LAS __attribute__((address_space(3)))

typedef unsigned short bf16;
typedef short bf16x8 __attribute__((ext_vector_type(8)));
typedef float f32x4 __attribute__((ext_vector_type(4)));
typedef unsigned u32x4 __attribute__((ext_vector_type(4)));
typedef unsigned u32x2 __attribute__((ext_vector_type(2)));

constexpr int S = 16384, D = 1024, NIN = 4104, NEXP = 32, DFF = 1024;
constexpr int NPROJ = 4096;
constexpr int NPAD = 4352;
constexpr float DN_ALPHA = 1.4142135623730951f;
constexpr int NT = 256;
constexpr int LDS_BYTES = 76032;

constexpr size_t MiB = 1ull << 20;
constexpr size_t WS_CTL = 0;
constexpr size_t CTL_BYTES = 1 * MiB;
constexpr size_t OFF_BAR = 0;
constexpr size_t OFF_ADA = 64 * 1024;
constexpr size_t OFF_CNT = 128 * 1024;
constexpr size_t WS_ROT = 1 * MiB;
constexpr size_t WS_WIN = WS_ROT + (size_t)S * 64 * 4;
constexpr size_t WS_WOUT = WS_WIN + 2ull * NPAD * D * 2;
constexpr size_t WS_WUP = WS_WOUT + 2ull * D * D * 2;
constexpr size_t WS_WDN = WS_WUP + 2ull * NEXP * 2048 * D * 2;
constexpr size_t WS_HB = WS_WDN + 2ull * NEXP * D * DFF * 2;
constexpr size_t WS_PROJ = WS_HB + (size_t)S * D * 2;
constexpr size_t WS_PEX = WS_PROJ + (size_t)S * NPROJ * 2;
constexpr size_t WS_VFIRST = WS_PEX + (size_t)S * 64 * 4;
constexpr size_t WS_RECR = WS_VFIRST + (size_t)S * 256 * 4;
constexpr size_t WS_RECG = WS_RECR + (size_t)S * 4 * 384 * 2;
constexpr size_t WS_RECT = WS_RECG + (size_t)S * 4 * 392 * 2;
constexpr size_t WS_WDEC = WS_RECT + (size_t)S * 4 * 192 * 2;
constexpr size_t WS_GSC = WS_WDEC + (size_t)S * 256 * 4;
constexpr size_t WS_G = WS_GSC + (size_t)S * 16 * 4;
constexpr size_t WS_BON = WS_G + (size_t)S * 256 * 4;
constexpr size_t WS_YR = WS_BON + (size_t)S * 4 * 4;
constexpr size_t WS_OG = WS_YR + (size_t)S * 256 * 4;
constexpr size_t WS_ORT = WS_OG + (size_t)S * 512 * 4;
constexpr size_t WS_MIX = WS_ORT + (size_t)S * 256 * 4;
constexpr size_t WS_OPRE = WS_MIX + (size_t)S * D * 2;
constexpr size_t WS_X = WS_OPRE + (size_t)S * D * 4;
constexpr size_t WS_H2 = WS_X + (size_t)S * D * 4;
constexpr size_t WS_LIST = WS_H2 + (size_t)S * D * 2;
constexpr size_t WS_GATE = WS_LIST + (size_t)NEXP * S * 4;
constexpr size_t WS_ACT = WS_GATE + (size_t)S * 4 * 4;
constexpr size_t WS_YB = WS_ACT + ((size_t)S * 4 + 256) * DFF * 2;
constexpr size_t WS_ADAP = WS_YB + (size_t)S * 4 * D * 2;
constexpr size_t WS_RKV = WS_ADAP + 16ull * 12288 * 4;
constexpr size_t WS_RST = WS_RKV + 256ull * 4 * 4096 * 4;
constexpr size_t WS_GP = WS_RST + 256ull * 4 * 4096 * 2;
constexpr size_t WS_GB = WS_GP + 1024ull * 16384 * 2;
constexpr size_t WS_GD = WS_GB + 1024ull * 16384 * 4;
constexpr size_t WS_GQ = WS_GD + 4096;
constexpr size_t WS_GO = WS_GQ + 1024ull * 8192 * 2;
constexpr size_t WS_GS = WS_GO + 1024ull * 8192 * 4;
constexpr size_t WS_WP = WS_GS + 1024ull * 16384 * 2;
constexpr size_t WS_WC = WS_WP + 2048ull * 4096 * 2;
constexpr size_t WS_WD = WS_WC + 2048ull * 4096 * 4;
constexpr size_t WS_WQ = WS_WD + 2048ull * 64 * 4;
constexpr size_t WS_WY = WS_WQ + 2048ull * 2048 * 2;
constexpr size_t WS_WS = WS_WY + 2048ull * 2048 * 4;
constexpr size_t WS_GR = WS_WS + 2048ull * 4096 * 2;
constexpr size_t WS_GE0 = WS_GR + 1024ull * 8192 * 2;
constexpr size_t WS_GTE = WS_GE0 + 64ull * 16384 * 4;
constexpr size_t WS_GSG = WS_GTE + 64ull * 16384 * 2;
constexpr size_t WS_WR = WS_GSG + 64ull * 16384 * 2;
constexpr size_t WS_WE0 = WS_WR + 2048ull * 2048 * 2;
constexpr size_t WS_WTE = WS_WE0 + 64ull * 4096 * 4;
constexpr size_t WS_WSG = WS_WTE + 64ull * 4096 * 2;
constexpr size_t WS_LRT = WS_WSG + 64ull * 4096 * 2;
constexpr size_t WS_DUMP = WS_LRT + 2ull * 73728 * 2;
constexpr size_t WS_RWF = WS_DUMP + 4096;
constexpr size_t WS_END = WS_RWF + 2ull * 32 * 2 * 2 * 64 * 16;

struct P {
    const float* in[38];
    const int* pos;
    float* out;
    char* ws;
    int ph_lo, ph_hi;
};

DEVI float bf2f(bf16 v) { return __uint_as_float(((unsigned)v) << 16); }
DEVI unsigned f2bf(float f) { unsigned u = __float_as_uint(f); return (u + 0x7fffu + ((u >> 16) & 1u)) >> 16; }
typedef float f32x2_t __attribute__((ext_vector_type(2)));
typedef __bf16 bf16x2_t __attribute__((ext_vector_type(2)));
DEVI unsigned pk2(float lo, float hi) { const f32x2_t v = {lo, hi}; return __builtin_bit_cast(unsigned, __builtin_convertvector(v, bf16x2_t)); }
DEVI float sigmoidf_(float x) { return __builtin_amdgcn_rcpf(1.f + __builtin_amdgcn_exp2f(-1.4426950408889634f * x)); }
DEVI float siluf_(float x) { return x * sigmoidf_(x); }
DEVI float softplusf_(float x) { return fmaxf(x, 0.f) + log1pf(__expf(-fabsf(x))); }
DEVI float wave_sum(float v) {
#pragma unroll
    for (int o = 32; o >= 1; o >>= 1) v += __shfl_xor(v, o);
    return v;
}
template <int CTRL> DEVI float dpp_mov(float x) {
    return __int_as_float(__builtin_amdgcn_update_dpp(0, __float_as_int(x), CTRL, 0xf, 0xf, false));
}
DEVI float row16_sum(float x) {
    x += dpp_mov<0x128>(x);
    x += dpp_mov<0x124>(x);
    x += dpp_mov<0x122>(x);
    x += dpp_mov<0x121>(x);
    return x;
}

DEVI bf16x8 ldfrag(const bf16* base, int ld, int row0, int k0, int lane) {
    return *(const bf16x8*)(base + (row0 + (lane & 15)) * ld + k0 + (lane >> 4) * 8);
}
DEVI f32x4 ld_bf4(const bf16* p) {
    const u32x2 v = *(const u32x2*)p;
    return (f32x4){__uint_as_float(v.x << 16), __uint_as_float(v.x & 0xffff0000u), __uint_as_float(v.y << 16), __uint_as_float(v.y & 0xffff0000u)};
}
DEVI void st_bf4(bf16* p, const f32x4& v) { *(u32x2*)p = (u32x2){pk2(v.x, v.y), pk2(v.z, v.w)}; }
DEVI float quad_sum(float v) { v += __shfl_xor(v, 16); v += __shfl_xor(v, 32); return v; }
DEVI f32x4 mfma16(bf16x8 a, bf16x8 b, f32x4 c) { return __builtin_amdgcn_mfma_f32_16x16x32_bf16(a, b, c, 0, 0, 0); }

#define VTID ((int)(threadIdx.x & 255))
#define VBID ((int)(blockIdx.x * 2 + __builtin_amdgcn_readfirstlane((int)(threadIdx.x >> 8))))
#define VNB ((int)(gridDim.x * 2))
constexpr int VB_LDS = 76032;
constexpr int KT = 512;

#define XB_TMO      128
#define XB_XCNT(j)  (256  + 64 * (j))
#define XB_XSUB(j)  (1280 + 64 * (j))
#define XB_XGEN(j)  (2304 + 64 * (j))
#define XB_TOP      3328
#define XB_TOPGEN   3392
#define XCD_BAR_WORDS 3456
#define XB_SPIN_CAP (1u << 22)
DEVI unsigned xb_ld(unsigned* p) { return __hip_atomic_load(p, __ATOMIC_RELAXED, __HIP_MEMORY_SCOPE_AGENT); }
DEVI unsigned xb_add(unsigned* p, unsigned v) { return __hip_atomic_fetch_add(p, v, __ATOMIC_RELAXED, __HIP_MEMORY_SCOPE_AGENT); }
DEVI unsigned xb_xcc_id() { return (unsigned)__builtin_amdgcn_s_getreg((3 << 11) | 20) & 0xFu; }
#define XB_SPIN(cond, bar) do { unsigned _sp = 0; while (cond) { __builtin_amdgcn_s_sleep(1); \
    if ((++_sp & 255u) == 0u) { if (xb_ld(&(bar)[XB_TMO])) break; if (_sp > XB_SPIN_CAP) { atomicAdd(&(bar)[XB_TMO], 1u); break; } } } } while (0)
struct XcdBarrier { unsigned* bar; unsigned x; volatile LAS unsigned* st; };
DEVI XcdBarrier xcd_barrier_post(unsigned* bar, volatile LAS unsigned* st) {
    XcdBarrier b; b.bar = bar; b.x = xb_xcc_id(); b.st = st;
    if (threadIdx.x == 0) (void)xb_add(&bar[XB_XCNT(b.x)], 1u);
    return b;
}
DEVI void xcd_barrier_complete(unsigned* bar, unsigned x, unsigned& nloc, unsigned& nx) {
    const unsigned G = gridDim.x * gridDim.y * gridDim.z;
    unsigned sum, cnt, mine, sp = 0u;
    for (;;) {
        sum = 0u; cnt = 0u; mine = 0u;
#pragma unroll
        for (unsigned j = 0; j < 16; ++j) { const unsigned c = xb_ld(&bar[XB_XCNT(j)]); sum += c; cnt += (c > 0u) ? 1u : 0u; mine = (j == x) ? c : mine; }
        if (sum == G) break;
        __builtin_amdgcn_s_sleep(1);
        if ((++sp & 255u) == 0u) { if (xb_ld(&bar[XB_TMO])) break; if (sp > XB_SPIN_CAP) { atomicAdd(&bar[XB_TMO], 1u); break; } }
    }
    nloc = mine > 0u ? mine : 1u; nx = cnt > 0u ? cnt : 1u;
}
DEVI void xcd_barrier(const XcdBarrier& b) {
    asm volatile("s_waitcnt vmcnt(0)" ::: "memory");
    __syncthreads();
    if (threadIdx.x == 0) {
        unsigned* bar = b.bar;
        __builtin_amdgcn_s_waitcnt(0);
        unsigned nloc = b.st[0], nx = b.st[1];
        if (nloc == 0u) { xcd_barrier_complete(bar, b.x, nloc, nx); b.st[0] = nloc; b.st[1] = nx; }
        const unsigned old = xb_add(&bar[XB_XSUB(b.x)], 1u);
        const unsigned gen = old / nloc;
        if (old + 1u == (gen + 1u) * nloc) {
            __builtin_amdgcn_fence(__ATOMIC_RELEASE, "agent");
            asm volatile("s_waitcnt vmcnt(0)" ::: "memory");
            const unsigned og = xb_add(&bar[XB_TOP], 1u);
            const unsigned tg = og / nx;
            if (og + 1u == (tg + 1u) * nx) xb_add(&bar[XB_TOPGEN], 1u);
            else XB_SPIN(xb_ld(&bar[XB_TOPGEN]) == tg, bar);
            __builtin_amdgcn_fence(__ATOMIC_ACQUIRE, "agent");
            xb_add(&bar[XB_XGEN(b.x)], 1u);
            asm volatile("s_waitcnt vmcnt(0)" ::: "memory");
        } else {
            XB_SPIN(xb_ld(&bar[XB_XGEN(b.x)]) == gen, bar);
            __builtin_amdgcn_fence(__ATOMIC_ACQUIRE, "agent");
            asm volatile("s_waitcnt vmcnt(0)" ::: "memory");
        }
    }
    __syncthreads();
}

DEVI void transpose_item(const float* __restrict__ src, size_t ld, int k0, int ns0, bf16* __restrict__ dst, int kd, int nd0, float* lds) {
    const int tid = VTID;
    float tv[32];
#pragma unroll
    for (int i = 0; i < 32; ++i) tv[i] = __builtin_nontemporal_load(&src[(size_t)(k0 + i * 4 + (tid >> 6)) * ld + ns0 + (tid & 63)]);
    asm volatile("" ::: "memory");
#pragma unroll
    for (int i = 0; i < 32; ++i) lds[(i * 4 + (tid >> 6)) * 65 + (tid & 63)] = tv[i];
    __syncthreads();
#pragma unroll
    for (int i = 0; i < 4; ++i) {
        const int q = tid + 256 * i, n = q >> 4, kc = q & 15;
        const float* s = lds + (kc * 8) * 65 + n;
        u32x4 o;
        o.x = pk2(s[0 * 65], s[1 * 65]); o.y = pk2(s[2 * 65], s[3 * 65]);
        o.z = pk2(s[4 * 65], s[5 * 65]); o.w = pk2(s[6 * 65], s[7 * 65]);
        *(u32x4*)(dst + (size_t)(nd0 + n) * kd + k0 + kc * 8) = o;
    }
    __syncthreads();
}

DEVI void phase_prep(const P& p, char* smem) {
    float* lds = (float*)smem;
    const int tid = VTID;
    const int nb = VNB, bid = VBID;
    bf16* WIN = (bf16*)(p.ws + WS_WIN); bf16* WOUT = (bf16*)(p.ws + WS_WOUT);
    bf16* WUP = (bf16*)(p.ws + WS_WUP); bf16* WDN = (bf16*)(p.ws + WS_WDN);
    constexpr int I_UP = 2 * NEXP * 8 * 32;
    constexpr int I_DN = 2 * NEXP * 8 * 16;
    constexpr int I_IN = 2 * 8 * 64;
    constexpr int I_OUT = 2 * 8 * 16;
    constexpr int I_EX = 2 * 256;
    constexpr int I_ADA = 2 * 24 * 16;
    constexpr int I_ROT = S * 32 / 256;
    constexpr int I_LR = 2 * 288;
    constexpr int I_RW = 2 * 16;
    constexpr int NITEMS = I_UP + I_DN + I_IN + I_OUT + I_EX + I_ADA + I_ROT + I_LR + I_RW;
    constexpr int I_TR = I_UP + I_DN + I_IN + I_OUT;
    static_assert((I_TR % 512) % 2 == 0, "the two halves of every workgroup must run the same number of transpose items (they contain barriers)");
    for (int it = bid; it < NITEMS; it += nb) {
        int r = it;
        if (r < I_UP) {
            const int le = r / 256, q = r % 256, kt = q / 32, nt = q % 32;
            transpose_item(p.in[32] + (size_t)le * D * 2048, 2048, kt * 128, nt * 64, WUP + (size_t)le * 2048 * D, D, nt * 64, lds);
            continue;
        }
        r -= I_UP;
        if (r < I_DN) {
            const int le = r / 128, q = r % 128, kt = q / 16, nt = q % 16;
            transpose_item(p.in[34] + (size_t)le * DFF * D, D, kt * 128, nt * 64, WDN + (size_t)le * D * DFF, DFF, nt * 64, lds);
            continue;
        }
        r -= I_DN;
        if (r < I_IN) {
            const int l = r / 512, q = r % 512, kt = q / 64, nt = q % 64;
            const int nd0 = nt * 64, ns0 = nd0 < 3072 ? nd0 : nd0 + 8;
            transpose_item(p.in[5] + (size_t)l * D * NIN, NIN, kt * 128, ns0, WIN + (size_t)l * NPAD * D, D, nd0, lds);
            continue;
        }
        r -= I_IN;
        if (r < I_OUT) {
            const int l = r / 128, q = r % 128, kt = q / 16, nt = q % 16;
            transpose_item(p.in[27] + (size_t)l * D * D, D, kt * 128, nt * 64, WOUT + (size_t)l * D * D, D, nt * 64, lds);
            continue;
        }
        r -= I_OUT;
        if (r < I_EX) {
            const int l = r / 256, n = r % 256;
            bf16* dst = WIN + ((size_t)l * NPAD + NPROJ + n) * D;
            for (int k = tid; k < D; k += NT) {
                float v = 0.f;
                if (n < 8) v = p.in[5][(size_t)l * D * NIN + (size_t)k * NIN + 3072 + n];
                else if (n < 40 && l == 1) v = p.in[6][(size_t)k * 32 + (n - 8)];
                dst[k] = (bf16)f2bf(v);
            }
            continue;
        }
        r -= I_EX;
        if (r < I_ADA) {
            const int l = r / 384, q = r % 384, nc = q / 16, kc = q % 16;
            const int n = nc * 256 + tid;
            const float* W = p.in[3] + (size_t)l * D * 6144;
            float acc = (kc == 0) ? p.in[4][l * 6144 + n] : 0.f;
            for (int k = kc * 64; k < kc * 64 + 64; ++k) acc += siluf_(p.in[1][k]) * W[(size_t)k * 6144 + n];
            ((float*)(p.ws + WS_ADAP))[(size_t)kc * 12288 + l * 6144 + n] = acc;
            continue;
        }
        r -= I_ADA;
        if (r >= I_ROT + I_LR) {
            r -= I_ROT + I_LR;
            const int l = r >> 4, idx = (r & 15) * 256 + tid, kk = idx >> 7, n = (idx >> 6) & 1, ln = idx & 63;
            const float* rw = p.in[30] + (size_t)l * D * 32 + (size_t)(32 * kk + 8 * (ln >> 4)) * 32 + 16 * n + (ln & 15);
            unsigned hi[4], lo[4];
#pragma unroll
            for (int q = 0; q < 4; ++q) {
                const float a = rw[(2 * q) * 32], b = rw[(2 * q + 1) * 32];
                hi[q] = pk2(a, b);
                lo[q] = pk2(a - __uint_as_float(hi[q] << 16), b - __uint_as_float(hi[q] & 0xffff0000u));
            }
            u32x4* dst = (u32x4*)(p.ws + WS_RWF) + ((size_t)((l * 32 + kk) * 2 + n) * 2) * 64 + ln;
            dst[0] = (u32x4){hi[0], hi[1], hi[2], hi[3]}; dst[64] = (u32x4){lo[0], lo[1], lo[2], lo[3]};
            continue;
        }
        if (r >= I_ROT) {
            r -= I_ROT;
            const int l = r / 288, kk = r % 288, c = tid;
            bf16* LRT = (bf16*)(p.ws + WS_LRT) + (size_t)l * 73728;
            if (kk < 64) LRT[c * 64 + kk] = (bf16)f2bf(p.in[10][(l * 64 + kk) * 256 + c]);
            else if (kk < 128) LRT[16384 + c * 64 + (kk - 64)] = (bf16)f2bf(p.in[12][(l * 64 + kk - 64) * 256 + c]);
            else if (kk < 256) LRT[32768 + c * 128 + (kk - 128)] = (bf16)f2bf(p.in[13][(l * 128 + kk - 128) * 256 + c]);
            else LRT[65536 + c * 32 + (kk - 256)] = (bf16)f2bf(l == 1 ? p.in[20][(kk - 256) * 256 + c] : 0.f);
            continue;
        }
        {
            const int idx = r * 256 + tid;
            const int t = idx >> 5, i = idx & 31;
            const float invf = (float)pow(10000.0, -(double)i / 32.0);
            const float ang = (float)p.pos[t] * invf;
            float sn, cs; sincosf(ang, &sn, &cs);
            float* ROT = (float*)(p.ws + WS_ROT);
            ROT[(size_t)idx * 2] = cs; ROT[(size_t)idx * 2 + 1] = sn;
        }
    }
}

DEVI float ada_sum(const float* ADAP, int idx) {
    float s = 0.f;
#pragma unroll
    for (int kc = 0; kc < 16; ++kc) s += ADAP[(size_t)kc * 12288 + idx];
    return s;
}
DEVI void phase_h0(const P& p) {
    const float* ADAP = (const float*)(p.ws + WS_ADAP);
    float* ADA = (float*)(p.ws + OFF_ADA);
    bf16* HB = (bf16*)(p.ws + WS_HB);
    if (VBID < 48) ADA[VBID * 256 + VTID] = ada_sum(ADAP, VBID * 256 + VTID);
    const size_t n4 = (size_t)S * D / 4;
    const int c = (int)(((size_t)VBID * NT + VTID) % (D / 4)) * 4;
    f32x4 sh, sc;
    sh.x = ada_sum(ADAP, c); sh.y = ada_sum(ADAP, c + 1); sh.z = ada_sum(ADAP, c + 2); sh.w = ada_sum(ADAP, c + 3);
    sc.x = ada_sum(ADAP, 1024 + c); sc.y = ada_sum(ADAP, 1025 + c); sc.z = ada_sum(ADAP, 1026 + c); sc.w = ada_sum(ADAP, 1027 + c);
    for (size_t i = (size_t)VBID * NT + VTID; i < n4; i += (size_t)VNB * NT) {
        const f32x4 x = ((const f32x4*)p.in[0])[i];
        u32x2 o;
        o.x = pk2(x.x * (1.f + sc.x) + sh.x, x.y * (1.f + sc.y) + sh.y);
        o.y = pk2(x.z * (1.f + sc.z) + sh.z, x.w * (1.f + sc.w) + sh.w);
        ((u32x2*)HB)[i] = o;
    }
}

template <class AF, class BF>
DEVI void gemm_tile(char* smem, const bf16* __restrict__ Abase, AF arow, const bf16* __restrict__ Bbase, BF brow, int K, f32x4 (&acc)[4][8]) {
    const int tid = VTID, wid = tid >> 6, lane = tid & 63, wr = wid >> 1, wc = wid & 1, fr = lane & 15, fq = lane >> 4;
    const int r0 = tid >> 2;
    const int swz = ((tid & 3) ^ ((0x1320 >> (4 * ((tid >> 4) & 3))) & 3)) * 8;
    unsigned pa[2], pb[4];
#pragma unroll
    for (int i = 0; i < 2; ++i) pa[i] = arow(r0 + 64 * i) + swz;
#pragma unroll
    for (int i = 0; i < 4; ++i) pb[i] = brow(r0 + 64 * i) + swz;
#pragma unroll
    for (int m = 0; m < 4; ++m)
#pragma unroll
        for (int n = 0; n < 8; ++n) acc[m][n] = (f32x4){0.f, 0.f, 0.f, 0.f};
    const int nk = K / 32;
    const int ch = (fq ^ ((0x1320 >> (4 * ((fr >> 2) & 3))) & 3)) * 16;
#define GT_STAGE(kt) do { char* _sa = smem + ((kt) % 3) * 24576; char* _sb = _sa + 8192; \
        _Pragma("unroll") for (int _i = 0; _i < 2; ++_i) \
            __builtin_amdgcn_global_load_lds((const unsigned*)(Abase + pa[_i] + (kt) * 32), (unsigned*)(_sa + (tid + 256 * _i) * 16), 16, 0, 0); \
        _Pragma("unroll") for (int _i = 0; _i < 4; ++_i) \
            __builtin_amdgcn_global_load_lds((const unsigned*)(Bbase + pb[_i] + (kt) * 32), (unsigned*)(_sb + (tid + 256 * _i) * 16), 16, 0, 0); } while (0)
    asm volatile("s_waitcnt vmcnt(0)" ::: "memory");
    GT_STAGE(0); GT_STAGE(1);
    for (int kt = 0; kt < nk; ++kt) {
        if (kt + 1 < nk) asm volatile("s_waitcnt vmcnt(6)" ::: "memory");
        else asm volatile("s_waitcnt vmcnt(0)" ::: "memory");
        asm volatile("s_waitcnt lgkmcnt(0)" ::: "memory");
        __builtin_amdgcn_s_barrier();
        if (kt + 2 < nk) GT_STAGE(kt + 2);
        const char* SA = smem + (kt % 3) * 24576; const char* SB = SA + 8192;
        bf16x8 af[4], bfr[8];
#pragma unroll
        for (int m = 0; m < 4; ++m) af[m] = *(const bf16x8*)(SA + (wr * 64 + m * 16 + fr) * 64 + ch);
#pragma unroll
        for (int n = 0; n < 8; ++n) bfr[n] = *(const bf16x8*)(SB + (wc * 128 + n * 16 + fr) * 64 + ch);
#pragma unroll
        for (int m = 0; m < 4; ++m)
#pragma unroll
            for (int n = 0; n < 8; ++n)
                acc[m][n] = __builtin_amdgcn_mfma_f32_16x16x32_bf16(bfr[n], af[m], acc[m][n], 0, 0, 0);
    }
    asm volatile("s_waitcnt lgkmcnt(0)" ::: "memory");
    __builtin_amdgcn_s_barrier();
#undef GT_STAGE
}

DEVI float proj_at(const bf16* PROJ, int t, int col) { return bf2f(PROJ[(size_t)t * NPROJ + col]); }
DEVI float proj_shift(const bf16* PROJ, int t, int col, float mu) {
    const float cur = proj_at(PROJ, t, col);
    const float prv = t > 0 ? proj_at(PROJ, t - 1, col) : 0.f;
    return cur + (prv - cur) * mu;
}

DEVI f32x4 shift4(const bf16* PROJ, int t, int col, const f32x4& mu) {
    const f32x4 cur = ld_bf4(PROJ + (size_t)t * NPROJ + col);
    f32x4 prv = ld_bf4(PROJ + (size_t)(t > 0 ? t - 1 : 0) * NPROJ + col);
    const float keep = t > 0 ? 1.f : 0.f;
    prv = prv * keep;
    return cur + (prv - cur) * mu;
}
DEVI float fsig(float x) { return sigmoidf_(x); }
DEVI void phase_mixprep(const P& p, int l, char* smem) {
    const bf16* PROJ = (const bf16*)(p.ws + WS_PROJ); const float* PEX = (const float*)(p.ws + WS_PEX);
    float* VFIRST = (float*)(p.ws + WS_VFIRST);
    bf16* RECR = (bf16*)(p.ws + WS_RECR); bf16* RECG = (bf16*)(p.ws + WS_RECG); bf16* RECT = (bf16*)(p.ws + WS_RECT);
    float* WDEC = (float*)(p.ws + WS_WDEC); float* GSC = (float*)(p.ws + WS_GSC);
    float* GB = (float*)(p.ws + WS_G); float* BON = (float*)(p.ws + WS_BON);
    const float* ROT = (const float*)(p.ws + WS_ROT);
    const bf16* LRT = (const bf16*)(p.ws + WS_LRT) + (size_t)l * 73728;
    bf16* L = (bf16*)smem;
    float* CW = (float*)(smem + 9728);
    float* MU = CW + 6144;
    float* PW0 = MU + 1024; float* PA0 = PW0 + 256; float* PKK = PA0 + 256; float* PKA = PKK + 256; float* PRK = PKA + 256; float* PV0 = PRK + 256;
    {
        const int tid = VTID;
        for (int i = tid; i < 6144; i += NT) CW[i] = p.in[21][l * 6144 + i];
        for (int i = tid; i < 1024; i += NT) MU[i] = p.in[7][l * 1024 + i];
        PW0[tid] = p.in[9][l * 256 + tid]; PA0[tid] = p.in[11][l * 256 + tid]; PKK[tid] = p.in[14][l * 256 + tid];
        PKA[tid] = p.in[15][l * 256 + tid]; PRK[tid] = p.in[16][l * 256 + tid]; PV0[tid] = (l == 1) ? p.in[19][tid] : 0.f;
    }
    __syncthreads();
    for (int item = VBID; item < S / 16; item += VNB) {
        int tid = VTID; asm volatile("" : "+v"(tid));
        const int lane = tid & 63, w = tid >> 6, fr = lane & 15, fq = lane >> 4;
        const int t0 = item * 16;
        {
            u32x2 cur[5], prv[5]; f32x4 xc[5], xp[5];
#pragma unroll
            for (int q = 0; q < 5; ++q) {
                const int g = tid + 256 * q, gg = g < 1152 ? g : 1151, tt = gg / 72, i4 = (gg % 72) * 4, t = t0 + tt, tp = t > 0 ? t - 1 : 0;
                const int ia = i4 < 256 ? i4 : 252, ib = i4 < 256 ? 0 : i4 - 256;
                cur[q] = *(const u32x2*)(PROJ + (size_t)t * NPROJ + 768 + ia); prv[q] = *(const u32x2*)(PROJ + (size_t)tp * NPROJ + 768 + ia);
                xc[q] = *(const f32x4*)(PEX + (size_t)t * 64 + 8 + ib); xp[q] = *(const f32x4*)(PEX + (size_t)tp * 64 + 8 + ib);
            }
            asm volatile("" ::: "memory");
#pragma unroll
            for (int q = 0; q < 5; ++q) {
                const int g = tid + 256 * q, gg = g < 1152 ? g : 1151, tt = gg / 72, i4 = (gg % 72) * 4, t = t0 + tt;
                const float keep = t > 0 ? 1.f : 0.f;
                f32x4 v;
                if (i4 < 256) {
                    const f32x4 c4 = {__uint_as_float(cur[q].x << 16), __uint_as_float(cur[q].x & 0xffff0000u), __uint_as_float(cur[q].y << 16), __uint_as_float(cur[q].y & 0xffff0000u)};
                    const f32x4 p4 = (f32x4){__uint_as_float(prv[q].x << 16), __uint_as_float(prv[q].x & 0xffff0000u), __uint_as_float(prv[q].y << 16), __uint_as_float(prv[q].y & 0xffff0000u)} * keep;
                    v = c4 + (p4 - c4) * *(const f32x4*)(MU + 768 + i4);
                    if (i4 < 64) { v.x = tanhf(v.x); v.y = tanhf(v.y); v.z = tanhf(v.z); v.w = tanhf(v.w); }
                    else if (i4 >= 128) { v.x = fsig(v.x); v.y = fsig(v.y); v.z = fsig(v.z); v.w = fsig(v.w); }
                } else {
                    v = (f32x4){0.f, 0.f, 0.f, 0.f};
                    if (l == 1) v = xc[q] + (xp[q] * keep - xc[q]) * *(const f32x4*)(p.in[8] + (i4 - 256));
                }
                if (g < 1152) *(u32x2*)(L + tt * 296 + i4) = (u32x2){pk2(v.x, v.y), pk2(v.z, v.w)};
            }
        }
        __syncthreads();
        const int t = t0 + fr, h = w, tpv = t > 0 ? t - 1 : 0;
        const float keep = t > 0 ? 1.f : 0.f;
        u32x2 raw[2][4][4];
        size_t rowo[4];
        float tapm[4];
#pragma unroll
        for (int tap = 0; tap < 4; ++tap) { const int tp = t - 3 + tap; rowo[tap] = (size_t)(tp >= 0 ? tp : 0) * NPROJ; tapm[tap] = tp >= 0 ? 1.f : 0.f; }
#define GDN_LOAD(buf, b) do { _Pragma("unroll") for (int _i = 0; _i < 4; ++_i) _Pragma("unroll") for (int _tap = 0; _tap < 4; ++_tap) \
                raw[buf][_i][_tap] = *(const u32x2*)(PROJ + rowo[_tap] + 1024 + ((b) >> 1) * 512 + h * 128 + 16 * (((b) & 1) * 4 + _i) + 4 * fq); } while (0)
        {
            f32x4 aw[4], aa[4], ag[4], av[4];
#pragma unroll
            for (int i = 0; i < 4; ++i) { aw[i] = (f32x4){0.f, 0.f, 0.f, 0.f}; aa[i] = aw[i]; ag[i] = aw[i]; av[i] = aw[i]; }
            u32x2 rc[4], rp[4], kc[4], kp[4], vc[4], vp[4]; f32x4 vf4[4];
#pragma unroll
            for (int i2 = 0; i2 < 4; ++i2) {
                const int c2 = 64 * h + 16 * i2 + 4 * fq;
                rc[i2] = *(const u32x2*)(PROJ + (size_t)t * NPROJ + c2); rp[i2] = *(const u32x2*)(PROJ + (size_t)tpv * NPROJ + c2);
                kc[i2] = *(const u32x2*)(PROJ + (size_t)t * NPROJ + 256 + c2); kp[i2] = *(const u32x2*)(PROJ + (size_t)tpv * NPROJ + 256 + c2);
                vc[i2] = *(const u32x2*)(PROJ + (size_t)t * NPROJ + 512 + c2); vp[i2] = *(const u32x2*)(PROJ + (size_t)tpv * NPROJ + 512 + c2);
                if (l == 1) vf4[i2] = *(const f32x4*)(VFIRST + (size_t)t * 256 + c2);
            }
            asm volatile("" ::: "memory");
            bf16x8 lf[9];
#pragma unroll
            for (int ks = 0; ks < 9; ++ks) lf[ks] = *(const bf16x8*)(L + fr * 296 + ks * 32 + fq * 8);
#pragma unroll
            for (int i = 0; i < 4; ++i) {
                const int c = 64 * h + 16 * i + fr;
#pragma unroll
                for (int ks = 0; ks < 2; ++ks) aw[i] = mfma16(*(const bf16x8*)(LRT + c * 64 + ks * 32 + fq * 8), lf[ks], aw[i]);
#pragma unroll
                for (int ks = 0; ks < 2; ++ks) aa[i] = mfma16(*(const bf16x8*)(LRT + 16384 + c * 64 + ks * 32 + fq * 8), lf[2 + ks], aa[i]);
#pragma unroll
                for (int ks = 0; ks < 4; ++ks) ag[i] = mfma16(*(const bf16x8*)(LRT + 32768 + c * 128 + ks * 32 + fq * 8), lf[4 + ks], ag[i]);
                if (l == 1) av[i] = mfma16(*(const bf16x8*)(LRT + 65536 + c * 32 + fq * 8), lf[8], av[i]);
            }
            bf16* rec = RECR + ((size_t)t * 4 + h) * 384;
            f32x4 kx[4], as_[4];
            float ss = 0.f, bsum = 0.f;
#define UNPK4(u) ((f32x4){__uint_as_float((u).x << 16), __uint_as_float((u).x & 0xffff0000u), __uint_as_float((u).y << 16), __uint_as_float((u).y & 0xffff0000u)})
#pragma unroll
            for (int i = 0; i < 4; ++i) {
                const int j = 16 * i + 4 * fq, c = 64 * h + j;
                const f32x4 r0 = UNPK4(rc[i]), k0 = UNPK4(kc[i]), v0_ = UNPK4(vc[i]);
                const f32x4 r = r0 + (UNPK4(rp[i]) * keep - r0) * *(const f32x4*)(MU + c);
                const f32x4 k = k0 + (UNPK4(kp[i]) * keep - k0) * *(const f32x4*)(MU + 256 + c);
                f32x4 v = v0_ + (UNPK4(vp[i]) * keep - v0_) * *(const f32x4*)(MU + 512 + c);
                const f32x4 w0 = *(const f32x4*)(PW0 + c), a0 = *(const f32x4*)(PA0 + c);
                const f32x4 kkc = *(const f32x4*)(PKK + c), kac = *(const f32x4*)(PKA + c), rkc = *(const f32x4*)(PRK + c);
                f32x4 dec, a;
#pragma unroll
                for (int q = 0; q < 4; ++q) {
                    const float wl = -softplusf_(-(w0[q] + aw[i][q])) - 0.5f;
                    dec[q] = __expf(-__expf(wl));
                    a[q] = fsig(a0[q] + aa[i][q]);
                }
                if (l == 0) *(f32x4*)(VFIRST + (size_t)t * 256 + c) = v;
                else {
                    const f32x4 v0 = *(const f32x4*)(PV0 + c);
#pragma unroll
                    for (int q = 0; q < 4; ++q) v[q] = v[q] + (vf4[i][q] - v[q]) * fsig(v0[q] + av[i][q]);
                }
                kx[i] = k * kkc; as_[i] = a;
                const f32x4 k2 = k * ((a - 1.f) * kac + 1.f);
                ss += kx[i].x * kx[i].x + kx[i].y * kx[i].y + kx[i].z * kx[i].z + kx[i].w * kx[i].w;
                const f32x4 rb = r * k2 * rkc;
                bsum += (rb.x + rb.y) + (rb.z + rb.w);
                *(f32x4*)(WDEC + (size_t)t * 256 + c) = dec; st_bf4(rec + 192 + j, k2); st_bf4(rec + 256 + j, r); st_bf4(rec + 320 + j, v);
                *(f32x4*)(GB + (size_t)t * 256 + c) = ag[i];
            }
            asm volatile("" ::: "memory");
            GDN_LOAD(0, 0);
            asm volatile("" ::: "memory");
            const float rn = rsqrtf(quad_sum(ss) + 1e-12f);
            bsum = quad_sum(bsum);
            if (fq == 0) BON[(size_t)t * 4 + h] = bsum;
#pragma unroll
            for (int i = 0; i < 4; ++i) {
                const int j = 16 * i + 4 * fq;
                const f32x4 kk = kx[i] * rn;
                st_bf4(rec + j, -kk); st_bf4(rec + 128 + j, kk * as_[i]);
            }
        }
        u32x2 q1r[2], q2r[2], k1r[2], k2r[2], vr[4]; f32x4 c0r[2], c1r[2];
        {
            bf16* rec = RECG + ((size_t)t * 4 + h) * 392;
            f32x4 yq[8], yk[8];
            float sq = 0.f, sk = 0.f;
#pragma unroll
            for (int b = 0; b < 6; ++b) {
                const int which = b >> 1;
                asm volatile("" ::: "memory");
                if (b + 1 < 6) GDN_LOAD((b + 1) & 1, b + 1);
                asm volatile("" ::: "memory");
#pragma unroll
                for (int i4 = 0; i4 < 4; ++i4) {
                    const int i = (b & 1) * 4 + i4;
                    const int j = 16 * i + 4 * fq, ch = which * 512 + h * 128 + j;
                    f32x4 cv = {0.f, 0.f, 0.f, 0.f};
#pragma unroll
                    for (int tap = 0; tap < 4; ++tap) cv = cv + UNPK4(raw[b & 1][i4][tap]) * (*(const f32x4*)(CW + tap * 1536 + ch) * tapm[tap]);
                    f32x4 y; y.x = siluf_(cv.x); y.y = siluf_(cv.y); y.z = siluf_(cv.z); y.w = siluf_(cv.w);
                    if (which == 0) { yq[i] = y; sq += y.x * y.x + y.y * y.y + y.z * y.z + y.w * y.w; }
                    else if (which == 1) { yk[i] = y; sk += y.x * y.x + y.y * y.y + y.z * y.z + y.w * y.w; }
                    else st_bf4(rec + 256 + j, y);
                }
            }
#undef GDN_LOAD
            asm volatile("" ::: "memory");
#pragma unroll
            for (int u = 0; u < 2; ++u) {
                const int i = 16 * u + 4 * fq;
                c0r[u] = *(const f32x4*)(ROT + ((size_t)t * 32 + i) * 2); c1r[u] = *(const f32x4*)(ROT + ((size_t)t * 32 + i) * 2 + 4);
                q1r[u] = *(const u32x2*)(PROJ + (size_t)t * NPROJ + 3072 + h * 64 + i); q2r[u] = *(const u32x2*)(PROJ + (size_t)t * NPROJ + 3072 + h * 64 + 32 + i);
                k1r[u] = *(const u32x2*)(PROJ + (size_t)t * NPROJ + 3328 + h * 64 + i); k2r[u] = *(const u32x2*)(PROJ + (size_t)t * NPROJ + 3328 + h * 64 + 32 + i);
            }
#pragma unroll
            for (int i = 0; i < 4; ++i) vr[i] = *(const u32x2*)(PROJ + (size_t)t * NPROJ + 3584 + h * 64 + 16 * i + 4 * fq);
            asm volatile("" ::: "memory");
            const float rq = rsqrtf(quad_sum(sq) + 1e-12f) * 0.08838834764831845f, rk = rsqrtf(quad_sum(sk) + 1e-12f);
#pragma unroll
            for (int i = 0; i < 8; ++i) { const int j = 16 * i + 4 * fq; st_bf4(rec + j, yq[i] * rq); st_bf4(rec + 128 + j, yk[i] * rk); }
            if (fq == 0) {
                const float av = PEX[(size_t)t * 64 + h], bv = PEX[(size_t)t * 64 + 4 + h];
                const float g = -__expf(p.in[22][l * 4 + h]) * softplusf_(av + p.in[23][l * 4 + h]);
                *(f32x4*)(GSC + ((size_t)t * 4 + h) * 4) = (f32x4){__expf(g), fsig(bv), g, 0.f};
            }
        }
        {
            bf16* rec = RECT + ((size_t)t * 4 + h) * 192;
#pragma unroll
            for (int u = 0; u < 2; ++u) {
                const int i = 16 * u + 4 * fq;
                const f32x4 cs = {c0r[u].x, c0r[u].z, c1r[u].x, c1r[u].z}, sn = {c0r[u].y, c0r[u].w, c1r[u].y, c1r[u].w};
                const f32x4 q1 = UNPK4(q1r[u]), q2 = UNPK4(q2r[u]), k1 = UNPK4(k1r[u]), k2 = UNPK4(k2r[u]);
                st_bf4(rec + i, q1 * cs - q2 * sn); st_bf4(rec + 32 + i, q1 * sn + q2 * cs);
                st_bf4(rec + 64 + i, (k1 * cs - k2 * sn) * 0.125f); st_bf4(rec + 96 + i, (k1 * sn + k2 * cs) * 0.125f);
            }
#pragma unroll
            for (int i = 0; i < 4; ++i) *(u32x2*)(rec + 128 + 16 * i + 4 * fq) = vr[i];
        }
#undef UNPK4
        __syncthreads();
    }
}

DEVI void retA_item(const P& p, int item, char* smem) {
    const bf16* REC = (const bf16*)(p.ws + WS_RECT); float* KV = (float*)(p.ws + WS_RKV);
    bf16* KT = (bf16*)smem; bf16* VT = KT + 64 * 72;
    const int n = item >> 2, h = item & 3;
    int tid = VTID; asm volatile("" : "+v"(tid));
    const int lane = tid & 63, w = tid >> 6, fr = lane & 15, fq = lane >> 4;
    const float lg = log2f(1.f - exp2f(-5.f - (float)h));
    {
        u32x4 v[4];
#pragma unroll
        for (int i = 0; i < 4; ++i) { const int idx = tid + 256 * i, c = idx >> 4, j = idx & 15; v[i] = *(const u32x4*)(REC + ((size_t)(n * 64 + c) * 4 + h) * 192 + 64 + j * 8); }
#pragma unroll
        for (int i = 0; i < 4; ++i) {
            const int idx = tid + 256 * i, c = idx >> 4, j = idx & 15;
            const float sc = (j < 8) ? exp2f((float)(63 - c) * lg) : 1.f;
            bf16* dst = ((j < 8) ? KT : VT) + ((j & 7) * 8) * 72 + c;
#pragma unroll
            for (int q = 0; q < 4; ++q) {
                const unsigned u = v[i][q];
                dst[(2 * q) * 72] = (j < 8) ? (bf16)f2bf(__uint_as_float(u << 16) * sc) : (bf16)(u & 0xffffu);
                dst[(2 * q + 1) * 72] = (j < 8) ? (bf16)f2bf(__uint_as_float(u & 0xffff0000u) * sc) : (bf16)(u >> 16);
            }
        }
    }
    __syncthreads();
    {
        const int dt = w;
        const bf16x8 a0 = ldfrag(KT, 72, 16 * dt, 0, lane), a1 = ldfrag(KT, 72, 16 * dt, 32, lane);
        float* out = KV + (size_t)item * 4096;
        const int s_ = dt >> 1, lane2 = 16 * (2 * (dt & 1) + (fq >> 1)) + fr;
#pragma unroll
        for (int et = 0; et < 4; ++et) {
            f32x4 acc = {0.f, 0.f, 0.f, 0.f};
            acc = mfma16(a0, ldfrag(VT, 72, 16 * et, 0, lane), acc);
            acc = mfma16(a1, ldfrag(VT, 72, 16 * et, 32, lane), acc);
            *(f32x4*)(out + ((et * 2 + s_) * 64 + lane2) * 8 + 4 * (fq & 1)) = acc;
        }
    }
    __syncthreads();
}

DEVI void retS_item(const P& p, int item) {
    const float* KV = (const float*)(p.ws + WS_RKV); bf16* RST = (bf16*)(p.ws + WS_RST);
    const int idx = item * NT + VTID;
    const int h = idx >> 12, i = idx & 4095;
    const float cd = exp2f(64.f * log2f(1.f - exp2f(-5.f - (float)h)));
    float r = 0.f;
#pragma unroll 1
    for (int n0 = 0; n0 < 256; n0 += 32) {
        float kv[32];
#pragma unroll
        for (int q = 0; q < 32; ++q) kv[q] = KV[((size_t)(n0 + q) * 4 + h) * 4096 + i];
#pragma unroll
        for (int q = 0; q < 32; ++q) { RST[((size_t)(n0 + q) * 4 + h) * 4096 + i] = (bf16)f2bf(r); r = r * cd + kv[q]; }
    }
}

DEVI void retC_item(const P& p, int item, int l, char* smem) {
    const bf16* REC = (const bf16*)(p.ws + WS_RECT); const bf16* RST = (const bf16*)(p.ws + WS_RST);
    const bf16* PROJ = (const bf16*)(p.ws + WS_PROJ); bf16* MIX = (bf16*)(p.ws + WS_MIX);
    const float* rgn = p.in[25] + l * 256; const float* rbn = p.in[26] + l * 256;
    bf16* Qs = (bf16*)smem; bf16* Ks = Qs + 64 * 72; bf16* VT = Ks + 64 * 72; bf16* Ps = VT + 64 * 72;
    const int n = item >> 2, h = item & 3;
    int tid = VTID; asm volatile("" : "+v"(tid));
    const int lane = tid & 63, w = tid >> 6, fr = lane & 15, fq = lane >> 4;
    const float lg = log2f(1.f - exp2f(-5.f - (float)h));
    {
        u32x4 v[6];
#pragma unroll
        for (int i = 0; i < 6; ++i) { const int idx = tid + 256 * i, c = idx / 24, j = idx - c * 24; v[i] = *(const u32x4*)(REC + ((size_t)(n * 64 + c) * 4 + h) * 192 + j * 8); }
#pragma unroll
        for (int i = 0; i < 6; ++i) {
            const int idx = tid + 256 * i, c = idx / 24, j = idx - c * 24;
            if (j < 16) *(u32x4*)(((j < 8) ? Qs : Ks) + c * 72 + (j & 7) * 8) = v[i];
            else {
                bf16* dst = VT + ((j & 7) * 8) * 72 + c;
#pragma unroll
                for (int q = 0; q < 4; ++q) { const unsigned u = v[i][q]; dst[(2 * q) * 72] = (bf16)(u & 0xffffu); dst[(2 * q + 1) * 72] = (bf16)(u >> 16); }
            }
        }
    }
    __syncthreads();
    const int ct = w, c = 16 * ct + fr;
    const bf16x8 q0 = ldfrag(Qs, 72, 16 * ct, 0, lane), q1 = ldfrag(Qs, 72, 16 * ct, 32, lane);
#pragma unroll
    for (int ct2 = 0; ct2 < 4; ++ct2) {
        f32x4 acc = {0.f, 0.f, 0.f, 0.f};
        acc = mfma16(ldfrag(Ks, 72, 16 * ct2, 0, lane), q0, acc);
        acc = mfma16(ldfrag(Ks, 72, 16 * ct2, 32, lane), q1, acc);
        float pv[4];
#pragma unroll
        for (int j = 0; j < 4; ++j) {
            const int c2 = 16 * ct2 + 4 * fq + j;
            pv[j] = (c >= c2) ? acc[j] * exp2f((float)(c - c2) * lg) : 0.f;
        }
        *(u32x2*)(Ps + c * 72 + 16 * ct2 + 4 * fq) = (u32x2){pk2(pv[0], pv[1]), pk2(pv[2], pv[3])};
    }
    __syncthreads();
    {
        const bf16x8 p0 = ldfrag(Ps, 72, 16 * ct, 0, lane), p1 = ldfrag(Ps, 72, 16 * ct, 32, lane);
        const float xi = exp2f((float)(c + 1) * lg);
        const bf16* RF = RST + (size_t)item * 4096;
        f32x4 o[4];
        float sm = 0.f;
        bf16x8 rfr[4][2];
#pragma unroll
        for (int et = 0; et < 4; ++et) { rfr[et][0] = *(const bf16x8*)(RF + ((et * 2 + 0) * 64 + lane) * 8); rfr[et][1] = *(const bf16x8*)(RF + ((et * 2 + 1) * 64 + lane) * 8); }
        asm volatile("" ::: "memory");
#pragma unroll
        for (int et = 0; et < 4; ++et) {
            f32x4 ai = {0.f, 0.f, 0.f, 0.f}, ax = {0.f, 0.f, 0.f, 0.f};
            ai = mfma16(ldfrag(VT, 72, 16 * et, 0, lane), p0, ai);
            ai = mfma16(ldfrag(VT, 72, 16 * et, 32, lane), p1, ai);
            ax = mfma16(rfr[et][0], q0, ax);
            ax = mfma16(rfr[et][1], q1, ax);
            o[et] = ai + ax * xi;
            sm += (o[et].x + o[et].y) + (o[et].z + o[et].w);
        }
        const float mean = quad_sum(sm) * (1.f / 64.f);
        float sv = 0.f;
#pragma unroll
        for (int et = 0; et < 4; ++et) { o[et] = o[et] - mean; sv += o[et].x * o[et].x + o[et].y * o[et].y + o[et].z * o[et].z + o[et].w * o[et].w; }
        const float rs = rsqrtf(quad_sum(sv) * (1.f / 64.f) + 1e-5f);
        const int t = n * 64 + c;
#pragma unroll
        for (int et = 0; et < 4; ++et) {
            const int e = h * 64 + 16 * et + 4 * fq;
            const f32x4 g = *(const f32x4*)(rgn + e), b = *(const f32x4*)(rbn + e);
            const f32x4 gt = ld_bf4(PROJ + (size_t)t * NPROJ + 3840 + e);
            const f32x4 y = o[et] * rs * g + b;
            *(u32x2*)(MIX + (size_t)t * D + 768 + e) = (u32x2){pk2(y.x * siluf_(gt.x), y.y * siluf_(gt.y)), pk2(y.z * siluf_(gt.z), y.w * siluf_(gt.w))};
        }
    }
    __syncthreads();
}

template <int I, int N> struct SolveRow {
    static DEVI void run(float (&x)[N], const float* M) {
        float s0 = 0.f, s1 = 0.f, s2 = 0.f, s3 = 0.f;
#pragma unroll
        for (int j4 = 0; j4 < (I + 3) / 4; ++j4) {
            const f32x4 m = *(const f32x4*)(M + I * N + 4 * j4);
            s0 += m.x * x[4 * j4]; s1 += m.y * x[4 * j4 + 1]; s2 += m.z * x[4 * j4 + 2]; s3 += m.w * x[4 * j4 + 3];
        }
        x[I] -= (s0 + s1) + (s2 + s3);
        asm volatile("" : "+v"(x[I]) :: "memory");
        SolveRow<I + 1, N>::run(x, M);
    }
};
template <int N> struct SolveRow<N, N> { static DEVI void run(float (&)[N], const float*) {} };

DEVI void gdnA_item(const P& p, int item, char* smem) {
    const bf16* REC = (const bf16*)(p.ws + WS_RECG); const float* GSC = (const float*)(p.ws + WS_GSC) + ((size_t)(item >> 2) * 64 * 4 + (item & 3)) * 4;
    bf16* GP = (bf16*)(p.ws + WS_GP) + (size_t)item * 16384; float* GB = (float*)(p.ws + WS_GB) + (size_t)item * 16384;
    float* GD = (float*)(p.ws + WS_GD);
    bf16* GQ = (bf16*)(p.ws + WS_GQ) + (size_t)item * 8192; float* GO = (float*)(p.ws + WS_GO) + (size_t)item * 8192;
    bf16* Kb = (bf16*)smem; bf16* Qb = Kb + 64 * 136;
    bf16* WT = (bf16*)smem; bf16* UT = WT + 128 * 72;
    bf16* Vb = (bf16*)(smem + 36864);
    float* M = (float*)(smem + 36864);
    bf16* KdT = (bf16*)(smem + 36864);
    bf16* At = (bf16*)(smem + 55296);
    float* gcs = (float*)(smem + 64512); float* bts = gcs + 64; float* sws = gcs + 128; float* sks = gcs + 192;
    const int n = item >> 2, h = item & 3;
    int tid = VTID; asm volatile("" : "+v"(tid));
    const int lane = tid & 63, w = tid >> 6, fr = lane & 15, fq = lane >> 4;
    const bf16* rec0 = REC + ((size_t)(n * 64) * 4 + h) * 392;
    if (w == 0) {
        float x = GSC[lane * 16 + 2];
#pragma unroll
        for (int off = 1; off < 64; off <<= 1) { const float y = __shfl_up(x, off); if (lane >= off) x += y; }
        const float bt = GSC[lane * 16 + 1];
        gcs[lane] = x; bts[lane] = bt; sws[lane] = bt * __expf(x); sks[lane] = __expf(__shfl(x, 63) - x);
    }
    {
        u32x4 v[12];
#pragma unroll
        for (int i = 0; i < 12; ++i) { const int idx = tid + 256 * i, c = idx / 48, j = idx - c * 48; v[i] = *(const u32x4*)(rec0 + (size_t)c * 1568 + j * 8); }
#pragma unroll
        for (int i = 0; i < 12; ++i) {
            const int idx = tid + 256 * i, c = idx / 48, j = idx - c * 48, which = j >> 4;
            const int boff = (which == 0 ? 17408 : 0) + (which == 2 ? 36864 : 0);
            *(u32x4*)(smem + boff + (c * 136 + (j & 15) * 8) * 2) = v[i];
        }
    }
    __syncthreads();
    float x[64];
    unsigned kdp[16];
    {
        const int col = tid & 127;
        int sel_b = (tid < 128) ? 36864 : 0, sel_s = (tid < 128) ? 64 : 128;
        asm volatile("" : "+v"(sel_b), "+v"(sel_s));
        const bf16* srcb = (const bf16*)(smem + sel_b) + col;
        const float* scs = gcs + sel_s;
#pragma unroll
        for (int c = 0; c < 64; ++c) {
            x[c] = scs[c] * bf2f(srcb[c * 136]);
            if ((c & 7) == 7) asm volatile("" : "+v"(x[c]) :: "memory");
        }
        const int half = tid >> 7;
#pragma unroll
        for (int i = 0; i < 16; ++i) {
            const int c = 32 * half + 2 * i;
            kdp[i] = pk2(bf2f(Kb[c * 136 + col]) * sks[c], bf2f(Kb[(c + 1) * 136 + col]) * sks[c + 1]);
            if ((i & 3) == 3) asm volatile("" : "+v"(kdp[i]) :: "memory");
        }
        if (tid == 0) GD[item] = __expf(gcs[63]);
    }
    __syncthreads();
    const int ct = w;
    f32x4 accQ[8];
    {
        const int c = 16 * ct + fr;
        const float gcc = gcs[c];
        {
            bf16x8 ka[4];
#pragma unroll
            for (int s = 0; s < 4; ++s) ka[s] = ldfrag(Kb, 136, 16 * ct, 32 * s, lane);
#pragma unroll
            for (int ct2 = 0; ct2 < 4; ++ct2) {
                f32x4 acc = {0.f, 0.f, 0.f, 0.f};
#pragma unroll
                for (int s = 0; s < 4; ++s) acc = mfma16(ka[s], ldfrag(Kb, 136, 16 * ct2, 32 * s, lane), acc);
                const int c2 = 16 * ct2 + fr; const float g2 = gcs[c2];
#pragma unroll
                for (int j = 0; j < 4; ++j) {
                    const int cc = 16 * ct + 4 * fq + j;
                    M[cc * 64 + c2] = (cc > c2) ? bts[cc] * acc[j] * __expf(gcs[cc] - g2) : 0.f;
                }
            }
        }
        {
            bf16x8 qa[4];
#pragma unroll
            for (int s = 0; s < 4; ++s) qa[s] = ldfrag(Qb, 136, 16 * ct, 32 * s, lane);
#pragma unroll
            for (int ct2 = 0; ct2 < 4; ++ct2) {
                f32x4 acc = {0.f, 0.f, 0.f, 0.f};
#pragma unroll
                for (int s = 0; s < 4; ++s) acc = mfma16(ldfrag(Kb, 136, 16 * ct2, 32 * s, lane), qa[s], acc);
                float pv[4];
#pragma unroll
                for (int j = 0; j < 4; ++j) { const int c2 = 16 * ct2 + 4 * fq + j; pv[j] = (c >= c2) ? acc[j] * __expf(gcc - gcs[c2]) : 0.f; }
                *(u32x2*)(At + c * 72 + 16 * ct2 + 4 * fq) = (u32x2){pk2(pv[0], pv[1]), pk2(pv[2], pv[3])};
            }
        }
    }
    __syncthreads();
    {
        SolveRow<1, 64>::run(x, M);
        unsigned xp[32];
#pragma unroll
        for (int q = 0; q < 32; ++q) xp[q] = pk2(x[2 * q], x[2 * q + 1]);
        {
            const int c = 16 * ct + fr;
            const float eg = __expf(gcs[c]);
#pragma unroll
            for (int dt = 0; dt < 8; ++dt) accQ[dt] = ld_bf4(Qb + c * 136 + 16 * dt + 4 * fq) * (-eg);
        }
        __syncthreads();
        int sel_d = (tid < 128) ? 128 * 72 : 0;
        asm volatile("" : "+v"(sel_d));
        bf16* dst = WT + sel_d + (tid & 127) * 72;
#pragma unroll
        for (int q = 0; q < 8; ++q) *(u32x4*)(dst + 8 * q) = (u32x4){xp[4 * q], xp[4 * q + 1], xp[4 * q + 2], xp[4 * q + 3]};
    }
    __syncthreads();
    {
        const int d = tid & 127, half = tid >> 7;
#pragma unroll
        for (int q = 0; q < 4; ++q) *(u32x4*)(KdT + d * 72 + 32 * half + 8 * q) = (u32x4){kdp[4 * q], kdp[4 * q + 1], kdp[4 * q + 2], kdp[4 * q + 3]};
    }
    __syncthreads();
    {
#pragma unroll 1
        for (int mi = 0; mi < 2; ++mi) {
            const int mt = 2 * w + mi;
            const bf16x8 kd0 = ldfrag(KdT, 72, 16 * mt, 0, lane), kd1 = ldfrag(KdT, 72, 16 * mt, 32, lane);
#pragma unroll
            for (int sp = 0; sp < 4; ++sp) {
                f32x4 a0 = {0.f, 0.f, 0.f, 0.f}, a1 = {0.f, 0.f, 0.f, 0.f};
                a0 = mfma16(ldfrag(WT, 72, 32 * sp, 0, lane), kd0, a0); a0 = mfma16(ldfrag(WT, 72, 32 * sp, 32, lane), kd1, a0);
                a1 = mfma16(ldfrag(WT, 72, 32 * sp + 16, 0, lane), kd0, a1); a1 = mfma16(ldfrag(WT, 72, 32 * sp + 16, 32, lane), kd1, a1);
                *(u32x4*)(GP + ((mt * 4 + sp) * 64 + lane) * 8) = (u32x4){pk2(-a0.x, -a0.y), pk2(-a0.z, -a0.w), pk2(-a1.x, -a1.y), pk2(-a1.z, -a1.w)};
            }
#pragma unroll
            for (int nt = 0; nt < 8; ++nt) {
                f32x4 a = {0.f, 0.f, 0.f, 0.f};
                a = mfma16(kd0, ldfrag(UT, 72, 16 * nt, 0, lane), a); a = mfma16(kd1, ldfrag(UT, 72, 16 * nt, 32, lane), a);
                *(f32x4*)(GB + ((nt * 8 + mt) * 64 + lane) * 4) = a;
            }
        }
        const bf16x8 at0 = ldfrag(At, 72, 16 * ct, 0, lane), at1 = ldfrag(At, 72, 16 * ct, 32, lane);
#pragma unroll
        for (int sp = 0; sp < 4; ++sp) {
            f32x4 a0 = accQ[2 * sp], a1 = accQ[2 * sp + 1];
            a0 = mfma16(ldfrag(WT, 72, 32 * sp, 0, lane), at0, a0); a0 = mfma16(ldfrag(WT, 72, 32 * sp, 32, lane), at1, a0);
            a1 = mfma16(ldfrag(WT, 72, 32 * sp + 16, 0, lane), at0, a1); a1 = mfma16(ldfrag(WT, 72, 32 * sp + 16, 32, lane), at1, a1);
            *(u32x4*)(GQ + ((ct * 4 + sp) * 64 + lane) * 8) = (u32x4){pk2(-a0.x, -a0.y), pk2(-a0.z, -a0.w), pk2(-a1.x, -a1.y), pk2(-a1.z, -a1.w)};
        }
#pragma unroll
        for (int et = 0; et < 8; ++et) {
            f32x4 a = {0.f, 0.f, 0.f, 0.f};
            a = mfma16(ldfrag(UT, 72, 16 * et, 0, lane), at0, a); a = mfma16(ldfrag(UT, 72, 16 * et, 32, lane), at1, a);
            *(f32x4*)(GO + ((ct * 8 + et) * 64 + lane) * 4) = a;
        }
    }
    __syncthreads();
}

DEVI bf16x8 pack_frag(const f32x4& a, const f32x4& b) {
    const u32x4 v = {pk2(a.x, a.y), pk2(a.z, a.w), pk2(b.x, b.y), pk2(b.z, b.w)};
    return __builtin_bit_cast(bf16x8, v);
}
DEVI void gdnL1_item(const P& p, int item, char* smem) {
    const bf16* GP = (const bf16*)(p.ws + WS_GP); const float* GB = (const float*)(p.ws + WS_GB); const float* GD = (const float*)(p.ws + WS_GD);
    const int half = item & 1, kind = (item >> 1) & 1, g = (item >> 2) & 15, h = item >> 6;
    const int tid = VTID, lane = tid & 63, ew = half * 4 + (tid >> 6), fr = lane & 15, fq = lane >> 4;
    const int n0 = g * 16;
#define L1_DMA(n) do { const bf16* _s = GP + ((size_t)(n) * 4 + h) * 16384 + tid * 8; char* _d = smem + ((n) & 1) * 32768 + tid * 16; \
        _Pragma("unroll") for (int _i = 0; _i < 8; ++_i) __builtin_amdgcn_global_load_lds((const unsigned*)(_s + _i * 2048), (unsigned*)(_d + _i * 4096), 16, 0, 0); } while (0)
    f32x4 acc[8];
    L1_DMA(n0);
    if (kind == 0) {
        bf16* GS = (bf16*)(p.ws + WS_GS);
#pragma unroll
        for (int m = 0; m < 8; ++m) acc[m] = (f32x4){0.f, 0.f, 0.f, 0.f};
        f32x4 bcur[8], bnxt[8]; float dcur, dnxt = 0.f;
        {
            const float* Bn = GB + ((size_t)n0 * 4 + h) * 16384 + (ew * 8 * 64 + lane) * 4;
#pragma unroll
            for (int m = 0; m < 8; ++m) bcur[m] = *(const f32x4*)(Bn + m * 256);
            dcur = GD[(size_t)n0 * 4 + h];
        }
#pragma unroll 1
        for (int n = n0; n < n0 + 16; ++n) {
            const size_t it = (size_t)n * 4 + h;
            asm volatile("s_waitcnt vmcnt(0)" ::: "memory");
            __syncthreads();
            if (n + 1 < n0 + 16) {
                L1_DMA(n + 1);
                const float* Bn = GB + (it + 4) * 16384 + (ew * 8 * 64 + lane) * 4;
#pragma unroll
                for (int m = 0; m < 8; ++m) bnxt[m] = *(const f32x4*)(Bn + m * 256);
                dnxt = GD[it + 4];
            }
            const char* ring = smem + (n & 1) * 32768 + lane * 16;
            bf16x8 sf[4];
#pragma unroll
            for (int s = 0; s < 4; ++s) {
                sf[s] = pack_frag(acc[2 * s], acc[2 * s + 1]);
                *(bf16x8*)(GS + it * 16384 + ((ew * 4 + s) * 64 + lane) * 8) = sf[s];
            }
#pragma unroll
            for (int m = 0; m < 8; ++m) {
                f32x4 a = acc[m] * dcur + bcur[m];
#pragma unroll
                for (int s = 0; s < 4; ++s) a = mfma16(*(const bf16x8*)(ring + (m * 4 + s) * 1024), sf[s], a);
                acc[m] = a;
            }
#pragma unroll
            for (int m = 0; m < 8; ++m) bcur[m] = bnxt[m];
            dcur = dnxt;
        }
        float* E0 = (float*)(p.ws + WS_GE0) + (size_t)(h * 16 + g) * 16384 + (ew * 8 * 64 + lane) * 4;
#pragma unroll
        for (int m = 0; m < 8; ++m) *(f32x4*)(E0 + m * 256) = acc[m];
    } else {
        const bf16* GQ = (const bf16*)(p.ws + WS_GQ); bf16* GR = (bf16*)(p.ws + WS_GR);
#pragma unroll
        for (int m = 0; m < 8; ++m)
#pragma unroll
            for (int j = 0; j < 4; ++j) acc[m][j] = (m == ew && 4 * fq + j == fr) ? 1.f : 0.f;
#pragma unroll 1
        for (int n = n0; n < n0 + 16; ++n) {
            const size_t it = (size_t)n * 4 + h;
            asm volatile("s_waitcnt vmcnt(0)" ::: "memory");
            __syncthreads();
            if (n + 1 < n0 + 16) L1_DMA(n + 1);
            bf16x8 qf[16];
#pragma unroll
            for (int i = 0; i < 16; ++i) qf[i] = *(const bf16x8*)(GQ + it * 8192 + (i * 64 + lane) * 8);
            const float dn = GD[it];
            const char* ring = smem + (n & 1) * 32768 + lane * 16;
            bf16x8 tf[4];
#pragma unroll
            for (int s = 0; s < 4; ++s) tf[s] = pack_frag(acc[2 * s], acc[2 * s + 1]);
#pragma unroll
            for (int m = 0; m < 8; ++m) {
                f32x4 a = acc[m] * dn;
#pragma unroll
                for (int s = 0; s < 4; ++s) a = mfma16(*(const bf16x8*)(ring + (m * 4 + s) * 1024), tf[s], a);
                acc[m] = a;
            }
#pragma unroll
            for (int tt = 0; tt < 4; ++tt) {
                f32x4 r = {0.f, 0.f, 0.f, 0.f};
#pragma unroll
                for (int s = 0; s < 4; ++s) r = mfma16(tf[s], qf[tt * 4 + s], r);
                *(u32x2*)(GR + it * 8192 + ((tt * 4 + (ew >> 1)) * 64 + lane) * 8 + 4 * (ew & 1)) = (u32x2){pk2(r.x, r.y), pk2(r.z, r.w)};
            }
        }
        bf16* TE = (bf16*)(p.ws + WS_GTE) + (size_t)(h * 16 + g) * 16384;
        const int s_ = ew >> 1, jj = 4 * (ew & 1) + (fr & 3), lg = fr >> 2;
#pragma unroll
        for (int m = 0; m < 8; ++m)
#pragma unroll
            for (int j = 0; j < 4; ++j) TE[((m * 4 + s_) * 64 + (4 * fq + j) + 16 * lg) * 8 + jj] = (bf16)f2bf(acc[m][j]);
    }
    asm volatile("s_waitcnt vmcnt(0)" ::: "memory");
    __syncthreads();
#undef L1_DMA
}
DEVI void gdnL2_item(const P& p, int item, char* smem) {
    const bf16* TE = (const bf16*)(p.ws + WS_GTE); const float* E0 = (const float*)(p.ws + WS_GE0); bf16* SG = (bf16*)(p.ws + WS_GSG);
    const int h = item >> 1, tid = VTID, lane = tid & 63, ew = (item & 1) * 4 + (tid >> 6);
#define L2_DMA(g) do { const bf16* _s = TE + ((size_t)h * 16 + (g)) * 16384 + tid * 8; char* _d = smem + ((g) & 1) * 32768 + tid * 16; \
        _Pragma("unroll") for (int _i = 0; _i < 8; ++_i) __builtin_amdgcn_global_load_lds((const unsigned*)(_s + _i * 2048), (unsigned*)(_d + _i * 4096), 16, 0, 0); } while (0)
    f32x4 acc[8];
#pragma unroll
    for (int m = 0; m < 8; ++m) acc[m] = (f32x4){0.f, 0.f, 0.f, 0.f};
    L2_DMA(0);
    f32x4 bcur[8], bnxt[8];
    {
        const float* En = E0 + (size_t)h * 16 * 16384 + (ew * 8 * 64 + lane) * 4;
#pragma unroll
        for (int m = 0; m < 8; ++m) bcur[m] = *(const f32x4*)(En + m * 256);
    }
#pragma unroll 1
    for (int g = 0; g < 16; ++g) {
        const size_t hg = (size_t)h * 16 + g;
        asm volatile("s_waitcnt vmcnt(0)" ::: "memory");
        __syncthreads();
        if (g + 1 < 16) {
            L2_DMA(g + 1);
            const float* En = E0 + (hg + 1) * 16384 + (ew * 8 * 64 + lane) * 4;
#pragma unroll
            for (int m = 0; m < 8; ++m) bnxt[m] = *(const f32x4*)(En + m * 256);
        }
        const char* ring = smem + (g & 1) * 32768 + lane * 16;
        bf16x8 sf[4];
#pragma unroll
        for (int s = 0; s < 4; ++s) {
            sf[s] = pack_frag(acc[2 * s], acc[2 * s + 1]);
            *(bf16x8*)(SG + hg * 16384 + ((ew * 4 + s) * 64 + lane) * 8) = sf[s];
        }
#pragma unroll
        for (int m = 0; m < 8; ++m) {
            f32x4 a = bcur[m];
#pragma unroll
            for (int s = 0; s < 4; ++s) a = mfma16(*(const bf16x8*)(ring + (m * 4 + s) * 1024), sf[s], a);
            acc[m] = a;
        }
#pragma unroll
        for (int m = 0; m < 8; ++m) bcur[m] = bnxt[m];
    }
    asm volatile("s_waitcnt vmcnt(0)" ::: "memory");
    __syncthreads();
#undef L2_DMA
}

DEVI void gdnC_item(const P& p, int item, int l) {
    const bf16* GQ = (const bf16*)(p.ws + WS_GQ) + (size_t)item * 8192; const float* GO = (const float*)(p.ws + WS_GO) + (size_t)item * 8192;
    const bf16* GS = (const bf16*)(p.ws + WS_GS) + (size_t)item * 16384;
    const bf16* PROJ = (const bf16*)(p.ws + WS_PROJ); bf16* MIX = (bf16*)(p.ws + WS_MIX);
    const float* gn = p.in[24] + l * 128;
    const int n = item >> 2, h = item & 3;
    const int lane = VTID & 63, ct = VTID >> 6, fr = lane & 15, fq = lane >> 4;
    const bf16* GR = (const bf16*)(p.ws + WS_GR) + (size_t)item * 8192;
    const bf16* SG = (const bf16*)(p.ws + WS_GSG) + (size_t)(h * 16 + (n >> 4)) * 16384;
    bf16x8 qf[4], rf[4];
#pragma unroll
    for (int s = 0; s < 4; ++s) { qf[s] = *(const bf16x8*)(GQ + ((ct * 4 + s) * 64 + lane) * 8); rf[s] = *(const bf16x8*)(GR + ((ct * 4 + s) * 64 + lane) * 8); }
    const int t = n * 64 + 16 * ct + fr;
    f32x4 a[8];
    float ss = 0.f;
    u32x2 zr[8]; f32x4 gv[8];
#pragma unroll
    for (int et = 0; et < 8; ++et) { zr[et] = *(const u32x2*)(PROJ + (size_t)t * NPROJ + 2560 + h * 128 + 16 * et + 4 * fq); gv[et] = *(const f32x4*)(gn + 16 * et + 4 * fq); }
#pragma unroll
    for (int e2 = 0; e2 < 4; ++e2) {
        f32x4 c0[2]; bf16x8 gs[2][4], sg[2][4];
#pragma unroll
        for (int u = 0; u < 2; ++u) {
            const int et = 2 * e2 + u;
            c0[u] = *(const f32x4*)(GO + ((ct * 8 + et) * 64 + lane) * 4);
#pragma unroll
            for (int s = 0; s < 4; ++s) { gs[u][s] = *(const bf16x8*)(GS + ((et * 4 + s) * 64 + lane) * 8); sg[u][s] = *(const bf16x8*)(SG + ((et * 4 + s) * 64 + lane) * 8); }
        }
        asm volatile("" ::: "memory");
#pragma unroll
        for (int u = 0; u < 2; ++u) {
            f32x4 acc = c0[u];
#pragma unroll
            for (int s = 0; s < 4; ++s) acc = mfma16(gs[u][s], qf[s], acc);
#pragma unroll
            for (int s = 0; s < 4; ++s) acc = mfma16(sg[u][s], rf[s], acc);
            a[2 * e2 + u] = acc;
            ss += acc.x * acc.x + acc.y * acc.y + acc.z * acc.z + acc.w * acc.w;
        }
    }
    const float rs = rsqrtf(quad_sum(ss) * (1.f / 128.f) + 1e-6f);
#pragma unroll
    for (int et = 0; et < 8; ++et) {
        const int e = 16 * et + 4 * fq;
        const f32x4 z = {__uint_as_float(zr[et].x << 16), __uint_as_float(zr[et].x & 0xffff0000u), __uint_as_float(zr[et].y << 16), __uint_as_float(zr[et].y & 0xffff0000u)};
        const f32x4 o = a[et] * rs * gv[et];
        *(u32x2*)(MIX + (size_t)t * D + 256 + h * 128 + e) = (u32x2){pk2(o.x * siluf_(z.x), o.y * siluf_(z.y)), pk2(o.z * siluf_(z.z), o.w * siluf_(z.w))};
    }
}

DEVI void rwkA_item(const P& p, int item, char* smem) {
    const bf16* REC = (const bf16*)(p.ws + WS_RECR); const float* WDEC = (const float*)(p.ws + WS_WDEC);
    bf16* WP = (bf16*)(p.ws + WS_WP) + (size_t)item * 4096; float* WC = (float*)(p.ws + WS_WC) + (size_t)item * 4096;
    float* WD = (float*)(p.ws + WS_WD) + (size_t)item * 64;
    bf16* WQ = (bf16*)(p.ws + WS_WQ) + (size_t)item * 2048; float* WY = (float*)(p.ws + WS_WY) + (size_t)item * 2048;
    bf16* At_ = (bf16*)smem; bf16* Rt = At_ + 32 * 72; bf16* Bt = Rt + 32 * 72; bf16* Kt = Bt + 32 * 72;
    float* ZT = (float*)(smem + 9216);
    bf16* BhT = (bf16*)(smem + 18432); bf16* KhT = BhT + 64 * 40; bf16* VT = KhT + 64 * 40; bf16* AhT = VT + 64 * 40; bf16* UhT = AhT + 64 * 40;
    float* M = (float*)(smem + 44032);
    bf16* Aak = (bf16*)(smem + 48128); bf16* Arb = Aak + 32 * 40; bf16* Ark = Arb + 32 * 40;
    float* tot = (float*)(smem + 55808);
    const int n = item >> 2, h = item & 3;
    int tid = VTID; asm volatile("" : "+v"(tid));
    const int lane = tid & 63, w = tid >> 6, fr = lane & 15, fq = lane >> 4;
    {
        const int d = lane;
        const bf16* rec = REC + ((size_t)(n * 32 + 8 * w) * 4 + h) * 384 + d;
        const float* dcy = WDEC + (size_t)(n * 32 + 8 * w) * 256 + h * 64 + d;
        float lw[8], lg[8];
        float run = 0.f;
        float dcv[8]; bf16 ra[8], rb[8], rk[8], rr_[8], rv[8];
#pragma unroll
        for (int i = 0; i < 8; ++i) {
            const bf16* r = rec + (size_t)i * 1536;
            dcv[i] = dcy[i * 256]; ra[i] = r[0]; rb[i] = r[128]; rk[i] = r[192]; rr_[i] = r[256]; rv[i] = r[320];
        }
        asm volatile("" ::: "memory");
#pragma unroll
        for (int i = 0; i < 8; ++i) { lg[i] = __logf(dcv[i]); run += lg[i]; lw[i] = run; }
        tot[w * 64 + d] = run;
        __syncthreads();
        float off = 0.f, total = 0.f;
#pragma unroll
        for (int q = 0; q < 4; ++q) { const float tq = tot[q * 64 + d]; total += tq; off += (q < w) ? tq : 0.f; }
        unsigned bh[4], kh[4], vv[4];
        float pb = 0.f, pk = 0.f, pv = 0.f;
#pragma unroll
        for (int i = 0; i < 8; ++i) {
            const float a = bf2f(ra[i]), b = bf2f(rb[i]), k = bf2f(rk[i]), rr = bf2f(rr_[i]), v = bf2f(rv[i]);
            const float lc = off + lw[i];
            const float cw = __expf(lc), cwm1 = __expf(lc - lg[i]), inv = __expf(-lc), rat = __expf(total - lc);
            const int t = 8 * w + i;
            At_[t * 72 + d] = (bf16)f2bf(a * cwm1); Rt[t * 72 + d] = (bf16)f2bf(rr * cw);
            Bt[t * 72 + d] = (bf16)f2bf(b * inv); Kt[t * 72 + d] = (bf16)f2bf(k * inv);
            if (i & 1) { bh[i >> 1] = pk2(pb, b * rat); kh[i >> 1] = pk2(pk, k * rat); vv[i >> 1] = pk2(pv, v); }
            else { pb = b * rat; pk = k * rat; pv = v; }
        }
        *(u32x4*)(BhT + d * 40 + 8 * w) = (u32x4){bh[0], bh[1], bh[2], bh[3]};
        *(u32x4*)(KhT + d * 40 + 8 * w) = (u32x4){kh[0], kh[1], kh[2], kh[3]};
        *(u32x4*)(VT + d * 40 + 8 * w) = (u32x4){vv[0], vv[1], vv[2], vv[3]};
        if (w == 0) WD[d] = __expf(total);
    }
    __syncthreads();
    {
        int offA = (w == 0) ? 0 : (w == 1 ? 3 : (w == 2 ? 2 : 3));
        int offB = (w == 0) ? 2 : (w == 1 ? 0 : 1);
        asm volatile("" : "+v"(offA), "+v"(offB));
        const bf16* As = At_ + offA * (32 * 72); const bf16* Bs = At_ + offB * (32 * 72);
#pragma unroll
        for (int ta = 0; ta < 2; ++ta) {
            const bf16x8 a0 = ldfrag(As, 72, 16 * ta, 0, lane), a1 = ldfrag(As, 72, 16 * ta, 32, lane);
#pragma unroll
            for (int tb = 0; tb < 2; ++tb) {
                f32x4 acc = {0.f, 0.f, 0.f, 0.f};
                acc = mfma16(a0, ldfrag(Bs, 72, 16 * tb, 0, lane), acc);
                acc = mfma16(a1, ldfrag(Bs, 72, 16 * tb, 32, lane), acc);
                if (w == 0) {
                    const int s_ = 16 * tb + fr;
#pragma unroll
                    for (int j = 0; j < 4; ++j) { const int t = 16 * ta + 4 * fq + j; M[t * 32 + s_] = (t > s_) ? -acc[j] : 0.f; }
                } else {
                    const int t = 16 * tb + fr;
                    float pv4[4];
#pragma unroll
                    for (int j = 0; j < 4; ++j) { const int s_ = 16 * ta + 4 * fq + j; pv4[j] = ((w == 1) ? (t > s_) : (t >= s_)) ? acc[j] : 0.f; }
                    int offD = w - 1; asm volatile("" : "+v"(offD));
                    *(u32x2*)(Aak + offD * (32 * 40) + t * 40 + 16 * ta + 4 * fq) = (u32x2){pk2(pv4[0], pv4[1]), pk2(pv4[2], pv4[3])};
                }
            }
        }
    }
    __syncthreads();
    {
        const int et = w;
        const bf16x8 vf = ldfrag(VT, 40, 16 * et, 0, lane);
#pragma unroll
        for (int tt = 0; tt < 2; ++tt) {
            f32x4 acc = {0.f, 0.f, 0.f, 0.f};
            acc = mfma16(ldfrag(Aak, 40, 16 * tt, 0, lane), vf, acc);
            *(f32x4*)(ZT + (16 * et + fr) * 36 + 16 * tt + 4 * fq) = acc;
        }
    }
    __syncthreads();
    if (tid < 128) {
        float x[32];
        if (tid < 64) {
#pragma unroll
            for (int t = 0; t < 32; ++t) x[t] = bf2f(At_[t * 72 + tid]);
        } else {
#pragma unroll
            for (int q = 0; q < 8; ++q) { const f32x4 z = *(const f32x4*)(ZT + (tid - 64) * 36 + 4 * q); x[4 * q] = z.x; x[4 * q + 1] = z.y; x[4 * q + 2] = z.z; x[4 * q + 3] = z.w; }
        }
        SolveRow<1, 32>::run(x, M);
        bf16* dst = AhT + tid * 40;
#pragma unroll
        for (int q = 0; q < 4; ++q)
            *(u32x4*)(dst + 8 * q) = (u32x4){pk2(x[8 * q], x[8 * q + 1]), pk2(x[8 * q + 2], x[8 * q + 3]), pk2(x[8 * q + 4], x[8 * q + 5]), pk2(x[8 * q + 6], x[8 * q + 7])};
    }
    __syncthreads();
    {
        const int mt = w;
        const bf16x8 bh = ldfrag(BhT, 40, 16 * mt, 0, lane), kh = ldfrag(KhT, 40, 16 * mt, 0, lane);
#pragma unroll
        for (int sp = 0; sp < 2; ++sp) {
            f32x4 a0 = {0.f, 0.f, 0.f, 0.f}, a1 = {0.f, 0.f, 0.f, 0.f};
            a0 = mfma16(ldfrag(AhT, 40, 32 * sp, 0, lane), bh, a0);
            a1 = mfma16(ldfrag(AhT, 40, 32 * sp + 16, 0, lane), bh, a1);
            *(u32x4*)(WP + ((mt * 2 + sp) * 64 + lane) * 8) = (u32x4){pk2(a0.x, a0.y), pk2(a0.z, a0.w), pk2(a1.x, a1.y), pk2(a1.z, a1.w)};
        }
#pragma unroll
        for (int nt = 0; nt < 4; ++nt) {
            f32x4 a = {0.f, 0.f, 0.f, 0.f};
            a = mfma16(bh, ldfrag(UhT, 40, 16 * nt, 0, lane), a);
            a = mfma16(kh, ldfrag(VT, 40, 16 * nt, 0, lane), a);
            *(f32x4*)(WC + ((nt * 4 + mt) * 64 + lane) * 4) = a;
        }
        {
            const int ct = w & 1, sp = w >> 1, t = 16 * ct + fr;
            const bf16x8 ar = ldfrag(Arb, 40, 16 * ct, 0, lane);
            f32x4 a0 = ld_bf4(Rt + t * 72 + 32 * sp + 4 * fq), a1 = ld_bf4(Rt + t * 72 + 32 * sp + 16 + 4 * fq);
            a0 = mfma16(ldfrag(AhT, 40, 32 * sp, 0, lane), ar, a0);
            a1 = mfma16(ldfrag(AhT, 40, 32 * sp + 16, 0, lane), ar, a1);
            *(u32x4*)(WQ + ((ct * 2 + sp) * 64 + lane) * 8) = (u32x4){pk2(a0.x, a0.y), pk2(a0.z, a0.w), pk2(a1.x, a1.y), pk2(a1.z, a1.w)};
        }
        {
            const int et = w;
            const bf16x8 uf = ldfrag(UhT, 40, 16 * et, 0, lane), vf = ldfrag(VT, 40, 16 * et, 0, lane);
#pragma unroll
            for (int ct = 0; ct < 2; ++ct) {
                f32x4 a = {0.f, 0.f, 0.f, 0.f};
                a = mfma16(uf, ldfrag(Arb, 40, 16 * ct, 0, lane), a);
                a = mfma16(vf, ldfrag(Ark, 40, 16 * ct, 0, lane), a);
                *(f32x4*)(WY + ((ct * 4 + et) * 64 + lane) * 4) = a;
            }
        }
    }
    __syncthreads();
}

struct RwkStep { bf16x8 pf[8]; f32x4 cf[4]; f32x4 dv[4]; };
DEVI void rwk_load(RwkStep& r, const bf16* WP, const float* WC, const float* WD, size_t it, int ew, int lane) {
#pragma unroll
    for (int i = 0; i < 8; ++i) r.pf[i] = *(const bf16x8*)(WP + it * 4096 + (i * 64 + lane) * 8);
#pragma unroll
    for (int m = 0; m < 4; ++m) r.cf[m] = *(const f32x4*)(WC + it * 4096 + ((ew * 4 + m) * 64 + lane) * 4);
#pragma unroll
    for (int m = 0; m < 4; ++m) r.dv[m] = *(const f32x4*)(WD + it * 64 + 16 * m + 4 * (lane >> 4));
}
DEVI void rwk_step(const RwkStep& r, f32x4 (&acc)[4], bf16* WSF, size_t it, int ew, int lane) {
    bf16x8 sf[2];
#pragma unroll
    for (int s = 0; s < 2; ++s) {
        const u32x4 v = {pk2(acc[2 * s].x, acc[2 * s].y), pk2(acc[2 * s].z, acc[2 * s].w), pk2(acc[2 * s + 1].x, acc[2 * s + 1].y), pk2(acc[2 * s + 1].z, acc[2 * s + 1].w)};
        *(u32x4*)(WSF + it * 4096 + ((ew * 2 + s) * 64 + lane) * 8) = v;
        sf[s] = __builtin_bit_cast(bf16x8, v);
    }
#pragma unroll
    for (int m = 0; m < 4; ++m) {
        f32x4 a = acc[m] * r.dv[m] + r.cf[m];
        a = mfma16(r.pf[m * 2], sf[0], a);
        a = mfma16(r.pf[m * 2 + 1], sf[1], a);
        acc[m] = a;
    }
}
DEVI void rwkL1_item(const P& p, int item) {
    const bf16* WP = (const bf16*)(p.ws + WS_WP); const float* WC = (const float*)(p.ws + WS_WC); const float* WD = (const float*)(p.ws + WS_WD);
    const int kind = item & 1, g = (item >> 1) & 15, h = item >> 5;
    const int lane = VTID & 63, ew = VTID >> 6, fr = lane & 15, fq = lane >> 4;
    f32x4 acc[4];
    if (kind == 0) {
        bf16* WSF = (bf16*)(p.ws + WS_WS);
#pragma unroll
        for (int m = 0; m < 4; ++m) acc[m] = (f32x4){0.f, 0.f, 0.f, 0.f};
        RwkStep A, B;
        const int n0 = g * 32;
        rwk_load(A, WP, WC, WD, (size_t)n0 * 4 + h, ew, lane);
#pragma unroll 1
        for (int n = n0; n < n0 + 32; n += 2) {
            rwk_load(B, WP, WC, WD, (size_t)(n + 1) * 4 + h, ew, lane);
            asm volatile("" ::: "memory");
            rwk_step(A, acc, WSF, (size_t)n * 4 + h, ew, lane);
            rwk_load(A, WP, WC, WD, (size_t)((n + 2 < n0 + 32) ? n + 2 : n) * 4 + h, ew, lane);
            asm volatile("" ::: "memory");
            rwk_step(B, acc, WSF, (size_t)(n + 1) * 4 + h, ew, lane);
        }
        float* E0 = (float*)(p.ws + WS_WE0) + (size_t)(h * 16 + g) * 4096 + (ew * 4 * 64 + lane) * 4;
#pragma unroll
        for (int m = 0; m < 4; ++m) *(f32x4*)(E0 + m * 256) = acc[m];
    } else {
        const bf16* WQ = (const bf16*)(p.ws + WS_WQ); bf16* WR = (bf16*)(p.ws + WS_WR);
#pragma unroll
        for (int m = 0; m < 4; ++m)
#pragma unroll
            for (int j = 0; j < 4; ++j) acc[m][j] = (m == ew && 4 * fq + j == fr) ? 1.f : 0.f;
#pragma unroll 1
        for (int n = g * 32; n < g * 32 + 32; ++n) {
            const size_t it = (size_t)n * 4 + h;
            bf16x8 pf[8], qf[4]; f32x4 dv[4];
#pragma unroll
            for (int i = 0; i < 8; ++i) pf[i] = *(const bf16x8*)(WP + it * 4096 + (i * 64 + lane) * 8);
#pragma unroll
            for (int i = 0; i < 4; ++i) qf[i] = *(const bf16x8*)(WQ + it * 2048 + (i * 64 + lane) * 8);
#pragma unroll
            for (int m = 0; m < 4; ++m) dv[m] = *(const f32x4*)(WD + it * 64 + 16 * m + 4 * fq);
            asm volatile("" ::: "memory");
            bf16x8 tf[2];
#pragma unroll
            for (int s = 0; s < 2; ++s) tf[s] = pack_frag(acc[2 * s], acc[2 * s + 1]);
#pragma unroll
            for (int tt = 0; tt < 2; ++tt) {
                f32x4 r = {0.f, 0.f, 0.f, 0.f};
                r = mfma16(tf[0], qf[tt * 2], r); r = mfma16(tf[1], qf[tt * 2 + 1], r);
                *(u32x2*)(WR + it * 2048 + ((tt * 2 + (ew >> 1)) * 64 + lane) * 8 + 4 * (ew & 1)) = (u32x2){pk2(r.x, r.y), pk2(r.z, r.w)};
            }
#pragma unroll
            for (int m = 0; m < 4; ++m) {
                f32x4 a = acc[m] * dv[m];
                a = mfma16(pf[m * 2], tf[0], a); a = mfma16(pf[m * 2 + 1], tf[1], a);
                acc[m] = a;
            }
        }
        bf16* TE = (bf16*)(p.ws + WS_WTE) + (size_t)(h * 16 + g) * 4096;
        const int s_ = ew >> 1, jj = 4 * (ew & 1) + (fr & 3), lg = fr >> 2;
#pragma unroll
        for (int m = 0; m < 4; ++m)
#pragma unroll
            for (int j = 0; j < 4; ++j) TE[((m * 2 + s_) * 64 + (4 * fq + j) + 16 * lg) * 8 + jj] = (bf16)f2bf(acc[m][j]);
    }
}
DEVI void rwkL2_item(const P& p, int h) {
    const bf16* TE = (const bf16*)(p.ws + WS_WTE); const float* E0 = (const float*)(p.ws + WS_WE0); bf16* SG = (bf16*)(p.ws + WS_WSG);
    const int lane = VTID & 63, ew = VTID >> 6;
    f32x4 acc[4];
#pragma unroll
    for (int m = 0; m < 4; ++m) acc[m] = (f32x4){0.f, 0.f, 0.f, 0.f};
#pragma unroll 1
    for (int g = 0; g < 16; ++g) {
        const size_t hg = (size_t)h * 16 + g;
        bf16x8 pf[8]; f32x4 bfr[4];
#pragma unroll
        for (int i = 0; i < 8; ++i) pf[i] = *(const bf16x8*)(TE + hg * 4096 + (i * 64 + lane) * 8);
#pragma unroll
        for (int m = 0; m < 4; ++m) bfr[m] = *(const f32x4*)(E0 + hg * 4096 + ((ew * 4 + m) * 64 + lane) * 4);
        asm volatile("" ::: "memory");
        bf16x8 sf[2];
#pragma unroll
        for (int s = 0; s < 2; ++s) {
            sf[s] = pack_frag(acc[2 * s], acc[2 * s + 1]);
            *(bf16x8*)(SG + hg * 4096 + ((ew * 2 + s) * 64 + lane) * 8) = sf[s];
        }
#pragma unroll
        for (int m = 0; m < 4; ++m) {
            f32x4 a = bfr[m];
            a = mfma16(pf[m * 2], sf[0], a); a = mfma16(pf[m * 2 + 1], sf[1], a);
            acc[m] = a;
        }
    }
}

DEVI void rwkC_item(const P& p, int n, int l) {
    const int lane = VTID & 63, h = VTID >> 6, fr = lane & 15, fq = lane >> 4;
    const size_t it = (size_t)n * 4 + h;
    const bf16* WQ = (const bf16*)(p.ws + WS_WQ) + it * 2048; const float* WY = (const float*)(p.ws + WS_WY) + it * 2048;
    const bf16* WSF = (const bf16*)(p.ws + WS_WS) + it * 4096;
    const bf16* WR = (const bf16*)(p.ws + WS_WR) + it * 2048; const bf16* WSG = (const bf16*)(p.ws + WS_WSG) + (size_t)(h * 16 + (n >> 5)) * 4096;
    const bf16* RECR = (const bf16*)(p.ws + WS_RECR); const float* GB = (const float*)(p.ws + WS_G); const float* BON = (const float*)(p.ws + WS_BON);
    bf16* MIX = (bf16*)(p.ws + WS_MIX);
    const float* ln_g = p.in[17] + l * 256 + h * 64; const float* ln_b = p.in[18] + l * 256 + h * 64;
#pragma unroll
    for (int ct = 0; ct < 2; ++ct) {
        const bf16x8 q0 = *(const bf16x8*)(WQ + ((ct * 2 + 0) * 64 + lane) * 8), q1 = *(const bf16x8*)(WQ + ((ct * 2 + 1) * 64 + lane) * 8);
        const bf16x8 r0 = *(const bf16x8*)(WR + ((ct * 2 + 0) * 64 + lane) * 8), r1 = *(const bf16x8*)(WR + ((ct * 2 + 1) * 64 + lane) * 8);
        const int t = n * 32 + 16 * ct + fr;
        f32x4 a[4];
        float sm = 0.f;
        f32x4 y0[4]; bf16x8 sfr[4][2], sgr[4][2];
#pragma unroll
        for (int et = 0; et < 4; ++et) {
            y0[et] = *(const f32x4*)(WY + ((ct * 4 + et) * 64 + lane) * 4);
#pragma unroll
            for (int s = 0; s < 2; ++s) { sfr[et][s] = *(const bf16x8*)(WSF + ((et * 2 + s) * 64 + lane) * 8); sgr[et][s] = *(const bf16x8*)(WSG + ((et * 2 + s) * 64 + lane) * 8); }
        }
        asm volatile("" ::: "memory");
#pragma unroll
        for (int et = 0; et < 4; ++et) {
            f32x4 acc = y0[et];
            acc = mfma16(sfr[et][0], q0, acc);
            acc = mfma16(sfr[et][1], q1, acc);
            acc = mfma16(sgr[et][0], r0, acc);
            acc = mfma16(sgr[et][1], r1, acc);
            a[et] = acc; sm += (acc.x + acc.y) + (acc.z + acc.w);
        }
        const float mean = quad_sum(sm) * (1.f / 64.f);
        float sv = 0.f;
#pragma unroll
        for (int et = 0; et < 4; ++et) { a[et] = a[et] - mean; sv += a[et].x * a[et].x + a[et].y * a[et].y + a[et].z * a[et].z + a[et].w * a[et].w; }
        const float rs = rsqrtf(quad_sum(sv) * (1.f / 64.f) + 64e-5f);
        const float bon = BON[(size_t)t * 4 + h];
        f32x4 gq[4], bq[4], vq[4], gateq[4];
#pragma unroll
        for (int et = 0; et < 4; ++et) {
            const int e = 16 * et + 4 * fq;
            gq[et] = *(const f32x4*)(ln_g + e); bq[et] = *(const f32x4*)(ln_b + e);
            vq[et] = ld_bf4(RECR + ((size_t)t * 4 + h) * 384 + 320 + e);
            gateq[et] = *(const f32x4*)(GB + (size_t)t * 256 + h * 64 + e);
        }
        asm volatile("" ::: "memory");
#pragma unroll
        for (int et = 0; et < 4; ++et) {
            const int e = 16 * et + 4 * fq;
            const f32x4 g = gq[et], b = bq[et];
            const f32x4 v = vq[et];
            const f32x4 gate = gateq[et];
            const f32x4 o = (a[et] * rs * g + b + v * bon) * gate;
            *(u32x2*)(MIX + (size_t)t * D + h * 64 + e) = (u32x2){pk2(o.x, o.y), pk2(o.z, o.w)};
        }
    }
}

DEVI void phase_scanL1(const P& p, char* smem) {
    for (int item = VBID; item < 448; item += VNB) {
        if (item < 256) gdnL1_item(p, item, smem);
        else if (item < 384) rwkL1_item(p, item - 256);
        else retS_item(p, item - 384);
    }
}
DEVI void retC_item(const P& p, int item, int l, char* smem);
DEVI void phase_scanL2(const P& p, int l, char* smem) {
    if (VBID < 12) { if (VBID < 8) gdnL2_item(p, VBID, smem); else rwkL2_item(p, VBID - 8); }
    else { for (int item = VBID - 12; item < 1024; item += VNB - 12) retC_item(p, item, l, smem); }
}
DEVI void phase_chunkA(const P& p, char* smem) {
    for (int item = VBID; item < 4096; item += VNB) { if (item < 1024) gdnA_item(p, item, smem); else if (item < 3072) rwkA_item(p, item - 1024, smem); else retA_item(p, item - 3072, smem); }
}
DEVI void phase_chunkC(const P& p, int l, char* smem) {
    for (int item = VBID; item < 1536; item += VNB) { if (item < 1024) gdnC_item(p, item, l); else rwkC_item(p, item - 1024, l); }
}

DEVI void phase_ln1_route(const P& p, int l, char* smem, bool commit = true) {
    const float* ADA = (const float*)(p.ws + OFF_ADA) + l * 6144;
    const float* xin = p.in[0];
    const bf16* OPRE = (const bf16*)(p.ws + WS_OPRE);
    bf16* X = (bf16*)(p.ws + WS_X); bf16* H2 = (bf16*)(p.ws + WS_H2);
    const float* lg = p.in[28] + l * D; const float* lb = p.in[29] + l * D;
    const float* rw = p.in[30] + (size_t)l * D * 32; const float* rbias = p.in[31] + l * 32;
    int* CNT = (int*)(p.ws + OFF_CNT) + l * 32 * 64; int* LIST = (int*)(p.ws + WS_LIST); float* GATE = (float*)(p.ws + WS_GATE);
    constexpr int HSS = 1028;
    float* HS = (float*)smem;
    float* RED = HS;
    int* SEL = (int*)(HS + 16 * HSS);
    int* RNK = SEL + 256;
    int* BASE = RNK + 256;
    int nasg = 0;
    const int tid = VTID, lane = tid & 63, w = tid >> 6, fr = lane & 15, fq = lane >> 4;
    f32x4 cg1[4], cg[4], cb[4], cG2[4], cB2[4];
#pragma unroll
    for (int j = 0; j < 4; ++j) {
        const int c = j * 256 + lane * 4;
        const f32x4 gt = *(const f32x4*)(ADA + 2048 + c), sh = *(const f32x4*)(ADA + 3072 + c), sc = *(const f32x4*)(ADA + 4096 + c);
        cg1[j] = gt + 1.f; cg[j] = *(const f32x4*)(lg + c); cb[j] = *(const f32x4*)(lb + c);
        cG2[j] = sc + 1.f; cB2[j] = sh;
    }
    const u32x4* RWF = (const u32x4*)(p.ws + WS_RWF) + (size_t)((l * 32 + w * 8) * 4) * 64 + lane;
    f32x4 xb[4]; u32x2 xh[4], ob[4];
#define LN1_LOAD(tok) do { const size_t _o = (size_t)(tok) * D + lane * 4; _Pragma("unroll") for (int _j = 0; _j < 4; ++_j) { \
        if (l == 0) xb[_j] = *(const f32x4*)(xin + _o + _j * 256); else xh[_j] = *(const u32x2*)(X + _o + _j * 256); \
        ob[_j] = *(const u32x2*)(OPRE + _o + _j * 256); } } while (0)
    LN1_LOAD(VBID * 16 + w);
    for (int item = VBID; item < S / 16; item += VNB) {
#pragma unroll 1
        for (int sub = 0; sub < 4; ++sub) {
            const int t = item * 16 + sub * 4 + w;
            f32x4 v[4]; float s = 0.f;
#pragma unroll
            for (int j = 0; j < 4; ++j) {
                const f32x4 xv = (l == 0) ? xb[j] : (f32x4){__uint_as_float(xh[j].x << 16), __uint_as_float(xh[j].x & 0xffff0000u), __uint_as_float(xh[j].y << 16), __uint_as_float(xh[j].y & 0xffff0000u)};
                const f32x4 ov = {__uint_as_float(ob[j].x << 16), __uint_as_float(ob[j].x & 0xffff0000u), __uint_as_float(ob[j].y << 16), __uint_as_float(ob[j].y & 0xffff0000u)};
                v[j] = xv * DN_ALPHA + cg1[j] * ov;
                s += (v[j].x + v[j].y) + (v[j].z + v[j].w);
            }
            {
                int tn = (sub < 3) ? t + 4 : (item + VNB) * 16 + w;
                if (tn >= S) tn = t;
                asm volatile("" ::: "memory");
                LN1_LOAD(tn);
                asm volatile("" ::: "memory");
            }
            const float mean = wave_sum(s) * (1.f / D);
            float s2 = 0.f;
#pragma unroll
            for (int j = 0; j < 4; ++j) { v[j] = v[j] - mean; s2 += (v[j].x * v[j].x + v[j].y * v[j].y) + (v[j].z * v[j].z + v[j].w * v[j].w); }
            const float rstd = rsqrtf(wave_sum(s2) * (1.f / D) + 1e-5f);
#pragma unroll
            for (int j = 0; j < 4; ++j) {
                const int c = j * 256 + lane * 4;
                f32x4 xo = v[j] * rstd * cg[j] + cb[j];
                *(u32x2*)(X + (size_t)t * D + c) = (u32x2){pk2(xo.x, xo.y), pk2(xo.z, xo.w)};
                f32x4 hh = xo * cG2[j] + cB2[j];
                *(f32x4*)(HS + (sub * 4 + w) * HSS + c) = hh;
                u32x2 o; o.x = pk2(hh.x, hh.y); o.y = pk2(hh.z, hh.w);
                *(u32x2*)(H2 + (size_t)t * D + c) = o;
            }
        }
        __syncthreads();
        f32x4 lacc[2] = {{0.f, 0.f, 0.f, 0.f}, {0.f, 0.f, 0.f, 0.f}};
        {
            const float* hrow = HS + fr * HSS + w * 256 + 8 * fq;
#pragma unroll
            for (int hb = 0; hb < 4; ++hb) {
                u32x4 bw[2][4];
#pragma unroll
                for (int s4 = 0; s4 < 2; ++s4)
#pragma unroll
                    for (int q = 0; q < 4; ++q) bw[s4][q] = RWF[((hb * 2 + s4) * 4 + q) * 64];
                asm volatile("" ::: "memory");
#pragma unroll
                for (int s4 = 0; s4 < 2; ++s4) {
                    const int ks = hb * 2 + s4;
                    const f32x4 h0 = *(const f32x4*)(hrow + 32 * ks), h1 = *(const f32x4*)(hrow + 32 * ks + 4);
                    const unsigned p0 = pk2(h0.x, h0.y), p1 = pk2(h0.z, h0.w), p2 = pk2(h1.x, h1.y), p3 = pk2(h1.z, h1.w);
                    const unsigned q0 = pk2(h0.x - __uint_as_float(p0 << 16), h0.y - __uint_as_float(p0 & 0xffff0000u));
                    const unsigned q1 = pk2(h0.z - __uint_as_float(p1 << 16), h0.w - __uint_as_float(p1 & 0xffff0000u));
                    const unsigned q2 = pk2(h1.x - __uint_as_float(p2 << 16), h1.y - __uint_as_float(p2 & 0xffff0000u));
                    const unsigned q3 = pk2(h1.z - __uint_as_float(p3 << 16), h1.w - __uint_as_float(p3 & 0xffff0000u));
                    const bf16x8 ahi = __builtin_bit_cast(bf16x8, ((u32x4){p0, p1, p2, p3})), alo = __builtin_bit_cast(bf16x8, ((u32x4){q0, q1, q2, q3}));
#pragma unroll
                    for (int n = 0; n < 2; ++n) {
                        const bf16x8 bhi = __builtin_bit_cast(bf16x8, bw[s4][2 * n]), blo = __builtin_bit_cast(bf16x8, bw[s4][2 * n + 1]);
                        lacc[n] = mfma16(ahi, bhi, lacc[n]); lacc[n] = mfma16(alo, bhi, lacc[n]); lacc[n] = mfma16(ahi, blo, lacc[n]);
                    }
                }
            }
        }
        __syncthreads();
#pragma unroll
        for (int n = 0; n < 2; ++n)
#pragma unroll
            for (int j = 0; j < 4; ++j) RED[(w * 16 + 4 * fq + j) * 32 + 16 * n + fr] = lacc[n][j];
        __syncthreads();
#pragma unroll 1
        for (int rnd = 0; rnd < 2; ++rnd) {
            const int tok = rnd * 8 + (tid >> 5), e = tid & 31, tt = item * 16 + tok;
            float logit = rbias[e];
#pragma unroll
            for (int ks = 0; ks < 4; ++ks) logit += RED[(ks * 16 + tok) * 32 + e];
            bool taken = false;
            float sv[4]; int si[4];
#pragma unroll
            for (int j = 0; j < 4; ++j) {
                float cand = taken ? -3.0e38f : logit; int ci = e;
#pragma unroll
                for (int off = 16; off >= 1; off >>= 1) {
                    const float ov = __shfl_xor(cand, off, 32); const int oi = __shfl_xor(ci, off, 32);
                    if (ov > cand || (ov == cand && oi < ci)) { cand = ov; ci = oi; }
                }
                sv[j] = cand; si[j] = ci; if (ci == e) taken = true;
            }
            const float e0 = 1.f, e1 = __expf(sv[1] - sv[0]), e2 = __expf(sv[2] - sv[0]), e3 = __expf(sv[3] - sv[0]);
            const float inv = 1.f / (e0 + e1 + e2 + e3);
            const float gts[4] = {e0 * inv, e1 * inv, e2 * inv, e3 * inv};
#pragma unroll
            for (int j = 0; j < 4; ++j) {
                if (si[j] == e) {
                    SEL[nasg + tok * 4 + j] = ((tt * 4 + j) << 5) | e;
                    GATE[(size_t)tt * 4 + j] = gts[j];
                }
            }
        }
        nasg += 64;
        __syncthreads();
    }
    if (!commit) return;
    if (tid < 32) {
        int c = 0;
        for (int a = 0; a < nasg; ++a) { if ((SEL[a] & 31) == tid) { RNK[a] = c; ++c; } }
        BASE[tid] = c ? atomicAdd(&CNT[tid * 64], c) : 0;
    }
    __syncthreads();
    for (int a = tid; a < nasg; a += NT) { const int v = SEL[a], e = v & 31; LIST[(size_t)e * S + BASE[e] + RNK[a]] = v >> 5; }
    __syncthreads();
#undef LN1_LOAD
}

DEVI void phase_ln2(const P& p, int l) {
    const float* ADA = (const float*)(p.ws + OFF_ADA) + l * 6144;
    const float* ADAn = (const float*)(p.ws + OFF_ADA) + 6144;
    bf16* X = (bf16*)(p.ws + WS_X); const bf16* YB = (const bf16*)(p.ws + WS_YB);
    bf16* HB = (bf16*)(p.ws + WS_HB);
    const float* lg = p.in[36] + l * D; const float* lb = p.in[37] + l * D;
    const int tid = VTID, lane = tid & 63, w = tid >> 6;
    f32x4 cg1[4], cg[4], cb[4], cG2[4], cB2[4];
#pragma unroll
    for (int j = 0; j < 4; ++j) {
        const int c = j * 256 + lane * 4;
        cg1[j] = *(const f32x4*)(ADA + 5120 + c) + 1.f; cg[j] = *(const f32x4*)(lg + c); cb[j] = *(const f32x4*)(lb + c);
        if (l == 0) { cB2[j] = *(const f32x4*)(ADAn + c); cG2[j] = *(const f32x4*)(ADAn + 1024 + c) + 1.f; }
        else { cB2[j] = cb[j]; cG2[j] = cg[j]; }
    }
    u32x2 xq[4]; u32x2 yq[4][4];
#define LN2_LOAD(tok) do { const size_t _o = (size_t)(tok) * D + lane * 4; _Pragma("unroll") for (int _j = 0; _j < 4; ++_j) { \
        xq[_j] = *(const u32x2*)(X + _o + _j * 256); \
        _Pragma("unroll") for (int _q = 0; _q < 4; ++_q) yq[_j][_q] = *(const u32x2*)(YB + ((size_t)(tok) * 4 + _q) * D + lane * 4 + _j * 256); } } while (0)
    LN2_LOAD(VBID * 4 + w);
    for (int item = VBID; item < S / 4; item += VNB) {
        const int t = item * 4 + w;
        f32x4 v[4]; float s = 0.f;
#pragma unroll
        for (int j = 0; j < 4; ++j) {
            f32x4 f = {0.f, 0.f, 0.f, 0.f};
#pragma unroll
            for (int q = 0; q < 4; ++q) {
                const u32x2 y = yq[j][q];
                f.x += __uint_as_float(y.x << 16); f.y += __uint_as_float(y.x & 0xffff0000u);
                f.z += __uint_as_float(y.y << 16); f.w += __uint_as_float(y.y & 0xffff0000u);
            }
            const f32x4 xv = {__uint_as_float(xq[j].x << 16), __uint_as_float(xq[j].x & 0xffff0000u), __uint_as_float(xq[j].y << 16), __uint_as_float(xq[j].y & 0xffff0000u)};
            v[j] = xv * DN_ALPHA + cg1[j] * f;
            s += (v[j].x + v[j].y) + (v[j].z + v[j].w);
        }
        {
            int tn = (item + VNB) * 4 + w;
            if (tn >= S) tn = t;
            asm volatile("" ::: "memory");
            LN2_LOAD(tn);
            asm volatile("" ::: "memory");
        }
        const float mean = wave_sum(s) * (1.f / D);
        float s2 = 0.f;
#pragma unroll
        for (int j = 0; j < 4; ++j) { v[j] = v[j] - mean; s2 += (v[j].x * v[j].x + v[j].y * v[j].y) + (v[j].z * v[j].z + v[j].w * v[j].w); }
        const float rstd = rsqrtf(wave_sum(s2) * (1.f / D) + 1e-5f);
#pragma unroll
        for (int j = 0; j < 4; ++j) {
            const int c = j * 256 + lane * 4;
            const f32x4 xo = v[j] * rstd * cg[j] + cb[j];
            if (l == 0) {
                *(u32x2*)(X + (size_t)t * D + c) = (u32x2){pk2(xo.x, xo.y), pk2(xo.z, xo.w)};
                const f32x4 hh = xo * cG2[j] + cB2[j];
                u32x2 o; o.x = pk2(hh.x, hh.y); o.y = pk2(hh.z, hh.w);
                *(u32x2*)(HB + (size_t)t * D + c) = o;
            } else {
                *(f32x4*)(p.out + (size_t)t * D + c) = xo;
            }
        }
    }
#undef LN2_LOAD
}

namespace pg8 {
constexpr int BK = 64, HALF = 128, HTB = HALF * BK * 2, STAGE_BYTES = 8 * HTB;
DEVI int lds_byte(int r, int c) { const int st = (r >> 4) * 2 + (c >> 5), rr = r & 15, cc = c & 31, ob = rr * 64 + cc * 2; return st * 1024 + (ob ^ (((ob >> 9) & 1) << 5)); }
DEVI void stage_rc(int b, int& R, int& C) { const int st = b / 1024, sb = b % 1024, swz = sb ^ (((sb >> 9) & 1) << 5); R = (st >> 1) * 16 + swz / 64; C = (st & 1) * 32 + (swz % 64) / 2; }
struct Unit { const char* a; const char* b; int x0, x1, x2, x3; };

template <class Epi, class Sched>
DEVI void gemm_phase(LAS unsigned char* lds, const int K, const Sched& S, const Epi& E) {
    const int tid = threadIdx.x, wid = __builtin_amdgcn_readfirstlane(tid >> 6), lane = tid & 63, wr = wid >> 2, wc = wid & 3, fr = lane & 15, fq = lane >> 4;
    const int nt = K / BK;
    unsigned voffA[2], voffB[2];
    int gR[2], gC[2];
#pragma unroll
    for (int i = 0; i < 2; ++i) { int R, C; stage_rc(tid * 16 + i * 8192, R, C); gR[i] = R; gC[i] = C; voffA[i] = (unsigned)(R * K + C) * 2u; voffB[i] = (unsigned)(Epi::brow(R) * K + C) * 2u; }
    unsigned co[2][2], no[2][2];
#define PG8_GOFF(dst, tab) do { _Pragma("unroll") for (int _h = 0; _h < 2; ++_h) _Pragma("unroll") for (int _i = 0; _i < 2; ++_i) \
        dst[_h][_i] = (unsigned)((tab)[_h * 128 + gR[_i]] * K + gC[_i]) * 2u; } while (0)
    const size_t kstep = (size_t)(BK * 2);
    const size_t hstepA = (size_t)HALF * K * 2, hstepB = (size_t)Epi::BHALF * K * 2;
    const unsigned ldsw = (unsigned)wid * 1024u;
    const int aoff = lds_byte(wr * 64 + fr, fq * 8), boff = lds_byte(wc * 32 + fr, fq * 8);
#define PG8_SA(b, h) (((b) * 2 + (h)) * HTB)
#define PG8_SB(b, h) ((4 + (b) * 2 + (h)) * HTB)
#define PG8_STAGE(bufoff, gbase, voff) do { _Pragma("unroll") for (int _i = 0; _i < 2; ++_i) \
        __builtin_amdgcn_global_load_lds((const unsigned*)((const char*)(gbase) + (voff)[_i]), (LAS unsigned*)(lds + (bufoff) + ldsw + _i * 8192), 16, 0, 0); } while (0)
#define PG8_LDA(dst, b, h) do { _Pragma("unroll") for (int m = 0; m < 4; ++m) _Pragma("unroll") for (int k = 0; k < 2; ++k) dst[m][k] = *(const LAS bf16x8*)(lds + PG8_SA(b, h) + aoff + m * 2048 + k * 1024); } while (0)
#define PG8_LDB(dst, b, h) do { _Pragma("unroll") for (int n = 0; n < 2; ++n) _Pragma("unroll") for (int k = 0; k < 2; ++k) dst[n][k] = *(const LAS bf16x8*)(lds + PG8_SB(b, h) + boff + n * 2048 + k * 1024); } while (0)
#define PG8_MMA(ai, bj, At, Bt) do { __builtin_amdgcn_s_setprio(1); _Pragma("unroll") for (int m = 0; m < 4; ++m) _Pragma("unroll") for (int n = 0; n < 2; ++n) _Pragma("unroll") for (int k = 0; k < 2; ++k) \
        acc[ai][bj][m][n] = __builtin_amdgcn_mfma_f32_16x16x32_bf16(Bt[n][k], At[m][k], acc[ai][bj][m][n], 0, 0, 0); __builtin_amdgcn_s_setprio(0); } while (0)
#define PG8_WAIT_V(n) asm volatile("s_waitcnt vmcnt(" #n ")" ::: "memory")
#define PG8_WAIT_L(n) asm volatile("s_waitcnt lgkmcnt(" #n ")" ::: "memory")
#define PG8_BAR __builtin_amdgcn_s_barrier()
#define PG8_SCHED __builtin_amdgcn_sched_barrier(0)
    Unit cur, nxt; int ui = 0;
    if (!S.next(0, cur)) return;
    f32x4 acc[2][2][4][2];
#pragma unroll
    for (int a = 0; a < 2; ++a)
#pragma unroll
        for (int b = 0; b < 2; ++b)
#pragma unroll
            for (int m = 0; m < 4; ++m)
#pragma unroll
                for (int n = 0; n < 2; ++n) acc[a][b][m][n] = (f32x4){0.f, 0.f, 0.f, 0.f};
    bf16x8 At[4][2], B0[2][2], B1[2][2];
    const char* cA = cur.a; const char* cB = cur.b;
    if constexpr (Epi::GATHER_A) { PG8_GOFF(co, S.rows(0)); PG8_WAIT_L(0); }
    else {
#pragma unroll
        for (int i = 0; i < 2; ++i) { co[0][i] = voffA[i]; co[1][i] = voffA[i] + (unsigned)hstepA; no[0][i] = co[0][i]; no[1][i] = co[1][i]; }
    }
    PG8_WAIT_V(0);
    PG8_STAGE(PG8_SB(0, 0), cB, voffB); PG8_STAGE(PG8_SA(0, 0), cA, co[0]); PG8_STAGE(PG8_SB(0, 1), cB + hstepB, voffB); PG8_STAGE(PG8_SA(0, 1), cA, co[1]);
    if (wr == 1) PG8_BAR;
    PG8_WAIT_V(4); PG8_BAR;
    PG8_STAGE(PG8_SB(1, 0), cB + kstep, voffB); PG8_STAGE(PG8_SA(1, 0), cA + kstep, co[0]); PG8_STAGE(PG8_SB(1, 1), cB + hstepB + kstep, voffB);
    PG8_WAIT_V(6); PG8_BAR;
    for (;;) {
        const bool has_next = S.next(ui + 1, nxt);
        const char* nA = has_next ? nxt.a : cA; const char* nB = has_next ? nxt.b : cB;
        if constexpr (Epi::GATHER_A) { if (has_next) PG8_GOFF(no, S.rows(ui + 1)); else { no[0][0] = co[0][0]; no[0][1] = co[0][1]; no[1][0] = co[1][0]; no[1][1] = co[1][1]; } }
        for (int t = 0; t < nt; t += 2) {
            const bool last = (t == nt - 2);
            const char* a1 = cA + (size_t)(t + 1) * kstep;
            const char* a2 = last ? nA : cA + (size_t)(t + 2) * kstep; const char* b2 = last ? nB : cB + (size_t)(t + 2) * kstep;
            const char* a3 = a2 + kstep; const char* b3 = b2 + kstep;
            unsigned fo[2][2];
#pragma unroll
            for (int h = 0; h < 2; ++h)
#pragma unroll
                for (int i = 0; i < 2; ++i) fo[h][i] = last ? no[h][i] : co[h][i];
            PG8_LDB(B0, 0, 0); PG8_SCHED; PG8_LDA(At, 0, 0); PG8_STAGE(PG8_SA(1, 1), a1, co[1]);
            PG8_WAIT_L(8); PG8_BAR; PG8_WAIT_L(0); PG8_MMA(0, 0, At, B0); PG8_BAR; PG8_SCHED;
            PG8_LDB(B1, 0, 1); PG8_STAGE(PG8_SB(0, 0), b2, voffB);
            PG8_BAR; PG8_WAIT_L(0); PG8_MMA(0, 1, At, B1); PG8_BAR;
            PG8_LDA(At, 0, 1); PG8_STAGE(PG8_SA(0, 0), a2, fo[0]);
            PG8_BAR; PG8_WAIT_L(0); PG8_MMA(1, 0, At, B0); PG8_BAR; PG8_SCHED;
            PG8_STAGE(PG8_SB(0, 1), b2 + hstepB, voffB);
            PG8_WAIT_V(6); PG8_BAR; PG8_MMA(1, 1, At, B1); PG8_BAR;
            PG8_LDB(B0, 1, 0); PG8_SCHED; PG8_LDA(At, 1, 0); PG8_STAGE(PG8_SA(0, 1), a2, fo[1]);
            PG8_WAIT_L(8); PG8_BAR; PG8_WAIT_L(0); PG8_MMA(0, 0, At, B0); PG8_BAR; PG8_SCHED;
            PG8_LDB(B1, 1, 1); PG8_STAGE(PG8_SB(1, 0), b3, voffB);
            PG8_BAR; PG8_WAIT_L(0); PG8_MMA(0, 1, At, B1); PG8_BAR;
            PG8_LDA(At, 1, 1); PG8_STAGE(PG8_SA(1, 0), a3, fo[0]);
            PG8_BAR; PG8_WAIT_L(0); PG8_MMA(1, 0, At, B0); PG8_BAR; PG8_SCHED;
            PG8_STAGE(PG8_SB(1, 1), b3 + hstepB, voffB);
            PG8_WAIT_V(6); PG8_BAR; PG8_MMA(1, 1, At, B1); PG8_BAR;
        }
        E(acc, cur, wr, wc, fr, fq);
        if (!has_next) break;
#pragma unroll
        for (int a = 0; a < 2; ++a)
#pragma unroll
            for (int b = 0; b < 2; ++b)
#pragma unroll
                for (int m = 0; m < 4; ++m)
#pragma unroll
                    for (int n = 0; n < 2; ++n) acc[a][b][m][n] = (f32x4){0.f, 0.f, 0.f, 0.f};
        cur = nxt; cA = nA; cB = nB; ++ui;
#pragma unroll
        for (int h = 0; h < 2; ++h) { co[h][0] = no[h][0]; co[h][1] = no[h][1]; }
    }
    PG8_WAIT_V(0);
    if (wr == 0) PG8_BAR;
    PG8_BAR;
#undef PG8_SA
#undef PG8_GOFF
#undef PG8_SB
#undef PG8_STAGE
#undef PG8_LDA
#undef PG8_LDB
#undef PG8_MMA
#undef PG8_WAIT_V
#undef PG8_WAIT_L
#undef PG8_BAR
#undef PG8_SCHED
}
}

struct SchedDense {
    const char* A; const char* B; int K; int mode;
    DEVI const int* rows(int) const { return nullptr; }
    DEVI bool next(int i, pg8::Unit& u) const {
        const int c = blockIdx.x, x = c & 7; int pm, pn;
        if (mode == 0) { if (i > 0) return false; const int j = c >> 3; pn = j & 3; pm = 8 * x + (j >> 2); }
        else { if (i > 3) return false; const int bk = i * 8 + x, j = c >> 3; pn = 8 * (bk & 1) + (j & 7); pm = 4 * (bk >> 1) + (j >> 3); }
        u.a = A + (size_t)pm * 256 * K * 2; u.b = B + (size_t)pn * 256 * K * 2; u.x0 = pm; u.x1 = pn; u.x2 = 0; u.x3 = 0;
        return true;
    }
};
struct EpiOutBf16 {
    static constexpr bool GATHER_A = false; static constexpr int BHALF = 128; static DEVI int brow(int R) { return R; }
    bf16* C;
    DEVI void operator()(const f32x4 (&acc)[2][2][4][2], const pg8::Unit& u, int wr, int wc, int fr, int fq) const {
#pragma unroll
        for (int ai = 0; ai < 2; ++ai)
#pragma unroll
            for (int m = 0; m < 4; ++m) {
                bf16* rowp = C + (size_t)(u.x0 * 256 + ai * 128 + wr * 64 + m * 16 + fr) * D + u.x1 * 256 + wc * 32 + 4 * fq;
#pragma unroll
                for (int bj = 0; bj < 2; ++bj)
#pragma unroll
                    for (int n = 0; n < 2; ++n) { const f32x4 v = acc[ai][bj][m][n]; *(u32x2*)(rowp + bj * 128 + n * 16) = (u32x2){pk2(v.x, v.y), pk2(v.z, v.w)}; }
            }
    }
};
struct EpiProjBf16 {
    static constexpr bool GATHER_A = false; static constexpr int BHALF = 128; static DEVI int brow(int R) { return R; }
    bf16* C;
    DEVI void operator()(const f32x4 (&acc)[2][2][4][2], const pg8::Unit& u, int wr, int wc, int fr, int fq) const {
#pragma unroll
        for (int ai = 0; ai < 2; ++ai)
#pragma unroll
            for (int m = 0; m < 4; ++m) {
                bf16* rowp = C + (size_t)(u.x0 * 256 + ai * 128 + wr * 64 + m * 16 + fr) * NPROJ + u.x1 * 256 + wc * 32 + 4 * fq;
#pragma unroll
                for (int bj = 0; bj < 2; ++bj)
#pragma unroll
                    for (int n = 0; n < 2; ++n) { const f32x4 v = acc[ai][bj][m][n]; *(u32x2*)(rowp + bj * 128 + n * 16) = (u32x2){pk2(v.x, v.y), pk2(v.z, v.w)}; }
            }
    }
};
DEVI void phase_outproj8(const P& p, int l, char* smem_all) {
    SchedDense Sd{(const char*)(p.ws + WS_MIX), (const char*)(p.ws + WS_WOUT) + (size_t)l * D * D * 2, D, 0};
    EpiOutBf16 E{(bf16*)(p.ws + WS_OPRE)};
    pg8::gemm_phase(( LAS unsigned char*)smem_all, D, Sd, E);
}
DEVI void phase_inproj8(const P& p, int l, char* smem_all) {
    SchedDense Sd{(const char*)(p.ws + WS_HB), (const char*)(p.ws + WS_WIN) + (size_t)l * NPAD * D * 2, D, 1};
    EpiProjBf16 E{(bf16*)(p.ws + WS_PROJ)};
    pg8::gemm_phase((LAS unsigned char*)smem_all, D, Sd, E);
}
DEVI void phase_inproj_extras(const P& p, int l, char* smem) {
    const bf16* HB = (const bf16*)(p.ws + WS_HB);
    const bf16* W = (const bf16*)(p.ws + WS_WIN) + (size_t)l * NPAD * D;
    float* PEX = (float*)(p.ws + WS_PEX);
    const int lane = VTID & 63, wid = VTID >> 6, wr = wid >> 1, wc = wid & 1, fr = lane & 15, fq = lane >> 4;
    for (int mt = VBID; mt < S / 128; mt += VNB) {
        f32x4 acc[4][8];
        gemm_tile(smem, HB, [&](int r) { return (unsigned)((mt * 128 + r) * D); }, W, [&](int r) { return (unsigned)((16 * 256 + r) * D); }, D, acc);
        if (wc == 0) {
#pragma unroll
            for (int m = 0; m < 4; ++m) {
                const int tok = mt * 128 + wr * 64 + m * 16 + fr;
#pragma unroll
                for (int n = 0; n < 4; ++n) *(f32x4*)(PEX + (size_t)tok * 64 + n * 16 + fq * 4) = acc[m][n];
            }
        }
    }
}

struct MoeMap8 { int cnt[32]; int off[32]; int tstart[33]; };
DEVI void moe_map8(const P& p, int l, MoeMap8* mm) {
    const int* CNT = (const int*)(p.ws + OFF_CNT) + l * 32 * 64;
    if (threadIdx.x < 32) mm->cnt[threadIdx.x] = __hip_atomic_load(&CNT[threadIdx.x * 64], __ATOMIC_RELAXED, __HIP_MEMORY_SCOPE_AGENT);
    __syncthreads();
    if (threadIdx.x == 0) {
        int o = 0, ts = 0;
        for (int e = 0; e < 32; ++e) { mm->off[e] = o; mm->tstart[e] = ts; o += mm->cnt[e]; ts += (mm->cnt[e] + 255) / 256; }
        mm->tstart[32] = ts;
    }
    __syncthreads();
}
struct MoeUnits { int n; int pad[3]; int e[32]; int m0[32]; int pn[32]; };
struct SchedMoe {
    const MoeMap8* mm; const MoeUnits* mu; const char* A; const char* Bw; int K;
    size_t bexp, bpn;
    const int* rowtab; bool gather;
    DEVI const int* rows(int i) const { return rowtab + 256 * i; }
    DEVI bool next(int i, pg8::Unit& u) const {
        if (i >= mu->n) return false;
        const int e = mu->e[i], m0 = mu->m0[i], pn = mu->pn[i], off = mm->off[e];
        u.a = gather ? A : A + (size_t)(off + m0) * K * 2; u.b = Bw + (size_t)e * bexp + (size_t)pn * bpn;
        u.x0 = e; u.x1 = m0; u.x2 = pn; u.x3 = off;
        return true;
    }
};
DEVI void moe_units(const MoeMap8* mm, MoeUnits* mu, int npn_log, int pnb_log) {
    if (threadIdx.x < 32) {
        const int x = (int)blockIdx.x & 7, j = (int)blockIdx.x >> 3, RT = mm->tstart[32], rpb = 32 >> pnb_log, nh_log = npn_log - pnb_log;
        const int bk = (int)threadIdx.x * 8 + x, rg = bk >> nh_log, ph = bk & ((1 << nh_log) - 1);
        const int rt = rpb * rg + (j >> pnb_log), pn = (ph << pnb_log) + (j & ((1 << pnb_log) - 1));
        const bool ok = rt < RT;
        if (ok) {
            int e = 0;
            while (mm->tstart[e + 1] <= rt) ++e;
            mu->e[threadIdx.x] = e; mu->m0[threadIdx.x] = (rt - mm->tstart[e]) * 256; mu->pn[threadIdx.x] = pn;
        }
        const unsigned long long okm = __ballot(ok);
        if (threadIdx.x == 0) mu->n = __popcll(okm & 0xffffffffull);
    }
    __syncthreads();
}
struct EpiMoeUp {
    static constexpr bool GATHER_A = true;
    static constexpr int BHALF = 64;
    static DEVI int brow(int R) { return ((R >> 5) & 3) * 16 + (R & 15) + (((R >> 4) & 1) ? 1024 : 0); }
    const MoeMap8* mm; bf16* ACT; const float* bup; bf16* dump;
    DEVI void operator()(const f32x4 (&acc)[2][2][4][2], const pg8::Unit& u, int wr, int wc, int fr, int fq) const {
        const int e = u.x0, cnt = mm->cnt[e];
        const float* be = bup + (size_t)e * 2048;
        f32x4 bg[2], bl[2];
#pragma unroll
        for (int bj = 0; bj < 2; ++bj) { const int col = u.x2 * 128 + (bj * 4 + wc) * 16 + 4 * fq; bg[bj] = *(const f32x4*)(be + col); bl[bj] = *(const f32x4*)(be + 1024 + col); }
#pragma unroll
        for (int ai = 0; ai < 2; ++ai)
#pragma unroll
            for (int m = 0; m < 4; ++m) {
                const int r = u.x1 + ai * 128 + wr * 64 + m * 16 + fr;
                bf16* rowp = (r < cnt) ? ACT + (size_t)(u.x3 + r) * DFF + u.x2 * 128 + wc * 16 + 4 * fq : dump + 4 * fq;
#pragma unroll
                for (int bj = 0; bj < 2; ++bj) {
                    float o[4];
#pragma unroll
                    for (int j = 0; j < 4; ++j) {
                        const float glu = fminf(acc[ai][bj][m][0][j] + bg[bj][j], 7.f);
                        const float lin = fminf(fmaxf(acc[ai][bj][m][1][j] + bl[bj][j], -7.f), 7.f);
                        o[j] = glu * sigmoidf_(1.702f * glu) * (lin + 1.f);
                    }
                    *(u32x2*)(rowp + bj * 64) = (u32x2){pk2(o[0], o[1]), pk2(o[2], o[3])};
                }
            }
    }
};
struct EpiMoeDown {
    static constexpr bool GATHER_A = false; static constexpr int BHALF = 128; static DEVI int brow(int R) { return R; }
    const MoeMap8* mm; bf16* YB; const float* bdn; const int* LIST; const float* GATE; bf16* dump;
    DEVI void operator()(const f32x4 (&acc)[2][2][4][2], const pg8::Unit& u, int wr, int wc, int fr, int fq) const {
        const int e = u.x0, cnt = mm->cnt[e];
        const float* be = bdn + (size_t)e * D + u.x2 * 256 + wc * 32 + 4 * fq;
        f32x4 bv[2][2];
#pragma unroll
        for (int bj = 0; bj < 2; ++bj)
#pragma unroll
            for (int n = 0; n < 2; ++n) bv[bj][n] = *(const f32x4*)(be + bj * 128 + n * 16);
        int ent[8]; float gt[8];
#pragma unroll
        for (int q = 0; q < 8; ++q) { const int r = u.x1 + (q >> 2) * 128 + wr * 64 + (q & 3) * 16 + fr; ent[q] = LIST[(size_t)e * S + (r < cnt ? r : cnt - 1)]; }
#pragma unroll
        for (int q = 0; q < 8; ++q) gt[q] = GATE[ent[q]];
#pragma unroll
        for (int ai = 0; ai < 2; ++ai)
#pragma unroll
            for (int m = 0; m < 4; ++m) {
                const int q = ai * 4 + m, r = u.x1 + ai * 128 + wr * 64 + m * 16 + fr;
                bf16* rowp = (r < cnt) ? YB + (size_t)ent[q] * D + u.x2 * 256 + wc * 32 + 4 * fq : dump + 4 * fq;
#pragma unroll
                for (int bj = 0; bj < 2; ++bj)
#pragma unroll
                    for (int n = 0; n < 2; ++n) {
                        const f32x4 v = (acc[ai][bj][m][n] + bv[bj][n]) * gt[q];
                        *(u32x2*)(rowp + bj * 128 + n * 16) = (u32x2){pk2(v.x, v.y), pk2(v.z, v.w)};
                    }
            }
    }
};
DEVI void phase_moe_up8(const P& p, int l, char* smem_all) {
    MoeMap8* mm = (MoeMap8*)(smem_all + 131072);
    moe_map8(p, l, mm);
    MoeUnits* mu = (MoeUnits*)(smem_all + 131072 + 512);
    moe_units(mm, mu, 3, 3);
    int* rowtab = (int*)(smem_all + 131072 + 1024);
    {
        const int* LIST = (const int*)(p.ws + WS_LIST);
        const int nu = mu->n < 12 ? mu->n : 12;
        for (int idx = threadIdx.x; idx < nu * 256; idx += KT) {
            const int i = idx >> 8, r = idx & 255, e = mu->e[i], cnt = mm->cnt[e], rr = mu->m0[i] + r;
            rowtab[idx] = LIST[(size_t)e * S + (rr < cnt ? rr : cnt - 1)] >> 2;
        }
        __syncthreads();
    }
    SchedMoe Sm{mm, mu, (const char*)(p.ws + WS_H2), (const char*)(p.ws + WS_WUP) + (size_t)l * NEXP * 2048 * D * 2, D, (size_t)2048 * D * 2, (size_t)128 * D * 2, rowtab, true};
    EpiMoeUp E{mm, (bf16*)(p.ws + WS_ACT), p.in[33] + (size_t)l * NEXP * 2048, (bf16*)(p.ws + WS_DUMP)};
    pg8::gemm_phase((LAS unsigned char*)smem_all, D, Sm, E);
}
DEVI void phase_moe_down8(const P& p, int l, char* smem_all) {
    MoeMap8* mm = (MoeMap8*)(smem_all + 131072);
    moe_map8(p, l, mm);
    MoeUnits* mu = (MoeUnits*)(smem_all + 131072 + 512);
    moe_units(mm, mu, 2, 2);
    SchedMoe Sm{mm, mu, (const char*)(p.ws + WS_ACT), (const char*)(p.ws + WS_WDN) + (size_t)l * NEXP * D * DFF * 2, DFF, (size_t)D * DFF * 2, (size_t)256 * DFF * 2, nullptr, false};
    EpiMoeDown E{mm, (bf16*)(p.ws + WS_YB), p.in[35] + (size_t)l * NEXP * D, (const int*)(p.ws + WS_LIST), (const float*)(p.ws + WS_GATE), (bf16*)(p.ws + WS_DUMP)};
    pg8::gemm_phase((LAS unsigned char*)smem_all, DFF, Sm, E);
}

constexpr int NPHASE = 24;
constexpr int LDS_TOTAL = 2 * VB_LDS + 64;
__global__ void __launch_bounds__(KT, 2) k_run(P p) {
    extern __shared__ __attribute__((aligned(16))) char smem_all[];
    char* smem = smem_all + __builtin_amdgcn_readfirstlane((int)(threadIdx.x >> 8)) * VB_LDS;
    XcdBarrier bar; bar.bar = nullptr; bar.x = 0; bar.st = nullptr;
    const bool multi = (p.ph_hi - p.ph_lo) > 1;
    if (multi) {
        volatile LAS unsigned* st = (volatile LAS unsigned*)(smem_all + 2 * VB_LDS);
        if (threadIdx.x == 0) { st[0] = 0u; st[1] = 0u; }
        __syncthreads();
        bar = xcd_barrier_post((unsigned*)(p.ws + OFF_BAR), st);
    }
#ifndef DUP
#define DUP -1
#endif
#ifndef DUP2
#define DUP2 -1
#endif
#define RUN(k, call) if (p.ph_lo <= (k) && (k) < p.ph_hi) { for (int _rep = ((k) == DUP || (k) == DUP2) ? 2 : 1; _rep > 0; --_rep) { call; if (multi && ((k) + 1 < p.ph_hi || _rep > 1)) xcd_barrier(bar); } }
    RUN(0, phase_prep(p, smem))
    RUN(1, phase_h0(p))
    RUN(2, { phase_inproj8(p, 0, smem_all); phase_inproj_extras(p, 0, smem); })
    RUN(3, phase_mixprep(p, 0, smem))
    RUN(4, phase_chunkA(p, smem))
    RUN(5, phase_scanL1(p, smem))
    RUN(6, phase_scanL2(p, 0, smem))
    RUN(7, phase_chunkC(p, 0, smem))
    RUN(8, phase_outproj8(p, 0, smem_all))
    RUN(9, phase_ln1_route(p, 0, smem, _rep == 1))
    RUN(10, phase_moe_up8(p, 0, smem_all))
    RUN(11, phase_moe_down8(p, 0, smem_all))
    RUN(12, phase_ln2(p, 0))
    RUN(13, { phase_inproj8(p, 1, smem_all); phase_inproj_extras(p, 1, smem); })
    RUN(14, phase_mixprep(p, 1, smem))
    RUN(15, phase_chunkA(p, smem))
    RUN(16, phase_scanL1(p, smem))
    RUN(17, phase_scanL2(p, 1, smem))
    RUN(18, phase_chunkC(p, 1, smem))
    RUN(19, phase_outproj8(p, 1, smem_all))
    RUN(20, phase_ln1_route(p, 1, smem))
    RUN(21, phase_moe_up8(p, 1, smem_all))
    RUN(22, phase_moe_down8(p, 1, smem_all))
    RUN(23, phase_ln2(p, 1))
#undef RUN
}

extern "C" void kernel_launch(void* const* d_in, const int* in_sizes, int n_in, void* d_out, int out_size, void* d_ws, size_t ws_size,
                              hipStream_t stream) {
    static int grid = 0;
    if (grid == 0) {
        if (n_in != 38 || ws_size < WS_END) { fprintf(stderr, "kernel_launch: unexpected n_in %d or ws_size %zu (< %zu)\n", n_in, ws_size, (size_t)WS_END); grid = -1; return; }
        int dev = 0, cus = 0, per_cu = 0;
        hipGetDevice(&dev);
        hipDeviceGetAttribute(&cus, hipDeviceAttributeMultiprocessorCount, dev);
        hipFuncSetAttribute((const void*)k_run, hipFuncAttributeMaxDynamicSharedMemorySize, LDS_TOTAL);
        hipOccupancyMaxActiveBlocksPerMultiprocessor(&per_cu, (const void*)k_run, KT, LDS_TOTAL);
        if (per_cu < 1) { fprintf(stderr, "kernel_launch: occupancy query returned %d\n", per_cu); grid = -1; return; }
        if (cus != 256) { fprintf(stderr, "kernel_launch: built for 256 CUs (one workgroup per CU), device has %d\n", cus); grid = -1; return; }
        grid = cus;
    }
    if (grid < 0) return;
    hipMemsetAsync((char*)d_ws + WS_CTL, 0, CTL_BYTES, stream);
    P p{};
    for (int i = 0; i < 38; ++i) p.in[i] = (const float*)d_in[i];
    p.pos = (const int*)d_in[2];
    p.out = (float*)d_out; p.ws = (char*)d_ws;
#if MEGA
    p.ph_lo = 0; p.ph_hi = NPHASE;
    void* args[] = {&p};
    hipError_t e = hipLaunchCooperativeKernel((const void*)k_run, dim3(grid), dim3(KT), args, LDS_TOTAL, stream);
    if (e != hipSuccess) fprintf(stderr, "cooperative launch failed: %s (grid %d)\n", hipGetErrorString(e), grid);
#else
    for (int ph = 0; ph < NPHASE; ++ph) {
        p.ph_lo = ph; p.ph_hi = ph + 1;
        hipLaunchKernelGGL(k_run, dim3(grid), dim3(KT), LDS_TOTAL, stream, p);
    }
#endif
}
```
